# Optimizing an MI355X kernel written in HIP

```python
import jax, jax.numpy as jnp
from jax import lax
import numpy as np

D_MODEL = 1024
BATCH = 1
SEQ = 16384
DEPTH = 1

D_MIX = D_MODEL
SB_HEADS = 8
SB_HEAD_DIM = 64
D_SB = SB_HEADS * SB_HEAD_DIM
D_RG = D_MIX - D_SB
RG_BLOCKS = 8
RG_BLOCK_DIM = D_RG // RG_BLOCKS
CONV_WIDTH = 4
RG_C = 8.0
D_IN_PROJ = 3 * D_SB + 2 * D_RG
Q_BLOCK = 128
PEER_HEADS = 8
PEER_N_KEYS = 128
PEER_N_EXPERTS = PEER_N_KEYS * PEER_N_KEYS
PEER_D_KEY = 256
PEER_HALF = PEER_D_KEY // 2
PEER_TOPK = 16
TOKEN_CHUNK = 128
EPS = 1e-6

kernel_name = "hymba_stickbreak_rglru_peer"


def rms_norm(x, g):
    xf = x.astype(jnp.float32)
    y = xf * lax.rsqrt(jnp.mean(xf * xf, axis=-1, keepdims=True) + EPS)
    return (y * g.astype(jnp.float32)).astype(x.dtype)


def stick_breaking_attention(q, k, v):
    B, H, S, Dh = q.shape
    nb = S // Q_BLOCK
    scale = Dh ** -0.5
    kpos = jnp.arange(S)

    def block(i):
        q_blk = lax.dynamic_slice_in_dim(q, i * Q_BLOCK, Q_BLOCK, axis=2)
        qpos = i * Q_BLOCK + jnp.arange(Q_BLOCK)
        causal = kpos[None, :] < qpos[:, None]
        z = jnp.einsum('bhqd,bhkd->bhqk', q_blk, k).astype(jnp.float32) * scale
        log_beta = jax.nn.log_sigmoid(z)
        log_one_minus = jnp.where(causal, jax.nn.log_sigmoid(-z), 0.0)
        suffix = lax.cumsum(log_one_minus, axis=3, reverse=True) - log_one_minus
        w = jnp.where(causal, jnp.exp(log_beta + suffix), 0.0)
        return jnp.einsum('bhqk,bhkd->bhqd', w.astype(v.dtype), v)

    out = lax.map(block, jnp.arange(nb))
    return out.transpose(1, 2, 0, 3, 4).reshape(B, H, S, Dh)


def causal_depthwise_conv(x, w, bias):
    S = x.shape[1]
    xp = jnp.pad(x, ((0, 0), (CONV_WIDTH - 1, 0), (0, 0)))
    y = xp[:, 0:S, :] * w[0]
    for j in range(1, CONV_WIDTH):
        y = y + xp[:, j:j + S, :] * w[j]
    return y + bias


def rg_lru(x, w_a, b_a, w_x, b_x, lam):
    B, S, C = x.shape
    xb = x.reshape(B, S, RG_BLOCKS, RG_BLOCK_DIM)
    r = jax.nn.sigmoid(jnp.einsum('bsni,nij->bsnj', xb, w_a).reshape(B, S, C) + b_a)
    i_gate = jax.nn.sigmoid(jnp.einsum('bsni,nij->bsnj', xb, w_x).reshape(B, S, C) + b_x)
    log_a = -RG_C * r.astype(jnp.float32) * jax.nn.softplus(-lam.astype(jnp.float32))
    a = jnp.exp(log_a)
    b = jnp.sqrt(-jnp.expm1(2.0 * log_a)) * (i_gate * x).astype(jnp.float32)

    def step(h, ab):
        a_t, b_t = ab
        h = a_t * h + b_t
        return h, h

    h0 = jnp.zeros((B, C), jnp.float32)
    _, hs = lax.scan(step, h0, (a.transpose(1, 0, 2), b.transpose(1, 0, 2)))
    return hs.transpose(1, 0, 2).astype(x.dtype)


def peer_ffn(x, w_query, sub_keys, expert_u, expert_v):
    B, S, D = x.shape
    T = B * S
    xt = x.reshape(T // TOKEN_CHUNK, TOKEN_CHUNK, D)

    def chunk(xc):
        q = jnp.einsum('td,dhk->thk', xc, w_query)
        q = q.reshape(TOKEN_CHUNK, PEER_HEADS, 2, PEER_HALF)
        s = jnp.einsum('thpk,hpnk->thpn', q, sub_keys).astype(jnp.float32)
        top_s, top_i = lax.top_k(s, PEER_TOPK)
        cand_s = top_s[:, :, 0, :, None] + top_s[:, :, 1, None, :]
        cand_i = top_i[:, :, 0, :, None] * PEER_N_KEYS + top_i[:, :, 1, None, :]
        cand_s = cand_s.reshape(TOKEN_CHUNK, PEER_HEADS, PEER_TOPK * PEER_TOPK)
        cand_i = cand_i.reshape(TOKEN_CHUNK, PEER_HEADS, PEER_TOPK * PEER_TOPK)
        best_s, best_pos = lax.top_k(cand_s, PEER_TOPK)
        idx = jnp.take_along_axis(cand_i, best_pos, axis=-1)
        g = jax.nn.softmax(best_s, axis=-1)
        u = jnp.take(expert_u, idx, axis=0)
        v = jnp.take(expert_v, idx, axis=0)
        act = jax.nn.gelu(jnp.einsum('td,thkd->thk', xc, u))
        return jnp.einsum('thk,thkd->td', (g * act).astype(v.dtype), v)

    y = lax.map(chunk, xt)
    return y.reshape(B, S, D)


def setup_inputs(seed: int = 0) -> dict:
    key = jax.random.key(seed)
    ks = jax.random.split(key, 24)
    f32 = jnp.float32

    def nrm(k, shape, scale):
        return jax.random.normal(k, shape, f32) * scale

    def gain(k, shape):
        return 1.0 + 0.02 * jax.random.normal(k, shape, f32)

    u_a = jax.random.uniform(ks[11], (DEPTH, D_RG), f32, 0.9, 0.999)
    a_base = u_a ** (1.0 / RG_C)
    rg_lambda = jnp.log(a_base) - jnp.log1p(-a_base)
    return {
        "x": jax.random.normal(ks[0], (BATCH, SEQ, D_MODEL), f32),
        "norm_mix": gain(ks[1], (DEPTH, D_MODEL)),
        "w_in": nrm(ks[2], (DEPTH, D_MODEL, D_IN_PROJ), D_MODEL ** -0.5),
        "q_norm": gain(ks[3], (DEPTH, SB_HEAD_DIM)),
        "k_norm": gain(ks[4], (DEPTH, SB_HEAD_DIM)),
        "conv_w": nrm(ks[5], (DEPTH, CONV_WIDTH, D_RG), CONV_WIDTH ** -0.5),
        "conv_b": nrm(ks[6], (DEPTH, D_RG), 0.01),
        "rg_w_a": nrm(ks[7], (DEPTH, RG_BLOCKS, RG_BLOCK_DIM, RG_BLOCK_DIM), RG_BLOCK_DIM ** -0.5),
        "rg_b_a": nrm(ks[8], (DEPTH, D_RG), 0.01),
        "rg_w_x": nrm(ks[9], (DEPTH, RG_BLOCKS, RG_BLOCK_DIM, RG_BLOCK_DIM), RG_BLOCK_DIM ** -0.5),
        "rg_b_x": nrm(ks[10], (DEPTH, D_RG), 0.01),
        "rg_lambda": rg_lambda,
        "out_norm_sb": gain(ks[12], (DEPTH, D_SB)),
        "out_norm_rg": gain(ks[13], (DEPTH, D_RG)),
        "w_out": nrm(ks[14], (DEPTH, D_MIX, D_MODEL), D_MIX ** -0.5),
        "norm_ffn": gain(ks[15], (DEPTH, D_MODEL)),
        "peer_w_query": nrm(ks[16], (DEPTH, D_MODEL, PEER_HEADS, PEER_D_KEY), D_MODEL ** -0.5),
        "peer_sub_keys": nrm(ks[17], (DEPTH, PEER_HEADS, 2, PEER_N_KEYS, PEER_HALF), PEER_HALF ** -0.5),
        "peer_u": nrm(ks[18], (DEPTH, PEER_N_EXPERTS, D_MODEL), D_MODEL ** -0.5),
        "peer_v": nrm(ks[19], (DEPTH, PEER_N_EXPERTS, D_MODEL), PEER_HEADS ** -0.5),
    }


def reference(x, norm_mix, w_in, q_norm, k_norm, conv_w, conv_b, rg_w_a, rg_b_a,
              rg_w_x, rg_b_x, rg_lambda, out_norm_sb, out_norm_rg, w_out, norm_ffn,
              peer_w_query, peer_sub_keys, peer_u, peer_v):
    B, S, _ = x.shape
    for l in range(DEPTH):
        h = rms_norm(x, norm_mix[l])
        proj = jnp.einsum('bsd,de->bse', h, w_in[l])
        q = proj[:, :, 0:D_SB]
        k = proj[:, :, D_SB:2 * D_SB]
        v = proj[:, :, 2 * D_SB:3 * D_SB]
        x_rg = proj[:, :, 3 * D_SB:3 * D_SB + D_RG]
        g_rg = proj[:, :, 3 * D_SB + D_RG:D_IN_PROJ]

        def to_heads(t):
            return t.reshape(B, S, SB_HEADS, SB_HEAD_DIM).transpose(0, 2, 1, 3)

        qh = rms_norm(to_heads(q), q_norm[l])
        kh = rms_norm(to_heads(k), k_norm[l])
        o_sb = stick_breaking_attention(qh, kh, to_heads(v))
        o_sb = o_sb.transpose(0, 2, 1, 3).reshape(B, S, D_SB)

        x_rg = causal_depthwise_conv(x_rg, conv_w[l], conv_b[l])
        o_rg = rg_lru(x_rg, rg_w_a[l], rg_b_a[l], rg_w_x[l], rg_b_x[l], rg_lambda[l])
        o_rg = o_rg * jax.nn.gelu(g_rg)

        mixed = jnp.concatenate(
            [rms_norm(o_sb, out_norm_sb[l]), rms_norm(o_rg, out_norm_rg[l])], axis=-1)
        x = x + jnp.einsum('bse,ed->bsd', mixed, w_out[l])

        h = rms_norm(x, norm_ffn[l])
        x = x + peer_ffn(h, peer_w_query[l], peer_sub_keys[l], peer_u[l], peer_v[l])
    return x
```

```cpp
#include <hip/hip_runtime.h>
#include <cstdint>
#include <cstdio>

typedef unsigned short bf16_t;
typedef short bf16x8 __attribute__((ext_vector_type(8)));
typedef float f32x4 __attribute__((ext_vector_type(4)));
typedef unsigned u32x4 __attribute__((ext_vector_type(4)));

constexpr int S = 16384, D = 1024, NPROJ = 2560, DSB = 512, DRG = 512, NH = 8, HD = 64;
constexpr int PH = 8, PNK = 128, PDK = 256, PHALF = 128, PTOPK = 16, NEXP = 16384, NQ = PH * PDK;
constexpr int CHUNK = 64, NCHUNK = S / CHUNK;
constexpr float EPS = 1e-6f;
constexpr float LOG2E = 1.4426950408889634f;
constexpr float QSCALE = 0.125f * LOG2E;
constexpr float CARRY_STOP = -160.0f;

constexpr size_t MiB = 1u << 20;
constexpr size_t WS_CTL = 0;
constexpr size_t WS_WINT = 1 * MiB;
constexpr size_t WS_WOUTT = 6 * MiB;
constexpr size_t WS_WQT = 8 * MiB;
constexpr size_t WS_SUBK = 12 * MiB;
constexpr size_t WS_RSTD1 = 12 * MiB + 512 * 1024;
constexpr size_t WS_RSTD2 = WS_RSTD1 + 64 * 1024;
constexpr size_t WS_RGP = WS_RSTD2 + 64 * 1024;
constexpr size_t WS_RGH = WS_RGP + 512 * 1024;
constexpr size_t WS_A = 14 * MiB;
constexpr size_t WS_B = 46 * MiB;
constexpr size_t WS_QH = WS_B, WS_KH = WS_B + 16 * MiB, WS_VH = WS_B + 32 * MiB, WS_XRG = WS_B + 48 * MiB;
constexpr size_t WS_GG = 110 * MiB;
constexpr size_t WS_OSB = 126 * MiB;
constexpr size_t WS_MIX = 142 * MiB;
constexpr size_t WS_SELI = WS_MIX, WS_SELG = WS_MIX + 8 * MiB;
constexpr size_t WS_UB = 174 * MiB;
constexpr size_t WS_VB = 206 * MiB;
constexpr size_t WS_END = 238 * MiB;

__device__ __forceinline__ unsigned f2bf(float f) { unsigned u = __builtin_bit_cast(unsigned, f); return (u + 0x7fffu + ((u >> 16) & 1u)) >> 16; }
__device__ __forceinline__ float bf2f(unsigned h) { return __builtin_bit_cast(float, h << 16); }
__device__ __forceinline__ unsigned pk2(float lo, float hi) { return f2bf(lo) | (f2bf(hi) << 16); }
__device__ __forceinline__ float wave_sum(float v) {
#pragma unroll
    for (int o = 1; o < 64; o <<= 1) v += __shfl_xor(v, o);
    return v;
}
__device__ __forceinline__ float gelu_tanh(float x) {
    const float u = 0.7978845608028654f * (x + 0.044715f * x * x * x);
    const float e = __expf(2.0f * u);
    const float th = 1.0f - 2.0f / (e + 1.0f);
    return 0.5f * x * (1.0f + th);
}
__device__ __forceinline__ float sigmoidf_(float x) { return 1.0f / (1.0f + __expf(-x)); }

struct Params {
    const float* in[20];
    float* out;
    unsigned char* ws;
};
enum { I_X = 0, I_NORM_MIX, I_W_IN, I_Q_NORM, I_K_NORM, I_CONV_W, I_CONV_B, I_RG_W_A, I_RG_B_A, I_RG_W_X, I_RG_B_X, I_RG_LAMBDA,
       I_OUT_NORM_SB, I_OUT_NORM_RG, I_W_OUT, I_NORM_FFN, I_PEER_WQ, I_PEER_SUBK, I_PEER_U, I_PEER_V };

__device__ void prep_transpose(const float* W, const float* gain0, const float* gain1, int K, int N, bf16_t* WT, int gtid, int gsize) {
    for (long e = gtid; e < (long)K * N; e += gsize) {
        const int k = (int)(e / N), n = (int)(e % N);
        float g = 1.0f;
        if (gain0) g = (gain1 && k >= 512) ? gain1[k - 512] : gain0[k];
        WT[(size_t)n * K + k] = (bf16_t)f2bf(g * W[e]);
    }
}
__global__ void __launch_bounds__(256) k_prep(Params p) {
    const int gtid = blockIdx.x * blockDim.x + threadIdx.x, gsize = gridDim.x * blockDim.x;
    const int lane = threadIdx.x & 63, gwave = gtid >> 6, nwave = gsize >> 6;
    unsigned char* ws = p.ws;
    prep_transpose(p.in[I_W_IN], p.in[I_NORM_MIX], nullptr, D, NPROJ, (bf16_t*)(ws + WS_WINT), gtid, gsize);
    prep_transpose(p.in[I_W_OUT], p.in[I_OUT_NORM_SB], p.in[I_OUT_NORM_RG], D, D, (bf16_t*)(ws + WS_WOUTT), gtid, gsize);
    prep_transpose(p.in[I_PEER_WQ], p.in[I_NORM_FFN], nullptr, D, NQ, (bf16_t*)(ws + WS_WQT), gtid, gsize);
    {
        const float* sk = p.in[I_PEER_SUBK]; bf16_t* o = (bf16_t*)(ws + WS_SUBK);
        for (int e = gtid; e < PH * 2 * PNK * PHALF; e += gsize) o[e] = (bf16_t)f2bf(sk[e]);
    }
    {
        const float* u = p.in[I_PEER_U]; const float* v = p.in[I_PEER_V]; const float* g = p.in[I_NORM_FFN];
        uint2* ub = (uint2*)(ws + WS_UB); uint2* vb = (uint2*)(ws + WS_VB);
        for (long e = gtid; e < (long)NEXP * D / 4; e += gsize) {
            const f32x4 a = ((const f32x4*)u)[e], b = ((const f32x4*)v)[e];
            const int d0 = (int)((e * 4) % D);
            const f32x4 gg = *(const f32x4*)(g + d0);
            ub[e] = make_uint2(pk2(a.x * gg.x, a.y * gg.y), pk2(a.z * gg.z, a.w * gg.w));
            vb[e] = make_uint2(pk2(b.x, b.y), pk2(b.z, b.w));
        }
    }
    {
        const float* x = p.in[I_X]; bf16_t* xb = (bf16_t*)(ws + WS_A); float* rstd1 = (float*)(ws + WS_RSTD1);
        for (int row = gwave; row < S; row += nwave) {
            const f32x4* xr = (const f32x4*)(x + (size_t)row * D) + lane;
            uint2* o = (uint2*)(xb + (size_t)row * D) + lane;
            float ss = 0.f;
#pragma unroll
            for (int j = 0; j < 4; ++j) {
                const f32x4 v = xr[64 * j];
                ss += v.x * v.x + v.y * v.y + v.z * v.z + v.w * v.w;
                o[64 * j] = make_uint2(pk2(v.x, v.y), pk2(v.z, v.w));
            }
            ss = wave_sum(ss);
            if (lane == 0) rstd1[row] = rsqrtf(ss * (1.0f / D) + EPS);
        }
    }
}

__device__ __forceinline__ void gemm_tile64(const bf16_t* A, int lda, const bf16_t* Bt, int ldb, int K, int row0, int col0, f32x4 (&acc)[4][4], int lane) {
    const int fr = lane & 15, fq = lane >> 4;
#pragma unroll
    for (int i = 0; i < 4; ++i)
#pragma unroll
        for (int j = 0; j < 4; ++j) acc[i][j] = (f32x4){0.f, 0.f, 0.f, 0.f};
    const bf16_t* ap = A + (size_t)(row0 + fr) * lda + 8 * fq;
    const bf16_t* bp = Bt + (size_t)(col0 + fr) * ldb + 8 * fq;
    for (int k0 = 0; k0 < K; k0 += 32) {
        bf16x8 a[4], b[4];
#pragma unroll
        for (int i = 0; i < 4; ++i) a[i] = *(const bf16x8*)(ap + (size_t)(16 * i) * lda + k0);
#pragma unroll
        for (int j = 0; j < 4; ++j) b[j] = *(const bf16x8*)(bp + (size_t)(16 * j) * ldb + k0);
#pragma unroll
        for (int i = 0; i < 4; ++i)
#pragma unroll
            for (int j = 0; j < 4; ++j) acc[i][j] = __builtin_amdgcn_mfma_f32_16x16x32_bf16(a[i], b[j], acc[i][j], 0, 0, 0);
    }
}

__global__ void __launch_bounds__(256) k_inproj(Params p) {
    const int lane = threadIdx.x & 63, gwave = (blockIdx.x * blockDim.x + threadIdx.x) >> 6, nwave = (gridDim.x * blockDim.x) >> 6;
    unsigned char* ws = p.ws;
    const bf16_t* xb = (const bf16_t*)(ws + WS_A); const bf16_t* wt = (const bf16_t*)(ws + WS_WINT);
    const float* rstd1 = (const float*)(ws + WS_RSTD1);
    bf16_t* qh = (bf16_t*)(ws + WS_QH); bf16_t* kh = (bf16_t*)(ws + WS_KH); bf16_t* vh = (bf16_t*)(ws + WS_VH);
    bf16_t* xrg = (bf16_t*)(ws + WS_XRG); bf16_t* gg = (bf16_t*)(ws + WS_GG);
    const float* qn = p.in[I_Q_NORM]; const float* kn = p.in[I_K_NORM];
    const int fr = lane & 15, fq = lane >> 4;
    constexpr int NCT = NPROJ / 64;
    for (int u = gwave; u < (S / 64) * NCT; u += nwave) {
        const int rt = u / NCT, ct = u % NCT, row0 = rt * 64, col0 = ct * 64;
        f32x4 acc[4][4];
        gemm_tile64(xb, D, wt, D, D, row0, col0, acc, lane);
        const int region = col0 / 512, head = (col0 % 512) / 64;
#pragma unroll
        for (int i = 0; i < 4; ++i)
#pragma unroll
            for (int r = 0; r < 4; ++r) {
                const int row = row0 + 16 * i + 4 * fq + r;
                const float rs = rstd1[row];
                float v[4];
#pragma unroll
                for (int j = 0; j < 4; ++j) v[j] = acc[i][j][r] * rs;
                if (region <= 1) {
                    float ss = v[0] * v[0] + v[1] * v[1] + v[2] * v[2] + v[3] * v[3];
                    ss += __shfl_xor(ss, 1); ss += __shfl_xor(ss, 2); ss += __shfl_xor(ss, 4); ss += __shfl_xor(ss, 8);
                    const float rn = rsqrtf(ss * (1.0f / HD) + EPS);
                    bf16_t* dst = (region == 0 ? qh : kh) + ((size_t)head * S + row) * HD;
                    const float* gn = region == 0 ? qn : kn;
                    const float sc = region == 0 ? QSCALE : 1.0f;
#pragma unroll
                    for (int j = 0; j < 4; ++j) { const int d = 16 * j + fr; dst[d] = (bf16_t)f2bf(v[j] * rn * gn[d] * sc); }
                } else if (region == 2) {
                    bf16_t* dst = vh + ((size_t)head * S + row) * HD;
#pragma unroll
                    for (int j = 0; j < 4; ++j) dst[16 * j + fr] = (bf16_t)f2bf(v[j]);
                } else if (region == 3) {
                    bf16_t* dst = xrg + (size_t)row * DRG + (col0 - 1536);
#pragma unroll
                    for (int j = 0; j < 4; ++j) dst[16 * j + fr] = (bf16_t)f2bf(v[j]);
                } else {
                    bf16_t* dst = gg + (size_t)row * DRG + (col0 - 2048);
#pragma unroll
                    for (int j = 0; j < 4; ++j) dst[16 * j + fr] = (bf16_t)f2bf(gelu_tanh(v[j]));
                }
            }
    }
}

__global__ void __launch_bounds__(256) k_attn(Params p) {
    unsigned char* ws = p.ws;
    const bf16_t* qh = (const bf16_t*)(ws + WS_QH); const bf16_t* kh = (const bf16_t*)(ws + WS_KH); const bf16_t* vh = (const bf16_t*)(ws + WS_VH);
    bf16_t* osb = (bf16_t*)(ws + WS_OSB);
    const int gtid = blockIdx.x * blockDim.x + threadIdx.x, gsize = gridDim.x * blockDim.x;
    for (int u = gtid; u < NH * S; u += gsize) {
        const int h = u / S, t = u % S;
        float q[HD], o[HD];
        {
            const bf16x8* qp = (const bf16x8*)(qh + ((size_t)h * S + t) * HD);
#pragma unroll
            for (int c = 0; c < 8; ++c) { const bf16x8 v = qp[c];
#pragma unroll
                for (int j = 0; j < 8; ++j) { q[8 * c + j] = bf2f((unsigned short)v[j]); o[8 * c + j] = 0.f; } }
        }
        float carry = 0.f;
        for (int s = t - 1; s >= 0; --s) {
            const bf16x8* kp = (const bf16x8*)(kh + ((size_t)h * S + s) * HD);
            float z = 0.f;
#pragma unroll
            for (int c = 0; c < 8; ++c) { const bf16x8 v = kp[c];
#pragma unroll
                for (int j = 0; j < 8; ++j) z += q[8 * c + j] * bf2f((unsigned short)v[j]); }
            const float sp2 = fmaxf(z, 0.f) + __builtin_amdgcn_logf(1.0f + __builtin_amdgcn_exp2f(-fabsf(z)));
            const float w = __builtin_amdgcn_exp2f(z - sp2 + carry);
            const bf16x8* vp = (const bf16x8*)(vh + ((size_t)h * S + s) * HD);
#pragma unroll
            for (int c = 0; c < 8; ++c) { const bf16x8 v = vp[c];
#pragma unroll
                for (int j = 0; j < 8; ++j) o[8 * c + j] += w * bf2f((unsigned short)v[j]); }
            carry -= sp2;
            if (carry < CARRY_STOP) break;
        }
        u32x4* op = (u32x4*)(osb + (size_t)t * DSB + h * HD);
#pragma unroll
        for (int c = 0; c < 8; ++c) { u32x4 w; w.x = pk2(o[8 * c], o[8 * c + 1]); w.y = pk2(o[8 * c + 2], o[8 * c + 3]); w.z = pk2(o[8 * c + 4], o[8 * c + 5]); w.w = pk2(o[8 * c + 6], o[8 * c + 7]); op[c] = w; }
    }
}

template <int PASS>
__global__ void __launch_bounds__(256) k_rg(Params p, float* org) {
    __shared__ float xc[CHUNK][65];
    __shared__ float as_[CHUNK][64];
    __shared__ float bs_[CHUNK][64];
    unsigned char* ws = p.ws;
    const bf16_t* xrg = (const bf16_t*)(ws + WS_XRG); const bf16_t* gg = (const bf16_t*)(ws + WS_GG);
    float* rgP = (float*)(ws + WS_RGP); float* rgH = (float*)(ws + WS_RGH);
    const float* cw = p.in[I_CONV_W]; const float* cb = p.in[I_CONV_B];
    const float* wa = p.in[I_RG_W_A]; const float* ba = p.in[I_RG_B_A]; const float* wx = p.in[I_RG_W_X]; const float* bx = p.in[I_RG_B_X];
    const float* lam = p.in[I_RG_LAMBDA];
    const int tid = threadIdx.x;
    for (int u = blockIdx.x; u < NCHUNK * 8; u += gridDim.x) {
        const int ch = u / 8, n = u % 8, t0 = ch * CHUNK, c0 = n * 64;
        __syncthreads();
        for (int e = tid; e < CHUNK * 64; e += 256) {
            const int t = e / 64, cc = e % 64, c = c0 + cc, tok = t0 + t;
            float a = cb[c];
#pragma unroll
            for (int k = 0; k < 4; ++k) { const int tt = tok + k - 3; if (tt >= 0) a += cw[k * DRG + c] * bf2f(xrg[(size_t)tt * DRG + c]); }
            xc[t][cc] = a;
        }
        __syncthreads();
        {
            const int j = tid & 63, tq = tid >> 6;
            const int c = c0 + j;
            const float sp = log1pf(__expf(-lam[c]));
            const float bav = ba[c], bxv = bx[c];
            for (int t = tq; t < CHUNK; t += 4) {
                float ra = bav, ri = bxv;
                for (int i = 0; i < 64; ++i) { const float xv = xc[t][i]; ra += xv * wa[((size_t)n * 64 + i) * 64 + j]; ri += xv * wx[((size_t)n * 64 + i) * 64 + j]; }
                const float r = sigmoidf_(ra), ig = sigmoidf_(ri);
                const float log_a = -8.0f * r * sp;
                const float a = __expf(log_a);
                const float b = sqrtf(-expm1f(2.0f * log_a)) * (ig * xc[t][j]);
                as_[t][j] = a; bs_[t][j] = b;
            }
        }
        __syncthreads();
        if (tid < 64) {
            const int c = c0 + tid;
            float h = 0.f, P = 1.f;
            if (PASS == 1) { for (int k = 0; k < ch; ++k) h = rgP[k * DRG + c] * h + rgH[k * DRG + c]; }
            for (int t = 0; t < CHUNK; ++t) {
                const float a = as_[t][tid];
                h = a * h + bs_[t][tid]; P *= a;
                if (PASS == 1) org[(size_t)(t0 + t) * DRG + c] = h * bf2f(gg[(size_t)(t0 + t) * DRG + c]);
            }
            if (PASS == 0) { rgP[ch * DRG + c] = P; rgH[ch * DRG + c] = h; }
        }
    }
}

__global__ void __launch_bounds__(256) k_mix(Params p, const float* org) {
    unsigned char* ws = p.ws;
    const bf16_t* osb = (const bf16_t*)(ws + WS_OSB); bf16_t* mix = (bf16_t*)(ws + WS_MIX);
    const int lane = threadIdx.x & 63, gwave = (blockIdx.x * blockDim.x + threadIdx.x) >> 6, nwave = (gridDim.x * blockDim.x) >> 6;
    for (int t = gwave; t < S; t += nwave) {
        const u32x4 a = *((const u32x4*)(osb + (size_t)t * DSB) + lane);
        float av[8] = {bf2f(a.x & 0xffff), bf2f(a.x >> 16), bf2f(a.y & 0xffff), bf2f(a.y >> 16), bf2f(a.z & 0xffff), bf2f(a.z >> 16), bf2f(a.w & 0xffff), bf2f(a.w >> 16)};
        const f32x4 b0 = *((const f32x4*)(org + (size_t)t * DRG) + 2 * lane), b1 = *((const f32x4*)(org + (size_t)t * DRG) + 2 * lane + 1);
        float ssa = 0.f, ssb = 0.f;
#pragma unroll
        for (int j = 0; j < 8; ++j) ssa += av[j] * av[j];
        ssb = b0.x * b0.x + b0.y * b0.y + b0.z * b0.z + b0.w * b0.w + b1.x * b1.x + b1.y * b1.y + b1.z * b1.z + b1.w * b1.w;
        ssa = wave_sum(ssa); ssb = wave_sum(ssb);
        const float ra = rsqrtf(ssa * (1.0f / DSB) + EPS), rb = rsqrtf(ssb * (1.0f / DRG) + EPS);
        u32x4 o; o.x = pk2(av[0] * ra, av[1] * ra); o.y = pk2(av[2] * ra, av[3] * ra); o.z = pk2(av[4] * ra, av[5] * ra); o.w = pk2(av[6] * ra, av[7] * ra);
        *((u32x4*)(mix + (size_t)t * D) + lane) = o;
        u32x4 o2; o2.x = pk2(b0.x * rb, b0.y * rb); o2.y = pk2(b0.z * rb, b0.w * rb); o2.z = pk2(b1.x * rb, b1.y * rb); o2.w = pk2(b1.z * rb, b1.w * rb);
        *((u32x4*)(mix + (size_t)t * D + DSB) + lane) = o2;
    }
}

__global__ void __launch_bounds__(256) k_outproj(Params p) {
    const int lane = threadIdx.x & 63, gwave = (blockIdx.x * blockDim.x + threadIdx.x) >> 6, nwave = (gridDim.x * blockDim.x) >> 6;
    unsigned char* ws = p.ws;
    const bf16_t* mix = (const bf16_t*)(ws + WS_MIX); const bf16_t* wt = (const bf16_t*)(ws + WS_WOUTT);
    bf16_t* x1b = (bf16_t*)(ws + WS_A); const float* x = p.in[I_X]; float* out = p.out;
    const int fr = lane & 15, fq = lane >> 4;
    constexpr int NCT = D / 64;
    for (int u = gwave; u < (S / 64) * NCT; u += nwave) {
        const int rt = u / NCT, ct = u % NCT, row0 = rt * 64, col0 = ct * 64;
        f32x4 acc[4][4];
        gemm_tile64(mix, D, wt, D, D, row0, col0, acc, lane);
#pragma unroll
        for (int i = 0; i < 4; ++i)
#pragma unroll
            for (int r = 0; r < 4; ++r) {
                const int row = row0 + 16 * i + 4 * fq + r;
#pragma unroll
                for (int j = 0; j < 4; ++j) { const size_t o = (size_t)row * D + col0 + 16 * j + fr; const float v = x[o] + acc[i][j][r]; out[o] = v; x1b[o] = (bf16_t)f2bf(v); }
            }
    }
}
__global__ void __launch_bounds__(256) k_rstd2(Params p) {
    const int lane = threadIdx.x & 63, gwave = (blockIdx.x * blockDim.x + threadIdx.x) >> 6, nwave = (gridDim.x * blockDim.x) >> 6;
    float* rstd2 = (float*)(p.ws + WS_RSTD2);
    for (int row = gwave; row < S; row += nwave) {
        const f32x4* xr = (const f32x4*)(p.out + (size_t)row * D) + lane;
        float ss = 0.f;
#pragma unroll
        for (int j = 0; j < 4; ++j) { const f32x4 v = xr[64 * j]; ss += v.x * v.x + v.y * v.y + v.z * v.z + v.w * v.w; }
        ss = wave_sum(ss);
        if (lane == 0) rstd2[row] = rsqrtf(ss * (1.0f / D) + EPS);
    }
}
__global__ void __launch_bounds__(256) k_peerq(Params p) {
    const int lane = threadIdx.x & 63, gwave = (blockIdx.x * blockDim.x + threadIdx.x) >> 6, nwave = (gridDim.x * blockDim.x) >> 6;
    unsigned char* ws = p.ws;
    const bf16_t* x1b = (const bf16_t*)(ws + WS_A); const bf16_t* wt = (const bf16_t*)(ws + WS_WQT);
    const float* rstd2 = (const float*)(ws + WS_RSTD2); bf16_t* qp = (bf16_t*)(ws + WS_B);
    const int fr = lane & 15, fq = lane >> 4;
    constexpr int NCT = NQ / 64;
    for (int u = gwave; u < (S / 64) * NCT; u += nwave) {
        const int rt = u / NCT, ct = u % NCT, row0 = rt * 64, col0 = ct * 64;
        f32x4 acc[4][4];
        gemm_tile64(x1b, D, wt, D, D, row0, col0, acc, lane);
#pragma unroll
        for (int i = 0; i < 4; ++i)
#pragma unroll
            for (int r = 0; r < 4; ++r) {
                const int row = row0 + 16 * i + 4 * fq + r; const float rs = rstd2[row];
#pragma unroll
                for (int j = 0; j < 4; ++j) qp[(size_t)row * NQ + col0 + 16 * j + fr] = (bf16_t)f2bf(acc[i][j][r] * rs);
            }
    }
}

__device__ __forceinline__ void topk_insert(float (&val)[16], int (&idx)[16], float x, int xi) {
#pragma unroll
    for (int i = 0; i < 16; ++i) {
        const bool sw = x > val[i];
        const float tv = sw ? val[i] : x; const int ti = sw ? idx[i] : xi;
        val[i] = sw ? x : val[i]; idx[i] = sw ? xi : idx[i];
        x = tv; xi = ti;
    }
}
__global__ void __launch_bounds__(256) k_topk(Params p) {
    unsigned char* ws = p.ws;
    const bf16_t* qp = (const bf16_t*)(ws + WS_B); const bf16_t* subk = (const bf16_t*)(ws + WS_SUBK);
    int* seli = (int*)(ws + WS_SELI); float* selg = (float*)(ws + WS_SELG);
    const int gtid = blockIdx.x * blockDim.x + threadIdx.x, gsize = gridDim.x * blockDim.x;
    for (int u = gtid; u < PH * S; u += gsize) {
        const int h = u / S, t = u % S;
        float tv[2][16]; int ti[2][16];
#pragma unroll
        for (int pp = 0; pp < 2; ++pp) {
#pragma unroll
            for (int i = 0; i < 16; ++i) { tv[pp][i] = -INFINITY; ti[pp][i] = 0; }
            const bf16x8* qr = (const bf16x8*)(qp + (size_t)t * NQ + h * PDK + pp * PHALF);
            for (int n = 0; n < PNK; ++n) {
                const bf16x8* kr = (const bf16x8*)(subk + (((size_t)h * 2 + pp) * PNK + n) * PHALF);
                float s = 0.f;
#pragma unroll
                for (int c = 0; c < 16; ++c) { const bf16x8 a = qr[c], b = kr[c];
#pragma unroll
                    for (int j = 0; j < 8; ++j) s += bf2f((unsigned short)a[j]) * bf2f((unsigned short)b[j]); }
                topk_insert(tv[pp], ti[pp], s, n);
            }
        }
        float bv[16]; int bi[16];
#pragma unroll
        for (int i = 0; i < 16; ++i) { bv[i] = -INFINITY; bi[i] = 0; }
#pragma unroll
        for (int a = 0; a < 16; ++a)
#pragma unroll
            for (int b = 0; b < 16; ++b)
                if ((a + 1) * (b + 1) <= 16) topk_insert(bv, bi, tv[0][a] + tv[1][b], ti[0][a] * PNK + ti[1][b]);
        float e[16], sum = 0.f;
#pragma unroll
        for (int i = 0; i < 16; ++i) { e[i] = __expf(bv[i] - bv[0]); sum += e[i]; }
        const float inv = 1.0f / sum;
#pragma unroll
        for (int i = 0; i < 16; ++i) { seli[(size_t)t * 128 + h * 16 + i] = bi[i]; selg[(size_t)t * 128 + h * 16 + i] = e[i] * inv; }
    }
}

__device__ __forceinline__ void unpack8(const u32x4 a, float (&f)[8]) {
    f[0] = bf2f(a.x & 0xffff); f[1] = bf2f(a.x >> 16); f[2] = bf2f(a.y & 0xffff); f[3] = bf2f(a.y >> 16);
    f[4] = bf2f(a.z & 0xffff); f[5] = bf2f(a.z >> 16); f[6] = bf2f(a.w & 0xffff); f[7] = bf2f(a.w >> 16);
}
__global__ void __launch_bounds__(256) k_gather(Params p) {
    unsigned char* ws = p.ws;
    const bf16_t* x1b = (const bf16_t*)(ws + WS_A); const bf16_t* ub = (const bf16_t*)(ws + WS_UB); const bf16_t* vb = (const bf16_t*)(ws + WS_VB);
    const int* seli = (const int*)(ws + WS_SELI); const float* selg = (const float*)(ws + WS_SELG); const float* rstd2 = (const float*)(ws + WS_RSTD2);
    float* out = p.out;
    const int lane = threadIdx.x & 63, gwave = (blockIdx.x * blockDim.x + threadIdx.x) >> 6, nwave = (gridDim.x * blockDim.x) >> 6;
    for (int t = gwave; t < S; t += nwave) {
        float xv[16], acc[16];
        { float f[8]; unpack8(*((const u32x4*)(x1b + (size_t)t * D) + lane), f);
#pragma unroll
          for (int j = 0; j < 8; ++j) xv[j] = f[j];
          unpack8(*((const u32x4*)(x1b + (size_t)t * D + 512) + lane), f);
#pragma unroll
          for (int j = 0; j < 8; ++j) xv[8 + j] = f[j]; }
#pragma unroll
        for (int j = 0; j < 16; ++j) acc[j] = 0.f;
        const float rs = rstd2[t];
        for (int j = 0; j < 128; ++j) {
            const int e = seli[(size_t)t * 128 + j]; const float g = selg[(size_t)t * 128 + j];
            float f0[8], f1[8];
            unpack8(*((const u32x4*)(ub + (size_t)e * D) + lane), f0); unpack8(*((const u32x4*)(ub + (size_t)e * D + 512) + lane), f1);
            float d = 0.f;
#pragma unroll
            for (int k = 0; k < 8; ++k) d += xv[k] * f0[k] + xv[8 + k] * f1[k];
            d = wave_sum(d);
            const float coef = g * gelu_tanh(d * rs);
            unpack8(*((const u32x4*)(vb + (size_t)e * D) + lane), f0); unpack8(*((const u32x4*)(vb + (size_t)e * D + 512) + lane), f1);
#pragma unroll
            for (int k = 0; k < 8; ++k) { acc[k] += coef * f0[k]; acc[8 + k] += coef * f1[k]; }
        }
        f32x4* o0 = (f32x4*)(out + (size_t)t * D + 8 * lane); f32x4* o1 = (f32x4*)(out + (size_t)t * D + 512 + 8 * lane);
        f32x4 a = o0[0], b = o0[1], c = o1[0], d2 = o1[1];
        a.x += acc[0]; a.y += acc[1]; a.z += acc[2]; a.w += acc[3]; b.x += acc[4]; b.y += acc[5]; b.z += acc[6]; b.w += acc[7];
        c.x += acc[8]; c.y += acc[9]; c.z += acc[10]; c.w += acc[11]; d2.x += acc[12]; d2.y += acc[13]; d2.z += acc[14]; d2.w += acc[15];
        o0[0] = a; o0[1] = b; o1[0] = c; o1[1] = d2;
    }
}

extern "C" void kernel_launch(void* const* d_in, const int* in_sizes, int n_in, void* d_out, int out_size, void* d_ws, size_t ws_size, hipStream_t stream) {
    if (n_in != 20 || out_size != S * D || ws_size < WS_END) { fprintf(stderr, "kernel_launch: unexpected shapes (n_in %d out %d ws %zu)\n", n_in, out_size, ws_size); return; }
    Params p{};
    for (int i = 0; i < 20; ++i) p.in[i] = (const float*)d_in[i];
    p.out = (float*)d_out; p.ws = (unsigned char*)d_ws;
    float* org = (float*)d_out;
    const dim3 blk(256);
    hipLaunchKernelGGL(k_prep, dim3(2048), blk, 0, stream, p);
    hipLaunchKernelGGL(k_inproj, dim3(2560), blk, 0, stream, p);
    hipLaunchKernelGGL(k_attn, dim3(512), blk, 0, stream, p);
    hipLaunchKernelGGL(k_rg<0>, dim3(2048), blk, 0, stream, p, org);
    hipLaunchKernelGGL(k_rg<1>, dim3(2048), blk, 0, stream, p, org);
    hipLaunchKernelGGL(k_mix, dim3(1024), blk, 0, stream, p, (const float*)org);
    hipLaunchKernelGGL(k_outproj, dim3(1024), blk, 0, stream, p);
    hipLaunchKernelGGL(k_rstd2, dim3(1024), blk, 0, stream, p);
    hipLaunchKernelGGL(k_peerq, dim3(2048), blk, 0, stream, p);
    hipLaunchKernelGGL(k_topk, dim3(512), blk, 0, stream, p);
    hipLaunchKernelGGL(k_gather, dim3(1024), blk, 0, stream, p);
}
```

```cpp
#include <hip/hip_runtime.h>
#include <cstdint>
#include <cstdio>

typedef unsigned short bf16_t;
typedef short bf16x8 __attribute__((ext_vector_type(8)));
typedef float f32x4 __attribute__((ext_vector_type(4)));
typedef unsigned u32x4 __attribute__((ext_vector_type(4)));

constexpr int S = 16384, D = 1024, NPROJ = 2560, DSB = 512, DRG = 512, NH = 8, HD = 64;
constexpr int PH = 8, PNK = 128, PDK = 256, PHALF = 128, PTOPK = 16, NEXP = 16384, NQ = PH * PDK;
constexpr int CHUNK = 64, NCHUNK = S / CHUNK;
constexpr float EPS = 1e-6f;
constexpr float LOG2E = 1.4426950408889634f;
constexpr float QSCALE = 0.125f * LOG2E;
constexpr int NTHR = 512;
constexpr float CARRY_STOP = -160.0f;

constexpr size_t MiB = 1u << 20;
constexpr size_t WS_CTL = 0;
constexpr size_t WS_WINT = 1 * MiB;
constexpr size_t WS_WOUTT = 6 * MiB;
constexpr size_t WS_WQT = 8 * MiB;
constexpr size_t WS_SUBK = 12 * MiB;
constexpr size_t WS_RSTD1 = 12 * MiB + 512 * 1024;
constexpr size_t WS_RSTD2 = WS_RSTD1 + 64 * 1024;
constexpr size_t WS_RGP = WS_RSTD2 + 64 * 1024;
constexpr size_t WS_RGH = WS_RGP + 512 * 1024;
constexpr size_t WS_A = 14 * MiB;
constexpr size_t WS_B = 46 * MiB;
constexpr size_t WS_QH = WS_B, WS_KH = WS_B + 16 * MiB, WS_VH = WS_B + 32 * MiB, WS_XRG = WS_B + 48 * MiB;
constexpr size_t WS_GG = 110 * MiB;
constexpr size_t WS_OSB = 126 * MiB;
constexpr size_t WS_MIX = 142 * MiB;
constexpr size_t WS_SELI = WS_MIX, WS_SELG = WS_MIX + 8 * MiB;
constexpr size_t WS_UB = 174 * MiB;
constexpr size_t WS_VB = 206 * MiB;
constexpr size_t WS_END = 238 * MiB;

__device__ __forceinline__ unsigned f2bf(float f) { unsigned u = __builtin_bit_cast(unsigned, f); return (u + 0x7fffu + ((u >> 16) & 1u)) >> 16; }
__device__ __forceinline__ float bf2f(unsigned h) { return __builtin_bit_cast(float, h << 16); }
__device__ __forceinline__ unsigned pk2(float lo, float hi) { return f2bf(lo) | (f2bf(hi) << 16); }
__device__ __forceinline__ float wave_sum(float v) {
#pragma unroll
    for (int o = 1; o < 64; o <<= 1) v += __shfl_xor(v, o);
    return v;
}
__device__ __forceinline__ float gelu_tanh(float x) {
    const float u = 0.7978845608028654f * (x + 0.044715f * x * x * x);
    const float e = __expf(2.0f * u);
    const float th = 1.0f - 2.0f / (e + 1.0f);
    return 0.5f * x * (1.0f + th);
}
__device__ __forceinline__ float sigmoidf_(float x) { return 1.0f / (1.0f + __expf(-x)); }

struct Params {
    const float* in[20];
    float* out;
    unsigned char* ws;
};
enum { I_X = 0, I_NORM_MIX, I_W_IN, I_Q_NORM, I_K_NORM, I_CONV_W, I_CONV_B, I_RG_W_A, I_RG_B_A, I_RG_W_X, I_RG_B_X, I_RG_LAMBDA,
       I_OUT_NORM_SB, I_OUT_NORM_RG, I_W_OUT, I_NORM_FFN, I_PEER_WQ, I_PEER_SUBK, I_PEER_U, I_PEER_V };

__device__ __forceinline__ void prep_transpose(const float* W, const float* gain0, const float* gain1, int K, int N, bf16_t* WT, int gtid, int gsize) {
    for (long e = gtid; e < (long)K * N; e += gsize) {
        const int k = (int)(e / N), n = (int)(e % N);
        float g = 1.0f;
        if (gain0) g = (gain1 && k >= 512) ? gain1[k - 512] : gain0[k];
        WT[(size_t)n * K + k] = (bf16_t)f2bf(g * W[e]);
    }
}
__device__ __forceinline__ void ph_prep(const Params& p) {
    const int gtid = blockIdx.x * blockDim.x + threadIdx.x, gsize = gridDim.x * blockDim.x;
    const int lane = threadIdx.x & 63, gwave = gtid >> 6, nwave = gsize >> 6;
    unsigned char* ws = p.ws;
    prep_transpose(p.in[I_W_IN], p.in[I_NORM_MIX], nullptr, D, NPROJ, (bf16_t*)(ws + WS_WINT), gtid, gsize);
    prep_transpose(p.in[I_W_OUT], p.in[I_OUT_NORM_SB], p.in[I_OUT_NORM_RG], D, D, (bf16_t*)(ws + WS_WOUTT), gtid, gsize);
    prep_transpose(p.in[I_PEER_WQ], p.in[I_NORM_FFN], nullptr, D, NQ, (bf16_t*)(ws + WS_WQT), gtid, gsize);
    {
        const float* sk = p.in[I_PEER_SUBK]; bf16_t* o = (bf16_t*)(ws + WS_SUBK);
        for (int e = gtid; e < PH * 2 * PNK * PHALF; e += gsize) o[e] = (bf16_t)f2bf(sk[e]);
    }
    {
        const float* u = p.in[I_PEER_U]; const float* v = p.in[I_PEER_V]; const float* g = p.in[I_NORM_FFN];
        uint2* ub = (uint2*)(ws + WS_UB); uint2* vb = (uint2*)(ws + WS_VB);
        for (long e = gtid; e < (long)NEXP * D / 4; e += gsize) {
            const f32x4 a = ((const f32x4*)u)[e], b = ((const f32x4*)v)[e];
            const int d0 = (int)((e * 4) % D);
            const f32x4 gg = *(const f32x4*)(g + d0);
            ub[e] = make_uint2(pk2(a.x * gg.x, a.y * gg.y), pk2(a.z * gg.z, a.w * gg.w));
            vb[e] = make_uint2(pk2(b.x, b.y), pk2(b.z, b.w));
        }
    }
    {
        const float* x = p.in[I_X]; bf16_t* xb = (bf16_t*)(ws + WS_A); float* rstd1 = (float*)(ws + WS_RSTD1);
        for (int row = gwave; row < S; row += nwave) {
            const f32x4* xr = (const f32x4*)(x + (size_t)row * D) + lane;
            uint2* o = (uint2*)(xb + (size_t)row * D) + lane;
            float ss = 0.f;
#pragma unroll
            for (int j = 0; j < 4; ++j) {
                const f32x4 v = xr[64 * j];
                ss += v.x * v.x + v.y * v.y + v.z * v.z + v.w * v.w;
                o[64 * j] = make_uint2(pk2(v.x, v.y), pk2(v.z, v.w));
            }
            ss = wave_sum(ss);
            if (lane == 0) rstd1[row] = rsqrtf(ss * (1.0f / D) + EPS);
        }
    }
}

__device__ __forceinline__ void gemm_tile64(const bf16_t* A, int lda, const bf16_t* Bt, int ldb, int K, int row0, int col0, f32x4 (&acc)[4][4], int lane) {
    const int fr = lane & 15, fq = lane >> 4;
#pragma unroll
    for (int i = 0; i < 4; ++i)
#pragma unroll
        for (int j = 0; j < 4; ++j) acc[i][j] = (f32x4){0.f, 0.f, 0.f, 0.f};
    const bf16_t* ap = A + (size_t)(row0 + fr) * lda + 8 * fq;
    const bf16_t* bp = Bt + (size_t)(col0 + fr) * ldb + 8 * fq;
    for (int k0 = 0; k0 < K; k0 += 32) {
        bf16x8 a[4], b[4];
#pragma unroll
        for (int i = 0; i < 4; ++i) a[i] = *(const bf16x8*)(ap + (size_t)(16 * i) * lda + k0);
#pragma unroll
        for (int j = 0; j < 4; ++j) b[j] = *(const bf16x8*)(bp + (size_t)(16 * j) * ldb + k0);
#pragma unroll
        for (int i = 0; i < 4; ++i)
#pragma unroll
            for (int j = 0; j < 4; ++j) acc[i][j] = __builtin_amdgcn_mfma_f32_16x16x32_bf16(a[i], b[j], acc[i][j], 0, 0, 0);
    }
}

__device__ __forceinline__ void ph_inproj(const Params& p) {
    const int lane = threadIdx.x & 63, gwave = (blockIdx.x * blockDim.x + threadIdx.x) >> 6, nwave = (gridDim.x * blockDim.x) >> 6;
    unsigned char* ws = p.ws;
    const bf16_t* xb = (const bf16_t*)(ws + WS_A); const bf16_t* wt = (const bf16_t*)(ws + WS_WINT);
    const float* rstd1 = (const float*)(ws + WS_RSTD1);
    bf16_t* qh = (bf16_t*)(ws + WS_QH); bf16_t* kh = (bf16_t*)(ws + WS_KH); bf16_t* vh = (bf16_t*)(ws + WS_VH);
    bf16_t* xrg = (bf16_t*)(ws + WS_XRG); bf16_t* gg = (bf16_t*)(ws + WS_GG);
    const float* qn = p.in[I_Q_NORM]; const float* kn = p.in[I_K_NORM];
    const int fr = lane & 15, fq = lane >> 4;
    constexpr int NCT = NPROJ / 64;
    for (int u = gwave; u < (S / 64) * NCT; u += nwave) {
        const int rt = u / NCT, ct = u % NCT, row0 = rt * 64, col0 = ct * 64;
        f32x4 acc[4][4];
        gemm_tile64(xb, D, wt, D, D, row0, col0, acc, lane);
        const int region = col0 / 512, head = (col0 % 512) / 64;
#pragma unroll
        for (int i = 0; i < 4; ++i)
#pragma unroll
            for (int r = 0; r < 4; ++r) {
                const int row = row0 + 16 * i + 4 * fq + r;
                const float rs = rstd1[row];
                float v[4];
#pragma unroll
                for (int j = 0; j < 4; ++j) v[j] = acc[i][j][r] * rs;
                if (region <= 1) {
                    float ss = v[0] * v[0] + v[1] * v[1] + v[2] * v[2] + v[3] * v[3];
                    ss += __shfl_xor(ss, 1); ss += __shfl_xor(ss, 2); ss += __shfl_xor(ss, 4); ss += __shfl_xor(ss, 8);
                    const float rn = rsqrtf(ss * (1.0f / HD) + EPS);
                    bf16_t* dst = (region == 0 ? qh : kh) + ((size_t)head * S + row) * HD;
                    const float* gn = region == 0 ? qn : kn;
                    const float sc = region == 0 ? QSCALE : 1.0f;
#pragma unroll
                    for (int j = 0; j < 4; ++j) { const int d = 16 * j + fr; dst[d] = (bf16_t)f2bf(v[j] * rn * gn[d] * sc); }
                } else if (region == 2) {
                    bf16_t* dst = vh + ((size_t)head * S + row) * HD;
#pragma unroll
                    for (int j = 0; j < 4; ++j) dst[16 * j + fr] = (bf16_t)f2bf(v[j]);
                } else if (region == 3) {
                    bf16_t* dst = xrg + (size_t)row * DRG + (col0 - 1536);
#pragma unroll
                    for (int j = 0; j < 4; ++j) dst[16 * j + fr] = (bf16_t)f2bf(v[j]);
                } else {
                    bf16_t* dst = gg + (size_t)row * DRG + (col0 - 2048);
#pragma unroll
                    for (int j = 0; j < 4; ++j) dst[16 * j + fr] = (bf16_t)f2bf(gelu_tanh(v[j]));
                }
            }
    }
}

__device__ __forceinline__ void ph_attn(const Params& p) {
    unsigned char* ws = p.ws;
    const bf16_t* qh = (const bf16_t*)(ws + WS_QH); const bf16_t* kh = (const bf16_t*)(ws + WS_KH); const bf16_t* vh = (const bf16_t*)(ws + WS_VH);
    bf16_t* osb = (bf16_t*)(ws + WS_OSB);
    const int gtid = blockIdx.x * blockDim.x + threadIdx.x, gsize = gridDim.x * blockDim.x;
    for (int u = gtid; u < NH * S; u += gsize) {
        const int h = u / S, t = u % S;
        float q[HD], o[HD];
        {
            const bf16x8* qp = (const bf16x8*)(qh + ((size_t)h * S + t) * HD);
#pragma unroll
            for (int c = 0; c < 8; ++c) { const bf16x8 v = qp[c];
#pragma unroll
                for (int j = 0; j < 8; ++j) { q[8 * c + j] = bf2f((unsigned short)v[j]); o[8 * c + j] = 0.f; } }
        }
        float carry = 0.f;
        for (int s = t - 1; s >= 0; --s) {
            const bf16x8* kp = (const bf16x8*)(kh + ((size_t)h * S + s) * HD);
            float z = 0.f;
#pragma unroll
            for (int c = 0; c < 8; ++c) { const bf16x8 v = kp[c];
#pragma unroll
                for (int j = 0; j < 8; ++j) z += q[8 * c + j] * bf2f((unsigned short)v[j]); }
            const float sp2 = fmaxf(z, 0.f) + __builtin_amdgcn_logf(1.0f + __builtin_amdgcn_exp2f(-fabsf(z)));
            const float w = __builtin_amdgcn_exp2f(z - sp2 + carry);
            const bf16x8* vp = (const bf16x8*)(vh + ((size_t)h * S + s) * HD);
#pragma unroll
            for (int c = 0; c < 8; ++c) { const bf16x8 v = vp[c];
#pragma unroll
                for (int j = 0; j < 8; ++j) o[8 * c + j] += w * bf2f((unsigned short)v[j]); }
            carry -= sp2;
            if (carry < CARRY_STOP) break;
        }
        u32x4* op = (u32x4*)(osb + (size_t)t * DSB + h * HD);
#pragma unroll
        for (int c = 0; c < 8; ++c) { u32x4 w; w.x = pk2(o[8 * c], o[8 * c + 1]); w.y = pk2(o[8 * c + 2], o[8 * c + 3]); w.z = pk2(o[8 * c + 4], o[8 * c + 5]); w.w = pk2(o[8 * c + 6], o[8 * c + 7]); op[c] = w; }
    }
}

template <int PASS>
__device__ __forceinline__ void ph_rg(const Params& p, float* org, float* lds) {
    float (*xc)[65] = (float (*)[65])lds;
    float (*as_)[64] = (float (*)[64])(lds + CHUNK * 65);
    float (*bs_)[64] = (float (*)[64])(lds + CHUNK * 65 + CHUNK * 64);
    unsigned char* ws = p.ws;
    const bf16_t* xrg = (const bf16_t*)(ws + WS_XRG); const bf16_t* gg = (const bf16_t*)(ws + WS_GG);
    float* rgP = (float*)(ws + WS_RGP); float* rgH = (float*)(ws + WS_RGH);
    const float* cw = p.in[I_CONV_W]; const float* cb = p.in[I_CONV_B];
    const float* wa = p.in[I_RG_W_A]; const float* ba = p.in[I_RG_B_A]; const float* wx = p.in[I_RG_W_X]; const float* bx = p.in[I_RG_B_X];
    const float* lam = p.in[I_RG_LAMBDA];
    const int tid = threadIdx.x;
    for (int u = blockIdx.x; u < NCHUNK * 8; u += gridDim.x) {
        const int ch = u / 8, n = u % 8, t0 = ch * CHUNK, c0 = n * 64;
        __syncthreads();
        for (int e = tid; e < CHUNK * 64; e += NTHR) {
            const int t = e / 64, cc = e % 64, c = c0 + cc, tok = t0 + t;
            float a = cb[c];
#pragma unroll
            for (int k = 0; k < 4; ++k) { const int tt = tok + k - 3; if (tt >= 0) a += cw[k * DRG + c] * bf2f(xrg[(size_t)tt * DRG + c]); }
            xc[t][cc] = a;
        }
        __syncthreads();
        {
            const int j = tid & 63, tq = tid >> 6;
            const int c = c0 + j;
            const float sp = log1pf(__expf(-lam[c]));
            const float bav = ba[c], bxv = bx[c];
            for (int t = tq; t < CHUNK; t += NTHR / 64) {
                float ra = bav, ri = bxv;
                for (int i = 0; i < 64; ++i) { const float xv = xc[t][i]; ra += xv * wa[((size_t)n * 64 + i) * 64 + j]; ri += xv * wx[((size_t)n * 64 + i) * 64 + j]; }
                const float r = sigmoidf_(ra), ig = sigmoidf_(ri);
                const float log_a = -8.0f * r * sp;
                const float a = __expf(log_a);
                const float b = sqrtf(-expm1f(2.0f * log_a)) * (ig * xc[t][j]);
                as_[t][j] = a; bs_[t][j] = b;
            }
        }
        __syncthreads();
        if (tid < 64) {
            const int c = c0 + tid;
            float h = 0.f, P = 1.f;
            if (PASS == 1) { for (int k = 0; k < ch; ++k) h = rgP[k * DRG + c] * h + rgH[k * DRG + c]; }
            for (int t = 0; t < CHUNK; ++t) {
                const float a = as_[t][tid];
                h = a * h + bs_[t][tid]; P *= a;
                if (PASS == 1) org[(size_t)(t0 + t) * DRG + c] = h * bf2f(gg[(size_t)(t0 + t) * DRG + c]);
            }
            if (PASS == 0) { rgP[ch * DRG + c] = P; rgH[ch * DRG + c] = h; }
        }
    }
}

__device__ __forceinline__ void ph_mix(const Params& p, const float* org) {
    unsigned char* ws = p.ws;
    const bf16_t* osb = (const bf16_t*)(ws + WS_OSB); bf16_t* mix = (bf16_t*)(ws + WS_MIX);
    const int lane = threadIdx.x & 63, gwave = (blockIdx.x * blockDim.x + threadIdx.x) >> 6, nwave = (gridDim.x * blockDim.x) >> 6;
    for (int t = gwave; t < S; t += nwave) {
        const u32x4 a = *((const u32x4*)(osb + (size_t)t * DSB) + lane);
        float av[8] = {bf2f(a.x & 0xffff), bf2f(a.x >> 16), bf2f(a.y & 0xffff), bf2f(a.y >> 16), bf2f(a.z & 0xffff), bf2f(a.z >> 16), bf2f(a.w & 0xffff), bf2f(a.w >> 16)};
        const f32x4 b0 = *((const f32x4*)(org + (size_t)t * DRG) + 2 * lane), b1 = *((const f32x4*)(org + (size_t)t * DRG) + 2 * lane + 1);
        float ssa = 0.f, ssb = 0.f;
#pragma unroll
        for (int j = 0; j < 8; ++j) ssa += av[j] * av[j];
        ssb = b0.x * b0.x + b0.y * b0.y + b0.z * b0.z + b0.w * b0.w + b1.x * b1.x + b1.y * b1.y + b1.z * b1.z + b1.w * b1.w;
        ssa = wave_sum(ssa); ssb = wave_sum(ssb);
        const float ra = rsqrtf(ssa * (1.0f / DSB) + EPS), rb = rsqrtf(ssb * (1.0f / DRG) + EPS);
        u32x4 o; o.x = pk2(av[0] * ra, av[1] * ra); o.y = pk2(av[2] * ra, av[3] * ra); o.z = pk2(av[4] * ra, av[5] * ra); o.w = pk2(av[6] * ra, av[7] * ra);
        *((u32x4*)(mix + (size_t)t * D) + lane) = o;
        u32x4 o2; o2.x = pk2(b0.x * rb, b0.y * rb); o2.y = pk2(b0.z * rb, b0.w * rb); o2.z = pk2(b1.x * rb, b1.y * rb); o2.w = pk2(b1.z * rb, b1.w * rb);
        *((u32x4*)(mix + (size_t)t * D + DSB) + lane) = o2;
    }
}

__device__ __forceinline__ void ph_outproj(const Params& p) {
    const int lane = threadIdx.x & 63, gwave = (blockIdx.x * blockDim.x + threadIdx.x) >> 6, nwave = (gridDim.x * blockDim.x) >> 6;
    unsigned char* ws = p.ws;
    const bf16_t* mix = (const bf16_t*)(ws + WS_MIX); const bf16_t* wt = (const bf16_t*)(ws + WS_WOUTT);
    bf16_t* x1b = (bf16_t*)(ws + WS_A); const float* x = p.in[I_X]; float* out = p.out;
    const int fr = lane & 15, fq = lane >> 4;
    constexpr int NCT = D / 64;
    for (int u = gwave; u < (S / 64) * NCT; u += nwave) {
        const int rt = u / NCT, ct = u % NCT, row0 = rt * 64, col0 = ct * 64;
        f32x4 acc[4][4];
        gemm_tile64(mix, D, wt, D, D, row0, col0, acc, lane);
#pragma unroll
        for (int i = 0; i < 4; ++i)
#pragma unroll
            for (int r = 0; r < 4; ++r) {
                const int row = row0 + 16 * i + 4 * fq + r;
#pragma unroll
                for (int j = 0; j < 4; ++j) { const size_t o = (size_t)row * D + col0 + 16 * j + fr; const float v = x[o] + acc[i][j][r]; out[o] = v; x1b[o] = (bf16_t)f2bf(v); }
            }
    }
}
__device__ __forceinline__ void ph_rstd2(const Params& p) {
    const int lane = threadIdx.x & 63, gwave = (blockIdx.x * blockDim.x + threadIdx.x) >> 6, nwave = (gridDim.x * blockDim.x) >> 6;
    float* rstd2 = (float*)(p.ws + WS_RSTD2);
    for (int row = gwave; row < S; row += nwave) {
        const f32x4* xr = (const f32x4*)(p.out + (size_t)row * D) + lane;
        float ss = 0.f;
#pragma unroll
        for (int j = 0; j < 4; ++j) { const f32x4 v = xr[64 * j]; ss += v.x * v.x + v.y * v.y + v.z * v.z + v.w * v.w; }
        ss = wave_sum(ss);
        if (lane == 0) rstd2[row] = rsqrtf(ss * (1.0f / D) + EPS);
    }
}
__device__ __forceinline__ void ph_peerq(const Params& p) {
    const int lane = threadIdx.x & 63, gwave = (blockIdx.x * blockDim.x + threadIdx.x) >> 6, nwave = (gridDim.x * blockDim.x) >> 6;
    unsigned char* ws = p.ws;
    const bf16_t* x1b = (const bf16_t*)(ws + WS_A); const bf16_t* wt = (const bf16_t*)(ws + WS_WQT);
    const float* rstd2 = (const float*)(ws + WS_RSTD2); bf16_t* qp = (bf16_t*)(ws + WS_B);
    const int fr = lane & 15, fq = lane >> 4;
    constexpr int NCT = NQ / 64;
    for (int u = gwave; u < (S / 64) * NCT; u += nwave) {
        const int rt = u / NCT, ct = u % NCT, row0 = rt * 64, col0 = ct * 64;
        f32x4 acc[4][4];
        gemm_tile64(x1b, D, wt, D, D, row0, col0, acc, lane);
#pragma unroll
        for (int i = 0; i < 4; ++i)
#pragma unroll
            for (int r = 0; r < 4; ++r) {
                const int row = row0 + 16 * i + 4 * fq + r; const float rs = rstd2[row];
#pragma unroll
                for (int j = 0; j < 4; ++j) qp[(size_t)row * NQ + col0 + 16 * j + fr] = (bf16_t)f2bf(acc[i][j][r] * rs);
            }
    }
}

__device__ __forceinline__ int f2key(float f) { const int b = __builtin_bit_cast(int, f); return b ^ ((b >> 31) & 0x7fffffff); }
__device__ __forceinline__ float key2f(int k) { return __builtin_bit_cast(float, k ^ ((k >> 31) & 0x7fffffff)); }
__device__ __forceinline__ void topk_insert(int (&lst)[16], int x) {
#pragma unroll
    for (int i = 0; i < 16; ++i) { const int hi = max(lst[i], x); x = min(lst[i], x); lst[i] = hi; }
}
__device__ __forceinline__ void ph_topk(const Params& p, int* lds) {
    unsigned char* ws = p.ws;
    const bf16_t* qp = (const bf16_t*)(ws + WS_B); const bf16_t* subk = (const bf16_t*)(ws + WS_SUBK);
    int* seli = (int*)(ws + WS_SELI); float* selg = (float*)(ws + WS_SELG);
    const int gtid = blockIdx.x * blockDim.x + threadIdx.x, gsize = gridDim.x * blockDim.x, tid = threadIdx.x;
    for (int u = gtid; u < PH * S; u += gsize) {
        const int h = u / S, t = u % S;
        int tk[2][16];
#pragma unroll
        for (int pp = 0; pp < 2; ++pp) {
#pragma unroll
            for (int i = 0; i < 16; ++i) tk[pp][i] = (int)0x80000000;
            const bf16x8* qr = (const bf16x8*)(qp + (size_t)t * NQ + h * PDK + pp * PHALF);
            for (int n = 0; n < PNK; ++n) {
                int nn = n; asm volatile("" : "+v"(nn));
                const bf16x8* kr = (const bf16x8*)(subk + (((size_t)h * 2 + pp) * PNK + nn) * PHALF);
                float s = 0.f;
#pragma unroll
                for (int c = 0; c < 16; ++c) { const bf16x8 a = qr[c], b = kr[c];
#pragma unroll
                    for (int j = 0; j < 8; ++j) s += bf2f((unsigned short)a[j]) * bf2f((unsigned short)b[j]); }
                topk_insert(tk[pp], (f2key(s) & ~127) | (127 - n));
            }
        }
#pragma unroll
        for (int i = 0; i < 16; ++i) { lds[i * NTHR + tid] = tk[0][i]; lds[(16 + i) * NTHR + tid] = tk[1][i]; }
        float v0[16], v1[16];
#pragma unroll
        for (int i = 0; i < 16; ++i) { v0[i] = key2f(tk[0][i]); v1[i] = key2f(tk[1][i]); }
        int bk[16];
#pragma unroll
        for (int i = 0; i < 16; ++i) bk[i] = (int)0x80000000;
#pragma unroll
        for (int a = 0; a < 16; ++a)
#pragma unroll
            for (int b = 0; b < 16; ++b)
                if ((a + 1) * (b + 1) <= 16) topk_insert(bk, (f2key(v0[a] + v1[b]) & ~255) | (255 - (a * 16 + b)));
        float e[16], sum = 0.f; const float m = key2f(bk[0]);
#pragma unroll
        for (int i = 0; i < 16; ++i) { e[i] = __expf(key2f(bk[i]) - m); sum += e[i]; }
        const float inv = 1.0f / sum;
#pragma unroll
        for (int i = 0; i < 16; ++i) {
            const int code = 255 - (bk[i] & 255), a = code >> 4, b = code & 15;
            const int i1 = 127 - (lds[a * NTHR + tid] & 127), i2 = 127 - (lds[(16 + b) * NTHR + tid] & 127);
            seli[(size_t)t * 128 + h * 16 + i] = i1 * PNK + i2; selg[(size_t)t * 128 + h * 16 + i] = e[i] * inv;
        }
    }
}

__device__ __forceinline__ void unpack8(const u32x4 a, float (&f)[8]) {
    f[0] = bf2f(a.x & 0xffff); f[1] = bf2f(a.x >> 16); f[2] = bf2f(a.y & 0xffff); f[3] = bf2f(a.y >> 16);
    f[4] = bf2f(a.z & 0xffff); f[5] = bf2f(a.z >> 16); f[6] = bf2f(a.w & 0xffff); f[7] = bf2f(a.w >> 16);
}
__device__ __forceinline__ void ph_gather(const Params& p) {
    unsigned char* ws = p.ws;
    const bf16_t* x1b = (const bf16_t*)(ws + WS_A); const bf16_t* ub = (const bf16_t*)(ws + WS_UB); const bf16_t* vb = (const bf16_t*)(ws + WS_VB);
    const int* seli = (const int*)(ws + WS_SELI); const float* selg = (const float*)(ws + WS_SELG); const float* rstd2 = (const float*)(ws + WS_RSTD2);
    float* out = p.out;
    const int lane = threadIdx.x & 63, gwave = (blockIdx.x * blockDim.x + threadIdx.x) >> 6, nwave = (gridDim.x * blockDim.x) >> 6;
    for (int t = gwave; t < S; t += nwave) {
        float xv[16], acc[16];
        { float f[8]; unpack8(*((const u32x4*)(x1b + (size_t)t * D) + lane), f);
#pragma unroll
          for (int j = 0; j < 8; ++j) xv[j] = f[j];
          unpack8(*((const u32x4*)(x1b + (size_t)t * D + 512) + lane), f);
#pragma unroll
          for (int j = 0; j < 8; ++j) xv[8 + j] = f[j]; }
#pragma unroll
        for (int j = 0; j < 16; ++j) acc[j] = 0.f;
        const float rs = rstd2[t];
        for (int j = 0; j < 128; ++j) {
            const int e = seli[(size_t)t * 128 + j]; const float g = selg[(size_t)t * 128 + j];
            float f0[8], f1[8];
            unpack8(*((const u32x4*)(ub + (size_t)e * D) + lane), f0); unpack8(*((const u32x4*)(ub + (size_t)e * D + 512) + lane), f1);
            float d = 0.f;
#pragma unroll
            for (int k = 0; k < 8; ++k) d += xv[k] * f0[k] + xv[8 + k] * f1[k];
            d = wave_sum(d);
            const float coef = g * gelu_tanh(d * rs);
            unpack8(*((const u32x4*)(vb + (size_t)e * D) + lane), f0); unpack8(*((const u32x4*)(vb + (size_t)e * D + 512) + lane), f1);
#pragma unroll
            for (int k = 0; k < 8; ++k) { acc[k] += coef * f0[k]; acc[8 + k] += coef * f1[k]; }
        }
        f32x4* o0 = (f32x4*)(out + (size_t)t * D + 8 * lane); f32x4* o1 = (f32x4*)(out + (size_t)t * D + 512 + 8 * lane);
        f32x4 a = o0[0], b = o0[1], c = o1[0], d2 = o1[1];
        a.x += acc[0]; a.y += acc[1]; a.z += acc[2]; a.w += acc[3]; b.x += acc[4]; b.y += acc[5]; b.z += acc[6]; b.w += acc[7];
        c.x += acc[8]; c.y += acc[9]; c.z += acc[10]; c.w += acc[11]; d2.x += acc[12]; d2.y += acc[13]; d2.z += acc[14]; d2.w += acc[15];
        o0[0] = a; o0[1] = b; o1[0] = c; o1[1] = d2;
    }
}

#define LAS __attribute__((address_space(3)))
#define XB_TMO      128
#define XB_XCNT(j)  (256  + 64 * (j))
#define XB_XSUB(j)  (1280 + 64 * (j))
#define XB_XGEN(j)  (2304 + 64 * (j))
#define XB_TOP      3328
#define XB_TOPGEN   3392
#define XCD_BAR_WORDS 3456
#define XB_SPIN_CAP (1u << 18)
__device__ __forceinline__ unsigned xb_ld(unsigned* p)              { return __hip_atomic_load(p, __ATOMIC_RELAXED, __HIP_MEMORY_SCOPE_AGENT); }
__device__ __forceinline__ unsigned xb_add(unsigned* p, unsigned v) { return __hip_atomic_fetch_add(p, v, __ATOMIC_RELAXED, __HIP_MEMORY_SCOPE_AGENT); }
__device__ __forceinline__ unsigned xb_xcc_id() { return (unsigned)__builtin_amdgcn_s_getreg((3 << 11) | 20) & 0xFu; }
#define XB_SPIN(cond, bar) do { unsigned _sp = 0; while (cond) { __builtin_amdgcn_s_sleep(1); \
    if ((++_sp & 255u) == 0u) { if (xb_ld(&(bar)[XB_TMO])) break; if (_sp > XB_SPIN_CAP) { atomicAdd(&(bar)[XB_TMO], 1u); break; } } } } while (0)
struct XcdBarrier { unsigned* bar; unsigned x; volatile LAS unsigned* st; };
__device__ __forceinline__ XcdBarrier xcd_barrier_post(unsigned* bar, volatile LAS unsigned* st) {
    XcdBarrier b; b.bar = bar; b.x = xb_xcc_id(); b.st = st;
    if (threadIdx.x == 0) (void)xb_add(&bar[XB_XCNT(b.x)], 1u);
    return b;
}
__device__ __forceinline__ void xcd_barrier_complete(unsigned* bar, unsigned x, unsigned& nloc, unsigned& nx) {
    const unsigned G = gridDim.x * gridDim.y * gridDim.z;
    unsigned sum, cnt, mine, sp = 0u;
    for (;;) {
        sum = 0u; cnt = 0u; mine = 0u;
#pragma unroll
        for (unsigned j = 0; j < 16; ++j) { const unsigned c = xb_ld(&bar[XB_XCNT(j)]); sum += c; cnt += (c > 0u) ? 1u : 0u; mine = (j == x) ? c : mine; }
        if (sum == G) break;
        __builtin_amdgcn_s_sleep(1);
        if ((++sp & 255u) == 0u) { if (xb_ld(&bar[XB_TMO])) break; if (sp > XB_SPIN_CAP) { atomicAdd(&bar[XB_TMO], 1u); break; } }
    }
    nloc = mine > 0u ? mine : 1u; nx = cnt > 0u ? cnt : 1u;
}
__device__ __forceinline__ void xcd_barrier(const XcdBarrier& b) {
    asm volatile("s_waitcnt vmcnt(0)" ::: "memory");
    __syncthreads();
    if (threadIdx.x == 0) {
        unsigned* bar = b.bar;
        __builtin_amdgcn_s_waitcnt(0);
        unsigned nloc = b.st[0], nx = b.st[1];
        if (nloc == 0u) { xcd_barrier_complete(bar, b.x, nloc, nx); b.st[0] = nloc; b.st[1] = nx; }
        const unsigned old = xb_add(&bar[XB_XSUB(b.x)], 1u);
        const unsigned gen = old / nloc;
        if (old + 1u == (gen + 1u) * nloc) {
            __builtin_amdgcn_fence(__ATOMIC_RELEASE, "agent");
            asm volatile("s_waitcnt vmcnt(0)" ::: "memory");
            const unsigned og = xb_add(&bar[XB_TOP], 1u);
            const unsigned tg = og / nx;
            if (og + 1u == (tg + 1u) * nx) xb_add(&bar[XB_TOPGEN], 1u);
            else XB_SPIN(xb_ld(&bar[XB_TOPGEN]) == tg, bar);
            __builtin_amdgcn_fence(__ATOMIC_ACQUIRE, "agent");
            xb_add(&bar[XB_XGEN(b.x)], 1u);
            asm volatile("s_waitcnt vmcnt(0)" ::: "memory");
        } else {
            XB_SPIN(xb_ld(&bar[XB_XGEN(b.x)]) == gen, bar);
            __builtin_amdgcn_fence(__ATOMIC_ACQUIRE, "agent");
            asm volatile("s_waitcnt vmcnt(0)" ::: "memory");
        }
    }
    __syncthreads();
}

constexpr int LDS_BYTES = 98304;
constexpr int LDS_MISC = 65536;

__global__ void __launch_bounds__(NTHR) hymba_fwd(Params p) {
    extern __shared__ __attribute__((aligned(16))) unsigned char lds[];
    volatile LAS unsigned* misc = (volatile LAS unsigned*)((LAS unsigned char*)lds + LDS_MISC);
    if (threadIdx.x < 4) misc[threadIdx.x] = 0u;
    __syncthreads();
    XcdBarrier bar = xcd_barrier_post((unsigned*)(p.ws + WS_CTL), misc);
    float* org = p.out;

    ph_prep(p);                               xcd_barrier(bar);
    ph_inproj(p);                             xcd_barrier(bar);
    ph_attn(p); ph_rg<0>(p, org, (float*)lds); xcd_barrier(bar);
    ph_rg<1>(p, org, (float*)lds);            xcd_barrier(bar);
    ph_mix(p, org);                           xcd_barrier(bar);
    ph_outproj(p);                            xcd_barrier(bar);
    ph_rstd2(p);                              xcd_barrier(bar);
    ph_peerq(p);                              xcd_barrier(bar);
    ph_topk(p, (int*)lds);                    xcd_barrier(bar);
    ph_gather(p);
}

extern "C" void kernel_launch(void* const* d_in, const int* in_sizes, int n_in, void* d_out, int out_size, void* d_ws, size_t ws_size, hipStream_t stream) {
    static int grid = 0;
    if (grid == 0) {
        if (n_in != 20 || out_size != S * D || ws_size < WS_END) { fprintf(stderr, "kernel_launch: unexpected shapes (n_in %d out %d ws %zu)\n", n_in, out_size, ws_size); grid = -1; return; }
        int dev = 0, cus = 0, per_cu = 0;
        if (hipGetDevice(&dev) != hipSuccess || hipDeviceGetAttribute(&cus, hipDeviceAttributeMultiprocessorCount, dev) != hipSuccess) { grid = -1; return; }
        if (hipFuncSetAttribute((const void*)hymba_fwd, hipFuncAttributeMaxDynamicSharedMemorySize, LDS_BYTES) != hipSuccess) { fprintf(stderr, "kernel_launch: hipFuncSetAttribute failed\n"); grid = -1; return; }
        if (hipOccupancyMaxActiveBlocksPerMultiprocessor(&per_cu, (const void*)hymba_fwd, NTHR, LDS_BYTES) != hipSuccess || per_cu < 1) { fprintf(stderr, "kernel_launch: occupancy query says %d blocks per CU\n", per_cu); grid = -1; return; }
        (void)hipGetLastError();
        grid = cus;
    }
    if (grid < 0) return;
    (void)hipMemsetAsync((char*)d_ws + WS_CTL, 0, XCD_BAR_WORDS * 4, stream);
    Params p{};
    for (int i = 0; i < 20; ++i) p.in[i] = (const float*)d_in[i];
    p.out = (float*)d_out; p.ws = (unsigned char*)d_ws;
    hipLaunchKernelGGL(hymba_fwd, dim3(grid), dim3(NTHR), LDS_BYTES, stream, p);
}
```

```cpp
#include <hip/hip_runtime.h>
#include <cstdint>
#include <cstdio>

typedef unsigned short bf16_t;
typedef short bf16x8 __attribute__((ext_vector_type(8)));
typedef float f32x4 __attribute__((ext_vector_type(4)));
typedef unsigned u32x4 __attribute__((ext_vector_type(4)));

constexpr int S = 16384, D = 1024, NPROJ = 2560, DSB = 512, DRG = 512, NH = 8, HD = 64;
constexpr int PH = 8, PNK = 128, PDK = 256, PHALF = 128, PTOPK = 16, NEXP = 16384, NQ = PH * PDK;
constexpr int CHUNK = 64, NCHUNK = S / CHUNK;
constexpr float EPS = 1e-6f;
constexpr float LOG2E = 1.4426950408889634f;
constexpr float QSCALE = 0.125f * LOG2E;
constexpr int NTHR = 512;
constexpr float CARRY_STOP = -160.0f;

constexpr size_t MiB = 1u << 20;
constexpr size_t WS_CTL = 0;
constexpr size_t WS_WINT = 1 * MiB;
constexpr size_t WS_WOUTT = 6 * MiB;
constexpr size_t WS_WQT = 8 * MiB;
constexpr size_t WS_SUBK = 12 * MiB;
constexpr size_t WS_RSTD1 = 12 * MiB + 512 * 1024;
constexpr size_t WS_RSTD2 = WS_RSTD1 + 64 * 1024;
constexpr size_t WS_RGP = WS_RSTD2 + 64 * 1024;
constexpr size_t WS_RGH = WS_RGP + 512 * 1024;
constexpr size_t WS_A = 14 * MiB;
constexpr size_t WS_B = 46 * MiB;
constexpr size_t WS_QH = WS_B, WS_KH = WS_B + 16 * MiB, WS_VH = WS_B + 32 * MiB, WS_XRG = WS_B + 48 * MiB;
constexpr size_t WS_GG = 110 * MiB;
constexpr size_t WS_OSB = 126 * MiB;
constexpr size_t WS_MIX = 142 * MiB;
constexpr size_t WS_SELI = WS_MIX, WS_SELG = WS_MIX + 8 * MiB;
constexpr size_t WS_UB = 174 * MiB;
constexpr size_t WS_VB = 206 * MiB;
constexpr size_t WS_SSQ = 238 * MiB;
constexpr size_t WS_END = 239 * MiB;

__device__ __forceinline__ unsigned f2bf(float f) { unsigned u = __builtin_bit_cast(unsigned, f); return (u + 0x7fffu + ((u >> 16) & 1u)) >> 16; }
__device__ __forceinline__ float bf2f(unsigned h) { return __builtin_bit_cast(float, h << 16); }
__device__ __forceinline__ unsigned pk2(float lo, float hi) { return f2bf(lo) | (f2bf(hi) << 16); }
__device__ __forceinline__ float wave_sum(float v) {
#pragma unroll
    for (int o = 1; o < 64; o <<= 1) v += __shfl_xor(v, o);
    return v;
}
__device__ __forceinline__ float gelu_tanh(float x) {
    const float u = 0.7978845608028654f * (x + 0.044715f * x * x * x);
    const float e = __expf(2.0f * u);
    const float th = 1.0f - 2.0f / (e + 1.0f);
    return 0.5f * x * (1.0f + th);
}
__device__ __forceinline__ float sigmoidf_(float x) { return 1.0f / (1.0f + __expf(-x)); }

__host__ __device__ __forceinline__ int inproj_phys_row(int nlog) { const int t = nlog >> 8, L = nlog & 255; return (t << 8) + 128 * ((L & 63) >> 5) + 32 * (L >> 6) + (L & 31); }

struct Params {
    const float* in[20];
    float* out;
    unsigned char* ws;
};
enum { I_X = 0, I_NORM_MIX, I_W_IN, I_Q_NORM, I_K_NORM, I_CONV_W, I_CONV_B, I_RG_W_A, I_RG_B_A, I_RG_W_X, I_RG_B_X, I_RG_LAMBDA,
       I_OUT_NORM_SB, I_OUT_NORM_RG, I_W_OUT, I_NORM_FFN, I_PEER_WQ, I_PEER_SUBK, I_PEER_U, I_PEER_V };

template <bool INPROJ_PERM>
__device__ __forceinline__ void prep_transpose(const float* W, const float* gain0, const float* gain1, int K, int N, bf16_t* WT, int gtid, int gsize) {
    for (long e = gtid; e < (long)K * N; e += gsize) {
        const int k = (int)(e / N), n = (int)(e % N);
        float g = 1.0f;
        if (gain0) g = (gain1 && k >= 512) ? gain1[k - 512] : gain0[k];
        const int nr = INPROJ_PERM ? inproj_phys_row(n) : n;
        WT[(size_t)nr * K + k] = (bf16_t)f2bf(g * W[e]);
    }
}
__device__ __forceinline__ void ph_prep(const Params& p) {
    const int gtid = blockIdx.x * blockDim.x + threadIdx.x, gsize = gridDim.x * blockDim.x;
    const int lane = threadIdx.x & 63, gwave = gtid >> 6, nwave = gsize >> 6;
    unsigned char* ws = p.ws;
    prep_transpose<true>(p.in[I_W_IN], p.in[I_NORM_MIX], nullptr, D, NPROJ, (bf16_t*)(ws + WS_WINT), gtid, gsize);
    prep_transpose<false>(p.in[I_W_OUT], p.in[I_OUT_NORM_SB], p.in[I_OUT_NORM_RG], D, D, (bf16_t*)(ws + WS_WOUTT), gtid, gsize);
    prep_transpose<false>(p.in[I_PEER_WQ], p.in[I_NORM_FFN], nullptr, D, NQ, (bf16_t*)(ws + WS_WQT), gtid, gsize);
    {
        const float* sk = p.in[I_PEER_SUBK]; bf16_t* o = (bf16_t*)(ws + WS_SUBK);
        for (int e = gtid; e < PH * 2 * PNK * PHALF; e += gsize) o[e] = (bf16_t)f2bf(sk[e]);
    }
    {
        const float* u = p.in[I_PEER_U]; const float* v = p.in[I_PEER_V]; const float* g = p.in[I_NORM_FFN];
        uint2* ub = (uint2*)(ws + WS_UB); uint2* vb = (uint2*)(ws + WS_VB);
        for (long e = gtid; e < (long)NEXP * D / 4; e += gsize) {
            const f32x4 a = ((const f32x4*)u)[e], b = ((const f32x4*)v)[e];
            const int d0 = (int)((e * 4) % D);
            const f32x4 gg = *(const f32x4*)(g + d0);
            ub[e] = make_uint2(pk2(a.x * gg.x, a.y * gg.y), pk2(a.z * gg.z, a.w * gg.w));
            vb[e] = make_uint2(pk2(b.x, b.y), pk2(b.z, b.w));
        }
    }
    {
        const float* x = p.in[I_X]; bf16_t* xb = (bf16_t*)(ws + WS_A); float* rstd1 = (float*)(ws + WS_RSTD1);
        for (int row = gwave; row < S; row += nwave) {
            const f32x4* xr = (const f32x4*)(x + (size_t)row * D) + lane;
            uint2* o = (uint2*)(xb + (size_t)row * D) + lane;
            float ss = 0.f;
#pragma unroll
            for (int j = 0; j < 4; ++j) {
                const f32x4 v = xr[64 * j];
                ss += v.x * v.x + v.y * v.y + v.z * v.z + v.w * v.w;
                o[64 * j] = make_uint2(pk2(v.x, v.y), pk2(v.z, v.w));
            }
            ss = wave_sum(ss);
            if (lane == 0) rstd1[row] = rsqrtf(ss * (1.0f / D) + EPS);
        }
    }
}

namespace pg8 {
#define PG8_LAS __attribute__((address_space(3)))
typedef unsigned short bf16_t;
typedef short bf16x8 __attribute__((ext_vector_type(8)));
typedef float f32x4 __attribute__((ext_vector_type(4)));
typedef unsigned u32x4 __attribute__((ext_vector_type(4)));
constexpr int BM = 256, BK = 64, HALF = 128, HTB = HALF * BK * 2  , STAGE_BYTES = 8 * HTB, NXCD = 8, WGM = 8;

__host__ __device__ __forceinline__ int lds_byte(int r, int c) { const int st = (r >> 4) * 2 + (c >> 5), rr = r & 15, cc = c & 31, ob = rr * 64 + cc * 2; return st * 1024 + (ob ^ (((ob >> 9) & 1) << 5)); }
__host__ __device__ __forceinline__ void stage_rc(int b, int& R, int& C) { const int st = b / 1024, sb = b % 1024, swz = sb ^ (((sb >> 9) & 1) << 5); R = (st >> 1) * 16 + swz / 64; C = (st & 1) * 32 + (swz % 64) / 2; }
__host__ __device__ __forceinline__ int perm32(int rho) { const int n = rho >> 4, i = rho & 15; return 8 * (i >> 2) + 4 * n + (i & 3); }

struct Unit { int pm, pn; };
struct Gemm { const bf16_t* A; const bf16_t* Bt; int M, N, K; };

struct StaticOrder {
    int nM, nN, nwg, G, c;
    __host__ __device__ void init(int M, int N, int G_, int c_) { nM = M / BM; nN = N / BM; nwg = nM * nN; G = G_; c = c_; }
    __host__ __device__ bool next(int i, Unit& u) const {
        const long L = (long)i * G + c; if (L >= nwg) return false;
        int wgid = (int)L; { const int q = nwg / NXCD, r = nwg % NXCD, xcd = wgid % NXCD, off = wgid / NXCD; wgid = (xcd < r ? xcd * (q + 1) : r * (q + 1) + (xcd - r) * q) + off; }
        const int nig = WGM * nN, gid = wgid / nig, fm = gid * WGM, gsz = (nM - fm) < WGM ? (nM - fm) : WGM;
        u.pm = fm + ((wgid % nig) % gsz); u.pn = (wgid % nig) / gsz; return true;
    }
    __device__ __forceinline__ void a_ready(const Unit&) const {}
    __device__ __forceinline__ void done(const Unit&) const {}
};

__device__ __forceinline__ unsigned cvt_pk_bf16(float lo, float hi) { unsigned r; asm volatile("v_cvt_pk_bf16_f32 %0, %1, %2" : "=v"(r) : "v"(lo), "v"(hi)); return r; }
template <class Epi, class Sched, bool ALIGN_EPI = false, bool SP2 = false>
__device__ __forceinline__ void gemm_phase(PG8_LAS unsigned char* lds, const Gemm g, const Sched& S, const Epi& E) {
    const int tid = threadIdx.x, wid = __builtin_amdgcn_readfirstlane(tid >> 6), lane = tid & 63, wr = wid >> 2, wc = wid & 3, fr = lane & 15, fq = lane >> 4;
    const int K = g.K, nt = K / BK;
    unsigned voffA[2], voffB[2];
#pragma unroll
    for (int i = 0; i < 2; ++i) { int R, C; stage_rc(tid * 16 + i * 8192, R, C); const int Rb = Epi::PERM ? ((R & ~31) + perm32(R & 31)) : R;
        voffA[i] = (unsigned)(R * K + C) * 2u; voffB[i] = (unsigned)(Rb * K + C) * 2u; }
    const size_t kstep = (size_t)(BK * 2);
    const size_t hstep = (size_t)HALF * K * 2;
    const size_t tstep = 2 * hstep;
    const unsigned ldsw = (unsigned)wid * 1024u;
    const int aoff = lds_byte(wr * 64 + fr, fq * 8), boff = lds_byte(wc * 32 + fr, fq * 8);
#define PG8_SA(b, h) (((b) * 2 + (h)) * HTB)
#define PG8_SB(b, h) ((4 + (b) * 2 + (h)) * HTB)
#define PG8_STAGE(bufoff, gbase, voff) do { _Pragma("unroll") for (int _i = 0; _i < 2; ++_i) \
        __builtin_amdgcn_global_load_lds((const unsigned*)((const char*)(gbase) + (voff)[_i]), (PG8_LAS unsigned*)(lds + (bufoff) + ldsw + _i * 8192), 16, 0, 0); } while (0)
#define PG8_LDA(dst, b, h) do { _Pragma("unroll") for (int m = 0; m < 4; ++m) _Pragma("unroll") for (int k = 0; k < 2; ++k) dst[m][k] = *(const PG8_LAS bf16x8*)(lds + PG8_SA(b, h) + aoff + m * 2048 + k * 1024); } while (0)
#define PG8_LDB(dst, b, h) do { _Pragma("unroll") for (int n = 0; n < 2; ++n) _Pragma("unroll") for (int k = 0; k < 2; ++k) dst[n][k] = *(const PG8_LAS bf16x8*)(lds + PG8_SB(b, h) + boff + n * 2048 + k * 1024); } while (0)
#define PG8_MMA(ai, bj, At, Bt) do { __builtin_amdgcn_s_setprio(1); _Pragma("unroll") for (int m = 0; m < 4; ++m) _Pragma("unroll") for (int n = 0; n < 2; ++n) _Pragma("unroll") for (int k = 0; k < 2; ++k) \
        acc[ai][bj][m][n] = __builtin_amdgcn_mfma_f32_16x16x32_bf16(Bt[n][k], At[m][k], acc[ai][bj][m][n], 0, 0, 0); __builtin_amdgcn_s_setprio(0); } while (0)
#define PG8_WAIT_V(n) asm volatile("s_waitcnt vmcnt(" #n ")" ::: "memory")
#define PG8_WAIT_L(n) asm volatile("s_waitcnt lgkmcnt(" #n ")" ::: "memory")
#define PG8_BAR __builtin_amdgcn_s_barrier()
#define PG8_SCHED __builtin_amdgcn_sched_barrier(0)
    Unit cur, nxt; int ui = 0;
    if (!S.next(0, cur)) return;
    f32x4 acc[2][2][4][2];
#pragma unroll
    for (int a = 0; a < 2; ++a)
#pragma unroll
        for (int b = 0; b < 2; ++b)
#pragma unroll
            for (int m = 0; m < 4; ++m)
#pragma unroll
                for (int n = 0; n < 2; ++n) acc[a][b][m][n] = (f32x4){0.f, 0.f, 0.f, 0.f};
    bf16x8 At[4][2], B0[2][2], B1[2][2];
    const char* cA = (const char*)g.A + (size_t)cur.pm * tstep; const char* cB = (const char*)g.Bt + (size_t)cur.pn * tstep;
    S.a_ready(cur);
    if constexpr (SP2) {
        PG8_STAGE(PG8_SB(0, 0), cB, voffB); PG8_STAGE(PG8_SB(0, 1), cB + hstep, voffB); PG8_STAGE(PG8_SA(0, 0), cA, voffA); PG8_STAGE(PG8_SA(0, 1), cA + hstep, voffA);
        if (wr == 1) PG8_BAR;
        PG8_WAIT_V(2); PG8_BAR;
        PG8_STAGE(PG8_SB(1, 0), cB + kstep, voffB); PG8_STAGE(PG8_SA(1, 0), cA + kstep, voffA); PG8_STAGE(PG8_SB(1, 1), cB + hstep + kstep, voffB);
        PG8_WAIT_V(6); PG8_BAR;
    } else {
        PG8_STAGE(PG8_SB(0, 0), cB, voffB); PG8_STAGE(PG8_SA(0, 0), cA, voffA); PG8_STAGE(PG8_SB(0, 1), cB + hstep, voffB); PG8_STAGE(PG8_SA(0, 1), cA + hstep, voffA);
        if (wr == 1) PG8_BAR;
        PG8_WAIT_V(4); PG8_BAR;
        PG8_STAGE(PG8_SB(1, 0), cB + kstep, voffB); PG8_STAGE(PG8_SA(1, 0), cA + kstep, voffA); PG8_STAGE(PG8_SB(1, 1), cB + hstep + kstep, voffB);
        PG8_WAIT_V(6); PG8_BAR;
    }
    for (;;) {
        const bool has_next = S.next(ui + 1, nxt);
        const char* nA = has_next ? (const char*)g.A + (size_t)nxt.pm * tstep : cA; const char* nB = has_next ? (const char*)g.Bt + (size_t)nxt.pn * tstep : cB;
        for (int t = 0; t < nt; t += 2) {
            const bool last = (t == nt - 2);
            const char* a1 = cA + (size_t)(t + 1) * kstep;
            const char* a2 = last ? nA : cA + (size_t)(t + 2) * kstep; const char* b2 = last ? nB : cB + (size_t)(t + 2) * kstep;
            const char* a3 = a2 + kstep; const char* b3 = b2 + kstep;
            if (last && has_next) S.a_ready(nxt);
            if constexpr (SP2) {
            PG8_LDB(B0, 0, 0); PG8_LDB(B1, 0, 1); PG8_SCHED; PG8_LDA(At, 0, 0); PG8_STAGE(PG8_SA(1, 1), a1 + hstep, voffA);
            PG8_WAIT_V(8); PG8_WAIT_L(0); PG8_BAR; PG8_MMA(0, 0, At, B0); PG8_MMA(0, 1, At, B1); PG8_BAR; PG8_SCHED;
            PG8_LDA(At, 0, 1); PG8_STAGE(PG8_SB(0, 0), b2, voffB); PG8_STAGE(PG8_SB(0, 1), b2 + hstep, voffB); PG8_STAGE(PG8_SA(0, 0), a2, voffA);
            PG8_WAIT_V(8); PG8_WAIT_L(0); PG8_BAR; PG8_MMA(1, 0, At, B0); PG8_MMA(1, 1, At, B1); PG8_BAR; PG8_SCHED;
            PG8_LDB(B0, 1, 0); PG8_LDB(B1, 1, 1); PG8_SCHED; PG8_LDA(At, 1, 0); PG8_STAGE(PG8_SA(0, 1), a2 + hstep, voffA);
            PG8_WAIT_V(8); PG8_WAIT_L(0); PG8_BAR; PG8_MMA(0, 0, At, B0); PG8_MMA(0, 1, At, B1); PG8_BAR; PG8_SCHED;
            PG8_LDA(At, 1, 1); PG8_STAGE(PG8_SB(1, 0), b3, voffB); PG8_STAGE(PG8_SB(1, 1), b3 + hstep, voffB); PG8_STAGE(PG8_SA(1, 0), a3, voffA);
            PG8_WAIT_V(8); PG8_WAIT_L(0); PG8_BAR; PG8_MMA(1, 0, At, B0); PG8_MMA(1, 1, At, B1); PG8_BAR; PG8_SCHED;
            } else {
            PG8_LDB(B0, 0, 0); PG8_SCHED; PG8_LDA(At, 0, 0); PG8_STAGE(PG8_SA(1, 1), a1 + hstep, voffA);
            PG8_WAIT_L(8); PG8_BAR; PG8_WAIT_L(0); PG8_MMA(0, 0, At, B0); PG8_BAR; PG8_SCHED;
            PG8_LDB(B1, 0, 1); PG8_STAGE(PG8_SB(0, 0), b2, voffB);
            PG8_BAR; PG8_WAIT_L(0); PG8_MMA(0, 1, At, B1); PG8_BAR;
            PG8_LDA(At, 0, 1); PG8_STAGE(PG8_SA(0, 0), a2, voffA);
            PG8_BAR; PG8_WAIT_L(0); PG8_MMA(1, 0, At, B0); PG8_BAR; PG8_SCHED;
            PG8_STAGE(PG8_SB(0, 1), b2 + hstep, voffB);
            PG8_WAIT_V(6); PG8_BAR; PG8_MMA(1, 1, At, B1); PG8_BAR;
            PG8_LDB(B0, 1, 0); PG8_SCHED; PG8_LDA(At, 1, 0); PG8_STAGE(PG8_SA(0, 1), a2 + hstep, voffA);
            PG8_WAIT_L(8); PG8_BAR; PG8_WAIT_L(0); PG8_MMA(0, 0, At, B0); PG8_BAR; PG8_SCHED;
            PG8_LDB(B1, 1, 1); PG8_STAGE(PG8_SB(1, 0), b3, voffB);
            PG8_BAR; PG8_WAIT_L(0); PG8_MMA(0, 1, At, B1); PG8_BAR;
            PG8_LDA(At, 1, 1); PG8_STAGE(PG8_SA(1, 0), a3, voffA);
            PG8_BAR; PG8_WAIT_L(0); PG8_MMA(1, 0, At, B0); PG8_BAR; PG8_SCHED;
            PG8_STAGE(PG8_SB(1, 1), b3 + hstep, voffB);
            PG8_WAIT_V(6); PG8_BAR; PG8_MMA(1, 1, At, B1); PG8_BAR;
            }
        }
        if constexpr (ALIGN_EPI) { if (wr == 0) PG8_BAR; }
        if constexpr (!Epi::AFTER_DRAIN) { E(acc, cur, wr, wc, fr, fq); S.done(cur); }
        if (!has_next) break;
#pragma unroll
        for (int a = 0; a < 2; ++a)
#pragma unroll
            for (int b = 0; b < 2; ++b)
#pragma unroll
                for (int m = 0; m < 4; ++m)
#pragma unroll
                    for (int n = 0; n < 2; ++n) acc[a][b][m][n] = (f32x4){0.f, 0.f, 0.f, 0.f};
        cur = nxt; cA = nA; cB = nB; ++ui;
        if constexpr (ALIGN_EPI) { if (wr == 1) PG8_BAR; }
    }
    PG8_WAIT_V(0);
    if constexpr (!ALIGN_EPI) { if (wr == 0) PG8_BAR; }
    PG8_BAR;
    if constexpr (Epi::AFTER_DRAIN) { E.fused(acc, cur, wr, wc, fr, fq, lds, wid, lane); S.done(cur); }
#undef PG8_SA
#undef PG8_SB
#undef PG8_STAGE
#undef PG8_LDA
#undef PG8_LDB
#undef PG8_MMA
#undef PG8_WAIT_V
#undef PG8_WAIT_L
#undef PG8_BAR
#undef PG8_SCHED
}
}

struct EpiInProj {
    static constexpr bool PERM = true, AFTER_DRAIN = false;
    const float* rstd1; const float* qn; const float* kn; bf16_t *qh, *kh, *vh, *xrg, *gg;
    __device__ __forceinline__ void operator()(const pg8::f32x4 (&acc)[2][2][4][2], const pg8::Unit& u, int wr, int wc, int fr, int fq) const {
        const int region = u.pn >> 1;
        const int head = (u.pn & 1) * 4 + wc;
        pg8::f32x4 gn[2][2];
        if (region <= 1) {
            const float* g = region == 0 ? qn : kn; const float sc = region == 0 ? QSCALE : 1.0f;
#pragma unroll
            for (int bj = 0; bj < 2; ++bj)
#pragma unroll
                for (int n = 0; n < 2; ++n) gn[bj][n] = *(const pg8::f32x4*)(g + 32 * bj + 8 * fq + 4 * n) * sc;
        }
#pragma unroll
        for (int ai = 0; ai < 2; ++ai)
#pragma unroll
            for (int m = 0; m < 4; ++m) {
                const int row = u.pm * 256 + ai * 128 + wr * 64 + m * 16 + fr;
                const float rs = rstd1[row];
                pg8::f32x4 v[2][2];
#pragma unroll
                for (int bj = 0; bj < 2; ++bj)
#pragma unroll
                    for (int n = 0; n < 2; ++n) v[bj][n] = acc[ai][bj][m][n] * rs;
                bf16_t* dst;
                if (region <= 1) {
                    float ss = 0.f;
#pragma unroll
                    for (int bj = 0; bj < 2; ++bj)
#pragma unroll
                        for (int n = 0; n < 2; ++n) ss += (v[bj][n][0] * v[bj][n][0] + v[bj][n][1] * v[bj][n][1]) + (v[bj][n][2] * v[bj][n][2] + v[bj][n][3] * v[bj][n][3]);
                    ss += __shfl_xor(ss, 16); ss += __shfl_xor(ss, 32);
                    const float rn = rsqrtf(ss * (1.0f / HD) + EPS);
#pragma unroll
                    for (int bj = 0; bj < 2; ++bj)
#pragma unroll
                        for (int n = 0; n < 2; ++n) v[bj][n] = v[bj][n] * rn * gn[bj][n];
                    dst = (region == 0 ? qh : kh) + ((size_t)head * S + row) * HD;
                } else if (region == 2) {
                    dst = vh + ((size_t)head * S + row) * HD;
                } else if (region == 3) {
                    dst = xrg + (size_t)row * DRG + head * 64;
                } else {
#pragma unroll
                    for (int bj = 0; bj < 2; ++bj)
#pragma unroll
                        for (int n = 0; n < 2; ++n)
#pragma unroll
                            for (int i = 0; i < 4; ++i) v[bj][n][i] = gelu_tanh(v[bj][n][i]);
                    dst = gg + (size_t)row * DRG + head * 64;
                }
#pragma unroll
                for (int bj = 0; bj < 2; ++bj) {
                    pg8::u32x4 w; w.x = pg8::cvt_pk_bf16(v[bj][0][0], v[bj][0][1]); w.y = pg8::cvt_pk_bf16(v[bj][0][2], v[bj][0][3]);
                    w.z = pg8::cvt_pk_bf16(v[bj][1][0], v[bj][1][1]); w.w = pg8::cvt_pk_bf16(v[bj][1][2], v[bj][1][3]);
                    *(pg8::u32x4*)(dst + 32 * bj + 8 * fq) = w;
                }
            }
    }
};
struct EpiOutProj {
    static constexpr bool PERM = true, AFTER_DRAIN = false;
    const float* x; float* out; bf16_t* x1b; float* ssq;
    __device__ __forceinline__ void operator()(const pg8::f32x4 (&acc)[2][2][4][2], const pg8::Unit& u, int wr, int wc, int fr, int fq) const {
#pragma unroll
        for (int ai = 0; ai < 2; ++ai)
#pragma unroll
            for (int m = 0; m < 4; ++m) {
                const int row = u.pm * 256 + ai * 128 + wr * 64 + m * 16 + fr;
                float ss = 0.f;
#pragma unroll
                for (int bj = 0; bj < 2; ++bj) {
                    const size_t o = (size_t)row * D + u.pn * 256 + bj * 128 + wc * 32 + 8 * fq;
                    const pg8::f32x4 a = *(const pg8::f32x4*)(x + o) + acc[ai][bj][m][0], b = *(const pg8::f32x4*)(x + o + 4) + acc[ai][bj][m][1];
                    *(pg8::f32x4*)(out + o) = a; *(pg8::f32x4*)(out + o + 4) = b;
                    ss += (a[0] * a[0] + a[1] * a[1]) + (a[2] * a[2] + a[3] * a[3]) + (b[0] * b[0] + b[1] * b[1]) + (b[2] * b[2] + b[3] * b[3]);
                    pg8::u32x4 w; w.x = pg8::cvt_pk_bf16(a[0], a[1]); w.y = pg8::cvt_pk_bf16(a[2], a[3]); w.z = pg8::cvt_pk_bf16(b[0], b[1]); w.w = pg8::cvt_pk_bf16(b[2], b[3]);
                    *(pg8::u32x4*)(x1b + o) = w;
                }
                ss += __shfl_xor(ss, 16); ss += __shfl_xor(ss, 32);
                if (fq == 0) ssq[(size_t)row * 16 + u.pn * 4 + wc] = ss;
            }
    }
};
struct EpiPeerQ {
    static constexpr bool PERM = true, AFTER_DRAIN = false;
    bf16_t* qp;
    __device__ __forceinline__ void operator()(const pg8::f32x4 (&acc)[2][2][4][2], const pg8::Unit& u, int wr, int wc, int fr, int fq) const {
#pragma unroll
        for (int ai = 0; ai < 2; ++ai)
#pragma unroll
            for (int m = 0; m < 4; ++m) {
                const int row = u.pm * 256 + ai * 128 + wr * 64 + m * 16 + fr;
#pragma unroll
                for (int bj = 0; bj < 2; ++bj) {
                    const pg8::f32x4 a = acc[ai][bj][m][0], b = acc[ai][bj][m][1];
                    pg8::u32x4 w; w.x = pg8::cvt_pk_bf16(a[0], a[1]); w.y = pg8::cvt_pk_bf16(a[2], a[3]); w.z = pg8::cvt_pk_bf16(b[0], b[1]); w.w = pg8::cvt_pk_bf16(b[2], b[3]);
                    *(pg8::u32x4*)(qp + (size_t)row * NQ + u.pn * 256 + bj * 128 + wc * 32 + 8 * fq) = w;
                }
            }
    }
};

__device__ __forceinline__ void ph_attn(const Params& p) {
    unsigned char* ws = p.ws;
    const bf16_t* qh = (const bf16_t*)(ws + WS_QH); const bf16_t* kh = (const bf16_t*)(ws + WS_KH); const bf16_t* vh = (const bf16_t*)(ws + WS_VH);
    bf16_t* osb = (bf16_t*)(ws + WS_OSB);
    const int gtid = blockIdx.x * blockDim.x + threadIdx.x, gsize = gridDim.x * blockDim.x;
    for (int u = gtid; u < NH * S; u += gsize) {
        const int h = u / S, t = u % S;
        float q[HD], o[HD];
        {
            const bf16x8* qp = (const bf16x8*)(qh + ((size_t)h * S + t) * HD);
#pragma unroll
            for (int c = 0; c < 8; ++c) { const bf16x8 v = qp[c];
#pragma unroll
                for (int j = 0; j < 8; ++j) { q[8 * c + j] = bf2f((unsigned short)v[j]); o[8 * c + j] = 0.f; } }
        }
        float carry = 0.f;
        for (int s = t - 1; s >= 0; --s) {
            const bf16x8* kp = (const bf16x8*)(kh + ((size_t)h * S + s) * HD);
            float z = 0.f;
#pragma unroll
            for (int c = 0; c < 8; ++c) { const bf16x8 v = kp[c];
#pragma unroll
                for (int j = 0; j < 8; ++j) z += q[8 * c + j] * bf2f((unsigned short)v[j]); }
            const float sp2 = fmaxf(z, 0.f) + __builtin_amdgcn_logf(1.0f + __builtin_amdgcn_exp2f(-fabsf(z)));
            const float w = __builtin_amdgcn_exp2f(z - sp2 + carry);
            const bf16x8* vp = (const bf16x8*)(vh + ((size_t)h * S + s) * HD);
#pragma unroll
            for (int c = 0; c < 8; ++c) { const bf16x8 v = vp[c];
#pragma unroll
                for (int j = 0; j < 8; ++j) o[8 * c + j] += w * bf2f((unsigned short)v[j]); }
            carry -= sp2;
            if (carry < CARRY_STOP) break;
        }
        u32x4* op = (u32x4*)(osb + (size_t)t * DSB + h * HD);
#pragma unroll
        for (int c = 0; c < 8; ++c) { u32x4 w; w.x = pk2(o[8 * c], o[8 * c + 1]); w.y = pk2(o[8 * c + 2], o[8 * c + 3]); w.z = pk2(o[8 * c + 4], o[8 * c + 5]); w.w = pk2(o[8 * c + 6], o[8 * c + 7]); op[c] = w; }
    }
}

template <int PASS>
__device__ __forceinline__ void ph_rg(const Params& p, float* org, float* lds) {
    float (*xc)[65] = (float (*)[65])lds;
    float (*as_)[64] = (float (*)[64])(lds + CHUNK * 65);
    float (*bs_)[64] = (float (*)[64])(lds + CHUNK * 65 + CHUNK * 64);
    unsigned char* ws = p.ws;
    const bf16_t* xrg = (const bf16_t*)(ws + WS_XRG); const bf16_t* gg = (const bf16_t*)(ws + WS_GG);
    float* rgP = (float*)(ws + WS_RGP); float* rgH = (float*)(ws + WS_RGH);
    const float* cw = p.in[I_CONV_W]; const float* cb = p.in[I_CONV_B];
    const float* wa = p.in[I_RG_W_A]; const float* ba = p.in[I_RG_B_A]; const float* wx = p.in[I_RG_W_X]; const float* bx = p.in[I_RG_B_X];
    const float* lam = p.in[I_RG_LAMBDA];
    const int tid = threadIdx.x;
    for (int u = blockIdx.x; u < NCHUNK * 8; u += gridDim.x) {
        const int ch = u / 8, n = u % 8, t0 = ch * CHUNK, c0 = n * 64;
        __syncthreads();
        for (int e = tid; e < CHUNK * 64; e += NTHR) {
            const int t = e / 64, cc = e % 64, c = c0 + cc, tok = t0 + t;
            float a = cb[c];
#pragma unroll
            for (int k = 0; k < 4; ++k) { const int tt = tok + k - 3; if (tt >= 0) a += cw[k * DRG + c] * bf2f(xrg[(size_t)tt * DRG + c]); }
            xc[t][cc] = a;
        }
        __syncthreads();
        {
            const int j = tid & 63, tq = tid >> 6;
            const int c = c0 + j;
            const float sp = log1pf(__expf(-lam[c]));
            const float bav = ba[c], bxv = bx[c];
            for (int t = tq; t < CHUNK; t += NTHR / 64) {
                float ra = bav, ri = bxv;
                for (int i = 0; i < 64; ++i) { const float xv = xc[t][i]; ra += xv * wa[((size_t)n * 64 + i) * 64 + j]; ri += xv * wx[((size_t)n * 64 + i) * 64 + j]; }
                const float r = sigmoidf_(ra), ig = sigmoidf_(ri);
                const float log_a = -8.0f * r * sp;
                const float a = __expf(log_a);
                const float b = sqrtf(-expm1f(2.0f * log_a)) * (ig * xc[t][j]);
                as_[t][j] = a; bs_[t][j] = b;
            }
        }
        __syncthreads();
        if (tid < 64) {
            const int c = c0 + tid;
            float h = 0.f, P = 1.f;
            if (PASS == 1) { for (int k = 0; k < ch; ++k) h = rgP[k * DRG + c] * h + rgH[k * DRG + c]; }
            for (int t = 0; t < CHUNK; ++t) {
                const float a = as_[t][tid];
                h = a * h + bs_[t][tid]; P *= a;
                if (PASS == 1) org[(size_t)(t0 + t) * DRG + c] = h * bf2f(gg[(size_t)(t0 + t) * DRG + c]);
            }
            if (PASS == 0) { rgP[ch * DRG + c] = P; rgH[ch * DRG + c] = h; }
        }
    }
}

__device__ __forceinline__ void ph_mix(const Params& p, const float* org) {
    unsigned char* ws = p.ws;
    const bf16_t* osb = (const bf16_t*)(ws + WS_OSB); bf16_t* mix = (bf16_t*)(ws + WS_MIX);
    const int lane = threadIdx.x & 63, gwave = (blockIdx.x * blockDim.x + threadIdx.x) >> 6, nwave = (gridDim.x * blockDim.x) >> 6;
    for (int t = gwave; t < S; t += nwave) {
        const u32x4 a = *((const u32x4*)(osb + (size_t)t * DSB) + lane);
        float av[8] = {bf2f(a.x & 0xffff), bf2f(a.x >> 16), bf2f(a.y & 0xffff), bf2f(a.y >> 16), bf2f(a.z & 0xffff), bf2f(a.z >> 16), bf2f(a.w & 0xffff), bf2f(a.w >> 16)};
        const f32x4 b0 = *((const f32x4*)(org + (size_t)t * DRG) + 2 * lane), b1 = *((const f32x4*)(org + (size_t)t * DRG) + 2 * lane + 1);
        float ssa = 0.f, ssb = 0.f;
#pragma unroll
        for (int j = 0; j < 8; ++j) ssa += av[j] * av[j];
        ssb = b0.x * b0.x + b0.y * b0.y + b0.z * b0.z + b0.w * b0.w + b1.x * b1.x + b1.y * b1.y + b1.z * b1.z + b1.w * b1.w;
        ssa = wave_sum(ssa); ssb = wave_sum(ssb);
        const float ra = rsqrtf(ssa * (1.0f / DSB) + EPS), rb = rsqrtf(ssb * (1.0f / DRG) + EPS);
        u32x4 o; o.x = pk2(av[0] * ra, av[1] * ra); o.y = pk2(av[2] * ra, av[3] * ra); o.z = pk2(av[4] * ra, av[5] * ra); o.w = pk2(av[6] * ra, av[7] * ra);
        *((u32x4*)(mix + (size_t)t * D) + lane) = o;
        u32x4 o2; o2.x = pk2(b0.x * rb, b0.y * rb); o2.y = pk2(b0.z * rb, b0.w * rb); o2.z = pk2(b1.x * rb, b1.y * rb); o2.w = pk2(b1.z * rb, b1.w * rb);
        *((u32x4*)(mix + (size_t)t * D + DSB) + lane) = o2;
    }
}

__device__ __forceinline__ int f2key(float f) { const int b = __builtin_bit_cast(int, f); return b ^ ((b >> 31) & 0x7fffffff); }
__device__ __forceinline__ float key2f(int k) { return __builtin_bit_cast(float, k ^ ((k >> 31) & 0x7fffffff)); }
__device__ __forceinline__ void topk_insert(int (&lst)[16], int x) {
#pragma unroll
    for (int i = 0; i < 16; ++i) { const int hi = max(lst[i], x); x = min(lst[i], x); lst[i] = hi; }
}
__device__ __forceinline__ void ph_topk(const Params& p, int* lds) {
    unsigned char* ws = p.ws;
    const bf16_t* qp = (const bf16_t*)(ws + WS_B); const bf16_t* subk = (const bf16_t*)(ws + WS_SUBK);
    int* seli = (int*)(ws + WS_SELI); float* selg = (float*)(ws + WS_SELG);
    const float* ssq = (const float*)(ws + WS_SSQ); float* rstd2 = (float*)(ws + WS_RSTD2);
    const int gtid = blockIdx.x * blockDim.x + threadIdx.x, gsize = gridDim.x * blockDim.x, tid = threadIdx.x;
    for (int u = gtid; u < PH * S; u += gsize) {
        const int h = u / S, t = u % S;
        int tk[2][16];
#pragma unroll
        for (int pp = 0; pp < 2; ++pp) {
#pragma unroll
            for (int i = 0; i < 16; ++i) tk[pp][i] = (int)0x80000000;
            const bf16x8* qr = (const bf16x8*)(qp + (size_t)t * NQ + h * PDK + pp * PHALF);
            for (int n = 0; n < PNK; ++n) {
                int nn = n; asm volatile("" : "+v"(nn));
                const bf16x8* kr = (const bf16x8*)(subk + (((size_t)h * 2 + pp) * PNK + nn) * PHALF);
                float s = 0.f;
#pragma unroll
                for (int c = 0; c < 16; ++c) { const bf16x8 a = qr[c], b = kr[c];
#pragma unroll
                    for (int j = 0; j < 8; ++j) s += bf2f((unsigned short)a[j]) * bf2f((unsigned short)b[j]); }
                topk_insert(tk[pp], (f2key(s) & ~127) | (127 - n));
            }
        }
#pragma unroll
        for (int i = 0; i < 16; ++i) { lds[i * NTHR + tid] = tk[0][i]; lds[(16 + i) * NTHR + tid] = tk[1][i]; }
        float v0[16], v1[16];
#pragma unroll
        for (int i = 0; i < 16; ++i) { v0[i] = key2f(tk[0][i]); v1[i] = key2f(tk[1][i]); }
        int bk[16];
#pragma unroll
        for (int i = 0; i < 16; ++i) bk[i] = (int)0x80000000;
#pragma unroll
        for (int a = 0; a < 16; ++a)
#pragma unroll
            for (int b = 0; b < 16; ++b)
                if ((a + 1) * (b + 1) <= 16) topk_insert(bk, (f2key(v0[a] + v1[b]) & ~255) | (255 - (a * 16 + b)));
        float ssum = 0.f;
#pragma unroll
        for (int i = 0; i < 16; ++i) ssum += ssq[(size_t)t * 16 + i];
        const float rs = rsqrtf(ssum * (1.0f / D) + EPS);
        if (h == 0) rstd2[t] = rs;
        float e[16], sum = 0.f; const float m = key2f(bk[0]);
#pragma unroll
        for (int i = 0; i < 16; ++i) { e[i] = __expf((key2f(bk[i]) - m) * rs); sum += e[i]; }
        const float inv = 1.0f / sum;
#pragma unroll
        for (int i = 0; i < 16; ++i) {
            const int code = 255 - (bk[i] & 255), a = code >> 4, b = code & 15;
            const int i1 = 127 - (lds[a * NTHR + tid] & 127), i2 = 127 - (lds[(16 + b) * NTHR + tid] & 127);
            seli[(size_t)t * 128 + h * 16 + i] = i1 * PNK + i2; selg[(size_t)t * 128 + h * 16 + i] = e[i] * inv;
        }
    }
}

__device__ __forceinline__ void unpack8(const u32x4 a, float (&f)[8]) {
    f[0] = bf2f(a.x & 0xffff); f[1] = bf2f(a.x >> 16); f[2] = bf2f(a.y & 0xffff); f[3] = bf2f(a.y >> 16);
    f[4] = bf2f(a.z & 0xffff); f[5] = bf2f(a.z >> 16); f[6] = bf2f(a.w & 0xffff); f[7] = bf2f(a.w >> 16);
}
__device__ __forceinline__ void ph_gather(const Params& p) {
    unsigned char* ws = p.ws;
    const bf16_t* x1b = (const bf16_t*)(ws + WS_A); const bf16_t* ub = (const bf16_t*)(ws + WS_UB); const bf16_t* vb = (const bf16_t*)(ws + WS_VB);
    const int* seli = (const int*)(ws + WS_SELI); const float* selg = (const float*)(ws + WS_SELG); const float* rstd2 = (const float*)(ws + WS_RSTD2);
    float* out = p.out;
    const int lane = threadIdx.x & 63, gwave = (blockIdx.x * blockDim.x + threadIdx.x) >> 6, nwave = (gridDim.x * blockDim.x) >> 6;
    for (int t = gwave; t < S; t += nwave) {
        float xv[16], acc[16];
        { float f[8]; unpack8(*((const u32x4*)(x1b + (size_t)t * D) + lane), f);
#pragma unroll
          for (int j = 0; j < 8; ++j) xv[j] = f[j];
          unpack8(*((const u32x4*)(x1b + (size_t)t * D + 512) + lane), f);
#pragma unroll
          for (int j = 0; j < 8; ++j) xv[8 + j] = f[j]; }
#pragma unroll
        for (int j = 0; j < 16; ++j) acc[j] = 0.f;
        const float rs = rstd2[t];
        for (int j = 0; j < 128; ++j) {
            const int e = seli[(size_t)t * 128 + j]; const float g = selg[(size_t)t * 128 + j];
            float f0[8], f1[8];
            unpack8(*((const u32x4*)(ub + (size_t)e * D) + lane), f0); unpack8(*((const u32x4*)(ub + (size_t)e * D + 512) + lane), f1);
            float d = 0.f;
#pragma unroll
            for (int k = 0; k < 8; ++k) d += xv[k] * f0[k] + xv[8 + k] * f1[k];
            d = wave_sum(d);
            const float coef = g * gelu_tanh(d * rs);
            unpack8(*((const u32x4*)(vb + (size_t)e * D) + lane), f0); unpack8(*((const u32x4*)(vb + (size_t)e * D + 512) + lane), f1);
#pragma unroll
            for (int k = 0; k < 8; ++k) { acc[k] += coef * f0[k]; acc[8 + k] += coef * f1[k]; }
        }
        f32x4* o0 = (f32x4*)(out + (size_t)t * D + 8 * lane); f32x4* o1 = (f32x4*)(out + (size_t)t * D + 512 + 8 * lane);
        f32x4 a = o0[0], b = o0[1], c = o1[0], d2 = o1[1];
        a.x += acc[0]; a.y += acc[1]; a.z += acc[2]; a.w += acc[3]; b.x += acc[4]; b.y += acc[5]; b.z += acc[6]; b.w += acc[7];
        c.x += acc[8]; c.y += acc[9]; c.z += acc[10]; c.w += acc[11]; d2.x += acc[12]; d2.y += acc[13]; d2.z += acc[14]; d2.w += acc[15];
        o0[0] = a; o0[1] = b; o1[0] = c; o1[1] = d2;
    }
}

#define LAS __attribute__((address_space(3)))
#define XB_TMO      128
#define XB_XCNT(j)  (256  + 64 * (j))
#define XB_XSUB(j)  (1280 + 64 * (j))
#define XB_XGEN(j)  (2304 + 64 * (j))
#define XB_TOP      3328
#define XB_TOPGEN   3392
#define XCD_BAR_WORDS 3456
#define XB_SPIN_CAP (1u << 18)
__device__ __forceinline__ unsigned xb_ld(unsigned* p)              { return __hip_atomic_load(p, __ATOMIC_RELAXED, __HIP_MEMORY_SCOPE_AGENT); }
__device__ __forceinline__ unsigned xb_add(unsigned* p, unsigned v) { return __hip_atomic_fetch_add(p, v, __ATOMIC_RELAXED, __HIP_MEMORY_SCOPE_AGENT); }
__device__ __forceinline__ unsigned xb_xcc_id() { return (unsigned)__builtin_amdgcn_s_getreg((3 << 11) | 20) & 0xFu; }
#define XB_SPIN(cond, bar) do { unsigned _sp = 0; while (cond) { __builtin_amdgcn_s_sleep(1); \
    if ((++_sp & 255u) == 0u) { if (xb_ld(&(bar)[XB_TMO])) break; if (_sp > XB_SPIN_CAP) { atomicAdd(&(bar)[XB_TMO], 1u); break; } } } } while (0)
struct XcdBarrier { unsigned* bar; unsigned x; volatile LAS unsigned* st; };
__device__ __forceinline__ XcdBarrier xcd_barrier_post(unsigned* bar, volatile LAS unsigned* st) {
    XcdBarrier b; b.bar = bar; b.x = xb_xcc_id(); b.st = st;
    if (threadIdx.x == 0) (void)xb_add(&bar[XB_XCNT(b.x)], 1u);
    return b;
}
__device__ __forceinline__ void xcd_barrier_complete(unsigned* bar, unsigned x, unsigned& nloc, unsigned& nx) {
    const unsigned G = gridDim.x * gridDim.y * gridDim.z;
    unsigned sum, cnt, mine, sp = 0u;
    for (;;) {
        sum = 0u; cnt = 0u; mine = 0u;
#pragma unroll
        for (unsigned j = 0; j < 16; ++j) { const unsigned c = xb_ld(&bar[XB_XCNT(j)]); sum += c; cnt += (c > 0u) ? 1u : 0u; mine = (j == x) ? c : mine; }
        if (sum == G) break;
        __builtin_amdgcn_s_sleep(1);
        if ((++sp & 255u) == 0u) { if (xb_ld(&bar[XB_TMO])) break; if (sp > XB_SPIN_CAP) { atomicAdd(&bar[XB_TMO], 1u); break; } }
    }
    nloc = mine > 0u ? mine : 1u; nx = cnt > 0u ? cnt : 1u;
}
__device__ __forceinline__ void xcd_barrier(const XcdBarrier& b) {
    asm volatile("s_waitcnt vmcnt(0)" ::: "memory");
    __syncthreads();
    if (threadIdx.x == 0) {
        unsigned* bar = b.bar;
        __builtin_amdgcn_s_waitcnt(0);
        unsigned nloc = b.st[0], nx = b.st[1];
        if (nloc == 0u) { xcd_barrier_complete(bar, b.x, nloc, nx); b.st[0] = nloc; b.st[1] = nx; }
        const unsigned old = xb_add(&bar[XB_XSUB(b.x)], 1u);
        const unsigned gen = old / nloc;
        if (old + 1u == (gen + 1u) * nloc) {
            __builtin_amdgcn_fence(__ATOMIC_RELEASE, "agent");
            asm volatile("s_waitcnt vmcnt(0)" ::: "memory");
            const unsigned og = xb_add(&bar[XB_TOP], 1u);
            const unsigned tg = og / nx;
            if (og + 1u == (tg + 1u) * nx) xb_add(&bar[XB_TOPGEN], 1u);
            else XB_SPIN(xb_ld(&bar[XB_TOPGEN]) == tg, bar);
            __builtin_amdgcn_fence(__ATOMIC_ACQUIRE, "agent");
            xb_add(&bar[XB_XGEN(b.x)], 1u);
            asm volatile("s_waitcnt vmcnt(0)" ::: "memory");
        } else {
            XB_SPIN(xb_ld(&bar[XB_XGEN(b.x)]) == gen, bar);
            __builtin_amdgcn_fence(__ATOMIC_ACQUIRE, "agent");
            asm volatile("s_waitcnt vmcnt(0)" ::: "memory");
        }
    }
    __syncthreads();
}

constexpr int LDS_MISC = 131072;
constexpr int LDS_BYTES = LDS_MISC + 1024;

__global__ void __launch_bounds__(NTHR, 2) hymba_fwd(Params p) {
    extern __shared__ __attribute__((aligned(16))) unsigned char lds[];
    volatile LAS unsigned* misc = (volatile LAS unsigned*)((LAS unsigned char*)lds + LDS_MISC);
    if (threadIdx.x < 4) misc[threadIdx.x] = 0u;
    __syncthreads();
    XcdBarrier bar = xcd_barrier_post((unsigned*)(p.ws + WS_CTL), misc);
    float* org = p.out;

    PG8_LAS unsigned char* ring = (PG8_LAS unsigned char*)lds;
    unsigned char* ws = p.ws;
    ph_prep(p);                               xcd_barrier(bar);
    {
        pg8::Gemm g{(const bf16_t*)(ws + WS_A), (const bf16_t*)(ws + WS_WINT), S, NPROJ, D}; pg8::StaticOrder so; so.init(S, NPROJ, (int)gridDim.x, (int)blockIdx.x);
        EpiInProj E{(const float*)(ws + WS_RSTD1), p.in[I_Q_NORM], p.in[I_K_NORM], (bf16_t*)(ws + WS_QH), (bf16_t*)(ws + WS_KH), (bf16_t*)(ws + WS_VH), (bf16_t*)(ws + WS_XRG), (bf16_t*)(ws + WS_GG)};
        pg8::gemm_phase<EpiInProj, pg8::StaticOrder, true, true>(ring, g, so, E);
    }
    xcd_barrier(bar);
    ph_attn(p); ph_rg<0>(p, org, (float*)lds); xcd_barrier(bar);
    ph_rg<1>(p, org, (float*)lds);            xcd_barrier(bar);
    ph_mix(p, org);                           xcd_barrier(bar);
    {
        pg8::Gemm g{(const bf16_t*)(ws + WS_MIX), (const bf16_t*)(ws + WS_WOUTT), S, D, D}; pg8::StaticOrder so; so.init(S, D, (int)gridDim.x, (int)blockIdx.x);
        EpiOutProj E{p.in[I_X], p.out, (bf16_t*)(ws + WS_A), (float*)(ws + WS_SSQ)};
        pg8::gemm_phase<EpiOutProj, pg8::StaticOrder, true, true>(ring, g, so, E);
    }
    xcd_barrier(bar);
    {
        pg8::Gemm g{(const bf16_t*)(ws + WS_A), (const bf16_t*)(ws + WS_WQT), S, NQ, D}; pg8::StaticOrder so; so.init(S, NQ, (int)gridDim.x, (int)blockIdx.x);
        EpiPeerQ E{(bf16_t*)(ws + WS_B)};
        pg8::gemm_phase<EpiPeerQ, pg8::StaticOrder, true, true>(ring, g, so, E);
    }
    xcd_barrier(bar);
    ph_topk(p, (int*)lds);                    xcd_barrier(bar);
    ph_gather(p);
}

extern "C" void kernel_launch(void* const* d_in, const int* in_sizes, int n_in, void* d_out, int out_size, void* d_ws, size_t ws_size, hipStream_t stream) {
    static int grid = 0;
    if (grid == 0) {
        if (n_in != 20 || out_size != S * D || ws_size < WS_END) { fprintf(stderr, "kernel_launch: unexpected shapes (n_in %d out %d ws %zu)\n", n_in, out_size, ws_size); grid = -1; return; }
        int dev = 0, cus = 0, per_cu = 0;
        if (hipGetDevice(&dev) != hipSuccess || hipDeviceGetAttribute(&cus, hipDeviceAttributeMultiprocessorCount, dev) != hipSuccess) { grid = -1; return; }
        if (hipFuncSetAttribute((const void*)hymba_fwd, hipFuncAttributeMaxDynamicSharedMemorySize, LDS_BYTES) != hipSuccess) { fprintf(stderr, "kernel_launch: hipFuncSetAttribute failed\n"); grid = -1; return; }
        if (hipOccupancyMaxActiveBlocksPerMultiprocessor(&per_cu, (const void*)hymba_fwd, NTHR, LDS_BYTES) != hipSuccess || per_cu < 1) { fprintf(stderr, "kernel_launch: occupancy query says %d blocks per CU\n", per_cu); grid = -1; return; }
        (void)hipGetLastError();
        grid = cus;
    }
    if (grid < 0) return;
    (void)hipMemsetAsync((char*)d_ws + WS_CTL, 0, XCD_BAR_WORDS * 4, stream);
    Params p{};
    for (int i = 0; i < 20; ++i) p.in[i] = (const float*)d_in[i];
    p.out = (float*)d_out; p.ws = (unsigned char*)d_ws;
    hipLaunchKernelGGL(hymba_fwd, dim3(grid), dim3(NTHR), LDS_BYTES, stream, p);
}
```

```cpp
#include <hip/hip_runtime.h>
#include <cstdint>
#include <cstdio>

typedef unsigned short bf16_t;
typedef short bf16x8 __attribute__((ext_vector_type(8)));
typedef float f32x4 __attribute__((ext_vector_type(4)));
typedef unsigned u32x4 __attribute__((ext_vector_type(4)));

constexpr int S = 16384, D = 1024, NPROJ = 2560, DSB = 512, DRG = 512, NH = 8, HD = 64;
constexpr int PH = 8, PNK = 128, PDK = 256, PHALF = 128, PTOPK = 16, NEXP = 16384, NQ = PH * PDK;
constexpr int CHUNK = 64, NCHUNK = S / CHUNK;
constexpr float EPS = 1e-6f;
constexpr float LOG2E = 1.4426950408889634f;
constexpr float QSCALE = 0.125f * LOG2E;
constexpr int NTHR = 512;
constexpr float CARRY_STOP = -160.0f;

constexpr size_t MiB = 1u << 20;
constexpr size_t WS_CTL = 0;
constexpr size_t WS_WINT = 1 * MiB;
constexpr size_t WS_WOUTT = 6 * MiB;
constexpr size_t WS_WQT = 8 * MiB;
constexpr size_t WS_SUBK = 12 * MiB;
constexpr size_t WS_RSTD1 = 12 * MiB + 512 * 1024;
constexpr size_t WS_RSTD2 = WS_RSTD1 + 64 * 1024;
constexpr size_t WS_RGP = WS_RSTD2 + 64 * 1024;
constexpr size_t WS_RGH = WS_RGP + 512 * 1024;
constexpr size_t WS_A = 14 * MiB;
constexpr size_t WS_B = 46 * MiB;
constexpr size_t WS_QH = WS_B, WS_KH = WS_B + 16 * MiB, WS_VH = WS_B + 32 * MiB, WS_XRG = WS_B + 48 * MiB;
constexpr size_t WS_GG = 110 * MiB;
constexpr size_t WS_OSB = 126 * MiB;
constexpr size_t WS_MIX = 142 * MiB;
constexpr size_t WS_SELI = WS_MIX, WS_SELG = WS_MIX + 8 * MiB;
constexpr size_t WS_UB = 174 * MiB;
constexpr size_t WS_VB = 190 * MiB;
constexpr size_t WS_USC = 206 * MiB;
constexpr size_t WS_VSC = 206 * MiB + 64 * 1024;
constexpr size_t WS_SSQ = 238 * MiB;
constexpr size_t WS_END = 239 * MiB;

__device__ __forceinline__ unsigned f2bf(float f) { unsigned u = __builtin_bit_cast(unsigned, f); return (u + 0x7fffu + ((u >> 16) & 1u)) >> 16; }
__device__ __forceinline__ float bf2f(unsigned h) { return __builtin_bit_cast(float, h << 16); }
__device__ __forceinline__ unsigned pk2(float lo, float hi) { return f2bf(lo) | (f2bf(hi) << 16); }
__device__ __forceinline__ float wave_sum(float v) {
#pragma unroll
    for (int o = 1; o < 64; o <<= 1) v += __shfl_xor(v, o);
    return v;
}
__device__ __forceinline__ float gelu_tanh(float x) {
    const float u = 0.7978845608028654f * (x + 0.044715f * x * x * x);
    const float e = __expf(2.0f * u);
    const float th = 1.0f - 2.0f / (e + 1.0f);
    return 0.5f * x * (1.0f + th);
}
__device__ __forceinline__ float sigmoidf_(float x) { return 1.0f / (1.0f + __expf(-x)); }

__host__ __device__ __forceinline__ int inproj_phys_row(int nlog) { const int t = nlog >> 8, L = nlog & 255; return (t << 8) + 128 * ((L & 63) >> 5) + 32 * (L >> 6) + (L & 31); }

struct Params {
    const float* in[20];
    float* out;
    unsigned char* ws;
};
enum { I_X = 0, I_NORM_MIX, I_W_IN, I_Q_NORM, I_K_NORM, I_CONV_W, I_CONV_B, I_RG_W_A, I_RG_B_A, I_RG_W_X, I_RG_B_X, I_RG_LAMBDA,
       I_OUT_NORM_SB, I_OUT_NORM_RG, I_W_OUT, I_NORM_FFN, I_PEER_WQ, I_PEER_SUBK, I_PEER_U, I_PEER_V };

template <bool INPROJ_PERM>
__device__ __forceinline__ void prep_transpose(const float* W, const float* gain0, const float* gain1, int K, int N, bf16_t* WT, int gtid, int gsize) {
    for (long e = gtid; e < (long)K * N; e += gsize) {
        const int k = (int)(e / N), n = (int)(e % N);
        float g = 1.0f;
        if (gain0) g = (gain1 && k >= 512) ? gain1[k - 512] : gain0[k];
        const int nr = INPROJ_PERM ? inproj_phys_row(n) : n;
        WT[(size_t)nr * K + k] = (bf16_t)f2bf(g * W[e]);
    }
}
__device__ __forceinline__ void ph_prep(const Params& p) {
    const int gtid = blockIdx.x * blockDim.x + threadIdx.x, gsize = gridDim.x * blockDim.x;
    const int lane = threadIdx.x & 63, gwave = gtid >> 6, nwave = gsize >> 6;
    unsigned char* ws = p.ws;
    prep_transpose<true>(p.in[I_W_IN], p.in[I_NORM_MIX], nullptr, D, NPROJ, (bf16_t*)(ws + WS_WINT), gtid, gsize);
    prep_transpose<false>(p.in[I_W_OUT], p.in[I_OUT_NORM_SB], p.in[I_OUT_NORM_RG], D, D, (bf16_t*)(ws + WS_WOUTT), gtid, gsize);
    prep_transpose<false>(p.in[I_PEER_WQ], p.in[I_NORM_FFN], nullptr, D, NQ, (bf16_t*)(ws + WS_WQT), gtid, gsize);
    {
        const float* sk = p.in[I_PEER_SUBK]; bf16_t* o = (bf16_t*)(ws + WS_SUBK);
        for (int e = gtid; e < PH * 2 * PNK * PHALF; e += gsize) o[e] = (bf16_t)f2bf(sk[e]);
    }
    {
        const float* u = p.in[I_PEER_U]; const float* v = p.in[I_PEER_V]; const float* g = p.in[I_NORM_FFN];
        unsigned* ub = (unsigned*)(ws + WS_UB); unsigned* vb = (unsigned*)(ws + WS_VB); float* usc = (float*)(ws + WS_USC); float* vsc = (float*)(ws + WS_VSC);
        f32x4 gq[4];
#pragma unroll
        for (int j = 0; j < 4; ++j) gq[j] = *((const f32x4*)g + lane + 64 * j);
        for (int e = gwave; e < NEXP; e += nwave) {
            f32x4 a[4], b[4]; float ma = 0.f, mb = 0.f;
#pragma unroll
            for (int j = 0; j < 4; ++j) {
                a[j] = *((const f32x4*)(u + (size_t)e * D) + lane + 64 * j) * gq[j]; b[j] = *((const f32x4*)(v + (size_t)e * D) + lane + 64 * j);
                ma = fmaxf(ma, fmaxf(fmaxf(fabsf(a[j].x), fabsf(a[j].y)), fmaxf(fabsf(a[j].z), fabsf(a[j].w))));
                mb = fmaxf(mb, fmaxf(fmaxf(fabsf(b[j].x), fabsf(b[j].y)), fmaxf(fabsf(b[j].z), fabsf(b[j].w))));
            }
#pragma unroll
            for (int o = 1; o < 64; o <<= 1) { ma = fmaxf(ma, __shfl_xor(ma, o)); mb = fmaxf(mb, __shfl_xor(mb, o)); }
            const float sa = ma > 0.f ? 256.0f / ma : 1.0f, sb = mb > 0.f ? 256.0f / mb : 1.0f;
#pragma unroll
            for (int j = 0; j < 4; ++j) {
                int w = 0;
                w = __builtin_amdgcn_cvt_pk_fp8_f32(a[j].x * sa, a[j].y * sa, w, false); w = __builtin_amdgcn_cvt_pk_fp8_f32(a[j].z * sa, a[j].w * sa, w, true);
                ub[(size_t)e * (D / 4) + lane + 64 * j] = (unsigned)w;
                w = 0;
                w = __builtin_amdgcn_cvt_pk_fp8_f32(b[j].x * sb, b[j].y * sb, w, false); w = __builtin_amdgcn_cvt_pk_fp8_f32(b[j].z * sb, b[j].w * sb, w, true);
                vb[(size_t)e * (D / 4) + lane + 64 * j] = (unsigned)w;
            }
            if (lane == 0) { usc[e] = ma > 0.f ? ma * (1.0f / 256.0f) : 1.0f; vsc[e] = mb > 0.f ? mb * (1.0f / 256.0f) : 1.0f; }
        }
    }
    {
        const float* x = p.in[I_X]; bf16_t* xb = (bf16_t*)(ws + WS_A); float* rstd1 = (float*)(ws + WS_RSTD1);
        for (int row = gwave; row < S; row += nwave) {
            const f32x4* xr = (const f32x4*)(x + (size_t)row * D) + lane;
            uint2* o = (uint2*)(xb + (size_t)row * D) + lane;
            float ss = 0.f;
#pragma unroll
            for (int j = 0; j < 4; ++j) {
                const f32x4 v = xr[64 * j];
                ss += v.x * v.x + v.y * v.y + v.z * v.z + v.w * v.w;
                o[64 * j] = make_uint2(pk2(v.x, v.y), pk2(v.z, v.w));
            }
            ss = wave_sum(ss);
            if (lane == 0) rstd1[row] = rsqrtf(ss * (1.0f / D) + EPS);
        }
    }
}

namespace pg8 {
#define PG8_LAS __attribute__((address_space(3)))
typedef unsigned short bf16_t;
typedef short bf16x8 __attribute__((ext_vector_type(8)));
typedef float f32x4 __attribute__((ext_vector_type(4)));
typedef unsigned u32x4 __attribute__((ext_vector_type(4)));
constexpr int BM = 256, BK = 64, HALF = 128, HTB = HALF * BK * 2  , STAGE_BYTES = 8 * HTB, NXCD = 8, WGM = 8;

__host__ __device__ __forceinline__ int lds_byte(int r, int c) { const int st = (r >> 4) * 2 + (c >> 5), rr = r & 15, cc = c & 31, ob = rr * 64 + cc * 2; return st * 1024 + (ob ^ (((ob >> 9) & 1) << 5)); }
__host__ __device__ __forceinline__ void stage_rc(int b, int& R, int& C) { const int st = b / 1024, sb = b % 1024, swz = sb ^ (((sb >> 9) & 1) << 5); R = (st >> 1) * 16 + swz / 64; C = (st & 1) * 32 + (swz % 64) / 2; }
__host__ __device__ __forceinline__ int perm32(int rho) { const int n = rho >> 4, i = rho & 15; return 8 * (i >> 2) + 4 * n + (i & 3); }

struct Unit { int pm, pn; };
struct Gemm { const bf16_t* A; const bf16_t* Bt; int M, N, K; };

struct StaticOrder {
    int nM, nN, nwg, G, c;
    __host__ __device__ void init(int M, int N, int G_, int c_) { nM = M / BM; nN = N / BM; nwg = nM * nN; G = G_; c = c_; }
    __host__ __device__ bool next(int i, Unit& u) const {
        const long L = (long)i * G + c; if (L >= nwg) return false;
        int wgid = (int)L; { const int q = nwg / NXCD, r = nwg % NXCD, xcd = wgid % NXCD, off = wgid / NXCD; wgid = (xcd < r ? xcd * (q + 1) : r * (q + 1) + (xcd - r) * q) + off; }
        const int nig = WGM * nN, gid = wgid / nig, fm = gid * WGM, gsz = (nM - fm) < WGM ? (nM - fm) : WGM;
        u.pm = fm + ((wgid % nig) % gsz); u.pn = (wgid % nig) / gsz; return true;
    }
    __device__ __forceinline__ void a_ready(const Unit&) const {}
    __device__ __forceinline__ void done(const Unit&) const {}
};

__device__ __forceinline__ unsigned cvt_pk_bf16(float lo, float hi) { unsigned r; asm volatile("v_cvt_pk_bf16_f32 %0, %1, %2" : "=v"(r) : "v"(lo), "v"(hi)); return r; }
template <class Epi, class Sched, bool ALIGN_EPI = false, bool SP2 = false>
__device__ __forceinline__ void gemm_phase(PG8_LAS unsigned char* lds, const Gemm g, const Sched& S, const Epi& E) {
    const int tid = threadIdx.x, wid = __builtin_amdgcn_readfirstlane(tid >> 6), lane = tid & 63, wr = wid >> 2, wc = wid & 3, fr = lane & 15, fq = lane >> 4;
    const int K = g.K, nt = K / BK;
    unsigned voffA[2], voffB[2];
#pragma unroll
    for (int i = 0; i < 2; ++i) { int R, C; stage_rc(tid * 16 + i * 8192, R, C); const int Rb = Epi::PERM ? ((R & ~31) + perm32(R & 31)) : R;
        voffA[i] = (unsigned)(R * K + C) * 2u; voffB[i] = (unsigned)(Rb * K + C) * 2u; }
    const size_t kstep = (size_t)(BK * 2);
    const size_t hstep = (size_t)HALF * K * 2;
    const size_t tstep = 2 * hstep;
    const unsigned ldsw = (unsigned)wid * 1024u;
    const int aoff = lds_byte(wr * 64 + fr, fq * 8), boff = lds_byte(wc * 32 + fr, fq * 8);
#define PG8_SA(b, h) (((b) * 2 + (h)) * HTB)
#define PG8_SB(b, h) ((4 + (b) * 2 + (h)) * HTB)
#define PG8_STAGE(bufoff, gbase, voff) do { _Pragma("unroll") for (int _i = 0; _i < 2; ++_i) \
        __builtin_amdgcn_global_load_lds((const unsigned*)((const char*)(gbase) + (voff)[_i]), (PG8_LAS unsigned*)(lds + (bufoff) + ldsw + _i * 8192), 16, 0, 0); } while (0)
#define PG8_LDA(dst, b, h) do { _Pragma("unroll") for (int m = 0; m < 4; ++m) _Pragma("unroll") for (int k = 0; k < 2; ++k) dst[m][k] = *(const PG8_LAS bf16x8*)(lds + PG8_SA(b, h) + aoff + m * 2048 + k * 1024); } while (0)
#define PG8_LDB(dst, b, h) do { _Pragma("unroll") for (int n = 0; n < 2; ++n) _Pragma("unroll") for (int k = 0; k < 2; ++k) dst[n][k] = *(const PG8_LAS bf16x8*)(lds + PG8_SB(b, h) + boff + n * 2048 + k * 1024); } while (0)
#define PG8_MMA(ai, bj, At, Bt) do { __builtin_amdgcn_s_setprio(1); _Pragma("unroll") for (int m = 0; m < 4; ++m) _Pragma("unroll") for (int n = 0; n < 2; ++n) _Pragma("unroll") for (int k = 0; k < 2; ++k) \
        acc[ai][bj][m][n] = __builtin_amdgcn_mfma_f32_16x16x32_bf16(Bt[n][k], At[m][k], acc[ai][bj][m][n], 0, 0, 0); __builtin_amdgcn_s_setprio(0); } while (0)
#define PG8_WAIT_V(n) asm volatile("s_waitcnt vmcnt(" #n ")" ::: "memory")
#define PG8_WAIT_L(n) asm volatile("s_waitcnt lgkmcnt(" #n ")" ::: "memory")
#define PG8_BAR __builtin_amdgcn_s_barrier()
#define PG8_SCHED __builtin_amdgcn_sched_barrier(0)
    Unit cur, nxt; int ui = 0;
    if (!S.next(0, cur)) return;
    f32x4 acc[2][2][4][2];
#pragma unroll
    for (int a = 0; a < 2; ++a)
#pragma unroll
        for (int b = 0; b < 2; ++b)
#pragma unroll
            for (int m = 0; m < 4; ++m)
#pragma unroll
                for (int n = 0; n < 2; ++n) acc[a][b][m][n] = (f32x4){0.f, 0.f, 0.f, 0.f};
    bf16x8 At[4][2], B0[2][2], B1[2][2];
    const char* cA = (const char*)g.A + (size_t)cur.pm * tstep; const char* cB = (const char*)g.Bt + (size_t)cur.pn * tstep;
    S.a_ready(cur);
    if constexpr (SP2) {
        PG8_STAGE(PG8_SB(0, 0), cB, voffB); PG8_STAGE(PG8_SB(0, 1), cB + hstep, voffB); PG8_STAGE(PG8_SA(0, 0), cA, voffA); PG8_STAGE(PG8_SA(0, 1), cA + hstep, voffA);
        if (wr == 1) PG8_BAR;
        PG8_WAIT_V(2); PG8_BAR;
        PG8_STAGE(PG8_SB(1, 0), cB + kstep, voffB); PG8_STAGE(PG8_SA(1, 0), cA + kstep, voffA); PG8_STAGE(PG8_SB(1, 1), cB + hstep + kstep, voffB);
        PG8_WAIT_V(6); PG8_BAR;
    } else {
        PG8_STAGE(PG8_SB(0, 0), cB, voffB); PG8_STAGE(PG8_SA(0, 0), cA, voffA); PG8_STAGE(PG8_SB(0, 1), cB + hstep, voffB); PG8_STAGE(PG8_SA(0, 1), cA + hstep, voffA);
        if (wr == 1) PG8_BAR;
        PG8_WAIT_V(4); PG8_BAR;
        PG8_STAGE(PG8_SB(1, 0), cB + kstep, voffB); PG8_STAGE(PG8_SA(1, 0), cA + kstep, voffA); PG8_STAGE(PG8_SB(1, 1), cB + hstep + kstep, voffB);
        PG8_WAIT_V(6); PG8_BAR;
    }
    for (;;) {
        const bool has_next = S.next(ui + 1, nxt);
        const char* nA = has_next ? (const char*)g.A + (size_t)nxt.pm * tstep : cA; const char* nB = has_next ? (const char*)g.Bt + (size_t)nxt.pn * tstep : cB;
        for (int t = 0; t < nt; t += 2) {
            const bool last = (t == nt - 2);
            const char* a1 = cA + (size_t)(t + 1) * kstep;
            const char* a2 = last ? nA : cA + (size_t)(t + 2) * kstep; const char* b2 = last ? nB : cB + (size_t)(t + 2) * kstep;
            const char* a3 = a2 + kstep; const char* b3 = b2 + kstep;
            if (last && has_next) S.a_ready(nxt);
            if constexpr (SP2) {
            PG8_LDB(B0, 0, 0); PG8_LDB(B1, 0, 1); PG8_SCHED; PG8_LDA(At, 0, 0); PG8_STAGE(PG8_SA(1, 1), a1 + hstep, voffA);
            PG8_WAIT_V(8); PG8_WAIT_L(0); PG8_BAR; PG8_MMA(0, 0, At, B0); PG8_MMA(0, 1, At, B1); PG8_BAR; PG8_SCHED;
            PG8_LDA(At, 0, 1); PG8_STAGE(PG8_SB(0, 0), b2, voffB); PG8_STAGE(PG8_SB(0, 1), b2 + hstep, voffB); PG8_STAGE(PG8_SA(0, 0), a2, voffA);
            PG8_WAIT_V(8); PG8_WAIT_L(0); PG8_BAR; PG8_MMA(1, 0, At, B0); PG8_MMA(1, 1, At, B1); PG8_BAR; PG8_SCHED;
            PG8_LDB(B0, 1, 0); PG8_LDB(B1, 1, 1); PG8_SCHED; PG8_LDA(At, 1, 0); PG8_STAGE(PG8_SA(0, 1), a2 + hstep, voffA);
            PG8_WAIT_V(8); PG8_WAIT_L(0); PG8_BAR; PG8_MMA(0, 0, At, B0); PG8_MMA(0, 1, At, B1); PG8_BAR; PG8_SCHED;
            PG8_LDA(At, 1, 1); PG8_STAGE(PG8_SB(1, 0), b3, voffB); PG8_STAGE(PG8_SB(1, 1), b3 + hstep, voffB); PG8_STAGE(PG8_SA(1, 0), a3, voffA);
            PG8_WAIT_V(8); PG8_WAIT_L(0); PG8_BAR; PG8_MMA(1, 0, At, B0); PG8_MMA(1, 1, At, B1); PG8_BAR; PG8_SCHED;
            } else {
            PG8_LDB(B0, 0, 0); PG8_SCHED; PG8_LDA(At, 0, 0); PG8_STAGE(PG8_SA(1, 1), a1 + hstep, voffA);
            PG8_WAIT_L(8); PG8_BAR; PG8_WAIT_L(0); PG8_MMA(0, 0, At, B0); PG8_BAR; PG8_SCHED;
            PG8_LDB(B1, 0, 1); PG8_STAGE(PG8_SB(0, 0), b2, voffB);
            PG8_BAR; PG8_WAIT_L(0); PG8_MMA(0, 1, At, B1); PG8_BAR;
            PG8_LDA(At, 0, 1); PG8_STAGE(PG8_SA(0, 0), a2, voffA);
            PG8_BAR; PG8_WAIT_L(0); PG8_MMA(1, 0, At, B0); PG8_BAR; PG8_SCHED;
            PG8_STAGE(PG8_SB(0, 1), b2 + hstep, voffB);
            PG8_WAIT_V(6); PG8_BAR; PG8_MMA(1, 1, At, B1); PG8_BAR;
            PG8_LDB(B0, 1, 0); PG8_SCHED; PG8_LDA(At, 1, 0); PG8_STAGE(PG8_SA(0, 1), a2 + hstep, voffA);
            PG8_WAIT_L(8); PG8_BAR; PG8_WAIT_L(0); PG8_MMA(0, 0, At, B0); PG8_BAR; PG8_SCHED;
            PG8_LDB(B1, 1, 1); PG8_STAGE(PG8_SB(1, 0), b3, voffB);
            PG8_BAR; PG8_WAIT_L(0); PG8_MMA(0, 1, At, B1); PG8_BAR;
            PG8_LDA(At, 1, 1); PG8_STAGE(PG8_SA(1, 0), a3, voffA);
            PG8_BAR; PG8_WAIT_L(0); PG8_MMA(1, 0, At, B0); PG8_BAR; PG8_SCHED;
            PG8_STAGE(PG8_SB(1, 1), b3 + hstep, voffB);
            PG8_WAIT_V(6); PG8_BAR; PG8_MMA(1, 1, At, B1); PG8_BAR;
            }
        }
        if constexpr (ALIGN_EPI) { if (wr == 0) PG8_BAR; }
        if constexpr (!Epi::AFTER_DRAIN) { E(acc, cur, wr, wc, fr, fq); S.done(cur); }
        if (!has_next) break;
#pragma unroll
        for (int a = 0; a < 2; ++a)
#pragma unroll
            for (int b = 0; b < 2; ++b)
#pragma unroll
                for (int m = 0; m < 4; ++m)
#pragma unroll
                    for (int n = 0; n < 2; ++n) acc[a][b][m][n] = (f32x4){0.f, 0.f, 0.f, 0.f};
        cur = nxt; cA = nA; cB = nB; ++ui;
        if constexpr (ALIGN_EPI) { if (wr == 1) PG8_BAR; }
    }
    PG8_WAIT_V(0);
    if constexpr (!ALIGN_EPI) { if (wr == 0) PG8_BAR; }
    PG8_BAR;
    if constexpr (Epi::AFTER_DRAIN) { E.fused(acc, cur, wr, wc, fr, fq, lds, wid, lane); S.done(cur); }
#undef PG8_SA
#undef PG8_SB
#undef PG8_STAGE
#undef PG8_LDA
#undef PG8_LDB
#undef PG8_MMA
#undef PG8_WAIT_V
#undef PG8_WAIT_L
#undef PG8_BAR
#undef PG8_SCHED
}
}

struct EpiInProj {
    static constexpr bool PERM = true, AFTER_DRAIN = false;
    const float* rstd1; const float* qn; const float* kn; bf16_t *qh, *kh, *vh, *xrg, *gg;
    __device__ __forceinline__ void operator()(const pg8::f32x4 (&acc)[2][2][4][2], const pg8::Unit& u, int wr, int wc, int fr, int fq) const {
        const int region = u.pn >> 1;
        const int head = (u.pn & 1) * 4 + wc;
        pg8::f32x4 gn[2][2];
        if (region <= 1) {
            const float* g = region == 0 ? qn : kn; const float sc = region == 0 ? QSCALE : 1.0f;
#pragma unroll
            for (int bj = 0; bj < 2; ++bj)
#pragma unroll
                for (int n = 0; n < 2; ++n) gn[bj][n] = *(const pg8::f32x4*)(g + 32 * bj + 8 * fq + 4 * n) * sc;
        }
#pragma unroll
        for (int ai = 0; ai < 2; ++ai)
#pragma unroll
            for (int m = 0; m < 4; ++m) {
                const int row = u.pm * 256 + ai * 128 + wr * 64 + m * 16 + fr;
                const float rs = rstd1[row];
                pg8::f32x4 v[2][2];
#pragma unroll
                for (int bj = 0; bj < 2; ++bj)
#pragma unroll
                    for (int n = 0; n < 2; ++n) v[bj][n] = acc[ai][bj][m][n] * rs;
                bf16_t* dst;
                if (region <= 1) {
                    float ss = 0.f;
#pragma unroll
                    for (int bj = 0; bj < 2; ++bj)
#pragma unroll
                        for (int n = 0; n < 2; ++n) ss += (v[bj][n][0] * v[bj][n][0] + v[bj][n][1] * v[bj][n][1]) + (v[bj][n][2] * v[bj][n][2] + v[bj][n][3] * v[bj][n][3]);
                    ss += __shfl_xor(ss, 16); ss += __shfl_xor(ss, 32);
                    const float rn = rsqrtf(ss * (1.0f / HD) + EPS);
#pragma unroll
                    for (int bj = 0; bj < 2; ++bj)
#pragma unroll
                        for (int n = 0; n < 2; ++n) v[bj][n] = v[bj][n] * rn * gn[bj][n];
                    dst = (region == 0 ? qh : kh) + ((size_t)head * S + row) * HD;
                } else if (region == 2) {
                    dst = vh + ((size_t)head * S + row) * HD;
                } else if (region == 3) {
                    dst = xrg + (size_t)row * DRG + head * 64;
                } else {
#pragma unroll
                    for (int bj = 0; bj < 2; ++bj)
#pragma unroll
                        for (int n = 0; n < 2; ++n)
#pragma unroll
                            for (int i = 0; i < 4; ++i) v[bj][n][i] = gelu_tanh(v[bj][n][i]);
                    dst = gg + (size_t)row * DRG + head * 64;
                }
#pragma unroll
                for (int bj = 0; bj < 2; ++bj) {
                    pg8::u32x4 w; w.x = pg8::cvt_pk_bf16(v[bj][0][0], v[bj][0][1]); w.y = pg8::cvt_pk_bf16(v[bj][0][2], v[bj][0][3]);
                    w.z = pg8::cvt_pk_bf16(v[bj][1][0], v[bj][1][1]); w.w = pg8::cvt_pk_bf16(v[bj][1][2], v[bj][1][3]);
                    *(pg8::u32x4*)(dst + 32 * bj + 8 * fq) = w;
                }
            }
    }
};
struct EpiOutProj {
    static constexpr bool PERM = true, AFTER_DRAIN = false;
    const float* x; float* out; bf16_t* x1b; float* ssq;
    __device__ __forceinline__ void operator()(const pg8::f32x4 (&acc)[2][2][4][2], const pg8::Unit& u, int wr, int wc, int fr, int fq) const {
#pragma unroll
        for (int ai = 0; ai < 2; ++ai)
#pragma unroll
            for (int m = 0; m < 4; ++m) {
                const int row = u.pm * 256 + ai * 128 + wr * 64 + m * 16 + fr;
                float ss = 0.f;
#pragma unroll
                for (int bj = 0; bj < 2; ++bj) {
                    const size_t o = (size_t)row * D + u.pn * 256 + bj * 128 + wc * 32 + 8 * fq;
                    const pg8::f32x4 a = *(const pg8::f32x4*)(x + o) + acc[ai][bj][m][0], b = *(const pg8::f32x4*)(x + o + 4) + acc[ai][bj][m][1];
                    *(pg8::f32x4*)(out + o) = a; *(pg8::f32x4*)(out + o + 4) = b;
                    ss += (a[0] * a[0] + a[1] * a[1]) + (a[2] * a[2] + a[3] * a[3]) + (b[0] * b[0] + b[1] * b[1]) + (b[2] * b[2] + b[3] * b[3]);
                    pg8::u32x4 w; w.x = pg8::cvt_pk_bf16(a[0], a[1]); w.y = pg8::cvt_pk_bf16(a[2], a[3]); w.z = pg8::cvt_pk_bf16(b[0], b[1]); w.w = pg8::cvt_pk_bf16(b[2], b[3]);
                    *(pg8::u32x4*)(x1b + o) = w;
                }
                ss += __shfl_xor(ss, 16); ss += __shfl_xor(ss, 32);
                if (fq == 0) ssq[(size_t)row * 16 + u.pn * 4 + wc] = ss;
            }
    }
};
struct EpiPeerQ {
    static constexpr bool PERM = true, AFTER_DRAIN = false;
    bf16_t* qp;
    __device__ __forceinline__ void operator()(const pg8::f32x4 (&acc)[2][2][4][2], const pg8::Unit& u, int wr, int wc, int fr, int fq) const {
#pragma unroll
        for (int ai = 0; ai < 2; ++ai)
#pragma unroll
            for (int m = 0; m < 4; ++m) {
                const int row = u.pm * 256 + ai * 128 + wr * 64 + m * 16 + fr;
#pragma unroll
                for (int bj = 0; bj < 2; ++bj) {
                    const pg8::f32x4 a = acc[ai][bj][m][0], b = acc[ai][bj][m][1];
                    pg8::u32x4 w; w.x = pg8::cvt_pk_bf16(a[0], a[1]); w.y = pg8::cvt_pk_bf16(a[2], a[3]); w.z = pg8::cvt_pk_bf16(b[0], b[1]); w.w = pg8::cvt_pk_bf16(b[2], b[3]);
                    *(pg8::u32x4*)(qp + (size_t)row * NQ + u.pn * 256 + bj * 128 + wc * 32 + 8 * fq) = w;
                }
            }
    }
};

__device__ __forceinline__ void ph_attn(const Params& p) {
    unsigned char* ws = p.ws;
    const bf16_t* qh = (const bf16_t*)(ws + WS_QH); const bf16_t* kh = (const bf16_t*)(ws + WS_KH); const bf16_t* vh = (const bf16_t*)(ws + WS_VH);
    bf16_t* osb = (bf16_t*)(ws + WS_OSB);
    const int gtid = blockIdx.x * blockDim.x + threadIdx.x, gsize = gridDim.x * blockDim.x;
    for (int u = gtid; u < NH * S; u += gsize) {
        const int h = u / S, t = u % S;
        float q[HD], o[HD];
        {
            const bf16x8* qp = (const bf16x8*)(qh + ((size_t)h * S + t) * HD);
#pragma unroll
            for (int c = 0; c < 8; ++c) { const bf16x8 v = qp[c];
#pragma unroll
                for (int j = 0; j < 8; ++j) { q[8 * c + j] = bf2f((unsigned short)v[j]); o[8 * c + j] = 0.f; } }
        }
        float carry = 0.f;
        for (int s = t - 1; s >= 0; --s) {
            const bf16x8* kp = (const bf16x8*)(kh + ((size_t)h * S + s) * HD);
            float z = 0.f;
#pragma unroll
            for (int c = 0; c < 8; ++c) { const bf16x8 v = kp[c];
#pragma unroll
                for (int j = 0; j < 8; ++j) z += q[8 * c + j] * bf2f((unsigned short)v[j]); }
            const float sp2 = fmaxf(z, 0.f) + __builtin_amdgcn_logf(1.0f + __builtin_amdgcn_exp2f(-fabsf(z)));
            const float w = __builtin_amdgcn_exp2f(z - sp2 + carry);
            const bf16x8* vp = (const bf16x8*)(vh + ((size_t)h * S + s) * HD);
#pragma unroll
            for (int c = 0; c < 8; ++c) { const bf16x8 v = vp[c];
#pragma unroll
                for (int j = 0; j < 8; ++j) o[8 * c + j] += w * bf2f((unsigned short)v[j]); }
            carry -= sp2;
            if (carry < CARRY_STOP) break;
        }
        u32x4* op = (u32x4*)(osb + (size_t)t * DSB + h * HD);
#pragma unroll
        for (int c = 0; c < 8; ++c) { u32x4 w; w.x = pk2(o[8 * c], o[8 * c + 1]); w.y = pk2(o[8 * c + 2], o[8 * c + 3]); w.z = pk2(o[8 * c + 4], o[8 * c + 5]); w.w = pk2(o[8 * c + 6], o[8 * c + 7]); op[c] = w; }
    }
}

template <int PASS>
__device__ __forceinline__ void ph_rg(const Params& p, float* org, float* lds) {
    float (*xc)[65] = (float (*)[65])lds;
    float (*as_)[64] = (float (*)[64])(lds + CHUNK * 65);
    float (*bs_)[64] = (float (*)[64])(lds + CHUNK * 65 + CHUNK * 64);
    unsigned char* ws = p.ws;
    const bf16_t* xrg = (const bf16_t*)(ws + WS_XRG); const bf16_t* gg = (const bf16_t*)(ws + WS_GG);
    float* rgP = (float*)(ws + WS_RGP); float* rgH = (float*)(ws + WS_RGH);
    const float* cw = p.in[I_CONV_W]; const float* cb = p.in[I_CONV_B];
    const float* wa = p.in[I_RG_W_A]; const float* ba = p.in[I_RG_B_A]; const float* wx = p.in[I_RG_W_X]; const float* bx = p.in[I_RG_B_X];
    const float* lam = p.in[I_RG_LAMBDA];
    const int tid = threadIdx.x;
    for (int u = blockIdx.x; u < NCHUNK * 8; u += gridDim.x) {
        const int ch = u / 8, n = u % 8, t0 = ch * CHUNK, c0 = n * 64;
        __syncthreads();
        for (int e = tid; e < CHUNK * 64; e += NTHR) {
            const int t = e / 64, cc = e % 64, c = c0 + cc, tok = t0 + t;
            float a = cb[c];
#pragma unroll
            for (int k = 0; k < 4; ++k) { const int tt = tok + k - 3; if (tt >= 0) a += cw[k * DRG + c] * bf2f(xrg[(size_t)tt * DRG + c]); }
            xc[t][cc] = a;
        }
        __syncthreads();
        {
            const int j = tid & 63, tq = tid >> 6;
            const int c = c0 + j;
            const float sp = log1pf(__expf(-lam[c]));
            const float bav = ba[c], bxv = bx[c];
            for (int t = tq; t < CHUNK; t += NTHR / 64) {
                float ra = bav, ri = bxv;
                for (int i = 0; i < 64; ++i) { const float xv = xc[t][i]; ra += xv * wa[((size_t)n * 64 + i) * 64 + j]; ri += xv * wx[((size_t)n * 64 + i) * 64 + j]; }
                const float r = sigmoidf_(ra), ig = sigmoidf_(ri);
                const float log_a = -8.0f * r * sp;
                const float a = __expf(log_a);
                const float b = sqrtf(-expm1f(2.0f * log_a)) * (ig * xc[t][j]);
                as_[t][j] = a; bs_[t][j] = b;
            }
        }
        __syncthreads();
        if (tid < 64) {
            const int c = c0 + tid;
            float h = 0.f, P = 1.f;
            if (PASS == 1) { for (int k = 0; k < ch; ++k) h = rgP[k * DRG + c] * h + rgH[k * DRG + c]; }
            for (int t = 0; t < CHUNK; ++t) {
                const float a = as_[t][tid];
                h = a * h + bs_[t][tid]; P *= a;
                if (PASS == 1) org[(size_t)(t0 + t) * DRG + c] = h * bf2f(gg[(size_t)(t0 + t) * DRG + c]);
            }
            if (PASS == 0) { rgP[ch * DRG + c] = P; rgH[ch * DRG + c] = h; }
        }
    }
}

__device__ __forceinline__ void ph_mix(const Params& p, const float* org) {
    unsigned char* ws = p.ws;
    const bf16_t* osb = (const bf16_t*)(ws + WS_OSB); bf16_t* mix = (bf16_t*)(ws + WS_MIX);
    const int lane = threadIdx.x & 63, gwave = (blockIdx.x * blockDim.x + threadIdx.x) >> 6, nwave = (gridDim.x * blockDim.x) >> 6;
    for (int t = gwave; t < S; t += nwave) {
        const u32x4 a = *((const u32x4*)(osb + (size_t)t * DSB) + lane);
        float av[8] = {bf2f(a.x & 0xffff), bf2f(a.x >> 16), bf2f(a.y & 0xffff), bf2f(a.y >> 16), bf2f(a.z & 0xffff), bf2f(a.z >> 16), bf2f(a.w & 0xffff), bf2f(a.w >> 16)};
        const f32x4 b0 = *((const f32x4*)(org + (size_t)t * DRG) + 2 * lane), b1 = *((const f32x4*)(org + (size_t)t * DRG) + 2 * lane + 1);
        float ssa = 0.f, ssb = 0.f;
#pragma unroll
        for (int j = 0; j < 8; ++j) ssa += av[j] * av[j];
        ssb = b0.x * b0.x + b0.y * b0.y + b0.z * b0.z + b0.w * b0.w + b1.x * b1.x + b1.y * b1.y + b1.z * b1.z + b1.w * b1.w;
        ssa = wave_sum(ssa); ssb = wave_sum(ssb);
        const float ra = rsqrtf(ssa * (1.0f / DSB) + EPS), rb = rsqrtf(ssb * (1.0f / DRG) + EPS);
        u32x4 o; o.x = pk2(av[0] * ra, av[1] * ra); o.y = pk2(av[2] * ra, av[3] * ra); o.z = pk2(av[4] * ra, av[5] * ra); o.w = pk2(av[6] * ra, av[7] * ra);
        *((u32x4*)(mix + (size_t)t * D) + lane) = o;
        u32x4 o2; o2.x = pk2(b0.x * rb, b0.y * rb); o2.y = pk2(b0.z * rb, b0.w * rb); o2.z = pk2(b1.x * rb, b1.y * rb); o2.w = pk2(b1.z * rb, b1.w * rb);
        *((u32x4*)(mix + (size_t)t * D + DSB) + lane) = o2;
    }
}

__device__ __forceinline__ int f2key(float f) { const int b = __builtin_bit_cast(int, f); return b ^ ((b >> 31) & 0x7fffffff); }
__device__ __forceinline__ float key2f(int k) { return __builtin_bit_cast(float, k ^ ((k >> 31) & 0x7fffffff)); }
__device__ __forceinline__ void topk_insert(int (&lst)[16], int x) {
#pragma unroll
    for (int i = 0; i < 16; ++i) { const int hi = max(lst[i], x); x = min(lst[i], x); lst[i] = hi; }
}
typedef float f32x16 __attribute__((ext_vector_type(16)));
#define TOPK_CE(a, b) do { const int hi_ = max(a, b), lo_ = min(a, b); a = hi_; b = lo_; } while (0)
__device__ __forceinline__ void ph_topk(const Params& p, int* lds) {
    unsigned char* ws = p.ws;
    const bf16_t* qp = (const bf16_t*)(ws + WS_B); const bf16_t* subk = (const bf16_t*)(ws + WS_SUBK);
    int* seli = (int*)(ws + WS_SELI); float* selg = (float*)(ws + WS_SELG);
    const float* ssq = (const float*)(ws + WS_SSQ); float* rstd2 = (float*)(ws + WS_RSTD2);
    const int tid = threadIdx.x, lane = tid & 63, r = lane & 31, hh = lane >> 5, hx = 4 * hh;
    const int gwave = (blockIdx.x * blockDim.x + tid) >> 6, nwave = (gridDim.x * blockDim.x) >> 6;
    for (int u = gwave; u < (S / 32) * PH; u += nwave) {
        const int h = u / (S / 32), t0 = (u % (S / 32)) * 32, t = t0 + r;
        int tk[2][16];
#pragma unroll
        for (int pp = 0; pp < 2; ++pp) {
            f32x16 acc[4];
#pragma unroll
            for (int T = 0; T < 4; ++T)
#pragma unroll
                for (int i = 0; i < 16; ++i) acc[T][i] = 0.f;
            const bf16_t* qrow = qp + (size_t)t * NQ + h * PDK + pp * PHALF + 8 * hh;
            const bf16_t* krow = subk + (((size_t)h * 2 + pp) * PNK + r) * PHALF + 8 * hh;
#pragma unroll
            for (int s = 0; s < 8; ++s) {
                const bf16x8 b = *(const bf16x8*)(qrow + 16 * s);
#pragma unroll
                for (int T = 0; T < 4; ++T) {
                    const bf16x8 a = *(const bf16x8*)(krow + (size_t)(32 * T) * PHALF + 16 * s);
                    acc[T] = __builtin_amdgcn_mfma_f32_32x32x16_bf16(a, b, acc[T], 0, 0, 0);
                }
            }
            int lst[16];
#pragma unroll
            for (int i = 0; i < 16; ++i) lst[i] = (int)0x80000000;
#pragma unroll
            for (int T = 0; T < 4; ++T)
#pragma unroll
                for (int i = 0; i < 16; ++i) {
                    const int nb = 32 * T + (i & 3) + 8 * (i >> 2);
                    topk_insert(lst, ((f2key(acc[T][i]) & ~127) | (127 - nb)) ^ hx);
                }
            int m[16];
#pragma unroll
            for (int i = 0; i < 16; ++i) m[i] = max(lst[i], __shfl_xor(lst[15 - i], 32));
#pragma unroll
            for (int d = 8; d >= 1; d >>= 1)
#pragma unroll
                for (int i = 0; i < 16; ++i) if ((i & d) == 0) TOPK_CE(m[i], m[i + d]);
#pragma unroll
            for (int i = 0; i < 16; ++i) tk[pp][i] = m[i];
        }
#pragma unroll
        for (int i = 0; i < 16; ++i) { lds[i * NTHR + tid] = tk[0][i]; lds[(16 + i) * NTHR + tid] = tk[1][i]; }
        float v0[16], v1[16];
#pragma unroll
        for (int i = 0; i < 16; ++i) { v0[i] = key2f(tk[0][i]); v1[i] = key2f(tk[1][i]); }
        int bk[16];
#pragma unroll
        for (int i = 0; i < 16; ++i) bk[i] = (int)0x80000000;
#pragma unroll
        for (int a = 0; a < 16; ++a)
#pragma unroll
            for (int b = 0; b < 16; ++b)
                if ((a + 1) * (b + 1) <= 16) topk_insert(bk, (f2key(v0[a] + v1[b]) & ~255) | (255 - (a * 16 + b)));
        float ssum = 0.f;
#pragma unroll
        for (int i = 0; i < 4; ++i) { const f32x4 q4 = *(const f32x4*)(ssq + (size_t)t * 16 + 4 * i); ssum += (q4.x + q4.y) + (q4.z + q4.w); }
        const float rs = rsqrtf(ssum * (1.0f / D) + EPS);
        float e[16], sum = 0.f; const float mx = key2f(bk[0]);
#pragma unroll
        for (int i = 0; i < 16; ++i) { e[i] = __expf((key2f(bk[i]) - mx) * rs); sum += e[i]; }
        const float inv = 1.0f / sum;
        int eidx[16];
#pragma unroll
        for (int i = 0; i < 16; ++i) {
            const int code = 255 - (bk[i] & 255), a = code >> 4, b = code & 15;
            const int i1 = 127 - (lds[a * NTHR + tid] & 127), i2 = 127 - (lds[(16 + b) * NTHR + tid] & 127);
            eidx[i] = i1 * PNK + i2; e[i] *= inv;
        }
        if (hh == 0) {
            int4* o = (int4*)(seli + (size_t)t * 128 + h * 16);
#pragma unroll
            for (int i = 0; i < 4; ++i) o[i] = make_int4(eidx[4 * i], eidx[4 * i + 1], eidx[4 * i + 2], eidx[4 * i + 3]);
            if (h == 0) rstd2[t] = rs;
        } else {
            f32x4* o = (f32x4*)(selg + (size_t)t * 128 + h * 16);
#pragma unroll
            for (int i = 0; i < 4; ++i) o[i] = (f32x4){e[4 * i], e[4 * i + 1], e[4 * i + 2], e[4 * i + 3]};
        }
    }
}

__device__ __forceinline__ void unpack8(const u32x4 a, float (&f)[8]) {
    f[0] = bf2f(a.x & 0xffff); f[1] = bf2f(a.x >> 16); f[2] = bf2f(a.y & 0xffff); f[3] = bf2f(a.y >> 16);
    f[4] = bf2f(a.z & 0xffff); f[5] = bf2f(a.z >> 16); f[6] = bf2f(a.w & 0xffff); f[7] = bf2f(a.w >> 16);
}
typedef __bf16 bf16x2_t __attribute__((ext_vector_type(2)));
__device__ __forceinline__ float dot2_bf16(unsigned a, unsigned b, float c) { return __builtin_amdgcn_fdot2_f32_bf16(__builtin_bit_cast(bf16x2_t, a), __builtin_bit_cast(bf16x2_t, b), c, false); }
__device__ __forceinline__ float dot8_bf16(const u32x4 a, const u32x4 b, float c) {
    c = dot2_bf16(a.x, b.x, c); c = dot2_bf16(a.y, b.y, c); c = dot2_bf16(a.z, b.z, c); c = dot2_bf16(a.w, b.w, c);
    return c;
}
__device__ __forceinline__ void axpy8_bf16(float (&acc)[16], int o, const u32x4 w, float c) {
    acc[o + 0] += c * __builtin_bit_cast(float, w.x << 16); acc[o + 1] += c * __builtin_bit_cast(float, w.x & 0xffff0000u);
    acc[o + 2] += c * __builtin_bit_cast(float, w.y << 16); acc[o + 3] += c * __builtin_bit_cast(float, w.y & 0xffff0000u);
    acc[o + 4] += c * __builtin_bit_cast(float, w.z << 16); acc[o + 5] += c * __builtin_bit_cast(float, w.z & 0xffff0000u);
    acc[o + 6] += c * __builtin_bit_cast(float, w.w << 16); acc[o + 7] += c * __builtin_bit_cast(float, w.w & 0xffff0000u);
}
__device__ __forceinline__ float transpose_reduce64(float (&v)[64], int lane) {
#pragma unroll
    for (int s = 0; s < 6; ++s) {
        const bool up = (lane >> s) & 1;
#pragma unroll
        for (int i = 0; i < (32 >> s); ++i) {
            const float a = v[2 * i], b = v[2 * i + 1];
            const float keep = up ? b : a, send = up ? a : b;
            v[i] = keep + __shfl_xor(send, 1 << s);
        }
    }
    return v[0];
}
typedef float f32x2 __attribute__((ext_vector_type(2)));
__device__ __forceinline__ float dot16_fp8(const u32x4 w, const float (&x)[16], float c) {
    f32x2 q;
    q = __builtin_amdgcn_cvt_pk_f32_fp8((int)w.x, false); c += x[0] * q[0]; c += x[1] * q[1];   q = __builtin_amdgcn_cvt_pk_f32_fp8((int)w.x, true); c += x[2] * q[0]; c += x[3] * q[1];
    q = __builtin_amdgcn_cvt_pk_f32_fp8((int)w.y, false); c += x[4] * q[0]; c += x[5] * q[1];   q = __builtin_amdgcn_cvt_pk_f32_fp8((int)w.y, true); c += x[6] * q[0]; c += x[7] * q[1];
    q = __builtin_amdgcn_cvt_pk_f32_fp8((int)w.z, false); c += x[8] * q[0]; c += x[9] * q[1];   q = __builtin_amdgcn_cvt_pk_f32_fp8((int)w.z, true); c += x[10] * q[0]; c += x[11] * q[1];
    q = __builtin_amdgcn_cvt_pk_f32_fp8((int)w.w, false); c += x[12] * q[0]; c += x[13] * q[1]; q = __builtin_amdgcn_cvt_pk_f32_fp8((int)w.w, true); c += x[14] * q[0]; c += x[15] * q[1];
    return c;
}
__device__ __forceinline__ void axpy16_fp8(float (&acc)[16], const u32x4 w, float c) {
    f32x2 q;
    q = __builtin_amdgcn_cvt_pk_f32_fp8((int)w.x, false); acc[0] += c * q[0]; acc[1] += c * q[1];   q = __builtin_amdgcn_cvt_pk_f32_fp8((int)w.x, true); acc[2] += c * q[0]; acc[3] += c * q[1];
    q = __builtin_amdgcn_cvt_pk_f32_fp8((int)w.y, false); acc[4] += c * q[0]; acc[5] += c * q[1];   q = __builtin_amdgcn_cvt_pk_f32_fp8((int)w.y, true); acc[6] += c * q[0]; acc[7] += c * q[1];
    q = __builtin_amdgcn_cvt_pk_f32_fp8((int)w.z, false); acc[8] += c * q[0]; acc[9] += c * q[1];   q = __builtin_amdgcn_cvt_pk_f32_fp8((int)w.z, true); acc[10] += c * q[0]; acc[11] += c * q[1];
    q = __builtin_amdgcn_cvt_pk_f32_fp8((int)w.w, false); acc[12] += c * q[0]; acc[13] += c * q[1]; q = __builtin_amdgcn_cvt_pk_f32_fp8((int)w.w, true); acc[14] += c * q[0]; acc[15] += c * q[1];
}
__device__ __forceinline__ void ph_gather(const Params& p) {
    unsigned char* ws = p.ws;
    const unsigned char* ub = ws + WS_UB; const unsigned char* vb = ws + WS_VB; const float* usc = (const float*)(ws + WS_USC); const float* vsc = (const float*)(ws + WS_VSC);
    const int* seli = (const int*)(ws + WS_SELI); const float* selg = (const float*)(ws + WS_SELG); const float* rstd2 = (const float*)(ws + WS_RSTD2);
    float* out = p.out;
    const int lane = threadIdx.x & 63, gwave = (blockIdx.x * blockDim.x + threadIdx.x) >> 6, nwave = (gridDim.x * blockDim.x) >> 6;
    for (int t = gwave; t < S; t += nwave) {
        float xv[16];
        f32x4* orow = (f32x4*)(out + (size_t)t * D + 16 * lane);
#pragma unroll
        for (int j = 0; j < 4; ++j) { const f32x4 v = orow[j]; xv[4 * j] = v.x; xv[4 * j + 1] = v.y; xv[4 * j + 2] = v.z; xv[4 * j + 3] = v.w; }
        int ei[2]; float cf[2];
        ei[0] = seli[(size_t)t * 128 + lane]; ei[1] = seli[(size_t)t * 128 + 64 + lane];
        const float g0 = selg[(size_t)t * 128 + lane], g1 = selg[(size_t)t * 128 + 64 + lane];
        const float rs = rstd2[t];
#pragma unroll
        for (int r = 0; r < 2; ++r) {
            const float us = usc[ei[r]], vs = vsc[ei[r]];
            float part[64];
#pragma unroll
            for (int jb = 0; jb < 8; ++jb) {
                u32x4 ua[8];
#pragma unroll
                for (int k = 0; k < 8; ++k) { const int e = __builtin_amdgcn_readlane(ei[r], 8 * jb + k); ua[k] = *((const u32x4*)(ub + (size_t)e * D) + lane); }
#pragma unroll
                for (int k = 0; k < 8; ++k) part[8 * jb + k] = dot16_fp8(ua[k], xv, 0.f);
            }
            const float d = transpose_reduce64(part, lane);
            cf[r] = (r == 0 ? g0 : g1) * gelu_tanh(d * us * rs) * vs;
        }
        float acc[16];
#pragma unroll
        for (int j = 0; j < 16; ++j) acc[j] = 0.f;
#pragma unroll
        for (int r = 0; r < 2; ++r)
#pragma unroll
            for (int jb = 0; jb < 8; ++jb) {
                u32x4 va[8];
#pragma unroll
                for (int k = 0; k < 8; ++k) { const int e = __builtin_amdgcn_readlane(ei[r], 8 * jb + k); va[k] = *((const u32x4*)(vb + (size_t)e * D) + lane); }
#pragma unroll
                for (int k = 0; k < 8; ++k) {
                    const float c = __builtin_bit_cast(float, __builtin_amdgcn_readlane(__builtin_bit_cast(int, cf[r]), 8 * jb + k));
                    axpy16_fp8(acc, va[k], c);
                }
            }
#pragma unroll
        for (int j = 0; j < 4; ++j) orow[j] = (f32x4){xv[4 * j] + acc[4 * j], xv[4 * j + 1] + acc[4 * j + 1], xv[4 * j + 2] + acc[4 * j + 2], xv[4 * j + 3] + acc[4 * j + 3]};
    }
}

#define LAS __attribute__((address_space(3)))
#define XB_TMO      128
#define XB_XCNT(j)  (256  + 64 * (j))
#define XB_XSUB(j)  (1280 + 64 * (j))
#define XB_XGEN(j)  (2304 + 64 * (j))
#define XB_TOP      3328
#define XB_TOPGEN   3392
#define XCD_BAR_WORDS 3456
#define XB_SPIN_CAP (1u << 18)
__device__ __forceinline__ unsigned xb_ld(unsigned* p)              { return __hip_atomic_load(p, __ATOMIC_RELAXED, __HIP_MEMORY_SCOPE_AGENT); }
__device__ __forceinline__ unsigned xb_add(unsigned* p, unsigned v) { return __hip_atomic_fetch_add(p, v, __ATOMIC_RELAXED, __HIP_MEMORY_SCOPE_AGENT); }
__device__ __forceinline__ unsigned xb_xcc_id() { return (unsigned)__builtin_amdgcn_s_getreg((3 << 11) | 20) & 0xFu; }
#define XB_SPIN(cond, bar) do { unsigned _sp = 0; while (cond) { __builtin_amdgcn_s_sleep(1); \
    if ((++_sp & 255u) == 0u) { if (xb_ld(&(bar)[XB_TMO])) break; if (_sp > XB_SPIN_CAP) { atomicAdd(&(bar)[XB_TMO], 1u); break; } } } } while (0)
struct XcdBarrier { unsigned* bar; unsigned x; volatile LAS unsigned* st; };
__device__ __forceinline__ XcdBarrier xcd_barrier_post(unsigned* bar, volatile LAS unsigned* st) {
    XcdBarrier b; b.bar = bar; b.x = xb_xcc_id(); b.st = st;
    if (threadIdx.x == 0) (void)xb_add(&bar[XB_XCNT(b.x)], 1u);
    return b;
}
__device__ __forceinline__ void xcd_barrier_complete(unsigned* bar, unsigned x, unsigned& nloc, unsigned& nx) {
    const unsigned G = gridDim.x * gridDim.y * gridDim.z;
    unsigned sum, cnt, mine, sp = 0u;
    for (;;) {
        sum = 0u; cnt = 0u; mine = 0u;
#pragma unroll
        for (unsigned j = 0; j < 16; ++j) { const unsigned c = xb_ld(&bar[XB_XCNT(j)]); sum += c; cnt += (c > 0u) ? 1u : 0u; mine = (j == x) ? c : mine; }
        if (sum == G) break;
        __builtin_amdgcn_s_sleep(1);
        if ((++sp & 255u) == 0u) { if (xb_ld(&bar[XB_TMO])) break; if (sp > XB_SPIN_CAP) { atomicAdd(&bar[XB_TMO], 1u); break; } }
    }
    nloc = mine > 0u ? mine : 1u; nx = cnt > 0u ? cnt : 1u;
}
__device__ __forceinline__ void xcd_barrier(const XcdBarrier& b) {
    asm volatile("s_waitcnt vmcnt(0)" ::: "memory");
    __syncthreads();
    if (threadIdx.x == 0) {
        unsigned* bar = b.bar;
        __builtin_amdgcn_s_waitcnt(0);
        unsigned nloc = b.st[0], nx = b.st[1];
        if (nloc == 0u) { xcd_barrier_complete(bar, b.x, nloc, nx); b.st[0] = nloc; b.st[1] = nx; }
        const unsigned old = xb_add(&bar[XB_XSUB(b.x)], 1u);
        const unsigned gen = old / nloc;
        if (old + 1u == (gen + 1u) * nloc) {
            __builtin_amdgcn_fence(__ATOMIC_RELEASE, "agent");
            asm volatile("s_waitcnt vmcnt(0)" ::: "memory");
            const unsigned og = xb_add(&bar[XB_TOP], 1u);
            const unsigned tg = og / nx;
            if (og + 1u == (tg + 1u) * nx) xb_add(&bar[XB_TOPGEN], 1u);
            else XB_SPIN(xb_ld(&bar[XB_TOPGEN]) == tg, bar);
            __builtin_amdgcn_fence(__ATOMIC_ACQUIRE, "agent");
            xb_add(&bar[XB_XGEN(b.x)], 1u);
            asm volatile("s_waitcnt vmcnt(0)" ::: "memory");
        } else {
            XB_SPIN(xb_ld(&bar[XB_XGEN(b.x)]) == gen, bar);
            __builtin_amdgcn_fence(__ATOMIC_ACQUIRE, "agent");
            asm volatile("s_waitcnt vmcnt(0)" ::: "memory");
        }
    }
    __syncthreads();
}

constexpr int LDS_MISC = 131072;
constexpr int LDS_BYTES = LDS_MISC + 1024;

__global__ void __launch_bounds__(NTHR, 2) hymba_fwd(Params p) {
    extern __shared__ __attribute__((aligned(16))) unsigned char lds[];
    volatile LAS unsigned* misc = (volatile LAS unsigned*)((LAS unsigned char*)lds + LDS_MISC);
    if (threadIdx.x < 4) misc[threadIdx.x] = 0u;
    __syncthreads();
    XcdBarrier bar = xcd_barrier_post((unsigned*)(p.ws + WS_CTL), misc);
    float* org = p.out;

    PG8_LAS unsigned char* ring = (PG8_LAS unsigned char*)lds;
    unsigned char* ws = p.ws;
    ph_prep(p);                               xcd_barrier(bar);
    {
        pg8::Gemm g{(const bf16_t*)(ws + WS_A), (const bf16_t*)(ws + WS_WINT), S, NPROJ, D}; pg8::StaticOrder so; so.init(S, NPROJ, (int)gridDim.x, (int)blockIdx.x);
        EpiInProj E{(const float*)(ws + WS_RSTD1), p.in[I_Q_NORM], p.in[I_K_NORM], (bf16_t*)(ws + WS_QH), (bf16_t*)(ws + WS_KH), (bf16_t*)(ws + WS_VH), (bf16_t*)(ws + WS_XRG), (bf16_t*)(ws + WS_GG)};
        pg8::gemm_phase<EpiInProj, pg8::StaticOrder, true, true>(ring, g, so, E);
    }
    xcd_barrier(bar);
    ph_attn(p); ph_rg<0>(p, org, (float*)lds); xcd_barrier(bar);
    ph_rg<1>(p, org, (float*)lds);            xcd_barrier(bar);
    ph_mix(p, org);                           xcd_barrier(bar);
    {
        pg8::Gemm g{(const bf16_t*)(ws + WS_MIX), (const bf16_t*)(ws + WS_WOUTT), S, D, D}; pg8::StaticOrder so; so.init(S, D, (int)gridDim.x, (int)blockIdx.x);
        EpiOutProj E{p.in[I_X], p.out, (bf16_t*)(ws + WS_A), (float*)(ws + WS_SSQ)};
        pg8::gemm_phase<EpiOutProj, pg8::StaticOrder, true, true>(ring, g, so, E);
    }
    xcd_barrier(bar);
    {
        pg8::Gemm g{(const bf16_t*)(ws + WS_A), (const bf16_t*)(ws + WS_WQT), S, NQ, D}; pg8::StaticOrder so; so.init(S, NQ, (int)gridDim.x, (int)blockIdx.x);
        EpiPeerQ E{(bf16_t*)(ws + WS_B)};
        pg8::gemm_phase<EpiPeerQ, pg8::StaticOrder, true, true>(ring, g, so, E);
    }
    xcd_barrier(bar);
    ph_topk(p, (int*)lds);                    xcd_barrier(bar);
    ph_gather(p);
}

extern "C" void kernel_launch(void* const* d_in, const int* in_sizes, int n_in, void* d_out, int out_size, void* d_ws, size_t ws_size, hipStream_t stream) {
    static int grid = 0;
    if (grid == 0) {
        if (n_in != 20 || out_size != S * D || ws_size < WS_END) { fprintf(stderr, "kernel_launch: unexpected shapes (n_in %d out %d ws %zu)\n", n_in, out_size, ws_size); grid = -1; return; }
        int dev = 0, cus = 0, per_cu = 0;
        if (hipGetDevice(&dev) != hipSuccess || hipDeviceGetAttribute(&cus, hipDeviceAttributeMultiprocessorCount, dev) != hipSuccess) { grid = -1; return; }
        if (hipFuncSetAttribute((const void*)hymba_fwd, hipFuncAttributeMaxDynamicSharedMemorySize, LDS_BYTES) != hipSuccess) { fprintf(stderr, "kernel_launch: hipFuncSetAttribute failed\n"); grid = -1; return; }
        if (hipOccupancyMaxActiveBlocksPerMultiprocessor(&per_cu, (const void*)hymba_fwd, NTHR, LDS_BYTES) != hipSuccess || per_cu < 1) { fprintf(stderr, "kernel_launch: occupancy query says %d blocks per CU\n", per_cu); grid = -1; return; }
        (void)hipGetLastError();
        grid = cus;
    }
    if (grid < 0) return;
    (void)hipMemsetAsync((char*)d_ws + WS_CTL, 0, XCD_BAR_WORDS * 4, stream);
    Params p{};
    for (int i = 0; i < 20; ++i) p.in[i] = (const float*)d_in[i];
    p.out = (float*)d_out; p.ws = (unsigned char*)d_ws;
    hipLaunchKernelGGL(hymba_fwd, dim3(grid), dim3(NTHR), LDS_BYTES, stream, p);
}
```

```cpp
#include <hip/hip_runtime.h>
#include <cstdint>
#include <cstdio>

typedef unsigned short bf16_t;
typedef short bf16x8 __attribute__((ext_vector_type(8)));
typedef float f32x4 __attribute__((ext_vector_type(4)));
typedef unsigned u32x4 __attribute__((ext_vector_type(4)));
typedef float f32x16 __attribute__((ext_vector_type(16)));

constexpr int S = 16384, D = 1024, NPROJ = 2560, DSB = 512, DRG = 512, NH = 8, HD = 64;
constexpr int PH = 8, PNK = 128, PDK = 256, PHALF = 128, PTOPK = 16, NEXP = 16384, NQ = PH * PDK;
constexpr int CHUNK = 64, NCHUNK = S / CHUNK;
constexpr float EPS = 1e-6f;
constexpr float LOG2E = 1.4426950408889634f;
constexpr float QSCALE = 0.125f * LOG2E;
constexpr int NTHR = 512;
constexpr float CARRY_STOP = -160.0f;

constexpr size_t MiB = 1u << 20;
constexpr size_t WS_CTL = 0;
constexpr size_t WS_WINT = 1 * MiB;
constexpr size_t WS_WOUTT = 6 * MiB;
constexpr size_t WS_WQT = 8 * MiB;
constexpr size_t WS_SUBK = 12 * MiB;
constexpr size_t WS_RSTD1 = 12 * MiB + 512 * 1024;
constexpr size_t WS_RSTD2 = WS_RSTD1 + 64 * 1024;
constexpr size_t WS_RGP = WS_RSTD2 + 64 * 1024;
constexpr size_t WS_RGH = WS_RGP + 512 * 1024;
constexpr size_t WS_A = 14 * MiB;
constexpr size_t WS_B = 46 * MiB;
constexpr size_t WS_QH = WS_B, WS_KH = WS_B + 16 * MiB, WS_VH = WS_B + 32 * MiB, WS_XRG = WS_B + 48 * MiB;
constexpr size_t WS_GG = 110 * MiB;
constexpr size_t WS_OSB = 126 * MiB;
constexpr size_t WS_MIX = 142 * MiB;
constexpr size_t WS_SELI = WS_MIX, WS_SELG = WS_MIX + 8 * MiB;
constexpr size_t WS_UB = 174 * MiB;
constexpr size_t WS_VB = 190 * MiB;
constexpr size_t WS_USC = 206 * MiB;
constexpr size_t WS_VSC = 206 * MiB + 64 * 1024;
constexpr size_t WS_SSQ = 238 * MiB;
constexpr size_t WS_RGW = 239 * MiB;
constexpr size_t WS_END = 240 * MiB;

__device__ __forceinline__ unsigned f2bf(float f) { unsigned u = __builtin_bit_cast(unsigned, f); return (u + 0x7fffu + ((u >> 16) & 1u)) >> 16; }
__device__ __forceinline__ float bf2f(unsigned h) { return __builtin_bit_cast(float, h << 16); }
__device__ __forceinline__ unsigned pk2(float lo, float hi) { return f2bf(lo) | (f2bf(hi) << 16); }
__device__ __forceinline__ float wave_sum(float v) {
#pragma unroll
    for (int o = 1; o < 64; o <<= 1) v += __shfl_xor(v, o);
    return v;
}
__device__ __forceinline__ float gelu_tanh(float x) {
    const float u = 0.7978845608028654f * (x + 0.044715f * x * x * x);
    const float e = __expf(2.0f * u);
    const float th = 1.0f - 2.0f / (e + 1.0f);
    return 0.5f * x * (1.0f + th);
}
__device__ __forceinline__ float sigmoidf_(float x) { return 1.0f / (1.0f + __expf(-x)); }

__host__ __device__ __forceinline__ int inproj_phys_row(int nlog) { const int t = nlog >> 8, L = nlog & 255; return (t << 8) + 128 * ((L & 63) >> 5) + 32 * (L >> 6) + (L & 31); }

__device__ __forceinline__ int phase_tid() { int t = threadIdx.x; asm volatile("" : "+v"(t)); return t; }

struct Params {
    const float* in[20];
    float* out;
    unsigned char* ws;
};
enum { I_X = 0, I_NORM_MIX, I_W_IN, I_Q_NORM, I_K_NORM, I_CONV_W, I_CONV_B, I_RG_W_A, I_RG_B_A, I_RG_W_X, I_RG_B_X, I_RG_LAMBDA,
       I_OUT_NORM_SB, I_OUT_NORM_RG, I_W_OUT, I_NORM_FFN, I_PEER_WQ, I_PEER_SUBK, I_PEER_U, I_PEER_V };

template <bool INPROJ_PERM>
__device__ __forceinline__ void prep_transpose(const float* W, const float* gain0, const float* gain1, int K, int N, bf16_t* WT, int gtid, int gsize) {
    for (long e = gtid; e < (long)K * N; e += gsize) {
        const int k = (int)(e / N), n = (int)(e % N);
        float g = 1.0f;
        if (gain0) g = (gain1 && k >= 512) ? gain1[k - 512] : gain0[k];
        const int nr = INPROJ_PERM ? inproj_phys_row(n) : n;
        WT[(size_t)nr * K + k] = (bf16_t)f2bf(g * W[e]);
    }
}
__device__ __forceinline__ void ph_prep(const Params& p) {
    const int tid_ = phase_tid();
    const int gtid = blockIdx.x * blockDim.x + tid_, gsize = gridDim.x * blockDim.x;
    const int lane = tid_ & 63, gwave = gtid >> 6, nwave = gsize >> 6;
    unsigned char* ws = p.ws;
    prep_transpose<true>(p.in[I_W_IN], p.in[I_NORM_MIX], nullptr, D, NPROJ, (bf16_t*)(ws + WS_WINT), gtid, gsize);
    prep_transpose<false>(p.in[I_W_OUT], p.in[I_OUT_NORM_SB], p.in[I_OUT_NORM_RG], D, D, (bf16_t*)(ws + WS_WOUTT), gtid, gsize);
    prep_transpose<false>(p.in[I_PEER_WQ], p.in[I_NORM_FFN], nullptr, D, NQ, (bf16_t*)(ws + WS_WQT), gtid, gsize);
    {
        const float* wa = p.in[I_RG_W_A]; const float* wx = p.in[I_RG_W_X]; bf16_t* o = (bf16_t*)(ws + WS_RGW);
        for (int e = gtid; e < 8 * 2 * 2 * 4 * 64 * 8; e += gsize) {
            const int el = e & 7, ln = (e >> 3) & 63, s = (e >> 9) & 3, jt = (e >> 11) & 1, g = (e >> 12) & 1, n = e >> 13;
            const int j = 32 * jt + (ln & 31), i = 16 * s + 8 * (el >> 2) + 4 * (ln >> 5) + (el & 3);
            o[e] = (bf16_t)f2bf((g == 0 ? wa : wx)[((size_t)n * 64 + i) * 64 + j]);
        }
    }
    {
        const float* sk = p.in[I_PEER_SUBK]; bf16_t* o = (bf16_t*)(ws + WS_SUBK);
        for (int e = gtid; e < PH * 2 * PNK * PHALF; e += gsize) o[e] = (bf16_t)f2bf(sk[e]);
    }
    {
        const float* u = p.in[I_PEER_U]; const float* v = p.in[I_PEER_V]; const float* g = p.in[I_NORM_FFN];
        unsigned* ub = (unsigned*)(ws + WS_UB); unsigned* vb = (unsigned*)(ws + WS_VB); float* usc = (float*)(ws + WS_USC); float* vsc = (float*)(ws + WS_VSC);
        f32x4 gq[4];
#pragma unroll
        for (int j = 0; j < 4; ++j) gq[j] = *((const f32x4*)g + lane + 64 * j);
        for (int e = gwave; e < NEXP; e += nwave) {
            f32x4 a[4], b[4]; float ma = 0.f, mb = 0.f;
#pragma unroll
            for (int j = 0; j < 4; ++j) {
                a[j] = *((const f32x4*)(u + (size_t)e * D) + lane + 64 * j) * gq[j]; b[j] = *((const f32x4*)(v + (size_t)e * D) + lane + 64 * j);
                ma = fmaxf(ma, fmaxf(fmaxf(fabsf(a[j].x), fabsf(a[j].y)), fmaxf(fabsf(a[j].z), fabsf(a[j].w))));
                mb = fmaxf(mb, fmaxf(fmaxf(fabsf(b[j].x), fabsf(b[j].y)), fmaxf(fabsf(b[j].z), fabsf(b[j].w))));
            }
#pragma unroll
            for (int o = 1; o < 64; o <<= 1) { ma = fmaxf(ma, __shfl_xor(ma, o)); mb = fmaxf(mb, __shfl_xor(mb, o)); }
            const float sa = ma > 0.f ? 256.0f / ma : 1.0f, sb = mb > 0.f ? 256.0f / mb : 1.0f;
#pragma unroll
            for (int j = 0; j < 4; ++j) {
                int w = 0;
                w = __builtin_amdgcn_cvt_pk_fp8_f32(a[j].x * sa, a[j].y * sa, w, false); w = __builtin_amdgcn_cvt_pk_fp8_f32(a[j].z * sa, a[j].w * sa, w, true);
                ub[(size_t)e * (D / 4) + lane + 64 * j] = (unsigned)w;
                w = 0;
                w = __builtin_amdgcn_cvt_pk_fp8_f32(b[j].x * sb, b[j].y * sb, w, false); w = __builtin_amdgcn_cvt_pk_fp8_f32(b[j].z * sb, b[j].w * sb, w, true);
                vb[(size_t)e * (D / 4) + lane + 64 * j] = (unsigned)w;
            }
            if (lane == 0) { usc[e] = ma > 0.f ? ma * (1.0f / 256.0f) : 1.0f; vsc[e] = mb > 0.f ? mb * (1.0f / 256.0f) : 1.0f; }
        }
    }
    {
        const float* x = p.in[I_X]; bf16_t* xb = (bf16_t*)(ws + WS_A); float* rstd1 = (float*)(ws + WS_RSTD1);
        for (int row = gwave; row < S; row += nwave) {
            const f32x4* xr = (const f32x4*)(x + (size_t)row * D) + lane;
            uint2* o = (uint2*)(xb + (size_t)row * D) + lane;
            float ss = 0.f;
#pragma unroll
            for (int j = 0; j < 4; ++j) {
                const f32x4 v = xr[64 * j];
                ss += v.x * v.x + v.y * v.y + v.z * v.z + v.w * v.w;
                o[64 * j] = make_uint2(pk2(v.x, v.y), pk2(v.z, v.w));
            }
            ss = wave_sum(ss);
            if (lane == 0) rstd1[row] = rsqrtf(ss * (1.0f / D) + EPS);
        }
    }
}

namespace pg8 {
#define PG8_LAS __attribute__((address_space(3)))
typedef unsigned short bf16_t;
typedef short bf16x8 __attribute__((ext_vector_type(8)));
typedef float f32x4 __attribute__((ext_vector_type(4)));
typedef unsigned u32x4 __attribute__((ext_vector_type(4)));
constexpr int BM = 256, BK = 64, HALF = 128, HTB = HALF * BK * 2  , STAGE_BYTES = 8 * HTB, NXCD = 8, WGM = 8;

__host__ __device__ __forceinline__ int lds_byte(int r, int c) { const int st = (r >> 4) * 2 + (c >> 5), rr = r & 15, cc = c & 31, ob = rr * 64 + cc * 2; return st * 1024 + (ob ^ (((ob >> 9) & 1) << 5)); }
__host__ __device__ __forceinline__ void stage_rc(int b, int& R, int& C) { const int st = b / 1024, sb = b % 1024, swz = sb ^ (((sb >> 9) & 1) << 5); R = (st >> 1) * 16 + swz / 64; C = (st & 1) * 32 + (swz % 64) / 2; }
__host__ __device__ __forceinline__ int perm32(int rho) { const int n = rho >> 4, i = rho & 15; return 8 * (i >> 2) + 4 * n + (i & 3); }

struct Unit { int pm, pn; };
struct Gemm { const bf16_t* A; const bf16_t* Bt; int M, N, K; };

struct StaticOrder {
    int nM, nN, nwg, G, c;
    __host__ __device__ void init(int M, int N, int G_, int c_) { nM = M / BM; nN = N / BM; nwg = nM * nN; G = G_; c = c_; }
    __host__ __device__ bool next(int i, Unit& u) const {
        const long L = (long)i * G + c; if (L >= nwg) return false;
        int wgid = (int)L; { const int q = nwg / NXCD, r = nwg % NXCD, xcd = wgid % NXCD, off = wgid / NXCD; wgid = (xcd < r ? xcd * (q + 1) : r * (q + 1) + (xcd - r) * q) + off; }
        const int nig = WGM * nN, gid = wgid / nig, fm = gid * WGM, gsz = (nM - fm) < WGM ? (nM - fm) : WGM;
        u.pm = fm + ((wgid % nig) % gsz); u.pn = (wgid % nig) / gsz; return true;
    }
    __device__ __forceinline__ void a_ready(const Unit&) const {}
    __device__ __forceinline__ void done(const Unit&) const {}
};

__device__ __forceinline__ unsigned cvt_pk_bf16(float lo, float hi) { unsigned r; asm volatile("v_cvt_pk_bf16_f32 %0, %1, %2" : "=v"(r) : "v"(lo), "v"(hi)); return r; }
template <class Epi, class Sched, bool ALIGN_EPI = false, bool SP2 = false>
__device__ __forceinline__ void gemm_phase(PG8_LAS unsigned char* lds, const Gemm g, const Sched& S, const Epi& E) {
    const int tid = phase_tid(), wid = __builtin_amdgcn_readfirstlane(tid >> 6), lane = tid & 63, wr = wid >> 2, wc = wid & 3, fr = lane & 15, fq = lane >> 4;
    const int K = g.K, nt = K / BK;
    unsigned voffA[2], voffB[2];
#pragma unroll
    for (int i = 0; i < 2; ++i) { int R, C; stage_rc(tid * 16 + i * 8192, R, C); const int Rb = Epi::PERM ? ((R & ~31) + perm32(R & 31)) : R;
        voffA[i] = (unsigned)(R * K + C) * 2u; voffB[i] = (unsigned)(Rb * K + C) * 2u; }
    const size_t kstep = (size_t)(BK * 2);
    const size_t hstep = (size_t)HALF * K * 2;
    const size_t tstep = 2 * hstep;
    const unsigned ldsw = (unsigned)wid * 1024u;
    const int aoff = lds_byte(wr * 64 + fr, fq * 8), boff = lds_byte(wc * 32 + fr, fq * 8);
#define PG8_SA(b, h) (((b) * 2 + (h)) * HTB)
#define PG8_SB(b, h) ((4 + (b) * 2 + (h)) * HTB)
#define PG8_STAGE(bufoff, gbase, voff) do { _Pragma("unroll") for (int _i = 0; _i < 2; ++_i) \
        __builtin_amdgcn_global_load_lds((const unsigned*)((const char*)(gbase) + (voff)[_i]), (PG8_LAS unsigned*)(lds + (bufoff) + ldsw + _i * 8192), 16, 0, 0); } while (0)
#define PG8_LDA(dst, b, h) do { _Pragma("unroll") for (int m = 0; m < 4; ++m) _Pragma("unroll") for (int k = 0; k < 2; ++k) dst[m][k] = *(const PG8_LAS bf16x8*)(lds + PG8_SA(b, h) + aoff + m * 2048 + k * 1024); } while (0)
#define PG8_LDB(dst, b, h) do { _Pragma("unroll") for (int n = 0; n < 2; ++n) _Pragma("unroll") for (int k = 0; k < 2; ++k) dst[n][k] = *(const PG8_LAS bf16x8*)(lds + PG8_SB(b, h) + boff + n * 2048 + k * 1024); } while (0)
#define PG8_MMA(ai, bj, At, Bt) do { __builtin_amdgcn_s_setprio(1); _Pragma("unroll") for (int m = 0; m < 4; ++m) _Pragma("unroll") for (int n = 0; n < 2; ++n) _Pragma("unroll") for (int k = 0; k < 2; ++k) \
        acc[ai][bj][m][n] = __builtin_amdgcn_mfma_f32_16x16x32_bf16(Bt[n][k], At[m][k], acc[ai][bj][m][n], 0, 0, 0); __builtin_amdgcn_s_setprio(0); } while (0)
#define PG8_WAIT_V(n) asm volatile("s_waitcnt vmcnt(" #n ")" ::: "memory")
#define PG8_WAIT_L(n) asm volatile("s_waitcnt lgkmcnt(" #n ")" ::: "memory")
#define PG8_BAR __builtin_amdgcn_s_barrier()
#define PG8_SCHED __builtin_amdgcn_sched_barrier(0)
    Unit cur, nxt; int ui = 0;
    if (!S.next(0, cur)) return;
    f32x4 acc[2][2][4][2];
#pragma unroll
    for (int a = 0; a < 2; ++a)
#pragma unroll
        for (int b = 0; b < 2; ++b)
#pragma unroll
            for (int m = 0; m < 4; ++m)
#pragma unroll
                for (int n = 0; n < 2; ++n) acc[a][b][m][n] = (f32x4){0.f, 0.f, 0.f, 0.f};
    bf16x8 At[4][2], B0[2][2], B1[2][2];
    const char* cA = (const char*)g.A + (size_t)cur.pm * tstep; const char* cB = (const char*)g.Bt + (size_t)cur.pn * tstep;
    S.a_ready(cur);
    if constexpr (SP2) {
        PG8_STAGE(PG8_SB(0, 0), cB, voffB); PG8_STAGE(PG8_SB(0, 1), cB + hstep, voffB); PG8_STAGE(PG8_SA(0, 0), cA, voffA); PG8_STAGE(PG8_SA(0, 1), cA + hstep, voffA);
        if (wr == 1) PG8_BAR;
        PG8_WAIT_V(2); PG8_BAR;
        PG8_STAGE(PG8_SB(1, 0), cB + kstep, voffB); PG8_STAGE(PG8_SA(1, 0), cA + kstep, voffA); PG8_STAGE(PG8_SB(1, 1), cB + hstep + kstep, voffB);
        PG8_WAIT_V(6); PG8_BAR;
    } else {
        PG8_STAGE(PG8_SB(0, 0), cB, voffB); PG8_STAGE(PG8_SA(0, 0), cA, voffA); PG8_STAGE(PG8_SB(0, 1), cB + hstep, voffB); PG8_STAGE(PG8_SA(0, 1), cA + hstep, voffA);
        if (wr == 1) PG8_BAR;
        PG8_WAIT_V(4); PG8_BAR;
        PG8_STAGE(PG8_SB(1, 0), cB + kstep, voffB); PG8_STAGE(PG8_SA(1, 0), cA + kstep, voffA); PG8_STAGE(PG8_SB(1, 1), cB + hstep + kstep, voffB);
        PG8_WAIT_V(6); PG8_BAR;
    }
    for (;;) {
        const bool has_next = S.next(ui + 1, nxt);
        const char* nA = has_next ? (const char*)g.A + (size_t)nxt.pm * tstep : cA; const char* nB = has_next ? (const char*)g.Bt + (size_t)nxt.pn * tstep : cB;
        for (int t = 0; t < nt; t += 2) {
            const bool last = (t == nt - 2);
            const char* a1 = cA + (size_t)(t + 1) * kstep;
            const char* a2 = last ? nA : cA + (size_t)(t + 2) * kstep; const char* b2 = last ? nB : cB + (size_t)(t + 2) * kstep;
            const char* a3 = a2 + kstep; const char* b3 = b2 + kstep;
            if (last && has_next) S.a_ready(nxt);
            if constexpr (SP2) {
            PG8_LDB(B0, 0, 0); PG8_LDB(B1, 0, 1); PG8_SCHED; PG8_LDA(At, 0, 0); PG8_STAGE(PG8_SA(1, 1), a1 + hstep, voffA);
            PG8_WAIT_V(8); PG8_WAIT_L(0); PG8_BAR; PG8_MMA(0, 0, At, B0); PG8_MMA(0, 1, At, B1); PG8_BAR; PG8_SCHED;
            PG8_LDA(At, 0, 1); PG8_STAGE(PG8_SB(0, 0), b2, voffB); PG8_STAGE(PG8_SB(0, 1), b2 + hstep, voffB); PG8_STAGE(PG8_SA(0, 0), a2, voffA);
            PG8_WAIT_V(8); PG8_WAIT_L(0); PG8_BAR; PG8_MMA(1, 0, At, B0); PG8_MMA(1, 1, At, B1); PG8_BAR; PG8_SCHED;
            PG8_LDB(B0, 1, 0); PG8_LDB(B1, 1, 1); PG8_SCHED; PG8_LDA(At, 1, 0); PG8_STAGE(PG8_SA(0, 1), a2 + hstep, voffA);
            PG8_WAIT_V(8); PG8_WAIT_L(0); PG8_BAR; PG8_MMA(0, 0, At, B0); PG8_MMA(0, 1, At, B1); PG8_BAR; PG8_SCHED;
            PG8_LDA(At, 1, 1); PG8_STAGE(PG8_SB(1, 0), b3, voffB); PG8_STAGE(PG8_SB(1, 1), b3 + hstep, voffB); PG8_STAGE(PG8_SA(1, 0), a3, voffA);
            PG8_WAIT_V(8); PG8_WAIT_L(0); PG8_BAR; PG8_MMA(1, 0, At, B0); PG8_MMA(1, 1, At, B1); PG8_BAR; PG8_SCHED;
            } else {
            PG8_LDB(B0, 0, 0); PG8_SCHED; PG8_LDA(At, 0, 0); PG8_STAGE(PG8_SA(1, 1), a1 + hstep, voffA);
            PG8_WAIT_L(8); PG8_BAR; PG8_WAIT_L(0); PG8_MMA(0, 0, At, B0); PG8_BAR; PG8_SCHED;
            PG8_LDB(B1, 0, 1); PG8_STAGE(PG8_SB(0, 0), b2, voffB);
            PG8_BAR; PG8_WAIT_L(0); PG8_MMA(0, 1, At, B1); PG8_BAR;
            PG8_LDA(At, 0, 1); PG8_STAGE(PG8_SA(0, 0), a2, voffA);
            PG8_BAR; PG8_WAIT_L(0); PG8_MMA(1, 0, At, B0); PG8_BAR; PG8_SCHED;
            PG8_STAGE(PG8_SB(0, 1), b2 + hstep, voffB);
            PG8_WAIT_V(6); PG8_BAR; PG8_MMA(1, 1, At, B1); PG8_BAR;
            PG8_LDB(B0, 1, 0); PG8_SCHED; PG8_LDA(At, 1, 0); PG8_STAGE(PG8_SA(0, 1), a2 + hstep, voffA);
            PG8_WAIT_L(8); PG8_BAR; PG8_WAIT_L(0); PG8_MMA(0, 0, At, B0); PG8_BAR; PG8_SCHED;
            PG8_LDB(B1, 1, 1); PG8_STAGE(PG8_SB(1, 0), b3, voffB);
            PG8_BAR; PG8_WAIT_L(0); PG8_MMA(0, 1, At, B1); PG8_BAR;
            PG8_LDA(At, 1, 1); PG8_STAGE(PG8_SA(1, 0), a3, voffA);
            PG8_BAR; PG8_WAIT_L(0); PG8_MMA(1, 0, At, B0); PG8_BAR; PG8_SCHED;
            PG8_STAGE(PG8_SB(1, 1), b3 + hstep, voffB);
            PG8_WAIT_V(6); PG8_BAR; PG8_MMA(1, 1, At, B1); PG8_BAR;
            }
        }
        if constexpr (ALIGN_EPI) { if (wr == 0) PG8_BAR; }
        if constexpr (!Epi::AFTER_DRAIN) { E(acc, cur, wr, wc, fr, fq); S.done(cur); }
        if (!has_next) break;
#pragma unroll
        for (int a = 0; a < 2; ++a)
#pragma unroll
            for (int b = 0; b < 2; ++b)
#pragma unroll
                for (int m = 0; m < 4; ++m)
#pragma unroll
                    for (int n = 0; n < 2; ++n) acc[a][b][m][n] = (f32x4){0.f, 0.f, 0.f, 0.f};
        cur = nxt; cA = nA; cB = nB; ++ui;
        if constexpr (ALIGN_EPI) { if (wr == 1) PG8_BAR; }
    }
    PG8_WAIT_V(0);
    if constexpr (!ALIGN_EPI) { if (wr == 0) PG8_BAR; }
    PG8_BAR;
    if constexpr (Epi::AFTER_DRAIN) { E.fused(acc, cur, wr, wc, fr, fq, lds, wid, lane); S.done(cur); }
#undef PG8_SA
#undef PG8_SB
#undef PG8_STAGE
#undef PG8_LDA
#undef PG8_LDB
#undef PG8_MMA
#undef PG8_WAIT_V
#undef PG8_WAIT_L
#undef PG8_BAR
#undef PG8_SCHED
}
}

struct EpiInProj {
    static constexpr bool PERM = true, AFTER_DRAIN = false;
    const float* rstd1; const float* qn; const float* kn; bf16_t *qh, *kh, *vh, *xrg, *gg;
    __device__ __forceinline__ void operator()(const pg8::f32x4 (&acc)[2][2][4][2], const pg8::Unit& u, int wr, int wc, int fr, int fq) const {
        const int region = u.pn >> 1;
        const int head = (u.pn & 1) * 4 + wc;
        pg8::f32x4 gn[2][2];
        if (region <= 1) {
            const float* g = region == 0 ? qn : kn; const float sc = region == 0 ? QSCALE : 1.0f;
#pragma unroll
            for (int bj = 0; bj < 2; ++bj)
#pragma unroll
                for (int n = 0; n < 2; ++n) gn[bj][n] = *(const pg8::f32x4*)(g + 32 * bj + 8 * fq + 4 * n) * sc;
        }
#pragma unroll
        for (int ai = 0; ai < 2; ++ai)
#pragma unroll
            for (int m = 0; m < 4; ++m) {
                const int row = u.pm * 256 + ai * 128 + wr * 64 + m * 16 + fr;
                const float rs = rstd1[row];
                pg8::f32x4 v[2][2];
#pragma unroll
                for (int bj = 0; bj < 2; ++bj)
#pragma unroll
                    for (int n = 0; n < 2; ++n) v[bj][n] = acc[ai][bj][m][n] * rs;
                bf16_t* dst;
                if (region <= 1) {
                    float ss = 0.f;
#pragma unroll
                    for (int bj = 0; bj < 2; ++bj)
#pragma unroll
                        for (int n = 0; n < 2; ++n) ss += (v[bj][n][0] * v[bj][n][0] + v[bj][n][1] * v[bj][n][1]) + (v[bj][n][2] * v[bj][n][2] + v[bj][n][3] * v[bj][n][3]);
                    ss += __shfl_xor(ss, 16); ss += __shfl_xor(ss, 32);
                    const float rn = rsqrtf(ss * (1.0f / HD) + EPS);
#pragma unroll
                    for (int bj = 0; bj < 2; ++bj)
#pragma unroll
                        for (int n = 0; n < 2; ++n) v[bj][n] = v[bj][n] * rn * gn[bj][n];
                    dst = (region == 0 ? qh : kh) + ((size_t)head * S + row) * HD;
                } else if (region == 2) {
#pragma unroll
                    for (int bj = 0; bj < 2; ++bj)
#pragma unroll
                        for (int n = 0; n < 2; ++n)
#pragma unroll
                            for (int i = 0; i < 4; ++i) vh[((size_t)head * HD + 32 * bj + 8 * fq + 4 * n + i) * S + row] = (bf16_t)f2bf(v[bj][n][i]);
                    continue;
                } else if (region == 3) {
                    dst = xrg + (size_t)row * DRG + head * 64;
                } else {
#pragma unroll
                    for (int bj = 0; bj < 2; ++bj)
#pragma unroll
                        for (int n = 0; n < 2; ++n)
#pragma unroll
                            for (int i = 0; i < 4; ++i) v[bj][n][i] = gelu_tanh(v[bj][n][i]);
                    dst = gg + (size_t)row * DRG + head * 64;
                }
#pragma unroll
                for (int bj = 0; bj < 2; ++bj) {
                    pg8::u32x4 w; w.x = pg8::cvt_pk_bf16(v[bj][0][0], v[bj][0][1]); w.y = pg8::cvt_pk_bf16(v[bj][0][2], v[bj][0][3]);
                    w.z = pg8::cvt_pk_bf16(v[bj][1][0], v[bj][1][1]); w.w = pg8::cvt_pk_bf16(v[bj][1][2], v[bj][1][3]);
                    *(pg8::u32x4*)(dst + 32 * bj + 8 * fq) = w;
                }
            }
    }
};
struct EpiOutProj {
    static constexpr bool PERM = true, AFTER_DRAIN = false;
    const float* x; float* out; bf16_t* x1b; float* ssq;
    __device__ __forceinline__ void operator()(const pg8::f32x4 (&acc)[2][2][4][2], const pg8::Unit& u, int wr, int wc, int fr, int fq) const {
#pragma unroll
        for (int ai = 0; ai < 2; ++ai)
#pragma unroll
            for (int m = 0; m < 4; ++m) {
                const int row = u.pm * 256 + ai * 128 + wr * 64 + m * 16 + fr;
                float ss = 0.f;
#pragma unroll
                for (int bj = 0; bj < 2; ++bj) {
                    const size_t o = (size_t)row * D + u.pn * 256 + bj * 128 + wc * 32 + 8 * fq;
                    const pg8::f32x4 a = *(const pg8::f32x4*)(x + o) + acc[ai][bj][m][0], b = *(const pg8::f32x4*)(x + o + 4) + acc[ai][bj][m][1];
                    *(pg8::f32x4*)(out + o) = a; *(pg8::f32x4*)(out + o + 4) = b;
                    ss += (a[0] * a[0] + a[1] * a[1]) + (a[2] * a[2] + a[3] * a[3]) + (b[0] * b[0] + b[1] * b[1]) + (b[2] * b[2] + b[3] * b[3]);
                    pg8::u32x4 w; w.x = pg8::cvt_pk_bf16(a[0], a[1]); w.y = pg8::cvt_pk_bf16(a[2], a[3]); w.z = pg8::cvt_pk_bf16(b[0], b[1]); w.w = pg8::cvt_pk_bf16(b[2], b[3]);
                    *(pg8::u32x4*)(x1b + o) = w;
                }
                ss += __shfl_xor(ss, 16); ss += __shfl_xor(ss, 32);
                if (fq == 0) ssq[(size_t)row * 16 + u.pn * 4 + wc] = ss;
            }
    }
};
struct EpiPeerQ {
    static constexpr bool PERM = true, AFTER_DRAIN = false;
    bf16_t* qp;
    __device__ __forceinline__ void operator()(const pg8::f32x4 (&acc)[2][2][4][2], const pg8::Unit& u, int wr, int wc, int fr, int fq) const {
#pragma unroll
        for (int ai = 0; ai < 2; ++ai)
#pragma unroll
            for (int m = 0; m < 4; ++m) {
                const int row = u.pm * 256 + ai * 128 + wr * 64 + m * 16 + fr;
#pragma unroll
                for (int bj = 0; bj < 2; ++bj) {
                    const pg8::f32x4 a = acc[ai][bj][m][0], b = acc[ai][bj][m][1];
                    pg8::u32x4 w; w.x = pg8::cvt_pk_bf16(a[0], a[1]); w.y = pg8::cvt_pk_bf16(a[2], a[3]); w.z = pg8::cvt_pk_bf16(b[0], b[1]); w.w = pg8::cvt_pk_bf16(b[2], b[3]);
                    *(pg8::u32x4*)(qp + (size_t)row * NQ + u.pn * 256 + bj * 128 + wc * 32 + 8 * fq) = w;
                }
            }
    }
};

typedef float f32x2v __attribute__((ext_vector_type(2)));
typedef __bf16 bf16x2v __attribute__((ext_vector_type(2)));
__device__ __forceinline__ unsigned cvtpk(float lo, float hi) { const f32x2v v = {lo, hi}; const bf16x2v b = __builtin_convertvector(v, bf16x2v); return __builtin_bit_cast(unsigned, b); }
__device__ __forceinline__ bf16x8 pack_step(const f32x16& x, int s) {
    u32x4 pkd; pkd.x = cvtpk(x[8 * s], x[8 * s + 1]); pkd.y = cvtpk(x[8 * s + 2], x[8 * s + 3]); pkd.z = cvtpk(x[8 * s + 4], x[8 * s + 5]); pkd.w = cvtpk(x[8 * s + 6], x[8 * s + 7]);
    return __builtin_bit_cast(bf16x8, pkd);
}
#define MFMA32(a, b, c) __builtin_amdgcn_mfma_f32_32x32x16_bf16((a), (b), (c), 0, 0, 0)
__device__ __forceinline__ void ph_attn(const Params& p) {
    unsigned char* ws = p.ws;
    const bf16_t* qh = (const bf16_t*)(ws + WS_QH); const bf16_t* kh = (const bf16_t*)(ws + WS_KH); const bf16_t* vT = (const bf16_t*)(ws + WS_VH);
    bf16_t* osb = (bf16_t*)(ws + WS_OSB);
    const int tid = phase_tid(), lane = tid & 63, r = lane & 31, hh = lane >> 5;
    const int gwave = (blockIdx.x * blockDim.x + tid) >> 6, nwave = (gridDim.x * blockDim.x) >> 6;
    bf16x8 tp[2];
#pragma unroll
    for (int ss = 0; ss < 2; ++ss)
#pragma unroll
        for (int e = 0; e < 8; ++e) { const int k = 16 * ss + 8 * (e >> 2) + 4 * hh + (e & 3); tp[ss][e] = (k > r) ? (short)0x3F80 : (short)0; }
    f32x16 zero16;
#pragma unroll
    for (int i = 0; i < 16; ++i) zero16[i] = 0.f;
    for (int u = gwave; u < NH * (S / 32); u += nwave) {
        const int h = u / (S / 32), t0 = (u % (S / 32)) * 32;
        bf16x8 bq[4];
#pragma unroll
        for (int s = 0; s < 4; ++s) bq[s] = *(const bf16x8*)(qh + ((size_t)h * S + t0 + r) * HD + 16 * s + 8 * hh);
        f32x16 ot[2] = {zero16, zero16};
        float carry = 0.f;
        for (int kt0 = t0; kt0 >= 0; kt0 -= 32) {
            bf16x8 ak[4], av[2][2];
#pragma unroll
            for (int s = 0; s < 4; ++s) ak[s] = *(const bf16x8*)(kh + ((size_t)h * S + kt0 + r) * HD + 16 * s + 8 * hh);
#pragma unroll
            for (int dt = 0; dt < 2; ++dt)
#pragma unroll
                for (int ss = 0; ss < 2; ++ss) {
                    const bf16_t* vp = vT + ((size_t)h * HD + 32 * dt + r) * S + kt0 + 16 * ss + 4 * hh;
                    const uint2 lo = *(const uint2*)vp, hi = *(const uint2*)(vp + 8);
                    u32x4 w4; w4.x = lo.x; w4.y = lo.y; w4.z = hi.x; w4.w = hi.y;
                    av[dt][ss] = __builtin_bit_cast(bf16x8, w4);
                }
            f32x16 st = zero16;
#pragma unroll
            for (int s = 0; s < 4; ++s) st = MFMA32(ak[s], bq[s], st);
            const bool diag = (kt0 == t0);
            f32x16 lom, lb;
            float csum = 0.f;
#pragma unroll
            for (int i = 0; i < 16; ++i) {
                const float z = st[i];
                const float sp2 = fmaxf(z, 0.f) + __builtin_amdgcn_logf(1.0f + __builtin_amdgcn_exp2f(-fabsf(z)));
                const bool valid = !diag || ((i & 3) + 8 * (i >> 2) + 4 * hh < r);
                lom[i] = valid ? -sp2 : 0.f;
                lb[i] = z - sp2;
                csum += lom[i];
            }
            f32x16 suf = MFMA32(tp[0], pack_step(lom, 0), zero16);
            suf = MFMA32(tp[1], pack_step(lom, 1), suf);
            f32x16 w;
#pragma unroll
            for (int i = 0; i < 16; ++i) {
                const bool valid = !diag || ((i & 3) + 8 * (i >> 2) + 4 * hh < r);
                w[i] = valid ? __builtin_amdgcn_exp2f(lb[i] + suf[i] + carry) : 0.f;
            }
            const bf16x8 w0 = pack_step(w, 0), w1 = pack_step(w, 1);
#pragma unroll
            for (int dt = 0; dt < 2; ++dt) { ot[dt] = MFMA32(av[dt][0], w0, ot[dt]); ot[dt] = MFMA32(av[dt][1], w1, ot[dt]); }
            carry += csum + __shfl_xor(csum, 32);
            if (__all(carry < CARRY_STOP)) break;
        }
#pragma unroll
        for (int dt = 0; dt < 2; ++dt)
#pragma unroll
            for (int g = 0; g < 4; ++g) {
                uint2 o; o.x = cvtpk(ot[dt][4 * g], ot[dt][4 * g + 1]); o.y = cvtpk(ot[dt][4 * g + 2], ot[dt][4 * g + 3]);
                *(uint2*)(osb + (size_t)(t0 + r) * DSB + h * HD + 32 * dt + 8 * g + 4 * hh) = o;
            }
    }
}

constexpr int RG_LDS_CST = 0, RG_LDS_HIN = 16384, RG_LDS_P = 18432, RG_LDS_SSQ = 20480;
typedef __attribute__((address_space(3))) float lds_f;
template <int PASS>
__device__ __forceinline__ void ph_rg(const Params& p, unsigned char* lds_raw) {
    float* lds = (float*)lds_raw;
    unsigned char* ws = p.ws;
    const bf16_t* xrg = (const bf16_t*)(ws + WS_XRG); const bf16_t* gg = (const bf16_t*)(ws + WS_GG); const bf16_t* wfrag = (const bf16_t*)(ws + WS_RGW);
    const bf16_t* osb = (const bf16_t*)(ws + WS_OSB); bf16_t* mix = (bf16_t*)(ws + WS_MIX);
    float* rgP = (float*)(ws + WS_RGP); float* rgH = (float*)(ws + WS_RGH);
    const int tid = phase_tid(), lane = tid & 63, r = lane & 31, hh = lane >> 5, n = __builtin_amdgcn_readfirstlane(tid >> 6);
    __syncthreads();
    for (int e = tid; e < 8 * 2 * 8 * 32; e += NTHR) {
        const int q = e & 31, k = (e >> 5) & 7, h2 = (e >> 8) & 1, nn = e >> 9;
        const int c = 64 * nn + 32 * (q >> 4) + (q & 3) + 8 * ((q >> 2) & 3) + 4 * h2;
        float v;
        if (k < 4) v = p.in[I_CONV_W][k * DRG + c];
        else if (k == 4) v = p.in[I_CONV_B][c];
        else if (k == 5) v = p.in[I_RG_B_A][c];
        else if (k == 6) v = p.in[I_RG_B_X][c];
        else v = 8.0f * LOG2E * log1pf(__expf(-p.in[I_RG_LAMBDA][c]));
        lds[e] = v;
    }
    __syncthreads();
    const unsigned lds0 = (unsigned)(size_t)((__attribute__((address_space(3))) unsigned char*)lds_raw);
    const unsigned cst_base = lds0 + (unsigned)((n * 2 + hh) * 1024);
    lds_f* hin_l = (lds_f*)(size_t)(lds0 + RG_LDS_HIN + (n * 2 + hh) * 128);
    lds_f* pc_l = (lds_f*)(size_t)(lds0 + RG_LDS_P + (n * 2 + hh) * 128);
    f32x16 zero16;
#pragma unroll
    for (int i = 0; i < 16; ++i) zero16[i] = 0.f;
    for (int ch = blockIdx.x; ch < NCHUNK; ch += gridDim.x) {
        const int t0 = ch * CHUNK;
        if (PASS == 1) {
            const int c = 64 * n + lane;
            float h = 0.f;
            for (int k = 0; k < ch; ++k) h = rgP[k * DRG + c] * h + rgH[k * DRG + c];
            lds[RG_LDS_HIN / 4 + (n * 2 + ((lane >> 2) & 1)) * 32 + 16 * (lane >> 5) + 4 * ((lane >> 3) & 3) + (lane & 3)] = h;
        } else {
            if (r == 0) {
#pragma unroll
                for (int q = 0; q < 32; ++q) { hin_l[q] = 0.f; pc_l[q] = 1.f; }
            }
        }
        if (PASS == 1) __syncthreads();
#pragma unroll 1
        for (int tl = 0; tl < 2; ++tl) {
            const int tok = t0 + 32 * tl + r;
            unsigned cst_a = cst_base; asm volatile("" : "+v"(cst_a));
            const lds_f* cst = (const lds_f*)(size_t)cst_a;
            float xcv[32];
#pragma unroll
            for (int q = 0; q < 32; ++q) xcv[q] = cst[4 * 32 + q];
#pragma unroll
            for (int k = 0; k < 4; ++k) {
                const int tt = tok + k - 3;
#pragma unroll
                for (int m = 0; m < 8; ++m) {
                    uint2 xw = make_uint2(0u, 0u);
                    if (tt >= 0) xw = *(const uint2*)(xrg + (size_t)tt * DRG + 64 * n + 8 * m + 4 * hh);
                    xcv[4 * m + 0] += cst[k * 32 + 4 * m + 0] * bf2f(xw.x & 0xffffu); xcv[4 * m + 1] += cst[k * 32 + 4 * m + 1] * bf2f(xw.x >> 16);
                    xcv[4 * m + 2] += cst[k * 32 + 4 * m + 2] * bf2f(xw.y & 0xffffu); xcv[4 * m + 3] += cst[k * 32 + 4 * m + 3] * bf2f(xw.y >> 16);
                }
                __builtin_amdgcn_sched_barrier(0);
            }
            bf16x8 bx[4];
#pragma unroll
            for (int s = 0; s < 4; ++s) {
                u32x4 pk; pk.x = cvtpk(xcv[8 * s], xcv[8 * s + 1]); pk.y = cvtpk(xcv[8 * s + 2], xcv[8 * s + 3]); pk.z = cvtpk(xcv[8 * s + 4], xcv[8 * s + 5]); pk.w = cvtpk(xcv[8 * s + 6], xcv[8 * s + 7]);
                bx[s] = __builtin_bit_cast(bf16x8, pk);
            }
            float ss = 0.f;
            const bf16_t* wb = wfrag + ((size_t)n * 16 * 64 + lane) * 8; asm volatile("" : "+v"(wb));
#pragma unroll
            for (int jt = 0; jt < 2; ++jt) {
                float av[16], bv[16];
#pragma unroll
                for (int g = 0; g < 2; ++g) {
                    f32x16 acc = zero16;
#pragma unroll
                    for (int s = 0; s < 4; ++s) {
                        const bf16x8 aw = *(const bf16x8*)(wb + (((g * 2 + jt) * 4 + s) * 64) * 8);
                        acc = MFMA32(aw, bx[s], acc);
                    }
#pragma unroll
                    for (int i = 0; i < 16; ++i) {
                        const int q = 16 * jt + i;
                        const float pre = acc[i] + cst[(5 + g) * 32 + q];
                        const float sg = 1.0f / (1.0f + __builtin_amdgcn_exp2f(-LOG2E * pre));
                        if (g == 0) av[i] = __builtin_amdgcn_exp2f(-sg * cst[7 * 32 + q]);
                        else bv[i] = __builtin_amdgcn_sqrtf(fmaxf(__builtin_fmaf(-av[i], av[i], 1.0f), 0.f)) * (sg * xcv[q]);
                    }
                    __builtin_amdgcn_sched_barrier(0);
                }
#pragma unroll
                for (int d = 1; d < 32; d <<= 1) {
                    const bool on = r >= d;
#pragma unroll
                    for (int i = 0; i < 16; ++i) {
                        const float ap = __shfl_up(av[i], d, 32), bp = __shfl_up(bv[i], d, 32);
                        if (on) { bv[i] = __builtin_fmaf(av[i], bp, bv[i]); av[i] *= ap; }
                    }
                    __builtin_amdgcn_sched_barrier(0);
                }
#pragma unroll
                for (int i = 0; i < 16; ++i) {
                    const int q = 16 * jt + i;
                    const float h = __builtin_fmaf(av[i], hin_l[q], bv[i]);
                    if (r == 31) { hin_l[q] = h; if (PASS == 0) pc_l[q] *= av[i]; }
                    bv[i] = h;
                }
                if (PASS == 1) {
#pragma unroll
                    for (int g4 = 0; g4 < 4; ++g4) {
                        const int m = 4 * jt + g4;
                        const uint2 gw = *(const uint2*)(gg + (size_t)tok * DRG + 64 * n + 8 * m + 4 * hh);
                        const float o0 = bv[4 * g4] * bf2f(gw.x & 0xffffu), o1 = bv[4 * g4 + 1] * bf2f(gw.x >> 16), o2 = bv[4 * g4 + 2] * bf2f(gw.y & 0xffffu), o3 = bv[4 * g4 + 3] * bf2f(gw.y >> 16);
                        ss += (o0 * o0 + o1 * o1) + (o2 * o2 + o3 * o3);
                        uint2 o; o.x = cvtpk(o0, o1); o.y = cvtpk(o2, o3);
                        *(uint2*)(mix + (size_t)tok * D + DSB + 64 * n + 8 * m + 4 * hh) = o;
                    }
                }
                __builtin_amdgcn_sched_barrier(0);
            }
            if (PASS == 1) { ss += __shfl_xor(ss, 32); if (hh == 0) lds[RG_LDS_SSQ / 4 + (tl * 8 + n) * 32 + r] = ss; }
        }
        if (PASS == 0) {
            if (r == 0) {
#pragma unroll
                for (int m = 0; m < 8; ++m) {
                    const int c = 64 * n + 8 * m + 4 * hh;
                    *(f32x4*)(rgP + (size_t)ch * DRG + c) = (f32x4){pc_l[4 * m], pc_l[4 * m + 1], pc_l[4 * m + 2], pc_l[4 * m + 3]};
                    *(f32x4*)(rgH + (size_t)ch * DRG + c) = (f32x4){hin_l[4 * m], hin_l[4 * m + 1], hin_l[4 * m + 2], hin_l[4 * m + 3]};
                }
            }
        } else {
            __syncthreads();
#pragma unroll
            for (int tl = 0; tl < 2; ++tl) {
                float tot = 0.f;
#pragma unroll
                for (int w = 0; w < 8; ++w) tot += lds[RG_LDS_SSQ / 4 + (tl * 8 + w) * 32 + r];
                const float rn = rsqrtf(tot * (1.0f / DRG) + EPS);
                const int tok = t0 + 32 * tl + r;
#pragma unroll
                for (int m = 0; m < 8; ++m) {
                    uint2* mp = (uint2*)(mix + (size_t)tok * D + DSB + 64 * n + 8 * m + 4 * hh);
                    const uint2 w = *mp;
                    uint2 o; o.x = cvtpk(bf2f(w.x & 0xffffu) * rn, bf2f(w.x >> 16) * rn); o.y = cvtpk(bf2f(w.y & 0xffffu) * rn, bf2f(w.y >> 16) * rn);
                    *mp = o;
                }
            }
            for (int j = 0; j < 8; ++j) {
                const int tok = t0 + 8 * n + j;
                const u32x4 a = *((const u32x4*)(osb + (size_t)tok * DSB) + lane);
                float f[8] = {bf2f(a.x & 0xffffu), bf2f(a.x >> 16), bf2f(a.y & 0xffffu), bf2f(a.y >> 16), bf2f(a.z & 0xffffu), bf2f(a.z >> 16), bf2f(a.w & 0xffffu), bf2f(a.w >> 16)};
                float sa = 0.f;
#pragma unroll
                for (int k = 0; k < 8; ++k) sa += f[k] * f[k];
                sa = wave_sum(sa);
                const float ra = rsqrtf(sa * (1.0f / DSB) + EPS);
                u32x4 o; o.x = cvtpk(f[0] * ra, f[1] * ra); o.y = cvtpk(f[2] * ra, f[3] * ra); o.z = cvtpk(f[4] * ra, f[5] * ra); o.w = cvtpk(f[6] * ra, f[7] * ra);
                *((u32x4*)(mix + (size_t)tok * D) + lane) = o;
            }
        }
    }
}

__device__ __forceinline__ int f2key(float f) { const int b = __builtin_bit_cast(int, f); return b ^ ((b >> 31) & 0x7fffffff); }
__device__ __forceinline__ float key2f(int k) { return __builtin_bit_cast(float, k ^ ((k >> 31) & 0x7fffffff)); }
__device__ __forceinline__ void topk_insert(int (&lst)[16], int x) {
#pragma unroll
    for (int i = 0; i < 16; ++i) { const int hi = max(lst[i], x); x = min(lst[i], x); lst[i] = hi; }
}
#define TOPK_CE(a, b) do { const int hi_ = max(a, b), lo_ = min(a, b); a = hi_; b = lo_; } while (0)
__device__ __forceinline__ void ph_topk(const Params& p, int* lds) {
    unsigned char* ws = p.ws;
    const bf16_t* qp = (const bf16_t*)(ws + WS_B); const bf16_t* subk = (const bf16_t*)(ws + WS_SUBK);
    int* seli = (int*)(ws + WS_SELI); float* selg = (float*)(ws + WS_SELG);
    const float* ssq = (const float*)(ws + WS_SSQ); float* rstd2 = (float*)(ws + WS_RSTD2);
    const int tid = phase_tid(), lane = tid & 63, r = lane & 31, hh = lane >> 5, hx = 4 * hh;
    const int gwave = (blockIdx.x * blockDim.x + tid) >> 6, nwave = (gridDim.x * blockDim.x) >> 6;
    for (int u = gwave; u < (S / 32) * PH; u += nwave) {
        const int h = u / (S / 32), t0 = (u % (S / 32)) * 32, t = t0 + r;
        int tk[2][16];
#pragma unroll
        for (int pp = 0; pp < 2; ++pp) {
            f32x16 acc[4];
#pragma unroll
            for (int T = 0; T < 4; ++T)
#pragma unroll
                for (int i = 0; i < 16; ++i) acc[T][i] = 0.f;
            const bf16_t* qrow = qp + (size_t)t * NQ + h * PDK + pp * PHALF + 8 * hh;
            const bf16_t* krow = subk + (((size_t)h * 2 + pp) * PNK + r) * PHALF + 8 * hh;
#pragma unroll
            for (int s = 0; s < 8; ++s) {
                const bf16x8 b = *(const bf16x8*)(qrow + 16 * s);
#pragma unroll
                for (int T = 0; T < 4; ++T) {
                    const bf16x8 a = *(const bf16x8*)(krow + (size_t)(32 * T) * PHALF + 16 * s);
                    acc[T] = __builtin_amdgcn_mfma_f32_32x32x16_bf16(a, b, acc[T], 0, 0, 0);
                }
            }
            int lst[16];
#pragma unroll
            for (int i = 0; i < 16; ++i) lst[i] = (int)0x80000000;
#pragma unroll
            for (int T = 0; T < 4; ++T)
#pragma unroll
                for (int i = 0; i < 16; ++i) {
                    const int nb = 32 * T + (i & 3) + 8 * (i >> 2);
                    topk_insert(lst, ((f2key(acc[T][i]) & ~127) | (127 - nb)) ^ hx);
                }
            int m[16];
#pragma unroll
            for (int i = 0; i < 16; ++i) m[i] = max(lst[i], __shfl_xor(lst[15 - i], 32));
#pragma unroll
            for (int d = 8; d >= 1; d >>= 1)
#pragma unroll
                for (int i = 0; i < 16; ++i) if ((i & d) == 0) TOPK_CE(m[i], m[i + d]);
#pragma unroll
            for (int i = 0; i < 16; ++i) tk[pp][i] = m[i];
        }
#pragma unroll
        for (int i = 0; i < 16; ++i) { lds[i * NTHR + tid] = tk[0][i]; lds[(16 + i) * NTHR + tid] = tk[1][i]; }
        float v0[16], v1[16];
#pragma unroll
        for (int i = 0; i < 16; ++i) { v0[i] = key2f(tk[0][i]); v1[i] = key2f(tk[1][i]); }
        int bk[16];
#pragma unroll
        for (int i = 0; i < 16; ++i) bk[i] = (int)0x80000000;
#pragma unroll
        for (int a = 0; a < 16; ++a)
#pragma unroll
            for (int b = 0; b < 16; ++b)
                if ((a + 1) * (b + 1) <= 16) topk_insert(bk, (f2key(v0[a] + v1[b]) & ~255) | (255 - (a * 16 + b)));
        float ssum = 0.f;
#pragma unroll
        for (int i = 0; i < 4; ++i) { const f32x4 q4 = *(const f32x4*)(ssq + (size_t)t * 16 + 4 * i); ssum += (q4.x + q4.y) + (q4.z + q4.w); }
        const float rs = rsqrtf(ssum * (1.0f / D) + EPS);
        float e[16], sum = 0.f; const float mx = key2f(bk[0]);
#pragma unroll
        for (int i = 0; i < 16; ++i) { e[i] = __expf((key2f(bk[i]) - mx) * rs); sum += e[i]; }
        const float inv = 1.0f / sum;
        int eidx[16];
#pragma unroll
        for (int i = 0; i < 16; ++i) {
            const int code = 255 - (bk[i] & 255), a = code >> 4, b = code & 15;
            const int i1 = 127 - (lds[a * NTHR + tid] & 127), i2 = 127 - (lds[(16 + b) * NTHR + tid] & 127);
            eidx[i] = i1 * PNK + i2; e[i] *= inv;
        }
        if (hh == 0) {
            int4* o = (int4*)(seli + (size_t)t * 128 + h * 16);
#pragma unroll
            for (int i = 0; i < 4; ++i) o[i] = make_int4(eidx[4 * i], eidx[4 * i + 1], eidx[4 * i + 2], eidx[4 * i + 3]);
            if (h == 0) rstd2[t] = rs;
        } else {
            f32x4* o = (f32x4*)(selg + (size_t)t * 128 + h * 16);
#pragma unroll
            for (int i = 0; i < 4; ++i) o[i] = (f32x4){e[4 * i], e[4 * i + 1], e[4 * i + 2], e[4 * i + 3]};
        }
    }
}

__device__ __forceinline__ void unpack8(const u32x4 a, float (&f)[8]) {
    f[0] = bf2f(a.x & 0xffff); f[1] = bf2f(a.x >> 16); f[2] = bf2f(a.y & 0xffff); f[3] = bf2f(a.y >> 16);
    f[4] = bf2f(a.z & 0xffff); f[5] = bf2f(a.z >> 16); f[6] = bf2f(a.w & 0xffff); f[7] = bf2f(a.w >> 16);
}
typedef __bf16 bf16x2_t __attribute__((ext_vector_type(2)));
__device__ __forceinline__ float dot2_bf16(unsigned a, unsigned b, float c) { return __builtin_amdgcn_fdot2_f32_bf16(__builtin_bit_cast(bf16x2_t, a), __builtin_bit_cast(bf16x2_t, b), c, false); }
__device__ __forceinline__ float dot8_bf16(const u32x4 a, const u32x4 b, float c) {
    c = dot2_bf16(a.x, b.x, c); c = dot2_bf16(a.y, b.y, c); c = dot2_bf16(a.z, b.z, c); c = dot2_bf16(a.w, b.w, c);
    return c;
}
__device__ __forceinline__ void axpy8_bf16(float (&acc)[16], int o, const u32x4 w, float c) {
    acc[o + 0] += c * __builtin_bit_cast(float, w.x << 16); acc[o + 1] += c * __builtin_bit_cast(float, w.x & 0xffff0000u);
    acc[o + 2] += c * __builtin_bit_cast(float, w.y << 16); acc[o + 3] += c * __builtin_bit_cast(float, w.y & 0xffff0000u);
    acc[o + 4] += c * __builtin_bit_cast(float, w.z << 16); acc[o + 5] += c * __builtin_bit_cast(float, w.z & 0xffff0000u);
    acc[o + 6] += c * __builtin_bit_cast(float, w.w << 16); acc[o + 7] += c * __builtin_bit_cast(float, w.w & 0xffff0000u);
}
__device__ __forceinline__ float transpose_reduce64(float (&v)[64], int lane) {
#pragma unroll
    for (int s = 0; s < 6; ++s) {
        const bool up = (lane >> s) & 1;
#pragma unroll
        for (int i = 0; i < (32 >> s); ++i) {
            const float a = v[2 * i], b = v[2 * i + 1];
            const float keep = up ? b : a, send = up ? a : b;
            v[i] = keep + __shfl_xor(send, 1 << s);
        }
    }
    return v[0];
}
typedef float f32x2 __attribute__((ext_vector_type(2)));
__device__ __forceinline__ float dot16_fp8(const u32x4 w, const float (&x)[16], float c) {
    f32x2 q;
    q = __builtin_amdgcn_cvt_pk_f32_fp8((int)w.x, false); c += x[0] * q[0]; c += x[1] * q[1];   q = __builtin_amdgcn_cvt_pk_f32_fp8((int)w.x, true); c += x[2] * q[0]; c += x[3] * q[1];
    q = __builtin_amdgcn_cvt_pk_f32_fp8((int)w.y, false); c += x[4] * q[0]; c += x[5] * q[1];   q = __builtin_amdgcn_cvt_pk_f32_fp8((int)w.y, true); c += x[6] * q[0]; c += x[7] * q[1];
    q = __builtin_amdgcn_cvt_pk_f32_fp8((int)w.z, false); c += x[8] * q[0]; c += x[9] * q[1];   q = __builtin_amdgcn_cvt_pk_f32_fp8((int)w.z, true); c += x[10] * q[0]; c += x[11] * q[1];
    q = __builtin_amdgcn_cvt_pk_f32_fp8((int)w.w, false); c += x[12] * q[0]; c += x[13] * q[1]; q = __builtin_amdgcn_cvt_pk_f32_fp8((int)w.w, true); c += x[14] * q[0]; c += x[15] * q[1];
    return c;
}
__device__ __forceinline__ void axpy16_fp8(float (&acc)[16], const u32x4 w, float c) {
    f32x2 q;
    q = __builtin_amdgcn_cvt_pk_f32_fp8((int)w.x, false); acc[0] += c * q[0]; acc[1] += c * q[1];   q = __builtin_amdgcn_cvt_pk_f32_fp8((int)w.x, true); acc[2] += c * q[0]; acc[3] += c * q[1];
    q = __builtin_amdgcn_cvt_pk_f32_fp8((int)w.y, false); acc[4] += c * q[0]; acc[5] += c * q[1];   q = __builtin_amdgcn_cvt_pk_f32_fp8((int)w.y, true); acc[6] += c * q[0]; acc[7] += c * q[1];
    q = __builtin_amdgcn_cvt_pk_f32_fp8((int)w.z, false); acc[8] += c * q[0]; acc[9] += c * q[1];   q = __builtin_amdgcn_cvt_pk_f32_fp8((int)w.z, true); acc[10] += c * q[0]; acc[11] += c * q[1];
    q = __builtin_amdgcn_cvt_pk_f32_fp8((int)w.w, false); acc[12] += c * q[0]; acc[13] += c * q[1]; q = __builtin_amdgcn_cvt_pk_f32_fp8((int)w.w, true); acc[14] += c * q[0]; acc[15] += c * q[1];
}
__device__ __forceinline__ void ph_gather(const Params& p) {
    unsigned char* ws = p.ws;
    const unsigned char* ub = ws + WS_UB; const unsigned char* vb = ws + WS_VB; const float* usc = (const float*)(ws + WS_USC); const float* vsc = (const float*)(ws + WS_VSC);
    const int* seli = (const int*)(ws + WS_SELI); const float* selg = (const float*)(ws + WS_SELG); const float* rstd2 = (const float*)(ws + WS_RSTD2);
    float* out = p.out;
    const int tid_ = phase_tid();
    const int lane = tid_ & 63, gwave = (blockIdx.x * blockDim.x + tid_) >> 6, nwave = (gridDim.x * blockDim.x) >> 6;
    for (int t = gwave; t < S; t += nwave) {
        float xv[16];
        f32x4* orow = (f32x4*)(out + (size_t)t * D + 16 * lane);
#pragma unroll
        for (int j = 0; j < 4; ++j) { const f32x4 v = orow[j]; xv[4 * j] = v.x; xv[4 * j + 1] = v.y; xv[4 * j + 2] = v.z; xv[4 * j + 3] = v.w; }
        int ei[2]; float cf[2];
        ei[0] = seli[(size_t)t * 128 + lane]; ei[1] = seli[(size_t)t * 128 + 64 + lane];
        const float g0 = selg[(size_t)t * 128 + lane], g1 = selg[(size_t)t * 128 + 64 + lane];
        const float rs = rstd2[t];
#pragma unroll
        for (int r = 0; r < 2; ++r) {
            const float us = usc[ei[r]], vs = vsc[ei[r]];
            float part[64];
#pragma unroll
            for (int jb = 0; jb < 8; ++jb) {
                u32x4 ua[8];
#pragma unroll
                for (int k = 0; k < 8; ++k) { const int e = __builtin_amdgcn_readlane(ei[r], 8 * jb + k); ua[k] = *((const u32x4*)(ub + (size_t)e * D) + lane); }
#pragma unroll
                for (int k = 0; k < 8; ++k) part[8 * jb + k] = dot16_fp8(ua[k], xv, 0.f);
            }
            const float d = transpose_reduce64(part, lane);
            cf[r] = (r == 0 ? g0 : g1) * gelu_tanh(d * us * rs) * vs;
        }
        float acc[16];
#pragma unroll
        for (int j = 0; j < 16; ++j) acc[j] = 0.f;
#pragma unroll
        for (int r = 0; r < 2; ++r)
#pragma unroll
            for (int jb = 0; jb < 8; ++jb) {
                u32x4 va[8];
#pragma unroll
                for (int k = 0; k < 8; ++k) { const int e = __builtin_amdgcn_readlane(ei[r], 8 * jb + k); va[k] = *((const u32x4*)(vb + (size_t)e * D) + lane); }
#pragma unroll
                for (int k = 0; k < 8; ++k) {
                    const float c = __builtin_bit_cast(float, __builtin_amdgcn_readlane(__builtin_bit_cast(int, cf[r]), 8 * jb + k));
                    axpy16_fp8(acc, va[k], c);
                }
            }
#pragma unroll
        for (int j = 0; j < 4; ++j) orow[j] = (f32x4){xv[4 * j] + acc[4 * j], xv[4 * j + 1] + acc[4 * j + 1], xv[4 * j + 2] + acc[4 * j + 2], xv[4 * j + 3] + acc[4 * j + 3]};
    }
}

#define LAS __attribute__((address_space(3)))
#define XB_TMO      128
#define XB_XCNT(j)  (256  + 64 * (j))
#define XB_XSUB(j)  (1280 + 64 * (j))
#define XB_XGEN(j)  (2304 + 64 * (j))
#define XB_TOP      3328
#define XB_TOPGEN   3392
#define XCD_BAR_WORDS 3456
#define XB_SPIN_CAP (1u << 18)
__device__ __forceinline__ unsigned xb_ld(unsigned* p)              { return __hip_atomic_load(p, __ATOMIC_RELAXED, __HIP_MEMORY_SCOPE_AGENT); }
__device__ __forceinline__ unsigned xb_add(unsigned* p, unsigned v) { return __hip_atomic_fetch_add(p, v, __ATOMIC_RELAXED, __HIP_MEMORY_SCOPE_AGENT); }
__device__ __forceinline__ unsigned xb_xcc_id() { return (unsigned)__builtin_amdgcn_s_getreg((3 << 11) | 20) & 0xFu; }
#define XB_SPIN(cond, bar) do { unsigned _sp = 0; while (cond) { __builtin_amdgcn_s_sleep(1); \
    if ((++_sp & 255u) == 0u) { if (xb_ld(&(bar)[XB_TMO])) break; if (_sp > XB_SPIN_CAP) { atomicAdd(&(bar)[XB_TMO], 1u); break; } } } } while (0)
struct XcdBarrier { unsigned* bar; unsigned x; volatile LAS unsigned* st; };
__device__ __forceinline__ XcdBarrier xcd_barrier_post(unsigned* bar, volatile LAS unsigned* st) {
    XcdBarrier b; b.bar = bar; b.x = xb_xcc_id(); b.st = st;
    if (threadIdx.x == 0) (void)xb_add(&bar[XB_XCNT(b.x)], 1u);
    return b;
}
__device__ __forceinline__ void xcd_barrier_complete(unsigned* bar, unsigned x, unsigned& nloc, unsigned& nx) {
    const unsigned G = gridDim.x * gridDim.y * gridDim.z;
    unsigned sum, cnt, mine, sp = 0u;
    for (;;) {
        sum = 0u; cnt = 0u; mine = 0u;
#pragma unroll
        for (unsigned j = 0; j < 16; ++j) { const unsigned c = xb_ld(&bar[XB_XCNT(j)]); sum += c; cnt += (c > 0u) ? 1u : 0u; mine = (j == x) ? c : mine; }
        if (sum == G) break;
        __builtin_amdgcn_s_sleep(1);
        if ((++sp & 255u) == 0u) { if (xb_ld(&bar[XB_TMO])) break; if (sp > XB_SPIN_CAP) { atomicAdd(&bar[XB_TMO], 1u); break; } }
    }
    nloc = mine > 0u ? mine : 1u; nx = cnt > 0u ? cnt : 1u;
}
__device__ __forceinline__ void xcd_barrier(const XcdBarrier& b) {
    asm volatile("s_waitcnt vmcnt(0)" ::: "memory");
    __syncthreads();
    if (threadIdx.x == 0) {
        unsigned* bar = b.bar;
        __builtin_amdgcn_s_waitcnt(0);
        unsigned nloc = b.st[0], nx = b.st[1];
        if (nloc == 0u) { xcd_barrier_complete(bar, b.x, nloc, nx); b.st[0] = nloc; b.st[1] = nx; }
        const unsigned old = xb_add(&bar[XB_XSUB(b.x)], 1u);
        const unsigned gen = old / nloc;
        if (old + 1u == (gen + 1u) * nloc) {
            __builtin_amdgcn_fence(__ATOMIC_RELEASE, "agent");
            asm volatile("s_waitcnt vmcnt(0)" ::: "memory");
            const unsigned og = xb_add(&bar[XB_TOP], 1u);
            const unsigned tg = og / nx;
            if (og + 1u == (tg + 1u) * nx) xb_add(&bar[XB_TOPGEN], 1u);
            else XB_SPIN(xb_ld(&bar[XB_TOPGEN]) == tg, bar);
            __builtin_amdgcn_fence(__ATOMIC_ACQUIRE, "agent");
            xb_add(&bar[XB_XGEN(b.x)], 1u);
            asm volatile("s_waitcnt vmcnt(0)" ::: "memory");
        } else {
            XB_SPIN(xb_ld(&bar[XB_XGEN(b.x)]) == gen, bar);
            __builtin_amdgcn_fence(__ATOMIC_ACQUIRE, "agent");
            asm volatile("s_waitcnt vmcnt(0)" ::: "memory");
        }
    }
    __syncthreads();
}

constexpr int LDS_MISC = 131072;
constexpr int LDS_BYTES = LDS_MISC + 1024;

__global__ void __launch_bounds__(NTHR, 2) hymba_fwd(Params p) {
    extern __shared__ __attribute__((aligned(16))) unsigned char lds[];
    volatile LAS unsigned* misc = (volatile LAS unsigned*)((LAS unsigned char*)lds + LDS_MISC);
    if (threadIdx.x < 4) misc[threadIdx.x] = 0u;
    __syncthreads();
    XcdBarrier bar = xcd_barrier_post((unsigned*)(p.ws + WS_CTL), misc);

    PG8_LAS unsigned char* ring = (PG8_LAS unsigned char*)lds;
    unsigned char* ws = p.ws;
    ph_prep(p);                               xcd_barrier(bar);
    {
        pg8::Gemm g{(const bf16_t*)(ws + WS_A), (const bf16_t*)(ws + WS_WINT), S, NPROJ, D}; pg8::StaticOrder so; so.init(S, NPROJ, (int)gridDim.x, (int)blockIdx.x);
        EpiInProj E{(const float*)(ws + WS_RSTD1), p.in[I_Q_NORM], p.in[I_K_NORM], (bf16_t*)(ws + WS_QH), (bf16_t*)(ws + WS_KH), (bf16_t*)(ws + WS_VH), (bf16_t*)(ws + WS_XRG), (bf16_t*)(ws + WS_GG)};
        pg8::gemm_phase<EpiInProj, pg8::StaticOrder, true, true>(ring, g, so, E);
    }
    xcd_barrier(bar);
    ph_attn(p); ph_rg<0>(p, lds);             xcd_barrier(bar);
    ph_rg<1>(p, lds);                         xcd_barrier(bar);
    {
        pg8::Gemm g{(const bf16_t*)(ws + WS_MIX), (const bf16_t*)(ws + WS_WOUTT), S, D, D}; pg8::StaticOrder so; so.init(S, D, (int)gridDim.x, (int)blockIdx.x);
        EpiOutProj E{p.in[I_X], p.out, (bf16_t*)(ws + WS_A), (float*)(ws + WS_SSQ)};
        pg8::gemm_phase<EpiOutProj, pg8::StaticOrder, true, true>(ring, g, so, E);
    }
    xcd_barrier(bar);
    {
        pg8::Gemm g{(const bf16_t*)(ws + WS_A), (const bf16_t*)(ws + WS_WQT), S, NQ, D}; pg8::StaticOrder so; so.init(S, NQ, (int)gridDim.x, (int)blockIdx.x);
        EpiPeerQ E{(bf16_t*)(ws + WS_B)};
        pg8::gemm_phase<EpiPeerQ, pg8::StaticOrder, true, true>(ring, g, so, E);
    }
    xcd_barrier(bar);
    ph_topk(p, (int*)lds);                    xcd_barrier(bar);
    ph_gather(p);
}

extern "C" void kernel_launch(void* const* d_in, const int* in_sizes, int n_in, void* d_out, int out_size, void* d_ws, size_t ws_size, hipStream_t stream) {
    static int grid = 0;
    if (grid == 0) {
        if (n_in != 20 || out_size != S * D || ws_size < WS_END) { fprintf(stderr, "kernel_launch: unexpected shapes (n_in %d out %d ws %zu)\n", n_in, out_size, ws_size); grid = -1; return; }
        int dev = 0, cus = 0, per_cu = 0;
        if (hipGetDevice(&dev) != hipSuccess || hipDeviceGetAttribute(&cus, hipDeviceAttributeMultiprocessorCount, dev) != hipSuccess) { grid = -1; return; }
        if (hipFuncSetAttribute((const void*)hymba_fwd, hipFuncAttributeMaxDynamicSharedMemorySize, LDS_BYTES) != hipSuccess) { fprintf(stderr, "kernel_launch: hipFuncSetAttribute failed\n"); grid = -1; return; }
        if (hipOccupancyMaxActiveBlocksPerMultiprocessor(&per_cu, (const void*)hymba_fwd, NTHR, LDS_BYTES) != hipSuccess || per_cu < 1) { fprintf(stderr, "kernel_launch: occupancy query says %d blocks per CU\n", per_cu); grid = -1; return; }
        (void)hipGetLastError();
        grid = cus;
    }
    if (grid < 0) return;
    (void)hipMemsetAsync((char*)d_ws + WS_CTL, 0, XCD_BAR_WORDS * 4, stream);
    Params p{};
    for (int i = 0; i < 20; ++i) p.in[i] = (const float*)d_in[i];
    p.out = (float*)d_out; p.ws = (unsigned char*)d_ws;
    hipLaunchKernelGGL(hymba_fwd, dim3(grid), dim3(NTHR), LDS_BYTES, stream, p);
}
```

```cpp
#include <hip/hip_runtime.h>
#include <cstdint>
#include <cstdio>

typedef unsigned short bf16_t;
typedef short bf16x8 __attribute__((ext_vector_type(8)));
typedef float f32x4 __attribute__((ext_vector_type(4)));
typedef unsigned u32x4 __attribute__((ext_vector_type(4)));
typedef float f32x16 __attribute__((ext_vector_type(16)));

constexpr int S = 16384, D = 1024, NPROJ = 2560, DSB = 512, DRG = 512, NH = 8, HD = 64;
constexpr int PH = 8, PNK = 128, PDK = 256, PHALF = 128, PTOPK = 16, NEXP = 16384, NQ = PH * PDK;
constexpr int CHUNK = 64, NCHUNK = S / CHUNK;
constexpr float EPS = 1e-6f;
constexpr float LOG2E = 1.4426950408889634f;
constexpr float QSCALE = 0.125f * LOG2E;
constexpr int NTHR = 512;
constexpr float CARRY_STOP = -160.0f;

constexpr size_t MiB = 1u << 20;
constexpr size_t WS_CTL = 0;
constexpr size_t WS_WINT = 1 * MiB;
constexpr size_t WS_WOUTT = 6 * MiB;
constexpr size_t WS_WQT = 8 * MiB;
constexpr size_t WS_SUBK = 12 * MiB;
constexpr size_t WS_RSTD1 = 12 * MiB + 512 * 1024;
constexpr size_t WS_RSTD2 = WS_RSTD1 + 64 * 1024;
constexpr size_t WS_RGP = WS_RSTD2 + 64 * 1024;
constexpr size_t WS_RGH = WS_RGP + 512 * 1024;
constexpr size_t WS_A = 14 * MiB;
constexpr size_t WS_B = 46 * MiB;
constexpr size_t WS_QH = WS_B, WS_KH = WS_B + 16 * MiB, WS_VH = WS_B + 32 * MiB, WS_XRG = WS_B + 48 * MiB;
constexpr size_t WS_GG = 110 * MiB;
constexpr size_t WS_OSB = 126 * MiB;
constexpr size_t WS_MIX = 142 * MiB;
constexpr size_t WS_SELI = WS_MIX, WS_SELG = WS_MIX + 8 * MiB;
constexpr size_t WS_PD = WS_B;
constexpr size_t WS_CBUF = WS_GG;
constexpr size_t WS_UB = 174 * MiB;
constexpr size_t WS_VB = 190 * MiB;
constexpr size_t WS_USC = 206 * MiB;
constexpr size_t WS_VSC = 206 * MiB + 64 * 1024;
constexpr size_t WS_SSQ = 238 * MiB;
constexpr size_t WS_RGW = 239 * MiB;
constexpr size_t WS_END = 240 * MiB;

__device__ __forceinline__ unsigned f2bf(float f) { unsigned u = __builtin_bit_cast(unsigned, f); return (u + 0x7fffu + ((u >> 16) & 1u)) >> 16; }
__device__ __forceinline__ float u2f(unsigned u) { return __builtin_bit_cast(float, u); }
__device__ __forceinline__ float bf2f(unsigned h) { return __builtin_bit_cast(float, h << 16); }
__device__ __forceinline__ unsigned pk2(float lo, float hi) { return f2bf(lo) | (f2bf(hi) << 16); }
__device__ __forceinline__ float wave_sum(float v) {
#pragma unroll
    for (int o = 1; o < 64; o <<= 1) v += __shfl_xor(v, o);
    return v;
}
__device__ __forceinline__ float gelu_tanh(float x) {
    const float u = 0.7978845608028654f * (x + 0.044715f * x * x * x);
    const float e = __expf(2.0f * u);
    const float th = 1.0f - 2.0f / (e + 1.0f);
    return 0.5f * x * (1.0f + th);
}
__device__ __forceinline__ float sigmoidf_(float x) { return 1.0f / (1.0f + __expf(-x)); }

__host__ __device__ __forceinline__ int inproj_phys_row(int nlog) { const int t = nlog >> 8, L = nlog & 255; return (t << 8) + 128 * ((L & 63) >> 5) + 32 * (L >> 6) + (L & 31); }

__device__ __forceinline__ int phase_tid() { int t = threadIdx.x; asm volatile("" : "+v"(t)); return t; }

struct Params {
    const float* in[20];
    float* out;
    unsigned char* ws;
};
enum { I_X = 0, I_NORM_MIX, I_W_IN, I_Q_NORM, I_K_NORM, I_CONV_W, I_CONV_B, I_RG_W_A, I_RG_B_A, I_RG_W_X, I_RG_B_X, I_RG_LAMBDA,
       I_OUT_NORM_SB, I_OUT_NORM_RG, I_W_OUT, I_NORM_FFN, I_PEER_WQ, I_PEER_SUBK, I_PEER_U, I_PEER_V };

template <bool INPROJ_PERM>
__device__ __forceinline__ void prep_transpose_item(const float* W, const float* gain0, const float* gain1, int K, int N, bf16_t* WT, float* scr, int item, int lane) {
    const int nblk = N / 32, kb = item / nblk, nb = item % nblk, k0 = 64 * kb, n0 = 32 * nb;
#pragma unroll 8
    for (int i = 0; i < 32; ++i) {
        const int kk = 2 * i + (lane >> 5), k = k0 + kk;
        const float g = (gain1 && k >= 512) ? gain1[k - 512] : gain0[k];
        scr[kk * 33 + (lane & 31)] = g * W[(size_t)k * N + n0 + (lane & 31)];
    }
    asm volatile("s_waitcnt lgkmcnt(0)" ::: "memory");
    const int c = lane & 7;
#pragma unroll
    for (int j = 0; j < 4; ++j) {
        const int n = (lane >> 3) + 8 * j; const float* s = scr + (8 * c) * 33 + n;
        u32x4 o; o.x = pk2(s[0 * 33], s[1 * 33]); o.y = pk2(s[2 * 33], s[3 * 33]); o.z = pk2(s[4 * 33], s[5 * 33]); o.w = pk2(s[6 * 33], s[7 * 33]);
        const int nr = INPROJ_PERM ? inproj_phys_row(n0 + n) : n0 + n;
        *(u32x4*)(WT + (size_t)nr * K + k0 + 8 * c) = o;
    }
    asm volatile("s_waitcnt lgkmcnt(0)" ::: "memory");
}
__device__ __forceinline__ void ph_prep(const Params& p, unsigned char* lds) {
    const int tid_ = phase_tid();
    const int gtid = blockIdx.x * blockDim.x + tid_, gsize = gridDim.x * blockDim.x;
    const int lane = tid_ & 63, gwave = gtid >> 6, nwave = gsize >> 6;
    unsigned char* ws = p.ws;
    {
        float* scr = (float*)lds + (tid_ >> 6) * (64 * 33);
        constexpr int I_IN = (D / 64) * (NPROJ / 32), I_OUT = (D / 64) * (D / 32), I_Q = (D / 64) * (NQ / 32);
        for (int it = gwave; it < I_IN + I_OUT + I_Q; it += nwave) {
            if (it < I_IN) prep_transpose_item<true>(p.in[I_W_IN], p.in[I_NORM_MIX], nullptr, D, NPROJ, (bf16_t*)(ws + WS_WINT), scr, it, lane);
            else if (it < I_IN + I_OUT) prep_transpose_item<false>(p.in[I_W_OUT], p.in[I_OUT_NORM_SB], p.in[I_OUT_NORM_RG], D, D, (bf16_t*)(ws + WS_WOUTT), scr, it - I_IN, lane);
            else prep_transpose_item<false>(p.in[I_PEER_WQ], p.in[I_NORM_FFN], nullptr, D, NQ, (bf16_t*)(ws + WS_WQT), scr, it - I_IN - I_OUT, lane);
        }
    }
    {
        const float* wa = p.in[I_RG_W_A]; const float* wx = p.in[I_RG_W_X]; bf16_t* o = (bf16_t*)(ws + WS_RGW);
        for (int e = gtid; e < 8 * 2 * 2 * 4 * 64 * 8; e += gsize) {
            const int el = e & 7, ln = (e >> 3) & 63, s = (e >> 9) & 3, jt = (e >> 11) & 1, g = (e >> 12) & 1, n = e >> 13;
            const int j = 32 * jt + (ln & 31), i = 16 * s + 8 * (el >> 2) + 4 * (ln >> 5) + (el & 3);
            o[e] = (bf16_t)f2bf((g == 0 ? wa : wx)[((size_t)n * 64 + i) * 64 + j]);
        }
    }
    {
        const float* sk = p.in[I_PEER_SUBK]; bf16_t* o = (bf16_t*)(ws + WS_SUBK);
        for (int e = gtid; e < PH * 2 * PNK * PHALF; e += gsize) o[e] = (bf16_t)f2bf(sk[e]);
    }
    {
        const float* u = p.in[I_PEER_U]; const float* v = p.in[I_PEER_V]; const float* g = p.in[I_NORM_FFN];
        unsigned* ub = (unsigned*)(ws + WS_UB); unsigned* vb = (unsigned*)(ws + WS_VB); float* usc = (float*)(ws + WS_USC); float* vsc = (float*)(ws + WS_VSC);
        f32x4 gq[4];
#pragma unroll
        for (int j = 0; j < 4; ++j) gq[j] = *((const f32x4*)g + lane + 64 * j);
        for (int e = gwave; e < NEXP; e += nwave) {
            f32x4 a[4], b[4]; float ma = 0.f, mb = 0.f;
#pragma unroll
            for (int j = 0; j < 4; ++j) {
                a[j] = *((const f32x4*)(u + (size_t)e * D) + lane + 64 * j) * gq[j]; b[j] = *((const f32x4*)(v + (size_t)e * D) + lane + 64 * j);
                ma = fmaxf(ma, fmaxf(fmaxf(fabsf(a[j].x), fabsf(a[j].y)), fmaxf(fabsf(a[j].z), fabsf(a[j].w))));
                mb = fmaxf(mb, fmaxf(fmaxf(fabsf(b[j].x), fabsf(b[j].y)), fmaxf(fabsf(b[j].z), fabsf(b[j].w))));
            }
#pragma unroll
            for (int o = 1; o < 64; o <<= 1) { ma = fmaxf(ma, __shfl_xor(ma, o)); mb = fmaxf(mb, __shfl_xor(mb, o)); }
            const float sa = ma > 0.f ? 256.0f / ma : 1.0f, sb = mb > 0.f ? 256.0f / mb : 1.0f;
#pragma unroll
            for (int j = 0; j < 4; ++j) {
                int w = 0;
                w = __builtin_amdgcn_cvt_pk_fp8_f32(a[j].x * sa, a[j].y * sa, w, false); w = __builtin_amdgcn_cvt_pk_fp8_f32(a[j].z * sa, a[j].w * sa, w, true);
                ub[((size_t)(2 * j + (lane >> 5)) * NEXP + e) * 32 + (lane & 31)] = (unsigned)w;
                w = 0;
                w = __builtin_amdgcn_cvt_pk_fp8_f32(b[j].x * sb, b[j].y * sb, w, false); w = __builtin_amdgcn_cvt_pk_fp8_f32(b[j].z * sb, b[j].w * sb, w, true);
                vb[((size_t)(2 * j + (lane >> 5)) * NEXP + e) * 32 + (lane & 31)] = (unsigned)w;
            }
            if (lane == 0) { usc[e] = ma > 0.f ? ma * (1.0f / 256.0f) : 1.0f; vsc[e] = mb > 0.f ? mb * (1.0f / 256.0f) : 1.0f; }
        }
    }
    {
        const float* x = p.in[I_X]; bf16_t* xb = (bf16_t*)(ws + WS_A); float* rstd1 = (float*)(ws + WS_RSTD1);
        for (int row = gwave; row < S; row += nwave) {
            const f32x4* xr = (const f32x4*)(x + (size_t)row * D) + lane;
            uint2* o = (uint2*)(xb + (size_t)row * D) + lane;
            float ss = 0.f;
#pragma unroll
            for (int j = 0; j < 4; ++j) {
                const f32x4 v = xr[64 * j];
                ss += v.x * v.x + v.y * v.y + v.z * v.z + v.w * v.w;
                o[64 * j] = make_uint2(pk2(v.x, v.y), pk2(v.z, v.w));
            }
            ss = wave_sum(ss);
            if (lane == 0) rstd1[row] = rsqrtf(ss * (1.0f / D) + EPS);
        }
    }
}

namespace pg8 {
#define PG8_LAS __attribute__((address_space(3)))
typedef unsigned short bf16_t;
typedef short bf16x8 __attribute__((ext_vector_type(8)));
typedef float f32x4 __attribute__((ext_vector_type(4)));
typedef unsigned u32x4 __attribute__((ext_vector_type(4)));
constexpr int BM = 256, BK = 64, HALF = 128, HTB = HALF * BK * 2  , STAGE_BYTES = 8 * HTB, NXCD = 8, WGM = 8;

__host__ __device__ __forceinline__ int lds_byte(int r, int c) { const int st = (r >> 4) * 2 + (c >> 5), rr = r & 15, cc = c & 31, ob = rr * 64 + cc * 2; return st * 1024 + (ob ^ (((ob >> 9) & 1) << 5)); }
__host__ __device__ __forceinline__ void stage_rc(int b, int& R, int& C) { const int st = b / 1024, sb = b % 1024, swz = sb ^ (((sb >> 9) & 1) << 5); R = (st >> 1) * 16 + swz / 64; C = (st & 1) * 32 + (swz % 64) / 2; }
__host__ __device__ __forceinline__ int perm32(int rho) { const int n = rho >> 4, i = rho & 15; return 8 * (i >> 2) + 4 * n + (i & 3); }

struct Unit { int pm, pn; };
struct Gemm { const bf16_t* A; const bf16_t* Bt; int M, N, K; };

struct StaticOrder {
    int nM, nN, nwg, G, c;
    __host__ __device__ void init(int M, int N, int G_, int c_) { nM = M / BM; nN = N / BM; nwg = nM * nN; G = G_; c = c_; }
    __host__ __device__ bool next(int i, Unit& u) const {
        const long L = (long)i * G + c; if (L >= nwg) return false;
        int wgid = (int)L; { const int q = nwg / NXCD, r = nwg % NXCD, xcd = wgid % NXCD, off = wgid / NXCD; wgid = (xcd < r ? xcd * (q + 1) : r * (q + 1) + (xcd - r) * q) + off; }
        const int nig = WGM * nN, gid = wgid / nig, fm = gid * WGM, gsz = (nM - fm) < WGM ? (nM - fm) : WGM;
        u.pm = fm + ((wgid % nig) % gsz); u.pn = (wgid % nig) / gsz; return true;
    }
    __device__ __forceinline__ void a_ready(const Unit&) const {}
    __device__ __forceinline__ void done(const Unit&) const {}
};

__device__ __forceinline__ unsigned cvt_pk_bf16(float lo, float hi) { unsigned r; asm volatile("v_cvt_pk_bf16_f32 %0, %1, %2" : "=v"(r) : "v"(lo), "v"(hi)); return r; }
template <class Epi, class Sched, bool ALIGN_EPI = false, bool SP2 = false>
__device__ __forceinline__ void gemm_phase(PG8_LAS unsigned char* lds, const Gemm g, const Sched& S, const Epi& E) {
    const int tid = phase_tid(), wid = __builtin_amdgcn_readfirstlane(tid >> 6), lane = tid & 63, wr = wid >> 2, wc = wid & 3, fr = lane & 15, fq = lane >> 4;
    const int K = g.K, nt = K / BK;
    unsigned voffA[2], voffB[2];
#pragma unroll
    for (int i = 0; i < 2; ++i) { int R, C; stage_rc(tid * 16 + i * 8192, R, C); const int Rb = Epi::PERM ? ((R & ~31) + perm32(R & 31)) : R;
        voffA[i] = (unsigned)(R * K + C) * 2u; voffB[i] = (unsigned)(Rb * K + C) * 2u; }
    const size_t kstep = (size_t)(BK * 2);
    const size_t hstep = (size_t)HALF * K * 2;
    const size_t tstep = 2 * hstep;
    const unsigned ldsw = (unsigned)wid * 1024u;
    const int aoff = lds_byte(wr * 64 + fr, fq * 8), boff = lds_byte(wc * 32 + fr, fq * 8);
#define PG8_SA(b, h) (((b) * 2 + (h)) * HTB)
#define PG8_SB(b, h) ((4 + (b) * 2 + (h)) * HTB)
#define PG8_STAGE(bufoff, gbase, voff) do { _Pragma("unroll") for (int _i = 0; _i < 2; ++_i) \
        __builtin_amdgcn_global_load_lds((const unsigned*)((const char*)(gbase) + (voff)[_i]), (PG8_LAS unsigned*)(lds + (bufoff) + ldsw + _i * 8192), 16, 0, 0); } while (0)
#define PG8_LDA(dst, b, h) do { _Pragma("unroll") for (int m = 0; m < 4; ++m) _Pragma("unroll") for (int k = 0; k < 2; ++k) dst[m][k] = *(const PG8_LAS bf16x8*)(lds + PG8_SA(b, h) + aoff + m * 2048 + k * 1024); } while (0)
#define PG8_LDB(dst, b, h) do { _Pragma("unroll") for (int n = 0; n < 2; ++n) _Pragma("unroll") for (int k = 0; k < 2; ++k) dst[n][k] = *(const PG8_LAS bf16x8*)(lds + PG8_SB(b, h) + boff + n * 2048 + k * 1024); } while (0)
#define PG8_MMA(ai, bj, At, Bt) do { __builtin_amdgcn_s_setprio(1); _Pragma("unroll") for (int m = 0; m < 4; ++m) _Pragma("unroll") for (int n = 0; n < 2; ++n) _Pragma("unroll") for (int k = 0; k < 2; ++k) \
        acc[ai][bj][m][n] = __builtin_amdgcn_mfma_f32_16x16x32_bf16(Bt[n][k], At[m][k], acc[ai][bj][m][n], 0, 0, 0); __builtin_amdgcn_s_setprio(0); } while (0)
#define PG8_WAIT_V(n) asm volatile("s_waitcnt vmcnt(" #n ")" ::: "memory")
#define PG8_WAIT_L(n) asm volatile("s_waitcnt lgkmcnt(" #n ")" ::: "memory")
#define PG8_BAR __builtin_amdgcn_s_barrier()
#define PG8_SCHED __builtin_amdgcn_sched_barrier(0)
    Unit cur, nxt; int ui = 0;
    if (!S.next(0, cur)) return;
    f32x4 acc[2][2][4][2];
#pragma unroll
    for (int a = 0; a < 2; ++a)
#pragma unroll
        for (int b = 0; b < 2; ++b)
#pragma unroll
            for (int m = 0; m < 4; ++m)
#pragma unroll
                for (int n = 0; n < 2; ++n) acc[a][b][m][n] = (f32x4){0.f, 0.f, 0.f, 0.f};
    bf16x8 At[4][2], B0[2][2], B1[2][2];
    const char* cA = (const char*)g.A + (size_t)cur.pm * tstep; const char* cB = (const char*)g.Bt + (size_t)cur.pn * tstep;
    S.a_ready(cur);
    if constexpr (SP2) {
        PG8_STAGE(PG8_SB(0, 0), cB, voffB); PG8_STAGE(PG8_SB(0, 1), cB + hstep, voffB); PG8_STAGE(PG8_SA(0, 0), cA, voffA); PG8_STAGE(PG8_SA(0, 1), cA + hstep, voffA);
        if (wr == 1) PG8_BAR;
        PG8_WAIT_V(2); PG8_BAR;
        PG8_STAGE(PG8_SB(1, 0), cB + kstep, voffB); PG8_STAGE(PG8_SA(1, 0), cA + kstep, voffA); PG8_STAGE(PG8_SB(1, 1), cB + hstep + kstep, voffB);
        PG8_WAIT_V(6); PG8_BAR;
    } else {
        PG8_STAGE(PG8_SB(0, 0), cB, voffB); PG8_STAGE(PG8_SA(0, 0), cA, voffA); PG8_STAGE(PG8_SB(0, 1), cB + hstep, voffB); PG8_STAGE(PG8_SA(0, 1), cA + hstep, voffA);
        if (wr == 1) PG8_BAR;
        PG8_WAIT_V(4); PG8_BAR;
        PG8_STAGE(PG8_SB(1, 0), cB + kstep, voffB); PG8_STAGE(PG8_SA(1, 0), cA + kstep, voffA); PG8_STAGE(PG8_SB(1, 1), cB + hstep + kstep, voffB);
        PG8_WAIT_V(6); PG8_BAR;
    }
    for (;;) {
        const bool has_next = S.next(ui + 1, nxt);
        const char* nA = has_next ? (const char*)g.A + (size_t)nxt.pm * tstep : cA; const char* nB = has_next ? (const char*)g.Bt + (size_t)nxt.pn * tstep : cB;
        for (int t = 0; t < nt; t += 2) {
            const bool last = (t == nt - 2);
            const char* a1 = cA + (size_t)(t + 1) * kstep;
            const char* a2 = last ? nA : cA + (size_t)(t + 2) * kstep; const char* b2 = last ? nB : cB + (size_t)(t + 2) * kstep;
            const char* a3 = a2 + kstep; const char* b3 = b2 + kstep;
            if (last && has_next) S.a_ready(nxt);
            if constexpr (SP2) {
            PG8_LDB(B0, 0, 0); PG8_LDB(B1, 0, 1); PG8_SCHED; PG8_LDA(At, 0, 0); PG8_STAGE(PG8_SA(1, 1), a1 + hstep, voffA);
            PG8_WAIT_V(8); PG8_WAIT_L(0); PG8_BAR; PG8_MMA(0, 0, At, B0); PG8_MMA(0, 1, At, B1); PG8_BAR; PG8_SCHED;
            PG8_LDA(At, 0, 1); PG8_STAGE(PG8_SB(0, 0), b2, voffB); PG8_STAGE(PG8_SB(0, 1), b2 + hstep, voffB); PG8_STAGE(PG8_SA(0, 0), a2, voffA);
            PG8_WAIT_V(8); PG8_WAIT_L(0); PG8_BAR; PG8_MMA(1, 0, At, B0); PG8_MMA(1, 1, At, B1); PG8_BAR; PG8_SCHED;
            PG8_LDB(B0, 1, 0); PG8_LDB(B1, 1, 1); PG8_SCHED; PG8_LDA(At, 1, 0); PG8_STAGE(PG8_SA(0, 1), a2 + hstep, voffA);
            PG8_WAIT_V(8); PG8_WAIT_L(0); PG8_BAR; PG8_MMA(0, 0, At, B0); PG8_MMA(0, 1, At, B1); PG8_BAR; PG8_SCHED;
            PG8_LDA(At, 1, 1); PG8_STAGE(PG8_SB(1, 0), b3, voffB); PG8_STAGE(PG8_SB(1, 1), b3 + hstep, voffB); PG8_STAGE(PG8_SA(1, 0), a3, voffA);
            PG8_WAIT_V(8); PG8_WAIT_L(0); PG8_BAR; PG8_MMA(1, 0, At, B0); PG8_MMA(1, 1, At, B1); PG8_BAR; PG8_SCHED;
            } else {
            PG8_LDB(B0, 0, 0); PG8_SCHED; PG8_LDA(At, 0, 0); PG8_STAGE(PG8_SA(1, 1), a1 + hstep, voffA);
            PG8_WAIT_L(8); PG8_BAR; PG8_WAIT_L(0); PG8_MMA(0, 0, At, B0); PG8_BAR; PG8_SCHED;
            PG8_LDB(B1, 0, 1); PG8_STAGE(PG8_SB(0, 0), b2, voffB);
            PG8_BAR; PG8_WAIT_L(0); PG8_MMA(0, 1, At, B1); PG8_BAR;
            PG8_LDA(At, 0, 1); PG8_STAGE(PG8_SA(0, 0), a2, voffA);
            PG8_BAR; PG8_WAIT_L(0); PG8_MMA(1, 0, At, B0); PG8_BAR; PG8_SCHED;
            PG8_STAGE(PG8_SB(0, 1), b2 + hstep, voffB);
            PG8_WAIT_V(6); PG8_BAR; PG8_MMA(1, 1, At, B1); PG8_BAR;
            PG8_LDB(B0, 1, 0); PG8_SCHED; PG8_LDA(At, 1, 0); PG8_STAGE(PG8_SA(0, 1), a2 + hstep, voffA);
            PG8_WAIT_L(8); PG8_BAR; PG8_WAIT_L(0); PG8_MMA(0, 0, At, B0); PG8_BAR; PG8_SCHED;
            PG8_LDB(B1, 1, 1); PG8_STAGE(PG8_SB(1, 0), b3, voffB);
            PG8_BAR; PG8_WAIT_L(0); PG8_MMA(0, 1, At, B1); PG8_BAR;
            PG8_LDA(At, 1, 1); PG8_STAGE(PG8_SA(1, 0), a3, voffA);
            PG8_BAR; PG8_WAIT_L(0); PG8_MMA(1, 0, At, B0); PG8_BAR; PG8_SCHED;
            PG8_STAGE(PG8_SB(1, 1), b3 + hstep, voffB);
            PG8_WAIT_V(6); PG8_BAR; PG8_MMA(1, 1, At, B1); PG8_BAR;
            }
        }
        if constexpr (ALIGN_EPI) { if (wr == 0) PG8_BAR; }
        if constexpr (!Epi::AFTER_DRAIN) { E(acc, cur, wr, wc, fr, fq); S.done(cur); }
        if (!has_next) break;
#pragma unroll
        for (int a = 0; a < 2; ++a)
#pragma unroll
            for (int b = 0; b < 2; ++b)
#pragma unroll
                for (int m = 0; m < 4; ++m)
#pragma unroll
                    for (int n = 0; n < 2; ++n) acc[a][b][m][n] = (f32x4){0.f, 0.f, 0.f, 0.f};
        cur = nxt; cA = nA; cB = nB; ++ui;
        if constexpr (ALIGN_EPI) { if (wr == 1) PG8_BAR; }
    }
    PG8_WAIT_V(0);
    if constexpr (!ALIGN_EPI) { if (wr == 0) PG8_BAR; }
    PG8_BAR;
    if constexpr (Epi::AFTER_DRAIN) { E.fused(acc, cur, wr, wc, fr, fq, lds, wid, lane); S.done(cur); }
#undef PG8_SA
#undef PG8_SB
#undef PG8_STAGE
#undef PG8_LDA
#undef PG8_LDB
#undef PG8_MMA
#undef PG8_WAIT_V
#undef PG8_WAIT_L
#undef PG8_BAR
#undef PG8_SCHED
}
}

struct EpiInProj {
    static constexpr bool PERM = true, AFTER_DRAIN = false;
    const float* rstd1; const float* qn; const float* kn; bf16_t *qh, *kh, *vh, *xrg, *gg;
    __device__ __forceinline__ void operator()(const pg8::f32x4 (&acc)[2][2][4][2], const pg8::Unit& u, int wr, int wc, int fr, int fq) const {
        const int region = u.pn >> 1;
        const int head = (u.pn & 1) * 4 + wc;
        pg8::f32x4 gn[2][2];
        if (region <= 1) {
            const float* g = region == 0 ? qn : kn; const float sc = region == 0 ? QSCALE : 1.0f;
#pragma unroll
            for (int bj = 0; bj < 2; ++bj)
#pragma unroll
                for (int n = 0; n < 2; ++n) gn[bj][n] = *(const pg8::f32x4*)(g + 32 * bj + 8 * fq + 4 * n) * sc;
        }
#pragma unroll
        for (int ai = 0; ai < 2; ++ai)
#pragma unroll
            for (int m = 0; m < 4; ++m) {
                const int row = u.pm * 256 + ai * 128 + wr * 64 + m * 16 + fr;
                const float rs = rstd1[row];
                pg8::f32x4 v[2][2];
#pragma unroll
                for (int bj = 0; bj < 2; ++bj)
#pragma unroll
                    for (int n = 0; n < 2; ++n) v[bj][n] = acc[ai][bj][m][n] * rs;
                bf16_t* dst;
                if (region <= 1) {
                    float ss = 0.f;
#pragma unroll
                    for (int bj = 0; bj < 2; ++bj)
#pragma unroll
                        for (int n = 0; n < 2; ++n) ss += (v[bj][n][0] * v[bj][n][0] + v[bj][n][1] * v[bj][n][1]) + (v[bj][n][2] * v[bj][n][2] + v[bj][n][3] * v[bj][n][3]);
                    ss += __shfl_xor(ss, 16); ss += __shfl_xor(ss, 32);
                    const float rn = rsqrtf(ss * (1.0f / HD) + EPS);
#pragma unroll
                    for (int bj = 0; bj < 2; ++bj)
#pragma unroll
                        for (int n = 0; n < 2; ++n) v[bj][n] = v[bj][n] * rn * gn[bj][n];
                    dst = (region == 0 ? qh : kh) + ((size_t)head * S + row) * HD;
                } else if (region == 2) {
#pragma unroll
                    for (int bj = 0; bj < 2; ++bj)
#pragma unroll
                        for (int n = 0; n < 2; ++n)
#pragma unroll
                            for (int i = 0; i < 4; ++i) vh[((size_t)head * HD + 32 * bj + 8 * fq + 4 * n + i) * S + row] = (bf16_t)f2bf(v[bj][n][i]);
                    continue;
                } else if (region == 3) {
                    dst = xrg + (size_t)row * DRG + head * 64;
                } else {
#pragma unroll
                    for (int bj = 0; bj < 2; ++bj)
#pragma unroll
                        for (int n = 0; n < 2; ++n)
#pragma unroll
                            for (int i = 0; i < 4; ++i) v[bj][n][i] = gelu_tanh(v[bj][n][i]);
                    dst = gg + (size_t)row * DRG + head * 64;
                }
#pragma unroll
                for (int bj = 0; bj < 2; ++bj) {
                    pg8::u32x4 w; w.x = pg8::cvt_pk_bf16(v[bj][0][0], v[bj][0][1]); w.y = pg8::cvt_pk_bf16(v[bj][0][2], v[bj][0][3]);
                    w.z = pg8::cvt_pk_bf16(v[bj][1][0], v[bj][1][1]); w.w = pg8::cvt_pk_bf16(v[bj][1][2], v[bj][1][3]);
                    *(pg8::u32x4*)(dst + 32 * bj + 8 * fq) = w;
                }
            }
    }
};
struct EpiOutProj {
    static constexpr bool PERM = true, AFTER_DRAIN = false;
    const float* x; float* out; bf16_t* x1b; float* ssq;
    __device__ __forceinline__ void operator()(const pg8::f32x4 (&acc)[2][2][4][2], const pg8::Unit& u, int wr, int wc, int fr, int fq) const {
#pragma unroll
        for (int ai = 0; ai < 2; ++ai)
#pragma unroll
            for (int m = 0; m < 4; ++m) {
                const int row = u.pm * 256 + ai * 128 + wr * 64 + m * 16 + fr;
                float ss = 0.f;
#pragma unroll
                for (int bj = 0; bj < 2; ++bj) {
                    const size_t o = (size_t)row * D + u.pn * 256 + bj * 128 + wc * 32 + 8 * fq;
                    const pg8::f32x4 a = *(const pg8::f32x4*)(x + o) + acc[ai][bj][m][0], b = *(const pg8::f32x4*)(x + o + 4) + acc[ai][bj][m][1];
                    *(pg8::f32x4*)(out + o) = a; *(pg8::f32x4*)(out + o + 4) = b;
                    ss += (a[0] * a[0] + a[1] * a[1]) + (a[2] * a[2] + a[3] * a[3]) + (b[0] * b[0] + b[1] * b[1]) + (b[2] * b[2] + b[3] * b[3]);
                    pg8::u32x4 w; w.x = pg8::cvt_pk_bf16(a[0], a[1]); w.y = pg8::cvt_pk_bf16(a[2], a[3]); w.z = pg8::cvt_pk_bf16(b[0], b[1]); w.w = pg8::cvt_pk_bf16(b[2], b[3]);
                    *(pg8::u32x4*)(x1b + o) = w;
                }
                ss += __shfl_xor(ss, 16); ss += __shfl_xor(ss, 32);
                if (fq == 0) ssq[(size_t)row * 16 + u.pn * 4 + wc] = ss;
            }
    }
};
struct EpiPeerQ {
    static constexpr bool PERM = true, AFTER_DRAIN = false;
    bf16_t* qp;
    __device__ __forceinline__ void operator()(const pg8::f32x4 (&acc)[2][2][4][2], const pg8::Unit& u, int wr, int wc, int fr, int fq) const {
#pragma unroll
        for (int ai = 0; ai < 2; ++ai)
#pragma unroll
            for (int m = 0; m < 4; ++m) {
                const int row = u.pm * 256 + ai * 128 + wr * 64 + m * 16 + fr;
#pragma unroll
                for (int bj = 0; bj < 2; ++bj) {
                    const pg8::f32x4 a = acc[ai][bj][m][0], b = acc[ai][bj][m][1];
                    pg8::u32x4 w; w.x = pg8::cvt_pk_bf16(a[0], a[1]); w.y = pg8::cvt_pk_bf16(a[2], a[3]); w.z = pg8::cvt_pk_bf16(b[0], b[1]); w.w = pg8::cvt_pk_bf16(b[2], b[3]);
                    *(pg8::u32x4*)(qp + (size_t)row * NQ + u.pn * 256 + bj * 128 + wc * 32 + 8 * fq) = w;
                }
            }
    }
};

typedef float f32x2v __attribute__((ext_vector_type(2)));
typedef __bf16 bf16x2v __attribute__((ext_vector_type(2)));
__device__ __forceinline__ unsigned cvtpk(float lo, float hi) { const f32x2v v = {lo, hi}; const bf16x2v b = __builtin_convertvector(v, bf16x2v); return __builtin_bit_cast(unsigned, b); }
__device__ __forceinline__ bf16x8 pack_step(const f32x16& x, int s) {
    u32x4 pkd; pkd.x = cvtpk(x[8 * s], x[8 * s + 1]); pkd.y = cvtpk(x[8 * s + 2], x[8 * s + 3]); pkd.z = cvtpk(x[8 * s + 4], x[8 * s + 5]); pkd.w = cvtpk(x[8 * s + 6], x[8 * s + 7]);
    return __builtin_bit_cast(bf16x8, pkd);
}
#define MFMA32(a, b, c) __builtin_amdgcn_mfma_f32_32x32x16_bf16((a), (b), (c), 0, 0, 0)
__device__ __forceinline__ void ph_attn(const Params& p) {
    unsigned char* ws = p.ws;
    const bf16_t* qh = (const bf16_t*)(ws + WS_QH); const bf16_t* kh = (const bf16_t*)(ws + WS_KH); const bf16_t* vT = (const bf16_t*)(ws + WS_VH);
    bf16_t* osb = (bf16_t*)(ws + WS_OSB);
    const int tid = phase_tid(), lane = tid & 63, r = lane & 31, hh = lane >> 5;
    const int gwave = (blockIdx.x * blockDim.x + tid) >> 6, nwave = (gridDim.x * blockDim.x) >> 6;
    bf16x8 tp[2];
#pragma unroll
    for (int ss = 0; ss < 2; ++ss)
#pragma unroll
        for (int e = 0; e < 8; ++e) { const int k = 16 * ss + 8 * (e >> 2) + 4 * hh + (e & 3); tp[ss][e] = (k > r) ? (short)0x3F80 : (short)0; }
    f32x16 zero16;
#pragma unroll
    for (int i = 0; i < 16; ++i) zero16[i] = 0.f;
    for (int u = gwave; u < NH * (S / 32); u += nwave) {
        const int h = u / (S / 32), t0 = (u % (S / 32)) * 32;
        bf16x8 bq[4];
#pragma unroll
        for (int s = 0; s < 4; ++s) bq[s] = *(const bf16x8*)(qh + ((size_t)h * S + t0 + r) * HD + 16 * s + 8 * hh);
        f32x16 ot[2] = {zero16, zero16};
        float carry = 0.f;
        for (int kt0 = t0; kt0 >= 0; kt0 -= 32) {
            bf16x8 ak[4], av[2][2];
#pragma unroll
            for (int s = 0; s < 4; ++s) ak[s] = *(const bf16x8*)(kh + ((size_t)h * S + kt0 + r) * HD + 16 * s + 8 * hh);
#pragma unroll
            for (int dt = 0; dt < 2; ++dt)
#pragma unroll
                for (int ss = 0; ss < 2; ++ss) {
                    const bf16_t* vp = vT + ((size_t)h * HD + 32 * dt + r) * S + kt0 + 16 * ss + 4 * hh;
                    const uint2 lo = *(const uint2*)vp, hi = *(const uint2*)(vp + 8);
                    u32x4 w4; w4.x = lo.x; w4.y = lo.y; w4.z = hi.x; w4.w = hi.y;
                    av[dt][ss] = __builtin_bit_cast(bf16x8, w4);
                }
            f32x16 st = zero16;
#pragma unroll
            for (int s = 0; s < 4; ++s) st = MFMA32(ak[s], bq[s], st);
            const bool diag = (kt0 == t0);
            f32x16 lom, lb;
            float csum = 0.f;
#pragma unroll
            for (int i = 0; i < 16; ++i) {
                const float z = st[i];
                const float sp2 = fmaxf(z, 0.f) + __builtin_amdgcn_logf(1.0f + __builtin_amdgcn_exp2f(-fabsf(z)));
                const bool valid = !diag || ((i & 3) + 8 * (i >> 2) + 4 * hh < r);
                lom[i] = valid ? -sp2 : 0.f;
                lb[i] = z - sp2;
                csum += lom[i];
            }
            f32x16 suf = MFMA32(tp[0], pack_step(lom, 0), zero16);
            suf = MFMA32(tp[1], pack_step(lom, 1), suf);
            f32x16 w;
#pragma unroll
            for (int i = 0; i < 16; ++i) {
                const bool valid = !diag || ((i & 3) + 8 * (i >> 2) + 4 * hh < r);
                w[i] = valid ? __builtin_amdgcn_exp2f(lb[i] + suf[i] + carry) : 0.f;
            }
            const bf16x8 w0 = pack_step(w, 0), w1 = pack_step(w, 1);
#pragma unroll
            for (int dt = 0; dt < 2; ++dt) { ot[dt] = MFMA32(av[dt][0], w0, ot[dt]); ot[dt] = MFMA32(av[dt][1], w1, ot[dt]); }
            carry += csum + __shfl_xor(csum, 32);
            if (__all(carry < CARRY_STOP)) break;
        }
#pragma unroll
        for (int dt = 0; dt < 2; ++dt)
#pragma unroll
            for (int g = 0; g < 4; ++g) {
                uint2 o; o.x = cvtpk(ot[dt][4 * g], ot[dt][4 * g + 1]); o.y = cvtpk(ot[dt][4 * g + 2], ot[dt][4 * g + 3]);
                *(uint2*)(osb + (size_t)(t0 + r) * DSB + h * HD + 32 * dt + 8 * g + 4 * hh) = o;
            }
    }
}

constexpr int RG_LDS_CST = 0, RG_LDS_HIN = 16384, RG_LDS_P = 18432, RG_LDS_SSQ = 20480;
constexpr int RG_LDS_X = 22528, RG_XP = 1032, RG_LDS_O = 91904;
typedef unsigned u32x2 __attribute__((ext_vector_type(2)));
typedef __attribute__((address_space(3))) float lds_f;
typedef __attribute__((address_space(3))) unsigned char lds_b;
template <int CTRL, int ROWMASK>
__device__ __forceinline__ float dpp_mov(float oob, float x) {
    return __builtin_bit_cast(float, __builtin_amdgcn_update_dpp(__builtin_bit_cast(int, oob), __builtin_bit_cast(int, x), CTRL, ROWMASK, 0xf, false));
}
template <int CTRL, int ROWMASK>
__device__ __forceinline__ void scan_step(float (&av)[16], float (&bv)[16]) {
#pragma unroll
    for (int i = 0; i < 16; ++i) {
        const float ap = dpp_mov<CTRL, ROWMASK>(1.0f, av[i]), bp = dpp_mov<CTRL, ROWMASK>(0.0f, bv[i]);
        bv[i] = __builtin_fmaf(av[i], bp, bv[i]); av[i] *= ap;
    }
}
template <int PASS>
__device__ __forceinline__ void ph_rg(const Params& p, unsigned char* lds_raw) {
    float* lds = (float*)lds_raw;
    unsigned char* ws = p.ws;
    const bf16_t* xrg = (const bf16_t*)(ws + WS_XRG); const bf16_t* gg = (const bf16_t*)(ws + WS_GG); const bf16_t* wfrag = (const bf16_t*)(ws + WS_RGW);
    const bf16_t* osb = (const bf16_t*)(ws + WS_OSB); bf16_t* mix = (bf16_t*)(ws + WS_MIX);
    float* rgP = (float*)(ws + WS_RGP); float* rgH = (float*)(ws + WS_RGH);
    const int tid = phase_tid(), lane = tid & 63, r = lane & 31, hh = lane >> 5, n = __builtin_amdgcn_readfirstlane(tid >> 6);
    __syncthreads();
    for (int e = tid; e < 8 * 2 * 8 * 32; e += NTHR) {
        const int q = e & 31, k = (e >> 5) & 7, h2 = (e >> 8) & 1, nn = e >> 9;
        const int c = 64 * nn + 32 * (q >> 4) + (q & 3) + 8 * ((q >> 2) & 3) + 4 * h2;
        float v;
        if (k < 4) v = p.in[I_CONV_W][k * DRG + c];
        else if (k == 4) v = p.in[I_CONV_B][c];
        else if (k == 5) v = p.in[I_RG_B_A][c];
        else if (k == 6) v = p.in[I_RG_B_X][c];
        else v = 8.0f * LOG2E * log1pf(__expf(-p.in[I_RG_LAMBDA][c]));
        lds[e] = v;
    }
    const unsigned lds0 = (unsigned)(size_t)((lds_b*)lds_raw);
    const unsigned cst_base = lds0 + (unsigned)((n * 2 + hh) * 1024);
    lds_f* hin_l = (lds_f*)(size_t)(lds0 + RG_LDS_HIN + (n * 2 + hh) * 128);
    lds_f* pc_l = (lds_f*)(size_t)(lds0 + RG_LDS_P + (n * 2 + hh) * 128);
    lds_b* xt = (lds_b*)(size_t)(lds0 + RG_LDS_X);
    lds_b* ot = (lds_b*)(size_t)(lds0 + RG_LDS_O);
    f32x16 zero16;
#pragma unroll
    for (int i = 0; i < 16; ++i) zero16[i] = 0.f;
    for (int ch = blockIdx.x; ch < NCHUNK; ch += gridDim.x) {
        const int t0 = ch * CHUNK;
        __syncthreads();
        for (int ci = tid; ci < (CHUNK + 3) * 64; ci += NTHR) {
            const int row = ci >> 6, c16 = ci & 63, tt = t0 - 3 + row;
            u32x4 v = {0u, 0u, 0u, 0u};
            if (tt >= 0) v = *(const u32x4*)(xrg + (size_t)tt * DRG + 8 * c16);
            __attribute__((address_space(3))) u32x2* d = (__attribute__((address_space(3))) u32x2*)(xt + row * RG_XP + 16 * c16);
            d[0] = (u32x2){v.x, v.y}; d[1] = (u32x2){v.z, v.w};
        }
        if (PASS == 1) {
            const int c = 64 * n + lane;
            float h = 0.f;
            int k = 0;
            for (; k + 16 <= ch; k += 16) {
                float pv[16], hv[16];
#pragma unroll
                for (int j = 0; j < 16; ++j) { pv[j] = rgP[(k + j) * DRG + c]; hv[j] = rgH[(k + j) * DRG + c]; }
#pragma unroll
                for (int j = 0; j < 16; ++j) h = pv[j] * h + hv[j];
            }
            for (; k < ch; ++k) h = rgP[k * DRG + c] * h + rgH[k * DRG + c];
            lds[RG_LDS_HIN / 4 + (n * 2 + ((lane >> 2) & 1)) * 32 + 16 * (lane >> 5) + 4 * ((lane >> 3) & 3) + (lane & 3)] = h;
        } else {
            if (r == 0) {
#pragma unroll
                for (int q = 0; q < 32; ++q) { hin_l[q] = 0.f; pc_l[q] = 1.f; }
            }
        }
        __syncthreads();
#pragma unroll 1
        for (int tl = 0; tl < 2; ++tl) {
            const int tok = t0 + 32 * tl + r;
            unsigned cst_a = cst_base; asm volatile("" : "+v"(cst_a));
            const lds_f* cst = (const lds_f*)(size_t)cst_a;
            float xcv[32];
#pragma unroll
            for (int q = 0; q < 32; ++q) xcv[q] = cst[4 * 32 + q];
#pragma unroll
            for (int k = 0; k < 4; ++k) {
                const lds_b* xr = xt + (32 * tl + r + k) * RG_XP + (64 * n + 4 * hh) * 2;
#pragma unroll
                for (int m = 0; m < 8; ++m) {
                    const u32x2 xw = *(const __attribute__((address_space(3))) u32x2*)(xr + 16 * m);
                    xcv[4 * m + 0] += cst[k * 32 + 4 * m + 0] * bf2f(xw.x & 0xffffu); xcv[4 * m + 1] += cst[k * 32 + 4 * m + 1] * bf2f(xw.x >> 16);
                    xcv[4 * m + 2] += cst[k * 32 + 4 * m + 2] * bf2f(xw.y & 0xffffu); xcv[4 * m + 3] += cst[k * 32 + 4 * m + 3] * bf2f(xw.y >> 16);
                }
                __builtin_amdgcn_sched_barrier(0);
            }
            bf16x8 bx[4];
#pragma unroll
            for (int s = 0; s < 4; ++s) {
                u32x4 pk; pk.x = cvtpk(xcv[8 * s], xcv[8 * s + 1]); pk.y = cvtpk(xcv[8 * s + 2], xcv[8 * s + 3]); pk.z = cvtpk(xcv[8 * s + 4], xcv[8 * s + 5]); pk.w = cvtpk(xcv[8 * s + 6], xcv[8 * s + 7]);
                bx[s] = __builtin_bit_cast(bf16x8, pk);
            }
            float ss = 0.f;
            const bf16_t* wb = wfrag + ((size_t)n * 16 * 64 + lane) * 8; asm volatile("" : "+v"(wb));
#pragma unroll
            for (int jt = 0; jt < 2; ++jt) {
                float av[16], bv[16];
#pragma unroll
                for (int g = 0; g < 2; ++g) {
                    f32x16 acc = zero16;
#pragma unroll
                    for (int s = 0; s < 4; ++s) {
                        const bf16x8 aw = *(const __attribute__((address_space(1))) bf16x8*)(wb + (((g * 2 + jt) * 4 + s) * 64) * 8);
                        acc = MFMA32(aw, bx[s], acc);
                    }
#pragma unroll
                    for (int i = 0; i < 16; ++i) {
                        const int q = 16 * jt + i;
                        const float pre = acc[i] + cst[(5 + g) * 32 + q];
                        const float sg = 1.0f / (1.0f + __builtin_amdgcn_exp2f(-LOG2E * pre));
                        if (g == 0) av[i] = __builtin_amdgcn_exp2f(-sg * cst[7 * 32 + q]);
                        else bv[i] = __builtin_amdgcn_sqrtf(fmaxf(__builtin_fmaf(-av[i], av[i], 1.0f), 0.f)) * (sg * xcv[q]);
                    }
                    __builtin_amdgcn_sched_barrier(0);
                }
                scan_step<0x111, 0xf>(av, bv); scan_step<0x112, 0xf>(av, bv); scan_step<0x114, 0xf>(av, bv); scan_step<0x118, 0xf>(av, bv);
                scan_step<0x142, 0xa>(av, bv);
                __builtin_amdgcn_sched_barrier(0);
#pragma unroll
                for (int i = 0; i < 16; ++i) {
                    const int q = 16 * jt + i;
                    const float h = __builtin_fmaf(av[i], hin_l[q], bv[i]);
                    if (r == 31) { hin_l[q] = h; if (PASS == 0) pc_l[q] *= av[i]; }
                    bv[i] = h;
                }
                if (PASS == 1) {
#pragma unroll
                    for (int g4 = 0; g4 < 4; ++g4) {
                        const int m = 4 * jt + g4;
                        const uint2 gw = *(const uint2*)(gg + (size_t)tok * DRG + 64 * n + 8 * m + 4 * hh);
                        const float o0 = bv[4 * g4] * bf2f(gw.x & 0xffffu), o1 = bv[4 * g4 + 1] * bf2f(gw.x >> 16), o2 = bv[4 * g4 + 2] * bf2f(gw.y & 0xffffu), o3 = bv[4 * g4 + 3] * bf2f(gw.y >> 16);
                        ss += (o0 * o0 + o1 * o1) + (o2 * o2 + o3 * o3);
                        *(__attribute__((address_space(3))) u32x2*)(ot + (32 * tl + r) * RG_XP + (64 * n + 8 * m + 4 * hh) * 2) = (u32x2){cvtpk(o0, o1), cvtpk(o2, o3)};
                    }
                }
                __builtin_amdgcn_sched_barrier(0);
            }
            if (PASS == 1) { ss += __shfl_xor(ss, 32); if (hh == 0) lds[RG_LDS_SSQ / 4 + (tl * 8 + n) * 32 + r] = ss; }
        }
        if (PASS == 0) {
            if (r == 0) {
#pragma unroll
                for (int m = 0; m < 8; ++m) {
                    const int c = 64 * n + 8 * m + 4 * hh;
                    *(f32x4*)(rgP + (size_t)ch * DRG + c) = (f32x4){pc_l[4 * m], pc_l[4 * m + 1], pc_l[4 * m + 2], pc_l[4 * m + 3]};
                    *(f32x4*)(rgH + (size_t)ch * DRG + c) = (f32x4){hin_l[4 * m], hin_l[4 * m + 1], hin_l[4 * m + 2], hin_l[4 * m + 3]};
                }
            }
        } else {
            __syncthreads();
            for (int j = 0; j < 8; ++j) {
                const int tr = 8 * n + j, tok = t0 + tr;
                float tot = 0.f;
#pragma unroll
                for (int w = 0; w < 8; ++w) tot += lds[RG_LDS_SSQ / 4 + ((tr >> 5) * 8 + w) * 32 + (tr & 31)];
                const float rn = rsqrtf(tot * (1.0f / DRG) + EPS);
                const __attribute__((address_space(3))) u32x2* op = (const __attribute__((address_space(3))) u32x2*)(ot + tr * RG_XP + 16 * lane);
                const u32x2 w0 = op[0], w1 = op[1];
                u32x4 o2; o2.x = cvtpk(bf2f(w0.x & 0xffffu) * rn, bf2f(w0.x >> 16) * rn); o2.y = cvtpk(bf2f(w0.y & 0xffffu) * rn, bf2f(w0.y >> 16) * rn);
                o2.z = cvtpk(bf2f(w1.x & 0xffffu) * rn, bf2f(w1.x >> 16) * rn); o2.w = cvtpk(bf2f(w1.y & 0xffffu) * rn, bf2f(w1.y >> 16) * rn);
                *((u32x4*)(mix + (size_t)tok * D + DSB) + lane) = o2;
                const u32x4 a = *((const u32x4*)(osb + (size_t)tok * DSB) + lane);
                float f[8] = {bf2f(a.x & 0xffffu), bf2f(a.x >> 16), bf2f(a.y & 0xffffu), bf2f(a.y >> 16), bf2f(a.z & 0xffffu), bf2f(a.z >> 16), bf2f(a.w & 0xffffu), bf2f(a.w >> 16)};
                float sa = 0.f;
#pragma unroll
                for (int k = 0; k < 8; ++k) sa += f[k] * f[k];
                sa = wave_sum(sa);
                const float ra = rsqrtf(sa * (1.0f / DSB) + EPS);
                u32x4 o; o.x = cvtpk(f[0] * ra, f[1] * ra); o.y = cvtpk(f[2] * ra, f[3] * ra); o.z = cvtpk(f[4] * ra, f[5] * ra); o.w = cvtpk(f[6] * ra, f[7] * ra);
                *((u32x4*)(mix + (size_t)tok * D) + lane) = o;
            }
        }
    }
}

__device__ __forceinline__ int f2key(float f) { const int b = __builtin_bit_cast(int, f); return b ^ ((b >> 31) & 0x7fffffff); }
__device__ __forceinline__ float key2f(int k) { return __builtin_bit_cast(float, k ^ ((k >> 31) & 0x7fffffff)); }
__device__ __forceinline__ void topk_insert(int (&lst)[16], int x) {
#pragma unroll
    for (int i = 0; i < 16; ++i) { const int hi = max(lst[i], x); x = min(lst[i], x); lst[i] = hi; }
}
#define TOPK_CE(a, b) do { const int hi_ = max(a, b), lo_ = min(a, b); a = hi_; b = lo_; } while (0)
__device__ __forceinline__ void sort16_desc(int (&v)[16]) { TOPK_CE(v[0], v[1]); TOPK_CE(v[2], v[3]); TOPK_CE(v[0], v[2]); TOPK_CE(v[1], v[3]); TOPK_CE(v[1], v[2]); TOPK_CE(v[4], v[5]); TOPK_CE(v[6], v[7]); TOPK_CE(v[4], v[6]); TOPK_CE(v[5], v[7]); TOPK_CE(v[5], v[6]); TOPK_CE(v[0], v[4]); TOPK_CE(v[2], v[6]); TOPK_CE(v[2], v[4]); TOPK_CE(v[1], v[5]); TOPK_CE(v[3], v[7]); TOPK_CE(v[3], v[5]); TOPK_CE(v[1], v[2]); TOPK_CE(v[3], v[4]); TOPK_CE(v[5], v[6]); TOPK_CE(v[8], v[9]); TOPK_CE(v[10], v[11]); TOPK_CE(v[8], v[10]); TOPK_CE(v[9], v[11]); TOPK_CE(v[9], v[10]); TOPK_CE(v[12], v[13]); TOPK_CE(v[14], v[15]); TOPK_CE(v[12], v[14]); TOPK_CE(v[13], v[15]); TOPK_CE(v[13], v[14]); TOPK_CE(v[8], v[12]); TOPK_CE(v[10], v[14]); TOPK_CE(v[10], v[12]); TOPK_CE(v[9], v[13]); TOPK_CE(v[11], v[15]); TOPK_CE(v[11], v[13]); TOPK_CE(v[9], v[10]); TOPK_CE(v[11], v[12]); TOPK_CE(v[13], v[14]); TOPK_CE(v[0], v[8]); TOPK_CE(v[4], v[12]); TOPK_CE(v[4], v[8]); TOPK_CE(v[2], v[10]); TOPK_CE(v[6], v[14]); TOPK_CE(v[6], v[10]); TOPK_CE(v[2], v[4]); TOPK_CE(v[6], v[8]); TOPK_CE(v[10], v[12]); TOPK_CE(v[1], v[9]); TOPK_CE(v[5], v[13]); TOPK_CE(v[5], v[9]); TOPK_CE(v[3], v[11]); TOPK_CE(v[7], v[15]); TOPK_CE(v[7], v[11]); TOPK_CE(v[3], v[5]); TOPK_CE(v[7], v[9]); TOPK_CE(v[11], v[13]); TOPK_CE(v[1], v[2]); TOPK_CE(v[3], v[4]); TOPK_CE(v[5], v[6]); TOPK_CE(v[7], v[8]); TOPK_CE(v[9], v[10]); TOPK_CE(v[11], v[12]); TOPK_CE(v[13], v[14]); }
__device__ __forceinline__ void merge16_desc(int (&a)[16], const int (&b)[16]) {
#pragma unroll
    for (int i = 0; i < 16; ++i) a[i] = max(a[i], b[15 - i]);
#pragma unroll
    for (int d = 8; d >= 1; d >>= 1)
#pragma unroll
        for (int i = 0; i < 16; ++i) if ((i & d) == 0) TOPK_CE(a[i], a[i + d]);
}
__device__ __forceinline__ void ph_topk(const Params& p, int* lds) {
    unsigned char* ws = p.ws;
    const bf16_t* qp = (const bf16_t*)(ws + WS_B); const bf16_t* subk = (const bf16_t*)(ws + WS_SUBK);
    int* seli = (int*)(ws + WS_SELI); float* selg = (float*)(ws + WS_SELG);
    const float* ssq = (const float*)(ws + WS_SSQ); float* rstd2 = (float*)(ws + WS_RSTD2);
    const int tid = phase_tid(), lane = tid & 63, r = lane & 31, hh = lane >> 5, hx = 4 * hh;
    const int gwave = (blockIdx.x * blockDim.x + tid) >> 6, nwave = (gridDim.x * blockDim.x) >> 6;
    constexpr int SK_OFF = 65536, SK_PITCH = 272;
    typedef __attribute__((address_space(3))) unsigned char lds_b;
    lds_b* skl = (lds_b*)lds + SK_OFF;
    const int w = tid >> 6;
    for (int ub = blockIdx.x * (NTHR / 64); ub < (S / 32) * PH; ub += gridDim.x * (NTHR / 64)) {
        const int u = ub + w;
        const int h = ub / (S / 32), t0 = (u % (S / 32)) * 32, t = t0 + r;
        __syncthreads();
#pragma unroll
        for (int j = 0; j < 8; ++j) {
            const int ci = tid + NTHR * j, row = ci >> 4, c16 = ci & 15;
            const u32x4 v = *(const u32x4*)(subk + ((size_t)h * 256 + row) * PHALF + 8 * c16);
            *(__attribute__((address_space(3))) u32x4*)(skl + row * SK_PITCH + 16 * c16) = v;
        }
        __syncthreads();
        int tk[2][16];
#pragma unroll
        for (int pp = 0; pp < 2; ++pp) {
            f32x16 acc[4];
#pragma unroll
            for (int T = 0; T < 4; ++T)
#pragma unroll
                for (int i = 0; i < 16; ++i) acc[T][i] = 0.f;
            const bf16_t* qrow = qp + (size_t)t * NQ + h * PDK + pp * PHALF + 8 * hh;
            const lds_b* krow = skl + (pp * PNK + r) * SK_PITCH + 16 * hh;
#pragma unroll
            for (int s = 0; s < 8; ++s) {
                const bf16x8 b = *(const bf16x8*)(qrow + 16 * s);
#pragma unroll
                for (int T = 0; T < 4; ++T) {
                    const bf16x8 a = *(const __attribute__((address_space(3))) bf16x8*)(krow + (32 * T) * SK_PITCH + 32 * s);
                    acc[T] = __builtin_amdgcn_mfma_f32_32x32x16_bf16(a, b, acc[T], 0, 0, 0);
                }
            }
            int kq[4][16];
#pragma unroll
            for (int T = 0; T < 4; ++T) {
#pragma unroll
                for (int i = 0; i < 16; ++i) {
                    const int nb = 32 * T + (i & 3) + 8 * (i >> 2);
                    kq[T][i] = ((f2key(acc[T][i]) & ~127) | (127 - nb)) ^ hx;
                }
                sort16_desc(kq[T]);
            }
            merge16_desc(kq[0], kq[1]); merge16_desc(kq[2], kq[3]); merge16_desc(kq[0], kq[2]);
            int m[16], po[16];
#pragma unroll
            for (int i = 0; i < 16; ++i) { m[i] = kq[0][i]; po[i] = __shfl_xor(kq[0][i], 32); }
            merge16_desc(m, po);
#pragma unroll
            for (int i = 0; i < 16; ++i) tk[pp][i] = m[i];
        }
#pragma unroll
        for (int i = 0; i < 16; ++i) { lds[i * NTHR + tid] = tk[0][i]; lds[(16 + i) * NTHR + tid] = tk[1][i]; }
        float v0[16], v1[16];
#pragma unroll
        for (int i = 0; i < 16; ++i) { v0[i] = key2f(tk[0][i]); v1[i] = key2f(tk[1][i]); }
#define CKEY(a, b) ((f2key(v0[a] + v1[b]) & ~255) | (255 - ((a) * 16 + (b))))
        const int NEGK = (int)0x80000000;
        int bk[16], l1[16], ga[16], gb[16];
#pragma unroll
        for (int b = 0; b < 16; ++b) bk[b] = CKEY(0, b);
#pragma unroll
        for (int b = 0; b < 16; ++b) l1[b] = b < 8 ? CKEY(1, b) : NEGK;
        ga[0] = CKEY(2, 0); ga[1] = CKEY(2, 1); ga[2] = CKEY(2, 2); ga[3] = CKEY(2, 3); ga[4] = CKEY(2, 4);
        ga[5] = CKEY(3, 0); ga[6] = CKEY(3, 1); ga[7] = CKEY(3, 2); ga[8] = CKEY(3, 3);
        ga[9] = CKEY(4, 0); ga[10] = CKEY(4, 1); ga[11] = CKEY(4, 2); ga[12] = CKEY(5, 0); ga[13] = CKEY(5, 1); ga[14] = NEGK; ga[15] = NEGK;
        gb[0] = CKEY(6, 0); gb[1] = CKEY(6, 1); gb[2] = CKEY(7, 0); gb[3] = CKEY(7, 1);
#pragma unroll
        for (int a = 8; a < 16; ++a) gb[a - 4] = CKEY(a, 0);
        gb[12] = NEGK; gb[13] = NEGK; gb[14] = NEGK; gb[15] = NEGK;
#undef CKEY
        sort16_desc(ga); sort16_desc(gb);
        merge16_desc(bk, l1); merge16_desc(ga, gb); merge16_desc(bk, ga);
        float ssum = 0.f;
#pragma unroll
        for (int i = 0; i < 4; ++i) { const f32x4 q4 = *(const f32x4*)(ssq + (size_t)t * 16 + 4 * i); ssum += (q4.x + q4.y) + (q4.z + q4.w); }
        const float rs = rsqrtf(ssum * (1.0f / D) + EPS);
        float e[16], sum = 0.f; const float mx = key2f(bk[0]);
#pragma unroll
        for (int i = 0; i < 16; ++i) { e[i] = __expf((key2f(bk[i]) - mx) * rs); sum += e[i]; }
        const float inv = 1.0f / sum;
        int eidx[16];
#pragma unroll
        for (int i = 0; i < 16; ++i) {
            const int code = 255 - (bk[i] & 255), a = code >> 4, b = code & 15;
            const int i1 = 127 - (lds[a * NTHR + tid] & 127), i2 = 127 - (lds[(16 + b) * NTHR + tid] & 127);
            eidx[i] = i1 * PNK + i2; e[i] *= inv;
        }
        if (hh == 0) {
            int4* o = (int4*)(seli + (size_t)t * 128 + h * 16);
#pragma unroll
            for (int i = 0; i < 4; ++i) o[i] = make_int4(eidx[4 * i], eidx[4 * i + 1], eidx[4 * i + 2], eidx[4 * i + 3]);
            if (h == 0) rstd2[t] = rs;
        } else {
            f32x4* o = (f32x4*)(selg + (size_t)t * 128 + h * 16);
#pragma unroll
            for (int i = 0; i < 4; ++i) o[i] = (f32x4){e[4 * i], e[4 * i + 1], e[4 * i + 2], e[4 * i + 3]};
        }
    }
}

__device__ __forceinline__ void unpack8(const u32x4 a, float (&f)[8]) {
    f[0] = bf2f(a.x & 0xffff); f[1] = bf2f(a.x >> 16); f[2] = bf2f(a.y & 0xffff); f[3] = bf2f(a.y >> 16);
    f[4] = bf2f(a.z & 0xffff); f[5] = bf2f(a.z >> 16); f[6] = bf2f(a.w & 0xffff); f[7] = bf2f(a.w >> 16);
}
typedef __bf16 bf16x2_t __attribute__((ext_vector_type(2)));
__device__ __forceinline__ float dot2_bf16(unsigned a, unsigned b, float c) { return __builtin_amdgcn_fdot2_f32_bf16(__builtin_bit_cast(bf16x2_t, a), __builtin_bit_cast(bf16x2_t, b), c, false); }
__device__ __forceinline__ float dot8_bf16(const u32x4 a, const u32x4 b, float c) {
    c = dot2_bf16(a.x, b.x, c); c = dot2_bf16(a.y, b.y, c); c = dot2_bf16(a.z, b.z, c); c = dot2_bf16(a.w, b.w, c);
    return c;
}
__device__ __forceinline__ void axpy8_bf16(float (&acc)[16], int o, const u32x4 w, float c) {
    acc[o + 0] += c * __builtin_bit_cast(float, w.x << 16); acc[o + 1] += c * __builtin_bit_cast(float, w.x & 0xffff0000u);
    acc[o + 2] += c * __builtin_bit_cast(float, w.y << 16); acc[o + 3] += c * __builtin_bit_cast(float, w.y & 0xffff0000u);
    acc[o + 4] += c * __builtin_bit_cast(float, w.z << 16); acc[o + 5] += c * __builtin_bit_cast(float, w.z & 0xffff0000u);
    acc[o + 6] += c * __builtin_bit_cast(float, w.w << 16); acc[o + 7] += c * __builtin_bit_cast(float, w.w & 0xffff0000u);
}
__device__ __forceinline__ float transpose_reduce64(float (&v)[64], int lane) {
#pragma unroll
    for (int s = 0; s < 6; ++s) {
        const bool up = (lane >> s) & 1;
#pragma unroll
        for (int i = 0; i < (32 >> s); ++i) {
            const float a = v[2 * i], b = v[2 * i + 1];
            const float keep = up ? b : a, send = up ? a : b;
            v[i] = keep + __shfl_xor(send, 1 << s);
        }
    }
    return v[0];
}
typedef float f32x2 __attribute__((ext_vector_type(2)));
__device__ __forceinline__ float dot16_fp8(const u32x4 w, const float (&x)[16], float c) {
    f32x2 q;
    q = __builtin_amdgcn_cvt_pk_f32_fp8((int)w.x, false); c += x[0] * q[0]; c += x[1] * q[1];   q = __builtin_amdgcn_cvt_pk_f32_fp8((int)w.x, true); c += x[2] * q[0]; c += x[3] * q[1];
    q = __builtin_amdgcn_cvt_pk_f32_fp8((int)w.y, false); c += x[4] * q[0]; c += x[5] * q[1];   q = __builtin_amdgcn_cvt_pk_f32_fp8((int)w.y, true); c += x[6] * q[0]; c += x[7] * q[1];
    q = __builtin_amdgcn_cvt_pk_f32_fp8((int)w.z, false); c += x[8] * q[0]; c += x[9] * q[1];   q = __builtin_amdgcn_cvt_pk_f32_fp8((int)w.z, true); c += x[10] * q[0]; c += x[11] * q[1];
    q = __builtin_amdgcn_cvt_pk_f32_fp8((int)w.w, false); c += x[12] * q[0]; c += x[13] * q[1]; q = __builtin_amdgcn_cvt_pk_f32_fp8((int)w.w, true); c += x[14] * q[0]; c += x[15] * q[1];
    return c;
}
__device__ __forceinline__ void axpy16_fp8(float (&acc)[16], const u32x4 w, float c) {
    f32x2 q;
    q = __builtin_amdgcn_cvt_pk_f32_fp8((int)w.x, false); acc[0] += c * q[0]; acc[1] += c * q[1];   q = __builtin_amdgcn_cvt_pk_f32_fp8((int)w.x, true); acc[2] += c * q[0]; acc[3] += c * q[1];
    q = __builtin_amdgcn_cvt_pk_f32_fp8((int)w.y, false); acc[4] += c * q[0]; acc[5] += c * q[1];   q = __builtin_amdgcn_cvt_pk_f32_fp8((int)w.y, true); acc[6] += c * q[0]; acc[7] += c * q[1];
    q = __builtin_amdgcn_cvt_pk_f32_fp8((int)w.z, false); acc[8] += c * q[0]; acc[9] += c * q[1];   q = __builtin_amdgcn_cvt_pk_f32_fp8((int)w.z, true); acc[10] += c * q[0]; acc[11] += c * q[1];
    q = __builtin_amdgcn_cvt_pk_f32_fp8((int)w.w, false); acc[12] += c * q[0]; acc[13] += c * q[1]; q = __builtin_amdgcn_cvt_pk_f32_fp8((int)w.w, true); acc[14] += c * q[0]; acc[15] += c * q[1];
}
template <int XS0, int XS1, int XS2>
__device__ __forceinline__ void reduce16_over8(float (&v)[16], int sel) {
    { const bool up = sel & 1;
#pragma unroll
      for (int i = 0; i < 8; ++i) { const float a = v[2 * i], b = v[2 * i + 1]; v[i] = (up ? b : a) + __shfl_xor(up ? a : b, XS0); } }
    { const bool up = (sel >> 1) & 1;
#pragma unroll
      for (int i = 0; i < 4; ++i) { const float a = v[2 * i], b = v[2 * i + 1]; v[i] = (up ? b : a) + __shfl_xor(up ? a : b, XS1); } }
    { const bool up = (sel >> 2) & 1;
#pragma unroll
      for (int i = 0; i < 2; ++i) { const float a = v[2 * i], b = v[2 * i + 1]; v[i] = (up ? b : a) + __shfl_xor(up ? a : b, XS2); } }
}
__device__ __forceinline__ void peer_load_idx(const unsigned char* ws, int t, int rsl, int (&ei)[16]) {
    const int* seli = (const int*)(ws + WS_SELI);
#pragma unroll
    for (int j = 0; j < 4; ++j) { const int4 v = *(const int4*)(seli + (size_t)t * 128 + 16 * rsl + 4 * j); ei[4 * j] = v.x; ei[4 * j + 1] = v.y; ei[4 * j + 2] = v.z; ei[4 * j + 3] = v.w; }
}
template <int PASS>
__device__ __forceinline__ void peer_load_rows(const unsigned char* ws, int t, int g, int rsl, int c, const int (&ei)[16], u32x4 (&row)[16], u32x4 (&aux)[4]) {
    const unsigned char* tab = ws + (PASS == 0 ? WS_UB : WS_VB) + (size_t)g * NEXP * 128 + 16 * c;
#pragma unroll
    for (int i = 0; i < 16; ++i) row[i] = *(const u32x4*)(tab + (size_t)ei[i] * 128);
    if (PASS == 0) {
        const bf16_t* xp = (const bf16_t*)(ws + WS_A) + (size_t)t * D + 128 * g + 16 * c;
        aux[0] = *(const u32x4*)xp; aux[1] = *(const u32x4*)(xp + 8);
    } else {
        const u32x4* cb = (const u32x4*)((const float*)(ws + WS_CBUF) + (size_t)t * 128 + 16 * rsl);
#pragma unroll
        for (int j = 0; j < 4; ++j) aux[j] = cb[j];
    }
}
template <int PASS  >
__device__ __forceinline__ void peer_compute(const Params& p, int t, int g, int rsl, int c, const u32x4 (&row)[16], const u32x4 (&aux)[4]) {
    unsigned char* ws = p.ws;
    if (PASS == 0) {
        float xv[16];
        { float f[8]; unpack8(aux[0], f);
#pragma unroll
          for (int j = 0; j < 8; ++j) xv[j] = f[j];
          unpack8(aux[1], f);
#pragma unroll
          for (int j = 0; j < 8; ++j) xv[8 + j] = f[j]; }
        float pd[16];
#pragma unroll
        for (int i = 0; i < 16; ++i) pd[i] = dot16_fp8(row[i], xv, 0.f);
        reduce16_over8<1, 2, 4>(pd, c);
        float* o = (float*)(ws + WS_PD) + ((size_t)g * S + t) * 128 + 16 * rsl + c;
        o[0] = pd[0]; o[8] = pd[1];
    } else {
        float acc[16];
#pragma unroll
        for (int j = 0; j < 16; ++j) acc[j] = 0.f;
#pragma unroll
        for (int j = 0; j < 4; ++j) {
            const u32x4 cw = aux[j];
            axpy16_fp8(acc, row[4 * j], u2f(cw.x)); axpy16_fp8(acc, row[4 * j + 1], u2f(cw.y));
            axpy16_fp8(acc, row[4 * j + 2], u2f(cw.z)); axpy16_fp8(acc, row[4 * j + 3], u2f(cw.w));
        }
        reduce16_over8<8, 16, 32>(acc, rsl);
        float* o = p.out + (size_t)t * D + 128 * g + 16 * c + rsl;
        o[0] += acc[0]; o[8] += acc[1];
    }
}
template <int PASS>
__device__ __forceinline__ void peer_stream(const Params& p, int g, int t0, int dt, int n, int lane) {
    const unsigned char* ws = p.ws;
    const int rsl = lane >> 3, c = lane & 7;
    int eiA[16], eiB[16]; u32x4 rowA[16], rowB[16], auxA[4], auxB[4];
    if (n <= 0) return;
    peer_load_idx(ws, t0, rsl, eiA);
    peer_load_rows<PASS>(ws, t0, g, rsl, c, eiA, rowA, auxA);
    if (n > 1) peer_load_idx(ws, t0 + dt, rsl, eiB);
    for (int i = 0; i < n; i += 2) {
        const int t = t0 + i * dt;
        if (i + 1 < n) peer_load_rows<PASS>(ws, t + dt, g, rsl, c, eiB, rowB, auxB);
        if (i + 2 < n) peer_load_idx(ws, t + 2 * dt, rsl, eiA);
        peer_compute<PASS>(p, t, g, rsl, c, rowA, auxA);
        if (i + 1 < n) {
            if (i + 2 < n) peer_load_rows<PASS>(ws, t + 2 * dt, g, rsl, c, eiA, rowA, auxA);
            if (i + 3 < n) peer_load_idx(ws, t + 3 * dt, rsl, eiB);
            peer_compute<PASS>(p, t + dt, g, rsl, c, rowB, auxB);
        }
    }
}
template <int PASS>
__device__ __forceinline__ void ph_peer(const Params& p) {
    const int tid_ = phase_tid();
    const int lane = tid_ & 63, w = tid_ >> 6, b = blockIdx.x, G = gridDim.x;
    if ((G & 7) == 0) {
        const int nsw = (G >> 3) * (NTHR / 64), t0 = (b >> 3) * (NTHR / 64) + w;
        peer_stream<PASS>(p, b & 7, t0, nsw, t0 < S ? (S - 1 - t0) / nsw + 1 : 0, lane);
    } else {
        const int nw = G * (NTHR / 64), it0 = b * (NTHR / 64) + w;
        for (int it = it0; it < S * 8; it += nw) peer_stream<PASS>(p, it & 7, it >> 3, 0, 1, lane);
    }
}
__device__ __forceinline__ void ph_peer_combine(const Params& p) {
    unsigned char* ws = p.ws;
    const int* seli = (const int*)(ws + WS_SELI); const float* selg = (const float*)(ws + WS_SELG); const float* rstd2 = (const float*)(ws + WS_RSTD2);
    const float* usc = (const float*)(ws + WS_USC); const float* vsc = (const float*)(ws + WS_VSC);
    const float* pd = (const float*)(ws + WS_PD); float* cb = (float*)(ws + WS_CBUF);
    const int gtid = blockIdx.x * blockDim.x + phase_tid(), gsize = gridDim.x * blockDim.x;
    for (int e = gtid; e < S * 128; e += gsize) {
        float d = 0.f;
#pragma unroll
        for (int g = 0; g < 8; ++g) d += pd[(size_t)g * S * 128 + e];
        const int idx = seli[e];
        cb[e] = selg[e] * gelu_tanh(d * usc[idx] * rstd2[e >> 7]) * vsc[idx];
    }
}

#define LAS __attribute__((address_space(3)))
#define XB_TMO      128
#define XB_XCNT(j)  (256  + 64 * (j))
#define XB_XSUB(j)  (1280 + 64 * (j))
#define XB_XGEN(j)  (2304 + 64 * (j))
#define XB_TOP      3328
#define XB_TOPGEN   3392
#define XCD_BAR_WORDS 3456
#define XB_SPIN_CAP (1u << 18)
__device__ __forceinline__ unsigned xb_ld(unsigned* p)              { return __hip_atomic_load(p, __ATOMIC_RELAXED, __HIP_MEMORY_SCOPE_AGENT); }
__device__ __forceinline__ unsigned xb_add(unsigned* p, unsigned v) { return __hip_atomic_fetch_add(p, v, __ATOMIC_RELAXED, __HIP_MEMORY_SCOPE_AGENT); }
__device__ __forceinline__ unsigned xb_xcc_id() { return (unsigned)__builtin_amdgcn_s_getreg((3 << 11) | 20) & 0xFu; }
#define XB_SPIN(cond, bar) do { unsigned _sp = 0; while (cond) { __builtin_amdgcn_s_sleep(1); \
    if ((++_sp & 255u) == 0u) { if (xb_ld(&(bar)[XB_TMO])) break; if (_sp > XB_SPIN_CAP) { atomicAdd(&(bar)[XB_TMO], 1u); break; } } } } while (0)
struct XcdBarrier { unsigned* bar; unsigned x; volatile LAS unsigned* st; };
__device__ __forceinline__ XcdBarrier xcd_barrier_post(unsigned* bar, volatile LAS unsigned* st) {
    XcdBarrier b; b.bar = bar; b.x = xb_xcc_id(); b.st = st;
    if (threadIdx.x == 0) (void)xb_add(&bar[XB_XCNT(b.x)], 1u);
    return b;
}
__device__ __forceinline__ void xcd_barrier_complete(unsigned* bar, unsigned x, unsigned& nloc, unsigned& nx) {
    const unsigned G = gridDim.x * gridDim.y * gridDim.z;
    unsigned sum, cnt, mine, sp = 0u;
    for (;;) {
        sum = 0u; cnt = 0u; mine = 0u;
#pragma unroll
        for (unsigned j = 0; j < 16; ++j) { const unsigned c = xb_ld(&bar[XB_XCNT(j)]); sum += c; cnt += (c > 0u) ? 1u : 0u; mine = (j == x) ? c : mine; }
        if (sum == G) break;
        __builtin_amdgcn_s_sleep(1);
        if ((++sp & 255u) == 0u) { if (xb_ld(&bar[XB_TMO])) break; if (sp > XB_SPIN_CAP) { atomicAdd(&bar[XB_TMO], 1u); break; } }
    }
    nloc = mine > 0u ? mine : 1u; nx = cnt > 0u ? cnt : 1u;
}
__device__ __forceinline__ void xcd_barrier(const XcdBarrier& b) {
    asm volatile("s_waitcnt vmcnt(0)" ::: "memory");
    __syncthreads();
    if (threadIdx.x == 0) {
        unsigned* bar = b.bar;
        __builtin_amdgcn_s_waitcnt(0);
        unsigned nloc = b.st[0], nx = b.st[1];
        if (nloc == 0u) { xcd_barrier_complete(bar, b.x, nloc, nx); b.st[0] = nloc; b.st[1] = nx; }
        const unsigned old = xb_add(&bar[XB_XSUB(b.x)], 1u);
        const unsigned gen = old / nloc;
        if (old + 1u == (gen + 1u) * nloc) {
            __builtin_amdgcn_fence(__ATOMIC_RELEASE, "agent");
            asm volatile("s_waitcnt vmcnt(0)" ::: "memory");
            const unsigned og = xb_add(&bar[XB_TOP], 1u);
            const unsigned tg = og / nx;
            if (og + 1u == (tg + 1u) * nx) xb_add(&bar[XB_TOPGEN], 1u);
            else XB_SPIN(xb_ld(&bar[XB_TOPGEN]) == tg, bar);
            __builtin_amdgcn_fence(__ATOMIC_ACQUIRE, "agent");
            xb_add(&bar[XB_XGEN(b.x)], 1u);
            asm volatile("s_waitcnt vmcnt(0)" ::: "memory");
        } else {
            XB_SPIN(xb_ld(&bar[XB_XGEN(b.x)]) == gen, bar);
            __builtin_amdgcn_fence(__ATOMIC_ACQUIRE, "agent");
            asm volatile("s_waitcnt vmcnt(0)" ::: "memory");
        }
    }
    __syncthreads();
}

constexpr int LDS_MISC = 158720;
constexpr int LDS_BYTES = LDS_MISC + 1024;

__global__ void __launch_bounds__(NTHR, 2) hymba_fwd(Params p) {
    extern __shared__ __attribute__((aligned(16))) unsigned char lds[];
    volatile LAS unsigned* misc = (volatile LAS unsigned*)((LAS unsigned char*)lds + LDS_MISC);
    if (threadIdx.x < 4) misc[threadIdx.x] = 0u;
    __syncthreads();
    XcdBarrier bar = xcd_barrier_post((unsigned*)(p.ws + WS_CTL), misc);

    PG8_LAS unsigned char* ring = (PG8_LAS unsigned char*)lds;
    unsigned char* ws = p.ws;
    ph_prep(p, lds);                          xcd_barrier(bar);
    {
        pg8::Gemm g{(const bf16_t*)(ws + WS_A), (const bf16_t*)(ws + WS_WINT), S, NPROJ, D}; pg8::StaticOrder so; so.init(S, NPROJ, (int)gridDim.x, (int)blockIdx.x);
        EpiInProj E{(const float*)(ws + WS_RSTD1), p.in[I_Q_NORM], p.in[I_K_NORM], (bf16_t*)(ws + WS_QH), (bf16_t*)(ws + WS_KH), (bf16_t*)(ws + WS_VH), (bf16_t*)(ws + WS_XRG), (bf16_t*)(ws + WS_GG)};
        pg8::gemm_phase<EpiInProj, pg8::StaticOrder, true, true>(ring, g, so, E);
    }
    xcd_barrier(bar);
    ph_attn(p); ph_rg<0>(p, lds);             xcd_barrier(bar);
    ph_rg<1>(p, lds);                         xcd_barrier(bar);
    {
        pg8::Gemm g{(const bf16_t*)(ws + WS_MIX), (const bf16_t*)(ws + WS_WOUTT), S, D, D}; pg8::StaticOrder so; so.init(S, D, (int)gridDim.x, (int)blockIdx.x);
        EpiOutProj E{p.in[I_X], p.out, (bf16_t*)(ws + WS_A), (float*)(ws + WS_SSQ)};
        pg8::gemm_phase<EpiOutProj, pg8::StaticOrder, true, true>(ring, g, so, E);
    }
    xcd_barrier(bar);
    {
        pg8::Gemm g{(const bf16_t*)(ws + WS_A), (const bf16_t*)(ws + WS_WQT), S, NQ, D}; pg8::StaticOrder so; so.init(S, NQ, (int)gridDim.x, (int)blockIdx.x);
        EpiPeerQ E{(bf16_t*)(ws + WS_B)};
        pg8::gemm_phase<EpiPeerQ, pg8::StaticOrder, true, true>(ring, g, so, E);
    }
    xcd_barrier(bar);
    ph_topk(p, (int*)lds);                    xcd_barrier(bar);
    ph_peer<0>(p);                            xcd_barrier(bar);
    ph_peer_combine(p);                       xcd_barrier(bar);
    ph_peer<1>(p);
}

extern "C" void kernel_launch(void* const* d_in, const int* in_sizes, int n_in, void* d_out, int out_size, void* d_ws, size_t ws_size, hipStream_t stream) {
    static int grid = 0;
    if (grid == 0) {
        if (n_in != 20 || out_size != S * D || ws_size < WS_END) { fprintf(stderr, "kernel_launch: unexpected shapes (n_in %d out %d ws %zu)\n", n_in, out_size, ws_size); grid = -1; return; }
        int dev = 0, cus = 0, per_cu = 0;
        if (hipGetDevice(&dev) != hipSuccess || hipDeviceGetAttribute(&cus, hipDeviceAttributeMultiprocessorCount, dev) != hipSuccess) { grid = -1; return; }
        if (hipFuncSetAttribute((const void*)hymba_fwd, hipFuncAttributeMaxDynamicSharedMemorySize, LDS_BYTES) != hipSuccess) { fprintf(stderr, "kernel_launch: hipFuncSetAttribute failed\n"); grid = -1; return; }
        if (hipOccupancyMaxActiveBlocksPerMultiprocessor(&per_cu, (const void*)hymba_fwd, NTHR, LDS_BYTES) != hipSuccess || per_cu < 1) { fprintf(stderr, "kernel_launch: occupancy query says %d blocks per CU\n", per_cu); grid = -1; return; }
        (void)hipGetLastError();
        grid = cus;
    }
    if (grid < 0) return;
    (void)hipMemsetAsync((char*)d_ws + WS_CTL, 0, XCD_BAR_WORDS * 4, stream);
    Params p{};
    for (int i = 0; i < 20; ++i) p.in[i] = (const float*)d_in[i];
    p.out = (float*)d_out; p.ws = (unsigned char*)d_ws;
    hipLaunchKernelGGL(hymba_fwd, dim3(grid), dim3(NTHR), LDS_BYTES, stream, p);
}
```

```cpp
#include <hip/hip_runtime.h>
#include <cstdint>
#include <cstdio>

typedef unsigned short bf16_t;
typedef short bf16x8 __attribute__((ext_vector_type(8)));
typedef float f32x4 __attribute__((ext_vector_type(4)));
typedef unsigned u32x4 __attribute__((ext_vector_type(4)));
typedef float f32x16 __attribute__((ext_vector_type(16)));

constexpr int S = 16384, D = 1024, NPROJ = 2560, DSB = 512, DRG = 512, NH = 8, HD = 64;
constexpr int PH = 8, PNK = 128, PDK = 256, PHALF = 128, PTOPK = 16, NEXP = 16384, NQ = PH * PDK;
constexpr int CHUNK = 64, NCHUNK = S / CHUNK;
constexpr float EPS = 1e-6f;
constexpr float LOG2E = 1.4426950408889634f;
constexpr float QSCALE = 0.125f * LOG2E;
constexpr int NTHR = 512;
constexpr float CARRY_STOP = -160.0f;

constexpr size_t MiB = 1u << 20;
constexpr size_t WS_CTL = 0;
constexpr size_t WS_WINT = 1 * MiB;
constexpr size_t WS_WOUTT = 6 * MiB;
constexpr size_t WS_WQT = 8 * MiB;
constexpr size_t WS_SUBK = 12 * MiB;
constexpr size_t WS_RSTD1 = 12 * MiB + 512 * 1024;
constexpr size_t WS_RSTD2 = WS_RSTD1 + 64 * 1024;
constexpr size_t WS_RGP = WS_RSTD2 + 64 * 1024;
constexpr size_t WS_RGH = WS_RGP + 512 * 1024;
constexpr size_t WS_A = 14 * MiB;
constexpr size_t WS_B = 46 * MiB;
constexpr size_t WS_QH = WS_B, WS_KH = WS_B + 16 * MiB, WS_VH = WS_B + 32 * MiB, WS_XRG = WS_B + 48 * MiB;
constexpr size_t WS_GG = 110 * MiB;
constexpr size_t WS_OSB = 126 * MiB;
constexpr size_t WS_MIX = 142 * MiB;
constexpr size_t WS_SELI = WS_MIX, WS_SELG = WS_MIX + 8 * MiB;
constexpr size_t WS_PD = WS_B;
constexpr size_t WS_CBUF = WS_GG;
constexpr size_t WS_UB = 174 * MiB;
constexpr size_t WS_VB = 190 * MiB;
constexpr size_t WS_USC = 206 * MiB;
constexpr size_t WS_VSC = 206 * MiB + 64 * 1024;
constexpr size_t WS_SSQ = 238 * MiB;
constexpr size_t WS_RGW = 239 * MiB;
constexpr size_t WS_END = 240 * MiB;

__device__ __forceinline__ unsigned f2bf(float f) { unsigned u = __builtin_bit_cast(unsigned, f); return (u + 0x7fffu + ((u >> 16) & 1u)) >> 16; }
__device__ __forceinline__ float u2f(unsigned u) { return __builtin_bit_cast(float, u); }
__device__ __forceinline__ float bf2f(unsigned h) { return __builtin_bit_cast(float, h << 16); }
__device__ __forceinline__ unsigned pk2(float lo, float hi) { return f2bf(lo) | (f2bf(hi) << 16); }
__device__ __forceinline__ unsigned pack_i8(float a, float b, float c, float d) {
    const int qa = __float2int_rn(a), qb = __float2int_rn(b), qc = __float2int_rn(c), qd = __float2int_rn(d);
    return (unsigned)(qa & 255) | ((unsigned)(qb & 255) << 8) | ((unsigned)(qc & 255) << 16) | ((unsigned)qd << 24);
}
__device__ __forceinline__ float wave_sum(float v) {
#pragma unroll
    for (int o = 1; o < 64; o <<= 1) v += __shfl_xor(v, o);
    return v;
}
__device__ __forceinline__ float gelu_tanh(float x) {
    const float u = 0.7978845608028654f * (x + 0.044715f * x * x * x);
    const float e = __expf(2.0f * u);
    const float th = 1.0f - 2.0f / (e + 1.0f);
    return 0.5f * x * (1.0f + th);
}
__device__ __forceinline__ float sigmoidf_(float x) { return 1.0f / (1.0f + __expf(-x)); }

__host__ __device__ __forceinline__ int inproj_phys_row(int nlog) { const int t = nlog >> 8, L = nlog & 255; return (t << 8) + 128 * ((L & 63) >> 5) + 32 * (L >> 6) + (L & 31); }

__device__ __forceinline__ int phase_tid() { int t = threadIdx.x; asm volatile("" : "+v"(t)); return t; }

struct Params {
    const float* in[20];
    float* out;
    unsigned char* ws;
};
enum { I_X = 0, I_NORM_MIX, I_W_IN, I_Q_NORM, I_K_NORM, I_CONV_W, I_CONV_B, I_RG_W_A, I_RG_B_A, I_RG_W_X, I_RG_B_X, I_RG_LAMBDA,
       I_OUT_NORM_SB, I_OUT_NORM_RG, I_W_OUT, I_NORM_FFN, I_PEER_WQ, I_PEER_SUBK, I_PEER_U, I_PEER_V };

template <bool INPROJ_PERM>
__device__ __forceinline__ void prep_transpose_item(const float* W, const float* gain0, const float* gain1, int K, int N, bf16_t* WT, float* scr, int item, int lane) {
    const int nblk = N / 32, kb = item / nblk, nb = item % nblk, k0 = 64 * kb, n0 = 32 * nb;
#pragma unroll 8
    for (int i = 0; i < 32; ++i) {
        const int kk = 2 * i + (lane >> 5), k = k0 + kk;
        const float g = (gain1 && k >= 512) ? gain1[k - 512] : gain0[k];
        scr[kk * 33 + (lane & 31)] = g * W[(size_t)k * N + n0 + (lane & 31)];
    }
    asm volatile("s_waitcnt lgkmcnt(0)" ::: "memory");
    const int c = lane & 7;
#pragma unroll
    for (int j = 0; j < 4; ++j) {
        const int n = (lane >> 3) + 8 * j; const float* s = scr + (8 * c) * 33 + n;
        u32x4 o; o.x = pk2(s[0 * 33], s[1 * 33]); o.y = pk2(s[2 * 33], s[3 * 33]); o.z = pk2(s[4 * 33], s[5 * 33]); o.w = pk2(s[6 * 33], s[7 * 33]);
        const int nr = INPROJ_PERM ? inproj_phys_row(n0 + n) : n0 + n;
        *(u32x4*)(WT + (size_t)nr * K + k0 + 8 * c) = o;
    }
    asm volatile("s_waitcnt lgkmcnt(0)" ::: "memory");
}
__device__ __forceinline__ void ph_prep(const Params& p, unsigned char* lds) {
    const int tid_ = phase_tid();
    const int gtid = blockIdx.x * blockDim.x + tid_, gsize = gridDim.x * blockDim.x;
    const int lane = tid_ & 63, gwave = gtid >> 6, nwave = gsize >> 6;
    unsigned char* ws = p.ws;
    {
        float* scr = (float*)lds + (tid_ >> 6) * (64 * 33);
        constexpr int I_IN = (D / 64) * (NPROJ / 32), I_OUT = (D / 64) * (D / 32), I_Q = (D / 64) * (NQ / 32);
        for (int it = gwave; it < I_IN + I_OUT + I_Q; it += nwave) {
            if (it < I_IN) prep_transpose_item<true>(p.in[I_W_IN], p.in[I_NORM_MIX], nullptr, D, NPROJ, (bf16_t*)(ws + WS_WINT), scr, it, lane);
            else if (it < I_IN + I_OUT) prep_transpose_item<false>(p.in[I_W_OUT], p.in[I_OUT_NORM_SB], p.in[I_OUT_NORM_RG], D, D, (bf16_t*)(ws + WS_WOUTT), scr, it - I_IN, lane);
            else prep_transpose_item<false>(p.in[I_PEER_WQ], p.in[I_NORM_FFN], nullptr, D, NQ, (bf16_t*)(ws + WS_WQT), scr, it - I_IN - I_OUT, lane);
        }
    }
    {
        const float* wa = p.in[I_RG_W_A]; const float* wx = p.in[I_RG_W_X]; bf16_t* o = (bf16_t*)(ws + WS_RGW);
        for (int e = gtid; e < 8 * 2 * 2 * 4 * 64 * 8; e += gsize) {
            const int el = e & 7, ln = (e >> 3) & 63, s = (e >> 9) & 3, jt = (e >> 11) & 1, g = (e >> 12) & 1, n = e >> 13;
            const int j = 32 * jt + (ln & 31), i = 16 * s + 8 * (el >> 2) + 4 * (ln >> 5) + (el & 3);
            o[e] = (bf16_t)f2bf((g == 0 ? wa : wx)[((size_t)n * 64 + i) * 64 + j]);
        }
    }
    {
        const float* sk = p.in[I_PEER_SUBK]; bf16_t* o = (bf16_t*)(ws + WS_SUBK);
        for (int e = gtid; e < PH * 2 * PNK * PHALF; e += gsize) o[e] = (bf16_t)f2bf(sk[e]);
    }
    {
        const float* u = p.in[I_PEER_U]; const float* v = p.in[I_PEER_V]; const float* g = p.in[I_NORM_FFN];
        unsigned* ub = (unsigned*)(ws + WS_UB); unsigned* vb = (unsigned*)(ws + WS_VB); float* usc = (float*)(ws + WS_USC); float* vsc = (float*)(ws + WS_VSC);
        f32x4 gq[4];
#pragma unroll
        for (int j = 0; j < 4; ++j) gq[j] = *((const f32x4*)g + lane + 64 * j);
        for (int e = gwave; e < NEXP; e += nwave) {
            f32x4 a[4], b[4]; float ma = 0.f, mb = 0.f;
#pragma unroll
            for (int j = 0; j < 4; ++j) {
                a[j] = *((const f32x4*)(u + (size_t)e * D) + lane + 64 * j) * gq[j]; b[j] = *((const f32x4*)(v + (size_t)e * D) + lane + 64 * j);
                ma = fmaxf(ma, fmaxf(fmaxf(fabsf(a[j].x), fabsf(a[j].y)), fmaxf(fabsf(a[j].z), fabsf(a[j].w))));
                mb = fmaxf(mb, fmaxf(fmaxf(fabsf(b[j].x), fabsf(b[j].y)), fmaxf(fabsf(b[j].z), fabsf(b[j].w))));
            }
#pragma unroll
            for (int o = 1; o < 64; o <<= 1) { ma = fmaxf(ma, __shfl_xor(ma, o)); mb = fmaxf(mb, __shfl_xor(mb, o)); }
            const float sa = ma > 0.f ? 127.0f / ma : 0.f, sb = mb > 0.f ? 127.0f / mb : 0.f;
#pragma unroll
            for (int j = 0; j < 4; ++j) {
                ub[((size_t)(2 * j + (lane >> 5)) * NEXP + e) * 32 + (lane & 31)] = pack_i8(a[j].x * sa, a[j].y * sa, a[j].z * sa, a[j].w * sa);
                vb[((size_t)(2 * j + (lane >> 5)) * NEXP + e) * 32 + (lane & 31)] = pack_i8(b[j].x * sb, b[j].y * sb, b[j].z * sb, b[j].w * sb);
            }
            if (lane == 0) { usc[e] = ma * (1.0f / 127.0f); vsc[e] = mb * (1.0f / 127.0f); }
        }
    }
    {
        const float* x = p.in[I_X]; bf16_t* xb = (bf16_t*)(ws + WS_A); float* rstd1 = (float*)(ws + WS_RSTD1);
        for (int row = gwave; row < S; row += nwave) {
            const f32x4* xr = (const f32x4*)(x + (size_t)row * D) + lane;
            uint2* o = (uint2*)(xb + (size_t)row * D) + lane;
            float ss = 0.f;
#pragma unroll
            for (int j = 0; j < 4; ++j) {
                const f32x4 v = xr[64 * j];
                ss += v.x * v.x + v.y * v.y + v.z * v.z + v.w * v.w;
                o[64 * j] = make_uint2(pk2(v.x, v.y), pk2(v.z, v.w));
            }
            ss = wave_sum(ss);
            if (lane == 0) rstd1[row] = rsqrtf(ss * (1.0f / D) + EPS);
        }
    }
}

namespace pg8 {
#define PG8_LAS __attribute__((address_space(3)))
typedef unsigned short bf16_t;
typedef short bf16x8 __attribute__((ext_vector_type(8)));
typedef float f32x4 __attribute__((ext_vector_type(4)));
typedef unsigned u32x4 __attribute__((ext_vector_type(4)));
constexpr int BM = 256, BK = 64, HALF = 128, HTB = HALF * BK * 2  , STAGE_BYTES = 8 * HTB, NXCD = 8, WGM = 8;

__host__ __device__ __forceinline__ int lds_byte(int r, int c) { const int st = (r >> 4) * 2 + (c >> 5), rr = r & 15, cc = c & 31, ob = rr * 64 + cc * 2; return st * 1024 + (ob ^ (((ob >> 9) & 1) << 5)); }
__host__ __device__ __forceinline__ void stage_rc(int b, int& R, int& C) { const int st = b / 1024, sb = b % 1024, swz = sb ^ (((sb >> 9) & 1) << 5); R = (st >> 1) * 16 + swz / 64; C = (st & 1) * 32 + (swz % 64) / 2; }
__host__ __device__ __forceinline__ int perm32(int rho) { const int n = rho >> 4, i = rho & 15; return 8 * (i >> 2) + 4 * n + (i & 3); }

struct Unit { int pm, pn; };
struct Gemm { const bf16_t* A; const bf16_t* Bt; int M, N, K; };

struct StaticOrder {
    int nM, nN, nwg, G, c;
    __host__ __device__ void init(int M, int N, int G_, int c_) { nM = M / BM; nN = N / BM; nwg = nM * nN; G = G_; c = c_; }
    __host__ __device__ bool next(int i, Unit& u) const {
        const long L = (long)i * G + c; if (L >= nwg) return false;
        int wgid = (int)L; { const int q = nwg / NXCD, r = nwg % NXCD, xcd = wgid % NXCD, off = wgid / NXCD; wgid = (xcd < r ? xcd * (q + 1) : r * (q + 1) + (xcd - r) * q) + off; }
        const int nig = WGM * nN, gid = wgid / nig, fm = gid * WGM, gsz = (nM - fm) < WGM ? (nM - fm) : WGM;
        u.pm = fm + ((wgid % nig) % gsz); u.pn = (wgid % nig) / gsz; return true;
    }
    __device__ __forceinline__ void a_ready(const Unit&) const {}
    __device__ __forceinline__ void done(const Unit&) const {}
};

__device__ __forceinline__ unsigned cvt_pk_bf16(float lo, float hi) { unsigned r; asm volatile("v_cvt_pk_bf16_f32 %0, %1, %2" : "=v"(r) : "v"(lo), "v"(hi)); return r; }
template <class Epi, class Sched, bool ALIGN_EPI = false, bool SP2 = false>
__device__ __forceinline__ void gemm_phase(PG8_LAS unsigned char* lds, const Gemm g, const Sched& S, const Epi& E) {
    const int tid = phase_tid(), wid = __builtin_amdgcn_readfirstlane(tid >> 6), lane = tid & 63, wr = wid >> 2, wc = wid & 3, fr = lane & 15, fq = lane >> 4;
    const int K = g.K, nt = K / BK;
    unsigned voffA[2], voffB[2];
#pragma unroll
    for (int i = 0; i < 2; ++i) { int R, C; stage_rc(tid * 16 + i * 8192, R, C); const int Rb = Epi::PERM ? ((R & ~31) + perm32(R & 31)) : R;
        voffA[i] = (unsigned)(R * K + C) * 2u; voffB[i] = (unsigned)(Rb * K + C) * 2u; }
    const size_t kstep = (size_t)(BK * 2);
    const size_t hstep = (size_t)HALF * K * 2;
    const size_t tstep = 2 * hstep;
    const unsigned ldsw = (unsigned)wid * 1024u;
    const int aoff = lds_byte(wr * 64 + fr, fq * 8), boff = lds_byte(wc * 32 + fr, fq * 8);
#define PG8_SA(b, h) (((b) * 2 + (h)) * HTB)
#define PG8_SB(b, h) ((4 + (b) * 2 + (h)) * HTB)
#define PG8_STAGE(bufoff, gbase, voff) do { _Pragma("unroll") for (int _i = 0; _i < 2; ++_i) \
        __builtin_amdgcn_global_load_lds((const unsigned*)((const char*)(gbase) + (voff)[_i]), (PG8_LAS unsigned*)(lds + (bufoff) + ldsw + _i * 8192), 16, 0, 0); } while (0)
#define PG8_LDA(dst, b, h) do { _Pragma("unroll") for (int m = 0; m < 4; ++m) _Pragma("unroll") for (int k = 0; k < 2; ++k) dst[m][k] = *(const PG8_LAS bf16x8*)(lds + PG8_SA(b, h) + aoff + m * 2048 + k * 1024); } while (0)
#define PG8_LDB(dst, b, h) do { _Pragma("unroll") for (int n = 0; n < 2; ++n) _Pragma("unroll") for (int k = 0; k < 2; ++k) dst[n][k] = *(const PG8_LAS bf16x8*)(lds + PG8_SB(b, h) + boff + n * 2048 + k * 1024); } while (0)
#define PG8_MMA(ai, bj, At, Bt) do { __builtin_amdgcn_s_setprio(1); _Pragma("unroll") for (int m = 0; m < 4; ++m) _Pragma("unroll") for (int n = 0; n < 2; ++n) _Pragma("unroll") for (int k = 0; k < 2; ++k) \
        acc[ai][bj][m][n] = __builtin_amdgcn_mfma_f32_16x16x32_bf16(Bt[n][k], At[m][k], acc[ai][bj][m][n], 0, 0, 0); __builtin_amdgcn_s_setprio(0); } while (0)
#define PG8_WAIT_V(n) asm volatile("s_waitcnt vmcnt(" #n ")" ::: "memory")
#define PG8_WAIT_L(n) asm volatile("s_waitcnt lgkmcnt(" #n ")" ::: "memory")
#define PG8_BAR __builtin_amdgcn_s_barrier()
#define PG8_SCHED __builtin_amdgcn_sched_barrier(0)
    Unit cur, nxt; int ui = 0;
    if (!S.next(0, cur)) return;
    f32x4 acc[2][2][4][2];
#pragma unroll
    for (int a = 0; a < 2; ++a)
#pragma unroll
        for (int b = 0; b < 2; ++b)
#pragma unroll
            for (int m = 0; m < 4; ++m)
#pragma unroll
                for (int n = 0; n < 2; ++n) acc[a][b][m][n] = (f32x4){0.f, 0.f, 0.f, 0.f};
    bf16x8 At[4][2], B0[2][2], B1[2][2];
    const char* cA = (const char*)g.A + (size_t)cur.pm * tstep; const char* cB = (const char*)g.Bt + (size_t)cur.pn * tstep;
    S.a_ready(cur);
    if constexpr (SP2) {
        PG8_STAGE(PG8_SB(0, 0), cB, voffB); PG8_STAGE(PG8_SB(0, 1), cB + hstep, voffB); PG8_STAGE(PG8_SA(0, 0), cA, voffA); PG8_STAGE(PG8_SA(0, 1), cA + hstep, voffA);
        if (wr == 1) PG8_BAR;
        PG8_WAIT_V(2); PG8_BAR;
        PG8_STAGE(PG8_SB(1, 0), cB + kstep, voffB); PG8_STAGE(PG8_SA(1, 0), cA + kstep, voffA); PG8_STAGE(PG8_SB(1, 1), cB + hstep + kstep, voffB);
        PG8_WAIT_V(6); PG8_BAR;
    } else {
        PG8_STAGE(PG8_SB(0, 0), cB, voffB); PG8_STAGE(PG8_SA(0, 0), cA, voffA); PG8_STAGE(PG8_SB(0, 1), cB + hstep, voffB); PG8_STAGE(PG8_SA(0, 1), cA + hstep, voffA);
        if (wr == 1) PG8_BAR;
        PG8_WAIT_V(4); PG8_BAR;
        PG8_STAGE(PG8_SB(1, 0), cB + kstep, voffB); PG8_STAGE(PG8_SA(1, 0), cA + kstep, voffA); PG8_STAGE(PG8_SB(1, 1), cB + hstep + kstep, voffB);
        PG8_WAIT_V(6); PG8_BAR;
    }
    for (;;) {
        const bool has_next = S.next(ui + 1, nxt);
        const char* nA = has_next ? (const char*)g.A + (size_t)nxt.pm * tstep : cA; const char* nB = has_next ? (const char*)g.Bt + (size_t)nxt.pn * tstep : cB;
        for (int t = 0; t < nt; t += 2) {
            const bool last = (t == nt - 2);
            const char* a1 = cA + (size_t)(t + 1) * kstep;
            const char* a2 = last ? nA : cA + (size_t)(t + 2) * kstep; const char* b2 = last ? nB : cB + (size_t)(t + 2) * kstep;
            const char* a3 = a2 + kstep; const char* b3 = b2 + kstep;
            if (last && has_next) S.a_ready(nxt);
            if constexpr (SP2) {
            PG8_LDB(B0, 0, 0); PG8_LDB(B1, 0, 1); PG8_SCHED; PG8_LDA(At, 0, 0); PG8_STAGE(PG8_SA(1, 1), a1 + hstep, voffA);
            PG8_WAIT_V(8); PG8_WAIT_L(0); PG8_BAR; PG8_MMA(0, 0, At, B0); PG8_MMA(0, 1, At, B1); PG8_BAR; PG8_SCHED;
            PG8_LDA(At, 0, 1); PG8_STAGE(PG8_SB(0, 0), b2, voffB); PG8_STAGE(PG8_SB(0, 1), b2 + hstep, voffB); PG8_STAGE(PG8_SA(0, 0), a2, voffA);
            PG8_WAIT_V(8); PG8_WAIT_L(0); PG8_BAR; PG8_MMA(1, 0, At, B0); PG8_MMA(1, 1, At, B1); PG8_BAR; PG8_SCHED;
            PG8_LDB(B0, 1, 0); PG8_LDB(B1, 1, 1); PG8_SCHED; PG8_LDA(At, 1, 0); PG8_STAGE(PG8_SA(0, 1), a2 + hstep, voffA);
            PG8_WAIT_V(8); PG8_WAIT_L(0); PG8_BAR; PG8_MMA(0, 0, At, B0); PG8_MMA(0, 1, At, B1); PG8_BAR; PG8_SCHED;
            PG8_LDA(At, 1, 1); PG8_STAGE(PG8_SB(1, 0), b3, voffB); PG8_STAGE(PG8_SB(1, 1), b3 + hstep, voffB); PG8_STAGE(PG8_SA(1, 0), a3, voffA);
            PG8_WAIT_V(8); PG8_WAIT_L(0); PG8_BAR; PG8_MMA(1, 0, At, B0); PG8_MMA(1, 1, At, B1); PG8_BAR; PG8_SCHED;
            } else {
            PG8_LDB(B0, 0, 0); PG8_SCHED; PG8_LDA(At, 0, 0); PG8_STAGE(PG8_SA(1, 1), a1 + hstep, voffA);
            PG8_WAIT_L(8); PG8_BAR; PG8_WAIT_L(0); PG8_MMA(0, 0, At, B0); PG8_BAR; PG8_SCHED;
            PG8_LDB(B1, 0, 1); PG8_STAGE(PG8_SB(0, 0), b2, voffB);
            PG8_BAR; PG8_WAIT_L(0); PG8_MMA(0, 1, At, B1); PG8_BAR;
            PG8_LDA(At, 0, 1); PG8_STAGE(PG8_SA(0, 0), a2, voffA);
            PG8_BAR; PG8_WAIT_L(0); PG8_MMA(1, 0, At, B0); PG8_BAR; PG8_SCHED;
            PG8_STAGE(PG8_SB(0, 1), b2 + hstep, voffB);
            PG8_WAIT_V(6); PG8_BAR; PG8_MMA(1, 1, At, B1); PG8_BAR;
            PG8_LDB(B0, 1, 0); PG8_SCHED; PG8_LDA(At, 1, 0); PG8_STAGE(PG8_SA(0, 1), a2 + hstep, voffA);
            PG8_WAIT_L(8); PG8_BAR; PG8_WAIT_L(0); PG8_MMA(0, 0, At, B0); PG8_BAR; PG8_SCHED;
            PG8_LDB(B1, 1, 1); PG8_STAGE(PG8_SB(1, 0), b3, voffB);
            PG8_BAR; PG8_WAIT_L(0); PG8_MMA(0, 1, At, B1); PG8_BAR;
            PG8_LDA(At, 1, 1); PG8_STAGE(PG8_SA(1, 0), a3, voffA);
            PG8_BAR; PG8_WAIT_L(0); PG8_MMA(1, 0, At, B0); PG8_BAR; PG8_SCHED;
            PG8_STAGE(PG8_SB(1, 1), b3 + hstep, voffB);
            PG8_WAIT_V(6); PG8_BAR; PG8_MMA(1, 1, At, B1); PG8_BAR;
            }
        }
        if constexpr (ALIGN_EPI) { if (wr == 0) PG8_BAR; }
        if constexpr (!Epi::AFTER_DRAIN) { E(acc, cur, wr, wc, fr, fq); S.done(cur); }
        if (!has_next) break;
#pragma unroll
        for (int a = 0; a < 2; ++a)
#pragma unroll
            for (int b = 0; b < 2; ++b)
#pragma unroll
                for (int m = 0; m < 4; ++m)
#pragma unroll
                    for (int n = 0; n < 2; ++n) acc[a][b][m][n] = (f32x4){0.f, 0.f, 0.f, 0.f};
        cur = nxt; cA = nA; cB = nB; ++ui;
        if constexpr (ALIGN_EPI) { if (wr == 1) PG8_BAR; }
    }
    PG8_WAIT_V(0);
    if constexpr (!ALIGN_EPI) { if (wr == 0) PG8_BAR; }
    PG8_BAR;
    if constexpr (Epi::AFTER_DRAIN) { E.fused(acc, cur, wr, wc, fr, fq, lds, wid, lane); S.done(cur); }
#undef PG8_SA
#undef PG8_SB
#undef PG8_STAGE
#undef PG8_LDA
#undef PG8_LDB
#undef PG8_MMA
#undef PG8_WAIT_V
#undef PG8_WAIT_L
#undef PG8_BAR
#undef PG8_SCHED
}
}

struct EpiInProj {
    static constexpr bool PERM = true, AFTER_DRAIN = false;
    const float* rstd1; const float* qn; const float* kn; bf16_t *qh, *kh, *vh, *xrg, *gg;
    __device__ __forceinline__ void operator()(const pg8::f32x4 (&acc)[2][2][4][2], const pg8::Unit& u, int wr, int wc, int fr, int fq) const {
        const int region = u.pn >> 1;
        const int head = (u.pn & 1) * 4 + wc;
        pg8::f32x4 gn[2][2];
        if (region <= 1) {
            const float* g = region == 0 ? qn : kn; const float sc = region == 0 ? QSCALE : 1.0f;
#pragma unroll
            for (int bj = 0; bj < 2; ++bj)
#pragma unroll
                for (int n = 0; n < 2; ++n) gn[bj][n] = *(const pg8::f32x4*)(g + 32 * bj + 8 * fq + 4 * n) * sc;
        }
#pragma unroll
        for (int ai = 0; ai < 2; ++ai)
#pragma unroll
            for (int m = 0; m < 4; ++m) {
                const int row = u.pm * 256 + ai * 128 + wr * 64 + m * 16 + fr;
                const float rs = rstd1[row];
                pg8::f32x4 v[2][2];
#pragma unroll
                for (int bj = 0; bj < 2; ++bj)
#pragma unroll
                    for (int n = 0; n < 2; ++n) v[bj][n] = acc[ai][bj][m][n] * rs;
                bf16_t* dst;
                if (region <= 1) {
                    float ss = 0.f;
#pragma unroll
                    for (int bj = 0; bj < 2; ++bj)
#pragma unroll
                        for (int n = 0; n < 2; ++n) ss += (v[bj][n][0] * v[bj][n][0] + v[bj][n][1] * v[bj][n][1]) + (v[bj][n][2] * v[bj][n][2] + v[bj][n][3] * v[bj][n][3]);
                    ss += __shfl_xor(ss, 16); ss += __shfl_xor(ss, 32);
                    const float rn = rsqrtf(ss * (1.0f / HD) + EPS);
#pragma unroll
                    for (int bj = 0; bj < 2; ++bj)
#pragma unroll
                        for (int n = 0; n < 2; ++n) v[bj][n] = v[bj][n] * rn * gn[bj][n];
                    dst = (region == 0 ? qh : kh) + ((size_t)head * S + row) * HD;
                } else if (region == 2) {
#pragma unroll
                    for (int bj = 0; bj < 2; ++bj)
#pragma unroll
                        for (int n = 0; n < 2; ++n)
#pragma unroll
                            for (int i = 0; i < 4; ++i) vh[((size_t)head * HD + 32 * bj + 8 * fq + 4 * n + i) * S + row] = (bf16_t)f2bf(v[bj][n][i]);
                    continue;
                } else if (region == 3) {
                    dst = xrg + (size_t)row * DRG + head * 64;
                } else {
#pragma unroll
                    for (int bj = 0; bj < 2; ++bj)
#pragma unroll
                        for (int n = 0; n < 2; ++n)
#pragma unroll
                            for (int i = 0; i < 4; ++i) v[bj][n][i] = gelu_tanh(v[bj][n][i]);
                    dst = gg + (size_t)row * DRG + head * 64;
                }
#pragma unroll
                for (int bj = 0; bj < 2; ++bj) {
                    pg8::u32x4 w; w.x = pg8::cvt_pk_bf16(v[bj][0][0], v[bj][0][1]); w.y = pg8::cvt_pk_bf16(v[bj][0][2], v[bj][0][3]);
                    w.z = pg8::cvt_pk_bf16(v[bj][1][0], v[bj][1][1]); w.w = pg8::cvt_pk_bf16(v[bj][1][2], v[bj][1][3]);
                    *(pg8::u32x4*)(dst + 32 * bj + 8 * fq) = w;
                }
            }
    }
};
struct EpiOutProj {
    static constexpr bool PERM = true, AFTER_DRAIN = false;
    const float* x; float* out; bf16_t* x1b; float* ssq;
    __device__ __forceinline__ void operator()(const pg8::f32x4 (&acc)[2][2][4][2], const pg8::Unit& u, int wr, int wc, int fr, int fq) const {
#pragma unroll
        for (int ai = 0; ai < 2; ++ai)
#pragma unroll
            for (int m = 0; m < 4; ++m) {
                const int row = u.pm * 256 + ai * 128 + wr * 64 + m * 16 + fr;
                float ss = 0.f;
#pragma unroll
                for (int bj = 0; bj < 2; ++bj) {
                    const size_t o = (size_t)row * D + u.pn * 256 + bj * 128 + wc * 32 + 8 * fq;
                    const pg8::f32x4 a = *(const pg8::f32x4*)(x + o) + acc[ai][bj][m][0], b = *(const pg8::f32x4*)(x + o + 4) + acc[ai][bj][m][1];
                    *(pg8::f32x4*)(out + o) = a; *(pg8::f32x4*)(out + o + 4) = b;
                    ss += (a[0] * a[0] + a[1] * a[1]) + (a[2] * a[2] + a[3] * a[3]) + (b[0] * b[0] + b[1] * b[1]) + (b[2] * b[2] + b[3] * b[3]);
                    pg8::u32x4 w; w.x = pg8::cvt_pk_bf16(a[0], a[1]); w.y = pg8::cvt_pk_bf16(a[2], a[3]); w.z = pg8::cvt_pk_bf16(b[0], b[1]); w.w = pg8::cvt_pk_bf16(b[2], b[3]);
                    *(pg8::u32x4*)(x1b + o) = w;
                }
                ss += __shfl_xor(ss, 16); ss += __shfl_xor(ss, 32);
                if (fq == 0) ssq[(size_t)row * 16 + u.pn * 4 + wc] = ss;
            }
    }
};
struct EpiPeerQ {
    static constexpr bool PERM = true, AFTER_DRAIN = false;
    bf16_t* qp;
    __device__ __forceinline__ void operator()(const pg8::f32x4 (&acc)[2][2][4][2], const pg8::Unit& u, int wr, int wc, int fr, int fq) const {
#pragma unroll
        for (int ai = 0; ai < 2; ++ai)
#pragma unroll
            for (int m = 0; m < 4; ++m) {
                const int row = u.pm * 256 + ai * 128 + wr * 64 + m * 16 + fr;
#pragma unroll
                for (int bj = 0; bj < 2; ++bj) {
                    const pg8::f32x4 a = acc[ai][bj][m][0], b = acc[ai][bj][m][1];
                    pg8::u32x4 w; w.x = pg8::cvt_pk_bf16(a[0], a[1]); w.y = pg8::cvt_pk_bf16(a[2], a[3]); w.z = pg8::cvt_pk_bf16(b[0], b[1]); w.w = pg8::cvt_pk_bf16(b[2], b[3]);
                    *(pg8::u32x4*)(qp + (size_t)row * NQ + u.pn * 256 + bj * 128 + wc * 32 + 8 * fq) = w;
                }
            }
    }
};

typedef float f32x2v __attribute__((ext_vector_type(2)));
typedef __bf16 bf16x2v __attribute__((ext_vector_type(2)));
__device__ __forceinline__ unsigned cvtpk(float lo, float hi) { const f32x2v v = {lo, hi}; const bf16x2v b = __builtin_convertvector(v, bf16x2v); return __builtin_bit_cast(unsigned, b); }
__device__ __forceinline__ bf16x8 pack_step(const f32x16& x, int s) {
    u32x4 pkd; pkd.x = cvtpk(x[8 * s], x[8 * s + 1]); pkd.y = cvtpk(x[8 * s + 2], x[8 * s + 3]); pkd.z = cvtpk(x[8 * s + 4], x[8 * s + 5]); pkd.w = cvtpk(x[8 * s + 6], x[8 * s + 7]);
    return __builtin_bit_cast(bf16x8, pkd);
}
#define MFMA32(a, b, c) __builtin_amdgcn_mfma_f32_32x32x16_bf16((a), (b), (c), 0, 0, 0)
__device__ __forceinline__ void ph_attn(const Params& p) {
    unsigned char* ws = p.ws;
    const bf16_t* qh = (const bf16_t*)(ws + WS_QH); const bf16_t* kh = (const bf16_t*)(ws + WS_KH); const bf16_t* vT = (const bf16_t*)(ws + WS_VH);
    bf16_t* osb = (bf16_t*)(ws + WS_OSB);
    const int tid = phase_tid(), lane = tid & 63, r = lane & 31, hh = lane >> 5;
    const int gwave = (blockIdx.x * blockDim.x + tid) >> 6, nwave = (gridDim.x * blockDim.x) >> 6;
    bf16x8 tp[2];
#pragma unroll
    for (int ss = 0; ss < 2; ++ss)
#pragma unroll
        for (int e = 0; e < 8; ++e) { const int k = 16 * ss + 8 * (e >> 2) + 4 * hh + (e & 3); tp[ss][e] = (k > r) ? (short)0x3F80 : (short)0; }
    f32x16 zero16;
#pragma unroll
    for (int i = 0; i < 16; ++i) zero16[i] = 0.f;
    for (int u = gwave; u < NH * (S / 32); u += nwave) {
        const int h = u / (S / 32), t0 = (u % (S / 32)) * 32;
        bf16x8 bq[4];
#pragma unroll
        for (int s = 0; s < 4; ++s) bq[s] = *(const bf16x8*)(qh + ((size_t)h * S + t0 + r) * HD + 16 * s + 8 * hh);
        f32x16 ot[2] = {zero16, zero16};
        float carry = 0.f;
        for (int kt0 = t0; kt0 >= 0; kt0 -= 32) {
            bf16x8 ak[4], av[2][2];
#pragma unroll
            for (int s = 0; s < 4; ++s) ak[s] = *(const bf16x8*)(kh + ((size_t)h * S + kt0 + r) * HD + 16 * s + 8 * hh);
#pragma unroll
            for (int dt = 0; dt < 2; ++dt)
#pragma unroll
                for (int ss = 0; ss < 2; ++ss) {
                    const bf16_t* vp = vT + ((size_t)h * HD + 32 * dt + r) * S + kt0 + 16 * ss + 4 * hh;
                    const uint2 lo = *(const uint2*)vp, hi = *(const uint2*)(vp + 8);
                    u32x4 w4; w4.x = lo.x; w4.y = lo.y; w4.z = hi.x; w4.w = hi.y;
                    av[dt][ss] = __builtin_bit_cast(bf16x8, w4);
                }
            f32x16 st = zero16;
#pragma unroll
            for (int s = 0; s < 4; ++s) st = MFMA32(ak[s], bq[s], st);
            const bool diag = (kt0 == t0);
            f32x16 lom, lb;
            float csum = 0.f;
#pragma unroll
            for (int i = 0; i < 16; ++i) {
                const float z = st[i];
                const float sp2 = fmaxf(z, 0.f) + __builtin_amdgcn_logf(1.0f + __builtin_amdgcn_exp2f(-fabsf(z)));
                const bool valid = !diag || ((i & 3) + 8 * (i >> 2) + 4 * hh < r);
                lom[i] = valid ? -sp2 : 0.f;
                lb[i] = z - sp2;
                csum += lom[i];
            }
            f32x16 suf = MFMA32(tp[0], pack_step(lom, 0), zero16);
            suf = MFMA32(tp[1], pack_step(lom, 1), suf);
            f32x16 w;
#pragma unroll
            for (int i = 0; i < 16; ++i) {
                const bool valid = !diag || ((i & 3) + 8 * (i >> 2) + 4 * hh < r);
                w[i] = valid ? __builtin_amdgcn_exp2f(lb[i] + suf[i] + carry) : 0.f;
            }
            const bf16x8 w0 = pack_step(w, 0), w1 = pack_step(w, 1);
#pragma unroll
            for (int dt = 0; dt < 2; ++dt) { ot[dt] = MFMA32(av[dt][0], w0, ot[dt]); ot[dt] = MFMA32(av[dt][1], w1, ot[dt]); }
            carry += csum + __shfl_xor(csum, 32);
            if (__all(carry < CARRY_STOP)) break;
        }
#pragma unroll
        for (int dt = 0; dt < 2; ++dt)
#pragma unroll
            for (int g = 0; g < 4; ++g) {
                uint2 o; o.x = cvtpk(ot[dt][4 * g], ot[dt][4 * g + 1]); o.y = cvtpk(ot[dt][4 * g + 2], ot[dt][4 * g + 3]);
                *(uint2*)(osb + (size_t)(t0 + r) * DSB + h * HD + 32 * dt + 8 * g + 4 * hh) = o;
            }
    }
}

constexpr int RG_LDS_CST = 0, RG_LDS_HIN = 16384, RG_LDS_P = 18432, RG_LDS_SSQ = 20480;
constexpr int RG_LDS_X = 22528, RG_XP = 1032, RG_LDS_O = 91904;
typedef unsigned u32x2 __attribute__((ext_vector_type(2)));
typedef __attribute__((address_space(3))) float lds_f;
typedef __attribute__((address_space(3))) unsigned char lds_b;
template <int CTRL, int ROWMASK>
__device__ __forceinline__ float dpp_mov(float oob, float x) {
    return __builtin_bit_cast(float, __builtin_amdgcn_update_dpp(__builtin_bit_cast(int, oob), __builtin_bit_cast(int, x), CTRL, ROWMASK, 0xf, false));
}
template <int CTRL, int ROWMASK>
__device__ __forceinline__ void scan_step(float (&av)[16], float (&bv)[16]) {
#pragma unroll
    for (int i = 0; i < 16; ++i) {
        const float ap = dpp_mov<CTRL, ROWMASK>(1.0f, av[i]), bp = dpp_mov<CTRL, ROWMASK>(0.0f, bv[i]);
        bv[i] = __builtin_fmaf(av[i], bp, bv[i]); av[i] *= ap;
    }
}
template <int PASS>
__device__ __forceinline__ void ph_rg(const Params& p, unsigned char* lds_raw) {
    float* lds = (float*)lds_raw;
    unsigned char* ws = p.ws;
    const bf16_t* xrg = (const bf16_t*)(ws + WS_XRG); const bf16_t* gg = (const bf16_t*)(ws + WS_GG); const bf16_t* wfrag = (const bf16_t*)(ws + WS_RGW);
    const bf16_t* osb = (const bf16_t*)(ws + WS_OSB); bf16_t* mix = (bf16_t*)(ws + WS_MIX);
    float* rgP = (float*)(ws + WS_RGP); float* rgH = (float*)(ws + WS_RGH);
    const int tid = phase_tid(), lane = tid & 63, r = lane & 31, hh = lane >> 5, n = __builtin_amdgcn_readfirstlane(tid >> 6);
    __syncthreads();
    for (int e = tid; e < 8 * 2 * 8 * 32; e += NTHR) {
        const int q = e & 31, k = (e >> 5) & 7, h2 = (e >> 8) & 1, nn = e >> 9;
        const int c = 64 * nn + 32 * (q >> 4) + (q & 3) + 8 * ((q >> 2) & 3) + 4 * h2;
        float v;
        if (k < 4) v = p.in[I_CONV_W][k * DRG + c];
        else if (k == 4) v = p.in[I_CONV_B][c];
        else if (k == 5) v = p.in[I_RG_B_A][c];
        else if (k == 6) v = p.in[I_RG_B_X][c];
        else v = 8.0f * LOG2E * log1pf(__expf(-p.in[I_RG_LAMBDA][c]));
        lds[e] = v;
    }
    const unsigned lds0 = (unsigned)(size_t)((lds_b*)lds_raw);
    const unsigned cst_base = lds0 + (unsigned)((n * 2 + hh) * 1024);
    lds_f* hin_l = (lds_f*)(size_t)(lds0 + RG_LDS_HIN + (n * 2 + hh) * 128);
    lds_f* pc_l = (lds_f*)(size_t)(lds0 + RG_LDS_P + (n * 2 + hh) * 128);
    lds_b* xt = (lds_b*)(size_t)(lds0 + RG_LDS_X);
    lds_b* ot = (lds_b*)(size_t)(lds0 + RG_LDS_O);
    f32x16 zero16;
#pragma unroll
    for (int i = 0; i < 16; ++i) zero16[i] = 0.f;
    for (int ch = blockIdx.x; ch < NCHUNK; ch += gridDim.x) {
        const int t0 = ch * CHUNK;
        __syncthreads();
        for (int ci = tid; ci < (CHUNK + 3) * 64; ci += NTHR) {
            const int row = ci >> 6, c16 = ci & 63, tt = t0 - 3 + row;
            u32x4 v = {0u, 0u, 0u, 0u};
            if (tt >= 0) v = *(const u32x4*)(xrg + (size_t)tt * DRG + 8 * c16);
            __attribute__((address_space(3))) u32x2* d = (__attribute__((address_space(3))) u32x2*)(xt + row * RG_XP + 16 * c16);
            d[0] = (u32x2){v.x, v.y}; d[1] = (u32x2){v.z, v.w};
        }
        if (PASS == 1) {
            const int c = 64 * n + lane;
            float h = 0.f;
            int k = 0;
            for (; k + 16 <= ch; k += 16) {
                float pv[16], hv[16];
#pragma unroll
                for (int j = 0; j < 16; ++j) { pv[j] = rgP[(k + j) * DRG + c]; hv[j] = rgH[(k + j) * DRG + c]; }
#pragma unroll
                for (int j = 0; j < 16; ++j) h = pv[j] * h + hv[j];
            }
            for (; k < ch; ++k) h = rgP[k * DRG + c] * h + rgH[k * DRG + c];
            lds[RG_LDS_HIN / 4 + (n * 2 + ((lane >> 2) & 1)) * 32 + 16 * (lane >> 5) + 4 * ((lane >> 3) & 3) + (lane & 3)] = h;
        } else {
            if (r == 0) {
#pragma unroll
                for (int q = 0; q < 32; ++q) { hin_l[q] = 0.f; pc_l[q] = 1.f; }
            }
        }
        __syncthreads();
#pragma unroll 1
        for (int tl = 0; tl < 2; ++tl) {
            const int tok = t0 + 32 * tl + r;
            unsigned cst_a = cst_base; asm volatile("" : "+v"(cst_a));
            const lds_f* cst = (const lds_f*)(size_t)cst_a;
            float xcv[32];
#pragma unroll
            for (int q = 0; q < 32; ++q) xcv[q] = cst[4 * 32 + q];
#pragma unroll
            for (int k = 0; k < 4; ++k) {
                const lds_b* xr = xt + (32 * tl + r + k) * RG_XP + (64 * n + 4 * hh) * 2;
#pragma unroll
                for (int m = 0; m < 8; ++m) {
                    const u32x2 xw = *(const __attribute__((address_space(3))) u32x2*)(xr + 16 * m);
                    xcv[4 * m + 0] += cst[k * 32 + 4 * m + 0] * bf2f(xw.x & 0xffffu); xcv[4 * m + 1] += cst[k * 32 + 4 * m + 1] * bf2f(xw.x >> 16);
                    xcv[4 * m + 2] += cst[k * 32 + 4 * m + 2] * bf2f(xw.y & 0xffffu); xcv[4 * m + 3] += cst[k * 32 + 4 * m + 3] * bf2f(xw.y >> 16);
                }
                __builtin_amdgcn_sched_barrier(0);
            }
            bf16x8 bx[4];
#pragma unroll
            for (int s = 0; s < 4; ++s) {
                u32x4 pk; pk.x = cvtpk(xcv[8 * s], xcv[8 * s + 1]); pk.y = cvtpk(xcv[8 * s + 2], xcv[8 * s + 3]); pk.z = cvtpk(xcv[8 * s + 4], xcv[8 * s + 5]); pk.w = cvtpk(xcv[8 * s + 6], xcv[8 * s + 7]);
                bx[s] = __builtin_bit_cast(bf16x8, pk);
            }
            float ss = 0.f;
            const bf16_t* wb = wfrag + ((size_t)n * 16 * 64 + lane) * 8; asm volatile("" : "+v"(wb));
#pragma unroll
            for (int jt = 0; jt < 2; ++jt) {
                float av[16], bv[16];
#pragma unroll
                for (int g = 0; g < 2; ++g) {
                    f32x16 acc = zero16;
#pragma unroll
                    for (int s = 0; s < 4; ++s) {
                        const bf16x8 aw = *(const __attribute__((address_space(1))) bf16x8*)(wb + (((g * 2 + jt) * 4 + s) * 64) * 8);
                        acc = MFMA32(aw, bx[s], acc);
                    }
#pragma unroll
                    for (int i = 0; i < 16; ++i) {
                        const int q = 16 * jt + i;
                        const float pre = acc[i] + cst[(5 + g) * 32 + q];
                        const float sg = 1.0f / (1.0f + __builtin_amdgcn_exp2f(-LOG2E * pre));
                        if (g == 0) av[i] = __builtin_amdgcn_exp2f(-sg * cst[7 * 32 + q]);
                        else bv[i] = __builtin_amdgcn_sqrtf(fmaxf(__builtin_fmaf(-av[i], av[i], 1.0f), 0.f)) * (sg * xcv[q]);
                    }
                    __builtin_amdgcn_sched_barrier(0);
                }
                scan_step<0x111, 0xf>(av, bv); scan_step<0x112, 0xf>(av, bv); scan_step<0x114, 0xf>(av, bv); scan_step<0x118, 0xf>(av, bv);
                scan_step<0x142, 0xa>(av, bv);
                __builtin_amdgcn_sched_barrier(0);
#pragma unroll
                for (int i = 0; i < 16; ++i) {
                    const int q = 16 * jt + i;
                    const float h = __builtin_fmaf(av[i], hin_l[q], bv[i]);
                    if (r == 31) { hin_l[q] = h; if (PASS == 0) pc_l[q] *= av[i]; }
                    bv[i] = h;
                }
                if (PASS == 1) {
#pragma unroll
                    for (int g4 = 0; g4 < 4; ++g4) {
                        const int m = 4 * jt + g4;
                        const uint2 gw = *(const uint2*)(gg + (size_t)tok * DRG + 64 * n + 8 * m + 4 * hh);
                        const float o0 = bv[4 * g4] * bf2f(gw.x & 0xffffu), o1 = bv[4 * g4 + 1] * bf2f(gw.x >> 16), o2 = bv[4 * g4 + 2] * bf2f(gw.y & 0xffffu), o3 = bv[4 * g4 + 3] * bf2f(gw.y >> 16);
                        ss += (o0 * o0 + o1 * o1) + (o2 * o2 + o3 * o3);
                        *(__attribute__((address_space(3))) u32x2*)(ot + (32 * tl + r) * RG_XP + (64 * n + 8 * m + 4 * hh) * 2) = (u32x2){cvtpk(o0, o1), cvtpk(o2, o3)};
                    }
                }
                __builtin_amdgcn_sched_barrier(0);
            }
            if (PASS == 1) { ss += __shfl_xor(ss, 32); if (hh == 0) lds[RG_LDS_SSQ / 4 + (tl * 8 + n) * 32 + r] = ss; }
        }
        if (PASS == 0) {
            if (r == 0) {
#pragma unroll
                for (int m = 0; m < 8; ++m) {
                    const int c = 64 * n + 8 * m + 4 * hh;
                    *(f32x4*)(rgP + (size_t)ch * DRG + c) = (f32x4){pc_l[4 * m], pc_l[4 * m + 1], pc_l[4 * m + 2], pc_l[4 * m + 3]};
                    *(f32x4*)(rgH + (size_t)ch * DRG + c) = (f32x4){hin_l[4 * m], hin_l[4 * m + 1], hin_l[4 * m + 2], hin_l[4 * m + 3]};
                }
            }
        } else {
            __syncthreads();
            for (int j = 0; j < 8; ++j) {
                const int tr = 8 * n + j, tok = t0 + tr;
                float tot = 0.f;
#pragma unroll
                for (int w = 0; w < 8; ++w) tot += lds[RG_LDS_SSQ / 4 + ((tr >> 5) * 8 + w) * 32 + (tr & 31)];
                const float rn = rsqrtf(tot * (1.0f / DRG) + EPS);
                const __attribute__((address_space(3))) u32x2* op = (const __attribute__((address_space(3))) u32x2*)(ot + tr * RG_XP + 16 * lane);
                const u32x2 w0 = op[0], w1 = op[1];
                u32x4 o2; o2.x = cvtpk(bf2f(w0.x & 0xffffu) * rn, bf2f(w0.x >> 16) * rn); o2.y = cvtpk(bf2f(w0.y & 0xffffu) * rn, bf2f(w0.y >> 16) * rn);
                o2.z = cvtpk(bf2f(w1.x & 0xffffu) * rn, bf2f(w1.x >> 16) * rn); o2.w = cvtpk(bf2f(w1.y & 0xffffu) * rn, bf2f(w1.y >> 16) * rn);
                *((u32x4*)(mix + (size_t)tok * D + DSB) + lane) = o2;
                const u32x4 a = *((const u32x4*)(osb + (size_t)tok * DSB) + lane);
                float f[8] = {bf2f(a.x & 0xffffu), bf2f(a.x >> 16), bf2f(a.y & 0xffffu), bf2f(a.y >> 16), bf2f(a.z & 0xffffu), bf2f(a.z >> 16), bf2f(a.w & 0xffffu), bf2f(a.w >> 16)};
                float sa = 0.f;
#pragma unroll
                for (int k = 0; k < 8; ++k) sa += f[k] * f[k];
                sa = wave_sum(sa);
                const float ra = rsqrtf(sa * (1.0f / DSB) + EPS);
                u32x4 o; o.x = cvtpk(f[0] * ra, f[1] * ra); o.y = cvtpk(f[2] * ra, f[3] * ra); o.z = cvtpk(f[4] * ra, f[5] * ra); o.w = cvtpk(f[6] * ra, f[7] * ra);
                *((u32x4*)(mix + (size_t)tok * D) + lane) = o;
            }
        }
    }
}

__device__ __forceinline__ int f2key(float f) { const int b = __builtin_bit_cast(int, f); return b ^ ((b >> 31) & 0x7fffffff); }
__device__ __forceinline__ float key2f(int k) { return __builtin_bit_cast(float, k ^ ((k >> 31) & 0x7fffffff)); }
__device__ __forceinline__ void topk_insert(int (&lst)[16], int x) {
#pragma unroll
    for (int i = 0; i < 16; ++i) { const int hi = max(lst[i], x); x = min(lst[i], x); lst[i] = hi; }
}
#define TOPK_CE(a, b) do { const int hi_ = max(a, b), lo_ = min(a, b); a = hi_; b = lo_; } while (0)
__device__ __forceinline__ void sort16_desc(int (&v)[16]) { TOPK_CE(v[0], v[1]); TOPK_CE(v[2], v[3]); TOPK_CE(v[0], v[2]); TOPK_CE(v[1], v[3]); TOPK_CE(v[1], v[2]); TOPK_CE(v[4], v[5]); TOPK_CE(v[6], v[7]); TOPK_CE(v[4], v[6]); TOPK_CE(v[5], v[7]); TOPK_CE(v[5], v[6]); TOPK_CE(v[0], v[4]); TOPK_CE(v[2], v[6]); TOPK_CE(v[2], v[4]); TOPK_CE(v[1], v[5]); TOPK_CE(v[3], v[7]); TOPK_CE(v[3], v[5]); TOPK_CE(v[1], v[2]); TOPK_CE(v[3], v[4]); TOPK_CE(v[5], v[6]); TOPK_CE(v[8], v[9]); TOPK_CE(v[10], v[11]); TOPK_CE(v[8], v[10]); TOPK_CE(v[9], v[11]); TOPK_CE(v[9], v[10]); TOPK_CE(v[12], v[13]); TOPK_CE(v[14], v[15]); TOPK_CE(v[12], v[14]); TOPK_CE(v[13], v[15]); TOPK_CE(v[13], v[14]); TOPK_CE(v[8], v[12]); TOPK_CE(v[10], v[14]); TOPK_CE(v[10], v[12]); TOPK_CE(v[9], v[13]); TOPK_CE(v[11], v[15]); TOPK_CE(v[11], v[13]); TOPK_CE(v[9], v[10]); TOPK_CE(v[11], v[12]); TOPK_CE(v[13], v[14]); TOPK_CE(v[0], v[8]); TOPK_CE(v[4], v[12]); TOPK_CE(v[4], v[8]); TOPK_CE(v[2], v[10]); TOPK_CE(v[6], v[14]); TOPK_CE(v[6], v[10]); TOPK_CE(v[2], v[4]); TOPK_CE(v[6], v[8]); TOPK_CE(v[10], v[12]); TOPK_CE(v[1], v[9]); TOPK_CE(v[5], v[13]); TOPK_CE(v[5], v[9]); TOPK_CE(v[3], v[11]); TOPK_CE(v[7], v[15]); TOPK_CE(v[7], v[11]); TOPK_CE(v[3], v[5]); TOPK_CE(v[7], v[9]); TOPK_CE(v[11], v[13]); TOPK_CE(v[1], v[2]); TOPK_CE(v[3], v[4]); TOPK_CE(v[5], v[6]); TOPK_CE(v[7], v[8]); TOPK_CE(v[9], v[10]); TOPK_CE(v[11], v[12]); TOPK_CE(v[13], v[14]); }
__device__ __forceinline__ void merge16_desc(int (&a)[16], const int (&b)[16]) {
#pragma unroll
    for (int i = 0; i < 16; ++i) a[i] = max(a[i], b[15 - i]);
#pragma unroll
    for (int d = 8; d >= 1; d >>= 1)
#pragma unroll
        for (int i = 0; i < 16; ++i) if ((i & d) == 0) TOPK_CE(a[i], a[i + d]);
}
__device__ __forceinline__ void ph_topk(const Params& p, int* lds) {
    unsigned char* ws = p.ws;
    const bf16_t* qp = (const bf16_t*)(ws + WS_B); const bf16_t* subk = (const bf16_t*)(ws + WS_SUBK);
    int* seli = (int*)(ws + WS_SELI); float* selg = (float*)(ws + WS_SELG);
    const float* ssq = (const float*)(ws + WS_SSQ); float* rstd2 = (float*)(ws + WS_RSTD2);
    const int tid = phase_tid(), lane = tid & 63, r = lane & 31, hh = lane >> 5, hx = 4 * hh;
    const int gwave = (blockIdx.x * blockDim.x + tid) >> 6, nwave = (gridDim.x * blockDim.x) >> 6;
    constexpr int SK_OFF = 65536, SK_PITCH = 272;
    typedef __attribute__((address_space(3))) unsigned char lds_b;
    lds_b* skl = (lds_b*)lds + SK_OFF;
    const int w = tid >> 6;
    for (int ub = blockIdx.x * (NTHR / 64); ub < (S / 32) * PH; ub += gridDim.x * (NTHR / 64)) {
        const int u = ub + w;
        const int h = ub / (S / 32), t0 = (u % (S / 32)) * 32, t = t0 + r;
        __syncthreads();
#pragma unroll
        for (int j = 0; j < 8; ++j) {
            const int ci = tid + NTHR * j, row = ci >> 4, c16 = ci & 15;
            const u32x4 v = *(const u32x4*)(subk + ((size_t)h * 256 + row) * PHALF + 8 * c16);
            *(__attribute__((address_space(3))) u32x4*)(skl + row * SK_PITCH + 16 * c16) = v;
        }
        __syncthreads();
        int tk[2][16];
#pragma unroll
        for (int pp = 0; pp < 2; ++pp) {
            f32x16 acc[4];
#pragma unroll
            for (int T = 0; T < 4; ++T)
#pragma unroll
                for (int i = 0; i < 16; ++i) acc[T][i] = 0.f;
            const bf16_t* qrow = qp + (size_t)t * NQ + h * PDK + pp * PHALF + 8 * hh;
            const lds_b* krow = skl + (pp * PNK + r) * SK_PITCH + 16 * hh;
#pragma unroll
            for (int s = 0; s < 8; ++s) {
                const bf16x8 b = *(const bf16x8*)(qrow + 16 * s);
#pragma unroll
                for (int T = 0; T < 4; ++T) {
                    const bf16x8 a = *(const __attribute__((address_space(3))) bf16x8*)(krow + (32 * T) * SK_PITCH + 32 * s);
                    acc[T] = __builtin_amdgcn_mfma_f32_32x32x16_bf16(a, b, acc[T], 0, 0, 0);
                }
            }
            int kq[4][16];
#pragma unroll
            for (int T = 0; T < 4; ++T) {
#pragma unroll
                for (int i = 0; i < 16; ++i) {
                    const int nb = 32 * T + (i & 3) + 8 * (i >> 2);
                    kq[T][i] = ((f2key(acc[T][i]) & ~127) | (127 - nb)) ^ hx;
                }
                sort16_desc(kq[T]);
            }
            merge16_desc(kq[0], kq[1]); merge16_desc(kq[2], kq[3]); merge16_desc(kq[0], kq[2]);
            int m[16], po[16];
#pragma unroll
            for (int i = 0; i < 16; ++i) { m[i] = kq[0][i]; po[i] = __shfl_xor(kq[0][i], 32); }
            merge16_desc(m, po);
#pragma unroll
            for (int i = 0; i < 16; ++i) tk[pp][i] = m[i];
        }
#pragma unroll
        for (int i = 0; i < 16; ++i) { lds[i * NTHR + tid] = tk[0][i]; lds[(16 + i) * NTHR + tid] = tk[1][i]; }
        float v0[16], v1[16];
#pragma unroll
        for (int i = 0; i < 16; ++i) { v0[i] = key2f(tk[0][i]); v1[i] = key2f(tk[1][i]); }
#define CKEY(a, b) ((f2key(v0[a] + v1[b]) & ~255) | (255 - ((a) * 16 + (b))))
        const int NEGK = (int)0x80000000;
        int bk[16], l1[16], ga[16], gb[16];
#pragma unroll
        for (int b = 0; b < 16; ++b) bk[b] = CKEY(0, b);
#pragma unroll
        for (int b = 0; b < 16; ++b) l1[b] = b < 8 ? CKEY(1, b) : NEGK;
        ga[0] = CKEY(2, 0); ga[1] = CKEY(2, 1); ga[2] = CKEY(2, 2); ga[3] = CKEY(2, 3); ga[4] = CKEY(2, 4);
        ga[5] = CKEY(3, 0); ga[6] = CKEY(3, 1); ga[7] = CKEY(3, 2); ga[8] = CKEY(3, 3);
        ga[9] = CKEY(4, 0); ga[10] = CKEY(4, 1); ga[11] = CKEY(4, 2); ga[12] = CKEY(5, 0); ga[13] = CKEY(5, 1); ga[14] = NEGK; ga[15] = NEGK;
        gb[0] = CKEY(6, 0); gb[1] = CKEY(6, 1); gb[2] = CKEY(7, 0); gb[3] = CKEY(7, 1);
#pragma unroll
        for (int a = 8; a < 16; ++a) gb[a - 4] = CKEY(a, 0);
        gb[12] = NEGK; gb[13] = NEGK; gb[14] = NEGK; gb[15] = NEGK;
#undef CKEY
        sort16_desc(ga); sort16_desc(gb);
        merge16_desc(bk, l1); merge16_desc(ga, gb); merge16_desc(bk, ga);
        float ssum = 0.f;
#pragma unroll
        for (int i = 0; i < 4; ++i) { const f32x4 q4 = *(const f32x4*)(ssq + (size_t)t * 16 + 4 * i); ssum += (q4.x + q4.y) + (q4.z + q4.w); }
        const float rs = rsqrtf(ssum * (1.0f / D) + EPS);
        float e[16], sum = 0.f; const float mx = key2f(bk[0]);
#pragma unroll
        for (int i = 0; i < 16; ++i) { e[i] = __expf((key2f(bk[i]) - mx) * rs); sum += e[i]; }
        const float inv = 1.0f / sum;
        int eidx[16];
#pragma unroll
        for (int i = 0; i < 16; ++i) {
            const int code = 255 - (bk[i] & 255), a = code >> 4, b = code & 15;
            const int i1 = 127 - (lds[a * NTHR + tid] & 127), i2 = 127 - (lds[(16 + b) * NTHR + tid] & 127);
            eidx[i] = i1 * PNK + i2; e[i] *= inv;
        }
        if (hh == 0) {
            int4* o = (int4*)(seli + (size_t)t * 128 + h * 16);
#pragma unroll
            for (int i = 0; i < 4; ++i) o[i] = make_int4(eidx[4 * i], eidx[4 * i + 1], eidx[4 * i + 2], eidx[4 * i + 3]);
            if (h == 0) rstd2[t] = rs;
        } else {
            f32x4* o = (f32x4*)(selg + (size_t)t * 128 + h * 16);
#pragma unroll
            for (int i = 0; i < 4; ++i) o[i] = (f32x4){e[4 * i], e[4 * i + 1], e[4 * i + 2], e[4 * i + 3]};
        }
    }
}

__device__ __forceinline__ void unpack8(const u32x4 a, float (&f)[8]) {
    f[0] = bf2f(a.x & 0xffff); f[1] = bf2f(a.x >> 16); f[2] = bf2f(a.y & 0xffff); f[3] = bf2f(a.y >> 16);
    f[4] = bf2f(a.z & 0xffff); f[5] = bf2f(a.z >> 16); f[6] = bf2f(a.w & 0xffff); f[7] = bf2f(a.w >> 16);
}
typedef __bf16 bf16x2_t __attribute__((ext_vector_type(2)));
__device__ __forceinline__ float dot2_bf16(unsigned a, unsigned b, float c) { return __builtin_amdgcn_fdot2_f32_bf16(__builtin_bit_cast(bf16x2_t, a), __builtin_bit_cast(bf16x2_t, b), c, false); }
__device__ __forceinline__ float dot8_bf16(const u32x4 a, const u32x4 b, float c) {
    c = dot2_bf16(a.x, b.x, c); c = dot2_bf16(a.y, b.y, c); c = dot2_bf16(a.z, b.z, c); c = dot2_bf16(a.w, b.w, c);
    return c;
}
__device__ __forceinline__ void axpy8_bf16(float (&acc)[16], int o, const u32x4 w, float c) {
    acc[o + 0] += c * __builtin_bit_cast(float, w.x << 16); acc[o + 1] += c * __builtin_bit_cast(float, w.x & 0xffff0000u);
    acc[o + 2] += c * __builtin_bit_cast(float, w.y << 16); acc[o + 3] += c * __builtin_bit_cast(float, w.y & 0xffff0000u);
    acc[o + 4] += c * __builtin_bit_cast(float, w.z << 16); acc[o + 5] += c * __builtin_bit_cast(float, w.z & 0xffff0000u);
    acc[o + 6] += c * __builtin_bit_cast(float, w.w << 16); acc[o + 7] += c * __builtin_bit_cast(float, w.w & 0xffff0000u);
}
__device__ __forceinline__ float transpose_reduce64(float (&v)[64], int lane) {
#pragma unroll
    for (int s = 0; s < 6; ++s) {
        const bool up = (lane >> s) & 1;
#pragma unroll
        for (int i = 0; i < (32 >> s); ++i) {
            const float a = v[2 * i], b = v[2 * i + 1];
            const float keep = up ? b : a, send = up ? a : b;
            v[i] = keep + __shfl_xor(send, 1 << s);
        }
    }
    return v[0];
}
typedef float f32x2 __attribute__((ext_vector_type(2)));
__device__ __forceinline__ float dot16_fp8(const u32x4 w, const float (&x)[16], float c) {
    f32x2 q;
    q = __builtin_amdgcn_cvt_pk_f32_fp8((int)w.x, false); c += x[0] * q[0]; c += x[1] * q[1];   q = __builtin_amdgcn_cvt_pk_f32_fp8((int)w.x, true); c += x[2] * q[0]; c += x[3] * q[1];
    q = __builtin_amdgcn_cvt_pk_f32_fp8((int)w.y, false); c += x[4] * q[0]; c += x[5] * q[1];   q = __builtin_amdgcn_cvt_pk_f32_fp8((int)w.y, true); c += x[6] * q[0]; c += x[7] * q[1];
    q = __builtin_amdgcn_cvt_pk_f32_fp8((int)w.z, false); c += x[8] * q[0]; c += x[9] * q[1];   q = __builtin_amdgcn_cvt_pk_f32_fp8((int)w.z, true); c += x[10] * q[0]; c += x[11] * q[1];
    q = __builtin_amdgcn_cvt_pk_f32_fp8((int)w.w, false); c += x[12] * q[0]; c += x[13] * q[1]; q = __builtin_amdgcn_cvt_pk_f32_fp8((int)w.w, true); c += x[14] * q[0]; c += x[15] * q[1];
    return c;
}
__device__ __forceinline__ void axpy16_fp8(float (&acc)[16], const u32x4 w, float c) {
    f32x2 q;
    q = __builtin_amdgcn_cvt_pk_f32_fp8((int)w.x, false); acc[0] += c * q[0]; acc[1] += c * q[1];   q = __builtin_amdgcn_cvt_pk_f32_fp8((int)w.x, true); acc[2] += c * q[0]; acc[3] += c * q[1];
    q = __builtin_amdgcn_cvt_pk_f32_fp8((int)w.y, false); acc[4] += c * q[0]; acc[5] += c * q[1];   q = __builtin_amdgcn_cvt_pk_f32_fp8((int)w.y, true); acc[6] += c * q[0]; acc[7] += c * q[1];
    q = __builtin_amdgcn_cvt_pk_f32_fp8((int)w.z, false); acc[8] += c * q[0]; acc[9] += c * q[1];   q = __builtin_amdgcn_cvt_pk_f32_fp8((int)w.z, true); acc[10] += c * q[0]; acc[11] += c * q[1];
    q = __builtin_amdgcn_cvt_pk_f32_fp8((int)w.w, false); acc[12] += c * q[0]; acc[13] += c * q[1]; q = __builtin_amdgcn_cvt_pk_f32_fp8((int)w.w, true); acc[14] += c * q[0]; acc[15] += c * q[1];
}
template <int XS0, int XS1, int XS2>
__device__ __forceinline__ void reduce16_over8(float (&v)[16], int sel) {
    { const bool up = sel & 1;
#pragma unroll
      for (int i = 0; i < 8; ++i) { const float a = v[2 * i], b = v[2 * i + 1]; v[i] = (up ? b : a) + __shfl_xor(up ? a : b, XS0); } }
    { const bool up = (sel >> 1) & 1;
#pragma unroll
      for (int i = 0; i < 4; ++i) { const float a = v[2 * i], b = v[2 * i + 1]; v[i] = (up ? b : a) + __shfl_xor(up ? a : b, XS1); } }
    { const bool up = (sel >> 2) & 1;
#pragma unroll
      for (int i = 0; i < 2; ++i) { const float a = v[2 * i], b = v[2 * i + 1]; v[i] = (up ? b : a) + __shfl_xor(up ? a : b, XS2); } }
}
__device__ __forceinline__ void peer_load_idx(const unsigned char* ws, int t, int rsl, int (&ei)[16]) {
    const int* seli = (const int*)(ws + WS_SELI);
#pragma unroll
    for (int j = 0; j < 4; ++j) { const int4 v = *(const int4*)(seli + (size_t)t * 128 + 16 * rsl + 4 * j); ei[4 * j] = v.x; ei[4 * j + 1] = v.y; ei[4 * j + 2] = v.z; ei[4 * j + 3] = v.w; }
}
template <int PASS>
__device__ __forceinline__ void peer_load_rows(const unsigned char* ws, int t, int g, int rsl, int c, const int (&ei)[16], u32x4 (&row)[16], u32x4 (&aux)[4]) {
    const unsigned char* tab = ws + (PASS == 0 ? WS_UB : WS_VB) + (size_t)g * NEXP * 128 + 16 * c;
#pragma unroll
    for (int i = 0; i < 16; ++i) row[i] = *(const u32x4*)(tab + (size_t)ei[i] * 128);
    if (PASS == 0) {
        const bf16_t* xp = (const bf16_t*)(ws + WS_A) + (size_t)t * D + 128 * g + 16 * c;
        aux[0] = *(const u32x4*)xp; aux[1] = *(const u32x4*)(xp + 8);
    } else {
        const u32x4* cb = (const u32x4*)((const float*)(ws + WS_CBUF) + (size_t)t * 128 + 16 * rsl);
#pragma unroll
        for (int j = 0; j < 4; ++j) aux[j] = cb[j];
    }
}
__device__ __forceinline__ int dot16_i8(unsigned r0, unsigned r1, unsigned r2, unsigned r3, const unsigned (&xq)[4]) {
    int a = __builtin_amdgcn_sdot4((int)r0, (int)xq[0], 0, false);
    a = __builtin_amdgcn_sdot4((int)r1, (int)xq[1], a, false); a = __builtin_amdgcn_sdot4((int)r2, (int)xq[2], a, false); a = __builtin_amdgcn_sdot4((int)r3, (int)xq[3], a, false);
    return a;
}
__device__ __forceinline__ void axpy4rows_i8(int (&acc)[16], int w, unsigned A, unsigned B, unsigned C, unsigned D, unsigned cq) {
    const unsigned ablo = __builtin_amdgcn_perm(B, A, 0x05010400u), abhi = __builtin_amdgcn_perm(B, A, 0x07030602u);
    const unsigned cdlo = __builtin_amdgcn_perm(D, C, 0x05010400u), cdhi = __builtin_amdgcn_perm(D, C, 0x07030602u);
    const unsigned t0 = __builtin_amdgcn_perm(cdlo, ablo, 0x05040100u), t1 = __builtin_amdgcn_perm(cdlo, ablo, 0x07060302u);
    const unsigned t2 = __builtin_amdgcn_perm(cdhi, abhi, 0x05040100u), t3 = __builtin_amdgcn_perm(cdhi, abhi, 0x07060302u);
    acc[4 * w + 0] = __builtin_amdgcn_sdot4((int)t0, (int)cq, acc[4 * w + 0], false); acc[4 * w + 1] = __builtin_amdgcn_sdot4((int)t1, (int)cq, acc[4 * w + 1], false);
    acc[4 * w + 2] = __builtin_amdgcn_sdot4((int)t2, (int)cq, acc[4 * w + 2], false); acc[4 * w + 3] = __builtin_amdgcn_sdot4((int)t3, (int)cq, acc[4 * w + 3], false);
}
__device__ __forceinline__ float quant16_i8(const float (&v)[16], unsigned (&q)[4]) {
    float m = 0.f;
#pragma unroll
    for (int i = 0; i < 16; ++i) m = fmaxf(m, fabsf(v[i]));
    const float inv = m > 0.f ? 127.0f / m : 0.f;
#pragma unroll
    for (int j = 0; j < 4; ++j) q[j] = pack_i8(v[4 * j] * inv, v[4 * j + 1] * inv, v[4 * j + 2] * inv, v[4 * j + 3] * inv);
    return m * (1.0f / 127.0f);
}
template <int PASS  >
__device__ __forceinline__ void peer_compute(const Params& p, int t, int g, int rsl, int c, const u32x4 (&row)[16], const u32x4 (&aux)[4]) {
    unsigned char* ws = p.ws;
    if (PASS == 0) {
        float xv[16];
        { float f[8]; unpack8(aux[0], f);
#pragma unroll
          for (int j = 0; j < 8; ++j) xv[j] = f[j];
          unpack8(aux[1], f);
#pragma unroll
          for (int j = 0; j < 8; ++j) xv[8 + j] = f[j]; }
        unsigned xq[4];
        const float xs = quant16_i8(xv, xq);
        float pd[16];
#pragma unroll
        for (int i = 0; i < 16; ++i) { const u32x4 rw = row[i]; pd[i] = (float)dot16_i8(rw.x, rw.y, rw.z, rw.w, xq) * xs; }
        reduce16_over8<1, 2, 4>(pd, c);
        float* o = (float*)(ws + WS_PD) + ((size_t)g * S + t) * 128 + 16 * rsl + c;
        o[0] = pd[0]; o[8] = pd[1];
    } else {
        float cf[16];
#pragma unroll
        for (int j = 0; j < 4; ++j) { const u32x4 cw = aux[j]; cf[4 * j] = u2f(cw.x); cf[4 * j + 1] = u2f(cw.y); cf[4 * j + 2] = u2f(cw.z); cf[4 * j + 3] = u2f(cw.w); }
        unsigned cq[4];
        const float cs = quant16_i8(cf, cq);
        int acc[16];
#pragma unroll
        for (int j = 0; j < 16; ++j) acc[j] = 0;
#pragma unroll
        for (int j = 0; j < 4; ++j) {
            const u32x4 A = row[4 * j], B = row[4 * j + 1], C = row[4 * j + 2], Dw = row[4 * j + 3];
            axpy4rows_i8(acc, 0, A.x, B.x, C.x, Dw.x, cq[j]); axpy4rows_i8(acc, 1, A.y, B.y, C.y, Dw.y, cq[j]);
            axpy4rows_i8(acc, 2, A.z, B.z, C.z, Dw.z, cq[j]); axpy4rows_i8(acc, 3, A.w, B.w, C.w, Dw.w, cq[j]);
        }
        float af[16];
#pragma unroll
        for (int j = 0; j < 16; ++j) af[j] = (float)acc[j] * cs;
        reduce16_over8<8, 16, 32>(af, rsl);
        float* o = p.out + (size_t)t * D + 128 * g + 16 * c + rsl;
        o[0] += af[0]; o[8] += af[1];
    }
}
template <int PASS>
__device__ __forceinline__ void peer_stream(const Params& p, int g, int t0, int dt, int n, int lane) {
    const unsigned char* ws = p.ws;
    const int rsl = lane >> 3, c = lane & 7;
    int eiA[16], eiB[16]; u32x4 rowA[16], rowB[16], auxA[4], auxB[4];
    if (n <= 0) return;
    peer_load_idx(ws, t0, rsl, eiA);
    peer_load_rows<PASS>(ws, t0, g, rsl, c, eiA, rowA, auxA);
    if (n > 1) peer_load_idx(ws, t0 + dt, rsl, eiB);
    for (int i = 0; i < n; i += 2) {
        const int t = t0 + i * dt;
        if (i + 1 < n) peer_load_rows<PASS>(ws, t + dt, g, rsl, c, eiB, rowB, auxB);
        if (i + 2 < n) peer_load_idx(ws, t + 2 * dt, rsl, eiA);
        peer_compute<PASS>(p, t, g, rsl, c, rowA, auxA);
        if (i + 1 < n) {
            if (i + 2 < n) peer_load_rows<PASS>(ws, t + 2 * dt, g, rsl, c, eiA, rowA, auxA);
            if (i + 3 < n) peer_load_idx(ws, t + 3 * dt, rsl, eiB);
            peer_compute<PASS>(p, t + dt, g, rsl, c, rowB, auxB);
        }
    }
}
template <int PASS>
__device__ __forceinline__ void ph_peer(const Params& p) {
    const int tid_ = phase_tid();
    const int lane = tid_ & 63, w = tid_ >> 6, b = blockIdx.x, G = gridDim.x;
    if ((G & 7) == 0) {
        const int nsw = (G >> 3) * (NTHR / 64), t0 = (b >> 3) * (NTHR / 64) + w;
        peer_stream<PASS>(p, b & 7, t0, nsw, t0 < S ? (S - 1 - t0) / nsw + 1 : 0, lane);
    } else {
        const int nw = G * (NTHR / 64), it0 = b * (NTHR / 64) + w;
        for (int it = it0; it < S * 8; it += nw) peer_stream<PASS>(p, it & 7, it >> 3, 0, 1, lane);
    }
}
__device__ __forceinline__ void ph_peer_combine(const Params& p) {
    unsigned char* ws = p.ws;
    const int* seli = (const int*)(ws + WS_SELI); const float* selg = (const float*)(ws + WS_SELG); const float* rstd2 = (const float*)(ws + WS_RSTD2);
    const float* usc = (const float*)(ws + WS_USC); const float* vsc = (const float*)(ws + WS_VSC);
    const float* pd = (const float*)(ws + WS_PD); float* cb = (float*)(ws + WS_CBUF);
    const int gtid = blockIdx.x * blockDim.x + phase_tid(), gsize = gridDim.x * blockDim.x;
    for (int e = gtid; e < S * 128; e += gsize) {
        float d = 0.f;
#pragma unroll
        for (int g = 0; g < 8; ++g) d += pd[(size_t)g * S * 128 + e];
        const int idx = seli[e];
        cb[e] = selg[e] * gelu_tanh(d * usc[idx] * rstd2[e >> 7]) * vsc[idx];
    }
}

#define LAS __attribute__((address_space(3)))
#define XB_TMO      128
#define XB_XCNT(j)  (256  + 64 * (j))
#define XB_XSUB(j)  (1280 + 64 * (j))
#define XB_XGEN(j)  (2304 + 64 * (j))
#define XB_TOP      3328
#define XB_TOPGEN   3392
#define XCD_BAR_WORDS 3456
#define XB_SPIN_CAP (1u << 18)
__device__ __forceinline__ unsigned xb_ld(unsigned* p)              { return __hip_atomic_load(p, __ATOMIC_RELAXED, __HIP_MEMORY_SCOPE_AGENT); }
__device__ __forceinline__ unsigned xb_add(unsigned* p, unsigned v) { return __hip_atomic_fetch_add(p, v, __ATOMIC_RELAXED, __HIP_MEMORY_SCOPE_AGENT); }
__device__ __forceinline__ unsigned xb_xcc_id() { return (unsigned)__builtin_amdgcn_s_getreg((3 << 11) | 20) & 0xFu; }
#define XB_SPIN(cond, bar) do { unsigned _sp = 0; while (cond) { __builtin_amdgcn_s_sleep(1); \
    if ((++_sp & 255u) == 0u) { if (xb_ld(&(bar)[XB_TMO])) break; if (_sp > XB_SPIN_CAP) { atomicAdd(&(bar)[XB_TMO], 1u); break; } } } } while (0)
struct XcdBarrier { unsigned* bar; unsigned x; volatile LAS unsigned* st; };
__device__ __forceinline__ XcdBarrier xcd_barrier_post(unsigned* bar, volatile LAS unsigned* st) {
    XcdBarrier b; b.bar = bar; b.x = xb_xcc_id(); b.st = st;
    if (threadIdx.x == 0) (void)xb_add(&bar[XB_XCNT(b.x)], 1u);
    return b;
}
__device__ __forceinline__ void xcd_barrier_complete(unsigned* bar, unsigned x, unsigned& nloc, unsigned& nx) {
    const unsigned G = gridDim.x * gridDim.y * gridDim.z;
    unsigned sum, cnt, mine, sp = 0u;
    for (;;) {
        sum = 0u; cnt = 0u; mine = 0u;
#pragma unroll
        for (unsigned j = 0; j < 16; ++j) { const unsigned c = xb_ld(&bar[XB_XCNT(j)]); sum += c; cnt += (c > 0u) ? 1u : 0u; mine = (j == x) ? c : mine; }
        if (sum == G) break;
        __builtin_amdgcn_s_sleep(1);
        if ((++sp & 255u) == 0u) { if (xb_ld(&bar[XB_TMO])) break; if (sp > XB_SPIN_CAP) { atomicAdd(&bar[XB_TMO], 1u); break; } }
    }
    nloc = mine > 0u ? mine : 1u; nx = cnt > 0u ? cnt : 1u;
}
__device__ __forceinline__ void xcd_barrier(const XcdBarrier& b) {
    asm volatile("s_waitcnt vmcnt(0)" ::: "memory");
    __syncthreads();
    if (threadIdx.x == 0) {
        unsigned* bar = b.bar;
        __builtin_amdgcn_s_waitcnt(0);
        unsigned nloc = b.st[0], nx = b.st[1];
        if (nloc == 0u) { xcd_barrier_complete(bar, b.x, nloc, nx); b.st[0] = nloc; b.st[1] = nx; }
        const unsigned old = xb_add(&bar[XB_XSUB(b.x)], 1u);
        const unsigned gen = old / nloc;
        if (old + 1u == (gen + 1u) * nloc) {
            __builtin_amdgcn_fence(__ATOMIC_RELEASE, "agent");
            asm volatile("s_waitcnt vmcnt(0)" ::: "memory");
            const unsigned og = xb_add(&bar[XB_TOP], 1u);
            const unsigned tg = og / nx;
            if (og + 1u == (tg + 1u) * nx) xb_add(&bar[XB_TOPGEN], 1u);
            else XB_SPIN(xb_ld(&bar[XB_TOPGEN]) == tg, bar);
            __builtin_amdgcn_fence(__ATOMIC_ACQUIRE, "agent");
            xb_add(&bar[XB_XGEN(b.x)], 1u);
            asm volatile("s_waitcnt vmcnt(0)" ::: "memory");
        } else {
            XB_SPIN(xb_ld(&bar[XB_XGEN(b.x)]) == gen, bar);
            __builtin_amdgcn_fence(__ATOMIC_ACQUIRE, "agent");
            asm volatile("s_waitcnt vmcnt(0)" ::: "memory");
        }
    }
    __syncthreads();
}

constexpr int LDS_MISC = 158720;
constexpr int LDS_BYTES = LDS_MISC + 1024;

__global__ void __launch_bounds__(NTHR, 2) hymba_fwd(Params p) {
    extern __shared__ __attribute__((aligned(16))) unsigned char lds[];
    volatile LAS unsigned* misc = (volatile LAS unsigned*)((LAS unsigned char*)lds + LDS_MISC);
    if (threadIdx.x < 4) misc[threadIdx.x] = 0u;
    __syncthreads();
    XcdBarrier bar = xcd_barrier_post((unsigned*)(p.ws + WS_CTL), misc);

    PG8_LAS unsigned char* ring = (PG8_LAS unsigned char*)lds;
    unsigned char* ws = p.ws;
    ph_prep(p, lds);                          xcd_barrier(bar);
    {
        pg8::Gemm g{(const bf16_t*)(ws + WS_A), (const bf16_t*)(ws + WS_WINT), S, NPROJ, D}; pg8::StaticOrder so; so.init(S, NPROJ, (int)gridDim.x, (int)blockIdx.x);
        EpiInProj E{(const float*)(ws + WS_RSTD1), p.in[I_Q_NORM], p.in[I_K_NORM], (bf16_t*)(ws + WS_QH), (bf16_t*)(ws + WS_KH), (bf16_t*)(ws + WS_VH), (bf16_t*)(ws + WS_XRG), (bf16_t*)(ws + WS_GG)};
        pg8::gemm_phase<EpiInProj, pg8::StaticOrder, true, true>(ring, g, so, E);
    }
    xcd_barrier(bar);
    ph_attn(p); ph_rg<0>(p, lds);             xcd_barrier(bar);
    ph_rg<1>(p, lds);                         xcd_barrier(bar);
    {
        pg8::Gemm g{(const bf16_t*)(ws + WS_MIX), (const bf16_t*)(ws + WS_WOUTT), S, D, D}; pg8::StaticOrder so; so.init(S, D, (int)gridDim.x, (int)blockIdx.x);
        EpiOutProj E{p.in[I_X], p.out, (bf16_t*)(ws + WS_A), (float*)(ws + WS_SSQ)};
        pg8::gemm_phase<EpiOutProj, pg8::StaticOrder, true, true>(ring, g, so, E);
    }
    xcd_barrier(bar);
    {
        pg8::Gemm g{(const bf16_t*)(ws + WS_A), (const bf16_t*)(ws + WS_WQT), S, NQ, D}; pg8::StaticOrder so; so.init(S, NQ, (int)gridDim.x, (int)blockIdx.x);
        EpiPeerQ E{(bf16_t*)(ws + WS_B)};
        pg8::gemm_phase<EpiPeerQ, pg8::StaticOrder, true, true>(ring, g, so, E);
    }
    xcd_barrier(bar);
    ph_topk(p, (int*)lds);                    xcd_barrier(bar);
    ph_peer<0>(p);                            xcd_barrier(bar);
    ph_peer_combine(p);                       xcd_barrier(bar);
    ph_peer<1>(p);
}

extern "C" void kernel_launch(void* const* d_in, const int* in_sizes, int n_in, void* d_out, int out_size, void* d_ws, size_t ws_size, hipStream_t stream) {
    static int grid = 0;
    if (grid == 0) {
        if (n_in != 20 || out_size != S * D || ws_size < WS_END) { fprintf(stderr, "kernel_launch: unexpected shapes (n_in %d out %d ws %zu)\n", n_in, out_size, ws_size); grid = -1; return; }
        int dev = 0, cus = 0, per_cu = 0;
        if (hipGetDevice(&dev) != hipSuccess || hipDeviceGetAttribute(&cus, hipDeviceAttributeMultiprocessorCount, dev) != hipSuccess) { grid = -1; return; }
        if (hipFuncSetAttribute((const void*)hymba_fwd, hipFuncAttributeMaxDynamicSharedMemorySize, LDS_BYTES) != hipSuccess) { fprintf(stderr, "kernel_launch: hipFuncSetAttribute failed\n"); grid = -1; return; }
        if (hipOccupancyMaxActiveBlocksPerMultiprocessor(&per_cu, (const void*)hymba_fwd, NTHR, LDS_BYTES) != hipSuccess || per_cu < 1) { fprintf(stderr, "kernel_launch: occupancy query says %d blocks per CU\n", per_cu); grid = -1; return; }
        (void)hipGetLastError();
        grid = cus;
    }
    if (grid < 0) return;
    (void)hipMemsetAsync((char*)d_ws + WS_CTL, 0, XCD_BAR_WORDS * 4, stream);
    Params p{};
    for (int i = 0; i < 20; ++i) p.in[i] = (const float*)d_in[i];
    p.out = (float*)d_out; p.ws = (unsigned char*)d_ws;
    hipLaunchKernelGGL(hymba_fwd, dim3(grid), dim3(NTHR), LDS_BYTES, stream, p);
}
```

```cpp
#include <hip/hip_runtime.h>
#include <cstdint>
#include <cstdio>

typedef unsigned short bf16_t;
typedef short bf16x8 __attribute__((ext_vector_type(8)));
typedef float f32x4 __attribute__((ext_vector_type(4)));
typedef unsigned u32x4 __attribute__((ext_vector_type(4)));
typedef float f32x16 __attribute__((ext_vector_type(16)));

constexpr int S = 16384, D = 1024, NPROJ = 2560, DSB = 512, DRG = 512, NH = 8, HD = 64;
constexpr int PH = 8, PNK = 128, PDK = 256, PHALF = 128, PTOPK = 16, NEXP = 16384, NQ = PH * PDK;
constexpr int CHUNK = 64, NCHUNK = S / CHUNK;
constexpr float EPS = 1e-6f;
constexpr float LOG2E = 1.4426950408889634f;
constexpr float QSCALE = 0.125f * LOG2E;
constexpr int NTHR = 512;
constexpr float CARRY_STOP = -160.0f;

constexpr size_t MiB = 1u << 20;
constexpr size_t WS_CTL = 0;
constexpr size_t WS_WINT = 1 * MiB;
constexpr size_t WS_WOUTT = 6 * MiB;
constexpr size_t WS_WQT = 8 * MiB;
constexpr size_t WS_SUBK = 12 * MiB;
constexpr size_t WS_RSTD1 = 12 * MiB + 512 * 1024;
constexpr size_t WS_RSTD2 = WS_RSTD1 + 64 * 1024;
constexpr size_t WS_RGP = WS_RSTD2 + 64 * 1024;
constexpr size_t WS_RGH = WS_RGP + 512 * 1024;
constexpr size_t WS_A = 14 * MiB;
constexpr size_t WS_B = 46 * MiB;
constexpr size_t WS_QH = WS_B, WS_KH = WS_B + 16 * MiB, WS_VH = WS_B + 32 * MiB, WS_XRG = WS_B + 48 * MiB;
constexpr size_t WS_GG = 110 * MiB;
constexpr size_t WS_OSB = 126 * MiB;
constexpr size_t WS_MIX = 142 * MiB;
constexpr size_t WS_SELI = WS_MIX, WS_SELG = WS_MIX + 8 * MiB;
constexpr size_t WS_PD = WS_B;
constexpr size_t WS_CBUF = WS_GG;
constexpr size_t WS_CSC = WS_GG + 4 * MiB;
constexpr size_t WS_X1Q = WS_OSB;
constexpr size_t WS_XSC = WS_GG + 8 * MiB;
constexpr size_t WS_UB = 174 * MiB;
constexpr size_t WS_VB = 190 * MiB;
constexpr size_t WS_USC = 206 * MiB;
constexpr size_t WS_SSQ = 238 * MiB;
constexpr size_t WS_RGW = 239 * MiB;
constexpr size_t WS_END = 240 * MiB;

__device__ __forceinline__ unsigned f2bf(float f) { unsigned u = __builtin_bit_cast(unsigned, f); return (u + 0x7fffu + ((u >> 16) & 1u)) >> 16; }
__device__ __forceinline__ float u2f(unsigned u) { return __builtin_bit_cast(float, u); }
__device__ __forceinline__ float bf2f(unsigned h) { return __builtin_bit_cast(float, h << 16); }
__device__ __forceinline__ unsigned pk2(float lo, float hi) { return f2bf(lo) | (f2bf(hi) << 16); }
__device__ __forceinline__ unsigned pack_i8(float a, float b, float c, float d) {
    const int qa = __float2int_rn(a), qb = __float2int_rn(b), qc = __float2int_rn(c), qd = __float2int_rn(d);
    return (unsigned)(qa & 255) | ((unsigned)(qb & 255) << 8) | ((unsigned)(qc & 255) << 16) | ((unsigned)qd << 24);
}
__device__ __forceinline__ unsigned pack_n4(float a, float b, float c, float d) {
    const int qa = min(max(__float2int_rn(a), -7), 7) & 15, qb = min(max(__float2int_rn(b), -7), 7) & 15, qc = min(max(__float2int_rn(c), -7), 7) & 15, qd = min(max(__float2int_rn(d), -7), 7) & 15;
    return (unsigned)qa | ((unsigned)qb << 4) | ((unsigned)qc << 8) | ((unsigned)qd << 12);
}
template <int OFFS>
__device__ __forceinline__ unsigned pack_u4(float a, float b, float c, float d) {
    const int qa = (min(max(__float2int_rn(a), -7), 7) + OFFS) & 15, qb = (min(max(__float2int_rn(b), -7), 7) + OFFS) & 15, qc = (min(max(__float2int_rn(c), -7), 7) + OFFS) & 15, qd = (min(max(__float2int_rn(d), -7), 7) + OFFS) & 15;
    return (unsigned)qa | ((unsigned)qb << 8) | ((unsigned)qc << 16) | ((unsigned)qd << 24);
}
__device__ __forceinline__ float wave_sum(float v) {
#pragma unroll
    for (int o = 1; o < 64; o <<= 1) v += __shfl_xor(v, o);
    return v;
}
__device__ __forceinline__ float gelu_tanh(float x) {
    const float u = 0.7978845608028654f * (x + 0.044715f * x * x * x);
    const float e = __expf(2.0f * u);
    const float th = 1.0f - 2.0f / (e + 1.0f);
    return 0.5f * x * (1.0f + th);
}

__host__ __device__ __forceinline__ int inproj_phys_row(int nlog) { const int t = nlog >> 8, L = nlog & 255; return (t << 8) + 128 * ((L & 63) >> 5) + 32 * (L >> 6) + (L & 31); }

__device__ __forceinline__ int phase_tid() { int t = threadIdx.x; asm volatile("" : "+v"(t)); return t; }

struct Params {
    const float* in[20];
    float* out;
    unsigned char* ws;
};
enum { I_X = 0, I_NORM_MIX, I_W_IN, I_Q_NORM, I_K_NORM, I_CONV_W, I_CONV_B, I_RG_W_A, I_RG_B_A, I_RG_W_X, I_RG_B_X, I_RG_LAMBDA,
       I_OUT_NORM_SB, I_OUT_NORM_RG, I_W_OUT, I_NORM_FFN, I_PEER_WQ, I_PEER_SUBK, I_PEER_U, I_PEER_V };

template <bool INPROJ_PERM>
__device__ __forceinline__ void prep_transpose_item(const float* W, const float* gain0, const float* gain1, int K, int N, bf16_t* WT, float* scr, int item, int lane) {
    const int nblk = N / 32, kb = item / nblk, nb = item % nblk, k0 = 64 * kb, n0 = 32 * nb;
#pragma unroll 8
    for (int i = 0; i < 32; ++i) {
        const int kk = 2 * i + (lane >> 5), k = k0 + kk;
        const float g = (gain1 && k >= 512) ? gain1[k - 512] : gain0[k];
        scr[kk * 33 + (lane & 31)] = g * W[(size_t)k * N + n0 + (lane & 31)];
    }
    asm volatile("s_waitcnt lgkmcnt(0)" ::: "memory");
    const int c = lane & 7;
#pragma unroll
    for (int j = 0; j < 4; ++j) {
        const int n = (lane >> 3) + 8 * j; const float* s = scr + (8 * c) * 33 + n;
        u32x4 o; o.x = pk2(s[0 * 33], s[1 * 33]); o.y = pk2(s[2 * 33], s[3 * 33]); o.z = pk2(s[4 * 33], s[5 * 33]); o.w = pk2(s[6 * 33], s[7 * 33]);
        const int nr = INPROJ_PERM ? inproj_phys_row(n0 + n) : n0 + n;
        *(u32x4*)(WT + (size_t)nr * K + k0 + 8 * c) = o;
    }
    asm volatile("s_waitcnt lgkmcnt(0)" ::: "memory");
}
__device__ __forceinline__ void ph_tables(const Params& p, int cw, int ncw, int lane) {
    unsigned char* ws = p.ws;
    {
        const float* u = p.in[I_PEER_U]; const float* v = p.in[I_PEER_V]; const float* g = p.in[I_NORM_FFN];
        unsigned* ub = (unsigned*)(ws + WS_UB); unsigned* vb = (unsigned*)(ws + WS_VB); float2* uvsc = (float2*)(ws + WS_USC);
        f32x4 gq[4];
#pragma unroll
        for (int j = 0; j < 4; ++j) gq[j] = *((const f32x4*)g + lane + 64 * j);
        for (int e0 = cw; e0 < NEXP; e0 += 2 * ncw) {
            f32x4 a[2][4], b[2][4]; float ma[2], mb[2], sa2[2], sb2[2];
#pragma unroll
            for (int rr = 0; rr < 2; ++rr) {
                const int e = min(e0 + rr * ncw, NEXP - 1);
#pragma unroll
                for (int j = 0; j < 4; ++j) { a[rr][j] = *((const f32x4*)(u + (size_t)e * D) + lane + 64 * j); b[rr][j] = *((const f32x4*)(v + (size_t)e * D) + lane + 64 * j); }
            }
#pragma unroll
            for (int rr = 0; rr < 2; ++rr) {
                ma[rr] = 0.f; mb[rr] = 0.f; sa2[rr] = 0.f; sb2[rr] = 0.f;
#pragma unroll
                for (int j = 0; j < 4; ++j) {
                    a[rr][j] = a[rr][j] * gq[j];
                    const f32x4 aa = a[rr][j], bb = b[rr][j];
                    ma[rr] = fmaxf(ma[rr], fmaxf(fmaxf(fabsf(aa.x), fabsf(aa.y)), fmaxf(fabsf(aa.z), fabsf(aa.w))));
                    mb[rr] = fmaxf(mb[rr], fmaxf(fmaxf(fabsf(bb.x), fabsf(bb.y)), fmaxf(fabsf(bb.z), fabsf(bb.w))));
                    sa2[rr] += (aa.x * aa.x + aa.y * aa.y) + (aa.z * aa.z + aa.w * aa.w);
                    sb2[rr] += (bb.x * bb.x + bb.y * bb.y) + (bb.z * bb.z + bb.w * bb.w);
                }
            }
#pragma unroll
            for (int o = 1; o < 64; o <<= 1)
#pragma unroll
                for (int rr = 0; rr < 2; ++rr) { ma[rr] = fmaxf(ma[rr], __shfl_xor(ma[rr], o)); mb[rr] = fmaxf(mb[rr], __shfl_xor(mb[rr], o)); sa2[rr] += __shfl_xor(sa2[rr], o); sb2[rr] += __shfl_xor(sb2[rr], o); }
#pragma unroll
            for (int rr = 0; rr < 2; ++rr) {
                const int e = e0 + rr * ncw;
                if (e < NEXP) {
                    const float ca = fminf(ma[rr], 2.5f * sqrtf(sa2[rr] * (1.0f / D))), cb = fminf(mb[rr], 2.5f * sqrtf(sb2[rr] * (1.0f / D)));
                    const float ia = ca > 0.f ? 7.0f / ca : 0.f, ib = cb > 0.f ? 7.0f / cb : 0.f;
#pragma unroll
                    for (int j = 0; j < 4; ++j) {
                        const f32x4 aa = a[rr][j], bb = b[rr][j];
                        const unsigned na = pack_u4<0>(aa.x * ia, aa.y * ia, aa.z * ia, aa.w * ia), nb = pack_n4(bb.x * ib, bb.y * ib, bb.z * ib, bb.w * ib);
                        const unsigned pa = __shfl_xor(na, 1), pb = __shfl_xor(nb, 1);
                        if ((lane & 1) == 0) {
                            ub[((size_t)j * NEXP + e) * 32 + (lane >> 1)] = na | (pa << 4);
                            vb[((size_t)j * NEXP + e) * 32 + (lane >> 1)] = nb | (pb << 16);
                        }
                    }
                    if (lane == 0) uvsc[e] = make_float2(ca * (1.0f / 7.0f), cb * (1.0f / 7.0f));
                }
            }
        }
    }
}

__device__ __forceinline__ void ph_prep(const Params& p, unsigned char* lds) {
    const int tid_ = phase_tid();
    const int gtid = blockIdx.x * blockDim.x + tid_, gsize = gridDim.x * blockDim.x;
    const int lane = tid_ & 63, gwave = gtid >> 6, nwave = gsize >> 6;
    unsigned char* ws = p.ws;
    {
        float* scr = (float*)lds + (tid_ >> 6) * (64 * 33);
        constexpr int I_IN = (D / 64) * (NPROJ / 32), I_OUT = (D / 64) * (D / 32), I_Q = (D / 64) * (NQ / 32);
        for (int it = gwave; it < I_IN + I_OUT + I_Q; it += nwave) {
            if (it < I_IN) prep_transpose_item<true>(p.in[I_W_IN], p.in[I_NORM_MIX], nullptr, D, NPROJ, (bf16_t*)(ws + WS_WINT), scr, it, lane);
            else if (it < I_IN + I_OUT) prep_transpose_item<false>(p.in[I_W_OUT], p.in[I_OUT_NORM_SB], p.in[I_OUT_NORM_RG], D, D, (bf16_t*)(ws + WS_WOUTT), scr, it - I_IN, lane);
            else prep_transpose_item<false>(p.in[I_PEER_WQ], p.in[I_NORM_FFN], nullptr, D, NQ, (bf16_t*)(ws + WS_WQT), scr, it - I_IN - I_OUT, lane);
        }
    }
    {
        const float* wa = p.in[I_RG_W_A]; const float* wx = p.in[I_RG_W_X]; bf16_t* o = (bf16_t*)(ws + WS_RGW);
        for (int e = gtid; e < 8 * 2 * 2 * 4 * 64 * 8; e += gsize) {
            const int el = e & 7, ln = (e >> 3) & 63, s = (e >> 9) & 3, jt = (e >> 11) & 1, g = (e >> 12) & 1, n = e >> 13;
            const int j = 32 * jt + (ln & 31), i = 16 * s + 8 * (el >> 2) + 4 * (ln >> 5) + (el & 3);
            o[e] = (bf16_t)f2bf((g == 0 ? wa : wx)[((size_t)n * 64 + i) * 64 + j]);
        }
    }
    {
        const float* sk = p.in[I_PEER_SUBK]; bf16_t* o = (bf16_t*)(ws + WS_SUBK);
        for (int e = gtid; e < PH * 2 * PNK * PHALF; e += gsize) o[e] = (bf16_t)f2bf(sk[e]);
    }
    {
        const float* x = p.in[I_X]; bf16_t* xb = (bf16_t*)(ws + WS_A); float* rstd1 = (float*)(ws + WS_RSTD1);
        for (int row0 = gwave; row0 < S; row0 += 4 * nwave) {
            f32x4 v[4][4];
#pragma unroll
            for (int rr = 0; rr < 4; ++rr) {
                const int row = min(row0 + rr * nwave, S - 1);
#pragma unroll
                for (int j = 0; j < 4; ++j) v[rr][j] = ((const f32x4*)(x + (size_t)row * D) + lane)[64 * j];
            }
#pragma unroll
            for (int rr = 0; rr < 4; ++rr) {
                const int row = row0 + rr * nwave;
                float ss = 0.f;
#pragma unroll
                for (int j = 0; j < 4; ++j) ss += (v[rr][j].x * v[rr][j].x + v[rr][j].y * v[rr][j].y) + (v[rr][j].z * v[rr][j].z + v[rr][j].w * v[rr][j].w);
                ss = wave_sum(ss);
                if (row < S) {
                    uint2* o = (uint2*)(xb + (size_t)row * D) + lane;
#pragma unroll
                    for (int j = 0; j < 4; ++j) o[64 * j] = make_uint2(pk2(v[rr][j].x, v[rr][j].y), pk2(v[rr][j].z, v[rr][j].w));
                    if (lane == 0) rstd1[row] = rsqrtf(ss * (1.0f / D) + EPS);
                }
            }
        }
    }
}

namespace pg8 {
#define PG8_LAS __attribute__((address_space(3)))
typedef unsigned short bf16_t;
typedef short bf16x8 __attribute__((ext_vector_type(8)));
typedef float f32x4 __attribute__((ext_vector_type(4)));
typedef unsigned u32x4 __attribute__((ext_vector_type(4)));
constexpr int BM = 256, BK = 64, HALF = 128, HTB = HALF * BK * 2  , STAGE_BYTES = 8 * HTB, NXCD = 8, WGM = 8;

__host__ __device__ __forceinline__ int lds_byte(int r, int c) { const int st = (r >> 4) * 2 + (c >> 5), rr = r & 15, cc = c & 31, ob = rr * 64 + cc * 2; return st * 1024 + (ob ^ (((ob >> 9) & 1) << 5)); }
__host__ __device__ __forceinline__ void stage_rc(int b, int& R, int& C) { const int st = b / 1024, sb = b % 1024, swz = sb ^ (((sb >> 9) & 1) << 5); R = (st >> 1) * 16 + swz / 64; C = (st & 1) * 32 + (swz % 64) / 2; }
__host__ __device__ __forceinline__ int perm32(int rho) { const int n = rho >> 4, i = rho & 15; return 8 * (i >> 2) + 4 * n + (i & 3); }

struct Unit { int pm, pn; };
struct Gemm { const bf16_t* A; const bf16_t* Bt; int M, N, K; };

struct StaticOrder {
    int nM, nN, nwg, G, c;
    __host__ __device__ void init(int M, int N, int G_, int c_) { nM = M / BM; nN = N / BM; nwg = nM * nN; G = G_; c = c_; }
    __host__ __device__ bool next(int i, Unit& u) const {
        const long L = (long)i * G + c; if (L >= nwg) return false;
        int wgid = (int)L; { const int q = nwg / NXCD, r = nwg % NXCD, xcd = wgid % NXCD, off = wgid / NXCD; wgid = (xcd < r ? xcd * (q + 1) : r * (q + 1) + (xcd - r) * q) + off; }
        const int nig = WGM * nN, gid = wgid / nig, fm = gid * WGM, gsz = (nM - fm) < WGM ? (nM - fm) : WGM;
        u.pm = fm + ((wgid % nig) % gsz); u.pn = (wgid % nig) / gsz; return true;
    }
    __device__ __forceinline__ void a_ready(const Unit&) const {}
    __device__ __forceinline__ void done(const Unit&) const {}
};

__device__ __forceinline__ unsigned cvt_pk_bf16(float lo, float hi) { unsigned r; asm volatile("v_cvt_pk_bf16_f32 %0, %1, %2" : "=v"(r) : "v"(lo), "v"(hi)); return r; }
template <class Epi, class Sched, bool ALIGN_EPI = false, bool SP2 = false>
__device__ __forceinline__ void gemm_phase(PG8_LAS unsigned char* lds, const Gemm g, const Sched& S, const Epi& E) {
    const int tid = phase_tid(), wid = __builtin_amdgcn_readfirstlane(tid >> 6), lane = tid & 63, wr = wid >> 2, wc = wid & 3, fr = lane & 15, fq = lane >> 4;
    const int K = g.K, nt = K / BK;
    unsigned voffA[2], voffB[2];
#pragma unroll
    for (int i = 0; i < 2; ++i) { int R, C; stage_rc(tid * 16 + i * 8192, R, C); const int Rb = Epi::PERM ? ((R & ~31) + perm32(R & 31)) : R;
        voffA[i] = (unsigned)(R * K + C) * 2u; voffB[i] = (unsigned)(Rb * K + C) * 2u; }
    const size_t kstep = (size_t)(BK * 2);
    const size_t hstep = (size_t)HALF * K * 2;
    const size_t tstep = 2 * hstep;
    const unsigned ldsw = (unsigned)wid * 1024u;
    const int aoff = lds_byte(wr * 64 + fr, fq * 8), boff = lds_byte(wc * 32 + fr, fq * 8);
#define PG8_SA(b, h) (((b) * 2 + (h)) * HTB)
#define PG8_SB(b, h) ((4 + (b) * 2 + (h)) * HTB)
#define PG8_STAGE(bufoff, gbase, voff) do { _Pragma("unroll") for (int _i = 0; _i < 2; ++_i) \
        __builtin_amdgcn_global_load_lds((const unsigned*)((const char*)(gbase) + (voff)[_i]), (PG8_LAS unsigned*)(lds + (bufoff) + ldsw + _i * 8192), 16, 0, 0); } while (0)
#define PG8_LDA(dst, b, h) do { _Pragma("unroll") for (int m = 0; m < 4; ++m) _Pragma("unroll") for (int k = 0; k < 2; ++k) dst[m][k] = *(const PG8_LAS bf16x8*)(lds + PG8_SA(b, h) + aoff + m * 2048 + k * 1024); } while (0)
#define PG8_LDB(dst, b, h) do { _Pragma("unroll") for (int n = 0; n < 2; ++n) _Pragma("unroll") for (int k = 0; k < 2; ++k) dst[n][k] = *(const PG8_LAS bf16x8*)(lds + PG8_SB(b, h) + boff + n * 2048 + k * 1024); } while (0)
#define PG8_MMA(ai, bj, At, Bt) do { __builtin_amdgcn_s_setprio(1); _Pragma("unroll") for (int m = 0; m < 4; ++m) _Pragma("unroll") for (int n = 0; n < 2; ++n) _Pragma("unroll") for (int k = 0; k < 2; ++k) \
        acc[ai][bj][m][n] = __builtin_amdgcn_mfma_f32_16x16x32_bf16(Bt[n][k], At[m][k], acc[ai][bj][m][n], 0, 0, 0); __builtin_amdgcn_s_setprio(0); } while (0)
#define PG8_WAIT_V(n) asm volatile("s_waitcnt vmcnt(" #n ")" ::: "memory")
#define PG8_WAIT_L(n) asm volatile("s_waitcnt lgkmcnt(" #n ")" ::: "memory")
#define PG8_BAR __builtin_amdgcn_s_barrier()
#define PG8_SCHED __builtin_amdgcn_sched_barrier(0)
    Unit cur, nxt; int ui = 0;
    if (!S.next(0, cur)) return;
    f32x4 acc[2][2][4][2];
#pragma unroll
    for (int a = 0; a < 2; ++a)
#pragma unroll
        for (int b = 0; b < 2; ++b)
#pragma unroll
            for (int m = 0; m < 4; ++m)
#pragma unroll
                for (int n = 0; n < 2; ++n) acc[a][b][m][n] = (f32x4){0.f, 0.f, 0.f, 0.f};
    bf16x8 At[4][2], B0[2][2], B1[2][2];
    const char* cA = (const char*)g.A + (size_t)cur.pm * tstep; const char* cB = (const char*)g.Bt + (size_t)cur.pn * tstep;
    S.a_ready(cur);
    if constexpr (SP2) {
        PG8_STAGE(PG8_SB(0, 0), cB, voffB); PG8_STAGE(PG8_SB(0, 1), cB + hstep, voffB); PG8_STAGE(PG8_SA(0, 0), cA, voffA); PG8_STAGE(PG8_SA(0, 1), cA + hstep, voffA);
        if (wr == 1) PG8_BAR;
        PG8_WAIT_V(2); PG8_BAR;
        PG8_STAGE(PG8_SB(1, 0), cB + kstep, voffB); PG8_STAGE(PG8_SA(1, 0), cA + kstep, voffA); PG8_STAGE(PG8_SB(1, 1), cB + hstep + kstep, voffB);
        PG8_WAIT_V(6); PG8_BAR;
    } else {
        PG8_STAGE(PG8_SB(0, 0), cB, voffB); PG8_STAGE(PG8_SA(0, 0), cA, voffA); PG8_STAGE(PG8_SB(0, 1), cB + hstep, voffB); PG8_STAGE(PG8_SA(0, 1), cA + hstep, voffA);
        if (wr == 1) PG8_BAR;
        PG8_WAIT_V(4); PG8_BAR;
        PG8_STAGE(PG8_SB(1, 0), cB + kstep, voffB); PG8_STAGE(PG8_SA(1, 0), cA + kstep, voffA); PG8_STAGE(PG8_SB(1, 1), cB + hstep + kstep, voffB);
        PG8_WAIT_V(6); PG8_BAR;
    }
    for (;;) {
        const bool has_next = S.next(ui + 1, nxt);
        const char* nA = has_next ? (const char*)g.A + (size_t)nxt.pm * tstep : cA; const char* nB = has_next ? (const char*)g.Bt + (size_t)nxt.pn * tstep : cB;
        for (int t = 0; t < nt; t += 2) {
            const bool last = (t == nt - 2);
            const char* a1 = cA + (size_t)(t + 1) * kstep;
            const char* a2 = last ? nA : cA + (size_t)(t + 2) * kstep; const char* b2 = last ? nB : cB + (size_t)(t + 2) * kstep;
            const char* a3 = a2 + kstep; const char* b3 = b2 + kstep;
            if (last && has_next) S.a_ready(nxt);
            if constexpr (SP2) {
            PG8_LDB(B0, 0, 0); PG8_LDB(B1, 0, 1); PG8_SCHED; PG8_LDA(At, 0, 0); PG8_STAGE(PG8_SA(1, 1), a1 + hstep, voffA);
            PG8_WAIT_V(8); PG8_WAIT_L(0); PG8_BAR; PG8_MMA(0, 0, At, B0); PG8_MMA(0, 1, At, B1); PG8_BAR; PG8_SCHED;
            PG8_LDA(At, 0, 1); PG8_STAGE(PG8_SB(0, 0), b2, voffB); PG8_STAGE(PG8_SB(0, 1), b2 + hstep, voffB); PG8_STAGE(PG8_SA(0, 0), a2, voffA);
            PG8_WAIT_V(8); PG8_WAIT_L(0); PG8_BAR; PG8_MMA(1, 0, At, B0); PG8_MMA(1, 1, At, B1); PG8_BAR; PG8_SCHED;
            PG8_LDB(B0, 1, 0); PG8_LDB(B1, 1, 1); PG8_SCHED; PG8_LDA(At, 1, 0); PG8_STAGE(PG8_SA(0, 1), a2 + hstep, voffA);
            PG8_WAIT_V(8); PG8_WAIT_L(0); PG8_BAR; PG8_MMA(0, 0, At, B0); PG8_MMA(0, 1, At, B1); PG8_BAR; PG8_SCHED;
            PG8_LDA(At, 1, 1); PG8_STAGE(PG8_SB(1, 0), b3, voffB); PG8_STAGE(PG8_SB(1, 1), b3 + hstep, voffB); PG8_STAGE(PG8_SA(1, 0), a3, voffA);
            PG8_WAIT_V(8); PG8_WAIT_L(0); PG8_BAR; PG8_MMA(1, 0, At, B0); PG8_MMA(1, 1, At, B1); PG8_BAR; PG8_SCHED;
            } else {
            PG8_LDB(B0, 0, 0); PG8_SCHED; PG8_LDA(At, 0, 0); PG8_STAGE(PG8_SA(1, 1), a1 + hstep, voffA);
            PG8_WAIT_L(8); PG8_BAR; PG8_WAIT_L(0); PG8_MMA(0, 0, At, B0); PG8_BAR; PG8_SCHED;
            PG8_LDB(B1, 0, 1); PG8_STAGE(PG8_SB(0, 0), b2, voffB);
            PG8_BAR; PG8_WAIT_L(0); PG8_MMA(0, 1, At, B1); PG8_BAR;
            PG8_LDA(At, 0, 1); PG8_STAGE(PG8_SA(0, 0), a2, voffA);
            PG8_BAR; PG8_WAIT_L(0); PG8_MMA(1, 0, At, B0); PG8_BAR; PG8_SCHED;
            PG8_STAGE(PG8_SB(0, 1), b2 + hstep, voffB);
            PG8_WAIT_V(6); PG8_BAR; PG8_MMA(1, 1, At, B1); PG8_BAR;
            PG8_LDB(B0, 1, 0); PG8_SCHED; PG8_LDA(At, 1, 0); PG8_STAGE(PG8_SA(0, 1), a2 + hstep, voffA);
            PG8_WAIT_L(8); PG8_BAR; PG8_WAIT_L(0); PG8_MMA(0, 0, At, B0); PG8_BAR; PG8_SCHED;
            PG8_LDB(B1, 1, 1); PG8_STAGE(PG8_SB(1, 0), b3, voffB);
            PG8_BAR; PG8_WAIT_L(0); PG8_MMA(0, 1, At, B1); PG8_BAR;
            PG8_LDA(At, 1, 1); PG8_STAGE(PG8_SA(1, 0), a3, voffA);
            PG8_BAR; PG8_WAIT_L(0); PG8_MMA(1, 0, At, B0); PG8_BAR; PG8_SCHED;
            PG8_STAGE(PG8_SB(1, 1), b3 + hstep, voffB);
            PG8_WAIT_V(6); PG8_BAR; PG8_MMA(1, 1, At, B1); PG8_BAR;
            }
        }
        if constexpr (ALIGN_EPI) { if (wr == 0) PG8_BAR; }
        if constexpr (!Epi::AFTER_DRAIN) { E(acc, cur, wr, wc, fr, fq); S.done(cur); }
        if (!has_next) break;
#pragma unroll
        for (int a = 0; a < 2; ++a)
#pragma unroll
            for (int b = 0; b < 2; ++b)
#pragma unroll
                for (int m = 0; m < 4; ++m)
#pragma unroll
                    for (int n = 0; n < 2; ++n) acc[a][b][m][n] = (f32x4){0.f, 0.f, 0.f, 0.f};
        cur = nxt; cA = nA; cB = nB; ++ui;
        if constexpr (ALIGN_EPI) { if (wr == 1) PG8_BAR; }
    }
    PG8_WAIT_V(0);
    if constexpr (!ALIGN_EPI) { if (wr == 0) PG8_BAR; }
    PG8_BAR;
    if constexpr (Epi::AFTER_DRAIN) { E.fused(acc, cur, wr, wc, fr, fq, lds, wid, lane); S.done(cur); }
#undef PG8_SA
#undef PG8_SB
#undef PG8_STAGE
#undef PG8_LDA
#undef PG8_LDB
#undef PG8_MMA
#undef PG8_WAIT_V
#undef PG8_WAIT_L
#undef PG8_BAR
#undef PG8_SCHED
}
}

struct EpiInProj {
    static constexpr bool PERM = true, AFTER_DRAIN = false;
    const float* rstd1; const float* qn; const float* kn; bf16_t *qh, *kh, *vh, *xrg, *gg;
    __device__ __forceinline__ void operator()(const pg8::f32x4 (&acc)[2][2][4][2], const pg8::Unit& u, int wr, int wc, int fr, int fq) const {
        const int region = u.pn >> 1;
        const int head = (u.pn & 1) * 4 + wc;
        pg8::f32x4 gn[2][2];
        if (region <= 1) {
            const float* g = region == 0 ? qn : kn; const float sc = region == 0 ? QSCALE : 1.0f;
#pragma unroll
            for (int bj = 0; bj < 2; ++bj)
#pragma unroll
                for (int n = 0; n < 2; ++n) gn[bj][n] = *(const pg8::f32x4*)(g + 32 * bj + 8 * fq + 4 * n) * sc;
        }
#pragma unroll
        for (int ai = 0; ai < 2; ++ai)
#pragma unroll
            for (int m = 0; m < 4; ++m) {
                const int row = u.pm * 256 + ai * 128 + wr * 64 + m * 16 + fr;
                const float rs = rstd1[row];
                pg8::f32x4 v[2][2];
#pragma unroll
                for (int bj = 0; bj < 2; ++bj)
#pragma unroll
                    for (int n = 0; n < 2; ++n) v[bj][n] = acc[ai][bj][m][n] * rs;
                bf16_t* dst;
                if (region <= 1) {
                    float ss = 0.f;
#pragma unroll
                    for (int bj = 0; bj < 2; ++bj)
#pragma unroll
                        for (int n = 0; n < 2; ++n) ss += (v[bj][n][0] * v[bj][n][0] + v[bj][n][1] * v[bj][n][1]) + (v[bj][n][2] * v[bj][n][2] + v[bj][n][3] * v[bj][n][3]);
                    ss += __shfl_xor(ss, 16); ss += __shfl_xor(ss, 32);
                    const float rn = rsqrtf(ss * (1.0f / HD) + EPS);
#pragma unroll
                    for (int bj = 0; bj < 2; ++bj)
#pragma unroll
                        for (int n = 0; n < 2; ++n) v[bj][n] = v[bj][n] * rn * gn[bj][n];
                    dst = (region == 0 ? qh : kh) + ((size_t)head * S + row) * HD;
                } else if (region == 2) {
#pragma unroll
                    for (int bj = 0; bj < 2; ++bj)
#pragma unroll
                        for (int n = 0; n < 2; ++n)
#pragma unroll
                            for (int i = 0; i < 4; ++i) vh[((size_t)head * HD + 32 * bj + 8 * fq + 4 * n + i) * S + row] = (bf16_t)f2bf(v[bj][n][i]);
                    continue;
                } else if (region == 3) {
                    dst = xrg + (size_t)row * DRG + head * 64;
                } else {
#pragma unroll
                    for (int bj = 0; bj < 2; ++bj)
#pragma unroll
                        for (int n = 0; n < 2; ++n)
#pragma unroll
                            for (int i = 0; i < 4; ++i) v[bj][n][i] = gelu_tanh(v[bj][n][i]);
                    dst = gg + (size_t)row * DRG + head * 64;
                }
#pragma unroll
                for (int bj = 0; bj < 2; ++bj) {
                    pg8::u32x4 w; w.x = pg8::cvt_pk_bf16(v[bj][0][0], v[bj][0][1]); w.y = pg8::cvt_pk_bf16(v[bj][0][2], v[bj][0][3]);
                    w.z = pg8::cvt_pk_bf16(v[bj][1][0], v[bj][1][1]); w.w = pg8::cvt_pk_bf16(v[bj][1][2], v[bj][1][3]);
                    *(pg8::u32x4*)(dst + 32 * bj + 8 * fq) = w;
                }
            }
    }
};
struct EpiOutProj {
    static constexpr bool PERM = true, AFTER_DRAIN = false;
    const float* x; bf16_t* x1b; float* ssq; unsigned char* x1q; float* xsc;
    __device__ __forceinline__ void operator()(const pg8::f32x4 (&acc)[2][2][4][2], const pg8::Unit& u, int wr, int wc, int fr, int fq) const {
#pragma unroll
        for (int ai = 0; ai < 2; ++ai)
#pragma unroll
            for (int m = 0; m < 4; ++m) {
                const int row = u.pm * 256 + ai * 128 + wr * 64 + m * 16 + fr;
                float ss = 0.f;
#pragma unroll
                for (int bj = 0; bj < 2; ++bj) {
                    const int col = u.pn * 256 + bj * 128 + wc * 32 + 8 * fq;
                    const size_t o = (size_t)row * D + col;
                    const pg8::f32x4 a = *(const pg8::f32x4*)(x + o) + acc[ai][bj][m][0], b = *(const pg8::f32x4*)(x + o + 4) + acc[ai][bj][m][1];
                    ss += (a[0] * a[0] + a[1] * a[1]) + (a[2] * a[2] + a[3] * a[3]) + (b[0] * b[0] + b[1] * b[1]) + (b[2] * b[2] + b[3] * b[3]);
                    pg8::u32x4 w; w.x = pg8::cvt_pk_bf16(a[0], a[1]); w.y = pg8::cvt_pk_bf16(a[2], a[3]); w.z = pg8::cvt_pk_bf16(b[0], b[1]); w.w = pg8::cvt_pk_bf16(b[2], b[3]);
                    *(pg8::u32x4*)(x1b + o) = w;
                    float mx = fmaxf(fmaxf(fmaxf(fabsf(a[0]), fabsf(a[1])), fmaxf(fabsf(a[2]), fabsf(a[3]))), fmaxf(fmaxf(fabsf(b[0]), fabsf(b[1])), fmaxf(fabsf(b[2]), fabsf(b[3]))));
                    mx = fmaxf(mx, __shfl_xor(mx, 16)); mx = fmaxf(mx, __shfl_xor(mx, 32));
                    const float inv = mx > 0.f ? 119.0f / mx : 0.f;
                    unsigned pl = 0u, ph = 0u;
#pragma unroll
                    for (int i = 0; i < 4; ++i) {
                        const int qa = __float2int_rn(a[i] * inv), qb = __float2int_rn(b[i] * inv);
                        pl |= ((unsigned)(qa & 15) << (8 * i)) | ((unsigned)(qb & 15) << (8 * i + 4));
                        ph |= ((unsigned)(((qa + 8) >> 4) & 15) << (8 * i)) | ((unsigned)(((qb + 8) >> 4) & 15) << (8 * i + 4));
                    }
                    unsigned* cq = (unsigned*)(x1q + (size_t)row * D + (col & ~31));
                    cq[fq] = pl; cq[4 + fq] = ph;
                    if (fq == 0) xsc[(size_t)row * 32 + (col >> 5)] = mx * (1.0f / 119.0f);
                }
                ss += __shfl_xor(ss, 16); ss += __shfl_xor(ss, 32);
                if (fq == 0) ssq[(size_t)row * 16 + u.pn * 4 + wc] = ss;
            }
    }
};
struct EpiPeerQ {
    static constexpr bool PERM = true, AFTER_DRAIN = false;
    bf16_t* qp;
    __device__ __forceinline__ void operator()(const pg8::f32x4 (&acc)[2][2][4][2], const pg8::Unit& u, int wr, int wc, int fr, int fq) const {
#pragma unroll
        for (int ai = 0; ai < 2; ++ai)
#pragma unroll
            for (int m = 0; m < 4; ++m) {
                const int row = u.pm * 256 + ai * 128 + wr * 64 + m * 16 + fr;
#pragma unroll
                for (int bj = 0; bj < 2; ++bj) {
                    const pg8::f32x4 a = acc[ai][bj][m][0], b = acc[ai][bj][m][1];
                    pg8::u32x4 w; w.x = pg8::cvt_pk_bf16(a[0], a[1]); w.y = pg8::cvt_pk_bf16(a[2], a[3]); w.z = pg8::cvt_pk_bf16(b[0], b[1]); w.w = pg8::cvt_pk_bf16(b[2], b[3]);
                    *(pg8::u32x4*)(qp + (size_t)row * NQ + u.pn * 256 + bj * 128 + wc * 32 + 8 * fq) = w;
                }
            }
    }
};

typedef float f32x2v __attribute__((ext_vector_type(2)));
typedef __bf16 bf16x2v __attribute__((ext_vector_type(2)));
__device__ __forceinline__ unsigned cvtpk(float lo, float hi) { const f32x2v v = {lo, hi}; const bf16x2v b = __builtin_convertvector(v, bf16x2v); return __builtin_bit_cast(unsigned, b); }
__device__ __forceinline__ bf16x8 pack_step(const f32x16& x, int s) {
    u32x4 pkd; pkd.x = cvtpk(x[8 * s], x[8 * s + 1]); pkd.y = cvtpk(x[8 * s + 2], x[8 * s + 3]); pkd.z = cvtpk(x[8 * s + 4], x[8 * s + 5]); pkd.w = cvtpk(x[8 * s + 6], x[8 * s + 7]);
    return __builtin_bit_cast(bf16x8, pkd);
}
#define MFMA32(a, b, c) __builtin_amdgcn_mfma_f32_32x32x16_bf16((a), (b), (c), 0, 0, 0)
__device__ __forceinline__ void ph_attn(const Params& p) {
    unsigned char* ws = p.ws;
    const bf16_t* qh = (const bf16_t*)(ws + WS_QH); const bf16_t* kh = (const bf16_t*)(ws + WS_KH); const bf16_t* vT = (const bf16_t*)(ws + WS_VH);
    bf16_t* osb = (bf16_t*)(ws + WS_OSB);
    const int tid = phase_tid(), lane = tid & 63, r = lane & 31, hh = lane >> 5;
    const int gwave = (blockIdx.x * blockDim.x + tid) >> 6, nwave = (gridDim.x * blockDim.x) >> 6;
    bf16x8 tp[2];
#pragma unroll
    for (int ss = 0; ss < 2; ++ss)
#pragma unroll
        for (int e = 0; e < 8; ++e) { const int k = 16 * ss + 8 * (e >> 2) + 4 * hh + (e & 3); tp[ss][e] = (k > r) ? (short)0x3F80 : (short)0; }
    f32x16 zero16;
#pragma unroll
    for (int i = 0; i < 16; ++i) zero16[i] = 0.f;
    for (int u = gwave; u < NH * (S / 32); u += nwave) {
        const int h = u / (S / 32), t0 = (u % (S / 32)) * 32;
        bf16x8 bq[4];
#pragma unroll
        for (int s = 0; s < 4; ++s) bq[s] = *(const bf16x8*)(qh + ((size_t)h * S + t0 + r) * HD + 16 * s + 8 * hh);
        f32x16 ot[2] = {zero16, zero16};
        float carry = 0.f;
        for (int kt0 = t0; kt0 >= 0; kt0 -= 32) {
            bf16x8 ak[4], av[2][2];
#pragma unroll
            for (int s = 0; s < 4; ++s) ak[s] = *(const bf16x8*)(kh + ((size_t)h * S + kt0 + r) * HD + 16 * s + 8 * hh);
#pragma unroll
            for (int dt = 0; dt < 2; ++dt)
#pragma unroll
                for (int ss = 0; ss < 2; ++ss) {
                    const bf16_t* vp = vT + ((size_t)h * HD + 32 * dt + r) * S + kt0 + 16 * ss + 4 * hh;
                    const uint2 lo = *(const uint2*)vp, hi = *(const uint2*)(vp + 8);
                    u32x4 w4; w4.x = lo.x; w4.y = lo.y; w4.z = hi.x; w4.w = hi.y;
                    av[dt][ss] = __builtin_bit_cast(bf16x8, w4);
                }
            f32x16 st = zero16;
#pragma unroll
            for (int s = 0; s < 4; ++s) st = MFMA32(ak[s], bq[s], st);
            const bool diag = (kt0 == t0);
            f32x16 lom, lb;
            float csum = 0.f;
#pragma unroll
            for (int i = 0; i < 16; ++i) {
                const float z = st[i];
                const float sp2 = fmaxf(z, 0.f) + __builtin_amdgcn_logf(1.0f + __builtin_amdgcn_exp2f(-fabsf(z)));
                const bool valid = !diag || ((i & 3) + 8 * (i >> 2) + 4 * hh < r);
                lom[i] = valid ? -sp2 : 0.f;
                lb[i] = z - sp2;
                csum += lom[i];
            }
            f32x16 suf = MFMA32(tp[0], pack_step(lom, 0), zero16);
            suf = MFMA32(tp[1], pack_step(lom, 1), suf);
            f32x16 w;
#pragma unroll
            for (int i = 0; i < 16; ++i) {
                const bool valid = !diag || ((i & 3) + 8 * (i >> 2) + 4 * hh < r);
                w[i] = valid ? __builtin_amdgcn_exp2f(lb[i] + suf[i] + carry) : 0.f;
            }
            const bf16x8 w0 = pack_step(w, 0), w1 = pack_step(w, 1);
#pragma unroll
            for (int dt = 0; dt < 2; ++dt) { ot[dt] = MFMA32(av[dt][0], w0, ot[dt]); ot[dt] = MFMA32(av[dt][1], w1, ot[dt]); }
            carry += csum + __shfl_xor(csum, 32);
            if (__all(carry < CARRY_STOP)) break;
        }
#pragma unroll
        for (int dt = 0; dt < 2; ++dt)
#pragma unroll
            for (int g = 0; g < 4; ++g) {
                uint2 o; o.x = cvtpk(ot[dt][4 * g], ot[dt][4 * g + 1]); o.y = cvtpk(ot[dt][4 * g + 2], ot[dt][4 * g + 3]);
                *(uint2*)(osb + (size_t)(t0 + r) * DSB + h * HD + 32 * dt + 8 * g + 4 * hh) = o;
            }
    }
}

constexpr int RG_LDS_CST = 0, RG_LDS_HIN = 16384, RG_LDS_P = 18432, RG_LDS_SSQ = 20480;
constexpr int RG_LDS_X = 22528, RG_XP = 1032, RG_LDS_O = 91904;
typedef unsigned u32x2 __attribute__((ext_vector_type(2)));
typedef __attribute__((address_space(3))) float lds_f;
typedef __attribute__((address_space(3))) unsigned char lds_b;
template <int CTRL, int ROWMASK>
__device__ __forceinline__ float dpp_mov(float oob, float x) {
    return __builtin_bit_cast(float, __builtin_amdgcn_update_dpp(__builtin_bit_cast(int, oob), __builtin_bit_cast(int, x), CTRL, ROWMASK, 0xf, false));
}
template <int CTRL, int ROWMASK>
__device__ __forceinline__ void scan_step(float (&av)[16], float (&bv)[16]) {
#pragma unroll
    for (int i = 0; i < 16; ++i) {
        const float ap = dpp_mov<CTRL, ROWMASK>(1.0f, av[i]), bp = dpp_mov<CTRL, ROWMASK>(0.0f, bv[i]);
        bv[i] = __builtin_fmaf(av[i], bp, bv[i]); av[i] *= ap;
    }
}
template <int PASS>
__device__ __forceinline__ void ph_rg(const Params& p, unsigned char* lds_raw) {
    float* lds = (float*)lds_raw;
    unsigned char* ws = p.ws;
    const bf16_t* xrg = (const bf16_t*)(ws + WS_XRG); const bf16_t* gg = (const bf16_t*)(ws + WS_GG); const bf16_t* wfrag = (const bf16_t*)(ws + WS_RGW);
    const bf16_t* osb = (const bf16_t*)(ws + WS_OSB); bf16_t* mix = (bf16_t*)(ws + WS_MIX);
    float* rgP = (float*)(ws + WS_RGP); float* rgH = (float*)(ws + WS_RGH);
    const int tid = phase_tid(), lane = tid & 63, r = lane & 31, hh = lane >> 5, n = __builtin_amdgcn_readfirstlane(tid >> 6);
    __syncthreads();
    for (int e = tid; e < 8 * 2 * 8 * 32; e += NTHR) {
        const int q = e & 31, k = (e >> 5) & 7, h2 = (e >> 8) & 1, nn = e >> 9;
        const int c = 64 * nn + 32 * (q >> 4) + (q & 3) + 8 * ((q >> 2) & 3) + 4 * h2;
        float v;
        if (k < 4) v = p.in[I_CONV_W][k * DRG + c];
        else if (k == 4) v = p.in[I_CONV_B][c];
        else if (k == 5) v = p.in[I_RG_B_A][c];
        else if (k == 6) v = p.in[I_RG_B_X][c];
        else v = 8.0f * LOG2E * log1pf(__expf(-p.in[I_RG_LAMBDA][c]));
        lds[e] = v;
    }
    const unsigned lds0 = (unsigned)(size_t)((lds_b*)lds_raw);
    const unsigned cst_base = lds0 + (unsigned)((n * 2 + hh) * 1024);
    lds_f* hin_l = (lds_f*)(size_t)(lds0 + RG_LDS_HIN + (n * 2 + hh) * 128);
    lds_f* pc_l = (lds_f*)(size_t)(lds0 + RG_LDS_P + (n * 2 + hh) * 128);
    lds_b* xt = (lds_b*)(size_t)(lds0 + RG_LDS_X);
    lds_b* ot = (lds_b*)(size_t)(lds0 + RG_LDS_O);
    f32x16 zero16;
#pragma unroll
    for (int i = 0; i < 16; ++i) zero16[i] = 0.f;
    for (int ch = blockIdx.x; ch < NCHUNK; ch += gridDim.x) {
        const int t0 = ch * CHUNK;
        __syncthreads();
        for (int ci = tid; ci < (CHUNK + 3) * 64; ci += NTHR) {
            const int row = ci >> 6, c16 = ci & 63, tt = t0 - 3 + row;
            u32x4 v = {0u, 0u, 0u, 0u};
            if (tt >= 0) v = *(const u32x4*)(xrg + (size_t)tt * DRG + 8 * c16);
            __attribute__((address_space(3))) u32x2* d = (__attribute__((address_space(3))) u32x2*)(xt + row * RG_XP + 16 * c16);
            d[0] = (u32x2){v.x, v.y}; d[1] = (u32x2){v.z, v.w};
        }
        if (PASS == 1) {
            const int c = 64 * n + lane;
            float h = 0.f;
            int k = 0;
            for (; k + 32 <= ch; k += 32) {
                float pv[32], hv[32];
#pragma unroll
                for (int j = 0; j < 32; ++j) { pv[j] = rgP[(k + j) * DRG + c]; hv[j] = rgH[(k + j) * DRG + c]; }
#pragma unroll
                for (int j = 0; j < 32; ++j) h = pv[j] * h + hv[j];
            }
            for (; k + 8 <= ch; k += 8) {
                float pv[8], hv[8];
#pragma unroll
                for (int j = 0; j < 8; ++j) { pv[j] = rgP[(k + j) * DRG + c]; hv[j] = rgH[(k + j) * DRG + c]; }
#pragma unroll
                for (int j = 0; j < 8; ++j) h = pv[j] * h + hv[j];
            }
            for (; k < ch; ++k) h = rgP[k * DRG + c] * h + rgH[k * DRG + c];
            lds[RG_LDS_HIN / 4 + (n * 2 + ((lane >> 2) & 1)) * 32 + 16 * (lane >> 5) + 4 * ((lane >> 3) & 3) + (lane & 3)] = h;
        } else {
            if (r == 0) {
#pragma unroll
                for (int q = 0; q < 32; ++q) { hin_l[q] = 0.f; pc_l[q] = 1.f; }
            }
        }
        __syncthreads();
#pragma unroll 1
        for (int tl = 0; tl < 2; ++tl) {
            const int tok = t0 + 32 * tl + r;
            unsigned cst_a = cst_base; asm volatile("" : "+v"(cst_a));
            const lds_f* cst = (const lds_f*)(size_t)cst_a;
            float xcv[32];
#pragma unroll
            for (int q = 0; q < 32; ++q) xcv[q] = cst[4 * 32 + q];
#pragma unroll
            for (int k = 0; k < 4; ++k) {
                const lds_b* xr = xt + (32 * tl + r + k) * RG_XP + (64 * n + 4 * hh) * 2;
#pragma unroll
                for (int m = 0; m < 8; ++m) {
                    const u32x2 xw = *(const __attribute__((address_space(3))) u32x2*)(xr + 16 * m);
                    xcv[4 * m + 0] += cst[k * 32 + 4 * m + 0] * bf2f(xw.x & 0xffffu); xcv[4 * m + 1] += cst[k * 32 + 4 * m + 1] * bf2f(xw.x >> 16);
                    xcv[4 * m + 2] += cst[k * 32 + 4 * m + 2] * bf2f(xw.y & 0xffffu); xcv[4 * m + 3] += cst[k * 32 + 4 * m + 3] * bf2f(xw.y >> 16);
                }
                __builtin_amdgcn_sched_barrier(0);
            }
            bf16x8 bx[4];
#pragma unroll
            for (int s = 0; s < 4; ++s) {
                u32x4 pk; pk.x = cvtpk(xcv[8 * s], xcv[8 * s + 1]); pk.y = cvtpk(xcv[8 * s + 2], xcv[8 * s + 3]); pk.z = cvtpk(xcv[8 * s + 4], xcv[8 * s + 5]); pk.w = cvtpk(xcv[8 * s + 6], xcv[8 * s + 7]);
                bx[s] = __builtin_bit_cast(bf16x8, pk);
            }
            float ss = 0.f;
            const bf16_t* wb = wfrag + ((size_t)n * 16 * 64 + lane) * 8; asm volatile("" : "+v"(wb));
#pragma unroll
            for (int jt = 0; jt < 2; ++jt) {
                float av[16], bv[16];
#pragma unroll
                for (int g = 0; g < 2; ++g) {
                    f32x16 acc = zero16;
#pragma unroll
                    for (int s = 0; s < 4; ++s) {
                        const bf16x8 aw = *(const __attribute__((address_space(1))) bf16x8*)(wb + (((g * 2 + jt) * 4 + s) * 64) * 8);
                        acc = MFMA32(aw, bx[s], acc);
                    }
#pragma unroll
                    for (int i = 0; i < 16; ++i) {
                        const int q = 16 * jt + i;
                        const float pre = acc[i] + cst[(5 + g) * 32 + q];
                        const float sg = 1.0f / (1.0f + __builtin_amdgcn_exp2f(-LOG2E * pre));
                        if (g == 0) av[i] = __builtin_amdgcn_exp2f(-sg * cst[7 * 32 + q]);
                        else bv[i] = __builtin_amdgcn_sqrtf(fmaxf(__builtin_fmaf(-av[i], av[i], 1.0f), 0.f)) * (sg * xcv[q]);
                    }
                    __builtin_amdgcn_sched_barrier(0);
                }
                scan_step<0x111, 0xf>(av, bv); scan_step<0x112, 0xf>(av, bv); scan_step<0x114, 0xf>(av, bv); scan_step<0x118, 0xf>(av, bv);
                scan_step<0x142, 0xa>(av, bv);
                __builtin_amdgcn_sched_barrier(0);
#pragma unroll
                for (int i = 0; i < 16; ++i) {
                    const int q = 16 * jt + i;
                    const float h = __builtin_fmaf(av[i], hin_l[q], bv[i]);
                    if (r == 31) { hin_l[q] = h; if (PASS == 0) pc_l[q] *= av[i]; }
                    bv[i] = h;
                }
                if (PASS == 1) {
#pragma unroll
                    for (int g4 = 0; g4 < 4; ++g4) {
                        const int m = 4 * jt + g4;
                        const uint2 gw = *(const uint2*)(gg + (size_t)tok * DRG + 64 * n + 8 * m + 4 * hh);
                        const float o0 = bv[4 * g4] * bf2f(gw.x & 0xffffu), o1 = bv[4 * g4 + 1] * bf2f(gw.x >> 16), o2 = bv[4 * g4 + 2] * bf2f(gw.y & 0xffffu), o3 = bv[4 * g4 + 3] * bf2f(gw.y >> 16);
                        ss += (o0 * o0 + o1 * o1) + (o2 * o2 + o3 * o3);
                        *(__attribute__((address_space(3))) u32x2*)(ot + (32 * tl + r) * RG_XP + (64 * n + 8 * m + 4 * hh) * 2) = (u32x2){cvtpk(o0, o1), cvtpk(o2, o3)};
                    }
                }
                __builtin_amdgcn_sched_barrier(0);
            }
            if (PASS == 1) { ss += __shfl_xor(ss, 32); if (hh == 0) lds[RG_LDS_SSQ / 4 + (tl * 8 + n) * 32 + r] = ss; }
        }
        if (PASS == 0) {
            if (r == 0) {
#pragma unroll
                for (int m = 0; m < 8; ++m) {
                    const int c = 64 * n + 8 * m + 4 * hh;
                    *(f32x4*)(rgP + (size_t)ch * DRG + c) = (f32x4){pc_l[4 * m], pc_l[4 * m + 1], pc_l[4 * m + 2], pc_l[4 * m + 3]};
                    *(f32x4*)(rgH + (size_t)ch * DRG + c) = (f32x4){hin_l[4 * m], hin_l[4 * m + 1], hin_l[4 * m + 2], hin_l[4 * m + 3]};
                }
            }
        } else {
            __syncthreads();
            for (int j = 0; j < 8; ++j) {
                const int tr = 8 * n + j, tok = t0 + tr;
                float tot = 0.f;
#pragma unroll
                for (int w = 0; w < 8; ++w) tot += lds[RG_LDS_SSQ / 4 + ((tr >> 5) * 8 + w) * 32 + (tr & 31)];
                const float rn = rsqrtf(tot * (1.0f / DRG) + EPS);
                const __attribute__((address_space(3))) u32x2* op = (const __attribute__((address_space(3))) u32x2*)(ot + tr * RG_XP + 16 * lane);
                const u32x2 w0 = op[0], w1 = op[1];
                u32x4 o2; o2.x = cvtpk(bf2f(w0.x & 0xffffu) * rn, bf2f(w0.x >> 16) * rn); o2.y = cvtpk(bf2f(w0.y & 0xffffu) * rn, bf2f(w0.y >> 16) * rn);
                o2.z = cvtpk(bf2f(w1.x & 0xffffu) * rn, bf2f(w1.x >> 16) * rn); o2.w = cvtpk(bf2f(w1.y & 0xffffu) * rn, bf2f(w1.y >> 16) * rn);
                *((u32x4*)(mix + (size_t)tok * D + DSB) + lane) = o2;
                const u32x4 a = *((const u32x4*)(osb + (size_t)tok * DSB) + lane);
                float f[8] = {bf2f(a.x & 0xffffu), bf2f(a.x >> 16), bf2f(a.y & 0xffffu), bf2f(a.y >> 16), bf2f(a.z & 0xffffu), bf2f(a.z >> 16), bf2f(a.w & 0xffffu), bf2f(a.w >> 16)};
                float sa = 0.f;
#pragma unroll
                for (int k = 0; k < 8; ++k) sa += f[k] * f[k];
                sa = wave_sum(sa);
                const float ra = rsqrtf(sa * (1.0f / DSB) + EPS);
                u32x4 o; o.x = cvtpk(f[0] * ra, f[1] * ra); o.y = cvtpk(f[2] * ra, f[3] * ra); o.z = cvtpk(f[4] * ra, f[5] * ra); o.w = cvtpk(f[6] * ra, f[7] * ra);
                *((u32x4*)(mix + (size_t)tok * D) + lane) = o;
            }
        }
    }
}

__device__ __forceinline__ int f2key(float f) { const int b = __builtin_bit_cast(int, f); return b ^ ((b >> 31) & 0x7fffffff); }
__device__ __forceinline__ float key2f(int k) { return __builtin_bit_cast(float, k ^ ((k >> 31) & 0x7fffffff)); }
#define TOPK_CE(a, b) do { const int hi_ = max(a, b), lo_ = min(a, b); a = hi_; b = lo_; } while (0)
__device__ __forceinline__ void sort16_desc(int (&v)[16]) { TOPK_CE(v[0], v[1]); TOPK_CE(v[2], v[3]); TOPK_CE(v[0], v[2]); TOPK_CE(v[1], v[3]); TOPK_CE(v[1], v[2]); TOPK_CE(v[4], v[5]); TOPK_CE(v[6], v[7]); TOPK_CE(v[4], v[6]); TOPK_CE(v[5], v[7]); TOPK_CE(v[5], v[6]); TOPK_CE(v[0], v[4]); TOPK_CE(v[2], v[6]); TOPK_CE(v[2], v[4]); TOPK_CE(v[1], v[5]); TOPK_CE(v[3], v[7]); TOPK_CE(v[3], v[5]); TOPK_CE(v[1], v[2]); TOPK_CE(v[3], v[4]); TOPK_CE(v[5], v[6]); TOPK_CE(v[8], v[9]); TOPK_CE(v[10], v[11]); TOPK_CE(v[8], v[10]); TOPK_CE(v[9], v[11]); TOPK_CE(v[9], v[10]); TOPK_CE(v[12], v[13]); TOPK_CE(v[14], v[15]); TOPK_CE(v[12], v[14]); TOPK_CE(v[13], v[15]); TOPK_CE(v[13], v[14]); TOPK_CE(v[8], v[12]); TOPK_CE(v[10], v[14]); TOPK_CE(v[10], v[12]); TOPK_CE(v[9], v[13]); TOPK_CE(v[11], v[15]); TOPK_CE(v[11], v[13]); TOPK_CE(v[9], v[10]); TOPK_CE(v[11], v[12]); TOPK_CE(v[13], v[14]); TOPK_CE(v[0], v[8]); TOPK_CE(v[4], v[12]); TOPK_CE(v[4], v[8]); TOPK_CE(v[2], v[10]); TOPK_CE(v[6], v[14]); TOPK_CE(v[6], v[10]); TOPK_CE(v[2], v[4]); TOPK_CE(v[6], v[8]); TOPK_CE(v[10], v[12]); TOPK_CE(v[1], v[9]); TOPK_CE(v[5], v[13]); TOPK_CE(v[5], v[9]); TOPK_CE(v[3], v[11]); TOPK_CE(v[7], v[15]); TOPK_CE(v[7], v[11]); TOPK_CE(v[3], v[5]); TOPK_CE(v[7], v[9]); TOPK_CE(v[11], v[13]); TOPK_CE(v[1], v[2]); TOPK_CE(v[3], v[4]); TOPK_CE(v[5], v[6]); TOPK_CE(v[7], v[8]); TOPK_CE(v[9], v[10]); TOPK_CE(v[11], v[12]); TOPK_CE(v[13], v[14]); }
__device__ __forceinline__ void merge16_desc(int (&a)[16], const int (&b)[16]) {
#pragma unroll
    for (int i = 0; i < 16; ++i) a[i] = max(a[i], b[15 - i]);
#pragma unroll
    for (int d = 8; d >= 1; d >>= 1)
#pragma unroll
        for (int i = 0; i < 16; ++i) if ((i & d) == 0) TOPK_CE(a[i], a[i + d]);
}
__device__ __forceinline__ void ph_topk(const Params& p, int* lds) {
    unsigned char* ws = p.ws;
    const bf16_t* qp = (const bf16_t*)(ws + WS_B); const bf16_t* subk = (const bf16_t*)(ws + WS_SUBK);
    int* seli = (int*)(ws + WS_SELI); float* selg = (float*)(ws + WS_SELG);
    const float* ssq = (const float*)(ws + WS_SSQ); float* rstd2 = (float*)(ws + WS_RSTD2);
    const int tid = phase_tid(), lane = tid & 63, r = lane & 31, hh = lane >> 5, hx = 4 * hh;
    const int gwave = (blockIdx.x * blockDim.x + tid) >> 6, nwave = (gridDim.x * blockDim.x) >> 6;
    constexpr int SK_OFF = 65536, SK_PITCH = 272;
    typedef __attribute__((address_space(3))) unsigned char lds_b;
    lds_b* skl = (lds_b*)lds + SK_OFF;
    const int w = tid >> 6;
    for (int ub = blockIdx.x * (NTHR / 64); ub < (S / 32) * PH; ub += gridDim.x * (NTHR / 64)) {
        const int u = ub + w;
        const int h = ub / (S / 32), t0 = (u % (S / 32)) * 32, t = t0 + r;
        __syncthreads();
#pragma unroll
        for (int j = 0; j < 8; ++j) {
            const int ci = tid + NTHR * j, row = ci >> 4, c16 = ci & 15;
            const u32x4 v = *(const u32x4*)(subk + ((size_t)h * 256 + row) * PHALF + 8 * c16);
            *(__attribute__((address_space(3))) u32x4*)(skl + row * SK_PITCH + 16 * c16) = v;
        }
        __syncthreads();
        int tk[2][16];
#pragma unroll
        for (int pp = 0; pp < 2; ++pp) {
            f32x16 acc[4];
#pragma unroll
            for (int T = 0; T < 4; ++T)
#pragma unroll
                for (int i = 0; i < 16; ++i) acc[T][i] = 0.f;
            const bf16_t* qrow = qp + (size_t)t * NQ + h * PDK + pp * PHALF + 8 * hh;
            const lds_b* krow = skl + (pp * PNK + r) * SK_PITCH + 16 * hh;
#pragma unroll
            for (int s = 0; s < 8; ++s) {
                const bf16x8 b = *(const bf16x8*)(qrow + 16 * s);
#pragma unroll
                for (int T = 0; T < 4; ++T) {
                    const bf16x8 a = *(const __attribute__((address_space(3))) bf16x8*)(krow + (32 * T) * SK_PITCH + 32 * s);
                    acc[T] = __builtin_amdgcn_mfma_f32_32x32x16_bf16(a, b, acc[T], 0, 0, 0);
                }
            }
            int kq[4][16];
#pragma unroll
            for (int T = 0; T < 4; ++T) {
#pragma unroll
                for (int i = 0; i < 16; ++i) {
                    const int nb = 32 * T + (i & 3) + 8 * (i >> 2);
                    kq[T][i] = ((f2key(acc[T][i]) & ~127) | (127 - nb)) ^ hx;
                }
                sort16_desc(kq[T]);
            }
            merge16_desc(kq[0], kq[1]); merge16_desc(kq[2], kq[3]); merge16_desc(kq[0], kq[2]);
            int m[16], po[16];
#pragma unroll
            for (int i = 0; i < 16; ++i) { m[i] = kq[0][i]; po[i] = __shfl_xor(kq[0][i], 32); }
            merge16_desc(m, po);
#pragma unroll
            for (int i = 0; i < 16; ++i) tk[pp][i] = m[i];
        }
#pragma unroll
        for (int i = 0; i < 16; ++i) { lds[i * NTHR + tid] = tk[0][i]; lds[(16 + i) * NTHR + tid] = tk[1][i]; }
        float v0[16], v1[16];
#pragma unroll
        for (int i = 0; i < 16; ++i) { v0[i] = key2f(tk[0][i]); v1[i] = key2f(tk[1][i]); }
#define CKEY(a, b) ((f2key(v0[a] + v1[b]) & ~255) | (255 - ((a) * 16 + (b))))
        const int NEGK = (int)0x80000000;
        int bk[16], l1[16], ga[16], gb[16];
#pragma unroll
        for (int b = 0; b < 16; ++b) bk[b] = CKEY(0, b);
#pragma unroll
        for (int b = 0; b < 16; ++b) l1[b] = b < 8 ? CKEY(1, b) : NEGK;
        ga[0] = CKEY(2, 0); ga[1] = CKEY(2, 1); ga[2] = CKEY(2, 2); ga[3] = CKEY(2, 3); ga[4] = CKEY(2, 4);
        ga[5] = CKEY(3, 0); ga[6] = CKEY(3, 1); ga[7] = CKEY(3, 2); ga[8] = CKEY(3, 3);
        ga[9] = CKEY(4, 0); ga[10] = CKEY(4, 1); ga[11] = CKEY(4, 2); ga[12] = CKEY(5, 0); ga[13] = CKEY(5, 1); ga[14] = NEGK; ga[15] = NEGK;
        gb[0] = CKEY(6, 0); gb[1] = CKEY(6, 1); gb[2] = CKEY(7, 0); gb[3] = CKEY(7, 1);
#pragma unroll
        for (int a = 8; a < 16; ++a) gb[a - 4] = CKEY(a, 0);
        gb[12] = NEGK; gb[13] = NEGK; gb[14] = NEGK; gb[15] = NEGK;
#undef CKEY
        sort16_desc(ga); sort16_desc(gb);
        merge16_desc(bk, l1); merge16_desc(ga, gb); merge16_desc(bk, ga);
        float ssum = 0.f;
#pragma unroll
        for (int i = 0; i < 4; ++i) { const f32x4 q4 = *(const f32x4*)(ssq + (size_t)t * 16 + 4 * i); ssum += (q4.x + q4.y) + (q4.z + q4.w); }
        const float rs = rsqrtf(ssum * (1.0f / D) + EPS);
        float e[16], sum = 0.f; const float mx = key2f(bk[0]);
#pragma unroll
        for (int i = 0; i < 16; ++i) { e[i] = __expf((key2f(bk[i]) - mx) * rs); sum += e[i]; }
        const float inv = 1.0f / sum;
        int eidx[16];
#pragma unroll
        for (int i = 0; i < 16; ++i) {
            const int code = 255 - (bk[i] & 255), a = code >> 4, b = code & 15;
            const int i1 = 127 - (lds[a * NTHR + tid] & 127), i2 = 127 - (lds[(16 + b) * NTHR + tid] & 127);
            eidx[i] = i1 * PNK + i2; e[i] *= inv;
        }
        if (hh == 0) {
            int4* o = (int4*)(seli + (size_t)t * 128 + h * 16);
#pragma unroll
            for (int i = 0; i < 4; ++i) o[i] = make_int4(eidx[4 * i], eidx[4 * i + 1], eidx[4 * i + 2], eidx[4 * i + 3]);
            if (h == 0) rstd2[t] = rs;
        } else {
            f32x4* o = (f32x4*)(selg + (size_t)t * 128 + h * 16);
#pragma unroll
            for (int i = 0; i < 4; ++i) o[i] = (f32x4){e[4 * i], e[4 * i + 1], e[4 * i + 2], e[4 * i + 3]};
        }
    }
}

typedef __bf16 bf16x2_t __attribute__((ext_vector_type(2)));
typedef float f32x2 __attribute__((ext_vector_type(2)));
template <int NV, int XS0, int XS1, int XS2>
__device__ __forceinline__ void reduce_over8(float (&v)[NV], int sel) {
    { const bool up = sel & 1;
#pragma unroll
      for (int i = 0; i < NV / 2; ++i) { const float a = v[2 * i], b = v[2 * i + 1]; v[i] = (up ? b : a) + __shfl_xor(up ? a : b, XS0); } }
    { const bool up = (sel >> 1) & 1;
#pragma unroll
      for (int i = 0; i < NV / 4; ++i) { const float a = v[2 * i], b = v[2 * i + 1]; v[i] = (up ? b : a) + __shfl_xor(up ? a : b, XS1); } }
    { const bool up = (sel >> 2) & 1;
#pragma unroll
      for (int i = 0; i < NV / 8; ++i) { const float a = v[2 * i], b = v[2 * i + 1]; v[i] = (up ? b : a) + __shfl_xor(up ? a : b, XS2); } }
}
__device__ __forceinline__ void peer_load_idx(const unsigned char* ws, int t, int rsl, int (&ei)[16]) {
    const unsigned off = (unsigned)WS_SELI + ((unsigned)t * 128u + 16u * (unsigned)rsl) * 4u;
#pragma unroll
    for (int j = 0; j < 4; ++j) { const int4 v = *(const int4*)(ws + (off + 16u * j)); ei[4 * j] = v.x; ei[4 * j + 1] = v.y; ei[4 * j + 2] = v.z; ei[4 * j + 3] = v.w; }
}
template <int PASS>
__device__ __forceinline__ void peer_load_rows(const unsigned char* ws, int t, int sl, int rsl, int c, const int (&ei)[16], u32x4 (&row)[16], u32x4 (&aux)[4]) {
    const unsigned tab = (unsigned)(PASS == 0 ? WS_UB : WS_VB) + (unsigned)sl * (unsigned)(NEXP * 128) + 16u * (unsigned)c;
#pragma unroll
    for (int i = 0; i < 16; ++i) row[i] = *(const u32x4*)(ws + (tab + (unsigned)ei[i] * 128u));
    const unsigned xo = (unsigned)WS_X1Q + (unsigned)t * (unsigned)D + 256u * sl + 32u * c;
    aux[0] = *(const u32x4*)(ws + xo); aux[1] = *(const u32x4*)(ws + (xo + 16u));
    aux[2].x = *(const unsigned*)(ws + ((unsigned)WS_XSC + ((unsigned)t * 32u + 8u * sl + c) * 4u));
}
constexpr int PEER_IMG_PITCH = 136, PEER_IMG_BYTES = 128 * PEER_IMG_PITCH;
template <int PASS  >
__device__ __forceinline__ void peer_compute(const Params& p, unsigned char* lds, int lane_w, int t, int sl, int rsl, int c, const u32x4 (&row)[16], const u32x4 (&aux)[4]) {
    unsigned char* ws = p.ws;
    if (PASS == 0) {
        const u32x4 x0 = aux[0], x1_ = aux[1]; const unsigned xl[4] = {x0.x, x0.y, x0.z, x0.w}, xh[4] = {x1_.x, x1_.y, x1_.z, x1_.w};
        const unsigned xsu = aux[2].x; const float xs = u2f(xsu);
        float pd[16];
#pragma unroll
        for (int i = 0; i < 16; ++i) {
            const u32x4 rw = row[i]; const unsigned w4[4] = {rw.x, rw.y, rw.z, rw.w};
            int al = 0, ah = 0;
#pragma unroll
            for (int j = 0; j < 4; ++j) { al = __builtin_amdgcn_sdot8((int)w4[j], (int)xl[j], al, false); ah = __builtin_amdgcn_sdot8((int)w4[j], (int)xh[j], ah, false); }
            pd[i] = (float)(16 * ah + al) * xs;
        }
        reduce_over8<16, 1, 2, 4>(pd, c);
        const unsigned po = (unsigned)WS_PD + (((unsigned)sl * S + (unsigned)t) * 128u + 16u * rsl + c) * 4u;
        *(float*)(ws + po) = pd[0]; *(float*)(ws + (po + 32u)) = pd[1];
    }
}
template <int PASS>
__device__ __forceinline__ void peer_stream(const Params& p, unsigned char* lds, int lane_w, int sl, int t0, int dt, int n) {
    const unsigned char* ws = p.ws;
    const int lane = lane_w & 63, rsl = lane >> 3, c = lane & 7;
    int eiA[16], eiB[16]; u32x4 rowA[16], rowB[16], auxA[4], auxB[4];
    if (n <= 0) return;
    peer_load_idx(ws, t0, rsl, eiA);
    peer_load_rows<PASS>(ws, t0, sl, rsl, c, eiA, rowA, auxA);
    if (n > 1) peer_load_idx(ws, t0 + dt, rsl, eiB);
    for (int i = 0; i < n; i += 2) {
        const int t = t0 + i * dt;
        if (i + 1 < n) peer_load_rows<PASS>(ws, t + dt, sl, rsl, c, eiB, rowB, auxB);
        if (i + 2 < n) peer_load_idx(ws, t + 2 * dt, rsl, eiA);
        peer_compute<PASS>(p, lds, lane_w, t, sl, rsl, c, rowA, auxA);
        if (i + 1 < n) {
            if (i + 2 < n) peer_load_rows<PASS>(ws, t + 2 * dt, sl, rsl, c, eiA, rowA, auxA);
            if (i + 3 < n) peer_load_idx(ws, t + 3 * dt, rsl, eiB);
            peer_compute<PASS>(p, lds, lane_w, t + dt, sl, rsl, c, rowB, auxB);
        }
    }
}
__device__ __forceinline__ void peerv_load_idx(const unsigned char* ws, int t, int hf, int rsl, int (&ei)[8]) {
    const unsigned off = (unsigned)WS_SELI + ((unsigned)t * 128u + 16u * (unsigned)rsl + 8u * (unsigned)hf) * 4u;
    const int4 v0 = *(const int4*)(ws + off), v1 = *(const int4*)(ws + (off + 16u));
    ei[0] = v0.x; ei[1] = v0.y; ei[2] = v0.z; ei[3] = v0.w; ei[4] = v1.x; ei[5] = v1.y; ei[6] = v1.z; ei[7] = v1.w;
}
__device__ __forceinline__ void peerv_load_rows(const unsigned char* ws, int sl, int c, const int (&ei)[8], u32x4 (&row)[8]) {
    const unsigned tab = (unsigned)WS_VB + (unsigned)sl * (unsigned)(NEXP * 128) + 16u * (unsigned)c;
#pragma unroll
    for (int i = 0; i < 8; ++i) row[i] = *(const u32x4*)(ws + (tab + (unsigned)ei[i] * 128u));
}
struct PeerVAux { u32x4 cp; unsigned cs; unsigned xo[4]; };
__device__ __forceinline__ void peerv_load_aux(const unsigned char* ws, int t, int sl, int lane, PeerVAux& a) {
    a.cp = *(const u32x4*)(ws + ((unsigned)WS_CBUF + (unsigned)t * 128u + 16u * (unsigned)(lane & 7)));
    a.cs = *(const unsigned*)(ws + ((unsigned)WS_CSC + (unsigned)t * 4u));
    const unsigned xo = (unsigned)WS_A + ((unsigned)t * (unsigned)D + 256u * sl + (unsigned)lane) * 2u;
    a.xo[0] = *(const bf16_t*)(ws + xo); a.xo[1] = *(const bf16_t*)(ws + (xo + 128u)); a.xo[2] = *(const bf16_t*)(ws + (xo + 256u)); a.xo[3] = *(const bf16_t*)(ws + (xo + 384u));
}
template <int HF>
__device__ __forceinline__ void peerv_half(lds_b* img, int lane, const u32x4 (&row)[8], const PeerVAux& a, int (&acc)[4]) {
    const int rsl = lane >> 3, c = lane & 7;
#pragma unroll
    for (int i = 0; i < 8; ++i) {
        const u32x4 rw = row[i];
        __attribute__((address_space(3))) u32x2* d = (__attribute__((address_space(3))) u32x2*)(img + (16 * rsl + i) * PEER_IMG_PITCH + 16 * c);
        d[0] = (u32x2){rw.x, rw.y}; d[1] = (u32x2){rw.z, rw.w};
    }
    const unsigned cpl = HF == 0 ? a.cp.x : a.cp.y, cph = HF == 0 ? a.cp.z : a.cp.w;
    asm volatile("s_waitcnt lgkmcnt(0)" ::: "memory");
    const unsigned ra = (unsigned)(size_t)img + (unsigned)((lane & 15) * PEER_IMG_PITCH + 8 * (lane >> 4));
#define PEER_TR4(R0, R1, R2, R3, RS) asm volatile("ds_read_b64_tr_b4 %0, %4 offset:%5\n\tds_read_b64_tr_b4 %1, %4 offset:%6\n\tds_read_b64_tr_b4 %2, %4 offset:%7\n\tds_read_b64_tr_b4 %3, %4 offset:%8" \
            : "=&v"(R0), "=&v"(R1), "=&v"(R2), "=&v"(R3) : "v"(ra), "i"((RS) * 16 * PEER_IMG_PITCH), "i"((RS) * 16 * PEER_IMG_PITCH + 32), "i"((RS) * 16 * PEER_IMG_PITCH + 64), "i"((RS) * 16 * PEER_IMG_PITCH + 96) : "memory")
#define PEER_USE4(R0, R1, R2, R3, RS, WAITSTR) do { \
            asm volatile(WAITSTR : "+v"(R0), "+v"(R1), "+v"(R2), "+v"(R3) :: "memory"); \
            const int cl_ = __builtin_amdgcn_readlane((int)cpl, RS), ch_ = __builtin_amdgcn_readlane((int)cph, RS); \
            const unsigned lo4_[4] = {R0.x, R1.x, R2.x, R3.x}; \
            _Pragma("unroll") for (int tcg = 0; tcg < 4; ++tcg) acc[tcg] += 16 * __builtin_amdgcn_sdot8((int)lo4_[tcg], ch_, 0, false) + __builtin_amdgcn_sdot8((int)lo4_[tcg], cl_, 0, false); } while (0)
    {
        u32x2 a0, a1, a2, a3, b0, b1, b2, b3;
        PEER_TR4(a0, a1, a2, a3, 0);
        PEER_TR4(b0, b1, b2, b3, 1); PEER_USE4(a0, a1, a2, a3, 0, "s_waitcnt lgkmcnt(4)");
        PEER_TR4(a0, a1, a2, a3, 2); PEER_USE4(b0, b1, b2, b3, 1, "s_waitcnt lgkmcnt(4)");
        PEER_TR4(b0, b1, b2, b3, 3); PEER_USE4(a0, a1, a2, a3, 2, "s_waitcnt lgkmcnt(4)");
        PEER_TR4(a0, a1, a2, a3, 4); PEER_USE4(b0, b1, b2, b3, 3, "s_waitcnt lgkmcnt(4)");
        PEER_TR4(b0, b1, b2, b3, 5); PEER_USE4(a0, a1, a2, a3, 4, "s_waitcnt lgkmcnt(4)");
        PEER_TR4(a0, a1, a2, a3, 6); PEER_USE4(b0, b1, b2, b3, 5, "s_waitcnt lgkmcnt(4)");
        PEER_TR4(b0, b1, b2, b3, 7); PEER_USE4(a0, a1, a2, a3, 6, "s_waitcnt lgkmcnt(4)");
        PEER_USE4(b0, b1, b2, b3, 7, "s_waitcnt lgkmcnt(0)");
    }
#undef PEER_TR4
#undef PEER_USE4
}
__device__ __forceinline__ void peerv_stream(const Params& p, unsigned char* lds, int tid_, int sl, int t0, int dt, int n) {
    const unsigned char* ws = p.ws;
    const int lane = tid_ & 63, rsl = lane >> 3, c = lane & 7;
    lds_b* img = (lds_b*)lds + (tid_ >> 6) * PEER_IMG_BYTES;
    for (int e = lane; e < 64 * (PEER_IMG_PITCH / 8); e += 64) {
        const int zr = e / (PEER_IMG_PITCH / 8), zc = e % (PEER_IMG_PITCH / 8);
        *(__attribute__((address_space(3))) u32x2*)(img + (16 * (zr >> 3) + 8 + (zr & 7)) * PEER_IMG_PITCH + 8 * zc) = (u32x2){0u, 0u};
    }
    if (n <= 0) return;
    int ei0[8], ei1[8]; u32x4 rowA[8], rowB[8]; PeerVAux ax, axn;
    peerv_load_idx(ws, t0, 0, rsl, ei0);
    peerv_load_rows(ws, sl, c, ei0, rowA); peerv_load_aux(ws, t0, sl, lane, ax);
    peerv_load_idx(ws, t0, 1, rsl, ei1);
    for (int i = 0; i < n; ++i) {
        const int t = t0 + i * dt; const bool more = i + 1 < n;
        int acc[4] = {0, 0, 0, 0};
        peerv_load_rows(ws, sl, c, ei1, rowB);
        if (more) peerv_load_idx(ws, t + dt, 0, rsl, ei0);
        peerv_half<0>(img, lane, rowA, ax, acc);
        if (more) { peerv_load_rows(ws, sl, c, ei0, rowA); peerv_load_aux(ws, t + dt, sl, lane, axn); peerv_load_idx(ws, t + dt, 1, rsl, ei1); }
        peerv_half<1>(img, lane, rowB, ax, acc);
        const float cs = u2f(ax.cs);
#pragma unroll
        for (int tcg = 0; tcg < 4; ++tcg) {
            const unsigned oo = ((unsigned)t * (unsigned)D + 256u * sl + 64u * tcg + (unsigned)lane) * 4u;
            *(float*)((unsigned char*)p.out + oo) = bf2f(ax.xo[tcg]) + (float)acc[tcg] * cs;
        }
        if (more) ax = axn;
    }
}
template <int PASS>
__device__ __forceinline__ void ph_peer(const Params& p, unsigned char* lds) {
    const int tid_ = phase_tid();
    const int lane = tid_ & 63, w = tid_ >> 6, b = blockIdx.x, G = gridDim.x;
    if ((G & 7) == 0) {
        const int g = b & 7, nsw = (G >> 3) * 2 * (NTHR / 64), t0 = ((g >> 2) * (G >> 3) + (b >> 3)) * (NTHR / 64) + w;
        if (PASS == 0) peer_stream<0>(p, lds, tid_, g & 3, t0, nsw, t0 < S ? (S - 1 - t0) / nsw + 1 : 0);
        else peerv_stream(p, lds, tid_, g & 3, t0, nsw, t0 < S ? (S - 1 - t0) / nsw + 1 : 0);
    } else {
        const int nw = G * (NTHR / 64), it0 = b * (NTHR / 64) + w;
        for (int it = it0; it < S * 4; it += nw) { if (PASS == 0) peer_stream<0>(p, lds, tid_, it & 3, it >> 2, 0, 1); else peerv_stream(p, lds, tid_, it & 3, it >> 2, 0, 1); }
    }
}
__device__ __forceinline__ void ph_peer_combine(const Params& p) {
    unsigned char* ws = p.ws;
    const int* seli = (const int*)(ws + WS_SELI); const float* selg = (const float*)(ws + WS_SELG); const float* rstd2 = (const float*)(ws + WS_RSTD2);
    const float2* uvsc = (const float2*)(ws + WS_USC);
    const float* pd = (const float*)(ws + WS_PD);
    unsigned* cpl = (unsigned*)(ws + WS_CBUF); float* csc = (float*)(ws + WS_CSC);
    const int tid_ = phase_tid(), lane = tid_ & 63, gwave = (blockIdx.x * blockDim.x + tid_) >> 6, nwave = (gridDim.x * blockDim.x) >> 6;
    for (int t = gwave; t < S; t += nwave) {
        float cf[2];
#pragma unroll
        for (int hf = 0; hf < 2; ++hf) {
            const int e = t * 128 + 64 * hf + lane;
            float d = 0.f;
#pragma unroll
            for (int g = 0; g < 4; ++g) d += pd[(size_t)g * S * 128 + e];
            const float2 sc2 = uvsc[seli[e]];
            cf[hf] = selg[e] * gelu_tanh(d * sc2.x * rstd2[t]) * sc2.y;
        }
        float m = fmaxf(fabsf(cf[0]), fabsf(cf[1]));
#pragma unroll
        for (int o = 1; o < 64; o <<= 1) m = fmaxf(m, __shfl_xor(m, o));
        const float inv = m > 0.f ? 119.0f / m : 0.f;
#pragma unroll
        for (int hf = 0; hf < 2; ++hf) {
            const int q = __float2int_rn(cf[hf] * inv);
            unsigned dl = (unsigned)(q & 15) << (4 * (lane & 7)), dh = (unsigned)(((q + 8) >> 4) & 15) << (4 * (lane & 7));
            dl |= __shfl_xor(dl, 1); dh |= __shfl_xor(dh, 1); dl |= __shfl_xor(dl, 2); dh |= __shfl_xor(dh, 2); dl |= __shfl_xor(dl, 4); dh |= __shfl_xor(dh, 4);
            if ((lane & 7) == 0) {
                const int dk = 8 * hf + (lane >> 3), rs = dk >> 1, half = dk & 1;
                cpl[(size_t)t * 32 + 4 * rs + half] = dl; cpl[(size_t)t * 32 + 4 * rs + 2 + half] = dh;
            }
        }
        if (lane == 0) csc[t] = m * (1.0f / 119.0f);
    }
}

#define LAS __attribute__((address_space(3)))
#define XB_TMO      128
#define XB_XCNT(j)  (256  + 64 * (j))
#define XB_XSUB(j)  (1280 + 64 * (j))
#define XB_XGEN(j)  (2304 + 64 * (j))
#define XB_TOP      3328
#define XB_TOPGEN   3392
#define XCD_BAR_WORDS 3456
#define XB_SPIN_CAP (1u << 18)
__device__ __forceinline__ unsigned xb_ld(unsigned* p)              { return __hip_atomic_load(p, __ATOMIC_RELAXED, __HIP_MEMORY_SCOPE_AGENT); }
__device__ __forceinline__ unsigned xb_add(unsigned* p, unsigned v) { return __hip_atomic_fetch_add(p, v, __ATOMIC_RELAXED, __HIP_MEMORY_SCOPE_AGENT); }
__device__ __forceinline__ unsigned xb_xcc_id() { return (unsigned)__builtin_amdgcn_s_getreg((3 << 11) | 20) & 0xFu; }
#define XB_SPIN(cond, bar) do { unsigned _sp = 0; while (cond) { __builtin_amdgcn_s_sleep(1); \
    if ((++_sp & 255u) == 0u) { if (xb_ld(&(bar)[XB_TMO])) break; if (_sp > XB_SPIN_CAP) { atomicAdd(&(bar)[XB_TMO], 1u); break; } } } } while (0)
struct XcdBarrier { unsigned* bar; unsigned x; volatile LAS unsigned* st; };
__device__ __forceinline__ XcdBarrier xcd_barrier_post(unsigned* bar, volatile LAS unsigned* st) {
    XcdBarrier b; b.bar = bar; b.x = xb_xcc_id(); b.st = st;
    if (threadIdx.x == 0) (void)xb_add(&bar[XB_XCNT(b.x)], 1u);
    return b;
}
__device__ __forceinline__ void xcd_barrier_complete(unsigned* bar, unsigned x, unsigned& nloc, unsigned& nx) {
    const unsigned G = gridDim.x * gridDim.y * gridDim.z;
    unsigned sum, cnt, mine, sp = 0u;
    for (;;) {
        sum = 0u; cnt = 0u; mine = 0u;
#pragma unroll
        for (unsigned j = 0; j < 16; ++j) { const unsigned c = xb_ld(&bar[XB_XCNT(j)]); sum += c; cnt += (c > 0u) ? 1u : 0u; mine = (j == x) ? c : mine; }
        if (sum == G) break;
        __builtin_amdgcn_s_sleep(1);
        if ((++sp & 255u) == 0u) { if (xb_ld(&bar[XB_TMO])) break; if (sp > XB_SPIN_CAP) { atomicAdd(&bar[XB_TMO], 1u); break; } }
    }
    nloc = mine > 0u ? mine : 1u; nx = cnt > 0u ? cnt : 1u;
}
__device__ __forceinline__ void xcd_barrier(const XcdBarrier& b) {
    asm volatile("s_waitcnt vmcnt(0)" ::: "memory");
    __syncthreads();
    if (threadIdx.x == 0) {
        unsigned* bar = b.bar;
        __builtin_amdgcn_s_waitcnt(0);
        unsigned nloc = b.st[0], nx = b.st[1];
        if (nloc == 0u) { xcd_barrier_complete(bar, b.x, nloc, nx); b.st[0] = nloc; b.st[1] = nx; }
        const unsigned old = xb_add(&bar[XB_XSUB(b.x)], 1u);
        const unsigned gen = old / nloc;
        if (old + 1u == (gen + 1u) * nloc) {
            __builtin_amdgcn_fence(__ATOMIC_RELEASE, "agent");
            asm volatile("s_waitcnt vmcnt(0)" ::: "memory");
            const unsigned og = xb_add(&bar[XB_TOP], 1u);
            const unsigned tg = og / nx;
            if (og + 1u == (tg + 1u) * nx) xb_add(&bar[XB_TOPGEN], 1u);
            else XB_SPIN(xb_ld(&bar[XB_TOPGEN]) == tg, bar);
            __builtin_amdgcn_fence(__ATOMIC_ACQUIRE, "agent");
            xb_add(&bar[XB_XGEN(b.x)], 1u);
            asm volatile("s_waitcnt vmcnt(0)" ::: "memory");
        } else {
            XB_SPIN(xb_ld(&bar[XB_XGEN(b.x)]) == gen, bar);
            __builtin_amdgcn_fence(__ATOMIC_ACQUIRE, "agent");
            asm volatile("s_waitcnt vmcnt(0)" ::: "memory");
        }
    }
    __syncthreads();
}

constexpr int LDS_MISC = 158720;
constexpr int LDS_BYTES = LDS_MISC + 1024;

__global__ void __launch_bounds__(NTHR, 2) hymba_fwd(Params p) {
    extern __shared__ __attribute__((aligned(16))) unsigned char lds[];
    volatile LAS unsigned* misc = (volatile LAS unsigned*)((LAS unsigned char*)lds + LDS_MISC);
    if (threadIdx.x < 4) misc[threadIdx.x] = 0u;
    __syncthreads();
    XcdBarrier bar = xcd_barrier_post((unsigned*)(p.ws + WS_CTL), misc);

    PG8_LAS unsigned char* ring = (PG8_LAS unsigned char*)lds;
    unsigned char* ws = p.ws;
    ph_prep(p, lds);                          xcd_barrier(bar);
    {
        pg8::Gemm g{(const bf16_t*)(ws + WS_A), (const bf16_t*)(ws + WS_WINT), S, NPROJ, D}; pg8::StaticOrder so; so.init(S, NPROJ, (int)gridDim.x, (int)blockIdx.x);
        EpiInProj E{(const float*)(ws + WS_RSTD1), p.in[I_Q_NORM], p.in[I_K_NORM], (bf16_t*)(ws + WS_QH), (bf16_t*)(ws + WS_KH), (bf16_t*)(ws + WS_VH), (bf16_t*)(ws + WS_XRG), (bf16_t*)(ws + WS_GG)};
        pg8::gemm_phase<EpiInProj, pg8::StaticOrder, true, true>(ring, g, so, E);
        const int G = (int)gridDim.x, nunits = (S / 256) * (NPROJ / 256), rem = nunits % G, b = (int)blockIdx.x;
        const int tid_ = phase_tid(), w = tid_ >> 6, lane = tid_ & 63;
        if (rem == 0) ph_tables(p, b * (NTHR / 64) + w, G * (NTHR / 64), lane);
        else if (b >= rem) ph_tables(p, (b - rem) * (NTHR / 64) + w, (G - rem) * (NTHR / 64), lane);
    }
    xcd_barrier(bar);
    ph_attn(p); ph_rg<0>(p, lds);             xcd_barrier(bar);
    ph_rg<1>(p, lds);                         xcd_barrier(bar);
    {
        pg8::Gemm g{(const bf16_t*)(ws + WS_MIX), (const bf16_t*)(ws + WS_WOUTT), S, D, D}; pg8::StaticOrder so; so.init(S, D, (int)gridDim.x, (int)blockIdx.x);
        EpiOutProj E{p.in[I_X], (bf16_t*)(ws + WS_A), (float*)(ws + WS_SSQ), ws + WS_X1Q, (float*)(ws + WS_XSC)};
        pg8::gemm_phase<EpiOutProj, pg8::StaticOrder, true, true>(ring, g, so, E);
    }
    xcd_barrier(bar);
    {
        pg8::Gemm g{(const bf16_t*)(ws + WS_A), (const bf16_t*)(ws + WS_WQT), S, NQ, D}; pg8::StaticOrder so; so.init(S, NQ, (int)gridDim.x, (int)blockIdx.x);
        EpiPeerQ E{(bf16_t*)(ws + WS_B)};
        pg8::gemm_phase<EpiPeerQ, pg8::StaticOrder, true, true>(ring, g, so, E);
    }
    xcd_barrier(bar);
    ph_topk(p, (int*)lds);                    xcd_barrier(bar);
    ph_peer<0>(p, lds);                       xcd_barrier(bar);
    ph_peer_combine(p);                       xcd_barrier(bar);
    ph_peer<1>(p, lds);
}

extern "C" void kernel_launch(void* const* d_in, const int* in_sizes, int n_in, void* d_out, int out_size, void* d_ws, size_t ws_size, hipStream_t stream) {
    static int grid = 0;
    if (grid == 0) {
        if (n_in != 20 || out_size != S * D || ws_size < WS_END) { fprintf(stderr, "kernel_launch: unexpected shapes (n_in %d out %d ws %zu)\n", n_in, out_size, ws_size); grid = -1; return; }
        int dev = 0, cus = 0, per_cu = 0;
        if (hipGetDevice(&dev) != hipSuccess || hipDeviceGetAttribute(&cus, hipDeviceAttributeMultiprocessorCount, dev) != hipSuccess) { grid = -1; return; }
        if (hipFuncSetAttribute((const void*)hymba_fwd, hipFuncAttributeMaxDynamicSharedMemorySize, LDS_BYTES) != hipSuccess) { fprintf(stderr, "kernel_launch: hipFuncSetAttribute failed\n"); grid = -1; return; }
        if (hipOccupancyMaxActiveBlocksPerMultiprocessor(&per_cu, (const void*)hymba_fwd, NTHR, LDS_BYTES) != hipSuccess || per_cu < 1) { fprintf(stderr, "kernel_launch: occupancy query says %d blocks per CU\n", per_cu); grid = -1; return; }
        (void)hipGetLastError();
        grid = cus;
    }
    if (grid < 0) return;
    (void)hipMemsetAsync((char*)d_ws + WS_CTL, 0, XCD_BAR_WORDS * 4, stream);
    Params p{};
    for (int i = 0; i < 20; ++i) p.in[i] = (const float*)d_in[i];
    p.out = (float*)d_out; p.ws = (unsigned char*)d_ws;
    hipLaunchKernelGGL(hymba_fwd, dim3(grid), dim3(NTHR), LDS_BYTES, stream, p);
}
```

```cpp
#include <hip/hip_runtime.h>
#include <cstdint>
#include <cstdio>

typedef unsigned short bf16_t;
typedef short bf16x8 __attribute__((ext_vector_type(8)));
typedef float f32x4 __attribute__((ext_vector_type(4)));
typedef unsigned u32x4 __attribute__((ext_vector_type(4)));
typedef float f32x16 __attribute__((ext_vector_type(16)));

constexpr int S = 16384, D = 1024, NPROJ = 2560, DSB = 512, DRG = 512, NH = 8, HD = 64;
constexpr int PH = 8, PNK = 128, PDK = 256, PHALF = 128, PTOPK = 16, NEXP = 16384, NQ = PH * PDK;
constexpr int CHUNK = 64, NCHUNK = S / CHUNK;
constexpr float EPS = 1e-6f;
constexpr float LOG2E = 1.4426950408889634f;
constexpr float QSCALE = 0.125f * LOG2E;
constexpr int NTHR = 512;
constexpr float CARRY_STOP = -160.0f;

constexpr size_t MiB = 1u << 20;
constexpr size_t WS_CTL = 0;
constexpr size_t WS_WINT = 1 * MiB;
constexpr size_t WS_WOUTT = 6 * MiB;
constexpr size_t WS_WQT = 8 * MiB;
constexpr size_t WS_SUBK = 12 * MiB;
constexpr size_t WS_RSTD1 = 12 * MiB + 512 * 1024;
constexpr size_t WS_RSTD2 = WS_RSTD1 + 64 * 1024;
constexpr size_t WS_RGP = WS_RSTD2 + 64 * 1024;
constexpr size_t WS_RGH = WS_RGP + 512 * 1024;
constexpr size_t WS_RGSA = 14 * MiB, WS_RGSB = 30 * MiB;
constexpr size_t WS_A = 14 * MiB;
constexpr size_t WS_B = 46 * MiB;
constexpr size_t WS_QH = WS_B, WS_KH = WS_B + 16 * MiB, WS_VH = WS_B + 32 * MiB, WS_XRG = WS_B + 48 * MiB;
constexpr size_t WS_GG = 110 * MiB;
constexpr size_t WS_OSB = 126 * MiB;
constexpr size_t WS_MIX = 142 * MiB;
constexpr size_t WS_SELI = WS_MIX, WS_SELG = WS_MIX + 8 * MiB;
constexpr size_t WS_PD = WS_B;
constexpr size_t WS_CBUF = WS_GG;
constexpr size_t WS_CSC = WS_GG + 4 * MiB;
constexpr size_t WS_X1Q = WS_OSB;
constexpr size_t WS_XSC = WS_GG + 8 * MiB;
constexpr size_t WS_UB = 174 * MiB;
constexpr size_t WS_VB = 190 * MiB;
constexpr size_t WS_USC = 206 * MiB;
constexpr size_t WS_SSQ = 238 * MiB;
constexpr size_t WS_RGW = 239 * MiB;
constexpr size_t WS_END = 240 * MiB;

__device__ __forceinline__ unsigned f2bf(float f) { unsigned u = __builtin_bit_cast(unsigned, f); return (u + 0x7fffu + ((u >> 16) & 1u)) >> 16; }
__device__ __forceinline__ float u2f(unsigned u) { return __builtin_bit_cast(float, u); }
__device__ __forceinline__ float bf2f(unsigned h) { return __builtin_bit_cast(float, h << 16); }
__device__ __forceinline__ unsigned pk2(float lo, float hi) { return f2bf(lo) | (f2bf(hi) << 16); }
__device__ __forceinline__ unsigned pack_i8(float a, float b, float c, float d) {
    const int qa = __float2int_rn(a), qb = __float2int_rn(b), qc = __float2int_rn(c), qd = __float2int_rn(d);
    return (unsigned)(qa & 255) | ((unsigned)(qb & 255) << 8) | ((unsigned)(qc & 255) << 16) | ((unsigned)qd << 24);
}
__device__ __forceinline__ unsigned pack_n4(float a, float b, float c, float d) {
    const int qa = min(max(__float2int_rn(a), -7), 7) & 15, qb = min(max(__float2int_rn(b), -7), 7) & 15, qc = min(max(__float2int_rn(c), -7), 7) & 15, qd = min(max(__float2int_rn(d), -7), 7) & 15;
    return (unsigned)qa | ((unsigned)qb << 4) | ((unsigned)qc << 8) | ((unsigned)qd << 12);
}
template <int OFFS>
__device__ __forceinline__ unsigned pack_u4(float a, float b, float c, float d) {
    const int qa = (min(max(__float2int_rn(a), -7), 7) + OFFS) & 15, qb = (min(max(__float2int_rn(b), -7), 7) + OFFS) & 15, qc = (min(max(__float2int_rn(c), -7), 7) + OFFS) & 15, qd = (min(max(__float2int_rn(d), -7), 7) + OFFS) & 15;
    return (unsigned)qa | ((unsigned)qb << 8) | ((unsigned)qc << 16) | ((unsigned)qd << 24);
}
__device__ __forceinline__ float wave_sum(float v) {
#pragma unroll
    for (int o = 1; o < 64; o <<= 1) v += __shfl_xor(v, o);
    return v;
}
__device__ __forceinline__ float gelu_tanh(float x) {
    const float u = 0.7978845608028654f * (x + 0.044715f * x * x * x);
    const float e = __expf(2.0f * u);
    const float th = 1.0f - 2.0f / (e + 1.0f);
    return 0.5f * x * (1.0f + th);
}

__host__ __device__ __forceinline__ int inproj_phys_row(int nlog) { const int t = nlog >> 8, L = nlog & 255; return (t << 8) + 128 * ((L & 63) >> 5) + 32 * (L >> 6) + (L & 31); }

__device__ __forceinline__ int phase_tid() { int t = threadIdx.x; asm volatile("" : "+v"(t)); return t; }

struct Params {
    const float* in[20];
    float* out;
    unsigned char* ws;
};
enum { I_X = 0, I_NORM_MIX, I_W_IN, I_Q_NORM, I_K_NORM, I_CONV_W, I_CONV_B, I_RG_W_A, I_RG_B_A, I_RG_W_X, I_RG_B_X, I_RG_LAMBDA,
       I_OUT_NORM_SB, I_OUT_NORM_RG, I_W_OUT, I_NORM_FFN, I_PEER_WQ, I_PEER_SUBK, I_PEER_U, I_PEER_V };

template <bool INPROJ_PERM>
__device__ __forceinline__ void prep_transpose_item(const float* W, const float* gain0, const float* gain1, int K, int N, bf16_t* WT, float* scr, int item, int lane) {
    const int nblk = N / 32, kb = item / nblk, nb = item % nblk, k0 = 64 * kb, n0 = 32 * nb;
#pragma unroll 8
    for (int i = 0; i < 32; ++i) {
        const int kk = 2 * i + (lane >> 5), k = k0 + kk;
        const float g = (gain1 && k >= 512) ? gain1[k - 512] : gain0[k];
        scr[kk * 33 + (lane & 31)] = g * W[(size_t)k * N + n0 + (lane & 31)];
    }
    asm volatile("s_waitcnt lgkmcnt(0)" ::: "memory");
    const int c = lane & 7;
#pragma unroll
    for (int j = 0; j < 4; ++j) {
        const int n = (lane >> 3) + 8 * j; const float* s = scr + (8 * c) * 33 + n;
        u32x4 o; o.x = pk2(s[0 * 33], s[1 * 33]); o.y = pk2(s[2 * 33], s[3 * 33]); o.z = pk2(s[4 * 33], s[5 * 33]); o.w = pk2(s[6 * 33], s[7 * 33]);
        const int nr = INPROJ_PERM ? inproj_phys_row(n0 + n) : n0 + n;
        *(u32x4*)(WT + (size_t)nr * K + k0 + 8 * c) = o;
    }
    asm volatile("s_waitcnt lgkmcnt(0)" ::: "memory");
}
__device__ __forceinline__ void ph_tables(const Params& p, int cw, int ncw, int lane) {
    unsigned char* ws = p.ws;
    {
        const float* u = p.in[I_PEER_U]; const float* v = p.in[I_PEER_V]; const float* g = p.in[I_NORM_FFN];
        unsigned* ub = (unsigned*)(ws + WS_UB); unsigned* vb = (unsigned*)(ws + WS_VB); float2* uvsc = (float2*)(ws + WS_USC);
        f32x4 gq[4];
#pragma unroll
        for (int j = 0; j < 4; ++j) gq[j] = *((const f32x4*)g + lane + 64 * j);
        for (int e0 = cw; e0 < NEXP; e0 += 2 * ncw) {
            f32x4 a[2][4], b[2][4]; float ma[2], mb[2], sa2[2], sb2[2];
#pragma unroll
            for (int rr = 0; rr < 2; ++rr) {
                const int e = min(e0 + rr * ncw, NEXP - 1);
#pragma unroll
                for (int j = 0; j < 4; ++j) { a[rr][j] = *((const f32x4*)(u + (size_t)e * D) + lane + 64 * j); b[rr][j] = *((const f32x4*)(v + (size_t)e * D) + lane + 64 * j); }
            }
#pragma unroll
            for (int rr = 0; rr < 2; ++rr) {
                ma[rr] = 0.f; mb[rr] = 0.f; sa2[rr] = 0.f; sb2[rr] = 0.f;
#pragma unroll
                for (int j = 0; j < 4; ++j) {
                    a[rr][j] = a[rr][j] * gq[j];
                    const f32x4 aa = a[rr][j], bb = b[rr][j];
                    ma[rr] = fmaxf(ma[rr], fmaxf(fmaxf(fabsf(aa.x), fabsf(aa.y)), fmaxf(fabsf(aa.z), fabsf(aa.w))));
                    mb[rr] = fmaxf(mb[rr], fmaxf(fmaxf(fabsf(bb.x), fabsf(bb.y)), fmaxf(fabsf(bb.z), fabsf(bb.w))));
                    sa2[rr] += (aa.x * aa.x + aa.y * aa.y) + (aa.z * aa.z + aa.w * aa.w);
                    sb2[rr] += (bb.x * bb.x + bb.y * bb.y) + (bb.z * bb.z + bb.w * bb.w);
                }
            }
#pragma unroll
            for (int o = 1; o < 64; o <<= 1)
#pragma unroll
                for (int rr = 0; rr < 2; ++rr) { ma[rr] = fmaxf(ma[rr], __shfl_xor(ma[rr], o)); mb[rr] = fmaxf(mb[rr], __shfl_xor(mb[rr], o)); sa2[rr] += __shfl_xor(sa2[rr], o); sb2[rr] += __shfl_xor(sb2[rr], o); }
#pragma unroll
            for (int rr = 0; rr < 2; ++rr) {
                const int e = e0 + rr * ncw;
                if (e < NEXP) {
                    const float ca = fminf(ma[rr], 2.5f * sqrtf(sa2[rr] * (1.0f / D))), cb = fminf(mb[rr], 2.5f * sqrtf(sb2[rr] * (1.0f / D)));
                    const float ia = ca > 0.f ? 7.0f / ca : 0.f, ib = cb > 0.f ? 7.0f / cb : 0.f;
#pragma unroll
                    for (int j = 0; j < 4; ++j) {
                        const f32x4 aa = a[rr][j], bb = b[rr][j];
                        const unsigned na = pack_u4<0>(aa.x * ia, aa.y * ia, aa.z * ia, aa.w * ia), nb = pack_n4(bb.x * ib, bb.y * ib, bb.z * ib, bb.w * ib);
                        const unsigned pa = __shfl_xor(na, 1), pb = __shfl_xor(nb, 1);
                        if ((lane & 1) == 0) {
                            ub[((size_t)j * NEXP + e) * 32 + (lane >> 1)] = na | (pa << 4);
                            vb[((size_t)j * NEXP + e) * 32 + (lane >> 1)] = nb | (pb << 16);
                        }
                    }
                    if (lane == 0) uvsc[e] = make_float2(ca * (1.0f / 7.0f), cb * (1.0f / 7.0f));
                }
            }
        }
    }
}

__device__ __forceinline__ void ph_prep(const Params& p, unsigned char* lds) {
    const int tid_ = phase_tid();
    const int gtid = blockIdx.x * blockDim.x + tid_, gsize = gridDim.x * blockDim.x;
    const int lane = tid_ & 63, gwave = gtid >> 6, nwave = gsize >> 6;
    unsigned char* ws = p.ws;
    {
        float* scr = (float*)lds + (tid_ >> 6) * (64 * 33);
        constexpr int I_IN = (D / 64) * (NPROJ / 32), I_OUT = (D / 64) * (D / 32), I_Q = (D / 64) * (NQ / 32);
        for (int it = gwave; it < I_IN + I_OUT + I_Q; it += nwave) {
            if (it < I_IN) prep_transpose_item<true>(p.in[I_W_IN], p.in[I_NORM_MIX], nullptr, D, NPROJ, (bf16_t*)(ws + WS_WINT), scr, it, lane);
            else if (it < I_IN + I_OUT) prep_transpose_item<false>(p.in[I_W_OUT], p.in[I_OUT_NORM_SB], p.in[I_OUT_NORM_RG], D, D, (bf16_t*)(ws + WS_WOUTT), scr, it - I_IN, lane);
            else prep_transpose_item<false>(p.in[I_PEER_WQ], p.in[I_NORM_FFN], nullptr, D, NQ, (bf16_t*)(ws + WS_WQT), scr, it - I_IN - I_OUT, lane);
        }
    }
    {
        const float* wa = p.in[I_RG_W_A]; const float* wx = p.in[I_RG_W_X]; bf16_t* o = (bf16_t*)(ws + WS_RGW);
        for (int e = gtid; e < 8 * 2 * 2 * 4 * 64 * 8; e += gsize) {
            const int el = e & 7, ln = (e >> 3) & 63, s = (e >> 9) & 3, jt = (e >> 11) & 1, g = (e >> 12) & 1, n = e >> 13;
            const int j = 32 * jt + (ln & 31), i = 16 * s + 8 * (el >> 2) + 4 * (ln >> 5) + (el & 3);
            o[e] = (bf16_t)f2bf((g == 0 ? wa : wx)[((size_t)n * 64 + i) * 64 + j]);
        }
    }
    {
        const float* sk = p.in[I_PEER_SUBK]; bf16_t* o = (bf16_t*)(ws + WS_SUBK);
        for (int e = gtid; e < PH * 2 * PNK * PHALF; e += gsize) o[e] = (bf16_t)f2bf(sk[e]);
    }
    {
        const float* x = p.in[I_X]; bf16_t* xb = (bf16_t*)(ws + WS_A); float* rstd1 = (float*)(ws + WS_RSTD1);
        for (int row0 = gwave; row0 < S; row0 += 4 * nwave) {
            f32x4 v[4][4];
#pragma unroll
            for (int rr = 0; rr < 4; ++rr) {
                const int row = min(row0 + rr * nwave, S - 1);
#pragma unroll
                for (int j = 0; j < 4; ++j) v[rr][j] = ((const f32x4*)(x + (size_t)row * D) + lane)[64 * j];
            }
#pragma unroll
            for (int rr = 0; rr < 4; ++rr) {
                const int row = row0 + rr * nwave;
                float ss = 0.f;
#pragma unroll
                for (int j = 0; j < 4; ++j) ss += (v[rr][j].x * v[rr][j].x + v[rr][j].y * v[rr][j].y) + (v[rr][j].z * v[rr][j].z + v[rr][j].w * v[rr][j].w);
                ss = wave_sum(ss);
                if (row < S) {
                    uint2* o = (uint2*)(xb + (size_t)row * D) + lane;
#pragma unroll
                    for (int j = 0; j < 4; ++j) o[64 * j] = make_uint2(pk2(v[rr][j].x, v[rr][j].y), pk2(v[rr][j].z, v[rr][j].w));
                    if (lane == 0) rstd1[row] = rsqrtf(ss * (1.0f / D) + EPS);
                }
            }
        }
    }
}

namespace pg8 {
#define PG8_LAS __attribute__((address_space(3)))
typedef unsigned short bf16_t;
typedef short bf16x8 __attribute__((ext_vector_type(8)));
typedef float f32x4 __attribute__((ext_vector_type(4)));
typedef unsigned u32x4 __attribute__((ext_vector_type(4)));
constexpr int BM = 256, BK = 64, HALF = 128, HTB = HALF * BK * 2  , STAGE_BYTES = 8 * HTB, NXCD = 8, WGM = 8;

__host__ __device__ __forceinline__ int lds_byte(int r, int c) { const int st = (r >> 4) * 2 + (c >> 5), rr = r & 15, cc = c & 31, ob = rr * 64 + cc * 2; return st * 1024 + (ob ^ (((ob >> 9) & 1) << 5)); }
__host__ __device__ __forceinline__ void stage_rc(int b, int& R, int& C) { const int st = b / 1024, sb = b % 1024, swz = sb ^ (((sb >> 9) & 1) << 5); R = (st >> 1) * 16 + swz / 64; C = (st & 1) * 32 + (swz % 64) / 2; }
__host__ __device__ __forceinline__ int perm32(int rho) { const int n = rho >> 4, i = rho & 15; return 8 * (i >> 2) + 4 * n + (i & 3); }

struct Unit { int pm, pn; };
struct Gemm { const bf16_t* A; const bf16_t* Bt; int M, N, K; };

struct StaticOrder {
    int nM, nN, nwg, G, c;
    __host__ __device__ void init(int M, int N, int G_, int c_) { nM = M / BM; nN = N / BM; nwg = nM * nN; G = G_; c = c_; }
    __host__ __device__ bool next(int i, Unit& u) const {
        const long L = (long)i * G + c; if (L >= nwg) return false;
        int wgid = (int)L; { const int q = nwg / NXCD, r = nwg % NXCD, xcd = wgid % NXCD, off = wgid / NXCD; wgid = (xcd < r ? xcd * (q + 1) : r * (q + 1) + (xcd - r) * q) + off; }
        const int nig = WGM * nN, gid = wgid / nig, fm = gid * WGM, gsz = (nM - fm) < WGM ? (nM - fm) : WGM;
        u.pm = fm + ((wgid % nig) % gsz); u.pn = (wgid % nig) / gsz; return true;
    }
    __device__ __forceinline__ void a_ready(const Unit&) const {}
    __device__ __forceinline__ void done(const Unit&) const {}
};

__device__ __forceinline__ unsigned cvt_pk_bf16(float lo, float hi) { unsigned r; asm volatile("v_cvt_pk_bf16_f32 %0, %1, %2" : "=v"(r) : "v"(lo), "v"(hi)); return r; }
template <class Epi, class Sched, bool ALIGN_EPI = false, bool SP2 = false>
__device__ __forceinline__ void gemm_phase(PG8_LAS unsigned char* lds, const Gemm g, const Sched& S, const Epi& E) {
    const int tid = phase_tid(), wid = __builtin_amdgcn_readfirstlane(tid >> 6), lane = tid & 63, wr = wid >> 2, wc = wid & 3, fr = lane & 15, fq = lane >> 4;
    const int K = g.K, nt = K / BK;
    unsigned voffA[2], voffB[2];
#pragma unroll
    for (int i = 0; i < 2; ++i) { int R, C; stage_rc(tid * 16 + i * 8192, R, C); const int Rb = Epi::PERM ? ((R & ~31) + perm32(R & 31)) : R;
        voffA[i] = (unsigned)(R * K + C) * 2u; voffB[i] = (unsigned)(Rb * K + C) * 2u; }
    const size_t kstep = (size_t)(BK * 2);
    const size_t hstep = (size_t)HALF * K * 2;
    const size_t tstep = 2 * hstep;
    const unsigned ldsw = (unsigned)wid * 1024u;
    const int aoff = lds_byte(wr * 64 + fr, fq * 8), boff = lds_byte(wc * 32 + fr, fq * 8);
#define PG8_SA(b, h) (((b) * 2 + (h)) * HTB)
#define PG8_SB(b, h) ((4 + (b) * 2 + (h)) * HTB)
#define PG8_STAGE(bufoff, gbase, voff) do { _Pragma("unroll") for (int _i = 0; _i < 2; ++_i) \
        __builtin_amdgcn_global_load_lds((const unsigned*)((const char*)(gbase) + (voff)[_i]), (PG8_LAS unsigned*)(lds + (bufoff) + ldsw + _i * 8192), 16, 0, 0); } while (0)
#define PG8_LDA(dst, b, h) do { _Pragma("unroll") for (int m = 0; m < 4; ++m) _Pragma("unroll") for (int k = 0; k < 2; ++k) dst[m][k] = *(const PG8_LAS bf16x8*)(lds + PG8_SA(b, h) + aoff + m * 2048 + k * 1024); } while (0)
#define PG8_LDB(dst, b, h) do { _Pragma("unroll") for (int n = 0; n < 2; ++n) _Pragma("unroll") for (int k = 0; k < 2; ++k) dst[n][k] = *(const PG8_LAS bf16x8*)(lds + PG8_SB(b, h) + boff + n * 2048 + k * 1024); } while (0)
#define PG8_MMA(ai, bj, At, Bt) do { __builtin_amdgcn_s_setprio(1); _Pragma("unroll") for (int m = 0; m < 4; ++m) _Pragma("unroll") for (int n = 0; n < 2; ++n) _Pragma("unroll") for (int k = 0; k < 2; ++k) \
        acc[ai][bj][m][n] = __builtin_amdgcn_mfma_f32_16x16x32_bf16(Bt[n][k], At[m][k], acc[ai][bj][m][n], 0, 0, 0); __builtin_amdgcn_s_setprio(0); } while (0)
#define PG8_WAIT_V(n) asm volatile("s_waitcnt vmcnt(" #n ")" ::: "memory")
#define PG8_WAIT_L(n) asm volatile("s_waitcnt lgkmcnt(" #n ")" ::: "memory")
#define PG8_BAR __builtin_amdgcn_s_barrier()
#define PG8_SCHED __builtin_amdgcn_sched_barrier(0)
    Unit cur, nxt; int ui = 0;
    if (!S.next(0, cur)) return;
    f32x4 acc[2][2][4][2];
#pragma unroll
    for (int a = 0; a < 2; ++a)
#pragma unroll
        for (int b = 0; b < 2; ++b)
#pragma unroll
            for (int m = 0; m < 4; ++m)
#pragma unroll
                for (int n = 0; n < 2; ++n) acc[a][b][m][n] = (f32x4){0.f, 0.f, 0.f, 0.f};
    bf16x8 At[4][2], B0[2][2], B1[2][2];
    const char* cA = (const char*)g.A + (size_t)cur.pm * tstep; const char* cB = (const char*)g.Bt + (size_t)cur.pn * tstep;
    S.a_ready(cur);
    if constexpr (SP2) {
        PG8_STAGE(PG8_SB(0, 0), cB, voffB); PG8_STAGE(PG8_SB(0, 1), cB + hstep, voffB); PG8_STAGE(PG8_SA(0, 0), cA, voffA); PG8_STAGE(PG8_SA(0, 1), cA + hstep, voffA);
        if (wr == 1) PG8_BAR;
        PG8_WAIT_V(2); PG8_BAR;
        PG8_STAGE(PG8_SB(1, 0), cB + kstep, voffB); PG8_STAGE(PG8_SA(1, 0), cA + kstep, voffA); PG8_STAGE(PG8_SB(1, 1), cB + hstep + kstep, voffB);
        PG8_WAIT_V(6); PG8_BAR;
    } else {
        PG8_STAGE(PG8_SB(0, 0), cB, voffB); PG8_STAGE(PG8_SA(0, 0), cA, voffA); PG8_STAGE(PG8_SB(0, 1), cB + hstep, voffB); PG8_STAGE(PG8_SA(0, 1), cA + hstep, voffA);
        if (wr == 1) PG8_BAR;
        PG8_WAIT_V(4); PG8_BAR;
        PG8_STAGE(PG8_SB(1, 0), cB + kstep, voffB); PG8_STAGE(PG8_SA(1, 0), cA + kstep, voffA); PG8_STAGE(PG8_SB(1, 1), cB + hstep + kstep, voffB);
        PG8_WAIT_V(6); PG8_BAR;
    }
    for (;;) {
        const bool has_next = S.next(ui + 1, nxt);
        const char* nA = has_next ? (const char*)g.A + (size_t)nxt.pm * tstep : cA; const char* nB = has_next ? (const char*)g.Bt + (size_t)nxt.pn * tstep : cB;
        for (int t = 0; t < nt; t += 2) {
            const bool last = (t == nt - 2);
            const char* a1 = cA + (size_t)(t + 1) * kstep;
            const char* a2 = last ? nA : cA + (size_t)(t + 2) * kstep; const char* b2 = last ? nB : cB + (size_t)(t + 2) * kstep;
            const char* a3 = a2 + kstep; const char* b3 = b2 + kstep;
            if (last && has_next) S.a_ready(nxt);
            if constexpr (SP2) {
            PG8_LDB(B0, 0, 0); PG8_LDB(B1, 0, 1); PG8_SCHED; PG8_LDA(At, 0, 0); PG8_STAGE(PG8_SA(1, 1), a1 + hstep, voffA);
            PG8_WAIT_V(8); PG8_WAIT_L(0); PG8_BAR; PG8_MMA(0, 0, At, B0); PG8_MMA(0, 1, At, B1); PG8_BAR; PG8_SCHED;
            PG8_LDA(At, 0, 1); PG8_STAGE(PG8_SB(0, 0), b2, voffB); PG8_STAGE(PG8_SB(0, 1), b2 + hstep, voffB); PG8_STAGE(PG8_SA(0, 0), a2, voffA);
            PG8_WAIT_V(8); PG8_WAIT_L(0); PG8_BAR; PG8_MMA(1, 0, At, B0); PG8_MMA(1, 1, At, B1); PG8_BAR; PG8_SCHED;
            PG8_LDB(B0, 1, 0); PG8_LDB(B1, 1, 1); PG8_SCHED; PG8_LDA(At, 1, 0); PG8_STAGE(PG8_SA(0, 1), a2 + hstep, voffA);
            PG8_WAIT_V(8); PG8_WAIT_L(0); PG8_BAR; PG8_MMA(0, 0, At, B0); PG8_MMA(0, 1, At, B1); PG8_BAR; PG8_SCHED;
            PG8_LDA(At, 1, 1); PG8_STAGE(PG8_SB(1, 0), b3, voffB); PG8_STAGE(PG8_SB(1, 1), b3 + hstep, voffB); PG8_STAGE(PG8_SA(1, 0), a3, voffA);
            PG8_WAIT_V(8); PG8_WAIT_L(0); PG8_BAR; PG8_MMA(1, 0, At, B0); PG8_MMA(1, 1, At, B1); PG8_BAR; PG8_SCHED;
            } else {
            PG8_LDB(B0, 0, 0); PG8_SCHED; PG8_LDA(At, 0, 0); PG8_STAGE(PG8_SA(1, 1), a1 + hstep, voffA);
            PG8_WAIT_L(8); PG8_BAR; PG8_WAIT_L(0); PG8_MMA(0, 0, At, B0); PG8_BAR; PG8_SCHED;
            PG8_LDB(B1, 0, 1); PG8_STAGE(PG8_SB(0, 0), b2, voffB);
            PG8_BAR; PG8_WAIT_L(0); PG8_MMA(0, 1, At, B1); PG8_BAR;
            PG8_LDA(At, 0, 1); PG8_STAGE(PG8_SA(0, 0), a2, voffA);
            PG8_BAR; PG8_WAIT_L(0); PG8_MMA(1, 0, At, B0); PG8_BAR; PG8_SCHED;
            PG8_STAGE(PG8_SB(0, 1), b2 + hstep, voffB);
            PG8_WAIT_V(6); PG8_BAR; PG8_MMA(1, 1, At, B1); PG8_BAR;
            PG8_LDB(B0, 1, 0); PG8_SCHED; PG8_LDA(At, 1, 0); PG8_STAGE(PG8_SA(0, 1), a2 + hstep, voffA);
            PG8_WAIT_L(8); PG8_BAR; PG8_WAIT_L(0); PG8_MMA(0, 0, At, B0); PG8_BAR; PG8_SCHED;
            PG8_LDB(B1, 1, 1); PG8_STAGE(PG8_SB(1, 0), b3, voffB);
            PG8_BAR; PG8_WAIT_L(0); PG8_MMA(0, 1, At, B1); PG8_BAR;
            PG8_LDA(At, 1, 1); PG8_STAGE(PG8_SA(1, 0), a3, voffA);
            PG8_BAR; PG8_WAIT_L(0); PG8_MMA(1, 0, At, B0); PG8_BAR; PG8_SCHED;
            PG8_STAGE(PG8_SB(1, 1), b3 + hstep, voffB);
            PG8_WAIT_V(6); PG8_BAR; PG8_MMA(1, 1, At, B1); PG8_BAR;
            }
        }
        if constexpr (ALIGN_EPI) { if (wr == 0) PG8_BAR; }
        if constexpr (!Epi::AFTER_DRAIN) { E(acc, cur, wr, wc, fr, fq); S.done(cur); }
        if (!has_next) break;
#pragma unroll
        for (int a = 0; a < 2; ++a)
#pragma unroll
            for (int b = 0; b < 2; ++b)
#pragma unroll
                for (int m = 0; m < 4; ++m)
#pragma unroll
                    for (int n = 0; n < 2; ++n) acc[a][b][m][n] = (f32x4){0.f, 0.f, 0.f, 0.f};
        cur = nxt; cA = nA; cB = nB; ++ui;
        if constexpr (ALIGN_EPI) { if (wr == 1) PG8_BAR; }
    }
    PG8_WAIT_V(0);
    if constexpr (!ALIGN_EPI) { if (wr == 0) PG8_BAR; }
    PG8_BAR;
    if constexpr (Epi::AFTER_DRAIN) { E.fused(acc, cur, wr, wc, fr, fq, lds, wid, lane); S.done(cur); }
#undef PG8_SA
#undef PG8_SB
#undef PG8_STAGE
#undef PG8_LDA
#undef PG8_LDB
#undef PG8_MMA
#undef PG8_WAIT_V
#undef PG8_WAIT_L
#undef PG8_BAR
#undef PG8_SCHED
}
}

struct EpiInProj {
    static constexpr bool PERM = true, AFTER_DRAIN = false;
    const float* rstd1; const float* qn; const float* kn; bf16_t *qh, *kh, *vh, *xrg, *gg;
    __device__ __forceinline__ void operator()(const pg8::f32x4 (&acc)[2][2][4][2], const pg8::Unit& u, int wr, int wc, int fr, int fq) const {
        const int region = u.pn >> 1;
        const int head = (u.pn & 1) * 4 + wc;
        pg8::f32x4 gn[2][2];
        if (region <= 1) {
            const float* g = region == 0 ? qn : kn; const float sc = region == 0 ? QSCALE : 1.0f;
#pragma unroll
            for (int bj = 0; bj < 2; ++bj)
#pragma unroll
                for (int n = 0; n < 2; ++n) gn[bj][n] = *(const pg8::f32x4*)(g + 32 * bj + 8 * fq + 4 * n) * sc;
        }
#pragma unroll
        for (int ai = 0; ai < 2; ++ai)
#pragma unroll
            for (int m = 0; m < 4; ++m) {
                const int row = u.pm * 256 + ai * 128 + wr * 64 + m * 16 + fr;
                const float rs = rstd1[row];
                pg8::f32x4 v[2][2];
#pragma unroll
                for (int bj = 0; bj < 2; ++bj)
#pragma unroll
                    for (int n = 0; n < 2; ++n) v[bj][n] = acc[ai][bj][m][n] * rs;
                bf16_t* dst;
                if (region <= 1) {
                    float ss = 0.f;
#pragma unroll
                    for (int bj = 0; bj < 2; ++bj)
#pragma unroll
                        for (int n = 0; n < 2; ++n) ss += (v[bj][n][0] * v[bj][n][0] + v[bj][n][1] * v[bj][n][1]) + (v[bj][n][2] * v[bj][n][2] + v[bj][n][3] * v[bj][n][3]);
                    ss += __shfl_xor(ss, 16); ss += __shfl_xor(ss, 32);
                    const float rn = rsqrtf(ss * (1.0f / HD) + EPS);
#pragma unroll
                    for (int bj = 0; bj < 2; ++bj)
#pragma unroll
                        for (int n = 0; n < 2; ++n) v[bj][n] = v[bj][n] * rn * gn[bj][n];
                    bf16_t* fb = (region == 0 ? qh : kh) + ((size_t)(head * (S / 32) + (row >> 5)) * 4 * 64 + (row & 31)) * 8;
#pragma unroll
                    for (int bj = 0; bj < 2; ++bj) {
                        pg8::u32x4 w; w.x = pg8::cvt_pk_bf16(v[bj][0][0], v[bj][0][1]); w.y = pg8::cvt_pk_bf16(v[bj][0][2], v[bj][0][3]);
                        w.z = pg8::cvt_pk_bf16(v[bj][1][0], v[bj][1][1]); w.w = pg8::cvt_pk_bf16(v[bj][1][2], v[bj][1][3]);
                        *(pg8::u32x4*)(fb + ((2 * bj + (fq >> 1)) * 64 + 32 * (fq & 1)) * 8) = w;
                    }
                    continue;
                } else if (region == 2) {
#pragma unroll
                    for (int bj = 0; bj < 2; ++bj)
#pragma unroll
                        for (int n = 0; n < 2; ++n)
#pragma unroll
                            for (int i = 0; i < 4; ++i) {
                                const int d = 32 * bj + 8 * fq + 4 * n + i, kl = row & 31;
                                vh[(((((size_t)head * (S / 32) + (row >> 5)) * 2 + (d >> 5)) * 2 + (kl >> 4)) * 64 + (d & 31) + 32 * ((kl >> 2) & 1)) * 8 + 4 * ((kl >> 3) & 1) + (kl & 3)] = (bf16_t)f2bf(v[bj][n][i]);
                            }
                    continue;
                } else if (region == 3) {
                    dst = xrg + (size_t)row * DRG + head * 64;
                } else {
#pragma unroll
                    for (int bj = 0; bj < 2; ++bj)
#pragma unroll
                        for (int n = 0; n < 2; ++n)
#pragma unroll
                            for (int i = 0; i < 4; ++i) v[bj][n][i] = gelu_tanh(v[bj][n][i]);
#pragma unroll
                    for (int bj = 0; bj < 2; ++bj)
#pragma unroll
                        for (int n = 0; n < 2; ++n)
                            *(uint2*)(gg + ((((size_t)(row >> 5) * 8 + head) * 8 + (4 * bj + fq)) * 64 + (row & 31) + 32 * n) * 4) = make_uint2(pg8::cvt_pk_bf16(v[bj][n][0], v[bj][n][1]), pg8::cvt_pk_bf16(v[bj][n][2], v[bj][n][3]));
                    continue;
                }
#pragma unroll
                for (int bj = 0; bj < 2; ++bj) {
                    pg8::u32x4 w; w.x = pg8::cvt_pk_bf16(v[bj][0][0], v[bj][0][1]); w.y = pg8::cvt_pk_bf16(v[bj][0][2], v[bj][0][3]);
                    w.z = pg8::cvt_pk_bf16(v[bj][1][0], v[bj][1][1]); w.w = pg8::cvt_pk_bf16(v[bj][1][2], v[bj][1][3]);
                    *(pg8::u32x4*)(dst + 32 * bj + 8 * fq) = w;
                }
            }
    }
};
struct EpiOutProj {
    static constexpr bool PERM = true, AFTER_DRAIN = false;
    const float* x; bf16_t* x1b; float* ssq; unsigned char* x1q; float* xsc;
    __device__ __forceinline__ void operator()(const pg8::f32x4 (&acc)[2][2][4][2], const pg8::Unit& u, int wr, int wc, int fr, int fq) const {
#pragma unroll
        for (int ai = 0; ai < 2; ++ai)
#pragma unroll
            for (int m = 0; m < 4; ++m) {
                const int row = u.pm * 256 + ai * 128 + wr * 64 + m * 16 + fr;
                float ss = 0.f;
#pragma unroll
                for (int bj = 0; bj < 2; ++bj) {
                    const int col = u.pn * 256 + bj * 128 + wc * 32 + 8 * fq;
                    const size_t o = (size_t)row * D + col;
                    const pg8::f32x4 a = *(const pg8::f32x4*)(x + o) + acc[ai][bj][m][0], b = *(const pg8::f32x4*)(x + o + 4) + acc[ai][bj][m][1];
                    ss += (a[0] * a[0] + a[1] * a[1]) + (a[2] * a[2] + a[3] * a[3]) + (b[0] * b[0] + b[1] * b[1]) + (b[2] * b[2] + b[3] * b[3]);
                    pg8::u32x4 w; w.x = pg8::cvt_pk_bf16(a[0], a[1]); w.y = pg8::cvt_pk_bf16(a[2], a[3]); w.z = pg8::cvt_pk_bf16(b[0], b[1]); w.w = pg8::cvt_pk_bf16(b[2], b[3]);
                    *(pg8::u32x4*)(x1b + o) = w;
                    float mx = fmaxf(fmaxf(fmaxf(fabsf(a[0]), fabsf(a[1])), fmaxf(fabsf(a[2]), fabsf(a[3]))), fmaxf(fmaxf(fabsf(b[0]), fabsf(b[1])), fmaxf(fabsf(b[2]), fabsf(b[3]))));
                    mx = fmaxf(mx, __shfl_xor(mx, 16)); mx = fmaxf(mx, __shfl_xor(mx, 32));
                    const float inv = mx > 0.f ? 119.0f / mx : 0.f;
                    unsigned pl = 0u, ph = 0u;
#pragma unroll
                    for (int i = 0; i < 4; ++i) {
                        const int qa = __float2int_rn(a[i] * inv), qb = __float2int_rn(b[i] * inv);
                        pl |= ((unsigned)(qa & 15) << (8 * i)) | ((unsigned)(qb & 15) << (8 * i + 4));
                        ph |= ((unsigned)(((qa + 8) >> 4) & 15) << (8 * i)) | ((unsigned)(((qb + 8) >> 4) & 15) << (8 * i + 4));
                    }
                    unsigned* cq = (unsigned*)(x1q + (size_t)row * D + (col & ~31));
                    cq[fq] = pl; cq[4 + fq] = ph;
                    if (fq == 0) xsc[(size_t)row * 32 + (col >> 5)] = mx * (1.0f / 119.0f);
                }
                ss += __shfl_xor(ss, 16); ss += __shfl_xor(ss, 32);
                if (fq == 0) ssq[(size_t)row * 16 + u.pn * 4 + wc] = ss;
            }
    }
};
struct EpiPeerQ {
    static constexpr bool PERM = true, AFTER_DRAIN = false;
    bf16_t* qp;
    __device__ __forceinline__ void operator()(const pg8::f32x4 (&acc)[2][2][4][2], const pg8::Unit& u, int wr, int wc, int fr, int fq) const {
#pragma unroll
        for (int ai = 0; ai < 2; ++ai)
#pragma unroll
            for (int m = 0; m < 4; ++m) {
                const int row = u.pm * 256 + ai * 128 + wr * 64 + m * 16 + fr;
#pragma unroll
                for (int bj = 0; bj < 2; ++bj) {
                    const pg8::f32x4 a = acc[ai][bj][m][0], b = acc[ai][bj][m][1];
                    pg8::u32x4 w; w.x = pg8::cvt_pk_bf16(a[0], a[1]); w.y = pg8::cvt_pk_bf16(a[2], a[3]); w.z = pg8::cvt_pk_bf16(b[0], b[1]); w.w = pg8::cvt_pk_bf16(b[2], b[3]);
                    *(pg8::u32x4*)(qp + ((((size_t)((row >> 5) * 8 + u.pn) * 2 + bj) * 8 + 2 * wc + (fq >> 1)) * 64 + (row & 31) + 32 * (fq & 1)) * 8) = w;
                }
            }
    }
};

typedef float f32x2v __attribute__((ext_vector_type(2)));
typedef __bf16 bf16x2v __attribute__((ext_vector_type(2)));
__device__ __forceinline__ unsigned cvtpk(float lo, float hi) { const f32x2v v = {lo, hi}; const bf16x2v b = __builtin_convertvector(v, bf16x2v); return __builtin_bit_cast(unsigned, b); }
__device__ __forceinline__ bf16x8 pack_step(const f32x16& x, int s) {
    u32x4 pkd; pkd.x = cvtpk(x[8 * s], x[8 * s + 1]); pkd.y = cvtpk(x[8 * s + 2], x[8 * s + 3]); pkd.z = cvtpk(x[8 * s + 4], x[8 * s + 5]); pkd.w = cvtpk(x[8 * s + 6], x[8 * s + 7]);
    return __builtin_bit_cast(bf16x8, pkd);
}
#define MFMA32(a, b, c) __builtin_amdgcn_mfma_f32_32x32x16_bf16((a), (b), (c), 0, 0, 0)
__device__ __forceinline__ void ph_attn(const Params& p) {
    unsigned char* ws = p.ws;
    const bf16_t* qh = (const bf16_t*)(ws + WS_QH); const bf16_t* kh = (const bf16_t*)(ws + WS_KH); const bf16_t* vT = (const bf16_t*)(ws + WS_VH);
    bf16_t* osb = (bf16_t*)(ws + WS_OSB);
    const int tid = phase_tid(), lane = tid & 63, r = lane & 31, hh = lane >> 5;
    const int gwave = (blockIdx.x * blockDim.x + tid) >> 6, nwave = (gridDim.x * blockDim.x) >> 6;
    bf16x8 tp[2];
#pragma unroll
    for (int ss = 0; ss < 2; ++ss)
#pragma unroll
        for (int e = 0; e < 8; ++e) { const int k = 16 * ss + 8 * (e >> 2) + 4 * hh + (e & 3); tp[ss][e] = (k > r) ? (short)0x3F80 : (short)0; }
    f32x16 zero16;
#pragma unroll
    for (int i = 0; i < 16; ++i) zero16[i] = 0.f;
    for (int u = gwave; u < NH * (S / 32); u += nwave) {
        const int h = u / (S / 32), t0 = (u % (S / 32)) * 32;
        bf16x8 bq[4];
#pragma unroll
        for (int s = 0; s < 4; ++s) bq[s] = *(const bf16x8*)(qh + (((size_t)(h * (S / 32) + (t0 >> 5)) * 4 + s) * 64 + lane) * 8);
        f32x16 ot[2] = {zero16, zero16};
        float carry = 0.f;
        for (int kt0 = t0; kt0 >= 0; kt0 -= 32) {
            bf16x8 ak[4], av[2][2];
#pragma unroll
            for (int s = 0; s < 4; ++s) ak[s] = *(const bf16x8*)(kh + (((size_t)(h * (S / 32) + (kt0 >> 5)) * 4 + s) * 64 + lane) * 8);
#pragma unroll
            for (int dt = 0; dt < 2; ++dt)
#pragma unroll
                for (int ss = 0; ss < 2; ++ss) av[dt][ss] = *(const bf16x8*)(vT + ((((size_t)(h * (S / 32) + (kt0 >> 5)) * 2 + dt) * 2 + ss) * 64 + lane) * 8);
            f32x16 st = zero16;
#pragma unroll
            for (int s = 0; s < 4; ++s) st = MFMA32(ak[s], bq[s], st);
            const bool diag = (kt0 == t0);
            f32x16 lom, lb;
            float csum = 0.f;
#pragma unroll
            for (int i = 0; i < 16; ++i) {
                const float z = st[i];
                const float sp2 = fmaxf(z, 0.f) + __builtin_amdgcn_logf(1.0f + __builtin_amdgcn_exp2f(-fabsf(z)));
                const bool valid = !diag || ((i & 3) + 8 * (i >> 2) + 4 * hh < r);
                lom[i] = valid ? -sp2 : 0.f;
                lb[i] = z - sp2;
                csum += lom[i];
            }
            f32x16 suf = MFMA32(tp[0], pack_step(lom, 0), zero16);
            suf = MFMA32(tp[1], pack_step(lom, 1), suf);
            f32x16 w;
#pragma unroll
            for (int i = 0; i < 16; ++i) {
                const bool valid = !diag || ((i & 3) + 8 * (i >> 2) + 4 * hh < r);
                w[i] = valid ? __builtin_amdgcn_exp2f(lb[i] + suf[i] + carry) : 0.f;
            }
            const bf16x8 w0 = pack_step(w, 0), w1 = pack_step(w, 1);
#pragma unroll
            for (int dt = 0; dt < 2; ++dt) { ot[dt] = MFMA32(av[dt][0], w0, ot[dt]); ot[dt] = MFMA32(av[dt][1], w1, ot[dt]); }
            carry += csum + __shfl_xor(csum, 32);
            if (__all(carry < CARRY_STOP)) break;
        }
#pragma unroll
        for (int dt = 0; dt < 2; ++dt)
#pragma unroll
            for (int g = 0; g < 4; ++g) {
                uint2 o; o.x = cvtpk(ot[dt][4 * g], ot[dt][4 * g + 1]); o.y = cvtpk(ot[dt][4 * g + 2], ot[dt][4 * g + 3]);
                *(uint2*)(osb + (size_t)(t0 + r) * DSB + h * HD + 32 * dt + 8 * g + 4 * hh) = o;
            }
    }
}

constexpr int RG_LDS_CST = 0, RG_LDS_HIN = 16384, RG_LDS_P = 18432, RG_LDS_SSQ = 20480;
constexpr int RG_LDS_X = 22528, RG_XP = 1032, RG_LDS_O = 91904;
typedef unsigned u32x2 __attribute__((ext_vector_type(2)));
typedef __attribute__((address_space(3))) float lds_f;
typedef __attribute__((address_space(3))) unsigned char lds_b;
template <int CTRL, int ROWMASK>
__device__ __forceinline__ float dpp_mov(float oob, float x) {
    return __builtin_bit_cast(float, __builtin_amdgcn_update_dpp(__builtin_bit_cast(int, oob), __builtin_bit_cast(int, x), CTRL, ROWMASK, 0xf, false));
}
template <int CTRL, int ROWMASK>
__device__ __forceinline__ void scan_step(float (&av)[16], float (&bv)[16]) {
#pragma unroll
    for (int i = 0; i < 16; ++i) {
        const float ap = dpp_mov<CTRL, ROWMASK>(1.0f, av[i]), bp = dpp_mov<CTRL, ROWMASK>(0.0f, bv[i]);
        bv[i] = __builtin_fmaf(av[i], bp, bv[i]); av[i] *= ap;
    }
}
template <int PASS>
__device__ __forceinline__ void ph_rg(const Params& p, unsigned char* lds_raw) {
    float* lds = (float*)lds_raw;
    unsigned char* ws = p.ws;
    const bf16_t* xrg = (const bf16_t*)(ws + WS_XRG); const bf16_t* gg = (const bf16_t*)(ws + WS_GG); const bf16_t* wfrag = (const bf16_t*)(ws + WS_RGW);
    const bf16_t* osb = (const bf16_t*)(ws + WS_OSB); bf16_t* mix = (bf16_t*)(ws + WS_MIX);
    float* rgP = (float*)(ws + WS_RGP); float* rgH = (float*)(ws + WS_RGH);
    bf16_t* scA = (bf16_t*)(ws + WS_RGSA); bf16_t* scB = (bf16_t*)(ws + WS_RGSB);
    const int tid = phase_tid(), lane = tid & 63, r = lane & 31, hh = lane >> 5, n = __builtin_amdgcn_readfirstlane(tid >> 6);
    __syncthreads();
    if (PASS == 0) for (int e = tid; e < 8 * 2 * 8 * 32; e += NTHR) {
        const int q = e & 31, k = (e >> 5) & 7, h2 = (e >> 8) & 1, nn = e >> 9;
        const int c = 64 * nn + 32 * (q >> 4) + (q & 3) + 8 * ((q >> 2) & 3) + 4 * h2;
        float v;
        if (k < 4) v = p.in[I_CONV_W][k * DRG + c];
        else if (k == 4) v = p.in[I_CONV_B][c];
        else if (k == 5) v = p.in[I_RG_B_A][c];
        else if (k == 6) v = p.in[I_RG_B_X][c];
        else v = 8.0f * LOG2E * log1pf(__expf(-p.in[I_RG_LAMBDA][c]));
        lds[e] = v;
    }
    const unsigned lds0 = (unsigned)(size_t)((lds_b*)lds_raw);
    const unsigned cst_base = lds0 + (unsigned)((n * 2 + hh) * 1024);
    lds_f* hin_l = (lds_f*)(size_t)(lds0 + RG_LDS_HIN + (n * 2 + hh) * 128);
    lds_f* pc_l = (lds_f*)(size_t)(lds0 + RG_LDS_P + (n * 2 + hh) * 128);
    lds_b* xt = (lds_b*)(size_t)(lds0 + RG_LDS_X);
    lds_b* ot = (lds_b*)(size_t)(lds0 + RG_LDS_O);
    f32x16 zero16;
#pragma unroll
    for (int i = 0; i < 16; ++i) zero16[i] = 0.f;
    for (int ch = blockIdx.x; ch < NCHUNK; ch += gridDim.x) {
        const int t0 = ch * CHUNK;
        __syncthreads();
        if (PASS == 0) for (int ci = tid; ci < (CHUNK + 3) * 64; ci += NTHR) {
            const int row = ci >> 6, c16 = ci & 63, tt = t0 - 3 + row;
            u32x4 v = {0u, 0u, 0u, 0u};
            if (tt >= 0) v = *(const u32x4*)(xrg + (size_t)tt * DRG + 8 * c16);
            __attribute__((address_space(3))) u32x2* d = (__attribute__((address_space(3))) u32x2*)(xt + row * RG_XP + 16 * c16);
            d[0] = (u32x2){v.x, v.y}; d[1] = (u32x2){v.z, v.w};
        }
        if (PASS == 1) {
            const int c = 64 * n + lane;
            float h = 0.f;
            int k = 0;
            for (; k + 32 <= ch; k += 32) {
                float pv[32], hv[32];
#pragma unroll
                for (int j = 0; j < 32; ++j) { pv[j] = rgP[(k + j) * DRG + c]; hv[j] = rgH[(k + j) * DRG + c]; }
#pragma unroll
                for (int j = 0; j < 32; ++j) h = pv[j] * h + hv[j];
            }
            for (; k + 8 <= ch; k += 8) {
                float pv[8], hv[8];
#pragma unroll
                for (int j = 0; j < 8; ++j) { pv[j] = rgP[(k + j) * DRG + c]; hv[j] = rgH[(k + j) * DRG + c]; }
#pragma unroll
                for (int j = 0; j < 8; ++j) h = pv[j] * h + hv[j];
            }
            for (; k < ch; ++k) h = rgP[k * DRG + c] * h + rgH[k * DRG + c];
            lds[RG_LDS_HIN / 4 + (n * 2 + ((lane >> 2) & 1)) * 32 + 16 * (lane >> 5) + 4 * ((lane >> 3) & 3) + (lane & 3)] = h;
        } else {
            if (r == 0) {
#pragma unroll
                for (int q = 0; q < 32; ++q) { hin_l[q] = 0.f; pc_l[q] = 1.f; }
            }
        }
        __syncthreads();
#pragma unroll 1
        for (int tl = 0; tl < 2; ++tl) {
            const int tok = t0 + 32 * tl + r;
            unsigned cst_a = cst_base; asm volatile("" : "+v"(cst_a));
            const lds_f* cst = (const lds_f*)(size_t)cst_a;
            float xcv[32]; bf16x8 bx[4];
            if (PASS == 0) {
#pragma unroll
            for (int q = 0; q < 32; ++q) xcv[q] = cst[4 * 32 + q];
#pragma unroll
            for (int k = 0; k < 4; ++k) {
                const lds_b* xr = xt + (32 * tl + r + k) * RG_XP + (64 * n + 4 * hh) * 2;
#pragma unroll
                for (int m = 0; m < 8; ++m) {
                    const u32x2 xw = *(const __attribute__((address_space(3))) u32x2*)(xr + 16 * m);
                    xcv[4 * m + 0] += cst[k * 32 + 4 * m + 0] * bf2f(xw.x & 0xffffu); xcv[4 * m + 1] += cst[k * 32 + 4 * m + 1] * bf2f(xw.x >> 16);
                    xcv[4 * m + 2] += cst[k * 32 + 4 * m + 2] * bf2f(xw.y & 0xffffu); xcv[4 * m + 3] += cst[k * 32 + 4 * m + 3] * bf2f(xw.y >> 16);
                }
                __builtin_amdgcn_sched_barrier(0);
            }
#pragma unroll
            for (int s = 0; s < 4; ++s) {
                u32x4 pk; pk.x = cvtpk(xcv[8 * s], xcv[8 * s + 1]); pk.y = cvtpk(xcv[8 * s + 2], xcv[8 * s + 3]); pk.z = cvtpk(xcv[8 * s + 4], xcv[8 * s + 5]); pk.w = cvtpk(xcv[8 * s + 6], xcv[8 * s + 7]);
                bx[s] = __builtin_bit_cast(bf16x8, pk);
            }
            }
            float ss = 0.f;
            const bf16_t* wb = wfrag + ((size_t)n * 16 * 64 + lane) * 8; asm volatile("" : "+v"(wb));
#pragma unroll
            for (int jt = 0; jt < 2; ++jt) {
                float av[16], bv[16];
                const size_t sco = ((((size_t)(2 * ch + tl) * 8 + n) * 2 + jt) * 64 + lane) * 16;
                if (PASS == 0) {
#pragma unroll
                for (int g = 0; g < 2; ++g) {
                    f32x16 acc = zero16;
#pragma unroll
                    for (int s = 0; s < 4; ++s) {
                        const bf16x8 aw = *(const __attribute__((address_space(1))) bf16x8*)(wb + (((g * 2 + jt) * 4 + s) * 64) * 8);
                        acc = MFMA32(aw, bx[s], acc);
                    }
#pragma unroll
                    for (int i = 0; i < 16; ++i) {
                        const int q = 16 * jt + i;
                        const float pre = acc[i] + cst[(5 + g) * 32 + q];
                        const float sg = 1.0f / (1.0f + __builtin_amdgcn_exp2f(-LOG2E * pre));
                        if (g == 0) av[i] = __builtin_amdgcn_exp2f(-sg * cst[7 * 32 + q]);
                        else bv[i] = __builtin_amdgcn_sqrtf(fmaxf(__builtin_fmaf(-av[i], av[i], 1.0f), 0.f)) * (sg * xcv[q]);
                    }
                    __builtin_amdgcn_sched_barrier(0);
                }
                scan_step<0x111, 0xf>(av, bv); scan_step<0x112, 0xf>(av, bv); scan_step<0x114, 0xf>(av, bv); scan_step<0x118, 0xf>(av, bv);
                scan_step<0x142, 0xa>(av, bv);
                u32x4 sa0, sa1, sb0, sb1;
                sa0.x = cvtpk(av[0], av[1]); sa0.y = cvtpk(av[2], av[3]); sa0.z = cvtpk(av[4], av[5]); sa0.w = cvtpk(av[6], av[7]); sa1.x = cvtpk(av[8], av[9]); sa1.y = cvtpk(av[10], av[11]); sa1.z = cvtpk(av[12], av[13]); sa1.w = cvtpk(av[14], av[15]);
                sb0.x = cvtpk(bv[0], bv[1]); sb0.y = cvtpk(bv[2], bv[3]); sb0.z = cvtpk(bv[4], bv[5]); sb0.w = cvtpk(bv[6], bv[7]); sb1.x = cvtpk(bv[8], bv[9]); sb1.y = cvtpk(bv[10], bv[11]); sb1.z = cvtpk(bv[12], bv[13]); sb1.w = cvtpk(bv[14], bv[15]);
                *(u32x4*)(scA + sco) = sa0; *(u32x4*)(scA + sco + 8) = sa1; *(u32x4*)(scB + sco) = sb0; *(u32x4*)(scB + sco + 8) = sb1;
                } else {
                    const u32x4 sa0 = *(const u32x4*)(scA + sco), sa1 = *(const u32x4*)(scA + sco + 8), sb0 = *(const u32x4*)(scB + sco), sb1 = *(const u32x4*)(scB + sco + 8);
                    const unsigned wa[8] = {sa0.x, sa0.y, sa0.z, sa0.w, sa1.x, sa1.y, sa1.z, sa1.w}, wbb[8] = {sb0.x, sb0.y, sb0.z, sb0.w, sb1.x, sb1.y, sb1.z, sb1.w};
#pragma unroll
                    for (int k = 0; k < 8; ++k) { av[2 * k] = bf2f(wa[k] & 0xffffu); av[2 * k + 1] = bf2f(wa[k] >> 16); bv[2 * k] = bf2f(wbb[k] & 0xffffu); bv[2 * k + 1] = bf2f(wbb[k] >> 16); }
                }
                __builtin_amdgcn_sched_barrier(0);
#pragma unroll
                for (int i = 0; i < 16; ++i) {
                    const int q = 16 * jt + i;
                    const float h = __builtin_fmaf(av[i], hin_l[q], bv[i]);
                    if (r == 31) { hin_l[q] = h; if (PASS == 0) pc_l[q] *= av[i]; }
                    bv[i] = h;
                }
                if (PASS == 1) {
#pragma unroll
                    for (int g4 = 0; g4 < 4; ++g4) {
                        const int m = 4 * jt + g4;
                        const uint2 gw = *(const uint2*)(gg + ((((size_t)(tok >> 5) * 8 + n) * 8 + m) * 64 + lane) * 4);
                        const float o0 = bv[4 * g4] * bf2f(gw.x & 0xffffu), o1 = bv[4 * g4 + 1] * bf2f(gw.x >> 16), o2 = bv[4 * g4 + 2] * bf2f(gw.y & 0xffffu), o3 = bv[4 * g4 + 3] * bf2f(gw.y >> 16);
                        ss += (o0 * o0 + o1 * o1) + (o2 * o2 + o3 * o3);
                        *(__attribute__((address_space(3))) u32x2*)(ot + (32 * tl + r) * RG_XP + (64 * n + 8 * m + 4 * hh) * 2) = (u32x2){cvtpk(o0, o1), cvtpk(o2, o3)};
                    }
                }
                __builtin_amdgcn_sched_barrier(0);
            }
            if (PASS == 1) { ss += __shfl_xor(ss, 32); if (hh == 0) lds[RG_LDS_SSQ / 4 + (tl * 8 + n) * 32 + r] = ss; }
        }
        if (PASS == 0) {
            if (r == 0) {
#pragma unroll
                for (int m = 0; m < 8; ++m) {
                    const int c = 64 * n + 8 * m + 4 * hh;
                    *(f32x4*)(rgP + (size_t)ch * DRG + c) = (f32x4){pc_l[4 * m], pc_l[4 * m + 1], pc_l[4 * m + 2], pc_l[4 * m + 3]};
                    *(f32x4*)(rgH + (size_t)ch * DRG + c) = (f32x4){hin_l[4 * m], hin_l[4 * m + 1], hin_l[4 * m + 2], hin_l[4 * m + 3]};
                }
            }
        } else {
            __syncthreads();
            for (int j = 0; j < 8; ++j) {
                const int tr = 8 * n + j, tok = t0 + tr;
                float tot = 0.f;
#pragma unroll
                for (int w = 0; w < 8; ++w) tot += lds[RG_LDS_SSQ / 4 + ((tr >> 5) * 8 + w) * 32 + (tr & 31)];
                const float rn = rsqrtf(tot * (1.0f / DRG) + EPS);
                const __attribute__((address_space(3))) u32x2* op = (const __attribute__((address_space(3))) u32x2*)(ot + tr * RG_XP + 16 * lane);
                const u32x2 w0 = op[0], w1 = op[1];
                u32x4 o2; o2.x = cvtpk(bf2f(w0.x & 0xffffu) * rn, bf2f(w0.x >> 16) * rn); o2.y = cvtpk(bf2f(w0.y & 0xffffu) * rn, bf2f(w0.y >> 16) * rn);
                o2.z = cvtpk(bf2f(w1.x & 0xffffu) * rn, bf2f(w1.x >> 16) * rn); o2.w = cvtpk(bf2f(w1.y & 0xffffu) * rn, bf2f(w1.y >> 16) * rn);
                *((u32x4*)(mix + (size_t)tok * D + DSB) + lane) = o2;
                const u32x4 a = *((const u32x4*)(osb + (size_t)tok * DSB) + lane);
                float f[8] = {bf2f(a.x & 0xffffu), bf2f(a.x >> 16), bf2f(a.y & 0xffffu), bf2f(a.y >> 16), bf2f(a.z & 0xffffu), bf2f(a.z >> 16), bf2f(a.w & 0xffffu), bf2f(a.w >> 16)};
                float sa = 0.f;
#pragma unroll
                for (int k = 0; k < 8; ++k) sa += f[k] * f[k];
                sa = wave_sum(sa);
                const float ra = rsqrtf(sa * (1.0f / DSB) + EPS);
                u32x4 o; o.x = cvtpk(f[0] * ra, f[1] * ra); o.y = cvtpk(f[2] * ra, f[3] * ra); o.z = cvtpk(f[4] * ra, f[5] * ra); o.w = cvtpk(f[6] * ra, f[7] * ra);
                *((u32x4*)(mix + (size_t)tok * D) + lane) = o;
            }
        }
    }
}

__device__ __forceinline__ int f2key(float f) { const int b = __builtin_bit_cast(int, f); return b ^ ((b >> 31) & 0x7fffffff); }
__device__ __forceinline__ float key2f(int k) { return __builtin_bit_cast(float, k ^ ((k >> 31) & 0x7fffffff)); }
#define TOPK_CE(a, b) do { const int hi_ = max(a, b), lo_ = min(a, b); a = hi_; b = lo_; } while (0)
__device__ __forceinline__ void sort16_desc(int (&v)[16]) { TOPK_CE(v[0], v[1]); TOPK_CE(v[2], v[3]); TOPK_CE(v[0], v[2]); TOPK_CE(v[1], v[3]); TOPK_CE(v[1], v[2]); TOPK_CE(v[4], v[5]); TOPK_CE(v[6], v[7]); TOPK_CE(v[4], v[6]); TOPK_CE(v[5], v[7]); TOPK_CE(v[5], v[6]); TOPK_CE(v[0], v[4]); TOPK_CE(v[2], v[6]); TOPK_CE(v[2], v[4]); TOPK_CE(v[1], v[5]); TOPK_CE(v[3], v[7]); TOPK_CE(v[3], v[5]); TOPK_CE(v[1], v[2]); TOPK_CE(v[3], v[4]); TOPK_CE(v[5], v[6]); TOPK_CE(v[8], v[9]); TOPK_CE(v[10], v[11]); TOPK_CE(v[8], v[10]); TOPK_CE(v[9], v[11]); TOPK_CE(v[9], v[10]); TOPK_CE(v[12], v[13]); TOPK_CE(v[14], v[15]); TOPK_CE(v[12], v[14]); TOPK_CE(v[13], v[15]); TOPK_CE(v[13], v[14]); TOPK_CE(v[8], v[12]); TOPK_CE(v[10], v[14]); TOPK_CE(v[10], v[12]); TOPK_CE(v[9], v[13]); TOPK_CE(v[11], v[15]); TOPK_CE(v[11], v[13]); TOPK_CE(v[9], v[10]); TOPK_CE(v[11], v[12]); TOPK_CE(v[13], v[14]); TOPK_CE(v[0], v[8]); TOPK_CE(v[4], v[12]); TOPK_CE(v[4], v[8]); TOPK_CE(v[2], v[10]); TOPK_CE(v[6], v[14]); TOPK_CE(v[6], v[10]); TOPK_CE(v[2], v[4]); TOPK_CE(v[6], v[8]); TOPK_CE(v[10], v[12]); TOPK_CE(v[1], v[9]); TOPK_CE(v[5], v[13]); TOPK_CE(v[5], v[9]); TOPK_CE(v[3], v[11]); TOPK_CE(v[7], v[15]); TOPK_CE(v[7], v[11]); TOPK_CE(v[3], v[5]); TOPK_CE(v[7], v[9]); TOPK_CE(v[11], v[13]); TOPK_CE(v[1], v[2]); TOPK_CE(v[3], v[4]); TOPK_CE(v[5], v[6]); TOPK_CE(v[7], v[8]); TOPK_CE(v[9], v[10]); TOPK_CE(v[11], v[12]); TOPK_CE(v[13], v[14]); }
__device__ __forceinline__ void merge16_desc(int (&a)[16], const int (&b)[16]) {
#pragma unroll
    for (int i = 0; i < 16; ++i) a[i] = max(a[i], b[15 - i]);
#pragma unroll
    for (int d = 8; d >= 1; d >>= 1)
#pragma unroll
        for (int i = 0; i < 16; ++i) if ((i & d) == 0) TOPK_CE(a[i], a[i + d]);
}
__device__ __forceinline__ void ph_topk(const Params& p, int* lds) {
    unsigned char* ws = p.ws;
    const bf16_t* qp = (const bf16_t*)(ws + WS_B); const bf16_t* subk = (const bf16_t*)(ws + WS_SUBK);
    int* seli = (int*)(ws + WS_SELI); float* selg = (float*)(ws + WS_SELG);
    const float* ssq = (const float*)(ws + WS_SSQ); float* rstd2 = (float*)(ws + WS_RSTD2);
    const int tid = phase_tid(), lane = tid & 63, r = lane & 31, hh = lane >> 5, hx = 4 * hh;
    const int gwave = (blockIdx.x * blockDim.x + tid) >> 6, nwave = (gridDim.x * blockDim.x) >> 6;
    constexpr int SK_OFF = 65536, SK_PITCH = 272;
    typedef __attribute__((address_space(3))) unsigned char lds_b;
    lds_b* skl = (lds_b*)lds + SK_OFF;
    const int w = tid >> 6;
    for (int ub = blockIdx.x * (NTHR / 64); ub < (S / 32) * PH; ub += gridDim.x * (NTHR / 64)) {
        const int u = ub + w;
        const int h = ub / (S / 32), t0 = (u % (S / 32)) * 32, t = t0 + r;
        __syncthreads();
#pragma unroll
        for (int j = 0; j < 8; ++j) {
            const int ci = tid + NTHR * j, row = ci >> 4, c16 = ci & 15;
            const u32x4 v = *(const u32x4*)(subk + ((size_t)h * 256 + row) * PHALF + 8 * c16);
            *(__attribute__((address_space(3))) u32x4*)(skl + row * SK_PITCH + 16 * c16) = v;
        }
        __syncthreads();
        int tk[2][16];
#pragma unroll
        for (int pp = 0; pp < 2; ++pp) {
            f32x16 acc[4];
#pragma unroll
            for (int T = 0; T < 4; ++T)
#pragma unroll
                for (int i = 0; i < 16; ++i) acc[T][i] = 0.f;
            const bf16_t* qrow = qp + ((((size_t)((t0 >> 5) * 8 + h) * 2 + pp) * 8) * 64 + lane) * 8;
            const lds_b* krow = skl + (pp * PNK + r) * SK_PITCH + 16 * hh;
#pragma unroll
            for (int s = 0; s < 8; ++s) {
                const bf16x8 b = *(const bf16x8*)(qrow + s * 64 * 8);
#pragma unroll
                for (int T = 0; T < 4; ++T) {
                    const bf16x8 a = *(const __attribute__((address_space(3))) bf16x8*)(krow + (32 * T) * SK_PITCH + 32 * s);
                    acc[T] = __builtin_amdgcn_mfma_f32_32x32x16_bf16(a, b, acc[T], 0, 0, 0);
                }
            }
            int kq[4][16];
#pragma unroll
            for (int T = 0; T < 4; ++T) {
#pragma unroll
                for (int i = 0; i < 16; ++i) {
                    const int nb = 32 * T + (i & 3) + 8 * (i >> 2);
                    kq[T][i] = ((f2key(acc[T][i]) & ~127) | (127 - nb)) ^ hx;
                }
                sort16_desc(kq[T]);
            }
            merge16_desc(kq[0], kq[1]); merge16_desc(kq[2], kq[3]); merge16_desc(kq[0], kq[2]);
            int m[16], po[16];
#pragma unroll
            for (int i = 0; i < 16; ++i) { m[i] = kq[0][i]; po[i] = __shfl_xor(kq[0][i], 32); }
            merge16_desc(m, po);
#pragma unroll
            for (int i = 0; i < 16; ++i) tk[pp][i] = m[i];
        }
#pragma unroll
        for (int i = 0; i < 16; ++i) { lds[i * NTHR + tid] = tk[0][i]; lds[(16 + i) * NTHR + tid] = tk[1][i]; }
        float v0[16], v1[16];
#pragma unroll
        for (int i = 0; i < 16; ++i) { v0[i] = key2f(tk[0][i]); v1[i] = key2f(tk[1][i]); }
#define CKEY(a, b) ((f2key(v0[a] + v1[b]) & ~255) | (255 - ((a) * 16 + (b))))
        const int NEGK = (int)0x80000000;
        int bk[16], l1[16], ga[16], gb[16];
#pragma unroll
        for (int b = 0; b < 16; ++b) bk[b] = CKEY(0, b);
#pragma unroll
        for (int b = 0; b < 16; ++b) l1[b] = b < 8 ? CKEY(1, b) : NEGK;
        ga[0] = CKEY(2, 0); ga[1] = CKEY(2, 1); ga[2] = CKEY(2, 2); ga[3] = CKEY(2, 3); ga[4] = CKEY(2, 4);
        ga[5] = CKEY(3, 0); ga[6] = CKEY(3, 1); ga[7] = CKEY(3, 2); ga[8] = CKEY(3, 3);
        ga[9] = CKEY(4, 0); ga[10] = CKEY(4, 1); ga[11] = CKEY(4, 2); ga[12] = CKEY(5, 0); ga[13] = CKEY(5, 1); ga[14] = NEGK; ga[15] = NEGK;
        gb[0] = CKEY(6, 0); gb[1] = CKEY(6, 1); gb[2] = CKEY(7, 0); gb[3] = CKEY(7, 1);
#pragma unroll
        for (int a = 8; a < 16; ++a) gb[a - 4] = CKEY(a, 0);
        gb[12] = NEGK; gb[13] = NEGK; gb[14] = NEGK; gb[15] = NEGK;
#undef CKEY
        sort16_desc(ga); sort16_desc(gb);
        merge16_desc(bk, l1); merge16_desc(ga, gb); merge16_desc(bk, ga);
        float ssum = 0.f;
#pragma unroll
        for (int i = 0; i < 4; ++i) { const f32x4 q4 = *(const f32x4*)(ssq + (size_t)t * 16 + 4 * i); ssum += (q4.x + q4.y) + (q4.z + q4.w); }
        const float rs = rsqrtf(ssum * (1.0f / D) + EPS);
        float e[16], sum = 0.f; const float mx = key2f(bk[0]);
#pragma unroll
        for (int i = 0; i < 16; ++i) { e[i] = __expf((key2f(bk[i]) - mx) * rs); sum += e[i]; }
        const float inv = 1.0f / sum;
        int eidx[16];
#pragma unroll
        for (int i = 0; i < 16; ++i) {
            const int code = 255 - (bk[i] & 255), a = code >> 4, b = code & 15;
            const int i1 = 127 - (lds[a * NTHR + tid] & 127), i2 = 127 - (lds[(16 + b) * NTHR + tid] & 127);
            eidx[i] = i1 * PNK + i2; e[i] *= inv;
        }
        if (hh == 0) {
            int4* o = (int4*)(seli + (size_t)t * 128 + h * 16);
#pragma unroll
            for (int i = 0; i < 4; ++i) o[i] = make_int4(eidx[4 * i], eidx[4 * i + 1], eidx[4 * i + 2], eidx[4 * i + 3]);
            if (h == 0) rstd2[t] = rs;
        } else {
            f32x4* o = (f32x4*)(selg + (size_t)t * 128 + h * 16);
#pragma unroll
            for (int i = 0; i < 4; ++i) o[i] = (f32x4){e[4 * i], e[4 * i + 1], e[4 * i + 2], e[4 * i + 3]};
        }
    }
}

typedef __bf16 bf16x2_t __attribute__((ext_vector_type(2)));
typedef float f32x2 __attribute__((ext_vector_type(2)));
template <int NV, int XS0, int XS1, int XS2>
__device__ __forceinline__ void reduce_over8(float (&v)[NV], int sel) {
    { const bool up = sel & 1;
#pragma unroll
      for (int i = 0; i < NV / 2; ++i) { const float a = v[2 * i], b = v[2 * i + 1]; v[i] = (up ? b : a) + __shfl_xor(up ? a : b, XS0); } }
    { const bool up = (sel >> 1) & 1;
#pragma unroll
      for (int i = 0; i < NV / 4; ++i) { const float a = v[2 * i], b = v[2 * i + 1]; v[i] = (up ? b : a) + __shfl_xor(up ? a : b, XS1); } }
    { const bool up = (sel >> 2) & 1;
#pragma unroll
      for (int i = 0; i < NV / 8; ++i) { const float a = v[2 * i], b = v[2 * i + 1]; v[i] = (up ? b : a) + __shfl_xor(up ? a : b, XS2); } }
}
__device__ __forceinline__ void peer_load_idx(const unsigned char* ws, int t, int rsl, int (&ei)[16]) {
    const unsigned off = (unsigned)WS_SELI + ((unsigned)t * 128u + 16u * (unsigned)rsl) * 4u;
#pragma unroll
    for (int j = 0; j < 4; ++j) { const int4 v = *(const int4*)(ws + (off + 16u * j)); ei[4 * j] = v.x; ei[4 * j + 1] = v.y; ei[4 * j + 2] = v.z; ei[4 * j + 3] = v.w; }
}
template <int PASS>
__device__ __forceinline__ void peer_load_rows(const unsigned char* ws, int t, int sl, int rsl, int c, const int (&ei)[16], u32x4 (&row)[16], u32x4 (&aux)[4]) {
    const unsigned tab = (unsigned)(PASS == 0 ? WS_UB : WS_VB) + (unsigned)sl * (unsigned)(NEXP * 128) + 16u * (unsigned)c;
#pragma unroll
    for (int i = 0; i < 16; ++i) row[i] = *(const u32x4*)(ws + (tab + (unsigned)ei[i] * 128u));
    const unsigned xo = (unsigned)WS_X1Q + (unsigned)t * (unsigned)D + 256u * sl + 32u * c;
    aux[0] = *(const u32x4*)(ws + xo); aux[1] = *(const u32x4*)(ws + (xo + 16u));
    aux[2].x = *(const unsigned*)(ws + ((unsigned)WS_XSC + ((unsigned)t * 32u + 8u * sl + c) * 4u));
}
constexpr int PEER_IMG_PITCH = 136, PEER_IMG_BYTES = 128 * PEER_IMG_PITCH;
template <int PASS  >
__device__ __forceinline__ void peer_compute(const Params& p, unsigned char* lds, int lane_w, int t, int sl, int rsl, int c, const u32x4 (&row)[16], const u32x4 (&aux)[4]) {
    unsigned char* ws = p.ws;
    if (PASS == 0) {
        const u32x4 x0 = aux[0], x1_ = aux[1]; const unsigned xl[4] = {x0.x, x0.y, x0.z, x0.w}, xh[4] = {x1_.x, x1_.y, x1_.z, x1_.w};
        const unsigned xsu = aux[2].x; const float xs = u2f(xsu);
        float pd[16];
#pragma unroll
        for (int i = 0; i < 16; ++i) {
            const u32x4 rw = row[i]; const unsigned w4[4] = {rw.x, rw.y, rw.z, rw.w};
            int al = 0, ah = 0;
#pragma unroll
            for (int j = 0; j < 4; ++j) { al = __builtin_amdgcn_sdot8((int)w4[j], (int)xl[j], al, false); ah = __builtin_amdgcn_sdot8((int)w4[j], (int)xh[j], ah, false); }
            pd[i] = (float)(16 * ah + al) * xs;
        }
        reduce_over8<16, 1, 2, 4>(pd, c);
        const unsigned po = (unsigned)WS_PD + (((unsigned)sl * S + (unsigned)t) * 128u + 16u * rsl + c) * 4u;
        *(float*)(ws + po) = pd[0]; *(float*)(ws + (po + 32u)) = pd[1];
    }
}
template <int PASS>
__device__ __forceinline__ void peer_stream(const Params& p, unsigned char* lds, int lane_w, int sl, int t0, int dt, int n) {
    const unsigned char* ws = p.ws;
    const int lane = lane_w & 63, rsl = lane >> 3, c = lane & 7;
    int eiA[16], eiB[16]; u32x4 rowA[16], rowB[16], auxA[4], auxB[4];
    if (n <= 0) return;
    peer_load_idx(ws, t0, rsl, eiA);
    peer_load_rows<PASS>(ws, t0, sl, rsl, c, eiA, rowA, auxA);
    if (n > 1) peer_load_idx(ws, t0 + dt, rsl, eiB);
    for (int i = 0; i < n; i += 2) {
        const int t = t0 + i * dt;
        if (i + 1 < n) peer_load_rows<PASS>(ws, t + dt, sl, rsl, c, eiB, rowB, auxB);
        if (i + 2 < n) peer_load_idx(ws, t + 2 * dt, rsl, eiA);
        peer_compute<PASS>(p, lds, lane_w, t, sl, rsl, c, rowA, auxA);
        if (i + 1 < n) {
            if (i + 2 < n) peer_load_rows<PASS>(ws, t + 2 * dt, sl, rsl, c, eiA, rowA, auxA);
            if (i + 3 < n) peer_load_idx(ws, t + 3 * dt, rsl, eiB);
            peer_compute<PASS>(p, lds, lane_w, t + dt, sl, rsl, c, rowB, auxB);
        }
    }
}
__device__ __forceinline__ void peerv_load_idx(const unsigned char* ws, int t, int hf, int rsl, int (&ei)[8]) {
    const unsigned off = (unsigned)WS_SELI + ((unsigned)t * 128u + 16u * (unsigned)rsl + 8u * (unsigned)hf) * 4u;
    const int4 v0 = *(const int4*)(ws + off), v1 = *(const int4*)(ws + (off + 16u));
    ei[0] = v0.x; ei[1] = v0.y; ei[2] = v0.z; ei[3] = v0.w; ei[4] = v1.x; ei[5] = v1.y; ei[6] = v1.z; ei[7] = v1.w;
}
__device__ __forceinline__ void peerv_load_rows(const unsigned char* ws, int sl, int c, const int (&ei)[8], u32x4 (&row)[8]) {
    const unsigned tab = (unsigned)WS_VB + (unsigned)sl * (unsigned)(NEXP * 128) + 16u * (unsigned)c;
#pragma unroll
    for (int i = 0; i < 8; ++i) row[i] = *(const u32x4*)(ws + (tab + (unsigned)ei[i] * 128u));
}
struct PeerVAux { u32x4 cp; unsigned cs; unsigned xo[4]; };
__device__ __forceinline__ void peerv_load_aux(const unsigned char* ws, int t, int sl, int lane, PeerVAux& a) {
    a.cp = *(const u32x4*)(ws + ((unsigned)WS_CBUF + (unsigned)t * 128u + 16u * (unsigned)(lane & 7)));
    a.cs = *(const unsigned*)(ws + ((unsigned)WS_CSC + (unsigned)t * 4u));
    const unsigned xo = (unsigned)WS_A + ((unsigned)t * (unsigned)D + 256u * sl + (unsigned)lane) * 2u;
    a.xo[0] = *(const bf16_t*)(ws + xo); a.xo[1] = *(const bf16_t*)(ws + (xo + 128u)); a.xo[2] = *(const bf16_t*)(ws + (xo + 256u)); a.xo[3] = *(const bf16_t*)(ws + (xo + 384u));
}
template <int HF>
__device__ __forceinline__ void peerv_half(lds_b* img, int lane, const u32x4 (&row)[8], const PeerVAux& a, int (&acc)[4]) {
    const int rsl = lane >> 3, c = lane & 7;
#pragma unroll
    for (int i = 0; i < 8; ++i) {
        const u32x4 rw = row[i];
        __attribute__((address_space(3))) u32x2* d = (__attribute__((address_space(3))) u32x2*)(img + (16 * rsl + i) * PEER_IMG_PITCH + 16 * c);
        d[0] = (u32x2){rw.x, rw.y}; d[1] = (u32x2){rw.z, rw.w};
    }
    const unsigned cpl = HF == 0 ? a.cp.x : a.cp.y, cph = HF == 0 ? a.cp.z : a.cp.w;
    asm volatile("s_waitcnt lgkmcnt(0)" ::: "memory");
    const unsigned ra = (unsigned)(size_t)img + (unsigned)((lane & 15) * PEER_IMG_PITCH + 8 * (lane >> 4));
#define PEER_TR4(R0, R1, R2, R3, RS) asm volatile("ds_read_b64_tr_b4 %0, %4 offset:%5\n\tds_read_b64_tr_b4 %1, %4 offset:%6\n\tds_read_b64_tr_b4 %2, %4 offset:%7\n\tds_read_b64_tr_b4 %3, %4 offset:%8" \
            : "=&v"(R0), "=&v"(R1), "=&v"(R2), "=&v"(R3) : "v"(ra), "i"((RS) * 16 * PEER_IMG_PITCH), "i"((RS) * 16 * PEER_IMG_PITCH + 32), "i"((RS) * 16 * PEER_IMG_PITCH + 64), "i"((RS) * 16 * PEER_IMG_PITCH + 96) : "memory")
#define PEER_USE4(R0, R1, R2, R3, RS, WAITSTR) do { \
            asm volatile(WAITSTR : "+v"(R0), "+v"(R1), "+v"(R2), "+v"(R3) :: "memory"); \
            const int cl_ = __builtin_amdgcn_readlane((int)cpl, RS), ch_ = __builtin_amdgcn_readlane((int)cph, RS); \
            const unsigned lo4_[4] = {R0.x, R1.x, R2.x, R3.x}; \
            _Pragma("unroll") for (int tcg = 0; tcg < 4; ++tcg) acc[tcg] += 16 * __builtin_amdgcn_sdot8((int)lo4_[tcg], ch_, 0, false) + __builtin_amdgcn_sdot8((int)lo4_[tcg], cl_, 0, false); } while (0)
    {
        u32x2 a0, a1, a2, a3, b0, b1, b2, b3;
        PEER_TR4(a0, a1, a2, a3, 0);
        PEER_TR4(b0, b1, b2, b3, 1); PEER_USE4(a0, a1, a2, a3, 0, "s_waitcnt lgkmcnt(4)");
        PEER_TR4(a0, a1, a2, a3, 2); PEER_USE4(b0, b1, b2, b3, 1, "s_waitcnt lgkmcnt(4)");
        PEER_TR4(b0, b1, b2, b3, 3); PEER_USE4(a0, a1, a2, a3, 2, "s_waitcnt lgkmcnt(4)");
        PEER_TR4(a0, a1, a2, a3, 4); PEER_USE4(b0, b1, b2, b3, 3, "s_waitcnt lgkmcnt(4)");
        PEER_TR4(b0, b1, b2, b3, 5); PEER_USE4(a0, a1, a2, a3, 4, "s_waitcnt lgkmcnt(4)");
        PEER_TR4(a0, a1, a2, a3, 6); PEER_USE4(b0, b1, b2, b3, 5, "s_waitcnt lgkmcnt(4)");
        PEER_TR4(b0, b1, b2, b3, 7); PEER_USE4(a0, a1, a2, a3, 6, "s_waitcnt lgkmcnt(4)");
        PEER_USE4(b0, b1, b2, b3, 7, "s_waitcnt lgkmcnt(0)");
    }
#undef PEER_TR4
#undef PEER_USE4
}
__device__ __forceinline__ void peerv_stream(const Params& p, unsigned char* lds, int tid_, int sl, int t0, int dt, int n) {
    const unsigned char* ws = p.ws;
    const int lane = tid_ & 63, rsl = lane >> 3, c = lane & 7;
    lds_b* img = (lds_b*)lds + (tid_ >> 6) * PEER_IMG_BYTES;
    for (int e = lane; e < 64 * (PEER_IMG_PITCH / 8); e += 64) {
        const int zr = e / (PEER_IMG_PITCH / 8), zc = e % (PEER_IMG_PITCH / 8);
        *(__attribute__((address_space(3))) u32x2*)(img + (16 * (zr >> 3) + 8 + (zr & 7)) * PEER_IMG_PITCH + 8 * zc) = (u32x2){0u, 0u};
    }
    if (n <= 0) return;
    int ei0[8], ei1[8]; u32x4 rowA[8], rowB[8]; PeerVAux ax, axn;
    peerv_load_idx(ws, t0, 0, rsl, ei0);
    peerv_load_rows(ws, sl, c, ei0, rowA); peerv_load_aux(ws, t0, sl, lane, ax);
    peerv_load_idx(ws, t0, 1, rsl, ei1);
    for (int i = 0; i < n; ++i) {
        const int t = t0 + i * dt; const bool more = i + 1 < n;
        int acc[4] = {0, 0, 0, 0};
        peerv_load_rows(ws, sl, c, ei1, rowB);
        if (more) peerv_load_idx(ws, t + dt, 0, rsl, ei0);
        peerv_half<0>(img, lane, rowA, ax, acc);
        if (more) { peerv_load_rows(ws, sl, c, ei0, rowA); peerv_load_aux(ws, t + dt, sl, lane, axn); peerv_load_idx(ws, t + dt, 1, rsl, ei1); }
        peerv_half<1>(img, lane, rowB, ax, acc);
        const float cs = u2f(ax.cs);
#pragma unroll
        for (int tcg = 0; tcg < 4; ++tcg) {
            const unsigned oo = ((unsigned)t * (unsigned)D + 256u * sl + 64u * tcg + (unsigned)lane) * 4u;
            *(float*)((unsigned char*)p.out + oo) = bf2f(ax.xo[tcg]) + (float)acc[tcg] * cs;
        }
        if (more) ax = axn;
    }
}
template <int PASS>
__device__ __forceinline__ void ph_peer(const Params& p, unsigned char* lds) {
    const int tid_ = phase_tid();
    const int lane = tid_ & 63, w = tid_ >> 6, b = blockIdx.x, G = gridDim.x;
    if ((G & 7) == 0) {
        const int g = b & 7, nsw = (G >> 3) * 2 * (NTHR / 64), t0 = ((g >> 2) * (G >> 3) + (b >> 3)) * (NTHR / 64) + w;
        if (PASS == 0) peer_stream<0>(p, lds, tid_, g & 3, t0, nsw, t0 < S ? (S - 1 - t0) / nsw + 1 : 0);
        else peerv_stream(p, lds, tid_, g & 3, t0, nsw, t0 < S ? (S - 1 - t0) / nsw + 1 : 0);
    } else {
        const int nw = G * (NTHR / 64), it0 = b * (NTHR / 64) + w;
        for (int it = it0; it < S * 4; it += nw) { if (PASS == 0) peer_stream<0>(p, lds, tid_, it & 3, it >> 2, 0, 1); else peerv_stream(p, lds, tid_, it & 3, it >> 2, 0, 1); }
    }
}
__device__ __forceinline__ void ph_peer_combine(const Params& p) {
    unsigned char* ws = p.ws;
    const int* seli = (const int*)(ws + WS_SELI); const float* selg = (const float*)(ws + WS_SELG); const float* rstd2 = (const float*)(ws + WS_RSTD2);
    const float2* uvsc = (const float2*)(ws + WS_USC);
    const float* pd = (const float*)(ws + WS_PD);
    unsigned* cpl = (unsigned*)(ws + WS_CBUF); float* csc = (float*)(ws + WS_CSC);
    const int tid_ = phase_tid(), lane = tid_ & 63, gwave = (blockIdx.x * blockDim.x + tid_) >> 6, nwave = (gridDim.x * blockDim.x) >> 6;
    for (int t = gwave; t < S; t += nwave) {
        float cf[2];
#pragma unroll
        for (int hf = 0; hf < 2; ++hf) {
            const int e = t * 128 + 64 * hf + lane;
            float d = 0.f;
#pragma unroll
            for (int g = 0; g < 4; ++g) d += pd[(size_t)g * S * 128 + e];
            const float2 sc2 = uvsc[seli[e]];
            cf[hf] = selg[e] * gelu_tanh(d * sc2.x * rstd2[t]) * sc2.y;
        }
        float m = fmaxf(fabsf(cf[0]), fabsf(cf[1]));
#pragma unroll
        for (int o = 1; o < 64; o <<= 1) m = fmaxf(m, __shfl_xor(m, o));
        const float inv = m > 0.f ? 119.0f / m : 0.f;
#pragma unroll
        for (int hf = 0; hf < 2; ++hf) {
            const int q = __float2int_rn(cf[hf] * inv);
            unsigned dl = (unsigned)(q & 15) << (4 * (lane & 7)), dh = (unsigned)(((q + 8) >> 4) & 15) << (4 * (lane & 7));
            dl |= __shfl_xor(dl, 1); dh |= __shfl_xor(dh, 1); dl |= __shfl_xor(dl, 2); dh |= __shfl_xor(dh, 2); dl |= __shfl_xor(dl, 4); dh |= __shfl_xor(dh, 4);
            if ((lane & 7) == 0) {
                const int dk = 8 * hf + (lane >> 3), rs = dk >> 1, half = dk & 1;
                cpl[(size_t)t * 32 + 4 * rs + half] = dl; cpl[(size_t)t * 32 + 4 * rs + 2 + half] = dh;
            }
        }
        if (lane == 0) csc[t] = m * (1.0f / 119.0f);
    }
}

#define LAS __attribute__((address_space(3)))
#define XB_TMO      128
#define XB_XCNT(j)  (256  + 64 * (j))
#define XB_XSUB(j)  (1280 + 64 * (j))
#define XB_XGEN(j)  (2304 + 64 * (j))
#define XB_TOP      3328
#define XB_TOPGEN   3392
#define XCD_BAR_WORDS 3456
#define XB_SPIN_CAP (1u << 18)
__device__ __forceinline__ unsigned xb_ld(unsigned* p)              { return __hip_atomic_load(p, __ATOMIC_RELAXED, __HIP_MEMORY_SCOPE_AGENT); }
__device__ __forceinline__ unsigned xb_add(unsigned* p, unsigned v) { return __hip_atomic_fetch_add(p, v, __ATOMIC_RELAXED, __HIP_MEMORY_SCOPE_AGENT); }
__device__ __forceinline__ unsigned xb_xcc_id() { return (unsigned)__builtin_amdgcn_s_getreg((3 << 11) | 20) & 0xFu; }
#define XB_SPIN(cond, bar) do { unsigned _sp = 0; while (cond) { __builtin_amdgcn_s_sleep(1); \
    if ((++_sp & 255u) == 0u) { if (xb_ld(&(bar)[XB_TMO])) break; if (_sp > XB_SPIN_CAP) { atomicAdd(&(bar)[XB_TMO], 1u); break; } } } } while (0)
struct XcdBarrier { unsigned* bar; unsigned x; volatile LAS unsigned* st; };
__device__ __forceinline__ XcdBarrier xcd_barrier_post(unsigned* bar, volatile LAS unsigned* st) {
    XcdBarrier b; b.bar = bar; b.x = xb_xcc_id(); b.st = st;
    if (threadIdx.x == 0) (void)xb_add(&bar[XB_XCNT(b.x)], 1u);
    return b;
}
__device__ __forceinline__ void xcd_barrier_complete(unsigned* bar, unsigned x, unsigned& nloc, unsigned& nx) {
    const unsigned G = gridDim.x * gridDim.y * gridDim.z;
    unsigned sum, cnt, mine, sp = 0u;
    for (;;) {
        sum = 0u; cnt = 0u; mine = 0u;
#pragma unroll
        for (unsigned j = 0; j < 16; ++j) { const unsigned c = xb_ld(&bar[XB_XCNT(j)]); sum += c; cnt += (c > 0u) ? 1u : 0u; mine = (j == x) ? c : mine; }
        if (sum == G) break;
        __builtin_amdgcn_s_sleep(1);
        if ((++sp & 255u) == 0u) { if (xb_ld(&bar[XB_TMO])) break; if (sp > XB_SPIN_CAP) { atomicAdd(&bar[XB_TMO], 1u); break; } }
    }
    nloc = mine > 0u ? mine : 1u; nx = cnt > 0u ? cnt : 1u;
}
__device__ __forceinline__ void xcd_barrier(const XcdBarrier& b) {
    asm volatile("s_waitcnt vmcnt(0)" ::: "memory");
    __syncthreads();
    if (threadIdx.x == 0) {
        unsigned* bar = b.bar;
        __builtin_amdgcn_s_waitcnt(0);
        unsigned nloc = b.st[0], nx = b.st[1];
        if (nloc == 0u) { xcd_barrier_complete(bar, b.x, nloc, nx); b.st[0] = nloc; b.st[1] = nx; }
        const unsigned old = xb_add(&bar[XB_XSUB(b.x)], 1u);
        const unsigned gen = old / nloc;
        if (old + 1u == (gen + 1u) * nloc) {
            __builtin_amdgcn_fence(__ATOMIC_RELEASE, "agent");
            asm volatile("s_waitcnt vmcnt(0)" ::: "memory");
            const unsigned og = xb_add(&bar[XB_TOP], 1u);
            const unsigned tg = og / nx;
            if (og + 1u == (tg + 1u) * nx) xb_add(&bar[XB_TOPGEN], 1u);
            else XB_SPIN(xb_ld(&bar[XB_TOPGEN]) == tg, bar);
            __builtin_amdgcn_fence(__ATOMIC_ACQUIRE, "agent");
            xb_add(&bar[XB_XGEN(b.x)], 1u);
            asm volatile("s_waitcnt vmcnt(0)" ::: "memory");
        } else {
            XB_SPIN(xb_ld(&bar[XB_XGEN(b.x)]) == gen, bar);
            __builtin_amdgcn_fence(__ATOMIC_ACQUIRE, "agent");
            asm volatile("s_waitcnt vmcnt(0)" ::: "memory");
        }
    }
    __syncthreads();
}

constexpr int LDS_MISC = 158720;
constexpr int LDS_BYTES = LDS_MISC + 1024;

__global__ void __launch_bounds__(NTHR, 2) hymba_fwd(Params p) {
    extern __shared__ __attribute__((aligned(16))) unsigned char lds[];
    volatile LAS unsigned* misc = (volatile LAS unsigned*)((LAS unsigned char*)lds + LDS_MISC);
    if (threadIdx.x < 4) misc[threadIdx.x] = 0u;
    __syncthreads();
    XcdBarrier bar = xcd_barrier_post((unsigned*)(p.ws + WS_CTL), misc);

    PG8_LAS unsigned char* ring = (PG8_LAS unsigned char*)lds;
    unsigned char* ws = p.ws;
    ph_prep(p, lds);                          xcd_barrier(bar);
    {
        pg8::Gemm g{(const bf16_t*)(ws + WS_A), (const bf16_t*)(ws + WS_WINT), S, NPROJ, D}; pg8::StaticOrder so; so.init(S, NPROJ, (int)gridDim.x, (int)blockIdx.x);
        EpiInProj E{(const float*)(ws + WS_RSTD1), p.in[I_Q_NORM], p.in[I_K_NORM], (bf16_t*)(ws + WS_QH), (bf16_t*)(ws + WS_KH), (bf16_t*)(ws + WS_VH), (bf16_t*)(ws + WS_XRG), (bf16_t*)(ws + WS_GG)};
        pg8::gemm_phase<EpiInProj, pg8::StaticOrder, true, true>(ring, g, so, E);
        const int G = (int)gridDim.x, nunits = (S / 256) * (NPROJ / 256), rem = nunits % G, b = (int)blockIdx.x;
        const int tid_ = phase_tid(), w = tid_ >> 6, lane = tid_ & 63;
        if (rem == 0) ph_tables(p, b * (NTHR / 64) + w, G * (NTHR / 64), lane);
        else if (b >= rem) ph_tables(p, (b - rem) * (NTHR / 64) + w, (G - rem) * (NTHR / 64), lane);
    }
    xcd_barrier(bar);
    ph_attn(p); ph_rg<0>(p, lds);             xcd_barrier(bar);
    ph_rg<1>(p, lds);                         xcd_barrier(bar);
    {
        pg8::Gemm g{(const bf16_t*)(ws + WS_MIX), (const bf16_t*)(ws + WS_WOUTT), S, D, D}; pg8::StaticOrder so; so.init(S, D, (int)gridDim.x, (int)blockIdx.x);
        EpiOutProj E{p.in[I_X], (bf16_t*)(ws + WS_A), (float*)(ws + WS_SSQ), ws + WS_X1Q, (float*)(ws + WS_XSC)};
        pg8::gemm_phase<EpiOutProj, pg8::StaticOrder, true, true>(ring, g, so, E);
    }
    xcd_barrier(bar);
    {
        pg8::Gemm g{(const bf16_t*)(ws + WS_A), (const bf16_t*)(ws + WS_WQT), S, NQ, D}; pg8::StaticOrder so; so.init(S, NQ, (int)gridDim.x, (int)blockIdx.x);
        EpiPeerQ E{(bf16_t*)(ws + WS_B)};
        pg8::gemm_phase<EpiPeerQ, pg8::StaticOrder, true, true>(ring, g, so, E);
    }
    xcd_barrier(bar);
    ph_topk(p, (int*)lds);                    xcd_barrier(bar);
    ph_peer<0>(p, lds);                       xcd_barrier(bar);
    ph_peer_combine(p);                       xcd_barrier(bar);
    ph_peer<1>(p, lds);
}

extern "C" void kernel_launch(void* const* d_in, const int* in_sizes, int n_in, void* d_out, int out_size, void* d_ws, size_t ws_size, hipStream_t stream) {
    static int grid = 0;
    if (grid == 0) {
        if (n_in != 20 || out_size != S * D || ws_size < WS_END) { fprintf(stderr, "kernel_launch: unexpected shapes (n_in %d out %d ws %zu)\n", n_in, out_size, ws_size); grid = -1; return; }
        int dev = 0, cus = 0, per_cu = 0;
        if (hipGetDevice(&dev) != hipSuccess || hipDeviceGetAttribute(&cus, hipDeviceAttributeMultiprocessorCount, dev) != hipSuccess) { grid = -1; return; }
        if (hipFuncSetAttribute((const void*)hymba_fwd, hipFuncAttributeMaxDynamicSharedMemorySize, LDS_BYTES) != hipSuccess) { fprintf(stderr, "kernel_launch: hipFuncSetAttribute failed\n"); grid = -1; return; }
        if (hipOccupancyMaxActiveBlocksPerMultiprocessor(&per_cu, (const void*)hymba_fwd, NTHR, LDS_BYTES) != hipSuccess || per_cu < 1) { fprintf(stderr, "kernel_launch: occupancy query says %d blocks per CU\n", per_cu); grid = -1; return; }
        (void)hipGetLastError();
        grid = cus;
    }
    if (grid < 0) return;
    (void)hipMemsetAsync((char*)d_ws + WS_CTL, 0, XCD_BAR_WORDS * 4, stream);
    Params p{};
    for (int i = 0; i < 20; ++i) p.in[i] = (const float*)d_in[i];
    p.out = (float*)d_out; p.ws = (unsigned char*)d_ws;
    hipLaunchKernelGGL(hymba_fwd, dim3(grid), dim3(NTHR), LDS_BYTES, stream, p);
}
```

```cpp
#include <hip/hip_runtime.h>
#include <cstdint>
#include <cstdio>

typedef unsigned short bf16_t;
typedef short bf16x8 __attribute__((ext_vector_type(8)));
typedef float f32x4 __attribute__((ext_vector_type(4)));
typedef unsigned u32x4 __attribute__((ext_vector_type(4)));
typedef float f32x16 __attribute__((ext_vector_type(16)));

constexpr int S = 16384, D = 1024, NPROJ = 2560, DSB = 512, DRG = 512, NH = 8, HD = 64;
constexpr int PH = 8, PNK = 128, PDK = 256, PHALF = 128, PTOPK = 16, NEXP = 16384, NQ = PH * PDK;
constexpr int CHUNK = 64, NCHUNK = S / CHUNK;
constexpr float EPS = 1e-6f;
constexpr float LOG2E = 1.4426950408889634f;
constexpr float QSCALE = 0.125f * LOG2E;
constexpr int NTHR = 512;
constexpr float CARRY_STOP = -160.0f;

constexpr size_t MiB = 1u << 20;
constexpr size_t WS_CTL = 0;
constexpr size_t WS_WINT = 1 * MiB;
constexpr size_t WS_WOUTT = 6 * MiB;
constexpr size_t WS_WQT = 8 * MiB;
constexpr size_t WS_SUBK = 12 * MiB;
constexpr size_t WS_RSTD1 = 12 * MiB + 512 * 1024;
constexpr size_t WS_RSTD2 = WS_RSTD1 + 64 * 1024;
constexpr size_t WS_RGP = WS_RSTD2 + 64 * 1024;
constexpr size_t WS_RGH = WS_RGP + 512 * 1024;
constexpr size_t WS_RGSA = 14 * MiB, WS_RGSB = 30 * MiB;
constexpr size_t WS_A = 14 * MiB;
constexpr size_t WS_B = 46 * MiB;
constexpr size_t WS_QH = WS_B, WS_KH = WS_B + 16 * MiB, WS_VH = WS_B + 32 * MiB, WS_XRG = WS_B + 48 * MiB;
constexpr size_t WS_GG = 110 * MiB;
constexpr size_t WS_OSB = 126 * MiB;
constexpr size_t WS_MIX = 142 * MiB;
constexpr size_t WS_SELI = WS_MIX, WS_SELG = WS_MIX + 8 * MiB;
constexpr size_t WS_PD = WS_B;
constexpr size_t WS_CBUF = WS_GG;
constexpr size_t WS_CSC = WS_GG + 4 * MiB;
constexpr size_t WS_X1Q = WS_OSB;
constexpr size_t WS_XSC = WS_GG + 8 * MiB;
constexpr size_t WS_UB = 174 * MiB;
constexpr size_t WS_VB = 190 * MiB;
constexpr size_t WS_USC = 206 * MiB;
constexpr size_t WS_SSQ = 238 * MiB;
constexpr size_t WS_RGW = 239 * MiB;
constexpr size_t WS_END = 240 * MiB;

__device__ __forceinline__ unsigned f2bf(float f) { unsigned u = __builtin_bit_cast(unsigned, f); return (u + 0x7fffu + ((u >> 16) & 1u)) >> 16; }
__device__ __forceinline__ float u2f(unsigned u) { return __builtin_bit_cast(float, u); }
__device__ __forceinline__ float bf2f(unsigned h) { return __builtin_bit_cast(float, h << 16); }
__device__ __forceinline__ unsigned pk2(float lo, float hi) { return f2bf(lo) | (f2bf(hi) << 16); }
__device__ __forceinline__ unsigned pack_i8(float a, float b, float c, float d) {
    const int qa = __float2int_rn(a), qb = __float2int_rn(b), qc = __float2int_rn(c), qd = __float2int_rn(d);
    return (unsigned)(qa & 255) | ((unsigned)(qb & 255) << 8) | ((unsigned)(qc & 255) << 16) | ((unsigned)qd << 24);
}
__device__ __forceinline__ unsigned pack_n4(float a, float b, float c, float d) {
    const int qa = min(max(__float2int_rn(a), -7), 7) & 15, qb = min(max(__float2int_rn(b), -7), 7) & 15, qc = min(max(__float2int_rn(c), -7), 7) & 15, qd = min(max(__float2int_rn(d), -7), 7) & 15;
    return (unsigned)qa | ((unsigned)qb << 4) | ((unsigned)qc << 8) | ((unsigned)qd << 12);
}
template <int OFFS>
__device__ __forceinline__ unsigned pack_u4(float a, float b, float c, float d) {
    const int qa = (min(max(__float2int_rn(a), -7), 7) + OFFS) & 15, qb = (min(max(__float2int_rn(b), -7), 7) + OFFS) & 15, qc = (min(max(__float2int_rn(c), -7), 7) + OFFS) & 15, qd = (min(max(__float2int_rn(d), -7), 7) + OFFS) & 15;
    return (unsigned)qa | ((unsigned)qb << 8) | ((unsigned)qc << 16) | ((unsigned)qd << 24);
}
__device__ __forceinline__ float wave_sum(float v) {
#pragma unroll
    for (int o = 1; o < 64; o <<= 1) v += __shfl_xor(v, o);
    return v;
}
__device__ __forceinline__ float gelu_tanh(float x) {
    const float u = 0.7978845608028654f * (x + 0.044715f * x * x * x);
    const float e = __expf(2.0f * u);
    const float th = 1.0f - 2.0f / (e + 1.0f);
    return 0.5f * x * (1.0f + th);
}

__host__ __device__ __forceinline__ int inproj_phys_row(int nlog) { const int t = nlog >> 8, L = nlog & 255; return (t << 8) + 128 * ((L & 63) >> 5) + 32 * (L >> 6) + (L & 31); }

__device__ __forceinline__ int phase_tid() { int t = threadIdx.x; asm volatile("" : "+v"(t)); return t; }

struct Params {
    const float* in[20];
    float* out;
    unsigned char* ws;
};
enum { I_X = 0, I_NORM_MIX, I_W_IN, I_Q_NORM, I_K_NORM, I_CONV_W, I_CONV_B, I_RG_W_A, I_RG_B_A, I_RG_W_X, I_RG_B_X, I_RG_LAMBDA,
       I_OUT_NORM_SB, I_OUT_NORM_RG, I_W_OUT, I_NORM_FFN, I_PEER_WQ, I_PEER_SUBK, I_PEER_U, I_PEER_V };

template <bool INPROJ_PERM>
__device__ __forceinline__ void prep_transpose_item(const float* W, const float* gain0, const float* gain1, int K, int N, bf16_t* WT, float* scr, int item, int lane) {
    const int nblk = N / 32, kb = item / nblk, nb = item % nblk, k0 = 64 * kb, n0 = 32 * nb;
#pragma unroll 8
    for (int i = 0; i < 32; ++i) {
        const int kk = 2 * i + (lane >> 5), k = k0 + kk;
        const float g = (gain1 && k >= 512) ? gain1[k - 512] : gain0[k];
        scr[kk * 33 + (lane & 31)] = g * W[(size_t)k * N + n0 + (lane & 31)];
    }
    asm volatile("s_waitcnt lgkmcnt(0)" ::: "memory");
    const int c = lane & 7;
#pragma unroll
    for (int j = 0; j < 4; ++j) {
        const int n = (lane >> 3) + 8 * j; const float* s = scr + (8 * c) * 33 + n;
        u32x4 o; o.x = pk2(s[0 * 33], s[1 * 33]); o.y = pk2(s[2 * 33], s[3 * 33]); o.z = pk2(s[4 * 33], s[5 * 33]); o.w = pk2(s[6 * 33], s[7 * 33]);
        const int nr = INPROJ_PERM ? inproj_phys_row(n0 + n) : n0 + n;
        *(u32x4*)(WT + (size_t)nr * K + k0 + 8 * c) = o;
    }
    asm volatile("s_waitcnt lgkmcnt(0)" ::: "memory");
}
__device__ __forceinline__ void ph_tables(const Params& p, int cw, int ncw, int lane) {
    unsigned char* ws = p.ws;
    {
        const float* u = p.in[I_PEER_U]; const float* v = p.in[I_PEER_V]; const float* g = p.in[I_NORM_FFN];
        unsigned* ub = (unsigned*)(ws + WS_UB); unsigned* vb = (unsigned*)(ws + WS_VB); float2* uvsc = (float2*)(ws + WS_USC);
        f32x4 gq[4];
#pragma unroll
        for (int j = 0; j < 4; ++j) gq[j] = *((const f32x4*)g + lane + 64 * j);
        for (int e0 = cw; e0 < NEXP; e0 += 2 * ncw) {
            f32x4 a[2][4], b[2][4]; float ma[2], mb[2], sa2[2], sb2[2];
#pragma unroll
            for (int rr = 0; rr < 2; ++rr) {
                const int e = min(e0 + rr * ncw, NEXP - 1);
#pragma unroll
                for (int j = 0; j < 4; ++j) { a[rr][j] = *((const f32x4*)(u + (size_t)e * D) + lane + 64 * j); b[rr][j] = *((const f32x4*)(v + (size_t)e * D) + lane + 64 * j); }
            }
#pragma unroll
            for (int rr = 0; rr < 2; ++rr) {
                ma[rr] = 0.f; mb[rr] = 0.f; sa2[rr] = 0.f; sb2[rr] = 0.f;
#pragma unroll
                for (int j = 0; j < 4; ++j) {
                    a[rr][j] = a[rr][j] * gq[j];
                    const f32x4 aa = a[rr][j], bb = b[rr][j];
                    ma[rr] = fmaxf(ma[rr], fmaxf(fmaxf(fabsf(aa.x), fabsf(aa.y)), fmaxf(fabsf(aa.z), fabsf(aa.w))));
                    mb[rr] = fmaxf(mb[rr], fmaxf(fmaxf(fabsf(bb.x), fabsf(bb.y)), fmaxf(fabsf(bb.z), fabsf(bb.w))));
                    sa2[rr] += (aa.x * aa.x + aa.y * aa.y) + (aa.z * aa.z + aa.w * aa.w);
                    sb2[rr] += (bb.x * bb.x + bb.y * bb.y) + (bb.z * bb.z + bb.w * bb.w);
                }
            }
#pragma unroll
            for (int o = 1; o < 64; o <<= 1)
#pragma unroll
                for (int rr = 0; rr < 2; ++rr) { ma[rr] = fmaxf(ma[rr], __shfl_xor(ma[rr], o)); mb[rr] = fmaxf(mb[rr], __shfl_xor(mb[rr], o)); sa2[rr] += __shfl_xor(sa2[rr], o); sb2[rr] += __shfl_xor(sb2[rr], o); }
#pragma unroll
            for (int rr = 0; rr < 2; ++rr) {
                const int e = e0 + rr * ncw;
                if (e < NEXP) {
                    const float ca = fminf(ma[rr], 2.5f * sqrtf(sa2[rr] * (1.0f / D))), cb = fminf(mb[rr], 2.5f * sqrtf(sb2[rr] * (1.0f / D)));
                    const float ia = ca > 0.f ? 7.0f / ca : 0.f, ib = cb > 0.f ? 7.0f / cb : 0.f;
#pragma unroll
                    for (int j = 0; j < 4; ++j) {
                        const f32x4 aa = a[rr][j], bb = b[rr][j];
                        const unsigned na = pack_u4<0>(aa.x * ia, aa.y * ia, aa.z * ia, aa.w * ia), nb = pack_n4(bb.x * ib, bb.y * ib, bb.z * ib, bb.w * ib);
                        const unsigned pa = __shfl_xor(na, 1), pb = __shfl_xor(nb, 1);
                        if ((lane & 1) == 0) {
                            ub[((size_t)j * NEXP + e) * 32 + (lane >> 1)] = na | (pa << 4);
                            vb[((size_t)j * NEXP + e) * 32 + (lane >> 1)] = nb | (pb << 16);
                        }
                    }
                    if (lane == 0) uvsc[e] = make_float2(ca * (1.0f / 7.0f), cb * (1.0f / 7.0f));
                }
            }
        }
    }
}

__device__ __forceinline__ void ph_prep(const Params& p, unsigned char* lds) {
    const int tid_ = phase_tid();
    const int gtid = blockIdx.x * blockDim.x + tid_, gsize = gridDim.x * blockDim.x;
    const int lane = tid_ & 63, gwave = gtid >> 6, nwave = gsize >> 6;
    unsigned char* ws = p.ws;
    {
        float* scr = (float*)lds + (tid_ >> 6) * (64 * 33);
        constexpr int I_IN = (D / 64) * (NPROJ / 32), I_OUT = (D / 64) * (D / 32), I_Q = (D / 64) * (NQ / 32);
        for (int it = gwave; it < I_IN + I_OUT + I_Q; it += nwave) {
            if (it < I_IN) prep_transpose_item<true>(p.in[I_W_IN], p.in[I_NORM_MIX], nullptr, D, NPROJ, (bf16_t*)(ws + WS_WINT), scr, it, lane);
            else if (it < I_IN + I_OUT) prep_transpose_item<false>(p.in[I_W_OUT], p.in[I_OUT_NORM_SB], p.in[I_OUT_NORM_RG], D, D, (bf16_t*)(ws + WS_WOUTT), scr, it - I_IN, lane);
            else prep_transpose_item<false>(p.in[I_PEER_WQ], p.in[I_NORM_FFN], nullptr, D, NQ, (bf16_t*)(ws + WS_WQT), scr, it - I_IN - I_OUT, lane);
        }
    }
    {
        const float* wa = p.in[I_RG_W_A]; const float* wx = p.in[I_RG_W_X]; bf16_t* o = (bf16_t*)(ws + WS_RGW);
        for (int e = gtid; e < 8 * 2 * 2 * 4 * 64 * 8; e += gsize) {
            const int el = e & 7, ln = (e >> 3) & 63, s = (e >> 9) & 3, jt = (e >> 11) & 1, g = (e >> 12) & 1, n = e >> 13;
            const int j = 32 * jt + (ln & 31), i = 16 * s + 8 * (el >> 2) + 4 * (ln >> 5) + (el & 3);
            o[e] = (bf16_t)f2bf((g == 0 ? wa : wx)[((size_t)n * 64 + i) * 64 + j]);
        }
    }
    {
        const float* sk = p.in[I_PEER_SUBK]; bf16_t* o = (bf16_t*)(ws + WS_SUBK);
        for (int e = gtid; e < PH * 2 * PNK * PHALF; e += gsize) o[e] = (bf16_t)f2bf(sk[e]);
    }
    {
        const float* x = p.in[I_X]; bf16_t* xb = (bf16_t*)(ws + WS_A); float* rstd1 = (float*)(ws + WS_RSTD1);
        for (int row0 = gwave; row0 < S; row0 += 4 * nwave) {
            f32x4 v[4][4];
#pragma unroll
            for (int rr = 0; rr < 4; ++rr) {
                const int row = min(row0 + rr * nwave, S - 1);
#pragma unroll
                for (int j = 0; j < 4; ++j) v[rr][j] = ((const f32x4*)(x + (size_t)row * D) + lane)[64 * j];
            }
#pragma unroll
            for (int rr = 0; rr < 4; ++rr) {
                const int row = row0 + rr * nwave;
                float ss = 0.f;
#pragma unroll
                for (int j = 0; j < 4; ++j) ss += (v[rr][j].x * v[rr][j].x + v[rr][j].y * v[rr][j].y) + (v[rr][j].z * v[rr][j].z + v[rr][j].w * v[rr][j].w);
                ss = wave_sum(ss);
                if (row < S) {
                    uint2* o = (uint2*)(xb + (size_t)row * D) + lane;
#pragma unroll
                    for (int j = 0; j < 4; ++j) o[64 * j] = make_uint2(pk2(v[rr][j].x, v[rr][j].y), pk2(v[rr][j].z, v[rr][j].w));
                    if (lane == 0) rstd1[row] = rsqrtf(ss * (1.0f / D) + EPS);
                }
            }
        }
    }
}

namespace pg8 {
#define PG8_LAS __attribute__((address_space(3)))
typedef unsigned short bf16_t;
typedef short bf16x8 __attribute__((ext_vector_type(8)));
typedef float f32x4 __attribute__((ext_vector_type(4)));
typedef unsigned u32x4 __attribute__((ext_vector_type(4)));
constexpr int BM = 256, BK = 64, HALF = 128, HTB = HALF * BK * 2  , STAGE_BYTES = 8 * HTB, NXCD = 8, WGM = 8;

__host__ __device__ __forceinline__ int lds_byte(int r, int c) { const int st = (r >> 4) * 2 + (c >> 5), rr = r & 15, cc = c & 31, ob = rr * 64 + cc * 2; return st * 1024 + (ob ^ (((ob >> 9) & 1) << 5)); }
__host__ __device__ __forceinline__ void stage_rc(int b, int& R, int& C) { const int st = b / 1024, sb = b % 1024, swz = sb ^ (((sb >> 9) & 1) << 5); R = (st >> 1) * 16 + swz / 64; C = (st & 1) * 32 + (swz % 64) / 2; }
__host__ __device__ __forceinline__ int perm32(int rho) { const int n = rho >> 4, i = rho & 15; return 8 * (i >> 2) + 4 * n + (i & 3); }

struct Unit { int pm, pn; };
struct Gemm { const bf16_t* A; const bf16_t* Bt; int M, N, K; };

struct StaticOrder {
    int nM, nN, nwg, G, c;
    __host__ __device__ void init(int M, int N, int G_, int c_) { nM = M / BM; nN = N / BM; nwg = nM * nN; G = G_; c = c_; }
    __host__ __device__ bool next(int i, Unit& u) const {
        const long L = (long)i * G + c; if (L >= nwg) return false;
        int wgid = (int)L; { const int q = nwg / NXCD, r = nwg % NXCD, xcd = wgid % NXCD, off = wgid / NXCD; wgid = (xcd < r ? xcd * (q + 1) : r * (q + 1) + (xcd - r) * q) + off; }
        const int nig = WGM * nN, gid = wgid / nig, fm = gid * WGM, gsz = (nM - fm) < WGM ? (nM - fm) : WGM;
        u.pm = fm + ((wgid % nig) % gsz); u.pn = (wgid % nig) / gsz; return true;
    }
    __device__ __forceinline__ void a_ready(const Unit&) const {}
    __device__ __forceinline__ void done(const Unit&) const {}
};

__device__ __forceinline__ unsigned cvt_pk_bf16(float lo, float hi) { unsigned r; asm volatile("v_cvt_pk_bf16_f32 %0, %1, %2" : "=v"(r) : "v"(lo), "v"(hi)); return r; }
template <class Epi, class Sched, bool ALIGN_EPI = false, bool SP2 = false>
__device__ __forceinline__ void gemm_phase(PG8_LAS unsigned char* lds, const Gemm g, const Sched& S, const Epi& E) {
    const int tid = phase_tid(), wid = __builtin_amdgcn_readfirstlane(tid >> 6), lane = tid & 63, wr = wid >> 2, wc = wid & 3, fr = lane & 15, fq = lane >> 4;
    const int K = g.K, nt = K / BK;
    unsigned voffA[2], voffB[2];
#pragma unroll
    for (int i = 0; i < 2; ++i) { int R, C; stage_rc(tid * 16 + i * 8192, R, C); const int Rb = Epi::PERM ? ((R & ~31) + perm32(R & 31)) : R;
        voffA[i] = (unsigned)(R * K + C) * 2u; voffB[i] = (unsigned)(Rb * K + C) * 2u; }
    const size_t kstep = (size_t)(BK * 2);
    const size_t hstep = (size_t)HALF * K * 2;
    const size_t tstep = 2 * hstep;
    const unsigned ldsw = (unsigned)wid * 1024u;
    const int aoff = lds_byte(wr * 64 + fr, fq * 8), boff = lds_byte(wc * 32 + fr, fq * 8);
#define PG8_SA(b, h) (((b) * 2 + (h)) * HTB)
#define PG8_SB(b, h) ((4 + (b) * 2 + (h)) * HTB)
#define PG8_STAGE(bufoff, gbase, voff) do { _Pragma("unroll") for (int _i = 0; _i < 2; ++_i) \
        __builtin_amdgcn_global_load_lds((const unsigned*)((const char*)(gbase) + (voff)[_i]), (PG8_LAS unsigned*)(lds + (bufoff) + ldsw + _i * 8192), 16, 0, 0); } while (0)
#define PG8_LDA(dst, b, h) do { _Pragma("unroll") for (int m = 0; m < 4; ++m) _Pragma("unroll") for (int k = 0; k < 2; ++k) dst[m][k] = *(const PG8_LAS bf16x8*)(lds + PG8_SA(b, h) + aoff + m * 2048 + k * 1024); } while (0)
#define PG8_LDB(dst, b, h) do { _Pragma("unroll") for (int n = 0; n < 2; ++n) _Pragma("unroll") for (int k = 0; k < 2; ++k) dst[n][k] = *(const PG8_LAS bf16x8*)(lds + PG8_SB(b, h) + boff + n * 2048 + k * 1024); } while (0)
#define PG8_MMA(ai, bj, At, Bt) do { __builtin_amdgcn_s_setprio(1); _Pragma("unroll") for (int m = 0; m < 4; ++m) _Pragma("unroll") for (int n = 0; n < 2; ++n) _Pragma("unroll") for (int k = 0; k < 2; ++k) \
        acc[ai][bj][m][n] = __builtin_amdgcn_mfma_f32_16x16x32_bf16(Bt[n][k], At[m][k], acc[ai][bj][m][n], 0, 0, 0); __builtin_amdgcn_s_setprio(0); } while (0)
#define PG8_WAIT_V(n) asm volatile("s_waitcnt vmcnt(" #n ")" ::: "memory")
#define PG8_WAIT_L(n) asm volatile("s_waitcnt lgkmcnt(" #n ")" ::: "memory")
#define PG8_BAR __builtin_amdgcn_s_barrier()
#define PG8_SCHED __builtin_amdgcn_sched_barrier(0)
    Unit cur, nxt; int ui = 0;
    if (!S.next(0, cur)) return;
    f32x4 acc[2][2][4][2];
#pragma unroll
    for (int a = 0; a < 2; ++a)
#pragma unroll
        for (int b = 0; b < 2; ++b)
#pragma unroll
            for (int m = 0; m < 4; ++m)
#pragma unroll
                for (int n = 0; n < 2; ++n) acc[a][b][m][n] = (f32x4){0.f, 0.f, 0.f, 0.f};
    bf16x8 At[4][2], B0[2][2], B1[2][2];
    const char* cA = (const char*)g.A + (size_t)cur.pm * tstep; const char* cB = (const char*)g.Bt + (size_t)cur.pn * tstep;
    S.a_ready(cur);
    if constexpr (SP2) {
        PG8_STAGE(PG8_SB(0, 0), cB, voffB); PG8_STAGE(PG8_SB(0, 1), cB + hstep, voffB); PG8_STAGE(PG8_SA(0, 0), cA, voffA); PG8_STAGE(PG8_SA(0, 1), cA + hstep, voffA);
        if (wr == 1) PG8_BAR;
        PG8_WAIT_V(2); PG8_BAR;
        PG8_STAGE(PG8_SB(1, 0), cB + kstep, voffB); PG8_STAGE(PG8_SA(1, 0), cA + kstep, voffA); PG8_STAGE(PG8_SB(1, 1), cB + hstep + kstep, voffB);
        PG8_WAIT_V(6); PG8_BAR;
    } else {
        PG8_STAGE(PG8_SB(0, 0), cB, voffB); PG8_STAGE(PG8_SA(0, 0), cA, voffA); PG8_STAGE(PG8_SB(0, 1), cB + hstep, voffB); PG8_STAGE(PG8_SA(0, 1), cA + hstep, voffA);
        if (wr == 1) PG8_BAR;
        PG8_WAIT_V(4); PG8_BAR;
        PG8_STAGE(PG8_SB(1, 0), cB + kstep, voffB); PG8_STAGE(PG8_SA(1, 0), cA + kstep, voffA); PG8_STAGE(PG8_SB(1, 1), cB + hstep + kstep, voffB);
        PG8_WAIT_V(6); PG8_BAR;
    }
    for (;;) {
        const bool has_next = S.next(ui + 1, nxt);
        const char* nA = has_next ? (const char*)g.A + (size_t)nxt.pm * tstep : cA; const char* nB = has_next ? (const char*)g.Bt + (size_t)nxt.pn * tstep : cB;
        for (int t = 0; t < nt; t += 2) {
            const bool last = (t == nt - 2);
            const char* a1 = cA + (size_t)(t + 1) * kstep;
            const char* a2 = last ? nA : cA + (size_t)(t + 2) * kstep; const char* b2 = last ? nB : cB + (size_t)(t + 2) * kstep;
            const char* a3 = a2 + kstep; const char* b3 = b2 + kstep;
            if (last && has_next) S.a_ready(nxt);
            if constexpr (SP2) {
            PG8_LDB(B0, 0, 0); PG8_LDB(B1, 0, 1); PG8_SCHED; PG8_LDA(At, 0, 0); PG8_STAGE(PG8_SA(1, 1), a1 + hstep, voffA);
            PG8_WAIT_V(8); PG8_WAIT_L(0); PG8_BAR; PG8_MMA(0, 0, At, B0); PG8_MMA(0, 1, At, B1); PG8_BAR; PG8_SCHED;
            PG8_LDA(At, 0, 1); PG8_STAGE(PG8_SB(0, 0), b2, voffB); PG8_STAGE(PG8_SB(0, 1), b2 + hstep, voffB); PG8_STAGE(PG8_SA(0, 0), a2, voffA);
            PG8_WAIT_V(8); PG8_WAIT_L(0); PG8_BAR; PG8_MMA(1, 0, At, B0); PG8_MMA(1, 1, At, B1); PG8_BAR; PG8_SCHED;
            PG8_LDB(B0, 1, 0); PG8_LDB(B1, 1, 1); PG8_SCHED; PG8_LDA(At, 1, 0); PG8_STAGE(PG8_SA(0, 1), a2 + hstep, voffA);
            PG8_WAIT_V(8); PG8_WAIT_L(0); PG8_BAR; PG8_MMA(0, 0, At, B0); PG8_MMA(0, 1, At, B1); PG8_BAR; PG8_SCHED;
            PG8_LDA(At, 1, 1); PG8_STAGE(PG8_SB(1, 0), b3, voffB); PG8_STAGE(PG8_SB(1, 1), b3 + hstep, voffB); PG8_STAGE(PG8_SA(1, 0), a3, voffA);
            PG8_WAIT_V(8); PG8_WAIT_L(0); PG8_BAR; PG8_MMA(1, 0, At, B0); PG8_MMA(1, 1, At, B1); PG8_BAR; PG8_SCHED;
            } else {
            PG8_LDB(B0, 0, 0); PG8_SCHED; PG8_LDA(At, 0, 0); PG8_STAGE(PG8_SA(1, 1), a1 + hstep, voffA);
            PG8_WAIT_L(8); PG8_BAR; PG8_WAIT_L(0); PG8_MMA(0, 0, At, B0); PG8_BAR; PG8_SCHED;
            PG8_LDB(B1, 0, 1); PG8_STAGE(PG8_SB(0, 0), b2, voffB);
            PG8_BAR; PG8_WAIT_L(0); PG8_MMA(0, 1, At, B1); PG8_BAR;
            PG8_LDA(At, 0, 1); PG8_STAGE(PG8_SA(0, 0), a2, voffA);
            PG8_BAR; PG8_WAIT_L(0); PG8_MMA(1, 0, At, B0); PG8_BAR; PG8_SCHED;
            PG8_STAGE(PG8_SB(0, 1), b2 + hstep, voffB);
            PG8_WAIT_V(6); PG8_BAR; PG8_MMA(1, 1, At, B1); PG8_BAR;
            PG8_LDB(B0, 1, 0); PG8_SCHED; PG8_LDA(At, 1, 0); PG8_STAGE(PG8_SA(0, 1), a2 + hstep, voffA);
            PG8_WAIT_L(8); PG8_BAR; PG8_WAIT_L(0); PG8_MMA(0, 0, At, B0); PG8_BAR; PG8_SCHED;
            PG8_LDB(B1, 1, 1); PG8_STAGE(PG8_SB(1, 0), b3, voffB);
            PG8_BAR; PG8_WAIT_L(0); PG8_MMA(0, 1, At, B1); PG8_BAR;
            PG8_LDA(At, 1, 1); PG8_STAGE(PG8_SA(1, 0), a3, voffA);
            PG8_BAR; PG8_WAIT_L(0); PG8_MMA(1, 0, At, B0); PG8_BAR; PG8_SCHED;
            PG8_STAGE(PG8_SB(1, 1), b3 + hstep, voffB);
            PG8_WAIT_V(6); PG8_BAR; PG8_MMA(1, 1, At, B1); PG8_BAR;
            }
        }
        if constexpr (ALIGN_EPI) { if (wr == 0) PG8_BAR; }
        if constexpr (!Epi::AFTER_DRAIN) { E(acc, cur, wr, wc, fr, fq); S.done(cur); }
        if (!has_next) break;
#pragma unroll
        for (int a = 0; a < 2; ++a)
#pragma unroll
            for (int b = 0; b < 2; ++b)
#pragma unroll
                for (int m = 0; m < 4; ++m)
#pragma unroll
                    for (int n = 0; n < 2; ++n) acc[a][b][m][n] = (f32x4){0.f, 0.f, 0.f, 0.f};
        cur = nxt; cA = nA; cB = nB; ++ui;
        if constexpr (ALIGN_EPI) { if (wr == 1) PG8_BAR; }
    }
    PG8_WAIT_V(0);
    if constexpr (!ALIGN_EPI) { if (wr == 0) PG8_BAR; }
    PG8_BAR;
    if constexpr (Epi::AFTER_DRAIN) { E.fused(acc, cur, wr, wc, fr, fq, lds, wid, lane); S.done(cur); }
#undef PG8_SA
#undef PG8_SB
#undef PG8_STAGE
#undef PG8_LDA
#undef PG8_LDB
#undef PG8_MMA
#undef PG8_WAIT_V
#undef PG8_WAIT_L
#undef PG8_BAR
#undef PG8_SCHED
}
}

struct EpiInProj {
    static constexpr bool PERM = true, AFTER_DRAIN = false;
    const float* rstd1; const float* qn; const float* kn; bf16_t *qh, *kh, *vh, *xrg, *gg;
    __device__ __forceinline__ void operator()(const pg8::f32x4 (&acc)[2][2][4][2], const pg8::Unit& u, int wr, int wc, int fr, int fq) const {
        const int region = u.pn >> 1;
        const int head = (u.pn & 1) * 4 + wc;
        pg8::f32x4 gn[2][2];
        if (region <= 1) {
            const float* g = region == 0 ? qn : kn; const float sc = region == 0 ? QSCALE : 1.0f;
#pragma unroll
            for (int bj = 0; bj < 2; ++bj)
#pragma unroll
                for (int n = 0; n < 2; ++n) gn[bj][n] = *(const pg8::f32x4*)(g + 32 * bj + 8 * fq + 4 * n) * sc;
        }
#pragma unroll
        for (int ai = 0; ai < 2; ++ai)
#pragma unroll
            for (int m = 0; m < 4; ++m) {
                const int row = u.pm * 256 + ai * 128 + wr * 64 + m * 16 + fr;
                const float rs = rstd1[row];
                pg8::f32x4 v[2][2];
#pragma unroll
                for (int bj = 0; bj < 2; ++bj)
#pragma unroll
                    for (int n = 0; n < 2; ++n) v[bj][n] = acc[ai][bj][m][n] * rs;
                bf16_t* dst;
                if (region <= 1) {
                    float ss = 0.f;
#pragma unroll
                    for (int bj = 0; bj < 2; ++bj)
#pragma unroll
                        for (int n = 0; n < 2; ++n) ss += (v[bj][n][0] * v[bj][n][0] + v[bj][n][1] * v[bj][n][1]) + (v[bj][n][2] * v[bj][n][2] + v[bj][n][3] * v[bj][n][3]);
                    ss += __shfl_xor(ss, 16); ss += __shfl_xor(ss, 32);
                    const float rn = rsqrtf(ss * (1.0f / HD) + EPS);
#pragma unroll
                    for (int bj = 0; bj < 2; ++bj)
#pragma unroll
                        for (int n = 0; n < 2; ++n) v[bj][n] = v[bj][n] * rn * gn[bj][n];
                    bf16_t* fb = (region == 0 ? qh : kh) + ((size_t)(head * (S / 32) + (row >> 5)) * 4 * 64 + (row & 31)) * 8;
#pragma unroll
                    for (int bj = 0; bj < 2; ++bj) {
                        pg8::u32x4 w; w.x = pg8::cvt_pk_bf16(v[bj][0][0], v[bj][0][1]); w.y = pg8::cvt_pk_bf16(v[bj][0][2], v[bj][0][3]);
                        w.z = pg8::cvt_pk_bf16(v[bj][1][0], v[bj][1][1]); w.w = pg8::cvt_pk_bf16(v[bj][1][2], v[bj][1][3]);
                        *(pg8::u32x4*)(fb + ((2 * bj + (fq >> 1)) * 64 + 32 * (fq & 1)) * 8) = w;
                    }
                    continue;
                } else if (region == 2) {
#pragma unroll
                    for (int bj = 0; bj < 2; ++bj)
#pragma unroll
                        for (int n = 0; n < 2; ++n)
#pragma unroll
                            for (int i = 0; i < 4; ++i) {
                                const int d = 32 * bj + 8 * fq + 4 * n + i, kl = row & 31;
                                vh[(((((size_t)head * (S / 32) + (row >> 5)) * 2 + (d >> 5)) * 2 + (kl >> 4)) * 64 + (d & 31) + 32 * ((kl >> 2) & 1)) * 8 + 4 * ((kl >> 3) & 1) + (kl & 3)] = (bf16_t)f2bf(v[bj][n][i]);
                            }
                    continue;
                } else if (region == 3) {
                    dst = xrg + (size_t)row * DRG + head * 64;
                } else {
#pragma unroll
                    for (int bj = 0; bj < 2; ++bj)
#pragma unroll
                        for (int n = 0; n < 2; ++n)
#pragma unroll
                            for (int i = 0; i < 4; ++i) v[bj][n][i] = gelu_tanh(v[bj][n][i]);
#pragma unroll
                    for (int bj = 0; bj < 2; ++bj)
#pragma unroll
                        for (int n = 0; n < 2; ++n)
                            *(uint2*)(gg + ((((size_t)(row >> 5) * 8 + head) * 8 + (4 * bj + fq)) * 64 + (row & 31) + 32 * n) * 4) = make_uint2(pg8::cvt_pk_bf16(v[bj][n][0], v[bj][n][1]), pg8::cvt_pk_bf16(v[bj][n][2], v[bj][n][3]));
                    continue;
                }
#pragma unroll
                for (int bj = 0; bj < 2; ++bj) {
                    pg8::u32x4 w; w.x = pg8::cvt_pk_bf16(v[bj][0][0], v[bj][0][1]); w.y = pg8::cvt_pk_bf16(v[bj][0][2], v[bj][0][3]);
                    w.z = pg8::cvt_pk_bf16(v[bj][1][0], v[bj][1][1]); w.w = pg8::cvt_pk_bf16(v[bj][1][2], v[bj][1][3]);
                    *(pg8::u32x4*)(dst + 32 * bj + 8 * fq) = w;
                }
            }
    }
};
struct EpiOutProj {
    static constexpr bool PERM = true, AFTER_DRAIN = false;
    const float* x; bf16_t* x1b; float* ssq; unsigned char* x1q; float* xsc;
    __device__ __forceinline__ void operator()(const pg8::f32x4 (&acc)[2][2][4][2], const pg8::Unit& u, int wr, int wc, int fr, int fq) const {
#pragma unroll
        for (int ai = 0; ai < 2; ++ai)
#pragma unroll
            for (int m = 0; m < 4; ++m) {
                const int row = u.pm * 256 + ai * 128 + wr * 64 + m * 16 + fr;
                float ss = 0.f;
#pragma unroll
                for (int bj = 0; bj < 2; ++bj) {
                    const int col = u.pn * 256 + bj * 128 + wc * 32 + 8 * fq;
                    const size_t o = (size_t)row * D + col;
                    const pg8::f32x4 a = *(const pg8::f32x4*)(x + o) + acc[ai][bj][m][0], b = *(const pg8::f32x4*)(x + o + 4) + acc[ai][bj][m][1];
                    ss += (a[0] * a[0] + a[1] * a[1]) + (a[2] * a[2] + a[3] * a[3]) + (b[0] * b[0] + b[1] * b[1]) + (b[2] * b[2] + b[3] * b[3]);
                    pg8::u32x4 w; w.x = pg8::cvt_pk_bf16(a[0], a[1]); w.y = pg8::cvt_pk_bf16(a[2], a[3]); w.z = pg8::cvt_pk_bf16(b[0], b[1]); w.w = pg8::cvt_pk_bf16(b[2], b[3]);
                    *(pg8::u32x4*)(x1b + o) = w;
                    float mx = fmaxf(fmaxf(fmaxf(fabsf(a[0]), fabsf(a[1])), fmaxf(fabsf(a[2]), fabsf(a[3]))), fmaxf(fmaxf(fabsf(b[0]), fabsf(b[1])), fmaxf(fabsf(b[2]), fabsf(b[3]))));
                    mx = fmaxf(mx, __shfl_xor(mx, 16)); mx = fmaxf(mx, __shfl_xor(mx, 32));
                    const float inv = mx > 0.f ? 119.0f / mx : 0.f;
                    unsigned pl = 0u, ph = 0u;
#pragma unroll
                    for (int i = 0; i < 4; ++i) {
                        const int qa = __float2int_rn(a[i] * inv), qb = __float2int_rn(b[i] * inv);
                        pl |= ((unsigned)(qa & 15) << (8 * i)) | ((unsigned)(qb & 15) << (8 * i + 4));
                        ph |= ((unsigned)(((qa + 8) >> 4) & 15) << (8 * i)) | ((unsigned)(((qb + 8) >> 4) & 15) << (8 * i + 4));
                    }
                    unsigned* cq = (unsigned*)(x1q + (size_t)row * D + (col & ~31));
                    cq[fq] = pl; cq[4 + fq] = ph;
                    if (fq == 0) xsc[(size_t)row * 32 + (col >> 5)] = mx * (1.0f / 119.0f);
                }
                ss += __shfl_xor(ss, 16); ss += __shfl_xor(ss, 32);
                if (fq == 0) ssq[(size_t)row * 16 + u.pn * 4 + wc] = ss;
            }
    }
};
struct EpiPeerQ {
    static constexpr bool PERM = true, AFTER_DRAIN = false;
    bf16_t* qp;
    __device__ __forceinline__ void operator()(const pg8::f32x4 (&acc)[2][2][4][2], const pg8::Unit& u, int wr, int wc, int fr, int fq) const {
#pragma unroll
        for (int ai = 0; ai < 2; ++ai)
#pragma unroll
            for (int m = 0; m < 4; ++m) {
                const int row = u.pm * 256 + ai * 128 + wr * 64 + m * 16 + fr;
#pragma unroll
                for (int bj = 0; bj < 2; ++bj) {
                    const pg8::f32x4 a = acc[ai][bj][m][0], b = acc[ai][bj][m][1];
                    pg8::u32x4 w; w.x = pg8::cvt_pk_bf16(a[0], a[1]); w.y = pg8::cvt_pk_bf16(a[2], a[3]); w.z = pg8::cvt_pk_bf16(b[0], b[1]); w.w = pg8::cvt_pk_bf16(b[2], b[3]);
                    *(pg8::u32x4*)(qp + ((((size_t)((row >> 5) * 8 + u.pn) * 2 + bj) * 8 + 2 * wc + (fq >> 1)) * 64 + (row & 31) + 32 * (fq & 1)) * 8) = w;
                }
            }
    }
};

typedef float f32x2v __attribute__((ext_vector_type(2)));
typedef __bf16 bf16x2v __attribute__((ext_vector_type(2)));
__device__ __forceinline__ unsigned cvtpk(float lo, float hi) { const f32x2v v = {lo, hi}; const bf16x2v b = __builtin_convertvector(v, bf16x2v); return __builtin_bit_cast(unsigned, b); }
__device__ __forceinline__ bf16x8 pack_step(const f32x16& x, int s) {
    u32x4 pkd; pkd.x = cvtpk(x[8 * s], x[8 * s + 1]); pkd.y = cvtpk(x[8 * s + 2], x[8 * s + 3]); pkd.z = cvtpk(x[8 * s + 4], x[8 * s + 5]); pkd.w = cvtpk(x[8 * s + 6], x[8 * s + 7]);
    return __builtin_bit_cast(bf16x8, pkd);
}
#define MFMA32(a, b, c) __builtin_amdgcn_mfma_f32_32x32x16_bf16((a), (b), (c), 0, 0, 0)
__device__ __forceinline__ void ph_attn(const Params& p) {
    unsigned char* ws = p.ws;
    const bf16_t* qh = (const bf16_t*)(ws + WS_QH); const bf16_t* kh = (const bf16_t*)(ws + WS_KH); const bf16_t* vT = (const bf16_t*)(ws + WS_VH);
    bf16_t* osb = (bf16_t*)(ws + WS_OSB);
    const int tid = phase_tid(), lane = tid & 63, r = lane & 31, hh = lane >> 5;
    const int gwave = (blockIdx.x * blockDim.x + tid) >> 6, nwave = (gridDim.x * blockDim.x) >> 6;
    bf16x8 tp[2];
#pragma unroll
    for (int ss = 0; ss < 2; ++ss)
#pragma unroll
        for (int e = 0; e < 8; ++e) { const int k = 16 * ss + 8 * (e >> 2) + 4 * hh + (e & 3); tp[ss][e] = (k > r) ? (short)0x3F80 : (short)0; }
    f32x16 zero16;
#pragma unroll
    for (int i = 0; i < 16; ++i) zero16[i] = 0.f;
    for (int u = gwave; u < NH * (S / 32); u += nwave) {
        const int h = u / (S / 32), t0 = (u % (S / 32)) * 32;
        bf16x8 bq[4];
#pragma unroll
        for (int s = 0; s < 4; ++s) bq[s] = *(const bf16x8*)(qh + (((size_t)(h * (S / 32) + (t0 >> 5)) * 4 + s) * 64 + lane) * 8);
        f32x16 ot[2] = {zero16, zero16};
        float carry = 0.f;
        for (int kt0 = t0; kt0 >= 0; kt0 -= 32) {
            bf16x8 ak[4], av[2][2];
#pragma unroll
            for (int s = 0; s < 4; ++s) ak[s] = *(const bf16x8*)(kh + (((size_t)(h * (S / 32) + (kt0 >> 5)) * 4 + s) * 64 + lane) * 8);
#pragma unroll
            for (int dt = 0; dt < 2; ++dt)
#pragma unroll
                for (int ss = 0; ss < 2; ++ss) av[dt][ss] = *(const bf16x8*)(vT + ((((size_t)(h * (S / 32) + (kt0 >> 5)) * 2 + dt) * 2 + ss) * 64 + lane) * 8);
            f32x16 st = zero16;
#pragma unroll
            for (int s = 0; s < 4; ++s) st = MFMA32(ak[s], bq[s], st);
            const bool diag = (kt0 == t0);
            f32x16 lom, lb;
            float csum = 0.f;
#pragma unroll
            for (int i = 0; i < 16; ++i) {
                const float z = st[i];
                const float sp2 = fmaxf(z, 0.f) + __builtin_amdgcn_logf(1.0f + __builtin_amdgcn_exp2f(-fabsf(z)));
                const bool valid = !diag || ((i & 3) + 8 * (i >> 2) + 4 * hh < r);
                lom[i] = valid ? -sp2 : 0.f;
                lb[i] = z - sp2;
                csum += lom[i];
            }
            f32x16 suf = MFMA32(tp[0], pack_step(lom, 0), zero16);
            suf = MFMA32(tp[1], pack_step(lom, 1), suf);
            f32x16 w;
#pragma unroll
            for (int i = 0; i < 16; ++i) {
                const bool valid = !diag || ((i & 3) + 8 * (i >> 2) + 4 * hh < r);
                w[i] = valid ? __builtin_amdgcn_exp2f(lb[i] + suf[i] + carry) : 0.f;
            }
            const bf16x8 w0 = pack_step(w, 0), w1 = pack_step(w, 1);
#pragma unroll
            for (int dt = 0; dt < 2; ++dt) { ot[dt] = MFMA32(av[dt][0], w0, ot[dt]); ot[dt] = MFMA32(av[dt][1], w1, ot[dt]); }
            carry += csum + __shfl_xor(csum, 32);
            if (__all(carry < CARRY_STOP)) break;
        }
#pragma unroll
        for (int dt = 0; dt < 2; ++dt)
#pragma unroll
            for (int g = 0; g < 4; ++g) {
                uint2 o; o.x = cvtpk(ot[dt][4 * g], ot[dt][4 * g + 1]); o.y = cvtpk(ot[dt][4 * g + 2], ot[dt][4 * g + 3]);
                *(uint2*)(osb + (size_t)(t0 + r) * DSB + h * HD + 32 * dt + 8 * g + 4 * hh) = o;
            }
    }
}

constexpr int RG_LDS_CST = 0, RG_LDS_HIN = 16384, RG_LDS_P = 18432, RG_LDS_SSQ = 20480;
constexpr int RG_LDS_X = 22528, RG_XP = 1032, RG_LDS_O = 91904;
typedef unsigned u32x2 __attribute__((ext_vector_type(2)));
typedef __attribute__((address_space(3))) float lds_f;
typedef __attribute__((address_space(3))) unsigned char lds_b;
template <int CTRL, int ROWMASK>
__device__ __forceinline__ float dpp_mov(float oob, float x) {
    return __builtin_bit_cast(float, __builtin_amdgcn_update_dpp(__builtin_bit_cast(int, oob), __builtin_bit_cast(int, x), CTRL, ROWMASK, 0xf, false));
}
template <int CTRL, int ROWMASK>
__device__ __forceinline__ void scan_step(float (&av)[16], float (&bv)[16]) {
#pragma unroll
    for (int i = 0; i < 16; ++i) {
        const float ap = dpp_mov<CTRL, ROWMASK>(1.0f, av[i]), bp = dpp_mov<CTRL, ROWMASK>(0.0f, bv[i]);
        bv[i] = __builtin_fmaf(av[i], bp, bv[i]); av[i] *= ap;
    }
}
template <int PASS>
__device__ __forceinline__ void ph_rg(const Params& p, unsigned char* lds_raw) {
    float* lds = (float*)lds_raw;
    unsigned char* ws = p.ws;
    const bf16_t* xrg = (const bf16_t*)(ws + WS_XRG); const bf16_t* gg = (const bf16_t*)(ws + WS_GG); const bf16_t* wfrag = (const bf16_t*)(ws + WS_RGW);
    const bf16_t* osb = (const bf16_t*)(ws + WS_OSB); bf16_t* mix = (bf16_t*)(ws + WS_MIX);
    float* rgP = (float*)(ws + WS_RGP); float* rgH = (float*)(ws + WS_RGH);
    bf16_t* scA = (bf16_t*)(ws + WS_RGSA); bf16_t* scB = (bf16_t*)(ws + WS_RGSB);
    const int tid = phase_tid(), lane = tid & 63, r = lane & 31, hh = lane >> 5, n = __builtin_amdgcn_readfirstlane(tid >> 6);
    __syncthreads();
    if (PASS == 0) for (int e = tid; e < 8 * 2 * 8 * 32; e += NTHR) {
        const int q = e & 31, k = (e >> 5) & 7, h2 = (e >> 8) & 1, nn = e >> 9;
        const int c = 64 * nn + 32 * (q >> 4) + (q & 3) + 8 * ((q >> 2) & 3) + 4 * h2;
        float v;
        if (k < 4) v = p.in[I_CONV_W][k * DRG + c];
        else if (k == 4) v = p.in[I_CONV_B][c];
        else if (k == 5) v = p.in[I_RG_B_A][c];
        else if (k == 6) v = p.in[I_RG_B_X][c];
        else v = 8.0f * LOG2E * log1pf(__expf(-p.in[I_RG_LAMBDA][c]));
        lds[e] = v;
    }
    const unsigned lds0 = (unsigned)(size_t)((lds_b*)lds_raw);
    const unsigned cst_base = lds0 + (unsigned)((n * 2 + hh) * 1024);
    lds_f* hin_l = (lds_f*)(size_t)(lds0 + RG_LDS_HIN + (n * 2 + hh) * 128);
    lds_f* pc_l = (lds_f*)(size_t)(lds0 + RG_LDS_P + (n * 2 + hh) * 128);
    lds_b* xt = (lds_b*)(size_t)(lds0 + RG_LDS_X);
    lds_b* ot = (lds_b*)(size_t)(lds0 + RG_LDS_O);
    f32x16 zero16;
#pragma unroll
    for (int i = 0; i < 16; ++i) zero16[i] = 0.f;
    for (int ch = blockIdx.x; ch < NCHUNK; ch += gridDim.x) {
        const int t0 = ch * CHUNK;
        __syncthreads();
        if (PASS == 0) for (int ci = tid; ci < (CHUNK + 3) * 64; ci += NTHR) {
            const int row = ci >> 6, c16 = ci & 63, tt = t0 - 3 + row;
            u32x4 v = {0u, 0u, 0u, 0u};
            if (tt >= 0) v = *(const u32x4*)(xrg + (size_t)tt * DRG + 8 * c16);
            __attribute__((address_space(3))) u32x2* d = (__attribute__((address_space(3))) u32x2*)(xt + row * RG_XP + 16 * c16);
            d[0] = (u32x2){v.x, v.y}; d[1] = (u32x2){v.z, v.w};
        }
        if (PASS == 1) {
            const int c = 64 * n + lane;
            float h = 0.f;
            int k = 0;
            for (; k + 32 <= ch; k += 32) {
                float pv[32], hv[32];
#pragma unroll
                for (int j = 0; j < 32; ++j) { pv[j] = rgP[(k + j) * DRG + c]; hv[j] = rgH[(k + j) * DRG + c]; }
#pragma unroll
                for (int j = 0; j < 32; ++j) h = pv[j] * h + hv[j];
            }
            for (; k + 8 <= ch; k += 8) {
                float pv[8], hv[8];
#pragma unroll
                for (int j = 0; j < 8; ++j) { pv[j] = rgP[(k + j) * DRG + c]; hv[j] = rgH[(k + j) * DRG + c]; }
#pragma unroll
                for (int j = 0; j < 8; ++j) h = pv[j] * h + hv[j];
            }
            for (; k < ch; ++k) h = rgP[k * DRG + c] * h + rgH[k * DRG + c];
            lds[RG_LDS_HIN / 4 + (n * 2 + ((lane >> 2) & 1)) * 32 + 16 * (lane >> 5) + 4 * ((lane >> 3) & 3) + (lane & 3)] = h;
        } else {
            if (r == 0) {
#pragma unroll
                for (int q = 0; q < 32; ++q) { hin_l[q] = 0.f; pc_l[q] = 1.f; }
            }
        }
        __syncthreads();
#pragma unroll 1
        for (int tl = 0; tl < 2; ++tl) {
            const int tok = t0 + 32 * tl + r;
            unsigned cst_a = cst_base; asm volatile("" : "+v"(cst_a));
            const lds_f* cst = (const lds_f*)(size_t)cst_a;
            float xcv[32]; bf16x8 bx[4];
            if (PASS == 0) {
#pragma unroll
            for (int q = 0; q < 32; ++q) xcv[q] = cst[4 * 32 + q];
#pragma unroll
            for (int k = 0; k < 4; ++k) {
                const lds_b* xr = xt + (32 * tl + r + k) * RG_XP + (64 * n + 4 * hh) * 2;
#pragma unroll
                for (int m = 0; m < 8; ++m) {
                    const u32x2 xw = *(const __attribute__((address_space(3))) u32x2*)(xr + 16 * m);
                    xcv[4 * m + 0] += cst[k * 32 + 4 * m + 0] * bf2f(xw.x & 0xffffu); xcv[4 * m + 1] += cst[k * 32 + 4 * m + 1] * bf2f(xw.x >> 16);
                    xcv[4 * m + 2] += cst[k * 32 + 4 * m + 2] * bf2f(xw.y & 0xffffu); xcv[4 * m + 3] += cst[k * 32 + 4 * m + 3] * bf2f(xw.y >> 16);
                }
                __builtin_amdgcn_sched_barrier(0);
            }
#pragma unroll
            for (int s = 0; s < 4; ++s) {
                u32x4 pk; pk.x = cvtpk(xcv[8 * s], xcv[8 * s + 1]); pk.y = cvtpk(xcv[8 * s + 2], xcv[8 * s + 3]); pk.z = cvtpk(xcv[8 * s + 4], xcv[8 * s + 5]); pk.w = cvtpk(xcv[8 * s + 6], xcv[8 * s + 7]);
                bx[s] = __builtin_bit_cast(bf16x8, pk);
            }
            }
            float ss = 0.f;
            const bf16_t* wb = wfrag + ((size_t)n * 16 * 64 + lane) * 8; asm volatile("" : "+v"(wb));
#pragma unroll
            for (int jt = 0; jt < 2; ++jt) {
                float av[16], bv[16];
                const size_t sco = ((((size_t)(2 * ch + tl) * 8 + n) * 2 + jt) * 64 + lane) * 16;
                if (PASS == 0) {
#pragma unroll
                for (int g = 0; g < 2; ++g) {
                    f32x16 acc = zero16;
#pragma unroll
                    for (int s = 0; s < 4; ++s) {
                        const bf16x8 aw = *(const __attribute__((address_space(1))) bf16x8*)(wb + (((g * 2 + jt) * 4 + s) * 64) * 8);
                        acc = MFMA32(aw, bx[s], acc);
                    }
#pragma unroll
                    for (int i = 0; i < 16; ++i) {
                        const int q = 16 * jt + i;
                        const float pre = acc[i] + cst[(5 + g) * 32 + q];
                        const float sg = 1.0f / (1.0f + __builtin_amdgcn_exp2f(-LOG2E * pre));
                        if (g == 0) av[i] = __builtin_amdgcn_exp2f(-sg * cst[7 * 32 + q]);
                        else bv[i] = __builtin_amdgcn_sqrtf(fmaxf(__builtin_fmaf(-av[i], av[i], 1.0f), 0.f)) * (sg * xcv[q]);
                    }
                    __builtin_amdgcn_sched_barrier(0);
                }
                scan_step<0x111, 0xf>(av, bv); scan_step<0x112, 0xf>(av, bv); scan_step<0x114, 0xf>(av, bv); scan_step<0x118, 0xf>(av, bv);
                scan_step<0x142, 0xa>(av, bv);
                u32x4 sa0, sa1, sb0, sb1;
                sa0.x = cvtpk(av[0], av[1]); sa0.y = cvtpk(av[2], av[3]); sa0.z = cvtpk(av[4], av[5]); sa0.w = cvtpk(av[6], av[7]); sa1.x = cvtpk(av[8], av[9]); sa1.y = cvtpk(av[10], av[11]); sa1.z = cvtpk(av[12], av[13]); sa1.w = cvtpk(av[14], av[15]);
                sb0.x = cvtpk(bv[0], bv[1]); sb0.y = cvtpk(bv[2], bv[3]); sb0.z = cvtpk(bv[4], bv[5]); sb0.w = cvtpk(bv[6], bv[7]); sb1.x = cvtpk(bv[8], bv[9]); sb1.y = cvtpk(bv[10], bv[11]); sb1.z = cvtpk(bv[12], bv[13]); sb1.w = cvtpk(bv[14], bv[15]);
                *(u32x4*)(scA + sco) = sa0; *(u32x4*)(scA + sco + 8) = sa1; *(u32x4*)(scB + sco) = sb0; *(u32x4*)(scB + sco + 8) = sb1;
                } else {
                    const u32x4 sa0 = *(const u32x4*)(scA + sco), sa1 = *(const u32x4*)(scA + sco + 8), sb0 = *(const u32x4*)(scB + sco), sb1 = *(const u32x4*)(scB + sco + 8);
                    const unsigned wa[8] = {sa0.x, sa0.y, sa0.z, sa0.w, sa1.x, sa1.y, sa1.z, sa1.w}, wbb[8] = {sb0.x, sb0.y, sb0.z, sb0.w, sb1.x, sb1.y, sb1.z, sb1.w};
#pragma unroll
                    for (int k = 0; k < 8; ++k) { av[2 * k] = bf2f(wa[k] & 0xffffu); av[2 * k + 1] = bf2f(wa[k] >> 16); bv[2 * k] = bf2f(wbb[k] & 0xffffu); bv[2 * k + 1] = bf2f(wbb[k] >> 16); }
                }
                __builtin_amdgcn_sched_barrier(0);
#pragma unroll
                for (int i = 0; i < 16; ++i) {
                    const int q = 16 * jt + i;
                    const float h = __builtin_fmaf(av[i], hin_l[q], bv[i]);
                    if (r == 31) { hin_l[q] = h; if (PASS == 0) pc_l[q] *= av[i]; }
                    bv[i] = h;
                }
                if (PASS == 1) {
#pragma unroll
                    for (int g4 = 0; g4 < 4; ++g4) {
                        const int m = 4 * jt + g4;
                        const uint2 gw = *(const uint2*)(gg + ((((size_t)(tok >> 5) * 8 + n) * 8 + m) * 64 + lane) * 4);
                        const float o0 = bv[4 * g4] * bf2f(gw.x & 0xffffu), o1 = bv[4 * g4 + 1] * bf2f(gw.x >> 16), o2 = bv[4 * g4 + 2] * bf2f(gw.y & 0xffffu), o3 = bv[4 * g4 + 3] * bf2f(gw.y >> 16);
                        ss += (o0 * o0 + o1 * o1) + (o2 * o2 + o3 * o3);
                        *(__attribute__((address_space(3))) u32x2*)(ot + (32 * tl + r) * RG_XP + (64 * n + 8 * m + 4 * hh) * 2) = (u32x2){cvtpk(o0, o1), cvtpk(o2, o3)};
                    }
                }
                __builtin_amdgcn_sched_barrier(0);
            }
            if (PASS == 1) { ss += __shfl_xor(ss, 32); if (hh == 0) lds[RG_LDS_SSQ / 4 + (tl * 8 + n) * 32 + r] = ss; }
        }
        if (PASS == 0) {
            if (r == 0) {
#pragma unroll
                for (int m = 0; m < 8; ++m) {
                    const int c = 64 * n + 8 * m + 4 * hh;
                    *(f32x4*)(rgP + (size_t)ch * DRG + c) = (f32x4){pc_l[4 * m], pc_l[4 * m + 1], pc_l[4 * m + 2], pc_l[4 * m + 3]};
                    *(f32x4*)(rgH + (size_t)ch * DRG + c) = (f32x4){hin_l[4 * m], hin_l[4 * m + 1], hin_l[4 * m + 2], hin_l[4 * m + 3]};
                }
            }
        } else {
            __syncthreads();
            for (int j = 0; j < 8; ++j) {
                const int tr = 8 * n + j, tok = t0 + tr;
                float tot = 0.f;
#pragma unroll
                for (int w = 0; w < 8; ++w) tot += lds[RG_LDS_SSQ / 4 + ((tr >> 5) * 8 + w) * 32 + (tr & 31)];
                const float rn = rsqrtf(tot * (1.0f / DRG) + EPS);
                const __attribute__((address_space(3))) u32x2* op = (const __attribute__((address_space(3))) u32x2*)(ot + tr * RG_XP + 16 * lane);
                const u32x2 w0 = op[0], w1 = op[1];
                u32x4 o2; o2.x = cvtpk(bf2f(w0.x & 0xffffu) * rn, bf2f(w0.x >> 16) * rn); o2.y = cvtpk(bf2f(w0.y & 0xffffu) * rn, bf2f(w0.y >> 16) * rn);
                o2.z = cvtpk(bf2f(w1.x & 0xffffu) * rn, bf2f(w1.x >> 16) * rn); o2.w = cvtpk(bf2f(w1.y & 0xffffu) * rn, bf2f(w1.y >> 16) * rn);
                *((u32x4*)(mix + (size_t)tok * D + DSB) + lane) = o2;
                const u32x4 a = *((const u32x4*)(osb + (size_t)tok * DSB) + lane);
                float f[8] = {bf2f(a.x & 0xffffu), bf2f(a.x >> 16), bf2f(a.y & 0xffffu), bf2f(a.y >> 16), bf2f(a.z & 0xffffu), bf2f(a.z >> 16), bf2f(a.w & 0xffffu), bf2f(a.w >> 16)};
                float sa = 0.f;
#pragma unroll
                for (int k = 0; k < 8; ++k) sa += f[k] * f[k];
                sa = wave_sum(sa);
                const float ra = rsqrtf(sa * (1.0f / DSB) + EPS);
                u32x4 o; o.x = cvtpk(f[0] * ra, f[1] * ra); o.y = cvtpk(f[2] * ra, f[3] * ra); o.z = cvtpk(f[4] * ra, f[5] * ra); o.w = cvtpk(f[6] * ra, f[7] * ra);
                *((u32x4*)(mix + (size_t)tok * D) + lane) = o;
            }
        }
    }
}

__device__ __forceinline__ int f2key(float f) { const int b = __builtin_bit_cast(int, f); return b ^ ((b >> 31) & 0x7fffffff); }
__device__ __forceinline__ float key2f(int k) { return __builtin_bit_cast(float, k ^ ((k >> 31) & 0x7fffffff)); }
#define TOPK_CE(a, b) do { const int hi_ = max(a, b), lo_ = min(a, b); a = hi_; b = lo_; } while (0)
__device__ __forceinline__ void sort16_desc(int (&v)[16]) { TOPK_CE(v[0], v[1]); TOPK_CE(v[2], v[3]); TOPK_CE(v[0], v[2]); TOPK_CE(v[1], v[3]); TOPK_CE(v[1], v[2]); TOPK_CE(v[4], v[5]); TOPK_CE(v[6], v[7]); TOPK_CE(v[4], v[6]); TOPK_CE(v[5], v[7]); TOPK_CE(v[5], v[6]); TOPK_CE(v[0], v[4]); TOPK_CE(v[2], v[6]); TOPK_CE(v[2], v[4]); TOPK_CE(v[1], v[5]); TOPK_CE(v[3], v[7]); TOPK_CE(v[3], v[5]); TOPK_CE(v[1], v[2]); TOPK_CE(v[3], v[4]); TOPK_CE(v[5], v[6]); TOPK_CE(v[8], v[9]); TOPK_CE(v[10], v[11]); TOPK_CE(v[8], v[10]); TOPK_CE(v[9], v[11]); TOPK_CE(v[9], v[10]); TOPK_CE(v[12], v[13]); TOPK_CE(v[14], v[15]); TOPK_CE(v[12], v[14]); TOPK_CE(v[13], v[15]); TOPK_CE(v[13], v[14]); TOPK_CE(v[8], v[12]); TOPK_CE(v[10], v[14]); TOPK_CE(v[10], v[12]); TOPK_CE(v[9], v[13]); TOPK_CE(v[11], v[15]); TOPK_CE(v[11], v[13]); TOPK_CE(v[9], v[10]); TOPK_CE(v[11], v[12]); TOPK_CE(v[13], v[14]); TOPK_CE(v[0], v[8]); TOPK_CE(v[4], v[12]); TOPK_CE(v[4], v[8]); TOPK_CE(v[2], v[10]); TOPK_CE(v[6], v[14]); TOPK_CE(v[6], v[10]); TOPK_CE(v[2], v[4]); TOPK_CE(v[6], v[8]); TOPK_CE(v[10], v[12]); TOPK_CE(v[1], v[9]); TOPK_CE(v[5], v[13]); TOPK_CE(v[5], v[9]); TOPK_CE(v[3], v[11]); TOPK_CE(v[7], v[15]); TOPK_CE(v[7], v[11]); TOPK_CE(v[3], v[5]); TOPK_CE(v[7], v[9]); TOPK_CE(v[11], v[13]); TOPK_CE(v[1], v[2]); TOPK_CE(v[3], v[4]); TOPK_CE(v[5], v[6]); TOPK_CE(v[7], v[8]); TOPK_CE(v[9], v[10]); TOPK_CE(v[11], v[12]); TOPK_CE(v[13], v[14]); }
__device__ __forceinline__ void merge16_desc(int (&a)[16], const int (&b)[16]) {
#pragma unroll
    for (int i = 0; i < 16; ++i) a[i] = max(a[i], b[15 - i]);
#pragma unroll
    for (int d = 8; d >= 1; d >>= 1)
#pragma unroll
        for (int i = 0; i < 16; ++i) if ((i & d) == 0) TOPK_CE(a[i], a[i + d]);
}
__device__ __forceinline__ void ph_topk(const Params& p, int* lds) {
    unsigned char* ws = p.ws;
    const bf16_t* qp = (const bf16_t*)(ws + WS_B); const bf16_t* subk = (const bf16_t*)(ws + WS_SUBK);
    int* seli = (int*)(ws + WS_SELI); float* selg = (float*)(ws + WS_SELG);
    const float* ssq = (const float*)(ws + WS_SSQ); float* rstd2 = (float*)(ws + WS_RSTD2);
    const int tid = phase_tid(), lane = tid & 63, r = lane & 31, hh = lane >> 5, hx = 4 * hh;
    const int gwave = (blockIdx.x * blockDim.x + tid) >> 6, nwave = (gridDim.x * blockDim.x) >> 6;
    constexpr int SK_OFF = 65536, SK_PITCH = 272;
    typedef __attribute__((address_space(3))) unsigned char lds_b;
    lds_b* skl = (lds_b*)lds + SK_OFF;
    const int w = tid >> 6;
    pg8::StaticOrder so; so.init(S, NQ, (int)gridDim.x, (int)blockIdx.x);
    pg8::Unit gu;
    for (int ui = 0; so.next(ui, gu); ++ui) {
        const int h = gu.pn, t0 = gu.pm * 256 + 32 * w, t = t0 + r;
        __syncthreads();
#pragma unroll
        for (int j = 0; j < 8; ++j) {
            const int ci = tid + NTHR * j, row = ci >> 4, c16 = ci & 15;
            const u32x4 v = *(const u32x4*)(subk + ((size_t)h * 256 + row) * PHALF + 8 * c16);
            *(__attribute__((address_space(3))) u32x4*)(skl + row * SK_PITCH + 16 * c16) = v;
        }
        __syncthreads();
        int tk[2][16];
#pragma unroll
        for (int pp = 0; pp < 2; ++pp) {
            f32x16 acc[4];
#pragma unroll
            for (int T = 0; T < 4; ++T)
#pragma unroll
                for (int i = 0; i < 16; ++i) acc[T][i] = 0.f;
            const bf16_t* qrow = qp + ((((size_t)((t0 >> 5) * 8 + h) * 2 + pp) * 8) * 64 + lane) * 8;
            const lds_b* krow = skl + (pp * PNK + r) * SK_PITCH + 16 * hh;
#pragma unroll
            for (int s = 0; s < 8; ++s) {
                const bf16x8 b = *(const bf16x8*)(qrow + s * 64 * 8);
#pragma unroll
                for (int T = 0; T < 4; ++T) {
                    const bf16x8 a = *(const __attribute__((address_space(3))) bf16x8*)(krow + (32 * T) * SK_PITCH + 32 * s);
                    acc[T] = __builtin_amdgcn_mfma_f32_32x32x16_bf16(a, b, acc[T], 0, 0, 0);
                }
            }
            int kq[4][16];
#pragma unroll
            for (int T = 0; T < 4; ++T) {
#pragma unroll
                for (int i = 0; i < 16; ++i) {
                    const int nb = 32 * T + (i & 3) + 8 * (i >> 2);
                    kq[T][i] = ((f2key(acc[T][i]) & ~127) | (127 - nb)) ^ hx;
                }
                sort16_desc(kq[T]);
            }
            merge16_desc(kq[0], kq[1]); merge16_desc(kq[2], kq[3]); merge16_desc(kq[0], kq[2]);
            int m[16], po[16];
#pragma unroll
            for (int i = 0; i < 16; ++i) { m[i] = kq[0][i]; po[i] = __shfl_xor(kq[0][i], 32); }
            merge16_desc(m, po);
#pragma unroll
            for (int i = 0; i < 16; ++i) tk[pp][i] = m[i];
        }
#pragma unroll
        for (int i = 0; i < 16; ++i) { lds[i * NTHR + tid] = tk[0][i]; lds[(16 + i) * NTHR + tid] = tk[1][i]; }
        float v0[16], v1[16];
#pragma unroll
        for (int i = 0; i < 16; ++i) { v0[i] = key2f(tk[0][i]); v1[i] = key2f(tk[1][i]); }
#define CKEY(a, b) ((f2key(v0[a] + v1[b]) & ~255) | (255 - ((a) * 16 + (b))))
        const int NEGK = (int)0x80000000;
        int bk[16], l1[16], ga[16], gb[16];
#pragma unroll
        for (int b = 0; b < 16; ++b) bk[b] = CKEY(0, b);
#pragma unroll
        for (int b = 0; b < 16; ++b) l1[b] = b < 8 ? CKEY(1, b) : NEGK;
        ga[0] = CKEY(2, 0); ga[1] = CKEY(2, 1); ga[2] = CKEY(2, 2); ga[3] = CKEY(2, 3); ga[4] = CKEY(2, 4);
        ga[5] = CKEY(3, 0); ga[6] = CKEY(3, 1); ga[7] = CKEY(3, 2); ga[8] = CKEY(3, 3);
        ga[9] = CKEY(4, 0); ga[10] = CKEY(4, 1); ga[11] = CKEY(4, 2); ga[12] = CKEY(5, 0); ga[13] = CKEY(5, 1); ga[14] = NEGK; ga[15] = NEGK;
        gb[0] = CKEY(6, 0); gb[1] = CKEY(6, 1); gb[2] = CKEY(7, 0); gb[3] = CKEY(7, 1);
#pragma unroll
        for (int a = 8; a < 16; ++a) gb[a - 4] = CKEY(a, 0);
        gb[12] = NEGK; gb[13] = NEGK; gb[14] = NEGK; gb[15] = NEGK;
#undef CKEY
        sort16_desc(ga); sort16_desc(gb);
        merge16_desc(bk, l1); merge16_desc(ga, gb); merge16_desc(bk, ga);
        float ssum = 0.f;
#pragma unroll
        for (int i = 0; i < 4; ++i) { const f32x4 q4 = *(const f32x4*)(ssq + (size_t)t * 16 + 4 * i); ssum += (q4.x + q4.y) + (q4.z + q4.w); }
        const float rs = rsqrtf(ssum * (1.0f / D) + EPS);
        float e[16], sum = 0.f; const float mx = key2f(bk[0]);
#pragma unroll
        for (int i = 0; i < 16; ++i) { e[i] = __expf((key2f(bk[i]) - mx) * rs); sum += e[i]; }
        const float inv = 1.0f / sum;
        int eidx[16];
#pragma unroll
        for (int i = 0; i < 16; ++i) {
            const int code = 255 - (bk[i] & 255), a = code >> 4, b = code & 15;
            const int i1 = 127 - (lds[a * NTHR + tid] & 127), i2 = 127 - (lds[(16 + b) * NTHR + tid] & 127);
            eidx[i] = i1 * PNK + i2; e[i] *= inv;
        }
        if (hh == 0) {
            int4* o = (int4*)(seli + (size_t)t * 128 + h * 16);
#pragma unroll
            for (int i = 0; i < 4; ++i) o[i] = make_int4(eidx[4 * i], eidx[4 * i + 1], eidx[4 * i + 2], eidx[4 * i + 3]);
            if (h == 0) rstd2[t] = rs;
        } else {
            f32x4* o = (f32x4*)(selg + (size_t)t * 128 + h * 16);
#pragma unroll
            for (int i = 0; i < 4; ++i) o[i] = (f32x4){e[4 * i], e[4 * i + 1], e[4 * i + 2], e[4 * i + 3]};
        }
    }
}

typedef __bf16 bf16x2_t __attribute__((ext_vector_type(2)));
typedef float f32x2 __attribute__((ext_vector_type(2)));
template <int NV, int XS0, int XS1, int XS2>
__device__ __forceinline__ void reduce_over8(float (&v)[NV], int sel) {
    { const bool up = sel & 1;
#pragma unroll
      for (int i = 0; i < NV / 2; ++i) { const float a = v[2 * i], b = v[2 * i + 1]; v[i] = (up ? b : a) + __shfl_xor(up ? a : b, XS0); } }
    { const bool up = (sel >> 1) & 1;
#pragma unroll
      for (int i = 0; i < NV / 4; ++i) { const float a = v[2 * i], b = v[2 * i + 1]; v[i] = (up ? b : a) + __shfl_xor(up ? a : b, XS1); } }
    { const bool up = (sel >> 2) & 1;
#pragma unroll
      for (int i = 0; i < NV / 8; ++i) { const float a = v[2 * i], b = v[2 * i + 1]; v[i] = (up ? b : a) + __shfl_xor(up ? a : b, XS2); } }
}
__device__ __forceinline__ void peer_load_idx(const unsigned char* ws, int t, int rsl, int (&ei)[16]) {
    const unsigned off = (unsigned)WS_SELI + ((unsigned)t * 128u + 16u * (unsigned)rsl) * 4u;
#pragma unroll
    for (int j = 0; j < 4; ++j) { const int4 v = *(const int4*)(ws + (off + 16u * j)); ei[4 * j] = v.x; ei[4 * j + 1] = v.y; ei[4 * j + 2] = v.z; ei[4 * j + 3] = v.w; }
}
template <int PASS>
__device__ __forceinline__ void peer_load_rows(const unsigned char* ws, int t, int sl, int rsl, int c, const int (&ei)[16], u32x4 (&row)[16], u32x4 (&aux)[4]) {
    const unsigned tab = (unsigned)(PASS == 0 ? WS_UB : WS_VB) + (unsigned)sl * (unsigned)(NEXP * 128) + 16u * (unsigned)c;
#pragma unroll
    for (int i = 0; i < 16; ++i) row[i] = *(const u32x4*)(ws + (tab + (unsigned)ei[i] * 128u));
    const unsigned xo = (unsigned)WS_X1Q + (unsigned)t * (unsigned)D + 256u * sl + 32u * c;
    aux[0] = *(const u32x4*)(ws + xo); aux[1] = *(const u32x4*)(ws + (xo + 16u));
    aux[2].x = *(const unsigned*)(ws + ((unsigned)WS_XSC + ((unsigned)t * 32u + 8u * sl + c) * 4u));
}
constexpr int PEER_IMG_PITCH = 136, PEER_IMG_BYTES = 128 * PEER_IMG_PITCH;
template <int PASS  >
__device__ __forceinline__ void peer_compute(const Params& p, unsigned char* lds, int lane_w, int t, int sl, int rsl, int c, const u32x4 (&row)[16], const u32x4 (&aux)[4]) {
    unsigned char* ws = p.ws;
    if (PASS == 0) {
        const u32x4 x0 = aux[0], x1_ = aux[1]; const unsigned xl[4] = {x0.x, x0.y, x0.z, x0.w}, xh[4] = {x1_.x, x1_.y, x1_.z, x1_.w};
        const unsigned xsu = aux[2].x; const float xs = u2f(xsu);
        float pd[16];
#pragma unroll
        for (int i = 0; i < 16; ++i) {
            const u32x4 rw = row[i]; const unsigned w4[4] = {rw.x, rw.y, rw.z, rw.w};
            int al = 0, ah = 0;
#pragma unroll
            for (int j = 0; j < 4; ++j) { al = __builtin_amdgcn_sdot8((int)w4[j], (int)xl[j], al, false); ah = __builtin_amdgcn_sdot8((int)w4[j], (int)xh[j], ah, false); }
            pd[i] = (float)(16 * ah + al) * xs;
        }
        reduce_over8<16, 1, 2, 4>(pd, c);
        const unsigned po = (unsigned)WS_PD + (((unsigned)sl * S + (unsigned)t) * 128u + 16u * rsl + c) * 4u;
        *(float*)(ws + po) = pd[0]; *(float*)(ws + (po + 32u)) = pd[1];
    }
}
template <int PASS>
__device__ __forceinline__ void peer_stream(const Params& p, unsigned char* lds, int lane_w, int sl, int t0, int dt, int n) {
    const unsigned char* ws = p.ws;
    const int lane = lane_w & 63, rsl = lane >> 3, c = lane & 7;
    int eiA[16], eiB[16]; u32x4 rowA[16], rowB[16], auxA[4], auxB[4];
    if (n <= 0) return;
    peer_load_idx(ws, t0, rsl, eiA);
    peer_load_rows<PASS>(ws, t0, sl, rsl, c, eiA, rowA, auxA);
    if (n > 1) peer_load_idx(ws, t0 + dt, rsl, eiB);
    for (int i = 0; i < n; i += 2) {
        const int t = t0 + i * dt;
        if (i + 1 < n) peer_load_rows<PASS>(ws, t + dt, sl, rsl, c, eiB, rowB, auxB);
        if (i + 2 < n) peer_load_idx(ws, t + 2 * dt, rsl, eiA);
        peer_compute<PASS>(p, lds, lane_w, t, sl, rsl, c, rowA, auxA);
        if (i + 1 < n) {
            if (i + 2 < n) peer_load_rows<PASS>(ws, t + 2 * dt, sl, rsl, c, eiA, rowA, auxA);
            if (i + 3 < n) peer_load_idx(ws, t + 3 * dt, rsl, eiB);
            peer_compute<PASS>(p, lds, lane_w, t + dt, sl, rsl, c, rowB, auxB);
        }
    }
}
__device__ __forceinline__ void peerv_load_idx(const unsigned char* ws, int t, int hf, int rsl, int (&ei)[8]) {
    const unsigned off = (unsigned)WS_SELI + ((unsigned)t * 128u + 16u * (unsigned)rsl + 8u * (unsigned)hf) * 4u;
    const int4 v0 = *(const int4*)(ws + off), v1 = *(const int4*)(ws + (off + 16u));
    ei[0] = v0.x; ei[1] = v0.y; ei[2] = v0.z; ei[3] = v0.w; ei[4] = v1.x; ei[5] = v1.y; ei[6] = v1.z; ei[7] = v1.w;
}
__device__ __forceinline__ void peerv_load_rows(const unsigned char* ws, int sl, int c, const int (&ei)[8], u32x4 (&row)[8]) {
    const unsigned tab = (unsigned)WS_VB + (unsigned)sl * (unsigned)(NEXP * 128) + 16u * (unsigned)c;
#pragma unroll
    for (int i = 0; i < 8; ++i) row[i] = *(const u32x4*)(ws + (tab + (unsigned)ei[i] * 128u));
}
struct PeerVAux { u32x4 cp; unsigned cs; unsigned xo[4]; };
__device__ __forceinline__ void peerv_load_aux(const unsigned char* ws, int t, int sl, int lane, PeerVAux& a) {
    a.cp = *(const u32x4*)(ws + ((unsigned)WS_CBUF + (unsigned)t * 128u + 16u * (unsigned)(lane & 7)));
    a.cs = *(const unsigned*)(ws + ((unsigned)WS_CSC + (unsigned)t * 4u));
    const unsigned xo = (unsigned)WS_A + ((unsigned)t * (unsigned)D + 256u * sl + (unsigned)lane) * 2u;
    a.xo[0] = *(const bf16_t*)(ws + xo); a.xo[1] = *(const bf16_t*)(ws + (xo + 128u)); a.xo[2] = *(const bf16_t*)(ws + (xo + 256u)); a.xo[3] = *(const bf16_t*)(ws + (xo + 384u));
}
template <int HF>
__device__ __forceinline__ void peerv_half(lds_b* img, int lane, const u32x4 (&row)[8], const PeerVAux& a, int (&acc)[4]) {
    const int rsl = lane >> 3, c = lane & 7;
#pragma unroll
    for (int i = 0; i < 8; ++i) {
        const u32x4 rw = row[i];
        __attribute__((address_space(3))) u32x2* d = (__attribute__((address_space(3))) u32x2*)(img + (16 * rsl + i) * PEER_IMG_PITCH + 16 * c);
        d[0] = (u32x2){rw.x, rw.y}; d[1] = (u32x2){rw.z, rw.w};
    }
    const unsigned cpl = HF == 0 ? a.cp.x : a.cp.y, cph = HF == 0 ? a.cp.z : a.cp.w;
    asm volatile("s_waitcnt lgkmcnt(0)" ::: "memory");
    const unsigned ra = (unsigned)(size_t)img + (unsigned)((lane & 15) * PEER_IMG_PITCH + 8 * (lane >> 4));
#define PEER_TR4(R0, R1, R2, R3, RS) asm volatile("ds_read_b64_tr_b4 %0, %4 offset:%5\n\tds_read_b64_tr_b4 %1, %4 offset:%6\n\tds_read_b64_tr_b4 %2, %4 offset:%7\n\tds_read_b64_tr_b4 %3, %4 offset:%8" \
            : "=&v"(R0), "=&v"(R1), "=&v"(R2), "=&v"(R3) : "v"(ra), "i"((RS) * 16 * PEER_IMG_PITCH), "i"((RS) * 16 * PEER_IMG_PITCH + 32), "i"((RS) * 16 * PEER_IMG_PITCH + 64), "i"((RS) * 16 * PEER_IMG_PITCH + 96) : "memory")
#define PEER_USE4(R0, R1, R2, R3, RS, WAITSTR) do { \
            asm volatile(WAITSTR : "+v"(R0), "+v"(R1), "+v"(R2), "+v"(R3) :: "memory"); \
            const int cl_ = __builtin_amdgcn_readlane((int)cpl, RS), ch_ = __builtin_amdgcn_readlane((int)cph, RS); \
            const unsigned lo4_[4] = {R0.x, R1.x, R2.x, R3.x}; \
            _Pragma("unroll") for (int tcg = 0; tcg < 4; ++tcg) acc[tcg] += 16 * __builtin_amdgcn_sdot8((int)lo4_[tcg], ch_, 0, false) + __builtin_amdgcn_sdot8((int)lo4_[tcg], cl_, 0, false); } while (0)
    {
        u32x2 a0, a1, a2, a3, b0, b1, b2, b3;
        PEER_TR4(a0, a1, a2, a3, 0);
        PEER_TR4(b0, b1, b2, b3, 1); PEER_USE4(a0, a1, a2, a3, 0, "s_waitcnt lgkmcnt(4)");
        PEER_TR4(a0, a1, a2, a3, 2); PEER_USE4(b0, b1, b2, b3, 1, "s_waitcnt lgkmcnt(4)");
        PEER_TR4(b0, b1, b2, b3, 3); PEER_USE4(a0, a1, a2, a3, 2, "s_waitcnt lgkmcnt(4)");
        PEER_TR4(a0, a1, a2, a3, 4); PEER_USE4(b0, b1, b2, b3, 3, "s_waitcnt lgkmcnt(4)");
        PEER_TR4(b0, b1, b2, b3, 5); PEER_USE4(a0, a1, a2, a3, 4, "s_waitcnt lgkmcnt(4)");
        PEER_TR4(a0, a1, a2, a3, 6); PEER_USE4(b0, b1, b2, b3, 5, "s_waitcnt lgkmcnt(4)");
        PEER_TR4(b0, b1, b2, b3, 7); PEER_USE4(a0, a1, a2, a3, 6, "s_waitcnt lgkmcnt(4)");
        PEER_USE4(b0, b1, b2, b3, 7, "s_waitcnt lgkmcnt(0)");
    }
#undef PEER_TR4
#undef PEER_USE4
}
__device__ __forceinline__ void peerv_stream(const Params& p, unsigned char* lds, int tid_, int sl, int t0, int dt, int n) {
    const unsigned char* ws = p.ws;
    const int lane = tid_ & 63, rsl = lane >> 3, c = lane & 7;
    lds_b* img = (lds_b*)lds + (tid_ >> 6) * PEER_IMG_BYTES;
    for (int e = lane; e < 64 * (PEER_IMG_PITCH / 8); e += 64) {
        const int zr = e / (PEER_IMG_PITCH / 8), zc = e % (PEER_IMG_PITCH / 8);
        *(__attribute__((address_space(3))) u32x2*)(img + (16 * (zr >> 3) + 8 + (zr & 7)) * PEER_IMG_PITCH + 8 * zc) = (u32x2){0u, 0u};
    }
    if (n <= 0) return;
    int ei0[8], ei1[8]; u32x4 rowA[8], rowB[8]; PeerVAux ax, axn;
    peerv_load_idx(ws, t0, 0, rsl, ei0);
    peerv_load_rows(ws, sl, c, ei0, rowA); peerv_load_aux(ws, t0, sl, lane, ax);
    peerv_load_idx(ws, t0, 1, rsl, ei1);
    for (int i = 0; i < n; ++i) {
        const int t = t0 + i * dt; const bool more = i + 1 < n;
        int acc[4] = {0, 0, 0, 0};
        peerv_load_rows(ws, sl, c, ei1, rowB);
        if (more) peerv_load_idx(ws, t + dt, 0, rsl, ei0);
        peerv_half<0>(img, lane, rowA, ax, acc);
        if (more) { peerv_load_rows(ws, sl, c, ei0, rowA); peerv_load_aux(ws, t + dt, sl, lane, axn); peerv_load_idx(ws, t + dt, 1, rsl, ei1); }
        peerv_half<1>(img, lane, rowB, ax, acc);
        const float cs = u2f(ax.cs);
#pragma unroll
        for (int tcg = 0; tcg < 4; ++tcg) {
            const unsigned oo = ((unsigned)t * (unsigned)D + 256u * sl + 64u * tcg + (unsigned)lane) * 4u;
            *(float*)((unsigned char*)p.out + oo) = bf2f(ax.xo[tcg]) + (float)acc[tcg] * cs;
        }
        if (more) ax = axn;
    }
}
template <int PASS>
__device__ __forceinline__ void ph_peer(const Params& p, unsigned char* lds) {
    const int tid_ = phase_tid();
    const int lane = tid_ & 63, w = tid_ >> 6, b = blockIdx.x, G = gridDim.x;
    if ((G & 7) == 0) {
        const int g = b & 7, nsw = (G >> 3) * 2 * (NTHR / 64), t0 = ((g >> 2) * (G >> 3) + (b >> 3)) * (NTHR / 64) + w;
        if (PASS == 0) peer_stream<0>(p, lds, tid_, g & 3, t0, nsw, t0 < S ? (S - 1 - t0) / nsw + 1 : 0);
        else peerv_stream(p, lds, tid_, g & 3, t0, nsw, t0 < S ? (S - 1 - t0) / nsw + 1 : 0);
    } else {
        const int nw = G * (NTHR / 64), it0 = b * (NTHR / 64) + w;
        for (int it = it0; it < S * 4; it += nw) { if (PASS == 0) peer_stream<0>(p, lds, tid_, it & 3, it >> 2, 0, 1); else peerv_stream(p, lds, tid_, it & 3, it >> 2, 0, 1); }
    }
}
__device__ __forceinline__ void ph_peer_combine(const Params& p) {
    unsigned char* ws = p.ws;
    const int* seli = (const int*)(ws + WS_SELI); const float* selg = (const float*)(ws + WS_SELG); const float* rstd2 = (const float*)(ws + WS_RSTD2);
    const float2* uvsc = (const float2*)(ws + WS_USC);
    const float* pd = (const float*)(ws + WS_PD);
    unsigned* cpl = (unsigned*)(ws + WS_CBUF); float* csc = (float*)(ws + WS_CSC);
    const int tid_ = phase_tid(), lane = tid_ & 63, gwave = (blockIdx.x * blockDim.x + tid_) >> 6, nwave = (gridDim.x * blockDim.x) >> 6;
    for (int t = gwave; t < S; t += nwave) {
        float cf[2];
#pragma unroll
        for (int hf = 0; hf < 2; ++hf) {
            const int e = t * 128 + 64 * hf + lane;
            float d = 0.f;
#pragma unroll
            for (int g = 0; g < 4; ++g) d += pd[(size_t)g * S * 128 + e];
            const float2 sc2 = uvsc[seli[e]];
            cf[hf] = selg[e] * gelu_tanh(d * sc2.x * rstd2[t]) * sc2.y;
        }
        float m = fmaxf(fabsf(cf[0]), fabsf(cf[1]));
#pragma unroll
        for (int o = 1; o < 64; o <<= 1) m = fmaxf(m, __shfl_xor(m, o));
        const float inv = m > 0.f ? 119.0f / m : 0.f;
#pragma unroll
        for (int hf = 0; hf < 2; ++hf) {
            const int q = __float2int_rn(cf[hf] * inv);
            unsigned dl = (unsigned)(q & 15) << (4 * (lane & 7)), dh = (unsigned)(((q + 8) >> 4) & 15) << (4 * (lane & 7));
            dl |= __shfl_xor(dl, 1); dh |= __shfl_xor(dh, 1); dl |= __shfl_xor(dl, 2); dh |= __shfl_xor(dh, 2); dl |= __shfl_xor(dl, 4); dh |= __shfl_xor(dh, 4);
            if ((lane & 7) == 0) {
                const int dk = 8 * hf + (lane >> 3), rs = dk >> 1, half = dk & 1;
                cpl[(size_t)t * 32 + 4 * rs + half] = dl; cpl[(size_t)t * 32 + 4 * rs + 2 + half] = dh;
            }
        }
        if (lane == 0) csc[t] = m * (1.0f / 119.0f);
    }
}

#define LAS __attribute__((address_space(3)))
#define XB_TMO      128
#define XB_XCNT(j)  (256  + 64 * (j))
#define XB_XSUB(j)  (1280 + 64 * (j))
#define XB_XGEN(j)  (2304 + 64 * (j))
#define XB_TOP      3328
#define XB_TOPGEN   3392
#define XCD_BAR_WORDS 3456
#define XB_SPIN_CAP (1u << 18)
__device__ __forceinline__ unsigned xb_ld(unsigned* p)              { return __hip_atomic_load(p, __ATOMIC_RELAXED, __HIP_MEMORY_SCOPE_AGENT); }
__device__ __forceinline__ unsigned xb_add(unsigned* p, unsigned v) { return __hip_atomic_fetch_add(p, v, __ATOMIC_RELAXED, __HIP_MEMORY_SCOPE_AGENT); }
__device__ __forceinline__ unsigned xb_xcc_id() { return (unsigned)__builtin_amdgcn_s_getreg((3 << 11) | 20) & 0xFu; }
#define XB_SPIN(cond, bar) do { unsigned _sp = 0; while (cond) { __builtin_amdgcn_s_sleep(1); \
    if ((++_sp & 255u) == 0u) { if (xb_ld(&(bar)[XB_TMO])) break; if (_sp > XB_SPIN_CAP) { atomicAdd(&(bar)[XB_TMO], 1u); break; } } } } while (0)
struct XcdBarrier { unsigned* bar; unsigned x; volatile LAS unsigned* st; };
__device__ __forceinline__ XcdBarrier xcd_barrier_post(unsigned* bar, volatile LAS unsigned* st) {
    XcdBarrier b; b.bar = bar; b.x = xb_xcc_id(); b.st = st;
    if (threadIdx.x == 0) (void)xb_add(&bar[XB_XCNT(b.x)], 1u);
    return b;
}
__device__ __forceinline__ void xcd_barrier_complete(unsigned* bar, unsigned x, unsigned& nloc, unsigned& nx) {
    const unsigned G = gridDim.x * gridDim.y * gridDim.z;
    unsigned sum, cnt, mine, sp = 0u;
    for (;;) {
        sum = 0u; cnt = 0u; mine = 0u;
#pragma unroll
        for (unsigned j = 0; j < 16; ++j) { const unsigned c = xb_ld(&bar[XB_XCNT(j)]); sum += c; cnt += (c > 0u) ? 1u : 0u; mine = (j == x) ? c : mine; }
        if (sum == G) break;
        __builtin_amdgcn_s_sleep(1);
        if ((++sp & 255u) == 0u) { if (xb_ld(&bar[XB_TMO])) break; if (sp > XB_SPIN_CAP) { atomicAdd(&bar[XB_TMO], 1u); break; } }
    }
    nloc = mine > 0u ? mine : 1u; nx = cnt > 0u ? cnt : 1u;
}
__device__ __forceinline__ void xcd_barrier(const XcdBarrier& b) {
    asm volatile("s_waitcnt vmcnt(0)" ::: "memory");
    __syncthreads();
    if (threadIdx.x == 0) {
        unsigned* bar = b.bar;
        __builtin_amdgcn_s_waitcnt(0);
        unsigned nloc = b.st[0], nx = b.st[1];
        if (nloc == 0u) { xcd_barrier_complete(bar, b.x, nloc, nx); b.st[0] = nloc; b.st[1] = nx; }
        const unsigned old = xb_add(&bar[XB_XSUB(b.x)], 1u);
        const unsigned gen = old / nloc;
        if (old + 1u == (gen + 1u) * nloc) {
            __builtin_amdgcn_fence(__ATOMIC_RELEASE, "agent");
            asm volatile("s_waitcnt vmcnt(0)" ::: "memory");
            const unsigned og = xb_add(&bar[XB_TOP], 1u);
            const unsigned tg = og / nx;
            if (og + 1u == (tg + 1u) * nx) xb_add(&bar[XB_TOPGEN], 1u);
            else XB_SPIN(xb_ld(&bar[XB_TOPGEN]) == tg, bar);
            __builtin_amdgcn_fence(__ATOMIC_ACQUIRE, "agent");
            xb_add(&bar[XB_XGEN(b.x)], 1u);
            asm volatile("s_waitcnt vmcnt(0)" ::: "memory");
        } else {
            XB_SPIN(xb_ld(&bar[XB_XGEN(b.x)]) == gen, bar);
            __builtin_amdgcn_fence(__ATOMIC_ACQUIRE, "agent");
            asm volatile("s_waitcnt vmcnt(0)" ::: "memory");
        }
    }
    __syncthreads();
}

constexpr int LDS_MISC = 158720;
constexpr int LDS_BYTES = LDS_MISC + 1024;

__global__ void __launch_bounds__(NTHR, 2) hymba_fwd(Params p) {
    extern __shared__ __attribute__((aligned(16))) unsigned char lds[];
    volatile LAS unsigned* misc = (volatile LAS unsigned*)((LAS unsigned char*)lds + LDS_MISC);
    if (threadIdx.x < 4) misc[threadIdx.x] = 0u;
    __syncthreads();
    XcdBarrier bar = xcd_barrier_post((unsigned*)(p.ws + WS_CTL), misc);

    PG8_LAS unsigned char* ring = (PG8_LAS unsigned char*)lds;
    unsigned char* ws = p.ws;
    ph_prep(p, lds);                          xcd_barrier(bar);
    {
        pg8::Gemm g{(const bf16_t*)(ws + WS_A), (const bf16_t*)(ws + WS_WINT), S, NPROJ, D}; pg8::StaticOrder so; so.init(S, NPROJ, (int)gridDim.x, (int)blockIdx.x);
        EpiInProj E{(const float*)(ws + WS_RSTD1), p.in[I_Q_NORM], p.in[I_K_NORM], (bf16_t*)(ws + WS_QH), (bf16_t*)(ws + WS_KH), (bf16_t*)(ws + WS_VH), (bf16_t*)(ws + WS_XRG), (bf16_t*)(ws + WS_GG)};
        pg8::gemm_phase<EpiInProj, pg8::StaticOrder, true, true>(ring, g, so, E);
        const int G = (int)gridDim.x, nunits = (S / 256) * (NPROJ / 256), rem = nunits % G, b = (int)blockIdx.x;
        const int tid_ = phase_tid(), w = tid_ >> 6, lane = tid_ & 63;
        if (rem == 0) ph_tables(p, b * (NTHR / 64) + w, G * (NTHR / 64), lane);
        else if (b >= rem) ph_tables(p, (b - rem) * (NTHR / 64) + w, (G - rem) * (NTHR / 64), lane);
    }
    xcd_barrier(bar);
    ph_attn(p); ph_rg<0>(p, lds);             xcd_barrier(bar);
    ph_rg<1>(p, lds);                         xcd_barrier(bar);
    {
        pg8::Gemm g{(const bf16_t*)(ws + WS_MIX), (const bf16_t*)(ws + WS_WOUTT), S, D, D}; pg8::StaticOrder so; so.init(S, D, (int)gridDim.x, (int)blockIdx.x);
        EpiOutProj E{p.in[I_X], (bf16_t*)(ws + WS_A), (float*)(ws + WS_SSQ), ws + WS_X1Q, (float*)(ws + WS_XSC)};
        pg8::gemm_phase<EpiOutProj, pg8::StaticOrder, true, true>(ring, g, so, E);
    }
    xcd_barrier(bar);
    {
        pg8::Gemm g{(const bf16_t*)(ws + WS_A), (const bf16_t*)(ws + WS_WQT), S, NQ, D}; pg8::StaticOrder so; so.init(S, NQ, (int)gridDim.x, (int)blockIdx.x);
        EpiPeerQ E{(bf16_t*)(ws + WS_B)};
        pg8::gemm_phase<EpiPeerQ, pg8::StaticOrder, true, true>(ring, g, so, E);
    }
    asm volatile("s_waitcnt vmcnt(0)" ::: "memory"); __syncthreads();
    ph_topk(p, (int*)lds);                    xcd_barrier(bar);
    ph_peer<0>(p, lds);                       xcd_barrier(bar);
    ph_peer_combine(p);                       xcd_barrier(bar);
    ph_peer<1>(p, lds);
}

extern "C" void kernel_launch(void* const* d_in, const int* in_sizes, int n_in, void* d_out, int out_size, void* d_ws, size_t ws_size, hipStream_t stream) {
    static int grid = 0;
    if (grid == 0) {
        if (n_in != 20 || out_size != S * D || ws_size < WS_END) { fprintf(stderr, "kernel_launch: unexpected shapes (n_in %d out %d ws %zu)\n", n_in, out_size, ws_size); grid = -1; return; }
        int dev = 0, cus = 0, per_cu = 0;
        if (hipGetDevice(&dev) != hipSuccess || hipDeviceGetAttribute(&cus, hipDeviceAttributeMultiprocessorCount, dev) != hipSuccess) { grid = -1; return; }
        if (hipFuncSetAttribute((const void*)hymba_fwd, hipFuncAttributeMaxDynamicSharedMemorySize, LDS_BYTES) != hipSuccess) { fprintf(stderr, "kernel_launch: hipFuncSetAttribute failed\n"); grid = -1; return; }
        if (hipOccupancyMaxActiveBlocksPerMultiprocessor(&per_cu, (const void*)hymba_fwd, NTHR, LDS_BYTES) != hipSuccess || per_cu < 1) { fprintf(stderr, "kernel_launch: occupancy query says %d blocks per CU\n", per_cu); grid = -1; return; }
        (void)hipGetLastError();
        grid = cus;
    }
    if (grid < 0) return;
    (void)hipMemsetAsync((char*)d_ws + WS_CTL, 0, XCD_BAR_WORDS * 4, stream);
    Params p{};
    for (int i = 0; i < 20; ++i) p.in[i] = (const float*)d_in[i];
    p.out = (float*)d_out; p.ws = (unsigned char*)d_ws;
    hipLaunchKernelGGL(hymba_fwd, dim3(grid), dim3(NTHR), LDS_BYTES, stream, p);
}
```

```cpp
#include <hip/hip_runtime.h>
#include <cstdint>
#include <cstdio>

typedef unsigned short bf16_t;
typedef short bf16x8 __attribute__((ext_vector_type(8)));
typedef float f32x4 __attribute__((ext_vector_type(4)));
typedef unsigned u32x4 __attribute__((ext_vector_type(4)));
typedef float f32x16 __attribute__((ext_vector_type(16)));

constexpr int S = 16384, D = 1024, NPROJ = 2560, DSB = 512, DRG = 512, NH = 8, HD = 64;
constexpr int PH = 8, PNK = 128, PDK = 256, PHALF = 128, PTOPK = 16, NEXP = 16384, NQ = PH * PDK;
constexpr int CHUNK = 64, NCHUNK = S / CHUNK;
constexpr float EPS = 1e-6f;
constexpr float LOG2E = 1.4426950408889634f;
constexpr float QSCALE = 0.125f * LOG2E;
constexpr int NTHR = 512;
constexpr float CARRY_STOP = -160.0f;

constexpr size_t MiB = 1u << 20;
constexpr size_t WS_CTL = 0;
constexpr size_t WS_WINT = 1 * MiB;
constexpr size_t WS_WOUTT = 6 * MiB;
constexpr size_t WS_WQT = 8 * MiB;
constexpr size_t WS_SUBK = 12 * MiB;
constexpr size_t WS_RSTD1 = 12 * MiB + 512 * 1024;
constexpr size_t WS_RSTD2 = WS_RSTD1 + 64 * 1024;
constexpr size_t WS_RGP = WS_RSTD2 + 64 * 1024;
constexpr size_t WS_RGH = WS_RGP + 512 * 1024;
constexpr size_t WS_RGSA = 14 * MiB, WS_RGSB = 30 * MiB;
constexpr size_t WS_A = 14 * MiB;
constexpr size_t WS_B = 46 * MiB;
constexpr size_t WS_QH = WS_B, WS_KH = WS_B + 16 * MiB, WS_VH = WS_B + 32 * MiB, WS_XRG = WS_B + 48 * MiB;
constexpr size_t WS_GG = 110 * MiB;
constexpr size_t WS_OSB = 126 * MiB;
constexpr size_t WS_MIX = 142 * MiB;
constexpr size_t WS_SELI = WS_MIX, WS_SELG = WS_MIX + 8 * MiB;
constexpr size_t WS_PD = WS_B;
constexpr size_t WS_CBUF = WS_GG;
constexpr size_t WS_CSC = WS_GG + 4 * MiB;
constexpr size_t WS_X1Q = WS_OSB;
constexpr size_t WS_XSC = WS_GG + 8 * MiB;
constexpr size_t WS_UB = 174 * MiB;
constexpr size_t WS_VB = 190 * MiB;
constexpr size_t WS_USC = 206 * MiB;
constexpr size_t WS_SSQ = 238 * MiB;
constexpr size_t WS_RGW = 239 * MiB;
constexpr size_t WS_END = 240 * MiB;

__device__ __forceinline__ unsigned f2bf(float f) { unsigned u = __builtin_bit_cast(unsigned, f); return (u + 0x7fffu + ((u >> 16) & 1u)) >> 16; }
__device__ __forceinline__ float u2f(unsigned u) { return __builtin_bit_cast(float, u); }
__device__ __forceinline__ float bf2f(unsigned h) { return __builtin_bit_cast(float, h << 16); }
__device__ __forceinline__ unsigned pk2(float lo, float hi) { return f2bf(lo) | (f2bf(hi) << 16); }
__device__ __forceinline__ unsigned pack_i8(float a, float b, float c, float d) {
    const int qa = __float2int_rn(a), qb = __float2int_rn(b), qc = __float2int_rn(c), qd = __float2int_rn(d);
    return (unsigned)(qa & 255) | ((unsigned)(qb & 255) << 8) | ((unsigned)(qc & 255) << 16) | ((unsigned)qd << 24);
}
__device__ __forceinline__ unsigned pack_n4(float a, float b, float c, float d) {
    const int qa = min(max(__float2int_rn(a), -7), 7) & 15, qb = min(max(__float2int_rn(b), -7), 7) & 15, qc = min(max(__float2int_rn(c), -7), 7) & 15, qd = min(max(__float2int_rn(d), -7), 7) & 15;
    return (unsigned)qa | ((unsigned)qb << 4) | ((unsigned)qc << 8) | ((unsigned)qd << 12);
}
template <int OFFS>
__device__ __forceinline__ unsigned pack_u4(float a, float b, float c, float d) {
    const int qa = (min(max(__float2int_rn(a), -7), 7) + OFFS) & 15, qb = (min(max(__float2int_rn(b), -7), 7) + OFFS) & 15, qc = (min(max(__float2int_rn(c), -7), 7) + OFFS) & 15, qd = (min(max(__float2int_rn(d), -7), 7) + OFFS) & 15;
    return (unsigned)qa | ((unsigned)qb << 8) | ((unsigned)qc << 16) | ((unsigned)qd << 24);
}
__device__ __forceinline__ float wave_sum(float v) {
#pragma unroll
    for (int o = 1; o < 64; o <<= 1) v += __shfl_xor(v, o);
    return v;
}
__device__ __forceinline__ float gelu_tanh(float x) {
    const float u = 0.7978845608028654f * (x + 0.044715f * x * x * x);
    const float e = __expf(2.0f * u);
    const float th = 1.0f - 2.0f / (e + 1.0f);
    return 0.5f * x * (1.0f + th);
}

__host__ __device__ __forceinline__ int inproj_phys_row(int nlog) { const int t = nlog >> 8, L = nlog & 255; return (t << 8) + 128 * ((L & 63) >> 5) + 32 * (L >> 6) + (L & 31); }

__device__ __forceinline__ int phase_tid() { int t = threadIdx.x; asm volatile("" : "+v"(t)); return t; }

struct Params {
    const float* in[20];
    float* out;
    unsigned char* ws;
};
enum { I_X = 0, I_NORM_MIX, I_W_IN, I_Q_NORM, I_K_NORM, I_CONV_W, I_CONV_B, I_RG_W_A, I_RG_B_A, I_RG_W_X, I_RG_B_X, I_RG_LAMBDA,
       I_OUT_NORM_SB, I_OUT_NORM_RG, I_W_OUT, I_NORM_FFN, I_PEER_WQ, I_PEER_SUBK, I_PEER_U, I_PEER_V };

template <bool INPROJ_PERM>
__device__ __forceinline__ void prep_transpose_item(const float* W, const float* gain0, const float* gain1, int K, int N, bf16_t* WT, float* scr, int item, int lane) {
    const int nblk = N / 32, kb = item / nblk, nb = item % nblk, k0 = 64 * kb, n0 = 32 * nb;
#pragma unroll 8
    for (int i = 0; i < 32; ++i) {
        const int kk = 2 * i + (lane >> 5), k = k0 + kk;
        const float g = (gain1 && k >= 512) ? gain1[k - 512] : gain0[k];
        scr[kk * 33 + (lane & 31)] = g * W[(size_t)k * N + n0 + (lane & 31)];
    }
    asm volatile("s_waitcnt lgkmcnt(0)" ::: "memory");
    const int c = lane & 7;
#pragma unroll
    for (int j = 0; j < 4; ++j) {
        const int n = (lane >> 3) + 8 * j; const float* s = scr + (8 * c) * 33 + n;
        u32x4 o; o.x = pk2(s[0 * 33], s[1 * 33]); o.y = pk2(s[2 * 33], s[3 * 33]); o.z = pk2(s[4 * 33], s[5 * 33]); o.w = pk2(s[6 * 33], s[7 * 33]);
        const int nr = INPROJ_PERM ? inproj_phys_row(n0 + n) : n0 + n;
        *(u32x4*)(WT + (size_t)nr * K + k0 + 8 * c) = o;
    }
    asm volatile("s_waitcnt lgkmcnt(0)" ::: "memory");
}
__device__ __forceinline__ void ph_tables(const Params& p, int cw, int ncw, int lane) {
    unsigned char* ws = p.ws;
    {
        const float* u = p.in[I_PEER_U]; const float* v = p.in[I_PEER_V]; const float* g = p.in[I_NORM_FFN];
        unsigned* ub = (unsigned*)(ws + WS_UB); unsigned* vb = (unsigned*)(ws + WS_VB); float2* uvsc = (float2*)(ws + WS_USC);
        f32x4 gq[4];
#pragma unroll
        for (int j = 0; j < 4; ++j) gq[j] = *((const f32x4*)g + lane + 64 * j);
        for (int e0 = cw; e0 < NEXP; e0 += 2 * ncw) {
            f32x4 a[2][4], b[2][4]; float ma[2], mb[2], sa2[2], sb2[2];
#pragma unroll
            for (int rr = 0; rr < 2; ++rr) {
                const int e = min(e0 + rr * ncw, NEXP - 1);
#pragma unroll
                for (int j = 0; j < 4; ++j) { a[rr][j] = *((const f32x4*)(u + (size_t)e * D) + lane + 64 * j); b[rr][j] = *((const f32x4*)(v + (size_t)e * D) + lane + 64 * j); }
            }
#pragma unroll
            for (int rr = 0; rr < 2; ++rr) {
                ma[rr] = 0.f; mb[rr] = 0.f; sa2[rr] = 0.f; sb2[rr] = 0.f;
#pragma unroll
                for (int j = 0; j < 4; ++j) {
                    a[rr][j] = a[rr][j] * gq[j];
                    const f32x4 aa = a[rr][j], bb = b[rr][j];
                    ma[rr] = fmaxf(ma[rr], fmaxf(fmaxf(fabsf(aa.x), fabsf(aa.y)), fmaxf(fabsf(aa.z), fabsf(aa.w))));
                    mb[rr] = fmaxf(mb[rr], fmaxf(fmaxf(fabsf(bb.x), fabsf(bb.y)), fmaxf(fabsf(bb.z), fabsf(bb.w))));
                    sa2[rr] += (aa.x * aa.x + aa.y * aa.y) + (aa.z * aa.z + aa.w * aa.w);
                    sb2[rr] += (bb.x * bb.x + bb.y * bb.y) + (bb.z * bb.z + bb.w * bb.w);
                }
            }
#pragma unroll
            for (int o = 1; o < 64; o <<= 1)
#pragma unroll
                for (int rr = 0; rr < 2; ++rr) { ma[rr] = fmaxf(ma[rr], __shfl_xor(ma[rr], o)); mb[rr] = fmaxf(mb[rr], __shfl_xor(mb[rr], o)); sa2[rr] += __shfl_xor(sa2[rr], o); sb2[rr] += __shfl_xor(sb2[rr], o); }
#pragma unroll
            for (int rr = 0; rr < 2; ++rr) {
                const int e = e0 + rr * ncw;
                if (e < NEXP) {
                    const float ca = fminf(ma[rr], 2.5f * sqrtf(sa2[rr] * (1.0f / D))), cb = fminf(mb[rr], 2.5f * sqrtf(sb2[rr] * (1.0f / D)));
                    const float ia = ca > 0.f ? 7.0f / ca : 0.f, ib = cb > 0.f ? 7.0f / cb : 0.f;
#pragma unroll
                    for (int j = 0; j < 4; ++j) {
                        const f32x4 aa = a[rr][j], bb = b[rr][j];
                        const unsigned na = pack_u4<0>(aa.x * ia, aa.y * ia, aa.z * ia, aa.w * ia), nb = pack_n4(bb.x * ib, bb.y * ib, bb.z * ib, bb.w * ib);
                        const unsigned pa = __shfl_xor(na, 1), pb = __shfl_xor(nb, 1);
                        if ((lane & 1) == 0) {
                            ub[((size_t)j * NEXP + e) * 32 + (lane >> 1)] = na | (pa << 4);
                            vb[((size_t)j * NEXP + e) * 32 + (lane >> 1)] = nb | (pb << 16);
                        }
                    }
                    if (lane == 0) uvsc[e] = make_float2(ca * (1.0f / 7.0f), cb * (1.0f / 7.0f));
                }
            }
        }
    }
}

__device__ __forceinline__ void ph_prep(const Params& p, unsigned char* lds) {
    const int tid_ = phase_tid();
    const int gtid = blockIdx.x * blockDim.x + tid_, gsize = gridDim.x * blockDim.x;
    const int lane = tid_ & 63, gwave = gtid >> 6, nwave = gsize >> 6;
    unsigned char* ws = p.ws;
    {
        float* scr = (float*)lds + (tid_ >> 6) * (64 * 33);
        constexpr int I_IN = (D / 64) * (NPROJ / 32), I_OUT = (D / 64) * (D / 32), I_Q = (D / 64) * (NQ / 32);
        for (int it = gwave; it < I_IN + I_OUT + I_Q; it += nwave) {
            if (it < I_IN) prep_transpose_item<true>(p.in[I_W_IN], p.in[I_NORM_MIX], nullptr, D, NPROJ, (bf16_t*)(ws + WS_WINT), scr, it, lane);
            else if (it < I_IN + I_OUT) prep_transpose_item<false>(p.in[I_W_OUT], p.in[I_OUT_NORM_SB], p.in[I_OUT_NORM_RG], D, D, (bf16_t*)(ws + WS_WOUTT), scr, it - I_IN, lane);
            else prep_transpose_item<false>(p.in[I_PEER_WQ], p.in[I_NORM_FFN], nullptr, D, NQ, (bf16_t*)(ws + WS_WQT), scr, it - I_IN - I_OUT, lane);
        }
    }
    {
        const float* wa = p.in[I_RG_W_A]; const float* wx = p.in[I_RG_W_X]; bf16_t* o = (bf16_t*)(ws + WS_RGW);
        for (int e = gtid; e < 8 * 2 * 2 * 4 * 64 * 8; e += gsize) {
            const int el = e & 7, ln = (e >> 3) & 63, s = (e >> 9) & 3, jt = (e >> 11) & 1, g = (e >> 12) & 1, n = e >> 13;
            const int j = 32 * jt + (ln & 31), i = 16 * s + 8 * (el >> 2) + 4 * (ln >> 5) + (el & 3);
            o[e] = (bf16_t)f2bf((g == 0 ? wa : wx)[((size_t)n * 64 + i) * 64 + j]);
        }
    }
    {
        const float* sk = p.in[I_PEER_SUBK]; bf16_t* o = (bf16_t*)(ws + WS_SUBK);
        for (int e = gtid; e < PH * 2 * PNK * PHALF; e += gsize) o[e] = (bf16_t)f2bf(sk[e]);
    }
    {
        const float* x = p.in[I_X]; bf16_t* xb = (bf16_t*)(ws + WS_A); float* rstd1 = (float*)(ws + WS_RSTD1);
        for (int row0 = gwave; row0 < S; row0 += 4 * nwave) {
            f32x4 v[4][4];
#pragma unroll
            for (int rr = 0; rr < 4; ++rr) {
                const int row = min(row0 + rr * nwave, S - 1);
#pragma unroll
                for (int j = 0; j < 4; ++j) v[rr][j] = ((const f32x4*)(x + (size_t)row * D) + lane)[64 * j];
            }
#pragma unroll
            for (int rr = 0; rr < 4; ++rr) {
                const int row = row0 + rr * nwave;
                float ss = 0.f;
#pragma unroll
                for (int j = 0; j < 4; ++j) ss += (v[rr][j].x * v[rr][j].x + v[rr][j].y * v[rr][j].y) + (v[rr][j].z * v[rr][j].z + v[rr][j].w * v[rr][j].w);
                ss = wave_sum(ss);
                if (row < S) {
                    uint2* o = (uint2*)(xb + (size_t)row * D) + lane;
#pragma unroll
                    for (int j = 0; j < 4; ++j) o[64 * j] = make_uint2(pk2(v[rr][j].x, v[rr][j].y), pk2(v[rr][j].z, v[rr][j].w));
                    if (lane == 0) rstd1[row] = rsqrtf(ss * (1.0f / D) + EPS);
                }
            }
        }
    }
}

namespace pg8 {
#define PG8_LAS __attribute__((address_space(3)))
typedef unsigned short bf16_t;
typedef short bf16x8 __attribute__((ext_vector_type(8)));
typedef float f32x4 __attribute__((ext_vector_type(4)));
typedef unsigned u32x4 __attribute__((ext_vector_type(4)));
constexpr int BM = 256, BK = 64, HALF = 128, HTB = HALF * BK * 2  , STAGE_BYTES = 8 * HTB, NXCD = 8, WGM = 8;

__host__ __device__ __forceinline__ int lds_byte(int r, int c) { const int st = (r >> 4) * 2 + (c >> 5), rr = r & 15, cc = c & 31, ob = rr * 64 + cc * 2; return st * 1024 + (ob ^ (((ob >> 9) & 1) << 5)); }
__host__ __device__ __forceinline__ void stage_rc(int b, int& R, int& C) { const int st = b / 1024, sb = b % 1024, swz = sb ^ (((sb >> 9) & 1) << 5); R = (st >> 1) * 16 + swz / 64; C = (st & 1) * 32 + (swz % 64) / 2; }
__host__ __device__ __forceinline__ int perm32(int rho) { const int n = rho >> 4, i = rho & 15; return 8 * (i >> 2) + 4 * n + (i & 3); }

struct Unit { int pm, pn; };
struct Gemm { const bf16_t* A; const bf16_t* Bt; int M, N, K; };

struct StaticOrder {
    int nM, nN, nwg, G, c;
    __host__ __device__ void init(int M, int N, int G_, int c_) { nM = M / BM; nN = N / BM; nwg = nM * nN; G = G_; c = c_; }
    __host__ __device__ bool next(int i, Unit& u) const {
        const long L = (long)i * G + c; if (L >= nwg) return false;
        int wgid = (int)L; { const int q = nwg / NXCD, r = nwg % NXCD, xcd = wgid % NXCD, off = wgid / NXCD; wgid = (xcd < r ? xcd * (q + 1) : r * (q + 1) + (xcd - r) * q) + off; }
        const int nig = WGM * nN, gid = wgid / nig, fm = gid * WGM, gsz = (nM - fm) < WGM ? (nM - fm) : WGM;
        u.pm = fm + ((wgid % nig) % gsz); u.pn = (wgid % nig) / gsz; return true;
    }
    __device__ __forceinline__ void a_ready(const Unit&) const {}
    __device__ __forceinline__ void done(const Unit&) const {}
};

__device__ __forceinline__ unsigned cvt_pk_bf16(float lo, float hi) { unsigned r; asm volatile("v_cvt_pk_bf16_f32 %0, %1, %2" : "=v"(r) : "v"(lo), "v"(hi)); return r; }
template <class Epi, class Sched, bool ALIGN_EPI = false, bool SP2 = false>
__device__ __forceinline__ void gemm_phase(PG8_LAS unsigned char* lds, const Gemm g, const Sched& S, const Epi& E) {
    const int tid = phase_tid(), wid = __builtin_amdgcn_readfirstlane(tid >> 6), lane = tid & 63, wr = wid >> 2, wc = wid & 3, fr = lane & 15, fq = lane >> 4;
    const int K = g.K, nt = K / BK;
    unsigned voffA[2], voffB[2];
#pragma unroll
    for (int i = 0; i < 2; ++i) { int R, C; stage_rc(tid * 16 + i * 8192, R, C); const int Rb = Epi::PERM ? ((R & ~31) + perm32(R & 31)) : R;
        voffA[i] = (unsigned)(R * K + C) * 2u; voffB[i] = (unsigned)(Rb * K + C) * 2u; }
    const size_t kstep = (size_t)(BK * 2);
    const size_t hstep = (size_t)HALF * K * 2;
    const size_t tstep = 2 * hstep;
    const unsigned ldsw = (unsigned)wid * 1024u;
    const int aoff = lds_byte(wr * 64 + fr, fq * 8), boff = lds_byte(wc * 32 + fr, fq * 8);
#define PG8_SA(b, h) (((b) * 2 + (h)) * HTB)
#define PG8_SB(b, h) ((4 + (b) * 2 + (h)) * HTB)
#define PG8_STAGE(bufoff, gbase, voff) do { _Pragma("unroll") for (int _i = 0; _i < 2; ++_i) \
        __builtin_amdgcn_global_load_lds((const unsigned*)((const char*)(gbase) + (voff)[_i]), (PG8_LAS unsigned*)(lds + (bufoff) + ldsw + _i * 8192), 16, 0, 0); } while (0)
#define PG8_LDA(dst, b, h) do { _Pragma("unroll") for (int m = 0; m < 4; ++m) _Pragma("unroll") for (int k = 0; k < 2; ++k) dst[m][k] = *(const PG8_LAS bf16x8*)(lds + PG8_SA(b, h) + aoff + m * 2048 + k * 1024); } while (0)
#define PG8_LDB(dst, b, h) do { _Pragma("unroll") for (int n = 0; n < 2; ++n) _Pragma("unroll") for (int k = 0; k < 2; ++k) dst[n][k] = *(const PG8_LAS bf16x8*)(lds + PG8_SB(b, h) + boff + n * 2048 + k * 1024); } while (0)
#define PG8_MMA(ai, bj, At, Bt) do { __builtin_amdgcn_s_setprio(1); _Pragma("unroll") for (int m = 0; m < 4; ++m) _Pragma("unroll") for (int n = 0; n < 2; ++n) _Pragma("unroll") for (int k = 0; k < 2; ++k) \
        acc[ai][bj][m][n] = __builtin_amdgcn_mfma_f32_16x16x32_bf16(Bt[n][k], At[m][k], acc[ai][bj][m][n], 0, 0, 0); __builtin_amdgcn_s_setprio(0); } while (0)
#define PG8_WAIT_V(n) asm volatile("s_waitcnt vmcnt(" #n ")" ::: "memory")
#define PG8_WAIT_L(n) asm volatile("s_waitcnt lgkmcnt(" #n ")" ::: "memory")
#define PG8_BAR __builtin_amdgcn_s_barrier()
#define PG8_SCHED __builtin_amdgcn_sched_barrier(0)
    Unit cur, nxt; int ui = 0;
    if (!S.next(0, cur)) return;
    f32x4 acc[2][2][4][2];
#pragma unroll
    for (int a = 0; a < 2; ++a)
#pragma unroll
        for (int b = 0; b < 2; ++b)
#pragma unroll
            for (int m = 0; m < 4; ++m)
#pragma unroll
                for (int n = 0; n < 2; ++n) acc[a][b][m][n] = (f32x4){0.f, 0.f, 0.f, 0.f};
    bf16x8 At[4][2], B0[2][2], B1[2][2];
    const char* cA = (const char*)g.A + (size_t)cur.pm * tstep; const char* cB = (const char*)g.Bt + (size_t)cur.pn * tstep;
    S.a_ready(cur);
    if constexpr (SP2) {
        PG8_STAGE(PG8_SB(0, 0), cB, voffB); PG8_STAGE(PG8_SB(0, 1), cB + hstep, voffB); PG8_STAGE(PG8_SA(0, 0), cA, voffA); PG8_STAGE(PG8_SA(0, 1), cA + hstep, voffA);
        if (wr == 1) PG8_BAR;
        PG8_WAIT_V(2); PG8_BAR;
        PG8_STAGE(PG8_SB(1, 0), cB + kstep, voffB); PG8_STAGE(PG8_SA(1, 0), cA + kstep, voffA); PG8_STAGE(PG8_SB(1, 1), cB + hstep + kstep, voffB);
        PG8_WAIT_V(6); PG8_BAR;
    } else {
        PG8_STAGE(PG8_SB(0, 0), cB, voffB); PG8_STAGE(PG8_SA(0, 0), cA, voffA); PG8_STAGE(PG8_SB(0, 1), cB + hstep, voffB); PG8_STAGE(PG8_SA(0, 1), cA + hstep, voffA);
        if (wr == 1) PG8_BAR;
        PG8_WAIT_V(4); PG8_BAR;
        PG8_STAGE(PG8_SB(1, 0), cB + kstep, voffB); PG8_STAGE(PG8_SA(1, 0), cA + kstep, voffA); PG8_STAGE(PG8_SB(1, 1), cB + hstep + kstep, voffB);
        PG8_WAIT_V(6); PG8_BAR;
    }
    for (;;) {
        const bool has_next = S.next(ui + 1, nxt);
        const char* nA = has_next ? (const char*)g.A + (size_t)nxt.pm * tstep : cA; const char* nB = has_next ? (const char*)g.Bt + (size_t)nxt.pn * tstep : cB;
        for (int t = 0; t < nt; t += 2) {
            const bool last = (t == nt - 2);
            const char* a1 = cA + (size_t)(t + 1) * kstep;
            const char* a2 = last ? nA : cA + (size_t)(t + 2) * kstep; const char* b2 = last ? nB : cB + (size_t)(t + 2) * kstep;
            const char* a3 = a2 + kstep; const char* b3 = b2 + kstep;
            if (last && has_next) S.a_ready(nxt);
            if constexpr (SP2) {
            PG8_LDB(B0, 0, 0); PG8_LDB(B1, 0, 1); PG8_SCHED; PG8_LDA(At, 0, 0); PG8_STAGE(PG8_SA(1, 1), a1 + hstep, voffA);
            PG8_WAIT_V(8); PG8_WAIT_L(0); PG8_BAR; PG8_MMA(0, 0, At, B0); PG8_MMA(0, 1, At, B1); PG8_BAR; PG8_SCHED;
            PG8_LDA(At, 0, 1); PG8_STAGE(PG8_SB(0, 0), b2, voffB); PG8_STAGE(PG8_SB(0, 1), b2 + hstep, voffB); PG8_STAGE(PG8_SA(0, 0), a2, voffA);
            PG8_WAIT_V(8); PG8_WAIT_L(0); PG8_BAR; PG8_MMA(1, 0, At, B0); PG8_MMA(1, 1, At, B1); PG8_BAR; PG8_SCHED;
            PG8_LDB(B0, 1, 0); PG8_LDB(B1, 1, 1); PG8_SCHED; PG8_LDA(At, 1, 0); PG8_STAGE(PG8_SA(0, 1), a2 + hstep, voffA);
            PG8_WAIT_V(8); PG8_WAIT_L(0); PG8_BAR; PG8_MMA(0, 0, At, B0); PG8_MMA(0, 1, At, B1); PG8_BAR; PG8_SCHED;
            PG8_LDA(At, 1, 1); PG8_STAGE(PG8_SB(1, 0), b3, voffB); PG8_STAGE(PG8_SB(1, 1), b3 + hstep, voffB); PG8_STAGE(PG8_SA(1, 0), a3, voffA);
            PG8_WAIT_V(8); PG8_WAIT_L(0); PG8_BAR; PG8_MMA(1, 0, At, B0); PG8_MMA(1, 1, At, B1); PG8_BAR; PG8_SCHED;
            } else {
            PG8_LDB(B0, 0, 0); PG8_SCHED; PG8_LDA(At, 0, 0); PG8_STAGE(PG8_SA(1, 1), a1 + hstep, voffA);
            PG8_WAIT_L(8); PG8_BAR; PG8_WAIT_L(0); PG8_MMA(0, 0, At, B0); PG8_BAR; PG8_SCHED;
            PG8_LDB(B1, 0, 1); PG8_STAGE(PG8_SB(0, 0), b2, voffB);
            PG8_BAR; PG8_WAIT_L(0); PG8_MMA(0, 1, At, B1); PG8_BAR;
            PG8_LDA(At, 0, 1); PG8_STAGE(PG8_SA(0, 0), a2, voffA);
            PG8_BAR; PG8_WAIT_L(0); PG8_MMA(1, 0, At, B0); PG8_BAR; PG8_SCHED;
            PG8_STAGE(PG8_SB(0, 1), b2 + hstep, voffB);
            PG8_WAIT_V(6); PG8_BAR; PG8_MMA(1, 1, At, B1); PG8_BAR;
            PG8_LDB(B0, 1, 0); PG8_SCHED; PG8_LDA(At, 1, 0); PG8_STAGE(PG8_SA(0, 1), a2 + hstep, voffA);
            PG8_WAIT_L(8); PG8_BAR; PG8_WAIT_L(0); PG8_MMA(0, 0, At, B0); PG8_BAR; PG8_SCHED;
            PG8_LDB(B1, 1, 1); PG8_STAGE(PG8_SB(1, 0), b3, voffB);
            PG8_BAR; PG8_WAIT_L(0); PG8_MMA(0, 1, At, B1); PG8_BAR;
            PG8_LDA(At, 1, 1); PG8_STAGE(PG8_SA(1, 0), a3, voffA);
            PG8_BAR; PG8_WAIT_L(0); PG8_MMA(1, 0, At, B0); PG8_BAR; PG8_SCHED;
            PG8_STAGE(PG8_SB(1, 1), b3 + hstep, voffB);
            PG8_WAIT_V(6); PG8_BAR; PG8_MMA(1, 1, At, B1); PG8_BAR;
            }
        }
        if constexpr (ALIGN_EPI) { if (wr == 0) PG8_BAR; }
        if constexpr (!Epi::AFTER_DRAIN) { E(acc, cur, wr, wc, fr, fq); S.done(cur); }
        if (!has_next) break;
#pragma unroll
        for (int a = 0; a < 2; ++a)
#pragma unroll
            for (int b = 0; b < 2; ++b)
#pragma unroll
                for (int m = 0; m < 4; ++m)
#pragma unroll
                    for (int n = 0; n < 2; ++n) acc[a][b][m][n] = (f32x4){0.f, 0.f, 0.f, 0.f};
        cur = nxt; cA = nA; cB = nB; ++ui;
        if constexpr (ALIGN_EPI) { if (wr == 1) PG8_BAR; }
    }
    PG8_WAIT_V(0);
    if constexpr (!ALIGN_EPI) { if (wr == 0) PG8_BAR; }
    PG8_BAR;
    if constexpr (Epi::AFTER_DRAIN) { E.fused(acc, cur, wr, wc, fr, fq, lds, wid, lane); S.done(cur); }
#undef PG8_SA
#undef PG8_SB
#undef PG8_STAGE
#undef PG8_LDA
#undef PG8_LDB
#undef PG8_MMA
#undef PG8_WAIT_V
#undef PG8_WAIT_L
#undef PG8_BAR
#undef PG8_SCHED
}
}

struct EpiInProj {
    static constexpr bool PERM = true, AFTER_DRAIN = false;
    const float* rstd1; const float* qn; const float* kn; bf16_t *qh, *kh, *vh, *xrg, *gg;
    __device__ __forceinline__ void operator()(const pg8::f32x4 (&acc)[2][2][4][2], const pg8::Unit& u, int wr, int wc, int fr, int fq) const {
        const int region = u.pn >> 1;
        const int head = (u.pn & 1) * 4 + wc;
        float rsv[2][4];
#pragma unroll
        for (int ai = 0; ai < 2; ++ai)
#pragma unroll
            for (int m = 0; m < 4; ++m) rsv[ai][m] = rstd1[u.pm * 256 + ai * 128 + wr * 64 + m * 16 + fr];
        pg8::f32x4 gn[2][2];
        if (region <= 1) {
            const float* g = region == 0 ? qn : kn; const float sc = region == 0 ? QSCALE : 1.0f;
#pragma unroll
            for (int bj = 0; bj < 2; ++bj)
#pragma unroll
                for (int n = 0; n < 2; ++n) gn[bj][n] = *(const pg8::f32x4*)(g + 32 * bj + 8 * fq + 4 * n) * sc;
        }
#pragma unroll
        for (int ai = 0; ai < 2; ++ai)
#pragma unroll
            for (int m = 0; m < 4; ++m) {
                const int row = u.pm * 256 + ai * 128 + wr * 64 + m * 16 + fr;
                const float rs = rsv[ai][m];
                pg8::f32x4 v[2][2];
#pragma unroll
                for (int bj = 0; bj < 2; ++bj)
#pragma unroll
                    for (int n = 0; n < 2; ++n) v[bj][n] = acc[ai][bj][m][n] * rs;
                bf16_t* dst;
                if (region <= 1) {
                    float ss = 0.f;
#pragma unroll
                    for (int bj = 0; bj < 2; ++bj)
#pragma unroll
                        for (int n = 0; n < 2; ++n) ss += (v[bj][n][0] * v[bj][n][0] + v[bj][n][1] * v[bj][n][1]) + (v[bj][n][2] * v[bj][n][2] + v[bj][n][3] * v[bj][n][3]);
                    ss += __shfl_xor(ss, 16); ss += __shfl_xor(ss, 32);
                    const float rn = rsqrtf(ss * (1.0f / HD) + EPS);
#pragma unroll
                    for (int bj = 0; bj < 2; ++bj)
#pragma unroll
                        for (int n = 0; n < 2; ++n) v[bj][n] = v[bj][n] * rn * gn[bj][n];
                    bf16_t* fb = (region == 0 ? qh : kh) + ((size_t)(head * (S / 32) + (row >> 5)) * 4 * 64 + (row & 31)) * 8;
#pragma unroll
                    for (int bj = 0; bj < 2; ++bj) {
                        pg8::u32x4 w; w.x = pg8::cvt_pk_bf16(v[bj][0][0], v[bj][0][1]); w.y = pg8::cvt_pk_bf16(v[bj][0][2], v[bj][0][3]);
                        w.z = pg8::cvt_pk_bf16(v[bj][1][0], v[bj][1][1]); w.w = pg8::cvt_pk_bf16(v[bj][1][2], v[bj][1][3]);
                        *(pg8::u32x4*)(fb + ((2 * bj + (fq >> 1)) * 64 + 32 * (fq & 1)) * 8) = w;
                    }
                    continue;
                } else if (region == 2) {
#pragma unroll
                    for (int bj = 0; bj < 2; ++bj)
#pragma unroll
                        for (int n = 0; n < 2; ++n)
#pragma unroll
                            for (int i = 0; i < 4; ++i) {
                                const int d = 32 * bj + 8 * fq + 4 * n + i, kl = row & 31;
                                vh[(((((size_t)head * (S / 32) + (row >> 5)) * 2 + (d >> 5)) * 2 + (kl >> 4)) * 64 + (d & 31) + 32 * ((kl >> 2) & 1)) * 8 + 4 * ((kl >> 3) & 1) + (kl & 3)] = (bf16_t)f2bf(v[bj][n][i]);
                            }
                    continue;
                } else if (region == 3) {
                    dst = xrg + (size_t)row * DRG + head * 64;
                } else {
#pragma unroll
                    for (int bj = 0; bj < 2; ++bj)
#pragma unroll
                        for (int n = 0; n < 2; ++n)
#pragma unroll
                            for (int i = 0; i < 4; ++i) v[bj][n][i] = gelu_tanh(v[bj][n][i]);
#pragma unroll
                    for (int bj = 0; bj < 2; ++bj)
#pragma unroll
                        for (int n = 0; n < 2; ++n)
                            *(uint2*)(gg + ((((size_t)(row >> 5) * 8 + head) * 8 + (4 * bj + fq)) * 64 + (row & 31) + 32 * n) * 4) = make_uint2(pg8::cvt_pk_bf16(v[bj][n][0], v[bj][n][1]), pg8::cvt_pk_bf16(v[bj][n][2], v[bj][n][3]));
                    continue;
                }
#pragma unroll
                for (int bj = 0; bj < 2; ++bj) {
                    pg8::u32x4 w; w.x = pg8::cvt_pk_bf16(v[bj][0][0], v[bj][0][1]); w.y = pg8::cvt_pk_bf16(v[bj][0][2], v[bj][0][3]);
                    w.z = pg8::cvt_pk_bf16(v[bj][1][0], v[bj][1][1]); w.w = pg8::cvt_pk_bf16(v[bj][1][2], v[bj][1][3]);
                    *(pg8::u32x4*)(dst + 32 * bj + 8 * fq) = w;
                }
            }
    }
};
struct EpiOutProj {
    static constexpr bool PERM = true, AFTER_DRAIN = false;
    const float* x; bf16_t* x1b; float* ssq; unsigned char* x1q; float* xsc;
    __device__ __forceinline__ void operator()(const pg8::f32x4 (&acc)[2][2][4][2], const pg8::Unit& u, int wr, int wc, int fr, int fq) const {
        pg8::f32x4 xv[2][2][2][2];
#define OUTPROJ_LD(buf, ai_, mh_) do { _Pragma("unroll") for (int mm_ = 0; mm_ < 2; ++mm_) _Pragma("unroll") for (int bj_ = 0; bj_ < 2; ++bj_) { \
            const size_t o_ = (size_t)(u.pm * 256 + (ai_) * 128 + wr * 64 + (2 * (mh_) + mm_) * 16 + fr) * D + u.pn * 256 + bj_ * 128 + wc * 32 + 8 * fq; \
            xv[buf][mm_][bj_][0] = *(const pg8::f32x4*)(x + o_); xv[buf][mm_][bj_][1] = *(const pg8::f32x4*)(x + o_ + 4); } } while (0)
        OUTPROJ_LD(0, 0, 0);
#pragma unroll
        for (int ai = 0; ai < 2; ++ai)
#pragma unroll
            for (int m = 0; m < 4; ++m) {
                const int kb = ai * 2 + (m >> 1);
                if ((m & 1) == 0 && kb < 3) OUTPROJ_LD((kb + 1) & 1, (kb + 1) >> 1, (kb + 1) & 1);
                const int row = u.pm * 256 + ai * 128 + wr * 64 + m * 16 + fr;
                float ss = 0.f;
#pragma unroll
                for (int bj = 0; bj < 2; ++bj) {
                    const int col = u.pn * 256 + bj * 128 + wc * 32 + 8 * fq;
                    const size_t o = (size_t)row * D + col;
                    const pg8::f32x4 a = xv[kb & 1][m & 1][bj][0] + acc[ai][bj][m][0], b = xv[kb & 1][m & 1][bj][1] + acc[ai][bj][m][1];
                    ss += (a[0] * a[0] + a[1] * a[1]) + (a[2] * a[2] + a[3] * a[3]) + (b[0] * b[0] + b[1] * b[1]) + (b[2] * b[2] + b[3] * b[3]);
                    pg8::u32x4 w; w.x = pg8::cvt_pk_bf16(a[0], a[1]); w.y = pg8::cvt_pk_bf16(a[2], a[3]); w.z = pg8::cvt_pk_bf16(b[0], b[1]); w.w = pg8::cvt_pk_bf16(b[2], b[3]);
                    *(pg8::u32x4*)(x1b + o) = w;
                    float mx = fmaxf(fmaxf(fmaxf(fabsf(a[0]), fabsf(a[1])), fmaxf(fabsf(a[2]), fabsf(a[3]))), fmaxf(fmaxf(fabsf(b[0]), fabsf(b[1])), fmaxf(fabsf(b[2]), fabsf(b[3]))));
                    mx = fmaxf(mx, __shfl_xor(mx, 16)); mx = fmaxf(mx, __shfl_xor(mx, 32));
                    const float inv = mx > 0.f ? 119.0f / mx : 0.f;
                    unsigned pl = 0u, ph = 0u;
#pragma unroll
                    for (int i = 0; i < 4; ++i) {
                        const int qa = __float2int_rn(a[i] * inv), qb = __float2int_rn(b[i] * inv);
                        pl |= ((unsigned)(qa & 15) << (8 * i)) | ((unsigned)(qb & 15) << (8 * i + 4));
                        ph |= ((unsigned)(((qa + 8) >> 4) & 15) << (8 * i)) | ((unsigned)(((qb + 8) >> 4) & 15) << (8 * i + 4));
                    }
                    unsigned* cq = (unsigned*)(x1q + (size_t)row * D + (col & ~31));
                    cq[fq] = pl; cq[4 + fq] = ph;
                    if (fq == 0) xsc[(size_t)row * 32 + (col >> 5)] = mx * (1.0f / 119.0f);
                }
                ss += __shfl_xor(ss, 16); ss += __shfl_xor(ss, 32);
                if (fq == 0) ssq[(size_t)row * 16 + u.pn * 4 + wc] = ss;
            }
    }
};
#undef OUTPROJ_LD
struct EpiPeerQ {
    static constexpr bool PERM = true, AFTER_DRAIN = false;
    bf16_t* qp;
    __device__ __forceinline__ void operator()(const pg8::f32x4 (&acc)[2][2][4][2], const pg8::Unit& u, int wr, int wc, int fr, int fq) const {
#pragma unroll
        for (int ai = 0; ai < 2; ++ai)
#pragma unroll
            for (int m = 0; m < 4; ++m) {
                const int row = u.pm * 256 + ai * 128 + wr * 64 + m * 16 + fr;
#pragma unroll
                for (int bj = 0; bj < 2; ++bj) {
                    const pg8::f32x4 a = acc[ai][bj][m][0], b = acc[ai][bj][m][1];
                    pg8::u32x4 w; w.x = pg8::cvt_pk_bf16(a[0], a[1]); w.y = pg8::cvt_pk_bf16(a[2], a[3]); w.z = pg8::cvt_pk_bf16(b[0], b[1]); w.w = pg8::cvt_pk_bf16(b[2], b[3]);
                    *(pg8::u32x4*)(qp + ((((size_t)((row >> 5) * 8 + u.pn) * 2 + bj) * 8 + 2 * wc + (fq >> 1)) * 64 + (row & 31) + 32 * (fq & 1)) * 8) = w;
                }
            }
    }
};

typedef float f32x2v __attribute__((ext_vector_type(2)));
typedef __bf16 bf16x2v __attribute__((ext_vector_type(2)));
__device__ __forceinline__ unsigned cvtpk(float lo, float hi) { const f32x2v v = {lo, hi}; const bf16x2v b = __builtin_convertvector(v, bf16x2v); return __builtin_bit_cast(unsigned, b); }
__device__ __forceinline__ bf16x8 pack_step(const f32x16& x, int s) {
    u32x4 pkd; pkd.x = cvtpk(x[8 * s], x[8 * s + 1]); pkd.y = cvtpk(x[8 * s + 2], x[8 * s + 3]); pkd.z = cvtpk(x[8 * s + 4], x[8 * s + 5]); pkd.w = cvtpk(x[8 * s + 6], x[8 * s + 7]);
    return __builtin_bit_cast(bf16x8, pkd);
}
#define MFMA32(a, b, c) __builtin_amdgcn_mfma_f32_32x32x16_bf16((a), (b), (c), 0, 0, 0)
__device__ __forceinline__ void ph_attn(const Params& p) {
    unsigned char* ws = p.ws;
    const bf16_t* qh = (const bf16_t*)(ws + WS_QH); const bf16_t* kh = (const bf16_t*)(ws + WS_KH); const bf16_t* vT = (const bf16_t*)(ws + WS_VH);
    bf16_t* osb = (bf16_t*)(ws + WS_OSB);
    const int tid = phase_tid(), lane = tid & 63, r = lane & 31, hh = lane >> 5;
    const int gwave = (blockIdx.x * blockDim.x + tid) >> 6, nwave = (gridDim.x * blockDim.x) >> 6;
    bf16x8 tp[2];
#pragma unroll
    for (int ss = 0; ss < 2; ++ss)
#pragma unroll
        for (int e = 0; e < 8; ++e) { const int k = 16 * ss + 8 * (e >> 2) + 4 * hh + (e & 3); tp[ss][e] = (k > r) ? (short)0x3F80 : (short)0; }
    f32x16 zero16;
#pragma unroll
    for (int i = 0; i < 16; ++i) zero16[i] = 0.f;
    for (int u = gwave; u < NH * (S / 32); u += nwave) {
        const int h = u / (S / 32), t0 = (u % (S / 32)) * 32;
        bf16x8 bq[4];
#pragma unroll
        for (int s = 0; s < 4; ++s) bq[s] = *(const bf16x8*)(qh + (((size_t)(h * (S / 32) + (t0 >> 5)) * 4 + s) * 64 + lane) * 8);
        f32x16 ot[2] = {zero16, zero16};
        float carry = 0.f;
        for (int kt0 = t0; kt0 >= 0; kt0 -= 32) {
            bf16x8 ak[4], av[2][2];
#pragma unroll
            for (int s = 0; s < 4; ++s) ak[s] = *(const bf16x8*)(kh + (((size_t)(h * (S / 32) + (kt0 >> 5)) * 4 + s) * 64 + lane) * 8);
#pragma unroll
            for (int dt = 0; dt < 2; ++dt)
#pragma unroll
                for (int ss = 0; ss < 2; ++ss) av[dt][ss] = *(const bf16x8*)(vT + ((((size_t)(h * (S / 32) + (kt0 >> 5)) * 2 + dt) * 2 + ss) * 64 + lane) * 8);
            f32x16 st = zero16;
#pragma unroll
            for (int s = 0; s < 4; ++s) st = MFMA32(ak[s], bq[s], st);
            const bool diag = (kt0 == t0);
            f32x16 lom, lb;
            float csum = 0.f;
#pragma unroll
            for (int i = 0; i < 16; ++i) {
                const float z = st[i];
                const float sp2 = fmaxf(z, 0.f) + __builtin_amdgcn_logf(1.0f + __builtin_amdgcn_exp2f(-fabsf(z)));
                const bool valid = !diag || ((i & 3) + 8 * (i >> 2) + 4 * hh < r);
                lom[i] = valid ? -sp2 : 0.f;
                lb[i] = z - sp2;
                csum += lom[i];
            }
            f32x16 suf = MFMA32(tp[0], pack_step(lom, 0), zero16);
            suf = MFMA32(tp[1], pack_step(lom, 1), suf);
            f32x16 w;
#pragma unroll
            for (int i = 0; i < 16; ++i) {
                const bool valid = !diag || ((i & 3) + 8 * (i >> 2) + 4 * hh < r);
                w[i] = valid ? __builtin_amdgcn_exp2f(lb[i] + suf[i] + carry) : 0.f;
            }
            const bf16x8 w0 = pack_step(w, 0), w1 = pack_step(w, 1);
#pragma unroll
            for (int dt = 0; dt < 2; ++dt) { ot[dt] = MFMA32(av[dt][0], w0, ot[dt]); ot[dt] = MFMA32(av[dt][1], w1, ot[dt]); }
            carry += csum + __shfl_xor(csum, 32);
            if (__all(carry < CARRY_STOP)) break;
        }
#pragma unroll
        for (int dt = 0; dt < 2; ++dt)
#pragma unroll
            for (int g = 0; g < 4; ++g) {
                uint2 o; o.x = cvtpk(ot[dt][4 * g], ot[dt][4 * g + 1]); o.y = cvtpk(ot[dt][4 * g + 2], ot[dt][4 * g + 3]);
                *(uint2*)(osb + (size_t)(t0 + r) * DSB + h * HD + 32 * dt + 8 * g + 4 * hh) = o;
            }
    }
}

constexpr int RG_LDS_CST = 0, RG_LDS_HIN = 16384, RG_LDS_P = 18432, RG_LDS_SSQ = 20480;
constexpr int RG_LDS_X = 22528, RG_XP = 1032, RG_LDS_O = 91904;
typedef unsigned u32x2 __attribute__((ext_vector_type(2)));
typedef __attribute__((address_space(3))) float lds_f;
typedef __attribute__((address_space(3))) unsigned char lds_b;
template <int CTRL, int ROWMASK>
__device__ __forceinline__ float dpp_mov(float oob, float x) {
    return __builtin_bit_cast(float, __builtin_amdgcn_update_dpp(__builtin_bit_cast(int, oob), __builtin_bit_cast(int, x), CTRL, ROWMASK, 0xf, false));
}
template <int CTRL, int ROWMASK>
__device__ __forceinline__ void scan_step(float (&av)[16], float (&bv)[16]) {
#pragma unroll
    for (int i = 0; i < 16; ++i) {
        const float ap = dpp_mov<CTRL, ROWMASK>(1.0f, av[i]), bp = dpp_mov<CTRL, ROWMASK>(0.0f, bv[i]);
        bv[i] = __builtin_fmaf(av[i], bp, bv[i]); av[i] *= ap;
    }
}
template <int PASS>
__device__ __forceinline__ void ph_rg(const Params& p, unsigned char* lds_raw) {
    float* lds = (float*)lds_raw;
    unsigned char* ws = p.ws;
    const bf16_t* xrg = (const bf16_t*)(ws + WS_XRG); const bf16_t* gg = (const bf16_t*)(ws + WS_GG); const bf16_t* wfrag = (const bf16_t*)(ws + WS_RGW);
    const bf16_t* osb = (const bf16_t*)(ws + WS_OSB); bf16_t* mix = (bf16_t*)(ws + WS_MIX);
    float* rgP = (float*)(ws + WS_RGP); float* rgH = (float*)(ws + WS_RGH);
    bf16_t* scA = (bf16_t*)(ws + WS_RGSA); bf16_t* scB = (bf16_t*)(ws + WS_RGSB);
    const int tid = phase_tid(), lane = tid & 63, r = lane & 31, hh = lane >> 5, n = __builtin_amdgcn_readfirstlane(tid >> 6);
    __syncthreads();
    if (PASS == 0) for (int e = tid; e < 8 * 2 * 8 * 32; e += NTHR) {
        const int q = e & 31, k = (e >> 5) & 7, h2 = (e >> 8) & 1, nn = e >> 9;
        const int c = 64 * nn + 32 * (q >> 4) + (q & 3) + 8 * ((q >> 2) & 3) + 4 * h2;
        float v;
        if (k < 4) v = p.in[I_CONV_W][k * DRG + c];
        else if (k == 4) v = p.in[I_CONV_B][c];
        else if (k == 5) v = p.in[I_RG_B_A][c];
        else if (k == 6) v = p.in[I_RG_B_X][c];
        else v = 8.0f * LOG2E * log1pf(__expf(-p.in[I_RG_LAMBDA][c]));
        lds[e] = v;
    }
    const unsigned lds0 = (unsigned)(size_t)((lds_b*)lds_raw);
    const unsigned cst_base = lds0 + (unsigned)((n * 2 + hh) * 1024);
    lds_f* hin_l = (lds_f*)(size_t)(lds0 + RG_LDS_HIN + (n * 2 + hh) * 128);
    lds_f* pc_l = (lds_f*)(size_t)(lds0 + RG_LDS_P + (n * 2 + hh) * 128);
    lds_b* xt = (lds_b*)(size_t)(lds0 + RG_LDS_X);
    lds_b* ot = (lds_b*)(size_t)(lds0 + RG_LDS_O);
    f32x16 zero16;
#pragma unroll
    for (int i = 0; i < 16; ++i) zero16[i] = 0.f;
    for (int ch = blockIdx.x; ch < NCHUNK; ch += gridDim.x) {
        const int t0 = ch * CHUNK;
        __syncthreads();
        if (PASS == 0) for (int ci = tid; ci < (CHUNK + 3) * 64; ci += NTHR) {
            const int row = ci >> 6, c16 = ci & 63, tt = t0 - 3 + row;
            u32x4 v = {0u, 0u, 0u, 0u};
            if (tt >= 0) v = *(const u32x4*)(xrg + (size_t)tt * DRG + 8 * c16);
            __attribute__((address_space(3))) u32x2* d = (__attribute__((address_space(3))) u32x2*)(xt + row * RG_XP + 16 * c16);
            d[0] = (u32x2){v.x, v.y}; d[1] = (u32x2){v.z, v.w};
        }
        if (PASS == 1) {
            const int c = 64 * n + lane;
            float h = 0.f;
            int k = 0;
            for (; k + 32 <= ch; k += 32) {
                float pv[32], hv[32];
#pragma unroll
                for (int j = 0; j < 32; ++j) { pv[j] = rgP[(k + j) * DRG + c]; hv[j] = rgH[(k + j) * DRG + c]; }
#pragma unroll
                for (int j = 0; j < 32; ++j) h = pv[j] * h + hv[j];
            }
            for (; k + 8 <= ch; k += 8) {
                float pv[8], hv[8];
#pragma unroll
                for (int j = 0; j < 8; ++j) { pv[j] = rgP[(k + j) * DRG + c]; hv[j] = rgH[(k + j) * DRG + c]; }
#pragma unroll
                for (int j = 0; j < 8; ++j) h = pv[j] * h + hv[j];
            }
            for (; k < ch; ++k) h = rgP[k * DRG + c] * h + rgH[k * DRG + c];
            lds[RG_LDS_HIN / 4 + (n * 2 + ((lane >> 2) & 1)) * 32 + 16 * (lane >> 5) + 4 * ((lane >> 3) & 3) + (lane & 3)] = h;
        } else {
            if (r == 0) {
#pragma unroll
                for (int q = 0; q < 32; ++q) { hin_l[q] = 0.f; pc_l[q] = 1.f; }
            }
        }
        __syncthreads();
#pragma unroll 1
        for (int tl = 0; tl < 2; ++tl) {
            const int tok = t0 + 32 * tl + r;
            unsigned cst_a = cst_base; asm volatile("" : "+v"(cst_a));
            const lds_f* cst = (const lds_f*)(size_t)cst_a;
            float xcv[32]; bf16x8 bx[4];
            if (PASS == 0) {
#pragma unroll
            for (int q = 0; q < 32; ++q) xcv[q] = cst[4 * 32 + q];
#pragma unroll
            for (int k = 0; k < 4; ++k) {
                const lds_b* xr = xt + (32 * tl + r + k) * RG_XP + (64 * n + 4 * hh) * 2;
#pragma unroll
                for (int m = 0; m < 8; ++m) {
                    const u32x2 xw = *(const __attribute__((address_space(3))) u32x2*)(xr + 16 * m);
                    xcv[4 * m + 0] += cst[k * 32 + 4 * m + 0] * bf2f(xw.x & 0xffffu); xcv[4 * m + 1] += cst[k * 32 + 4 * m + 1] * bf2f(xw.x >> 16);
                    xcv[4 * m + 2] += cst[k * 32 + 4 * m + 2] * bf2f(xw.y & 0xffffu); xcv[4 * m + 3] += cst[k * 32 + 4 * m + 3] * bf2f(xw.y >> 16);
                }
                __builtin_amdgcn_sched_barrier(0);
            }
#pragma unroll
            for (int s = 0; s < 4; ++s) {
                u32x4 pk; pk.x = cvtpk(xcv[8 * s], xcv[8 * s + 1]); pk.y = cvtpk(xcv[8 * s + 2], xcv[8 * s + 3]); pk.z = cvtpk(xcv[8 * s + 4], xcv[8 * s + 5]); pk.w = cvtpk(xcv[8 * s + 6], xcv[8 * s + 7]);
                bx[s] = __builtin_bit_cast(bf16x8, pk);
            }
            }
            float ss = 0.f;
            const bf16_t* wb = wfrag + ((size_t)n * 16 * 64 + lane) * 8; asm volatile("" : "+v"(wb));
#pragma unroll
            for (int jt = 0; jt < 2; ++jt) {
                float av[16], bv[16];
                const size_t sco = ((((size_t)(2 * ch + tl) * 8 + n) * 2 + jt) * 64 + lane) * 16;
                if (PASS == 0) {
#pragma unroll
                for (int g = 0; g < 2; ++g) {
                    f32x16 acc = zero16;
#pragma unroll
                    for (int s = 0; s < 4; ++s) {
                        const bf16x8 aw = *(const __attribute__((address_space(1))) bf16x8*)(wb + (((g * 2 + jt) * 4 + s) * 64) * 8);
                        acc = MFMA32(aw, bx[s], acc);
                    }
#pragma unroll
                    for (int i = 0; i < 16; ++i) {
                        const int q = 16 * jt + i;
                        const float pre = acc[i] + cst[(5 + g) * 32 + q];
                        const float sg = 1.0f / (1.0f + __builtin_amdgcn_exp2f(-LOG2E * pre));
                        if (g == 0) av[i] = __builtin_amdgcn_exp2f(-sg * cst[7 * 32 + q]);
                        else bv[i] = __builtin_amdgcn_sqrtf(fmaxf(__builtin_fmaf(-av[i], av[i], 1.0f), 0.f)) * (sg * xcv[q]);
                    }
                    __builtin_amdgcn_sched_barrier(0);
                }
                scan_step<0x111, 0xf>(av, bv); scan_step<0x112, 0xf>(av, bv); scan_step<0x114, 0xf>(av, bv); scan_step<0x118, 0xf>(av, bv);
                scan_step<0x142, 0xa>(av, bv);
                u32x4 sa0, sa1, sb0, sb1;
                sa0.x = cvtpk(av[0], av[1]); sa0.y = cvtpk(av[2], av[3]); sa0.z = cvtpk(av[4], av[5]); sa0.w = cvtpk(av[6], av[7]); sa1.x = cvtpk(av[8], av[9]); sa1.y = cvtpk(av[10], av[11]); sa1.z = cvtpk(av[12], av[13]); sa1.w = cvtpk(av[14], av[15]);
                sb0.x = cvtpk(bv[0], bv[1]); sb0.y = cvtpk(bv[2], bv[3]); sb0.z = cvtpk(bv[4], bv[5]); sb0.w = cvtpk(bv[6], bv[7]); sb1.x = cvtpk(bv[8], bv[9]); sb1.y = cvtpk(bv[10], bv[11]); sb1.z = cvtpk(bv[12], bv[13]); sb1.w = cvtpk(bv[14], bv[15]);
                *(u32x4*)(scA + sco) = sa0; *(u32x4*)(scA + sco + 8) = sa1; *(u32x4*)(scB + sco) = sb0; *(u32x4*)(scB + sco + 8) = sb1;
                } else {
                    const u32x4 sa0 = *(const u32x4*)(scA + sco), sa1 = *(const u32x4*)(scA + sco + 8), sb0 = *(const u32x4*)(scB + sco), sb1 = *(const u32x4*)(scB + sco + 8);
                    const unsigned wa[8] = {sa0.x, sa0.y, sa0.z, sa0.w, sa1.x, sa1.y, sa1.z, sa1.w}, wbb[8] = {sb0.x, sb0.y, sb0.z, sb0.w, sb1.x, sb1.y, sb1.z, sb1.w};
#pragma unroll
                    for (int k = 0; k < 8; ++k) { av[2 * k] = bf2f(wa[k] & 0xffffu); av[2 * k + 1] = bf2f(wa[k] >> 16); bv[2 * k] = bf2f(wbb[k] & 0xffffu); bv[2 * k + 1] = bf2f(wbb[k] >> 16); }
                }
                __builtin_amdgcn_sched_barrier(0);
#pragma unroll
                for (int i = 0; i < 16; ++i) {
                    const int q = 16 * jt + i;
                    const float h = __builtin_fmaf(av[i], hin_l[q], bv[i]);
                    if (r == 31) { hin_l[q] = h; if (PASS == 0) pc_l[q] *= av[i]; }
                    bv[i] = h;
                }
                if (PASS == 1) {
#pragma unroll
                    for (int g4 = 0; g4 < 4; ++g4) {
                        const int m = 4 * jt + g4;
                        const uint2 gw = *(const uint2*)(gg + ((((size_t)(tok >> 5) * 8 + n) * 8 + m) * 64 + lane) * 4);
                        const float o0 = bv[4 * g4] * bf2f(gw.x & 0xffffu), o1 = bv[4 * g4 + 1] * bf2f(gw.x >> 16), o2 = bv[4 * g4 + 2] * bf2f(gw.y & 0xffffu), o3 = bv[4 * g4 + 3] * bf2f(gw.y >> 16);
                        ss += (o0 * o0 + o1 * o1) + (o2 * o2 + o3 * o3);
                        *(__attribute__((address_space(3))) u32x2*)(ot + (32 * tl + r) * RG_XP + (64 * n + 8 * m + 4 * hh) * 2) = (u32x2){cvtpk(o0, o1), cvtpk(o2, o3)};
                    }
                }
                __builtin_amdgcn_sched_barrier(0);
            }
            if (PASS == 1) { ss += __shfl_xor(ss, 32); if (hh == 0) lds[RG_LDS_SSQ / 4 + (tl * 8 + n) * 32 + r] = ss; }
        }
        if (PASS == 0) {
            if (r == 0) {
#pragma unroll
                for (int m = 0; m < 8; ++m) {
                    const int c = 64 * n + 8 * m + 4 * hh;
                    *(f32x4*)(rgP + (size_t)ch * DRG + c) = (f32x4){pc_l[4 * m], pc_l[4 * m + 1], pc_l[4 * m + 2], pc_l[4 * m + 3]};
                    *(f32x4*)(rgH + (size_t)ch * DRG + c) = (f32x4){hin_l[4 * m], hin_l[4 * m + 1], hin_l[4 * m + 2], hin_l[4 * m + 3]};
                }
            }
        } else {
            __syncthreads();
            for (int j = 0; j < 8; ++j) {
                const int tr = 8 * n + j, tok = t0 + tr;
                float tot = 0.f;
#pragma unroll
                for (int w = 0; w < 8; ++w) tot += lds[RG_LDS_SSQ / 4 + ((tr >> 5) * 8 + w) * 32 + (tr & 31)];
                const float rn = rsqrtf(tot * (1.0f / DRG) + EPS);
                const __attribute__((address_space(3))) u32x2* op = (const __attribute__((address_space(3))) u32x2*)(ot + tr * RG_XP + 16 * lane);
                const u32x2 w0 = op[0], w1 = op[1];
                u32x4 o2; o2.x = cvtpk(bf2f(w0.x & 0xffffu) * rn, bf2f(w0.x >> 16) * rn); o2.y = cvtpk(bf2f(w0.y & 0xffffu) * rn, bf2f(w0.y >> 16) * rn);
                o2.z = cvtpk(bf2f(w1.x & 0xffffu) * rn, bf2f(w1.x >> 16) * rn); o2.w = cvtpk(bf2f(w1.y & 0xffffu) * rn, bf2f(w1.y >> 16) * rn);
                *((u32x4*)(mix + (size_t)tok * D + DSB) + lane) = o2;
                const u32x4 a = *((const u32x4*)(osb + (size_t)tok * DSB) + lane);
                float f[8] = {bf2f(a.x & 0xffffu), bf2f(a.x >> 16), bf2f(a.y & 0xffffu), bf2f(a.y >> 16), bf2f(a.z & 0xffffu), bf2f(a.z >> 16), bf2f(a.w & 0xffffu), bf2f(a.w >> 16)};
                float sa = 0.f;
#pragma unroll
                for (int k = 0; k < 8; ++k) sa += f[k] * f[k];
                sa = wave_sum(sa);
                const float ra = rsqrtf(sa * (1.0f / DSB) + EPS);
                u32x4 o; o.x = cvtpk(f[0] * ra, f[1] * ra); o.y = cvtpk(f[2] * ra, f[3] * ra); o.z = cvtpk(f[4] * ra, f[5] * ra); o.w = cvtpk(f[6] * ra, f[7] * ra);
                *((u32x4*)(mix + (size_t)tok * D) + lane) = o;
            }
        }
    }
}

__device__ __forceinline__ int f2key(float f) { const int b = __builtin_bit_cast(int, f); return b ^ ((b >> 31) & 0x7fffffff); }
__device__ __forceinline__ float key2f(int k) { return __builtin_bit_cast(float, k ^ ((k >> 31) & 0x7fffffff)); }
#define TOPK_CE(a, b) do { const int hi_ = max(a, b), lo_ = min(a, b); a = hi_; b = lo_; } while (0)
__device__ __forceinline__ void sort16_desc(int (&v)[16]) { TOPK_CE(v[0], v[1]); TOPK_CE(v[2], v[3]); TOPK_CE(v[0], v[2]); TOPK_CE(v[1], v[3]); TOPK_CE(v[1], v[2]); TOPK_CE(v[4], v[5]); TOPK_CE(v[6], v[7]); TOPK_CE(v[4], v[6]); TOPK_CE(v[5], v[7]); TOPK_CE(v[5], v[6]); TOPK_CE(v[0], v[4]); TOPK_CE(v[2], v[6]); TOPK_CE(v[2], v[4]); TOPK_CE(v[1], v[5]); TOPK_CE(v[3], v[7]); TOPK_CE(v[3], v[5]); TOPK_CE(v[1], v[2]); TOPK_CE(v[3], v[4]); TOPK_CE(v[5], v[6]); TOPK_CE(v[8], v[9]); TOPK_CE(v[10], v[11]); TOPK_CE(v[8], v[10]); TOPK_CE(v[9], v[11]); TOPK_CE(v[9], v[10]); TOPK_CE(v[12], v[13]); TOPK_CE(v[14], v[15]); TOPK_CE(v[12], v[14]); TOPK_CE(v[13], v[15]); TOPK_CE(v[13], v[14]); TOPK_CE(v[8], v[12]); TOPK_CE(v[10], v[14]); TOPK_CE(v[10], v[12]); TOPK_CE(v[9], v[13]); TOPK_CE(v[11], v[15]); TOPK_CE(v[11], v[13]); TOPK_CE(v[9], v[10]); TOPK_CE(v[11], v[12]); TOPK_CE(v[13], v[14]); TOPK_CE(v[0], v[8]); TOPK_CE(v[4], v[12]); TOPK_CE(v[4], v[8]); TOPK_CE(v[2], v[10]); TOPK_CE(v[6], v[14]); TOPK_CE(v[6], v[10]); TOPK_CE(v[2], v[4]); TOPK_CE(v[6], v[8]); TOPK_CE(v[10], v[12]); TOPK_CE(v[1], v[9]); TOPK_CE(v[5], v[13]); TOPK_CE(v[5], v[9]); TOPK_CE(v[3], v[11]); TOPK_CE(v[7], v[15]); TOPK_CE(v[7], v[11]); TOPK_CE(v[3], v[5]); TOPK_CE(v[7], v[9]); TOPK_CE(v[11], v[13]); TOPK_CE(v[1], v[2]); TOPK_CE(v[3], v[4]); TOPK_CE(v[5], v[6]); TOPK_CE(v[7], v[8]); TOPK_CE(v[9], v[10]); TOPK_CE(v[11], v[12]); TOPK_CE(v[13], v[14]); }
__device__ __forceinline__ void merge16_desc(int (&a)[16], const int (&b)[16]) {
#pragma unroll
    for (int i = 0; i < 16; ++i) a[i] = max(a[i], b[15 - i]);
#pragma unroll
    for (int d = 8; d >= 1; d >>= 1)
#pragma unroll
        for (int i = 0; i < 16; ++i) if ((i & d) == 0) TOPK_CE(a[i], a[i + d]);
}
__device__ __forceinline__ void ph_topk(const Params& p, int* lds) {
    unsigned char* ws = p.ws;
    const bf16_t* qp = (const bf16_t*)(ws + WS_B); const bf16_t* subk = (const bf16_t*)(ws + WS_SUBK);
    int* seli = (int*)(ws + WS_SELI); float* selg = (float*)(ws + WS_SELG);
    const float* ssq = (const float*)(ws + WS_SSQ); float* rstd2 = (float*)(ws + WS_RSTD2);
    const int tid = phase_tid(), lane = tid & 63, r = lane & 31, hh = lane >> 5, hx = 4 * hh;
    const int gwave = (blockIdx.x * blockDim.x + tid) >> 6, nwave = (gridDim.x * blockDim.x) >> 6;
    constexpr int SK_OFF = 65536, SK_PITCH = 272;
    typedef __attribute__((address_space(3))) unsigned char lds_b;
    lds_b* skl = (lds_b*)lds + SK_OFF;
    const int w = tid >> 6;
    pg8::StaticOrder so; so.init(S, NQ, (int)gridDim.x, (int)blockIdx.x);
    pg8::Unit gu;
    for (int ui = 0; so.next(ui, gu); ++ui) {
        const int h = gu.pn, t0 = gu.pm * 256 + 32 * w, t = t0 + r;
        __syncthreads();
#pragma unroll
        for (int j = 0; j < 8; ++j) {
            const int ci = tid + NTHR * j, row = ci >> 4, c16 = ci & 15;
            const u32x4 v = *(const u32x4*)(subk + ((size_t)h * 256 + row) * PHALF + 8 * c16);
            *(__attribute__((address_space(3))) u32x4*)(skl + row * SK_PITCH + 16 * c16) = v;
        }
        __syncthreads();
        int tk[2][16];
#pragma unroll
        for (int pp = 0; pp < 2; ++pp) {
            f32x16 acc[4];
#pragma unroll
            for (int T = 0; T < 4; ++T)
#pragma unroll
                for (int i = 0; i < 16; ++i) acc[T][i] = 0.f;
            const bf16_t* qrow = qp + ((((size_t)((t0 >> 5) * 8 + h) * 2 + pp) * 8) * 64 + lane) * 8;
            const lds_b* krow = skl + (pp * PNK + r) * SK_PITCH + 16 * hh;
#pragma unroll
            for (int s = 0; s < 8; ++s) {
                const bf16x8 b = *(const bf16x8*)(qrow + s * 64 * 8);
#pragma unroll
                for (int T = 0; T < 4; ++T) {
                    const bf16x8 a = *(const __attribute__((address_space(3))) bf16x8*)(krow + (32 * T) * SK_PITCH + 32 * s);
                    acc[T] = __builtin_amdgcn_mfma_f32_32x32x16_bf16(a, b, acc[T], 0, 0, 0);
                }
            }
            int kq[4][16];
#pragma unroll
            for (int T = 0; T < 4; ++T) {
#pragma unroll
                for (int i = 0; i < 16; ++i) {
                    const int nb = 32 * T + (i & 3) + 8 * (i >> 2);
                    kq[T][i] = ((f2key(acc[T][i]) & ~127) | (127 - nb)) ^ hx;
                }
                sort16_desc(kq[T]);
            }
            merge16_desc(kq[0], kq[1]); merge16_desc(kq[2], kq[3]); merge16_desc(kq[0], kq[2]);
            int m[16], po[16];
#pragma unroll
            for (int i = 0; i < 16; ++i) { m[i] = kq[0][i]; po[i] = __shfl_xor(kq[0][i], 32); }
            merge16_desc(m, po);
#pragma unroll
            for (int i = 0; i < 16; ++i) tk[pp][i] = m[i];
        }
#pragma unroll
        for (int i = 0; i < 16; ++i) { lds[i * NTHR + tid] = tk[0][i]; lds[(16 + i) * NTHR + tid] = tk[1][i]; }
        float v0[16], v1[16];
#pragma unroll
        for (int i = 0; i < 16; ++i) { v0[i] = key2f(tk[0][i]); v1[i] = key2f(tk[1][i]); }
#define CKEY(a, b) ((f2key(v0[a] + v1[b]) & ~255) | (255 - ((a) * 16 + (b))))
        const int NEGK = (int)0x80000000;
        int bk[16], l1[16], ga[16], gb[16];
#pragma unroll
        for (int b = 0; b < 16; ++b) bk[b] = CKEY(0, b);
#pragma unroll
        for (int b = 0; b < 16; ++b) l1[b] = b < 8 ? CKEY(1, b) : NEGK;
        ga[0] = CKEY(2, 0); ga[1] = CKEY(2, 1); ga[2] = CKEY(2, 2); ga[3] = CKEY(2, 3); ga[4] = CKEY(2, 4);
        ga[5] = CKEY(3, 0); ga[6] = CKEY(3, 1); ga[7] = CKEY(3, 2); ga[8] = CKEY(3, 3);
        ga[9] = CKEY(4, 0); ga[10] = CKEY(4, 1); ga[11] = CKEY(4, 2); ga[12] = CKEY(5, 0); ga[13] = CKEY(5, 1); ga[14] = NEGK; ga[15] = NEGK;
        gb[0] = CKEY(6, 0); gb[1] = CKEY(6, 1); gb[2] = CKEY(7, 0); gb[3] = CKEY(7, 1);
#pragma unroll
        for (int a = 8; a < 16; ++a) gb[a - 4] = CKEY(a, 0);
        gb[12] = NEGK; gb[13] = NEGK; gb[14] = NEGK; gb[15] = NEGK;
#undef CKEY
        sort16_desc(ga); sort16_desc(gb);
        merge16_desc(bk, l1); merge16_desc(ga, gb); merge16_desc(bk, ga);
        float ssum = 0.f;
#pragma unroll
        for (int i = 0; i < 4; ++i) { const f32x4 q4 = *(const f32x4*)(ssq + (size_t)t * 16 + 4 * i); ssum += (q4.x + q4.y) + (q4.z + q4.w); }
        const float rs = rsqrtf(ssum * (1.0f / D) + EPS);
        float e[16], sum = 0.f; const float mx = key2f(bk[0]);
#pragma unroll
        for (int i = 0; i < 16; ++i) { e[i] = __expf((key2f(bk[i]) - mx) * rs); sum += e[i]; }
        const float inv = 1.0f / sum;
        int eidx[16];
#pragma unroll
        for (int i = 0; i < 16; ++i) {
            const int code = 255 - (bk[i] & 255), a = code >> 4, b = code & 15;
            const int i1 = 127 - (lds[a * NTHR + tid] & 127), i2 = 127 - (lds[(16 + b) * NTHR + tid] & 127);
            eidx[i] = i1 * PNK + i2; e[i] *= inv;
        }
        if (hh == 0) {
            int4* o = (int4*)(seli + (size_t)t * 128 + h * 16);
#pragma unroll
            for (int i = 0; i < 4; ++i) o[i] = make_int4(eidx[4 * i], eidx[4 * i + 1], eidx[4 * i + 2], eidx[4 * i + 3]);
            if (h == 0) rstd2[t] = rs;
        } else {
            f32x4* o = (f32x4*)(selg + (size_t)t * 128 + h * 16);
#pragma unroll
            for (int i = 0; i < 4; ++i) o[i] = (f32x4){e[4 * i], e[4 * i + 1], e[4 * i + 2], e[4 * i + 3]};
        }
    }
}

typedef __bf16 bf16x2_t __attribute__((ext_vector_type(2)));
typedef float f32x2 __attribute__((ext_vector_type(2)));
template <int NV, int XS0, int XS1, int XS2>
__device__ __forceinline__ void reduce_over8(float (&v)[NV], int sel) {
    { const bool up = sel & 1;
#pragma unroll
      for (int i = 0; i < NV / 2; ++i) { const float a = v[2 * i], b = v[2 * i + 1]; v[i] = (up ? b : a) + __shfl_xor(up ? a : b, XS0); } }
    { const bool up = (sel >> 1) & 1;
#pragma unroll
      for (int i = 0; i < NV / 4; ++i) { const float a = v[2 * i], b = v[2 * i + 1]; v[i] = (up ? b : a) + __shfl_xor(up ? a : b, XS1); } }
    { const bool up = (sel >> 2) & 1;
#pragma unroll
      for (int i = 0; i < NV / 8; ++i) { const float a = v[2 * i], b = v[2 * i + 1]; v[i] = (up ? b : a) + __shfl_xor(up ? a : b, XS2); } }
}
__device__ __forceinline__ void peer_load_idx(const unsigned char* ws, int t, int rsl, int (&ei)[16]) {
    const unsigned off = (unsigned)WS_SELI + ((unsigned)t * 128u + 16u * (unsigned)rsl) * 4u;
#pragma unroll
    for (int j = 0; j < 4; ++j) { const int4 v = *(const int4*)(ws + (off + 16u * j)); ei[4 * j] = v.x; ei[4 * j + 1] = v.y; ei[4 * j + 2] = v.z; ei[4 * j + 3] = v.w; }
}
template <int PASS>
__device__ __forceinline__ void peer_load_rows(const unsigned char* ws, int t, int sl, int rsl, int c, const int (&ei)[16], u32x4 (&row)[16], u32x4 (&aux)[4]) {
    const unsigned tab = (unsigned)(PASS == 0 ? WS_UB : WS_VB) + (unsigned)sl * (unsigned)(NEXP * 128) + 16u * (unsigned)c;
#pragma unroll
    for (int i = 0; i < 16; ++i) row[i] = *(const u32x4*)(ws + (tab + (unsigned)ei[i] * 128u));
    const unsigned xo = (unsigned)WS_X1Q + (unsigned)t * (unsigned)D + 256u * sl + 32u * c;
    aux[0] = *(const u32x4*)(ws + xo); aux[1] = *(const u32x4*)(ws + (xo + 16u));
    aux[2].x = *(const unsigned*)(ws + ((unsigned)WS_XSC + ((unsigned)t * 32u + 8u * sl + c) * 4u));
}
constexpr int PEER_IMG_PITCH = 136, PEER_IMG_BYTES = 128 * PEER_IMG_PITCH;
template <int PASS  >
__device__ __forceinline__ void peer_compute(const Params& p, unsigned char* lds, int lane_w, int t, int sl, int rsl, int c, const u32x4 (&row)[16], const u32x4 (&aux)[4]) {
    unsigned char* ws = p.ws;
    if (PASS == 0) {
        const u32x4 x0 = aux[0], x1_ = aux[1]; const unsigned xl[4] = {x0.x, x0.y, x0.z, x0.w}, xh[4] = {x1_.x, x1_.y, x1_.z, x1_.w};
        const unsigned xsu = aux[2].x; const float xs = u2f(xsu);
        float pd[16];
#pragma unroll
        for (int i = 0; i < 16; ++i) {
            const u32x4 rw = row[i]; const unsigned w4[4] = {rw.x, rw.y, rw.z, rw.w};
            int al = 0, ah = 0;
#pragma unroll
            for (int j = 0; j < 4; ++j) { al = __builtin_amdgcn_sdot8((int)w4[j], (int)xl[j], al, false); ah = __builtin_amdgcn_sdot8((int)w4[j], (int)xh[j], ah, false); }
            pd[i] = (float)(16 * ah + al) * xs;
        }
        reduce_over8<16, 1, 2, 4>(pd, c);
        const unsigned po = (unsigned)WS_PD + (((unsigned)sl * S + (unsigned)t) * 128u + 16u * rsl + c) * 4u;
        *(float*)(ws + po) = pd[0]; *(float*)(ws + (po + 32u)) = pd[1];
    }
}
template <int PASS>
__device__ __forceinline__ void peer_stream(const Params& p, unsigned char* lds, int lane_w, int sl, int t0, int dt, int n) {
    const unsigned char* ws = p.ws;
    const int lane = lane_w & 63, rsl = lane >> 3, c = lane & 7;
    int eiA[16], eiB[16]; u32x4 rowA[16], rowB[16], auxA[4], auxB[4];
    if (n <= 0) return;
    peer_load_idx(ws, t0, rsl, eiA);
    peer_load_rows<PASS>(ws, t0, sl, rsl, c, eiA, rowA, auxA);
    if (n > 1) peer_load_idx(ws, t0 + dt, rsl, eiB);
    for (int i = 0; i < n; i += 2) {
        const int t = t0 + i * dt;
        if (i + 1 < n) peer_load_rows<PASS>(ws, t + dt, sl, rsl, c, eiB, rowB, auxB);
        if (i + 2 < n) peer_load_idx(ws, t + 2 * dt, rsl, eiA);
        peer_compute<PASS>(p, lds, lane_w, t, sl, rsl, c, rowA, auxA);
        if (i + 1 < n) {
            if (i + 2 < n) peer_load_rows<PASS>(ws, t + 2 * dt, sl, rsl, c, eiA, rowA, auxA);
            if (i + 3 < n) peer_load_idx(ws, t + 3 * dt, rsl, eiB);
            peer_compute<PASS>(p, lds, lane_w, t + dt, sl, rsl, c, rowB, auxB);
        }
    }
}
__device__ __forceinline__ void peerv_load_idx(const unsigned char* ws, int t, int hf, int rsl, int (&ei)[8]) {
    const unsigned off = (unsigned)WS_SELI + ((unsigned)t * 128u + 16u * (unsigned)rsl + 8u * (unsigned)hf) * 4u;
    const int4 v0 = *(const int4*)(ws + off), v1 = *(const int4*)(ws + (off + 16u));
    ei[0] = v0.x; ei[1] = v0.y; ei[2] = v0.z; ei[3] = v0.w; ei[4] = v1.x; ei[5] = v1.y; ei[6] = v1.z; ei[7] = v1.w;
}
__device__ __forceinline__ void peerv_load_rows(const unsigned char* ws, int sl, int c, const int (&ei)[8], u32x4 (&row)[8]) {
    const unsigned tab = (unsigned)WS_VB + (unsigned)sl * (unsigned)(NEXP * 128) + 16u * (unsigned)c;
#pragma unroll
    for (int i = 0; i < 8; ++i) row[i] = *(const u32x4*)(ws + (tab + (unsigned)ei[i] * 128u));
}
struct PeerVAux { u32x4 cp; unsigned cs; unsigned xo[4]; };
__device__ __forceinline__ void peerv_load_aux(const unsigned char* ws, int t, int sl, int lane, PeerVAux& a) {
    a.cp = *(const u32x4*)(ws + ((unsigned)WS_CBUF + (unsigned)t * 128u + 16u * (unsigned)(lane & 7)));
    a.cs = *(const unsigned*)(ws + ((unsigned)WS_CSC + (unsigned)t * 4u));
    const unsigned xo = (unsigned)WS_A + ((unsigned)t * (unsigned)D + 256u * sl + (unsigned)lane) * 2u;
    a.xo[0] = *(const bf16_t*)(ws + xo); a.xo[1] = *(const bf16_t*)(ws + (xo + 128u)); a.xo[2] = *(const bf16_t*)(ws + (xo + 256u)); a.xo[3] = *(const bf16_t*)(ws + (xo + 384u));
}
template <int HF>
__device__ __forceinline__ void peerv_half(lds_b* img, int lane, const u32x4 (&row)[8], const PeerVAux& a, int (&acc)[4]) {
    const int rsl = lane >> 3, c = lane & 7;
#pragma unroll
    for (int i = 0; i < 8; ++i) {
        const u32x4 rw = row[i];
        __attribute__((address_space(3))) u32x2* d = (__attribute__((address_space(3))) u32x2*)(img + (16 * rsl + i) * PEER_IMG_PITCH + 16 * c);
        d[0] = (u32x2){rw.x, rw.y}; d[1] = (u32x2){rw.z, rw.w};
    }
    const unsigned cpl = HF == 0 ? a.cp.x : a.cp.y, cph = HF == 0 ? a.cp.z : a.cp.w;
    asm volatile("s_waitcnt lgkmcnt(0)" ::: "memory");
    const unsigned ra = (unsigned)(size_t)img + (unsigned)((lane & 15) * PEER_IMG_PITCH + 8 * (lane >> 4));
#define PEER_TR4(R0, R1, R2, R3, RS) asm volatile("ds_read_b64_tr_b4 %0, %4 offset:%5\n\tds_read_b64_tr_b4 %1, %4 offset:%6\n\tds_read_b64_tr_b4 %2, %4 offset:%7\n\tds_read_b64_tr_b4 %3, %4 offset:%8" \
            : "=&v"(R0), "=&v"(R1), "=&v"(R2), "=&v"(R3) : "v"(ra), "i"((RS) * 16 * PEER_IMG_PITCH), "i"((RS) * 16 * PEER_IMG_PITCH + 32), "i"((RS) * 16 * PEER_IMG_PITCH + 64), "i"((RS) * 16 * PEER_IMG_PITCH + 96) : "memory")
#define PEER_USE4(R0, R1, R2, R3, RS, WAITSTR) do { \
            asm volatile(WAITSTR : "+v"(R0), "+v"(R1), "+v"(R2), "+v"(R3) :: "memory"); \
            const int cl_ = __builtin_amdgcn_readlane((int)cpl, RS), ch_ = __builtin_amdgcn_readlane((int)cph, RS); \
            const unsigned lo4_[4] = {R0.x, R1.x, R2.x, R3.x}; \
            _Pragma("unroll") for (int tcg = 0; tcg < 4; ++tcg) acc[tcg] += 16 * __builtin_amdgcn_sdot8((int)lo4_[tcg], ch_, 0, false) + __builtin_amdgcn_sdot8((int)lo4_[tcg], cl_, 0, false); } while (0)
    {
        u32x2 a0, a1, a2, a3, b0, b1, b2, b3;
        PEER_TR4(a0, a1, a2, a3, 0);
        PEER_TR4(b0, b1, b2, b3, 1); PEER_USE4(a0, a1, a2, a3, 0, "s_waitcnt lgkmcnt(4)");
        PEER_TR4(a0, a1, a2, a3, 2); PEER_USE4(b0, b1, b2, b3, 1, "s_waitcnt lgkmcnt(4)");
        PEER_TR4(b0, b1, b2, b3, 3); PEER_USE4(a0, a1, a2, a3, 2, "s_waitcnt lgkmcnt(4)");
        PEER_TR4(a0, a1, a2, a3, 4); PEER_USE4(b0, b1, b2, b3, 3, "s_waitcnt lgkmcnt(4)");
        PEER_TR4(b0, b1, b2, b3, 5); PEER_USE4(a0, a1, a2, a3, 4, "s_waitcnt lgkmcnt(4)");
        PEER_TR4(a0, a1, a2, a3, 6); PEER_USE4(b0, b1, b2, b3, 5, "s_waitcnt lgkmcnt(4)");
        PEER_TR4(b0, b1, b2, b3, 7); PEER_USE4(a0, a1, a2, a3, 6, "s_waitcnt lgkmcnt(4)");
        PEER_USE4(b0, b1, b2, b3, 7, "s_waitcnt lgkmcnt(0)");
    }
#undef PEER_TR4
#undef PEER_USE4
}
__device__ __forceinline__ void peerv_stream(const Params& p, unsigned char* lds, int tid_, int sl, int t0, int dt, int n) {
    const unsigned char* ws = p.ws;
    const int lane = tid_ & 63, rsl = lane >> 3, c = lane & 7;
    lds_b* img = (lds_b*)lds + (tid_ >> 6) * PEER_IMG_BYTES;
    for (int e = lane; e < 64 * (PEER_IMG_PITCH / 8); e += 64) {
        const int zr = e / (PEER_IMG_PITCH / 8), zc = e % (PEER_IMG_PITCH / 8);
        *(__attribute__((address_space(3))) u32x2*)(img + (16 * (zr >> 3) + 8 + (zr & 7)) * PEER_IMG_PITCH + 8 * zc) = (u32x2){0u, 0u};
    }
    if (n <= 0) return;
    int ei0[8], ei1[8]; u32x4 rowA[8], rowB[8]; PeerVAux ax, axn;
    peerv_load_idx(ws, t0, 0, rsl, ei0);
    peerv_load_rows(ws, sl, c, ei0, rowA); peerv_load_aux(ws, t0, sl, lane, ax);
    peerv_load_idx(ws, t0, 1, rsl, ei1);
    for (int i = 0; i < n; ++i) {
        const int t = t0 + i * dt; const bool more = i + 1 < n;
        int acc[4] = {0, 0, 0, 0};
        peerv_load_rows(ws, sl, c, ei1, rowB);
        if (more) peerv_load_idx(ws, t + dt, 0, rsl, ei0);
        peerv_half<0>(img, lane, rowA, ax, acc);
        if (more) { peerv_load_rows(ws, sl, c, ei0, rowA); peerv_load_aux(ws, t + dt, sl, lane, axn); peerv_load_idx(ws, t + dt, 1, rsl, ei1); }
        peerv_half<1>(img, lane, rowB, ax, acc);
        const float cs = u2f(ax.cs);
#pragma unroll
        for (int tcg = 0; tcg < 4; ++tcg) {
            const unsigned oo = ((unsigned)t * (unsigned)D + 256u * sl + 64u * tcg + (unsigned)lane) * 4u;
            *(float*)((unsigned char*)p.out + oo) = bf2f(ax.xo[tcg]) + (float)acc[tcg] * cs;
        }
        if (more) ax = axn;
    }
}
template <int PASS>
__device__ __forceinline__ void ph_peer(const Params& p, unsigned char* lds) {
    const int tid_ = phase_tid();
    const int lane = tid_ & 63, w = tid_ >> 6, b = blockIdx.x, G = gridDim.x;
    if ((G & 7) == 0) {
        const int g = b & 7, nsw = (G >> 3) * 2 * (NTHR / 64), t0 = ((g >> 2) * (G >> 3) + (b >> 3)) * (NTHR / 64) + w;
        if (PASS == 0) peer_stream<0>(p, lds, tid_, g & 3, t0, nsw, t0 < S ? (S - 1 - t0) / nsw + 1 : 0);
        else peerv_stream(p, lds, tid_, g & 3, t0, nsw, t0 < S ? (S - 1 - t0) / nsw + 1 : 0);
    } else {
        const int nw = G * (NTHR / 64), it0 = b * (NTHR / 64) + w;
        for (int it = it0; it < S * 4; it += nw) { if (PASS == 0) peer_stream<0>(p, lds, tid_, it & 3, it >> 2, 0, 1); else peerv_stream(p, lds, tid_, it & 3, it >> 2, 0, 1); }
    }
}
__device__ __forceinline__ void ph_peer_combine(const Params& p) {
    unsigned char* ws = p.ws;
    const int* seli = (const int*)(ws + WS_SELI); const float* selg = (const float*)(ws + WS_SELG); const float* rstd2 = (const float*)(ws + WS_RSTD2);
    const float2* uvsc = (const float2*)(ws + WS_USC);
    const float* pd = (const float*)(ws + WS_PD);
    unsigned* cpl = (unsigned*)(ws + WS_CBUF); float* csc = (float*)(ws + WS_CSC);
    const int tid_ = phase_tid(), lane = tid_ & 63, gwave = (blockIdx.x * blockDim.x + tid_) >> 6, nwave = (gridDim.x * blockDim.x) >> 6;
    for (int t = gwave; t < S; t += nwave) {
        float cf[2];
#pragma unroll
        for (int hf = 0; hf < 2; ++hf) {
            const int e = t * 128 + 64 * hf + lane;
            float d = 0.f;
#pragma unroll
            for (int g = 0; g < 4; ++g) d += pd[(size_t)g * S * 128 + e];
            const float2 sc2 = uvsc[seli[e]];
            cf[hf] = selg[e] * gelu_tanh(d * sc2.x * rstd2[t]) * sc2.y;
        }
        float m = fmaxf(fabsf(cf[0]), fabsf(cf[1]));
#pragma unroll
        for (int o = 1; o < 64; o <<= 1) m = fmaxf(m, __shfl_xor(m, o));
        const float inv = m > 0.f ? 119.0f / m : 0.f;
#pragma unroll
        for (int hf = 0; hf < 2; ++hf) {
            const int q = __float2int_rn(cf[hf] * inv);
            unsigned dl = (unsigned)(q & 15) << (4 * (lane & 7)), dh = (unsigned)(((q + 8) >> 4) & 15) << (4 * (lane & 7));
            dl |= __shfl_xor(dl, 1); dh |= __shfl_xor(dh, 1); dl |= __shfl_xor(dl, 2); dh |= __shfl_xor(dh, 2); dl |= __shfl_xor(dl, 4); dh |= __shfl_xor(dh, 4);
            if ((lane & 7) == 0) {
                const int dk = 8 * hf + (lane >> 3), rs = dk >> 1, half = dk & 1;
                cpl[(size_t)t * 32 + 4 * rs + half] = dl; cpl[(size_t)t * 32 + 4 * rs + 2 + half] = dh;
            }
        }
        if (lane == 0) csc[t] = m * (1.0f / 119.0f);
    }
}

#define LAS __attribute__((address_space(3)))
#define XB_TMO      128
#define XB_XCNT(j)  (256  + 64 * (j))
#define XB_XSUB(j)  (1280 + 64 * (j))
#define XB_XGEN(j)  (2304 + 64 * (j))
#define XB_TOP      3328
#define XB_TOPGEN   3392
#define XCD_BAR_WORDS 3456
#define XB_SPIN_CAP (1u << 18)
__device__ __forceinline__ unsigned xb_ld(unsigned* p)              { return __hip_atomic_load(p, __ATOMIC_RELAXED, __HIP_MEMORY_SCOPE_AGENT); }
__device__ __forceinline__ unsigned xb_add(unsigned* p, unsigned v) { return __hip_atomic_fetch_add(p, v, __ATOMIC_RELAXED, __HIP_MEMORY_SCOPE_AGENT); }
__device__ __forceinline__ unsigned xb_xcc_id() { return (unsigned)__builtin_amdgcn_s_getreg((3 << 11) | 20) & 0xFu; }
#define XB_SPIN(cond, bar) do { unsigned _sp = 0; while (cond) { __builtin_amdgcn_s_sleep(1); \
    if ((++_sp & 255u) == 0u) { if (xb_ld(&(bar)[XB_TMO])) break; if (_sp > XB_SPIN_CAP) { atomicAdd(&(bar)[XB_TMO], 1u); break; } } } } while (0)
struct XcdBarrier { unsigned* bar; unsigned x; volatile LAS unsigned* st; };
__device__ __forceinline__ XcdBarrier xcd_barrier_post(unsigned* bar, volatile LAS unsigned* st) {
    XcdBarrier b; b.bar = bar; b.x = xb_xcc_id(); b.st = st;
    if (threadIdx.x == 0) (void)xb_add(&bar[XB_XCNT(b.x)], 1u);
    return b;
}
__device__ __forceinline__ void xcd_barrier_complete(unsigned* bar, unsigned x, unsigned& nloc, unsigned& nx) {
    const unsigned G = gridDim.x * gridDim.y * gridDim.z;
    unsigned sum, cnt, mine, sp = 0u;
    for (;;) {
        sum = 0u; cnt = 0u; mine = 0u;
#pragma unroll
        for (unsigned j = 0; j < 16; ++j) { const unsigned c = xb_ld(&bar[XB_XCNT(j)]); sum += c; cnt += (c > 0u) ? 1u : 0u; mine = (j == x) ? c : mine; }
        if (sum == G) break;
        __builtin_amdgcn_s_sleep(1);
        if ((++sp & 255u) == 0u) { if (xb_ld(&bar[XB_TMO])) break; if (sp > XB_SPIN_CAP) { atomicAdd(&bar[XB_TMO], 1u); break; } }
    }
    nloc = mine > 0u ? mine : 1u; nx = cnt > 0u ? cnt : 1u;
}
__device__ __forceinline__ void xcd_barrier(const XcdBarrier& b) {
    asm volatile("s_waitcnt vmcnt(0)" ::: "memory");
    __syncthreads();
    if (threadIdx.x == 0) {
        unsigned* bar = b.bar;
        __builtin_amdgcn_s_waitcnt(0);
        unsigned nloc = b.st[0], nx = b.st[1];
        if (nloc == 0u) { xcd_barrier_complete(bar, b.x, nloc, nx); b.st[0] = nloc; b.st[1] = nx; }
        const unsigned old = xb_add(&bar[XB_XSUB(b.x)], 1u);
        const unsigned gen = old / nloc;
        if (old + 1u == (gen + 1u) * nloc) {
            __builtin_amdgcn_fence(__ATOMIC_RELEASE, "agent");
            asm volatile("s_waitcnt vmcnt(0)" ::: "memory");
            const unsigned og = xb_add(&bar[XB_TOP], 1u);
            const unsigned tg = og / nx;
            if (og + 1u == (tg + 1u) * nx) xb_add(&bar[XB_TOPGEN], 1u);
            else XB_SPIN(xb_ld(&bar[XB_TOPGEN]) == tg, bar);
            __builtin_amdgcn_fence(__ATOMIC_ACQUIRE, "agent");
            xb_add(&bar[XB_XGEN(b.x)], 1u);
            asm volatile("s_waitcnt vmcnt(0)" ::: "memory");
        } else {
            XB_SPIN(xb_ld(&bar[XB_XGEN(b.x)]) == gen, bar);
            __builtin_amdgcn_fence(__ATOMIC_ACQUIRE, "agent");
            asm volatile("s_waitcnt vmcnt(0)" ::: "memory");
        }
    }
    __syncthreads();
}

constexpr int LDS_MISC = 158720;
constexpr int LDS_BYTES = LDS_MISC + 1024;

__global__ void __launch_bounds__(NTHR, 2) hymba_fwd(Params p) {
    extern __shared__ __attribute__((aligned(16))) unsigned char lds[];
    volatile LAS unsigned* misc = (volatile LAS unsigned*)((LAS unsigned char*)lds + LDS_MISC);
    if (threadIdx.x < 4) misc[threadIdx.x] = 0u;
    __syncthreads();
    XcdBarrier bar = xcd_barrier_post((unsigned*)(p.ws + WS_CTL), misc);

    PG8_LAS unsigned char* ring = (PG8_LAS unsigned char*)lds;
    unsigned char* ws = p.ws;
    ph_prep(p, lds);                          xcd_barrier(bar);
    {
        pg8::Gemm g{(const bf16_t*)(ws + WS_A), (const bf16_t*)(ws + WS_WINT), S, NPROJ, D}; pg8::StaticOrder so; so.init(S, NPROJ, (int)gridDim.x, (int)blockIdx.x);
        EpiInProj E{(const float*)(ws + WS_RSTD1), p.in[I_Q_NORM], p.in[I_K_NORM], (bf16_t*)(ws + WS_QH), (bf16_t*)(ws + WS_KH), (bf16_t*)(ws + WS_VH), (bf16_t*)(ws + WS_XRG), (bf16_t*)(ws + WS_GG)};
        pg8::gemm_phase<EpiInProj, pg8::StaticOrder, true, true>(ring, g, so, E);
        const int G = (int)gridDim.x, nunits = (S / 256) * (NPROJ / 256), rem = nunits % G, b = (int)blockIdx.x;
        const int tid_ = phase_tid(), w = tid_ >> 6, lane = tid_ & 63;
        if (rem == 0) ph_tables(p, b * (NTHR / 64) + w, G * (NTHR / 64), lane);
        else if (b >= rem) ph_tables(p, (b - rem) * (NTHR / 64) + w, (G - rem) * (NTHR / 64), lane);
    }
    xcd_barrier(bar);
    ph_attn(p); ph_rg<0>(p, lds);             xcd_barrier(bar);
    ph_rg<1>(p, lds);                         xcd_barrier(bar);
    {
        pg8::Gemm g{(const bf16_t*)(ws + WS_MIX), (const bf16_t*)(ws + WS_WOUTT), S, D, D}; pg8::StaticOrder so; so.init(S, D, (int)gridDim.x, (int)blockIdx.x);
        EpiOutProj E{p.in[I_X], (bf16_t*)(ws + WS_A), (float*)(ws + WS_SSQ), ws + WS_X1Q, (float*)(ws + WS_XSC)};
        pg8::gemm_phase<EpiOutProj, pg8::StaticOrder, true, true>(ring, g, so, E);
    }
    xcd_barrier(bar);
    {
        pg8::Gemm g{(const bf16_t*)(ws + WS_A), (const bf16_t*)(ws + WS_WQT), S, NQ, D}; pg8::StaticOrder so; so.init(S, NQ, (int)gridDim.x, (int)blockIdx.x);
        EpiPeerQ E{(bf16_t*)(ws + WS_B)};
        pg8::gemm_phase<EpiPeerQ, pg8::StaticOrder, true, true>(ring, g, so, E);
    }
    asm volatile("s_waitcnt vmcnt(0)" ::: "memory"); __syncthreads();
    ph_topk(p, (int*)lds);                    xcd_barrier(bar);
    ph_peer<0>(p, lds);                       xcd_barrier(bar);
    ph_peer_combine(p);                       xcd_barrier(bar);
    ph_peer<1>(p, lds);
}

extern "C" void kernel_launch(void* const* d_in, const int* in_sizes, int n_in, void* d_out, int out_size, void* d_ws, size_t ws_size, hipStream_t stream) {
    static int grid = 0;
    if (grid == 0) {
        if (n_in != 20 || out_size != S * D || ws_size < WS_END) { fprintf(stderr, "kernel_launch: unexpected shapes (n_in %d out %d ws %zu)\n", n_in, out_size, ws_size); grid = -1; return; }
        int dev = 0, cus = 0, per_cu = 0;
        if (hipGetDevice(&dev) != hipSuccess || hipDeviceGetAttribute(&cus, hipDeviceAttributeMultiprocessorCount, dev) != hipSuccess) { grid = -1; return; }
        if (hipFuncSetAttribute((const void*)hymba_fwd, hipFuncAttributeMaxDynamicSharedMemorySize, LDS_BYTES) != hipSuccess) { fprintf(stderr, "kernel_launch: hipFuncSetAttribute failed\n"); grid = -1; return; }
        if (hipOccupancyMaxActiveBlocksPerMultiprocessor(&per_cu, (const void*)hymba_fwd, NTHR, LDS_BYTES) != hipSuccess || per_cu < 1) { fprintf(stderr, "kernel_launch: occupancy query says %d blocks per CU\n", per_cu); grid = -1; return; }
        (void)hipGetLastError();
        grid = cus;
    }
    if (grid < 0) return;
    (void)hipMemsetAsync((char*)d_ws + WS_CTL, 0, XCD_BAR_WORDS * 4, stream);
    Params p{};
    for (int i = 0; i < 20; ++i) p.in[i] = (const float*)d_in[i];
    p.out = (float*)d_out; p.ws = (unsigned char*)d_ws;
    hipLaunchKernelGGL(hymba_fwd, dim3(grid), dim3(NTHR), LDS_BYTES, stream, p);
}
```

```cpp
#include <hip/hip_runtime.h>
#include <cstdint>
#include <cstdio>

typedef unsigned short bf16_t;
typedef short bf16x8 __attribute__((ext_vector_type(8)));
typedef float f32x4 __attribute__((ext_vector_type(4)));
typedef unsigned u32x4 __attribute__((ext_vector_type(4)));
typedef float f32x16 __attribute__((ext_vector_type(16)));

constexpr int S = 16384, D = 1024, NPROJ = 2560, DSB = 512, DRG = 512, NH = 8, HD = 64;
constexpr int PH = 8, PNK = 128, PDK = 256, PHALF = 128, PTOPK = 16, NEXP = 16384, NQ = PH * PDK;
constexpr int CHUNK = 64, NCHUNK = S / CHUNK;
constexpr float EPS = 1e-6f;
constexpr float LOG2E = 1.4426950408889634f;
constexpr float QSCALE = 0.125f * LOG2E;
constexpr int NTHR = 512;
constexpr float CARRY_STOP = -160.0f;

constexpr size_t MiB = 1u << 20;
constexpr size_t WS_CTL = 0;
constexpr size_t WS_WINT = 1 * MiB;
constexpr size_t WS_WOUTT = 6 * MiB;
constexpr size_t WS_WQT = 8 * MiB;
constexpr size_t WS_SUBK = 12 * MiB;
constexpr size_t WS_RSTD1 = 12 * MiB + 512 * 1024;
constexpr size_t WS_RSTD2 = WS_RSTD1 + 64 * 1024;
constexpr size_t WS_RGP = WS_RSTD2 + 64 * 1024;
constexpr size_t WS_RGH = WS_RGP + 512 * 1024;
constexpr size_t WS_RGSA = 14 * MiB, WS_RGSB = 30 * MiB;
constexpr size_t WS_A = 14 * MiB;
constexpr size_t WS_B = 46 * MiB;
constexpr size_t WS_QH = WS_B, WS_KH = WS_B + 16 * MiB, WS_VH = WS_B + 32 * MiB, WS_XRG = WS_B + 48 * MiB;
constexpr size_t WS_GG = 110 * MiB;
constexpr size_t WS_OSB = 126 * MiB;
constexpr size_t WS_MIX = 142 * MiB;
constexpr size_t WS_SELI = WS_MIX, WS_SELG = WS_MIX + 8 * MiB;
constexpr size_t WS_PD = WS_B;
constexpr size_t WS_CBUF = WS_GG;
constexpr size_t WS_CSC = WS_GG + 4 * MiB;
constexpr size_t WS_X1Q = WS_OSB;
constexpr size_t WS_XSC = WS_GG + 8 * MiB;
constexpr size_t WS_UB = 174 * MiB;
constexpr size_t WS_VB = 190 * MiB;
constexpr size_t WS_USC = 206 * MiB;
constexpr size_t WS_SSQ = 238 * MiB;
constexpr size_t WS_RGW = 239 * MiB;
constexpr size_t WS_END = 240 * MiB;

__device__ __forceinline__ unsigned f2bf(float f) { unsigned u = __builtin_bit_cast(unsigned, f); return (u + 0x7fffu + ((u >> 16) & 1u)) >> 16; }
__device__ __forceinline__ float u2f(unsigned u) { return __builtin_bit_cast(float, u); }
__device__ __forceinline__ float bf2f(unsigned h) { return __builtin_bit_cast(float, h << 16); }
__device__ __forceinline__ unsigned pk2(float lo, float hi) { return f2bf(lo) | (f2bf(hi) << 16); }
__device__ __forceinline__ unsigned pack_i8(float a, float b, float c, float d) {
    const int qa = __float2int_rn(a), qb = __float2int_rn(b), qc = __float2int_rn(c), qd = __float2int_rn(d);
    return (unsigned)(qa & 255) | ((unsigned)(qb & 255) << 8) | ((unsigned)(qc & 255) << 16) | ((unsigned)qd << 24);
}
__device__ __forceinline__ unsigned pack_n4(float a, float b, float c, float d) {
    const int qa = min(max(__float2int_rn(a), -7), 7) & 15, qb = min(max(__float2int_rn(b), -7), 7) & 15, qc = min(max(__float2int_rn(c), -7), 7) & 15, qd = min(max(__float2int_rn(d), -7), 7) & 15;
    return (unsigned)qa | ((unsigned)qb << 4) | ((unsigned)qc << 8) | ((unsigned)qd << 12);
}
template <int OFFS>
__device__ __forceinline__ unsigned pack_u4(float a, float b, float c, float d) {
    const int qa = (min(max(__float2int_rn(a), -7), 7) + OFFS) & 15, qb = (min(max(__float2int_rn(b), -7), 7) + OFFS) & 15, qc = (min(max(__float2int_rn(c), -7), 7) + OFFS) & 15, qd = (min(max(__float2int_rn(d), -7), 7) + OFFS) & 15;
    return (unsigned)qa | ((unsigned)qb << 8) | ((unsigned)qc << 16) | ((unsigned)qd << 24);
}
__device__ __forceinline__ float wave_sum(float v) {
#pragma unroll
    for (int o = 1; o < 64; o <<= 1) v += __shfl_xor(v, o);
    return v;
}
__device__ __forceinline__ float gelu_tanh(float x) {
    const float u = 0.7978845608028654f * (x + 0.044715f * x * x * x);
    const float e = __expf(2.0f * u);
    const float th = 1.0f - 2.0f / (e + 1.0f);
    return 0.5f * x * (1.0f + th);
}

__host__ __device__ __forceinline__ int inproj_phys_row(int nlog) { const int t = nlog >> 8, L = nlog & 255; return (t << 8) + 128 * ((L & 63) >> 5) + 32 * (L >> 6) + (L & 31); }

__device__ __forceinline__ int phase_tid() { int t = threadIdx.x; asm volatile("" : "+v"(t)); return t; }

struct Params {
    const float* in[20];
    float* out;
    unsigned char* ws;
};
enum { I_X = 0, I_NORM_MIX, I_W_IN, I_Q_NORM, I_K_NORM, I_CONV_W, I_CONV_B, I_RG_W_A, I_RG_B_A, I_RG_W_X, I_RG_B_X, I_RG_LAMBDA,
       I_OUT_NORM_SB, I_OUT_NORM_RG, I_W_OUT, I_NORM_FFN, I_PEER_WQ, I_PEER_SUBK, I_PEER_U, I_PEER_V };

template <bool INPROJ_PERM>
__device__ __forceinline__ void prep_transpose_item(const float* W, const float* gain0, const float* gain1, int K, int N, bf16_t* WT, float* scr, int item, int lane) {
    const int nblk = N / 32, kb = item / nblk, nb = item % nblk, k0 = 64 * kb, n0 = 32 * nb;
#pragma unroll 8
    for (int i = 0; i < 32; ++i) {
        const int kk = 2 * i + (lane >> 5), k = k0 + kk;
        const float g = (gain1 && k >= 512) ? gain1[k - 512] : gain0[k];
        scr[kk * 33 + (lane & 31)] = g * W[(size_t)k * N + n0 + (lane & 31)];
    }
    asm volatile("s_waitcnt lgkmcnt(0)" ::: "memory");
    const int c = lane & 7;
#pragma unroll
    for (int j = 0; j < 4; ++j) {
        const int n = (lane >> 3) + 8 * j; const float* s = scr + (8 * c) * 33 + n;
        u32x4 o; o.x = pk2(s[0 * 33], s[1 * 33]); o.y = pk2(s[2 * 33], s[3 * 33]); o.z = pk2(s[4 * 33], s[5 * 33]); o.w = pk2(s[6 * 33], s[7 * 33]);
        const int nr = INPROJ_PERM ? inproj_phys_row(n0 + n) : n0 + n;
        *(u32x4*)(WT + (size_t)nr * K + k0 + 8 * c) = o;
    }
    asm volatile("s_waitcnt lgkmcnt(0)" ::: "memory");
}
__device__ __forceinline__ void ph_tables(const Params& p, int cw, int ncw, int lane) {
    unsigned char* ws = p.ws;
    {
        const float* u = p.in[I_PEER_U]; const float* v = p.in[I_PEER_V]; const float* g = p.in[I_NORM_FFN];
        unsigned* ub = (unsigned*)(ws + WS_UB); unsigned* vb = (unsigned*)(ws + WS_VB); float2* uvsc = (float2*)(ws + WS_USC);
        f32x4 gq[4];
#pragma unroll
        for (int j = 0; j < 4; ++j) gq[j] = *((const f32x4*)g + lane + 64 * j);
        for (int e0 = cw; e0 < NEXP; e0 += 2 * ncw) {
            f32x4 a[2][4], b[2][4]; float ma[2], mb[2], sa2[2], sb2[2];
#pragma unroll
            for (int rr = 0; rr < 2; ++rr) {
                const int e = min(e0 + rr * ncw, NEXP - 1);
#pragma unroll
                for (int j = 0; j < 4; ++j) { a[rr][j] = *((const f32x4*)(u + (size_t)e * D) + lane + 64 * j); b[rr][j] = *((const f32x4*)(v + (size_t)e * D) + lane + 64 * j); }
            }
#pragma unroll
            for (int rr = 0; rr < 2; ++rr) {
                ma[rr] = 0.f; mb[rr] = 0.f; sa2[rr] = 0.f; sb2[rr] = 0.f;
#pragma unroll
                for (int j = 0; j < 4; ++j) {
                    a[rr][j] = a[rr][j] * gq[j];
                    const f32x4 aa = a[rr][j], bb = b[rr][j];
                    ma[rr] = fmaxf(ma[rr], fmaxf(fmaxf(fabsf(aa.x), fabsf(aa.y)), fmaxf(fabsf(aa.z), fabsf(aa.w))));
                    mb[rr] = fmaxf(mb[rr], fmaxf(fmaxf(fabsf(bb.x), fabsf(bb.y)), fmaxf(fabsf(bb.z), fabsf(bb.w))));
                    sa2[rr] += (aa.x * aa.x + aa.y * aa.y) + (aa.z * aa.z + aa.w * aa.w);
                    sb2[rr] += (bb.x * bb.x + bb.y * bb.y) + (bb.z * bb.z + bb.w * bb.w);
                }
            }
#pragma unroll
            for (int o = 1; o < 64; o <<= 1)
#pragma unroll
                for (int rr = 0; rr < 2; ++rr) { ma[rr] = fmaxf(ma[rr], __shfl_xor(ma[rr], o)); mb[rr] = fmaxf(mb[rr], __shfl_xor(mb[rr], o)); sa2[rr] += __shfl_xor(sa2[rr], o); sb2[rr] += __shfl_xor(sb2[rr], o); }
#pragma unroll
            for (int rr = 0; rr < 2; ++rr) {
                const int e = e0 + rr * ncw;
                if (e < NEXP) {
                    const float ca = fminf(ma[rr], 2.5f * sqrtf(sa2[rr] * (1.0f / D))), cb = fminf(mb[rr], 2.5f * sqrtf(sb2[rr] * (1.0f / D)));
                    const float ia = ca > 0.f ? 7.0f / ca : 0.f, ib = cb > 0.f ? 7.0f / cb : 0.f;
#pragma unroll
                    for (int j = 0; j < 4; ++j) {
                        const f32x4 aa = a[rr][j], bb = b[rr][j];
                        const unsigned na = pack_u4<0>(aa.x * ia, aa.y * ia, aa.z * ia, aa.w * ia), nb = pack_n4(bb.x * ib, bb.y * ib, bb.z * ib, bb.w * ib);
                        const unsigned pa = __shfl_xor(na, 1), pb = __shfl_xor(nb, 1);
                        if ((lane & 1) == 0) {
                            ub[((size_t)j * NEXP + e) * 32 + (lane >> 1)] = na | (pa << 4);
                            vb[((size_t)j * NEXP + e) * 32 + (lane >> 1)] = nb | (pb << 16);
                        }
                    }
                    if (lane == 0) uvsc[e] = make_float2(ca * (1.0f / 7.0f), cb * (1.0f / 7.0f));
                }
            }
        }
    }
}

__device__ __forceinline__ void ph_prep(const Params& p, unsigned char* lds) {
    const int tid_ = phase_tid();
    const int gtid = blockIdx.x * blockDim.x + tid_, gsize = gridDim.x * blockDim.x;
    const int lane = tid_ & 63, gwave = gtid >> 6, nwave = gsize >> 6;
    unsigned char* ws = p.ws;
    {
        float* scr = (float*)lds + (tid_ >> 6) * (64 * 33);
        constexpr int I_IN = (D / 64) * (NPROJ / 32), I_OUT = (D / 64) * (D / 32), I_Q = (D / 64) * (NQ / 32);
        for (int it = gwave; it < I_IN + I_OUT + I_Q; it += nwave) {
            if (it < I_IN) prep_transpose_item<true>(p.in[I_W_IN], p.in[I_NORM_MIX], nullptr, D, NPROJ, (bf16_t*)(ws + WS_WINT), scr, it, lane);
            else if (it < I_IN + I_OUT) prep_transpose_item<false>(p.in[I_W_OUT], p.in[I_OUT_NORM_SB], p.in[I_OUT_NORM_RG], D, D, (bf16_t*)(ws + WS_WOUTT), scr, it - I_IN, lane);
            else prep_transpose_item<false>(p.in[I_PEER_WQ], p.in[I_NORM_FFN], nullptr, D, NQ, (bf16_t*)(ws + WS_WQT), scr, it - I_IN - I_OUT, lane);
        }
    }
    {
        const float* wa = p.in[I_RG_W_A]; const float* wx = p.in[I_RG_W_X]; bf16_t* o = (bf16_t*)(ws + WS_RGW);
        for (int e = gtid; e < 8 * 2 * 2 * 4 * 64 * 8; e += gsize) {
            const int el = e & 7, ln = (e >> 3) & 63, s = (e >> 9) & 3, jt = (e >> 11) & 1, g = (e >> 12) & 1, n = e >> 13;
            const int j = 32 * jt + (ln & 31), i = 16 * s + 8 * (el >> 2) + 4 * (ln >> 5) + (el & 3);
            o[e] = (bf16_t)f2bf((g == 0 ? wa : wx)[((size_t)n * 64 + i) * 64 + j]);
        }
    }
    {
        const float* sk = p.in[I_PEER_SUBK]; bf16_t* o = (bf16_t*)(ws + WS_SUBK);
        for (int e = gtid; e < PH * 2 * PNK * PHALF; e += gsize) o[e] = (bf16_t)f2bf(sk[e]);
    }
    {
        const float* x = p.in[I_X]; bf16_t* xb = (bf16_t*)(ws + WS_A); float* rstd1 = (float*)(ws + WS_RSTD1);
        for (int row0 = gwave; row0 < S; row0 += 4 * nwave) {
            f32x4 v[4][4];
#pragma unroll
            for (int rr = 0; rr < 4; ++rr) {
                const int row = min(row0 + rr * nwave, S - 1);
#pragma unroll
                for (int j = 0; j < 4; ++j) v[rr][j] = ((const f32x4*)(x + (size_t)row * D) + lane)[64 * j];
            }
#pragma unroll
            for (int rr = 0; rr < 4; ++rr) {
                const int row = row0 + rr * nwave;
                float ss = 0.f;
#pragma unroll
                for (int j = 0; j < 4; ++j) ss += (v[rr][j].x * v[rr][j].x + v[rr][j].y * v[rr][j].y) + (v[rr][j].z * v[rr][j].z + v[rr][j].w * v[rr][j].w);
                ss = wave_sum(ss);
                if (row < S) {
                    uint2* o = (uint2*)(xb + (size_t)row * D) + lane;
#pragma unroll
                    for (int j = 0; j < 4; ++j) o[64 * j] = make_uint2(pk2(v[rr][j].x, v[rr][j].y), pk2(v[rr][j].z, v[rr][j].w));
                    if (lane == 0) rstd1[row] = rsqrtf(ss * (1.0f / D) + EPS);
                }
            }
        }
    }
}

namespace pg8 {
#define PG8_LAS __attribute__((address_space(3)))
typedef unsigned short bf16_t;
typedef short bf16x8 __attribute__((ext_vector_type(8)));
typedef float f32x4 __attribute__((ext_vector_type(4)));
typedef unsigned u32x4 __attribute__((ext_vector_type(4)));
constexpr int BM = 256, BK = 64, HALF = 128, HTB = HALF * BK * 2  , STAGE_BYTES = 8 * HTB, NXCD = 8, WGM = 8;

__host__ __device__ __forceinline__ int lds_byte(int r, int c) { const int st = (r >> 4) * 2 + (c >> 5), rr = r & 15, cc = c & 31, ob = rr * 64 + cc * 2; return st * 1024 + (ob ^ (((ob >> 9) & 1) << 5)); }
__host__ __device__ __forceinline__ void stage_rc(int b, int& R, int& C) { const int st = b / 1024, sb = b % 1024, swz = sb ^ (((sb >> 9) & 1) << 5); R = (st >> 1) * 16 + swz / 64; C = (st & 1) * 32 + (swz % 64) / 2; }
__host__ __device__ __forceinline__ int perm32(int rho) { const int n = rho >> 4, i = rho & 15; return 8 * (i >> 2) + 4 * n + (i & 3); }

struct Unit { int pm, pn; };
struct Gemm { const bf16_t* A; const bf16_t* Bt; int M, N, K; };

struct StaticOrder {
    int nM, nN, nwg, G, c;
    __host__ __device__ void init(int M, int N, int G_, int c_) { nM = M / BM; nN = N / BM; nwg = nM * nN; G = G_; c = c_; }
    __host__ __device__ bool next(int i, Unit& u) const {
        const long L = (long)i * G + c; if (L >= nwg) return false;
        int wgid = (int)L; { const int q = nwg / NXCD, r = nwg % NXCD, xcd = wgid % NXCD, off = wgid / NXCD; wgid = (xcd < r ? xcd * (q + 1) : r * (q + 1) + (xcd - r) * q) + off; }
        const int nig = WGM * nN, gid = wgid / nig, fm = gid * WGM, gsz = (nM - fm) < WGM ? (nM - fm) : WGM;
        u.pm = fm + ((wgid % nig) % gsz); u.pn = (wgid % nig) / gsz; return true;
    }
    __device__ __forceinline__ void a_ready(const Unit&) const {}
    __device__ __forceinline__ void done(const Unit&) const {}
};

__device__ __forceinline__ unsigned cvt_pk_bf16(float lo, float hi) { unsigned r; asm volatile("v_cvt_pk_bf16_f32 %0, %1, %2" : "=v"(r) : "v"(lo), "v"(hi)); return r; }
template <class Epi, class Sched, bool ALIGN_EPI = false, bool SP2 = false>
__device__ __forceinline__ void gemm_phase(PG8_LAS unsigned char* lds, const Gemm g, const Sched& S, const Epi& E) {
    const int tid = phase_tid(), wid = __builtin_amdgcn_readfirstlane(tid >> 6), lane = tid & 63, wr = wid >> 2, wc = wid & 3, fr = lane & 15, fq = lane >> 4;
    const int K = g.K, nt = K / BK;
    unsigned voffA[2], voffB[2];
#pragma unroll
    for (int i = 0; i < 2; ++i) { int R, C; stage_rc(tid * 16 + i * 8192, R, C); const int Rb = Epi::PERM ? ((R & ~31) + perm32(R & 31)) : R;
        voffA[i] = (unsigned)(R * K + C) * 2u; voffB[i] = (unsigned)(Rb * K + C) * 2u; }
    const size_t kstep = (size_t)(BK * 2);
    const size_t hstep = (size_t)HALF * K * 2;
    const size_t tstep = 2 * hstep;
    const unsigned ldsw = (unsigned)wid * 1024u;
    const int aoff = lds_byte(wr * 64 + fr, fq * 8), boff = lds_byte(wc * 32 + fr, fq * 8);
#define PG8_SA(b, h) (((b) * 2 + (h)) * HTB)
#define PG8_SB(b, h) ((4 + (b) * 2 + (h)) * HTB)
#define PG8_STAGE(bufoff, gbase, voff) do { _Pragma("unroll") for (int _i = 0; _i < 2; ++_i) \
        __builtin_amdgcn_global_load_lds((const unsigned*)((const char*)(gbase) + (voff)[_i]), (PG8_LAS unsigned*)(lds + (bufoff) + ldsw + _i * 8192), 16, 0, 0); } while (0)
#define PG8_LDA(dst, b, h) do { _Pragma("unroll") for (int m = 0; m < 4; ++m) _Pragma("unroll") for (int k = 0; k < 2; ++k) dst[m][k] = *(const PG8_LAS bf16x8*)(lds + PG8_SA(b, h) + aoff + m * 2048 + k * 1024); } while (0)
#define PG8_LDB(dst, b, h) do { _Pragma("unroll") for (int n = 0; n < 2; ++n) _Pragma("unroll") for (int k = 0; k < 2; ++k) dst[n][k] = *(const PG8_LAS bf16x8*)(lds + PG8_SB(b, h) + boff + n * 2048 + k * 1024); } while (0)
#define PG8_MMA(ai, bj, At, Bt) do { __builtin_amdgcn_s_setprio(1); _Pragma("unroll") for (int m = 0; m < 4; ++m) _Pragma("unroll") for (int n = 0; n < 2; ++n) _Pragma("unroll") for (int k = 0; k < 2; ++k) \
        acc[ai][bj][m][n] = __builtin_amdgcn_mfma_f32_16x16x32_bf16(Bt[n][k], At[m][k], acc[ai][bj][m][n], 0, 0, 0); __builtin_amdgcn_s_setprio(0); } while (0)
#define PG8_WAIT_V(n) asm volatile("s_waitcnt vmcnt(" #n ")" ::: "memory")
#define PG8_WAIT_L(n) asm volatile("s_waitcnt lgkmcnt(" #n ")" ::: "memory")
#define PG8_BAR __builtin_amdgcn_s_barrier()
#define PG8_SCHED __builtin_amdgcn_sched_barrier(0)
    Unit cur, nxt; int ui = 0;
    if (!S.next(0, cur)) return;
    f32x4 acc[2][2][4][2];
#pragma unroll
    for (int a = 0; a < 2; ++a)
#pragma unroll
        for (int b = 0; b < 2; ++b)
#pragma unroll
            for (int m = 0; m < 4; ++m)
#pragma unroll
                for (int n = 0; n < 2; ++n) acc[a][b][m][n] = (f32x4){0.f, 0.f, 0.f, 0.f};
    bf16x8 At[4][2], B0[2][2], B1[2][2];
    const char* cA = (const char*)g.A + (size_t)cur.pm * tstep; const char* cB = (const char*)g.Bt + (size_t)cur.pn * tstep;
    S.a_ready(cur);
    if constexpr (SP2) {
        PG8_STAGE(PG8_SB(0, 0), cB, voffB); PG8_STAGE(PG8_SB(0, 1), cB + hstep, voffB); PG8_STAGE(PG8_SA(0, 0), cA, voffA); PG8_STAGE(PG8_SA(0, 1), cA + hstep, voffA);
        if (wr == 1) PG8_BAR;
        PG8_WAIT_V(2); PG8_BAR;
        PG8_STAGE(PG8_SB(1, 0), cB + kstep, voffB); PG8_STAGE(PG8_SA(1, 0), cA + kstep, voffA); PG8_STAGE(PG8_SB(1, 1), cB + hstep + kstep, voffB);
        PG8_WAIT_V(6); PG8_BAR;
    } else {
        PG8_STAGE(PG8_SB(0, 0), cB, voffB); PG8_STAGE(PG8_SA(0, 0), cA, voffA); PG8_STAGE(PG8_SB(0, 1), cB + hstep, voffB); PG8_STAGE(PG8_SA(0, 1), cA + hstep, voffA);
        if (wr == 1) PG8_BAR;
        PG8_WAIT_V(4); PG8_BAR;
        PG8_STAGE(PG8_SB(1, 0), cB + kstep, voffB); PG8_STAGE(PG8_SA(1, 0), cA + kstep, voffA); PG8_STAGE(PG8_SB(1, 1), cB + hstep + kstep, voffB);
        PG8_WAIT_V(6); PG8_BAR;
    }
    for (;;) {
        const bool has_next = S.next(ui + 1, nxt);
        const char* nA = has_next ? (const char*)g.A + (size_t)nxt.pm * tstep : cA; const char* nB = has_next ? (const char*)g.Bt + (size_t)nxt.pn * tstep : cB;
        for (int t = 0; t < nt; t += 2) {
            const bool last = (t == nt - 2);
            const char* a1 = cA + (size_t)(t + 1) * kstep;
            const char* a2 = last ? nA : cA + (size_t)(t + 2) * kstep; const char* b2 = last ? nB : cB + (size_t)(t + 2) * kstep;
            const char* a3 = a2 + kstep; const char* b3 = b2 + kstep;
            if (last && has_next) S.a_ready(nxt);
            if constexpr (SP2) {
            PG8_LDB(B0, 0, 0); PG8_LDB(B1, 0, 1); PG8_SCHED; PG8_LDA(At, 0, 0); PG8_STAGE(PG8_SA(1, 1), a1 + hstep, voffA);
            PG8_WAIT_V(8); PG8_WAIT_L(0); PG8_BAR; PG8_MMA(0, 0, At, B0); PG8_MMA(0, 1, At, B1); PG8_BAR; PG8_SCHED;
            PG8_LDA(At, 0, 1); PG8_STAGE(PG8_SB(0, 0), b2, voffB); PG8_STAGE(PG8_SB(0, 1), b2 + hstep, voffB); PG8_STAGE(PG8_SA(0, 0), a2, voffA);
            PG8_WAIT_V(8); PG8_WAIT_L(0); PG8_BAR; PG8_MMA(1, 0, At, B0); PG8_MMA(1, 1, At, B1); PG8_BAR; PG8_SCHED;
            PG8_LDB(B0, 1, 0); PG8_LDB(B1, 1, 1); PG8_SCHED; PG8_LDA(At, 1, 0); PG8_STAGE(PG8_SA(0, 1), a2 + hstep, voffA);
            PG8_WAIT_V(8); PG8_WAIT_L(0); PG8_BAR; PG8_MMA(0, 0, At, B0); PG8_MMA(0, 1, At, B1); PG8_BAR; PG8_SCHED;
            PG8_LDA(At, 1, 1); PG8_STAGE(PG8_SB(1, 0), b3, voffB); PG8_STAGE(PG8_SB(1, 1), b3 + hstep, voffB); PG8_STAGE(PG8_SA(1, 0), a3, voffA);
            PG8_WAIT_V(8); PG8_WAIT_L(0); PG8_BAR; PG8_MMA(1, 0, At, B0); PG8_MMA(1, 1, At, B1); PG8_BAR; PG8_SCHED;
            } else {
            PG8_LDB(B0, 0, 0); PG8_SCHED; PG8_LDA(At, 0, 0); PG8_STAGE(PG8_SA(1, 1), a1 + hstep, voffA);
            PG8_WAIT_L(8); PG8_BAR; PG8_WAIT_L(0); PG8_MMA(0, 0, At, B0); PG8_BAR; PG8_SCHED;
            PG8_LDB(B1, 0, 1); PG8_STAGE(PG8_SB(0, 0), b2, voffB);
            PG8_BAR; PG8_WAIT_L(0); PG8_MMA(0, 1, At, B1); PG8_BAR;
            PG8_LDA(At, 0, 1); PG8_STAGE(PG8_SA(0, 0), a2, voffA);
            PG8_BAR; PG8_WAIT_L(0); PG8_MMA(1, 0, At, B0); PG8_BAR; PG8_SCHED;
            PG8_STAGE(PG8_SB(0, 1), b2 + hstep, voffB);
            PG8_WAIT_V(6); PG8_BAR; PG8_MMA(1, 1, At, B1); PG8_BAR;
            PG8_LDB(B0, 1, 0); PG8_SCHED; PG8_LDA(At, 1, 0); PG8_STAGE(PG8_SA(0, 1), a2 + hstep, voffA);
            PG8_WAIT_L(8); PG8_BAR; PG8_WAIT_L(0); PG8_MMA(0, 0, At, B0); PG8_BAR; PG8_SCHED;
            PG8_LDB(B1, 1, 1); PG8_STAGE(PG8_SB(1, 0), b3, voffB);
            PG8_BAR; PG8_WAIT_L(0); PG8_MMA(0, 1, At, B1); PG8_BAR;
            PG8_LDA(At, 1, 1); PG8_STAGE(PG8_SA(1, 0), a3, voffA);
            PG8_BAR; PG8_WAIT_L(0); PG8_MMA(1, 0, At, B0); PG8_BAR; PG8_SCHED;
            PG8_STAGE(PG8_SB(1, 1), b3 + hstep, voffB);
            PG8_WAIT_V(6); PG8_BAR; PG8_MMA(1, 1, At, B1); PG8_BAR;
            }
        }
        if constexpr (ALIGN_EPI) { if (wr == 0) PG8_BAR; }
        if constexpr (!Epi::AFTER_DRAIN) { E(acc, cur, wr, wc, fr, fq); S.done(cur); }
        if (!has_next) break;
#pragma unroll
        for (int a = 0; a < 2; ++a)
#pragma unroll
            for (int b = 0; b < 2; ++b)
#pragma unroll
                for (int m = 0; m < 4; ++m)
#pragma unroll
                    for (int n = 0; n < 2; ++n) acc[a][b][m][n] = (f32x4){0.f, 0.f, 0.f, 0.f};
        cur = nxt; cA = nA; cB = nB; ++ui;
        if constexpr (ALIGN_EPI) { if (wr == 1) PG8_BAR; }
    }
    PG8_WAIT_V(0);
    if constexpr (!ALIGN_EPI) { if (wr == 0) PG8_BAR; }
    PG8_BAR;
    if constexpr (Epi::AFTER_DRAIN) { E.fused(acc, cur, wr, wc, fr, fq, lds, wid, lane); S.done(cur); }
#undef PG8_SA
#undef PG8_SB
#undef PG8_STAGE
#undef PG8_LDA
#undef PG8_LDB
#undef PG8_MMA
#undef PG8_WAIT_V
#undef PG8_WAIT_L
#undef PG8_BAR
#undef PG8_SCHED
}
}

struct EpiInProj {
    static constexpr bool PERM = true, AFTER_DRAIN = false;
    const float* rstd1; const float* qn; const float* kn; bf16_t *qh, *kh, *vh, *xrg, *gg;
    __device__ __forceinline__ void operator()(const pg8::f32x4 (&acc)[2][2][4][2], const pg8::Unit& u, int wr, int wc, int fr, int fq) const {
        const int region = u.pn >> 1;
        const int head = (u.pn & 1) * 4 + wc;
        float rsv[2][4];
#pragma unroll
        for (int ai = 0; ai < 2; ++ai)
#pragma unroll
            for (int m = 0; m < 4; ++m) rsv[ai][m] = rstd1[u.pm * 256 + ai * 128 + wr * 64 + m * 16 + fr];
        pg8::f32x4 gn[2][2];
        if (region <= 1) {
            const float* g = region == 0 ? qn : kn; const float sc = region == 0 ? QSCALE : 1.0f;
#pragma unroll
            for (int bj = 0; bj < 2; ++bj)
#pragma unroll
                for (int n = 0; n < 2; ++n) gn[bj][n] = *(const pg8::f32x4*)(g + 32 * bj + 8 * fq + 4 * n) * sc;
        }
#pragma unroll
        for (int ai = 0; ai < 2; ++ai)
#pragma unroll
            for (int m = 0; m < 4; ++m) {
                const int row = u.pm * 256 + ai * 128 + wr * 64 + m * 16 + fr;
                const float rs = rsv[ai][m];
                pg8::f32x4 v[2][2];
#pragma unroll
                for (int bj = 0; bj < 2; ++bj)
#pragma unroll
                    for (int n = 0; n < 2; ++n) v[bj][n] = acc[ai][bj][m][n] * rs;
                bf16_t* dst;
                if (region <= 1) {
                    float ss = 0.f;
#pragma unroll
                    for (int bj = 0; bj < 2; ++bj)
#pragma unroll
                        for (int n = 0; n < 2; ++n) ss += (v[bj][n][0] * v[bj][n][0] + v[bj][n][1] * v[bj][n][1]) + (v[bj][n][2] * v[bj][n][2] + v[bj][n][3] * v[bj][n][3]);
                    ss += __shfl_xor(ss, 16); ss += __shfl_xor(ss, 32);
                    const float rn = rsqrtf(ss * (1.0f / HD) + EPS);
#pragma unroll
                    for (int bj = 0; bj < 2; ++bj)
#pragma unroll
                        for (int n = 0; n < 2; ++n) v[bj][n] = v[bj][n] * rn * gn[bj][n];
                    bf16_t* fb = (region == 0 ? qh : kh) + ((size_t)(head * (S / 32) + (row >> 5)) * 4 * 64 + (row & 31)) * 8;
#pragma unroll
                    for (int bj = 0; bj < 2; ++bj) {
                        pg8::u32x4 w; w.x = pg8::cvt_pk_bf16(v[bj][0][0], v[bj][0][1]); w.y = pg8::cvt_pk_bf16(v[bj][0][2], v[bj][0][3]);
                        w.z = pg8::cvt_pk_bf16(v[bj][1][0], v[bj][1][1]); w.w = pg8::cvt_pk_bf16(v[bj][1][2], v[bj][1][3]);
                        *(pg8::u32x4*)(fb + ((2 * bj + (fq >> 1)) * 64 + 32 * (fq & 1)) * 8) = w;
                    }
                    continue;
                } else if (region == 2) {
#pragma unroll
                    for (int bj = 0; bj < 2; ++bj)
#pragma unroll
                        for (int n = 0; n < 2; ++n)
#pragma unroll
                            for (int i = 0; i < 4; ++i) {
                                const int d = 32 * bj + 8 * fq + 4 * n + i, kl = row & 31;
                                vh[(((((size_t)head * (S / 32) + (row >> 5)) * 2 + (d >> 5)) * 2 + (kl >> 4)) * 64 + (d & 31) + 32 * ((kl >> 2) & 1)) * 8 + 4 * ((kl >> 3) & 1) + (kl & 3)] = (bf16_t)f2bf(v[bj][n][i]);
                            }
                    continue;
                } else if (region == 3) {
                    dst = xrg + (size_t)row * DRG + head * 64;
                } else {
#pragma unroll
                    for (int bj = 0; bj < 2; ++bj)
#pragma unroll
                        for (int n = 0; n < 2; ++n)
#pragma unroll
                            for (int i = 0; i < 4; ++i) v[bj][n][i] = gelu_tanh(v[bj][n][i]);
#pragma unroll
                    for (int bj = 0; bj < 2; ++bj)
#pragma unroll
                        for (int n = 0; n < 2; ++n)
                            *(uint2*)(gg + ((((size_t)(row >> 5) * 8 + head) * 8 + (4 * bj + fq)) * 64 + (row & 31) + 32 * n) * 4) = make_uint2(pg8::cvt_pk_bf16(v[bj][n][0], v[bj][n][1]), pg8::cvt_pk_bf16(v[bj][n][2], v[bj][n][3]));
                    continue;
                }
#pragma unroll
                for (int bj = 0; bj < 2; ++bj) {
                    pg8::u32x4 w; w.x = pg8::cvt_pk_bf16(v[bj][0][0], v[bj][0][1]); w.y = pg8::cvt_pk_bf16(v[bj][0][2], v[bj][0][3]);
                    w.z = pg8::cvt_pk_bf16(v[bj][1][0], v[bj][1][1]); w.w = pg8::cvt_pk_bf16(v[bj][1][2], v[bj][1][3]);
                    *(pg8::u32x4*)(dst + 32 * bj + 8 * fq) = w;
                }
            }
    }
};
struct EpiOutProj {
    static constexpr bool PERM = true, AFTER_DRAIN = false;
    const float* x; bf16_t* x1b; float* ssq; unsigned char* x1q; float* xsc;
    __device__ __forceinline__ void operator()(const pg8::f32x4 (&acc)[2][2][4][2], const pg8::Unit& u, int wr, int wc, int fr, int fq) const {
        pg8::f32x4 xv[2][2][2][2];
#define OUTPROJ_LD(buf, ai_, mh_) do { _Pragma("unroll") for (int mm_ = 0; mm_ < 2; ++mm_) _Pragma("unroll") for (int bj_ = 0; bj_ < 2; ++bj_) { \
            const size_t o_ = (size_t)(u.pm * 256 + (ai_) * 128 + wr * 64 + (2 * (mh_) + mm_) * 16 + fr) * D + u.pn * 256 + bj_ * 128 + wc * 32 + 8 * fq; \
            xv[buf][mm_][bj_][0] = *(const pg8::f32x4*)(x + o_); xv[buf][mm_][bj_][1] = *(const pg8::f32x4*)(x + o_ + 4); } } while (0)
        OUTPROJ_LD(0, 0, 0);
#pragma unroll
        for (int ai = 0; ai < 2; ++ai)
#pragma unroll
            for (int m = 0; m < 4; ++m) {
                const int kb = ai * 2 + (m >> 1);
                if ((m & 1) == 0 && kb < 3) OUTPROJ_LD((kb + 1) & 1, (kb + 1) >> 1, (kb + 1) & 1);
                const int row = u.pm * 256 + ai * 128 + wr * 64 + m * 16 + fr;
                float ss = 0.f;
#pragma unroll
                for (int bj = 0; bj < 2; ++bj) {
                    const int col = u.pn * 256 + bj * 128 + wc * 32 + 8 * fq;
                    const size_t o = (size_t)row * D + col;
                    const pg8::f32x4 a = xv[kb & 1][m & 1][bj][0] + acc[ai][bj][m][0], b = xv[kb & 1][m & 1][bj][1] + acc[ai][bj][m][1];
                    ss += (a[0] * a[0] + a[1] * a[1]) + (a[2] * a[2] + a[3] * a[3]) + (b[0] * b[0] + b[1] * b[1]) + (b[2] * b[2] + b[3] * b[3]);
                    pg8::u32x4 w; w.x = pg8::cvt_pk_bf16(a[0], a[1]); w.y = pg8::cvt_pk_bf16(a[2], a[3]); w.z = pg8::cvt_pk_bf16(b[0], b[1]); w.w = pg8::cvt_pk_bf16(b[2], b[3]);
                    *(pg8::u32x4*)(x1b + o) = w;
                    float mx = fmaxf(fmaxf(fmaxf(fabsf(a[0]), fabsf(a[1])), fmaxf(fabsf(a[2]), fabsf(a[3]))), fmaxf(fmaxf(fabsf(b[0]), fabsf(b[1])), fmaxf(fabsf(b[2]), fabsf(b[3]))));
                    mx = fmaxf(mx, __shfl_xor(mx, 16)); mx = fmaxf(mx, __shfl_xor(mx, 32));
                    const float inv = mx > 0.f ? 119.0f / mx : 0.f;
                    unsigned pl = 0u, ph = 0u;
#pragma unroll
                    for (int i = 0; i < 4; ++i) {
                        const int qa = __float2int_rn(a[i] * inv), qb = __float2int_rn(b[i] * inv);
                        pl |= ((unsigned)(qa & 15) << (8 * i)) | ((unsigned)(qb & 15) << (8 * i + 4));
                        ph |= ((unsigned)(((qa + 8) >> 4) & 15) << (8 * i)) | ((unsigned)(((qb + 8) >> 4) & 15) << (8 * i + 4));
                    }
                    unsigned* cq = (unsigned*)(x1q + (size_t)row * D + (col & ~31));
                    cq[fq] = pl; cq[4 + fq] = ph;
                    if (fq == 0) xsc[(size_t)row * 32 + (col >> 5)] = mx * (1.0f / 119.0f);
                }
                ss += __shfl_xor(ss, 16); ss += __shfl_xor(ss, 32);
                if (fq == 0) ssq[(size_t)row * 16 + u.pn * 4 + wc] = ss;
            }
    }
};
#undef OUTPROJ_LD
struct EpiPeerQ {
    static constexpr bool PERM = true, AFTER_DRAIN = false;
    bf16_t* qp;
    __device__ __forceinline__ void operator()(const pg8::f32x4 (&acc)[2][2][4][2], const pg8::Unit& u, int wr, int wc, int fr, int fq) const {
#pragma unroll
        for (int ai = 0; ai < 2; ++ai)
#pragma unroll
            for (int m = 0; m < 4; ++m) {
                const int row = u.pm * 256 + ai * 128 + wr * 64 + m * 16 + fr;
#pragma unroll
                for (int bj = 0; bj < 2; ++bj) {
                    const pg8::f32x4 a = acc[ai][bj][m][0], b = acc[ai][bj][m][1];
                    pg8::u32x4 w; w.x = pg8::cvt_pk_bf16(a[0], a[1]); w.y = pg8::cvt_pk_bf16(a[2], a[3]); w.z = pg8::cvt_pk_bf16(b[0], b[1]); w.w = pg8::cvt_pk_bf16(b[2], b[3]);
                    *(pg8::u32x4*)(qp + ((((size_t)((row >> 5) * 8 + u.pn) * 2 + bj) * 8 + 2 * wc + (fq >> 1)) * 64 + (row & 31) + 32 * (fq & 1)) * 8) = w;
                }
            }
    }
};

typedef float f32x2v __attribute__((ext_vector_type(2)));
typedef __bf16 bf16x2v __attribute__((ext_vector_type(2)));
__device__ __forceinline__ unsigned cvtpk(float lo, float hi) { const f32x2v v = {lo, hi}; const bf16x2v b = __builtin_convertvector(v, bf16x2v); return __builtin_bit_cast(unsigned, b); }
__device__ __forceinline__ bf16x8 pack_step(const f32x16& x, int s) {
    u32x4 pkd; pkd.x = cvtpk(x[8 * s], x[8 * s + 1]); pkd.y = cvtpk(x[8 * s + 2], x[8 * s + 3]); pkd.z = cvtpk(x[8 * s + 4], x[8 * s + 5]); pkd.w = cvtpk(x[8 * s + 6], x[8 * s + 7]);
    return __builtin_bit_cast(bf16x8, pkd);
}
#define MFMA32(a, b, c) __builtin_amdgcn_mfma_f32_32x32x16_bf16((a), (b), (c), 0, 0, 0)
__device__ __forceinline__ void ph_attn(const Params& p) {
    unsigned char* ws = p.ws;
    const bf16_t* qh = (const bf16_t*)(ws + WS_QH); const bf16_t* kh = (const bf16_t*)(ws + WS_KH); const bf16_t* vT = (const bf16_t*)(ws + WS_VH);
    bf16_t* osb = (bf16_t*)(ws + WS_OSB);
    const int tid = phase_tid(), lane = tid & 63, r = lane & 31, hh = lane >> 5;
    const int gwave = (blockIdx.x * blockDim.x + tid) >> 6, nwave = (gridDim.x * blockDim.x) >> 6;
    bf16x8 tp[2];
#pragma unroll
    for (int ss = 0; ss < 2; ++ss)
#pragma unroll
        for (int e = 0; e < 8; ++e) { const int k = 16 * ss + 8 * (e >> 2) + 4 * hh + (e & 3); tp[ss][e] = (k > r) ? (short)0x3F80 : (short)0; }
    f32x16 zero16;
#pragma unroll
    for (int i = 0; i < 16; ++i) zero16[i] = 0.f;
    for (int u = gwave; u < NH * (S / 32); u += nwave) {
        const int h = u / (S / 32), t0 = (u % (S / 32)) * 32;
        bf16x8 bq[4];
#pragma unroll
        for (int s = 0; s < 4; ++s) bq[s] = *(const bf16x8*)(qh + (((size_t)(h * (S / 32) + (t0 >> 5)) * 4 + s) * 64 + lane) * 8);
        f32x16 ot[2] = {zero16, zero16};
        float carry = 0.f;
        for (int kt0 = t0; kt0 >= 0; kt0 -= 32) {
            bf16x8 ak[4], av[2][2];
#pragma unroll
            for (int s = 0; s < 4; ++s) ak[s] = *(const bf16x8*)(kh + (((size_t)(h * (S / 32) + (kt0 >> 5)) * 4 + s) * 64 + lane) * 8);
#pragma unroll
            for (int dt = 0; dt < 2; ++dt)
#pragma unroll
                for (int ss = 0; ss < 2; ++ss) av[dt][ss] = *(const bf16x8*)(vT + ((((size_t)(h * (S / 32) + (kt0 >> 5)) * 2 + dt) * 2 + ss) * 64 + lane) * 8);
            f32x16 st = zero16;
#pragma unroll
            for (int s = 0; s < 4; ++s) st = MFMA32(ak[s], bq[s], st);
            const bool diag = (kt0 == t0);
            f32x16 lom, lb;
            float csum = 0.f;
#pragma unroll
            for (int i = 0; i < 16; ++i) {
                const float z = st[i];
                const float sp2 = fmaxf(z, 0.f) + __builtin_amdgcn_logf(1.0f + __builtin_amdgcn_exp2f(-fabsf(z)));
                const bool valid = !diag || ((i & 3) + 8 * (i >> 2) + 4 * hh < r);
                lom[i] = valid ? -sp2 : 0.f;
                lb[i] = z - sp2;
                csum += lom[i];
            }
            f32x16 suf = MFMA32(tp[0], pack_step(lom, 0), zero16);
            suf = MFMA32(tp[1], pack_step(lom, 1), suf);
            f32x16 w;
#pragma unroll
            for (int i = 0; i < 16; ++i) {
                const bool valid = !diag || ((i & 3) + 8 * (i >> 2) + 4 * hh < r);
                w[i] = valid ? __builtin_amdgcn_exp2f(lb[i] + suf[i] + carry) : 0.f;
            }
            const bf16x8 w0 = pack_step(w, 0), w1 = pack_step(w, 1);
#pragma unroll
            for (int dt = 0; dt < 2; ++dt) { ot[dt] = MFMA32(av[dt][0], w0, ot[dt]); ot[dt] = MFMA32(av[dt][1], w1, ot[dt]); }
            carry += csum + __shfl_xor(csum, 32);
            if (__all(carry < CARRY_STOP)) break;
        }
#pragma unroll
        for (int dt = 0; dt < 2; ++dt)
#pragma unroll
            for (int g = 0; g < 4; ++g) {
                uint2 o; o.x = cvtpk(ot[dt][4 * g], ot[dt][4 * g + 1]); o.y = cvtpk(ot[dt][4 * g + 2], ot[dt][4 * g + 3]);
                *(uint2*)(osb + (size_t)(t0 + r) * DSB + h * HD + 32 * dt + 8 * g + 4 * hh) = o;
            }
    }
}

constexpr int RG_LDS_CST = 0, RG_LDS_HIN = 16384, RG_LDS_P = 18432, RG_LDS_SSQ = 20480;
constexpr int RG_LDS_X = 22528, RG_XP = 1032, RG_LDS_O = 91904;
typedef unsigned u32x2 __attribute__((ext_vector_type(2)));
typedef __attribute__((address_space(3))) float lds_f;
typedef __attribute__((address_space(3))) unsigned char lds_b;
template <int CTRL, int ROWMASK>
__device__ __forceinline__ float dpp_mov(float oob, float x) {
    return __builtin_bit_cast(float, __builtin_amdgcn_update_dpp(__builtin_bit_cast(int, oob), __builtin_bit_cast(int, x), CTRL, ROWMASK, 0xf, false));
}
template <int CTRL, int ROWMASK>
__device__ __forceinline__ void scan_step(float (&av)[16], float (&bv)[16]) {
#pragma unroll
    for (int i = 0; i < 16; ++i) {
        const float ap = dpp_mov<CTRL, ROWMASK>(1.0f, av[i]), bp = dpp_mov<CTRL, ROWMASK>(0.0f, bv[i]);
        bv[i] = __builtin_fmaf(av[i], bp, bv[i]); av[i] *= ap;
    }
}
template <int PASS>
__device__ __forceinline__ void ph_rg(const Params& p, unsigned char* lds_raw) {
    float* lds = (float*)lds_raw;
    unsigned char* ws = p.ws;
    const bf16_t* xrg = (const bf16_t*)(ws + WS_XRG); const bf16_t* gg = (const bf16_t*)(ws + WS_GG); const bf16_t* wfrag = (const bf16_t*)(ws + WS_RGW);
    const bf16_t* osb = (const bf16_t*)(ws + WS_OSB); bf16_t* mix = (bf16_t*)(ws + WS_MIX);
    float* rgP = (float*)(ws + WS_RGP); float* rgH = (float*)(ws + WS_RGH);
    bf16_t* scA = (bf16_t*)(ws + WS_RGSA); bf16_t* scB = (bf16_t*)(ws + WS_RGSB);
    const int tid = phase_tid(), lane = tid & 63, r = lane & 31, hh = lane >> 5, n = __builtin_amdgcn_readfirstlane(tid >> 6);
    __syncthreads();
    if (PASS == 0) for (int e = tid; e < 8 * 2 * 8 * 32; e += NTHR) {
        const int q = e & 31, k = (e >> 5) & 7, h2 = (e >> 8) & 1, nn = e >> 9;
        const int c = 64 * nn + 32 * (q >> 4) + (q & 3) + 8 * ((q >> 2) & 3) + 4 * h2;
        float v;
        if (k < 4) v = p.in[I_CONV_W][k * DRG + c];
        else if (k == 4) v = p.in[I_CONV_B][c];
        else if (k == 5) v = p.in[I_RG_B_A][c];
        else if (k == 6) v = p.in[I_RG_B_X][c];
        else v = 8.0f * LOG2E * log1pf(__expf(-p.in[I_RG_LAMBDA][c]));
        lds[e] = v;
    }
    const unsigned lds0 = (unsigned)(size_t)((lds_b*)lds_raw);
    const unsigned cst_base = lds0 + (unsigned)((n * 2 + hh) * 1024);
    lds_f* hin_l = (lds_f*)(size_t)(lds0 + RG_LDS_HIN + (n * 2 + hh) * 128);
    lds_f* pc_l = (lds_f*)(size_t)(lds0 + RG_LDS_P + (n * 2 + hh) * 128);
    lds_b* xt = (lds_b*)(size_t)(lds0 + RG_LDS_X);
    lds_b* ot = (lds_b*)(size_t)(lds0 + RG_LDS_O);
    f32x16 zero16;
#pragma unroll
    for (int i = 0; i < 16; ++i) zero16[i] = 0.f;
    for (int ch = blockIdx.x; ch < NCHUNK; ch += gridDim.x) {
        const int t0 = ch * CHUNK;
        __syncthreads();
        if (PASS == 0) for (int ci = tid; ci < (CHUNK + 3) * 64; ci += NTHR) {
            const int row = ci >> 6, c16 = ci & 63, tt = t0 - 3 + row;
            u32x4 v = {0u, 0u, 0u, 0u};
            if (tt >= 0) v = *(const u32x4*)(xrg + (size_t)tt * DRG + 8 * c16);
            __attribute__((address_space(3))) u32x2* d = (__attribute__((address_space(3))) u32x2*)(xt + row * RG_XP + 16 * c16);
            d[0] = (u32x2){v.x, v.y}; d[1] = (u32x2){v.z, v.w};
        }
        if (PASS == 1) {
            const int c = 64 * n + lane;
            float h = 0.f;
            int k = 0;
            for (; k + 32 <= ch; k += 32) {
                float pv[32], hv[32];
#pragma unroll
                for (int j = 0; j < 32; ++j) { pv[j] = rgP[(k + j) * DRG + c]; hv[j] = rgH[(k + j) * DRG + c]; }
#pragma unroll
                for (int j = 0; j < 32; ++j) h = pv[j] * h + hv[j];
            }
            for (; k + 8 <= ch; k += 8) {
                float pv[8], hv[8];
#pragma unroll
                for (int j = 0; j < 8; ++j) { pv[j] = rgP[(k + j) * DRG + c]; hv[j] = rgH[(k + j) * DRG + c]; }
#pragma unroll
                for (int j = 0; j < 8; ++j) h = pv[j] * h + hv[j];
            }
            for (; k < ch; ++k) h = rgP[k * DRG + c] * h + rgH[k * DRG + c];
            lds[RG_LDS_HIN / 4 + (n * 2 + ((lane >> 2) & 1)) * 32 + 16 * (lane >> 5) + 4 * ((lane >> 3) & 3) + (lane & 3)] = h;
        } else {
            if (r == 0) {
#pragma unroll
                for (int q = 0; q < 32; ++q) { hin_l[q] = 0.f; pc_l[q] = 1.f; }
            }
        }
        __syncthreads();
#pragma unroll 1
        for (int tl = 0; tl < 2; ++tl) {
            const int tok = t0 + 32 * tl + r;
            unsigned cst_a = cst_base; asm volatile("" : "+v"(cst_a));
            const lds_f* cst = (const lds_f*)(size_t)cst_a;
            float xcv[32]; bf16x8 bx[4];
            if (PASS == 0) {
#pragma unroll
            for (int q = 0; q < 32; ++q) xcv[q] = cst[4 * 32 + q];
#pragma unroll
            for (int k = 0; k < 4; ++k) {
                const lds_b* xr = xt + (32 * tl + r + k) * RG_XP + (64 * n + 4 * hh) * 2;
#pragma unroll
                for (int m = 0; m < 8; ++m) {
                    const u32x2 xw = *(const __attribute__((address_space(3))) u32x2*)(xr + 16 * m);
                    xcv[4 * m + 0] += cst[k * 32 + 4 * m + 0] * bf2f(xw.x & 0xffffu); xcv[4 * m + 1] += cst[k * 32 + 4 * m + 1] * bf2f(xw.x >> 16);
                    xcv[4 * m + 2] += cst[k * 32 + 4 * m + 2] * bf2f(xw.y & 0xffffu); xcv[4 * m + 3] += cst[k * 32 + 4 * m + 3] * bf2f(xw.y >> 16);
                }
                __builtin_amdgcn_sched_barrier(0);
            }
#pragma unroll
            for (int s = 0; s < 4; ++s) {
                u32x4 pk; pk.x = cvtpk(xcv[8 * s], xcv[8 * s + 1]); pk.y = cvtpk(xcv[8 * s + 2], xcv[8 * s + 3]); pk.z = cvtpk(xcv[8 * s + 4], xcv[8 * s + 5]); pk.w = cvtpk(xcv[8 * s + 6], xcv[8 * s + 7]);
                bx[s] = __builtin_bit_cast(bf16x8, pk);
            }
            }
            float ss = 0.f;
            const bf16_t* wb = wfrag + ((size_t)n * 16 * 64 + lane) * 8; asm volatile("" : "+v"(wb));
#pragma unroll
            for (int jt = 0; jt < 2; ++jt) {
                float av[16], bv[16];
                const size_t sco = ((((size_t)(2 * ch + tl) * 8 + n) * 2 + jt) * 64 + lane) * 16;
                if (PASS == 0) {
#pragma unroll
                for (int g = 0; g < 2; ++g) {
                    f32x16 acc = zero16;
#pragma unroll
                    for (int s = 0; s < 4; ++s) {
                        const bf16x8 aw = *(const __attribute__((address_space(1))) bf16x8*)(wb + (((g * 2 + jt) * 4 + s) * 64) * 8);
                        acc = MFMA32(aw, bx[s], acc);
                    }
#pragma unroll
                    for (int i = 0; i < 16; ++i) {
                        const int q = 16 * jt + i;
                        const float pre = acc[i] + cst[(5 + g) * 32 + q];
                        const float sg = 1.0f / (1.0f + __builtin_amdgcn_exp2f(-LOG2E * pre));
                        if (g == 0) av[i] = __builtin_amdgcn_exp2f(-sg * cst[7 * 32 + q]);
                        else bv[i] = __builtin_amdgcn_sqrtf(fmaxf(__builtin_fmaf(-av[i], av[i], 1.0f), 0.f)) * (sg * xcv[q]);
                    }
                    __builtin_amdgcn_sched_barrier(0);
                }
                scan_step<0x111, 0xf>(av, bv); scan_step<0x112, 0xf>(av, bv); scan_step<0x114, 0xf>(av, bv); scan_step<0x118, 0xf>(av, bv);
                scan_step<0x142, 0xa>(av, bv);
                u32x4 sa0, sa1, sb0, sb1;
                sa0.x = cvtpk(av[0], av[1]); sa0.y = cvtpk(av[2], av[3]); sa0.z = cvtpk(av[4], av[5]); sa0.w = cvtpk(av[6], av[7]); sa1.x = cvtpk(av[8], av[9]); sa1.y = cvtpk(av[10], av[11]); sa1.z = cvtpk(av[12], av[13]); sa1.w = cvtpk(av[14], av[15]);
                sb0.x = cvtpk(bv[0], bv[1]); sb0.y = cvtpk(bv[2], bv[3]); sb0.z = cvtpk(bv[4], bv[5]); sb0.w = cvtpk(bv[6], bv[7]); sb1.x = cvtpk(bv[8], bv[9]); sb1.y = cvtpk(bv[10], bv[11]); sb1.z = cvtpk(bv[12], bv[13]); sb1.w = cvtpk(bv[14], bv[15]);
                *(u32x4*)(scA + sco) = sa0; *(u32x4*)(scA + sco + 8) = sa1; *(u32x4*)(scB + sco) = sb0; *(u32x4*)(scB + sco + 8) = sb1;
                } else {
                    const u32x4 sa0 = *(const u32x4*)(scA + sco), sa1 = *(const u32x4*)(scA + sco + 8), sb0 = *(const u32x4*)(scB + sco), sb1 = *(const u32x4*)(scB + sco + 8);
                    const unsigned wa[8] = {sa0.x, sa0.y, sa0.z, sa0.w, sa1.x, sa1.y, sa1.z, sa1.w}, wbb[8] = {sb0.x, sb0.y, sb0.z, sb0.w, sb1.x, sb1.y, sb1.z, sb1.w};
#pragma unroll
                    for (int k = 0; k < 8; ++k) { av[2 * k] = bf2f(wa[k] & 0xffffu); av[2 * k + 1] = bf2f(wa[k] >> 16); bv[2 * k] = bf2f(wbb[k] & 0xffffu); bv[2 * k + 1] = bf2f(wbb[k] >> 16); }
                }
                __builtin_amdgcn_sched_barrier(0);
#pragma unroll
                for (int i = 0; i < 16; ++i) {
                    const int q = 16 * jt + i;
                    const float h = __builtin_fmaf(av[i], hin_l[q], bv[i]);
                    if (r == 31) { hin_l[q] = h; if (PASS == 0) pc_l[q] *= av[i]; }
                    bv[i] = h;
                }
                if (PASS == 1) {
#pragma unroll
                    for (int g4 = 0; g4 < 4; ++g4) {
                        const int m = 4 * jt + g4;
                        const uint2 gw = *(const uint2*)(gg + ((((size_t)(tok >> 5) * 8 + n) * 8 + m) * 64 + lane) * 4);
                        const float o0 = bv[4 * g4] * bf2f(gw.x & 0xffffu), o1 = bv[4 * g4 + 1] * bf2f(gw.x >> 16), o2 = bv[4 * g4 + 2] * bf2f(gw.y & 0xffffu), o3 = bv[4 * g4 + 3] * bf2f(gw.y >> 16);
                        ss += (o0 * o0 + o1 * o1) + (o2 * o2 + o3 * o3);
                        *(__attribute__((address_space(3))) u32x2*)(ot + (32 * tl + r) * RG_XP + (64 * n + 8 * m + 4 * hh) * 2) = (u32x2){cvtpk(o0, o1), cvtpk(o2, o3)};
                    }
                }
                __builtin_amdgcn_sched_barrier(0);
            }
            if (PASS == 1) { ss += __shfl_xor(ss, 32); if (hh == 0) lds[RG_LDS_SSQ / 4 + (tl * 8 + n) * 32 + r] = ss; }
        }
        if (PASS == 0) {
            if (r == 0) {
#pragma unroll
                for (int m = 0; m < 8; ++m) {
                    const int c = 64 * n + 8 * m + 4 * hh;
                    *(f32x4*)(rgP + (size_t)ch * DRG + c) = (f32x4){pc_l[4 * m], pc_l[4 * m + 1], pc_l[4 * m + 2], pc_l[4 * m + 3]};
                    *(f32x4*)(rgH + (size_t)ch * DRG + c) = (f32x4){hin_l[4 * m], hin_l[4 * m + 1], hin_l[4 * m + 2], hin_l[4 * m + 3]};
                }
            }
        } else {
            __syncthreads();
            for (int j = 0; j < 8; ++j) {
                const int tr = 8 * n + j, tok = t0 + tr;
                float tot = 0.f;
#pragma unroll
                for (int w = 0; w < 8; ++w) tot += lds[RG_LDS_SSQ / 4 + ((tr >> 5) * 8 + w) * 32 + (tr & 31)];
                const float rn = rsqrtf(tot * (1.0f / DRG) + EPS);
                const __attribute__((address_space(3))) u32x2* op = (const __attribute__((address_space(3))) u32x2*)(ot + tr * RG_XP + 16 * lane);
                const u32x2 w0 = op[0], w1 = op[1];
                u32x4 o2; o2.x = cvtpk(bf2f(w0.x & 0xffffu) * rn, bf2f(w0.x >> 16) * rn); o2.y = cvtpk(bf2f(w0.y & 0xffffu) * rn, bf2f(w0.y >> 16) * rn);
                o2.z = cvtpk(bf2f(w1.x & 0xffffu) * rn, bf2f(w1.x >> 16) * rn); o2.w = cvtpk(bf2f(w1.y & 0xffffu) * rn, bf2f(w1.y >> 16) * rn);
                *((u32x4*)(mix + (size_t)tok * D + DSB) + lane) = o2;
                const u32x4 a = *((const u32x4*)(osb + (size_t)tok * DSB) + lane);
                float f[8] = {bf2f(a.x & 0xffffu), bf2f(a.x >> 16), bf2f(a.y & 0xffffu), bf2f(a.y >> 16), bf2f(a.z & 0xffffu), bf2f(a.z >> 16), bf2f(a.w & 0xffffu), bf2f(a.w >> 16)};
                float sa = 0.f;
#pragma unroll
                for (int k = 0; k < 8; ++k) sa += f[k] * f[k];
                sa = wave_sum(sa);
                const float ra = rsqrtf(sa * (1.0f / DSB) + EPS);
                u32x4 o; o.x = cvtpk(f[0] * ra, f[1] * ra); o.y = cvtpk(f[2] * ra, f[3] * ra); o.z = cvtpk(f[4] * ra, f[5] * ra); o.w = cvtpk(f[6] * ra, f[7] * ra);
                *((u32x4*)(mix + (size_t)tok * D) + lane) = o;
            }
        }
    }
}

__device__ __forceinline__ int f2key(float f) { const int b = __builtin_bit_cast(int, f); return b ^ ((b >> 31) & 0x7fffffff); }
__device__ __forceinline__ float key2f(int k) { return __builtin_bit_cast(float, k ^ ((k >> 31) & 0x7fffffff)); }
#define TOPK_CE(a, b) do { const int hi_ = max(a, b), lo_ = min(a, b); a = hi_; b = lo_; } while (0)
__device__ __forceinline__ void sort16_desc(int (&v)[16]) { TOPK_CE(v[0], v[1]); TOPK_CE(v[2], v[3]); TOPK_CE(v[0], v[2]); TOPK_CE(v[1], v[3]); TOPK_CE(v[1], v[2]); TOPK_CE(v[4], v[5]); TOPK_CE(v[6], v[7]); TOPK_CE(v[4], v[6]); TOPK_CE(v[5], v[7]); TOPK_CE(v[5], v[6]); TOPK_CE(v[0], v[4]); TOPK_CE(v[2], v[6]); TOPK_CE(v[2], v[4]); TOPK_CE(v[1], v[5]); TOPK_CE(v[3], v[7]); TOPK_CE(v[3], v[5]); TOPK_CE(v[1], v[2]); TOPK_CE(v[3], v[4]); TOPK_CE(v[5], v[6]); TOPK_CE(v[8], v[9]); TOPK_CE(v[10], v[11]); TOPK_CE(v[8], v[10]); TOPK_CE(v[9], v[11]); TOPK_CE(v[9], v[10]); TOPK_CE(v[12], v[13]); TOPK_CE(v[14], v[15]); TOPK_CE(v[12], v[14]); TOPK_CE(v[13], v[15]); TOPK_CE(v[13], v[14]); TOPK_CE(v[8], v[12]); TOPK_CE(v[10], v[14]); TOPK_CE(v[10], v[12]); TOPK_CE(v[9], v[13]); TOPK_CE(v[11], v[15]); TOPK_CE(v[11], v[13]); TOPK_CE(v[9], v[10]); TOPK_CE(v[11], v[12]); TOPK_CE(v[13], v[14]); TOPK_CE(v[0], v[8]); TOPK_CE(v[4], v[12]); TOPK_CE(v[4], v[8]); TOPK_CE(v[2], v[10]); TOPK_CE(v[6], v[14]); TOPK_CE(v[6], v[10]); TOPK_CE(v[2], v[4]); TOPK_CE(v[6], v[8]); TOPK_CE(v[10], v[12]); TOPK_CE(v[1], v[9]); TOPK_CE(v[5], v[13]); TOPK_CE(v[5], v[9]); TOPK_CE(v[3], v[11]); TOPK_CE(v[7], v[15]); TOPK_CE(v[7], v[11]); TOPK_CE(v[3], v[5]); TOPK_CE(v[7], v[9]); TOPK_CE(v[11], v[13]); TOPK_CE(v[1], v[2]); TOPK_CE(v[3], v[4]); TOPK_CE(v[5], v[6]); TOPK_CE(v[7], v[8]); TOPK_CE(v[9], v[10]); TOPK_CE(v[11], v[12]); TOPK_CE(v[13], v[14]); }
__device__ __forceinline__ void merge16_desc(int (&a)[16], const int (&b)[16]) {
#pragma unroll
    for (int i = 0; i < 16; ++i) a[i] = max(a[i], b[15 - i]);
#pragma unroll
    for (int d = 8; d >= 1; d >>= 1)
#pragma unroll
        for (int i = 0; i < 16; ++i) if ((i & d) == 0) TOPK_CE(a[i], a[i + d]);
}
__device__ __forceinline__ void ph_topk(const Params& p, int* lds) {
    unsigned char* ws = p.ws;
    const bf16_t* qp = (const bf16_t*)(ws + WS_B); const bf16_t* subk = (const bf16_t*)(ws + WS_SUBK);
    int* seli = (int*)(ws + WS_SELI); float* selg = (float*)(ws + WS_SELG);
    const float* ssq = (const float*)(ws + WS_SSQ); float* rstd2 = (float*)(ws + WS_RSTD2);
    const int tid = phase_tid(), lane = tid & 63, r = lane & 31, hh = lane >> 5, hx = 4 * hh;
    const int gwave = (blockIdx.x * blockDim.x + tid) >> 6, nwave = (gridDim.x * blockDim.x) >> 6;
    constexpr int SK_OFF = 65536, SK_PITCH = 272;
    typedef __attribute__((address_space(3))) unsigned char lds_b;
    lds_b* skl = (lds_b*)lds + SK_OFF;
    const int w = tid >> 6;
    pg8::StaticOrder so; so.init(S, NQ, (int)gridDim.x, (int)blockIdx.x);
    pg8::Unit gu;
    for (int ui = 0; so.next(ui, gu); ++ui) {
        const int h = gu.pn, t0 = gu.pm * 256 + 32 * w, t = t0 + r;
        u32x4 skv[8]; bf16x8 bq[2][8];
#pragma unroll
        for (int j = 0; j < 8; ++j) {
            const int ci = tid + NTHR * j, row = ci >> 4, c16 = ci & 15;
            skv[j] = *(const u32x4*)(subk + ((size_t)h * 256 + row) * PHALF + 8 * c16);
        }
#pragma unroll
        for (int pp = 0; pp < 2; ++pp)
#pragma unroll
            for (int s = 0; s < 8; ++s) bq[pp][s] = *(const bf16x8*)(qp + ((((size_t)((t0 >> 5) * 8 + h) * 2 + pp) * 8 + s) * 64 + lane) * 8);
        __builtin_amdgcn_sched_barrier(0);
        __syncthreads();
#pragma unroll
        for (int j = 0; j < 8; ++j) {
            const int ci = tid + NTHR * j, row = ci >> 4, c16 = ci & 15;
            *(__attribute__((address_space(3))) u32x4*)(skl + row * SK_PITCH + 16 * c16) = skv[j];
        }
        __syncthreads();
        int tk[2][16];
#pragma unroll
        for (int pp = 0; pp < 2; ++pp) {
            f32x16 acc[4];
#pragma unroll
            for (int T = 0; T < 4; ++T)
#pragma unroll
                for (int i = 0; i < 16; ++i) acc[T][i] = 0.f;
            const lds_b* krow = skl + (pp * PNK + r) * SK_PITCH + 16 * hh;
#pragma unroll
            for (int s = 0; s < 8; ++s) {
                const bf16x8 b = bq[pp][s];
#pragma unroll
                for (int T = 0; T < 4; ++T) {
                    const bf16x8 a = *(const __attribute__((address_space(3))) bf16x8*)(krow + (32 * T) * SK_PITCH + 32 * s);
                    acc[T] = __builtin_amdgcn_mfma_f32_32x32x16_bf16(a, b, acc[T], 0, 0, 0);
                }
            }
            int kq[4][16];
#pragma unroll
            for (int T = 0; T < 4; ++T) {
#pragma unroll
                for (int i = 0; i < 16; ++i) {
                    const int nb = 32 * T + (i & 3) + 8 * (i >> 2);
                    kq[T][i] = ((f2key(acc[T][i]) & ~127) | (127 - nb)) ^ hx;
                }
                sort16_desc(kq[T]);
            }
            merge16_desc(kq[0], kq[1]); merge16_desc(kq[2], kq[3]); merge16_desc(kq[0], kq[2]);
            int m[16], po[16];
#pragma unroll
            for (int i = 0; i < 16; ++i) { m[i] = kq[0][i]; po[i] = __shfl_xor(kq[0][i], 32); }
            merge16_desc(m, po);
#pragma unroll
            for (int i = 0; i < 16; ++i) tk[pp][i] = m[i];
        }
#pragma unroll
        for (int i = 0; i < 16; ++i) { lds[i * NTHR + tid] = tk[0][i]; lds[(16 + i) * NTHR + tid] = tk[1][i]; }
        float v0[16], v1[16];
#pragma unroll
        for (int i = 0; i < 16; ++i) { v0[i] = key2f(tk[0][i]); v1[i] = key2f(tk[1][i]); }
#define CKEY(a, b) ((f2key(v0[a] + v1[b]) & ~255) | (255 - ((a) * 16 + (b))))
        const int NEGK = (int)0x80000000;
        int bk[16], l1[16], ga[16], gb[16];
#pragma unroll
        for (int b = 0; b < 16; ++b) bk[b] = CKEY(0, b);
#pragma unroll
        for (int b = 0; b < 16; ++b) l1[b] = b < 8 ? CKEY(1, b) : NEGK;
        ga[0] = CKEY(2, 0); ga[1] = CKEY(2, 1); ga[2] = CKEY(2, 2); ga[3] = CKEY(2, 3); ga[4] = CKEY(2, 4);
        ga[5] = CKEY(3, 0); ga[6] = CKEY(3, 1); ga[7] = CKEY(3, 2); ga[8] = CKEY(3, 3);
        ga[9] = CKEY(4, 0); ga[10] = CKEY(4, 1); ga[11] = CKEY(4, 2); ga[12] = CKEY(5, 0); ga[13] = CKEY(5, 1); ga[14] = NEGK; ga[15] = NEGK;
        gb[0] = CKEY(6, 0); gb[1] = CKEY(6, 1); gb[2] = CKEY(7, 0); gb[3] = CKEY(7, 1);
#pragma unroll
        for (int a = 8; a < 16; ++a) gb[a - 4] = CKEY(a, 0);
        gb[12] = NEGK; gb[13] = NEGK; gb[14] = NEGK; gb[15] = NEGK;
#undef CKEY
        sort16_desc(ga); sort16_desc(gb);
        merge16_desc(bk, l1); merge16_desc(ga, gb); merge16_desc(bk, ga);
        float ssum = 0.f;
#pragma unroll
        for (int i = 0; i < 4; ++i) { const f32x4 q4 = *(const f32x4*)(ssq + (size_t)t * 16 + 4 * i); ssum += (q4.x + q4.y) + (q4.z + q4.w); }
        const float rs = rsqrtf(ssum * (1.0f / D) + EPS);
        float e[16], sum = 0.f; const float mx = key2f(bk[0]);
#pragma unroll
        for (int i = 0; i < 16; ++i) { e[i] = __expf((key2f(bk[i]) - mx) * rs); sum += e[i]; }
        const float inv = 1.0f / sum;
        int eidx[16];
#pragma unroll
        for (int i = 0; i < 16; ++i) {
            const int code = 255 - (bk[i] & 255), a = code >> 4, b = code & 15;
            const int i1 = 127 - (lds[a * NTHR + tid] & 127), i2 = 127 - (lds[(16 + b) * NTHR + tid] & 127);
            eidx[i] = i1 * PNK + i2; e[i] *= inv;
        }
        if (hh == 0) {
            int4* o = (int4*)(seli + (size_t)t * 128 + h * 16);
#pragma unroll
            for (int i = 0; i < 4; ++i) o[i] = make_int4(eidx[4 * i], eidx[4 * i + 1], eidx[4 * i + 2], eidx[4 * i + 3]);
            if (h == 0) rstd2[t] = rs;
        } else {
            f32x4* o = (f32x4*)(selg + (size_t)t * 128 + h * 16);
#pragma unroll
            for (int i = 0; i < 4; ++i) o[i] = (f32x4){e[4 * i], e[4 * i + 1], e[4 * i + 2], e[4 * i + 3]};
        }
    }
}

typedef __bf16 bf16x2_t __attribute__((ext_vector_type(2)));
typedef float f32x2 __attribute__((ext_vector_type(2)));
template <int NV, int XS0, int XS1, int XS2>
__device__ __forceinline__ void reduce_over8(float (&v)[NV], int sel) {
    { const bool up = sel & 1;
#pragma unroll
      for (int i = 0; i < NV / 2; ++i) { const float a = v[2 * i], b = v[2 * i + 1]; v[i] = (up ? b : a) + __shfl_xor(up ? a : b, XS0); } }
    { const bool up = (sel >> 1) & 1;
#pragma unroll
      for (int i = 0; i < NV / 4; ++i) { const float a = v[2 * i], b = v[2 * i + 1]; v[i] = (up ? b : a) + __shfl_xor(up ? a : b, XS1); } }
    { const bool up = (sel >> 2) & 1;
#pragma unroll
      for (int i = 0; i < NV / 8; ++i) { const float a = v[2 * i], b = v[2 * i + 1]; v[i] = (up ? b : a) + __shfl_xor(up ? a : b, XS2); } }
}
__device__ __forceinline__ void peer_load_idx(const unsigned char* ws, int t, int rsl, int (&ei)[16]) {
    const unsigned off = (unsigned)WS_SELI + ((unsigned)t * 128u + 16u * (unsigned)rsl) * 4u;
#pragma unroll
    for (int j = 0; j < 4; ++j) { const int4 v = *(const int4*)(ws + (off + 16u * j)); ei[4 * j] = v.x; ei[4 * j + 1] = v.y; ei[4 * j + 2] = v.z; ei[4 * j + 3] = v.w; }
}
template <int PASS>
__device__ __forceinline__ void peer_load_rows(const unsigned char* ws, int t, int sl, int rsl, int c, const int (&ei)[16], u32x4 (&row)[16], u32x4 (&aux)[4]) {
    const unsigned tab = (unsigned)(PASS == 0 ? WS_UB : WS_VB) + (unsigned)sl * (unsigned)(NEXP * 128) + 16u * (unsigned)c;
#pragma unroll
    for (int i = 0; i < 16; ++i) row[i] = *(const u32x4*)(ws + (tab + (unsigned)ei[i] * 128u));
    const unsigned xo = (unsigned)WS_X1Q + (unsigned)t * (unsigned)D + 256u * sl + 32u * c;
    aux[0] = *(const u32x4*)(ws + xo); aux[1] = *(const u32x4*)(ws + (xo + 16u));
    aux[2].x = *(const unsigned*)(ws + ((unsigned)WS_XSC + ((unsigned)t * 32u + 8u * sl + c) * 4u));
}
constexpr int PEER_IMG_PITCH = 136, PEER_IMG_BYTES = 128 * PEER_IMG_PITCH;
template <int PASS  >
__device__ __forceinline__ void peer_compute(const Params& p, unsigned char* lds, int lane_w, int t, int sl, int rsl, int c, const u32x4 (&row)[16], const u32x4 (&aux)[4]) {
    unsigned char* ws = p.ws;
    if (PASS == 0) {
        const u32x4 x0 = aux[0], x1_ = aux[1]; const unsigned xl[4] = {x0.x, x0.y, x0.z, x0.w}, xh[4] = {x1_.x, x1_.y, x1_.z, x1_.w};
        const unsigned xsu = aux[2].x; const float xs = u2f(xsu);
        float pd[16];
#pragma unroll
        for (int i = 0; i < 16; ++i) {
            const u32x4 rw = row[i]; const unsigned w4[4] = {rw.x, rw.y, rw.z, rw.w};
            int al = 0, ah = 0;
#pragma unroll
            for (int j = 0; j < 4; ++j) { al = __builtin_amdgcn_sdot8((int)w4[j], (int)xl[j], al, false); ah = __builtin_amdgcn_sdot8((int)w4[j], (int)xh[j], ah, false); }
            pd[i] = (float)(16 * ah + al) * xs;
        }
        reduce_over8<16, 1, 2, 4>(pd, c);
        const unsigned po = (unsigned)WS_PD + (((unsigned)sl * S + (unsigned)t) * 128u + 16u * rsl + c) * 4u;
        *(float*)(ws + po) = pd[0]; *(float*)(ws + (po + 32u)) = pd[1];
    }
}
template <int PASS>
__device__ __forceinline__ void peer_stream(const Params& p, unsigned char* lds, int lane_w, int sl, int t0, int dt, int n) {
    const unsigned char* ws = p.ws;
    const int lane = lane_w & 63, rsl = lane >> 3, c = lane & 7;
    int eiA[16], eiB[16]; u32x4 rowA[16], rowB[16], auxA[4], auxB[4];
    if (n <= 0) return;
    peer_load_idx(ws, t0, rsl, eiA);
    peer_load_rows<PASS>(ws, t0, sl, rsl, c, eiA, rowA, auxA);
    if (n > 1) peer_load_idx(ws, t0 + dt, rsl, eiB);
    for (int i = 0; i < n; i += 2) {
        const int t = t0 + i * dt;
        if (i + 1 < n) peer_load_rows<PASS>(ws, t + dt, sl, rsl, c, eiB, rowB, auxB);
        if (i + 2 < n) peer_load_idx(ws, t + 2 * dt, rsl, eiA);
        peer_compute<PASS>(p, lds, lane_w, t, sl, rsl, c, rowA, auxA);
        if (i + 1 < n) {
            if (i + 2 < n) peer_load_rows<PASS>(ws, t + 2 * dt, sl, rsl, c, eiA, rowA, auxA);
            if (i + 3 < n) peer_load_idx(ws, t + 3 * dt, rsl, eiB);
            peer_compute<PASS>(p, lds, lane_w, t + dt, sl, rsl, c, rowB, auxB);
        }
    }
}
__device__ __forceinline__ void peerv_load_idx(const unsigned char* ws, int t, int hf, int rsl, int (&ei)[8]) {
    const unsigned off = (unsigned)WS_SELI + ((unsigned)t * 128u + 16u * (unsigned)rsl + 8u * (unsigned)hf) * 4u;
    const int4 v0 = *(const int4*)(ws + off), v1 = *(const int4*)(ws + (off + 16u));
    ei[0] = v0.x; ei[1] = v0.y; ei[2] = v0.z; ei[3] = v0.w; ei[4] = v1.x; ei[5] = v1.y; ei[6] = v1.z; ei[7] = v1.w;
}
__device__ __forceinline__ void peerv_load_rows(const unsigned char* ws, int sl, int c, const int (&ei)[8], u32x4 (&row)[8]) {
    const unsigned tab = (unsigned)WS_VB + (unsigned)sl * (unsigned)(NEXP * 128) + 16u * (unsigned)c;
#pragma unroll
    for (int i = 0; i < 8; ++i) row[i] = *(const u32x4*)(ws + (tab + (unsigned)ei[i] * 128u));
}
struct PeerVAux { u32x4 cp; unsigned cs; unsigned xo[4]; };
__device__ __forceinline__ void peerv_load_aux(const unsigned char* ws, int t, int sl, int lane, PeerVAux& a) {
    a.cp = *(const u32x4*)(ws + ((unsigned)WS_CBUF + (unsigned)t * 128u + 16u * (unsigned)(lane & 7)));
    a.cs = *(const unsigned*)(ws + ((unsigned)WS_CSC + (unsigned)t * 4u));
    const unsigned xo = (unsigned)WS_A + ((unsigned)t * (unsigned)D + 256u * sl + (unsigned)lane) * 2u;
    a.xo[0] = *(const bf16_t*)(ws + xo); a.xo[1] = *(const bf16_t*)(ws + (xo + 128u)); a.xo[2] = *(const bf16_t*)(ws + (xo + 256u)); a.xo[3] = *(const bf16_t*)(ws + (xo + 384u));
}
template <int HF>
__device__ __forceinline__ void peerv_half(lds_b* img, int lane, const u32x4 (&row)[8], const PeerVAux& a, int (&acc)[4]) {
    const int rsl = lane >> 3, c = lane & 7;
#pragma unroll
    for (int i = 0; i < 8; ++i) {
        const u32x4 rw = row[i];
        __attribute__((address_space(3))) u32x2* d = (__attribute__((address_space(3))) u32x2*)(img + (16 * rsl + i) * PEER_IMG_PITCH + 16 * c);
        d[0] = (u32x2){rw.x, rw.y}; d[1] = (u32x2){rw.z, rw.w};
    }
    const unsigned cpl = HF == 0 ? a.cp.x : a.cp.y, cph = HF == 0 ? a.cp.z : a.cp.w;
    asm volatile("s_waitcnt lgkmcnt(0)" ::: "memory");
    const unsigned ra = (unsigned)(size_t)img + (unsigned)((lane & 15) * PEER_IMG_PITCH + 8 * (lane >> 4));
#define PEER_TR4(R0, R1, R2, R3, RS) asm volatile("ds_read_b64_tr_b4 %0, %4 offset:%5\n\tds_read_b64_tr_b4 %1, %4 offset:%6\n\tds_read_b64_tr_b4 %2, %4 offset:%7\n\tds_read_b64_tr_b4 %3, %4 offset:%8" \
            : "=&v"(R0), "=&v"(R1), "=&v"(R2), "=&v"(R3) : "v"(ra), "i"((RS) * 16 * PEER_IMG_PITCH), "i"((RS) * 16 * PEER_IMG_PITCH + 32), "i"((RS) * 16 * PEER_IMG_PITCH + 64), "i"((RS) * 16 * PEER_IMG_PITCH + 96) : "memory")
#define PEER_USE4(R0, R1, R2, R3, RS, WAITSTR) do { \
            asm volatile(WAITSTR : "+v"(R0), "+v"(R1), "+v"(R2), "+v"(R3) :: "memory"); \
            const int cl_ = __builtin_amdgcn_readlane((int)cpl, RS), ch_ = __builtin_amdgcn_readlane((int)cph, RS); \
            const unsigned lo4_[4] = {R0.x, R1.x, R2.x, R3.x}; \
            _Pragma("unroll") for (int tcg = 0; tcg < 4; ++tcg) acc[tcg] += 16 * __builtin_amdgcn_sdot8((int)lo4_[tcg], ch_, 0, false) + __builtin_amdgcn_sdot8((int)lo4_[tcg], cl_, 0, false); } while (0)
    {
        u32x2 a0, a1, a2, a3, b0, b1, b2, b3;
        PEER_TR4(a0, a1, a2, a3, 0);
        PEER_TR4(b0, b1, b2, b3, 1); PEER_USE4(a0, a1, a2, a3, 0, "s_waitcnt lgkmcnt(4)");
        PEER_TR4(a0, a1, a2, a3, 2); PEER_USE4(b0, b1, b2, b3, 1, "s_waitcnt lgkmcnt(4)");
        PEER_TR4(b0, b1, b2, b3, 3); PEER_USE4(a0, a1, a2, a3, 2, "s_waitcnt lgkmcnt(4)");
        PEER_TR4(a0, a1, a2, a3, 4); PEER_USE4(b0, b1, b2, b3, 3, "s_waitcnt lgkmcnt(4)");
        PEER_TR4(b0, b1, b2, b3, 5); PEER_USE4(a0, a1, a2, a3, 4, "s_waitcnt lgkmcnt(4)");
        PEER_TR4(a0, a1, a2, a3, 6); PEER_USE4(b0, b1, b2, b3, 5, "s_waitcnt lgkmcnt(4)");
        PEER_TR4(b0, b1, b2, b3, 7); PEER_USE4(a0, a1, a2, a3, 6, "s_waitcnt lgkmcnt(4)");
        PEER_USE4(b0, b1, b2, b3, 7, "s_waitcnt lgkmcnt(0)");
    }
#undef PEER_TR4
#undef PEER_USE4
}
__device__ __forceinline__ void peerv_stream(const Params& p, unsigned char* lds, int tid_, int sl, int t0, int dt, int n) {
    const unsigned char* ws = p.ws;
    const int lane = tid_ & 63, rsl = lane >> 3, c = lane & 7;
    lds_b* img = (lds_b*)lds + (tid_ >> 6) * PEER_IMG_BYTES;
    for (int e = lane; e < 64 * (PEER_IMG_PITCH / 8); e += 64) {
        const int zr = e / (PEER_IMG_PITCH / 8), zc = e % (PEER_IMG_PITCH / 8);
        *(__attribute__((address_space(3))) u32x2*)(img + (16 * (zr >> 3) + 8 + (zr & 7)) * PEER_IMG_PITCH + 8 * zc) = (u32x2){0u, 0u};
    }
    if (n <= 0) return;
    int ei0[8], ei1[8]; u32x4 rowA[8], rowB[8]; PeerVAux ax, axn;
    peerv_load_idx(ws, t0, 0, rsl, ei0);
    peerv_load_rows(ws, sl, c, ei0, rowA); peerv_load_aux(ws, t0, sl, lane, ax);
    peerv_load_idx(ws, t0, 1, rsl, ei1);
    for (int i = 0; i < n; ++i) {
        const int t = t0 + i * dt; const bool more = i + 1 < n;
        int acc[4] = {0, 0, 0, 0};
        peerv_load_rows(ws, sl, c, ei1, rowB);
        if (more) peerv_load_idx(ws, t + dt, 0, rsl, ei0);
        peerv_half<0>(img, lane, rowA, ax, acc);
        if (more) { peerv_load_rows(ws, sl, c, ei0, rowA); peerv_load_aux(ws, t + dt, sl, lane, axn); peerv_load_idx(ws, t + dt, 1, rsl, ei1); }
        peerv_half<1>(img, lane, rowB, ax, acc);
        const float cs = u2f(ax.cs);
#pragma unroll
        for (int tcg = 0; tcg < 4; ++tcg) {
            const unsigned oo = ((unsigned)t * (unsigned)D + 256u * sl + 64u * tcg + (unsigned)lane) * 4u;
            *(float*)((unsigned char*)p.out + oo) = bf2f(ax.xo[tcg]) + (float)acc[tcg] * cs;
        }
        if (more) ax = axn;
    }
}
template <int PASS>
__device__ __forceinline__ void ph_peer(const Params& p, unsigned char* lds) {
    const int tid_ = phase_tid();
    const int lane = tid_ & 63, w = tid_ >> 6, b = blockIdx.x, G = gridDim.x;
    if ((G & 7) == 0) {
        const int g = b & 7, nsw = (G >> 3) * 2 * (NTHR / 64), t0 = ((g >> 2) * (G >> 3) + (b >> 3)) * (NTHR / 64) + w;
        if (PASS == 0) peer_stream<0>(p, lds, tid_, g & 3, t0, nsw, t0 < S ? (S - 1 - t0) / nsw + 1 : 0);
        else peerv_stream(p, lds, tid_, g & 3, t0, nsw, t0 < S ? (S - 1 - t0) / nsw + 1 : 0);
    } else {
        const int nw = G * (NTHR / 64), it0 = b * (NTHR / 64) + w;
        for (int it = it0; it < S * 4; it += nw) { if (PASS == 0) peer_stream<0>(p, lds, tid_, it & 3, it >> 2, 0, 1); else peerv_stream(p, lds, tid_, it & 3, it >> 2, 0, 1); }
    }
}
__device__ __forceinline__ void ph_peer_combine(const Params& p) {
    unsigned char* ws = p.ws;
    const int* seli = (const int*)(ws + WS_SELI); const float* selg = (const float*)(ws + WS_SELG); const float* rstd2 = (const float*)(ws + WS_RSTD2);
    const float2* uvsc = (const float2*)(ws + WS_USC);
    const float* pd = (const float*)(ws + WS_PD);
    unsigned* cpl = (unsigned*)(ws + WS_CBUF); float* csc = (float*)(ws + WS_CSC);
    const int tid_ = phase_tid(), lane = tid_ & 63, gwave = (blockIdx.x * blockDim.x + tid_) >> 6, nwave = (gridDim.x * blockDim.x) >> 6;
    constexpr int TT = 4;
    for (int tb = gwave; tb < S; tb += TT * nwave) {
        float dsum[TT][2], sg[TT][2], rsd[TT]; int ei[TT][2];
#pragma unroll
        for (int k = 0; k < TT; ++k) {
            const int t = min(tb + k * nwave, S - 1);
#pragma unroll
            for (int hf = 0; hf < 2; ++hf) {
                const int e = t * 128 + 64 * hf + lane;
                ei[k][hf] = seli[e]; sg[k][hf] = selg[e];
                float d = 0.f;
#pragma unroll
                for (int g = 0; g < 4; ++g) d += pd[(size_t)g * S * 128 + e];
                dsum[k][hf] = d;
            }
            rsd[k] = rstd2[t];
        }
        float2 sc2[TT][2];
#pragma unroll
        for (int k = 0; k < TT; ++k)
#pragma unroll
            for (int hf = 0; hf < 2; ++hf) sc2[k][hf] = uvsc[ei[k][hf]];
#pragma unroll
        for (int k = 0; k < TT; ++k) {
            const int t = tb + k * nwave;
            if (t >= S) break;
            float cf[2];
#pragma unroll
            for (int hf = 0; hf < 2; ++hf) cf[hf] = sg[k][hf] * gelu_tanh(dsum[k][hf] * sc2[k][hf].x * rsd[k]) * sc2[k][hf].y;
            float m = fmaxf(fabsf(cf[0]), fabsf(cf[1]));
#pragma unroll
            for (int o = 1; o < 64; o <<= 1) m = fmaxf(m, __shfl_xor(m, o));
            const float inv = m > 0.f ? 119.0f / m : 0.f;
#pragma unroll
            for (int hf = 0; hf < 2; ++hf) {
                const int q = __float2int_rn(cf[hf] * inv);
                unsigned dl = (unsigned)(q & 15) << (4 * (lane & 7)), dh = (unsigned)(((q + 8) >> 4) & 15) << (4 * (lane & 7));
                dl |= __shfl_xor(dl, 1); dh |= __shfl_xor(dh, 1); dl |= __shfl_xor(dl, 2); dh |= __shfl_xor(dh, 2); dl |= __shfl_xor(dl, 4); dh |= __shfl_xor(dh, 4);
                if ((lane & 7) == 0) {
                    const int dk = 8 * hf + (lane >> 3), rs = dk >> 1, half = dk & 1;
                    cpl[(size_t)t * 32 + 4 * rs + half] = dl; cpl[(size_t)t * 32 + 4 * rs + 2 + half] = dh;
                }
            }
            if (lane == 0) csc[t] = m * (1.0f / 119.0f);
        }
    }
}

#define LAS __attribute__((address_space(3)))
#define XB_TMO      128
#define XB_XCNT(j)  (256  + 64 * (j))
#define XB_XSUB(j)  (1280 + 64 * (j))
#define XB_XGEN(j)  (2304 + 64 * (j))
#define XB_TOP      3328
#define XB_TOPGEN   3392
#define XCD_BAR_WORDS 3456
#define XB_SPIN_CAP (1u << 18)
__device__ __forceinline__ unsigned xb_ld(unsigned* p)              { return __hip_atomic_load(p, __ATOMIC_RELAXED, __HIP_MEMORY_SCOPE_AGENT); }
__device__ __forceinline__ unsigned xb_add(unsigned* p, unsigned v) { return __hip_atomic_fetch_add(p, v, __ATOMIC_RELAXED, __HIP_MEMORY_SCOPE_AGENT); }
__device__ __forceinline__ unsigned xb_xcc_id() { return (unsigned)__builtin_amdgcn_s_getreg((3 << 11) | 20) & 0xFu; }
#define XB_SPIN(cond, bar) do { unsigned _sp = 0; while (cond) { __builtin_amdgcn_s_sleep(1); \
    if ((++_sp & 255u) == 0u) { if (xb_ld(&(bar)[XB_TMO])) break; if (_sp > XB_SPIN_CAP) { atomicAdd(&(bar)[XB_TMO], 1u); break; } } } } while (0)
struct XcdBarrier { unsigned* bar; unsigned x; volatile LAS unsigned* st; };
__device__ __forceinline__ XcdBarrier xcd_barrier_post(unsigned* bar, volatile LAS unsigned* st) {
    XcdBarrier b; b.bar = bar; b.x = xb_xcc_id(); b.st = st;
    if (threadIdx.x == 0) (void)xb_add(&bar[XB_XCNT(b.x)], 1u);
    return b;
}
__device__ __forceinline__ void xcd_barrier_complete(unsigned* bar, unsigned x, unsigned& nloc, unsigned& nx) {
    const unsigned G = gridDim.x * gridDim.y * gridDim.z;
    unsigned sum, cnt, mine, sp = 0u;
    for (;;) {
        sum = 0u; cnt = 0u; mine = 0u;
#pragma unroll
        for (unsigned j = 0; j < 16; ++j) { const unsigned c = xb_ld(&bar[XB_XCNT(j)]); sum += c; cnt += (c > 0u) ? 1u : 0u; mine = (j == x) ? c : mine; }
        if (sum == G) break;
        __builtin_amdgcn_s_sleep(1);
        if ((++sp & 255u) == 0u) { if (xb_ld(&bar[XB_TMO])) break; if (sp > XB_SPIN_CAP) { atomicAdd(&bar[XB_TMO], 1u); break; } }
    }
    nloc = mine > 0u ? mine : 1u; nx = cnt > 0u ? cnt : 1u;
}
__device__ __forceinline__ void xcd_barrier(const XcdBarrier& b) {
    asm volatile("s_waitcnt vmcnt(0)" ::: "memory");
    __syncthreads();
    if (threadIdx.x == 0) {
        unsigned* bar = b.bar;
        __builtin_amdgcn_s_waitcnt(0);
        unsigned nloc = b.st[0], nx = b.st[1];
        if (nloc == 0u) { xcd_barrier_complete(bar, b.x, nloc, nx); b.st[0] = nloc; b.st[1] = nx; }
        const unsigned old = xb_add(&bar[XB_XSUB(b.x)], 1u);
        const unsigned gen = old / nloc;
        if (old + 1u == (gen + 1u) * nloc) {
            __builtin_amdgcn_fence(__ATOMIC_RELEASE, "agent");
            asm volatile("s_waitcnt vmcnt(0)" ::: "memory");
            const unsigned og = xb_add(&bar[XB_TOP], 1u);
            const unsigned tg = og / nx;
            if (og + 1u == (tg + 1u) * nx) xb_add(&bar[XB_TOPGEN], 1u);
            else XB_SPIN(xb_ld(&bar[XB_TOPGEN]) == tg, bar);
            __builtin_amdgcn_fence(__ATOMIC_ACQUIRE, "agent");
            xb_add(&bar[XB_XGEN(b.x)], 1u);
            asm volatile("s_waitcnt vmcnt(0)" ::: "memory");
        } else {
            XB_SPIN(xb_ld(&bar[XB_XGEN(b.x)]) == gen, bar);
            __builtin_amdgcn_fence(__ATOMIC_ACQUIRE, "agent");
            asm volatile("s_waitcnt vmcnt(0)" ::: "memory");
        }
    }
    __syncthreads();
}

constexpr int LDS_MISC = 158720;
constexpr int LDS_BYTES = LDS_MISC + 1024;

__global__ void __launch_bounds__(NTHR, 2) hymba_fwd(Params p) {
    extern __shared__ __attribute__((aligned(16))) unsigned char lds[];
    volatile LAS unsigned* misc = (volatile LAS unsigned*)((LAS unsigned char*)lds + LDS_MISC);
    if (threadIdx.x < 4) misc[threadIdx.x] = 0u;
    __syncthreads();
    XcdBarrier bar = xcd_barrier_post((unsigned*)(p.ws + WS_CTL), misc);

    PG8_LAS unsigned char* ring = (PG8_LAS unsigned char*)lds;
    unsigned char* ws = p.ws;
    ph_prep(p, lds);                          xcd_barrier(bar);
    {
        pg8::Gemm g{(const bf16_t*)(ws + WS_A), (const bf16_t*)(ws + WS_WINT), S, NPROJ, D}; pg8::StaticOrder so; so.init(S, NPROJ, (int)gridDim.x, (int)blockIdx.x);
        EpiInProj E{(const float*)(ws + WS_RSTD1), p.in[I_Q_NORM], p.in[I_K_NORM], (bf16_t*)(ws + WS_QH), (bf16_t*)(ws + WS_KH), (bf16_t*)(ws + WS_VH), (bf16_t*)(ws + WS_XRG), (bf16_t*)(ws + WS_GG)};
        pg8::gemm_phase<EpiInProj, pg8::StaticOrder, true, true>(ring, g, so, E);
        const int G = (int)gridDim.x, nunits = (S / 256) * (NPROJ / 256), rem = nunits % G, b = (int)blockIdx.x;
        const int tid_ = phase_tid(), w = tid_ >> 6, lane = tid_ & 63;
        if (rem == 0) ph_tables(p, b * (NTHR / 64) + w, G * (NTHR / 64), lane);
        else if (b >= rem) ph_tables(p, (b - rem) * (NTHR / 64) + w, (G - rem) * (NTHR / 64), lane);
    }
    xcd_barrier(bar);
    ph_attn(p); ph_rg<0>(p, lds);             xcd_barrier(bar);
    ph_rg<1>(p, lds);                         xcd_barrier(bar);
    {
        pg8::Gemm g{(const bf16_t*)(ws + WS_MIX), (const bf16_t*)(ws + WS_WOUTT), S, D, D}; pg8::StaticOrder so; so.init(S, D, (int)gridDim.x, (int)blockIdx.x);
        EpiOutProj E{p.in[I_X], (bf16_t*)(ws + WS_A), (float*)(ws + WS_SSQ), ws + WS_X1Q, (float*)(ws + WS_XSC)};
        pg8::gemm_phase<EpiOutProj, pg8::StaticOrder, true, true>(ring, g, so, E);
    }
    xcd_barrier(bar);
    {
        pg8::Gemm g{(const bf16_t*)(ws + WS_A), (const bf16_t*)(ws + WS_WQT), S, NQ, D}; pg8::StaticOrder so; so.init(S, NQ, (int)gridDim.x, (int)blockIdx.x);
        EpiPeerQ E{(bf16_t*)(ws + WS_B)};
        pg8::gemm_phase<EpiPeerQ, pg8::StaticOrder, true, true>(ring, g, so, E);
    }
    asm volatile("s_waitcnt vmcnt(0)" ::: "memory"); __syncthreads();
    ph_topk(p, (int*)lds);                    xcd_barrier(bar);
    ph_peer<0>(p, lds);                       xcd_barrier(bar);
    ph_peer_combine(p);                       xcd_barrier(bar);
    ph_peer<1>(p, lds);
}

extern "C" void kernel_launch(void* const* d_in, const int* in_sizes, int n_in, void* d_out, int out_size, void* d_ws, size_t ws_size, hipStream_t stream) {
    static int grid = 0;
    if (grid == 0) {
        if (n_in != 20 || out_size != S * D || ws_size < WS_END) { fprintf(stderr, "kernel_launch: unexpected shapes (n_in %d out %d ws %zu)\n", n_in, out_size, ws_size); grid = -1; return; }
        int dev = 0, cus = 0, per_cu = 0;
        if (hipGetDevice(&dev) != hipSuccess || hipDeviceGetAttribute(&cus, hipDeviceAttributeMultiprocessorCount, dev) != hipSuccess) { grid = -1; return; }
        if (hipFuncSetAttribute((const void*)hymba_fwd, hipFuncAttributeMaxDynamicSharedMemorySize, LDS_BYTES) != hipSuccess) { fprintf(stderr, "kernel_launch: hipFuncSetAttribute failed\n"); grid = -1; return; }
        if (hipOccupancyMaxActiveBlocksPerMultiprocessor(&per_cu, (const void*)hymba_fwd, NTHR, LDS_BYTES) != hipSuccess || per_cu < 1) { fprintf(stderr, "kernel_launch: occupancy query says %d blocks per CU\n", per_cu); grid = -1; return; }
        (void)hipGetLastError();
        grid = cus;
    }
    if (grid < 0) return;
    (void)hipMemsetAsync((char*)d_ws + WS_CTL, 0, XCD_BAR_WORDS * 4, stream);
    Params p{};
    for (int i = 0; i < 20; ++i) p.in[i] = (const float*)d_in[i];
    p.out = (float*)d_out; p.ws = (unsigned char*)d_ws;
    hipLaunchKernelGGL(hymba_fwd, dim3(grid), dim3(NTHR), LDS_BYTES, stream, p);
}
```

```cpp
#include <hip/hip_runtime.h>
#include <cstdint>
#include <cstdio>

typedef unsigned short bf16_t;
typedef short bf16x8 __attribute__((ext_vector_type(8)));
typedef float f32x4 __attribute__((ext_vector_type(4)));
typedef unsigned u32x4 __attribute__((ext_vector_type(4)));
typedef float f32x16 __attribute__((ext_vector_type(16)));

constexpr int S = 16384, D = 1024, NPROJ = 2560, DSB = 512, DRG = 512, NH = 8, HD = 64;
constexpr int PH = 8, PNK = 128, PDK = 256, PHALF = 128, PTOPK = 16, NEXP = 16384, NQ = PH * PDK;
constexpr int CHUNK = 64, NCHUNK = S / CHUNK;
constexpr float EPS = 1e-6f;
constexpr float LOG2E = 1.4426950408889634f;
constexpr float QSCALE = 0.125f * LOG2E;
constexpr int NTHR = 512;
constexpr float CARRY_STOP = -160.0f;

constexpr size_t MiB = 1u << 20;
constexpr size_t WS_CTL = 0;
constexpr size_t WS_WINT = 1 * MiB;
constexpr size_t WS_WOUTT = 6 * MiB;
constexpr size_t WS_WQT = 8 * MiB;
constexpr size_t WS_SUBK = 12 * MiB;
constexpr size_t WS_RSTD1 = 12 * MiB + 512 * 1024;
constexpr size_t WS_RSTD2 = WS_RSTD1 + 64 * 1024;
constexpr size_t WS_RGP = WS_RSTD2 + 64 * 1024;
constexpr size_t WS_RGH = WS_RGP + 512 * 1024;
constexpr size_t WS_RGSA = 207 * MiB, WS_RGSB = 223 * MiB;
constexpr size_t WS_A = 14 * MiB;
constexpr size_t WS_B = 46 * MiB;
constexpr size_t WS_QH = WS_B, WS_KH = WS_B + 16 * MiB, WS_VH = WS_B + 32 * MiB, WS_XRG = WS_B + 48 * MiB;
constexpr size_t WS_GG = 110 * MiB;
constexpr size_t WS_OSB = 126 * MiB;
constexpr size_t WS_MIX = 142 * MiB;
constexpr size_t WS_SELI = WS_MIX, WS_SELG = WS_MIX + 8 * MiB;
constexpr size_t WS_PD = WS_B;
constexpr size_t WS_CBUF = WS_GG;
constexpr size_t WS_CSC = WS_GG + 4 * MiB;
constexpr size_t WS_X1Q = WS_OSB;
constexpr size_t WS_XSC = WS_GG + 8 * MiB;
constexpr size_t WS_UB = 174 * MiB;
constexpr size_t WS_VB = 190 * MiB;
constexpr size_t WS_USC = 206 * MiB;
constexpr size_t WS_SSQ = 238 * MiB;
constexpr size_t WS_RGW = 239 * MiB;
constexpr size_t WS_END = 240 * MiB;

__device__ __forceinline__ unsigned f2bf(float f) { unsigned u = __builtin_bit_cast(unsigned, f); return (u + 0x7fffu + ((u >> 16) & 1u)) >> 16; }
__device__ __forceinline__ float u2f(unsigned u) { return __builtin_bit_cast(float, u); }
__device__ __forceinline__ float bf2f(unsigned h) { return __builtin_bit_cast(float, h << 16); }
__device__ __forceinline__ unsigned pk2(float lo, float hi) { return f2bf(lo) | (f2bf(hi) << 16); }
__device__ __forceinline__ unsigned pack_i8(float a, float b, float c, float d) {
    const int qa = __float2int_rn(a), qb = __float2int_rn(b), qc = __float2int_rn(c), qd = __float2int_rn(d);
    return (unsigned)(qa & 255) | ((unsigned)(qb & 255) << 8) | ((unsigned)(qc & 255) << 16) | ((unsigned)qd << 24);
}
__device__ __forceinline__ unsigned pack_n4(float a, float b, float c, float d) {
    const int qa = min(max(__float2int_rn(a), -7), 7) & 15, qb = min(max(__float2int_rn(b), -7), 7) & 15, qc = min(max(__float2int_rn(c), -7), 7) & 15, qd = min(max(__float2int_rn(d), -7), 7) & 15;
    return (unsigned)qa | ((unsigned)qb << 4) | ((unsigned)qc << 8) | ((unsigned)qd << 12);
}
template <int OFFS>
__device__ __forceinline__ unsigned pack_u4(float a, float b, float c, float d) {
    const int qa = (min(max(__float2int_rn(a), -7), 7) + OFFS) & 15, qb = (min(max(__float2int_rn(b), -7), 7) + OFFS) & 15, qc = (min(max(__float2int_rn(c), -7), 7) + OFFS) & 15, qd = (min(max(__float2int_rn(d), -7), 7) + OFFS) & 15;
    return (unsigned)qa | ((unsigned)qb << 8) | ((unsigned)qc << 16) | ((unsigned)qd << 24);
}
__device__ __forceinline__ float wave_sum(float v) {
#pragma unroll
    for (int o = 1; o < 64; o <<= 1) v += __shfl_xor(v, o);
    return v;
}
__device__ __forceinline__ float gelu_tanh(float x) {
    const float u = 0.7978845608028654f * (x + 0.044715f * x * x * x);
    const float e = __expf(2.0f * u);
    const float th = 1.0f - 2.0f / (e + 1.0f);
    return 0.5f * x * (1.0f + th);
}

__host__ __device__ __forceinline__ int inproj_phys_row(int nlog) { const int t = nlog >> 8, L = nlog & 255; return (t << 8) + 128 * ((L & 63) >> 5) + 32 * (L >> 6) + (L & 31); }

__device__ __forceinline__ int phase_tid() { int t = threadIdx.x; asm volatile("" : "+v"(t)); return t; }

struct Params {
    const float* in[20];
    float* out;
    unsigned char* ws;
};
enum { I_X = 0, I_NORM_MIX, I_W_IN, I_Q_NORM, I_K_NORM, I_CONV_W, I_CONV_B, I_RG_W_A, I_RG_B_A, I_RG_W_X, I_RG_B_X, I_RG_LAMBDA,
       I_OUT_NORM_SB, I_OUT_NORM_RG, I_W_OUT, I_NORM_FFN, I_PEER_WQ, I_PEER_SUBK, I_PEER_U, I_PEER_V };

template <bool INPROJ_PERM>
__device__ __forceinline__ void prep_transpose_item(const float* W, const float* gain0, const float* gain1, int K, int N, bf16_t* WT, float* scr, int item, int lane) {
    const int nblk = N / 32, kb = item / nblk, nb = item % nblk, k0 = 64 * kb, n0 = 32 * nb;
#pragma unroll 8
    for (int i = 0; i < 32; ++i) {
        const int kk = 2 * i + (lane >> 5), k = k0 + kk;
        const float g = (gain1 && k >= 512) ? gain1[k - 512] : gain0[k];
        scr[kk * 33 + (lane & 31)] = g * W[(size_t)k * N + n0 + (lane & 31)];
    }
    asm volatile("s_waitcnt lgkmcnt(0)" ::: "memory");
    const int c = lane & 7;
#pragma unroll
    for (int j = 0; j < 4; ++j) {
        const int n = (lane >> 3) + 8 * j; const float* s = scr + (8 * c) * 33 + n;
        u32x4 o; o.x = pk2(s[0 * 33], s[1 * 33]); o.y = pk2(s[2 * 33], s[3 * 33]); o.z = pk2(s[4 * 33], s[5 * 33]); o.w = pk2(s[6 * 33], s[7 * 33]);
        const int nr = INPROJ_PERM ? inproj_phys_row(n0 + n) : n0 + n;
        *(u32x4*)(WT + (size_t)nr * K + k0 + 8 * c) = o;
    }
    asm volatile("s_waitcnt lgkmcnt(0)" ::: "memory");
}
__device__ __forceinline__ void ph_tables(const Params& p, int cw, int ncw, int lane) {
    unsigned char* ws = p.ws;
    {
        const float* u = p.in[I_PEER_U]; const float* v = p.in[I_PEER_V]; const float* g = p.in[I_NORM_FFN];
        unsigned* ub = (unsigned*)(ws + WS_UB); unsigned* vb = (unsigned*)(ws + WS_VB); float2* uvsc = (float2*)(ws + WS_USC);
        f32x4 gq[4];
#pragma unroll
        for (int j = 0; j < 4; ++j) gq[j] = *((const f32x4*)g + lane + 64 * j);
        for (int e0 = cw; e0 < NEXP; e0 += 2 * ncw) {
            f32x4 a[2][4], b[2][4]; float ma[2], mb[2], sa2[2], sb2[2];
#pragma unroll
            for (int rr = 0; rr < 2; ++rr) {
                const int e = min(e0 + rr * ncw, NEXP - 1);
#pragma unroll
                for (int j = 0; j < 4; ++j) { a[rr][j] = *((const f32x4*)(u + (size_t)e * D) + lane + 64 * j); b[rr][j] = *((const f32x4*)(v + (size_t)e * D) + lane + 64 * j); }
            }
#pragma unroll
            for (int rr = 0; rr < 2; ++rr) {
                ma[rr] = 0.f; mb[rr] = 0.f; sa2[rr] = 0.f; sb2[rr] = 0.f;
#pragma unroll
                for (int j = 0; j < 4; ++j) {
                    a[rr][j] = a[rr][j] * gq[j];
                    const f32x4 aa = a[rr][j], bb = b[rr][j];
                    ma[rr] = fmaxf(ma[rr], fmaxf(fmaxf(fabsf(aa.x), fabsf(aa.y)), fmaxf(fabsf(aa.z), fabsf(aa.w))));
                    mb[rr] = fmaxf(mb[rr], fmaxf(fmaxf(fabsf(bb.x), fabsf(bb.y)), fmaxf(fabsf(bb.z), fabsf(bb.w))));
                    sa2[rr] += (aa.x * aa.x + aa.y * aa.y) + (aa.z * aa.z + aa.w * aa.w);
                    sb2[rr] += (bb.x * bb.x + bb.y * bb.y) + (bb.z * bb.z + bb.w * bb.w);
                }
            }
#pragma unroll
            for (int o = 1; o < 64; o <<= 1)
#pragma unroll
                for (int rr = 0; rr < 2; ++rr) { ma[rr] = fmaxf(ma[rr], __shfl_xor(ma[rr], o)); mb[rr] = fmaxf(mb[rr], __shfl_xor(mb[rr], o)); sa2[rr] += __shfl_xor(sa2[rr], o); sb2[rr] += __shfl_xor(sb2[rr], o); }
#pragma unroll
            for (int rr = 0; rr < 2; ++rr) {
                const int e = e0 + rr * ncw;
                if (e < NEXP) {
                    const float ca = fminf(ma[rr], 2.5f * sqrtf(sa2[rr] * (1.0f / D))), cb = fminf(mb[rr], 2.5f * sqrtf(sb2[rr] * (1.0f / D)));
                    const float ia = ca > 0.f ? 7.0f / ca : 0.f, ib = cb > 0.f ? 7.0f / cb : 0.f;
#pragma unroll
                    for (int j = 0; j < 4; ++j) {
                        const f32x4 aa = a[rr][j], bb = b[rr][j];
                        const unsigned na = pack_u4<0>(aa.x * ia, aa.y * ia, aa.z * ia, aa.w * ia), nb = pack_n4(bb.x * ib, bb.y * ib, bb.z * ib, bb.w * ib);
                        const unsigned pa = __shfl_xor(na, 1), pb = __shfl_xor(nb, 1);
                        if ((lane & 1) == 0) {
                            ub[((size_t)j * NEXP + e) * 32 + (lane >> 1)] = na | (pa << 4);
                            vb[((size_t)j * NEXP + e) * 32 + (lane >> 1)] = nb | (pb << 16);
                        }
                    }
                    if (lane == 0) uvsc[e] = make_float2(ca * (1.0f / 7.0f), cb * (1.0f / 7.0f));
                }
            }
        }
    }
}

__device__ __forceinline__ void ph_prep(const Params& p, unsigned char* lds) {
    const int tid_ = phase_tid();
    const int gtid = blockIdx.x * blockDim.x + tid_, gsize = gridDim.x * blockDim.x;
    const int lane = tid_ & 63, gwave = gtid >> 6, nwave = gsize >> 6;
    unsigned char* ws = p.ws;
    {
        float* scr = (float*)lds + (tid_ >> 6) * (64 * 33);
        constexpr int I_IN = (D / 64) * (NPROJ / 32), I_OUT = (D / 64) * (D / 32), I_Q = (D / 64) * (NQ / 32);
        for (int it = gwave; it < I_IN + I_OUT + I_Q; it += nwave) {
            if (it < I_IN) prep_transpose_item<true>(p.in[I_W_IN], p.in[I_NORM_MIX], nullptr, D, NPROJ, (bf16_t*)(ws + WS_WINT), scr, it, lane);
            else if (it < I_IN + I_OUT) prep_transpose_item<false>(p.in[I_W_OUT], p.in[I_OUT_NORM_SB], p.in[I_OUT_NORM_RG], D, D, (bf16_t*)(ws + WS_WOUTT), scr, it - I_IN, lane);
            else prep_transpose_item<false>(p.in[I_PEER_WQ], p.in[I_NORM_FFN], nullptr, D, NQ, (bf16_t*)(ws + WS_WQT), scr, it - I_IN - I_OUT, lane);
        }
    }
    {
        const float* wa = p.in[I_RG_W_A]; const float* wx = p.in[I_RG_W_X]; bf16_t* o = (bf16_t*)(ws + WS_RGW);
        for (int e = gtid; e < 8 * 2 * 2 * 4 * 64 * 8; e += gsize) {
            const int el = e & 7, ln = (e >> 3) & 63, s = (e >> 9) & 3, jt = (e >> 11) & 1, g = (e >> 12) & 1, n = e >> 13;
            const int j = 32 * jt + (ln & 31), i = 16 * s + 8 * (el >> 2) + 4 * (ln >> 5) + (el & 3);
            o[e] = (bf16_t)f2bf((g == 0 ? wa : wx)[((size_t)n * 64 + i) * 64 + j]);
        }
    }
    {
        const float* sk = p.in[I_PEER_SUBK]; bf16_t* o = (bf16_t*)(ws + WS_SUBK);
        for (int e = gtid; e < PH * 2 * PNK * PHALF; e += gsize) o[e] = (bf16_t)f2bf(sk[e]);
    }
    {
        const float* x = p.in[I_X]; bf16_t* xb = (bf16_t*)(ws + WS_A); float* rstd1 = (float*)(ws + WS_RSTD1);
        for (int row0 = gwave; row0 < S; row0 += 4 * nwave) {
            f32x4 v[4][4];
#pragma unroll
            for (int rr = 0; rr < 4; ++rr) {
                const int row = min(row0 + rr * nwave, S - 1);
#pragma unroll
                for (int j = 0; j < 4; ++j) v[rr][j] = ((const f32x4*)(x + (size_t)row * D) + lane)[64 * j];
            }
#pragma unroll
            for (int rr = 0; rr < 4; ++rr) {
                const int row = row0 + rr * nwave;
                float ss = 0.f;
#pragma unroll
                for (int j = 0; j < 4; ++j) ss += (v[rr][j].x * v[rr][j].x + v[rr][j].y * v[rr][j].y) + (v[rr][j].z * v[rr][j].z + v[rr][j].w * v[rr][j].w);
                ss = wave_sum(ss);
                if (row < S) {
                    uint2* o = (uint2*)(xb + (size_t)row * D) + lane;
#pragma unroll
                    for (int j = 0; j < 4; ++j) o[64 * j] = make_uint2(pk2(v[rr][j].x, v[rr][j].y), pk2(v[rr][j].z, v[rr][j].w));
                    if (lane == 0) rstd1[row] = rsqrtf(ss * (1.0f / D) + EPS);
                }
            }
        }
    }
}

namespace pg8 {
#define PG8_LAS __attribute__((address_space(3)))
typedef unsigned short bf16_t;
typedef short bf16x8 __attribute__((ext_vector_type(8)));
typedef float f32x4 __attribute__((ext_vector_type(4)));
typedef unsigned u32x4 __attribute__((ext_vector_type(4)));
constexpr int BM = 256, BK = 64, HALF = 128, HTB = HALF * BK * 2  , STAGE_BYTES = 8 * HTB, NXCD = 8, WGM = 8;

__host__ __device__ __forceinline__ int lds_byte(int r, int c) { const int st = (r >> 4) * 2 + (c >> 5), rr = r & 15, cc = c & 31, ob = rr * 64 + cc * 2; return st * 1024 + (ob ^ (((ob >> 9) & 1) << 5)); }
__host__ __device__ __forceinline__ void stage_rc(int b, int& R, int& C) { const int st = b / 1024, sb = b % 1024, swz = sb ^ (((sb >> 9) & 1) << 5); R = (st >> 1) * 16 + swz / 64; C = (st & 1) * 32 + (swz % 64) / 2; }
__host__ __device__ __forceinline__ int perm32(int rho) { const int n = rho >> 4, i = rho & 15; return 8 * (i >> 2) + 4 * n + (i & 3); }

struct Unit { int pm, pn; };
struct Gemm { const bf16_t* A; const bf16_t* Bt; int M, N, K; };

struct StaticOrder {
    int nM, nN, nwg, G, c;
    __host__ __device__ void init(int M, int N, int G_, int c_) { nM = M / BM; nN = N / BM; nwg = nM * nN; G = G_; c = c_; }
    __host__ __device__ bool next(int i, Unit& u) const {
        const long L = (long)i * G + c; if (L >= nwg) return false;
        int wgid = (int)L; { const int q = nwg / NXCD, r = nwg % NXCD, xcd = wgid % NXCD, off = wgid / NXCD; wgid = (xcd < r ? xcd * (q + 1) : r * (q + 1) + (xcd - r) * q) + off; }
        const int nig = WGM * nN, gid = wgid / nig, fm = gid * WGM, gsz = (nM - fm) < WGM ? (nM - fm) : WGM;
        u.pm = fm + ((wgid % nig) % gsz); u.pn = (wgid % nig) / gsz; return true;
    }
    __device__ __forceinline__ void a_ready(const Unit&) const {}
    __device__ __forceinline__ void done(const Unit&) const {}
};

__device__ __forceinline__ unsigned cvt_pk_bf16(float lo, float hi) { unsigned r; asm volatile("v_cvt_pk_bf16_f32 %0, %1, %2" : "=v"(r) : "v"(lo), "v"(hi)); return r; }
template <class Epi, class Sched, bool ALIGN_EPI = false, bool SP2 = false>
__device__ __forceinline__ void gemm_phase(PG8_LAS unsigned char* lds, const Gemm g, const Sched& S, const Epi& E) {
    const int tid = phase_tid(), wid = __builtin_amdgcn_readfirstlane(tid >> 6), lane = tid & 63, wr = wid >> 2, wc = wid & 3, fr = lane & 15, fq = lane >> 4;
    const int K = g.K, nt = K / BK;
    unsigned voffA[2], voffB[2];
#pragma unroll
    for (int i = 0; i < 2; ++i) { int R, C; stage_rc(tid * 16 + i * 8192, R, C); const int Rb = Epi::PERM ? ((R & ~31) + perm32(R & 31)) : R;
        voffA[i] = (unsigned)(R * K + C) * 2u; voffB[i] = (unsigned)(Rb * K + C) * 2u; }
    const size_t kstep = (size_t)(BK * 2);
    const size_t hstep = (size_t)HALF * K * 2;
    const size_t tstep = 2 * hstep;
    const unsigned ldsw = (unsigned)wid * 1024u;
    const int aoff = lds_byte(wr * 64 + fr, fq * 8), boff = lds_byte(wc * 32 + fr, fq * 8);
#define PG8_SA(b, h) (((b) * 2 + (h)) * HTB)
#define PG8_SB(b, h) ((4 + (b) * 2 + (h)) * HTB)
#define PG8_STAGE(bufoff, gbase, voff) do { _Pragma("unroll") for (int _i = 0; _i < 2; ++_i) \
        __builtin_amdgcn_global_load_lds((const unsigned*)((const char*)(gbase) + (voff)[_i]), (PG8_LAS unsigned*)(lds + (bufoff) + ldsw + _i * 8192), 16, 0, 0); } while (0)
#define PG8_LDA(dst, b, h) do { _Pragma("unroll") for (int m = 0; m < 4; ++m) _Pragma("unroll") for (int k = 0; k < 2; ++k) dst[m][k] = *(const PG8_LAS bf16x8*)(lds + PG8_SA(b, h) + aoff + m * 2048 + k * 1024); } while (0)
#define PG8_LDB(dst, b, h) do { _Pragma("unroll") for (int n = 0; n < 2; ++n) _Pragma("unroll") for (int k = 0; k < 2; ++k) dst[n][k] = *(const PG8_LAS bf16x8*)(lds + PG8_SB(b, h) + boff + n * 2048 + k * 1024); } while (0)
#define PG8_MMA(ai, bj, At, Bt) do { __builtin_amdgcn_s_setprio(1); _Pragma("unroll") for (int m = 0; m < 4; ++m) _Pragma("unroll") for (int n = 0; n < 2; ++n) _Pragma("unroll") for (int k = 0; k < 2; ++k) \
        acc[ai][bj][m][n] = __builtin_amdgcn_mfma_f32_16x16x32_bf16(Bt[n][k], At[m][k], acc[ai][bj][m][n], 0, 0, 0); __builtin_amdgcn_s_setprio(0); } while (0)
#define PG8_WAIT_V(n) asm volatile("s_waitcnt vmcnt(" #n ")" ::: "memory")
#define PG8_WAIT_L(n) asm volatile("s_waitcnt lgkmcnt(" #n ")" ::: "memory")
#define PG8_BAR __builtin_amdgcn_s_barrier()
#define PG8_SCHED __builtin_amdgcn_sched_barrier(0)
    Unit cur, nxt; int ui = 0;
    if (!S.next(0, cur)) return;
    f32x4 acc[2][2][4][2];
#pragma unroll
    for (int a = 0; a < 2; ++a)
#pragma unroll
        for (int b = 0; b < 2; ++b)
#pragma unroll
            for (int m = 0; m < 4; ++m)
#pragma unroll
                for (int n = 0; n < 2; ++n) acc[a][b][m][n] = (f32x4){0.f, 0.f, 0.f, 0.f};
    bf16x8 At[4][2], B0[2][2], B1[2][2];
    const char* cA = (const char*)g.A + (size_t)cur.pm * tstep; const char* cB = (const char*)g.Bt + (size_t)cur.pn * tstep;
    S.a_ready(cur);
    if constexpr (SP2) {
        PG8_STAGE(PG8_SB(0, 0), cB, voffB); PG8_STAGE(PG8_SB(0, 1), cB + hstep, voffB); PG8_STAGE(PG8_SA(0, 0), cA, voffA); PG8_STAGE(PG8_SA(0, 1), cA + hstep, voffA);
        if (wr == 1) PG8_BAR;
        PG8_WAIT_V(2); PG8_BAR;
        PG8_STAGE(PG8_SB(1, 0), cB + kstep, voffB); PG8_STAGE(PG8_SA(1, 0), cA + kstep, voffA); PG8_STAGE(PG8_SB(1, 1), cB + hstep + kstep, voffB);
        PG8_WAIT_V(6); PG8_BAR;
    } else {
        PG8_STAGE(PG8_SB(0, 0), cB, voffB); PG8_STAGE(PG8_SA(0, 0), cA, voffA); PG8_STAGE(PG8_SB(0, 1), cB + hstep, voffB); PG8_STAGE(PG8_SA(0, 1), cA + hstep, voffA);
        if (wr == 1) PG8_BAR;
        PG8_WAIT_V(4); PG8_BAR;
        PG8_STAGE(PG8_SB(1, 0), cB + kstep, voffB); PG8_STAGE(PG8_SA(1, 0), cA + kstep, voffA); PG8_STAGE(PG8_SB(1, 1), cB + hstep + kstep, voffB);
        PG8_WAIT_V(6); PG8_BAR;
    }
    for (;;) {
        const bool has_next = S.next(ui + 1, nxt);
        const char* nA = has_next ? (const char*)g.A + (size_t)nxt.pm * tstep : cA; const char* nB = has_next ? (const char*)g.Bt + (size_t)nxt.pn * tstep : cB;
        for (int t = 0; t < nt; t += 2) {
            const bool last = (t == nt - 2);
            const char* a1 = cA + (size_t)(t + 1) * kstep;
            const char* a2 = last ? nA : cA + (size_t)(t + 2) * kstep; const char* b2 = last ? nB : cB + (size_t)(t + 2) * kstep;
            const char* a3 = a2 + kstep; const char* b3 = b2 + kstep;
            if (last && has_next) S.a_ready(nxt);
            if constexpr (SP2) {
            PG8_LDB(B0, 0, 0); PG8_LDB(B1, 0, 1); PG8_SCHED; PG8_LDA(At, 0, 0); PG8_STAGE(PG8_SA(1, 1), a1 + hstep, voffA);
            PG8_WAIT_V(8); PG8_WAIT_L(0); PG8_BAR; PG8_MMA(0, 0, At, B0); PG8_MMA(0, 1, At, B1); PG8_BAR; PG8_SCHED;
            PG8_LDA(At, 0, 1); PG8_STAGE(PG8_SB(0, 0), b2, voffB); PG8_STAGE(PG8_SB(0, 1), b2 + hstep, voffB); PG8_STAGE(PG8_SA(0, 0), a2, voffA);
            PG8_WAIT_V(8); PG8_WAIT_L(0); PG8_BAR; PG8_MMA(1, 0, At, B0); PG8_MMA(1, 1, At, B1); PG8_BAR; PG8_SCHED;
            PG8_LDB(B0, 1, 0); PG8_LDB(B1, 1, 1); PG8_SCHED; PG8_LDA(At, 1, 0); PG8_STAGE(PG8_SA(0, 1), a2 + hstep, voffA);
            PG8_WAIT_V(8); PG8_WAIT_L(0); PG8_BAR; PG8_MMA(0, 0, At, B0); PG8_MMA(0, 1, At, B1); PG8_BAR; PG8_SCHED;
            PG8_LDA(At, 1, 1); PG8_STAGE(PG8_SB(1, 0), b3, voffB); PG8_STAGE(PG8_SB(1, 1), b3 + hstep, voffB); PG8_STAGE(PG8_SA(1, 0), a3, voffA);
            PG8_WAIT_V(8); PG8_WAIT_L(0); PG8_BAR; PG8_MMA(1, 0, At, B0); PG8_MMA(1, 1, At, B1); PG8_BAR; PG8_SCHED;
            } else {
            PG8_LDB(B0, 0, 0); PG8_SCHED; PG8_LDA(At, 0, 0); PG8_STAGE(PG8_SA(1, 1), a1 + hstep, voffA);
            PG8_WAIT_L(8); PG8_BAR; PG8_WAIT_L(0); PG8_MMA(0, 0, At, B0); PG8_BAR; PG8_SCHED;
            PG8_LDB(B1, 0, 1); PG8_STAGE(PG8_SB(0, 0), b2, voffB);
            PG8_BAR; PG8_WAIT_L(0); PG8_MMA(0, 1, At, B1); PG8_BAR;
            PG8_LDA(At, 0, 1); PG8_STAGE(PG8_SA(0, 0), a2, voffA);
            PG8_BAR; PG8_WAIT_L(0); PG8_MMA(1, 0, At, B0); PG8_BAR; PG8_SCHED;
            PG8_STAGE(PG8_SB(0, 1), b2 + hstep, voffB);
            PG8_WAIT_V(6); PG8_BAR; PG8_MMA(1, 1, At, B1); PG8_BAR;
            PG8_LDB(B0, 1, 0); PG8_SCHED; PG8_LDA(At, 1, 0); PG8_STAGE(PG8_SA(0, 1), a2 + hstep, voffA);
            PG8_WAIT_L(8); PG8_BAR; PG8_WAIT_L(0); PG8_MMA(0, 0, At, B0); PG8_BAR; PG8_SCHED;
            PG8_LDB(B1, 1, 1); PG8_STAGE(PG8_SB(1, 0), b3, voffB);
            PG8_BAR; PG8_WAIT_L(0); PG8_MMA(0, 1, At, B1); PG8_BAR;
            PG8_LDA(At, 1, 1); PG8_STAGE(PG8_SA(1, 0), a3, voffA);
            PG8_BAR; PG8_WAIT_L(0); PG8_MMA(1, 0, At, B0); PG8_BAR; PG8_SCHED;
            PG8_STAGE(PG8_SB(1, 1), b3 + hstep, voffB);
            PG8_WAIT_V(6); PG8_BAR; PG8_MMA(1, 1, At, B1); PG8_BAR;
            }
        }
        if constexpr (ALIGN_EPI) { if (wr == 0) PG8_BAR; }
        if constexpr (!Epi::AFTER_DRAIN) { E(acc, cur, wr, wc, fr, fq); S.done(cur); }
        if (!has_next) break;
#pragma unroll
        for (int a = 0; a < 2; ++a)
#pragma unroll
            for (int b = 0; b < 2; ++b)
#pragma unroll
                for (int m = 0; m < 4; ++m)
#pragma unroll
                    for (int n = 0; n < 2; ++n) acc[a][b][m][n] = (f32x4){0.f, 0.f, 0.f, 0.f};
        cur = nxt; cA = nA; cB = nB; ++ui;
        if constexpr (ALIGN_EPI) { if (wr == 1) PG8_BAR; }
    }
    PG8_WAIT_V(0);
    if constexpr (!ALIGN_EPI) { if (wr == 0) PG8_BAR; }
    PG8_BAR;
    if constexpr (Epi::AFTER_DRAIN) { E.fused(acc, cur, wr, wc, fr, fq, lds, wid, lane); S.done(cur); }
#undef PG8_SA
#undef PG8_SB
#undef PG8_STAGE
#undef PG8_LDA
#undef PG8_LDB
#undef PG8_MMA
#undef PG8_WAIT_V
#undef PG8_WAIT_L
#undef PG8_BAR
#undef PG8_SCHED
}
}

struct EpiInProj {
    static constexpr bool PERM = true, AFTER_DRAIN = false;
    const float* rstd1; const float* qn; const float* kn; bf16_t *qh, *kh, *vh, *xrg, *gg;
    __device__ __forceinline__ void operator()(const pg8::f32x4 (&acc)[2][2][4][2], const pg8::Unit& u, int wr, int wc, int fr, int fq) const {
        const int region = u.pn >> 1;
        const int head = (u.pn & 1) * 4 + wc;
        float rsv[2][4];
#pragma unroll
        for (int ai = 0; ai < 2; ++ai)
#pragma unroll
            for (int m = 0; m < 4; ++m) rsv[ai][m] = rstd1[u.pm * 256 + ai * 128 + wr * 64 + m * 16 + fr];
        pg8::f32x4 gn[2][2];
        if (region <= 1) {
            const float* g = region == 0 ? qn : kn; const float sc = region == 0 ? QSCALE : 1.0f;
#pragma unroll
            for (int bj = 0; bj < 2; ++bj)
#pragma unroll
                for (int n = 0; n < 2; ++n) gn[bj][n] = *(const pg8::f32x4*)(g + 32 * bj + 8 * fq + 4 * n) * sc;
        }
#pragma unroll
        for (int ai = 0; ai < 2; ++ai)
#pragma unroll
            for (int m = 0; m < 4; ++m) {
                const int row = u.pm * 256 + ai * 128 + wr * 64 + m * 16 + fr;
                const float rs = rsv[ai][m];
                pg8::f32x4 v[2][2];
#pragma unroll
                for (int bj = 0; bj < 2; ++bj)
#pragma unroll
                    for (int n = 0; n < 2; ++n) v[bj][n] = acc[ai][bj][m][n] * rs;
                bf16_t* dst;
                if (region <= 1) {
                    float ss = 0.f;
#pragma unroll
                    for (int bj = 0; bj < 2; ++bj)
#pragma unroll
                        for (int n = 0; n < 2; ++n) ss += (v[bj][n][0] * v[bj][n][0] + v[bj][n][1] * v[bj][n][1]) + (v[bj][n][2] * v[bj][n][2] + v[bj][n][3] * v[bj][n][3]);
                    ss += __shfl_xor(ss, 16); ss += __shfl_xor(ss, 32);
                    const float rn = rsqrtf(ss * (1.0f / HD) + EPS);
#pragma unroll
                    for (int bj = 0; bj < 2; ++bj)
#pragma unroll
                        for (int n = 0; n < 2; ++n) v[bj][n] = v[bj][n] * rn * gn[bj][n];
                    bf16_t* fb = (region == 0 ? qh : kh) + ((size_t)(head * (S / 32) + (row >> 5)) * 4 * 64 + (row & 31)) * 8;
#pragma unroll
                    for (int bj = 0; bj < 2; ++bj) {
                        pg8::u32x4 w; w.x = pg8::cvt_pk_bf16(v[bj][0][0], v[bj][0][1]); w.y = pg8::cvt_pk_bf16(v[bj][0][2], v[bj][0][3]);
                        w.z = pg8::cvt_pk_bf16(v[bj][1][0], v[bj][1][1]); w.w = pg8::cvt_pk_bf16(v[bj][1][2], v[bj][1][3]);
                        *(pg8::u32x4*)(fb + ((2 * bj + (fq >> 1)) * 64 + 32 * (fq & 1)) * 8) = w;
                    }
                    continue;
                } else if (region == 2) {
#pragma unroll
                    for (int bj = 0; bj < 2; ++bj)
#pragma unroll
                        for (int n = 0; n < 2; ++n)
#pragma unroll
                            for (int i = 0; i < 4; ++i) {
                                const int d = 32 * bj + 8 * fq + 4 * n + i, kl = row & 31;
                                vh[(((((size_t)head * (S / 32) + (row >> 5)) * 2 + (d >> 5)) * 2 + (kl >> 4)) * 64 + (d & 31) + 32 * ((kl >> 2) & 1)) * 8 + 4 * ((kl >> 3) & 1) + (kl & 3)] = (bf16_t)f2bf(v[bj][n][i]);
                            }
                    continue;
                } else if (region == 3) {
                    dst = xrg + (size_t)row * DRG + head * 64;
                } else {
#pragma unroll
                    for (int bj = 0; bj < 2; ++bj)
#pragma unroll
                        for (int n = 0; n < 2; ++n)
#pragma unroll
                            for (int i = 0; i < 4; ++i) v[bj][n][i] = gelu_tanh(v[bj][n][i]);
#pragma unroll
                    for (int bj = 0; bj < 2; ++bj)
#pragma unroll
                        for (int n = 0; n < 2; ++n)
                            *(uint2*)(gg + ((((size_t)(row >> 5) * 8 + head) * 8 + (4 * bj + fq)) * 64 + (row & 31) + 32 * n) * 4) = make_uint2(pg8::cvt_pk_bf16(v[bj][n][0], v[bj][n][1]), pg8::cvt_pk_bf16(v[bj][n][2], v[bj][n][3]));
                    continue;
                }
#pragma unroll
                for (int bj = 0; bj < 2; ++bj) {
                    pg8::u32x4 w; w.x = pg8::cvt_pk_bf16(v[bj][0][0], v[bj][0][1]); w.y = pg8::cvt_pk_bf16(v[bj][0][2], v[bj][0][3]);
                    w.z = pg8::cvt_pk_bf16(v[bj][1][0], v[bj][1][1]); w.w = pg8::cvt_pk_bf16(v[bj][1][2], v[bj][1][3]);
                    *(pg8::u32x4*)(dst + 32 * bj + 8 * fq) = w;
                }
            }
    }
};
struct EpiOutProj {
    static constexpr bool PERM = true, AFTER_DRAIN = false;
    const float* x; bf16_t* x1b; float* ssq; unsigned char* x1q; float* xsc;
    __device__ __forceinline__ void operator()(const pg8::f32x4 (&acc)[2][2][4][2], const pg8::Unit& u, int wr, int wc, int fr, int fq) const {
        pg8::u32x4 xv[2][2][2];
#define OUTPROJ_LD(buf, ai_, mh_) do { _Pragma("unroll") for (int mm_ = 0; mm_ < 2; ++mm_) _Pragma("unroll") for (int bj_ = 0; bj_ < 2; ++bj_) { \
            const size_t o_ = (size_t)(u.pm * 256 + (ai_) * 128 + wr * 64 + (2 * (mh_) + mm_) * 16 + fr) * D + u.pn * 256 + bj_ * 128 + wc * 32 + 8 * fq; \
            xv[buf][mm_][bj_] = *(const pg8::u32x4*)(x1b + o_); } } while (0)
        OUTPROJ_LD(0, 0, 0);
#pragma unroll
        for (int ai = 0; ai < 2; ++ai)
#pragma unroll
            for (int m = 0; m < 4; ++m) {
                const int kb = ai * 2 + (m >> 1);
                if ((m & 1) == 0 && kb < 3) OUTPROJ_LD((kb + 1) & 1, (kb + 1) >> 1, (kb + 1) & 1);
                const int row = u.pm * 256 + ai * 128 + wr * 64 + m * 16 + fr;
                float ss = 0.f;
#pragma unroll
                for (int bj = 0; bj < 2; ++bj) {
                    const int col = u.pn * 256 + bj * 128 + wc * 32 + 8 * fq;
                    const size_t o = (size_t)row * D + col;
                    const pg8::u32x4 xw = xv[kb & 1][m & 1][bj];
                    const pg8::f32x4 a = (pg8::f32x4){u2f(xw.x << 16), u2f(xw.x & 0xffff0000u), u2f(xw.y << 16), u2f(xw.y & 0xffff0000u)} + acc[ai][bj][m][0];
                    const pg8::f32x4 b = (pg8::f32x4){u2f(xw.z << 16), u2f(xw.z & 0xffff0000u), u2f(xw.w << 16), u2f(xw.w & 0xffff0000u)} + acc[ai][bj][m][1];
                    ss += (a[0] * a[0] + a[1] * a[1]) + (a[2] * a[2] + a[3] * a[3]) + (b[0] * b[0] + b[1] * b[1]) + (b[2] * b[2] + b[3] * b[3]);
                    pg8::u32x4 w; w.x = pg8::cvt_pk_bf16(a[0], a[1]); w.y = pg8::cvt_pk_bf16(a[2], a[3]); w.z = pg8::cvt_pk_bf16(b[0], b[1]); w.w = pg8::cvt_pk_bf16(b[2], b[3]);
                    *(pg8::u32x4*)(x1b + o) = w;
                    float mx = fmaxf(fmaxf(fmaxf(fabsf(a[0]), fabsf(a[1])), fmaxf(fabsf(a[2]), fabsf(a[3]))), fmaxf(fmaxf(fabsf(b[0]), fabsf(b[1])), fmaxf(fabsf(b[2]), fabsf(b[3]))));
                    mx = fmaxf(mx, __shfl_xor(mx, 16)); mx = fmaxf(mx, __shfl_xor(mx, 32));
                    const float inv = mx > 0.f ? 119.0f / mx : 0.f;
                    unsigned pl = 0u, ph = 0u;
#pragma unroll
                    for (int i = 0; i < 4; ++i) {
                        const int qa = __float2int_rn(a[i] * inv), qb = __float2int_rn(b[i] * inv);
                        pl |= ((unsigned)(qa & 15) << (8 * i)) | ((unsigned)(qb & 15) << (8 * i + 4));
                        ph |= ((unsigned)(((qa + 8) >> 4) & 15) << (8 * i)) | ((unsigned)(((qb + 8) >> 4) & 15) << (8 * i + 4));
                    }
                    unsigned* cq = (unsigned*)(x1q + (size_t)row * D + (col & ~31));
                    cq[fq] = pl; cq[4 + fq] = ph;
                    if (fq == 0) xsc[(size_t)row * 32 + (col >> 5)] = mx * (1.0f / 119.0f);
                }
                ss += __shfl_xor(ss, 16); ss += __shfl_xor(ss, 32);
                if (fq == 0) ssq[(size_t)row * 16 + u.pn * 4 + wc] = ss;
            }
    }
};
#undef OUTPROJ_LD
struct EpiPeerQ {
    static constexpr bool PERM = true, AFTER_DRAIN = false;
    bf16_t* qp;
    __device__ __forceinline__ void operator()(const pg8::f32x4 (&acc)[2][2][4][2], const pg8::Unit& u, int wr, int wc, int fr, int fq) const {
#pragma unroll
        for (int ai = 0; ai < 2; ++ai)
#pragma unroll
            for (int m = 0; m < 4; ++m) {
                const int row = u.pm * 256 + ai * 128 + wr * 64 + m * 16 + fr;
#pragma unroll
                for (int bj = 0; bj < 2; ++bj) {
                    const pg8::f32x4 a = acc[ai][bj][m][0], b = acc[ai][bj][m][1];
                    pg8::u32x4 w; w.x = pg8::cvt_pk_bf16(a[0], a[1]); w.y = pg8::cvt_pk_bf16(a[2], a[3]); w.z = pg8::cvt_pk_bf16(b[0], b[1]); w.w = pg8::cvt_pk_bf16(b[2], b[3]);
                    *(pg8::u32x4*)(qp + ((((size_t)((row >> 5) * 8 + u.pn) * 2 + bj) * 8 + 2 * wc + (fq >> 1)) * 64 + (row & 31) + 32 * (fq & 1)) * 8) = w;
                }
            }
    }
};

typedef float f32x2v __attribute__((ext_vector_type(2)));
typedef __bf16 bf16x2v __attribute__((ext_vector_type(2)));
__device__ __forceinline__ unsigned cvtpk(float lo, float hi) { const f32x2v v = {lo, hi}; const bf16x2v b = __builtin_convertvector(v, bf16x2v); return __builtin_bit_cast(unsigned, b); }
__device__ __forceinline__ bf16x8 pack_step(const f32x16& x, int s) {
    u32x4 pkd; pkd.x = cvtpk(x[8 * s], x[8 * s + 1]); pkd.y = cvtpk(x[8 * s + 2], x[8 * s + 3]); pkd.z = cvtpk(x[8 * s + 4], x[8 * s + 5]); pkd.w = cvtpk(x[8 * s + 6], x[8 * s + 7]);
    return __builtin_bit_cast(bf16x8, pkd);
}
#define MFMA32(a, b, c) __builtin_amdgcn_mfma_f32_32x32x16_bf16((a), (b), (c), 0, 0, 0)
__device__ __forceinline__ void ph_attn(const Params& p) {
    unsigned char* ws = p.ws;
    const bf16_t* qh = (const bf16_t*)(ws + WS_QH); const bf16_t* kh = (const bf16_t*)(ws + WS_KH); const bf16_t* vT = (const bf16_t*)(ws + WS_VH);
    bf16_t* osb = (bf16_t*)(ws + WS_OSB);
    const int tid = phase_tid(), lane = tid & 63, r = lane & 31, hh = lane >> 5;
    const int gwave = (blockIdx.x * blockDim.x + tid) >> 6, nwave = (gridDim.x * blockDim.x) >> 6;
    bf16x8 tp[2];
#pragma unroll
    for (int ss = 0; ss < 2; ++ss)
#pragma unroll
        for (int e = 0; e < 8; ++e) { const int k = 16 * ss + 8 * (e >> 2) + 4 * hh + (e & 3); tp[ss][e] = (k > r) ? (short)0x3F80 : (short)0; }
    f32x16 zero16;
#pragma unroll
    for (int i = 0; i < 16; ++i) zero16[i] = 0.f;
    for (int u = gwave; u < NH * (S / 32); u += nwave) {
        const int h = u / (S / 32), t0 = (u % (S / 32)) * 32;
        bf16x8 bq[4];
#pragma unroll
        for (int s = 0; s < 4; ++s) bq[s] = *(const bf16x8*)(qh + (((size_t)(h * (S / 32) + (t0 >> 5)) * 4 + s) * 64 + lane) * 8);
        f32x16 ot[2] = {zero16, zero16};
        float carry = 0.f;
        for (int kt0 = t0; kt0 >= 0; kt0 -= 32) {
            bf16x8 ak[4], av[2][2];
#pragma unroll
            for (int s = 0; s < 4; ++s) ak[s] = *(const bf16x8*)(kh + (((size_t)(h * (S / 32) + (kt0 >> 5)) * 4 + s) * 64 + lane) * 8);
#pragma unroll
            for (int dt = 0; dt < 2; ++dt)
#pragma unroll
                for (int ss = 0; ss < 2; ++ss) av[dt][ss] = *(const bf16x8*)(vT + ((((size_t)(h * (S / 32) + (kt0 >> 5)) * 2 + dt) * 2 + ss) * 64 + lane) * 8);
            f32x16 st = zero16;
#pragma unroll
            for (int s = 0; s < 4; ++s) st = MFMA32(ak[s], bq[s], st);
            const bool diag = (kt0 == t0);
            f32x16 lom, lb;
            float csum = 0.f;
#pragma unroll
            for (int i = 0; i < 16; ++i) {
                const float z = st[i];
                const float sp2 = fmaxf(z, 0.f) + __builtin_amdgcn_logf(1.0f + __builtin_amdgcn_exp2f(-fabsf(z)));
                const bool valid = !diag || ((i & 3) + 8 * (i >> 2) + 4 * hh < r);
                lom[i] = valid ? -sp2 : 0.f;
                lb[i] = z - sp2;
                csum += lom[i];
            }
            f32x16 suf = MFMA32(tp[0], pack_step(lom, 0), zero16);
            suf = MFMA32(tp[1], pack_step(lom, 1), suf);
            f32x16 w;
#pragma unroll
            for (int i = 0; i < 16; ++i) {
                const bool valid = !diag || ((i & 3) + 8 * (i >> 2) + 4 * hh < r);
                w[i] = valid ? __builtin_amdgcn_exp2f(lb[i] + suf[i] + carry) : 0.f;
            }
            const bf16x8 w0 = pack_step(w, 0), w1 = pack_step(w, 1);
#pragma unroll
            for (int dt = 0; dt < 2; ++dt) { ot[dt] = MFMA32(av[dt][0], w0, ot[dt]); ot[dt] = MFMA32(av[dt][1], w1, ot[dt]); }
            carry += csum + __shfl_xor(csum, 32);
            if (__all(carry < CARRY_STOP)) break;
        }
#pragma unroll
        for (int dt = 0; dt < 2; ++dt)
#pragma unroll
            for (int g = 0; g < 4; ++g) {
                uint2 o; o.x = cvtpk(ot[dt][4 * g], ot[dt][4 * g + 1]); o.y = cvtpk(ot[dt][4 * g + 2], ot[dt][4 * g + 3]);
                *(uint2*)(osb + (size_t)(t0 + r) * DSB + h * HD + 32 * dt + 8 * g + 4 * hh) = o;
            }
    }
}

constexpr int RG_LDS_CST = 0, RG_LDS_HIN = 16384, RG_LDS_P = 18432, RG_LDS_SSQ = 20480;
constexpr int RG_LDS_X = 22528, RG_XP = 1032, RG_LDS_O = 91904;
typedef unsigned u32x2 __attribute__((ext_vector_type(2)));
typedef __attribute__((address_space(3))) float lds_f;
typedef __attribute__((address_space(3))) unsigned char lds_b;
template <int CTRL, int ROWMASK>
__device__ __forceinline__ float dpp_mov(float oob, float x) {
    return __builtin_bit_cast(float, __builtin_amdgcn_update_dpp(__builtin_bit_cast(int, oob), __builtin_bit_cast(int, x), CTRL, ROWMASK, 0xf, false));
}
template <int CTRL, int ROWMASK>
__device__ __forceinline__ void scan_step(float (&av)[16], float (&bv)[16]) {
#pragma unroll
    for (int i = 0; i < 16; ++i) {
        const float ap = dpp_mov<CTRL, ROWMASK>(1.0f, av[i]), bp = dpp_mov<CTRL, ROWMASK>(0.0f, bv[i]);
        bv[i] = __builtin_fmaf(av[i], bp, bv[i]); av[i] *= ap;
    }
}
template <int PASS>
__device__ __forceinline__ void ph_rg(const Params& p, unsigned char* lds_raw) {
    float* lds = (float*)lds_raw;
    unsigned char* ws = p.ws;
    const bf16_t* xrg = (const bf16_t*)(ws + WS_XRG); const bf16_t* gg = (const bf16_t*)(ws + WS_GG); const bf16_t* wfrag = (const bf16_t*)(ws + WS_RGW);
    const bf16_t* osb = (const bf16_t*)(ws + WS_OSB); bf16_t* mix = (bf16_t*)(ws + WS_MIX);
    float* rgP = (float*)(ws + WS_RGP); float* rgH = (float*)(ws + WS_RGH);
    bf16_t* scA = (bf16_t*)(ws + WS_RGSA); bf16_t* scB = (bf16_t*)(ws + WS_RGSB);
    const int tid = phase_tid(), lane = tid & 63, r = lane & 31, hh = lane >> 5, n = __builtin_amdgcn_readfirstlane(tid >> 6);
    __syncthreads();
    if (PASS == 0) for (int e = tid; e < 8 * 2 * 8 * 32; e += NTHR) {
        const int q = e & 31, k = (e >> 5) & 7, h2 = (e >> 8) & 1, nn = e >> 9;
        const int c = 64 * nn + 32 * (q >> 4) + (q & 3) + 8 * ((q >> 2) & 3) + 4 * h2;
        float v;
        if (k < 4) v = p.in[I_CONV_W][k * DRG + c];
        else if (k == 4) v = p.in[I_CONV_B][c];
        else if (k == 5) v = p.in[I_RG_B_A][c];
        else if (k == 6) v = p.in[I_RG_B_X][c];
        else v = 8.0f * LOG2E * log1pf(__expf(-p.in[I_RG_LAMBDA][c]));
        lds[e] = v;
    }
    const unsigned lds0 = (unsigned)(size_t)((lds_b*)lds_raw);
    const unsigned cst_base = lds0 + (unsigned)((n * 2 + hh) * 1024);
    lds_f* hin_l = (lds_f*)(size_t)(lds0 + RG_LDS_HIN + (n * 2 + hh) * 128);
    lds_f* pc_l = (lds_f*)(size_t)(lds0 + RG_LDS_P + (n * 2 + hh) * 128);
    lds_b* xt = (lds_b*)(size_t)(lds0 + RG_LDS_X);
    lds_b* ot = (lds_b*)(size_t)(lds0 + RG_LDS_O);
    f32x16 zero16;
#pragma unroll
    for (int i = 0; i < 16; ++i) zero16[i] = 0.f;
    for (int ch = blockIdx.x; ch < NCHUNK; ch += gridDim.x) {
        const int t0 = ch * CHUNK;
        __syncthreads();
        if (PASS == 0) for (int ci = tid; ci < (CHUNK + 3) * 64; ci += NTHR) {
            const int row = ci >> 6, c16 = ci & 63, tt = t0 - 3 + row;
            u32x4 v = {0u, 0u, 0u, 0u};
            if (tt >= 0) v = *(const u32x4*)(xrg + (size_t)tt * DRG + 8 * c16);
            __attribute__((address_space(3))) u32x2* d = (__attribute__((address_space(3))) u32x2*)(xt + row * RG_XP + 16 * c16);
            d[0] = (u32x2){v.x, v.y}; d[1] = (u32x2){v.z, v.w};
        }
        if (PASS == 1) {
            const int c = 64 * n + lane;
            float h = 0.f;
            int k = 0;
            for (; k + 32 <= ch; k += 32) {
                float pv[32], hv[32];
#pragma unroll
                for (int j = 0; j < 32; ++j) { pv[j] = rgP[(k + j) * DRG + c]; hv[j] = rgH[(k + j) * DRG + c]; }
#pragma unroll
                for (int j = 0; j < 32; ++j) h = pv[j] * h + hv[j];
            }
            for (; k + 8 <= ch; k += 8) {
                float pv[8], hv[8];
#pragma unroll
                for (int j = 0; j < 8; ++j) { pv[j] = rgP[(k + j) * DRG + c]; hv[j] = rgH[(k + j) * DRG + c]; }
#pragma unroll
                for (int j = 0; j < 8; ++j) h = pv[j] * h + hv[j];
            }
            for (; k < ch; ++k) h = rgP[k * DRG + c] * h + rgH[k * DRG + c];
            lds[RG_LDS_HIN / 4 + (n * 2 + ((lane >> 2) & 1)) * 32 + 16 * (lane >> 5) + 4 * ((lane >> 3) & 3) + (lane & 3)] = h;
        } else {
            if (r == 0) {
#pragma unroll
                for (int q = 0; q < 32; ++q) { hin_l[q] = 0.f; pc_l[q] = 1.f; }
            }
        }
        __syncthreads();
#pragma unroll 1
        for (int tl = 0; tl < 2; ++tl) {
            const int tok = t0 + 32 * tl + r;
            unsigned cst_a = cst_base; asm volatile("" : "+v"(cst_a));
            const lds_f* cst = (const lds_f*)(size_t)cst_a;
            float xcv[32]; bf16x8 bx[4];
            if (PASS == 0) {
#pragma unroll
            for (int q = 0; q < 32; ++q) xcv[q] = cst[4 * 32 + q];
#pragma unroll
            for (int k = 0; k < 4; ++k) {
                const lds_b* xr = xt + (32 * tl + r + k) * RG_XP + (64 * n + 4 * hh) * 2;
#pragma unroll
                for (int m = 0; m < 8; ++m) {
                    const u32x2 xw = *(const __attribute__((address_space(3))) u32x2*)(xr + 16 * m);
                    xcv[4 * m + 0] += cst[k * 32 + 4 * m + 0] * bf2f(xw.x & 0xffffu); xcv[4 * m + 1] += cst[k * 32 + 4 * m + 1] * bf2f(xw.x >> 16);
                    xcv[4 * m + 2] += cst[k * 32 + 4 * m + 2] * bf2f(xw.y & 0xffffu); xcv[4 * m + 3] += cst[k * 32 + 4 * m + 3] * bf2f(xw.y >> 16);
                }
                __builtin_amdgcn_sched_barrier(0);
            }
#pragma unroll
            for (int s = 0; s < 4; ++s) {
                u32x4 pk; pk.x = cvtpk(xcv[8 * s], xcv[8 * s + 1]); pk.y = cvtpk(xcv[8 * s + 2], xcv[8 * s + 3]); pk.z = cvtpk(xcv[8 * s + 4], xcv[8 * s + 5]); pk.w = cvtpk(xcv[8 * s + 6], xcv[8 * s + 7]);
                bx[s] = __builtin_bit_cast(bf16x8, pk);
            }
            }
            float ss = 0.f;
            const bf16_t* wb = wfrag + ((size_t)n * 16 * 64 + lane) * 8; asm volatile("" : "+v"(wb));
#pragma unroll
            for (int jt = 0; jt < 2; ++jt) {
                float av[16], bv[16];
                const size_t sco = ((((size_t)(2 * ch + tl) * 8 + n) * 2 + jt) * 64 + lane) * 16;
                if (PASS == 0) {
#pragma unroll
                for (int g = 0; g < 2; ++g) {
                    f32x16 acc = zero16;
#pragma unroll
                    for (int s = 0; s < 4; ++s) {
                        const bf16x8 aw = *(const __attribute__((address_space(1))) bf16x8*)(wb + (((g * 2 + jt) * 4 + s) * 64) * 8);
                        acc = MFMA32(aw, bx[s], acc);
                    }
#pragma unroll
                    for (int i = 0; i < 16; ++i) {
                        const int q = 16 * jt + i;
                        const float pre = acc[i] + cst[(5 + g) * 32 + q];
                        const float sg = 1.0f / (1.0f + __builtin_amdgcn_exp2f(-LOG2E * pre));
                        if (g == 0) av[i] = __builtin_amdgcn_exp2f(-sg * cst[7 * 32 + q]);
                        else bv[i] = __builtin_amdgcn_sqrtf(fmaxf(__builtin_fmaf(-av[i], av[i], 1.0f), 0.f)) * (sg * xcv[q]);
                    }
                    __builtin_amdgcn_sched_barrier(0);
                }
                scan_step<0x111, 0xf>(av, bv); scan_step<0x112, 0xf>(av, bv); scan_step<0x114, 0xf>(av, bv); scan_step<0x118, 0xf>(av, bv);
                scan_step<0x142, 0xa>(av, bv);
                u32x4 sa0, sa1, sb0, sb1;
                sa0.x = cvtpk(av[0], av[1]); sa0.y = cvtpk(av[2], av[3]); sa0.z = cvtpk(av[4], av[5]); sa0.w = cvtpk(av[6], av[7]); sa1.x = cvtpk(av[8], av[9]); sa1.y = cvtpk(av[10], av[11]); sa1.z = cvtpk(av[12], av[13]); sa1.w = cvtpk(av[14], av[15]);
                sb0.x = cvtpk(bv[0], bv[1]); sb0.y = cvtpk(bv[2], bv[3]); sb0.z = cvtpk(bv[4], bv[5]); sb0.w = cvtpk(bv[6], bv[7]); sb1.x = cvtpk(bv[8], bv[9]); sb1.y = cvtpk(bv[10], bv[11]); sb1.z = cvtpk(bv[12], bv[13]); sb1.w = cvtpk(bv[14], bv[15]);
                *(u32x4*)(scA + sco) = sa0; *(u32x4*)(scA + sco + 8) = sa1; *(u32x4*)(scB + sco) = sb0; *(u32x4*)(scB + sco + 8) = sb1;
                } else {
                    const u32x4 sa0 = *(const u32x4*)(scA + sco), sa1 = *(const u32x4*)(scA + sco + 8), sb0 = *(const u32x4*)(scB + sco), sb1 = *(const u32x4*)(scB + sco + 8);
                    const unsigned wa[8] = {sa0.x, sa0.y, sa0.z, sa0.w, sa1.x, sa1.y, sa1.z, sa1.w}, wbb[8] = {sb0.x, sb0.y, sb0.z, sb0.w, sb1.x, sb1.y, sb1.z, sb1.w};
#pragma unroll
                    for (int k = 0; k < 8; ++k) { av[2 * k] = bf2f(wa[k] & 0xffffu); av[2 * k + 1] = bf2f(wa[k] >> 16); bv[2 * k] = bf2f(wbb[k] & 0xffffu); bv[2 * k + 1] = bf2f(wbb[k] >> 16); }
                }
                __builtin_amdgcn_sched_barrier(0);
#pragma unroll
                for (int i = 0; i < 16; ++i) {
                    const int q = 16 * jt + i;
                    const float h = __builtin_fmaf(av[i], hin_l[q], bv[i]);
                    if (r == 31) { hin_l[q] = h; if (PASS == 0) pc_l[q] *= av[i]; }
                    bv[i] = h;
                }
                if (PASS == 1) {
#pragma unroll
                    for (int g4 = 0; g4 < 4; ++g4) {
                        const int m = 4 * jt + g4;
                        const uint2 gw = *(const uint2*)(gg + ((((size_t)(tok >> 5) * 8 + n) * 8 + m) * 64 + lane) * 4);
                        const float o0 = bv[4 * g4] * bf2f(gw.x & 0xffffu), o1 = bv[4 * g4 + 1] * bf2f(gw.x >> 16), o2 = bv[4 * g4 + 2] * bf2f(gw.y & 0xffffu), o3 = bv[4 * g4 + 3] * bf2f(gw.y >> 16);
                        ss += (o0 * o0 + o1 * o1) + (o2 * o2 + o3 * o3);
                        *(__attribute__((address_space(3))) u32x2*)(ot + (32 * tl + r) * RG_XP + (64 * n + 8 * m + 4 * hh) * 2) = (u32x2){cvtpk(o0, o1), cvtpk(o2, o3)};
                    }
                }
                __builtin_amdgcn_sched_barrier(0);
            }
            if (PASS == 1) { ss += __shfl_xor(ss, 32); if (hh == 0) lds[RG_LDS_SSQ / 4 + (tl * 8 + n) * 32 + r] = ss; }
        }
        if (PASS == 0) {
            if (r == 0) {
#pragma unroll
                for (int m = 0; m < 8; ++m) {
                    const int c = 64 * n + 8 * m + 4 * hh;
                    *(f32x4*)(rgP + (size_t)ch * DRG + c) = (f32x4){pc_l[4 * m], pc_l[4 * m + 1], pc_l[4 * m + 2], pc_l[4 * m + 3]};
                    *(f32x4*)(rgH + (size_t)ch * DRG + c) = (f32x4){hin_l[4 * m], hin_l[4 * m + 1], hin_l[4 * m + 2], hin_l[4 * m + 3]};
                }
            }
        } else {
            __syncthreads();
            for (int j = 0; j < 8; ++j) {
                const int tr = 8 * n + j, tok = t0 + tr;
                float tot = 0.f;
#pragma unroll
                for (int w = 0; w < 8; ++w) tot += lds[RG_LDS_SSQ / 4 + ((tr >> 5) * 8 + w) * 32 + (tr & 31)];
                const float rn = rsqrtf(tot * (1.0f / DRG) + EPS);
                const __attribute__((address_space(3))) u32x2* op = (const __attribute__((address_space(3))) u32x2*)(ot + tr * RG_XP + 16 * lane);
                const u32x2 w0 = op[0], w1 = op[1];
                u32x4 o2; o2.x = cvtpk(bf2f(w0.x & 0xffffu) * rn, bf2f(w0.x >> 16) * rn); o2.y = cvtpk(bf2f(w0.y & 0xffffu) * rn, bf2f(w0.y >> 16) * rn);
                o2.z = cvtpk(bf2f(w1.x & 0xffffu) * rn, bf2f(w1.x >> 16) * rn); o2.w = cvtpk(bf2f(w1.y & 0xffffu) * rn, bf2f(w1.y >> 16) * rn);
                *((u32x4*)(mix + (size_t)tok * D + DSB) + lane) = o2;
                const u32x4 a = *((const u32x4*)(osb + (size_t)tok * DSB) + lane);
                float f[8] = {bf2f(a.x & 0xffffu), bf2f(a.x >> 16), bf2f(a.y & 0xffffu), bf2f(a.y >> 16), bf2f(a.z & 0xffffu), bf2f(a.z >> 16), bf2f(a.w & 0xffffu), bf2f(a.w >> 16)};
                float sa = 0.f;
#pragma unroll
                for (int k = 0; k < 8; ++k) sa += f[k] * f[k];
                sa = wave_sum(sa);
                const float ra = rsqrtf(sa * (1.0f / DSB) + EPS);
                u32x4 o; o.x = cvtpk(f[0] * ra, f[1] * ra); o.y = cvtpk(f[2] * ra, f[3] * ra); o.z = cvtpk(f[4] * ra, f[5] * ra); o.w = cvtpk(f[6] * ra, f[7] * ra);
                *((u32x4*)(mix + (size_t)tok * D) + lane) = o;
            }
        }
    }
}

__device__ __forceinline__ int f2key(float f) { const int b = __builtin_bit_cast(int, f); return b ^ ((b >> 31) & 0x7fffffff); }
__device__ __forceinline__ float key2f(int k) { return __builtin_bit_cast(float, k ^ ((k >> 31) & 0x7fffffff)); }
#define TOPK_CE(a, b) do { const int hi_ = max(a, b), lo_ = min(a, b); a = hi_; b = lo_; } while (0)
__device__ __forceinline__ void sort16_desc(int (&v)[16]) { TOPK_CE(v[0], v[1]); TOPK_CE(v[2], v[3]); TOPK_CE(v[0], v[2]); TOPK_CE(v[1], v[3]); TOPK_CE(v[1], v[2]); TOPK_CE(v[4], v[5]); TOPK_CE(v[6], v[7]); TOPK_CE(v[4], v[6]); TOPK_CE(v[5], v[7]); TOPK_CE(v[5], v[6]); TOPK_CE(v[0], v[4]); TOPK_CE(v[2], v[6]); TOPK_CE(v[2], v[4]); TOPK_CE(v[1], v[5]); TOPK_CE(v[3], v[7]); TOPK_CE(v[3], v[5]); TOPK_CE(v[1], v[2]); TOPK_CE(v[3], v[4]); TOPK_CE(v[5], v[6]); TOPK_CE(v[8], v[9]); TOPK_CE(v[10], v[11]); TOPK_CE(v[8], v[10]); TOPK_CE(v[9], v[11]); TOPK_CE(v[9], v[10]); TOPK_CE(v[12], v[13]); TOPK_CE(v[14], v[15]); TOPK_CE(v[12], v[14]); TOPK_CE(v[13], v[15]); TOPK_CE(v[13], v[14]); TOPK_CE(v[8], v[12]); TOPK_CE(v[10], v[14]); TOPK_CE(v[10], v[12]); TOPK_CE(v[9], v[13]); TOPK_CE(v[11], v[15]); TOPK_CE(v[11], v[13]); TOPK_CE(v[9], v[10]); TOPK_CE(v[11], v[12]); TOPK_CE(v[13], v[14]); TOPK_CE(v[0], v[8]); TOPK_CE(v[4], v[12]); TOPK_CE(v[4], v[8]); TOPK_CE(v[2], v[10]); TOPK_CE(v[6], v[14]); TOPK_CE(v[6], v[10]); TOPK_CE(v[2], v[4]); TOPK_CE(v[6], v[8]); TOPK_CE(v[10], v[12]); TOPK_CE(v[1], v[9]); TOPK_CE(v[5], v[13]); TOPK_CE(v[5], v[9]); TOPK_CE(v[3], v[11]); TOPK_CE(v[7], v[15]); TOPK_CE(v[7], v[11]); TOPK_CE(v[3], v[5]); TOPK_CE(v[7], v[9]); TOPK_CE(v[11], v[13]); TOPK_CE(v[1], v[2]); TOPK_CE(v[3], v[4]); TOPK_CE(v[5], v[6]); TOPK_CE(v[7], v[8]); TOPK_CE(v[9], v[10]); TOPK_CE(v[11], v[12]); TOPK_CE(v[13], v[14]); }
__device__ __forceinline__ void merge16_desc(int (&a)[16], const int (&b)[16]) {
#pragma unroll
    for (int i = 0; i < 16; ++i) a[i] = max(a[i], b[15 - i]);
#pragma unroll
    for (int d = 8; d >= 1; d >>= 1)
#pragma unroll
        for (int i = 0; i < 16; ++i) if ((i & d) == 0) TOPK_CE(a[i], a[i + d]);
}
__device__ __forceinline__ void ph_topk(const Params& p, int* lds) {
    unsigned char* ws = p.ws;
    const bf16_t* qp = (const bf16_t*)(ws + WS_B); const bf16_t* subk = (const bf16_t*)(ws + WS_SUBK);
    int* seli = (int*)(ws + WS_SELI); float* selg = (float*)(ws + WS_SELG);
    const float* ssq = (const float*)(ws + WS_SSQ); float* rstd2 = (float*)(ws + WS_RSTD2);
    const int tid = phase_tid(), lane = tid & 63, r = lane & 31, hh = lane >> 5, hx = 4 * hh;
    const int gwave = (blockIdx.x * blockDim.x + tid) >> 6, nwave = (gridDim.x * blockDim.x) >> 6;
    constexpr int SK_OFF = 65536, SK_PITCH = 272;
    typedef __attribute__((address_space(3))) unsigned char lds_b;
    lds_b* skl = (lds_b*)lds + SK_OFF;
    const int w = tid >> 6;
    pg8::StaticOrder so; so.init(S, NQ, (int)gridDim.x, (int)blockIdx.x);
    pg8::Unit gu;
    for (int ui = 0; so.next(ui, gu); ++ui) {
        const int h = gu.pn, t0 = gu.pm * 256 + 32 * w, t = t0 + r;
        u32x4 skv[8]; bf16x8 bq[2][8];
#pragma unroll
        for (int j = 0; j < 8; ++j) {
            const int ci = tid + NTHR * j, row = ci >> 4, c16 = ci & 15;
            skv[j] = *(const u32x4*)(subk + ((size_t)h * 256 + row) * PHALF + 8 * c16);
        }
#pragma unroll
        for (int pp = 0; pp < 2; ++pp)
#pragma unroll
            for (int s = 0; s < 8; ++s) bq[pp][s] = *(const bf16x8*)(qp + ((((size_t)((t0 >> 5) * 8 + h) * 2 + pp) * 8 + s) * 64 + lane) * 8);
        __builtin_amdgcn_sched_barrier(0);
        __syncthreads();
#pragma unroll
        for (int j = 0; j < 8; ++j) {
            const int ci = tid + NTHR * j, row = ci >> 4, c16 = ci & 15;
            *(__attribute__((address_space(3))) u32x4*)(skl + row * SK_PITCH + 16 * c16) = skv[j];
        }
        __syncthreads();
        int tk[2][16];
#pragma unroll
        for (int pp = 0; pp < 2; ++pp) {
            f32x16 acc[4];
#pragma unroll
            for (int T = 0; T < 4; ++T)
#pragma unroll
                for (int i = 0; i < 16; ++i) acc[T][i] = 0.f;
            const lds_b* krow = skl + (pp * PNK + r) * SK_PITCH + 16 * hh;
#pragma unroll
            for (int s = 0; s < 8; ++s) {
                const bf16x8 b = bq[pp][s];
#pragma unroll
                for (int T = 0; T < 4; ++T) {
                    const bf16x8 a = *(const __attribute__((address_space(3))) bf16x8*)(krow + (32 * T) * SK_PITCH + 32 * s);
                    acc[T] = __builtin_amdgcn_mfma_f32_32x32x16_bf16(a, b, acc[T], 0, 0, 0);
                }
            }
            int kq[4][16];
#pragma unroll
            for (int T = 0; T < 4; ++T) {
#pragma unroll
                for (int i = 0; i < 16; ++i) {
                    const int nb = 32 * T + (i & 3) + 8 * (i >> 2);
                    kq[T][i] = ((f2key(acc[T][i]) & ~127) | (127 - nb)) ^ hx;
                }
                sort16_desc(kq[T]);
            }
            merge16_desc(kq[0], kq[1]); merge16_desc(kq[2], kq[3]); merge16_desc(kq[0], kq[2]);
            int m[16], po[16];
#pragma unroll
            for (int i = 0; i < 16; ++i) { m[i] = kq[0][i]; po[i] = __shfl_xor(kq[0][i], 32); }
            merge16_desc(m, po);
#pragma unroll
            for (int i = 0; i < 16; ++i) tk[pp][i] = m[i];
        }
#pragma unroll
        for (int i = 0; i < 16; ++i) { lds[i * NTHR + tid] = tk[0][i]; lds[(16 + i) * NTHR + tid] = tk[1][i]; }
        float v0[16], v1[16];
#pragma unroll
        for (int i = 0; i < 16; ++i) { v0[i] = key2f(tk[0][i]); v1[i] = key2f(tk[1][i]); }
#define CKEY(a, b) ((f2key(v0[a] + v1[b]) & ~255) | (255 - ((a) * 16 + (b))))
        const int NEGK = (int)0x80000000;
        int bk[16], l1[16], ga[16], gb[16];
#pragma unroll
        for (int b = 0; b < 16; ++b) bk[b] = CKEY(0, b);
#pragma unroll
        for (int b = 0; b < 16; ++b) l1[b] = b < 8 ? CKEY(1, b) : NEGK;
        ga[0] = CKEY(2, 0); ga[1] = CKEY(2, 1); ga[2] = CKEY(2, 2); ga[3] = CKEY(2, 3); ga[4] = CKEY(2, 4);
        ga[5] = CKEY(3, 0); ga[6] = CKEY(3, 1); ga[7] = CKEY(3, 2); ga[8] = CKEY(3, 3);
        ga[9] = CKEY(4, 0); ga[10] = CKEY(4, 1); ga[11] = CKEY(4, 2); ga[12] = CKEY(5, 0); ga[13] = CKEY(5, 1); ga[14] = NEGK; ga[15] = NEGK;
        gb[0] = CKEY(6, 0); gb[1] = CKEY(6, 1); gb[2] = CKEY(7, 0); gb[3] = CKEY(7, 1);
#pragma unroll
        for (int a = 8; a < 16; ++a) gb[a - 4] = CKEY(a, 0);
        gb[12] = NEGK; gb[13] = NEGK; gb[14] = NEGK; gb[15] = NEGK;
#undef CKEY
        sort16_desc(ga); sort16_desc(gb);
        merge16_desc(bk, l1); merge16_desc(ga, gb); merge16_desc(bk, ga);
        float ssum = 0.f;
#pragma unroll
        for (int i = 0; i < 4; ++i) { const f32x4 q4 = *(const f32x4*)(ssq + (size_t)t * 16 + 4 * i); ssum += (q4.x + q4.y) + (q4.z + q4.w); }
        const float rs = rsqrtf(ssum * (1.0f / D) + EPS);
        float e[16], sum = 0.f; const float mx = key2f(bk[0]);
#pragma unroll
        for (int i = 0; i < 16; ++i) { e[i] = __expf((key2f(bk[i]) - mx) * rs); sum += e[i]; }
        const float inv = 1.0f / sum;
        int eidx[16];
#pragma unroll
        for (int i = 0; i < 16; ++i) {
            const int code = 255 - (bk[i] & 255), a = code >> 4, b = code & 15;
            const int i1 = 127 - (lds[a * NTHR + tid] & 127), i2 = 127 - (lds[(16 + b) * NTHR + tid] & 127);
            eidx[i] = i1 * PNK + i2; e[i] *= inv;
        }
        if (hh == 0) {
            int4* o = (int4*)(seli + (size_t)t * 128 + h * 16);
#pragma unroll
            for (int i = 0; i < 4; ++i) o[i] = make_int4(eidx[4 * i], eidx[4 * i + 1], eidx[4 * i + 2], eidx[4 * i + 3]);
            if (h == 0) rstd2[t] = rs;
        } else {
            f32x4* o = (f32x4*)(selg + (size_t)t * 128 + h * 16);
#pragma unroll
            for (int i = 0; i < 4; ++i) o[i] = (f32x4){e[4 * i], e[4 * i + 1], e[4 * i + 2], e[4 * i + 3]};
        }
    }
}

typedef __bf16 bf16x2_t __attribute__((ext_vector_type(2)));
typedef float f32x2 __attribute__((ext_vector_type(2)));
template <int NV, int XS0, int XS1, int XS2>
__device__ __forceinline__ void reduce_over8(float (&v)[NV], int sel) {
    { const bool up = sel & 1;
#pragma unroll
      for (int i = 0; i < NV / 2; ++i) { const float a = v[2 * i], b = v[2 * i + 1]; v[i] = (up ? b : a) + __shfl_xor(up ? a : b, XS0); } }
    { const bool up = (sel >> 1) & 1;
#pragma unroll
      for (int i = 0; i < NV / 4; ++i) { const float a = v[2 * i], b = v[2 * i + 1]; v[i] = (up ? b : a) + __shfl_xor(up ? a : b, XS1); } }
    { const bool up = (sel >> 2) & 1;
#pragma unroll
      for (int i = 0; i < NV / 8; ++i) { const float a = v[2 * i], b = v[2 * i + 1]; v[i] = (up ? b : a) + __shfl_xor(up ? a : b, XS2); } }
}
__device__ __forceinline__ void peer_load_idx(const unsigned char* ws, int t, int rsl, int (&ei)[16]) {
    const unsigned off = (unsigned)WS_SELI + ((unsigned)t * 128u + 16u * (unsigned)rsl) * 4u;
#pragma unroll
    for (int j = 0; j < 4; ++j) { const int4 v = *(const int4*)(ws + (off + 16u * j)); ei[4 * j] = v.x; ei[4 * j + 1] = v.y; ei[4 * j + 2] = v.z; ei[4 * j + 3] = v.w; }
}
template <int PASS>
__device__ __forceinline__ void peer_load_rows(const unsigned char* ws, int t, int sl, int rsl, int c, const int (&ei)[16], u32x4 (&row)[16], u32x4 (&aux)[4]) {
    const unsigned tab = (unsigned)(PASS == 0 ? WS_UB : WS_VB) + (unsigned)sl * (unsigned)(NEXP * 128) + 16u * (unsigned)c;
#pragma unroll
    for (int i = 0; i < 16; ++i) row[i] = *(const u32x4*)(ws + (tab + (unsigned)ei[i] * 128u));
    const unsigned xo = (unsigned)WS_X1Q + (unsigned)t * (unsigned)D + 256u * sl + 32u * c;
    aux[0] = *(const u32x4*)(ws + xo); aux[1] = *(const u32x4*)(ws + (xo + 16u));
    aux[2].x = *(const unsigned*)(ws + ((unsigned)WS_XSC + ((unsigned)t * 32u + 8u * sl + c) * 4u));
}
constexpr int PEER_IMG_PITCH = 136, PEER_IMG_BYTES = 128 * PEER_IMG_PITCH;
template <int PASS  >
__device__ __forceinline__ void peer_compute(const Params& p, unsigned char* lds, int lane_w, int t, int sl, int rsl, int c, const u32x4 (&row)[16], const u32x4 (&aux)[4]) {
    unsigned char* ws = p.ws;
    if (PASS == 0) {
        const u32x4 x0 = aux[0], x1_ = aux[1]; const unsigned xl[4] = {x0.x, x0.y, x0.z, x0.w}, xh[4] = {x1_.x, x1_.y, x1_.z, x1_.w};
        const unsigned xsu = aux[2].x; const float xs = u2f(xsu);
        float pd[16];
#pragma unroll
        for (int i = 0; i < 16; ++i) {
            const u32x4 rw = row[i]; const unsigned w4[4] = {rw.x, rw.y, rw.z, rw.w};
            int al = 0, ah = 0;
#pragma unroll
            for (int j = 0; j < 4; ++j) { al = __builtin_amdgcn_sdot8((int)w4[j], (int)xl[j], al, false); ah = __builtin_amdgcn_sdot8((int)w4[j], (int)xh[j], ah, false); }
            pd[i] = (float)(16 * ah + al) * xs;
        }
        reduce_over8<16, 1, 2, 4>(pd, c);
        const unsigned po = (unsigned)WS_PD + (((unsigned)sl * S + (unsigned)t) * 128u + 16u * rsl + c) * 4u;
        *(float*)(ws + po) = pd[0]; *(float*)(ws + (po + 32u)) = pd[1];
    }
}
template <int PASS>
__device__ __forceinline__ void peer_stream(const Params& p, unsigned char* lds, int lane_w, int sl, int t0, int dt, int n) {
    const unsigned char* ws = p.ws;
    const int lane = lane_w & 63, rsl = lane >> 3, c = lane & 7;
    int eiA[16], eiB[16]; u32x4 rowA[16], rowB[16], auxA[4], auxB[4];
    if (n <= 0) return;
    peer_load_idx(ws, t0, rsl, eiA);
    peer_load_rows<PASS>(ws, t0, sl, rsl, c, eiA, rowA, auxA);
    if (n > 1) peer_load_idx(ws, t0 + dt, rsl, eiB);
    for (int i = 0; i < n; i += 2) {
        const int t = t0 + i * dt;
        if (i + 1 < n) peer_load_rows<PASS>(ws, t + dt, sl, rsl, c, eiB, rowB, auxB);
        if (i + 2 < n) peer_load_idx(ws, t + 2 * dt, rsl, eiA);
        peer_compute<PASS>(p, lds, lane_w, t, sl, rsl, c, rowA, auxA);
        if (i + 1 < n) {
            if (i + 2 < n) peer_load_rows<PASS>(ws, t + 2 * dt, sl, rsl, c, eiA, rowA, auxA);
            if (i + 3 < n) peer_load_idx(ws, t + 3 * dt, rsl, eiB);
            peer_compute<PASS>(p, lds, lane_w, t + dt, sl, rsl, c, rowB, auxB);
        }
    }
}
__device__ __forceinline__ void peerv_load_idx(const unsigned char* ws, int t, int hf, int rsl, int (&ei)[8]) {
    const unsigned off = (unsigned)WS_SELI + ((unsigned)t * 128u + 16u * (unsigned)rsl + 8u * (unsigned)hf) * 4u;
    const int4 v0 = *(const int4*)(ws + off), v1 = *(const int4*)(ws + (off + 16u));
    ei[0] = v0.x; ei[1] = v0.y; ei[2] = v0.z; ei[3] = v0.w; ei[4] = v1.x; ei[5] = v1.y; ei[6] = v1.z; ei[7] = v1.w;
}
__device__ __forceinline__ void peerv_load_rows(const unsigned char* ws, int sl, int c, const int (&ei)[8], u32x4 (&row)[8]) {
    const unsigned tab = (unsigned)WS_VB + (unsigned)sl * (unsigned)(NEXP * 128) + 16u * (unsigned)c;
#pragma unroll
    for (int i = 0; i < 8; ++i) row[i] = *(const u32x4*)(ws + (tab + (unsigned)ei[i] * 128u));
}
struct PeerVAux { u32x4 cp; unsigned cs; unsigned xo[4]; };
__device__ __forceinline__ void peerv_load_aux(const unsigned char* ws, int t, int sl, int lane, PeerVAux& a) {
    a.cp = *(const u32x4*)(ws + ((unsigned)WS_CBUF + (unsigned)t * 128u + 16u * (unsigned)(lane & 7)));
    a.cs = *(const unsigned*)(ws + ((unsigned)WS_CSC + (unsigned)t * 4u));
    const unsigned xo = (unsigned)WS_A + ((unsigned)t * (unsigned)D + 256u * sl + (unsigned)lane) * 2u;
    a.xo[0] = *(const bf16_t*)(ws + xo); a.xo[1] = *(const bf16_t*)(ws + (xo + 128u)); a.xo[2] = *(const bf16_t*)(ws + (xo + 256u)); a.xo[3] = *(const bf16_t*)(ws + (xo + 384u));
}
template <int HF>
__device__ __forceinline__ void peerv_half(lds_b* img, int lane, const u32x4 (&row)[8], const PeerVAux& a, int (&acc)[4]) {
    const int rsl = lane >> 3, c = lane & 7;
#pragma unroll
    for (int i = 0; i < 8; ++i) {
        const u32x4 rw = row[i];
        __attribute__((address_space(3))) u32x2* d = (__attribute__((address_space(3))) u32x2*)(img + (16 * rsl + i) * PEER_IMG_PITCH + 16 * c);
        d[0] = (u32x2){rw.x, rw.y}; d[1] = (u32x2){rw.z, rw.w};
    }
    const unsigned cpl = HF == 0 ? a.cp.x : a.cp.y, cph = HF == 0 ? a.cp.z : a.cp.w;
    asm volatile("s_waitcnt lgkmcnt(0)" ::: "memory");
    const unsigned ra = (unsigned)(size_t)img + (unsigned)((lane & 15) * PEER_IMG_PITCH + 8 * (lane >> 4));
#define PEER_TR4(R0, R1, R2, R3, RS) asm volatile("ds_read_b64_tr_b4 %0, %4 offset:%5\n\tds_read_b64_tr_b4 %1, %4 offset:%6\n\tds_read_b64_tr_b4 %2, %4 offset:%7\n\tds_read_b64_tr_b4 %3, %4 offset:%8" \
            : "=&v"(R0), "=&v"(R1), "=&v"(R2), "=&v"(R3) : "v"(ra), "i"((RS) * 16 * PEER_IMG_PITCH), "i"((RS) * 16 * PEER_IMG_PITCH + 32), "i"((RS) * 16 * PEER_IMG_PITCH + 64), "i"((RS) * 16 * PEER_IMG_PITCH + 96) : "memory")
#define PEER_USE4(R0, R1, R2, R3, RS, WAITSTR) do { \
            asm volatile(WAITSTR : "+v"(R0), "+v"(R1), "+v"(R2), "+v"(R3) :: "memory"); \
            const int cl_ = __builtin_amdgcn_readlane((int)cpl, RS), ch_ = __builtin_amdgcn_readlane((int)cph, RS); \
            const unsigned lo4_[4] = {R0.x, R1.x, R2.x, R3.x}; \
            _Pragma("unroll") for (int tcg = 0; tcg < 4; ++tcg) acc[tcg] += 16 * __builtin_amdgcn_sdot8((int)lo4_[tcg], ch_, 0, false) + __builtin_amdgcn_sdot8((int)lo4_[tcg], cl_, 0, false); } while (0)
    {
        u32x2 a0, a1, a2, a3, b0, b1, b2, b3;
        PEER_TR4(a0, a1, a2, a3, 0);
        PEER_TR4(b0, b1, b2, b3, 1); PEER_USE4(a0, a1, a2, a3, 0, "s_waitcnt lgkmcnt(4)");
        PEER_TR4(a0, a1, a2, a3, 2); PEER_USE4(b0, b1, b2, b3, 1, "s_waitcnt lgkmcnt(4)");
        PEER_TR4(b0, b1, b2, b3, 3); PEER_USE4(a0, a1, a2, a3, 2, "s_waitcnt lgkmcnt(4)");
        PEER_TR4(a0, a1, a2, a3, 4); PEER_USE4(b0, b1, b2, b3, 3, "s_waitcnt lgkmcnt(4)");
        PEER_TR4(b0, b1, b2, b3, 5); PEER_USE4(a0, a1, a2, a3, 4, "s_waitcnt lgkmcnt(4)");
        PEER_TR4(a0, a1, a2, a3, 6); PEER_USE4(b0, b1, b2, b3, 5, "s_waitcnt lgkmcnt(4)");
        PEER_TR4(b0, b1, b2, b3, 7); PEER_USE4(a0, a1, a2, a3, 6, "s_waitcnt lgkmcnt(4)");
        PEER_USE4(b0, b1, b2, b3, 7, "s_waitcnt lgkmcnt(0)");
    }
#undef PEER_TR4
#undef PEER_USE4
}
__device__ __forceinline__ void peerv_stream(const Params& p, unsigned char* lds, int tid_, int sl, int t0, int dt, int n) {
    const unsigned char* ws = p.ws;
    const int lane = tid_ & 63, rsl = lane >> 3, c = lane & 7;
    lds_b* img = (lds_b*)lds + (tid_ >> 6) * PEER_IMG_BYTES;
    for (int e = lane; e < 64 * (PEER_IMG_PITCH / 8); e += 64) {
        const int zr = e / (PEER_IMG_PITCH / 8), zc = e % (PEER_IMG_PITCH / 8);
        *(__attribute__((address_space(3))) u32x2*)(img + (16 * (zr >> 3) + 8 + (zr & 7)) * PEER_IMG_PITCH + 8 * zc) = (u32x2){0u, 0u};
    }
    if (n <= 0) return;
    int ei0[8], ei1[8]; u32x4 rowA[8], rowB[8]; PeerVAux ax, axn;
    peerv_load_idx(ws, t0, 0, rsl, ei0);
    peerv_load_rows(ws, sl, c, ei0, rowA); peerv_load_aux(ws, t0, sl, lane, ax);
    peerv_load_idx(ws, t0, 1, rsl, ei1);
    for (int i = 0; i < n; ++i) {
        const int t = t0 + i * dt; const bool more = i + 1 < n;
        int acc[4] = {0, 0, 0, 0};
        peerv_load_rows(ws, sl, c, ei1, rowB);
        if (more) peerv_load_idx(ws, t + dt, 0, rsl, ei0);
        peerv_half<0>(img, lane, rowA, ax, acc);
        if (more) { peerv_load_rows(ws, sl, c, ei0, rowA); peerv_load_aux(ws, t + dt, sl, lane, axn); peerv_load_idx(ws, t + dt, 1, rsl, ei1); }
        peerv_half<1>(img, lane, rowB, ax, acc);
        const float cs = u2f(ax.cs);
#pragma unroll
        for (int tcg = 0; tcg < 4; ++tcg) {
            const unsigned oo = ((unsigned)t * (unsigned)D + 256u * sl + 64u * tcg + (unsigned)lane) * 4u;
            *(float*)((unsigned char*)p.out + oo) = bf2f(ax.xo[tcg]) + (float)acc[tcg] * cs;
        }
        if (more) ax = axn;
    }
}
template <int PASS>
__device__ __forceinline__ void ph_peer(const Params& p, unsigned char* lds) {
    const int tid_ = phase_tid();
    const int lane = tid_ & 63, w = tid_ >> 6, b = blockIdx.x, G = gridDim.x;
    if ((G & 7) == 0) {
        const int g = b & 7, nsw = (G >> 3) * 2 * (NTHR / 64), t0 = ((g >> 2) * (G >> 3) + (b >> 3)) * (NTHR / 64) + w;
        if (PASS == 0) peer_stream<0>(p, lds, tid_, g & 3, t0, nsw, t0 < S ? (S - 1 - t0) / nsw + 1 : 0);
        else peerv_stream(p, lds, tid_, g & 3, t0, nsw, t0 < S ? (S - 1 - t0) / nsw + 1 : 0);
    } else {
        const int nw = G * (NTHR / 64), it0 = b * (NTHR / 64) + w;
        for (int it = it0; it < S * 4; it += nw) { if (PASS == 0) peer_stream<0>(p, lds, tid_, it & 3, it >> 2, 0, 1); else peerv_stream(p, lds, tid_, it & 3, it >> 2, 0, 1); }
    }
}
__device__ __forceinline__ void ph_peer_combine(const Params& p) {
    unsigned char* ws = p.ws;
    const int* seli = (const int*)(ws + WS_SELI); const float* selg = (const float*)(ws + WS_SELG); const float* rstd2 = (const float*)(ws + WS_RSTD2);
    const float2* uvsc = (const float2*)(ws + WS_USC);
    const float* pd = (const float*)(ws + WS_PD);
    unsigned* cpl = (unsigned*)(ws + WS_CBUF); float* csc = (float*)(ws + WS_CSC);
    const int tid_ = phase_tid(), lane = tid_ & 63, gwave = (blockIdx.x * blockDim.x + tid_) >> 6, nwave = (gridDim.x * blockDim.x) >> 6;
    constexpr int TT = 4;
    for (int tb = gwave; tb < S; tb += TT * nwave) {
        float dsum[TT][2], sg[TT][2], rsd[TT]; int ei[TT][2];
#pragma unroll
        for (int k = 0; k < TT; ++k) {
            const int t = min(tb + k * nwave, S - 1);
#pragma unroll
            for (int hf = 0; hf < 2; ++hf) {
                const int e = t * 128 + 64 * hf + lane;
                ei[k][hf] = seli[e]; sg[k][hf] = selg[e];
                float d = 0.f;
#pragma unroll
                for (int g = 0; g < 4; ++g) d += pd[(size_t)g * S * 128 + e];
                dsum[k][hf] = d;
            }
            rsd[k] = rstd2[t];
        }
        float2 sc2[TT][2];
#pragma unroll
        for (int k = 0; k < TT; ++k)
#pragma unroll
            for (int hf = 0; hf < 2; ++hf) sc2[k][hf] = uvsc[ei[k][hf]];
#pragma unroll
        for (int k = 0; k < TT; ++k) {
            const int t = tb + k * nwave;
            if (t >= S) break;
            float cf[2];
#pragma unroll
            for (int hf = 0; hf < 2; ++hf) cf[hf] = sg[k][hf] * gelu_tanh(dsum[k][hf] * sc2[k][hf].x * rsd[k]) * sc2[k][hf].y;
            float m = fmaxf(fabsf(cf[0]), fabsf(cf[1]));
#pragma unroll
            for (int o = 1; o < 64; o <<= 1) m = fmaxf(m, __shfl_xor(m, o));
            const float inv = m > 0.f ? 119.0f / m : 0.f;
#pragma unroll
            for (int hf = 0; hf < 2; ++hf) {
                const int q = __float2int_rn(cf[hf] * inv);
                unsigned dl = (unsigned)(q & 15) << (4 * (lane & 7)), dh = (unsigned)(((q + 8) >> 4) & 15) << (4 * (lane & 7));
                dl |= __shfl_xor(dl, 1); dh |= __shfl_xor(dh, 1); dl |= __shfl_xor(dl, 2); dh |= __shfl_xor(dh, 2); dl |= __shfl_xor(dl, 4); dh |= __shfl_xor(dh, 4);
                if ((lane & 7) == 0) {
                    const int dk = 8 * hf + (lane >> 3), rs = dk >> 1, half = dk & 1;
                    cpl[(size_t)t * 32 + 4 * rs + half] = dl; cpl[(size_t)t * 32 + 4 * rs + 2 + half] = dh;
                }
            }
            if (lane == 0) csc[t] = m * (1.0f / 119.0f);
        }
    }
}

#define LAS __attribute__((address_space(3)))
#define XB_TMO      128
#define XB_XCNT(j)  (256  + 64 * (j))
#define XB_XSUB(j)  (1280 + 64 * (j))
#define XB_XGEN(j)  (2304 + 64 * (j))
#define XB_TOP      3328
#define XB_TOPGEN   3392
#define XCD_BAR_WORDS 3456
#define XB_SPIN_CAP (1u << 18)
__device__ __forceinline__ unsigned xb_ld(unsigned* p)              { return __hip_atomic_load(p, __ATOMIC_RELAXED, __HIP_MEMORY_SCOPE_AGENT); }
__device__ __forceinline__ unsigned xb_add(unsigned* p, unsigned v) { return __hip_atomic_fetch_add(p, v, __ATOMIC_RELAXED, __HIP_MEMORY_SCOPE_AGENT); }
__device__ __forceinline__ unsigned xb_xcc_id() { return (unsigned)__builtin_amdgcn_s_getreg((3 << 11) | 20) & 0xFu; }
#define XB_SPIN(cond, bar) do { unsigned _sp = 0; while (cond) { __builtin_amdgcn_s_sleep(1); \
    if ((++_sp & 255u) == 0u) { if (xb_ld(&(bar)[XB_TMO])) break; if (_sp > XB_SPIN_CAP) { atomicAdd(&(bar)[XB_TMO], 1u); break; } } } } while (0)
struct XcdBarrier { unsigned* bar; unsigned x; volatile LAS unsigned* st; };
__device__ __forceinline__ XcdBarrier xcd_barrier_post(unsigned* bar, volatile LAS unsigned* st) {
    XcdBarrier b; b.bar = bar; b.x = xb_xcc_id(); b.st = st;
    if (threadIdx.x == 0) (void)xb_add(&bar[XB_XCNT(b.x)], 1u);
    return b;
}
__device__ __forceinline__ void xcd_barrier_complete(unsigned* bar, unsigned x, unsigned& nloc, unsigned& nx) {
    const unsigned G = gridDim.x * gridDim.y * gridDim.z;
    unsigned sum, cnt, mine, sp = 0u;
    for (;;) {
        sum = 0u; cnt = 0u; mine = 0u;
#pragma unroll
        for (unsigned j = 0; j < 16; ++j) { const unsigned c = xb_ld(&bar[XB_XCNT(j)]); sum += c; cnt += (c > 0u) ? 1u : 0u; mine = (j == x) ? c : mine; }
        if (sum == G) break;
        __builtin_amdgcn_s_sleep(1);
        if ((++sp & 255u) == 0u) { if (xb_ld(&bar[XB_TMO])) break; if (sp > XB_SPIN_CAP) { atomicAdd(&bar[XB_TMO], 1u); break; } }
    }
    nloc = mine > 0u ? mine : 1u; nx = cnt > 0u ? cnt : 1u;
}
__device__ __forceinline__ void xcd_barrier(const XcdBarrier& b) {
    asm volatile("s_waitcnt vmcnt(0)" ::: "memory");
    __syncthreads();
    if (threadIdx.x == 0) {
        unsigned* bar = b.bar;
        __builtin_amdgcn_s_waitcnt(0);
        unsigned nloc = b.st[0], nx = b.st[1];
        if (nloc == 0u) { xcd_barrier_complete(bar, b.x, nloc, nx); b.st[0] = nloc; b.st[1] = nx; }
        const unsigned old = xb_add(&bar[XB_XSUB(b.x)], 1u);
        const unsigned gen = old / nloc;
        if (old + 1u == (gen + 1u) * nloc) {
            __builtin_amdgcn_fence(__ATOMIC_RELEASE, "agent");
            asm volatile("s_waitcnt vmcnt(0)" ::: "memory");
            const unsigned og = xb_add(&bar[XB_TOP], 1u);
            const unsigned tg = og / nx;
            if (og + 1u == (tg + 1u) * nx) xb_add(&bar[XB_TOPGEN], 1u);
            else XB_SPIN(xb_ld(&bar[XB_TOPGEN]) == tg, bar);
            __builtin_amdgcn_fence(__ATOMIC_ACQUIRE, "agent");
            xb_add(&bar[XB_XGEN(b.x)], 1u);
            asm volatile("s_waitcnt vmcnt(0)" ::: "memory");
        } else {
            XB_SPIN(xb_ld(&bar[XB_XGEN(b.x)]) == gen, bar);
            __builtin_amdgcn_fence(__ATOMIC_ACQUIRE, "agent");
            asm volatile("s_waitcnt vmcnt(0)" ::: "memory");
        }
    }
    __syncthreads();
}

constexpr int LDS_MISC = 158720;
constexpr int LDS_BYTES = LDS_MISC + 1024;

__global__ void __launch_bounds__(NTHR, 2) hymba_fwd(Params p) {
    extern __shared__ __attribute__((aligned(16))) unsigned char lds[];
    volatile LAS unsigned* misc = (volatile LAS unsigned*)((LAS unsigned char*)lds + LDS_MISC);
    if (threadIdx.x < 4) misc[threadIdx.x] = 0u;
    __syncthreads();
    XcdBarrier bar = xcd_barrier_post((unsigned*)(p.ws + WS_CTL), misc);

    PG8_LAS unsigned char* ring = (PG8_LAS unsigned char*)lds;
    unsigned char* ws = p.ws;
    ph_prep(p, lds);                          xcd_barrier(bar);
    {
        pg8::Gemm g{(const bf16_t*)(ws + WS_A), (const bf16_t*)(ws + WS_WINT), S, NPROJ, D}; pg8::StaticOrder so; so.init(S, NPROJ, (int)gridDim.x, (int)blockIdx.x);
        EpiInProj E{(const float*)(ws + WS_RSTD1), p.in[I_Q_NORM], p.in[I_K_NORM], (bf16_t*)(ws + WS_QH), (bf16_t*)(ws + WS_KH), (bf16_t*)(ws + WS_VH), (bf16_t*)(ws + WS_XRG), (bf16_t*)(ws + WS_GG)};
        pg8::gemm_phase<EpiInProj, pg8::StaticOrder, true, true>(ring, g, so, E);
        const int G = (int)gridDim.x, nunits = (S / 256) * (NPROJ / 256), rem = nunits % G, b = (int)blockIdx.x;
        const int tid_ = phase_tid(), w = tid_ >> 6, lane = tid_ & 63;
        if (rem == 0) ph_tables(p, b * (NTHR / 64) + w, G * (NTHR / 64), lane);
        else if (b >= rem) ph_tables(p, (b - rem) * (NTHR / 64) + w, (G - rem) * (NTHR / 64), lane);
    }
    xcd_barrier(bar);
    ph_attn(p); ph_rg<0>(p, lds);             xcd_barrier(bar);
    ph_rg<1>(p, lds);                         xcd_barrier(bar);
    {
        pg8::Gemm g{(const bf16_t*)(ws + WS_MIX), (const bf16_t*)(ws + WS_WOUTT), S, D, D}; pg8::StaticOrder so; so.init(S, D, (int)gridDim.x, (int)blockIdx.x);
        EpiOutProj E{p.in[I_X], (bf16_t*)(ws + WS_A), (float*)(ws + WS_SSQ), ws + WS_X1Q, (float*)(ws + WS_XSC)};
        pg8::gemm_phase<EpiOutProj, pg8::StaticOrder, true, true>(ring, g, so, E);
    }
    xcd_barrier(bar);
    {
        pg8::Gemm g{(const bf16_t*)(ws + WS_A), (const bf16_t*)(ws + WS_WQT), S, NQ, D}; pg8::StaticOrder so; so.init(S, NQ, (int)gridDim.x, (int)blockIdx.x);
        EpiPeerQ E{(bf16_t*)(ws + WS_B)};
        pg8::gemm_phase<EpiPeerQ, pg8::StaticOrder, true, true>(ring, g, so, E);
    }
    asm volatile("s_waitcnt vmcnt(0)" ::: "memory"); __syncthreads();
    ph_topk(p, (int*)lds);                    xcd_barrier(bar);
    ph_peer<0>(p, lds);                       xcd_barrier(bar);
    ph_peer_combine(p);                       xcd_barrier(bar);
    ph_peer<1>(p, lds);
}

extern "C" void kernel_launch(void* const* d_in, const int* in_sizes, int n_in, void* d_out, int out_size, void* d_ws, size_t ws_size, hipStream_t stream) {
    static int grid = 0;
    if (grid == 0) {
        if (n_in != 20 || out_size != S * D || ws_size < WS_END) { fprintf(stderr, "kernel_launch: unexpected shapes (n_in %d out %d ws %zu)\n", n_in, out_size, ws_size); grid = -1; return; }
        int dev = 0, cus = 0, per_cu = 0;
        if (hipGetDevice(&dev) != hipSuccess || hipDeviceGetAttribute(&cus, hipDeviceAttributeMultiprocessorCount, dev) != hipSuccess) { grid = -1; return; }
        if (hipFuncSetAttribute((const void*)hymba_fwd, hipFuncAttributeMaxDynamicSharedMemorySize, LDS_BYTES) != hipSuccess) { fprintf(stderr, "kernel_launch: hipFuncSetAttribute failed\n"); grid = -1; return; }
        if (hipOccupancyMaxActiveBlocksPerMultiprocessor(&per_cu, (const void*)hymba_fwd, NTHR, LDS_BYTES) != hipSuccess || per_cu < 1) { fprintf(stderr, "kernel_launch: occupancy query says %d blocks per CU\n", per_cu); grid = -1; return; }
        (void)hipGetLastError();
        grid = cus;
    }
    if (grid < 0) return;
    (void)hipMemsetAsync((char*)d_ws + WS_CTL, 0, XCD_BAR_WORDS * 4, stream);
    Params p{};
    for (int i = 0; i < 20; ++i) p.in[i] = (const float*)d_in[i];
    p.out = (float*)d_out; p.ws = (unsigned char*)d_ws;
    hipLaunchKernelGGL(hymba_fwd, dim3(grid), dim3(NTHR), LDS_BYTES, stream, p);
}
```

```cpp
#include <hip/hip_runtime.h>
#include <cstdint>
#include <cstdio>

typedef unsigned short bf16_t;
typedef short bf16x8 __attribute__((ext_vector_type(8)));
typedef float f32x4 __attribute__((ext_vector_type(4)));
typedef unsigned u32x4 __attribute__((ext_vector_type(4)));
typedef float f32x16 __attribute__((ext_vector_type(16)));

constexpr int S = 16384, D = 1024, NPROJ = 2560, DSB = 512, DRG = 512, NH = 8, HD = 64;
constexpr int PH = 8, PNK = 128, PDK = 256, PHALF = 128, PTOPK = 16, NEXP = 16384, NQ = PH * PDK;
constexpr int CHUNK = 64, NCHUNK = S / CHUNK;
constexpr float EPS = 1e-6f;
constexpr float LOG2E = 1.4426950408889634f;
constexpr float QSCALE = 0.125f * LOG2E;
constexpr int NTHR = 512;
constexpr float CARRY_STOP = -160.0f;

constexpr size_t MiB = 1u << 20;
constexpr size_t WS_CTL = 0;
constexpr size_t WS_WINT = 1 * MiB;
constexpr size_t WS_WOUTT = 6 * MiB;
constexpr size_t WS_WQT = 8 * MiB;
constexpr size_t WS_SUBK = 12 * MiB;
constexpr size_t WS_RSTD1 = 12 * MiB + 512 * 1024;
constexpr size_t WS_RSTD2 = WS_RSTD1 + 64 * 1024;
constexpr size_t WS_RGP = WS_RSTD2 + 64 * 1024;
constexpr size_t WS_RGH = WS_RGP + 512 * 1024;
constexpr size_t WS_RGSA = 207 * MiB, WS_RGSB = 223 * MiB;
constexpr size_t WS_A = 14 * MiB;
constexpr size_t WS_B = 46 * MiB;
constexpr size_t WS_QH = WS_B, WS_KH = WS_B + 16 * MiB, WS_VH = WS_B + 32 * MiB, WS_XRG = WS_B + 48 * MiB;
constexpr size_t WS_GG = 110 * MiB;
constexpr size_t WS_OSB = 126 * MiB;
constexpr size_t WS_MIX = 142 * MiB;
constexpr size_t WS_SELI = WS_MIX, WS_SELG = WS_MIX + 8 * MiB;
constexpr size_t WS_PD = WS_B;
constexpr size_t WS_CBUF = WS_GG;
constexpr size_t WS_CSC = WS_GG + 4 * MiB;
constexpr size_t WS_X1Q = WS_OSB;
constexpr size_t WS_XSC = WS_GG + 8 * MiB;
constexpr size_t WS_UB = 174 * MiB;
constexpr size_t WS_VB = 190 * MiB;
constexpr size_t WS_USC = 206 * MiB;
constexpr size_t WS_SSQ = 238 * MiB;
constexpr size_t WS_RGW = 239 * MiB;
constexpr size_t WS_END = 240 * MiB;

__device__ __forceinline__ unsigned f2bf(float f) { unsigned u = __builtin_bit_cast(unsigned, f); return (u + 0x7fffu + ((u >> 16) & 1u)) >> 16; }
__device__ __forceinline__ float u2f(unsigned u) { return __builtin_bit_cast(float, u); }
__device__ __forceinline__ float bf2f(unsigned h) { return __builtin_bit_cast(float, h << 16); }
__device__ __forceinline__ unsigned pk2(float lo, float hi) { return f2bf(lo) | (f2bf(hi) << 16); }
__device__ __forceinline__ unsigned pack_i8(float a, float b, float c, float d) {
    const int qa = __float2int_rn(a), qb = __float2int_rn(b), qc = __float2int_rn(c), qd = __float2int_rn(d);
    return (unsigned)(qa & 255) | ((unsigned)(qb & 255) << 8) | ((unsigned)(qc & 255) << 16) | ((unsigned)qd << 24);
}
__device__ __forceinline__ unsigned pack_n4(float a, float b, float c, float d) {
    const int qa = min(max(__float2int_rn(a), -7), 7) & 15, qb = min(max(__float2int_rn(b), -7), 7) & 15, qc = min(max(__float2int_rn(c), -7), 7) & 15, qd = min(max(__float2int_rn(d), -7), 7) & 15;
    return (unsigned)qa | ((unsigned)qb << 4) | ((unsigned)qc << 8) | ((unsigned)qd << 12);
}
template <int OFFS>
__device__ __forceinline__ unsigned pack_u4(float a, float b, float c, float d) {
    const int qa = (min(max(__float2int_rn(a), -7), 7) + OFFS) & 15, qb = (min(max(__float2int_rn(b), -7), 7) + OFFS) & 15, qc = (min(max(__float2int_rn(c), -7), 7) + OFFS) & 15, qd = (min(max(__float2int_rn(d), -7), 7) + OFFS) & 15;
    return (unsigned)qa | ((unsigned)qb << 8) | ((unsigned)qc << 16) | ((unsigned)qd << 24);
}
__device__ __forceinline__ float wave_sum(float v) {
#pragma unroll
    for (int o = 1; o < 64; o <<= 1) v += __shfl_xor(v, o);
    return v;
}
__device__ __forceinline__ float gelu_tanh(float x) {
    const float u = 0.7978845608028654f * (x + 0.044715f * x * x * x);
    const float e = __expf(2.0f * u);
    const float th = 1.0f - 2.0f / (e + 1.0f);
    return 0.5f * x * (1.0f + th);
}

__host__ __device__ __forceinline__ int inproj_phys_row(int nlog) { const int t = nlog >> 8, L = nlog & 255; return (t << 8) + 128 * ((L & 63) >> 5) + 32 * (L >> 6) + (L & 31); }

__device__ __forceinline__ int phase_tid() { int t = threadIdx.x; asm volatile("" : "+v"(t)); return t; }

struct Params {
    const float* in[20];
    float* out;
    unsigned char* ws;
};
enum { I_X = 0, I_NORM_MIX, I_W_IN, I_Q_NORM, I_K_NORM, I_CONV_W, I_CONV_B, I_RG_W_A, I_RG_B_A, I_RG_W_X, I_RG_B_X, I_RG_LAMBDA,
       I_OUT_NORM_SB, I_OUT_NORM_RG, I_W_OUT, I_NORM_FFN, I_PEER_WQ, I_PEER_SUBK, I_PEER_U, I_PEER_V };

template <bool INPROJ_PERM>
__device__ __forceinline__ void prep_transpose_item(const float* W, const float* gain0, const float* gain1, int K, int N, bf16_t* WT, float* scr, int item, int lane) {
    const int nblk = N / 32, kb = item / nblk, nb = item % nblk, k0 = 64 * kb, n0 = 32 * nb;
#pragma unroll 8
    for (int i = 0; i < 32; ++i) {
        const int kk = 2 * i + (lane >> 5), k = k0 + kk;
        const float g = (gain1 && k >= 512) ? gain1[k - 512] : gain0[k];
        scr[kk * 33 + (lane & 31)] = g * W[(size_t)k * N + n0 + (lane & 31)];
    }
    asm volatile("s_waitcnt lgkmcnt(0)" ::: "memory");
    const int c = lane & 7;
#pragma unroll
    for (int j = 0; j < 4; ++j) {
        const int n = (lane >> 3) + 8 * j; const float* s = scr + (8 * c) * 33 + n;
        u32x4 o; o.x = pk2(s[0 * 33], s[1 * 33]); o.y = pk2(s[2 * 33], s[3 * 33]); o.z = pk2(s[4 * 33], s[5 * 33]); o.w = pk2(s[6 * 33], s[7 * 33]);
        const int nr = INPROJ_PERM ? inproj_phys_row(n0 + n) : n0 + n;
        *(u32x4*)(WT + (size_t)nr * K + k0 + 8 * c) = o;
    }
    asm volatile("s_waitcnt lgkmcnt(0)" ::: "memory");
}
__device__ __forceinline__ void ph_tables(const Params& p, int cw, int ncw, int lane) {
    unsigned char* ws = p.ws;
    {
        const float* u = p.in[I_PEER_U]; const float* v = p.in[I_PEER_V]; const float* g = p.in[I_NORM_FFN];
        unsigned* ub = (unsigned*)(ws + WS_UB); unsigned* vb = (unsigned*)(ws + WS_VB); float2* uvsc = (float2*)(ws + WS_USC);
        f32x4 gq[4];
#pragma unroll
        for (int j = 0; j < 4; ++j) gq[j] = *((const f32x4*)g + lane + 64 * j);
        for (int e0 = cw; e0 < NEXP; e0 += 2 * ncw) {
            f32x4 a[2][4], b[2][4]; float ma[2], mb[2], sa2[2], sb2[2];
#pragma unroll
            for (int rr = 0; rr < 2; ++rr) {
                const int e = min(e0 + rr * ncw, NEXP - 1);
#pragma unroll
                for (int j = 0; j < 4; ++j) { a[rr][j] = *((const f32x4*)(u + (size_t)e * D) + lane + 64 * j); b[rr][j] = *((const f32x4*)(v + (size_t)e * D) + lane + 64 * j); }
            }
#pragma unroll
            for (int rr = 0; rr < 2; ++rr) {
                ma[rr] = 0.f; mb[rr] = 0.f; sa2[rr] = 0.f; sb2[rr] = 0.f;
#pragma unroll
                for (int j = 0; j < 4; ++j) {
                    a[rr][j] = a[rr][j] * gq[j];
                    const f32x4 aa = a[rr][j], bb = b[rr][j];
                    ma[rr] = fmaxf(ma[rr], fmaxf(fmaxf(fabsf(aa.x), fabsf(aa.y)), fmaxf(fabsf(aa.z), fabsf(aa.w))));
                    mb[rr] = fmaxf(mb[rr], fmaxf(fmaxf(fabsf(bb.x), fabsf(bb.y)), fmaxf(fabsf(bb.z), fabsf(bb.w))));
                    sa2[rr] += (aa.x * aa.x + aa.y * aa.y) + (aa.z * aa.z + aa.w * aa.w);
                    sb2[rr] += (bb.x * bb.x + bb.y * bb.y) + (bb.z * bb.z + bb.w * bb.w);
                }
            }
#pragma unroll
            for (int o = 1; o < 64; o <<= 1)
#pragma unroll
                for (int rr = 0; rr < 2; ++rr) { ma[rr] = fmaxf(ma[rr], __shfl_xor(ma[rr], o)); mb[rr] = fmaxf(mb[rr], __shfl_xor(mb[rr], o)); sa2[rr] += __shfl_xor(sa2[rr], o); sb2[rr] += __shfl_xor(sb2[rr], o); }
#pragma unroll
            for (int rr = 0; rr < 2; ++rr) {
                const int e = e0 + rr * ncw;
                if (e < NEXP) {
                    const float ca = fminf(ma[rr], 2.5f * sqrtf(sa2[rr] * (1.0f / D))), cb = fminf(mb[rr], 2.5f * sqrtf(sb2[rr] * (1.0f / D)));
                    const float ia = ca > 0.f ? 7.0f / ca : 0.f, ib = cb > 0.f ? 7.0f / cb : 0.f;
#pragma unroll
                    for (int j = 0; j < 4; ++j) {
                        const f32x4 aa = a[rr][j], bb = b[rr][j];
                        const unsigned na = pack_u4<0>(aa.x * ia, aa.y * ia, aa.z * ia, aa.w * ia), nb = pack_n4(bb.x * ib, bb.y * ib, bb.z * ib, bb.w * ib);
                        const unsigned pa = __shfl_xor(na, 1), pb = __shfl_xor(nb, 1);
                        if ((lane & 1) == 0) {
                            ub[((size_t)j * NEXP + e) * 32 + (lane >> 1)] = na | (pa << 4);
                            vb[((size_t)j * NEXP + e) * 32 + (lane >> 1)] = nb | (pb << 16);
                        }
                    }
                    if (lane == 0) uvsc[e] = make_float2(ca * (1.0f / 7.0f), cb * (1.0f / 7.0f));
                }
            }
        }
    }
}

__device__ __forceinline__ void ph_prep(const Params& p, unsigned char* lds) {
    const int tid_ = phase_tid();
    const int gtid = blockIdx.x * blockDim.x + tid_, gsize = gridDim.x * blockDim.x;
    const int lane = tid_ & 63, gwave = gtid >> 6, nwave = gsize >> 6;
    unsigned char* ws = p.ws;
    {
        float* scr = (float*)lds + (tid_ >> 6) * (64 * 33);
        constexpr int I_IN = (D / 64) * (NPROJ / 32), I_OUT = (D / 64) * (D / 32), I_Q = (D / 64) * (NQ / 32);
        for (int it = gwave; it < I_IN + I_OUT + I_Q; it += nwave) {
            if (it < I_IN) prep_transpose_item<true>(p.in[I_W_IN], p.in[I_NORM_MIX], nullptr, D, NPROJ, (bf16_t*)(ws + WS_WINT), scr, it, lane);
            else if (it < I_IN + I_OUT) prep_transpose_item<false>(p.in[I_W_OUT], p.in[I_OUT_NORM_SB], p.in[I_OUT_NORM_RG], D, D, (bf16_t*)(ws + WS_WOUTT), scr, it - I_IN, lane);
            else prep_transpose_item<false>(p.in[I_PEER_WQ], p.in[I_NORM_FFN], nullptr, D, NQ, (bf16_t*)(ws + WS_WQT), scr, it - I_IN - I_OUT, lane);
        }
    }
    {
        const float* wa = p.in[I_RG_W_A]; const float* wx = p.in[I_RG_W_X]; bf16_t* o = (bf16_t*)(ws + WS_RGW);
        for (int e = gtid; e < 8 * 2 * 2 * 4 * 64 * 8; e += gsize) {
            const int el = e & 7, ln = (e >> 3) & 63, s = (e >> 9) & 3, jt = (e >> 11) & 1, g = (e >> 12) & 1, n = e >> 13;
            const int j = 32 * jt + (ln & 31), i = 16 * s + 8 * (el >> 2) + 4 * (ln >> 5) + (el & 3);
            o[e] = (bf16_t)f2bf((g == 0 ? wa : wx)[((size_t)n * 64 + i) * 64 + j]);
        }
    }
    {
        const float* sk = p.in[I_PEER_SUBK]; bf16_t* o = (bf16_t*)(ws + WS_SUBK);
        for (int e = gtid; e < PH * 2 * PNK * PHALF; e += gsize) o[e] = (bf16_t)f2bf(sk[e]);
    }
    {
        const float* x = p.in[I_X]; bf16_t* xb = (bf16_t*)(ws + WS_A); float* rstd1 = (float*)(ws + WS_RSTD1);
        for (int row0 = gwave; row0 < S; row0 += 4 * nwave) {
            f32x4 v[4][4];
#pragma unroll
            for (int rr = 0; rr < 4; ++rr) {
                const int row = min(row0 + rr * nwave, S - 1);
#pragma unroll
                for (int j = 0; j < 4; ++j) v[rr][j] = ((const f32x4*)(x + (size_t)row * D) + lane)[64 * j];
            }
#pragma unroll
            for (int rr = 0; rr < 4; ++rr) {
                const int row = row0 + rr * nwave;
                float ss = 0.f;
#pragma unroll
                for (int j = 0; j < 4; ++j) ss += (v[rr][j].x * v[rr][j].x + v[rr][j].y * v[rr][j].y) + (v[rr][j].z * v[rr][j].z + v[rr][j].w * v[rr][j].w);
                ss = wave_sum(ss);
                if (row < S) {
                    uint2* o = (uint2*)(xb + (size_t)row * D) + lane;
#pragma unroll
                    for (int j = 0; j < 4; ++j) o[64 * j] = make_uint2(pk2(v[rr][j].x, v[rr][j].y), pk2(v[rr][j].z, v[rr][j].w));
                    if (lane == 0) rstd1[row] = rsqrtf(ss * (1.0f / D) + EPS);
                }
            }
        }
    }
}

namespace pg8 {
#define PG8_LAS __attribute__((address_space(3)))
typedef unsigned short bf16_t;
typedef short bf16x8 __attribute__((ext_vector_type(8)));
typedef float f32x4 __attribute__((ext_vector_type(4)));
typedef unsigned u32x4 __attribute__((ext_vector_type(4)));
constexpr int BM = 256, BK = 64, HALF = 128, HTB = HALF * BK * 2  , STAGE_BYTES = 8 * HTB, NXCD = 8, WGM = 8;

__host__ __device__ __forceinline__ int lds_byte(int r, int c) { const int st = (r >> 4) * 2 + (c >> 5), rr = r & 15, cc = c & 31, ob = rr * 64 + cc * 2; return st * 1024 + (ob ^ (((ob >> 9) & 1) << 5)); }
__host__ __device__ __forceinline__ void stage_rc(int b, int& R, int& C) { const int st = b / 1024, sb = b % 1024, swz = sb ^ (((sb >> 9) & 1) << 5); R = (st >> 1) * 16 + swz / 64; C = (st & 1) * 32 + (swz % 64) / 2; }
__host__ __device__ __forceinline__ int perm32(int rho) { const int n = rho >> 4, i = rho & 15; return 8 * (i >> 2) + 4 * n + (i & 3); }

struct Unit { int pm, pn; };
struct Gemm { const bf16_t* A; const bf16_t* Bt; int M, N, K; };

struct StaticOrder {
    int nM, nN, nwg, G, c;
    __host__ __device__ void init(int M, int N, int G_, int c_) { nM = M / BM; nN = N / BM; nwg = nM * nN; G = G_; c = c_; }
    __host__ __device__ bool next(int i, Unit& u) const {
        const long L = (long)i * G + c; if (L >= nwg) return false;
        int wgid = (int)L; { const int q = nwg / NXCD, r = nwg % NXCD, xcd = wgid % NXCD, off = wgid / NXCD; wgid = (xcd < r ? xcd * (q + 1) : r * (q + 1) + (xcd - r) * q) + off; }
        const int nig = WGM * nN, gid = wgid / nig, fm = gid * WGM, gsz = (nM - fm) < WGM ? (nM - fm) : WGM;
        u.pm = fm + ((wgid % nig) % gsz); u.pn = (wgid % nig) / gsz; return true;
    }
    __device__ __forceinline__ void a_ready(const Unit&) const {}
    __device__ __forceinline__ void done(const Unit&) const {}
};

__device__ __forceinline__ unsigned cvt_pk_bf16(float lo, float hi) { unsigned r; asm volatile("v_cvt_pk_bf16_f32 %0, %1, %2" : "=v"(r) : "v"(lo), "v"(hi)); return r; }
template <class Epi, class Sched, bool ALIGN_EPI = false, bool SP2 = false>
__device__ __forceinline__ void gemm_phase(PG8_LAS unsigned char* lds, const Gemm g, const Sched& S, const Epi& E) {
    const int tid = phase_tid(), wid = __builtin_amdgcn_readfirstlane(tid >> 6), lane = tid & 63, wr = wid >> 2, wc = wid & 3, fr = lane & 15, fq = lane >> 4;
    const int K = g.K, nt = K / BK;
    unsigned voffA[2], voffB[2];
#pragma unroll
    for (int i = 0; i < 2; ++i) { int R, C; stage_rc(tid * 16 + i * 8192, R, C); const int Rb = Epi::PERM ? ((R & ~31) + perm32(R & 31)) : R;
        voffA[i] = (unsigned)(R * K + C) * 2u; voffB[i] = (unsigned)(Rb * K + C) * 2u; }
    const size_t kstep = (size_t)(BK * 2);
    const size_t hstep = (size_t)HALF * K * 2;
    const size_t tstep = 2 * hstep;
    const unsigned ldsw = (unsigned)wid * 1024u;
    const int aoff = lds_byte(wr * 64 + fr, fq * 8), boff = lds_byte(wc * 32 + fr, fq * 8);
#define PG8_SA(b, h) (((b) * 2 + (h)) * HTB)
#define PG8_SB(b, h) ((4 + (b) * 2 + (h)) * HTB)
#define PG8_STAGE(bufoff, gbase, voff) do { _Pragma("unroll") for (int _i = 0; _i < 2; ++_i) \
        __builtin_amdgcn_global_load_lds((const unsigned*)((const char*)(gbase) + (voff)[_i]), (PG8_LAS unsigned*)(lds + (bufoff) + ldsw + _i * 8192), 16, 0, 0); } while (0)
#define PG8_LDA(dst, b, h) do { _Pragma("unroll") for (int m = 0; m < 4; ++m) _Pragma("unroll") for (int k = 0; k < 2; ++k) dst[m][k] = *(const PG8_LAS bf16x8*)(lds + PG8_SA(b, h) + aoff + m * 2048 + k * 1024); } while (0)
#define PG8_LDB(dst, b, h) do { _Pragma("unroll") for (int n = 0; n < 2; ++n) _Pragma("unroll") for (int k = 0; k < 2; ++k) dst[n][k] = *(const PG8_LAS bf16x8*)(lds + PG8_SB(b, h) + boff + n * 2048 + k * 1024); } while (0)
#define PG8_MMA(ai, bj, At, Bt) do { __builtin_amdgcn_s_setprio(1); _Pragma("unroll") for (int m = 0; m < 4; ++m) _Pragma("unroll") for (int n = 0; n < 2; ++n) _Pragma("unroll") for (int k = 0; k < 2; ++k) \
        acc[ai][bj][m][n] = __builtin_amdgcn_mfma_f32_16x16x32_bf16(Bt[n][k], At[m][k], acc[ai][bj][m][n], 0, 0, 0); __builtin_amdgcn_s_setprio(0); } while (0)
#define PG8_WAIT_V(n) asm volatile("s_waitcnt vmcnt(" #n ")" ::: "memory")
#define PG8_WAIT_L(n) asm volatile("s_waitcnt lgkmcnt(" #n ")" ::: "memory")
#define PG8_BAR __builtin_amdgcn_s_barrier()
#define PG8_SCHED __builtin_amdgcn_sched_barrier(0)
    Unit cur, nxt; int ui = 0;
    if (!S.next(0, cur)) return;
    f32x4 acc[2][2][4][2];
#pragma unroll
    for (int a = 0; a < 2; ++a)
#pragma unroll
        for (int b = 0; b < 2; ++b)
#pragma unroll
            for (int m = 0; m < 4; ++m)
#pragma unroll
                for (int n = 0; n < 2; ++n) acc[a][b][m][n] = (f32x4){0.f, 0.f, 0.f, 0.f};
    bf16x8 At[4][2], B0[2][2], B1[2][2];
    const char* cA = (const char*)g.A + (size_t)cur.pm * tstep; const char* cB = (const char*)g.Bt + (size_t)cur.pn * tstep;
    S.a_ready(cur);
    if constexpr (SP2) {
        PG8_STAGE(PG8_SB(0, 0), cB, voffB); PG8_STAGE(PG8_SB(0, 1), cB + hstep, voffB); PG8_STAGE(PG8_SA(0, 0), cA, voffA); PG8_STAGE(PG8_SA(0, 1), cA + hstep, voffA);
        if (wr == 1) PG8_BAR;
        PG8_WAIT_V(2); PG8_BAR;
        PG8_STAGE(PG8_SB(1, 0), cB + kstep, voffB); PG8_STAGE(PG8_SA(1, 0), cA + kstep, voffA); PG8_STAGE(PG8_SB(1, 1), cB + hstep + kstep, voffB);
        PG8_WAIT_V(6); PG8_BAR;
    } else {
        PG8_STAGE(PG8_SB(0, 0), cB, voffB); PG8_STAGE(PG8_SA(0, 0), cA, voffA); PG8_STAGE(PG8_SB(0, 1), cB + hstep, voffB); PG8_STAGE(PG8_SA(0, 1), cA + hstep, voffA);
        if (wr == 1) PG8_BAR;
        PG8_WAIT_V(4); PG8_BAR;
        PG8_STAGE(PG8_SB(1, 0), cB + kstep, voffB); PG8_STAGE(PG8_SA(1, 0), cA + kstep, voffA); PG8_STAGE(PG8_SB(1, 1), cB + hstep + kstep, voffB);
        PG8_WAIT_V(6); PG8_BAR;
    }
    for (;;) {
        const bool has_next = S.next(ui + 1, nxt);
        const char* nA = has_next ? (const char*)g.A + (size_t)nxt.pm * tstep : cA; const char* nB = has_next ? (const char*)g.Bt + (size_t)nxt.pn * tstep : cB;
        for (int t = 0; t < nt; t += 2) {
            const bool last = (t == nt - 2);
            const char* a1 = cA + (size_t)(t + 1) * kstep;
            const char* a2 = last ? nA : cA + (size_t)(t + 2) * kstep; const char* b2 = last ? nB : cB + (size_t)(t + 2) * kstep;
            const char* a3 = a2 + kstep; const char* b3 = b2 + kstep;
            if (last && has_next) S.a_ready(nxt);
            if constexpr (SP2) {
            PG8_LDB(B0, 0, 0); PG8_LDB(B1, 0, 1); PG8_SCHED; PG8_LDA(At, 0, 0); PG8_STAGE(PG8_SA(1, 1), a1 + hstep, voffA);
            PG8_WAIT_V(8); PG8_WAIT_L(0); PG8_BAR; PG8_MMA(0, 0, At, B0); PG8_MMA(0, 1, At, B1); PG8_BAR; PG8_SCHED;
            PG8_LDA(At, 0, 1); PG8_STAGE(PG8_SB(0, 0), b2, voffB); PG8_STAGE(PG8_SB(0, 1), b2 + hstep, voffB); PG8_STAGE(PG8_SA(0, 0), a2, voffA);
            PG8_WAIT_V(8); PG8_WAIT_L(0); PG8_BAR; PG8_MMA(1, 0, At, B0); PG8_MMA(1, 1, At, B1); PG8_BAR; PG8_SCHED;
            PG8_LDB(B0, 1, 0); PG8_LDB(B1, 1, 1); PG8_SCHED; PG8_LDA(At, 1, 0); PG8_STAGE(PG8_SA(0, 1), a2 + hstep, voffA);
            PG8_WAIT_V(8); PG8_WAIT_L(0); PG8_BAR; PG8_MMA(0, 0, At, B0); PG8_MMA(0, 1, At, B1); PG8_BAR; PG8_SCHED;
            PG8_LDA(At, 1, 1); PG8_STAGE(PG8_SB(1, 0), b3, voffB); PG8_STAGE(PG8_SB(1, 1), b3 + hstep, voffB); PG8_STAGE(PG8_SA(1, 0), a3, voffA);
            PG8_WAIT_V(8); PG8_WAIT_L(0); PG8_BAR; PG8_MMA(1, 0, At, B0); PG8_MMA(1, 1, At, B1); PG8_BAR; PG8_SCHED;
            } else {
            PG8_LDB(B0, 0, 0); PG8_SCHED; PG8_LDA(At, 0, 0); PG8_STAGE(PG8_SA(1, 1), a1 + hstep, voffA);
            PG8_WAIT_L(8); PG8_BAR; PG8_WAIT_L(0); PG8_MMA(0, 0, At, B0); PG8_BAR; PG8_SCHED;
            PG8_LDB(B1, 0, 1); PG8_STAGE(PG8_SB(0, 0), b2, voffB);
            PG8_BAR; PG8_WAIT_L(0); PG8_MMA(0, 1, At, B1); PG8_BAR;
            PG8_LDA(At, 0, 1); PG8_STAGE(PG8_SA(0, 0), a2, voffA);
            PG8_BAR; PG8_WAIT_L(0); PG8_MMA(1, 0, At, B0); PG8_BAR; PG8_SCHED;
            PG8_STAGE(PG8_SB(0, 1), b2 + hstep, voffB);
            PG8_WAIT_V(6); PG8_BAR; PG8_MMA(1, 1, At, B1); PG8_BAR;
            PG8_LDB(B0, 1, 0); PG8_SCHED; PG8_LDA(At, 1, 0); PG8_STAGE(PG8_SA(0, 1), a2 + hstep, voffA);
            PG8_WAIT_L(8); PG8_BAR; PG8_WAIT_L(0); PG8_MMA(0, 0, At, B0); PG8_BAR; PG8_SCHED;
            PG8_LDB(B1, 1, 1); PG8_STAGE(PG8_SB(1, 0), b3, voffB);
            PG8_BAR; PG8_WAIT_L(0); PG8_MMA(0, 1, At, B1); PG8_BAR;
            PG8_LDA(At, 1, 1); PG8_STAGE(PG8_SA(1, 0), a3, voffA);
            PG8_BAR; PG8_WAIT_L(0); PG8_MMA(1, 0, At, B0); PG8_BAR; PG8_SCHED;
            PG8_STAGE(PG8_SB(1, 1), b3 + hstep, voffB);
            PG8_WAIT_V(6); PG8_BAR; PG8_MMA(1, 1, At, B1); PG8_BAR;
            }
        }
        if constexpr (ALIGN_EPI) { if (wr == 0) PG8_BAR; }
        if constexpr (!Epi::AFTER_DRAIN) { E(acc, cur, wr, wc, fr, fq); S.done(cur); }
        if (!has_next) break;
#pragma unroll
        for (int a = 0; a < 2; ++a)
#pragma unroll
            for (int b = 0; b < 2; ++b)
#pragma unroll
                for (int m = 0; m < 4; ++m)
#pragma unroll
                    for (int n = 0; n < 2; ++n) acc[a][b][m][n] = (f32x4){0.f, 0.f, 0.f, 0.f};
        cur = nxt; cA = nA; cB = nB; ++ui;
        if constexpr (ALIGN_EPI) { if (wr == 1) PG8_BAR; }
    }
    PG8_WAIT_V(0);
    if constexpr (!ALIGN_EPI) { if (wr == 0) PG8_BAR; }
    PG8_BAR;
    if constexpr (Epi::AFTER_DRAIN) { E.fused(acc, cur, wr, wc, fr, fq, lds, wid, lane); S.done(cur); }
#undef PG8_SA
#undef PG8_SB
#undef PG8_STAGE
#undef PG8_LDA
#undef PG8_LDB
#undef PG8_MMA
#undef PG8_WAIT_V
#undef PG8_WAIT_L
#undef PG8_BAR
#undef PG8_SCHED
}
}

struct EpiInProj {
    static constexpr bool PERM = true, AFTER_DRAIN = false;
    const float* rstd1; const float* qn; const float* kn; bf16_t *qh, *kh, *vh, *xrg, *gg;
    __device__ __forceinline__ void operator()(const pg8::f32x4 (&acc)[2][2][4][2], const pg8::Unit& u, int wr, int wc, int fr, int fq) const {
        const int region = u.pn >> 1;
        const int head = (u.pn & 1) * 4 + wc;
        float rsv[2][4];
#pragma unroll
        for (int ai = 0; ai < 2; ++ai)
#pragma unroll
            for (int m = 0; m < 4; ++m) rsv[ai][m] = rstd1[u.pm * 256 + ai * 128 + wr * 64 + m * 16 + fr];
        pg8::f32x4 gn[2][2];
        if (region <= 1) {
            const float* g = region == 0 ? qn : kn; const float sc = region == 0 ? QSCALE : 1.0f;
#pragma unroll
            for (int bj = 0; bj < 2; ++bj)
#pragma unroll
                for (int n = 0; n < 2; ++n) gn[bj][n] = *(const pg8::f32x4*)(g + 32 * bj + 8 * fq + 4 * n) * sc;
        }
#pragma unroll
        for (int ai = 0; ai < 2; ++ai)
#pragma unroll
            for (int m = 0; m < 4; ++m) {
                const int row = u.pm * 256 + ai * 128 + wr * 64 + m * 16 + fr;
                const float rs = rsv[ai][m];
                pg8::f32x4 v[2][2];
#pragma unroll
                for (int bj = 0; bj < 2; ++bj)
#pragma unroll
                    for (int n = 0; n < 2; ++n) v[bj][n] = acc[ai][bj][m][n] * rs;
                bf16_t* dst;
                if (region <= 1) {
                    float ss = 0.f;
#pragma unroll
                    for (int bj = 0; bj < 2; ++bj)
#pragma unroll
                        for (int n = 0; n < 2; ++n) ss += (v[bj][n][0] * v[bj][n][0] + v[bj][n][1] * v[bj][n][1]) + (v[bj][n][2] * v[bj][n][2] + v[bj][n][3] * v[bj][n][3]);
                    ss += __shfl_xor(ss, 16); ss += __shfl_xor(ss, 32);
                    const float rn = rsqrtf(ss * (1.0f / HD) + EPS);
#pragma unroll
                    for (int bj = 0; bj < 2; ++bj)
#pragma unroll
                        for (int n = 0; n < 2; ++n) v[bj][n] = v[bj][n] * rn * gn[bj][n];
                    bf16_t* fb = (region == 0 ? qh : kh) + ((size_t)(head * (S / 32) + (row >> 5)) * 4 * 64 + (row & 31)) * 8;
#pragma unroll
                    for (int bj = 0; bj < 2; ++bj) {
                        pg8::u32x4 w; w.x = pg8::cvt_pk_bf16(v[bj][0][0], v[bj][0][1]); w.y = pg8::cvt_pk_bf16(v[bj][0][2], v[bj][0][3]);
                        w.z = pg8::cvt_pk_bf16(v[bj][1][0], v[bj][1][1]); w.w = pg8::cvt_pk_bf16(v[bj][1][2], v[bj][1][3]);
                        *(pg8::u32x4*)(fb + ((2 * bj + (fq >> 1)) * 64 + 32 * (fq & 1)) * 8) = w;
                    }
                    continue;
                } else if (region == 2) {
#pragma unroll
                    for (int bj = 0; bj < 2; ++bj)
#pragma unroll
                        for (int n = 0; n < 2; ++n)
#pragma unroll
                            for (int i = 0; i < 4; ++i) {
                                const int d = 32 * bj + 8 * fq + 4 * n + i, kl = row & 31;
                                vh[(((((size_t)head * (S / 32) + (row >> 5)) * 2 + (d >> 5)) * 2 + (kl >> 4)) * 64 + (d & 31) + 32 * ((kl >> 2) & 1)) * 8 + 4 * ((kl >> 3) & 1) + (kl & 3)] = (bf16_t)f2bf(v[bj][n][i]);
                            }
                    continue;
                } else if (region == 3) {
                    dst = xrg + (size_t)row * DRG + head * 64;
                } else {
#pragma unroll
                    for (int bj = 0; bj < 2; ++bj)
#pragma unroll
                        for (int n = 0; n < 2; ++n)
#pragma unroll
                            for (int i = 0; i < 4; ++i) v[bj][n][i] = gelu_tanh(v[bj][n][i]);
#pragma unroll
                    for (int bj = 0; bj < 2; ++bj)
#pragma unroll
                        for (int n = 0; n < 2; ++n)
                            *(uint2*)(gg + ((((size_t)(row >> 5) * 8 + head) * 8 + (4 * bj + fq)) * 64 + (row & 31) + 32 * n) * 4) = make_uint2(pg8::cvt_pk_bf16(v[bj][n][0], v[bj][n][1]), pg8::cvt_pk_bf16(v[bj][n][2], v[bj][n][3]));
                    continue;
                }
#pragma unroll
                for (int bj = 0; bj < 2; ++bj) {
                    pg8::u32x4 w; w.x = pg8::cvt_pk_bf16(v[bj][0][0], v[bj][0][1]); w.y = pg8::cvt_pk_bf16(v[bj][0][2], v[bj][0][3]);
                    w.z = pg8::cvt_pk_bf16(v[bj][1][0], v[bj][1][1]); w.w = pg8::cvt_pk_bf16(v[bj][1][2], v[bj][1][3]);
                    *(pg8::u32x4*)(dst + 32 * bj + 8 * fq) = w;
                }
            }
    }
};
struct EpiOutProj {
    static constexpr bool PERM = true, AFTER_DRAIN = false;
    const float* x; bf16_t* x1b; float* ssq; unsigned char* x1q; float* xsc;
    __device__ __forceinline__ void operator()(const pg8::f32x4 (&acc)[2][2][4][2], const pg8::Unit& u, int wr, int wc, int fr, int fq) const {
        pg8::u32x4 xv[2][2][2];
#define OUTPROJ_LD(buf, ai_, mh_) do { _Pragma("unroll") for (int mm_ = 0; mm_ < 2; ++mm_) _Pragma("unroll") for (int bj_ = 0; bj_ < 2; ++bj_) { \
            const size_t o_ = (size_t)(u.pm * 256 + (ai_) * 128 + wr * 64 + (2 * (mh_) + mm_) * 16 + fr) * D + u.pn * 256 + bj_ * 128 + wc * 32 + 8 * fq; \
            xv[buf][mm_][bj_] = *(const pg8::u32x4*)(x1b + o_); } } while (0)
        OUTPROJ_LD(0, 0, 0);
#pragma unroll
        for (int ai = 0; ai < 2; ++ai)
#pragma unroll
            for (int m = 0; m < 4; ++m) {
                const int kb = ai * 2 + (m >> 1);
                if ((m & 1) == 0 && kb < 3) OUTPROJ_LD((kb + 1) & 1, (kb + 1) >> 1, (kb + 1) & 1);
                const int row = u.pm * 256 + ai * 128 + wr * 64 + m * 16 + fr;
                float ss = 0.f;
#pragma unroll
                for (int bj = 0; bj < 2; ++bj) {
                    const int col = u.pn * 256 + bj * 128 + wc * 32 + 8 * fq;
                    const size_t o = (size_t)row * D + col;
                    const pg8::u32x4 xw = xv[kb & 1][m & 1][bj];
                    const pg8::f32x4 a = (pg8::f32x4){u2f(xw.x << 16), u2f(xw.x & 0xffff0000u), u2f(xw.y << 16), u2f(xw.y & 0xffff0000u)} + acc[ai][bj][m][0];
                    const pg8::f32x4 b = (pg8::f32x4){u2f(xw.z << 16), u2f(xw.z & 0xffff0000u), u2f(xw.w << 16), u2f(xw.w & 0xffff0000u)} + acc[ai][bj][m][1];
                    ss += (a[0] * a[0] + a[1] * a[1]) + (a[2] * a[2] + a[3] * a[3]) + (b[0] * b[0] + b[1] * b[1]) + (b[2] * b[2] + b[3] * b[3]);
                    pg8::u32x4 w; w.x = pg8::cvt_pk_bf16(a[0], a[1]); w.y = pg8::cvt_pk_bf16(a[2], a[3]); w.z = pg8::cvt_pk_bf16(b[0], b[1]); w.w = pg8::cvt_pk_bf16(b[2], b[3]);
                    *(pg8::u32x4*)(x1b + o) = w;
                    float mx = fmaxf(fmaxf(fmaxf(fabsf(a[0]), fabsf(a[1])), fmaxf(fabsf(a[2]), fabsf(a[3]))), fmaxf(fmaxf(fabsf(b[0]), fabsf(b[1])), fmaxf(fabsf(b[2]), fabsf(b[3]))));
                    mx = fmaxf(mx, __shfl_xor(mx, 16)); mx = fmaxf(mx, __shfl_xor(mx, 32));
                    const float inv = mx > 0.f ? 119.0f / mx : 0.f;
                    unsigned pl = 0u, ph = 0u;
#pragma unroll
                    for (int i = 0; i < 4; ++i) {
                        const int qa = __float2int_rn(a[i] * inv), qb = __float2int_rn(b[i] * inv);
                        pl |= ((unsigned)(qa & 15) << (8 * i)) | ((unsigned)(qb & 15) << (8 * i + 4));
                        ph |= ((unsigned)(((qa + 8) >> 4) & 15) << (8 * i)) | ((unsigned)(((qb + 8) >> 4) & 15) << (8 * i + 4));
                    }
                    unsigned* cq = (unsigned*)(x1q + (size_t)row * D + (col & ~31));
                    cq[fq] = pl; cq[4 + fq] = ph;
                    if (fq == 0) xsc[(size_t)row * 32 + (col >> 5)] = mx * (1.0f / 119.0f);
                }
                ss += __shfl_xor(ss, 16); ss += __shfl_xor(ss, 32);
                if (fq == 0) ssq[(size_t)row * 16 + u.pn * 4 + wc] = ss;
            }
    }
};
#undef OUTPROJ_LD
struct EpiPeerQ {
    static constexpr bool PERM = true, AFTER_DRAIN = false;
    bf16_t* qp;
    __device__ __forceinline__ void operator()(const pg8::f32x4 (&acc)[2][2][4][2], const pg8::Unit& u, int wr, int wc, int fr, int fq) const {
#pragma unroll
        for (int ai = 0; ai < 2; ++ai)
#pragma unroll
            for (int m = 0; m < 4; ++m) {
                const int row = u.pm * 256 + ai * 128 + wr * 64 + m * 16 + fr;
#pragma unroll
                for (int bj = 0; bj < 2; ++bj) {
                    const pg8::f32x4 a = acc[ai][bj][m][0], b = acc[ai][bj][m][1];
                    pg8::u32x4 w; w.x = pg8::cvt_pk_bf16(a[0], a[1]); w.y = pg8::cvt_pk_bf16(a[2], a[3]); w.z = pg8::cvt_pk_bf16(b[0], b[1]); w.w = pg8::cvt_pk_bf16(b[2], b[3]);
                    *(pg8::u32x4*)(qp + ((((size_t)((row >> 5) * 8 + u.pn) * 2 + bj) * 8 + 2 * wc + (fq >> 1)) * 64 + (row & 31) + 32 * (fq & 1)) * 8) = w;
                }
            }
    }
};

typedef float f32x2v __attribute__((ext_vector_type(2)));
typedef __bf16 bf16x2v __attribute__((ext_vector_type(2)));
__device__ __forceinline__ unsigned cvtpk(float lo, float hi) { const f32x2v v = {lo, hi}; const bf16x2v b = __builtin_convertvector(v, bf16x2v); return __builtin_bit_cast(unsigned, b); }
__device__ __forceinline__ bf16x8 pack_step(const f32x16& x, int s) {
    u32x4 pkd; pkd.x = cvtpk(x[8 * s], x[8 * s + 1]); pkd.y = cvtpk(x[8 * s + 2], x[8 * s + 3]); pkd.z = cvtpk(x[8 * s + 4], x[8 * s + 5]); pkd.w = cvtpk(x[8 * s + 6], x[8 * s + 7]);
    return __builtin_bit_cast(bf16x8, pkd);
}
#define MFMA32(a, b, c) __builtin_amdgcn_mfma_f32_32x32x16_bf16((a), (b), (c), 0, 0, 0)
__device__ __forceinline__ void ph_attn(const Params& p) {
    unsigned char* ws = p.ws;
    const bf16_t* qh = (const bf16_t*)(ws + WS_QH); const bf16_t* kh = (const bf16_t*)(ws + WS_KH); const bf16_t* vT = (const bf16_t*)(ws + WS_VH);
    bf16_t* osb = (bf16_t*)(ws + WS_OSB);
    const int tid = phase_tid(), lane = tid & 63, r = lane & 31, hh = lane >> 5;
    const int gwave = (blockIdx.x * blockDim.x + tid) >> 6, nwave = (gridDim.x * blockDim.x) >> 6;
    bf16x8 tp[2];
#pragma unroll
    for (int ss = 0; ss < 2; ++ss)
#pragma unroll
        for (int e = 0; e < 8; ++e) { const int k = 16 * ss + 8 * (e >> 2) + 4 * hh + (e & 3); tp[ss][e] = (k > r) ? (short)0x3F80 : (short)0; }
    f32x16 zero16;
#pragma unroll
    for (int i = 0; i < 16; ++i) zero16[i] = 0.f;
    for (int u = gwave; u < NH * (S / 32); u += nwave) {
        const int h = u / (S / 32), t0 = (u % (S / 32)) * 32;
        bf16x8 bq[4];
#pragma unroll
        for (int s = 0; s < 4; ++s) bq[s] = *(const bf16x8*)(qh + (((size_t)(h * (S / 32) + (t0 >> 5)) * 4 + s) * 64 + lane) * 8);
        f32x16 ot[2] = {zero16, zero16};
        float carry = 0.f;
        for (int kt0 = t0; kt0 >= 0; kt0 -= 32) {
            bf16x8 ak[4], av[2][2];
#pragma unroll
            for (int s = 0; s < 4; ++s) ak[s] = *(const bf16x8*)(kh + (((size_t)(h * (S / 32) + (kt0 >> 5)) * 4 + s) * 64 + lane) * 8);
#pragma unroll
            for (int dt = 0; dt < 2; ++dt)
#pragma unroll
                for (int ss = 0; ss < 2; ++ss) av[dt][ss] = *(const bf16x8*)(vT + ((((size_t)(h * (S / 32) + (kt0 >> 5)) * 2 + dt) * 2 + ss) * 64 + lane) * 8);
            f32x16 st = zero16;
#pragma unroll
            for (int s = 0; s < 4; ++s) st = MFMA32(ak[s], bq[s], st);
            const bool diag = (kt0 == t0);
            f32x16 lom, lb;
            float csum = 0.f;
#pragma unroll
            for (int i = 0; i < 16; ++i) {
                const float z = st[i];
                const float sp2 = fmaxf(z, 0.f) + __builtin_amdgcn_logf(1.0f + __builtin_amdgcn_exp2f(-fabsf(z)));
                const bool valid = !diag || ((i & 3) + 8 * (i >> 2) + 4 * hh < r);
                lom[i] = valid ? -sp2 : 0.f;
                lb[i] = z - sp2;
                csum += lom[i];
            }
            f32x16 suf = MFMA32(tp[0], pack_step(lom, 0), zero16);
            suf = MFMA32(tp[1], pack_step(lom, 1), suf);
            f32x16 w;
#pragma unroll
            for (int i = 0; i < 16; ++i) {
                const bool valid = !diag || ((i & 3) + 8 * (i >> 2) + 4 * hh < r);
                w[i] = valid ? __builtin_amdgcn_exp2f(lb[i] + suf[i] + carry) : 0.f;
            }
            const bf16x8 w0 = pack_step(w, 0), w1 = pack_step(w, 1);
#pragma unroll
            for (int dt = 0; dt < 2; ++dt) { ot[dt] = MFMA32(av[dt][0], w0, ot[dt]); ot[dt] = MFMA32(av[dt][1], w1, ot[dt]); }
            carry += csum + __shfl_xor(csum, 32);
            if (__all(carry < CARRY_STOP)) break;
        }
#pragma unroll
        for (int dt = 0; dt < 2; ++dt)
#pragma unroll
            for (int g = 0; g < 4; ++g) {
                uint2 o; o.x = cvtpk(ot[dt][4 * g], ot[dt][4 * g + 1]); o.y = cvtpk(ot[dt][4 * g + 2], ot[dt][4 * g + 3]);
                *(uint2*)(osb + (size_t)(t0 + r) * DSB + h * HD + 32 * dt + 8 * g + 4 * hh) = o;
            }
    }
}

constexpr int RG_LDS_CST = 0, RG_LDS_HIN = 16384, RG_LDS_P = 18432, RG_LDS_SSQ = 20480;
constexpr int RG_LDS_X = 22528, RG_XP = 1032, RG_LDS_O = 91904;
typedef unsigned u32x2 __attribute__((ext_vector_type(2)));
typedef __attribute__((address_space(3))) float lds_f;
typedef __attribute__((address_space(3))) unsigned char lds_b;
template <int CTRL, int ROWMASK>
__device__ __forceinline__ float dpp_mov(float oob, float x) {
    return __builtin_bit_cast(float, __builtin_amdgcn_update_dpp(__builtin_bit_cast(int, oob), __builtin_bit_cast(int, x), CTRL, ROWMASK, 0xf, false));
}
template <int CTRL, int ROWMASK>
__device__ __forceinline__ void scan_step(float (&av)[16], float (&bv)[16]) {
#pragma unroll
    for (int i = 0; i < 16; ++i) {
        const float ap = dpp_mov<CTRL, ROWMASK>(1.0f, av[i]), bp = dpp_mov<CTRL, ROWMASK>(0.0f, bv[i]);
        bv[i] = __builtin_fmaf(av[i], bp, bv[i]); av[i] *= ap;
    }
}
template <int PASS>
__device__ __forceinline__ void ph_rg(const Params& p, unsigned char* lds_raw) {
    float* lds = (float*)lds_raw;
    unsigned char* ws = p.ws;
    const bf16_t* xrg = (const bf16_t*)(ws + WS_XRG); const bf16_t* gg = (const bf16_t*)(ws + WS_GG); const bf16_t* wfrag = (const bf16_t*)(ws + WS_RGW);
    const bf16_t* osb = (const bf16_t*)(ws + WS_OSB); bf16_t* mix = (bf16_t*)(ws + WS_MIX);
    float* rgP = (float*)(ws + WS_RGP); float* rgH = (float*)(ws + WS_RGH);
    bf16_t* scA = (bf16_t*)(ws + WS_RGSA); bf16_t* scB = (bf16_t*)(ws + WS_RGSB);
    const int tid = phase_tid(), lane = tid & 63, r = lane & 31, hh = lane >> 5, n = __builtin_amdgcn_readfirstlane(tid >> 6);
    __syncthreads();
    if (PASS == 0) for (int e = tid; e < 8 * 2 * 8 * 32; e += NTHR) {
        const int q = e & 31, k = (e >> 5) & 7, h2 = (e >> 8) & 1, nn = e >> 9;
        const int c = 64 * nn + 32 * (q >> 4) + (q & 3) + 8 * ((q >> 2) & 3) + 4 * h2;
        float v;
        if (k < 4) v = p.in[I_CONV_W][k * DRG + c];
        else if (k == 4) v = p.in[I_CONV_B][c];
        else if (k == 5) v = p.in[I_RG_B_A][c];
        else if (k == 6) v = p.in[I_RG_B_X][c];
        else v = 8.0f * LOG2E * log1pf(__expf(-p.in[I_RG_LAMBDA][c]));
        lds[e] = v;
    }
    const unsigned lds0 = (unsigned)(size_t)((lds_b*)lds_raw);
    const unsigned cst_base = lds0 + (unsigned)((n * 2 + hh) * 1024);
    lds_f* hin_l = (lds_f*)(size_t)(lds0 + RG_LDS_HIN + (n * 2 + hh) * 128);
    lds_f* pc_l = (lds_f*)(size_t)(lds0 + RG_LDS_P + (n * 2 + hh) * 128);
    lds_b* xt = (lds_b*)(size_t)(lds0 + RG_LDS_X);
    lds_b* ot = (lds_b*)(size_t)(lds0 + RG_LDS_O);
    f32x16 zero16;
#pragma unroll
    for (int i = 0; i < 16; ++i) zero16[i] = 0.f;
    for (int ch = blockIdx.x; ch < NCHUNK; ch += gridDim.x) {
        const int t0 = ch * CHUNK;
        __syncthreads();
        if (PASS == 0) for (int ci = tid; ci < (CHUNK + 3) * 64; ci += NTHR) {
            const int row = ci >> 6, c16 = ci & 63, tt = t0 - 3 + row;
            u32x4 v = {0u, 0u, 0u, 0u};
            if (tt >= 0) v = *(const u32x4*)(xrg + (size_t)tt * DRG + 8 * c16);
            __attribute__((address_space(3))) u32x2* d = (__attribute__((address_space(3))) u32x2*)(xt + row * RG_XP + 16 * c16);
            d[0] = (u32x2){v.x, v.y}; d[1] = (u32x2){v.z, v.w};
        }
        if (PASS == 1) {
            const int c = 64 * n + lane;
            float h = 0.f;
            int k = 0;
            for (; k + 32 <= ch; k += 32) {
                float pv[32], hv[32];
#pragma unroll
                for (int j = 0; j < 32; ++j) { pv[j] = rgP[(k + j) * DRG + c]; hv[j] = rgH[(k + j) * DRG + c]; }
#pragma unroll
                for (int j = 0; j < 32; ++j) h = pv[j] * h + hv[j];
            }
            for (; k + 8 <= ch; k += 8) {
                float pv[8], hv[8];
#pragma unroll
                for (int j = 0; j < 8; ++j) { pv[j] = rgP[(k + j) * DRG + c]; hv[j] = rgH[(k + j) * DRG + c]; }
#pragma unroll
                for (int j = 0; j < 8; ++j) h = pv[j] * h + hv[j];
            }
            for (; k < ch; ++k) h = rgP[k * DRG + c] * h + rgH[k * DRG + c];
            lds[RG_LDS_HIN / 4 + (n * 2 + ((lane >> 2) & 1)) * 32 + 16 * (lane >> 5) + 4 * ((lane >> 3) & 3) + (lane & 3)] = h;
        } else {
            if (r == 0) {
#pragma unroll
                for (int q = 0; q < 32; ++q) { hin_l[q] = 0.f; pc_l[q] = 1.f; }
            }
        }
        __syncthreads();
#pragma unroll 1
        for (int tl = 0; tl < 2; ++tl) {
            const int tok = t0 + 32 * tl + r;
            unsigned cst_a = cst_base; asm volatile("" : "+v"(cst_a));
            const lds_f* cst = (const lds_f*)(size_t)cst_a;
            float xcv[32]; bf16x8 bx[4];
            if (PASS == 0) {
#pragma unroll
            for (int q = 0; q < 32; ++q) xcv[q] = cst[4 * 32 + q];
#pragma unroll
            for (int k = 0; k < 4; ++k) {
                const lds_b* xr = xt + (32 * tl + r + k) * RG_XP + (64 * n + 4 * hh) * 2;
#pragma unroll
                for (int m = 0; m < 8; ++m) {
                    const u32x2 xw = *(const __attribute__((address_space(3))) u32x2*)(xr + 16 * m);
                    xcv[4 * m + 0] += cst[k * 32 + 4 * m + 0] * bf2f(xw.x & 0xffffu); xcv[4 * m + 1] += cst[k * 32 + 4 * m + 1] * bf2f(xw.x >> 16);
                    xcv[4 * m + 2] += cst[k * 32 + 4 * m + 2] * bf2f(xw.y & 0xffffu); xcv[4 * m + 3] += cst[k * 32 + 4 * m + 3] * bf2f(xw.y >> 16);
                }
                __builtin_amdgcn_sched_barrier(0);
            }
#pragma unroll
            for (int s = 0; s < 4; ++s) {
                u32x4 pk; pk.x = cvtpk(xcv[8 * s], xcv[8 * s + 1]); pk.y = cvtpk(xcv[8 * s + 2], xcv[8 * s + 3]); pk.z = cvtpk(xcv[8 * s + 4], xcv[8 * s + 5]); pk.w = cvtpk(xcv[8 * s + 6], xcv[8 * s + 7]);
                bx[s] = __builtin_bit_cast(bf16x8, pk);
            }
            }
            float ss = 0.f;
            const bf16_t* wb = wfrag + ((size_t)n * 16 * 64 + lane) * 8; asm volatile("" : "+v"(wb));
#pragma unroll
            for (int jt = 0; jt < 2; ++jt) {
                float av[16], bv[16];
                const size_t sco = ((((size_t)(2 * ch + tl) * 8 + n) * 2 + jt) * 64 + lane) * 16;
                if (PASS == 0) {
#pragma unroll
                for (int g = 0; g < 2; ++g) {
                    f32x16 acc = zero16;
#pragma unroll
                    for (int s = 0; s < 4; ++s) {
                        const bf16x8 aw = *(const __attribute__((address_space(1))) bf16x8*)(wb + (((g * 2 + jt) * 4 + s) * 64) * 8);
                        acc = MFMA32(aw, bx[s], acc);
                    }
#pragma unroll
                    for (int i = 0; i < 16; ++i) {
                        const int q = 16 * jt + i;
                        const float pre = acc[i] + cst[(5 + g) * 32 + q];
                        const float sg = 1.0f / (1.0f + __builtin_amdgcn_exp2f(-LOG2E * pre));
                        if (g == 0) av[i] = __builtin_amdgcn_exp2f(-sg * cst[7 * 32 + q]);
                        else bv[i] = __builtin_amdgcn_sqrtf(fmaxf(__builtin_fmaf(-av[i], av[i], 1.0f), 0.f)) * (sg * xcv[q]);
                    }
                    __builtin_amdgcn_sched_barrier(0);
                }
                scan_step<0x111, 0xf>(av, bv); scan_step<0x112, 0xf>(av, bv); scan_step<0x114, 0xf>(av, bv); scan_step<0x118, 0xf>(av, bv);
                scan_step<0x142, 0xa>(av, bv);
                u32x4 sa0, sa1, sb0, sb1;
                sa0.x = cvtpk(av[0], av[1]); sa0.y = cvtpk(av[2], av[3]); sa0.z = cvtpk(av[4], av[5]); sa0.w = cvtpk(av[6], av[7]); sa1.x = cvtpk(av[8], av[9]); sa1.y = cvtpk(av[10], av[11]); sa1.z = cvtpk(av[12], av[13]); sa1.w = cvtpk(av[14], av[15]);
                sb0.x = cvtpk(bv[0], bv[1]); sb0.y = cvtpk(bv[2], bv[3]); sb0.z = cvtpk(bv[4], bv[5]); sb0.w = cvtpk(bv[6], bv[7]); sb1.x = cvtpk(bv[8], bv[9]); sb1.y = cvtpk(bv[10], bv[11]); sb1.z = cvtpk(bv[12], bv[13]); sb1.w = cvtpk(bv[14], bv[15]);
                *(u32x4*)(scA + sco) = sa0; *(u32x4*)(scA + sco + 8) = sa1; *(u32x4*)(scB + sco) = sb0; *(u32x4*)(scB + sco + 8) = sb1;
                } else {
                    const u32x4 sa0 = *(const u32x4*)(scA + sco), sa1 = *(const u32x4*)(scA + sco + 8), sb0 = *(const u32x4*)(scB + sco), sb1 = *(const u32x4*)(scB + sco + 8);
                    const unsigned wa[8] = {sa0.x, sa0.y, sa0.z, sa0.w, sa1.x, sa1.y, sa1.z, sa1.w}, wbb[8] = {sb0.x, sb0.y, sb0.z, sb0.w, sb1.x, sb1.y, sb1.z, sb1.w};
#pragma unroll
                    for (int k = 0; k < 8; ++k) { av[2 * k] = bf2f(wa[k] & 0xffffu); av[2 * k + 1] = bf2f(wa[k] >> 16); bv[2 * k] = bf2f(wbb[k] & 0xffffu); bv[2 * k + 1] = bf2f(wbb[k] >> 16); }
                }
                __builtin_amdgcn_sched_barrier(0);
#pragma unroll
                for (int i = 0; i < 16; ++i) {
                    const int q = 16 * jt + i;
                    const float h = __builtin_fmaf(av[i], hin_l[q], bv[i]);
                    if (r == 31) { hin_l[q] = h; if (PASS == 0) pc_l[q] *= av[i]; }
                    bv[i] = h;
                }
                if (PASS == 1) {
#pragma unroll
                    for (int g4 = 0; g4 < 4; ++g4) {
                        const int m = 4 * jt + g4;
                        const uint2 gw = *(const uint2*)(gg + ((((size_t)(tok >> 5) * 8 + n) * 8 + m) * 64 + lane) * 4);
                        const float o0 = bv[4 * g4] * bf2f(gw.x & 0xffffu), o1 = bv[4 * g4 + 1] * bf2f(gw.x >> 16), o2 = bv[4 * g4 + 2] * bf2f(gw.y & 0xffffu), o3 = bv[4 * g4 + 3] * bf2f(gw.y >> 16);
                        ss += (o0 * o0 + o1 * o1) + (o2 * o2 + o3 * o3);
                        *(__attribute__((address_space(3))) u32x2*)(ot + (32 * tl + r) * RG_XP + (64 * n + 8 * m + 4 * hh) * 2) = (u32x2){cvtpk(o0, o1), cvtpk(o2, o3)};
                    }
                }
                __builtin_amdgcn_sched_barrier(0);
            }
            if (PASS == 1) { ss += __shfl_xor(ss, 32); if (hh == 0) lds[RG_LDS_SSQ / 4 + (tl * 8 + n) * 32 + r] = ss; }
        }
        if (PASS == 0) {
            if (r == 0) {
#pragma unroll
                for (int m = 0; m < 8; ++m) {
                    const int c = 64 * n + 8 * m + 4 * hh;
                    *(f32x4*)(rgP + (size_t)ch * DRG + c) = (f32x4){pc_l[4 * m], pc_l[4 * m + 1], pc_l[4 * m + 2], pc_l[4 * m + 3]};
                    *(f32x4*)(rgH + (size_t)ch * DRG + c) = (f32x4){hin_l[4 * m], hin_l[4 * m + 1], hin_l[4 * m + 2], hin_l[4 * m + 3]};
                }
            }
        } else {
            __syncthreads();
            for (int j = 0; j < 8; ++j) {
                const int tr = 8 * n + j, tok = t0 + tr;
                float tot = 0.f;
#pragma unroll
                for (int w = 0; w < 8; ++w) tot += lds[RG_LDS_SSQ / 4 + ((tr >> 5) * 8 + w) * 32 + (tr & 31)];
                const float rn = rsqrtf(tot * (1.0f / DRG) + EPS);
                const __attribute__((address_space(3))) u32x2* op = (const __attribute__((address_space(3))) u32x2*)(ot + tr * RG_XP + 16 * lane);
                const u32x2 w0 = op[0], w1 = op[1];
                u32x4 o2; o2.x = cvtpk(bf2f(w0.x & 0xffffu) * rn, bf2f(w0.x >> 16) * rn); o2.y = cvtpk(bf2f(w0.y & 0xffffu) * rn, bf2f(w0.y >> 16) * rn);
                o2.z = cvtpk(bf2f(w1.x & 0xffffu) * rn, bf2f(w1.x >> 16) * rn); o2.w = cvtpk(bf2f(w1.y & 0xffffu) * rn, bf2f(w1.y >> 16) * rn);
                *((u32x4*)(mix + (size_t)tok * D + DSB) + lane) = o2;
                const u32x4 a = *((const u32x4*)(osb + (size_t)tok * DSB) + lane);
                float f[8] = {bf2f(a.x & 0xffffu), bf2f(a.x >> 16), bf2f(a.y & 0xffffu), bf2f(a.y >> 16), bf2f(a.z & 0xffffu), bf2f(a.z >> 16), bf2f(a.w & 0xffffu), bf2f(a.w >> 16)};
                float sa = 0.f;
#pragma unroll
                for (int k = 0; k < 8; ++k) sa += f[k] * f[k];
                sa = wave_sum(sa);
                const float ra = rsqrtf(sa * (1.0f / DSB) + EPS);
                u32x4 o; o.x = cvtpk(f[0] * ra, f[1] * ra); o.y = cvtpk(f[2] * ra, f[3] * ra); o.z = cvtpk(f[4] * ra, f[5] * ra); o.w = cvtpk(f[6] * ra, f[7] * ra);
                *((u32x4*)(mix + (size_t)tok * D) + lane) = o;
            }
        }
    }
}

__device__ __forceinline__ float kmax(float a, float b) { float r; asm("v_max_f32 %0, %1, %2" : "=v"(r) : "v"(a), "v"(b)); return r; }
__device__ __forceinline__ float kmin(float a, float b) { float r; asm("v_min_f32 %0, %1, %2" : "=v"(r) : "v"(a), "v"(b)); return r; }
__device__ __forceinline__ float key_tag(float f, unsigned keep, unsigned tag) { return __builtin_bit_cast(float, (__builtin_bit_cast(unsigned, f) & keep) | tag); }
#define TOPK_CE(a, b) do { const float hi_ = kmax(a, b), lo_ = kmin(a, b); a = hi_; b = lo_; } while (0)
__device__ __forceinline__ void sort16_desc(float (&v)[16]) { TOPK_CE(v[0], v[1]); TOPK_CE(v[2], v[3]); TOPK_CE(v[0], v[2]); TOPK_CE(v[1], v[3]); TOPK_CE(v[1], v[2]); TOPK_CE(v[4], v[5]); TOPK_CE(v[6], v[7]); TOPK_CE(v[4], v[6]); TOPK_CE(v[5], v[7]); TOPK_CE(v[5], v[6]); TOPK_CE(v[0], v[4]); TOPK_CE(v[2], v[6]); TOPK_CE(v[2], v[4]); TOPK_CE(v[1], v[5]); TOPK_CE(v[3], v[7]); TOPK_CE(v[3], v[5]); TOPK_CE(v[1], v[2]); TOPK_CE(v[3], v[4]); TOPK_CE(v[5], v[6]); TOPK_CE(v[8], v[9]); TOPK_CE(v[10], v[11]); TOPK_CE(v[8], v[10]); TOPK_CE(v[9], v[11]); TOPK_CE(v[9], v[10]); TOPK_CE(v[12], v[13]); TOPK_CE(v[14], v[15]); TOPK_CE(v[12], v[14]); TOPK_CE(v[13], v[15]); TOPK_CE(v[13], v[14]); TOPK_CE(v[8], v[12]); TOPK_CE(v[10], v[14]); TOPK_CE(v[10], v[12]); TOPK_CE(v[9], v[13]); TOPK_CE(v[11], v[15]); TOPK_CE(v[11], v[13]); TOPK_CE(v[9], v[10]); TOPK_CE(v[11], v[12]); TOPK_CE(v[13], v[14]); TOPK_CE(v[0], v[8]); TOPK_CE(v[4], v[12]); TOPK_CE(v[4], v[8]); TOPK_CE(v[2], v[10]); TOPK_CE(v[6], v[14]); TOPK_CE(v[6], v[10]); TOPK_CE(v[2], v[4]); TOPK_CE(v[6], v[8]); TOPK_CE(v[10], v[12]); TOPK_CE(v[1], v[9]); TOPK_CE(v[5], v[13]); TOPK_CE(v[5], v[9]); TOPK_CE(v[3], v[11]); TOPK_CE(v[7], v[15]); TOPK_CE(v[7], v[11]); TOPK_CE(v[3], v[5]); TOPK_CE(v[7], v[9]); TOPK_CE(v[11], v[13]); TOPK_CE(v[1], v[2]); TOPK_CE(v[3], v[4]); TOPK_CE(v[5], v[6]); TOPK_CE(v[7], v[8]); TOPK_CE(v[9], v[10]); TOPK_CE(v[11], v[12]); TOPK_CE(v[13], v[14]); }
__device__ __forceinline__ void merge16_desc(float (&a)[16], const float (&b)[16]) {
#pragma unroll
    for (int i = 0; i < 16; ++i) a[i] = kmax(a[i], b[15 - i]);
#pragma unroll
    for (int d = 8; d >= 1; d >>= 1)
#pragma unroll
        for (int i = 0; i < 16; ++i) if ((i & d) == 0) TOPK_CE(a[i], a[i + d]);
}
__device__ __forceinline__ void ph_topk(const Params& p, int* lds) {
    unsigned char* ws = p.ws;
    const bf16_t* qp = (const bf16_t*)(ws + WS_B); const bf16_t* subk = (const bf16_t*)(ws + WS_SUBK);
    int* seli = (int*)(ws + WS_SELI); float* selg = (float*)(ws + WS_SELG);
    const float* ssq = (const float*)(ws + WS_SSQ); float* rstd2 = (float*)(ws + WS_RSTD2);
    const int tid = phase_tid(), lane = tid & 63, r = lane & 31, hh = lane >> 5, hx = 4 * hh;
    const int gwave = (blockIdx.x * blockDim.x + tid) >> 6, nwave = (gridDim.x * blockDim.x) >> 6;
    constexpr int SK_OFF = 65536, SK_PITCH = 272;
    typedef __attribute__((address_space(3))) unsigned char lds_b;
    lds_b* skl = (lds_b*)lds + SK_OFF;
    const int w = tid >> 6;
    pg8::StaticOrder so; so.init(S, NQ, (int)gridDim.x, (int)blockIdx.x);
    pg8::Unit gu;
    for (int ui = 0; so.next(ui, gu); ++ui) {
        const int h = gu.pn, t0 = gu.pm * 256 + 32 * w, t = t0 + r;
        u32x4 skv[8]; bf16x8 bq[2][8];
#pragma unroll
        for (int j = 0; j < 8; ++j) {
            const int ci = tid + NTHR * j, row = ci >> 4, c16 = ci & 15;
            skv[j] = *(const u32x4*)(subk + ((size_t)h * 256 + row) * PHALF + 8 * c16);
        }
#pragma unroll
        for (int pp = 0; pp < 2; ++pp)
#pragma unroll
            for (int s = 0; s < 8; ++s) bq[pp][s] = *(const bf16x8*)(qp + ((((size_t)((t0 >> 5) * 8 + h) * 2 + pp) * 8 + s) * 64 + lane) * 8);
        __builtin_amdgcn_sched_barrier(0);
        __syncthreads();
#pragma unroll
        for (int j = 0; j < 8; ++j) {
            const int ci = tid + NTHR * j, row = ci >> 4, c16 = ci & 15;
            *(__attribute__((address_space(3))) u32x4*)(skl + row * SK_PITCH + 16 * c16) = skv[j];
        }
        __syncthreads();
        float tk[2][16];
#pragma unroll
        for (int pp = 0; pp < 2; ++pp) {
            f32x16 acc[4];
#pragma unroll
            for (int T = 0; T < 4; ++T)
#pragma unroll
                for (int i = 0; i < 16; ++i) acc[T][i] = 0.f;
            const lds_b* krow = skl + (pp * PNK + r) * SK_PITCH + 16 * hh;
#pragma unroll
            for (int s = 0; s < 8; ++s) {
                const bf16x8 b = bq[pp][s];
#pragma unroll
                for (int T = 0; T < 4; ++T) {
                    const bf16x8 a = *(const __attribute__((address_space(3))) bf16x8*)(krow + (32 * T) * SK_PITCH + 32 * s);
                    acc[T] = __builtin_amdgcn_mfma_f32_32x32x16_bf16(a, b, acc[T], 0, 0, 0);
                }
            }
            float kq[4][16];
#pragma unroll
            for (int T = 0; T < 4; ++T) {
#pragma unroll
                for (int i = 0; i < 16; ++i) {
                    const int nb = 32 * T + (i & 3) + 8 * (i >> 2);
                    kq[T][i] = key_tag(acc[T][i], ~127u, (unsigned)(127 - nb));
                }
                sort16_desc(kq[T]);
            }
            merge16_desc(kq[0], kq[1]); merge16_desc(kq[2], kq[3]); merge16_desc(kq[0], kq[2]);
            float m[16], po[16];
#pragma unroll
            for (int i = 0; i < 16; ++i) { m[i] = __builtin_bit_cast(float, __builtin_bit_cast(int, kq[0][i]) ^ hx); po[i] = __shfl_xor(m[i], 32); }
            merge16_desc(m, po);
#pragma unroll
            for (int i = 0; i < 16; ++i) tk[pp][i] = m[i];
        }
#pragma unroll
        for (int i = 0; i < 16; ++i) { lds[i * NTHR + tid] = __builtin_bit_cast(int, tk[0][i]); lds[(16 + i) * NTHR + tid] = __builtin_bit_cast(int, tk[1][i]); }
        const float (&v0)[16] = tk[0]; const float (&v1)[16] = tk[1];
#define CKEY(a, b) key_tag(v0[a] + v1[b], ~255u, (unsigned)(255 - ((a) * 16 + (b))))
        const float NEGK = __builtin_bit_cast(float, 0xff800000u);
        float bk[16], l1[16], ga[16], gb[16];
#pragma unroll
        for (int b = 0; b < 16; ++b) bk[b] = CKEY(0, b);
#pragma unroll
        for (int b = 0; b < 16; ++b) l1[b] = b < 8 ? CKEY(1, b) : NEGK;
        ga[0] = CKEY(2, 0); ga[1] = CKEY(2, 1); ga[2] = CKEY(2, 2); ga[3] = CKEY(2, 3); ga[4] = CKEY(2, 4);
        ga[5] = CKEY(3, 0); ga[6] = CKEY(3, 1); ga[7] = CKEY(3, 2); ga[8] = CKEY(3, 3);
        ga[9] = CKEY(4, 0); ga[10] = CKEY(4, 1); ga[11] = CKEY(4, 2); ga[12] = CKEY(5, 0); ga[13] = CKEY(5, 1); ga[14] = NEGK; ga[15] = NEGK;
        gb[0] = CKEY(6, 0); gb[1] = CKEY(6, 1); gb[2] = CKEY(7, 0); gb[3] = CKEY(7, 1);
#pragma unroll
        for (int a = 8; a < 16; ++a) gb[a - 4] = CKEY(a, 0);
        gb[12] = NEGK; gb[13] = NEGK; gb[14] = NEGK; gb[15] = NEGK;
#undef CKEY
        sort16_desc(ga); sort16_desc(gb);
        merge16_desc(bk, l1); merge16_desc(ga, gb); merge16_desc(bk, ga);
        float ssum = 0.f;
#pragma unroll
        for (int i = 0; i < 4; ++i) { const f32x4 q4 = *(const f32x4*)(ssq + (size_t)t * 16 + 4 * i); ssum += (q4.x + q4.y) + (q4.z + q4.w); }
        const float rs = rsqrtf(ssum * (1.0f / D) + EPS);
        float e[16], sum = 0.f; const float mx = bk[0];
#pragma unroll
        for (int i = 0; i < 16; ++i) { e[i] = __expf((bk[i] - mx) * rs); sum += e[i]; }
        const float inv = 1.0f / sum;
        int eidx[16];
#pragma unroll
        for (int i = 0; i < 16; ++i) {
            const int code = 255 - (__builtin_bit_cast(int, bk[i]) & 255), a = code >> 4, b = code & 15;
            const int i1 = 127 - (lds[a * NTHR + tid] & 127), i2 = 127 - (lds[(16 + b) * NTHR + tid] & 127);
            eidx[i] = i1 * PNK + i2; e[i] *= inv;
        }
        if (hh == 0) {
            int4* o = (int4*)(seli + (size_t)t * 128 + h * 16);
#pragma unroll
            for (int i = 0; i < 4; ++i) o[i] = make_int4(eidx[4 * i], eidx[4 * i + 1], eidx[4 * i + 2], eidx[4 * i + 3]);
            if (h == 0) rstd2[t] = rs;
        } else {
            f32x4* o = (f32x4*)(selg + (size_t)t * 128 + h * 16);
#pragma unroll
            for (int i = 0; i < 4; ++i) o[i] = (f32x4){e[4 * i], e[4 * i + 1], e[4 * i + 2], e[4 * i + 3]};
        }
    }
}

typedef __bf16 bf16x2_t __attribute__((ext_vector_type(2)));
typedef float f32x2 __attribute__((ext_vector_type(2)));
template <int NV, int XS0, int XS1, int XS2>
__device__ __forceinline__ void reduce_over8(float (&v)[NV], int sel) {
    { const bool up = sel & 1;
#pragma unroll
      for (int i = 0; i < NV / 2; ++i) { const float a = v[2 * i], b = v[2 * i + 1]; v[i] = (up ? b : a) + __shfl_xor(up ? a : b, XS0); } }
    { const bool up = (sel >> 1) & 1;
#pragma unroll
      for (int i = 0; i < NV / 4; ++i) { const float a = v[2 * i], b = v[2 * i + 1]; v[i] = (up ? b : a) + __shfl_xor(up ? a : b, XS1); } }
    { const bool up = (sel >> 2) & 1;
#pragma unroll
      for (int i = 0; i < NV / 8; ++i) { const float a = v[2 * i], b = v[2 * i + 1]; v[i] = (up ? b : a) + __shfl_xor(up ? a : b, XS2); } }
}
__device__ __forceinline__ void peer_load_idx(const unsigned char* ws, int t, int rsl, int (&ei)[16]) {
    const unsigned off = (unsigned)WS_SELI + ((unsigned)t * 128u + 16u * (unsigned)rsl) * 4u;
#pragma unroll
    for (int j = 0; j < 4; ++j) { const int4 v = *(const int4*)(ws + (off + 16u * j)); ei[4 * j] = v.x; ei[4 * j + 1] = v.y; ei[4 * j + 2] = v.z; ei[4 * j + 3] = v.w; }
}
template <int PASS>
__device__ __forceinline__ void peer_load_rows(const unsigned char* ws, int t, int sl, int rsl, int c, const int (&ei)[16], u32x4 (&row)[16], u32x4 (&aux)[4]) {
    const unsigned tab = (unsigned)(PASS == 0 ? WS_UB : WS_VB) + (unsigned)sl * (unsigned)(NEXP * 128) + 16u * (unsigned)c;
#pragma unroll
    for (int i = 0; i < 16; ++i) row[i] = *(const u32x4*)(ws + (tab + (unsigned)ei[i] * 128u));
    const unsigned xo = (unsigned)WS_X1Q + (unsigned)t * (unsigned)D + 256u * sl + 32u * c;
    aux[0] = *(const u32x4*)(ws + xo); aux[1] = *(const u32x4*)(ws + (xo + 16u));
    aux[2].x = *(const unsigned*)(ws + ((unsigned)WS_XSC + ((unsigned)t * 32u + 8u * sl + c) * 4u));
}
constexpr int PEER_IMG_PITCH = 136, PEER_IMG_BYTES = 128 * PEER_IMG_PITCH;
template <int PASS  >
__device__ __forceinline__ void peer_compute(const Params& p, unsigned char* lds, int lane_w, int t, int sl, int rsl, int c, const u32x4 (&row)[16], const u32x4 (&aux)[4]) {
    unsigned char* ws = p.ws;
    if (PASS == 0) {
        const u32x4 x0 = aux[0], x1_ = aux[1]; const unsigned xl[4] = {x0.x, x0.y, x0.z, x0.w}, xh[4] = {x1_.x, x1_.y, x1_.z, x1_.w};
        const unsigned xsu = aux[2].x; const float xs = u2f(xsu);
        float pd[16];
#pragma unroll
        for (int i = 0; i < 16; ++i) {
            const u32x4 rw = row[i]; const unsigned w4[4] = {rw.x, rw.y, rw.z, rw.w};
            int al = 0, ah = 0;
#pragma unroll
            for (int j = 0; j < 4; ++j) { al = __builtin_amdgcn_sdot8((int)w4[j], (int)xl[j], al, false); ah = __builtin_amdgcn_sdot8((int)w4[j], (int)xh[j], ah, false); }
            pd[i] = (float)(16 * ah + al) * xs;
        }
        reduce_over8<16, 1, 2, 4>(pd, c);
        const unsigned po = (unsigned)WS_PD + (((unsigned)sl * S + (unsigned)t) * 128u + 16u * rsl + c) * 4u;
        *(float*)(ws + po) = pd[0]; *(float*)(ws + (po + 32u)) = pd[1];
    }
}
template <int PASS>
__device__ __forceinline__ void peer_stream(const Params& p, unsigned char* lds, int lane_w, int sl, int t0, int dt, int n) {
    const unsigned char* ws = p.ws;
    const int lane = lane_w & 63, rsl = lane >> 3, c = lane & 7;
    int eiA[16], eiB[16]; u32x4 rowA[16], rowB[16], auxA[4], auxB[4];
    if (n <= 0) return;
    peer_load_idx(ws, t0, rsl, eiA);
    peer_load_rows<PASS>(ws, t0, sl, rsl, c, eiA, rowA, auxA);
    if (n > 1) peer_load_idx(ws, t0 + dt, rsl, eiB);
    for (int i = 0; i < n; i += 2) {
        const int t = t0 + i * dt;
        if (i + 1 < n) peer_load_rows<PASS>(ws, t + dt, sl, rsl, c, eiB, rowB, auxB);
        if (i + 2 < n) peer_load_idx(ws, t + 2 * dt, rsl, eiA);
        peer_compute<PASS>(p, lds, lane_w, t, sl, rsl, c, rowA, auxA);
        if (i + 1 < n) {
            if (i + 2 < n) peer_load_rows<PASS>(ws, t + 2 * dt, sl, rsl, c, eiA, rowA, auxA);
            if (i + 3 < n) peer_load_idx(ws, t + 3 * dt, rsl, eiB);
            peer_compute<PASS>(p, lds, lane_w, t + dt, sl, rsl, c, rowB, auxB);
        }
    }
}
__device__ __forceinline__ void peerv_load_idx(const unsigned char* ws, int t, int hf, int rsl, int (&ei)[8]) {
    const unsigned off = (unsigned)WS_SELI + ((unsigned)t * 128u + 16u * (unsigned)rsl + 8u * (unsigned)hf) * 4u;
    const int4 v0 = *(const int4*)(ws + off), v1 = *(const int4*)(ws + (off + 16u));
    ei[0] = v0.x; ei[1] = v0.y; ei[2] = v0.z; ei[3] = v0.w; ei[4] = v1.x; ei[5] = v1.y; ei[6] = v1.z; ei[7] = v1.w;
}
__device__ __forceinline__ void peerv_load_rows(const unsigned char* ws, int sl, int c, const int (&ei)[8], u32x4 (&row)[8]) {
    const unsigned tab = (unsigned)WS_VB + (unsigned)sl * (unsigned)(NEXP * 128) + 16u * (unsigned)c;
#pragma unroll
    for (int i = 0; i < 8; ++i) row[i] = *(const u32x4*)(ws + (tab + (unsigned)ei[i] * 128u));
}
struct PeerVAux { u32x4 cp; unsigned cs; unsigned xo[4]; };
__device__ __forceinline__ void peerv_load_aux(const unsigned char* ws, int t, int sl, int lane, PeerVAux& a) {
    a.cp = *(const u32x4*)(ws + ((unsigned)WS_CBUF + (unsigned)t * 128u + 16u * (unsigned)(lane & 7)));
    a.cs = *(const unsigned*)(ws + ((unsigned)WS_CSC + (unsigned)t * 4u));
    const unsigned xo = (unsigned)WS_A + ((unsigned)t * (unsigned)D + 256u * sl + (unsigned)lane) * 2u;
    a.xo[0] = *(const bf16_t*)(ws + xo); a.xo[1] = *(const bf16_t*)(ws + (xo + 128u)); a.xo[2] = *(const bf16_t*)(ws + (xo + 256u)); a.xo[3] = *(const bf16_t*)(ws + (xo + 384u));
}
template <int HF>
__device__ __forceinline__ void peerv_half(lds_b* img, int lane, const u32x4 (&row)[8], const PeerVAux& a, int (&acc)[4]) {
    const int rsl = lane >> 3, c = lane & 7;
#pragma unroll
    for (int i = 0; i < 8; ++i) {
        const u32x4 rw = row[i];
        __attribute__((address_space(3))) u32x2* d = (__attribute__((address_space(3))) u32x2*)(img + (16 * rsl + i) * PEER_IMG_PITCH + 16 * c);
        d[0] = (u32x2){rw.x, rw.y}; d[1] = (u32x2){rw.z, rw.w};
    }
    const unsigned cpl = HF == 0 ? a.cp.x : a.cp.y, cph = HF == 0 ? a.cp.z : a.cp.w;
    asm volatile("s_waitcnt lgkmcnt(0)" ::: "memory");
    const unsigned ra = (unsigned)(size_t)img + (unsigned)((lane & 15) * PEER_IMG_PITCH + 8 * (lane >> 4));
#define PEER_TR4(R0, R1, R2, R3, RS) asm volatile("ds_read_b64_tr_b4 %0, %4 offset:%5\n\tds_read_b64_tr_b4 %1, %4 offset:%6\n\tds_read_b64_tr_b4 %2, %4 offset:%7\n\tds_read_b64_tr_b4 %3, %4 offset:%8" \
            : "=&v"(R0), "=&v"(R1), "=&v"(R2), "=&v"(R3) : "v"(ra), "i"((RS) * 16 * PEER_IMG_PITCH), "i"((RS) * 16 * PEER_IMG_PITCH + 32), "i"((RS) * 16 * PEER_IMG_PITCH + 64), "i"((RS) * 16 * PEER_IMG_PITCH + 96) : "memory")
#define PEER_USE4(R0, R1, R2, R3, RS, WAITSTR) do { \
            asm volatile(WAITSTR : "+v"(R0), "+v"(R1), "+v"(R2), "+v"(R3) :: "memory"); \
            const int cl_ = __builtin_amdgcn_readlane((int)cpl, RS), ch_ = __builtin_amdgcn_readlane((int)cph, RS); \
            const unsigned lo4_[4] = {R0.x, R1.x, R2.x, R3.x}; \
            _Pragma("unroll") for (int tcg = 0; tcg < 4; ++tcg) acc[tcg] += 16 * __builtin_amdgcn_sdot8((int)lo4_[tcg], ch_, 0, false) + __builtin_amdgcn_sdot8((int)lo4_[tcg], cl_, 0, false); } while (0)
    {
        u32x2 a0, a1, a2, a3, b0, b1, b2, b3;
        PEER_TR4(a0, a1, a2, a3, 0);
        PEER_TR4(b0, b1, b2, b3, 1); PEER_USE4(a0, a1, a2, a3, 0, "s_waitcnt lgkmcnt(4)");
        PEER_TR4(a0, a1, a2, a3, 2); PEER_USE4(b0, b1, b2, b3, 1, "s_waitcnt lgkmcnt(4)");
        PEER_TR4(b0, b1, b2, b3, 3); PEER_USE4(a0, a1, a2, a3, 2, "s_waitcnt lgkmcnt(4)");
        PEER_TR4(a0, a1, a2, a3, 4); PEER_USE4(b0, b1, b2, b3, 3, "s_waitcnt lgkmcnt(4)");
        PEER_TR4(b0, b1, b2, b3, 5); PEER_USE4(a0, a1, a2, a3, 4, "s_waitcnt lgkmcnt(4)");
        PEER_TR4(a0, a1, a2, a3, 6); PEER_USE4(b0, b1, b2, b3, 5, "s_waitcnt lgkmcnt(4)");
        PEER_TR4(b0, b1, b2, b3, 7); PEER_USE4(a0, a1, a2, a3, 6, "s_waitcnt lgkmcnt(4)");
        PEER_USE4(b0, b1, b2, b3, 7, "s_waitcnt lgkmcnt(0)");
    }
#undef PEER_TR4
#undef PEER_USE4
}
__device__ __forceinline__ void peerv_stream(const Params& p, unsigned char* lds, int tid_, int sl, int t0, int dt, int n) {
    const unsigned char* ws = p.ws;
    const int lane = tid_ & 63, rsl = lane >> 3, c = lane & 7;
    lds_b* img = (lds_b*)lds + (tid_ >> 6) * PEER_IMG_BYTES;
    for (int e = lane; e < 64 * (PEER_IMG_PITCH / 8); e += 64) {
        const int zr = e / (PEER_IMG_PITCH / 8), zc = e % (PEER_IMG_PITCH / 8);
        *(__attribute__((address_space(3))) u32x2*)(img + (16 * (zr >> 3) + 8 + (zr & 7)) * PEER_IMG_PITCH + 8 * zc) = (u32x2){0u, 0u};
    }
    if (n <= 0) return;
    int ei0[8], ei1[8]; u32x4 rowA[8], rowB[8]; PeerVAux ax, axn;
    peerv_load_idx(ws, t0, 0, rsl, ei0);
    peerv_load_rows(ws, sl, c, ei0, rowA); peerv_load_aux(ws, t0, sl, lane, ax);
    peerv_load_idx(ws, t0, 1, rsl, ei1);
    for (int i = 0; i < n; ++i) {
        const int t = t0 + i * dt; const bool more = i + 1 < n;
        int acc[4] = {0, 0, 0, 0};
        peerv_load_rows(ws, sl, c, ei1, rowB);
        if (more) peerv_load_idx(ws, t + dt, 0, rsl, ei0);
        peerv_half<0>(img, lane, rowA, ax, acc);
        if (more) { peerv_load_rows(ws, sl, c, ei0, rowA); peerv_load_aux(ws, t + dt, sl, lane, axn); peerv_load_idx(ws, t + dt, 1, rsl, ei1); }
        peerv_half<1>(img, lane, rowB, ax, acc);
        const float cs = u2f(ax.cs);
#pragma unroll
        for (int tcg = 0; tcg < 4; ++tcg) {
            const unsigned oo = ((unsigned)t * (unsigned)D + 256u * sl + 64u * tcg + (unsigned)lane) * 4u;
            *(float*)((unsigned char*)p.out + oo) = bf2f(ax.xo[tcg]) + (float)acc[tcg] * cs;
        }
        if (more) ax = axn;
    }
}
template <int PASS>
__device__ __forceinline__ void ph_peer(const Params& p, unsigned char* lds) {
    const int tid_ = phase_tid();
    const int lane = tid_ & 63, w = tid_ >> 6, b = blockIdx.x, G = gridDim.x;
    if ((G & 7) == 0) {
        const int g = b & 7, nsw = (G >> 3) * 2 * (NTHR / 64), t0 = ((g >> 2) * (G >> 3) + (b >> 3)) * (NTHR / 64) + w;
        if (PASS == 0) peer_stream<0>(p, lds, tid_, g & 3, t0, nsw, t0 < S ? (S - 1 - t0) / nsw + 1 : 0);
        else peerv_stream(p, lds, tid_, g & 3, t0, nsw, t0 < S ? (S - 1 - t0) / nsw + 1 : 0);
    } else {
        const int nw = G * (NTHR / 64), it0 = b * (NTHR / 64) + w;
        for (int it = it0; it < S * 4; it += nw) { if (PASS == 0) peer_stream<0>(p, lds, tid_, it & 3, it >> 2, 0, 1); else peerv_stream(p, lds, tid_, it & 3, it >> 2, 0, 1); }
    }
}
__device__ __forceinline__ void ph_peer_combine(const Params& p) {
    unsigned char* ws = p.ws;
    const int* seli = (const int*)(ws + WS_SELI); const float* selg = (const float*)(ws + WS_SELG); const float* rstd2 = (const float*)(ws + WS_RSTD2);
    const float2* uvsc = (const float2*)(ws + WS_USC);
    const float* pd = (const float*)(ws + WS_PD);
    unsigned* cpl = (unsigned*)(ws + WS_CBUF); float* csc = (float*)(ws + WS_CSC);
    const int tid_ = phase_tid(), lane = tid_ & 63, gwave = (blockIdx.x * blockDim.x + tid_) >> 6, nwave = (gridDim.x * blockDim.x) >> 6;
    constexpr int TT = 4;
    for (int tb = gwave; tb < S; tb += TT * nwave) {
        float dsum[TT][2], sg[TT][2], rsd[TT]; int ei[TT][2];
#pragma unroll
        for (int k = 0; k < TT; ++k) {
            const int t = min(tb + k * nwave, S - 1);
#pragma unroll
            for (int hf = 0; hf < 2; ++hf) {
                const int e = t * 128 + 64 * hf + lane;
                ei[k][hf] = seli[e]; sg[k][hf] = selg[e];
                float d = 0.f;
#pragma unroll
                for (int g = 0; g < 4; ++g) d += pd[(size_t)g * S * 128 + e];
                dsum[k][hf] = d;
            }
            rsd[k] = rstd2[t];
        }
        float2 sc2[TT][2];
#pragma unroll
        for (int k = 0; k < TT; ++k)
#pragma unroll
            for (int hf = 0; hf < 2; ++hf) sc2[k][hf] = uvsc[ei[k][hf]];
#pragma unroll
        for (int k = 0; k < TT; ++k) {
            const int t = tb + k * nwave;
            if (t >= S) break;
            float cf[2];
#pragma unroll
            for (int hf = 0; hf < 2; ++hf) cf[hf] = sg[k][hf] * gelu_tanh(dsum[k][hf] * sc2[k][hf].x * rsd[k]) * sc2[k][hf].y;
            float m = fmaxf(fabsf(cf[0]), fabsf(cf[1]));
#pragma unroll
            for (int o = 1; o < 64; o <<= 1) m = fmaxf(m, __shfl_xor(m, o));
            const float inv = m > 0.f ? 119.0f / m : 0.f;
#pragma unroll
            for (int hf = 0; hf < 2; ++hf) {
                const int q = __float2int_rn(cf[hf] * inv);
                unsigned dl = (unsigned)(q & 15) << (4 * (lane & 7)), dh = (unsigned)(((q + 8) >> 4) & 15) << (4 * (lane & 7));
                dl |= __shfl_xor(dl, 1); dh |= __shfl_xor(dh, 1); dl |= __shfl_xor(dl, 2); dh |= __shfl_xor(dh, 2); dl |= __shfl_xor(dl, 4); dh |= __shfl_xor(dh, 4);
                if ((lane & 7) == 0) {
                    const int dk = 8 * hf + (lane >> 3), rs = dk >> 1, half = dk & 1;
                    cpl[(size_t)t * 32 + 4 * rs + half] = dl; cpl[(size_t)t * 32 + 4 * rs + 2 + half] = dh;
                }
            }
            if (lane == 0) csc[t] = m * (1.0f / 119.0f);
        }
    }
}

#define LAS __attribute__((address_space(3)))
#define XB_TMO      128
#define XB_XCNT(j)  (256  + 64 * (j))
#define XB_XSUB(j)  (1280 + 64 * (j))
#define XB_XGEN(j)  (2304 + 64 * (j))
#define XB_TOP      3328
#define XB_TOPGEN   3392
#define XCD_BAR_WORDS 3456
#define XB_SPIN_CAP (1u << 18)
__device__ __forceinline__ unsigned xb_ld(unsigned* p)              { return __hip_atomic_load(p, __ATOMIC_RELAXED, __HIP_MEMORY_SCOPE_AGENT); }
__device__ __forceinline__ unsigned xb_add(unsigned* p, unsigned v) { return __hip_atomic_fetch_add(p, v, __ATOMIC_RELAXED, __HIP_MEMORY_SCOPE_AGENT); }
__device__ __forceinline__ unsigned xb_xcc_id() { return (unsigned)__builtin_amdgcn_s_getreg((3 << 11) | 20) & 0xFu; }
#define XB_SPIN(cond, bar) do { unsigned _sp = 0; while (cond) { __builtin_amdgcn_s_sleep(1); \
    if ((++_sp & 255u) == 0u) { if (xb_ld(&(bar)[XB_TMO])) break; if (_sp > XB_SPIN_CAP) { atomicAdd(&(bar)[XB_TMO], 1u); break; } } } } while (0)
struct XcdBarrier { unsigned* bar; unsigned x; volatile LAS unsigned* st; };
__device__ __forceinline__ XcdBarrier xcd_barrier_post(unsigned* bar, volatile LAS unsigned* st) {
    XcdBarrier b; b.bar = bar; b.x = xb_xcc_id(); b.st = st;
    if (threadIdx.x == 0) (void)xb_add(&bar[XB_XCNT(b.x)], 1u);
    return b;
}
__device__ __forceinline__ void xcd_barrier_complete(unsigned* bar, unsigned x, unsigned& nloc, unsigned& nx) {
    const unsigned G = gridDim.x * gridDim.y * gridDim.z;
    unsigned sum, cnt, mine, sp = 0u;
    for (;;) {
        sum = 0u; cnt = 0u; mine = 0u;
#pragma unroll
        for (unsigned j = 0; j < 16; ++j) { const unsigned c = xb_ld(&bar[XB_XCNT(j)]); sum += c; cnt += (c > 0u) ? 1u : 0u; mine = (j == x) ? c : mine; }
        if (sum == G) break;
        __builtin_amdgcn_s_sleep(1);
        if ((++sp & 255u) == 0u) { if (xb_ld(&bar[XB_TMO])) break; if (sp > XB_SPIN_CAP) { atomicAdd(&bar[XB_TMO], 1u); break; } }
    }
    nloc = mine > 0u ? mine : 1u; nx = cnt > 0u ? cnt : 1u;
}
__device__ __forceinline__ void xcd_barrier(const XcdBarrier& b) {
    asm volatile("s_waitcnt vmcnt(0)" ::: "memory");
    __syncthreads();
    if (threadIdx.x == 0) {
        unsigned* bar = b.bar;
        __builtin_amdgcn_s_waitcnt(0);
        unsigned nloc = b.st[0], nx = b.st[1];
        if (nloc == 0u) { xcd_barrier_complete(bar, b.x, nloc, nx); b.st[0] = nloc; b.st[1] = nx; }
        const unsigned old = xb_add(&bar[XB_XSUB(b.x)], 1u);
        const unsigned gen = old / nloc;
        if (old + 1u == (gen + 1u) * nloc) {
            __builtin_amdgcn_fence(__ATOMIC_RELEASE, "agent");
            asm volatile("s_waitcnt vmcnt(0)" ::: "memory");
            const unsigned og = xb_add(&bar[XB_TOP], 1u);
            const unsigned tg = og / nx;
            if (og + 1u == (tg + 1u) * nx) xb_add(&bar[XB_TOPGEN], 1u);
            else XB_SPIN(xb_ld(&bar[XB_TOPGEN]) == tg, bar);
            __builtin_amdgcn_fence(__ATOMIC_ACQUIRE, "agent");
            xb_add(&bar[XB_XGEN(b.x)], 1u);
            asm volatile("s_waitcnt vmcnt(0)" ::: "memory");
        } else {
            XB_SPIN(xb_ld(&bar[XB_XGEN(b.x)]) == gen, bar);
            __builtin_amdgcn_fence(__ATOMIC_ACQUIRE, "agent");
            asm volatile("s_waitcnt vmcnt(0)" ::: "memory");
        }
    }
    __syncthreads();
}

constexpr int LDS_MISC = 158720;
constexpr int LDS_BYTES = LDS_MISC + 1024;

__global__ void __launch_bounds__(NTHR, 2) hymba_fwd(Params p) {
    extern __shared__ __attribute__((aligned(16))) unsigned char lds[];
    volatile LAS unsigned* misc = (volatile LAS unsigned*)((LAS unsigned char*)lds + LDS_MISC);
    if (threadIdx.x < 4) misc[threadIdx.x] = 0u;
    __syncthreads();
    XcdBarrier bar = xcd_barrier_post((unsigned*)(p.ws + WS_CTL), misc);

    PG8_LAS unsigned char* ring = (PG8_LAS unsigned char*)lds;
    unsigned char* ws = p.ws;
    ph_prep(p, lds);                          xcd_barrier(bar);
    {
        pg8::Gemm g{(const bf16_t*)(ws + WS_A), (const bf16_t*)(ws + WS_WINT), S, NPROJ, D}; pg8::StaticOrder so; so.init(S, NPROJ, (int)gridDim.x, (int)blockIdx.x);
        EpiInProj E{(const float*)(ws + WS_RSTD1), p.in[I_Q_NORM], p.in[I_K_NORM], (bf16_t*)(ws + WS_QH), (bf16_t*)(ws + WS_KH), (bf16_t*)(ws + WS_VH), (bf16_t*)(ws + WS_XRG), (bf16_t*)(ws + WS_GG)};
        pg8::gemm_phase<EpiInProj, pg8::StaticOrder, true, true>(ring, g, so, E);
        const int G = (int)gridDim.x, nunits = (S / 256) * (NPROJ / 256), rem = nunits % G, b = (int)blockIdx.x;
        const int tid_ = phase_tid(), w = tid_ >> 6, lane = tid_ & 63;
        if (rem == 0) ph_tables(p, b * (NTHR / 64) + w, G * (NTHR / 64), lane);
        else if (b >= rem) ph_tables(p, (b - rem) * (NTHR / 64) + w, (G - rem) * (NTHR / 64), lane);
    }
    xcd_barrier(bar);
    ph_attn(p); ph_rg<0>(p, lds);             xcd_barrier(bar);
    ph_rg<1>(p, lds);                         xcd_barrier(bar);
    {
        pg8::Gemm g{(const bf16_t*)(ws + WS_MIX), (const bf16_t*)(ws + WS_WOUTT), S, D, D}; pg8::StaticOrder so; so.init(S, D, (int)gridDim.x, (int)blockIdx.x);
        EpiOutProj E{p.in[I_X], (bf16_t*)(ws + WS_A), (float*)(ws + WS_SSQ), ws + WS_X1Q, (float*)(ws + WS_XSC)};
        pg8::gemm_phase<EpiOutProj, pg8::StaticOrder, true, true>(ring, g, so, E);
    }
    xcd_barrier(bar);
    {
        pg8::Gemm g{(const bf16_t*)(ws + WS_A), (const bf16_t*)(ws + WS_WQT), S, NQ, D}; pg8::StaticOrder so; so.init(S, NQ, (int)gridDim.x, (int)blockIdx.x);
        EpiPeerQ E{(bf16_t*)(ws + WS_B)};
        pg8::gemm_phase<EpiPeerQ, pg8::StaticOrder, true, true>(ring, g, so, E);
    }
    asm volatile("s_waitcnt vmcnt(0)" ::: "memory"); __syncthreads();
    ph_topk(p, (int*)lds);                    xcd_barrier(bar);
    ph_peer<0>(p, lds);                       xcd_barrier(bar);
    ph_peer_combine(p);                       xcd_barrier(bar);
    ph_peer<1>(p, lds);
}

extern "C" void kernel_launch(void* const* d_in, const int* in_sizes, int n_in, void* d_out, int out_size, void* d_ws, size_t ws_size, hipStream_t stream) {
    static int grid = 0;
    if (grid == 0) {
        if (n_in != 20 || out_size != S * D || ws_size < WS_END) { fprintf(stderr, "kernel_launch: unexpected shapes (n_in %d out %d ws %zu)\n", n_in, out_size, ws_size); grid = -1; return; }
        int dev = 0, cus = 0, per_cu = 0;
        if (hipGetDevice(&dev) != hipSuccess || hipDeviceGetAttribute(&cus, hipDeviceAttributeMultiprocessorCount, dev) != hipSuccess) { grid = -1; return; }
        if (hipFuncSetAttribute((const void*)hymba_fwd, hipFuncAttributeMaxDynamicSharedMemorySize, LDS_BYTES) != hipSuccess) { fprintf(stderr, "kernel_launch: hipFuncSetAttribute failed\n"); grid = -1; return; }
        if (hipOccupancyMaxActiveBlocksPerMultiprocessor(&per_cu, (const void*)hymba_fwd, NTHR, LDS_BYTES) != hipSuccess || per_cu < 1) { fprintf(stderr, "kernel_launch: occupancy query says %d blocks per CU\n", per_cu); grid = -1; return; }
        (void)hipGetLastError();
        grid = cus;
    }
    if (grid < 0) return;
    (void)hipMemsetAsync((char*)d_ws + WS_CTL, 0, XCD_BAR_WORDS * 4, stream);
    Params p{};
    for (int i = 0; i < 20; ++i) p.in[i] = (const float*)d_in[i];
    p.out = (float*)d_out; p.ws = (unsigned char*)d_ws;
    hipLaunchKernelGGL(hymba_fwd, dim3(grid), dim3(NTHR), LDS_BYTES, stream, p);
}
```

```cpp
#include <hip/hip_runtime.h>
#include <cstdint>
#include <cstdio>

typedef unsigned short bf16_t;
typedef short bf16x8 __attribute__((ext_vector_type(8)));
typedef float f32x4 __attribute__((ext_vector_type(4)));
typedef unsigned u32x4 __attribute__((ext_vector_type(4)));
typedef float f32x16 __attribute__((ext_vector_type(16)));

constexpr int S = 16384, D = 1024, NPROJ = 2560, DSB = 512, DRG = 512, NH = 8, HD = 64;
constexpr int PH = 8, PNK = 128, PDK = 256, PHALF = 128, PTOPK = 16, NEXP = 16384, NQ = PH * PDK;
constexpr int CHUNK = 64, NCHUNK = S / CHUNK;
constexpr float EPS = 1e-6f;
constexpr float LOG2E = 1.4426950408889634f;
constexpr float QSCALE = 0.125f * LOG2E;
constexpr int NTHR = 512;
constexpr float CARRY_STOP = -160.0f;

constexpr size_t MiB = 1u << 20;
constexpr size_t WS_CTL = 0;
constexpr size_t WS_WINT = 1 * MiB;
constexpr size_t WS_WOUTT = 6 * MiB;
constexpr size_t WS_WQT = 8 * MiB;
constexpr size_t WS_SUBK = 12 * MiB;
constexpr size_t WS_RSTD1 = 12 * MiB + 512 * 1024;
constexpr size_t WS_RSTD2 = WS_RSTD1 + 64 * 1024;
constexpr size_t WS_RGP = WS_RSTD2 + 64 * 1024;
constexpr size_t WS_RGH = WS_RGP + 512 * 1024;
constexpr size_t WS_RGSA = 207 * MiB, WS_RGSB = 223 * MiB;
constexpr size_t WS_A = 14 * MiB;
constexpr size_t WS_B = 46 * MiB;
constexpr size_t WS_QH = WS_B, WS_KH = WS_B + 16 * MiB, WS_VH = WS_B + 32 * MiB, WS_XRG = WS_B + 48 * MiB;
constexpr size_t WS_GG = 110 * MiB;
constexpr size_t WS_OSB = 126 * MiB;
constexpr size_t WS_MIX = 142 * MiB;
constexpr size_t WS_SSB = 198 * MiB;
constexpr size_t WS_RSB = WS_SSB + 512 * 1024;
constexpr size_t WS_SELI = WS_MIX, WS_SELG = WS_MIX + 8 * MiB;
constexpr size_t WS_PD = WS_B;
constexpr size_t WS_CBUF = WS_GG;
constexpr size_t WS_CSC = WS_GG + 4 * MiB;
constexpr size_t WS_X1Q = WS_OSB;
constexpr size_t WS_XSC = WS_GG + 8 * MiB;
constexpr size_t WS_UB = 174 * MiB;
constexpr size_t WS_VB = 190 * MiB;
constexpr size_t WS_USC = 206 * MiB;
constexpr size_t WS_SSQ = 238 * MiB;
constexpr size_t WS_RGW = 239 * MiB;
constexpr size_t WS_END = 240 * MiB;

__device__ __forceinline__ unsigned f2bf(float f) { unsigned u = __builtin_bit_cast(unsigned, f); return (u + 0x7fffu + ((u >> 16) & 1u)) >> 16; }
__device__ __forceinline__ float u2f(unsigned u) { return __builtin_bit_cast(float, u); }
__device__ __forceinline__ float bf2f(unsigned h) { return __builtin_bit_cast(float, h << 16); }
__device__ __forceinline__ unsigned pk2(float lo, float hi) { return f2bf(lo) | (f2bf(hi) << 16); }
__device__ __forceinline__ unsigned pack_i8(float a, float b, float c, float d) {
    const int qa = __float2int_rn(a), qb = __float2int_rn(b), qc = __float2int_rn(c), qd = __float2int_rn(d);
    return (unsigned)(qa & 255) | ((unsigned)(qb & 255) << 8) | ((unsigned)(qc & 255) << 16) | ((unsigned)qd << 24);
}
__device__ __forceinline__ unsigned pack_n4(float a, float b, float c, float d) {
    const int qa = min(max(__float2int_rn(a), -7), 7) & 15, qb = min(max(__float2int_rn(b), -7), 7) & 15, qc = min(max(__float2int_rn(c), -7), 7) & 15, qd = min(max(__float2int_rn(d), -7), 7) & 15;
    return (unsigned)qa | ((unsigned)qb << 4) | ((unsigned)qc << 8) | ((unsigned)qd << 12);
}
template <int OFFS>
__device__ __forceinline__ unsigned pack_u4(float a, float b, float c, float d) {
    const int qa = (min(max(__float2int_rn(a), -7), 7) + OFFS) & 15, qb = (min(max(__float2int_rn(b), -7), 7) + OFFS) & 15, qc = (min(max(__float2int_rn(c), -7), 7) + OFFS) & 15, qd = (min(max(__float2int_rn(d), -7), 7) + OFFS) & 15;
    return (unsigned)qa | ((unsigned)qb << 8) | ((unsigned)qc << 16) | ((unsigned)qd << 24);
}
__device__ __forceinline__ float wave_sum(float v) {
#pragma unroll
    for (int o = 1; o < 64; o <<= 1) v += __shfl_xor(v, o);
    return v;
}
__device__ __forceinline__ float gelu_tanh(float x) {
    const float u = 0.7978845608028654f * (x + 0.044715f * x * x * x);
    const float e = __expf(2.0f * u);
    const float th = 1.0f - 2.0f / (e + 1.0f);
    return 0.5f * x * (1.0f + th);
}

__host__ __device__ __forceinline__ int inproj_phys_row(int nlog) { const int t = nlog >> 8, L = nlog & 255; return (t << 8) + 128 * ((L & 63) >> 5) + 32 * (L >> 6) + (L & 31); }

__device__ __forceinline__ int phase_tid() { int t = threadIdx.x; asm volatile("" : "+v"(t)); return t; }

struct Params {
    const float* in[20];
    float* out;
    unsigned char* ws;
};
enum { I_X = 0, I_NORM_MIX, I_W_IN, I_Q_NORM, I_K_NORM, I_CONV_W, I_CONV_B, I_RG_W_A, I_RG_B_A, I_RG_W_X, I_RG_B_X, I_RG_LAMBDA,
       I_OUT_NORM_SB, I_OUT_NORM_RG, I_W_OUT, I_NORM_FFN, I_PEER_WQ, I_PEER_SUBK, I_PEER_U, I_PEER_V };

template <bool INPROJ_PERM>
__device__ __forceinline__ void prep_transpose_item(const float* W, const float* gain0, const float* gain1, int K, int N, bf16_t* WT, float* scr, int item, int lane) {
    const int nblk = N / 32, kb = item / nblk, nb = item % nblk, k0 = 64 * kb, n0 = 32 * nb;
#pragma unroll 8
    for (int i = 0; i < 32; ++i) {
        const int kk = 2 * i + (lane >> 5), k = k0 + kk;
        const float g = (gain1 && k >= 512) ? gain1[k - 512] : gain0[k];
        scr[kk * 33 + (lane & 31)] = g * W[(size_t)k * N + n0 + (lane & 31)];
    }
    asm volatile("s_waitcnt lgkmcnt(0)" ::: "memory");
    const int c = lane & 7;
#pragma unroll
    for (int j = 0; j < 4; ++j) {
        const int n = (lane >> 3) + 8 * j; const float* s = scr + (8 * c) * 33 + n;
        u32x4 o; o.x = pk2(s[0 * 33], s[1 * 33]); o.y = pk2(s[2 * 33], s[3 * 33]); o.z = pk2(s[4 * 33], s[5 * 33]); o.w = pk2(s[6 * 33], s[7 * 33]);
        const int nr = INPROJ_PERM ? inproj_phys_row(n0 + n) : n0 + n;
        *(u32x4*)(WT + (size_t)nr * K + k0 + 8 * c) = o;
    }
    asm volatile("s_waitcnt lgkmcnt(0)" ::: "memory");
}
__device__ __forceinline__ void ph_tables(const Params& p, int cw, int ncw, int lane) {
    unsigned char* ws = p.ws;
    {
        const float* u = p.in[I_PEER_U]; const float* v = p.in[I_PEER_V]; const float* g = p.in[I_NORM_FFN];
        unsigned* ub = (unsigned*)(ws + WS_UB); unsigned* vb = (unsigned*)(ws + WS_VB); float2* uvsc = (float2*)(ws + WS_USC);
        f32x4 gq[4];
#pragma unroll
        for (int j = 0; j < 4; ++j) gq[j] = *((const f32x4*)g + lane + 64 * j);
        for (int e0 = cw; e0 < NEXP; e0 += 2 * ncw) {
            f32x4 a[2][4], b[2][4]; float ma[2], mb[2], sa2[2], sb2[2];
#pragma unroll
            for (int rr = 0; rr < 2; ++rr) {
                const int e = min(e0 + rr * ncw, NEXP - 1);
#pragma unroll
                for (int j = 0; j < 4; ++j) { a[rr][j] = *((const f32x4*)(u + (size_t)e * D) + lane + 64 * j); b[rr][j] = *((const f32x4*)(v + (size_t)e * D) + lane + 64 * j); }
            }
#pragma unroll
            for (int rr = 0; rr < 2; ++rr) {
                ma[rr] = 0.f; mb[rr] = 0.f; sa2[rr] = 0.f; sb2[rr] = 0.f;
#pragma unroll
                for (int j = 0; j < 4; ++j) {
                    a[rr][j] = a[rr][j] * gq[j];
                    const f32x4 aa = a[rr][j], bb = b[rr][j];
                    ma[rr] = fmaxf(ma[rr], fmaxf(fmaxf(fabsf(aa.x), fabsf(aa.y)), fmaxf(fabsf(aa.z), fabsf(aa.w))));
                    mb[rr] = fmaxf(mb[rr], fmaxf(fmaxf(fabsf(bb.x), fabsf(bb.y)), fmaxf(fabsf(bb.z), fabsf(bb.w))));
                    sa2[rr] += (aa.x * aa.x + aa.y * aa.y) + (aa.z * aa.z + aa.w * aa.w);
                    sb2[rr] += (bb.x * bb.x + bb.y * bb.y) + (bb.z * bb.z + bb.w * bb.w);
                }
            }
#pragma unroll
            for (int o = 1; o < 64; o <<= 1)
#pragma unroll
                for (int rr = 0; rr < 2; ++rr) { ma[rr] = fmaxf(ma[rr], __shfl_xor(ma[rr], o)); mb[rr] = fmaxf(mb[rr], __shfl_xor(mb[rr], o)); sa2[rr] += __shfl_xor(sa2[rr], o); sb2[rr] += __shfl_xor(sb2[rr], o); }
#pragma unroll
            for (int rr = 0; rr < 2; ++rr) {
                const int e = e0 + rr * ncw;
                if (e < NEXP) {
                    const float ca = fminf(ma[rr], 2.5f * sqrtf(sa2[rr] * (1.0f / D))), cb = fminf(mb[rr], 2.5f * sqrtf(sb2[rr] * (1.0f / D)));
                    const float ia = ca > 0.f ? 7.0f / ca : 0.f, ib = cb > 0.f ? 7.0f / cb : 0.f;
#pragma unroll
                    for (int j = 0; j < 4; ++j) {
                        const f32x4 aa = a[rr][j], bb = b[rr][j];
                        const unsigned na = pack_u4<0>(aa.x * ia, aa.y * ia, aa.z * ia, aa.w * ia), nb = pack_n4(bb.x * ib, bb.y * ib, bb.z * ib, bb.w * ib);
                        const unsigned pa = __shfl_xor(na, 1), pb = __shfl_xor(nb, 1);
                        if ((lane & 1) == 0) {
                            ub[((size_t)j * NEXP + e) * 32 + (lane >> 1)] = na | (pa << 4);
                            vb[((size_t)j * NEXP + e) * 32 + (lane >> 1)] = nb | (pb << 16);
                        }
                    }
                    if (lane == 0) uvsc[e] = make_float2(ca * (1.0f / 7.0f), cb * (1.0f / 7.0f));
                }
            }
        }
    }
}

__device__ __forceinline__ void ph_prep(const Params& p, unsigned char* lds) {
    const int tid_ = phase_tid();
    const int gtid = blockIdx.x * blockDim.x + tid_, gsize = gridDim.x * blockDim.x;
    const int lane = tid_ & 63, gwave = gtid >> 6, nwave = gsize >> 6;
    unsigned char* ws = p.ws;
    {
        float* scr = (float*)lds + (tid_ >> 6) * (64 * 33);
        constexpr int I_IN = (D / 64) * (NPROJ / 32), I_OUT = (D / 64) * (D / 32), I_Q = (D / 64) * (NQ / 32);
        for (int it = gwave; it < I_IN + I_OUT + I_Q; it += nwave) {
            if (it < I_IN) prep_transpose_item<true>(p.in[I_W_IN], p.in[I_NORM_MIX], nullptr, D, NPROJ, (bf16_t*)(ws + WS_WINT), scr, it, lane);
            else if (it < I_IN + I_OUT) prep_transpose_item<false>(p.in[I_W_OUT], p.in[I_OUT_NORM_SB], p.in[I_OUT_NORM_RG], D, D, (bf16_t*)(ws + WS_WOUTT), scr, it - I_IN, lane);
            else prep_transpose_item<false>(p.in[I_PEER_WQ], p.in[I_NORM_FFN], nullptr, D, NQ, (bf16_t*)(ws + WS_WQT), scr, it - I_IN - I_OUT, lane);
        }
    }
    {
        const float* wa = p.in[I_RG_W_A]; const float* wx = p.in[I_RG_W_X]; bf16_t* o = (bf16_t*)(ws + WS_RGW);
        for (int e = gtid; e < 8 * 2 * 2 * 4 * 64 * 8; e += gsize) {
            const int el = e & 7, ln = (e >> 3) & 63, s = (e >> 9) & 3, jt = (e >> 11) & 1, g = (e >> 12) & 1, n = e >> 13;
            const int j = 32 * jt + (ln & 31), i = 16 * s + 8 * (el >> 2) + 4 * (ln >> 5) + (el & 3);
            o[e] = (bf16_t)f2bf((g == 0 ? wa : wx)[((size_t)n * 64 + i) * 64 + j]);
        }
    }
    {
        const float* sk = p.in[I_PEER_SUBK]; bf16_t* o = (bf16_t*)(ws + WS_SUBK);
        for (int e = gtid; e < PH * 2 * PNK * PHALF; e += gsize) o[e] = (bf16_t)f2bf(sk[e]);
    }
    {
        const float* x = p.in[I_X]; bf16_t* xb = (bf16_t*)(ws + WS_A); float* rstd1 = (float*)(ws + WS_RSTD1);
        for (int row0 = gwave; row0 < S; row0 += 4 * nwave) {
            f32x4 v[4][4];
#pragma unroll
            for (int rr = 0; rr < 4; ++rr) {
                const int row = min(row0 + rr * nwave, S - 1);
#pragma unroll
                for (int j = 0; j < 4; ++j) v[rr][j] = ((const f32x4*)(x + (size_t)row * D) + lane)[64 * j];
            }
#pragma unroll
            for (int rr = 0; rr < 4; ++rr) {
                const int row = row0 + rr * nwave;
                float ss = 0.f;
#pragma unroll
                for (int j = 0; j < 4; ++j) ss += (v[rr][j].x * v[rr][j].x + v[rr][j].y * v[rr][j].y) + (v[rr][j].z * v[rr][j].z + v[rr][j].w * v[rr][j].w);
                ss = wave_sum(ss);
                if (row < S) {
                    uint2* o = (uint2*)(xb + (size_t)row * D) + lane;
#pragma unroll
                    for (int j = 0; j < 4; ++j) o[64 * j] = make_uint2(pk2(v[rr][j].x, v[rr][j].y), pk2(v[rr][j].z, v[rr][j].w));
                    if (lane == 0) rstd1[row] = rsqrtf(ss * (1.0f / D) + EPS);
                }
            }
        }
    }
}

namespace pg8 {
#define PG8_LAS __attribute__((address_space(3)))
typedef unsigned short bf16_t;
typedef short bf16x8 __attribute__((ext_vector_type(8)));
typedef float f32x4 __attribute__((ext_vector_type(4)));
typedef unsigned u32x4 __attribute__((ext_vector_type(4)));
constexpr int BM = 256, BK = 64, HALF = 128, HTB = HALF * BK * 2  , STAGE_BYTES = 8 * HTB, NXCD = 8, WGM = 8;

__host__ __device__ __forceinline__ int lds_byte(int r, int c) { const int st = (r >> 4) * 2 + (c >> 5), rr = r & 15, cc = c & 31, ob = rr * 64 + cc * 2; return st * 1024 + (ob ^ (((ob >> 9) & 1) << 5)); }
__host__ __device__ __forceinline__ void stage_rc(int b, int& R, int& C) { const int st = b / 1024, sb = b % 1024, swz = sb ^ (((sb >> 9) & 1) << 5); R = (st >> 1) * 16 + swz / 64; C = (st & 1) * 32 + (swz % 64) / 2; }
__host__ __device__ __forceinline__ int perm32(int rho) { const int n = rho >> 4, i = rho & 15; return 8 * (i >> 2) + 4 * n + (i & 3); }

struct Unit { int pm, pn; };
struct Gemm { const bf16_t* A; const bf16_t* Bt; int M, N, K; };

struct StaticOrder {
    int nM, nN, nwg, G, c;
    __host__ __device__ void init(int M, int N, int G_, int c_) { nM = M / BM; nN = N / BM; nwg = nM * nN; G = G_; c = c_; }
    __host__ __device__ bool next(int i, Unit& u) const {
        const long L = (long)i * G + c; if (L >= nwg) return false;
        int wgid = (int)L; { const int q = nwg / NXCD, r = nwg % NXCD, xcd = wgid % NXCD, off = wgid / NXCD; wgid = (xcd < r ? xcd * (q + 1) : r * (q + 1) + (xcd - r) * q) + off; }
        const int nig = WGM * nN, gid = wgid / nig, fm = gid * WGM, gsz = (nM - fm) < WGM ? (nM - fm) : WGM;
        u.pm = fm + ((wgid % nig) % gsz); u.pn = (wgid % nig) / gsz; return true;
    }
    __device__ __forceinline__ void a_ready(const Unit&) const {}
    __device__ __forceinline__ void done(const Unit&) const {}
};

__device__ __forceinline__ unsigned cvt_pk_bf16(float lo, float hi) { unsigned r; asm volatile("v_cvt_pk_bf16_f32 %0, %1, %2" : "=v"(r) : "v"(lo), "v"(hi)); return r; }
template <class Epi, class Sched, bool ALIGN_EPI = false, bool SP2 = false>
__device__ __forceinline__ void gemm_phase(PG8_LAS unsigned char* lds, const Gemm g, const Sched& S, const Epi& E) {
    const int tid = phase_tid(), wid = __builtin_amdgcn_readfirstlane(tid >> 6), lane = tid & 63, wr = wid >> 2, wc = wid & 3, fr = lane & 15, fq = lane >> 4;
    const int K = g.K, nt = K / BK;
    unsigned voffA[2], voffB[2];
#pragma unroll
    for (int i = 0; i < 2; ++i) { int R, C; stage_rc(tid * 16 + i * 8192, R, C); const int Rb = Epi::PERM ? ((R & ~31) + perm32(R & 31)) : R;
        voffA[i] = (unsigned)(R * K + C) * 2u; voffB[i] = (unsigned)(Rb * K + C) * 2u; }
    const size_t kstep = (size_t)(BK * 2);
    const size_t hstep = (size_t)HALF * K * 2;
    const size_t tstep = 2 * hstep;
    const unsigned ldsw = (unsigned)wid * 1024u;
    const int aoff = lds_byte(wr * 64 + fr, fq * 8), boff = lds_byte(wc * 32 + fr, fq * 8);
#define PG8_SA(b, h) (((b) * 2 + (h)) * HTB)
#define PG8_SB(b, h) ((4 + (b) * 2 + (h)) * HTB)
#define PG8_STAGE(bufoff, gbase, voff) do { _Pragma("unroll") for (int _i = 0; _i < 2; ++_i) \
        __builtin_amdgcn_global_load_lds((const unsigned*)((const char*)(gbase) + (voff)[_i]), (PG8_LAS unsigned*)(lds + (bufoff) + ldsw + _i * 8192), 16, 0, 0); } while (0)
#define PG8_LDA(dst, b, h) do { _Pragma("unroll") for (int m = 0; m < 4; ++m) _Pragma("unroll") for (int k = 0; k < 2; ++k) dst[m][k] = *(const PG8_LAS bf16x8*)(lds + PG8_SA(b, h) + aoff + m * 2048 + k * 1024); } while (0)
#define PG8_LDB(dst, b, h) do { _Pragma("unroll") for (int n = 0; n < 2; ++n) _Pragma("unroll") for (int k = 0; k < 2; ++k) dst[n][k] = *(const PG8_LAS bf16x8*)(lds + PG8_SB(b, h) + boff + n * 2048 + k * 1024); } while (0)
#define PG8_MMA(ai, bj, At, Bt) do { __builtin_amdgcn_s_setprio(1); _Pragma("unroll") for (int m = 0; m < 4; ++m) _Pragma("unroll") for (int n = 0; n < 2; ++n) _Pragma("unroll") for (int k = 0; k < 2; ++k) \
        acc[ai][bj][m][n] = __builtin_amdgcn_mfma_f32_16x16x32_bf16(Bt[n][k], At[m][k], acc[ai][bj][m][n], 0, 0, 0); __builtin_amdgcn_s_setprio(0); } while (0)
#define PG8_WAIT_V(n) asm volatile("s_waitcnt vmcnt(" #n ")" ::: "memory")
#define PG8_WAIT_L(n) asm volatile("s_waitcnt lgkmcnt(" #n ")" ::: "memory")
#define PG8_BAR __builtin_amdgcn_s_barrier()
#define PG8_SCHED __builtin_amdgcn_sched_barrier(0)
    Unit cur, nxt; int ui = 0;
    if (!S.next(0, cur)) return;
    f32x4 acc[2][2][4][2];
#pragma unroll
    for (int a = 0; a < 2; ++a)
#pragma unroll
        for (int b = 0; b < 2; ++b)
#pragma unroll
            for (int m = 0; m < 4; ++m)
#pragma unroll
                for (int n = 0; n < 2; ++n) acc[a][b][m][n] = (f32x4){0.f, 0.f, 0.f, 0.f};
    bf16x8 At[4][2], B0[2][2], B1[2][2];
    const char* cA = (const char*)g.A + (size_t)cur.pm * tstep; const char* cB = (const char*)g.Bt + (size_t)cur.pn * tstep;
    S.a_ready(cur);
    if constexpr (SP2) {
        PG8_STAGE(PG8_SB(0, 0), cB, voffB); PG8_STAGE(PG8_SB(0, 1), cB + hstep, voffB); PG8_STAGE(PG8_SA(0, 0), cA, voffA); PG8_STAGE(PG8_SA(0, 1), cA + hstep, voffA);
        if (wr == 1) PG8_BAR;
        PG8_WAIT_V(2); PG8_BAR;
        PG8_STAGE(PG8_SB(1, 0), cB + kstep, voffB); PG8_STAGE(PG8_SA(1, 0), cA + kstep, voffA); PG8_STAGE(PG8_SB(1, 1), cB + hstep + kstep, voffB);
        PG8_WAIT_V(6); PG8_BAR;
    } else {
        PG8_STAGE(PG8_SB(0, 0), cB, voffB); PG8_STAGE(PG8_SA(0, 0), cA, voffA); PG8_STAGE(PG8_SB(0, 1), cB + hstep, voffB); PG8_STAGE(PG8_SA(0, 1), cA + hstep, voffA);
        if (wr == 1) PG8_BAR;
        PG8_WAIT_V(4); PG8_BAR;
        PG8_STAGE(PG8_SB(1, 0), cB + kstep, voffB); PG8_STAGE(PG8_SA(1, 0), cA + kstep, voffA); PG8_STAGE(PG8_SB(1, 1), cB + hstep + kstep, voffB);
        PG8_WAIT_V(6); PG8_BAR;
    }
    for (;;) {
        const bool has_next = S.next(ui + 1, nxt);
        const char* nA = has_next ? (const char*)g.A + (size_t)nxt.pm * tstep : cA; const char* nB = has_next ? (const char*)g.Bt + (size_t)nxt.pn * tstep : cB;
        for (int t = 0; t < nt; t += 2) {
            if constexpr (Epi::MIDSCALE) { if (t == nt / 2) E.mid(acc, cur, wr, wc, fr, fq); }
            const bool last = (t == nt - 2);
            const char* a1 = cA + (size_t)(t + 1) * kstep;
            const char* a2 = last ? nA : cA + (size_t)(t + 2) * kstep; const char* b2 = last ? nB : cB + (size_t)(t + 2) * kstep;
            const char* a3 = a2 + kstep; const char* b3 = b2 + kstep;
            if (last && has_next) S.a_ready(nxt);
            if constexpr (SP2) {
            PG8_LDB(B0, 0, 0); PG8_LDB(B1, 0, 1); PG8_SCHED; PG8_LDA(At, 0, 0); PG8_STAGE(PG8_SA(1, 1), a1 + hstep, voffA);
            PG8_WAIT_V(8); PG8_WAIT_L(0); PG8_BAR; PG8_MMA(0, 0, At, B0); PG8_MMA(0, 1, At, B1); PG8_BAR; PG8_SCHED;
            PG8_LDA(At, 0, 1); PG8_STAGE(PG8_SB(0, 0), b2, voffB); PG8_STAGE(PG8_SB(0, 1), b2 + hstep, voffB); PG8_STAGE(PG8_SA(0, 0), a2, voffA);
            PG8_WAIT_V(8); PG8_WAIT_L(0); PG8_BAR; PG8_MMA(1, 0, At, B0); PG8_MMA(1, 1, At, B1); PG8_BAR; PG8_SCHED;
            PG8_LDB(B0, 1, 0); PG8_LDB(B1, 1, 1); PG8_SCHED; PG8_LDA(At, 1, 0); PG8_STAGE(PG8_SA(0, 1), a2 + hstep, voffA);
            PG8_WAIT_V(8); PG8_WAIT_L(0); PG8_BAR; PG8_MMA(0, 0, At, B0); PG8_MMA(0, 1, At, B1); PG8_BAR; PG8_SCHED;
            PG8_LDA(At, 1, 1); PG8_STAGE(PG8_SB(1, 0), b3, voffB); PG8_STAGE(PG8_SB(1, 1), b3 + hstep, voffB); PG8_STAGE(PG8_SA(1, 0), a3, voffA);
            PG8_WAIT_V(8); PG8_WAIT_L(0); PG8_BAR; PG8_MMA(1, 0, At, B0); PG8_MMA(1, 1, At, B1); PG8_BAR; PG8_SCHED;
            } else {
            PG8_LDB(B0, 0, 0); PG8_SCHED; PG8_LDA(At, 0, 0); PG8_STAGE(PG8_SA(1, 1), a1 + hstep, voffA);
            PG8_WAIT_L(8); PG8_BAR; PG8_WAIT_L(0); PG8_MMA(0, 0, At, B0); PG8_BAR; PG8_SCHED;
            PG8_LDB(B1, 0, 1); PG8_STAGE(PG8_SB(0, 0), b2, voffB);
            PG8_BAR; PG8_WAIT_L(0); PG8_MMA(0, 1, At, B1); PG8_BAR;
            PG8_LDA(At, 0, 1); PG8_STAGE(PG8_SA(0, 0), a2, voffA);
            PG8_BAR; PG8_WAIT_L(0); PG8_MMA(1, 0, At, B0); PG8_BAR; PG8_SCHED;
            PG8_STAGE(PG8_SB(0, 1), b2 + hstep, voffB);
            PG8_WAIT_V(6); PG8_BAR; PG8_MMA(1, 1, At, B1); PG8_BAR;
            PG8_LDB(B0, 1, 0); PG8_SCHED; PG8_LDA(At, 1, 0); PG8_STAGE(PG8_SA(0, 1), a2 + hstep, voffA);
            PG8_WAIT_L(8); PG8_BAR; PG8_WAIT_L(0); PG8_MMA(0, 0, At, B0); PG8_BAR; PG8_SCHED;
            PG8_LDB(B1, 1, 1); PG8_STAGE(PG8_SB(1, 0), b3, voffB);
            PG8_BAR; PG8_WAIT_L(0); PG8_MMA(0, 1, At, B1); PG8_BAR;
            PG8_LDA(At, 1, 1); PG8_STAGE(PG8_SA(1, 0), a3, voffA);
            PG8_BAR; PG8_WAIT_L(0); PG8_MMA(1, 0, At, B0); PG8_BAR; PG8_SCHED;
            PG8_STAGE(PG8_SB(1, 1), b3 + hstep, voffB);
            PG8_WAIT_V(6); PG8_BAR; PG8_MMA(1, 1, At, B1); PG8_BAR;
            }
        }
        if constexpr (ALIGN_EPI) { if (wr == 0) PG8_BAR; }
        if constexpr (!Epi::AFTER_DRAIN) { E(acc, cur, wr, wc, fr, fq); S.done(cur); }
        if (!has_next) break;
#pragma unroll
        for (int a = 0; a < 2; ++a)
#pragma unroll
            for (int b = 0; b < 2; ++b)
#pragma unroll
                for (int m = 0; m < 4; ++m)
#pragma unroll
                    for (int n = 0; n < 2; ++n) acc[a][b][m][n] = (f32x4){0.f, 0.f, 0.f, 0.f};
        cur = nxt; cA = nA; cB = nB; ++ui;
        if constexpr (ALIGN_EPI) { if (wr == 1) PG8_BAR; }
    }
    PG8_WAIT_V(0);
    if constexpr (!ALIGN_EPI) { if (wr == 0) PG8_BAR; }
    PG8_BAR;
    if constexpr (Epi::AFTER_DRAIN) { E.fused(acc, cur, wr, wc, fr, fq, lds, wid, lane); S.done(cur); }
#undef PG8_SA
#undef PG8_SB
#undef PG8_STAGE
#undef PG8_LDA
#undef PG8_LDB
#undef PG8_MMA
#undef PG8_WAIT_V
#undef PG8_WAIT_L
#undef PG8_BAR
#undef PG8_SCHED
}
}

struct EpiInProj {
    static constexpr bool PERM = true, AFTER_DRAIN = false, MIDSCALE = false;
    const float* rstd1; const float* qn; const float* kn; bf16_t *qh, *kh, *vh, *xrg, *gg;
    __device__ __forceinline__ void operator()(const pg8::f32x4 (&acc)[2][2][4][2], const pg8::Unit& u, int wr, int wc, int fr, int fq) const {
        const int region = u.pn >> 1;
        const int head = (u.pn & 1) * 4 + wc;
        float rsv[2][4];
#pragma unroll
        for (int ai = 0; ai < 2; ++ai)
#pragma unroll
            for (int m = 0; m < 4; ++m) rsv[ai][m] = rstd1[u.pm * 256 + ai * 128 + wr * 64 + m * 16 + fr];
        pg8::f32x4 gn[2][2];
        if (region <= 1) {
            const float* g = region == 0 ? qn : kn; const float sc = region == 0 ? QSCALE : 1.0f;
#pragma unroll
            for (int bj = 0; bj < 2; ++bj)
#pragma unroll
                for (int n = 0; n < 2; ++n) gn[bj][n] = *(const pg8::f32x4*)(g + 32 * bj + 8 * fq + 4 * n) * sc;
        }
#pragma unroll
        for (int ai = 0; ai < 2; ++ai)
#pragma unroll
            for (int m = 0; m < 4; ++m) {
                const int row = u.pm * 256 + ai * 128 + wr * 64 + m * 16 + fr;
                const float rs = rsv[ai][m];
                pg8::f32x4 v[2][2];
#pragma unroll
                for (int bj = 0; bj < 2; ++bj)
#pragma unroll
                    for (int n = 0; n < 2; ++n) v[bj][n] = acc[ai][bj][m][n] * rs;
                bf16_t* dst;
                if (region <= 1) {
                    float ss = 0.f;
#pragma unroll
                    for (int bj = 0; bj < 2; ++bj)
#pragma unroll
                        for (int n = 0; n < 2; ++n) ss += (v[bj][n][0] * v[bj][n][0] + v[bj][n][1] * v[bj][n][1]) + (v[bj][n][2] * v[bj][n][2] + v[bj][n][3] * v[bj][n][3]);
                    ss += __shfl_xor(ss, 16); ss += __shfl_xor(ss, 32);
                    const float rn = rsqrtf(ss * (1.0f / HD) + EPS);
#pragma unroll
                    for (int bj = 0; bj < 2; ++bj)
#pragma unroll
                        for (int n = 0; n < 2; ++n) v[bj][n] = v[bj][n] * rn * gn[bj][n];
                    bf16_t* fb = (region == 0 ? qh : kh) + ((size_t)(head * (S / 32) + (row >> 5)) * 4 * 64 + (row & 31)) * 8;
#pragma unroll
                    for (int bj = 0; bj < 2; ++bj) {
                        pg8::u32x4 w; w.x = pg8::cvt_pk_bf16(v[bj][0][0], v[bj][0][1]); w.y = pg8::cvt_pk_bf16(v[bj][0][2], v[bj][0][3]);
                        w.z = pg8::cvt_pk_bf16(v[bj][1][0], v[bj][1][1]); w.w = pg8::cvt_pk_bf16(v[bj][1][2], v[bj][1][3]);
                        *(pg8::u32x4*)(fb + ((2 * bj + (fq >> 1)) * 64 + 32 * (fq & 1)) * 8) = w;
                    }
                    continue;
                } else if (region == 2) {
#pragma unroll
                    for (int bj = 0; bj < 2; ++bj)
#pragma unroll
                        for (int n = 0; n < 2; ++n)
#pragma unroll
                            for (int i = 0; i < 4; ++i) {
                                const int d = 32 * bj + 8 * fq + 4 * n + i, kl = row & 31;
                                vh[(((((size_t)head * (S / 32) + (row >> 5)) * 2 + (d >> 5)) * 2 + (kl >> 4)) * 64 + (d & 31) + 32 * ((kl >> 2) & 1)) * 8 + 4 * ((kl >> 3) & 1) + (kl & 3)] = (bf16_t)f2bf(v[bj][n][i]);
                            }
                    continue;
                } else if (region == 3) {
                    dst = xrg + (size_t)row * DRG + head * 64;
                } else {
#pragma unroll
                    for (int bj = 0; bj < 2; ++bj)
#pragma unroll
                        for (int n = 0; n < 2; ++n)
#pragma unroll
                            for (int i = 0; i < 4; ++i) v[bj][n][i] = gelu_tanh(v[bj][n][i]);
#pragma unroll
                    for (int bj = 0; bj < 2; ++bj)
#pragma unroll
                        for (int n = 0; n < 2; ++n)
                            *(uint2*)(gg + ((((size_t)(row >> 5) * 8 + head) * 8 + (4 * bj + fq)) * 64 + (row & 31) + 32 * n) * 4) = make_uint2(pg8::cvt_pk_bf16(v[bj][n][0], v[bj][n][1]), pg8::cvt_pk_bf16(v[bj][n][2], v[bj][n][3]));
                    continue;
                }
#pragma unroll
                for (int bj = 0; bj < 2; ++bj) {
                    pg8::u32x4 w; w.x = pg8::cvt_pk_bf16(v[bj][0][0], v[bj][0][1]); w.y = pg8::cvt_pk_bf16(v[bj][0][2], v[bj][0][3]);
                    w.z = pg8::cvt_pk_bf16(v[bj][1][0], v[bj][1][1]); w.w = pg8::cvt_pk_bf16(v[bj][1][2], v[bj][1][3]);
                    *(pg8::u32x4*)(dst + 32 * bj + 8 * fq) = w;
                }
            }
    }
};
struct EpiOutProj {
    static constexpr bool PERM = true, AFTER_DRAIN = false, MIDSCALE = true;
    __device__ __forceinline__ void mid(pg8::f32x4 (&acc)[2][2][4][2], const pg8::Unit& u, int wr, int wc, int fr, int fq) const {
        float sc[2][4];
        int fro = fr; asm volatile("" : "+v"(fro));
#pragma unroll
        for (int ai = 0; ai < 2; ++ai)
#pragma unroll
            for (int m = 0; m < 4; ++m) sc[ai][m] = rsb[u.pm * 256 + ai * 128 + wr * 64 + m * 16 + fro];
#pragma unroll
        for (int ai = 0; ai < 2; ++ai)
#pragma unroll
            for (int bj = 0; bj < 2; ++bj)
#pragma unroll
                for (int m = 0; m < 4; ++m)
#pragma unroll
                    for (int n = 0; n < 2; ++n) acc[ai][bj][m][n] = acc[ai][bj][m][n] * sc[ai][m];
    }
    const float* rsb;
    const float* x; bf16_t* x1b; float* ssq; unsigned char* x1q; float* xsc;
    __device__ __forceinline__ void operator()(const pg8::f32x4 (&acc)[2][2][4][2], const pg8::Unit& u, int wr, int wc, int fr, int fq) const {
        pg8::u32x4 xv[2][2][2];
#define OUTPROJ_LD(buf, ai_, mh_) do { _Pragma("unroll") for (int mm_ = 0; mm_ < 2; ++mm_) _Pragma("unroll") for (int bj_ = 0; bj_ < 2; ++bj_) { \
            const size_t o_ = (size_t)(u.pm * 256 + (ai_) * 128 + wr * 64 + (2 * (mh_) + mm_) * 16 + fr) * D + u.pn * 256 + bj_ * 128 + wc * 32 + 8 * fq; \
            xv[buf][mm_][bj_] = *(const pg8::u32x4*)(x1b + o_); } } while (0)
        OUTPROJ_LD(0, 0, 0);
#pragma unroll
        for (int ai = 0; ai < 2; ++ai)
#pragma unroll
            for (int m = 0; m < 4; ++m) {
                const int kb = ai * 2 + (m >> 1);
                if ((m & 1) == 0 && kb < 3) OUTPROJ_LD((kb + 1) & 1, (kb + 1) >> 1, (kb + 1) & 1);
                const int row = u.pm * 256 + ai * 128 + wr * 64 + m * 16 + fr;
                float ss = 0.f;
#pragma unroll
                for (int bj = 0; bj < 2; ++bj) {
                    const int col = u.pn * 256 + bj * 128 + wc * 32 + 8 * fq;
                    const size_t o = (size_t)row * D + col;
                    const pg8::u32x4 xw = xv[kb & 1][m & 1][bj];
                    const pg8::f32x4 a = (pg8::f32x4){u2f(xw.x << 16), u2f(xw.x & 0xffff0000u), u2f(xw.y << 16), u2f(xw.y & 0xffff0000u)} + acc[ai][bj][m][0];
                    const pg8::f32x4 b = (pg8::f32x4){u2f(xw.z << 16), u2f(xw.z & 0xffff0000u), u2f(xw.w << 16), u2f(xw.w & 0xffff0000u)} + acc[ai][bj][m][1];
                    ss += (a[0] * a[0] + a[1] * a[1]) + (a[2] * a[2] + a[3] * a[3]) + (b[0] * b[0] + b[1] * b[1]) + (b[2] * b[2] + b[3] * b[3]);
                    pg8::u32x4 w; w.x = pg8::cvt_pk_bf16(a[0], a[1]); w.y = pg8::cvt_pk_bf16(a[2], a[3]); w.z = pg8::cvt_pk_bf16(b[0], b[1]); w.w = pg8::cvt_pk_bf16(b[2], b[3]);
                    *(pg8::u32x4*)(x1b + o) = w;
                    float mx = fmaxf(fmaxf(fmaxf(fabsf(a[0]), fabsf(a[1])), fmaxf(fabsf(a[2]), fabsf(a[3]))), fmaxf(fmaxf(fabsf(b[0]), fabsf(b[1])), fmaxf(fabsf(b[2]), fabsf(b[3]))));
                    mx = fmaxf(mx, __shfl_xor(mx, 16)); mx = fmaxf(mx, __shfl_xor(mx, 32));
                    const float inv = mx > 0.f ? 119.0f / mx : 0.f;
                    unsigned pl = 0u, ph = 0u;
#pragma unroll
                    for (int i = 0; i < 4; ++i) {
                        const int qa = __float2int_rn(a[i] * inv), qb = __float2int_rn(b[i] * inv);
                        pl |= ((unsigned)(qa & 15) << (8 * i)) | ((unsigned)(qb & 15) << (8 * i + 4));
                        ph |= ((unsigned)(((qa + 8) >> 4) & 15) << (8 * i)) | ((unsigned)(((qb + 8) >> 4) & 15) << (8 * i + 4));
                    }
                    unsigned* cq = (unsigned*)(x1q + (size_t)row * D + (col & ~31));
                    cq[fq] = pl; cq[4 + fq] = ph;
                    if (fq == 0) xsc[(size_t)row * 32 + (col >> 5)] = mx * (1.0f / 119.0f);
                }
                ss += __shfl_xor(ss, 16); ss += __shfl_xor(ss, 32);
                if (fq == 0) ssq[(size_t)row * 16 + u.pn * 4 + wc] = ss;
            }
    }
};
#undef OUTPROJ_LD
struct EpiPeerQ {
    static constexpr bool PERM = true, AFTER_DRAIN = false, MIDSCALE = false;
    bf16_t* qp;
    __device__ __forceinline__ void operator()(const pg8::f32x4 (&acc)[2][2][4][2], const pg8::Unit& u, int wr, int wc, int fr, int fq) const {
#pragma unroll
        for (int ai = 0; ai < 2; ++ai)
#pragma unroll
            for (int m = 0; m < 4; ++m) {
                const int row = u.pm * 256 + ai * 128 + wr * 64 + m * 16 + fr;
#pragma unroll
                for (int bj = 0; bj < 2; ++bj) {
                    const pg8::f32x4 a = acc[ai][bj][m][0], b = acc[ai][bj][m][1];
                    pg8::u32x4 w; w.x = pg8::cvt_pk_bf16(a[0], a[1]); w.y = pg8::cvt_pk_bf16(a[2], a[3]); w.z = pg8::cvt_pk_bf16(b[0], b[1]); w.w = pg8::cvt_pk_bf16(b[2], b[3]);
                    *(pg8::u32x4*)(qp + ((((size_t)((row >> 5) * 8 + u.pn) * 2 + bj) * 8 + 2 * wc + (fq >> 1)) * 64 + (row & 31) + 32 * (fq & 1)) * 8) = w;
                }
            }
    }
};

typedef float f32x2v __attribute__((ext_vector_type(2)));
typedef __bf16 bf16x2v __attribute__((ext_vector_type(2)));
__device__ __forceinline__ unsigned cvtpk(float lo, float hi) { const f32x2v v = {lo, hi}; const bf16x2v b = __builtin_convertvector(v, bf16x2v); return __builtin_bit_cast(unsigned, b); }
__device__ __forceinline__ bf16x8 pack_step(const f32x16& x, int s) {
    u32x4 pkd; pkd.x = cvtpk(x[8 * s], x[8 * s + 1]); pkd.y = cvtpk(x[8 * s + 2], x[8 * s + 3]); pkd.z = cvtpk(x[8 * s + 4], x[8 * s + 5]); pkd.w = cvtpk(x[8 * s + 6], x[8 * s + 7]);
    return __builtin_bit_cast(bf16x8, pkd);
}
#define MFMA32(a, b, c) __builtin_amdgcn_mfma_f32_32x32x16_bf16((a), (b), (c), 0, 0, 0)
__device__ __forceinline__ void ph_attn(const Params& p) {
    unsigned char* ws = p.ws;
    const bf16_t* qh = (const bf16_t*)(ws + WS_QH); const bf16_t* kh = (const bf16_t*)(ws + WS_KH); const bf16_t* vT = (const bf16_t*)(ws + WS_VH);
    bf16_t* mixo = (bf16_t*)(ws + WS_MIX); float* ssb = (float*)(ws + WS_SSB);
    const int tid = phase_tid(), lane = tid & 63, r = lane & 31, hh = lane >> 5;
    const int gwave = (blockIdx.x * blockDim.x + tid) >> 6, nwave = (gridDim.x * blockDim.x) >> 6;
    bf16x8 tp[2];
#pragma unroll
    for (int ss = 0; ss < 2; ++ss)
#pragma unroll
        for (int e = 0; e < 8; ++e) { const int k = 16 * ss + 8 * (e >> 2) + 4 * hh + (e & 3); tp[ss][e] = (k > r) ? (short)0x3F80 : (short)0; }
    f32x16 zero16;
#pragma unroll
    for (int i = 0; i < 16; ++i) zero16[i] = 0.f;
    for (int u = gwave; u < NH * (S / 32); u += nwave) {
        const int h = u / (S / 32), t0 = (u % (S / 32)) * 32;
        bf16x8 bq[4];
#pragma unroll
        for (int s = 0; s < 4; ++s) bq[s] = *(const bf16x8*)(qh + (((size_t)(h * (S / 32) + (t0 >> 5)) * 4 + s) * 64 + lane) * 8);
        f32x16 ot[2] = {zero16, zero16};
        float carry = 0.f;
        for (int kt0 = t0; kt0 >= 0; kt0 -= 32) {
            bf16x8 ak[4], av[2][2];
#pragma unroll
            for (int s = 0; s < 4; ++s) ak[s] = *(const bf16x8*)(kh + (((size_t)(h * (S / 32) + (kt0 >> 5)) * 4 + s) * 64 + lane) * 8);
#pragma unroll
            for (int dt = 0; dt < 2; ++dt)
#pragma unroll
                for (int ss = 0; ss < 2; ++ss) av[dt][ss] = *(const bf16x8*)(vT + ((((size_t)(h * (S / 32) + (kt0 >> 5)) * 2 + dt) * 2 + ss) * 64 + lane) * 8);
            f32x16 st = zero16;
#pragma unroll
            for (int s = 0; s < 4; ++s) st = MFMA32(ak[s], bq[s], st);
            const bool diag = (kt0 == t0);
            f32x16 lom, lb;
            float csum = 0.f;
#pragma unroll
            for (int i = 0; i < 16; ++i) {
                const float z = st[i];
                const float sp2 = fmaxf(z, 0.f) + __builtin_amdgcn_logf(1.0f + __builtin_amdgcn_exp2f(-fabsf(z)));
                const bool valid = !diag || ((i & 3) + 8 * (i >> 2) + 4 * hh < r);
                lom[i] = valid ? -sp2 : 0.f;
                lb[i] = z - sp2;
                csum += lom[i];
            }
            f32x16 suf = MFMA32(tp[0], pack_step(lom, 0), zero16);
            suf = MFMA32(tp[1], pack_step(lom, 1), suf);
            f32x16 w;
#pragma unroll
            for (int i = 0; i < 16; ++i) {
                const bool valid = !diag || ((i & 3) + 8 * (i >> 2) + 4 * hh < r);
                w[i] = valid ? __builtin_amdgcn_exp2f(lb[i] + suf[i] + carry) : 0.f;
            }
            const bf16x8 w0 = pack_step(w, 0), w1 = pack_step(w, 1);
#pragma unroll
            for (int dt = 0; dt < 2; ++dt) { ot[dt] = MFMA32(av[dt][0], w0, ot[dt]); ot[dt] = MFMA32(av[dt][1], w1, ot[dt]); }
            carry += csum + __shfl_xor(csum, 32);
            if (__all(carry < CARRY_STOP)) break;
        }
        float oss = 0.f;
#pragma unroll
        for (int dt = 0; dt < 2; ++dt)
#pragma unroll
            for (int g = 0; g < 4; ++g) {
                uint2 o; o.x = cvtpk(ot[dt][4 * g], ot[dt][4 * g + 1]); o.y = cvtpk(ot[dt][4 * g + 2], ot[dt][4 * g + 3]);
                oss += (ot[dt][4 * g] * ot[dt][4 * g] + ot[dt][4 * g + 1] * ot[dt][4 * g + 1]) + (ot[dt][4 * g + 2] * ot[dt][4 * g + 2] + ot[dt][4 * g + 3] * ot[dt][4 * g + 3]);
                *(uint2*)(mixo + (size_t)(t0 + r) * D + h * HD + 32 * dt + 8 * g + 4 * hh) = o;
            }
        oss += __shfl_xor(oss, 32);
        if (hh == 0) ssb[(size_t)(t0 + r) * NH + h] = oss;
    }
}

constexpr int RG_LDS_CST = 0, RG_LDS_HIN = 16384, RG_LDS_P = 18432, RG_LDS_SSQ = 20480;
constexpr int RG_LDS_X = 22528, RG_XP = 1032, RG_LDS_O = 91904;
typedef unsigned u32x2 __attribute__((ext_vector_type(2)));
typedef __attribute__((address_space(3))) float lds_f;
typedef __attribute__((address_space(3))) unsigned char lds_b;
template <int CTRL, int ROWMASK>
__device__ __forceinline__ float dpp_mov(float oob, float x) {
    return __builtin_bit_cast(float, __builtin_amdgcn_update_dpp(__builtin_bit_cast(int, oob), __builtin_bit_cast(int, x), CTRL, ROWMASK, 0xf, false));
}
template <int CTRL, int ROWMASK>
__device__ __forceinline__ void scan_step(float (&av)[16], float (&bv)[16]) {
#pragma unroll
    for (int i = 0; i < 16; ++i) {
        const float ap = dpp_mov<CTRL, ROWMASK>(1.0f, av[i]), bp = dpp_mov<CTRL, ROWMASK>(0.0f, bv[i]);
        bv[i] = __builtin_fmaf(av[i], bp, bv[i]); av[i] *= ap;
    }
}
template <int PASS>
__device__ __forceinline__ void ph_rg(const Params& p, unsigned char* lds_raw) {
    float* lds = (float*)lds_raw;
    unsigned char* ws = p.ws;
    const bf16_t* xrg = (const bf16_t*)(ws + WS_XRG); const bf16_t* gg = (const bf16_t*)(ws + WS_GG); const bf16_t* wfrag = (const bf16_t*)(ws + WS_RGW);
    bf16_t* mix = (bf16_t*)(ws + WS_MIX);
    float* rgP = (float*)(ws + WS_RGP); float* rgH = (float*)(ws + WS_RGH);
    bf16_t* scA = (bf16_t*)(ws + WS_RGSA); bf16_t* scB = (bf16_t*)(ws + WS_RGSB);
    const int tid = phase_tid(), lane = tid & 63, r = lane & 31, hh = lane >> 5, n = __builtin_amdgcn_readfirstlane(tid >> 6);
    __syncthreads();
    if (PASS == 0) for (int e = tid; e < 8 * 2 * 8 * 32; e += NTHR) {
        const int q = e & 31, k = (e >> 5) & 7, h2 = (e >> 8) & 1, nn = e >> 9;
        const int c = 64 * nn + 32 * (q >> 4) + (q & 3) + 8 * ((q >> 2) & 3) + 4 * h2;
        float v;
        if (k < 4) v = p.in[I_CONV_W][k * DRG + c];
        else if (k == 4) v = p.in[I_CONV_B][c];
        else if (k == 5) v = p.in[I_RG_B_A][c];
        else if (k == 6) v = p.in[I_RG_B_X][c];
        else v = 8.0f * LOG2E * log1pf(__expf(-p.in[I_RG_LAMBDA][c]));
        lds[e] = v;
    }
    const unsigned lds0 = (unsigned)(size_t)((lds_b*)lds_raw);
    const unsigned cst_base = lds0 + (unsigned)((n * 2 + hh) * 1024);
    lds_f* hin_l = (lds_f*)(size_t)(lds0 + RG_LDS_HIN + (n * 2 + hh) * 128);
    lds_f* pc_l = (lds_f*)(size_t)(lds0 + RG_LDS_P + (n * 2 + hh) * 128);
    lds_b* xt = (lds_b*)(size_t)(lds0 + RG_LDS_X);
    lds_b* ot = (lds_b*)(size_t)(lds0 + RG_LDS_O);
    f32x16 zero16;
#pragma unroll
    for (int i = 0; i < 16; ++i) zero16[i] = 0.f;
    for (int ch = blockIdx.x; ch < NCHUNK; ch += gridDim.x) {
        const int t0 = ch * CHUNK;
        __syncthreads();
        if (PASS == 0) for (int ci = tid; ci < (CHUNK + 3) * 64; ci += NTHR) {
            const int row = ci >> 6, c16 = ci & 63, tt = t0 - 3 + row;
            u32x4 v = {0u, 0u, 0u, 0u};
            if (tt >= 0) v = *(const u32x4*)(xrg + (size_t)tt * DRG + 8 * c16);
            __attribute__((address_space(3))) u32x2* d = (__attribute__((address_space(3))) u32x2*)(xt + row * RG_XP + 16 * c16);
            d[0] = (u32x2){v.x, v.y}; d[1] = (u32x2){v.z, v.w};
        }
        if (PASS == 1) {
            const int c = 64 * n + lane;
            float h = 0.f;
            int k = 0;
            for (; k + 32 <= ch; k += 32) {
                float pv[32], hv[32];
#pragma unroll
                for (int j = 0; j < 32; ++j) { pv[j] = rgP[(k + j) * DRG + c]; hv[j] = rgH[(k + j) * DRG + c]; }
#pragma unroll
                for (int j = 0; j < 32; ++j) h = pv[j] * h + hv[j];
            }
            for (; k + 8 <= ch; k += 8) {
                float pv[8], hv[8];
#pragma unroll
                for (int j = 0; j < 8; ++j) { pv[j] = rgP[(k + j) * DRG + c]; hv[j] = rgH[(k + j) * DRG + c]; }
#pragma unroll
                for (int j = 0; j < 8; ++j) h = pv[j] * h + hv[j];
            }
            for (; k < ch; ++k) h = rgP[k * DRG + c] * h + rgH[k * DRG + c];
            lds[RG_LDS_HIN / 4 + (n * 2 + ((lane >> 2) & 1)) * 32 + 16 * (lane >> 5) + 4 * ((lane >> 3) & 3) + (lane & 3)] = h;
        } else {
            if (r == 0) {
#pragma unroll
                for (int q = 0; q < 32; ++q) { hin_l[q] = 0.f; pc_l[q] = 1.f; }
            }
        }
        __syncthreads();
#pragma unroll 1
        for (int tl = 0; tl < 2; ++tl) {
            const int tok = t0 + 32 * tl + r;
            unsigned cst_a = cst_base; asm volatile("" : "+v"(cst_a));
            const lds_f* cst = (const lds_f*)(size_t)cst_a;
            float xcv[32]; bf16x8 bx[4];
            if (PASS == 0) {
#pragma unroll
            for (int q = 0; q < 32; ++q) xcv[q] = cst[4 * 32 + q];
#pragma unroll
            for (int k = 0; k < 4; ++k) {
                const lds_b* xr = xt + (32 * tl + r + k) * RG_XP + (64 * n + 4 * hh) * 2;
#pragma unroll
                for (int m = 0; m < 8; ++m) {
                    const u32x2 xw = *(const __attribute__((address_space(3))) u32x2*)(xr + 16 * m);
                    xcv[4 * m + 0] += cst[k * 32 + 4 * m + 0] * bf2f(xw.x & 0xffffu); xcv[4 * m + 1] += cst[k * 32 + 4 * m + 1] * bf2f(xw.x >> 16);
                    xcv[4 * m + 2] += cst[k * 32 + 4 * m + 2] * bf2f(xw.y & 0xffffu); xcv[4 * m + 3] += cst[k * 32 + 4 * m + 3] * bf2f(xw.y >> 16);
                }
                __builtin_amdgcn_sched_barrier(0);
            }
#pragma unroll
            for (int s = 0; s < 4; ++s) {
                u32x4 pk; pk.x = cvtpk(xcv[8 * s], xcv[8 * s + 1]); pk.y = cvtpk(xcv[8 * s + 2], xcv[8 * s + 3]); pk.z = cvtpk(xcv[8 * s + 4], xcv[8 * s + 5]); pk.w = cvtpk(xcv[8 * s + 6], xcv[8 * s + 7]);
                bx[s] = __builtin_bit_cast(bf16x8, pk);
            }
            }
            float ss = 0.f;
            const bf16_t* wb = wfrag + ((size_t)n * 16 * 64 + lane) * 8; asm volatile("" : "+v"(wb));
#pragma unroll
            for (int jt = 0; jt < 2; ++jt) {
                float av[16], bv[16];
                const size_t sco = ((((size_t)(2 * ch + tl) * 8 + n) * 2 + jt) * 64 + lane) * 16;
                if (PASS == 0) {
#pragma unroll
                for (int g = 0; g < 2; ++g) {
                    f32x16 acc = zero16;
#pragma unroll
                    for (int s = 0; s < 4; ++s) {
                        const bf16x8 aw = *(const __attribute__((address_space(1))) bf16x8*)(wb + (((g * 2 + jt) * 4 + s) * 64) * 8);
                        acc = MFMA32(aw, bx[s], acc);
                    }
#pragma unroll
                    for (int i = 0; i < 16; ++i) {
                        const int q = 16 * jt + i;
                        const float pre = acc[i] + cst[(5 + g) * 32 + q];
                        const float sg = 1.0f / (1.0f + __builtin_amdgcn_exp2f(-LOG2E * pre));
                        if (g == 0) av[i] = __builtin_amdgcn_exp2f(-sg * cst[7 * 32 + q]);
                        else bv[i] = __builtin_amdgcn_sqrtf(fmaxf(__builtin_fmaf(-av[i], av[i], 1.0f), 0.f)) * (sg * xcv[q]);
                    }
                    __builtin_amdgcn_sched_barrier(0);
                }
                scan_step<0x111, 0xf>(av, bv); scan_step<0x112, 0xf>(av, bv); scan_step<0x114, 0xf>(av, bv); scan_step<0x118, 0xf>(av, bv);
                scan_step<0x142, 0xa>(av, bv);
                u32x4 sa0, sa1, sb0, sb1;
                sa0.x = cvtpk(av[0], av[1]); sa0.y = cvtpk(av[2], av[3]); sa0.z = cvtpk(av[4], av[5]); sa0.w = cvtpk(av[6], av[7]); sa1.x = cvtpk(av[8], av[9]); sa1.y = cvtpk(av[10], av[11]); sa1.z = cvtpk(av[12], av[13]); sa1.w = cvtpk(av[14], av[15]);
                sb0.x = cvtpk(bv[0], bv[1]); sb0.y = cvtpk(bv[2], bv[3]); sb0.z = cvtpk(bv[4], bv[5]); sb0.w = cvtpk(bv[6], bv[7]); sb1.x = cvtpk(bv[8], bv[9]); sb1.y = cvtpk(bv[10], bv[11]); sb1.z = cvtpk(bv[12], bv[13]); sb1.w = cvtpk(bv[14], bv[15]);
                *(u32x4*)(scA + sco) = sa0; *(u32x4*)(scA + sco + 8) = sa1; *(u32x4*)(scB + sco) = sb0; *(u32x4*)(scB + sco + 8) = sb1;
                } else {
                    const u32x4 sa0 = *(const u32x4*)(scA + sco), sa1 = *(const u32x4*)(scA + sco + 8), sb0 = *(const u32x4*)(scB + sco), sb1 = *(const u32x4*)(scB + sco + 8);
                    const unsigned wa[8] = {sa0.x, sa0.y, sa0.z, sa0.w, sa1.x, sa1.y, sa1.z, sa1.w}, wbb[8] = {sb0.x, sb0.y, sb0.z, sb0.w, sb1.x, sb1.y, sb1.z, sb1.w};
#pragma unroll
                    for (int k = 0; k < 8; ++k) { av[2 * k] = bf2f(wa[k] & 0xffffu); av[2 * k + 1] = bf2f(wa[k] >> 16); bv[2 * k] = bf2f(wbb[k] & 0xffffu); bv[2 * k + 1] = bf2f(wbb[k] >> 16); }
                }
                __builtin_amdgcn_sched_barrier(0);
#pragma unroll
                for (int i = 0; i < 16; ++i) {
                    const int q = 16 * jt + i;
                    const float h = __builtin_fmaf(av[i], hin_l[q], bv[i]);
                    if (r == 31) { hin_l[q] = h; if (PASS == 0) pc_l[q] *= av[i]; }
                    bv[i] = h;
                }
                if (PASS == 1) {
#pragma unroll
                    for (int g4 = 0; g4 < 4; ++g4) {
                        const int m = 4 * jt + g4;
                        const uint2 gw = *(const uint2*)(gg + ((((size_t)(tok >> 5) * 8 + n) * 8 + m) * 64 + lane) * 4);
                        const float o0 = bv[4 * g4] * bf2f(gw.x & 0xffffu), o1 = bv[4 * g4 + 1] * bf2f(gw.x >> 16), o2 = bv[4 * g4 + 2] * bf2f(gw.y & 0xffffu), o3 = bv[4 * g4 + 3] * bf2f(gw.y >> 16);
                        ss += (o0 * o0 + o1 * o1) + (o2 * o2 + o3 * o3);
                        *(__attribute__((address_space(3))) u32x2*)(ot + (32 * tl + r) * RG_XP + (64 * n + 8 * m + 4 * hh) * 2) = (u32x2){cvtpk(o0, o1), cvtpk(o2, o3)};
                    }
                }
                __builtin_amdgcn_sched_barrier(0);
            }
            if (PASS == 1) { ss += __shfl_xor(ss, 32); if (hh == 0) lds[RG_LDS_SSQ / 4 + (tl * 8 + n) * 32 + r] = ss; }
        }
        if (PASS == 0) {
            if (r == 0) {
#pragma unroll
                for (int m = 0; m < 8; ++m) {
                    const int c = 64 * n + 8 * m + 4 * hh;
                    *(f32x4*)(rgP + (size_t)ch * DRG + c) = (f32x4){pc_l[4 * m], pc_l[4 * m + 1], pc_l[4 * m + 2], pc_l[4 * m + 3]};
                    *(f32x4*)(rgH + (size_t)ch * DRG + c) = (f32x4){hin_l[4 * m], hin_l[4 * m + 1], hin_l[4 * m + 2], hin_l[4 * m + 3]};
                }
            }
        } else {
            __syncthreads();
            for (int j = 0; j < 8; ++j) {
                const int tr = 8 * n + j, tok = t0 + tr;
                float tot = 0.f;
#pragma unroll
                for (int w = 0; w < 8; ++w) tot += lds[RG_LDS_SSQ / 4 + ((tr >> 5) * 8 + w) * 32 + (tr & 31)];
                const float rn = rsqrtf(tot * (1.0f / DRG) + EPS);
                const __attribute__((address_space(3))) u32x2* op = (const __attribute__((address_space(3))) u32x2*)(ot + tr * RG_XP + 16 * lane);
                const u32x2 w0 = op[0], w1 = op[1];
                u32x4 o2; o2.x = cvtpk(bf2f(w0.x & 0xffffu) * rn, bf2f(w0.x >> 16) * rn); o2.y = cvtpk(bf2f(w0.y & 0xffffu) * rn, bf2f(w0.y >> 16) * rn);
                o2.z = cvtpk(bf2f(w1.x & 0xffffu) * rn, bf2f(w1.x >> 16) * rn); o2.w = cvtpk(bf2f(w1.y & 0xffffu) * rn, bf2f(w1.y >> 16) * rn);
                *((u32x4*)(mix + (size_t)tok * D + DSB) + lane) = o2;
            }
            if (tid < CHUNK) {
                const f32x4 s0 = *(const f32x4*)(ws + WS_SSB + (size_t)(t0 + tid) * NH * 4), s1 = *(const f32x4*)(ws + WS_SSB + (size_t)(t0 + tid) * NH * 4 + 16);
                ((float*)(ws + WS_RSB))[t0 + tid] = rsqrtf(((s0.x + s0.y) + (s0.z + s0.w) + (s1.x + s1.y) + (s1.z + s1.w)) * (1.0f / DSB) + EPS);
            }
        }
    }
}

__device__ __forceinline__ float kmax(float a, float b) { float r; asm("v_max_f32 %0, %1, %2" : "=v"(r) : "v"(a), "v"(b)); return r; }
__device__ __forceinline__ float kmin(float a, float b) { float r; asm("v_min_f32 %0, %1, %2" : "=v"(r) : "v"(a), "v"(b)); return r; }
__device__ __forceinline__ float key_tag(float f, unsigned keep, unsigned tag) { return __builtin_bit_cast(float, (__builtin_bit_cast(unsigned, f) & keep) | tag); }
#define TOPK_CE(a, b) do { const float hi_ = kmax(a, b), lo_ = kmin(a, b); a = hi_; b = lo_; } while (0)
__device__ __forceinline__ void sort16_desc(float (&v)[16]) { TOPK_CE(v[0], v[1]); TOPK_CE(v[2], v[3]); TOPK_CE(v[0], v[2]); TOPK_CE(v[1], v[3]); TOPK_CE(v[1], v[2]); TOPK_CE(v[4], v[5]); TOPK_CE(v[6], v[7]); TOPK_CE(v[4], v[6]); TOPK_CE(v[5], v[7]); TOPK_CE(v[5], v[6]); TOPK_CE(v[0], v[4]); TOPK_CE(v[2], v[6]); TOPK_CE(v[2], v[4]); TOPK_CE(v[1], v[5]); TOPK_CE(v[3], v[7]); TOPK_CE(v[3], v[5]); TOPK_CE(v[1], v[2]); TOPK_CE(v[3], v[4]); TOPK_CE(v[5], v[6]); TOPK_CE(v[8], v[9]); TOPK_CE(v[10], v[11]); TOPK_CE(v[8], v[10]); TOPK_CE(v[9], v[11]); TOPK_CE(v[9], v[10]); TOPK_CE(v[12], v[13]); TOPK_CE(v[14], v[15]); TOPK_CE(v[12], v[14]); TOPK_CE(v[13], v[15]); TOPK_CE(v[13], v[14]); TOPK_CE(v[8], v[12]); TOPK_CE(v[10], v[14]); TOPK_CE(v[10], v[12]); TOPK_CE(v[9], v[13]); TOPK_CE(v[11], v[15]); TOPK_CE(v[11], v[13]); TOPK_CE(v[9], v[10]); TOPK_CE(v[11], v[12]); TOPK_CE(v[13], v[14]); TOPK_CE(v[0], v[8]); TOPK_CE(v[4], v[12]); TOPK_CE(v[4], v[8]); TOPK_CE(v[2], v[10]); TOPK_CE(v[6], v[14]); TOPK_CE(v[6], v[10]); TOPK_CE(v[2], v[4]); TOPK_CE(v[6], v[8]); TOPK_CE(v[10], v[12]); TOPK_CE(v[1], v[9]); TOPK_CE(v[5], v[13]); TOPK_CE(v[5], v[9]); TOPK_CE(v[3], v[11]); TOPK_CE(v[7], v[15]); TOPK_CE(v[7], v[11]); TOPK_CE(v[3], v[5]); TOPK_CE(v[7], v[9]); TOPK_CE(v[11], v[13]); TOPK_CE(v[1], v[2]); TOPK_CE(v[3], v[4]); TOPK_CE(v[5], v[6]); TOPK_CE(v[7], v[8]); TOPK_CE(v[9], v[10]); TOPK_CE(v[11], v[12]); TOPK_CE(v[13], v[14]); }
__device__ __forceinline__ void merge16_desc(float (&a)[16], const float (&b)[16]) {
#pragma unroll
    for (int i = 0; i < 16; ++i) a[i] = kmax(a[i], b[15 - i]);
#pragma unroll
    for (int d = 8; d >= 1; d >>= 1)
#pragma unroll
        for (int i = 0; i < 16; ++i) if ((i & d) == 0) TOPK_CE(a[i], a[i + d]);
}
__device__ __forceinline__ void ph_topk(const Params& p, int* lds) {
    unsigned char* ws = p.ws;
    const bf16_t* qp = (const bf16_t*)(ws + WS_B); const bf16_t* subk = (const bf16_t*)(ws + WS_SUBK);
    int* seli = (int*)(ws + WS_SELI); float* selg = (float*)(ws + WS_SELG);
    const float* ssq = (const float*)(ws + WS_SSQ); float* rstd2 = (float*)(ws + WS_RSTD2);
    const int tid = phase_tid(), lane = tid & 63, r = lane & 31, hh = lane >> 5, hx = 4 * hh;
    const int gwave = (blockIdx.x * blockDim.x + tid) >> 6, nwave = (gridDim.x * blockDim.x) >> 6;
    constexpr int SK_OFF = 65536, SK_PITCH = 272;
    typedef __attribute__((address_space(3))) unsigned char lds_b;
    lds_b* skl = (lds_b*)lds + SK_OFF;
    const int w = tid >> 6;
    pg8::StaticOrder so; so.init(S, NQ, (int)gridDim.x, (int)blockIdx.x);
    pg8::Unit gu;
    for (int ui = 0; so.next(ui, gu); ++ui) {
        const int h = gu.pn, t0 = gu.pm * 256 + 32 * w, t = t0 + r;
        u32x4 skv[8]; bf16x8 bq[2][8];
#pragma unroll
        for (int j = 0; j < 8; ++j) {
            const int ci = tid + NTHR * j, row = ci >> 4, c16 = ci & 15;
            skv[j] = *(const u32x4*)(subk + ((size_t)h * 256 + row) * PHALF + 8 * c16);
        }
#pragma unroll
        for (int pp = 0; pp < 2; ++pp)
#pragma unroll
            for (int s = 0; s < 8; ++s) bq[pp][s] = *(const bf16x8*)(qp + ((((size_t)((t0 >> 5) * 8 + h) * 2 + pp) * 8 + s) * 64 + lane) * 8);
        __builtin_amdgcn_sched_barrier(0);
        __syncthreads();
#pragma unroll
        for (int j = 0; j < 8; ++j) {
            const int ci = tid + NTHR * j, row = ci >> 4, c16 = ci & 15;
            *(__attribute__((address_space(3))) u32x4*)(skl + row * SK_PITCH + 16 * c16) = skv[j];
        }
        __syncthreads();
        float tk[2][16];
#pragma unroll
        for (int pp = 0; pp < 2; ++pp) {
            f32x16 acc[4];
#pragma unroll
            for (int T = 0; T < 4; ++T)
#pragma unroll
                for (int i = 0; i < 16; ++i) acc[T][i] = 0.f;
            const lds_b* krow = skl + (pp * PNK + r) * SK_PITCH + 16 * hh;
#pragma unroll
            for (int s = 0; s < 8; ++s) {
                const bf16x8 b = bq[pp][s];
#pragma unroll
                for (int T = 0; T < 4; ++T) {
                    const bf16x8 a = *(const __attribute__((address_space(3))) bf16x8*)(krow + (32 * T) * SK_PITCH + 32 * s);
                    acc[T] = __builtin_amdgcn_mfma_f32_32x32x16_bf16(a, b, acc[T], 0, 0, 0);
                }
            }
            float kq[4][16];
#pragma unroll
            for (int T = 0; T < 4; ++T) {
#pragma unroll
                for (int i = 0; i < 16; ++i) {
                    const int nb = 32 * T + (i & 3) + 8 * (i >> 2);
                    kq[T][i] = key_tag(acc[T][i], ~127u, (unsigned)(127 - nb));
                }
                sort16_desc(kq[T]);
            }
            merge16_desc(kq[0], kq[1]); merge16_desc(kq[2], kq[3]); merge16_desc(kq[0], kq[2]);
            float m[16], po[16];
#pragma unroll
            for (int i = 0; i < 16; ++i) { m[i] = __builtin_bit_cast(float, __builtin_bit_cast(int, kq[0][i]) ^ hx); po[i] = __shfl_xor(m[i], 32); }
            merge16_desc(m, po);
#pragma unroll
            for (int i = 0; i < 16; ++i) tk[pp][i] = m[i];
        }
#pragma unroll
        for (int i = 0; i < 16; ++i) { lds[i * NTHR + tid] = __builtin_bit_cast(int, tk[0][i]); lds[(16 + i) * NTHR + tid] = __builtin_bit_cast(int, tk[1][i]); }
        const float (&v0)[16] = tk[0]; const float (&v1)[16] = tk[1];
#define CKEY(a, b) key_tag(v0[a] + v1[b], ~255u, (unsigned)(255 - ((a) * 16 + (b))))
        const float NEGK = __builtin_bit_cast(float, 0xff800000u);
        float bk[16], l1[16], ga[16], gb[16];
#pragma unroll
        for (int b = 0; b < 16; ++b) bk[b] = CKEY(0, b);
#pragma unroll
        for (int b = 0; b < 16; ++b) l1[b] = b < 8 ? CKEY(1, b) : NEGK;
        ga[0] = CKEY(2, 0); ga[1] = CKEY(2, 1); ga[2] = CKEY(2, 2); ga[3] = CKEY(2, 3); ga[4] = CKEY(2, 4);
        ga[5] = CKEY(3, 0); ga[6] = CKEY(3, 1); ga[7] = CKEY(3, 2); ga[8] = CKEY(3, 3);
        ga[9] = CKEY(4, 0); ga[10] = CKEY(4, 1); ga[11] = CKEY(4, 2); ga[12] = CKEY(5, 0); ga[13] = CKEY(5, 1); ga[14] = NEGK; ga[15] = NEGK;
        gb[0] = CKEY(6, 0); gb[1] = CKEY(6, 1); gb[2] = CKEY(7, 0); gb[3] = CKEY(7, 1);
#pragma unroll
        for (int a = 8; a < 16; ++a) gb[a - 4] = CKEY(a, 0);
        gb[12] = NEGK; gb[13] = NEGK; gb[14] = NEGK; gb[15] = NEGK;
#undef CKEY
        sort16_desc(ga); sort16_desc(gb);
        merge16_desc(bk, l1); merge16_desc(ga, gb); merge16_desc(bk, ga);
        float ssum = 0.f;
#pragma unroll
        for (int i = 0; i < 4; ++i) { const f32x4 q4 = *(const f32x4*)(ssq + (size_t)t * 16 + 4 * i); ssum += (q4.x + q4.y) + (q4.z + q4.w); }
        const float rs = rsqrtf(ssum * (1.0f / D) + EPS);
        float e[16], sum = 0.f; const float mx = bk[0];
#pragma unroll
        for (int i = 0; i < 16; ++i) { e[i] = __expf((bk[i] - mx) * rs); sum += e[i]; }
        const float inv = 1.0f / sum;
        int eidx[16];
#pragma unroll
        for (int i = 0; i < 16; ++i) {
            const int code = 255 - (__builtin_bit_cast(int, bk[i]) & 255), a = code >> 4, b = code & 15;
            const int i1 = 127 - (lds[a * NTHR + tid] & 127), i2 = 127 - (lds[(16 + b) * NTHR + tid] & 127);
            eidx[i] = i1 * PNK + i2; e[i] *= inv;
        }
        if (hh == 0) {
            int4* o = (int4*)(seli + (size_t)t * 128 + h * 16);
#pragma unroll
            for (int i = 0; i < 4; ++i) o[i] = make_int4(eidx[4 * i], eidx[4 * i + 1], eidx[4 * i + 2], eidx[4 * i + 3]);
            if (h == 0) rstd2[t] = rs;
        } else {
            f32x4* o = (f32x4*)(selg + (size_t)t * 128 + h * 16);
#pragma unroll
            for (int i = 0; i < 4; ++i) o[i] = (f32x4){e[4 * i], e[4 * i + 1], e[4 * i + 2], e[4 * i + 3]};
        }
    }
}

typedef __bf16 bf16x2_t __attribute__((ext_vector_type(2)));
typedef float f32x2 __attribute__((ext_vector_type(2)));
template <int NV, int XS0, int XS1, int XS2>
__device__ __forceinline__ void reduce_over8(float (&v)[NV], int sel) {
    { const bool up = sel & 1;
#pragma unroll
      for (int i = 0; i < NV / 2; ++i) { const float a = v[2 * i], b = v[2 * i + 1]; v[i] = (up ? b : a) + __shfl_xor(up ? a : b, XS0); } }
    { const bool up = (sel >> 1) & 1;
#pragma unroll
      for (int i = 0; i < NV / 4; ++i) { const float a = v[2 * i], b = v[2 * i + 1]; v[i] = (up ? b : a) + __shfl_xor(up ? a : b, XS1); } }
    { const bool up = (sel >> 2) & 1;
#pragma unroll
      for (int i = 0; i < NV / 8; ++i) { const float a = v[2 * i], b = v[2 * i + 1]; v[i] = (up ? b : a) + __shfl_xor(up ? a : b, XS2); } }
}
__device__ __forceinline__ void peer_load_idx(const unsigned char* ws, int t, int rsl, int (&ei)[16]) {
    const unsigned off = (unsigned)WS_SELI + ((unsigned)t * 128u + 16u * (unsigned)rsl) * 4u;
#pragma unroll
    for (int j = 0; j < 4; ++j) { const int4 v = *(const int4*)(ws + (off + 16u * j)); ei[4 * j] = v.x; ei[4 * j + 1] = v.y; ei[4 * j + 2] = v.z; ei[4 * j + 3] = v.w; }
}
template <int PASS>
__device__ __forceinline__ void peer_load_rows(const unsigned char* ws, int t, int sl, int rsl, int c, const int (&ei)[16], u32x4 (&row)[16], u32x4 (&aux)[4]) {
    const unsigned tab = (unsigned)(PASS == 0 ? WS_UB : WS_VB) + (unsigned)sl * (unsigned)(NEXP * 128) + 16u * (unsigned)c;
#pragma unroll
    for (int i = 0; i < 16; ++i) row[i] = *(const u32x4*)(ws + (tab + (unsigned)ei[i] * 128u));
    const unsigned xo = (unsigned)WS_X1Q + (unsigned)t * (unsigned)D + 256u * sl + 32u * c;
    aux[0] = *(const u32x4*)(ws + xo); aux[1] = *(const u32x4*)(ws + (xo + 16u));
    aux[2].x = *(const unsigned*)(ws + ((unsigned)WS_XSC + ((unsigned)t * 32u + 8u * sl + c) * 4u));
}
constexpr int PEER_IMG_PITCH = 136, PEER_IMG_BYTES = 128 * PEER_IMG_PITCH;
template <int PASS  >
__device__ __forceinline__ void peer_compute(const Params& p, unsigned char* lds, int lane_w, int t, int sl, int rsl, int c, const u32x4 (&row)[16], const u32x4 (&aux)[4]) {
    unsigned char* ws = p.ws;
    if (PASS == 0) {
        const u32x4 x0 = aux[0], x1_ = aux[1]; const unsigned xl[4] = {x0.x, x0.y, x0.z, x0.w}, xh[4] = {x1_.x, x1_.y, x1_.z, x1_.w};
        const unsigned xsu = aux[2].x; const float xs = u2f(xsu);
        float pd[16];
#pragma unroll
        for (int i = 0; i < 16; ++i) {
            const u32x4 rw = row[i]; const unsigned w4[4] = {rw.x, rw.y, rw.z, rw.w};
            int al = 0, ah = 0;
#pragma unroll
            for (int j = 0; j < 4; ++j) { al = __builtin_amdgcn_sdot8((int)w4[j], (int)xl[j], al, false); ah = __builtin_amdgcn_sdot8((int)w4[j], (int)xh[j], ah, false); }
            pd[i] = (float)(16 * ah + al) * xs;
        }
        reduce_over8<16, 1, 2, 4>(pd, c);
        const unsigned po = (unsigned)WS_PD + (((unsigned)sl * S + (unsigned)t) * 128u + 16u * rsl + c) * 4u;
        *(float*)(ws + po) = pd[0]; *(float*)(ws + (po + 32u)) = pd[1];
    }
}
template <int PASS>
__device__ __forceinline__ void peer_stream(const Params& p, unsigned char* lds, int lane_w, int sl, int t0, int dt, int n) {
    const unsigned char* ws = p.ws;
    const int lane = lane_w & 63, rsl = lane >> 3, c = lane & 7;
    int eiA[16], eiB[16]; u32x4 rowA[16], rowB[16], auxA[4], auxB[4];
    if (n <= 0) return;
    peer_load_idx(ws, t0, rsl, eiA);
    peer_load_rows<PASS>(ws, t0, sl, rsl, c, eiA, rowA, auxA);
    if (n > 1) peer_load_idx(ws, t0 + dt, rsl, eiB);
    for (int i = 0; i < n; i += 2) {
        const int t = t0 + i * dt;
        if (i + 1 < n) peer_load_rows<PASS>(ws, t + dt, sl, rsl, c, eiB, rowB, auxB);
        if (i + 2 < n) peer_load_idx(ws, t + 2 * dt, rsl, eiA);
        peer_compute<PASS>(p, lds, lane_w, t, sl, rsl, c, rowA, auxA);
        if (i + 1 < n) {
            if (i + 2 < n) peer_load_rows<PASS>(ws, t + 2 * dt, sl, rsl, c, eiA, rowA, auxA);
            if (i + 3 < n) peer_load_idx(ws, t + 3 * dt, rsl, eiB);
            peer_compute<PASS>(p, lds, lane_w, t + dt, sl, rsl, c, rowB, auxB);
        }
    }
}
__device__ __forceinline__ void peerv_load_idx(const unsigned char* ws, int t, int hf, int rsl, int (&ei)[8]) {
    const unsigned off = (unsigned)WS_SELI + ((unsigned)t * 128u + 16u * (unsigned)rsl + 8u * (unsigned)hf) * 4u;
    const int4 v0 = *(const int4*)(ws + off), v1 = *(const int4*)(ws + (off + 16u));
    ei[0] = v0.x; ei[1] = v0.y; ei[2] = v0.z; ei[3] = v0.w; ei[4] = v1.x; ei[5] = v1.y; ei[6] = v1.z; ei[7] = v1.w;
}
__device__ __forceinline__ void peerv_load_rows(const unsigned char* ws, int sl, int c, const int (&ei)[8], u32x4 (&row)[8]) {
    const unsigned tab = (unsigned)WS_VB + (unsigned)sl * (unsigned)(NEXP * 128) + 16u * (unsigned)c;
#pragma unroll
    for (int i = 0; i < 8; ++i) row[i] = *(const u32x4*)(ws + (tab + (unsigned)ei[i] * 128u));
}
struct PeerVAux { u32x4 cp; unsigned cs; unsigned xo[4]; };
__device__ __forceinline__ void peerv_load_aux(const unsigned char* ws, int t, int sl, int lane, PeerVAux& a) {
    a.cp = *(const u32x4*)(ws + ((unsigned)WS_CBUF + (unsigned)t * 128u + 16u * (unsigned)(lane & 7)));
    a.cs = *(const unsigned*)(ws + ((unsigned)WS_CSC + (unsigned)t * 4u));
    const unsigned xo = (unsigned)WS_A + ((unsigned)t * (unsigned)D + 256u * sl + (unsigned)lane) * 2u;
    a.xo[0] = *(const bf16_t*)(ws + xo); a.xo[1] = *(const bf16_t*)(ws + (xo + 128u)); a.xo[2] = *(const bf16_t*)(ws + (xo + 256u)); a.xo[3] = *(const bf16_t*)(ws + (xo + 384u));
}
template <int HF>
__device__ __forceinline__ void peerv_half(lds_b* img, int lane, const u32x4 (&row)[8], const PeerVAux& a, int (&acc)[4]) {
    const int rsl = lane >> 3, c = lane & 7;
#pragma unroll
    for (int i = 0; i < 8; ++i) {
        const u32x4 rw = row[i];
        __attribute__((address_space(3))) u32x2* d = (__attribute__((address_space(3))) u32x2*)(img + (16 * rsl + i) * PEER_IMG_PITCH + 16 * c);
        d[0] = (u32x2){rw.x, rw.y}; d[1] = (u32x2){rw.z, rw.w};
    }
    const unsigned cpl = HF == 0 ? a.cp.x : a.cp.y, cph = HF == 0 ? a.cp.z : a.cp.w;
    asm volatile("s_waitcnt lgkmcnt(0)" ::: "memory");
    const unsigned ra = (unsigned)(size_t)img + (unsigned)((lane & 15) * PEER_IMG_PITCH + 8 * (lane >> 4));
#define PEER_TR4(R0, R1, R2, R3, RS) asm volatile("ds_read_b64_tr_b4 %0, %4 offset:%5\n\tds_read_b64_tr_b4 %1, %4 offset:%6\n\tds_read_b64_tr_b4 %2, %4 offset:%7\n\tds_read_b64_tr_b4 %3, %4 offset:%8" \
            : "=&v"(R0), "=&v"(R1), "=&v"(R2), "=&v"(R3) : "v"(ra), "i"((RS) * 16 * PEER_IMG_PITCH), "i"((RS) * 16 * PEER_IMG_PITCH + 32), "i"((RS) * 16 * PEER_IMG_PITCH + 64), "i"((RS) * 16 * PEER_IMG_PITCH + 96) : "memory")
#define PEER_USE4(R0, R1, R2, R3, RS, WAITSTR) do { \
            asm volatile(WAITSTR : "+v"(R0), "+v"(R1), "+v"(R2), "+v"(R3) :: "memory"); \
            const int cl_ = __builtin_amdgcn_readlane((int)cpl, RS), ch_ = __builtin_amdgcn_readlane((int)cph, RS); \
            const unsigned lo4_[4] = {R0.x, R1.x, R2.x, R3.x}; \
            _Pragma("unroll") for (int tcg = 0; tcg < 4; ++tcg) acc[tcg] += 16 * __builtin_amdgcn_sdot8((int)lo4_[tcg], ch_, 0, false) + __builtin_amdgcn_sdot8((int)lo4_[tcg], cl_, 0, false); } while (0)
    {
        u32x2 a0, a1, a2, a3, b0, b1, b2, b3;
        PEER_TR4(a0, a1, a2, a3, 0);
        PEER_TR4(b0, b1, b2, b3, 1); PEER_USE4(a0, a1, a2, a3, 0, "s_waitcnt lgkmcnt(4)");
        PEER_TR4(a0, a1, a2, a3, 2); PEER_USE4(b0, b1, b2, b3, 1, "s_waitcnt lgkmcnt(4)");
        PEER_TR4(b0, b1, b2, b3, 3); PEER_USE4(a0, a1, a2, a3, 2, "s_waitcnt lgkmcnt(4)");
        PEER_TR4(a0, a1, a2, a3, 4); PEER_USE4(b0, b1, b2, b3, 3, "s_waitcnt lgkmcnt(4)");
        PEER_TR4(b0, b1, b2, b3, 5); PEER_USE4(a0, a1, a2, a3, 4, "s_waitcnt lgkmcnt(4)");
        PEER_TR4(a0, a1, a2, a3, 6); PEER_USE4(b0, b1, b2, b3, 5, "s_waitcnt lgkmcnt(4)");
        PEER_TR4(b0, b1, b2, b3, 7); PEER_USE4(a0, a1, a2, a3, 6, "s_waitcnt lgkmcnt(4)");
        PEER_USE4(b0, b1, b2, b3, 7, "s_waitcnt lgkmcnt(0)");
    }
#undef PEER_TR4
#undef PEER_USE4
}
__device__ __forceinline__ void peerv_stream(const Params& p, unsigned char* lds, int tid_, int sl, int t0, int dt, int n) {
    const unsigned char* ws = p.ws;
    const int lane = tid_ & 63, rsl = lane >> 3, c = lane & 7;
    lds_b* img = (lds_b*)lds + (tid_ >> 6) * PEER_IMG_BYTES;
    for (int e = lane; e < 64 * (PEER_IMG_PITCH / 8); e += 64) {
        const int zr = e / (PEER_IMG_PITCH / 8), zc = e % (PEER_IMG_PITCH / 8);
        *(__attribute__((address_space(3))) u32x2*)(img + (16 * (zr >> 3) + 8 + (zr & 7)) * PEER_IMG_PITCH + 8 * zc) = (u32x2){0u, 0u};
    }
    if (n <= 0) return;
    int ei0[8], ei1[8]; u32x4 rowA[8], rowB[8]; PeerVAux ax, axn;
    peerv_load_idx(ws, t0, 0, rsl, ei0);
    peerv_load_rows(ws, sl, c, ei0, rowA); peerv_load_aux(ws, t0, sl, lane, ax);
    peerv_load_idx(ws, t0, 1, rsl, ei1);
    for (int i = 0; i < n; ++i) {
        const int t = t0 + i * dt; const bool more = i + 1 < n;
        int acc[4] = {0, 0, 0, 0};
        peerv_load_rows(ws, sl, c, ei1, rowB);
        if (more) peerv_load_idx(ws, t + dt, 0, rsl, ei0);
        peerv_half<0>(img, lane, rowA, ax, acc);
        if (more) { peerv_load_rows(ws, sl, c, ei0, rowA); peerv_load_aux(ws, t + dt, sl, lane, axn); peerv_load_idx(ws, t + dt, 1, rsl, ei1); }
        peerv_half<1>(img, lane, rowB, ax, acc);
        const float cs = u2f(ax.cs);
#pragma unroll
        for (int tcg = 0; tcg < 4; ++tcg) {
            const unsigned oo = ((unsigned)t * (unsigned)D + 256u * sl + 64u * tcg + (unsigned)lane) * 4u;
            *(float*)((unsigned char*)p.out + oo) = bf2f(ax.xo[tcg]) + (float)acc[tcg] * cs;
        }
        if (more) ax = axn;
    }
}
template <int PASS>
__device__ __forceinline__ void ph_peer(const Params& p, unsigned char* lds) {
    const int tid_ = phase_tid();
    const int lane = tid_ & 63, w = tid_ >> 6, b = blockIdx.x, G = gridDim.x;
    if ((G & 7) == 0) {
        const int g = b & 7, nsw = (G >> 3) * 2 * (NTHR / 64), t0 = ((g >> 2) * (G >> 3) + (b >> 3)) * (NTHR / 64) + w;
        if (PASS == 0) peer_stream<0>(p, lds, tid_, g & 3, t0, nsw, t0 < S ? (S - 1 - t0) / nsw + 1 : 0);
        else peerv_stream(p, lds, tid_, g & 3, t0, nsw, t0 < S ? (S - 1 - t0) / nsw + 1 : 0);
    } else {
        const int nw = G * (NTHR / 64), it0 = b * (NTHR / 64) + w;
        for (int it = it0; it < S * 4; it += nw) { if (PASS == 0) peer_stream<0>(p, lds, tid_, it & 3, it >> 2, 0, 1); else peerv_stream(p, lds, tid_, it & 3, it >> 2, 0, 1); }
    }
}
__device__ __forceinline__ void ph_peer_combine(const Params& p) {
    unsigned char* ws = p.ws;
    const int* seli = (const int*)(ws + WS_SELI); const float* selg = (const float*)(ws + WS_SELG); const float* rstd2 = (const float*)(ws + WS_RSTD2);
    const float2* uvsc = (const float2*)(ws + WS_USC);
    const float* pd = (const float*)(ws + WS_PD);
    unsigned* cpl = (unsigned*)(ws + WS_CBUF); float* csc = (float*)(ws + WS_CSC);
    const int tid_ = phase_tid(), lane = tid_ & 63, gwave = (blockIdx.x * blockDim.x + tid_) >> 6, nwave = (gridDim.x * blockDim.x) >> 6;
    constexpr int TT = 4;
    for (int tb = gwave; tb < S; tb += TT * nwave) {
        float dsum[TT][2], sg[TT][2], rsd[TT]; int ei[TT][2];
#pragma unroll
        for (int k = 0; k < TT; ++k) {
            const int t = min(tb + k * nwave, S - 1);
#pragma unroll
            for (int hf = 0; hf < 2; ++hf) {
                const int e = t * 128 + 64 * hf + lane;
                ei[k][hf] = seli[e]; sg[k][hf] = selg[e];
                float d = 0.f;
#pragma unroll
                for (int g = 0; g < 4; ++g) d += pd[(size_t)g * S * 128 + e];
                dsum[k][hf] = d;
            }
            rsd[k] = rstd2[t];
        }
        float2 sc2[TT][2];
#pragma unroll
        for (int k = 0; k < TT; ++k)
#pragma unroll
            for (int hf = 0; hf < 2; ++hf) sc2[k][hf] = uvsc[ei[k][hf]];
#pragma unroll
        for (int k = 0; k < TT; ++k) {
            const int t = tb + k * nwave;
            if (t >= S) break;
            float cf[2];
#pragma unroll
            for (int hf = 0; hf < 2; ++hf) cf[hf] = sg[k][hf] * gelu_tanh(dsum[k][hf] * sc2[k][hf].x * rsd[k]) * sc2[k][hf].y;
            float m = fmaxf(fabsf(cf[0]), fabsf(cf[1]));
#pragma unroll
            for (int o = 1; o < 64; o <<= 1) m = fmaxf(m, __shfl_xor(m, o));
            const float inv = m > 0.f ? 119.0f / m : 0.f;
#pragma unroll
            for (int hf = 0; hf < 2; ++hf) {
                const int q = __float2int_rn(cf[hf] * inv);
                unsigned dl = (unsigned)(q & 15) << (4 * (lane & 7)), dh = (unsigned)(((q + 8) >> 4) & 15) << (4 * (lane & 7));
                dl |= __shfl_xor(dl, 1); dh |= __shfl_xor(dh, 1); dl |= __shfl_xor(dl, 2); dh |= __shfl_xor(dh, 2); dl |= __shfl_xor(dl, 4); dh |= __shfl_xor(dh, 4);
                if ((lane & 7) == 0) {
                    const int dk = 8 * hf + (lane >> 3), rs = dk >> 1, half = dk & 1;
                    cpl[(size_t)t * 32 + 4 * rs + half] = dl; cpl[(size_t)t * 32 + 4 * rs + 2 + half] = dh;
                }
            }
            if (lane == 0) csc[t] = m * (1.0f / 119.0f);
        }
    }
}

#define LAS __attribute__((address_space(3)))
#define XB_TMO      128
#define XB_XCNT(j)  (256  + 64 * (j))
#define XB_XSUB(j)  (1280 + 64 * (j))
#define XB_XGEN(j)  (2304 + 64 * (j))
#define XB_TOP      3328
#define XB_TOPGEN   3392
#define XCD_BAR_WORDS 3456
#define XB_SPIN_CAP (1u << 18)
__device__ __forceinline__ unsigned xb_ld(unsigned* p)              { return __hip_atomic_load(p, __ATOMIC_RELAXED, __HIP_MEMORY_SCOPE_AGENT); }
__device__ __forceinline__ unsigned xb_add(unsigned* p, unsigned v) { return __hip_atomic_fetch_add(p, v, __ATOMIC_RELAXED, __HIP_MEMORY_SCOPE_AGENT); }
__device__ __forceinline__ unsigned xb_xcc_id() { return (unsigned)__builtin_amdgcn_s_getreg((3 << 11) | 20) & 0xFu; }
#define XB_SPIN(cond, bar) do { unsigned _sp = 0; while (cond) { __builtin_amdgcn_s_sleep(1); \
    if ((++_sp & 255u) == 0u) { if (xb_ld(&(bar)[XB_TMO])) break; if (_sp > XB_SPIN_CAP) { atomicAdd(&(bar)[XB_TMO], 1u); break; } } } } while (0)
struct XcdBarrier { unsigned* bar; unsigned x; volatile LAS unsigned* st; };
__device__ __forceinline__ XcdBarrier xcd_barrier_post(unsigned* bar, volatile LAS unsigned* st) {
    XcdBarrier b; b.bar = bar; b.x = xb_xcc_id(); b.st = st;
    if (threadIdx.x == 0) (void)xb_add(&bar[XB_XCNT(b.x)], 1u);
    return b;
}
__device__ __forceinline__ void xcd_barrier_complete(unsigned* bar, unsigned x, unsigned& nloc, unsigned& nx) {
    const unsigned G = gridDim.x * gridDim.y * gridDim.z;
    unsigned sum, cnt, mine, sp = 0u;
    for (;;) {
        sum = 0u; cnt = 0u; mine = 0u;
#pragma unroll
        for (unsigned j = 0; j < 16; ++j) { const unsigned c = xb_ld(&bar[XB_XCNT(j)]); sum += c; cnt += (c > 0u) ? 1u : 0u; mine = (j == x) ? c : mine; }
        if (sum == G) break;
        __builtin_amdgcn_s_sleep(1);
        if ((++sp & 255u) == 0u) { if (xb_ld(&bar[XB_TMO])) break; if (sp > XB_SPIN_CAP) { atomicAdd(&bar[XB_TMO], 1u); break; } }
    }
    nloc = mine > 0u ? mine : 1u; nx = cnt > 0u ? cnt : 1u;
}
__device__ __forceinline__ void xcd_barrier(const XcdBarrier& b) {
    asm volatile("s_waitcnt vmcnt(0)" ::: "memory");
    __syncthreads();
    if (threadIdx.x == 0) {
        unsigned* bar = b.bar;
        __builtin_amdgcn_s_waitcnt(0);
        unsigned nloc = b.st[0], nx = b.st[1];
        if (nloc == 0u) { xcd_barrier_complete(bar, b.x, nloc, nx); b.st[0] = nloc; b.st[1] = nx; }
        const unsigned old = xb_add(&bar[XB_XSUB(b.x)], 1u);
        const unsigned gen = old / nloc;
        if (old + 1u == (gen + 1u) * nloc) {
            __builtin_amdgcn_fence(__ATOMIC_RELEASE, "agent");
            asm volatile("s_waitcnt vmcnt(0)" ::: "memory");
            const unsigned og = xb_add(&bar[XB_TOP], 1u);
            const unsigned tg = og / nx;
            if (og + 1u == (tg + 1u) * nx) xb_add(&bar[XB_TOPGEN], 1u);
            else XB_SPIN(xb_ld(&bar[XB_TOPGEN]) == tg, bar);
            __builtin_amdgcn_fence(__ATOMIC_ACQUIRE, "agent");
            xb_add(&bar[XB_XGEN(b.x)], 1u);
            asm volatile("s_waitcnt vmcnt(0)" ::: "memory");
        } else {
            XB_SPIN(xb_ld(&bar[XB_XGEN(b.x)]) == gen, bar);
            __builtin_amdgcn_fence(__ATOMIC_ACQUIRE, "agent");
            asm volatile("s_waitcnt vmcnt(0)" ::: "memory");
        }
    }
    __syncthreads();
}

constexpr int LDS_MISC = 158720;
constexpr int LDS_BYTES = LDS_MISC + 1024;

__global__ void __launch_bounds__(NTHR, 2) hymba_fwd(Params p) {
    extern __shared__ __attribute__((aligned(16))) unsigned char lds[];
    volatile LAS unsigned* misc = (volatile LAS unsigned*)((LAS unsigned char*)lds + LDS_MISC);
    if (threadIdx.x < 4) misc[threadIdx.x] = 0u;
    __syncthreads();
    XcdBarrier bar = xcd_barrier_post((unsigned*)(p.ws + WS_CTL), misc);

    PG8_LAS unsigned char* ring = (PG8_LAS unsigned char*)lds;
    unsigned char* ws = p.ws;
    ph_prep(p, lds);                          xcd_barrier(bar);
    {
        pg8::Gemm g{(const bf16_t*)(ws + WS_A), (const bf16_t*)(ws + WS_WINT), S, NPROJ, D}; pg8::StaticOrder so; so.init(S, NPROJ, (int)gridDim.x, (int)blockIdx.x);
        EpiInProj E{(const float*)(ws + WS_RSTD1), p.in[I_Q_NORM], p.in[I_K_NORM], (bf16_t*)(ws + WS_QH), (bf16_t*)(ws + WS_KH), (bf16_t*)(ws + WS_VH), (bf16_t*)(ws + WS_XRG), (bf16_t*)(ws + WS_GG)};
        pg8::gemm_phase<EpiInProj, pg8::StaticOrder, true, true>(ring, g, so, E);
        const int G = (int)gridDim.x, nunits = (S / 256) * (NPROJ / 256), rem = nunits % G, b = (int)blockIdx.x;
        const int tid_ = phase_tid(), w = tid_ >> 6, lane = tid_ & 63;
        if (rem == 0) ph_tables(p, b * (NTHR / 64) + w, G * (NTHR / 64), lane);
        else if (b >= rem) ph_tables(p, (b - rem) * (NTHR / 64) + w, (G - rem) * (NTHR / 64), lane);
    }
    xcd_barrier(bar);
    ph_attn(p); ph_rg<0>(p, lds);             xcd_barrier(bar);
    ph_rg<1>(p, lds);                         xcd_barrier(bar);
    {
        pg8::Gemm g{(const bf16_t*)(ws + WS_MIX), (const bf16_t*)(ws + WS_WOUTT), S, D, D}; pg8::StaticOrder so; so.init(S, D, (int)gridDim.x, (int)blockIdx.x);
        EpiOutProj E{(const float*)(ws + WS_RSB), p.in[I_X], (bf16_t*)(ws + WS_A), (float*)(ws + WS_SSQ), ws + WS_X1Q, (float*)(ws + WS_XSC)};
        pg8::gemm_phase<EpiOutProj, pg8::StaticOrder, true, true>(ring, g, so, E);
    }
    xcd_barrier(bar);
    {
        pg8::Gemm g{(const bf16_t*)(ws + WS_A), (const bf16_t*)(ws + WS_WQT), S, NQ, D}; pg8::StaticOrder so; so.init(S, NQ, (int)gridDim.x, (int)blockIdx.x);
        EpiPeerQ E{(bf16_t*)(ws + WS_B)};
        pg8::gemm_phase<EpiPeerQ, pg8::StaticOrder, true, true>(ring, g, so, E);
    }
    asm volatile("s_waitcnt vmcnt(0)" ::: "memory"); __syncthreads();
    ph_topk(p, (int*)lds);                    xcd_barrier(bar);
    ph_peer<0>(p, lds);                       xcd_barrier(bar);
    ph_peer_combine(p);                       xcd_barrier(bar);
    ph_peer<1>(p, lds);
}

extern "C" void kernel_launch(void* const* d_in, const int* in_sizes, int n_in, void* d_out, int out_size, void* d_ws, size_t ws_size, hipStream_t stream) {
    static int grid = 0;
    if (grid == 0) {
        if (n_in != 20 || out_size != S * D || ws_size < WS_END) { fprintf(stderr, "kernel_launch: unexpected shapes (n_in %d out %d ws %zu)\n", n_in, out_size, ws_size); grid = -1; return; }
        int dev = 0, cus = 0, per_cu = 0;
        if (hipGetDevice(&dev) != hipSuccess || hipDeviceGetAttribute(&cus, hipDeviceAttributeMultiprocessorCount, dev) != hipSuccess) { grid = -1; return; }
        if (hipFuncSetAttribute((const void*)hymba_fwd, hipFuncAttributeMaxDynamicSharedMemorySize, LDS_BYTES) != hipSuccess) { fprintf(stderr, "kernel_launch: hipFuncSetAttribute failed\n"); grid = -1; return; }
        if (hipOccupancyMaxActiveBlocksPerMultiprocessor(&per_cu, (const void*)hymba_fwd, NTHR, LDS_BYTES) != hipSuccess || per_cu < 1) { fprintf(stderr, "kernel_launch: occupancy query says %d blocks per CU\n", per_cu); grid = -1; return; }
        (void)hipGetLastError();
        grid = cus;
    }
    if (grid < 0) return;
    (void)hipMemsetAsync((char*)d_ws + WS_CTL, 0, XCD_BAR_WORDS * 4, stream);
    Params p{};
    for (int i = 0; i < 20; ++i) p.in[i] = (const float*)d_in[i];
    p.out = (float*)d_out; p.ws = (unsigned char*)d_ws;
    hipLaunchKernelGGL(hymba_fwd, dim3(grid), dim3(NTHR), LDS_BYTES, stream, p);
}
```

```cpp
#include <hip/hip_runtime.h>
#include <cstdint>
#include <cstdio>

typedef unsigned short bf16_t;
typedef short bf16x8 __attribute__((ext_vector_type(8)));
typedef float f32x4 __attribute__((ext_vector_type(4)));
typedef unsigned u32x4 __attribute__((ext_vector_type(4)));
typedef float f32x16 __attribute__((ext_vector_type(16)));

constexpr int S = 16384, D = 1024, NPROJ = 2560, DSB = 512, DRG = 512, NH = 8, HD = 64;
constexpr int PH = 8, PNK = 128, PDK = 256, PHALF = 128, PTOPK = 16, NEXP = 16384, NQ = PH * PDK;
constexpr int CHUNK = 64, NCHUNK = S / CHUNK;
constexpr float EPS = 1e-6f;
constexpr float LOG2E = 1.4426950408889634f;
constexpr float QSCALE = 0.125f * LOG2E;
constexpr int NTHR = 512;
constexpr float CARRY_STOP = -160.0f;

constexpr size_t MiB = 1u << 20;
constexpr size_t WS_CTL = 0;
constexpr size_t WS_WINT = 1 * MiB;
constexpr size_t WS_WOUTT = 6 * MiB;
constexpr size_t WS_WQT = 8 * MiB;
constexpr size_t WS_SUBK = 12 * MiB;
constexpr size_t WS_RSTD1 = 12 * MiB + 512 * 1024;
constexpr size_t WS_RSTD2 = WS_RSTD1 + 64 * 1024;
constexpr size_t WS_RGP = WS_RSTD2 + 64 * 1024;
constexpr size_t WS_RGH = WS_RGP + 512 * 1024;
constexpr size_t WS_RGSA = 207 * MiB, WS_RGSB = 223 * MiB;
constexpr size_t WS_A = 14 * MiB;
constexpr size_t WS_B = 46 * MiB;
constexpr size_t WS_QH = WS_B, WS_KH = WS_B + 16 * MiB, WS_VH = WS_B + 32 * MiB, WS_XRG = WS_B + 48 * MiB;
constexpr size_t WS_GG = 110 * MiB;
constexpr size_t WS_OSB = 126 * MiB;
constexpr size_t WS_MIX = 142 * MiB;
constexpr size_t WS_SSB = 198 * MiB;
constexpr size_t WS_RSB = WS_SSB + 512 * 1024;
constexpr size_t WS_SELI = WS_MIX, WS_SELG = WS_MIX + 8 * MiB;
constexpr size_t WS_PD = WS_B;
constexpr size_t WS_CBUF = WS_GG;
constexpr size_t WS_CSC = WS_GG + 4 * MiB;
constexpr size_t WS_X1Q = WS_OSB;
constexpr size_t WS_XSC = WS_GG + 8 * MiB;
constexpr size_t WS_UB = 174 * MiB;
constexpr size_t WS_VB = 190 * MiB;
constexpr size_t WS_USC = 206 * MiB;
constexpr size_t WS_SSQ = 238 * MiB;
constexpr size_t WS_RGW = 239 * MiB;
constexpr size_t WS_END = 240 * MiB;

__device__ __forceinline__ unsigned f2bf(float f) { unsigned u = __builtin_bit_cast(unsigned, f); return (u + 0x7fffu + ((u >> 16) & 1u)) >> 16; }
__device__ __forceinline__ float u2f(unsigned u) { return __builtin_bit_cast(float, u); }
__device__ __forceinline__ float bf2f(unsigned h) { return __builtin_bit_cast(float, h << 16); }
__device__ __forceinline__ unsigned pk2(float lo, float hi) { return f2bf(lo) | (f2bf(hi) << 16); }
__device__ __forceinline__ unsigned pack_i8(float a, float b, float c, float d) {
    const int qa = __float2int_rn(a), qb = __float2int_rn(b), qc = __float2int_rn(c), qd = __float2int_rn(d);
    return (unsigned)(qa & 255) | ((unsigned)(qb & 255) << 8) | ((unsigned)(qc & 255) << 16) | ((unsigned)qd << 24);
}
__device__ __forceinline__ unsigned pack_n4(float a, float b, float c, float d) {
    const int qa = min(max(__float2int_rn(a), -7), 7) & 15, qb = min(max(__float2int_rn(b), -7), 7) & 15, qc = min(max(__float2int_rn(c), -7), 7) & 15, qd = min(max(__float2int_rn(d), -7), 7) & 15;
    return (unsigned)qa | ((unsigned)qb << 4) | ((unsigned)qc << 8) | ((unsigned)qd << 12);
}
template <int OFFS>
__device__ __forceinline__ unsigned pack_u4(float a, float b, float c, float d) {
    const int qa = (min(max(__float2int_rn(a), -7), 7) + OFFS) & 15, qb = (min(max(__float2int_rn(b), -7), 7) + OFFS) & 15, qc = (min(max(__float2int_rn(c), -7), 7) + OFFS) & 15, qd = (min(max(__float2int_rn(d), -7), 7) + OFFS) & 15;
    return (unsigned)qa | ((unsigned)qb << 8) | ((unsigned)qc << 16) | ((unsigned)qd << 24);
}
__device__ __forceinline__ float wave_sum(float v) {
#pragma unroll
    for (int o = 1; o < 64; o <<= 1) v += __shfl_xor(v, o);
    return v;
}
__device__ __forceinline__ float gelu_tanh(float x) {
    const float u = 0.7978845608028654f * (x + 0.044715f * x * x * x);
    const float e = __expf(2.0f * u);
    const float th = 1.0f - 2.0f / (e + 1.0f);
    return 0.5f * x * (1.0f + th);
}

__host__ __device__ __forceinline__ int inproj_phys_row(int nlog) { const int t = nlog >> 8, L = nlog & 255; return (t << 8) + 128 * ((L & 63) >> 5) + 32 * (L >> 6) + (L & 31); }

__device__ __forceinline__ int phase_tid() { int t = threadIdx.x; asm volatile("" : "+v"(t)); return t; }

struct Params {
    const float* in[20];
    float* out;
    unsigned char* ws;
};
enum { I_X = 0, I_NORM_MIX, I_W_IN, I_Q_NORM, I_K_NORM, I_CONV_W, I_CONV_B, I_RG_W_A, I_RG_B_A, I_RG_W_X, I_RG_B_X, I_RG_LAMBDA,
       I_OUT_NORM_SB, I_OUT_NORM_RG, I_W_OUT, I_NORM_FFN, I_PEER_WQ, I_PEER_SUBK, I_PEER_U, I_PEER_V };

template <bool INPROJ_PERM>
__device__ __forceinline__ void prep_transpose_item(const float* W, const float* gain0, const float* gain1, int K, int N, bf16_t* WT, float* scr, int item, int lane) {
    const int nblk = N / 32, kb = item / nblk, nb = item % nblk, k0 = 64 * kb, n0 = 32 * nb;
#pragma unroll
    for (int i = 0; i < 32; ++i) {
        const int kk = 2 * i + (lane >> 5), k = k0 + kk;
        const float g = (gain1 && k >= 512) ? gain1[k - 512] : gain0[k];
        scr[kk * 33 + (lane & 31)] = g * W[(size_t)k * N + n0 + (lane & 31)];
    }
    asm volatile("s_waitcnt lgkmcnt(0)" ::: "memory");
    const int c = lane & 7;
#pragma unroll
    for (int j = 0; j < 4; ++j) {
        const int n = (lane >> 3) + 8 * j; const float* s = scr + (8 * c) * 33 + n;
        u32x4 o; o.x = pk2(s[0 * 33], s[1 * 33]); o.y = pk2(s[2 * 33], s[3 * 33]); o.z = pk2(s[4 * 33], s[5 * 33]); o.w = pk2(s[6 * 33], s[7 * 33]);
        const int nr = INPROJ_PERM ? inproj_phys_row(n0 + n) : n0 + n;
        *(u32x4*)(WT + (size_t)nr * K + k0 + 8 * c) = o;
    }
    asm volatile("s_waitcnt lgkmcnt(0)" ::: "memory");
}
__device__ __forceinline__ void ph_tables(const Params& p, int cw, int ncw, int lane) {
    unsigned char* ws = p.ws;
    {
        const float* u = p.in[I_PEER_U]; const float* v = p.in[I_PEER_V]; const float* g = p.in[I_NORM_FFN];
        unsigned* ub = (unsigned*)(ws + WS_UB); unsigned* vb = (unsigned*)(ws + WS_VB); float2* uvsc = (float2*)(ws + WS_USC);
        f32x4 gq[4];
#pragma unroll
        for (int j = 0; j < 4; ++j) gq[j] = *((const f32x4*)g + lane + 64 * j);
        for (int e0 = cw; e0 < NEXP; e0 += 2 * ncw) {
            f32x4 a[2][4], b[2][4]; float ma[2], mb[2], sa2[2], sb2[2];
#pragma unroll
            for (int rr = 0; rr < 2; ++rr) {
                const int e = min(e0 + rr * ncw, NEXP - 1);
#pragma unroll
                for (int j = 0; j < 4; ++j) { a[rr][j] = *((const f32x4*)(u + (size_t)e * D) + lane + 64 * j); b[rr][j] = *((const f32x4*)(v + (size_t)e * D) + lane + 64 * j); }
            }
#pragma unroll
            for (int rr = 0; rr < 2; ++rr) {
                ma[rr] = 0.f; mb[rr] = 0.f; sa2[rr] = 0.f; sb2[rr] = 0.f;
#pragma unroll
                for (int j = 0; j < 4; ++j) {
                    a[rr][j] = a[rr][j] * gq[j];
                    const f32x4 aa = a[rr][j], bb = b[rr][j];
                    ma[rr] = fmaxf(ma[rr], fmaxf(fmaxf(fabsf(aa.x), fabsf(aa.y)), fmaxf(fabsf(aa.z), fabsf(aa.w))));
                    mb[rr] = fmaxf(mb[rr], fmaxf(fmaxf(fabsf(bb.x), fabsf(bb.y)), fmaxf(fabsf(bb.z), fabsf(bb.w))));
                    sa2[rr] += (aa.x * aa.x + aa.y * aa.y) + (aa.z * aa.z + aa.w * aa.w);
                    sb2[rr] += (bb.x * bb.x + bb.y * bb.y) + (bb.z * bb.z + bb.w * bb.w);
                }
            }
#pragma unroll
            for (int o = 1; o < 64; o <<= 1)
#pragma unroll
                for (int rr = 0; rr < 2; ++rr) { ma[rr] = fmaxf(ma[rr], __shfl_xor(ma[rr], o)); mb[rr] = fmaxf(mb[rr], __shfl_xor(mb[rr], o)); sa2[rr] += __shfl_xor(sa2[rr], o); sb2[rr] += __shfl_xor(sb2[rr], o); }
#pragma unroll
            for (int rr = 0; rr < 2; ++rr) {
                const int e = e0 + rr * ncw;
                if (e < NEXP) {
                    const float ca = fminf(ma[rr], 2.5f * sqrtf(sa2[rr] * (1.0f / D))), cb = fminf(mb[rr], 2.5f * sqrtf(sb2[rr] * (1.0f / D)));
                    const float ia = ca > 0.f ? 7.0f / ca : 0.f, ib = cb > 0.f ? 7.0f / cb : 0.f;
#pragma unroll
                    for (int j = 0; j < 4; ++j) {
                        const f32x4 aa = a[rr][j], bb = b[rr][j];
                        const unsigned na = pack_u4<0>(aa.x * ia, aa.y * ia, aa.z * ia, aa.w * ia), nb = pack_n4(bb.x * ib, bb.y * ib, bb.z * ib, bb.w * ib);
                        const unsigned pa = __shfl_xor(na, 1), pb = __shfl_xor(nb, 1);
                        if ((lane & 1) == 0) {
                            ub[((size_t)j * NEXP + e) * 32 + (lane >> 1)] = na | (pa << 4);
                            vb[((size_t)j * NEXP + e) * 32 + (lane >> 1)] = nb | (pb << 16);
                        }
                    }
                    if (lane == 0) uvsc[e] = make_float2(ca * (1.0f / 7.0f), cb * (1.0f / 7.0f));
                }
            }
        }
    }
}

__device__ __forceinline__ void ph_prep(const Params& p, unsigned char* lds) {
    const int tid_ = phase_tid();
    const int gtid = blockIdx.x * blockDim.x + tid_, gsize = gridDim.x * blockDim.x;
    const int lane = tid_ & 63, gwave = gtid >> 6, nwave = gsize >> 6;
    unsigned char* ws = p.ws;
    {
        float* scr = (float*)lds + (tid_ >> 6) * (64 * 33);
        constexpr int I_IN = (D / 64) * (NPROJ / 32), I_OUT = (D / 64) * (D / 32), I_Q = (D / 64) * (NQ / 32);
        for (int it = gwave; it < I_IN + I_OUT + I_Q; it += nwave) {
            if (it < I_IN) prep_transpose_item<true>(p.in[I_W_IN], p.in[I_NORM_MIX], nullptr, D, NPROJ, (bf16_t*)(ws + WS_WINT), scr, it, lane);
            else if (it < I_IN + I_OUT) prep_transpose_item<false>(p.in[I_W_OUT], p.in[I_OUT_NORM_SB], p.in[I_OUT_NORM_RG], D, D, (bf16_t*)(ws + WS_WOUTT), scr, it - I_IN, lane);
            else prep_transpose_item<false>(p.in[I_PEER_WQ], p.in[I_NORM_FFN], nullptr, D, NQ, (bf16_t*)(ws + WS_WQT), scr, it - I_IN - I_OUT, lane);
        }
    }
    {
        const float* wa = p.in[I_RG_W_A]; const float* wx = p.in[I_RG_W_X]; bf16_t* o = (bf16_t*)(ws + WS_RGW);
        for (int e = gtid; e < 8 * 2 * 2 * 4 * 64 * 8; e += gsize) {
            const int el = e & 7, ln = (e >> 3) & 63, s = (e >> 9) & 3, jt = (e >> 11) & 1, g = (e >> 12) & 1, n = e >> 13;
            const int j = 32 * jt + (ln & 31), i = 16 * s + 8 * (el >> 2) + 4 * (ln >> 5) + (el & 3);
            o[e] = (bf16_t)f2bf((g == 0 ? wa : wx)[((size_t)n * 64 + i) * 64 + j]);
        }
    }
    {
        const float* sk = p.in[I_PEER_SUBK]; bf16_t* o = (bf16_t*)(ws + WS_SUBK);
        for (int e = gtid; e < PH * 2 * PNK * PHALF; e += gsize) o[e] = (bf16_t)f2bf(sk[e]);
    }
    {
        const float* x = p.in[I_X]; bf16_t* xb = (bf16_t*)(ws + WS_A); float* rstd1 = (float*)(ws + WS_RSTD1);
        for (int row0 = gwave; row0 < S; row0 += 4 * nwave) {
            f32x4 v[4][4];
#pragma unroll
            for (int rr = 0; rr < 4; ++rr) {
                const int row = min(row0 + rr * nwave, S - 1);
#pragma unroll
                for (int j = 0; j < 4; ++j) v[rr][j] = ((const f32x4*)(x + (size_t)row * D) + lane)[64 * j];
            }
#pragma unroll
            for (int rr = 0; rr < 4; ++rr) {
                const int row = row0 + rr * nwave;
                float ss = 0.f;
#pragma unroll
                for (int j = 0; j < 4; ++j) ss += (v[rr][j].x * v[rr][j].x + v[rr][j].y * v[rr][j].y) + (v[rr][j].z * v[rr][j].z + v[rr][j].w * v[rr][j].w);
                ss = wave_sum(ss);
                if (row < S) {
                    uint2* o = (uint2*)(xb + (size_t)row * D) + lane;
#pragma unroll
                    for (int j = 0; j < 4; ++j) o[64 * j] = make_uint2(pk2(v[rr][j].x, v[rr][j].y), pk2(v[rr][j].z, v[rr][j].w));
                    if (lane == 0) rstd1[row] = rsqrtf(ss * (1.0f / D) + EPS);
                }
            }
        }
    }
}

namespace pg8 {
#define PG8_LAS __attribute__((address_space(3)))
typedef unsigned short bf16_t;
typedef short bf16x8 __attribute__((ext_vector_type(8)));
typedef float f32x4 __attribute__((ext_vector_type(4)));
typedef unsigned u32x4 __attribute__((ext_vector_type(4)));
constexpr int BM = 256, BK = 64, HALF = 128, HTB = HALF * BK * 2  , STAGE_BYTES = 8 * HTB, NXCD = 8, WGM = 8;

__host__ __device__ __forceinline__ int lds_byte(int r, int c) { const int st = (r >> 4) * 2 + (c >> 5), rr = r & 15, cc = c & 31, ob = rr * 64 + cc * 2; return st * 1024 + (ob ^ (((ob >> 9) & 1) << 5)); }
__host__ __device__ __forceinline__ void stage_rc(int b, int& R, int& C) { const int st = b / 1024, sb = b % 1024, swz = sb ^ (((sb >> 9) & 1) << 5); R = (st >> 1) * 16 + swz / 64; C = (st & 1) * 32 + (swz % 64) / 2; }
__host__ __device__ __forceinline__ int perm32(int rho) { const int n = rho >> 4, i = rho & 15; return 8 * (i >> 2) + 4 * n + (i & 3); }

struct Unit { int pm, pn; };
struct Gemm { const bf16_t* A; const bf16_t* Bt; int M, N, K; };

struct StaticOrder {
    int nM, nN, nwg, G, c;
    __host__ __device__ void init(int M, int N, int G_, int c_) { nM = M / BM; nN = N / BM; nwg = nM * nN; G = G_; c = c_; }
    __host__ __device__ bool next(int i, Unit& u) const {
        const long L = (long)i * G + c; if (L >= nwg) return false;
        int wgid = (int)L; { const int q = nwg / NXCD, r = nwg % NXCD, xcd = wgid % NXCD, off = wgid / NXCD; wgid = (xcd < r ? xcd * (q + 1) : r * (q + 1) + (xcd - r) * q) + off; }
        const int nig = WGM * nN, gid = wgid / nig, fm = gid * WGM, gsz = (nM - fm) < WGM ? (nM - fm) : WGM;
        u.pm = fm + ((wgid % nig) % gsz); u.pn = (wgid % nig) / gsz; return true;
    }
    __device__ __forceinline__ void a_ready(const Unit&) const {}
    __device__ __forceinline__ void done(const Unit&) const {}
};

__device__ __forceinline__ unsigned cvt_pk_bf16(float lo, float hi) { unsigned r; asm volatile("v_cvt_pk_bf16_f32 %0, %1, %2" : "=v"(r) : "v"(lo), "v"(hi)); return r; }
template <class Epi, class Sched, bool ALIGN_EPI = false, bool SP2 = false>
__device__ __forceinline__ void gemm_phase(PG8_LAS unsigned char* lds, const Gemm g, const Sched& S, const Epi& E) {
    const int tid = phase_tid(), wid = __builtin_amdgcn_readfirstlane(tid >> 6), lane = tid & 63, wr = wid >> 2, wc = wid & 3, fr = lane & 15, fq = lane >> 4;
    const int K = g.K, nt = K / BK;
    unsigned voffA[2], voffB[2];
#pragma unroll
    for (int i = 0; i < 2; ++i) { int R, C; stage_rc(tid * 16 + i * 8192, R, C); const int Rb = Epi::PERM ? ((R & ~31) + perm32(R & 31)) : R;
        voffA[i] = (unsigned)(R * K + C) * 2u; voffB[i] = (unsigned)(Rb * K + C) * 2u; }
    const size_t kstep = (size_t)(BK * 2);
    const size_t hstep = (size_t)HALF * K * 2;
    const size_t tstep = 2 * hstep;
    const unsigned ldsw = (unsigned)wid * 1024u;
    const int aoff = lds_byte(wr * 64 + fr, fq * 8), boff = lds_byte(wc * 32 + fr, fq * 8);
#define PG8_SA(b, h) (((b) * 2 + (h)) * HTB)
#define PG8_SB(b, h) ((4 + (b) * 2 + (h)) * HTB)
#define PG8_STAGE(bufoff, gbase, voff) do { _Pragma("unroll") for (int _i = 0; _i < 2; ++_i) \
        __builtin_amdgcn_global_load_lds((const unsigned*)((const char*)(gbase) + (voff)[_i]), (PG8_LAS unsigned*)(lds + (bufoff) + ldsw + _i * 8192), 16, 0, 0); } while (0)
#define PG8_LDA(dst, b, h) do { _Pragma("unroll") for (int m = 0; m < 4; ++m) _Pragma("unroll") for (int k = 0; k < 2; ++k) dst[m][k] = *(const PG8_LAS bf16x8*)(lds + PG8_SA(b, h) + aoff + m * 2048 + k * 1024); } while (0)
#define PG8_LDB(dst, b, h) do { _Pragma("unroll") for (int n = 0; n < 2; ++n) _Pragma("unroll") for (int k = 0; k < 2; ++k) dst[n][k] = *(const PG8_LAS bf16x8*)(lds + PG8_SB(b, h) + boff + n * 2048 + k * 1024); } while (0)
#define PG8_MMA(ai, bj, At, Bt) do { __builtin_amdgcn_s_setprio(1); _Pragma("unroll") for (int m = 0; m < 4; ++m) _Pragma("unroll") for (int n = 0; n < 2; ++n) _Pragma("unroll") for (int k = 0; k < 2; ++k) \
        acc[ai][bj][m][n] = __builtin_amdgcn_mfma_f32_16x16x32_bf16(Bt[n][k], At[m][k], acc[ai][bj][m][n], 0, 0, 0); __builtin_amdgcn_s_setprio(0); } while (0)
#define PG8_WAIT_V(n) asm volatile("s_waitcnt vmcnt(" #n ")" ::: "memory")
#define PG8_WAIT_L(n) asm volatile("s_waitcnt lgkmcnt(" #n ")" ::: "memory")
#define PG8_BAR __builtin_amdgcn_s_barrier()
#define PG8_SCHED __builtin_amdgcn_sched_barrier(0)
    Unit cur, nxt; int ui = 0;
    if (!S.next(0, cur)) return;
    f32x4 acc[2][2][4][2];
#pragma unroll
    for (int a = 0; a < 2; ++a)
#pragma unroll
        for (int b = 0; b < 2; ++b)
#pragma unroll
            for (int m = 0; m < 4; ++m)
#pragma unroll
                for (int n = 0; n < 2; ++n) acc[a][b][m][n] = (f32x4){0.f, 0.f, 0.f, 0.f};
    bf16x8 At[4][2], B0[2][2], B1[2][2];
    const char* cA = (const char*)g.A + (size_t)cur.pm * tstep; const char* cB = (const char*)g.Bt + (size_t)cur.pn * tstep;
    S.a_ready(cur);
    if constexpr (SP2) {
        PG8_STAGE(PG8_SB(0, 0), cB, voffB); PG8_STAGE(PG8_SB(0, 1), cB + hstep, voffB); PG8_STAGE(PG8_SA(0, 0), cA, voffA); PG8_STAGE(PG8_SA(0, 1), cA + hstep, voffA);
        if (wr == 1) PG8_BAR;
        PG8_WAIT_V(2); PG8_BAR;
        PG8_STAGE(PG8_SB(1, 0), cB + kstep, voffB); PG8_STAGE(PG8_SA(1, 0), cA + kstep, voffA); PG8_STAGE(PG8_SB(1, 1), cB + hstep + kstep, voffB);
        PG8_WAIT_V(6); PG8_BAR;
    } else {
        PG8_STAGE(PG8_SB(0, 0), cB, voffB); PG8_STAGE(PG8_SA(0, 0), cA, voffA); PG8_STAGE(PG8_SB(0, 1), cB + hstep, voffB); PG8_STAGE(PG8_SA(0, 1), cA + hstep, voffA);
        if (wr == 1) PG8_BAR;
        PG8_WAIT_V(4); PG8_BAR;
        PG8_STAGE(PG8_SB(1, 0), cB + kstep, voffB); PG8_STAGE(PG8_SA(1, 0), cA + kstep, voffA); PG8_STAGE(PG8_SB(1, 1), cB + hstep + kstep, voffB);
        PG8_WAIT_V(6); PG8_BAR;
    }
    for (;;) {
        const bool has_next = S.next(ui + 1, nxt);
        const char* nA = has_next ? (const char*)g.A + (size_t)nxt.pm * tstep : cA; const char* nB = has_next ? (const char*)g.Bt + (size_t)nxt.pn * tstep : cB;
        for (int t = 0; t < nt; t += 2) {
            if constexpr (Epi::MIDSCALE) { if (t == nt / 2) E.mid(acc, cur, wr, wc, fr, fq); }
            const bool last = (t == nt - 2);
            const char* a1 = cA + (size_t)(t + 1) * kstep;
            const char* a2 = last ? nA : cA + (size_t)(t + 2) * kstep; const char* b2 = last ? nB : cB + (size_t)(t + 2) * kstep;
            const char* a3 = a2 + kstep; const char* b3 = b2 + kstep;
            if (last && has_next) S.a_ready(nxt);
            if constexpr (SP2) {
            PG8_LDB(B0, 0, 0); PG8_LDB(B1, 0, 1); PG8_SCHED; PG8_LDA(At, 0, 0); PG8_STAGE(PG8_SA(1, 1), a1 + hstep, voffA);
            PG8_WAIT_V(8); PG8_WAIT_L(0); PG8_BAR; PG8_MMA(0, 0, At, B0); PG8_MMA(0, 1, At, B1); PG8_BAR; PG8_SCHED;
            PG8_LDA(At, 0, 1); PG8_STAGE(PG8_SB(0, 0), b2, voffB); PG8_STAGE(PG8_SB(0, 1), b2 + hstep, voffB); PG8_STAGE(PG8_SA(0, 0), a2, voffA);
            PG8_WAIT_V(8); PG8_WAIT_L(0); PG8_BAR; PG8_MMA(1, 0, At, B0); PG8_MMA(1, 1, At, B1); PG8_BAR; PG8_SCHED;
            PG8_LDB(B0, 1, 0); PG8_LDB(B1, 1, 1); PG8_SCHED; PG8_LDA(At, 1, 0); PG8_STAGE(PG8_SA(0, 1), a2 + hstep, voffA);
            PG8_WAIT_V(8); PG8_WAIT_L(0); PG8_BAR; PG8_MMA(0, 0, At, B0); PG8_MMA(0, 1, At, B1); PG8_BAR; PG8_SCHED;
            PG8_LDA(At, 1, 1); PG8_STAGE(PG8_SB(1, 0), b3, voffB); PG8_STAGE(PG8_SB(1, 1), b3 + hstep, voffB); PG8_STAGE(PG8_SA(1, 0), a3, voffA);
            PG8_WAIT_V(8); PG8_WAIT_L(0); PG8_BAR; PG8_MMA(1, 0, At, B0); PG8_MMA(1, 1, At, B1); PG8_BAR; PG8_SCHED;
            } else {
            PG8_LDB(B0, 0, 0); PG8_SCHED; PG8_LDA(At, 0, 0); PG8_STAGE(PG8_SA(1, 1), a1 + hstep, voffA);
            PG8_WAIT_L(8); PG8_BAR; PG8_WAIT_L(0); PG8_MMA(0, 0, At, B0); PG8_BAR; PG8_SCHED;
            PG8_LDB(B1, 0, 1); PG8_STAGE(PG8_SB(0, 0), b2, voffB);
            PG8_BAR; PG8_WAIT_L(0); PG8_MMA(0, 1, At, B1); PG8_BAR;
            PG8_LDA(At, 0, 1); PG8_STAGE(PG8_SA(0, 0), a2, voffA);
            PG8_BAR; PG8_WAIT_L(0); PG8_MMA(1, 0, At, B0); PG8_BAR; PG8_SCHED;
            PG8_STAGE(PG8_SB(0, 1), b2 + hstep, voffB);
            PG8_WAIT_V(6); PG8_BAR; PG8_MMA(1, 1, At, B1); PG8_BAR;
            PG8_LDB(B0, 1, 0); PG8_SCHED; PG8_LDA(At, 1, 0); PG8_STAGE(PG8_SA(0, 1), a2 + hstep, voffA);
            PG8_WAIT_L(8); PG8_BAR; PG8_WAIT_L(0); PG8_MMA(0, 0, At, B0); PG8_BAR; PG8_SCHED;
            PG8_LDB(B1, 1, 1); PG8_STAGE(PG8_SB(1, 0), b3, voffB);
            PG8_BAR; PG8_WAIT_L(0); PG8_MMA(0, 1, At, B1); PG8_BAR;
            PG8_LDA(At, 1, 1); PG8_STAGE(PG8_SA(1, 0), a3, voffA);
            PG8_BAR; PG8_WAIT_L(0); PG8_MMA(1, 0, At, B0); PG8_BAR; PG8_SCHED;
            PG8_STAGE(PG8_SB(1, 1), b3 + hstep, voffB);
            PG8_WAIT_V(6); PG8_BAR; PG8_MMA(1, 1, At, B1); PG8_BAR;
            }
        }
        if constexpr (ALIGN_EPI) { if (wr == 0) PG8_BAR; }
        if constexpr (!Epi::AFTER_DRAIN) { E(acc, cur, wr, wc, fr, fq); S.done(cur); }
        if (!has_next) break;
#pragma unroll
        for (int a = 0; a < 2; ++a)
#pragma unroll
            for (int b = 0; b < 2; ++b)
#pragma unroll
                for (int m = 0; m < 4; ++m)
#pragma unroll
                    for (int n = 0; n < 2; ++n) acc[a][b][m][n] = (f32x4){0.f, 0.f, 0.f, 0.f};
        cur = nxt; cA = nA; cB = nB; ++ui;
        if constexpr (ALIGN_EPI) { if (wr == 1) PG8_BAR; }
    }
    PG8_WAIT_V(0);
    if constexpr (!ALIGN_EPI) { if (wr == 0) PG8_BAR; }
    PG8_BAR;
    if constexpr (Epi::AFTER_DRAIN) { E.fused(acc, cur, wr, wc, fr, fq, lds, wid, lane); S.done(cur); }
#undef PG8_SA
#undef PG8_SB
#undef PG8_STAGE
#undef PG8_LDA
#undef PG8_LDB
#undef PG8_MMA
#undef PG8_WAIT_V
#undef PG8_WAIT_L
#undef PG8_BAR
#undef PG8_SCHED
}
}

struct EpiInProj {
    static constexpr bool PERM = true, AFTER_DRAIN = false, MIDSCALE = false;
    const float* rstd1; const float* qn; const float* kn; bf16_t *qh, *kh, *vh, *xrg, *gg;
    __device__ __forceinline__ void operator()(const pg8::f32x4 (&acc)[2][2][4][2], const pg8::Unit& u, int wr, int wc, int fr, int fq) const {
        const int region = u.pn >> 1;
        const int head = (u.pn & 1) * 4 + wc;
        float rsv[2][4];
#pragma unroll
        for (int ai = 0; ai < 2; ++ai)
#pragma unroll
            for (int m = 0; m < 4; ++m) rsv[ai][m] = rstd1[u.pm * 256 + ai * 128 + wr * 64 + m * 16 + fr];
        pg8::f32x4 gn[2][2];
        if (region <= 1) {
            const float* g = region == 0 ? qn : kn; const float sc = region == 0 ? QSCALE : 1.0f;
#pragma unroll
            for (int bj = 0; bj < 2; ++bj)
#pragma unroll
                for (int n = 0; n < 2; ++n) gn[bj][n] = *(const pg8::f32x4*)(g + 32 * bj + 8 * fq + 4 * n) * sc;
        }
#pragma unroll
        for (int ai = 0; ai < 2; ++ai)
#pragma unroll
            for (int m = 0; m < 4; ++m) {
                const int row = u.pm * 256 + ai * 128 + wr * 64 + m * 16 + fr;
                const float rs = rsv[ai][m];
                pg8::f32x4 v[2][2];
#pragma unroll
                for (int bj = 0; bj < 2; ++bj)
#pragma unroll
                    for (int n = 0; n < 2; ++n) v[bj][n] = acc[ai][bj][m][n] * rs;
                bf16_t* dst;
                if (region <= 1) {
                    float ss = 0.f;
#pragma unroll
                    for (int bj = 0; bj < 2; ++bj)
#pragma unroll
                        for (int n = 0; n < 2; ++n) ss += (v[bj][n][0] * v[bj][n][0] + v[bj][n][1] * v[bj][n][1]) + (v[bj][n][2] * v[bj][n][2] + v[bj][n][3] * v[bj][n][3]);
                    ss += __shfl_xor(ss, 16); ss += __shfl_xor(ss, 32);
                    const float rn = rsqrtf(ss * (1.0f / HD) + EPS);
#pragma unroll
                    for (int bj = 0; bj < 2; ++bj)
#pragma unroll
                        for (int n = 0; n < 2; ++n) v[bj][n] = v[bj][n] * rn * gn[bj][n];
                    bf16_t* fb = (region == 0 ? qh : kh) + ((size_t)(head * (S / 32) + (row >> 5)) * 4 * 64 + (row & 31)) * 8;
#pragma unroll
                    for (int bj = 0; bj < 2; ++bj) {
                        pg8::u32x4 w; w.x = pg8::cvt_pk_bf16(v[bj][0][0], v[bj][0][1]); w.y = pg8::cvt_pk_bf16(v[bj][0][2], v[bj][0][3]);
                        w.z = pg8::cvt_pk_bf16(v[bj][1][0], v[bj][1][1]); w.w = pg8::cvt_pk_bf16(v[bj][1][2], v[bj][1][3]);
                        *(pg8::u32x4*)(fb + ((2 * bj + (fq >> 1)) * 64 + 32 * (fq & 1)) * 8) = w;
                    }
                    continue;
                } else if (region == 2) {
#pragma unroll
                    for (int bj = 0; bj < 2; ++bj)
#pragma unroll
                        for (int n = 0; n < 2; ++n)
#pragma unroll
                            for (int i = 0; i < 4; ++i) {
                                const int d = 32 * bj + 8 * fq + 4 * n + i, kl = row & 31;
                                vh[(((((size_t)head * (S / 32) + (row >> 5)) * 2 + (d >> 5)) * 2 + (kl >> 4)) * 64 + (d & 31) + 32 * ((kl >> 2) & 1)) * 8 + 4 * ((kl >> 3) & 1) + (kl & 3)] = (bf16_t)f2bf(v[bj][n][i]);
                            }
                    continue;
                } else if (region == 3) {
                    dst = xrg + (size_t)row * DRG + head * 64;
                } else {
#pragma unroll
                    for (int bj = 0; bj < 2; ++bj)
#pragma unroll
                        for (int n = 0; n < 2; ++n)
#pragma unroll
                            for (int i = 0; i < 4; ++i) v[bj][n][i] = gelu_tanh(v[bj][n][i]);
#pragma unroll
                    for (int bj = 0; bj < 2; ++bj)
#pragma unroll
                        for (int n = 0; n < 2; ++n)
                            *(uint2*)(gg + ((((size_t)(row >> 5) * 8 + head) * 8 + (4 * bj + fq)) * 64 + (row & 31) + 32 * n) * 4) = make_uint2(pg8::cvt_pk_bf16(v[bj][n][0], v[bj][n][1]), pg8::cvt_pk_bf16(v[bj][n][2], v[bj][n][3]));
                    continue;
                }
#pragma unroll
                for (int bj = 0; bj < 2; ++bj) {
                    pg8::u32x4 w; w.x = pg8::cvt_pk_bf16(v[bj][0][0], v[bj][0][1]); w.y = pg8::cvt_pk_bf16(v[bj][0][2], v[bj][0][3]);
                    w.z = pg8::cvt_pk_bf16(v[bj][1][0], v[bj][1][1]); w.w = pg8::cvt_pk_bf16(v[bj][1][2], v[bj][1][3]);
                    *(pg8::u32x4*)(dst + 32 * bj + 8 * fq) = w;
                }
            }
    }
};
struct EpiOutProj {
    static constexpr bool PERM = true, AFTER_DRAIN = false, MIDSCALE = true;
    __device__ __forceinline__ void mid(pg8::f32x4 (&acc)[2][2][4][2], const pg8::Unit& u, int wr, int wc, int fr, int fq) const {
        float sc[2][4];
        int fro = fr; asm volatile("" : "+v"(fro));
#pragma unroll
        for (int ai = 0; ai < 2; ++ai)
#pragma unroll
            for (int m = 0; m < 4; ++m) sc[ai][m] = rsb[u.pm * 256 + ai * 128 + wr * 64 + m * 16 + fro];
#pragma unroll
        for (int ai = 0; ai < 2; ++ai)
#pragma unroll
            for (int bj = 0; bj < 2; ++bj)
#pragma unroll
                for (int m = 0; m < 4; ++m)
#pragma unroll
                    for (int n = 0; n < 2; ++n) acc[ai][bj][m][n] = acc[ai][bj][m][n] * sc[ai][m];
    }
    const float* rsb;
    const float* x; bf16_t* x1b; float* ssq; unsigned char* x1q; float* xsc;
    __device__ __forceinline__ void operator()(const pg8::f32x4 (&acc)[2][2][4][2], const pg8::Unit& u, int wr, int wc, int fr, int fq) const {
        pg8::u32x4 xv[2][2][2];
#define OUTPROJ_LD(buf, ai_, mh_) do { _Pragma("unroll") for (int mm_ = 0; mm_ < 2; ++mm_) _Pragma("unroll") for (int bj_ = 0; bj_ < 2; ++bj_) { \
            const size_t o_ = (size_t)(u.pm * 256 + (ai_) * 128 + wr * 64 + (2 * (mh_) + mm_) * 16 + fr) * D + u.pn * 256 + bj_ * 128 + wc * 32 + 8 * fq; \
            xv[buf][mm_][bj_] = *(const pg8::u32x4*)(x1b + o_); } } while (0)
        OUTPROJ_LD(0, 0, 0);
#pragma unroll
        for (int ai = 0; ai < 2; ++ai)
#pragma unroll
            for (int m = 0; m < 4; ++m) {
                const int kb = ai * 2 + (m >> 1);
                if ((m & 1) == 0 && kb < 3) OUTPROJ_LD((kb + 1) & 1, (kb + 1) >> 1, (kb + 1) & 1);
                const int row = u.pm * 256 + ai * 128 + wr * 64 + m * 16 + fr;
                float ss = 0.f;
#pragma unroll
                for (int bj = 0; bj < 2; ++bj) {
                    const int col = u.pn * 256 + bj * 128 + wc * 32 + 8 * fq;
                    const size_t o = (size_t)row * D + col;
                    const pg8::u32x4 xw = xv[kb & 1][m & 1][bj];
                    const pg8::f32x4 a = (pg8::f32x4){u2f(xw.x << 16), u2f(xw.x & 0xffff0000u), u2f(xw.y << 16), u2f(xw.y & 0xffff0000u)} + acc[ai][bj][m][0];
                    const pg8::f32x4 b = (pg8::f32x4){u2f(xw.z << 16), u2f(xw.z & 0xffff0000u), u2f(xw.w << 16), u2f(xw.w & 0xffff0000u)} + acc[ai][bj][m][1];
                    ss += (a[0] * a[0] + a[1] * a[1]) + (a[2] * a[2] + a[3] * a[3]) + (b[0] * b[0] + b[1] * b[1]) + (b[2] * b[2] + b[3] * b[3]);
                    pg8::u32x4 w; w.x = pg8::cvt_pk_bf16(a[0], a[1]); w.y = pg8::cvt_pk_bf16(a[2], a[3]); w.z = pg8::cvt_pk_bf16(b[0], b[1]); w.w = pg8::cvt_pk_bf16(b[2], b[3]);
                    *(pg8::u32x4*)(x1b + o) = w;
                    float mx = fmaxf(fmaxf(fmaxf(fabsf(a[0]), fabsf(a[1])), fmaxf(fabsf(a[2]), fabsf(a[3]))), fmaxf(fmaxf(fabsf(b[0]), fabsf(b[1])), fmaxf(fabsf(b[2]), fabsf(b[3]))));
                    mx = fmaxf(mx, __shfl_xor(mx, 16)); mx = fmaxf(mx, __shfl_xor(mx, 32));
                    const float inv = mx > 0.f ? 119.0f / mx : 0.f;
                    unsigned pl = 0u, ph = 0u;
#pragma unroll
                    for (int i = 0; i < 4; ++i) {
                        const int qa = __float2int_rn(a[i] * inv), qb = __float2int_rn(b[i] * inv);
                        pl |= ((unsigned)(qa & 15) << (8 * i)) | ((unsigned)(qb & 15) << (8 * i + 4));
                        ph |= ((unsigned)(((qa + 8) >> 4) & 15) << (8 * i)) | ((unsigned)(((qb + 8) >> 4) & 15) << (8 * i + 4));
                    }
                    unsigned* cq = (unsigned*)(x1q + (size_t)row * D + (col & ~31));
                    cq[fq] = pl; cq[4 + fq] = ph;
                    if (fq == 0) xsc[(size_t)row * 32 + (col >> 5)] = mx * (1.0f / 119.0f);
                }
                ss += __shfl_xor(ss, 16); ss += __shfl_xor(ss, 32);
                if (fq == 0) ssq[(size_t)row * 16 + u.pn * 4 + wc] = ss;
            }
    }
};
#undef OUTPROJ_LD
struct EpiPeerQ {
    static constexpr bool PERM = true, AFTER_DRAIN = false, MIDSCALE = false;
    bf16_t* qp;
    __device__ __forceinline__ void operator()(const pg8::f32x4 (&acc)[2][2][4][2], const pg8::Unit& u, int wr, int wc, int fr, int fq) const {
#pragma unroll
        for (int ai = 0; ai < 2; ++ai)
#pragma unroll
            for (int m = 0; m < 4; ++m) {
                const int row = u.pm * 256 + ai * 128 + wr * 64 + m * 16 + fr;
#pragma unroll
                for (int bj = 0; bj < 2; ++bj) {
                    const pg8::f32x4 a = acc[ai][bj][m][0], b = acc[ai][bj][m][1];
                    pg8::u32x4 w; w.x = pg8::cvt_pk_bf16(a[0], a[1]); w.y = pg8::cvt_pk_bf16(a[2], a[3]); w.z = pg8::cvt_pk_bf16(b[0], b[1]); w.w = pg8::cvt_pk_bf16(b[2], b[3]);
                    *(pg8::u32x4*)(qp + ((((size_t)((row >> 5) * 8 + u.pn) * 2 + bj) * 8 + 2 * wc + (fq >> 1)) * 64 + (row & 31) + 32 * (fq & 1)) * 8) = w;
                }
            }
    }
};

typedef float f32x2v __attribute__((ext_vector_type(2)));
typedef __bf16 bf16x2v __attribute__((ext_vector_type(2)));
__device__ __forceinline__ unsigned cvtpk(float lo, float hi) { const f32x2v v = {lo, hi}; const bf16x2v b = __builtin_convertvector(v, bf16x2v); return __builtin_bit_cast(unsigned, b); }
__device__ __forceinline__ bf16x8 pack_step(const f32x16& x, int s) {
    u32x4 pkd; pkd.x = cvtpk(x[8 * s], x[8 * s + 1]); pkd.y = cvtpk(x[8 * s + 2], x[8 * s + 3]); pkd.z = cvtpk(x[8 * s + 4], x[8 * s + 5]); pkd.w = cvtpk(x[8 * s + 6], x[8 * s + 7]);
    return __builtin_bit_cast(bf16x8, pkd);
}
#define MFMA32(a, b, c) __builtin_amdgcn_mfma_f32_32x32x16_bf16((a), (b), (c), 0, 0, 0)
__device__ __forceinline__ void ph_attn(const Params& p) {
    unsigned char* ws = p.ws;
    const bf16_t* qh = (const bf16_t*)(ws + WS_QH); const bf16_t* kh = (const bf16_t*)(ws + WS_KH); const bf16_t* vT = (const bf16_t*)(ws + WS_VH);
    bf16_t* mixo = (bf16_t*)(ws + WS_MIX); float* ssb = (float*)(ws + WS_SSB);
    const int tid = phase_tid(), lane = tid & 63, r = lane & 31, hh = lane >> 5;
    const int gwave = (blockIdx.x * blockDim.x + tid) >> 6, nwave = (gridDim.x * blockDim.x) >> 6;
    bf16x8 tp[2];
#pragma unroll
    for (int ss = 0; ss < 2; ++ss)
#pragma unroll
        for (int e = 0; e < 8; ++e) { const int k = 16 * ss + 8 * (e >> 2) + 4 * hh + (e & 3); tp[ss][e] = (k > r) ? (short)0x3F80 : (short)0; }
    f32x16 zero16;
#pragma unroll
    for (int i = 0; i < 16; ++i) zero16[i] = 0.f;
    for (int u = gwave; u < NH * (S / 32); u += nwave) {
        const int h = u / (S / 32), t0 = (u % (S / 32)) * 32;
        bf16x8 bq[4];
#pragma unroll
        for (int s = 0; s < 4; ++s) bq[s] = *(const bf16x8*)(qh + (((size_t)(h * (S / 32) + (t0 >> 5)) * 4 + s) * 64 + lane) * 8);
        f32x16 ot[2] = {zero16, zero16};
        float carry = 0.f;
        for (int kt0 = t0; kt0 >= 0; kt0 -= 32) {
            bf16x8 ak[4], av[2][2];
#pragma unroll
            for (int s = 0; s < 4; ++s) ak[s] = *(const bf16x8*)(kh + (((size_t)(h * (S / 32) + (kt0 >> 5)) * 4 + s) * 64 + lane) * 8);
#pragma unroll
            for (int dt = 0; dt < 2; ++dt)
#pragma unroll
                for (int ss = 0; ss < 2; ++ss) av[dt][ss] = *(const bf16x8*)(vT + ((((size_t)(h * (S / 32) + (kt0 >> 5)) * 2 + dt) * 2 + ss) * 64 + lane) * 8);
            f32x16 st = zero16;
#pragma unroll
            for (int s = 0; s < 4; ++s) st = MFMA32(ak[s], bq[s], st);
            const bool diag = (kt0 == t0);
            f32x16 lom, lb;
            float csum = 0.f;
#pragma unroll
            for (int i = 0; i < 16; ++i) {
                const float z = st[i];
                const float sp2 = fmaxf(z, 0.f) + __builtin_amdgcn_logf(1.0f + __builtin_amdgcn_exp2f(-fabsf(z)));
                const bool valid = !diag || ((i & 3) + 8 * (i >> 2) + 4 * hh < r);
                lom[i] = valid ? -sp2 : 0.f;
                lb[i] = z - sp2;
                csum += lom[i];
            }
            f32x16 suf = MFMA32(tp[0], pack_step(lom, 0), zero16);
            suf = MFMA32(tp[1], pack_step(lom, 1), suf);
            f32x16 w;
#pragma unroll
            for (int i = 0; i < 16; ++i) {
                const bool valid = !diag || ((i & 3) + 8 * (i >> 2) + 4 * hh < r);
                w[i] = valid ? __builtin_amdgcn_exp2f(lb[i] + suf[i] + carry) : 0.f;
            }
            const bf16x8 w0 = pack_step(w, 0), w1 = pack_step(w, 1);
#pragma unroll
            for (int dt = 0; dt < 2; ++dt) { ot[dt] = MFMA32(av[dt][0], w0, ot[dt]); ot[dt] = MFMA32(av[dt][1], w1, ot[dt]); }
            carry += csum + __shfl_xor(csum, 32);
            if (__all(carry < CARRY_STOP)) break;
        }
        float oss = 0.f;
#pragma unroll
        for (int dt = 0; dt < 2; ++dt)
#pragma unroll
            for (int g = 0; g < 4; ++g) {
                uint2 o; o.x = cvtpk(ot[dt][4 * g], ot[dt][4 * g + 1]); o.y = cvtpk(ot[dt][4 * g + 2], ot[dt][4 * g + 3]);
                oss += (ot[dt][4 * g] * ot[dt][4 * g] + ot[dt][4 * g + 1] * ot[dt][4 * g + 1]) + (ot[dt][4 * g + 2] * ot[dt][4 * g + 2] + ot[dt][4 * g + 3] * ot[dt][4 * g + 3]);
                *(uint2*)(mixo + (size_t)(t0 + r) * D + h * HD + 32 * dt + 8 * g + 4 * hh) = o;
            }
        oss += __shfl_xor(oss, 32);
        if (hh == 0) ssb[(size_t)(t0 + r) * NH + h] = oss;
    }
}

constexpr int RG_LDS_CST = 0, RG_LDS_HIN = 16384, RG_LDS_P = 18432, RG_LDS_SSQ = 20480;
constexpr int RG_LDS_X = 22528, RG_XP = 1032, RG_LDS_O = 91904;
typedef unsigned u32x2 __attribute__((ext_vector_type(2)));
typedef __attribute__((address_space(3))) float lds_f;
typedef __attribute__((address_space(3))) unsigned char lds_b;
template <int CTRL, int ROWMASK>
__device__ __forceinline__ float dpp_mov(float oob, float x) {
    return __builtin_bit_cast(float, __builtin_amdgcn_update_dpp(__builtin_bit_cast(int, oob), __builtin_bit_cast(int, x), CTRL, ROWMASK, 0xf, false));
}
template <int CTRL, int ROWMASK>
__device__ __forceinline__ void scan_step(float (&av)[16], float (&bv)[16]) {
#pragma unroll
    for (int i = 0; i < 16; ++i) {
        const float ap = dpp_mov<CTRL, ROWMASK>(1.0f, av[i]), bp = dpp_mov<CTRL, ROWMASK>(0.0f, bv[i]);
        bv[i] = __builtin_fmaf(av[i], bp, bv[i]); av[i] *= ap;
    }
}
template <int PASS>
__device__ __forceinline__ void ph_rg(const Params& p, unsigned char* lds_raw) {
    float* lds = (float*)lds_raw;
    unsigned char* ws = p.ws;
    const bf16_t* xrg = (const bf16_t*)(ws + WS_XRG); const bf16_t* gg = (const bf16_t*)(ws + WS_GG); const bf16_t* wfrag = (const bf16_t*)(ws + WS_RGW);
    bf16_t* mix = (bf16_t*)(ws + WS_MIX);
    float* rgP = (float*)(ws + WS_RGP); float* rgH = (float*)(ws + WS_RGH);
    bf16_t* scA = (bf16_t*)(ws + WS_RGSA); bf16_t* scB = (bf16_t*)(ws + WS_RGSB);
    const int tid = phase_tid(), lane = tid & 63, r = lane & 31, hh = lane >> 5, n = __builtin_amdgcn_readfirstlane(tid >> 6);
    __syncthreads();
    if (PASS == 0) for (int e = tid; e < 8 * 2 * 8 * 32; e += NTHR) {
        const int q = e & 31, k = (e >> 5) & 7, h2 = (e >> 8) & 1, nn = e >> 9;
        const int c = 64 * nn + 32 * (q >> 4) + (q & 3) + 8 * ((q >> 2) & 3) + 4 * h2;
        float v;
        if (k < 4) v = p.in[I_CONV_W][k * DRG + c];
        else if (k == 4) v = p.in[I_CONV_B][c];
        else if (k == 5) v = p.in[I_RG_B_A][c];
        else if (k == 6) v = p.in[I_RG_B_X][c];
        else v = 8.0f * LOG2E * log1pf(__expf(-p.in[I_RG_LAMBDA][c]));
        lds[e] = v;
    }
    const unsigned lds0 = (unsigned)(size_t)((lds_b*)lds_raw);
    const unsigned cst_base = lds0 + (unsigned)((n * 2 + hh) * 1024);
    lds_f* hin_l = (lds_f*)(size_t)(lds0 + RG_LDS_HIN + (n * 2 + hh) * 128);
    lds_f* pc_l = (lds_f*)(size_t)(lds0 + RG_LDS_P + (n * 2 + hh) * 128);
    lds_b* xt = (lds_b*)(size_t)(lds0 + RG_LDS_X);
    lds_b* ot = (lds_b*)(size_t)(lds0 + RG_LDS_O);
    f32x16 zero16;
#pragma unroll
    for (int i = 0; i < 16; ++i) zero16[i] = 0.f;
    for (int ch = blockIdx.x; ch < NCHUNK; ch += gridDim.x) {
        const int t0 = ch * CHUNK;
        __syncthreads();
        if (PASS == 0) for (int ci = tid; ci < (CHUNK + 3) * 64; ci += NTHR) {
            const int row = ci >> 6, c16 = ci & 63, tt = t0 - 3 + row;
            u32x4 v = {0u, 0u, 0u, 0u};
            if (tt >= 0) v = *(const u32x4*)(xrg + (size_t)tt * DRG + 8 * c16);
            __attribute__((address_space(3))) u32x2* d = (__attribute__((address_space(3))) u32x2*)(xt + row * RG_XP + 16 * c16);
            d[0] = (u32x2){v.x, v.y}; d[1] = (u32x2){v.z, v.w};
        }
        if (PASS == 1) {
            const int c = 64 * n + lane;
            float h = 0.f;
            int k = 0;
            for (; k + 32 <= ch; k += 32) {
                float pv[32], hv[32];
#pragma unroll
                for (int j = 0; j < 32; ++j) { pv[j] = rgP[(k + j) * DRG + c]; hv[j] = rgH[(k + j) * DRG + c]; }
#pragma unroll
                for (int j = 0; j < 32; ++j) h = pv[j] * h + hv[j];
            }
            for (; k + 8 <= ch; k += 8) {
                float pv[8], hv[8];
#pragma unroll
                for (int j = 0; j < 8; ++j) { pv[j] = rgP[(k + j) * DRG + c]; hv[j] = rgH[(k + j) * DRG + c]; }
#pragma unroll
                for (int j = 0; j < 8; ++j) h = pv[j] * h + hv[j];
            }
            for (; k < ch; ++k) h = rgP[k * DRG + c] * h + rgH[k * DRG + c];
            lds[RG_LDS_HIN / 4 + (n * 2 + ((lane >> 2) & 1)) * 32 + 16 * (lane >> 5) + 4 * ((lane >> 3) & 3) + (lane & 3)] = h;
        } else {
            if (r == 0) {
#pragma unroll
                for (int q = 0; q < 32; ++q) { hin_l[q] = 0.f; pc_l[q] = 1.f; }
            }
        }
        __syncthreads();
#pragma unroll 1
        for (int tl = 0; tl < 2; ++tl) {
            const int tok = t0 + 32 * tl + r;
            unsigned cst_a = cst_base; asm volatile("" : "+v"(cst_a));
            const lds_f* cst = (const lds_f*)(size_t)cst_a;
            float xcv[32]; bf16x8 bx[4];
            if (PASS == 0) {
#pragma unroll
            for (int q = 0; q < 32; ++q) xcv[q] = cst[4 * 32 + q];
#pragma unroll
            for (int k = 0; k < 4; ++k) {
                const lds_b* xr = xt + (32 * tl + r + k) * RG_XP + (64 * n + 4 * hh) * 2;
#pragma unroll
                for (int m = 0; m < 8; ++m) {
                    const u32x2 xw = *(const __attribute__((address_space(3))) u32x2*)(xr + 16 * m);
                    xcv[4 * m + 0] += cst[k * 32 + 4 * m + 0] * bf2f(xw.x & 0xffffu); xcv[4 * m + 1] += cst[k * 32 + 4 * m + 1] * bf2f(xw.x >> 16);
                    xcv[4 * m + 2] += cst[k * 32 + 4 * m + 2] * bf2f(xw.y & 0xffffu); xcv[4 * m + 3] += cst[k * 32 + 4 * m + 3] * bf2f(xw.y >> 16);
                }
                __builtin_amdgcn_sched_barrier(0);
            }
#pragma unroll
            for (int s = 0; s < 4; ++s) {
                u32x4 pk; pk.x = cvtpk(xcv[8 * s], xcv[8 * s + 1]); pk.y = cvtpk(xcv[8 * s + 2], xcv[8 * s + 3]); pk.z = cvtpk(xcv[8 * s + 4], xcv[8 * s + 5]); pk.w = cvtpk(xcv[8 * s + 6], xcv[8 * s + 7]);
                bx[s] = __builtin_bit_cast(bf16x8, pk);
            }
            }
            float ss = 0.f;
            const bf16_t* wb = wfrag + ((size_t)n * 16 * 64 + lane) * 8; asm volatile("" : "+v"(wb));
#pragma unroll
            for (int jt = 0; jt < 2; ++jt) {
                float av[16], bv[16];
                const size_t sco = ((((size_t)(2 * ch + tl) * 8 + n) * 2 + jt) * 64 + lane) * 16;
                if (PASS == 0) {
#pragma unroll
                for (int g = 0; g < 2; ++g) {
                    f32x16 acc = zero16;
#pragma unroll
                    for (int s = 0; s < 4; ++s) {
                        const bf16x8 aw = *(const __attribute__((address_space(1))) bf16x8*)(wb + (((g * 2 + jt) * 4 + s) * 64) * 8);
                        acc = MFMA32(aw, bx[s], acc);
                    }
#pragma unroll
                    for (int i = 0; i < 16; ++i) {
                        const int q = 16 * jt + i;
                        const float pre = acc[i] + cst[(5 + g) * 32 + q];
                        const float sg = 1.0f / (1.0f + __builtin_amdgcn_exp2f(-LOG2E * pre));
                        if (g == 0) av[i] = __builtin_amdgcn_exp2f(-sg * cst[7 * 32 + q]);
                        else bv[i] = __builtin_amdgcn_sqrtf(fmaxf(__builtin_fmaf(-av[i], av[i], 1.0f), 0.f)) * (sg * xcv[q]);
                    }
                    __builtin_amdgcn_sched_barrier(0);
                }
                scan_step<0x111, 0xf>(av, bv); scan_step<0x112, 0xf>(av, bv); scan_step<0x114, 0xf>(av, bv); scan_step<0x118, 0xf>(av, bv);
                scan_step<0x142, 0xa>(av, bv);
                u32x4 sa0, sa1, sb0, sb1;
                sa0.x = cvtpk(av[0], av[1]); sa0.y = cvtpk(av[2], av[3]); sa0.z = cvtpk(av[4], av[5]); sa0.w = cvtpk(av[6], av[7]); sa1.x = cvtpk(av[8], av[9]); sa1.y = cvtpk(av[10], av[11]); sa1.z = cvtpk(av[12], av[13]); sa1.w = cvtpk(av[14], av[15]);
                sb0.x = cvtpk(bv[0], bv[1]); sb0.y = cvtpk(bv[2], bv[3]); sb0.z = cvtpk(bv[4], bv[5]); sb0.w = cvtpk(bv[6], bv[7]); sb1.x = cvtpk(bv[8], bv[9]); sb1.y = cvtpk(bv[10], bv[11]); sb1.z = cvtpk(bv[12], bv[13]); sb1.w = cvtpk(bv[14], bv[15]);
                *(u32x4*)(scA + sco) = sa0; *(u32x4*)(scA + sco + 8) = sa1; *(u32x4*)(scB + sco) = sb0; *(u32x4*)(scB + sco + 8) = sb1;
                } else {
                    const u32x4 sa0 = *(const u32x4*)(scA + sco), sa1 = *(const u32x4*)(scA + sco + 8), sb0 = *(const u32x4*)(scB + sco), sb1 = *(const u32x4*)(scB + sco + 8);
                    const unsigned wa[8] = {sa0.x, sa0.y, sa0.z, sa0.w, sa1.x, sa1.y, sa1.z, sa1.w}, wbb[8] = {sb0.x, sb0.y, sb0.z, sb0.w, sb1.x, sb1.y, sb1.z, sb1.w};
#pragma unroll
                    for (int k = 0; k < 8; ++k) { av[2 * k] = bf2f(wa[k] & 0xffffu); av[2 * k + 1] = bf2f(wa[k] >> 16); bv[2 * k] = bf2f(wbb[k] & 0xffffu); bv[2 * k + 1] = bf2f(wbb[k] >> 16); }
                }
                __builtin_amdgcn_sched_barrier(0);
#pragma unroll
                for (int i = 0; i < 16; ++i) {
                    const int q = 16 * jt + i;
                    const float h = __builtin_fmaf(av[i], hin_l[q], bv[i]);
                    if (r == 31) { hin_l[q] = h; if (PASS == 0) pc_l[q] *= av[i]; }
                    bv[i] = h;
                }
                if (PASS == 1) {
#pragma unroll
                    for (int g4 = 0; g4 < 4; ++g4) {
                        const int m = 4 * jt + g4;
                        const uint2 gw = *(const uint2*)(gg + ((((size_t)(tok >> 5) * 8 + n) * 8 + m) * 64 + lane) * 4);
                        const float o0 = bv[4 * g4] * bf2f(gw.x & 0xffffu), o1 = bv[4 * g4 + 1] * bf2f(gw.x >> 16), o2 = bv[4 * g4 + 2] * bf2f(gw.y & 0xffffu), o3 = bv[4 * g4 + 3] * bf2f(gw.y >> 16);
                        ss += (o0 * o0 + o1 * o1) + (o2 * o2 + o3 * o3);
                        *(__attribute__((address_space(3))) u32x2*)(ot + (32 * tl + r) * RG_XP + (64 * n + 8 * m + 4 * hh) * 2) = (u32x2){cvtpk(o0, o1), cvtpk(o2, o3)};
                    }
                }
                __builtin_amdgcn_sched_barrier(0);
            }
            if (PASS == 1) { ss += __shfl_xor(ss, 32); if (hh == 0) lds[RG_LDS_SSQ / 4 + (tl * 8 + n) * 32 + r] = ss; }
        }
        if (PASS == 0) {
            if (r == 0) {
#pragma unroll
                for (int m = 0; m < 8; ++m) {
                    const int c = 64 * n + 8 * m + 4 * hh;
                    *(f32x4*)(rgP + (size_t)ch * DRG + c) = (f32x4){pc_l[4 * m], pc_l[4 * m + 1], pc_l[4 * m + 2], pc_l[4 * m + 3]};
                    *(f32x4*)(rgH + (size_t)ch * DRG + c) = (f32x4){hin_l[4 * m], hin_l[4 * m + 1], hin_l[4 * m + 2], hin_l[4 * m + 3]};
                }
            }
        } else {
            __syncthreads();
            for (int j = 0; j < 8; ++j) {
                const int tr = 8 * n + j, tok = t0 + tr;
                float tot = 0.f;
#pragma unroll
                for (int w = 0; w < 8; ++w) tot += lds[RG_LDS_SSQ / 4 + ((tr >> 5) * 8 + w) * 32 + (tr & 31)];
                const float rn = rsqrtf(tot * (1.0f / DRG) + EPS);
                const __attribute__((address_space(3))) u32x2* op = (const __attribute__((address_space(3))) u32x2*)(ot + tr * RG_XP + 16 * lane);
                const u32x2 w0 = op[0], w1 = op[1];
                u32x4 o2; o2.x = cvtpk(bf2f(w0.x & 0xffffu) * rn, bf2f(w0.x >> 16) * rn); o2.y = cvtpk(bf2f(w0.y & 0xffffu) * rn, bf2f(w0.y >> 16) * rn);
                o2.z = cvtpk(bf2f(w1.x & 0xffffu) * rn, bf2f(w1.x >> 16) * rn); o2.w = cvtpk(bf2f(w1.y & 0xffffu) * rn, bf2f(w1.y >> 16) * rn);
                *((u32x4*)(mix + (size_t)tok * D + DSB) + lane) = o2;
            }
            if (tid < CHUNK) {
                const f32x4 s0 = *(const f32x4*)(ws + WS_SSB + (size_t)(t0 + tid) * NH * 4), s1 = *(const f32x4*)(ws + WS_SSB + (size_t)(t0 + tid) * NH * 4 + 16);
                ((float*)(ws + WS_RSB))[t0 + tid] = rsqrtf(((s0.x + s0.y) + (s0.z + s0.w) + (s1.x + s1.y) + (s1.z + s1.w)) * (1.0f / DSB) + EPS);
            }
        }
    }
}

__device__ __forceinline__ float kmax(float a, float b) { float r; asm("v_max_f32 %0, %1, %2" : "=v"(r) : "v"(a), "v"(b)); return r; }
__device__ __forceinline__ float kmin(float a, float b) { float r; asm("v_min_f32 %0, %1, %2" : "=v"(r) : "v"(a), "v"(b)); return r; }
__device__ __forceinline__ float key_tag(float f, unsigned keep, unsigned tag) { return __builtin_bit_cast(float, (__builtin_bit_cast(unsigned, f) & keep) | tag); }
#define TOPK_CE(a, b) do { const float hi_ = kmax(a, b), lo_ = kmin(a, b); a = hi_; b = lo_; } while (0)
__device__ __forceinline__ void sort16_desc(float (&v)[16]) { TOPK_CE(v[0], v[1]); TOPK_CE(v[2], v[3]); TOPK_CE(v[0], v[2]); TOPK_CE(v[1], v[3]); TOPK_CE(v[1], v[2]); TOPK_CE(v[4], v[5]); TOPK_CE(v[6], v[7]); TOPK_CE(v[4], v[6]); TOPK_CE(v[5], v[7]); TOPK_CE(v[5], v[6]); TOPK_CE(v[0], v[4]); TOPK_CE(v[2], v[6]); TOPK_CE(v[2], v[4]); TOPK_CE(v[1], v[5]); TOPK_CE(v[3], v[7]); TOPK_CE(v[3], v[5]); TOPK_CE(v[1], v[2]); TOPK_CE(v[3], v[4]); TOPK_CE(v[5], v[6]); TOPK_CE(v[8], v[9]); TOPK_CE(v[10], v[11]); TOPK_CE(v[8], v[10]); TOPK_CE(v[9], v[11]); TOPK_CE(v[9], v[10]); TOPK_CE(v[12], v[13]); TOPK_CE(v[14], v[15]); TOPK_CE(v[12], v[14]); TOPK_CE(v[13], v[15]); TOPK_CE(v[13], v[14]); TOPK_CE(v[8], v[12]); TOPK_CE(v[10], v[14]); TOPK_CE(v[10], v[12]); TOPK_CE(v[9], v[13]); TOPK_CE(v[11], v[15]); TOPK_CE(v[11], v[13]); TOPK_CE(v[9], v[10]); TOPK_CE(v[11], v[12]); TOPK_CE(v[13], v[14]); TOPK_CE(v[0], v[8]); TOPK_CE(v[4], v[12]); TOPK_CE(v[4], v[8]); TOPK_CE(v[2], v[10]); TOPK_CE(v[6], v[14]); TOPK_CE(v[6], v[10]); TOPK_CE(v[2], v[4]); TOPK_CE(v[6], v[8]); TOPK_CE(v[10], v[12]); TOPK_CE(v[1], v[9]); TOPK_CE(v[5], v[13]); TOPK_CE(v[5], v[9]); TOPK_CE(v[3], v[11]); TOPK_CE(v[7], v[15]); TOPK_CE(v[7], v[11]); TOPK_CE(v[3], v[5]); TOPK_CE(v[7], v[9]); TOPK_CE(v[11], v[13]); TOPK_CE(v[1], v[2]); TOPK_CE(v[3], v[4]); TOPK_CE(v[5], v[6]); TOPK_CE(v[7], v[8]); TOPK_CE(v[9], v[10]); TOPK_CE(v[11], v[12]); TOPK_CE(v[13], v[14]); }
__device__ __forceinline__ void merge16_desc(float (&a)[16], const float (&b)[16]) {
#pragma unroll
    for (int i = 0; i < 16; ++i) a[i] = kmax(a[i], b[15 - i]);
#pragma unroll
    for (int d = 8; d >= 1; d >>= 1)
#pragma unroll
        for (int i = 0; i < 16; ++i) if ((i & d) == 0) TOPK_CE(a[i], a[i + d]);
}
__device__ __forceinline__ void ph_topk(const Params& p, int* lds) {
    unsigned char* ws = p.ws;
    const bf16_t* qp = (const bf16_t*)(ws + WS_B); const bf16_t* subk = (const bf16_t*)(ws + WS_SUBK);
    int* seli = (int*)(ws + WS_SELI); float* selg = (float*)(ws + WS_SELG);
    const float* ssq = (const float*)(ws + WS_SSQ); float* rstd2 = (float*)(ws + WS_RSTD2);
    const int tid = phase_tid(), lane = tid & 63, r = lane & 31, hh = lane >> 5, hx = 4 * hh;
    const int gwave = (blockIdx.x * blockDim.x + tid) >> 6, nwave = (gridDim.x * blockDim.x) >> 6;
    constexpr int SK_OFF = 65536, SK_PITCH = 272;
    typedef __attribute__((address_space(3))) unsigned char lds_b;
    lds_b* skl = (lds_b*)lds + SK_OFF;
    const int w = tid >> 6;
    pg8::StaticOrder so; so.init(S, NQ, (int)gridDim.x, (int)blockIdx.x);
    pg8::Unit gu;
    for (int ui = 0; so.next(ui, gu); ++ui) {
        const int h = gu.pn, t0 = gu.pm * 256 + 32 * w, t = t0 + r;
        u32x4 skv[8]; bf16x8 bq[2][8];
#pragma unroll
        for (int j = 0; j < 8; ++j) {
            const int ci = tid + NTHR * j, row = ci >> 4, c16 = ci & 15;
            skv[j] = *(const u32x4*)(subk + ((size_t)h * 256 + row) * PHALF + 8 * c16);
        }
#pragma unroll
        for (int pp = 0; pp < 2; ++pp)
#pragma unroll
            for (int s = 0; s < 8; ++s) bq[pp][s] = *(const bf16x8*)(qp + ((((size_t)((t0 >> 5) * 8 + h) * 2 + pp) * 8 + s) * 64 + lane) * 8);
        __builtin_amdgcn_sched_barrier(0);
        __syncthreads();
#pragma unroll
        for (int j = 0; j < 8; ++j) {
            const int ci = tid + NTHR * j, row = ci >> 4, c16 = ci & 15;
            *(__attribute__((address_space(3))) u32x4*)(skl + row * SK_PITCH + 16 * c16) = skv[j];
        }
        __syncthreads();
        float tk[2][16];
#pragma unroll
        for (int pp = 0; pp < 2; ++pp) {
            f32x16 acc[4];
#pragma unroll
            for (int T = 0; T < 4; ++T)
#pragma unroll
                for (int i = 0; i < 16; ++i) acc[T][i] = 0.f;
            const lds_b* krow = skl + (pp * PNK + r) * SK_PITCH + 16 * hh;
#pragma unroll
            for (int s = 0; s < 8; ++s) {
                const bf16x8 b = bq[pp][s];
#pragma unroll
                for (int T = 0; T < 4; ++T) {
                    const bf16x8 a = *(const __attribute__((address_space(3))) bf16x8*)(krow + (32 * T) * SK_PITCH + 32 * s);
                    acc[T] = __builtin_amdgcn_mfma_f32_32x32x16_bf16(a, b, acc[T], 0, 0, 0);
                }
            }
            float kq[4][16];
#pragma unroll
            for (int T = 0; T < 4; ++T) {
#pragma unroll
                for (int i = 0; i < 16; ++i) {
                    const int nb = 32 * T + (i & 3) + 8 * (i >> 2);
                    kq[T][i] = key_tag(acc[T][i], ~127u, (unsigned)(127 - nb));
                }
                sort16_desc(kq[T]);
            }
            merge16_desc(kq[0], kq[1]); merge16_desc(kq[2], kq[3]); merge16_desc(kq[0], kq[2]);
            float m[16], po[16];
#pragma unroll
            for (int i = 0; i < 16; ++i) { m[i] = __builtin_bit_cast(float, __builtin_bit_cast(int, kq[0][i]) ^ hx); po[i] = __shfl_xor(m[i], 32); }
            merge16_desc(m, po);
#pragma unroll
            for (int i = 0; i < 16; ++i) tk[pp][i] = m[i];
        }
#pragma unroll
        for (int i = 0; i < 16; ++i) { lds[i * NTHR + tid] = __builtin_bit_cast(int, tk[0][i]); lds[(16 + i) * NTHR + tid] = __builtin_bit_cast(int, tk[1][i]); }
        const float (&v0)[16] = tk[0]; const float (&v1)[16] = tk[1];
#define CKEY(a, b) key_tag(v0[a] + v1[b], ~255u, (unsigned)(255 - ((a) * 16 + (b))))
        const float NEGK = __builtin_bit_cast(float, 0xff800000u);
        float bk[16], l1[16], ga[16], gb[16];
#pragma unroll
        for (int b = 0; b < 16; ++b) bk[b] = CKEY(0, b);
#pragma unroll
        for (int b = 0; b < 16; ++b) l1[b] = b < 8 ? CKEY(1, b) : NEGK;
        ga[0] = CKEY(2, 0); ga[1] = CKEY(2, 1); ga[2] = CKEY(2, 2); ga[3] = CKEY(2, 3); ga[4] = CKEY(2, 4);
        ga[5] = CKEY(3, 0); ga[6] = CKEY(3, 1); ga[7] = CKEY(3, 2); ga[8] = CKEY(3, 3);
        ga[9] = CKEY(4, 0); ga[10] = CKEY(4, 1); ga[11] = CKEY(4, 2); ga[12] = CKEY(5, 0); ga[13] = CKEY(5, 1); ga[14] = NEGK; ga[15] = NEGK;
        gb[0] = CKEY(6, 0); gb[1] = CKEY(6, 1); gb[2] = CKEY(7, 0); gb[3] = CKEY(7, 1);
#pragma unroll
        for (int a = 8; a < 16; ++a) gb[a - 4] = CKEY(a, 0);
        gb[12] = NEGK; gb[13] = NEGK; gb[14] = NEGK; gb[15] = NEGK;
#undef CKEY
        sort16_desc(ga); sort16_desc(gb);
        merge16_desc(bk, l1); merge16_desc(ga, gb); merge16_desc(bk, ga);
        float ssum = 0.f;
#pragma unroll
        for (int i = 0; i < 4; ++i) { const f32x4 q4 = *(const f32x4*)(ssq + (size_t)t * 16 + 4 * i); ssum += (q4.x + q4.y) + (q4.z + q4.w); }
        const float rs = rsqrtf(ssum * (1.0f / D) + EPS);
        float e[16], sum = 0.f; const float mx = bk[0];
#pragma unroll
        for (int i = 0; i < 16; ++i) { e[i] = __expf((bk[i] - mx) * rs); sum += e[i]; }
        const float inv = 1.0f / sum;
        int eidx[16];
#pragma unroll
        for (int i = 0; i < 16; ++i) {
            const int code = 255 - (__builtin_bit_cast(int, bk[i]) & 255), a = code >> 4, b = code & 15;
            const int i1 = 127 - (lds[a * NTHR + tid] & 127), i2 = 127 - (lds[(16 + b) * NTHR + tid] & 127);
            eidx[i] = i1 * PNK + i2; e[i] *= inv;
        }
        if (hh == 0) {
            int4* o = (int4*)(seli + (size_t)t * 128 + h * 16);
#pragma unroll
            for (int i = 0; i < 4; ++i) o[i] = make_int4(eidx[4 * i], eidx[4 * i + 1], eidx[4 * i + 2], eidx[4 * i + 3]);
            if (h == 0) rstd2[t] = rs;
        } else {
            f32x4* o = (f32x4*)(selg + (size_t)t * 128 + h * 16);
#pragma unroll
            for (int i = 0; i < 4; ++i) o[i] = (f32x4){e[4 * i], e[4 * i + 1], e[4 * i + 2], e[4 * i + 3]};
        }
    }
}

typedef __bf16 bf16x2_t __attribute__((ext_vector_type(2)));
typedef float f32x2 __attribute__((ext_vector_type(2)));
template <int NV, int XS0, int XS1, int XS2>
__device__ __forceinline__ void reduce_over8(float (&v)[NV], int sel) {
    { const bool up = sel & 1;
#pragma unroll
      for (int i = 0; i < NV / 2; ++i) { const float a = v[2 * i], b = v[2 * i + 1]; v[i] = (up ? b : a) + __shfl_xor(up ? a : b, XS0); } }
    { const bool up = (sel >> 1) & 1;
#pragma unroll
      for (int i = 0; i < NV / 4; ++i) { const float a = v[2 * i], b = v[2 * i + 1]; v[i] = (up ? b : a) + __shfl_xor(up ? a : b, XS1); } }
    { const bool up = (sel >> 2) & 1;
#pragma unroll
      for (int i = 0; i < NV / 8; ++i) { const float a = v[2 * i], b = v[2 * i + 1]; v[i] = (up ? b : a) + __shfl_xor(up ? a : b, XS2); } }
}
__device__ __forceinline__ void peer_load_idx(const unsigned char* ws, int t, int rsl, int (&ei)[16]) {
    const unsigned off = (unsigned)WS_SELI + ((unsigned)t * 128u + 16u * (unsigned)rsl) * 4u;
#pragma unroll
    for (int j = 0; j < 4; ++j) { const int4 v = *(const int4*)(ws + (off + 16u * j)); ei[4 * j] = v.x; ei[4 * j + 1] = v.y; ei[4 * j + 2] = v.z; ei[4 * j + 3] = v.w; }
}
template <int PASS>
__device__ __forceinline__ void peer_load_rows(const unsigned char* ws, int t, int sl, int rsl, int c, const int (&ei)[16], u32x4 (&row)[16], u32x4 (&aux)[4]) {
    const unsigned tab = (unsigned)(PASS == 0 ? WS_UB : WS_VB) + (unsigned)sl * (unsigned)(NEXP * 128) + 16u * (unsigned)c;
#pragma unroll
    for (int i = 0; i < 16; ++i) row[i] = *(const u32x4*)(ws + (tab + (unsigned)ei[i] * 128u));
    const unsigned xo = (unsigned)WS_X1Q + (unsigned)t * (unsigned)D + 256u * sl + 32u * c;
    aux[0] = *(const u32x4*)(ws + xo); aux[1] = *(const u32x4*)(ws + (xo + 16u));
    aux[2].x = *(const unsigned*)(ws + ((unsigned)WS_XSC + ((unsigned)t * 32u + 8u * sl + c) * 4u));
}
constexpr int PEER_IMG_PITCH = 136, PEER_IMG_BYTES = 128 * PEER_IMG_PITCH;
template <int PASS  >
__device__ __forceinline__ void peer_compute(const Params& p, unsigned char* lds, int lane_w, int t, int sl, int rsl, int c, const u32x4 (&row)[16], const u32x4 (&aux)[4]) {
    unsigned char* ws = p.ws;
    if (PASS == 0) {
        const u32x4 x0 = aux[0], x1_ = aux[1]; const unsigned xl[4] = {x0.x, x0.y, x0.z, x0.w}, xh[4] = {x1_.x, x1_.y, x1_.z, x1_.w};
        const unsigned xsu = aux[2].x; const float xs = u2f(xsu);
        float pd[16];
#pragma unroll
        for (int i = 0; i < 16; ++i) {
            const u32x4 rw = row[i]; const unsigned w4[4] = {rw.x, rw.y, rw.z, rw.w};
            int al = 0, ah = 0;
#pragma unroll
            for (int j = 0; j < 4; ++j) { al = __builtin_amdgcn_sdot8((int)w4[j], (int)xl[j], al, false); ah = __builtin_amdgcn_sdot8((int)w4[j], (int)xh[j], ah, false); }
            pd[i] = (float)(16 * ah + al) * xs;
        }
        reduce_over8<16, 1, 2, 4>(pd, c);
        const unsigned po = (unsigned)WS_PD + (((unsigned)sl * S + (unsigned)t) * 128u + 16u * rsl + c) * 4u;
        *(float*)(ws + po) = pd[0]; *(float*)(ws + (po + 32u)) = pd[1];
    }
}
template <int PASS>
__device__ __forceinline__ void peer_stream(const Params& p, unsigned char* lds, int lane_w, int sl, int t0, int dt, int n) {
    const unsigned char* ws = p.ws;
    const int lane = lane_w & 63, rsl = lane >> 3, c = lane & 7;
    int eiA[16], eiB[16]; u32x4 rowA[16], rowB[16], auxA[4], auxB[4];
    if (n <= 0) return;
    peer_load_idx(ws, t0, rsl, eiA);
    peer_load_rows<PASS>(ws, t0, sl, rsl, c, eiA, rowA, auxA);
    if (n > 1) peer_load_idx(ws, t0 + dt, rsl, eiB);
    for (int i = 0; i < n; i += 2) {
        const int t = t0 + i * dt;
        if (i + 1 < n) peer_load_rows<PASS>(ws, t + dt, sl, rsl, c, eiB, rowB, auxB);
        if (i + 2 < n) peer_load_idx(ws, t + 2 * dt, rsl, eiA);
        peer_compute<PASS>(p, lds, lane_w, t, sl, rsl, c, rowA, auxA);
        if (i + 1 < n) {
            if (i + 2 < n) peer_load_rows<PASS>(ws, t + 2 * dt, sl, rsl, c, eiA, rowA, auxA);
            if (i + 3 < n) peer_load_idx(ws, t + 3 * dt, rsl, eiB);
            peer_compute<PASS>(p, lds, lane_w, t + dt, sl, rsl, c, rowB, auxB);
        }
    }
}
__device__ __forceinline__ void peerv_load_idx(const unsigned char* ws, int t, int hf, int rsl, int (&ei)[8]) {
    const unsigned off = (unsigned)WS_SELI + ((unsigned)t * 128u + 16u * (unsigned)rsl + 8u * (unsigned)hf) * 4u;
    const int4 v0 = *(const int4*)(ws + off), v1 = *(const int4*)(ws + (off + 16u));
    ei[0] = v0.x; ei[1] = v0.y; ei[2] = v0.z; ei[3] = v0.w; ei[4] = v1.x; ei[5] = v1.y; ei[6] = v1.z; ei[7] = v1.w;
}
__device__ __forceinline__ void peerv_load_rows(const unsigned char* ws, int sl, int c, const int (&ei)[8], u32x4 (&row)[8]) {
    const unsigned tab = (unsigned)WS_VB + (unsigned)sl * (unsigned)(NEXP * 128) + 16u * (unsigned)c;
#pragma unroll
    for (int i = 0; i < 8; ++i) row[i] = *(const u32x4*)(ws + (tab + (unsigned)ei[i] * 128u));
}
struct PeerVAux { u32x4 cp; unsigned cs; unsigned xo[4]; };
__device__ __forceinline__ void peerv_load_aux(const unsigned char* ws, int t, int sl, int lane, PeerVAux& a) {
    a.cp = *(const u32x4*)(ws + ((unsigned)WS_CBUF + (unsigned)t * 128u + 16u * (unsigned)(lane & 7)));
    a.cs = *(const unsigned*)(ws + ((unsigned)WS_CSC + (unsigned)t * 4u));
    const unsigned xo = (unsigned)WS_A + ((unsigned)t * (unsigned)D + 256u * sl + (unsigned)lane) * 2u;
    a.xo[0] = *(const bf16_t*)(ws + xo); a.xo[1] = *(const bf16_t*)(ws + (xo + 128u)); a.xo[2] = *(const bf16_t*)(ws + (xo + 256u)); a.xo[3] = *(const bf16_t*)(ws + (xo + 384u));
}
template <int HF>
__device__ __forceinline__ void peerv_half(lds_b* img, int lane, const u32x4 (&row)[8], const PeerVAux& a, int (&acc)[4]) {
    const int rsl = lane >> 3, c = lane & 7;
#pragma unroll
    for (int i = 0; i < 8; ++i) {
        const u32x4 rw = row[i];
        __attribute__((address_space(3))) u32x2* d = (__attribute__((address_space(3))) u32x2*)(img + (16 * rsl + i) * PEER_IMG_PITCH + 16 * c);
        d[0] = (u32x2){rw.x, rw.y}; d[1] = (u32x2){rw.z, rw.w};
    }
    const unsigned cpl = HF == 0 ? a.cp.x : a.cp.y, cph = HF == 0 ? a.cp.z : a.cp.w;
    asm volatile("s_waitcnt lgkmcnt(0)" ::: "memory");
    const unsigned ra = (unsigned)(size_t)img + (unsigned)((lane & 15) * PEER_IMG_PITCH + 8 * (lane >> 4));
#define PEER_TR4(R0, R1, R2, R3, RS) asm volatile("ds_read_b64_tr_b4 %0, %4 offset:%5\n\tds_read_b64_tr_b4 %1, %4 offset:%6\n\tds_read_b64_tr_b4 %2, %4 offset:%7\n\tds_read_b64_tr_b4 %3, %4 offset:%8" \
            : "=&v"(R0), "=&v"(R1), "=&v"(R2), "=&v"(R3) : "v"(ra), "i"((RS) * 16 * PEER_IMG_PITCH), "i"((RS) * 16 * PEER_IMG_PITCH + 32), "i"((RS) * 16 * PEER_IMG_PITCH + 64), "i"((RS) * 16 * PEER_IMG_PITCH + 96) : "memory")
#define PEER_USE4(R0, R1, R2, R3, RS, WAITSTR) do { \
            asm volatile(WAITSTR : "+v"(R0), "+v"(R1), "+v"(R2), "+v"(R3) :: "memory"); \
            const int cl_ = __builtin_amdgcn_readlane((int)cpl, RS), ch_ = __builtin_amdgcn_readlane((int)cph, RS); \
            const unsigned lo4_[4] = {R0.x, R1.x, R2.x, R3.x}; \
            _Pragma("unroll") for (int tcg = 0; tcg < 4; ++tcg) acc[tcg] += 16 * __builtin_amdgcn_sdot8((int)lo4_[tcg], ch_, 0, false) + __builtin_amdgcn_sdot8((int)lo4_[tcg], cl_, 0, false); } while (0)
    {
        u32x2 a0, a1, a2, a3, b0, b1, b2, b3;
        PEER_TR4(a0, a1, a2, a3, 0);
        PEER_TR4(b0, b1, b2, b3, 1); PEER_USE4(a0, a1, a2, a3, 0, "s_waitcnt lgkmcnt(4)");
        PEER_TR4(a0, a1, a2, a3, 2); PEER_USE4(b0, b1, b2, b3, 1, "s_waitcnt lgkmcnt(4)");
        PEER_TR4(b0, b1, b2, b3, 3); PEER_USE4(a0, a1, a2, a3, 2, "s_waitcnt lgkmcnt(4)");
        PEER_TR4(a0, a1, a2, a3, 4); PEER_USE4(b0, b1, b2, b3, 3, "s_waitcnt lgkmcnt(4)");
        PEER_TR4(b0, b1, b2, b3, 5); PEER_USE4(a0, a1, a2, a3, 4, "s_waitcnt lgkmcnt(4)");
        PEER_TR4(a0, a1, a2, a3, 6); PEER_USE4(b0, b1, b2, b3, 5, "s_waitcnt lgkmcnt(4)");
        PEER_TR4(b0, b1, b2, b3, 7); PEER_USE4(a0, a1, a2, a3, 6, "s_waitcnt lgkmcnt(4)");
        PEER_USE4(b0, b1, b2, b3, 7, "s_waitcnt lgkmcnt(0)");
    }
#undef PEER_TR4
#undef PEER_USE4
}
__device__ __forceinline__ void peerv_stream(const Params& p, unsigned char* lds, int tid_, int sl, int t0, int dt, int n) {
    const unsigned char* ws = p.ws;
    const int lane = tid_ & 63, rsl = lane >> 3, c = lane & 7;
    lds_b* img = (lds_b*)lds + (tid_ >> 6) * PEER_IMG_BYTES;
    for (int e = lane; e < 64 * (PEER_IMG_PITCH / 8); e += 64) {
        const int zr = e / (PEER_IMG_PITCH / 8), zc = e % (PEER_IMG_PITCH / 8);
        *(__attribute__((address_space(3))) u32x2*)(img + (16 * (zr >> 3) + 8 + (zr & 7)) * PEER_IMG_PITCH + 8 * zc) = (u32x2){0u, 0u};
    }
    if (n <= 0) return;
    int ei0[8], ei1[8]; u32x4 rowA[8], rowB[8]; PeerVAux ax, axn;
    peerv_load_idx(ws, t0, 0, rsl, ei0);
    peerv_load_rows(ws, sl, c, ei0, rowA); peerv_load_aux(ws, t0, sl, lane, ax);
    peerv_load_idx(ws, t0, 1, rsl, ei1);
    for (int i = 0; i < n; ++i) {
        const int t = t0 + i * dt; const bool more = i + 1 < n;
        int acc[4] = {0, 0, 0, 0};
        peerv_load_rows(ws, sl, c, ei1, rowB);
        if (more) peerv_load_idx(ws, t + dt, 0, rsl, ei0);
        peerv_half<0>(img, lane, rowA, ax, acc);
        if (more) { peerv_load_rows(ws, sl, c, ei0, rowA); peerv_load_aux(ws, t + dt, sl, lane, axn); peerv_load_idx(ws, t + dt, 1, rsl, ei1); }
        peerv_half<1>(img, lane, rowB, ax, acc);
        const float cs = u2f(ax.cs);
#pragma unroll
        for (int tcg = 0; tcg < 4; ++tcg) {
            const unsigned oo = ((unsigned)t * (unsigned)D + 256u * sl + 64u * tcg + (unsigned)lane) * 4u;
            *(float*)((unsigned char*)p.out + oo) = bf2f(ax.xo[tcg]) + (float)acc[tcg] * cs;
        }
        if (more) ax = axn;
    }
}
template <int PASS>
__device__ __forceinline__ void ph_peer(const Params& p, unsigned char* lds) {
    const int tid_ = phase_tid();
    const int lane = tid_ & 63, w = tid_ >> 6, b = blockIdx.x, G = gridDim.x;
    if ((G & 7) == 0) {
        const int g = b & 7, nsw = (G >> 3) * 2 * (NTHR / 64), t0 = ((g >> 2) * (G >> 3) + (b >> 3)) * (NTHR / 64) + w;
        if (PASS == 0) peer_stream<0>(p, lds, tid_, g & 3, t0, nsw, t0 < S ? (S - 1 - t0) / nsw + 1 : 0);
        else peerv_stream(p, lds, tid_, g & 3, t0, nsw, t0 < S ? (S - 1 - t0) / nsw + 1 : 0);
    } else {
        const int nw = G * (NTHR / 64), it0 = b * (NTHR / 64) + w;
        for (int it = it0; it < S * 4; it += nw) { if (PASS == 0) peer_stream<0>(p, lds, tid_, it & 3, it >> 2, 0, 1); else peerv_stream(p, lds, tid_, it & 3, it >> 2, 0, 1); }
    }
}
__device__ __forceinline__ void ph_peer_combine(const Params& p) {
    unsigned char* ws = p.ws;
    const int* seli = (const int*)(ws + WS_SELI); const float* selg = (const float*)(ws + WS_SELG); const float* rstd2 = (const float*)(ws + WS_RSTD2);
    const float2* uvsc = (const float2*)(ws + WS_USC);
    const float* pd = (const float*)(ws + WS_PD);
    unsigned* cpl = (unsigned*)(ws + WS_CBUF); float* csc = (float*)(ws + WS_CSC);
    const int tid_ = phase_tid(), lane = tid_ & 63, gwave = (blockIdx.x * blockDim.x + tid_) >> 6, nwave = (gridDim.x * blockDim.x) >> 6;
    constexpr int TT = 4;
    for (int tb = gwave; tb < S; tb += TT * nwave) {
        float dsum[TT][2], sg[TT][2], rsd[TT]; int ei[TT][2];
#pragma unroll
        for (int k = 0; k < TT; ++k) {
            const int t = min(tb + k * nwave, S - 1);
#pragma unroll
            for (int hf = 0; hf < 2; ++hf) {
                const int e = t * 128 + 64 * hf + lane;
                ei[k][hf] = seli[e]; sg[k][hf] = selg[e];
                float d = 0.f;
#pragma unroll
                for (int g = 0; g < 4; ++g) d += pd[(size_t)g * S * 128 + e];
                dsum[k][hf] = d;
            }
            rsd[k] = rstd2[t];
        }
        float2 sc2[TT][2];
#pragma unroll
        for (int k = 0; k < TT; ++k)
#pragma unroll
            for (int hf = 0; hf < 2; ++hf) sc2[k][hf] = uvsc[ei[k][hf]];
#pragma unroll
        for (int k = 0; k < TT; ++k) {
            const int t = tb + k * nwave;
            if (t >= S) break;
            float cf[2];
#pragma unroll
            for (int hf = 0; hf < 2; ++hf) cf[hf] = sg[k][hf] * gelu_tanh(dsum[k][hf] * sc2[k][hf].x * rsd[k]) * sc2[k][hf].y;
            float m = fmaxf(fabsf(cf[0]), fabsf(cf[1]));
#pragma unroll
            for (int o = 1; o < 64; o <<= 1) m = fmaxf(m, __shfl_xor(m, o));
            const float inv = m > 0.f ? 119.0f / m : 0.f;
#pragma unroll
            for (int hf = 0; hf < 2; ++hf) {
                const int q = __float2int_rn(cf[hf] * inv);
                unsigned dl = (unsigned)(q & 15) << (4 * (lane & 7)), dh = (unsigned)(((q + 8) >> 4) & 15) << (4 * (lane & 7));
                dl |= __shfl_xor(dl, 1); dh |= __shfl_xor(dh, 1); dl |= __shfl_xor(dl, 2); dh |= __shfl_xor(dh, 2); dl |= __shfl_xor(dl, 4); dh |= __shfl_xor(dh, 4);
                if ((lane & 7) == 0) {
                    const int dk = 8 * hf + (lane >> 3), rs = dk >> 1, half = dk & 1;
                    cpl[(size_t)t * 32 + 4 * rs + half] = dl; cpl[(size_t)t * 32 + 4 * rs + 2 + half] = dh;
                }
            }
            if (lane == 0) csc[t] = m * (1.0f / 119.0f);
        }
    }
}

#define LAS __attribute__((address_space(3)))
#define XB_TMO      128
#define XB_XCNT(j)  (256  + 64 * (j))
#define XB_XSUB(j)  (1280 + 64 * (j))
#define XB_XGEN(j)  (2304 + 64 * (j))
#define XB_TOP      3328
#define XB_TOPGEN   3392
#define XCD_BAR_WORDS 3456
#define XB_SPIN_CAP (1u << 18)
__device__ __forceinline__ unsigned xb_ld(unsigned* p)              { return __hip_atomic_load(p, __ATOMIC_RELAXED, __HIP_MEMORY_SCOPE_AGENT); }
__device__ __forceinline__ unsigned xb_add(unsigned* p, unsigned v) { return __hip_atomic_fetch_add(p, v, __ATOMIC_RELAXED, __HIP_MEMORY_SCOPE_AGENT); }
__device__ __forceinline__ unsigned xb_xcc_id() { return (unsigned)__builtin_amdgcn_s_getreg((3 << 11) | 20) & 0xFu; }
#define XB_SPIN(cond, bar) do { unsigned _sp = 0; while (cond) { __builtin_amdgcn_s_sleep(1); \
    if ((++_sp & 255u) == 0u) { if (xb_ld(&(bar)[XB_TMO])) break; if (_sp > XB_SPIN_CAP) { atomicAdd(&(bar)[XB_TMO], 1u); break; } } } } while (0)
struct XcdBarrier { unsigned* bar; unsigned x; volatile LAS unsigned* st; };
__device__ __forceinline__ XcdBarrier xcd_barrier_post(unsigned* bar, volatile LAS unsigned* st) {
    XcdBarrier b; b.bar = bar; b.x = xb_xcc_id(); b.st = st;
    if (threadIdx.x == 0) (void)xb_add(&bar[XB_XCNT(b.x)], 1u);
    return b;
}
__device__ __forceinline__ void xcd_barrier_complete(unsigned* bar, unsigned x, unsigned& nloc, unsigned& nx) {
    const unsigned G = gridDim.x * gridDim.y * gridDim.z;
    unsigned sum, cnt, mine, sp = 0u;
    for (;;) {
        sum = 0u; cnt = 0u; mine = 0u;
#pragma unroll
        for (unsigned j = 0; j < 16; ++j) { const unsigned c = xb_ld(&bar[XB_XCNT(j)]); sum += c; cnt += (c > 0u) ? 1u : 0u; mine = (j == x) ? c : mine; }
        if (sum == G) break;
        __builtin_amdgcn_s_sleep(1);
        if ((++sp & 255u) == 0u) { if (xb_ld(&bar[XB_TMO])) break; if (sp > XB_SPIN_CAP) { atomicAdd(&bar[XB_TMO], 1u); break; } }
    }
    nloc = mine > 0u ? mine : 1u; nx = cnt > 0u ? cnt : 1u;
}
__device__ __forceinline__ void xcd_barrier(const XcdBarrier& b) {
    asm volatile("s_waitcnt vmcnt(0)" ::: "memory");
    __syncthreads();
    if (threadIdx.x == 0) {
        unsigned* bar = b.bar;
        __builtin_amdgcn_s_waitcnt(0);
        unsigned nloc = b.st[0], nx = b.st[1];
        if (nloc == 0u) { xcd_barrier_complete(bar, b.x, nloc, nx); b.st[0] = nloc; b.st[1] = nx; }
        const unsigned old = xb_add(&bar[XB_XSUB(b.x)], 1u);
        const unsigned gen = old / nloc;
        if (old + 1u == (gen + 1u) * nloc) {
            __builtin_amdgcn_fence(__ATOMIC_RELEASE, "agent");
            asm volatile("s_waitcnt vmcnt(0)" ::: "memory");
            const unsigned og = xb_add(&bar[XB_TOP], 1u);
            const unsigned tg = og / nx;
            if (og + 1u == (tg + 1u) * nx) xb_add(&bar[XB_TOPGEN], 1u);
            else XB_SPIN(xb_ld(&bar[XB_TOPGEN]) == tg, bar);
            __builtin_amdgcn_fence(__ATOMIC_ACQUIRE, "agent");
            xb_add(&bar[XB_XGEN(b.x)], 1u);
            asm volatile("s_waitcnt vmcnt(0)" ::: "memory");
        } else {
            XB_SPIN(xb_ld(&bar[XB_XGEN(b.x)]) == gen, bar);
            __builtin_amdgcn_fence(__ATOMIC_ACQUIRE, "agent");
            asm volatile("s_waitcnt vmcnt(0)" ::: "memory");
        }
    }
    __syncthreads();
}

constexpr int LDS_MISC = 158720;
constexpr int LDS_BYTES = LDS_MISC + 1024;

__global__ void __launch_bounds__(NTHR, 2) hymba_fwd(Params p) {
    extern __shared__ __attribute__((aligned(16))) unsigned char lds[];
    volatile LAS unsigned* misc = (volatile LAS unsigned*)((LAS unsigned char*)lds + LDS_MISC);
    if (threadIdx.x < 4) misc[threadIdx.x] = 0u;
    __syncthreads();
    XcdBarrier bar = xcd_barrier_post((unsigned*)(p.ws + WS_CTL), misc);

    PG8_LAS unsigned char* ring = (PG8_LAS unsigned char*)lds;
    unsigned char* ws = p.ws;
    ph_prep(p, lds);                          xcd_barrier(bar);
    {
        pg8::Gemm g{(const bf16_t*)(ws + WS_A), (const bf16_t*)(ws + WS_WINT), S, NPROJ, D}; pg8::StaticOrder so; so.init(S, NPROJ, (int)gridDim.x, (int)blockIdx.x);
        EpiInProj E{(const float*)(ws + WS_RSTD1), p.in[I_Q_NORM], p.in[I_K_NORM], (bf16_t*)(ws + WS_QH), (bf16_t*)(ws + WS_KH), (bf16_t*)(ws + WS_VH), (bf16_t*)(ws + WS_XRG), (bf16_t*)(ws + WS_GG)};
        pg8::gemm_phase<EpiInProj, pg8::StaticOrder, true, true>(ring, g, so, E);
        const int G = (int)gridDim.x, nunits = (S / 256) * (NPROJ / 256), rem = nunits % G, b = (int)blockIdx.x;
        const int tid_ = phase_tid(), w = tid_ >> 6, lane = tid_ & 63;
        if (rem == 0) ph_tables(p, b * (NTHR / 64) + w, G * (NTHR / 64), lane);
        else if (b >= rem) ph_tables(p, (b - rem) * (NTHR / 64) + w, (G - rem) * (NTHR / 64), lane);
    }
    xcd_barrier(bar);
    ph_attn(p); ph_rg<0>(p, lds);             xcd_barrier(bar);
    ph_rg<1>(p, lds);                         xcd_barrier(bar);
    {
        pg8::Gemm g{(const bf16_t*)(ws + WS_MIX), (const bf16_t*)(ws + WS_WOUTT), S, D, D}; pg8::StaticOrder so; so.init(S, D, (int)gridDim.x, (int)blockIdx.x);
        EpiOutProj E{(const float*)(ws + WS_RSB), p.in[I_X], (bf16_t*)(ws + WS_A), (float*)(ws + WS_SSQ), ws + WS_X1Q, (float*)(ws + WS_XSC)};
        pg8::gemm_phase<EpiOutProj, pg8::StaticOrder, true, true>(ring, g, so, E);
    }
    xcd_barrier(bar);
    {
        pg8::Gemm g{(const bf16_t*)(ws + WS_A), (const bf16_t*)(ws + WS_WQT), S, NQ, D}; pg8::StaticOrder so; so.init(S, NQ, (int)gridDim.x, (int)blockIdx.x);
        EpiPeerQ E{(bf16_t*)(ws + WS_B)};
        pg8::gemm_phase<EpiPeerQ, pg8::StaticOrder, true, true>(ring, g, so, E);
    }
    asm volatile("s_waitcnt vmcnt(0)" ::: "memory"); __syncthreads();
    ph_topk(p, (int*)lds);                    xcd_barrier(bar);
    ph_peer<0>(p, lds);                       xcd_barrier(bar);
    ph_peer_combine(p);                       xcd_barrier(bar);
    ph_peer<1>(p, lds);
}

extern "C" void kernel_launch(void* const* d_in, const int* in_sizes, int n_in, void* d_out, int out_size, void* d_ws, size_t ws_size, hipStream_t stream) {
    static int grid = 0;
    if (grid == 0) {
        if (n_in != 20 || out_size != S * D || ws_size < WS_END) { fprintf(stderr, "kernel_launch: unexpected shapes (n_in %d out %d ws %zu)\n", n_in, out_size, ws_size); grid = -1; return; }
        int dev = 0, cus = 0, per_cu = 0;
        if (hipGetDevice(&dev) != hipSuccess || hipDeviceGetAttribute(&cus, hipDeviceAttributeMultiprocessorCount, dev) != hipSuccess) { grid = -1; return; }
        if (hipFuncSetAttribute((const void*)hymba_fwd, hipFuncAttributeMaxDynamicSharedMemorySize, LDS_BYTES) != hipSuccess) { fprintf(stderr, "kernel_launch: hipFuncSetAttribute failed\n"); grid = -1; return; }
        if (hipOccupancyMaxActiveBlocksPerMultiprocessor(&per_cu, (const void*)hymba_fwd, NTHR, LDS_BYTES) != hipSuccess || per_cu < 1) { fprintf(stderr, "kernel_launch: occupancy query says %d blocks per CU\n", per_cu); grid = -1; return; }
        (void)hipGetLastError();
        grid = cus;
    }
    if (grid < 0) return;
    (void)hipMemsetAsync((char*)d_ws + WS_CTL, 0, XCD_BAR_WORDS * 4, stream);
    Params p{};
    for (int i = 0; i < 20; ++i) p.in[i] = (const float*)d_in[i];
    p.out = (float*)d_out; p.ws = (unsigned char*)d_ws;
    hipLaunchKernelGGL(hymba_fwd, dim3(grid), dim3(NTHR), LDS_BYTES, stream, p);
}
```

```cpp
#include <hip/hip_runtime.h>
#include <cstdint>
#include <cstdio>

typedef unsigned short bf16_t;
typedef short bf16x8 __attribute__((ext_vector_type(8)));
typedef float f32x4 __attribute__((ext_vector_type(4)));
typedef unsigned u32x4 __attribute__((ext_vector_type(4)));
typedef float f32x16 __attribute__((ext_vector_type(16)));

constexpr int S = 16384, D = 1024, NPROJ = 2560, DSB = 512, DRG = 512, NH = 8, HD = 64;
constexpr int PH = 8, PNK = 128, PDK = 256, PHALF = 128, PTOPK = 16, NEXP = 16384, NQ = PH * PDK;
constexpr int CHUNK = 64, NCHUNK = S / CHUNK;
constexpr float EPS = 1e-6f;
constexpr float LOG2E = 1.4426950408889634f;
constexpr float QSCALE = 0.125f * LOG2E;
constexpr int NTHR = 512;
constexpr float CARRY_STOP = -160.0f;

constexpr size_t MiB = 1u << 20;
constexpr size_t WS_CTL = 0;
constexpr size_t WS_WINT = 1 * MiB;
constexpr size_t WS_WOUTT = 6 * MiB;
constexpr size_t WS_WQT = 8 * MiB;
constexpr size_t WS_SUBK = 12 * MiB;
constexpr size_t WS_RSTD1 = 12 * MiB + 512 * 1024;
constexpr size_t WS_RSTD2 = WS_RSTD1 + 64 * 1024;
constexpr size_t WS_RGP = WS_RSTD2 + 64 * 1024;
constexpr size_t WS_RGH = WS_RGP + 512 * 1024;
constexpr size_t WS_RGSA = 207 * MiB, WS_RGSB = 223 * MiB;
constexpr size_t WS_A = 14 * MiB;
constexpr size_t WS_B = 46 * MiB;
constexpr size_t WS_QH = WS_B, WS_KH = WS_B + 16 * MiB, WS_VH = WS_B + 32 * MiB, WS_XRG = WS_B + 48 * MiB;
constexpr size_t WS_GG = 110 * MiB;
constexpr size_t WS_OSB = 126 * MiB;
constexpr size_t WS_MIX = 142 * MiB;
constexpr size_t WS_SSB = 198 * MiB;
constexpr size_t WS_RSB = WS_SSB + 512 * 1024;
constexpr size_t WS_SELI = WS_MIX, WS_SELG = WS_MIX + 8 * MiB;
constexpr size_t WS_PD = WS_B;
constexpr size_t WS_CBUF = WS_GG;
constexpr size_t WS_CSC = WS_GG + 4 * MiB;
constexpr size_t WS_X1Q = WS_OSB;
constexpr size_t WS_XSC = WS_GG + 8 * MiB;
constexpr size_t WS_UB = 174 * MiB;
constexpr size_t WS_VB = 190 * MiB;
constexpr size_t WS_USC = 206 * MiB;
constexpr size_t WS_SSQ = 238 * MiB;
constexpr size_t WS_RGW = 239 * MiB;
constexpr size_t WS_END = 240 * MiB;

__device__ __forceinline__ unsigned f2bf(float f) { unsigned u = __builtin_bit_cast(unsigned, f); return (u + 0x7fffu + ((u >> 16) & 1u)) >> 16; }
__device__ __forceinline__ float u2f(unsigned u) { return __builtin_bit_cast(float, u); }
__device__ __forceinline__ float bf2f(unsigned h) { return __builtin_bit_cast(float, h << 16); }
__device__ __forceinline__ unsigned pk2(float lo, float hi) { return f2bf(lo) | (f2bf(hi) << 16); }
__device__ __forceinline__ unsigned pack_i8(float a, float b, float c, float d) {
    const int qa = __float2int_rn(a), qb = __float2int_rn(b), qc = __float2int_rn(c), qd = __float2int_rn(d);
    return (unsigned)(qa & 255) | ((unsigned)(qb & 255) << 8) | ((unsigned)(qc & 255) << 16) | ((unsigned)qd << 24);
}
__device__ __forceinline__ unsigned pack_n4(float a, float b, float c, float d) {
    const int qa = min(max(__float2int_rn(a), -7), 7) & 15, qb = min(max(__float2int_rn(b), -7), 7) & 15, qc = min(max(__float2int_rn(c), -7), 7) & 15, qd = min(max(__float2int_rn(d), -7), 7) & 15;
    return (unsigned)qa | ((unsigned)qb << 4) | ((unsigned)qc << 8) | ((unsigned)qd << 12);
}
template <int OFFS>
__device__ __forceinline__ unsigned pack_u4(float a, float b, float c, float d) {
    const int qa = (min(max(__float2int_rn(a), -7), 7) + OFFS) & 15, qb = (min(max(__float2int_rn(b), -7), 7) + OFFS) & 15, qc = (min(max(__float2int_rn(c), -7), 7) + OFFS) & 15, qd = (min(max(__float2int_rn(d), -7), 7) + OFFS) & 15;
    return (unsigned)qa | ((unsigned)qb << 8) | ((unsigned)qc << 16) | ((unsigned)qd << 24);
}
__device__ __forceinline__ float wave_sum(float v) {
#pragma unroll
    for (int o = 1; o < 64; o <<= 1) v += __shfl_xor(v, o);
    return v;
}
__device__ __forceinline__ float gelu_tanh(float x) {
    const float u = 0.7978845608028654f * (x + 0.044715f * x * x * x);
    const float e = __expf(2.0f * u);
    const float th = 1.0f - 2.0f / (e + 1.0f);
    return 0.5f * x * (1.0f + th);
}

__host__ __device__ __forceinline__ int inproj_phys_row(int nlog) { const int t = nlog >> 8, L = nlog & 255; return (t << 8) + 128 * ((L & 63) >> 5) + 32 * (L >> 6) + (L & 31); }

__device__ __forceinline__ int phase_tid() { int t = threadIdx.x; asm volatile("" : "+v"(t)); return t; }

struct Params {
    const float* in[20];
    float* out;
    unsigned char* ws;
};
enum { I_X = 0, I_NORM_MIX, I_W_IN, I_Q_NORM, I_K_NORM, I_CONV_W, I_CONV_B, I_RG_W_A, I_RG_B_A, I_RG_W_X, I_RG_B_X, I_RG_LAMBDA,
       I_OUT_NORM_SB, I_OUT_NORM_RG, I_W_OUT, I_NORM_FFN, I_PEER_WQ, I_PEER_SUBK, I_PEER_U, I_PEER_V };

template <bool INPROJ_PERM>
__device__ __forceinline__ void prep_transpose_item(const float* W, const float* gain0, const float* gain1, int K, int N, bf16_t* WT, float* scr, int item, int lane) {
    const int nblk = N / 32, kb = item / nblk, nb = item % nblk, k0 = 64 * kb, n0 = 32 * nb;
#pragma unroll
    for (int i = 0; i < 32; ++i) {
        const int kk = 2 * i + (lane >> 5), k = k0 + kk;
        const float g = (gain1 && k >= 512) ? gain1[k - 512] : gain0[k];
        scr[kk * 33 + (lane & 31)] = g * W[(size_t)k * N + n0 + (lane & 31)];
    }
    asm volatile("s_waitcnt lgkmcnt(0)" ::: "memory");
    const int c = lane & 7;
#pragma unroll
    for (int j = 0; j < 4; ++j) {
        const int n = (lane >> 3) + 8 * j; const float* s = scr + (8 * c) * 33 + n;
        u32x4 o; o.x = pk2(s[0 * 33], s[1 * 33]); o.y = pk2(s[2 * 33], s[3 * 33]); o.z = pk2(s[4 * 33], s[5 * 33]); o.w = pk2(s[6 * 33], s[7 * 33]);
        const int nr = INPROJ_PERM ? inproj_phys_row(n0 + n) : n0 + n;
        *(u32x4*)(WT + (size_t)nr * K + k0 + 8 * c) = o;
    }
    asm volatile("s_waitcnt lgkmcnt(0)" ::: "memory");
}
__device__ __forceinline__ void ph_tables(const Params& p, int cw, int ncw, int lane) {
    unsigned char* ws = p.ws;
    {
        const float* u = p.in[I_PEER_U]; const float* v = p.in[I_PEER_V]; const float* g = p.in[I_NORM_FFN];
        unsigned* ub = (unsigned*)(ws + WS_UB); unsigned* vb = (unsigned*)(ws + WS_VB); float2* uvsc = (float2*)(ws + WS_USC);
        f32x4 gq[4];
#pragma unroll
        for (int j = 0; j < 4; ++j) gq[j] = *((const f32x4*)g + lane + 64 * j);
        for (int e0 = cw; e0 < NEXP; e0 += 2 * ncw) {
            f32x4 a[2][4], b[2][4]; float ma[2], mb[2], sa2[2], sb2[2];
#pragma unroll
            for (int rr = 0; rr < 2; ++rr) {
                const int e = min(e0 + rr * ncw, NEXP - 1);
#pragma unroll
                for (int j = 0; j < 4; ++j) { a[rr][j] = *((const f32x4*)(u + (size_t)e * D) + lane + 64 * j); b[rr][j] = *((const f32x4*)(v + (size_t)e * D) + lane + 64 * j); }
            }
#pragma unroll
            for (int rr = 0; rr < 2; ++rr) {
                ma[rr] = 0.f; mb[rr] = 0.f; sa2[rr] = 0.f; sb2[rr] = 0.f;
#pragma unroll
                for (int j = 0; j < 4; ++j) {
                    a[rr][j] = a[rr][j] * gq[j];
                    const f32x4 aa = a[rr][j], bb = b[rr][j];
                    ma[rr] = fmaxf(ma[rr], fmaxf(fmaxf(fabsf(aa.x), fabsf(aa.y)), fmaxf(fabsf(aa.z), fabsf(aa.w))));
                    mb[rr] = fmaxf(mb[rr], fmaxf(fmaxf(fabsf(bb.x), fabsf(bb.y)), fmaxf(fabsf(bb.z), fabsf(bb.w))));
                    sa2[rr] += (aa.x * aa.x + aa.y * aa.y) + (aa.z * aa.z + aa.w * aa.w);
                    sb2[rr] += (bb.x * bb.x + bb.y * bb.y) + (bb.z * bb.z + bb.w * bb.w);
                }
            }
#pragma unroll
            for (int o = 1; o < 64; o <<= 1)
#pragma unroll
                for (int rr = 0; rr < 2; ++rr) { ma[rr] = fmaxf(ma[rr], __shfl_xor(ma[rr], o)); mb[rr] = fmaxf(mb[rr], __shfl_xor(mb[rr], o)); sa2[rr] += __shfl_xor(sa2[rr], o); sb2[rr] += __shfl_xor(sb2[rr], o); }
#pragma unroll
            for (int rr = 0; rr < 2; ++rr) {
                const int e = e0 + rr * ncw;
                if (e < NEXP) {
                    const float ca = fminf(ma[rr], 2.5f * sqrtf(sa2[rr] * (1.0f / D))), cb = fminf(mb[rr], 2.5f * sqrtf(sb2[rr] * (1.0f / D)));
                    const float ia = ca > 0.f ? 7.0f / ca : 0.f, ib = cb > 0.f ? 7.0f / cb : 0.f;
#pragma unroll
                    for (int j = 0; j < 4; ++j) {
                        const f32x4 aa = a[rr][j], bb = b[rr][j];
                        const unsigned na = pack_u4<0>(aa.x * ia, aa.y * ia, aa.z * ia, aa.w * ia), nb = pack_n4(bb.x * ib, bb.y * ib, bb.z * ib, bb.w * ib);
                        const unsigned pa = __shfl_xor(na, 1), pb = __shfl_xor(nb, 1);
                        if ((lane & 1) == 0) {
                            ub[((size_t)j * NEXP + e) * 32 + (lane >> 1)] = na | (pa << 4);
                            vb[((size_t)j * NEXP + e) * 32 + (lane >> 1)] = nb | (pb << 16);
                        }
                    }
                    if (lane == 0) uvsc[e] = make_float2(ca * (1.0f / 7.0f), cb * (1.0f / 7.0f));
                }
            }
        }
    }
}

__device__ __forceinline__ void ph_prep(const Params& p, unsigned char* lds) {
    const int tid_ = phase_tid();
    const int gtid = blockIdx.x * blockDim.x + tid_, gsize = gridDim.x * blockDim.x;
    const int lane = tid_ & 63, gwave = gtid >> 6, nwave = gsize >> 6;
    unsigned char* ws = p.ws;
    {
        float* scr = (float*)lds + (tid_ >> 6) * (64 * 33);
        constexpr int I_IN = (D / 64) * (NPROJ / 32), I_OUT = (D / 64) * (D / 32), I_Q = (D / 64) * (NQ / 32);
        for (int it = gwave; it < I_IN + I_OUT + I_Q; it += nwave) {
            if (it < I_IN) prep_transpose_item<true>(p.in[I_W_IN], p.in[I_NORM_MIX], nullptr, D, NPROJ, (bf16_t*)(ws + WS_WINT), scr, it, lane);
            else if (it < I_IN + I_OUT) prep_transpose_item<false>(p.in[I_W_OUT], p.in[I_OUT_NORM_SB], p.in[I_OUT_NORM_RG], D, D, (bf16_t*)(ws + WS_WOUTT), scr, it - I_IN, lane);
            else prep_transpose_item<false>(p.in[I_PEER_WQ], p.in[I_NORM_FFN], nullptr, D, NQ, (bf16_t*)(ws + WS_WQT), scr, it - I_IN - I_OUT, lane);
        }
    }
    {
        const float* wa = p.in[I_RG_W_A]; const float* wx = p.in[I_RG_W_X]; bf16_t* o = (bf16_t*)(ws + WS_RGW);
        for (int e = gtid; e < 8 * 2 * 2 * 4 * 64 * 8; e += gsize) {
            const int el = e & 7, ln = (e >> 3) & 63, s = (e >> 9) & 3, jt = (e >> 11) & 1, g = (e >> 12) & 1, n = e >> 13;
            const int j = 32 * jt + (ln & 31), i = 16 * s + 8 * (el >> 2) + 4 * (ln >> 5) + (el & 3);
            o[e] = (bf16_t)f2bf((g == 0 ? wa : wx)[((size_t)n * 64 + i) * 64 + j]);
        }
    }
    {
        const float* sk = p.in[I_PEER_SUBK]; bf16_t* o = (bf16_t*)(ws + WS_SUBK);
        for (int e = gtid; e < PH * 2 * PNK * PHALF; e += gsize) o[e] = (bf16_t)f2bf(sk[e]);
    }
    {
        const float* x = p.in[I_X]; bf16_t* xb = (bf16_t*)(ws + WS_A); float* rstd1 = (float*)(ws + WS_RSTD1);
        for (int row0 = gwave; row0 < S; row0 += 4 * nwave) {
            f32x4 v[4][4];
#pragma unroll
            for (int rr = 0; rr < 4; ++rr) {
                const int row = min(row0 + rr * nwave, S - 1);
#pragma unroll
                for (int j = 0; j < 4; ++j) v[rr][j] = ((const f32x4*)(x + (size_t)row * D) + lane)[64 * j];
            }
#pragma unroll
            for (int rr = 0; rr < 4; ++rr) {
                const int row = row0 + rr * nwave;
                float ss = 0.f;
#pragma unroll
                for (int j = 0; j < 4; ++j) ss += (v[rr][j].x * v[rr][j].x + v[rr][j].y * v[rr][j].y) + (v[rr][j].z * v[rr][j].z + v[rr][j].w * v[rr][j].w);
                ss = wave_sum(ss);
                if (row < S) {
                    uint2* o = (uint2*)(xb + (size_t)row * D) + lane;
#pragma unroll
                    for (int j = 0; j < 4; ++j) o[64 * j] = make_uint2(pk2(v[rr][j].x, v[rr][j].y), pk2(v[rr][j].z, v[rr][j].w));
                    if (lane == 0) rstd1[row] = rsqrtf(ss * (1.0f / D) + EPS);
                }
            }
        }
    }
}

namespace pg8 {
#define PG8_LAS __attribute__((address_space(3)))
typedef unsigned short bf16_t;
typedef short bf16x8 __attribute__((ext_vector_type(8)));
typedef float f32x4 __attribute__((ext_vector_type(4)));
typedef unsigned u32x4 __attribute__((ext_vector_type(4)));
constexpr int BM = 256, BK = 64, HALF = 128, HTB = HALF * BK * 2  , STAGE_BYTES = 8 * HTB, NXCD = 8, WGM = 8;

__host__ __device__ __forceinline__ int lds_byte(int r, int c) { const int st = (r >> 4) * 2 + (c >> 5), rr = r & 15, cc = c & 31, ob = rr * 64 + cc * 2; return st * 1024 + (ob ^ (((ob >> 9) & 1) << 5)); }
__host__ __device__ __forceinline__ void stage_rc(int b, int& R, int& C) { const int st = b / 1024, sb = b % 1024, swz = sb ^ (((sb >> 9) & 1) << 5); R = (st >> 1) * 16 + swz / 64; C = (st & 1) * 32 + (swz % 64) / 2; }
__host__ __device__ __forceinline__ int perm32(int rho) { const int n = rho >> 4, i = rho & 15; return 8 * (i >> 2) + 4 * n + (i & 3); }

struct Unit { int pm, pn; };
struct Gemm { const bf16_t* A; const bf16_t* Bt; int M, N, K; };

struct StaticOrder {
    int nM, nN, nwg, G, c;
    __host__ __device__ void init(int M, int N, int G_, int c_) { nM = M / BM; nN = N / BM; nwg = nM * nN; G = G_; c = c_; }
    __host__ __device__ bool next(int i, Unit& u) const {
        const long L = (long)i * G + c; if (L >= nwg) return false;
        int wgid = (int)L; { const int q = nwg / NXCD, r = nwg % NXCD, xcd = wgid % NXCD, off = wgid / NXCD; wgid = (xcd < r ? xcd * (q + 1) : r * (q + 1) + (xcd - r) * q) + off; }
        const int nig = WGM * nN, gid = wgid / nig, fm = gid * WGM, gsz = (nM - fm) < WGM ? (nM - fm) : WGM;
        u.pm = fm + ((wgid % nig) % gsz); u.pn = (wgid % nig) / gsz; return true;
    }
    __device__ __forceinline__ void a_ready(const Unit&) const {}
    __device__ __forceinline__ void done(const Unit&) const {}
};

__device__ __forceinline__ unsigned cvt_pk_bf16(float lo, float hi) { unsigned r; asm volatile("v_cvt_pk_bf16_f32 %0, %1, %2" : "=v"(r) : "v"(lo), "v"(hi)); return r; }
template <class Epi, class Sched, bool ALIGN_EPI = false, bool SP2 = false>
__device__ __forceinline__ void gemm_phase(PG8_LAS unsigned char* lds, const Gemm g, const Sched& S, const Epi& E) {
    const int tid = phase_tid(), wid = __builtin_amdgcn_readfirstlane(tid >> 6), lane = tid & 63, wr = wid >> 2, wc = wid & 3, fr = lane & 15, fq = lane >> 4;
    const int K = g.K, nt = K / BK;
    unsigned voffA[2], voffB[2];
#pragma unroll
    for (int i = 0; i < 2; ++i) { int R, C; stage_rc(tid * 16 + i * 8192, R, C); const int Rb = Epi::PERM ? ((R & ~31) + perm32(R & 31)) : R;
        voffA[i] = (unsigned)(R * K + C) * 2u; voffB[i] = (unsigned)(Rb * K + C) * 2u; }
    const size_t kstep = (size_t)(BK * 2);
    const size_t hstep = (size_t)HALF * K * 2;
    const size_t tstep = 2 * hstep;
    const unsigned ldsw = (unsigned)wid * 1024u;
    const int aoff = lds_byte(wr * 64 + fr, fq * 8), boff = lds_byte(wc * 32 + fr, fq * 8);
#define PG8_SA(b, h) (((b) * 2 + (h)) * HTB)
#define PG8_SB(b, h) ((4 + (b) * 2 + (h)) * HTB)
#define PG8_STAGE(bufoff, gbase, voff) do { _Pragma("unroll") for (int _i = 0; _i < 2; ++_i) \
        __builtin_amdgcn_global_load_lds((const unsigned*)((const char*)(gbase) + (voff)[_i]), (PG8_LAS unsigned*)(lds + (bufoff) + ldsw + _i * 8192), 16, 0, 0); } while (0)
#define PG8_LDA(dst, b, h) do { _Pragma("unroll") for (int m = 0; m < 4; ++m) _Pragma("unroll") for (int k = 0; k < 2; ++k) dst[m][k] = *(const PG8_LAS bf16x8*)(lds + PG8_SA(b, h) + aoff + m * 2048 + k * 1024); } while (0)
#define PG8_LDB(dst, b, h) do { _Pragma("unroll") for (int n = 0; n < 2; ++n) _Pragma("unroll") for (int k = 0; k < 2; ++k) dst[n][k] = *(const PG8_LAS bf16x8*)(lds + PG8_SB(b, h) + boff + n * 2048 + k * 1024); } while (0)
#define PG8_MMA(ai, bj, At, Bt) do { __builtin_amdgcn_s_setprio(1); _Pragma("unroll") for (int m = 0; m < 4; ++m) _Pragma("unroll") for (int n = 0; n < 2; ++n) _Pragma("unroll") for (int k = 0; k < 2; ++k) \
        acc[ai][bj][m][n] = __builtin_amdgcn_mfma_f32_16x16x32_bf16(Bt[n][k], At[m][k], acc[ai][bj][m][n], 0, 0, 0); __builtin_amdgcn_s_setprio(0); } while (0)
#define PG8_WAIT_V(n) asm volatile("s_waitcnt vmcnt(" #n ")" ::: "memory")
#define PG8_WAIT_L(n) asm volatile("s_waitcnt lgkmcnt(" #n ")" ::: "memory")
#define PG8_BAR __builtin_amdgcn_s_barrier()
#define PG8_SCHED __builtin_amdgcn_sched_barrier(0)
    Unit cur, nxt; int ui = 0;
    if (!S.next(0, cur)) return;
    f32x4 acc[2][2][4][2];
#pragma unroll
    for (int a = 0; a < 2; ++a)
#pragma unroll
        for (int b = 0; b < 2; ++b)
#pragma unroll
            for (int m = 0; m < 4; ++m)
#pragma unroll
                for (int n = 0; n < 2; ++n) acc[a][b][m][n] = (f32x4){0.f, 0.f, 0.f, 0.f};
    bf16x8 At[4][2], B0[2][2], B1[2][2];
    const char* cA = (const char*)g.A + (size_t)cur.pm * tstep; const char* cB = (const char*)g.Bt + (size_t)cur.pn * tstep;
    S.a_ready(cur);
    if constexpr (SP2) {
        PG8_STAGE(PG8_SB(0, 0), cB, voffB); PG8_STAGE(PG8_SB(0, 1), cB + hstep, voffB); PG8_STAGE(PG8_SA(0, 0), cA, voffA); PG8_STAGE(PG8_SA(0, 1), cA + hstep, voffA);
        if (wr == 1) PG8_BAR;
        PG8_WAIT_V(2); PG8_BAR;
        PG8_STAGE(PG8_SB(1, 0), cB + kstep, voffB); PG8_STAGE(PG8_SA(1, 0), cA + kstep, voffA); PG8_STAGE(PG8_SB(1, 1), cB + hstep + kstep, voffB);
        PG8_WAIT_V(6); PG8_BAR;
    } else {
        PG8_STAGE(PG8_SB(0, 0), cB, voffB); PG8_STAGE(PG8_SA(0, 0), cA, voffA); PG8_STAGE(PG8_SB(0, 1), cB + hstep, voffB); PG8_STAGE(PG8_SA(0, 1), cA + hstep, voffA);
        if (wr == 1) PG8_BAR;
        PG8_WAIT_V(4); PG8_BAR;
        PG8_STAGE(PG8_SB(1, 0), cB + kstep, voffB); PG8_STAGE(PG8_SA(1, 0), cA + kstep, voffA); PG8_STAGE(PG8_SB(1, 1), cB + hstep + kstep, voffB);
        PG8_WAIT_V(6); PG8_BAR;
    }
    for (;;) {
        const bool has_next = S.next(ui + 1, nxt);
        const char* nA = has_next ? (const char*)g.A + (size_t)nxt.pm * tstep : cA; const char* nB = has_next ? (const char*)g.Bt + (size_t)nxt.pn * tstep : cB;
        for (int t = 0; t < nt; t += 2) {
            if constexpr (Epi::MIDSCALE) { if (t == nt / 2) E.mid(acc, cur, wr, wc, fr, fq); }
            const bool last = (t == nt - 2);
            const char* a1 = cA + (size_t)(t + 1) * kstep;
            const char* a2 = last ? nA : cA + (size_t)(t + 2) * kstep; const char* b2 = last ? nB : cB + (size_t)(t + 2) * kstep;
            const char* a3 = a2 + kstep; const char* b3 = b2 + kstep;
            if (last && has_next) S.a_ready(nxt);
            if constexpr (SP2) {
            PG8_LDB(B0, 0, 0); PG8_LDB(B1, 0, 1); PG8_SCHED; PG8_LDA(At, 0, 0); PG8_STAGE(PG8_SA(1, 1), a1 + hstep, voffA);
            PG8_WAIT_V(8); PG8_WAIT_L(0); PG8_BAR; PG8_MMA(0, 0, At, B0); PG8_MMA(0, 1, At, B1); PG8_BAR; PG8_SCHED;
            PG8_LDA(At, 0, 1); PG8_STAGE(PG8_SB(0, 0), b2, voffB); PG8_STAGE(PG8_SB(0, 1), b2 + hstep, voffB); PG8_STAGE(PG8_SA(0, 0), a2, voffA);
            PG8_WAIT_V(8); PG8_WAIT_L(0); PG8_BAR; PG8_MMA(1, 0, At, B0); PG8_MMA(1, 1, At, B1); PG8_BAR; PG8_SCHED;
            PG8_LDB(B0, 1, 0); PG8_LDB(B1, 1, 1); PG8_SCHED; PG8_LDA(At, 1, 0); PG8_STAGE(PG8_SA(0, 1), a2 + hstep, voffA);
            PG8_WAIT_V(8); PG8_WAIT_L(0); PG8_BAR; PG8_MMA(0, 0, At, B0); PG8_MMA(0, 1, At, B1); PG8_BAR; PG8_SCHED;
            PG8_LDA(At, 1, 1); PG8_STAGE(PG8_SB(1, 0), b3, voffB); PG8_STAGE(PG8_SB(1, 1), b3 + hstep, voffB); PG8_STAGE(PG8_SA(1, 0), a3, voffA);
            PG8_WAIT_V(8); PG8_WAIT_L(0); PG8_BAR; PG8_MMA(1, 0, At, B0); PG8_MMA(1, 1, At, B1); PG8_BAR; PG8_SCHED;
            } else {
            PG8_LDB(B0, 0, 0); PG8_SCHED; PG8_LDA(At, 0, 0); PG8_STAGE(PG8_SA(1, 1), a1 + hstep, voffA);
            PG8_WAIT_L(8); PG8_BAR; PG8_WAIT_L(0); PG8_MMA(0, 0, At, B0); PG8_BAR; PG8_SCHED;
            PG8_LDB(B1, 0, 1); PG8_STAGE(PG8_SB(0, 0), b2, voffB);
            PG8_BAR; PG8_WAIT_L(0); PG8_MMA(0, 1, At, B1); PG8_BAR;
            PG8_LDA(At, 0, 1); PG8_STAGE(PG8_SA(0, 0), a2, voffA);
            PG8_BAR; PG8_WAIT_L(0); PG8_MMA(1, 0, At, B0); PG8_BAR; PG8_SCHED;
            PG8_STAGE(PG8_SB(0, 1), b2 + hstep, voffB);
            PG8_WAIT_V(6); PG8_BAR; PG8_MMA(1, 1, At, B1); PG8_BAR;
            PG8_LDB(B0, 1, 0); PG8_SCHED; PG8_LDA(At, 1, 0); PG8_STAGE(PG8_SA(0, 1), a2 + hstep, voffA);
            PG8_WAIT_L(8); PG8_BAR; PG8_WAIT_L(0); PG8_MMA(0, 0, At, B0); PG8_BAR; PG8_SCHED;
            PG8_LDB(B1, 1, 1); PG8_STAGE(PG8_SB(1, 0), b3, voffB);
            PG8_BAR; PG8_WAIT_L(0); PG8_MMA(0, 1, At, B1); PG8_BAR;
            PG8_LDA(At, 1, 1); PG8_STAGE(PG8_SA(1, 0), a3, voffA);
            PG8_BAR; PG8_WAIT_L(0); PG8_MMA(1, 0, At, B0); PG8_BAR; PG8_SCHED;
            PG8_STAGE(PG8_SB(1, 1), b3 + hstep, voffB);
            PG8_WAIT_V(6); PG8_BAR; PG8_MMA(1, 1, At, B1); PG8_BAR;
            }
        }
        if constexpr (ALIGN_EPI) { if (wr == 0) PG8_BAR; }
        if constexpr (!Epi::AFTER_DRAIN) { E(acc, cur, wr, wc, fr, fq); S.done(cur); }
        if (!has_next) break;
#pragma unroll
        for (int a = 0; a < 2; ++a)
#pragma unroll
            for (int b = 0; b < 2; ++b)
#pragma unroll
                for (int m = 0; m < 4; ++m)
#pragma unroll
                    for (int n = 0; n < 2; ++n) acc[a][b][m][n] = (f32x4){0.f, 0.f, 0.f, 0.f};
        cur = nxt; cA = nA; cB = nB; ++ui;
        if constexpr (ALIGN_EPI) { if (wr == 1) PG8_BAR; }
    }
    PG8_WAIT_V(0);
    if constexpr (!ALIGN_EPI) { if (wr == 0) PG8_BAR; }
    PG8_BAR;
    if constexpr (Epi::AFTER_DRAIN) { E.fused(acc, cur, wr, wc, fr, fq, lds, wid, lane); S.done(cur); }
#undef PG8_SA
#undef PG8_SB
#undef PG8_STAGE
#undef PG8_LDA
#undef PG8_LDB
#undef PG8_MMA
#undef PG8_WAIT_V
#undef PG8_WAIT_L
#undef PG8_BAR
#undef PG8_SCHED
}
}

struct EpiInProj {
    static constexpr bool PERM = true, AFTER_DRAIN = false, MIDSCALE = false;
    const float* rstd1; const float* qn; const float* kn; bf16_t *qh, *kh, *vh, *xrg, *gg;
    __device__ __forceinline__ void operator()(const pg8::f32x4 (&acc)[2][2][4][2], const pg8::Unit& u, int wr, int wc, int fr, int fq) const {
        const int region = u.pn >> 1;
        const int head = (u.pn & 1) * 4 + wc;
        float rsv[2][4];
#pragma unroll
        for (int ai = 0; ai < 2; ++ai)
#pragma unroll
            for (int m = 0; m < 4; ++m) rsv[ai][m] = rstd1[u.pm * 256 + ai * 128 + wr * 64 + m * 16 + fr];
        pg8::f32x4 gn[2][2];
        if (region <= 1) {
            const float* g = region == 0 ? qn : kn; const float sc = region == 0 ? QSCALE : 1.0f;
#pragma unroll
            for (int bj = 0; bj < 2; ++bj)
#pragma unroll
                for (int n = 0; n < 2; ++n) gn[bj][n] = *(const pg8::f32x4*)(g + 32 * bj + 8 * fq + 4 * n) * sc;
        }
#pragma unroll
        for (int ai = 0; ai < 2; ++ai)
#pragma unroll
            for (int m = 0; m < 4; ++m) {
                const int row = u.pm * 256 + ai * 128 + wr * 64 + m * 16 + fr;
                const float rs = rsv[ai][m];
                pg8::f32x4 v[2][2];
#pragma unroll
                for (int bj = 0; bj < 2; ++bj)
#pragma unroll
                    for (int n = 0; n < 2; ++n) v[bj][n] = acc[ai][bj][m][n] * rs;
                bf16_t* dst;
                if (region <= 1) {
                    float ss = 0.f;
#pragma unroll
                    for (int bj = 0; bj < 2; ++bj)
#pragma unroll
                        for (int n = 0; n < 2; ++n) ss += (v[bj][n][0] * v[bj][n][0] + v[bj][n][1] * v[bj][n][1]) + (v[bj][n][2] * v[bj][n][2] + v[bj][n][3] * v[bj][n][3]);
                    ss += __shfl_xor(ss, 16); ss += __shfl_xor(ss, 32);
                    const float rn = rsqrtf(ss * (1.0f / HD) + EPS);
#pragma unroll
                    for (int bj = 0; bj < 2; ++bj)
#pragma unroll
                        for (int n = 0; n < 2; ++n) v[bj][n] = v[bj][n] * rn * gn[bj][n];
                    bf16_t* fb = (region == 0 ? qh : kh) + ((size_t)(head * (S / 32) + (row >> 5)) * 4 * 64 + (row & 31)) * 8;
#pragma unroll
                    for (int bj = 0; bj < 2; ++bj) {
                        pg8::u32x4 w; w.x = pg8::cvt_pk_bf16(v[bj][0][0], v[bj][0][1]); w.y = pg8::cvt_pk_bf16(v[bj][0][2], v[bj][0][3]);
                        w.z = pg8::cvt_pk_bf16(v[bj][1][0], v[bj][1][1]); w.w = pg8::cvt_pk_bf16(v[bj][1][2], v[bj][1][3]);
                        *(pg8::u32x4*)(fb + ((2 * bj + (fq >> 1)) * 64 + 32 * (fq & 1)) * 8) = w;
                    }
                    continue;
                } else if (region == 2) {
#pragma unroll
                    for (int bj = 0; bj < 2; ++bj)
#pragma unroll
                        for (int n = 0; n < 2; ++n)
#pragma unroll
                            for (int i = 0; i < 4; ++i) {
                                const int d = 32 * bj + 8 * fq + 4 * n + i, kl = row & 31;
                                vh[(((((size_t)head * (S / 32) + (row >> 5)) * 2 + (d >> 5)) * 2 + (kl >> 4)) * 64 + (d & 31) + 32 * ((kl >> 2) & 1)) * 8 + 4 * ((kl >> 3) & 1) + (kl & 3)] = (bf16_t)f2bf(v[bj][n][i]);
                            }
                    continue;
                } else if (region == 3) {
                    dst = xrg + (size_t)row * DRG + head * 64;
                } else {
#pragma unroll
                    for (int bj = 0; bj < 2; ++bj)
#pragma unroll
                        for (int n = 0; n < 2; ++n)
#pragma unroll
                            for (int i = 0; i < 4; ++i) v[bj][n][i] = gelu_tanh(v[bj][n][i]);
#pragma unroll
                    for (int bj = 0; bj < 2; ++bj)
#pragma unroll
                        for (int n = 0; n < 2; ++n)
                            *(uint2*)(gg + ((((size_t)(row >> 5) * 8 + head) * 8 + (4 * bj + fq)) * 64 + (row & 31) + 32 * n) * 4) = make_uint2(pg8::cvt_pk_bf16(v[bj][n][0], v[bj][n][1]), pg8::cvt_pk_bf16(v[bj][n][2], v[bj][n][3]));
                    continue;
                }
#pragma unroll
                for (int bj = 0; bj < 2; ++bj) {
                    pg8::u32x4 w; w.x = pg8::cvt_pk_bf16(v[bj][0][0], v[bj][0][1]); w.y = pg8::cvt_pk_bf16(v[bj][0][2], v[bj][0][3]);
                    w.z = pg8::cvt_pk_bf16(v[bj][1][0], v[bj][1][1]); w.w = pg8::cvt_pk_bf16(v[bj][1][2], v[bj][1][3]);
                    *(pg8::u32x4*)(dst + 32 * bj + 8 * fq) = w;
                }
            }
    }
};
struct EpiOutProj {
    static constexpr bool PERM = true, AFTER_DRAIN = false, MIDSCALE = true;
    __device__ __forceinline__ void mid(pg8::f32x4 (&acc)[2][2][4][2], const pg8::Unit& u, int wr, int wc, int fr, int fq) const {
        float sc[2][4];
        int fro = fr; asm volatile("" : "+v"(fro));
#pragma unroll
        for (int ai = 0; ai < 2; ++ai)
#pragma unroll
            for (int m = 0; m < 4; ++m) sc[ai][m] = rsb[u.pm * 256 + ai * 128 + wr * 64 + m * 16 + fro];
#pragma unroll
        for (int ai = 0; ai < 2; ++ai)
#pragma unroll
            for (int bj = 0; bj < 2; ++bj)
#pragma unroll
                for (int m = 0; m < 4; ++m)
#pragma unroll
                    for (int n = 0; n < 2; ++n) acc[ai][bj][m][n] = acc[ai][bj][m][n] * sc[ai][m];
    }
    const float* rsb;
    const float* x; bf16_t* x1b; float* ssq; unsigned char* x1q; float* xsc;
    __device__ __forceinline__ void operator()(const pg8::f32x4 (&acc)[2][2][4][2], const pg8::Unit& u, int wr, int wc, int fr, int fq) const {
        pg8::u32x4 xv[2][2][2];
#define OUTPROJ_LD(buf, ai_, mh_) do { _Pragma("unroll") for (int mm_ = 0; mm_ < 2; ++mm_) _Pragma("unroll") for (int bj_ = 0; bj_ < 2; ++bj_) { \
            const size_t o_ = (size_t)(u.pm * 256 + (ai_) * 128 + wr * 64 + (2 * (mh_) + mm_) * 16 + fr) * D + u.pn * 256 + bj_ * 128 + wc * 32 + 8 * fq; \
            xv[buf][mm_][bj_] = *(const pg8::u32x4*)(x1b + o_); } } while (0)
        OUTPROJ_LD(0, 0, 0);
#pragma unroll
        for (int ai = 0; ai < 2; ++ai)
#pragma unroll
            for (int m = 0; m < 4; ++m) {
                const int kb = ai * 2 + (m >> 1);
                if ((m & 1) == 0 && kb < 3) OUTPROJ_LD((kb + 1) & 1, (kb + 1) >> 1, (kb + 1) & 1);
                const int row = u.pm * 256 + ai * 128 + wr * 64 + m * 16 + fr;
                float ss = 0.f;
#pragma unroll
                for (int bj = 0; bj < 2; ++bj) {
                    const int col = u.pn * 256 + bj * 128 + wc * 32 + 8 * fq;
                    const size_t o = (size_t)row * D + col;
                    const pg8::u32x4 xw = xv[kb & 1][m & 1][bj];
                    const pg8::f32x4 a = (pg8::f32x4){u2f(xw.x << 16), u2f(xw.x & 0xffff0000u), u2f(xw.y << 16), u2f(xw.y & 0xffff0000u)} + acc[ai][bj][m][0];
                    const pg8::f32x4 b = (pg8::f32x4){u2f(xw.z << 16), u2f(xw.z & 0xffff0000u), u2f(xw.w << 16), u2f(xw.w & 0xffff0000u)} + acc[ai][bj][m][1];
                    ss += (a[0] * a[0] + a[1] * a[1]) + (a[2] * a[2] + a[3] * a[3]) + (b[0] * b[0] + b[1] * b[1]) + (b[2] * b[2] + b[3] * b[3]);
                    pg8::u32x4 w; w.x = pg8::cvt_pk_bf16(a[0], a[1]); w.y = pg8::cvt_pk_bf16(a[2], a[3]); w.z = pg8::cvt_pk_bf16(b[0], b[1]); w.w = pg8::cvt_pk_bf16(b[2], b[3]);
                    *(pg8::u32x4*)(x1b + o) = w;
                    float mx = fmaxf(fmaxf(fmaxf(fabsf(a[0]), fabsf(a[1])), fmaxf(fabsf(a[2]), fabsf(a[3]))), fmaxf(fmaxf(fabsf(b[0]), fabsf(b[1])), fmaxf(fabsf(b[2]), fabsf(b[3]))));
                    mx = fmaxf(mx, __shfl_xor(mx, 16)); mx = fmaxf(mx, __shfl_xor(mx, 32));
                    const float inv = mx > 0.f ? 119.0f / mx : 0.f;
                    unsigned pl = 0u, ph = 0u;
#pragma unroll
                    for (int i = 0; i < 4; ++i) {
                        const int qa = __float2int_rn(a[i] * inv), qb = __float2int_rn(b[i] * inv);
                        pl |= ((unsigned)(qa & 15) << (8 * i)) | ((unsigned)(qb & 15) << (8 * i + 4));
                        ph |= ((unsigned)(((qa + 8) >> 4) & 15) << (8 * i)) | ((unsigned)(((qb + 8) >> 4) & 15) << (8 * i + 4));
                    }
                    unsigned* cq = (unsigned*)(x1q + (size_t)row * D + (col & ~31));
                    cq[fq] = pl; cq[4 + fq] = ph;
                    if (fq == 0) xsc[(size_t)row * 32 + (col >> 5)] = mx * (1.0f / 119.0f);
                }
                ss += __shfl_xor(ss, 16); ss += __shfl_xor(ss, 32);
                if (fq == 0) ssq[(size_t)row * 16 + u.pn * 4 + wc] = ss;
            }
    }
};
#undef OUTPROJ_LD
struct EpiPeerQ {
    static constexpr bool PERM = true, AFTER_DRAIN = false, MIDSCALE = false;
    bf16_t* qp;
    __device__ __forceinline__ void operator()(const pg8::f32x4 (&acc)[2][2][4][2], const pg8::Unit& u, int wr, int wc, int fr, int fq) const {
#pragma unroll
        for (int ai = 0; ai < 2; ++ai)
#pragma unroll
            for (int m = 0; m < 4; ++m) {
                const int row = u.pm * 256 + ai * 128 + wr * 64 + m * 16 + fr;
#pragma unroll
                for (int bj = 0; bj < 2; ++bj) {
                    const pg8::f32x4 a = acc[ai][bj][m][0], b = acc[ai][bj][m][1];
                    pg8::u32x4 w; w.x = pg8::cvt_pk_bf16(a[0], a[1]); w.y = pg8::cvt_pk_bf16(a[2], a[3]); w.z = pg8::cvt_pk_bf16(b[0], b[1]); w.w = pg8::cvt_pk_bf16(b[2], b[3]);
                    *(pg8::u32x4*)(qp + ((((size_t)((row >> 5) * 8 + u.pn) * 2 + bj) * 8 + 2 * wc + (fq >> 1)) * 64 + (row & 31) + 32 * (fq & 1)) * 8) = w;
                }
            }
    }
};

typedef float f32x2v __attribute__((ext_vector_type(2)));
typedef __bf16 bf16x2v __attribute__((ext_vector_type(2)));
__device__ __forceinline__ unsigned cvtpk(float lo, float hi) { const f32x2v v = {lo, hi}; const bf16x2v b = __builtin_convertvector(v, bf16x2v); return __builtin_bit_cast(unsigned, b); }
__device__ __forceinline__ bf16x8 pack_step(const f32x16& x, int s) {
    u32x4 pkd; pkd.x = cvtpk(x[8 * s], x[8 * s + 1]); pkd.y = cvtpk(x[8 * s + 2], x[8 * s + 3]); pkd.z = cvtpk(x[8 * s + 4], x[8 * s + 5]); pkd.w = cvtpk(x[8 * s + 6], x[8 * s + 7]);
    return __builtin_bit_cast(bf16x8, pkd);
}
#define MFMA32(a, b, c) __builtin_amdgcn_mfma_f32_32x32x16_bf16((a), (b), (c), 0, 0, 0)
__device__ __forceinline__ void ph_attn(const Params& p) {
    unsigned char* ws = p.ws;
    const bf16_t* qh = (const bf16_t*)(ws + WS_QH); const bf16_t* kh = (const bf16_t*)(ws + WS_KH); const bf16_t* vT = (const bf16_t*)(ws + WS_VH);
    bf16_t* mixo = (bf16_t*)(ws + WS_MIX); float* ssb = (float*)(ws + WS_SSB);
    const int tid = phase_tid(), lane = tid & 63, r = lane & 31, hh = lane >> 5;
    const int gwave = (blockIdx.x * blockDim.x + tid) >> 6, nwave = (gridDim.x * blockDim.x) >> 6;
    bf16x8 tp[2];
#pragma unroll
    for (int ss = 0; ss < 2; ++ss)
#pragma unroll
        for (int e = 0; e < 8; ++e) { const int k = 16 * ss + 8 * (e >> 2) + 4 * hh + (e & 3); tp[ss][e] = (k > r) ? (short)0x3F80 : (short)0; }
    f32x16 zero16;
#pragma unroll
    for (int i = 0; i < 16; ++i) zero16[i] = 0.f;
    for (int u = gwave; u < NH * (S / 32); u += nwave) {
        const int h = u / (S / 32), t0 = (u % (S / 32)) * 32;
        bf16x8 bq[4];
#pragma unroll
        for (int s = 0; s < 4; ++s) bq[s] = *(const bf16x8*)(qh + (((size_t)(h * (S / 32) + (t0 >> 5)) * 4 + s) * 64 + lane) * 8);
        f32x16 ot[2] = {zero16, zero16};
        float carry = 0.f;
        for (int kt0 = t0; kt0 >= 0; kt0 -= 32) {
            bf16x8 ak[4], av[2][2];
#pragma unroll
            for (int s = 0; s < 4; ++s) ak[s] = *(const bf16x8*)(kh + (((size_t)(h * (S / 32) + (kt0 >> 5)) * 4 + s) * 64 + lane) * 8);
#pragma unroll
            for (int dt = 0; dt < 2; ++dt)
#pragma unroll
                for (int ss = 0; ss < 2; ++ss) av[dt][ss] = *(const bf16x8*)(vT + ((((size_t)(h * (S / 32) + (kt0 >> 5)) * 2 + dt) * 2 + ss) * 64 + lane) * 8);
            f32x16 st = zero16;
#pragma unroll
            for (int s = 0; s < 4; ++s) st = MFMA32(ak[s], bq[s], st);
            const bool diag = (kt0 == t0);
            f32x16 lom, lb;
            float csum = 0.f;
#pragma unroll
            for (int i = 0; i < 16; ++i) {
                const float z = st[i];
                const float sp2 = fmaxf(z, 0.f) + __builtin_amdgcn_logf(1.0f + __builtin_amdgcn_exp2f(-fabsf(z)));
                const bool valid = !diag || ((i & 3) + 8 * (i >> 2) + 4 * hh < r);
                lom[i] = valid ? -sp2 : 0.f;
                lb[i] = z - sp2;
                csum += lom[i];
            }
            f32x16 suf = MFMA32(tp[0], pack_step(lom, 0), zero16);
            suf = MFMA32(tp[1], pack_step(lom, 1), suf);
            f32x16 w;
#pragma unroll
            for (int i = 0; i < 16; ++i) {
                const bool valid = !diag || ((i & 3) + 8 * (i >> 2) + 4 * hh < r);
                w[i] = valid ? __builtin_amdgcn_exp2f(lb[i] + suf[i] + carry) : 0.f;
            }
            const bf16x8 w0 = pack_step(w, 0), w1 = pack_step(w, 1);
#pragma unroll
            for (int dt = 0; dt < 2; ++dt) { ot[dt] = MFMA32(av[dt][0], w0, ot[dt]); ot[dt] = MFMA32(av[dt][1], w1, ot[dt]); }
            carry += csum + __shfl_xor(csum, 32);
            if (__all(carry < CARRY_STOP)) break;
        }
        float oss = 0.f;
#pragma unroll
        for (int dt = 0; dt < 2; ++dt)
#pragma unroll
            for (int g = 0; g < 4; ++g) {
                uint2 o; o.x = cvtpk(ot[dt][4 * g], ot[dt][4 * g + 1]); o.y = cvtpk(ot[dt][4 * g + 2], ot[dt][4 * g + 3]);
                oss += (ot[dt][4 * g] * ot[dt][4 * g] + ot[dt][4 * g + 1] * ot[dt][4 * g + 1]) + (ot[dt][4 * g + 2] * ot[dt][4 * g + 2] + ot[dt][4 * g + 3] * ot[dt][4 * g + 3]);
                *(uint2*)(mixo + (size_t)(t0 + r) * D + h * HD + 32 * dt + 8 * g + 4 * hh) = o;
            }
        oss += __shfl_xor(oss, 32);
        if (hh == 0) ssb[(size_t)(t0 + r) * NH + h] = oss;
    }
}

constexpr int RG_LDS_CST = 0, RG_LDS_HIN = 16384, RG_LDS_P = 18432, RG_LDS_SSQ = 20480;
constexpr int RG_LDS_X = 22528, RG_XP = 1032, RG_LDS_O = 91904;
typedef unsigned u32x2 __attribute__((ext_vector_type(2)));
typedef __attribute__((address_space(3))) float lds_f;
typedef __attribute__((address_space(3))) unsigned char lds_b;
template <int CTRL, int ROWMASK>
__device__ __forceinline__ float dpp_mov(float oob, float x) {
    return __builtin_bit_cast(float, __builtin_amdgcn_update_dpp(__builtin_bit_cast(int, oob), __builtin_bit_cast(int, x), CTRL, ROWMASK, 0xf, false));
}
template <int CTRL, int ROWMASK>
__device__ __forceinline__ void scan_step(float (&av)[16], float (&bv)[16]) {
#pragma unroll
    for (int i = 0; i < 16; ++i) {
        const float ap = dpp_mov<CTRL, ROWMASK>(1.0f, av[i]), bp = dpp_mov<CTRL, ROWMASK>(0.0f, bv[i]);
        bv[i] = __builtin_fmaf(av[i], bp, bv[i]); av[i] *= ap;
    }
}
template <int PASS>
__device__ __forceinline__ void ph_rg(const Params& p, unsigned char* lds_raw) {
    float* lds = (float*)lds_raw;
    unsigned char* ws = p.ws;
    const bf16_t* xrg = (const bf16_t*)(ws + WS_XRG); const bf16_t* gg = (const bf16_t*)(ws + WS_GG); const bf16_t* wfrag = (const bf16_t*)(ws + WS_RGW);
    bf16_t* mix = (bf16_t*)(ws + WS_MIX);
    float* rgP = (float*)(ws + WS_RGP); float* rgH = (float*)(ws + WS_RGH);
    bf16_t* scA = (bf16_t*)(ws + WS_RGSA); bf16_t* scB = (bf16_t*)(ws + WS_RGSB);
    const int tid = phase_tid(), lane = tid & 63, r = lane & 31, hh = lane >> 5, n = __builtin_amdgcn_readfirstlane(tid >> 6);
    __syncthreads();
    if (PASS == 0) for (int e = tid; e < 8 * 2 * 8 * 32; e += NTHR) {
        const int q = e & 31, k = (e >> 5) & 7, h2 = (e >> 8) & 1, nn = e >> 9;
        const int c = 64 * nn + 32 * (q >> 4) + (q & 3) + 8 * ((q >> 2) & 3) + 4 * h2;
        float v;
        if (k < 4) v = p.in[I_CONV_W][k * DRG + c];
        else if (k == 4) v = p.in[I_CONV_B][c];
        else if (k == 5) v = p.in[I_RG_B_A][c];
        else if (k == 6) v = p.in[I_RG_B_X][c];
        else v = 8.0f * LOG2E * log1pf(__expf(-p.in[I_RG_LAMBDA][c]));
        lds[e] = v;
    }
    const unsigned lds0 = (unsigned)(size_t)((lds_b*)lds_raw);
    const unsigned cst_base = lds0 + (unsigned)((n * 2 + hh) * 1024);
    lds_f* hin_l = (lds_f*)(size_t)(lds0 + RG_LDS_HIN + (n * 2 + hh) * 128);
    lds_f* pc_l = (lds_f*)(size_t)(lds0 + RG_LDS_P + (n * 2 + hh) * 128);
    lds_b* xt = (lds_b*)(size_t)(lds0 + RG_LDS_X);
    lds_b* ot = (lds_b*)(size_t)(lds0 + RG_LDS_O);
    f32x16 zero16;
#pragma unroll
    for (int i = 0; i < 16; ++i) zero16[i] = 0.f;
    for (int ch = blockIdx.x; ch < NCHUNK; ch += gridDim.x) {
        const int t0 = ch * CHUNK;
        constexpr int NXS = ((CHUNK + 3) * 64 + NTHR - 1) / NTHR;
        u32x4 xs[PASS == 0 ? NXS : 1];
        if (PASS == 0) {
#pragma unroll
            for (int j = 0; j < NXS; ++j) {
                const int ci = tid + NTHR * j, row = ci >> 6, c16 = ci & 63, tt = t0 - 3 + row;
                xs[j] = (u32x4){0u, 0u, 0u, 0u};
                if (ci < (CHUNK + 3) * 64 && tt >= 0) xs[j] = *(const u32x4*)(xrg + (size_t)tt * DRG + 8 * c16);
            }
            __builtin_amdgcn_sched_barrier(0);
        }
        __syncthreads();
        if (PASS == 0) {
#pragma unroll
            for (int j = 0; j < NXS; ++j) {
                const int ci = tid + NTHR * j, row = ci >> 6, c16 = ci & 63;
                if (ci < (CHUNK + 3) * 64) {
                    __attribute__((address_space(3))) u32x2* d = (__attribute__((address_space(3))) u32x2*)(xt + row * RG_XP + 16 * c16);
                    d[0] = (u32x2){xs[j].x, xs[j].y}; d[1] = (u32x2){xs[j].z, xs[j].w};
                }
            }
        }
        if (PASS == 1) {
            const int c = 64 * n + lane;
            float h = 0.f;
            int k = 0;
            for (; k + 32 <= ch; k += 32) {
                float pv[32], hv[32];
#pragma unroll
                for (int j = 0; j < 32; ++j) { pv[j] = rgP[(k + j) * DRG + c]; hv[j] = rgH[(k + j) * DRG + c]; }
#pragma unroll
                for (int j = 0; j < 32; ++j) h = pv[j] * h + hv[j];
            }
            for (; k + 8 <= ch; k += 8) {
                float pv[8], hv[8];
#pragma unroll
                for (int j = 0; j < 8; ++j) { pv[j] = rgP[(k + j) * DRG + c]; hv[j] = rgH[(k + j) * DRG + c]; }
#pragma unroll
                for (int j = 0; j < 8; ++j) h = pv[j] * h + hv[j];
            }
            for (; k < ch; ++k) h = rgP[k * DRG + c] * h + rgH[k * DRG + c];
            lds[RG_LDS_HIN / 4 + (n * 2 + ((lane >> 2) & 1)) * 32 + 16 * (lane >> 5) + 4 * ((lane >> 3) & 3) + (lane & 3)] = h;
        } else {
            if (r == 0) {
#pragma unroll
                for (int q = 0; q < 32; ++q) { hin_l[q] = 0.f; pc_l[q] = 1.f; }
            }
        }
        __syncthreads();
#pragma unroll 1
        for (int tl = 0; tl < 2; ++tl) {
            const int tok = t0 + 32 * tl + r;
            unsigned cst_a = cst_base; asm volatile("" : "+v"(cst_a));
            const lds_f* cst = (const lds_f*)(size_t)cst_a;
            float xcv[32]; bf16x8 bx[4];
            if (PASS == 0) {
#pragma unroll
            for (int q = 0; q < 32; ++q) xcv[q] = cst[4 * 32 + q];
#pragma unroll
            for (int k = 0; k < 4; ++k) {
                const lds_b* xr = xt + (32 * tl + r + k) * RG_XP + (64 * n + 4 * hh) * 2;
#pragma unroll
                for (int m = 0; m < 8; ++m) {
                    const u32x2 xw = *(const __attribute__((address_space(3))) u32x2*)(xr + 16 * m);
                    xcv[4 * m + 0] += cst[k * 32 + 4 * m + 0] * bf2f(xw.x & 0xffffu); xcv[4 * m + 1] += cst[k * 32 + 4 * m + 1] * bf2f(xw.x >> 16);
                    xcv[4 * m + 2] += cst[k * 32 + 4 * m + 2] * bf2f(xw.y & 0xffffu); xcv[4 * m + 3] += cst[k * 32 + 4 * m + 3] * bf2f(xw.y >> 16);
                }
                __builtin_amdgcn_sched_barrier(0);
            }
#pragma unroll
            for (int s = 0; s < 4; ++s) {
                u32x4 pk; pk.x = cvtpk(xcv[8 * s], xcv[8 * s + 1]); pk.y = cvtpk(xcv[8 * s + 2], xcv[8 * s + 3]); pk.z = cvtpk(xcv[8 * s + 4], xcv[8 * s + 5]); pk.w = cvtpk(xcv[8 * s + 6], xcv[8 * s + 7]);
                bx[s] = __builtin_bit_cast(bf16x8, pk);
            }
            }
            float ss = 0.f;
            const bf16_t* wb = wfrag + ((size_t)n * 16 * 64 + lane) * 8; asm volatile("" : "+v"(wb));
#pragma unroll
            for (int jt = 0; jt < 2; ++jt) {
                float av[16], bv[16];
                const size_t sco = ((((size_t)(2 * ch + tl) * 8 + n) * 2 + jt) * 64 + lane) * 16;
                if (PASS == 0) {
#pragma unroll
                for (int g = 0; g < 2; ++g) {
                    f32x16 acc = zero16;
#pragma unroll
                    for (int s = 0; s < 4; ++s) {
                        const bf16x8 aw = *(const __attribute__((address_space(1))) bf16x8*)(wb + (((g * 2 + jt) * 4 + s) * 64) * 8);
                        acc = MFMA32(aw, bx[s], acc);
                    }
#pragma unroll
                    for (int i = 0; i < 16; ++i) {
                        const int q = 16 * jt + i;
                        const float pre = acc[i] + cst[(5 + g) * 32 + q];
                        const float sg = 1.0f / (1.0f + __builtin_amdgcn_exp2f(-LOG2E * pre));
                        if (g == 0) av[i] = __builtin_amdgcn_exp2f(-sg * cst[7 * 32 + q]);
                        else bv[i] = __builtin_amdgcn_sqrtf(fmaxf(__builtin_fmaf(-av[i], av[i], 1.0f), 0.f)) * (sg * xcv[q]);
                    }
                    __builtin_amdgcn_sched_barrier(0);
                }
                scan_step<0x111, 0xf>(av, bv); scan_step<0x112, 0xf>(av, bv); scan_step<0x114, 0xf>(av, bv); scan_step<0x118, 0xf>(av, bv);
                scan_step<0x142, 0xa>(av, bv);
                u32x4 sa0, sa1, sb0, sb1;
                sa0.x = cvtpk(av[0], av[1]); sa0.y = cvtpk(av[2], av[3]); sa0.z = cvtpk(av[4], av[5]); sa0.w = cvtpk(av[6], av[7]); sa1.x = cvtpk(av[8], av[9]); sa1.y = cvtpk(av[10], av[11]); sa1.z = cvtpk(av[12], av[13]); sa1.w = cvtpk(av[14], av[15]);
                sb0.x = cvtpk(bv[0], bv[1]); sb0.y = cvtpk(bv[2], bv[3]); sb0.z = cvtpk(bv[4], bv[5]); sb0.w = cvtpk(bv[6], bv[7]); sb1.x = cvtpk(bv[8], bv[9]); sb1.y = cvtpk(bv[10], bv[11]); sb1.z = cvtpk(bv[12], bv[13]); sb1.w = cvtpk(bv[14], bv[15]);
                *(u32x4*)(scA + sco) = sa0; *(u32x4*)(scA + sco + 8) = sa1; *(u32x4*)(scB + sco) = sb0; *(u32x4*)(scB + sco + 8) = sb1;
                } else {
                    const u32x4 sa0 = *(const u32x4*)(scA + sco), sa1 = *(const u32x4*)(scA + sco + 8), sb0 = *(const u32x4*)(scB + sco), sb1 = *(const u32x4*)(scB + sco + 8);
                    const unsigned wa[8] = {sa0.x, sa0.y, sa0.z, sa0.w, sa1.x, sa1.y, sa1.z, sa1.w}, wbb[8] = {sb0.x, sb0.y, sb0.z, sb0.w, sb1.x, sb1.y, sb1.z, sb1.w};
#pragma unroll
                    for (int k = 0; k < 8; ++k) { av[2 * k] = bf2f(wa[k] & 0xffffu); av[2 * k + 1] = bf2f(wa[k] >> 16); bv[2 * k] = bf2f(wbb[k] & 0xffffu); bv[2 * k + 1] = bf2f(wbb[k] >> 16); }
                }
                __builtin_amdgcn_sched_barrier(0);
#pragma unroll
                for (int i = 0; i < 16; ++i) {
                    const int q = 16 * jt + i;
                    const float h = __builtin_fmaf(av[i], hin_l[q], bv[i]);
                    if (r == 31) { hin_l[q] = h; if (PASS == 0) pc_l[q] *= av[i]; }
                    bv[i] = h;
                }
                if (PASS == 1) {
#pragma unroll
                    for (int g4 = 0; g4 < 4; ++g4) {
                        const int m = 4 * jt + g4;
                        const uint2 gw = *(const uint2*)(gg + ((((size_t)(tok >> 5) * 8 + n) * 8 + m) * 64 + lane) * 4);
                        const float o0 = bv[4 * g4] * bf2f(gw.x & 0xffffu), o1 = bv[4 * g4 + 1] * bf2f(gw.x >> 16), o2 = bv[4 * g4 + 2] * bf2f(gw.y & 0xffffu), o3 = bv[4 * g4 + 3] * bf2f(gw.y >> 16);
                        ss += (o0 * o0 + o1 * o1) + (o2 * o2 + o3 * o3);
                        *(__attribute__((address_space(3))) u32x2*)(ot + (32 * tl + r) * RG_XP + (64 * n + 8 * m + 4 * hh) * 2) = (u32x2){cvtpk(o0, o1), cvtpk(o2, o3)};
                    }
                }
                __builtin_amdgcn_sched_barrier(0);
            }
            if (PASS == 1) { ss += __shfl_xor(ss, 32); if (hh == 0) lds[RG_LDS_SSQ / 4 + (tl * 8 + n) * 32 + r] = ss; }
        }
        if (PASS == 0) {
            if (r == 0) {
#pragma unroll
                for (int m = 0; m < 8; ++m) {
                    const int c = 64 * n + 8 * m + 4 * hh;
                    *(f32x4*)(rgP + (size_t)ch * DRG + c) = (f32x4){pc_l[4 * m], pc_l[4 * m + 1], pc_l[4 * m + 2], pc_l[4 * m + 3]};
                    *(f32x4*)(rgH + (size_t)ch * DRG + c) = (f32x4){hin_l[4 * m], hin_l[4 * m + 1], hin_l[4 * m + 2], hin_l[4 * m + 3]};
                }
            }
        } else {
            __syncthreads();
            for (int j = 0; j < 8; ++j) {
                const int tr = 8 * n + j, tok = t0 + tr;
                float tot = 0.f;
#pragma unroll
                for (int w = 0; w < 8; ++w) tot += lds[RG_LDS_SSQ / 4 + ((tr >> 5) * 8 + w) * 32 + (tr & 31)];
                const float rn = rsqrtf(tot * (1.0f / DRG) + EPS);
                const __attribute__((address_space(3))) u32x2* op = (const __attribute__((address_space(3))) u32x2*)(ot + tr * RG_XP + 16 * lane);
                const u32x2 w0 = op[0], w1 = op[1];
                u32x4 o2; o2.x = cvtpk(bf2f(w0.x & 0xffffu) * rn, bf2f(w0.x >> 16) * rn); o2.y = cvtpk(bf2f(w0.y & 0xffffu) * rn, bf2f(w0.y >> 16) * rn);
                o2.z = cvtpk(bf2f(w1.x & 0xffffu) * rn, bf2f(w1.x >> 16) * rn); o2.w = cvtpk(bf2f(w1.y & 0xffffu) * rn, bf2f(w1.y >> 16) * rn);
                *((u32x4*)(mix + (size_t)tok * D + DSB) + lane) = o2;
            }
            if (tid < CHUNK) {
                const f32x4 s0 = *(const f32x4*)(ws + WS_SSB + (size_t)(t0 + tid) * NH * 4), s1 = *(const f32x4*)(ws + WS_SSB + (size_t)(t0 + tid) * NH * 4 + 16);
                ((float*)(ws + WS_RSB))[t0 + tid] = rsqrtf(((s0.x + s0.y) + (s0.z + s0.w) + (s1.x + s1.y) + (s1.z + s1.w)) * (1.0f / DSB) + EPS);
            }
        }
    }
}

__device__ __forceinline__ float kmax(float a, float b) { float r; asm("v_max_f32 %0, %1, %2" : "=v"(r) : "v"(a), "v"(b)); return r; }
__device__ __forceinline__ float kmin(float a, float b) { float r; asm("v_min_f32 %0, %1, %2" : "=v"(r) : "v"(a), "v"(b)); return r; }
__device__ __forceinline__ float key_tag(float f, unsigned keep, unsigned tag) { return __builtin_bit_cast(float, (__builtin_bit_cast(unsigned, f) & keep) | tag); }
#define TOPK_CE(a, b) do { const float hi_ = kmax(a, b), lo_ = kmin(a, b); a = hi_; b = lo_; } while (0)
__device__ __forceinline__ void sort16_desc(float (&v)[16]) { TOPK_CE(v[0], v[1]); TOPK_CE(v[2], v[3]); TOPK_CE(v[0], v[2]); TOPK_CE(v[1], v[3]); TOPK_CE(v[1], v[2]); TOPK_CE(v[4], v[5]); TOPK_CE(v[6], v[7]); TOPK_CE(v[4], v[6]); TOPK_CE(v[5], v[7]); TOPK_CE(v[5], v[6]); TOPK_CE(v[0], v[4]); TOPK_CE(v[2], v[6]); TOPK_CE(v[2], v[4]); TOPK_CE(v[1], v[5]); TOPK_CE(v[3], v[7]); TOPK_CE(v[3], v[5]); TOPK_CE(v[1], v[2]); TOPK_CE(v[3], v[4]); TOPK_CE(v[5], v[6]); TOPK_CE(v[8], v[9]); TOPK_CE(v[10], v[11]); TOPK_CE(v[8], v[10]); TOPK_CE(v[9], v[11]); TOPK_CE(v[9], v[10]); TOPK_CE(v[12], v[13]); TOPK_CE(v[14], v[15]); TOPK_CE(v[12], v[14]); TOPK_CE(v[13], v[15]); TOPK_CE(v[13], v[14]); TOPK_CE(v[8], v[12]); TOPK_CE(v[10], v[14]); TOPK_CE(v[10], v[12]); TOPK_CE(v[9], v[13]); TOPK_CE(v[11], v[15]); TOPK_CE(v[11], v[13]); TOPK_CE(v[9], v[10]); TOPK_CE(v[11], v[12]); TOPK_CE(v[13], v[14]); TOPK_CE(v[0], v[8]); TOPK_CE(v[4], v[12]); TOPK_CE(v[4], v[8]); TOPK_CE(v[2], v[10]); TOPK_CE(v[6], v[14]); TOPK_CE(v[6], v[10]); TOPK_CE(v[2], v[4]); TOPK_CE(v[6], v[8]); TOPK_CE(v[10], v[12]); TOPK_CE(v[1], v[9]); TOPK_CE(v[5], v[13]); TOPK_CE(v[5], v[9]); TOPK_CE(v[3], v[11]); TOPK_CE(v[7], v[15]); TOPK_CE(v[7], v[11]); TOPK_CE(v[3], v[5]); TOPK_CE(v[7], v[9]); TOPK_CE(v[11], v[13]); TOPK_CE(v[1], v[2]); TOPK_CE(v[3], v[4]); TOPK_CE(v[5], v[6]); TOPK_CE(v[7], v[8]); TOPK_CE(v[9], v[10]); TOPK_CE(v[11], v[12]); TOPK_CE(v[13], v[14]); }
__device__ __forceinline__ void merge16_desc(float (&a)[16], const float (&b)[16]) {
#pragma unroll
    for (int i = 0; i < 16; ++i) a[i] = kmax(a[i], b[15 - i]);
#pragma unroll
    for (int d = 8; d >= 1; d >>= 1)
#pragma unroll
        for (int i = 0; i < 16; ++i) if ((i & d) == 0) TOPK_CE(a[i], a[i + d]);
}
__device__ __forceinline__ void ph_topk(const Params& p, int* lds) {
    unsigned char* ws = p.ws;
    const bf16_t* qp = (const bf16_t*)(ws + WS_B); const bf16_t* subk = (const bf16_t*)(ws + WS_SUBK);
    int* seli = (int*)(ws + WS_SELI); float* selg = (float*)(ws + WS_SELG);
    const float* ssq = (const float*)(ws + WS_SSQ); float* rstd2 = (float*)(ws + WS_RSTD2);
    const int tid = phase_tid(), lane = tid & 63, r = lane & 31, hh = lane >> 5, hx = 4 * hh;
    const int gwave = (blockIdx.x * blockDim.x + tid) >> 6, nwave = (gridDim.x * blockDim.x) >> 6;
    constexpr int SK_OFF = 65536, SK_PITCH = 272;
    typedef __attribute__((address_space(3))) unsigned char lds_b;
    lds_b* skl = (lds_b*)lds + SK_OFF;
    const int w = tid >> 6;
    pg8::StaticOrder so; so.init(S, NQ, (int)gridDim.x, (int)blockIdx.x);
    pg8::Unit gu;
    for (int ui = 0; so.next(ui, gu); ++ui) {
        const int h = gu.pn, t0 = gu.pm * 256 + 32 * w, t = t0 + r;
        u32x4 skv[8]; bf16x8 bq[2][8];
#pragma unroll
        for (int j = 0; j < 8; ++j) {
            const int ci = tid + NTHR * j, row = ci >> 4, c16 = ci & 15;
            skv[j] = *(const u32x4*)(subk + ((size_t)h * 256 + row) * PHALF + 8 * c16);
        }
#pragma unroll
        for (int pp = 0; pp < 2; ++pp)
#pragma unroll
            for (int s = 0; s < 8; ++s) bq[pp][s] = *(const bf16x8*)(qp + ((((size_t)((t0 >> 5) * 8 + h) * 2 + pp) * 8 + s) * 64 + lane) * 8);
        __builtin_amdgcn_sched_barrier(0);
        __syncthreads();
#pragma unroll
        for (int j = 0; j < 8; ++j) {
            const int ci = tid + NTHR * j, row = ci >> 4, c16 = ci & 15;
            *(__attribute__((address_space(3))) u32x4*)(skl + row * SK_PITCH + 16 * c16) = skv[j];
        }
        __syncthreads();
        float tk[2][16];
#pragma unroll
        for (int pp = 0; pp < 2; ++pp) {
            f32x16 acc[4];
#pragma unroll
            for (int T = 0; T < 4; ++T)
#pragma unroll
                for (int i = 0; i < 16; ++i) acc[T][i] = 0.f;
            const lds_b* krow = skl + (pp * PNK + r) * SK_PITCH + 16 * hh;
#pragma unroll
            for (int s = 0; s < 8; ++s) {
                const bf16x8 b = bq[pp][s];
#pragma unroll
                for (int T = 0; T < 4; ++T) {
                    const bf16x8 a = *(const __attribute__((address_space(3))) bf16x8*)(krow + (32 * T) * SK_PITCH + 32 * s);
                    acc[T] = __builtin_amdgcn_mfma_f32_32x32x16_bf16(a, b, acc[T], 0, 0, 0);
                }
            }
            float kq[4][16];
#pragma unroll
            for (int T = 0; T < 4; ++T) {
#pragma unroll
                for (int i = 0; i < 16; ++i) {
                    const int nb = 32 * T + (i & 3) + 8 * (i >> 2);
                    kq[T][i] = key_tag(acc[T][i], ~127u, (unsigned)(127 - nb));
                }
                sort16_desc(kq[T]);
            }
            merge16_desc(kq[0], kq[1]); merge16_desc(kq[2], kq[3]); merge16_desc(kq[0], kq[2]);
            float m[16], po[16];
#pragma unroll
            for (int i = 0; i < 16; ++i) { m[i] = __builtin_bit_cast(float, __builtin_bit_cast(int, kq[0][i]) ^ hx); po[i] = __shfl_xor(m[i], 32); }
            merge16_desc(m, po);
#pragma unroll
            for (int i = 0; i < 16; ++i) tk[pp][i] = m[i];
        }
#pragma unroll
        for (int i = 0; i < 16; ++i) { lds[i * NTHR + tid] = __builtin_bit_cast(int, tk[0][i]); lds[(16 + i) * NTHR + tid] = __builtin_bit_cast(int, tk[1][i]); }
        const float (&v0)[16] = tk[0]; const float (&v1)[16] = tk[1];
#define CKEY(a, b) key_tag(v0[a] + v1[b], ~255u, (unsigned)(255 - ((a) * 16 + (b))))
        const float NEGK = __builtin_bit_cast(float, 0xff800000u);
        float bk[16], l1[16], ga[16], gb[16];
#pragma unroll
        for (int b = 0; b < 16; ++b) bk[b] = CKEY(0, b);
#pragma unroll
        for (int b = 0; b < 16; ++b) l1[b] = b < 8 ? CKEY(1, b) : NEGK;
        ga[0] = CKEY(2, 0); ga[1] = CKEY(2, 1); ga[2] = CKEY(2, 2); ga[3] = CKEY(2, 3); ga[4] = CKEY(2, 4);
        ga[5] = CKEY(3, 0); ga[6] = CKEY(3, 1); ga[7] = CKEY(3, 2); ga[8] = CKEY(3, 3);
        ga[9] = CKEY(4, 0); ga[10] = CKEY(4, 1); ga[11] = CKEY(4, 2); ga[12] = CKEY(5, 0); ga[13] = CKEY(5, 1); ga[14] = NEGK; ga[15] = NEGK;
        gb[0] = CKEY(6, 0); gb[1] = CKEY(6, 1); gb[2] = CKEY(7, 0); gb[3] = CKEY(7, 1);
#pragma unroll
        for (int a = 8; a < 16; ++a) gb[a - 4] = CKEY(a, 0);
        gb[12] = NEGK; gb[13] = NEGK; gb[14] = NEGK; gb[15] = NEGK;
#undef CKEY
        sort16_desc(ga); sort16_desc(gb);
        merge16_desc(bk, l1); merge16_desc(ga, gb); merge16_desc(bk, ga);
        float ssum = 0.f;
#pragma unroll
        for (int i = 0; i < 4; ++i) { const f32x4 q4 = *(const f32x4*)(ssq + (size_t)t * 16 + 4 * i); ssum += (q4.x + q4.y) + (q4.z + q4.w); }
        const float rs = rsqrtf(ssum * (1.0f / D) + EPS);
        float e[16], sum = 0.f; const float mx = bk[0];
#pragma unroll
        for (int i = 0; i < 16; ++i) { e[i] = __expf((bk[i] - mx) * rs); sum += e[i]; }
        const float inv = 1.0f / sum;
        int eidx[16];
#pragma unroll
        for (int i = 0; i < 16; ++i) {
            const int code = 255 - (__builtin_bit_cast(int, bk[i]) & 255), a = code >> 4, b = code & 15;
            const int i1 = 127 - (lds[a * NTHR + tid] & 127), i2 = 127 - (lds[(16 + b) * NTHR + tid] & 127);
            eidx[i] = i1 * PNK + i2; e[i] *= inv;
        }
        if (hh == 0) {
            int4* o = (int4*)(seli + (size_t)t * 128 + h * 16);
#pragma unroll
            for (int i = 0; i < 4; ++i) o[i] = make_int4(eidx[4 * i], eidx[4 * i + 1], eidx[4 * i + 2], eidx[4 * i + 3]);
            if (h == 0) rstd2[t] = rs;
        } else {
            f32x4* o = (f32x4*)(selg + (size_t)t * 128 + h * 16);
#pragma unroll
            for (int i = 0; i < 4; ++i) o[i] = (f32x4){e[4 * i], e[4 * i + 1], e[4 * i + 2], e[4 * i + 3]};
        }
    }
}

typedef __bf16 bf16x2_t __attribute__((ext_vector_type(2)));
typedef float f32x2 __attribute__((ext_vector_type(2)));
template <int NV, int XS0, int XS1, int XS2>
__device__ __forceinline__ void reduce_over8(float (&v)[NV], int sel) {
    { const bool up = sel & 1;
#pragma unroll
      for (int i = 0; i < NV / 2; ++i) { const float a = v[2 * i], b = v[2 * i + 1]; v[i] = (up ? b : a) + __shfl_xor(up ? a : b, XS0); } }
    { const bool up = (sel >> 1) & 1;
#pragma unroll
      for (int i = 0; i < NV / 4; ++i) { const float a = v[2 * i], b = v[2 * i + 1]; v[i] = (up ? b : a) + __shfl_xor(up ? a : b, XS1); } }
    { const bool up = (sel >> 2) & 1;
#pragma unroll
      for (int i = 0; i < NV / 8; ++i) { const float a = v[2 * i], b = v[2 * i + 1]; v[i] = (up ? b : a) + __shfl_xor(up ? a : b, XS2); } }
}
__device__ __forceinline__ void peer_load_idx(const unsigned char* ws, int t, int rsl, int (&ei)[16]) {
    const unsigned off = (unsigned)WS_SELI + ((unsigned)t * 128u + 16u * (unsigned)rsl) * 4u;
#pragma unroll
    for (int j = 0; j < 4; ++j) { const int4 v = *(const int4*)(ws + (off + 16u * j)); ei[4 * j] = v.x; ei[4 * j + 1] = v.y; ei[4 * j + 2] = v.z; ei[4 * j + 3] = v.w; }
}
template <int PASS>
__device__ __forceinline__ void peer_load_rows(const unsigned char* ws, int t, int sl, int rsl, int c, const int (&ei)[16], u32x4 (&row)[16], u32x4 (&aux)[4]) {
    const unsigned tab = (unsigned)(PASS == 0 ? WS_UB : WS_VB) + (unsigned)sl * (unsigned)(NEXP * 128) + 16u * (unsigned)c;
#pragma unroll
    for (int i = 0; i < 16; ++i) row[i] = *(const u32x4*)(ws + (tab + (unsigned)ei[i] * 128u));
    const unsigned xo = (unsigned)WS_X1Q + (unsigned)t * (unsigned)D + 256u * sl + 32u * c;
    aux[0] = *(const u32x4*)(ws + xo); aux[1] = *(const u32x4*)(ws + (xo + 16u));
    aux[2].x = *(const unsigned*)(ws + ((unsigned)WS_XSC + ((unsigned)t * 32u + 8u * sl + c) * 4u));
}
constexpr int PEER_IMG_PITCH = 136, PEER_IMG_BYTES = 128 * PEER_IMG_PITCH;
template <int PASS  >
__device__ __forceinline__ void peer_compute(const Params& p, unsigned char* lds, int lane_w, int t, int sl, int rsl, int c, const u32x4 (&row)[16], const u32x4 (&aux)[4]) {
    unsigned char* ws = p.ws;
    if (PASS == 0) {
        const u32x4 x0 = aux[0], x1_ = aux[1]; const unsigned xl[4] = {x0.x, x0.y, x0.z, x0.w}, xh[4] = {x1_.x, x1_.y, x1_.z, x1_.w};
        const unsigned xsu = aux[2].x; const float xs = u2f(xsu);
        float pd[16];
#pragma unroll
        for (int i = 0; i < 16; ++i) {
            const u32x4 rw = row[i]; const unsigned w4[4] = {rw.x, rw.y, rw.z, rw.w};
            int al = 0, ah = 0;
#pragma unroll
            for (int j = 0; j < 4; ++j) { al = __builtin_amdgcn_sdot8((int)w4[j], (int)xl[j], al, false); ah = __builtin_amdgcn_sdot8((int)w4[j], (int)xh[j], ah, false); }
            pd[i] = (float)(16 * ah + al) * xs;
        }
        reduce_over8<16, 1, 2, 4>(pd, c);
        const unsigned po = (unsigned)WS_PD + (((unsigned)sl * S + (unsigned)t) * 128u + 16u * rsl + c) * 4u;
        *(float*)(ws + po) = pd[0]; *(float*)(ws + (po + 32u)) = pd[1];
    }
}
template <int PASS>
__device__ __forceinline__ void peer_stream(const Params& p, unsigned char* lds, int lane_w, int sl, int t0, int dt, int n) {
    const unsigned char* ws = p.ws;
    const int lane = lane_w & 63, rsl = lane >> 3, c = lane & 7;
    int eiA[16], eiB[16]; u32x4 rowA[16], rowB[16], auxA[4], auxB[4];
    if (n <= 0) return;
    peer_load_idx(ws, t0, rsl, eiA);
    peer_load_rows<PASS>(ws, t0, sl, rsl, c, eiA, rowA, auxA);
    if (n > 1) peer_load_idx(ws, t0 + dt, rsl, eiB);
    for (int i = 0; i < n; i += 2) {
        const int t = t0 + i * dt;
        if (i + 1 < n) peer_load_rows<PASS>(ws, t + dt, sl, rsl, c, eiB, rowB, auxB);
        if (i + 2 < n) peer_load_idx(ws, t + 2 * dt, rsl, eiA);
        peer_compute<PASS>(p, lds, lane_w, t, sl, rsl, c, rowA, auxA);
        if (i + 1 < n) {
            if (i + 2 < n) peer_load_rows<PASS>(ws, t + 2 * dt, sl, rsl, c, eiA, rowA, auxA);
            if (i + 3 < n) peer_load_idx(ws, t + 3 * dt, rsl, eiB);
            peer_compute<PASS>(p, lds, lane_w, t + dt, sl, rsl, c, rowB, auxB);
        }
    }
}
__device__ __forceinline__ void peerv_load_idx(const unsigned char* ws, int t, int hf, int rsl, int (&ei)[8]) {
    const unsigned off = (unsigned)WS_SELI + ((unsigned)t * 128u + 16u * (unsigned)rsl + 8u * (unsigned)hf) * 4u;
    const int4 v0 = *(const int4*)(ws + off), v1 = *(const int4*)(ws + (off + 16u));
    ei[0] = v0.x; ei[1] = v0.y; ei[2] = v0.z; ei[3] = v0.w; ei[4] = v1.x; ei[5] = v1.y; ei[6] = v1.z; ei[7] = v1.w;
}
__device__ __forceinline__ void peerv_load_rows(const unsigned char* ws, int sl, int c, const int (&ei)[8], u32x4 (&row)[8]) {
    const unsigned tab = (unsigned)WS_VB + (unsigned)sl * (unsigned)(NEXP * 128) + 16u * (unsigned)c;
#pragma unroll
    for (int i = 0; i < 8; ++i) row[i] = *(const u32x4*)(ws + (tab + (unsigned)ei[i] * 128u));
}
struct PeerVAux { u32x4 cp; unsigned cs; unsigned xo[4]; };
__device__ __forceinline__ void peerv_load_aux(const unsigned char* ws, int t, int sl, int lane, PeerVAux& a) {
    a.cp = *(const u32x4*)(ws + ((unsigned)WS_CBUF + (unsigned)t * 128u + 16u * (unsigned)(lane & 7)));
    a.cs = *(const unsigned*)(ws + ((unsigned)WS_CSC + (unsigned)t * 4u));
    const unsigned xo = (unsigned)WS_A + ((unsigned)t * (unsigned)D + 256u * sl + (unsigned)lane) * 2u;
    a.xo[0] = *(const bf16_t*)(ws + xo); a.xo[1] = *(const bf16_t*)(ws + (xo + 128u)); a.xo[2] = *(const bf16_t*)(ws + (xo + 256u)); a.xo[3] = *(const bf16_t*)(ws + (xo + 384u));
}
template <int HF>
__device__ __forceinline__ void peerv_half(lds_b* img, int lane, const u32x4 (&row)[8], const PeerVAux& a, int (&acc)[4]) {
    const int rsl = lane >> 3, c = lane & 7;
#pragma unroll
    for (int i = 0; i < 8; ++i) {
        const u32x4 rw = row[i];
        __attribute__((address_space(3))) u32x2* d = (__attribute__((address_space(3))) u32x2*)(img + (16 * rsl + i) * PEER_IMG_PITCH + 16 * c);
        d[0] = (u32x2){rw.x, rw.y}; d[1] = (u32x2){rw.z, rw.w};
    }
    const unsigned cpl = HF == 0 ? a.cp.x : a.cp.y, cph = HF == 0 ? a.cp.z : a.cp.w;
    asm volatile("s_waitcnt lgkmcnt(0)" ::: "memory");
    const unsigned ra = (unsigned)(size_t)img + (unsigned)((lane & 15) * PEER_IMG_PITCH + 8 * (lane >> 4));
#define PEER_TR4(R0, R1, R2, R3, RS) asm volatile("ds_read_b64_tr_b4 %0, %4 offset:%5\n\tds_read_b64_tr_b4 %1, %4 offset:%6\n\tds_read_b64_tr_b4 %2, %4 offset:%7\n\tds_read_b64_tr_b4 %3, %4 offset:%8" \
            : "=&v"(R0), "=&v"(R1), "=&v"(R2), "=&v"(R3) : "v"(ra), "i"((RS) * 16 * PEER_IMG_PITCH), "i"((RS) * 16 * PEER_IMG_PITCH + 32), "i"((RS) * 16 * PEER_IMG_PITCH + 64), "i"((RS) * 16 * PEER_IMG_PITCH + 96) : "memory")
#define PEER_USE4(R0, R1, R2, R3, RS, WAITSTR) do { \
            asm volatile(WAITSTR : "+v"(R0), "+v"(R1), "+v"(R2), "+v"(R3) :: "memory"); \
            const int cl_ = __builtin_amdgcn_readlane((int)cpl, RS), ch_ = __builtin_amdgcn_readlane((int)cph, RS); \
            const unsigned lo4_[4] = {R0.x, R1.x, R2.x, R3.x}; \
            _Pragma("unroll") for (int tcg = 0; tcg < 4; ++tcg) acc[tcg] += 16 * __builtin_amdgcn_sdot8((int)lo4_[tcg], ch_, 0, false) + __builtin_amdgcn_sdot8((int)lo4_[tcg], cl_, 0, false); } while (0)
    {
        u32x2 a0, a1, a2, a3, b0, b1, b2, b3;
        PEER_TR4(a0, a1, a2, a3, 0);
        PEER_TR4(b0, b1, b2, b3, 1); PEER_USE4(a0, a1, a2, a3, 0, "s_waitcnt lgkmcnt(4)");
        PEER_TR4(a0, a1, a2, a3, 2); PEER_USE4(b0, b1, b2, b3, 1, "s_waitcnt lgkmcnt(4)");
        PEER_TR4(b0, b1, b2, b3, 3); PEER_USE4(a0, a1, a2, a3, 2, "s_waitcnt lgkmcnt(4)");
        PEER_TR4(a0, a1, a2, a3, 4); PEER_USE4(b0, b1, b2, b3, 3, "s_waitcnt lgkmcnt(4)");
        PEER_TR4(b0, b1, b2, b3, 5); PEER_USE4(a0, a1, a2, a3, 4, "s_waitcnt lgkmcnt(4)");
        PEER_TR4(a0, a1, a2, a3, 6); PEER_USE4(b0, b1, b2, b3, 5, "s_waitcnt lgkmcnt(4)");
        PEER_TR4(b0, b1, b2, b3, 7); PEER_USE4(a0, a1, a2, a3, 6, "s_waitcnt lgkmcnt(4)");
        PEER_USE4(b0, b1, b2, b3, 7, "s_waitcnt lgkmcnt(0)");
    }
#undef PEER_TR4
#undef PEER_USE4
}
__device__ __forceinline__ void peerv_stream(const Params& p, unsigned char* lds, int tid_, int sl, int t0, int dt, int n) {
    const unsigned char* ws = p.ws;
    const int lane = tid_ & 63, rsl = lane >> 3, c = lane & 7;
    lds_b* img = (lds_b*)lds + (tid_ >> 6) * PEER_IMG_BYTES;
    for (int e = lane; e < 64 * (PEER_IMG_PITCH / 8); e += 64) {
        const int zr = e / (PEER_IMG_PITCH / 8), zc = e % (PEER_IMG_PITCH / 8);
        *(__attribute__((address_space(3))) u32x2*)(img + (16 * (zr >> 3) + 8 + (zr & 7)) * PEER_IMG_PITCH + 8 * zc) = (u32x2){0u, 0u};
    }
    if (n <= 0) return;
    int ei0[8], ei1[8]; u32x4 rowA[8], rowB[8]; PeerVAux ax, axn;
    peerv_load_idx(ws, t0, 0, rsl, ei0);
    peerv_load_rows(ws, sl, c, ei0, rowA); peerv_load_aux(ws, t0, sl, lane, ax);
    peerv_load_idx(ws, t0, 1, rsl, ei1);
    for (int i = 0; i < n; ++i) {
        const int t = t0 + i * dt; const bool more = i + 1 < n;
        int acc[4] = {0, 0, 0, 0};
        peerv_load_rows(ws, sl, c, ei1, rowB);
        if (more) peerv_load_idx(ws, t + dt, 0, rsl, ei0);
        peerv_half<0>(img, lane, rowA, ax, acc);
        if (more) { peerv_load_rows(ws, sl, c, ei0, rowA); peerv_load_aux(ws, t + dt, sl, lane, axn); peerv_load_idx(ws, t + dt, 1, rsl, ei1); }
        peerv_half<1>(img, lane, rowB, ax, acc);
        const float cs = u2f(ax.cs);
#pragma unroll
        for (int tcg = 0; tcg < 4; ++tcg) {
            const unsigned oo = ((unsigned)t * (unsigned)D + 256u * sl + 64u * tcg + (unsigned)lane) * 4u;
            *(float*)((unsigned char*)p.out + oo) = bf2f(ax.xo[tcg]) + (float)acc[tcg] * cs;
        }
        if (more) ax = axn;
    }
}
template <int PASS>
__device__ __forceinline__ void ph_peer(const Params& p, unsigned char* lds) {
    const int tid_ = phase_tid();
    const int lane = tid_ & 63, w = tid_ >> 6, b = blockIdx.x, G = gridDim.x;
    if ((G & 7) == 0) {
        const int g = b & 7, nsw = (G >> 3) * 2 * (NTHR / 64), t0 = ((g >> 2) * (G >> 3) + (b >> 3)) * (NTHR / 64) + w;
        if (PASS == 0) peer_stream<0>(p, lds, tid_, g & 3, t0, nsw, t0 < S ? (S - 1 - t0) / nsw + 1 : 0);
        else peerv_stream(p, lds, tid_, g & 3, t0, nsw, t0 < S ? (S - 1 - t0) / nsw + 1 : 0);
    } else {
        const int nw = G * (NTHR / 64), it0 = b * (NTHR / 64) + w;
        for (int it = it0; it < S * 4; it += nw) { if (PASS == 0) peer_stream<0>(p, lds, tid_, it & 3, it >> 2, 0, 1); else peerv_stream(p, lds, tid_, it & 3, it >> 2, 0, 1); }
    }
}
__device__ __forceinline__ void ph_peer_combine(const Params& p) {
    unsigned char* ws = p.ws;
    const int* seli = (const int*)(ws + WS_SELI); const float* selg = (const float*)(ws + WS_SELG); const float* rstd2 = (const float*)(ws + WS_RSTD2);
    const float2* uvsc = (const float2*)(ws + WS_USC);
    const float* pd = (const float*)(ws + WS_PD);
    unsigned* cpl = (unsigned*)(ws + WS_CBUF); float* csc = (float*)(ws + WS_CSC);
    const int tid_ = phase_tid(), lane = tid_ & 63, gwave = (blockIdx.x * blockDim.x + tid_) >> 6, nwave = (gridDim.x * blockDim.x) >> 6;
    constexpr int TT = 4;
    for (int tb = gwave; tb < S; tb += TT * nwave) {
        float dsum[TT][2], sg[TT][2], rsd[TT]; int ei[TT][2];
#pragma unroll
        for (int k = 0; k < TT; ++k) {
            const int t = min(tb + k * nwave, S - 1);
#pragma unroll
            for (int hf = 0; hf < 2; ++hf) {
                const int e = t * 128 + 64 * hf + lane;
                ei[k][hf] = seli[e]; sg[k][hf] = selg[e];
                float d = 0.f;
#pragma unroll
                for (int g = 0; g < 4; ++g) d += pd[(size_t)g * S * 128 + e];
                dsum[k][hf] = d;
            }
            rsd[k] = rstd2[t];
        }
        float2 sc2[TT][2];
#pragma unroll
        for (int k = 0; k < TT; ++k)
#pragma unroll
            for (int hf = 0; hf < 2; ++hf) sc2[k][hf] = uvsc[ei[k][hf]];
#pragma unroll
        for (int k = 0; k < TT; ++k) {
            const int t = tb + k * nwave;
            if (t >= S) break;
            float cf[2];
#pragma unroll
            for (int hf = 0; hf < 2; ++hf) cf[hf] = sg[k][hf] * gelu_tanh(dsum[k][hf] * sc2[k][hf].x * rsd[k]) * sc2[k][hf].y;
            float m = fmaxf(fabsf(cf[0]), fabsf(cf[1]));
#pragma unroll
            for (int o = 1; o < 64; o <<= 1) m = fmaxf(m, __shfl_xor(m, o));
            const float inv = m > 0.f ? 119.0f / m : 0.f;
#pragma unroll
            for (int hf = 0; hf < 2; ++hf) {
                const int q = __float2int_rn(cf[hf] * inv);
                unsigned dl = (unsigned)(q & 15) << (4 * (lane & 7)), dh = (unsigned)(((q + 8) >> 4) & 15) << (4 * (lane & 7));
                dl |= __shfl_xor(dl, 1); dh |= __shfl_xor(dh, 1); dl |= __shfl_xor(dl, 2); dh |= __shfl_xor(dh, 2); dl |= __shfl_xor(dl, 4); dh |= __shfl_xor(dh, 4);
                if ((lane & 7) == 0) {
                    const int dk = 8 * hf + (lane >> 3), rs = dk >> 1, half = dk & 1;
                    cpl[(size_t)t * 32 + 4 * rs + half] = dl; cpl[(size_t)t * 32 + 4 * rs + 2 + half] = dh;
                }
            }
            if (lane == 0) csc[t] = m * (1.0f / 119.0f);
        }
    }
}

#define LAS __attribute__((address_space(3)))
#define XB_TMO      128
#define XB_XCNT(j)  (256  + 64 * (j))
#define XB_XSUB(j)  (1280 + 64 * (j))
#define XB_XGEN(j)  (2304 + 64 * (j))
#define XB_TOP      3328
#define XB_TOPGEN   3392
#define XCD_BAR_WORDS 3456
#define XB_SPIN_CAP (1u << 18)
__device__ __forceinline__ unsigned xb_ld(unsigned* p)              { return __hip_atomic_load(p, __ATOMIC_RELAXED, __HIP_MEMORY_SCOPE_AGENT); }
__device__ __forceinline__ unsigned xb_add(unsigned* p, unsigned v) { return __hip_atomic_fetch_add(p, v, __ATOMIC_RELAXED, __HIP_MEMORY_SCOPE_AGENT); }
__device__ __forceinline__ unsigned xb_xcc_id() { return (unsigned)__builtin_amdgcn_s_getreg((3 << 11) | 20) & 0xFu; }
#define XB_SPIN(cond, bar) do { unsigned _sp = 0; while (cond) { __builtin_amdgcn_s_sleep(1); \
    if ((++_sp & 255u) == 0u) { if (xb_ld(&(bar)[XB_TMO])) break; if (_sp > XB_SPIN_CAP) { atomicAdd(&(bar)[XB_TMO], 1u); break; } } } } while (0)
struct XcdBarrier { unsigned* bar; unsigned x; volatile LAS unsigned* st; };
__device__ __forceinline__ XcdBarrier xcd_barrier_post(unsigned* bar, volatile LAS unsigned* st) {
    XcdBarrier b; b.bar = bar; b.x = xb_xcc_id(); b.st = st;
    if (threadIdx.x == 0) (void)xb_add(&bar[XB_XCNT(b.x)], 1u);
    return b;
}
__device__ __forceinline__ void xcd_barrier_complete(unsigned* bar, unsigned x, unsigned& nloc, unsigned& nx) {
    const unsigned G = gridDim.x * gridDim.y * gridDim.z;
    unsigned sum, cnt, mine, sp = 0u;
    for (;;) {
        sum = 0u; cnt = 0u; mine = 0u;
#pragma unroll
        for (unsigned j = 0; j < 16; ++j) { const unsigned c = xb_ld(&bar[XB_XCNT(j)]); sum += c; cnt += (c > 0u) ? 1u : 0u; mine = (j == x) ? c : mine; }
        if (sum == G) break;
        __builtin_amdgcn_s_sleep(1);
        if ((++sp & 255u) == 0u) { if (xb_ld(&bar[XB_TMO])) break; if (sp > XB_SPIN_CAP) { atomicAdd(&bar[XB_TMO], 1u); break; } }
    }
    nloc = mine > 0u ? mine : 1u; nx = cnt > 0u ? cnt : 1u;
}
__device__ __forceinline__ void xcd_barrier(const XcdBarrier& b) {
    asm volatile("s_waitcnt vmcnt(0)" ::: "memory");
    __syncthreads();
    if (threadIdx.x == 0) {
        unsigned* bar = b.bar;
        __builtin_amdgcn_s_waitcnt(0);
        unsigned nloc = b.st[0], nx = b.st[1];
        if (nloc == 0u) { xcd_barrier_complete(bar, b.x, nloc, nx); b.st[0] = nloc; b.st[1] = nx; }
        const unsigned old = xb_add(&bar[XB_XSUB(b.x)], 1u);
        const unsigned gen = old / nloc;
        if (old + 1u == (gen + 1u) * nloc) {
            __builtin_amdgcn_fence(__ATOMIC_RELEASE, "agent");
            asm volatile("s_waitcnt vmcnt(0)" ::: "memory");
            const unsigned og = xb_add(&bar[XB_TOP], 1u);
            const unsigned tg = og / nx;
            if (og + 1u == (tg + 1u) * nx) xb_add(&bar[XB_TOPGEN], 1u);
            else XB_SPIN(xb_ld(&bar[XB_TOPGEN]) == tg, bar);
            __builtin_amdgcn_fence(__ATOMIC_ACQUIRE, "agent");
            xb_add(&bar[XB_XGEN(b.x)], 1u);
            asm volatile("s_waitcnt vmcnt(0)" ::: "memory");
        } else {
            XB_SPIN(xb_ld(&bar[XB_XGEN(b.x)]) == gen, bar);
            __builtin_amdgcn_fence(__ATOMIC_ACQUIRE, "agent");
            asm volatile("s_waitcnt vmcnt(0)" ::: "memory");
        }
    }
    __syncthreads();
}

constexpr int LDS_MISC = 158720;
constexpr int LDS_BYTES = LDS_MISC + 1024;

__global__ void __launch_bounds__(NTHR, 2) hymba_fwd(Params p) {
    extern __shared__ __attribute__((aligned(16))) unsigned char lds[];
    volatile LAS unsigned* misc = (volatile LAS unsigned*)((LAS unsigned char*)lds + LDS_MISC);
    if (threadIdx.x < 4) misc[threadIdx.x] = 0u;
    __syncthreads();
    XcdBarrier bar = xcd_barrier_post((unsigned*)(p.ws + WS_CTL), misc);

    PG8_LAS unsigned char* ring = (PG8_LAS unsigned char*)lds;
    unsigned char* ws = p.ws;
    ph_prep(p, lds);                          xcd_barrier(bar);
    {
        pg8::Gemm g{(const bf16_t*)(ws + WS_A), (const bf16_t*)(ws + WS_WINT), S, NPROJ, D}; pg8::StaticOrder so; so.init(S, NPROJ, (int)gridDim.x, (int)blockIdx.x);
        EpiInProj E{(const float*)(ws + WS_RSTD1), p.in[I_Q_NORM], p.in[I_K_NORM], (bf16_t*)(ws + WS_QH), (bf16_t*)(ws + WS_KH), (bf16_t*)(ws + WS_VH), (bf16_t*)(ws + WS_XRG), (bf16_t*)(ws + WS_GG)};
        pg8::gemm_phase<EpiInProj, pg8::StaticOrder, true, true>(ring, g, so, E);
        const int G = (int)gridDim.x, nunits = (S / 256) * (NPROJ / 256), rem = nunits % G, b = (int)blockIdx.x;
        const int tid_ = phase_tid(), w = tid_ >> 6, lane = tid_ & 63;
        if (rem == 0) ph_tables(p, b * (NTHR / 64) + w, G * (NTHR / 64), lane);
        else if (b >= rem) ph_tables(p, (b - rem) * (NTHR / 64) + w, (G - rem) * (NTHR / 64), lane);
    }
    xcd_barrier(bar);
    ph_attn(p); ph_rg<0>(p, lds);             xcd_barrier(bar);
    ph_rg<1>(p, lds);                         xcd_barrier(bar);
    {
        pg8::Gemm g{(const bf16_t*)(ws + WS_MIX), (const bf16_t*)(ws + WS_WOUTT), S, D, D}; pg8::StaticOrder so; so.init(S, D, (int)gridDim.x, (int)blockIdx.x);
        EpiOutProj E{(const float*)(ws + WS_RSB), p.in[I_X], (bf16_t*)(ws + WS_A), (float*)(ws + WS_SSQ), ws + WS_X1Q, (float*)(ws + WS_XSC)};
        pg8::gemm_phase<EpiOutProj, pg8::StaticOrder, true, true>(ring, g, so, E);
    }
    xcd_barrier(bar);
    {
        pg8::Gemm g{(const bf16_t*)(ws + WS_A), (const bf16_t*)(ws + WS_WQT), S, NQ, D}; pg8::StaticOrder so; so.init(S, NQ, (int)gridDim.x, (int)blockIdx.x);
        EpiPeerQ E{(bf16_t*)(ws + WS_B)};
        pg8::gemm_phase<EpiPeerQ, pg8::StaticOrder, true, true>(ring, g, so, E);
    }
    asm volatile("s_waitcnt vmcnt(0)" ::: "memory"); __syncthreads();
    ph_topk(p, (int*)lds);                    xcd_barrier(bar);
    ph_peer<0>(p, lds);                       xcd_barrier(bar);
    ph_peer_combine(p);                       xcd_barrier(bar);
    ph_peer<1>(p, lds);
}

extern "C" void kernel_launch(void* const* d_in, const int* in_sizes, int n_in, void* d_out, int out_size, void* d_ws, size_t ws_size, hipStream_t stream) {
    static int grid = 0;
    if (grid == 0) {
        if (n_in != 20 || out_size != S * D || ws_size < WS_END) { fprintf(stderr, "kernel_launch: unexpected shapes (n_in %d out %d ws %zu)\n", n_in, out_size, ws_size); grid = -1; return; }
        int dev = 0, cus = 0, per_cu = 0;
        if (hipGetDevice(&dev) != hipSuccess || hipDeviceGetAttribute(&cus, hipDeviceAttributeMultiprocessorCount, dev) != hipSuccess) { grid = -1; return; }
        if (hipFuncSetAttribute((const void*)hymba_fwd, hipFuncAttributeMaxDynamicSharedMemorySize, LDS_BYTES) != hipSuccess) { fprintf(stderr, "kernel_launch: hipFuncSetAttribute failed\n"); grid = -1; return; }
        if (hipOccupancyMaxActiveBlocksPerMultiprocessor(&per_cu, (const void*)hymba_fwd, NTHR, LDS_BYTES) != hipSuccess || per_cu < 1) { fprintf(stderr, "kernel_launch: occupancy query says %d blocks per CU\n", per_cu); grid = -1; return; }
        (void)hipGetLastError();
        grid = cus;
    }
    if (grid < 0) return;
    (void)hipMemsetAsync((char*)d_ws + WS_CTL, 0, XCD_BAR_WORDS * 4, stream);
    Params p{};
    for (int i = 0; i < 20; ++i) p.in[i] = (const float*)d_in[i];
    p.out = (float*)d_out; p.ws = (unsigned char*)d_ws;
    hipLaunchKernelGGL(hymba_fwd, dim3(grid), dim3(NTHR), LDS_BYTES, stream, p);
}
```

```cpp
#include <hip/hip_runtime.h>
#include <cstdint>
#include <cstdio>

typedef unsigned short bf16_t;
typedef short bf16x8 __attribute__((ext_vector_type(8)));
typedef float f32x4 __attribute__((ext_vector_type(4)));
typedef unsigned u32x4 __attribute__((ext_vector_type(4)));
typedef float f32x16 __attribute__((ext_vector_type(16)));

constexpr int S = 16384, D = 1024, NPROJ = 2560, DSB = 512, DRG = 512, NH = 8, HD = 64;
constexpr int PH = 8, PNK = 128, PDK = 256, PHALF = 128, PTOPK = 16, NEXP = 16384, NQ = PH * PDK;
constexpr int CHUNK = 64, NCHUNK = S / CHUNK;
constexpr float EPS = 1e-6f;
constexpr float LOG2E = 1.4426950408889634f;
constexpr float QSCALE = 0.125f * LOG2E;
constexpr int NTHR = 512;
constexpr float CARRY_STOP = -160.0f;

constexpr size_t MiB = 1u << 20;
constexpr size_t WS_CTL = 0;
constexpr size_t WS_WINT = 1 * MiB;
constexpr size_t WS_WOUTT = 6 * MiB;
constexpr size_t WS_WQT = 8 * MiB;
constexpr size_t WS_SUBK = 12 * MiB;
constexpr size_t WS_RSTD1 = 12 * MiB + 512 * 1024;
constexpr size_t WS_RSTD2 = WS_RSTD1 + 64 * 1024;
constexpr size_t WS_RGP = WS_RSTD2 + 64 * 1024;
constexpr size_t WS_RGH = WS_RGP + 512 * 1024;
constexpr size_t WS_RGSA = 207 * MiB, WS_RGSB = 223 * MiB;
constexpr size_t WS_A = 14 * MiB;
constexpr size_t WS_B = 46 * MiB;
constexpr size_t WS_QH = WS_B, WS_KH = WS_B + 16 * MiB, WS_VH = WS_B + 32 * MiB, WS_XRG = WS_B + 48 * MiB;
constexpr size_t WS_GG = 110 * MiB;
constexpr size_t WS_OSB = 126 * MiB;
constexpr size_t WS_MIX = 142 * MiB;
constexpr size_t WS_SSB = 198 * MiB;
constexpr size_t WS_RSB = WS_SSB + 512 * 1024;
constexpr size_t WS_SELI = WS_MIX, WS_SELG = WS_MIX + 8 * MiB;
constexpr size_t WS_PD = WS_B;
constexpr size_t WS_CBUF = WS_GG;
constexpr size_t WS_CSC = WS_GG + 4 * MiB;
constexpr size_t WS_X1Q = WS_OSB;
constexpr size_t WS_XSC = WS_GG + 8 * MiB;
constexpr size_t WS_UB = 174 * MiB;
constexpr size_t WS_VB = 190 * MiB;
constexpr size_t WS_USC = 206 * MiB;
constexpr size_t WS_SSQ = 238 * MiB;
constexpr size_t WS_RGW = 239 * MiB;
constexpr size_t WS_END = 240 * MiB;

__device__ __forceinline__ unsigned f2bf(float f) { unsigned u = __builtin_bit_cast(unsigned, f); return (u + 0x7fffu + ((u >> 16) & 1u)) >> 16; }
__device__ __forceinline__ float u2f(unsigned u) { return __builtin_bit_cast(float, u); }
__device__ __forceinline__ float bf2f(unsigned h) { return __builtin_bit_cast(float, h << 16); }
__device__ __forceinline__ unsigned pk2(float lo, float hi) { return f2bf(lo) | (f2bf(hi) << 16); }
__device__ __forceinline__ unsigned pack_i8(float a, float b, float c, float d) {
    const int qa = __float2int_rn(a), qb = __float2int_rn(b), qc = __float2int_rn(c), qd = __float2int_rn(d);
    return (unsigned)(qa & 255) | ((unsigned)(qb & 255) << 8) | ((unsigned)(qc & 255) << 16) | ((unsigned)qd << 24);
}
__device__ __forceinline__ unsigned pack_n4(float a, float b, float c, float d) {
    const int qa = min(max(__float2int_rn(a), -7), 7) & 15, qb = min(max(__float2int_rn(b), -7), 7) & 15, qc = min(max(__float2int_rn(c), -7), 7) & 15, qd = min(max(__float2int_rn(d), -7), 7) & 15;
    return (unsigned)qa | ((unsigned)qb << 4) | ((unsigned)qc << 8) | ((unsigned)qd << 12);
}
template <int OFFS>
__device__ __forceinline__ unsigned pack_u4(float a, float b, float c, float d) {
    const int qa = (min(max(__float2int_rn(a), -7), 7) + OFFS) & 15, qb = (min(max(__float2int_rn(b), -7), 7) + OFFS) & 15, qc = (min(max(__float2int_rn(c), -7), 7) + OFFS) & 15, qd = (min(max(__float2int_rn(d), -7), 7) + OFFS) & 15;
    return (unsigned)qa | ((unsigned)qb << 8) | ((unsigned)qc << 16) | ((unsigned)qd << 24);
}
__device__ __forceinline__ float wave_sum(float v) {
#pragma unroll
    for (int o = 1; o < 64; o <<= 1) v += __shfl_xor(v, o);
    return v;
}
__device__ __forceinline__ float gelu_tanh(float x) {
    const float u = 0.7978845608028654f * (x + 0.044715f * x * x * x);
    const float e = __expf(2.0f * u);
    const float th = 1.0f - 2.0f / (e + 1.0f);
    return 0.5f * x * (1.0f + th);
}

__host__ __device__ __forceinline__ int inproj_phys_row(int nlog) { const int t = nlog >> 8, L = nlog & 255; return (t << 8) + 128 * ((L & 63) >> 5) + 32 * (L >> 6) + (L & 31); }

__device__ __forceinline__ int phase_tid() { int t = threadIdx.x; asm volatile("" : "+v"(t)); return t; }

struct Params {
    const float* in[20];
    float* out;
    unsigned char* ws;
};
enum { I_X = 0, I_NORM_MIX, I_W_IN, I_Q_NORM, I_K_NORM, I_CONV_W, I_CONV_B, I_RG_W_A, I_RG_B_A, I_RG_W_X, I_RG_B_X, I_RG_LAMBDA,
       I_OUT_NORM_SB, I_OUT_NORM_RG, I_W_OUT, I_NORM_FFN, I_PEER_WQ, I_PEER_SUBK, I_PEER_U, I_PEER_V };

template <bool INPROJ_PERM>
__device__ __forceinline__ void prep_transpose_item(const float* W, const float* gain0, const float* gain1, int K, int N, bf16_t* WT, float* scr, int item, int lane) {
    const int nblk = N / 32, kb = item / nblk, nb = item % nblk, k0 = 64 * kb, n0 = 32 * nb;
#pragma unroll
    for (int i = 0; i < 32; ++i) {
        const int kk = 2 * i + (lane >> 5), k = k0 + kk;
        const float g = (gain1 && k >= 512) ? gain1[k - 512] : gain0[k];
        scr[kk * 33 + (lane & 31)] = g * W[(size_t)k * N + n0 + (lane & 31)];
    }
    asm volatile("s_waitcnt lgkmcnt(0)" ::: "memory");
    const int c = lane & 7;
#pragma unroll
    for (int j = 0; j < 4; ++j) {
        const int n = (lane >> 3) + 8 * j; const float* s = scr + (8 * c) * 33 + n;
        u32x4 o; o.x = pk2(s[0 * 33], s[1 * 33]); o.y = pk2(s[2 * 33], s[3 * 33]); o.z = pk2(s[4 * 33], s[5 * 33]); o.w = pk2(s[6 * 33], s[7 * 33]);
        const int nr = INPROJ_PERM ? inproj_phys_row(n0 + n) : n0 + n;
        *(u32x4*)(WT + (size_t)nr * K + k0 + 8 * c) = o;
    }
    asm volatile("s_waitcnt lgkmcnt(0)" ::: "memory");
}
__device__ __forceinline__ void ph_tables(const Params& p, int cw, int ncw, int lane) {
    unsigned char* ws = p.ws;
    {
        const float* u = p.in[I_PEER_U]; const float* v = p.in[I_PEER_V]; const float* g = p.in[I_NORM_FFN];
        unsigned* ub = (unsigned*)(ws + WS_UB); unsigned* vb = (unsigned*)(ws + WS_VB); float2* uvsc = (float2*)(ws + WS_USC);
        f32x4 gq[4];
#pragma unroll
        for (int j = 0; j < 4; ++j) gq[j] = *((const f32x4*)g + lane + 64 * j);
        for (int e0 = cw; e0 < NEXP; e0 += 2 * ncw) {
            f32x4 a[2][4], b[2][4]; float ma[2], mb[2], sa2[2], sb2[2];
#pragma unroll
            for (int rr = 0; rr < 2; ++rr) {
                const int e = min(e0 + rr * ncw, NEXP - 1);
#pragma unroll
                for (int j = 0; j < 4; ++j) { a[rr][j] = *((const f32x4*)(u + (size_t)e * D) + lane + 64 * j); b[rr][j] = *((const f32x4*)(v + (size_t)e * D) + lane + 64 * j); }
            }
#pragma unroll
            for (int rr = 0; rr < 2; ++rr) {
                ma[rr] = 0.f; mb[rr] = 0.f; sa2[rr] = 0.f; sb2[rr] = 0.f;
#pragma unroll
                for (int j = 0; j < 4; ++j) {
                    a[rr][j] = a[rr][j] * gq[j];
                    const f32x4 aa = a[rr][j], bb = b[rr][j];
                    ma[rr] = fmaxf(ma[rr], fmaxf(fmaxf(fabsf(aa.x), fabsf(aa.y)), fmaxf(fabsf(aa.z), fabsf(aa.w))));
                    mb[rr] = fmaxf(mb[rr], fmaxf(fmaxf(fabsf(bb.x), fabsf(bb.y)), fmaxf(fabsf(bb.z), fabsf(bb.w))));
                    sa2[rr] += (aa.x * aa.x + aa.y * aa.y) + (aa.z * aa.z + aa.w * aa.w);
                    sb2[rr] += (bb.x * bb.x + bb.y * bb.y) + (bb.z * bb.z + bb.w * bb.w);
                }
            }
#pragma unroll
            for (int o = 1; o < 64; o <<= 1)
#pragma unroll
                for (int rr = 0; rr < 2; ++rr) { ma[rr] = fmaxf(ma[rr], __shfl_xor(ma[rr], o)); mb[rr] = fmaxf(mb[rr], __shfl_xor(mb[rr], o)); sa2[rr] += __shfl_xor(sa2[rr], o); sb2[rr] += __shfl_xor(sb2[rr], o); }
#pragma unroll
            for (int rr = 0; rr < 2; ++rr) {
                const int e = e0 + rr * ncw;
                if (e < NEXP) {
                    const float ca = fminf(ma[rr], 2.5f * sqrtf(sa2[rr] * (1.0f / D))), cb = fminf(mb[rr], 2.5f * sqrtf(sb2[rr] * (1.0f / D)));
                    const float ia = ca > 0.f ? 7.0f / ca : 0.f, ib = cb > 0.f ? 7.0f / cb : 0.f;
#pragma unroll
                    for (int j = 0; j < 4; ++j) {
                        const f32x4 aa = a[rr][j], bb = b[rr][j];
                        const unsigned na = pack_u4<0>(aa.x * ia, aa.y * ia, aa.z * ia, aa.w * ia), nb = pack_n4(bb.x * ib, bb.y * ib, bb.z * ib, bb.w * ib);
                        const unsigned pa = __shfl_xor(na, 1), pb = __shfl_xor(nb, 1);
                        if ((lane & 1) == 0) {
                            ub[((size_t)j * NEXP + e) * 32 + (lane >> 1)] = na | (pa << 4);
                            vb[((size_t)j * NEXP + e) * 32 + (lane >> 1)] = nb | (pb << 16);
                        }
                    }
                    if (lane == 0) uvsc[e] = make_float2(ca * (1.0f / 7.0f), cb * (1.0f / 7.0f));
                }
            }
        }
    }
}

__device__ __forceinline__ void ph_prep(const Params& p, unsigned char* lds) {
    const int tid_ = phase_tid();
    const int gtid = blockIdx.x * blockDim.x + tid_, gsize = gridDim.x * blockDim.x;
    const int lane = tid_ & 63, gwave = gtid >> 6, nwave = gsize >> 6;
    unsigned char* ws = p.ws;
    {
        float* scr = (float*)lds + (tid_ >> 6) * (64 * 33);
        constexpr int I_IN = (D / 64) * (NPROJ / 32), I_OUT = (D / 64) * (D / 32), I_Q = (D / 64) * (NQ / 32);
        for (int it = gwave; it < I_IN + I_OUT + I_Q; it += nwave) {
            if (it < I_IN) prep_transpose_item<true>(p.in[I_W_IN], p.in[I_NORM_MIX], nullptr, D, NPROJ, (bf16_t*)(ws + WS_WINT), scr, it, lane);
            else if (it < I_IN + I_OUT) prep_transpose_item<false>(p.in[I_W_OUT], p.in[I_OUT_NORM_SB], p.in[I_OUT_NORM_RG], D, D, (bf16_t*)(ws + WS_WOUTT), scr, it - I_IN, lane);
            else prep_transpose_item<false>(p.in[I_PEER_WQ], p.in[I_NORM_FFN], nullptr, D, NQ, (bf16_t*)(ws + WS_WQT), scr, it - I_IN - I_OUT, lane);
        }
    }
    {
        const float* wa = p.in[I_RG_W_A]; const float* wx = p.in[I_RG_W_X]; bf16_t* o = (bf16_t*)(ws + WS_RGW);
        for (int e = gtid; e < 8 * 2 * 2 * 4 * 64 * 8; e += gsize) {
            const int el = e & 7, ln = (e >> 3) & 63, s = (e >> 9) & 3, jt = (e >> 11) & 1, g = (e >> 12) & 1, n = e >> 13;
            const int j = 32 * jt + (ln & 31), i = 16 * s + 8 * (el >> 2) + 4 * (ln >> 5) + (el & 3);
            o[e] = (bf16_t)f2bf((g == 0 ? wa : wx)[((size_t)n * 64 + i) * 64 + j]);
        }
    }
    {
        const float* sk = p.in[I_PEER_SUBK]; bf16_t* o = (bf16_t*)(ws + WS_SUBK);
        for (int e = gtid; e < PH * 2 * PNK * PHALF; e += gsize) o[e] = (bf16_t)f2bf(sk[e]);
    }
    {
        const float* x = p.in[I_X]; bf16_t* xb = (bf16_t*)(ws + WS_A); float* rstd1 = (float*)(ws + WS_RSTD1);
        for (int row0 = gwave; row0 < S; row0 += 4 * nwave) {
            f32x4 v[4][4];
#pragma unroll
            for (int rr = 0; rr < 4; ++rr) {
                const int row = min(row0 + rr * nwave, S - 1);
#pragma unroll
                for (int j = 0; j < 4; ++j) v[rr][j] = ((const f32x4*)(x + (size_t)row * D) + lane)[64 * j];
            }
#pragma unroll
            for (int rr = 0; rr < 4; ++rr) {
                const int row = row0 + rr * nwave;
                float ss = 0.f;
#pragma unroll
                for (int j = 0; j < 4; ++j) ss += (v[rr][j].x * v[rr][j].x + v[rr][j].y * v[rr][j].y) + (v[rr][j].z * v[rr][j].z + v[rr][j].w * v[rr][j].w);
                ss = wave_sum(ss);
                if (row < S) {
                    uint2* o = (uint2*)(xb + (size_t)row * D) + lane;
#pragma unroll
                    for (int j = 0; j < 4; ++j) o[64 * j] = make_uint2(pk2(v[rr][j].x, v[rr][j].y), pk2(v[rr][j].z, v[rr][j].w));
                    if (lane == 0) rstd1[row] = rsqrtf(ss * (1.0f / D) + EPS);
                }
            }
        }
    }
}

namespace pg8 {
#define PG8_LAS __attribute__((address_space(3)))
typedef unsigned short bf16_t;
typedef short bf16x8 __attribute__((ext_vector_type(8)));
typedef float f32x4 __attribute__((ext_vector_type(4)));
typedef unsigned u32x4 __attribute__((ext_vector_type(4)));
constexpr int BM = 256, BK = 64, HALF = 128, HTB = HALF * BK * 2  , STAGE_BYTES = 8 * HTB, NXCD = 8, WGM = 8;

__host__ __device__ __forceinline__ int lds_byte(int r, int c) { const int st = (r >> 4) * 2 + (c >> 5), rr = r & 15, cc = c & 31, ob = rr * 64 + cc * 2; return st * 1024 + (ob ^ (((ob >> 9) & 1) << 5)); }
__host__ __device__ __forceinline__ void stage_rc(int b, int& R, int& C) { const int st = b / 1024, sb = b % 1024, swz = sb ^ (((sb >> 9) & 1) << 5); R = (st >> 1) * 16 + swz / 64; C = (st & 1) * 32 + (swz % 64) / 2; }
__host__ __device__ __forceinline__ int perm32(int rho) { const int n = rho >> 4, i = rho & 15; return 8 * (i >> 2) + 4 * n + (i & 3); }

struct Unit { int pm, pn; };
struct Gemm { const bf16_t* A; const bf16_t* Bt; int M, N, K; };

struct StaticOrder {
    int nM, nN, nwg, G, c;
    __host__ __device__ void init(int M, int N, int G_, int c_) { nM = M / BM; nN = N / BM; nwg = nM * nN; G = G_; c = c_; }
    __host__ __device__ bool next(int i, Unit& u) const {
        const long L = (long)i * G + c; if (L >= nwg) return false;
        int wgid = (int)L; { const int q = nwg / NXCD, r = nwg % NXCD, xcd = wgid % NXCD, off = wgid / NXCD; wgid = (xcd < r ? xcd * (q + 1) : r * (q + 1) + (xcd - r) * q) + off; }
        const int nig = WGM * nN, gid = wgid / nig, fm = gid * WGM, gsz = (nM - fm) < WGM ? (nM - fm) : WGM;
        u.pm = fm + ((wgid % nig) % gsz); u.pn = (wgid % nig) / gsz; return true;
    }
    __device__ __forceinline__ void a_ready(const Unit&) const {}
    __device__ __forceinline__ void done(const Unit&) const {}
};

__device__ __forceinline__ unsigned cvt_pk_bf16(float lo, float hi) { unsigned r; asm volatile("v_cvt_pk_bf16_f32 %0, %1, %2" : "=v"(r) : "v"(lo), "v"(hi)); return r; }
template <class Epi, class Sched, bool ALIGN_EPI = false, bool SP2 = false>
__device__ __forceinline__ void gemm_phase(PG8_LAS unsigned char* lds, const Gemm g, const Sched& S, const Epi& E) {
    const int tid = phase_tid(), wid = __builtin_amdgcn_readfirstlane(tid >> 6), lane = tid & 63, wr = wid >> 2, wc = wid & 3, fr = lane & 15, fq = lane >> 4;
    const int K = g.K, nt = K / BK;
    unsigned voffA[2], voffB[2];
#pragma unroll
    for (int i = 0; i < 2; ++i) { int R, C; stage_rc(tid * 16 + i * 8192, R, C); const int Rb = Epi::PERM ? ((R & ~31) + perm32(R & 31)) : R;
        voffA[i] = (unsigned)(R * K + C) * 2u; voffB[i] = (unsigned)(Rb * K + C) * 2u; }
    const size_t kstep = (size_t)(BK * 2);
    const size_t hstep = (size_t)HALF * K * 2;
    const size_t tstep = 2 * hstep;
    const unsigned ldsw = (unsigned)wid * 1024u;
    const int aoff = lds_byte(wr * 64 + fr, fq * 8), boff = lds_byte(wc * 32 + fr, fq * 8);
#define PG8_SA(b, h) (((b) * 2 + (h)) * HTB)
#define PG8_SB(b, h) ((4 + (b) * 2 + (h)) * HTB)
#define PG8_STAGE(bufoff, gbase, voff) do { _Pragma("unroll") for (int _i = 0; _i < 2; ++_i) \
        __builtin_amdgcn_global_load_lds((const unsigned*)((const char*)(gbase) + (voff)[_i]), (PG8_LAS unsigned*)(lds + (bufoff) + ldsw + _i * 8192), 16, 0, 0); } while (0)
#define PG8_LDA(dst, b, h) do { _Pragma("unroll") for (int m = 0; m < 4; ++m) _Pragma("unroll") for (int k = 0; k < 2; ++k) dst[m][k] = *(const PG8_LAS bf16x8*)(lds + PG8_SA(b, h) + aoff + m * 2048 + k * 1024); } while (0)
#define PG8_LDB(dst, b, h) do { _Pragma("unroll") for (int n = 0; n < 2; ++n) _Pragma("unroll") for (int k = 0; k < 2; ++k) dst[n][k] = *(const PG8_LAS bf16x8*)(lds + PG8_SB(b, h) + boff + n * 2048 + k * 1024); } while (0)
#define PG8_MMA(ai, bj, At, Bt) do { __builtin_amdgcn_s_setprio(1); _Pragma("unroll") for (int m = 0; m < 4; ++m) _Pragma("unroll") for (int n = 0; n < 2; ++n) _Pragma("unroll") for (int k = 0; k < 2; ++k) \
        acc[ai][bj][m][n] = __builtin_amdgcn_mfma_f32_16x16x32_bf16(Bt[n][k], At[m][k], acc[ai][bj][m][n], 0, 0, 0); __builtin_amdgcn_s_setprio(0); } while (0)
#define PG8_WAIT_V(n) asm volatile("s_waitcnt vmcnt(" #n ")" ::: "memory")
#define PG8_WAIT_L(n) asm volatile("s_waitcnt lgkmcnt(" #n ")" ::: "memory")
#define PG8_BAR __builtin_amdgcn_s_barrier()
#define PG8_SCHED __builtin_amdgcn_sched_barrier(0)
    Unit cur, nxt; int ui = 0;
    if (!S.next(0, cur)) return;
    f32x4 acc[2][2][4][2];
#pragma unroll
    for (int a = 0; a < 2; ++a)
#pragma unroll
        for (int b = 0; b < 2; ++b)
#pragma unroll
            for (int m = 0; m < 4; ++m)
#pragma unroll
                for (int n = 0; n < 2; ++n) acc[a][b][m][n] = (f32x4){0.f, 0.f, 0.f, 0.f};
    bf16x8 At[4][2], B0[2][2], B1[2][2];
    const char* cA = (const char*)g.A + (size_t)cur.pm * tstep; const char* cB = (const char*)g.Bt + (size_t)cur.pn * tstep;
    S.a_ready(cur);
    if constexpr (SP2) {
        PG8_STAGE(PG8_SB(0, 0), cB, voffB); PG8_STAGE(PG8_SB(0, 1), cB + hstep, voffB); PG8_STAGE(PG8_SA(0, 0), cA, voffA); PG8_STAGE(PG8_SA(0, 1), cA + hstep, voffA);
        if (wr == 1) PG8_BAR;
        PG8_WAIT_V(2); PG8_BAR;
        PG8_STAGE(PG8_SB(1, 0), cB + kstep, voffB); PG8_STAGE(PG8_SA(1, 0), cA + kstep, voffA); PG8_STAGE(PG8_SB(1, 1), cB + hstep + kstep, voffB);
        PG8_WAIT_V(6); PG8_BAR;
    } else {
        PG8_STAGE(PG8_SB(0, 0), cB, voffB); PG8_STAGE(PG8_SA(0, 0), cA, voffA); PG8_STAGE(PG8_SB(0, 1), cB + hstep, voffB); PG8_STAGE(PG8_SA(0, 1), cA + hstep, voffA);
        if (wr == 1) PG8_BAR;
        PG8_WAIT_V(4); PG8_BAR;
        PG8_STAGE(PG8_SB(1, 0), cB + kstep, voffB); PG8_STAGE(PG8_SA(1, 0), cA + kstep, voffA); PG8_STAGE(PG8_SB(1, 1), cB + hstep + kstep, voffB);
        PG8_WAIT_V(6); PG8_BAR;
    }
    for (;;) {
        const bool has_next = S.next(ui + 1, nxt);
        const char* nA = has_next ? (const char*)g.A + (size_t)nxt.pm * tstep : cA; const char* nB = has_next ? (const char*)g.Bt + (size_t)nxt.pn * tstep : cB;
        for (int t = 0; t < nt; t += 2) {
            if constexpr (Epi::MIDSCALE) { if (t == nt / 2) E.mid(acc, cur, wr, wc, fr, fq); }
            const bool last = (t == nt - 2);
            const char* a1 = cA + (size_t)(t + 1) * kstep;
            const char* a2 = last ? nA : cA + (size_t)(t + 2) * kstep; const char* b2 = last ? nB : cB + (size_t)(t + 2) * kstep;
            const char* a3 = a2 + kstep; const char* b3 = b2 + kstep;
            if (last && has_next) S.a_ready(nxt);
            if constexpr (SP2) {
            PG8_LDB(B0, 0, 0); PG8_LDB(B1, 0, 1); PG8_SCHED; PG8_LDA(At, 0, 0); PG8_STAGE(PG8_SA(1, 1), a1 + hstep, voffA);
            PG8_WAIT_V(8); PG8_WAIT_L(0); PG8_BAR; PG8_MMA(0, 0, At, B0); PG8_MMA(0, 1, At, B1); PG8_BAR; PG8_SCHED;
            PG8_LDA(At, 0, 1); PG8_STAGE(PG8_SB(0, 0), b2, voffB); PG8_STAGE(PG8_SB(0, 1), b2 + hstep, voffB); PG8_STAGE(PG8_SA(0, 0), a2, voffA);
            PG8_WAIT_V(8); PG8_WAIT_L(0); PG8_BAR; PG8_MMA(1, 0, At, B0); PG8_MMA(1, 1, At, B1); PG8_BAR; PG8_SCHED;
            PG8_LDB(B0, 1, 0); PG8_LDB(B1, 1, 1); PG8_SCHED; PG8_LDA(At, 1, 0); PG8_STAGE(PG8_SA(0, 1), a2 + hstep, voffA);
            PG8_WAIT_V(8); PG8_WAIT_L(0); PG8_BAR; PG8_MMA(0, 0, At, B0); PG8_MMA(0, 1, At, B1); PG8_BAR; PG8_SCHED;
            PG8_LDA(At, 1, 1); PG8_STAGE(PG8_SB(1, 0), b3, voffB); PG8_STAGE(PG8_SB(1, 1), b3 + hstep, voffB); PG8_STAGE(PG8_SA(1, 0), a3, voffA);
            PG8_WAIT_V(8); PG8_WAIT_L(0); PG8_BAR; PG8_MMA(1, 0, At, B0); PG8_MMA(1, 1, At, B1); PG8_BAR; PG8_SCHED;
            } else {
            PG8_LDB(B0, 0, 0); PG8_SCHED; PG8_LDA(At, 0, 0); PG8_STAGE(PG8_SA(1, 1), a1 + hstep, voffA);
            PG8_WAIT_L(8); PG8_BAR; PG8_WAIT_L(0); PG8_MMA(0, 0, At, B0); PG8_BAR; PG8_SCHED;
            PG8_LDB(B1, 0, 1); PG8_STAGE(PG8_SB(0, 0), b2, voffB);
            PG8_BAR; PG8_WAIT_L(0); PG8_MMA(0, 1, At, B1); PG8_BAR;
            PG8_LDA(At, 0, 1); PG8_STAGE(PG8_SA(0, 0), a2, voffA);
            PG8_BAR; PG8_WAIT_L(0); PG8_MMA(1, 0, At, B0); PG8_BAR; PG8_SCHED;
            PG8_STAGE(PG8_SB(0, 1), b2 + hstep, voffB);
            PG8_WAIT_V(6); PG8_BAR; PG8_MMA(1, 1, At, B1); PG8_BAR;
            PG8_LDB(B0, 1, 0); PG8_SCHED; PG8_LDA(At, 1, 0); PG8_STAGE(PG8_SA(0, 1), a2 + hstep, voffA);
            PG8_WAIT_L(8); PG8_BAR; PG8_WAIT_L(0); PG8_MMA(0, 0, At, B0); PG8_BAR; PG8_SCHED;
            PG8_LDB(B1, 1, 1); PG8_STAGE(PG8_SB(1, 0), b3, voffB);
            PG8_BAR; PG8_WAIT_L(0); PG8_MMA(0, 1, At, B1); PG8_BAR;
            PG8_LDA(At, 1, 1); PG8_STAGE(PG8_SA(1, 0), a3, voffA);
            PG8_BAR; PG8_WAIT_L(0); PG8_MMA(1, 0, At, B0); PG8_BAR; PG8_SCHED;
            PG8_STAGE(PG8_SB(1, 1), b3 + hstep, voffB);
            PG8_WAIT_V(6); PG8_BAR; PG8_MMA(1, 1, At, B1); PG8_BAR;
            }
        }
        if constexpr (ALIGN_EPI) { if (wr == 0) PG8_BAR; }
        if constexpr (!Epi::AFTER_DRAIN) { E(acc, cur, wr, wc, fr, fq); S.done(cur); }
        if (!has_next) break;
#pragma unroll
        for (int a = 0; a < 2; ++a)
#pragma unroll
            for (int b = 0; b < 2; ++b)
#pragma unroll
                for (int m = 0; m < 4; ++m)
#pragma unroll
                    for (int n = 0; n < 2; ++n) acc[a][b][m][n] = (f32x4){0.f, 0.f, 0.f, 0.f};
        cur = nxt; cA = nA; cB = nB; ++ui;
        if constexpr (ALIGN_EPI) { if (wr == 1) PG8_BAR; }
    }
    PG8_WAIT_V(0);
    if constexpr (!ALIGN_EPI) { if (wr == 0) PG8_BAR; }
    PG8_BAR;
    if constexpr (Epi::AFTER_DRAIN) { E.fused(acc, cur, wr, wc, fr, fq, lds, wid, lane); S.done(cur); }
#undef PG8_SA
#undef PG8_SB
#undef PG8_STAGE
#undef PG8_LDA
#undef PG8_LDB
#undef PG8_MMA
#undef PG8_WAIT_V
#undef PG8_WAIT_L
#undef PG8_BAR
#undef PG8_SCHED
}
}

struct EpiInProj {
    static constexpr bool PERM = true, AFTER_DRAIN = false, MIDSCALE = false;
    const float* rstd1; const float* qn; const float* kn; bf16_t *qh, *kh, *vh, *xrg, *gg;
    __device__ __forceinline__ void operator()(const pg8::f32x4 (&acc)[2][2][4][2], const pg8::Unit& u, int wr, int wc, int fr, int fq) const {
        const int region = u.pn >> 1;
        const int head = (u.pn & 1) * 4 + wc;
        float rsv[2][4];
#pragma unroll
        for (int ai = 0; ai < 2; ++ai)
#pragma unroll
            for (int m = 0; m < 4; ++m) rsv[ai][m] = rstd1[u.pm * 256 + ai * 128 + wr * 64 + m * 16 + fr];
        pg8::f32x4 gn[2][2];
        if (region <= 1) {
            const float* g = region == 0 ? qn : kn; const float sc = region == 0 ? QSCALE : 1.0f;
#pragma unroll
            for (int bj = 0; bj < 2; ++bj)
#pragma unroll
                for (int n = 0; n < 2; ++n) gn[bj][n] = *(const pg8::f32x4*)(g + 32 * bj + 8 * fq + 4 * n) * sc;
        }
#pragma unroll
        for (int ai = 0; ai < 2; ++ai)
#pragma unroll
            for (int m = 0; m < 4; ++m) {
                const int row = u.pm * 256 + ai * 128 + wr * 64 + m * 16 + fr;
                const float rs = rsv[ai][m];
                pg8::f32x4 v[2][2];
#pragma unroll
                for (int bj = 0; bj < 2; ++bj)
#pragma unroll
                    for (int n = 0; n < 2; ++n) v[bj][n] = acc[ai][bj][m][n] * rs;
                bf16_t* dst;
                if (region <= 1) {
                    float ss = 0.f;
#pragma unroll
                    for (int bj = 0; bj < 2; ++bj)
#pragma unroll
                        for (int n = 0; n < 2; ++n) ss += (v[bj][n][0] * v[bj][n][0] + v[bj][n][1] * v[bj][n][1]) + (v[bj][n][2] * v[bj][n][2] + v[bj][n][3] * v[bj][n][3]);
                    ss += __shfl_xor(ss, 16); ss += __shfl_xor(ss, 32);
                    const float rn = rsqrtf(ss * (1.0f / HD) + EPS);
#pragma unroll
                    for (int bj = 0; bj < 2; ++bj)
#pragma unroll
                        for (int n = 0; n < 2; ++n) v[bj][n] = v[bj][n] * rn * gn[bj][n];
                    bf16_t* fb = (region == 0 ? qh : kh) + ((size_t)(head * (S / 32) + (row >> 5)) * 4 * 64 + (row & 31)) * 8;
#pragma unroll
                    for (int bj = 0; bj < 2; ++bj) {
                        pg8::u32x4 w; w.x = pg8::cvt_pk_bf16(v[bj][0][0], v[bj][0][1]); w.y = pg8::cvt_pk_bf16(v[bj][0][2], v[bj][0][3]);
                        w.z = pg8::cvt_pk_bf16(v[bj][1][0], v[bj][1][1]); w.w = pg8::cvt_pk_bf16(v[bj][1][2], v[bj][1][3]);
                        *(pg8::u32x4*)(fb + ((2 * bj + (fq >> 1)) * 64 + 32 * (fq & 1)) * 8) = w;
                    }
                    continue;
                } else if (region == 2) {
#pragma unroll
                    for (int bj = 0; bj < 2; ++bj)
#pragma unroll
                        for (int n = 0; n < 2; ++n)
#pragma unroll
                            for (int i = 0; i < 4; ++i) {
                                const int d = 32 * bj + 8 * fq + 4 * n + i, kl = row & 31;
                                vh[(((((size_t)head * (S / 32) + (row >> 5)) * 2 + (d >> 5)) * 2 + (kl >> 4)) * 64 + (d & 31) + 32 * ((kl >> 2) & 1)) * 8 + 4 * ((kl >> 3) & 1) + (kl & 3)] = (bf16_t)f2bf(v[bj][n][i]);
                            }
                    continue;
                } else if (region == 3) {
                    dst = xrg + (size_t)row * DRG + head * 64;
                } else {
#pragma unroll
                    for (int bj = 0; bj < 2; ++bj)
#pragma unroll
                        for (int n = 0; n < 2; ++n)
#pragma unroll
                            for (int i = 0; i < 4; ++i) v[bj][n][i] = gelu_tanh(v[bj][n][i]);
#pragma unroll
                    for (int bj = 0; bj < 2; ++bj)
#pragma unroll
                        for (int n = 0; n < 2; ++n)
                            *(uint2*)(gg + ((((size_t)(row >> 5) * 8 + head) * 8 + (4 * bj + fq)) * 64 + (row & 31) + 32 * n) * 4) = make_uint2(pg8::cvt_pk_bf16(v[bj][n][0], v[bj][n][1]), pg8::cvt_pk_bf16(v[bj][n][2], v[bj][n][3]));
                    continue;
                }
#pragma unroll
                for (int bj = 0; bj < 2; ++bj) {
                    pg8::u32x4 w; w.x = pg8::cvt_pk_bf16(v[bj][0][0], v[bj][0][1]); w.y = pg8::cvt_pk_bf16(v[bj][0][2], v[bj][0][3]);
                    w.z = pg8::cvt_pk_bf16(v[bj][1][0], v[bj][1][1]); w.w = pg8::cvt_pk_bf16(v[bj][1][2], v[bj][1][3]);
                    *(pg8::u32x4*)(dst + 32 * bj + 8 * fq) = w;
                }
            }
    }
};
struct EpiOutProj {
    static constexpr bool PERM = true, AFTER_DRAIN = false, MIDSCALE = true;
    __device__ __forceinline__ void mid(pg8::f32x4 (&acc)[2][2][4][2], const pg8::Unit& u, int wr, int wc, int fr, int fq) const {
        float sc[2][4];
        int fro = fr; asm volatile("" : "+v"(fro));
#pragma unroll
        for (int ai = 0; ai < 2; ++ai)
#pragma unroll
            for (int m = 0; m < 4; ++m) sc[ai][m] = rsb[u.pm * 256 + ai * 128 + wr * 64 + m * 16 + fro];
#pragma unroll
        for (int ai = 0; ai < 2; ++ai)
#pragma unroll
            for (int bj = 0; bj < 2; ++bj)
#pragma unroll
                for (int m = 0; m < 4; ++m)
#pragma unroll
                    for (int n = 0; n < 2; ++n) acc[ai][bj][m][n] = acc[ai][bj][m][n] * sc[ai][m];
    }
    const float* rsb;
    const float* x; bf16_t* x1b; float* ssq; unsigned char* x1q; float* xsc;
    __device__ __forceinline__ void operator()(const pg8::f32x4 (&acc)[2][2][4][2], const pg8::Unit& u, int wr, int wc, int fr, int fq) const {
        pg8::u32x4 xv[2][2][2];
#define OUTPROJ_LD(buf, ai_, mh_) do { _Pragma("unroll") for (int mm_ = 0; mm_ < 2; ++mm_) _Pragma("unroll") for (int bj_ = 0; bj_ < 2; ++bj_) { \
            const size_t o_ = (size_t)(u.pm * 256 + (ai_) * 128 + wr * 64 + (2 * (mh_) + mm_) * 16 + fr) * D + u.pn * 256 + bj_ * 128 + wc * 32 + 8 * fq; \
            xv[buf][mm_][bj_] = *(const pg8::u32x4*)(x1b + o_); } } while (0)
        OUTPROJ_LD(0, 0, 0);
#pragma unroll
        for (int ai = 0; ai < 2; ++ai)
#pragma unroll
            for (int m = 0; m < 4; ++m) {
                const int kb = ai * 2 + (m >> 1);
                if ((m & 1) == 0 && kb < 3) OUTPROJ_LD((kb + 1) & 1, (kb + 1) >> 1, (kb + 1) & 1);
                const int row = u.pm * 256 + ai * 128 + wr * 64 + m * 16 + fr;
                float ss = 0.f;
#pragma unroll
                for (int bj = 0; bj < 2; ++bj) {
                    const int col = u.pn * 256 + bj * 128 + wc * 32 + 8 * fq;
                    const size_t o = (size_t)row * D + col;
                    const pg8::u32x4 xw = xv[kb & 1][m & 1][bj];
                    const pg8::f32x4 a = (pg8::f32x4){u2f(xw.x << 16), u2f(xw.x & 0xffff0000u), u2f(xw.y << 16), u2f(xw.y & 0xffff0000u)} + acc[ai][bj][m][0];
                    const pg8::f32x4 b = (pg8::f32x4){u2f(xw.z << 16), u2f(xw.z & 0xffff0000u), u2f(xw.w << 16), u2f(xw.w & 0xffff0000u)} + acc[ai][bj][m][1];
                    ss += (a[0] * a[0] + a[1] * a[1]) + (a[2] * a[2] + a[3] * a[3]) + (b[0] * b[0] + b[1] * b[1]) + (b[2] * b[2] + b[3] * b[3]);
                    pg8::u32x4 w; w.x = pg8::cvt_pk_bf16(a[0], a[1]); w.y = pg8::cvt_pk_bf16(a[2], a[3]); w.z = pg8::cvt_pk_bf16(b[0], b[1]); w.w = pg8::cvt_pk_bf16(b[2], b[3]);
                    *(pg8::u32x4*)(x1b + o) = w;
                    float mx = fmaxf(fmaxf(fmaxf(fabsf(a[0]), fabsf(a[1])), fmaxf(fabsf(a[2]), fabsf(a[3]))), fmaxf(fmaxf(fabsf(b[0]), fabsf(b[1])), fmaxf(fabsf(b[2]), fabsf(b[3]))));
                    mx = fmaxf(mx, __shfl_xor(mx, 16)); mx = fmaxf(mx, __shfl_xor(mx, 32));
                    const float inv = mx > 0.f ? 119.0f / mx : 0.f;
                    unsigned pl = 0u, ph = 0u;
#pragma unroll
                    for (int i = 0; i < 4; ++i) {
                        const int qa = __float2int_rn(a[i] * inv), qb = __float2int_rn(b[i] * inv);
                        pl |= ((unsigned)(qa & 15) << (8 * i)) | ((unsigned)(qb & 15) << (8 * i + 4));
                        ph |= ((unsigned)(((qa + 8) >> 4) & 15) << (8 * i)) | ((unsigned)(((qb + 8) >> 4) & 15) << (8 * i + 4));
                    }
                    unsigned* cq = (unsigned*)(x1q + (size_t)row * D + (col & ~31));
                    cq[fq] = pl; cq[4 + fq] = ph;
                    if (fq == 0) xsc[(size_t)row * 32 + (col >> 5)] = mx * (1.0f / 119.0f);
                }
                ss += __shfl_xor(ss, 16); ss += __shfl_xor(ss, 32);
                if (fq == 0) ssq[(size_t)row * 16 + u.pn * 4 + wc] = ss;
            }
    }
};
#undef OUTPROJ_LD
struct EpiPeerQ {
    static constexpr bool PERM = true, AFTER_DRAIN = false, MIDSCALE = false;
    bf16_t* qp;
    __device__ __forceinline__ void operator()(const pg8::f32x4 (&acc)[2][2][4][2], const pg8::Unit& u, int wr, int wc, int fr, int fq) const {
#pragma unroll
        for (int ai = 0; ai < 2; ++ai)
#pragma unroll
            for (int m = 0; m < 4; ++m) {
                const int row = u.pm * 256 + ai * 128 + wr * 64 + m * 16 + fr;
#pragma unroll
                for (int bj = 0; bj < 2; ++bj) {
                    const pg8::f32x4 a = acc[ai][bj][m][0], b = acc[ai][bj][m][1];
                    pg8::u32x4 w; w.x = pg8::cvt_pk_bf16(a[0], a[1]); w.y = pg8::cvt_pk_bf16(a[2], a[3]); w.z = pg8::cvt_pk_bf16(b[0], b[1]); w.w = pg8::cvt_pk_bf16(b[2], b[3]);
                    *(pg8::u32x4*)(qp + ((((size_t)((row >> 5) * 8 + u.pn) * 2 + bj) * 8 + 2 * wc + (fq >> 1)) * 64 + (row & 31) + 32 * (fq & 1)) * 8) = w;
                }
            }
    }
};

typedef float f32x2v __attribute__((ext_vector_type(2)));
typedef __bf16 bf16x2v __attribute__((ext_vector_type(2)));
__device__ __forceinline__ unsigned cvtpk(float lo, float hi) { const f32x2v v = {lo, hi}; const bf16x2v b = __builtin_convertvector(v, bf16x2v); return __builtin_bit_cast(unsigned, b); }
__device__ __forceinline__ bf16x8 pack_step(const f32x16& x, int s) {
    u32x4 pkd; pkd.x = cvtpk(x[8 * s], x[8 * s + 1]); pkd.y = cvtpk(x[8 * s + 2], x[8 * s + 3]); pkd.z = cvtpk(x[8 * s + 4], x[8 * s + 5]); pkd.w = cvtpk(x[8 * s + 6], x[8 * s + 7]);
    return __builtin_bit_cast(bf16x8, pkd);
}
#define MFMA32(a, b, c) __builtin_amdgcn_mfma_f32_32x32x16_bf16((a), (b), (c), 0, 0, 0)
__device__ __forceinline__ void ph_attn(const Params& p) {
    unsigned char* ws = p.ws;
    const bf16_t* qh = (const bf16_t*)(ws + WS_QH); const bf16_t* kh = (const bf16_t*)(ws + WS_KH); const bf16_t* vT = (const bf16_t*)(ws + WS_VH);
    bf16_t* mixo = (bf16_t*)(ws + WS_MIX); float* ssb = (float*)(ws + WS_SSB);
    const int tid = phase_tid(), lane = tid & 63, r = lane & 31, hh = lane >> 5;
    const int gwave = (blockIdx.x * blockDim.x + tid) >> 6, nwave = (gridDim.x * blockDim.x) >> 6;
    bf16x8 tp[2];
#pragma unroll
    for (int ss = 0; ss < 2; ++ss)
#pragma unroll
        for (int e = 0; e < 8; ++e) { const int k = 16 * ss + 8 * (e >> 2) + 4 * hh + (e & 3); tp[ss][e] = (k > r) ? (short)0x3F80 : (short)0; }
    f32x16 zero16;
#pragma unroll
    for (int i = 0; i < 16; ++i) zero16[i] = 0.f;
    for (int u = gwave; u < NH * (S / 32); u += nwave) {
        const int h = u / (S / 32), t0 = (u % (S / 32)) * 32;
        bf16x8 bq[4];
#pragma unroll
        for (int s = 0; s < 4; ++s) bq[s] = *(const bf16x8*)(qh + (((size_t)(h * (S / 32) + (t0 >> 5)) * 4 + s) * 64 + lane) * 8);
        f32x16 ot[2] = {zero16, zero16};
        float carry = 0.f;
        for (int kt0 = t0; kt0 >= 0; kt0 -= 32) {
            bf16x8 ak[4], av[2][2];
#pragma unroll
            for (int s = 0; s < 4; ++s) ak[s] = *(const bf16x8*)(kh + (((size_t)(h * (S / 32) + (kt0 >> 5)) * 4 + s) * 64 + lane) * 8);
#pragma unroll
            for (int dt = 0; dt < 2; ++dt)
#pragma unroll
                for (int ss = 0; ss < 2; ++ss) av[dt][ss] = *(const bf16x8*)(vT + ((((size_t)(h * (S / 32) + (kt0 >> 5)) * 2 + dt) * 2 + ss) * 64 + lane) * 8);
            f32x16 st = zero16;
#pragma unroll
            for (int s = 0; s < 4; ++s) st = MFMA32(ak[s], bq[s], st);
            const bool diag = (kt0 == t0);
            f32x16 lom, lb;
            float csum = 0.f;
#pragma unroll
            for (int i = 0; i < 16; ++i) {
                const float z = st[i];
                const float sp2 = fmaxf(z, 0.f) + __builtin_amdgcn_logf(1.0f + __builtin_amdgcn_exp2f(-fabsf(z)));
                const bool valid = !diag || ((i & 3) + 8 * (i >> 2) + 4 * hh < r);
                lom[i] = valid ? -sp2 : 0.f;
                lb[i] = z - sp2;
                csum += lom[i];
            }
            f32x16 suf = MFMA32(tp[0], pack_step(lom, 0), zero16);
            suf = MFMA32(tp[1], pack_step(lom, 1), suf);
            f32x16 w;
#pragma unroll
            for (int i = 0; i < 16; ++i) {
                const bool valid = !diag || ((i & 3) + 8 * (i >> 2) + 4 * hh < r);
                w[i] = valid ? __builtin_amdgcn_exp2f(lb[i] + suf[i] + carry) : 0.f;
            }
            const bf16x8 w0 = pack_step(w, 0), w1 = pack_step(w, 1);
#pragma unroll
            for (int dt = 0; dt < 2; ++dt) { ot[dt] = MFMA32(av[dt][0], w0, ot[dt]); ot[dt] = MFMA32(av[dt][1], w1, ot[dt]); }
            carry += csum + __shfl_xor(csum, 32);
            if (__all(carry < CARRY_STOP)) break;
        }
        float oss = 0.f;
#pragma unroll
        for (int dt = 0; dt < 2; ++dt)
#pragma unroll
            for (int g = 0; g < 4; ++g) {
                uint2 o; o.x = cvtpk(ot[dt][4 * g], ot[dt][4 * g + 1]); o.y = cvtpk(ot[dt][4 * g + 2], ot[dt][4 * g + 3]);
                oss += (ot[dt][4 * g] * ot[dt][4 * g] + ot[dt][4 * g + 1] * ot[dt][4 * g + 1]) + (ot[dt][4 * g + 2] * ot[dt][4 * g + 2] + ot[dt][4 * g + 3] * ot[dt][4 * g + 3]);
                *(uint2*)(mixo + (size_t)(t0 + r) * D + h * HD + 32 * dt + 8 * g + 4 * hh) = o;
            }
        oss += __shfl_xor(oss, 32);
        if (hh == 0) ssb[(size_t)(t0 + r) * NH + h] = oss;
    }
}

constexpr int RG_LDS_CST = 0, RG_LDS_HIN = 16384, RG_LDS_P = 18432, RG_LDS_SSQ = 20480;
constexpr int RG_LDS_X = 22528, RG_XP = 1032, RG_LDS_O = 91904;
typedef unsigned u32x2 __attribute__((ext_vector_type(2)));
typedef __attribute__((address_space(3))) float lds_f;
typedef __attribute__((address_space(3))) unsigned char lds_b;
template <int CTRL, int ROWMASK>
__device__ __forceinline__ float dpp_mov(float oob, float x) {
    return __builtin_bit_cast(float, __builtin_amdgcn_update_dpp(__builtin_bit_cast(int, oob), __builtin_bit_cast(int, x), CTRL, ROWMASK, 0xf, false));
}
template <int CTRL, int ROWMASK>
__device__ __forceinline__ void scan_step(float (&av)[16], float (&bv)[16]) {
#pragma unroll
    for (int i = 0; i < 16; ++i) {
        const float ap = dpp_mov<CTRL, ROWMASK>(1.0f, av[i]), bp = dpp_mov<CTRL, ROWMASK>(0.0f, bv[i]);
        bv[i] = __builtin_fmaf(av[i], bp, bv[i]); av[i] *= ap;
    }
}
template <int PASS>
__device__ __forceinline__ void ph_rg(const Params& p, unsigned char* lds_raw) {
    float* lds = (float*)lds_raw;
    unsigned char* ws = p.ws;
    const bf16_t* xrg = (const bf16_t*)(ws + WS_XRG); const bf16_t* gg = (const bf16_t*)(ws + WS_GG); const bf16_t* wfrag = (const bf16_t*)(ws + WS_RGW);
    bf16_t* mix = (bf16_t*)(ws + WS_MIX);
    float* rgP = (float*)(ws + WS_RGP); float* rgH = (float*)(ws + WS_RGH);
    bf16_t* scA = (bf16_t*)(ws + WS_RGSA); bf16_t* scB = (bf16_t*)(ws + WS_RGSB);
    const int tid = phase_tid(), lane = tid & 63, r = lane & 31, hh = lane >> 5, n = __builtin_amdgcn_readfirstlane(tid >> 6);
    __syncthreads();
    if (PASS == 0) for (int e = tid; e < 8 * 2 * 8 * 32; e += NTHR) {
        const int q = e & 31, k = (e >> 5) & 7, h2 = (e >> 8) & 1, nn = e >> 9;
        const int c = 64 * nn + 32 * (q >> 4) + (q & 3) + 8 * ((q >> 2) & 3) + 4 * h2;
        float v;
        if (k < 4) v = p.in[I_CONV_W][k * DRG + c];
        else if (k == 4) v = p.in[I_CONV_B][c];
        else if (k == 5) v = p.in[I_RG_B_A][c];
        else if (k == 6) v = p.in[I_RG_B_X][c];
        else v = 8.0f * LOG2E * log1pf(__expf(-p.in[I_RG_LAMBDA][c]));
        lds[e] = v;
    }
    const unsigned lds0 = (unsigned)(size_t)((lds_b*)lds_raw);
    const unsigned cst_base = lds0 + (unsigned)((n * 2 + hh) * 1024);
    lds_f* hin_l = (lds_f*)(size_t)(lds0 + RG_LDS_HIN + (n * 2 + hh) * 128);
    lds_f* pc_l = (lds_f*)(size_t)(lds0 + RG_LDS_P + (n * 2 + hh) * 128);
    lds_b* xt = (lds_b*)(size_t)(lds0 + RG_LDS_X);
    lds_b* ot = (lds_b*)(size_t)(lds0 + RG_LDS_O);
    f32x16 zero16;
#pragma unroll
    for (int i = 0; i < 16; ++i) zero16[i] = 0.f;
    for (int ch = blockIdx.x; ch < NCHUNK; ch += gridDim.x) {
        const int t0 = ch * CHUNK;
        constexpr int NXS = ((CHUNK + 3) * 64 + NTHR - 1) / NTHR;
        u32x4 xs[PASS == 0 ? NXS : 1];
        if (PASS == 0) {
#pragma unroll
            for (int j = 0; j < NXS; ++j) {
                const int ci = tid + NTHR * j, row = ci >> 6, c16 = ci & 63, tt = t0 - 3 + row;
                xs[j] = (u32x4){0u, 0u, 0u, 0u};
                if (ci < (CHUNK + 3) * 64 && tt >= 0) xs[j] = *(const u32x4*)(xrg + (size_t)tt * DRG + 8 * c16);
            }
            __builtin_amdgcn_sched_barrier(0);
        }
        __syncthreads();
        if (PASS == 0) {
#pragma unroll
            for (int j = 0; j < NXS; ++j) {
                const int ci = tid + NTHR * j, row = ci >> 6, c16 = ci & 63;
                if (ci < (CHUNK + 3) * 64) {
                    __attribute__((address_space(3))) u32x2* d = (__attribute__((address_space(3))) u32x2*)(xt + row * RG_XP + 16 * c16);
                    d[0] = (u32x2){xs[j].x, xs[j].y}; d[1] = (u32x2){xs[j].z, xs[j].w};
                }
            }
        }
        if (PASS == 1) {
            const int c = 64 * n + lane;
            float h = 0.f;
            int k = 0;
            for (; k + 32 <= ch; k += 32) {
                float pv[32], hv[32];
#pragma unroll
                for (int j = 0; j < 32; ++j) { pv[j] = rgP[(k + j) * DRG + c]; hv[j] = rgH[(k + j) * DRG + c]; }
#pragma unroll
                for (int j = 0; j < 32; ++j) h = pv[j] * h + hv[j];
            }
            for (; k + 8 <= ch; k += 8) {
                float pv[8], hv[8];
#pragma unroll
                for (int j = 0; j < 8; ++j) { pv[j] = rgP[(k + j) * DRG + c]; hv[j] = rgH[(k + j) * DRG + c]; }
#pragma unroll
                for (int j = 0; j < 8; ++j) h = pv[j] * h + hv[j];
            }
            for (; k < ch; ++k) h = rgP[k * DRG + c] * h + rgH[k * DRG + c];
            lds[RG_LDS_HIN / 4 + (n * 2 + ((lane >> 2) & 1)) * 32 + 16 * (lane >> 5) + 4 * ((lane >> 3) & 3) + (lane & 3)] = h;
        } else {
            if (r == 0) {
#pragma unroll
                for (int q = 0; q < 32; ++q) { hin_l[q] = 0.f; pc_l[q] = 1.f; }
            }
        }
        __syncthreads();
#pragma unroll 1
        for (int tl = 0; tl < 2; ++tl) {
            const int tok = t0 + 32 * tl + r;
            unsigned cst_a = cst_base; asm volatile("" : "+v"(cst_a));
            const lds_f* cst = (const lds_f*)(size_t)cst_a;
            float xcv[32]; bf16x8 bx[4];
            if (PASS == 0) {
#pragma unroll
            for (int q = 0; q < 32; ++q) xcv[q] = cst[4 * 32 + q];
#pragma unroll
            for (int k = 0; k < 4; ++k) {
                const lds_b* xr = xt + (32 * tl + r + k) * RG_XP + (64 * n + 4 * hh) * 2;
#pragma unroll
                for (int m = 0; m < 8; ++m) {
                    const u32x2 xw = *(const __attribute__((address_space(3))) u32x2*)(xr + 16 * m);
                    xcv[4 * m + 0] += cst[k * 32 + 4 * m + 0] * bf2f(xw.x & 0xffffu); xcv[4 * m + 1] += cst[k * 32 + 4 * m + 1] * bf2f(xw.x >> 16);
                    xcv[4 * m + 2] += cst[k * 32 + 4 * m + 2] * bf2f(xw.y & 0xffffu); xcv[4 * m + 3] += cst[k * 32 + 4 * m + 3] * bf2f(xw.y >> 16);
                }
                __builtin_amdgcn_sched_barrier(0);
            }
#pragma unroll
            for (int s = 0; s < 4; ++s) {
                u32x4 pk; pk.x = cvtpk(xcv[8 * s], xcv[8 * s + 1]); pk.y = cvtpk(xcv[8 * s + 2], xcv[8 * s + 3]); pk.z = cvtpk(xcv[8 * s + 4], xcv[8 * s + 5]); pk.w = cvtpk(xcv[8 * s + 6], xcv[8 * s + 7]);
                bx[s] = __builtin_bit_cast(bf16x8, pk);
            }
            }
            float ss = 0.f;
            u32x4 psc[PASS == 1 ? 2 : 1][4]; uint2 pgg[PASS == 1 ? 2 : 1][4];
            if (PASS == 1) {
#pragma unroll
                for (int jt = 0; jt < 2; ++jt) {
                    const size_t sco = ((((size_t)(2 * ch + tl) * 8 + n) * 2 + jt) * 64 + lane) * 16;
                    psc[jt][0] = *(const u32x4*)(scA + sco); psc[jt][1] = *(const u32x4*)(scA + sco + 8); psc[jt][2] = *(const u32x4*)(scB + sco); psc[jt][3] = *(const u32x4*)(scB + sco + 8);
#pragma unroll
                    for (int g4 = 0; g4 < 4; ++g4) pgg[jt][g4] = *(const uint2*)(gg + ((((size_t)(tok >> 5) * 8 + n) * 8 + (4 * jt + g4)) * 64 + lane) * 4);
                }
                __builtin_amdgcn_sched_barrier(0);
            }
            const bf16_t* wb = wfrag + ((size_t)n * 16 * 64 + lane) * 8; asm volatile("" : "+v"(wb));
#pragma unroll
            for (int jt = 0; jt < 2; ++jt) {
                float av[16], bv[16];
                const size_t sco = ((((size_t)(2 * ch + tl) * 8 + n) * 2 + jt) * 64 + lane) * 16;
                if (PASS == 0) {
#pragma unroll
                for (int g = 0; g < 2; ++g) {
                    f32x16 acc = zero16;
#pragma unroll
                    for (int s = 0; s < 4; ++s) {
                        const bf16x8 aw = *(const __attribute__((address_space(1))) bf16x8*)(wb + (((g * 2 + jt) * 4 + s) * 64) * 8);
                        acc = MFMA32(aw, bx[s], acc);
                    }
#pragma unroll
                    for (int i = 0; i < 16; ++i) {
                        const int q = 16 * jt + i;
                        const float pre = acc[i] + cst[(5 + g) * 32 + q];
                        const float sg = 1.0f / (1.0f + __builtin_amdgcn_exp2f(-LOG2E * pre));
                        if (g == 0) av[i] = __builtin_amdgcn_exp2f(-sg * cst[7 * 32 + q]);
                        else bv[i] = __builtin_amdgcn_sqrtf(fmaxf(__builtin_fmaf(-av[i], av[i], 1.0f), 0.f)) * (sg * xcv[q]);
                    }
                    __builtin_amdgcn_sched_barrier(0);
                }
                scan_step<0x111, 0xf>(av, bv); scan_step<0x112, 0xf>(av, bv); scan_step<0x114, 0xf>(av, bv); scan_step<0x118, 0xf>(av, bv);
                scan_step<0x142, 0xa>(av, bv);
                u32x4 sa0, sa1, sb0, sb1;
                sa0.x = cvtpk(av[0], av[1]); sa0.y = cvtpk(av[2], av[3]); sa0.z = cvtpk(av[4], av[5]); sa0.w = cvtpk(av[6], av[7]); sa1.x = cvtpk(av[8], av[9]); sa1.y = cvtpk(av[10], av[11]); sa1.z = cvtpk(av[12], av[13]); sa1.w = cvtpk(av[14], av[15]);
                sb0.x = cvtpk(bv[0], bv[1]); sb0.y = cvtpk(bv[2], bv[3]); sb0.z = cvtpk(bv[4], bv[5]); sb0.w = cvtpk(bv[6], bv[7]); sb1.x = cvtpk(bv[8], bv[9]); sb1.y = cvtpk(bv[10], bv[11]); sb1.z = cvtpk(bv[12], bv[13]); sb1.w = cvtpk(bv[14], bv[15]);
                *(u32x4*)(scA + sco) = sa0; *(u32x4*)(scA + sco + 8) = sa1; *(u32x4*)(scB + sco) = sb0; *(u32x4*)(scB + sco + 8) = sb1;
                } else {
                    const u32x4 sa0 = psc[jt][0], sa1 = psc[jt][1], sb0 = psc[jt][2], sb1 = psc[jt][3];
                    const unsigned wa[8] = {sa0.x, sa0.y, sa0.z, sa0.w, sa1.x, sa1.y, sa1.z, sa1.w}, wbb[8] = {sb0.x, sb0.y, sb0.z, sb0.w, sb1.x, sb1.y, sb1.z, sb1.w};
#pragma unroll
                    for (int k = 0; k < 8; ++k) { av[2 * k] = bf2f(wa[k] & 0xffffu); av[2 * k + 1] = bf2f(wa[k] >> 16); bv[2 * k] = bf2f(wbb[k] & 0xffffu); bv[2 * k + 1] = bf2f(wbb[k] >> 16); }
                }
                __builtin_amdgcn_sched_barrier(0);
#pragma unroll
                for (int i = 0; i < 16; ++i) {
                    const int q = 16 * jt + i;
                    const float h = __builtin_fmaf(av[i], hin_l[q], bv[i]);
                    if (r == 31) { hin_l[q] = h; if (PASS == 0) pc_l[q] *= av[i]; }
                    bv[i] = h;
                }
                if (PASS == 1) {
#pragma unroll
                    for (int g4 = 0; g4 < 4; ++g4) {
                        const int m = 4 * jt + g4;
                        const uint2 gw = pgg[jt][g4];
                        const float o0 = bv[4 * g4] * bf2f(gw.x & 0xffffu), o1 = bv[4 * g4 + 1] * bf2f(gw.x >> 16), o2 = bv[4 * g4 + 2] * bf2f(gw.y & 0xffffu), o3 = bv[4 * g4 + 3] * bf2f(gw.y >> 16);
                        ss += (o0 * o0 + o1 * o1) + (o2 * o2 + o3 * o3);
                        *(__attribute__((address_space(3))) u32x2*)(ot + (32 * tl + r) * RG_XP + (64 * n + 8 * m + 4 * hh) * 2) = (u32x2){cvtpk(o0, o1), cvtpk(o2, o3)};
                    }
                }
                __builtin_amdgcn_sched_barrier(0);
            }
            if (PASS == 1) { ss += __shfl_xor(ss, 32); if (hh == 0) lds[RG_LDS_SSQ / 4 + (tl * 8 + n) * 32 + r] = ss; }
        }
        if (PASS == 0) {
            if (r == 0) {
#pragma unroll
                for (int m = 0; m < 8; ++m) {
                    const int c = 64 * n + 8 * m + 4 * hh;
                    *(f32x4*)(rgP + (size_t)ch * DRG + c) = (f32x4){pc_l[4 * m], pc_l[4 * m + 1], pc_l[4 * m + 2], pc_l[4 * m + 3]};
                    *(f32x4*)(rgH + (size_t)ch * DRG + c) = (f32x4){hin_l[4 * m], hin_l[4 * m + 1], hin_l[4 * m + 2], hin_l[4 * m + 3]};
                }
            }
        } else {
            __syncthreads();
            for (int j = 0; j < 8; ++j) {
                const int tr = 8 * n + j, tok = t0 + tr;
                float tot = 0.f;
#pragma unroll
                for (int w = 0; w < 8; ++w) tot += lds[RG_LDS_SSQ / 4 + ((tr >> 5) * 8 + w) * 32 + (tr & 31)];
                const float rn = rsqrtf(tot * (1.0f / DRG) + EPS);
                const __attribute__((address_space(3))) u32x2* op = (const __attribute__((address_space(3))) u32x2*)(ot + tr * RG_XP + 16 * lane);
                const u32x2 w0 = op[0], w1 = op[1];
                u32x4 o2; o2.x = cvtpk(bf2f(w0.x & 0xffffu) * rn, bf2f(w0.x >> 16) * rn); o2.y = cvtpk(bf2f(w0.y & 0xffffu) * rn, bf2f(w0.y >> 16) * rn);
                o2.z = cvtpk(bf2f(w1.x & 0xffffu) * rn, bf2f(w1.x >> 16) * rn); o2.w = cvtpk(bf2f(w1.y & 0xffffu) * rn, bf2f(w1.y >> 16) * rn);
                *((u32x4*)(mix + (size_t)tok * D + DSB) + lane) = o2;
            }
            if (tid < CHUNK) {
                const f32x4 s0 = *(const f32x4*)(ws + WS_SSB + (size_t)(t0 + tid) * NH * 4), s1 = *(const f32x4*)(ws + WS_SSB + (size_t)(t0 + tid) * NH * 4 + 16);
                ((float*)(ws + WS_RSB))[t0 + tid] = rsqrtf(((s0.x + s0.y) + (s0.z + s0.w) + (s1.x + s1.y) + (s1.z + s1.w)) * (1.0f / DSB) + EPS);
            }
        }
    }
}

__device__ __forceinline__ float kmax(float a, float b) { float r; asm("v_max_f32 %0, %1, %2" : "=v"(r) : "v"(a), "v"(b)); return r; }
__device__ __forceinline__ float kmin(float a, float b) { float r; asm("v_min_f32 %0, %1, %2" : "=v"(r) : "v"(a), "v"(b)); return r; }
__device__ __forceinline__ float key_tag(float f, unsigned keep, unsigned tag) { return __builtin_bit_cast(float, (__builtin_bit_cast(unsigned, f) & keep) | tag); }
#define TOPK_CE(a, b) do { const float hi_ = kmax(a, b), lo_ = kmin(a, b); a = hi_; b = lo_; } while (0)
__device__ __forceinline__ void sort16_desc(float (&v)[16]) { TOPK_CE(v[0], v[1]); TOPK_CE(v[2], v[3]); TOPK_CE(v[0], v[2]); TOPK_CE(v[1], v[3]); TOPK_CE(v[1], v[2]); TOPK_CE(v[4], v[5]); TOPK_CE(v[6], v[7]); TOPK_CE(v[4], v[6]); TOPK_CE(v[5], v[7]); TOPK_CE(v[5], v[6]); TOPK_CE(v[0], v[4]); TOPK_CE(v[2], v[6]); TOPK_CE(v[2], v[4]); TOPK_CE(v[1], v[5]); TOPK_CE(v[3], v[7]); TOPK_CE(v[3], v[5]); TOPK_CE(v[1], v[2]); TOPK_CE(v[3], v[4]); TOPK_CE(v[5], v[6]); TOPK_CE(v[8], v[9]); TOPK_CE(v[10], v[11]); TOPK_CE(v[8], v[10]); TOPK_CE(v[9], v[11]); TOPK_CE(v[9], v[10]); TOPK_CE(v[12], v[13]); TOPK_CE(v[14], v[15]); TOPK_CE(v[12], v[14]); TOPK_CE(v[13], v[15]); TOPK_CE(v[13], v[14]); TOPK_CE(v[8], v[12]); TOPK_CE(v[10], v[14]); TOPK_CE(v[10], v[12]); TOPK_CE(v[9], v[13]); TOPK_CE(v[11], v[15]); TOPK_CE(v[11], v[13]); TOPK_CE(v[9], v[10]); TOPK_CE(v[11], v[12]); TOPK_CE(v[13], v[14]); TOPK_CE(v[0], v[8]); TOPK_CE(v[4], v[12]); TOPK_CE(v[4], v[8]); TOPK_CE(v[2], v[10]); TOPK_CE(v[6], v[14]); TOPK_CE(v[6], v[10]); TOPK_CE(v[2], v[4]); TOPK_CE(v[6], v[8]); TOPK_CE(v[10], v[12]); TOPK_CE(v[1], v[9]); TOPK_CE(v[5], v[13]); TOPK_CE(v[5], v[9]); TOPK_CE(v[3], v[11]); TOPK_CE(v[7], v[15]); TOPK_CE(v[7], v[11]); TOPK_CE(v[3], v[5]); TOPK_CE(v[7], v[9]); TOPK_CE(v[11], v[13]); TOPK_CE(v[1], v[2]); TOPK_CE(v[3], v[4]); TOPK_CE(v[5], v[6]); TOPK_CE(v[7], v[8]); TOPK_CE(v[9], v[10]); TOPK_CE(v[11], v[12]); TOPK_CE(v[13], v[14]); }
__device__ __forceinline__ void merge16_desc(float (&a)[16], const float (&b)[16]) {
#pragma unroll
    for (int i = 0; i < 16; ++i) a[i] = kmax(a[i], b[15 - i]);
#pragma unroll
    for (int d = 8; d >= 1; d >>= 1)
#pragma unroll
        for (int i = 0; i < 16; ++i) if ((i & d) == 0) TOPK_CE(a[i], a[i + d]);
}
__device__ __forceinline__ void ph_topk(const Params& p, int* lds) {
    unsigned char* ws = p.ws;
    const bf16_t* qp = (const bf16_t*)(ws + WS_B); const bf16_t* subk = (const bf16_t*)(ws + WS_SUBK);
    int* seli = (int*)(ws + WS_SELI); float* selg = (float*)(ws + WS_SELG);
    const float* ssq = (const float*)(ws + WS_SSQ); float* rstd2 = (float*)(ws + WS_RSTD2);
    const int tid = phase_tid(), lane = tid & 63, r = lane & 31, hh = lane >> 5, hx = 4 * hh;
    const int gwave = (blockIdx.x * blockDim.x + tid) >> 6, nwave = (gridDim.x * blockDim.x) >> 6;
    constexpr int SK_OFF = 65536, SK_PITCH = 272;
    typedef __attribute__((address_space(3))) unsigned char lds_b;
    lds_b* skl = (lds_b*)lds + SK_OFF;
    const int w = tid >> 6;
    pg8::StaticOrder so; so.init(S, NQ, (int)gridDim.x, (int)blockIdx.x);
    pg8::Unit gu;
    for (int ui = 0; so.next(ui, gu); ++ui) {
        const int h = gu.pn, t0 = gu.pm * 256 + 32 * w, t = t0 + r;
        u32x4 skv[8]; bf16x8 bq[2][8];
#pragma unroll
        for (int j = 0; j < 8; ++j) {
            const int ci = tid + NTHR * j, row = ci >> 4, c16 = ci & 15;
            skv[j] = *(const u32x4*)(subk + ((size_t)h * 256 + row) * PHALF + 8 * c16);
        }
#pragma unroll
        for (int pp = 0; pp < 2; ++pp)
#pragma unroll
            for (int s = 0; s < 8; ++s) bq[pp][s] = *(const bf16x8*)(qp + ((((size_t)((t0 >> 5) * 8 + h) * 2 + pp) * 8 + s) * 64 + lane) * 8);
        __builtin_amdgcn_sched_barrier(0);
        __syncthreads();
#pragma unroll
        for (int j = 0; j < 8; ++j) {
            const int ci = tid + NTHR * j, row = ci >> 4, c16 = ci & 15;
            *(__attribute__((address_space(3))) u32x4*)(skl + row * SK_PITCH + 16 * c16) = skv[j];
        }
        __syncthreads();
        float tk[2][16];
#pragma unroll
        for (int pp = 0; pp < 2; ++pp) {
            f32x16 acc[4];
#pragma unroll
            for (int T = 0; T < 4; ++T)
#pragma unroll
                for (int i = 0; i < 16; ++i) acc[T][i] = 0.f;
            const lds_b* krow = skl + (pp * PNK + r) * SK_PITCH + 16 * hh;
#pragma unroll
            for (int s = 0; s < 8; ++s) {
                const bf16x8 b = bq[pp][s];
#pragma unroll
                for (int T = 0; T < 4; ++T) {
                    const bf16x8 a = *(const __attribute__((address_space(3))) bf16x8*)(krow + (32 * T) * SK_PITCH + 32 * s);
                    acc[T] = __builtin_amdgcn_mfma_f32_32x32x16_bf16(a, b, acc[T], 0, 0, 0);
                }
            }
            float kq[4][16];
#pragma unroll
            for (int T = 0; T < 4; ++T) {
#pragma unroll
                for (int i = 0; i < 16; ++i) {
                    const int nb = 32 * T + (i & 3) + 8 * (i >> 2);
                    kq[T][i] = key_tag(acc[T][i], ~127u, (unsigned)(127 - nb));
                }
                sort16_desc(kq[T]);
            }
            merge16_desc(kq[0], kq[1]); merge16_desc(kq[2], kq[3]); merge16_desc(kq[0], kq[2]);
            float m[16], po[16];
#pragma unroll
            for (int i = 0; i < 16; ++i) { m[i] = __builtin_bit_cast(float, __builtin_bit_cast(int, kq[0][i]) ^ hx); po[i] = __shfl_xor(m[i], 32); }
            merge16_desc(m, po);
#pragma unroll
            for (int i = 0; i < 16; ++i) tk[pp][i] = m[i];
        }
#pragma unroll
        for (int i = 0; i < 16; ++i) { lds[i * NTHR + tid] = __builtin_bit_cast(int, tk[0][i]); lds[(16 + i) * NTHR + tid] = __builtin_bit_cast(int, tk[1][i]); }
        const float (&v0)[16] = tk[0]; const float (&v1)[16] = tk[1];
#define CKEY(a, b) key_tag(v0[a] + v1[b], ~255u, (unsigned)(255 - ((a) * 16 + (b))))
        const float NEGK = __builtin_bit_cast(float, 0xff800000u);
        float bk[16], l1[16], ga[16], gb[16];
#pragma unroll
        for (int b = 0; b < 16; ++b) bk[b] = CKEY(0, b);
#pragma unroll
        for (int b = 0; b < 16; ++b) l1[b] = b < 8 ? CKEY(1, b) : NEGK;
        ga[0] = CKEY(2, 0); ga[1] = CKEY(2, 1); ga[2] = CKEY(2, 2); ga[3] = CKEY(2, 3); ga[4] = CKEY(2, 4);
        ga[5] = CKEY(3, 0); ga[6] = CKEY(3, 1); ga[7] = CKEY(3, 2); ga[8] = CKEY(3, 3);
        ga[9] = CKEY(4, 0); ga[10] = CKEY(4, 1); ga[11] = CKEY(4, 2); ga[12] = CKEY(5, 0); ga[13] = CKEY(5, 1); ga[14] = NEGK; ga[15] = NEGK;
        gb[0] = CKEY(6, 0); gb[1] = CKEY(6, 1); gb[2] = CKEY(7, 0); gb[3] = CKEY(7, 1);
#pragma unroll
        for (int a = 8; a < 16; ++a) gb[a - 4] = CKEY(a, 0);
        gb[12] = NEGK; gb[13] = NEGK; gb[14] = NEGK; gb[15] = NEGK;
#undef CKEY
        sort16_desc(ga); sort16_desc(gb);
        merge16_desc(bk, l1); merge16_desc(ga, gb); merge16_desc(bk, ga);
        float ssum = 0.f;
#pragma unroll
        for (int i = 0; i < 4; ++i) { const f32x4 q4 = *(const f32x4*)(ssq + (size_t)t * 16 + 4 * i); ssum += (q4.x + q4.y) + (q4.z + q4.w); }
        const float rs = rsqrtf(ssum * (1.0f / D) + EPS);
        float e[16], sum = 0.f; const float mx = bk[0];
#pragma unroll
        for (int i = 0; i < 16; ++i) { e[i] = __expf((bk[i] - mx) * rs); sum += e[i]; }
        const float inv = 1.0f / sum;
        int eidx[16];
#pragma unroll
        for (int i = 0; i < 16; ++i) {
            const int code = 255 - (__builtin_bit_cast(int, bk[i]) & 255), a = code >> 4, b = code & 15;
            const int i1 = 127 - (lds[a * NTHR + tid] & 127), i2 = 127 - (lds[(16 + b) * NTHR + tid] & 127);
            eidx[i] = i1 * PNK + i2; e[i] *= inv;
        }
        if (hh == 0) {
            int4* o = (int4*)(seli + (size_t)t * 128 + h * 16);
#pragma unroll
            for (int i = 0; i < 4; ++i) o[i] = make_int4(eidx[4 * i], eidx[4 * i + 1], eidx[4 * i + 2], eidx[4 * i + 3]);
            if (h == 0) rstd2[t] = rs;
        } else {
            f32x4* o = (f32x4*)(selg + (size_t)t * 128 + h * 16);
#pragma unroll
            for (int i = 0; i < 4; ++i) o[i] = (f32x4){e[4 * i], e[4 * i + 1], e[4 * i + 2], e[4 * i + 3]};
        }
    }
}

typedef __bf16 bf16x2_t __attribute__((ext_vector_type(2)));
typedef float f32x2 __attribute__((ext_vector_type(2)));
template <int NV, int XS0, int XS1, int XS2>
__device__ __forceinline__ void reduce_over8(float (&v)[NV], int sel) {
    { const bool up = sel & 1;
#pragma unroll
      for (int i = 0; i < NV / 2; ++i) { const float a = v[2 * i], b = v[2 * i + 1]; v[i] = (up ? b : a) + __shfl_xor(up ? a : b, XS0); } }
    { const bool up = (sel >> 1) & 1;
#pragma unroll
      for (int i = 0; i < NV / 4; ++i) { const float a = v[2 * i], b = v[2 * i + 1]; v[i] = (up ? b : a) + __shfl_xor(up ? a : b, XS1); } }
    { const bool up = (sel >> 2) & 1;
#pragma unroll
      for (int i = 0; i < NV / 8; ++i) { const float a = v[2 * i], b = v[2 * i + 1]; v[i] = (up ? b : a) + __shfl_xor(up ? a : b, XS2); } }
}
__device__ __forceinline__ void peer_load_idx(const unsigned char* ws, int t, int rsl, int (&ei)[16]) {
    const unsigned off = (unsigned)WS_SELI + ((unsigned)t * 128u + 16u * (unsigned)rsl) * 4u;
#pragma unroll
    for (int j = 0; j < 4; ++j) { const int4 v = *(const int4*)(ws + (off + 16u * j)); ei[4 * j] = v.x; ei[4 * j + 1] = v.y; ei[4 * j + 2] = v.z; ei[4 * j + 3] = v.w; }
}
template <int PASS>
__device__ __forceinline__ void peer_load_rows(const unsigned char* ws, int t, int sl, int rsl, int c, const int (&ei)[16], u32x4 (&row)[16], u32x4 (&aux)[4]) {
    const unsigned tab = (unsigned)(PASS == 0 ? WS_UB : WS_VB) + (unsigned)sl * (unsigned)(NEXP * 128) + 16u * (unsigned)c;
#pragma unroll
    for (int i = 0; i < 16; ++i) row[i] = *(const u32x4*)(ws + (tab + (unsigned)ei[i] * 128u));
    const unsigned xo = (unsigned)WS_X1Q + (unsigned)t * (unsigned)D + 256u * sl + 32u * c;
    aux[0] = *(const u32x4*)(ws + xo); aux[1] = *(const u32x4*)(ws + (xo + 16u));
    aux[2].x = *(const unsigned*)(ws + ((unsigned)WS_XSC + ((unsigned)t * 32u + 8u * sl + c) * 4u));
}
constexpr int PEER_IMG_PITCH = 136, PEER_IMG_BYTES = 128 * PEER_IMG_PITCH;
template <int PASS  >
__device__ __forceinline__ void peer_compute(const Params& p, unsigned char* lds, int lane_w, int t, int sl, int rsl, int c, const u32x4 (&row)[16], const u32x4 (&aux)[4]) {
    unsigned char* ws = p.ws;
    if (PASS == 0) {
        const u32x4 x0 = aux[0], x1_ = aux[1]; const unsigned xl[4] = {x0.x, x0.y, x0.z, x0.w}, xh[4] = {x1_.x, x1_.y, x1_.z, x1_.w};
        const unsigned xsu = aux[2].x; const float xs = u2f(xsu);
        float pd[16];
#pragma unroll
        for (int i = 0; i < 16; ++i) {
            const u32x4 rw = row[i]; const unsigned w4[4] = {rw.x, rw.y, rw.z, rw.w};
            int al = 0, ah = 0;
#pragma unroll
            for (int j = 0; j < 4; ++j) { al = __builtin_amdgcn_sdot8((int)w4[j], (int)xl[j], al, false); ah = __builtin_amdgcn_sdot8((int)w4[j], (int)xh[j], ah, false); }
            pd[i] = (float)(16 * ah + al) * xs;
        }
        reduce_over8<16, 1, 2, 4>(pd, c);
        const unsigned po = (unsigned)WS_PD + (((unsigned)sl * S + (unsigned)t) * 128u + 16u * rsl + c) * 4u;
        *(float*)(ws + po) = pd[0]; *(float*)(ws + (po + 32u)) = pd[1];
    }
}
template <int PASS>
__device__ __forceinline__ void peer_stream(const Params& p, unsigned char* lds, int lane_w, int sl, int t0, int dt, int n) {
    const unsigned char* ws = p.ws;
    const int lane = lane_w & 63, rsl = lane >> 3, c = lane & 7;
    int eiA[16], eiB[16]; u32x4 rowA[16], rowB[16], auxA[4], auxB[4];
    if (n <= 0) return;
    peer_load_idx(ws, t0, rsl, eiA);
    peer_load_rows<PASS>(ws, t0, sl, rsl, c, eiA, rowA, auxA);
    if (n > 1) peer_load_idx(ws, t0 + dt, rsl, eiB);
    for (int i = 0; i < n; i += 2) {
        const int t = t0 + i * dt;
        if (i + 1 < n) peer_load_rows<PASS>(ws, t + dt, sl, rsl, c, eiB, rowB, auxB);
        if (i + 2 < n) peer_load_idx(ws, t + 2 * dt, rsl, eiA);
        peer_compute<PASS>(p, lds, lane_w, t, sl, rsl, c, rowA, auxA);
        if (i + 1 < n) {
            if (i + 2 < n) peer_load_rows<PASS>(ws, t + 2 * dt, sl, rsl, c, eiA, rowA, auxA);
            if (i + 3 < n) peer_load_idx(ws, t + 3 * dt, rsl, eiB);
            peer_compute<PASS>(p, lds, lane_w, t + dt, sl, rsl, c, rowB, auxB);
        }
    }
}
__device__ __forceinline__ void peerv_load_idx(const unsigned char* ws, int t, int hf, int rsl, int (&ei)[8]) {
    const unsigned off = (unsigned)WS_SELI + ((unsigned)t * 128u + 16u * (unsigned)rsl + 8u * (unsigned)hf) * 4u;
    const int4 v0 = *(const int4*)(ws + off), v1 = *(const int4*)(ws + (off + 16u));
    ei[0] = v0.x; ei[1] = v0.y; ei[2] = v0.z; ei[3] = v0.w; ei[4] = v1.x; ei[5] = v1.y; ei[6] = v1.z; ei[7] = v1.w;
}
__device__ __forceinline__ void peerv_load_rows(const unsigned char* ws, int sl, int c, const int (&ei)[8], u32x4 (&row)[8]) {
    const unsigned tab = (unsigned)WS_VB + (unsigned)sl * (unsigned)(NEXP * 128) + 16u * (unsigned)c;
#pragma unroll
    for (int i = 0; i < 8; ++i) row[i] = *(const u32x4*)(ws + (tab + (unsigned)ei[i] * 128u));
}
struct PeerVAux { u32x4 cp; unsigned cs; unsigned xo[4]; };
__device__ __forceinline__ void peerv_load_aux(const unsigned char* ws, int t, int sl, int lane, PeerVAux& a) {
    a.cp = *(const u32x4*)(ws + ((unsigned)WS_CBUF + (unsigned)t * 128u + 16u * (unsigned)(lane & 7)));
    a.cs = *(const unsigned*)(ws + ((unsigned)WS_CSC + (unsigned)t * 4u));
    const unsigned xo = (unsigned)WS_A + ((unsigned)t * (unsigned)D + 256u * sl + (unsigned)lane) * 2u;
    a.xo[0] = *(const bf16_t*)(ws + xo); a.xo[1] = *(const bf16_t*)(ws + (xo + 128u)); a.xo[2] = *(const bf16_t*)(ws + (xo + 256u)); a.xo[3] = *(const bf16_t*)(ws + (xo + 384u));
}
template <int HF>
__device__ __forceinline__ void peerv_half(lds_b* img, int lane, const u32x4 (&row)[8], const PeerVAux& a, int (&acc)[4]) {
    const int rsl = lane >> 3, c = lane & 7;
#pragma unroll
    for (int i = 0; i < 8; ++i) {
        const u32x4 rw = row[i];
        __attribute__((address_space(3))) u32x2* d = (__attribute__((address_space(3))) u32x2*)(img + (16 * rsl + i) * PEER_IMG_PITCH + 16 * c);
        d[0] = (u32x2){rw.x, rw.y}; d[1] = (u32x2){rw.z, rw.w};
    }
    const unsigned cpl = HF == 0 ? a.cp.x : a.cp.y, cph = HF == 0 ? a.cp.z : a.cp.w;
    asm volatile("s_waitcnt lgkmcnt(0)" ::: "memory");
    const unsigned ra = (unsigned)(size_t)img + (unsigned)((lane & 15) * PEER_IMG_PITCH + 8 * (lane >> 4));
#define PEER_TR4(R0, R1, R2, R3, RS) asm volatile("ds_read_b64_tr_b4 %0, %4 offset:%5\n\tds_read_b64_tr_b4 %1, %4 offset:%6\n\tds_read_b64_tr_b4 %2, %4 offset:%7\n\tds_read_b64_tr_b4 %3, %4 offset:%8" \
            : "=&v"(R0), "=&v"(R1), "=&v"(R2), "=&v"(R3) : "v"(ra), "i"((RS) * 16 * PEER_IMG_PITCH), "i"((RS) * 16 * PEER_IMG_PITCH + 32), "i"((RS) * 16 * PEER_IMG_PITCH + 64), "i"((RS) * 16 * PEER_IMG_PITCH + 96) : "memory")
#define PEER_USE4(R0, R1, R2, R3, RS, WAITSTR) do { \
            asm volatile(WAITSTR : "+v"(R0), "+v"(R1), "+v"(R2), "+v"(R3) :: "memory"); \
            const int cl_ = __builtin_amdgcn_readlane((int)cpl, RS), ch_ = __builtin_amdgcn_readlane((int)cph, RS); \
            const unsigned lo4_[4] = {R0.x, R1.x, R2.x, R3.x}; \
            _Pragma("unroll") for (int tcg = 0; tcg < 4; ++tcg) acc[tcg] += 16 * __builtin_amdgcn_sdot8((int)lo4_[tcg], ch_, 0, false) + __builtin_amdgcn_sdot8((int)lo4_[tcg], cl_, 0, false); } while (0)
    {
        u32x2 a0, a1, a2, a3, b0, b1, b2, b3;
        PEER_TR4(a0, a1, a2, a3, 0);
        PEER_TR4(b0, b1, b2, b3, 1); PEER_USE4(a0, a1, a2, a3, 0, "s_waitcnt lgkmcnt(4)");
        PEER_TR4(a0, a1, a2, a3, 2); PEER_USE4(b0, b1, b2, b3, 1, "s_waitcnt lgkmcnt(4)");
        PEER_TR4(b0, b1, b2, b3, 3); PEER_USE4(a0, a1, a2, a3, 2, "s_waitcnt lgkmcnt(4)");
        PEER_TR4(a0, a1, a2, a3, 4); PEER_USE4(b0, b1, b2, b3, 3, "s_waitcnt lgkmcnt(4)");
        PEER_TR4(b0, b1, b2, b3, 5); PEER_USE4(a0, a1, a2, a3, 4, "s_waitcnt lgkmcnt(4)");
        PEER_TR4(a0, a1, a2, a3, 6); PEER_USE4(b0, b1, b2, b3, 5, "s_waitcnt lgkmcnt(4)");
        PEER_TR4(b0, b1, b2, b3, 7); PEER_USE4(a0, a1, a2, a3, 6, "s_waitcnt lgkmcnt(4)");
        PEER_USE4(b0, b1, b2, b3, 7, "s_waitcnt lgkmcnt(0)");
    }
#undef PEER_TR4
#undef PEER_USE4
}
__device__ __forceinline__ void peerv_stream(const Params& p, unsigned char* lds, int tid_, int sl, int t0, int dt, int n) {
    const unsigned char* ws = p.ws;
    const int lane = tid_ & 63, rsl = lane >> 3, c = lane & 7;
    lds_b* img = (lds_b*)lds + (tid_ >> 6) * PEER_IMG_BYTES;
    for (int e = lane; e < 64 * (PEER_IMG_PITCH / 8); e += 64) {
        const int zr = e / (PEER_IMG_PITCH / 8), zc = e % (PEER_IMG_PITCH / 8);
        *(__attribute__((address_space(3))) u32x2*)(img + (16 * (zr >> 3) + 8 + (zr & 7)) * PEER_IMG_PITCH + 8 * zc) = (u32x2){0u, 0u};
    }
    if (n <= 0) return;
    int ei0[8], ei1[8]; u32x4 rowA[8], rowB[8]; PeerVAux ax, axn;
    peerv_load_idx(ws, t0, 0, rsl, ei0);
    peerv_load_rows(ws, sl, c, ei0, rowA); peerv_load_aux(ws, t0, sl, lane, ax);
    peerv_load_idx(ws, t0, 1, rsl, ei1);
    for (int i = 0; i < n; ++i) {
        const int t = t0 + i * dt; const bool more = i + 1 < n;
        int acc[4] = {0, 0, 0, 0};
        peerv_load_rows(ws, sl, c, ei1, rowB);
        if (more) peerv_load_idx(ws, t + dt, 0, rsl, ei0);
        peerv_half<0>(img, lane, rowA, ax, acc);
        if (more) { peerv_load_rows(ws, sl, c, ei0, rowA); peerv_load_aux(ws, t + dt, sl, lane, axn); peerv_load_idx(ws, t + dt, 1, rsl, ei1); }
        peerv_half<1>(img, lane, rowB, ax, acc);
        const float cs = u2f(ax.cs);
#pragma unroll
        for (int tcg = 0; tcg < 4; ++tcg) {
            const unsigned oo = ((unsigned)t * (unsigned)D + 256u * sl + 64u * tcg + (unsigned)lane) * 4u;
            *(float*)((unsigned char*)p.out + oo) = bf2f(ax.xo[tcg]) + (float)acc[tcg] * cs;
        }
        if (more) ax = axn;
    }
}
template <int PASS>
__device__ __forceinline__ void ph_peer(const Params& p, unsigned char* lds) {
    const int tid_ = phase_tid();
    const int lane = tid_ & 63, w = tid_ >> 6, b = blockIdx.x, G = gridDim.x;
    if ((G & 7) == 0) {
        const int g = b & 7, nsw = (G >> 3) * 2 * (NTHR / 64), t0 = ((g >> 2) * (G >> 3) + (b >> 3)) * (NTHR / 64) + w;
        if (PASS == 0) peer_stream<0>(p, lds, tid_, g & 3, t0, nsw, t0 < S ? (S - 1 - t0) / nsw + 1 : 0);
        else peerv_stream(p, lds, tid_, g & 3, t0, nsw, t0 < S ? (S - 1 - t0) / nsw + 1 : 0);
    } else {
        const int nw = G * (NTHR / 64), it0 = b * (NTHR / 64) + w;
        for (int it = it0; it < S * 4; it += nw) { if (PASS == 0) peer_stream<0>(p, lds, tid_, it & 3, it >> 2, 0, 1); else peerv_stream(p, lds, tid_, it & 3, it >> 2, 0, 1); }
    }
}
__device__ __forceinline__ void ph_peer_combine(const Params& p) {
    unsigned char* ws = p.ws;
    const int* seli = (const int*)(ws + WS_SELI); const float* selg = (const float*)(ws + WS_SELG); const float* rstd2 = (const float*)(ws + WS_RSTD2);
    const float2* uvsc = (const float2*)(ws + WS_USC);
    const float* pd = (const float*)(ws + WS_PD);
    unsigned* cpl = (unsigned*)(ws + WS_CBUF); float* csc = (float*)(ws + WS_CSC);
    const int tid_ = phase_tid(), lane = tid_ & 63, gwave = (blockIdx.x * blockDim.x + tid_) >> 6, nwave = (gridDim.x * blockDim.x) >> 6;
    constexpr int TT = 4;
    for (int tb = gwave; tb < S; tb += TT * nwave) {
        float dsum[TT][2], sg[TT][2], rsd[TT]; int ei[TT][2];
#pragma unroll
        for (int k = 0; k < TT; ++k) {
            const int t = min(tb + k * nwave, S - 1);
#pragma unroll
            for (int hf = 0; hf < 2; ++hf) {
                const int e = t * 128 + 64 * hf + lane;
                ei[k][hf] = seli[e]; sg[k][hf] = selg[e];
                float d = 0.f;
#pragma unroll
                for (int g = 0; g < 4; ++g) d += pd[(size_t)g * S * 128 + e];
                dsum[k][hf] = d;
            }
            rsd[k] = rstd2[t];
        }
        float2 sc2[TT][2];
#pragma unroll
        for (int k = 0; k < TT; ++k)
#pragma unroll
            for (int hf = 0; hf < 2; ++hf) sc2[k][hf] = uvsc[ei[k][hf]];
#pragma unroll
        for (int k = 0; k < TT; ++k) {
            const int t = tb + k * nwave;
            if (t >= S) break;
            float cf[2];
#pragma unroll
            for (int hf = 0; hf < 2; ++hf) cf[hf] = sg[k][hf] * gelu_tanh(dsum[k][hf] * sc2[k][hf].x * rsd[k]) * sc2[k][hf].y;
            float m = fmaxf(fabsf(cf[0]), fabsf(cf[1]));
#pragma unroll
            for (int o = 1; o < 64; o <<= 1) m = fmaxf(m, __shfl_xor(m, o));
            const float inv = m > 0.f ? 119.0f / m : 0.f;
#pragma unroll
            for (int hf = 0; hf < 2; ++hf) {
                const int q = __float2int_rn(cf[hf] * inv);
                unsigned dl = (unsigned)(q & 15) << (4 * (lane & 7)), dh = (unsigned)(((q + 8) >> 4) & 15) << (4 * (lane & 7));
                dl |= __shfl_xor(dl, 1); dh |= __shfl_xor(dh, 1); dl |= __shfl_xor(dl, 2); dh |= __shfl_xor(dh, 2); dl |= __shfl_xor(dl, 4); dh |= __shfl_xor(dh, 4);
                if ((lane & 7) == 0) {
                    const int dk = 8 * hf + (lane >> 3), rs = dk >> 1, half = dk & 1;
                    cpl[(size_t)t * 32 + 4 * rs + half] = dl; cpl[(size_t)t * 32 + 4 * rs + 2 + half] = dh;
                }
            }
            if (lane == 0) csc[t] = m * (1.0f / 119.0f);
        }
    }
}

#define LAS __attribute__((address_space(3)))
#define XB_TMO      128
#define XB_XCNT(j)  (256  + 64 * (j))
#define XB_XSUB(j)  (1280 + 64 * (j))
#define XB_XGEN(j)  (2304 + 64 * (j))
#define XB_TOP      3328
#define XB_TOPGEN   3392
#define XCD_BAR_WORDS 3456
#define XB_SPIN_CAP (1u << 18)
__device__ __forceinline__ unsigned xb_ld(unsigned* p)              { return __hip_atomic_load(p, __ATOMIC_RELAXED, __HIP_MEMORY_SCOPE_AGENT); }
__device__ __forceinline__ unsigned xb_add(unsigned* p, unsigned v) { return __hip_atomic_fetch_add(p, v, __ATOMIC_RELAXED, __HIP_MEMORY_SCOPE_AGENT); }
__device__ __forceinline__ unsigned xb_xcc_id() { return (unsigned)__builtin_amdgcn_s_getreg((3 << 11) | 20) & 0xFu; }
#define XB_SPIN(cond, bar) do { unsigned _sp = 0; while (cond) { __builtin_amdgcn_s_sleep(1); \
    if ((++_sp & 255u) == 0u) { if (xb_ld(&(bar)[XB_TMO])) break; if (_sp > XB_SPIN_CAP) { atomicAdd(&(bar)[XB_TMO], 1u); break; } } } } while (0)
struct XcdBarrier { unsigned* bar; unsigned x; volatile LAS unsigned* st; };
__device__ __forceinline__ XcdBarrier xcd_barrier_post(unsigned* bar, volatile LAS unsigned* st) {
    XcdBarrier b; b.bar = bar; b.x = xb_xcc_id(); b.st = st;
    if (threadIdx.x == 0) (void)xb_add(&bar[XB_XCNT(b.x)], 1u);
    return b;
}
__device__ __forceinline__ void xcd_barrier_complete(unsigned* bar, unsigned x, unsigned& nloc, unsigned& nx) {
    const unsigned G = gridDim.x * gridDim.y * gridDim.z;
    unsigned sum, cnt, mine, sp = 0u;
    for (;;) {
        sum = 0u; cnt = 0u; mine = 0u;
#pragma unroll
        for (unsigned j = 0; j < 16; ++j) { const unsigned c = xb_ld(&bar[XB_XCNT(j)]); sum += c; cnt += (c > 0u) ? 1u : 0u; mine = (j == x) ? c : mine; }
        if (sum == G) break;
        __builtin_amdgcn_s_sleep(1);
        if ((++sp & 255u) == 0u) { if (xb_ld(&bar[XB_TMO])) break; if (sp > XB_SPIN_CAP) { atomicAdd(&bar[XB_TMO], 1u); break; } }
    }
    nloc = mine > 0u ? mine : 1u; nx = cnt > 0u ? cnt : 1u;
}
__device__ __forceinline__ void xcd_barrier(const XcdBarrier& b) {
    asm volatile("s_waitcnt vmcnt(0)" ::: "memory");
    __syncthreads();
    if (threadIdx.x == 0) {
        unsigned* bar = b.bar;
        __builtin_amdgcn_s_waitcnt(0);
        unsigned nloc = b.st[0], nx = b.st[1];
        if (nloc == 0u) { xcd_barrier_complete(bar, b.x, nloc, nx); b.st[0] = nloc; b.st[1] = nx; }
        const unsigned old = xb_add(&bar[XB_XSUB(b.x)], 1u);
        const unsigned gen = old / nloc;
        if (old + 1u == (gen + 1u) * nloc) {
            __builtin_amdgcn_fence(__ATOMIC_RELEASE, "agent");
            asm volatile("s_waitcnt vmcnt(0)" ::: "memory");
            const unsigned og = xb_add(&bar[XB_TOP], 1u);
            const unsigned tg = og / nx;
            if (og + 1u == (tg + 1u) * nx) xb_add(&bar[XB_TOPGEN], 1u);
            else XB_SPIN(xb_ld(&bar[XB_TOPGEN]) == tg, bar);
            __builtin_amdgcn_fence(__ATOMIC_ACQUIRE, "agent");
            xb_add(&bar[XB_XGEN(b.x)], 1u);
            asm volatile("s_waitcnt vmcnt(0)" ::: "memory");
        } else {
            XB_SPIN(xb_ld(&bar[XB_XGEN(b.x)]) == gen, bar);
            __builtin_amdgcn_fence(__ATOMIC_ACQUIRE, "agent");
            asm volatile("s_waitcnt vmcnt(0)" ::: "memory");
        }
    }
    __syncthreads();
}

constexpr int LDS_MISC = 158720;
constexpr int LDS_BYTES = LDS_MISC + 1024;

__global__ void __launch_bounds__(NTHR, 2) hymba_fwd(Params p) {
    extern __shared__ __attribute__((aligned(16))) unsigned char lds[];
    volatile LAS unsigned* misc = (volatile LAS unsigned*)((LAS unsigned char*)lds + LDS_MISC);
    if (threadIdx.x < 4) misc[threadIdx.x] = 0u;
    __syncthreads();
    XcdBarrier bar = xcd_barrier_post((unsigned*)(p.ws + WS_CTL), misc);

    PG8_LAS unsigned char* ring = (PG8_LAS unsigned char*)lds;
    unsigned char* ws = p.ws;
    ph_prep(p, lds);                          xcd_barrier(bar);
    {
        pg8::Gemm g{(const bf16_t*)(ws + WS_A), (const bf16_t*)(ws + WS_WINT), S, NPROJ, D}; pg8::StaticOrder so; so.init(S, NPROJ, (int)gridDim.x, (int)blockIdx.x);
        EpiInProj E{(const float*)(ws + WS_RSTD1), p.in[I_Q_NORM], p.in[I_K_NORM], (bf16_t*)(ws + WS_QH), (bf16_t*)(ws + WS_KH), (bf16_t*)(ws + WS_VH), (bf16_t*)(ws + WS_XRG), (bf16_t*)(ws + WS_GG)};
        pg8::gemm_phase<EpiInProj, pg8::StaticOrder, true, true>(ring, g, so, E);
        const int G = (int)gridDim.x, nunits = (S / 256) * (NPROJ / 256), rem = nunits % G, b = (int)blockIdx.x;
        const int tid_ = phase_tid(), w = tid_ >> 6, lane = tid_ & 63;
        if (rem == 0) ph_tables(p, b * (NTHR / 64) + w, G * (NTHR / 64), lane);
        else if (b >= rem) ph_tables(p, (b - rem) * (NTHR / 64) + w, (G - rem) * (NTHR / 64), lane);
    }
    xcd_barrier(bar);
    ph_attn(p); ph_rg<0>(p, lds);             xcd_barrier(bar);
    ph_rg<1>(p, lds);                         xcd_barrier(bar);
    {
        pg8::Gemm g{(const bf16_t*)(ws + WS_MIX), (const bf16_t*)(ws + WS_WOUTT), S, D, D}; pg8::StaticOrder so; so.init(S, D, (int)gridDim.x, (int)blockIdx.x);
        EpiOutProj E{(const float*)(ws + WS_RSB), p.in[I_X], (bf16_t*)(ws + WS_A), (float*)(ws + WS_SSQ), ws + WS_X1Q, (float*)(ws + WS_XSC)};
        pg8::gemm_phase<EpiOutProj, pg8::StaticOrder, true, true>(ring, g, so, E);
    }
    xcd_barrier(bar);
    {
        pg8::Gemm g{(const bf16_t*)(ws + WS_A), (const bf16_t*)(ws + WS_WQT), S, NQ, D}; pg8::StaticOrder so; so.init(S, NQ, (int)gridDim.x, (int)blockIdx.x);
        EpiPeerQ E{(bf16_t*)(ws + WS_B)};
        pg8::gemm_phase<EpiPeerQ, pg8::StaticOrder, true, true>(ring, g, so, E);
    }
    asm volatile("s_waitcnt vmcnt(0)" ::: "memory"); __syncthreads();
    ph_topk(p, (int*)lds);                    xcd_barrier(bar);
    ph_peer<0>(p, lds);                       xcd_barrier(bar);
    ph_peer_combine(p);                       xcd_barrier(bar);
    ph_peer<1>(p, lds);
}

extern "C" void kernel_launch(void* const* d_in, const int* in_sizes, int n_in, void* d_out, int out_size, void* d_ws, size_t ws_size, hipStream_t stream) {
    static int grid = 0;
    if (grid == 0) {
        if (n_in != 20 || out_size != S * D || ws_size < WS_END) { fprintf(stderr, "kernel_launch: unexpected shapes (n_in %d out %d ws %zu)\n", n_in, out_size, ws_size); grid = -1; return; }
        int dev = 0, cus = 0, per_cu = 0;
        if (hipGetDevice(&dev) != hipSuccess || hipDeviceGetAttribute(&cus, hipDeviceAttributeMultiprocessorCount, dev) != hipSuccess) { grid = -1; return; }
        if (hipFuncSetAttribute((const void*)hymba_fwd, hipFuncAttributeMaxDynamicSharedMemorySize, LDS_BYTES) != hipSuccess) { fprintf(stderr, "kernel_launch: hipFuncSetAttribute failed\n"); grid = -1; return; }
        if (hipOccupancyMaxActiveBlocksPerMultiprocessor(&per_cu, (const void*)hymba_fwd, NTHR, LDS_BYTES) != hipSuccess || per_cu < 1) { fprintf(stderr, "kernel_launch: occupancy query says %d blocks per CU\n", per_cu); grid = -1; return; }
        (void)hipGetLastError();
        grid = cus;
    }
    if (grid < 0) return;
    (void)hipMemsetAsync((char*)d_ws + WS_CTL, 0, XCD_BAR_WORDS * 4, stream);
    Params p{};
    for (int i = 0; i < 20; ++i) p.in[i] = (const float*)d_in[i];
    p.out = (float*)d_out; p.ws = (unsigned char*)d_ws;
    hipLaunchKernelGGL(hymba_fwd, dim3(grid), dim3(NTHR), LDS_BYTES, stream, p);
}
```

```cpp
#include <hip/hip_runtime.h>
#include <cstdint>
#include <cstdio>

typedef unsigned short bf16_t;
typedef short bf16x8 __attribute__((ext_vector_type(8)));
typedef float f32x4 __attribute__((ext_vector_type(4)));
typedef unsigned u32x4 __attribute__((ext_vector_type(4)));
typedef float f32x16 __attribute__((ext_vector_type(16)));

constexpr int S = 16384, D = 1024, NPROJ = 2560, DSB = 512, DRG = 512, NH = 8, HD = 64;
constexpr int PH = 8, PNK = 128, PDK = 256, PHALF = 128, PTOPK = 16, NEXP = 16384, NQ = PH * PDK;
constexpr int CHUNK = 64, NCHUNK = S / CHUNK;
constexpr float EPS = 1e-6f;
constexpr float LOG2E = 1.4426950408889634f;
constexpr float QSCALE = 0.125f * LOG2E;
constexpr int NTHR = 512;
constexpr float CARRY_STOP = -160.0f;

constexpr size_t MiB = 1u << 20;
constexpr size_t WS_CTL = 0;
constexpr size_t WS_WINT = 1 * MiB;
constexpr size_t WS_WOUTT = 6 * MiB;
constexpr size_t WS_WQT = 8 * MiB;
constexpr size_t WS_SUBK = 12 * MiB;
constexpr size_t WS_RSTD1 = 12 * MiB + 512 * 1024;
constexpr size_t WS_RSTD2 = WS_RSTD1 + 64 * 1024;
constexpr size_t WS_RGP = WS_RSTD2 + 64 * 1024;
constexpr size_t WS_RGH = WS_RGP + 512 * 1024;
constexpr size_t WS_RGSA = 207 * MiB, WS_RGSB = 223 * MiB;
constexpr size_t WS_A = 14 * MiB;
constexpr size_t WS_B = 46 * MiB;
constexpr size_t WS_QH = WS_B, WS_KH = WS_B + 16 * MiB, WS_VH = WS_B + 32 * MiB, WS_XRG = WS_B + 48 * MiB;
constexpr size_t WS_GG = 110 * MiB;
constexpr size_t WS_OSB = 126 * MiB;
constexpr size_t WS_MIX = 142 * MiB;
constexpr size_t WS_SSB = 198 * MiB;
constexpr size_t WS_RSB = WS_SSB + 512 * 1024;
constexpr size_t WS_SELI = WS_MIX, WS_SELG = WS_MIX + 8 * MiB;
constexpr size_t WS_PD = WS_B;
constexpr size_t WS_CBUF = WS_GG;
constexpr size_t WS_CSC = WS_GG + 4 * MiB;
constexpr size_t WS_X1Q = WS_OSB;
constexpr size_t WS_XSC = WS_GG + 8 * MiB;
constexpr size_t WS_UB = 174 * MiB;
constexpr size_t WS_VB = 190 * MiB;
constexpr size_t WS_USC = 206 * MiB;
constexpr size_t WS_SSQ = 238 * MiB;
constexpr size_t WS_RGW = 239 * MiB;
constexpr size_t WS_END = 240 * MiB;

__device__ __forceinline__ unsigned f2bf(float f) { unsigned u = __builtin_bit_cast(unsigned, f); return (u + 0x7fffu + ((u >> 16) & 1u)) >> 16; }
__device__ __forceinline__ float u2f(unsigned u) { return __builtin_bit_cast(float, u); }
__device__ __forceinline__ float bf2f(unsigned h) { return __builtin_bit_cast(float, h << 16); }
__device__ __forceinline__ unsigned pk2(float lo, float hi) { return f2bf(lo) | (f2bf(hi) << 16); }
__device__ __forceinline__ unsigned pack_i8(float a, float b, float c, float d) {
    const int qa = __float2int_rn(a), qb = __float2int_rn(b), qc = __float2int_rn(c), qd = __float2int_rn(d);
    return (unsigned)(qa & 255) | ((unsigned)(qb & 255) << 8) | ((unsigned)(qc & 255) << 16) | ((unsigned)qd << 24);
}
__device__ __forceinline__ unsigned pack_n4(float a, float b, float c, float d) {
    const int qa = min(max(__float2int_rn(a), -7), 7) & 15, qb = min(max(__float2int_rn(b), -7), 7) & 15, qc = min(max(__float2int_rn(c), -7), 7) & 15, qd = min(max(__float2int_rn(d), -7), 7) & 15;
    return (unsigned)qa | ((unsigned)qb << 4) | ((unsigned)qc << 8) | ((unsigned)qd << 12);
}
template <int OFFS>
__device__ __forceinline__ unsigned pack_u4(float a, float b, float c, float d) {
    const int qa = (min(max(__float2int_rn(a), -7), 7) + OFFS) & 15, qb = (min(max(__float2int_rn(b), -7), 7) + OFFS) & 15, qc = (min(max(__float2int_rn(c), -7), 7) + OFFS) & 15, qd = (min(max(__float2int_rn(d), -7), 7) + OFFS) & 15;
    return (unsigned)qa | ((unsigned)qb << 8) | ((unsigned)qc << 16) | ((unsigned)qd << 24);
}
__device__ __forceinline__ float wave_sum(float v) {
#pragma unroll
    for (int o = 1; o < 64; o <<= 1) v += __shfl_xor(v, o);
    return v;
}
__device__ __forceinline__ float gelu_tanh(float x) {
    const float u = 0.7978845608028654f * (x + 0.044715f * x * x * x);
    const float e = __expf(2.0f * u);
    const float th = 1.0f - 2.0f / (e + 1.0f);
    return 0.5f * x * (1.0f + th);
}

__host__ __device__ __forceinline__ int inproj_phys_row(int nlog) { const int t = nlog >> 8, L = nlog & 255; return (t << 8) + 128 * ((L & 63) >> 5) + 32 * (L >> 6) + (L & 31); }

__device__ __forceinline__ int phase_tid() { int t = threadIdx.x; asm volatile("" : "+v"(t)); return t; }

struct Params {
    const float* in[20];
    float* out;
    unsigned char* ws;
};
enum { I_X = 0, I_NORM_MIX, I_W_IN, I_Q_NORM, I_K_NORM, I_CONV_W, I_CONV_B, I_RG_W_A, I_RG_B_A, I_RG_W_X, I_RG_B_X, I_RG_LAMBDA,
       I_OUT_NORM_SB, I_OUT_NORM_RG, I_W_OUT, I_NORM_FFN, I_PEER_WQ, I_PEER_SUBK, I_PEER_U, I_PEER_V };

template <bool INPROJ_PERM>
__device__ __forceinline__ void prep_transpose_item(const float* W, const float* gain0, const float* gain1, int K, int N, bf16_t* WT, float* scr, int item, int lane) {
    const int nblk = N / 32, kb = item / nblk, nb = item % nblk, k0 = 64 * kb, n0 = 32 * nb;
#pragma unroll
    for (int i = 0; i < 32; ++i) {
        const int kk = 2 * i + (lane >> 5), k = k0 + kk;
        const float g = (gain1 && k >= 512) ? gain1[k - 512] : gain0[k];
        scr[kk * 33 + (lane & 31)] = g * W[(size_t)k * N + n0 + (lane & 31)];
    }
    asm volatile("s_waitcnt lgkmcnt(0)" ::: "memory");
    const int c = lane & 7;
#pragma unroll
    for (int j = 0; j < 4; ++j) {
        const int n = (lane >> 3) + 8 * j; const float* s = scr + (8 * c) * 33 + n;
        u32x4 o; o.x = pk2(s[0 * 33], s[1 * 33]); o.y = pk2(s[2 * 33], s[3 * 33]); o.z = pk2(s[4 * 33], s[5 * 33]); o.w = pk2(s[6 * 33], s[7 * 33]);
        const int nr = INPROJ_PERM ? inproj_phys_row(n0 + n) : n0 + n;
        *(u32x4*)(WT + (size_t)nr * K + k0 + 8 * c) = o;
    }
    asm volatile("s_waitcnt lgkmcnt(0)" ::: "memory");
}
__device__ __forceinline__ void ph_tables(const Params& p, int cw, int ncw, int lane) {
    unsigned char* ws = p.ws;
    {
        const float* u = p.in[I_PEER_U]; const float* v = p.in[I_PEER_V]; const float* g = p.in[I_NORM_FFN];
        unsigned* ub = (unsigned*)(ws + WS_UB); unsigned* vb = (unsigned*)(ws + WS_VB); float2* uvsc = (float2*)(ws + WS_USC);
        f32x4 gq[4];
#pragma unroll
        for (int j = 0; j < 4; ++j) gq[j] = *((const f32x4*)g + lane + 64 * j);
        for (int e0 = cw; e0 < NEXP; e0 += 2 * ncw) {
            f32x4 a[2][4], b[2][4]; float ma[2], mb[2], sa2[2], sb2[2];
#pragma unroll
            for (int rr = 0; rr < 2; ++rr) {
                const int e = min(e0 + rr * ncw, NEXP - 1);
#pragma unroll
                for (int j = 0; j < 4; ++j) { a[rr][j] = *((const f32x4*)(u + (size_t)e * D) + lane + 64 * j); b[rr][j] = *((const f32x4*)(v + (size_t)e * D) + lane + 64 * j); }
            }
#pragma unroll
            for (int rr = 0; rr < 2; ++rr) {
                ma[rr] = 0.f; mb[rr] = 0.f; sa2[rr] = 0.f; sb2[rr] = 0.f;
#pragma unroll
                for (int j = 0; j < 4; ++j) {
                    a[rr][j] = a[rr][j] * gq[j];
                    const f32x4 aa = a[rr][j], bb = b[rr][j];
                    ma[rr] = fmaxf(ma[rr], fmaxf(fmaxf(fabsf(aa.x), fabsf(aa.y)), fmaxf(fabsf(aa.z), fabsf(aa.w))));
                    mb[rr] = fmaxf(mb[rr], fmaxf(fmaxf(fabsf(bb.x), fabsf(bb.y)), fmaxf(fabsf(bb.z), fabsf(bb.w))));
                    sa2[rr] += (aa.x * aa.x + aa.y * aa.y) + (aa.z * aa.z + aa.w * aa.w);
                    sb2[rr] += (bb.x * bb.x + bb.y * bb.y) + (bb.z * bb.z + bb.w * bb.w);
                }
            }
#pragma unroll
            for (int o = 1; o < 64; o <<= 1)
#pragma unroll
                for (int rr = 0; rr < 2; ++rr) { ma[rr] = fmaxf(ma[rr], __shfl_xor(ma[rr], o)); mb[rr] = fmaxf(mb[rr], __shfl_xor(mb[rr], o)); sa2[rr] += __shfl_xor(sa2[rr], o); sb2[rr] += __shfl_xor(sb2[rr], o); }
#pragma unroll
            for (int rr = 0; rr < 2; ++rr) {
                const int e = e0 + rr * ncw;
                if (e < NEXP) {
                    const float ca = fminf(ma[rr], 2.5f * sqrtf(sa2[rr] * (1.0f / D))), cb = fminf(mb[rr], 2.5f * sqrtf(sb2[rr] * (1.0f / D)));
                    const float ia = ca > 0.f ? 7.0f / ca : 0.f, ib = cb > 0.f ? 7.0f / cb : 0.f;
#pragma unroll
                    for (int j = 0; j < 4; ++j) {
                        const f32x4 aa = a[rr][j], bb = b[rr][j];
                        const unsigned na = pack_u4<0>(aa.x * ia, aa.y * ia, aa.z * ia, aa.w * ia), nb = pack_n4(bb.x * ib, bb.y * ib, bb.z * ib, bb.w * ib);
                        const unsigned pa = __shfl_xor(na, 1), pb = __shfl_xor(nb, 1);
                        if ((lane & 1) == 0) {
                            ub[((size_t)j * NEXP + e) * 32 + (lane >> 1)] = na | (pa << 4);
                            vb[((size_t)j * NEXP + e) * 32 + (lane >> 1)] = nb | (pb << 16);
                        }
                    }
                    if (lane == 0) uvsc[e] = make_float2(ca * (1.0f / 7.0f), cb * (1.0f / 7.0f));
                }
            }
        }
    }
}

__device__ __forceinline__ void ph_prep(const Params& p, unsigned char* lds) {
    const int tid_ = phase_tid();
    const int gtid = blockIdx.x * blockDim.x + tid_, gsize = gridDim.x * blockDim.x;
    const int lane = tid_ & 63, gwave = gtid >> 6, nwave = gsize >> 6;
    unsigned char* ws = p.ws;
    {
        float* scr = (float*)lds + (tid_ >> 6) * (64 * 33);
        constexpr int I_IN = (D / 64) * (NPROJ / 32), I_OUT = (D / 64) * (D / 32), I_Q = (D / 64) * (NQ / 32);
        for (int it = gwave; it < I_IN + I_OUT + I_Q; it += nwave) {
            if (it < I_IN) prep_transpose_item<true>(p.in[I_W_IN], p.in[I_NORM_MIX], nullptr, D, NPROJ, (bf16_t*)(ws + WS_WINT), scr, it, lane);
            else if (it < I_IN + I_OUT) prep_transpose_item<false>(p.in[I_W_OUT], p.in[I_OUT_NORM_SB], p.in[I_OUT_NORM_RG], D, D, (bf16_t*)(ws + WS_WOUTT), scr, it - I_IN, lane);
            else prep_transpose_item<false>(p.in[I_PEER_WQ], p.in[I_NORM_FFN], nullptr, D, NQ, (bf16_t*)(ws + WS_WQT), scr, it - I_IN - I_OUT, lane);
        }
    }
    {
        const float* wa = p.in[I_RG_W_A]; const float* wx = p.in[I_RG_W_X]; bf16_t* o = (bf16_t*)(ws + WS_RGW);
        for (int e = gtid; e < 8 * 2 * 2 * 4 * 64 * 8; e += gsize) {
            const int el = e & 7, ln = (e >> 3) & 63, s = (e >> 9) & 3, jt = (e >> 11) & 1, g = (e >> 12) & 1, n = e >> 13;
            const int j = 32 * jt + (ln & 31), i = 16 * s + 8 * (el >> 2) + 4 * (ln >> 5) + (el & 3);
            o[e] = (bf16_t)f2bf((g == 0 ? wa : wx)[((size_t)n * 64 + i) * 64 + j]);
        }
    }
    {
        const float* sk = p.in[I_PEER_SUBK]; bf16_t* o = (bf16_t*)(ws + WS_SUBK);
        for (int e = gtid; e < PH * 2 * PNK * PHALF; e += gsize) o[e] = (bf16_t)f2bf(sk[e]);
    }
    {
        const float* x = p.in[I_X]; bf16_t* xb = (bf16_t*)(ws + WS_A); float* rstd1 = (float*)(ws + WS_RSTD1);
        for (int row0 = gwave; row0 < S; row0 += 4 * nwave) {
            f32x4 v[4][4];
#pragma unroll
            for (int rr = 0; rr < 4; ++rr) {
                const int row = min(row0 + rr * nwave, S - 1);
#pragma unroll
                for (int j = 0; j < 4; ++j) v[rr][j] = ((const f32x4*)(x + (size_t)row * D) + lane)[64 * j];
            }
#pragma unroll
            for (int rr = 0; rr < 4; ++rr) {
                const int row = row0 + rr * nwave;
                float ss = 0.f;
#pragma unroll
                for (int j = 0; j < 4; ++j) ss += (v[rr][j].x * v[rr][j].x + v[rr][j].y * v[rr][j].y) + (v[rr][j].z * v[rr][j].z + v[rr][j].w * v[rr][j].w);
                ss = wave_sum(ss);
                if (row < S) {
                    uint2* o = (uint2*)(xb + (size_t)row * D) + lane;
#pragma unroll
                    for (int j = 0; j < 4; ++j) o[64 * j] = make_uint2(pk2(v[rr][j].x, v[rr][j].y), pk2(v[rr][j].z, v[rr][j].w));
                    if (lane == 0) rstd1[row] = rsqrtf(ss * (1.0f / D) + EPS);
                }
            }
        }
    }
}

namespace pg8 {
#define PG8_LAS __attribute__((address_space(3)))
typedef unsigned short bf16_t;
typedef short bf16x8 __attribute__((ext_vector_type(8)));
typedef float f32x4 __attribute__((ext_vector_type(4)));
typedef unsigned u32x4 __attribute__((ext_vector_type(4)));
constexpr int BM = 256, BK = 64, HALF = 128, HTB = HALF * BK * 2  , STAGE_BYTES = 8 * HTB, NXCD = 8, WGM = 8;

__host__ __device__ __forceinline__ int lds_byte(int r, int c) { const int st = (r >> 4) * 2 + (c >> 5), rr = r & 15, cc = c & 31, ob = rr * 64 + cc * 2; return st * 1024 + (ob ^ (((ob >> 9) & 1) << 5)); }
__host__ __device__ __forceinline__ void stage_rc(int b, int& R, int& C) { const int st = b / 1024, sb = b % 1024, swz = sb ^ (((sb >> 9) & 1) << 5); R = (st >> 1) * 16 + swz / 64; C = (st & 1) * 32 + (swz % 64) / 2; }
__host__ __device__ __forceinline__ int perm32(int rho) { const int n = rho >> 4, i = rho & 15; return 8 * (i >> 2) + 4 * n + (i & 3); }

struct Unit { int pm, pn; };
struct Gemm { const bf16_t* A; const bf16_t* Bt; int M, N, K; };

struct StaticOrder {
    int nM, nN, nwg, G, c;
    __host__ __device__ void init(int M, int N, int G_, int c_) { nM = M / BM; nN = N / BM; nwg = nM * nN; G = G_; c = c_; }
    __host__ __device__ bool next(int i, Unit& u) const {
        const long L = (long)i * G + c; if (L >= nwg) return false;
        int wgid = (int)L; { const int q = nwg / NXCD, r = nwg % NXCD, xcd = wgid % NXCD, off = wgid / NXCD; wgid = (xcd < r ? xcd * (q + 1) : r * (q + 1) + (xcd - r) * q) + off; }
        const int nig = WGM * nN, gid = wgid / nig, fm = gid * WGM, gsz = (nM - fm) < WGM ? (nM - fm) : WGM;
        u.pm = fm + ((wgid % nig) % gsz); u.pn = (wgid % nig) / gsz; return true;
    }
    __device__ __forceinline__ void a_ready(const Unit&) const {}
    __device__ __forceinline__ void done(const Unit&) const {}
};

__device__ __forceinline__ unsigned cvt_pk_bf16(float lo, float hi) { unsigned r; asm volatile("v_cvt_pk_bf16_f32 %0, %1, %2" : "=v"(r) : "v"(lo), "v"(hi)); return r; }
template <class Epi, class Sched, bool ALIGN_EPI = false, bool SP2 = false>
__device__ __forceinline__ void gemm_phase(PG8_LAS unsigned char* lds, const Gemm g, const Sched& S, const Epi& E) {
    const int tid = phase_tid(), wid = __builtin_amdgcn_readfirstlane(tid >> 6), lane = tid & 63, wr = wid >> 2, wc = wid & 3, fr = lane & 15, fq = lane >> 4;
    const int K = g.K, nt = K / BK;
    unsigned voffA[2], voffB[2];
#pragma unroll
    for (int i = 0; i < 2; ++i) { int R, C; stage_rc(tid * 16 + i * 8192, R, C); const int Rb = Epi::PERM ? ((R & ~31) + perm32(R & 31)) : R;
        voffA[i] = (unsigned)(R * K + C) * 2u; voffB[i] = (unsigned)(Rb * K + C) * 2u; }
    const size_t kstep = (size_t)(BK * 2);
    const size_t hstep = (size_t)HALF * K * 2;
    const size_t tstep = 2 * hstep;
    const unsigned ldsw = (unsigned)wid * 1024u;
    const int aoff = lds_byte(wr * 64 + fr, fq * 8), boff = lds_byte(wc * 32 + fr, fq * 8);
#define PG8_SA(b, h) (((b) * 2 + (h)) * HTB)
#define PG8_SB(b, h) ((4 + (b) * 2 + (h)) * HTB)
#define PG8_STAGE(bufoff, gbase, voff) do { _Pragma("unroll") for (int _i = 0; _i < 2; ++_i) \
        __builtin_amdgcn_global_load_lds((const unsigned*)((const char*)(gbase) + (voff)[_i]), (PG8_LAS unsigned*)(lds + (bufoff) + ldsw + _i * 8192), 16, 0, 0); } while (0)
#define PG8_LDA(dst, b, h) do { _Pragma("unroll") for (int m = 0; m < 4; ++m) _Pragma("unroll") for (int k = 0; k < 2; ++k) dst[m][k] = *(const PG8_LAS bf16x8*)(lds + PG8_SA(b, h) + aoff + m * 2048 + k * 1024); } while (0)
#define PG8_LDB(dst, b, h) do { _Pragma("unroll") for (int n = 0; n < 2; ++n) _Pragma("unroll") for (int k = 0; k < 2; ++k) dst[n][k] = *(const PG8_LAS bf16x8*)(lds + PG8_SB(b, h) + boff + n * 2048 + k * 1024); } while (0)
#define PG8_MMA(ai, bj, At, Bt) do { __builtin_amdgcn_s_setprio(1); _Pragma("unroll") for (int m = 0; m < 4; ++m) _Pragma("unroll") for (int n = 0; n < 2; ++n) _Pragma("unroll") for (int k = 0; k < 2; ++k) \
        acc[ai][bj][m][n] = __builtin_amdgcn_mfma_f32_16x16x32_bf16(Bt[n][k], At[m][k], acc[ai][bj][m][n], 0, 0, 0); __builtin_amdgcn_s_setprio(0); } while (0)
#define PG8_WAIT_V(n) asm volatile("s_waitcnt vmcnt(" #n ")" ::: "memory")
#define PG8_WAIT_L(n) asm volatile("s_waitcnt lgkmcnt(" #n ")" ::: "memory")
#define PG8_BAR __builtin_amdgcn_s_barrier()
#define PG8_SCHED __builtin_amdgcn_sched_barrier(0)
    Unit cur, nxt; int ui = 0;
    if (!S.next(0, cur)) return;
    f32x4 acc[2][2][4][2];
#pragma unroll
    for (int a = 0; a < 2; ++a)
#pragma unroll
        for (int b = 0; b < 2; ++b)
#pragma unroll
            for (int m = 0; m < 4; ++m)
#pragma unroll
                for (int n = 0; n < 2; ++n) acc[a][b][m][n] = (f32x4){0.f, 0.f, 0.f, 0.f};
    bf16x8 At[4][2], B0[2][2], B1[2][2];
    const char* cA = (const char*)g.A + (size_t)cur.pm * tstep; const char* cB = (const char*)g.Bt + (size_t)cur.pn * tstep;
    S.a_ready(cur);
    if constexpr (SP2) {
        PG8_STAGE(PG8_SB(0, 0), cB, voffB); PG8_STAGE(PG8_SB(0, 1), cB + hstep, voffB); PG8_STAGE(PG8_SA(0, 0), cA, voffA); PG8_STAGE(PG8_SA(0, 1), cA + hstep, voffA);
        if (wr == 1) PG8_BAR;
        PG8_WAIT_V(2); PG8_BAR;
        PG8_STAGE(PG8_SB(1, 0), cB + kstep, voffB); PG8_STAGE(PG8_SA(1, 0), cA + kstep, voffA); PG8_STAGE(PG8_SB(1, 1), cB + hstep + kstep, voffB);
        PG8_WAIT_V(6); PG8_BAR;
    } else {
        PG8_STAGE(PG8_SB(0, 0), cB, voffB); PG8_STAGE(PG8_SA(0, 0), cA, voffA); PG8_STAGE(PG8_SB(0, 1), cB + hstep, voffB); PG8_STAGE(PG8_SA(0, 1), cA + hstep, voffA);
        if (wr == 1) PG8_BAR;
        PG8_WAIT_V(4); PG8_BAR;
        PG8_STAGE(PG8_SB(1, 0), cB + kstep, voffB); PG8_STAGE(PG8_SA(1, 0), cA + kstep, voffA); PG8_STAGE(PG8_SB(1, 1), cB + hstep + kstep, voffB);
        PG8_WAIT_V(6); PG8_BAR;
    }
    for (;;) {
        const bool has_next = S.next(ui + 1, nxt);
        const char* nA = has_next ? (const char*)g.A + (size_t)nxt.pm * tstep : cA; const char* nB = has_next ? (const char*)g.Bt + (size_t)nxt.pn * tstep : cB;
        for (int t = 0; t < nt; t += 2) {
            if constexpr (Epi::MIDSCALE) { if (t == nt / 2) E.mid(acc, cur, wr, wc, fr, fq); }
            const bool last = (t == nt - 2);
            const char* a1 = cA + (size_t)(t + 1) * kstep;
            const char* a2 = last ? nA : cA + (size_t)(t + 2) * kstep; const char* b2 = last ? nB : cB + (size_t)(t + 2) * kstep;
            const char* a3 = a2 + kstep; const char* b3 = b2 + kstep;
            if (last && has_next) S.a_ready(nxt);
            if constexpr (SP2) {
            PG8_LDB(B0, 0, 0); PG8_LDB(B1, 0, 1); PG8_SCHED; PG8_LDA(At, 0, 0); PG8_STAGE(PG8_SA(1, 1), a1 + hstep, voffA);
            PG8_WAIT_V(8); PG8_WAIT_L(0); PG8_BAR; PG8_MMA(0, 0, At, B0); PG8_MMA(0, 1, At, B1); PG8_BAR; PG8_SCHED;
            PG8_LDA(At, 0, 1); PG8_STAGE(PG8_SB(0, 0), b2, voffB); PG8_STAGE(PG8_SB(0, 1), b2 + hstep, voffB); PG8_STAGE(PG8_SA(0, 0), a2, voffA);
            PG8_WAIT_V(8); PG8_WAIT_L(0); PG8_BAR; PG8_MMA(1, 0, At, B0); PG8_MMA(1, 1, At, B1); PG8_BAR; PG8_SCHED;
            PG8_LDB(B0, 1, 0); PG8_LDB(B1, 1, 1); PG8_SCHED; PG8_LDA(At, 1, 0); PG8_STAGE(PG8_SA(0, 1), a2 + hstep, voffA);
            PG8_WAIT_V(8); PG8_WAIT_L(0); PG8_BAR; PG8_MMA(0, 0, At, B0); PG8_MMA(0, 1, At, B1); PG8_BAR; PG8_SCHED;
            PG8_LDA(At, 1, 1); PG8_STAGE(PG8_SB(1, 0), b3, voffB); PG8_STAGE(PG8_SB(1, 1), b3 + hstep, voffB); PG8_STAGE(PG8_SA(1, 0), a3, voffA);
            PG8_WAIT_V(8); PG8_WAIT_L(0); PG8_BAR; PG8_MMA(1, 0, At, B0); PG8_MMA(1, 1, At, B1); PG8_BAR; PG8_SCHED;
            } else {
            PG8_LDB(B0, 0, 0); PG8_SCHED; PG8_LDA(At, 0, 0); PG8_STAGE(PG8_SA(1, 1), a1 + hstep, voffA);
            PG8_WAIT_L(8); PG8_BAR; PG8_WAIT_L(0); PG8_MMA(0, 0, At, B0); PG8_BAR; PG8_SCHED;
            PG8_LDB(B1, 0, 1); PG8_STAGE(PG8_SB(0, 0), b2, voffB);
            PG8_BAR; PG8_WAIT_L(0); PG8_MMA(0, 1, At, B1); PG8_BAR;
            PG8_LDA(At, 0, 1); PG8_STAGE(PG8_SA(0, 0), a2, voffA);
            PG8_BAR; PG8_WAIT_L(0); PG8_MMA(1, 0, At, B0); PG8_BAR; PG8_SCHED;
            PG8_STAGE(PG8_SB(0, 1), b2 + hstep, voffB);
            PG8_WAIT_V(6); PG8_BAR; PG8_MMA(1, 1, At, B1); PG8_BAR;
            PG8_LDB(B0, 1, 0); PG8_SCHED; PG8_LDA(At, 1, 0); PG8_STAGE(PG8_SA(0, 1), a2 + hstep, voffA);
            PG8_WAIT_L(8); PG8_BAR; PG8_WAIT_L(0); PG8_MMA(0, 0, At, B0); PG8_BAR; PG8_SCHED;
            PG8_LDB(B1, 1, 1); PG8_STAGE(PG8_SB(1, 0), b3, voffB);
            PG8_BAR; PG8_WAIT_L(0); PG8_MMA(0, 1, At, B1); PG8_BAR;
            PG8_LDA(At, 1, 1); PG8_STAGE(PG8_SA(1, 0), a3, voffA);
            PG8_BAR; PG8_WAIT_L(0); PG8_MMA(1, 0, At, B0); PG8_BAR; PG8_SCHED;
            PG8_STAGE(PG8_SB(1, 1), b3 + hstep, voffB);
            PG8_WAIT_V(6); PG8_BAR; PG8_MMA(1, 1, At, B1); PG8_BAR;
            }
        }
        if constexpr (ALIGN_EPI) { if (wr == 0) PG8_BAR; }
        if constexpr (!Epi::AFTER_DRAIN) { E(acc, cur, wr, wc, fr, fq); S.done(cur); }
        if (!has_next) break;
#pragma unroll
        for (int a = 0; a < 2; ++a)
#pragma unroll
            for (int b = 0; b < 2; ++b)
#pragma unroll
                for (int m = 0; m < 4; ++m)
#pragma unroll
                    for (int n = 0; n < 2; ++n) acc[a][b][m][n] = (f32x4){0.f, 0.f, 0.f, 0.f};
        cur = nxt; cA = nA; cB = nB; ++ui;
        if constexpr (ALIGN_EPI) { if (wr == 1) PG8_BAR; }
    }
    PG8_WAIT_V(0);
    if constexpr (!ALIGN_EPI) { if (wr == 0) PG8_BAR; }
    PG8_BAR;
    if constexpr (Epi::AFTER_DRAIN) { E.fused(acc, cur, wr, wc, fr, fq, lds, wid, lane); S.done(cur); }
#undef PG8_SA
#undef PG8_SB
#undef PG8_STAGE
#undef PG8_LDA
#undef PG8_LDB
#undef PG8_MMA
#undef PG8_WAIT_V
#undef PG8_WAIT_L
#undef PG8_BAR
#undef PG8_SCHED
}
}

struct EpiInProj {
    static constexpr bool PERM = true, AFTER_DRAIN = false, MIDSCALE = false;
    const float* rstd1; const float* qn; const float* kn; bf16_t *qh, *kh, *vh, *xrg, *gg;
    __device__ __forceinline__ void operator()(const pg8::f32x4 (&acc)[2][2][4][2], const pg8::Unit& u, int wr, int wc, int fr, int fq) const {
        const int region = u.pn >> 1;
        const int head = (u.pn & 1) * 4 + wc;
        float rsv[2][4];
#pragma unroll
        for (int ai = 0; ai < 2; ++ai)
#pragma unroll
            for (int m = 0; m < 4; ++m) rsv[ai][m] = rstd1[u.pm * 256 + ai * 128 + wr * 64 + m * 16 + fr];
        pg8::f32x4 gn[2][2];
        if (region <= 1) {
            const float* g = region == 0 ? qn : kn; const float sc = region == 0 ? QSCALE : 1.0f;
#pragma unroll
            for (int bj = 0; bj < 2; ++bj)
#pragma unroll
                for (int n = 0; n < 2; ++n) gn[bj][n] = *(const pg8::f32x4*)(g + 32 * bj + 8 * fq + 4 * n) * sc;
        }
#pragma unroll
        for (int ai = 0; ai < 2; ++ai)
#pragma unroll
            for (int m = 0; m < 4; ++m) {
                const int row = u.pm * 256 + ai * 128 + wr * 64 + m * 16 + fr;
                const float rs = rsv[ai][m];
                pg8::f32x4 v[2][2];
#pragma unroll
                for (int bj = 0; bj < 2; ++bj)
#pragma unroll
                    for (int n = 0; n < 2; ++n) v[bj][n] = acc[ai][bj][m][n] * rs;
                bf16_t* dst;
                if (region <= 1) {
                    float ss = 0.f;
#pragma unroll
                    for (int bj = 0; bj < 2; ++bj)
#pragma unroll
                        for (int n = 0; n < 2; ++n) ss += (v[bj][n][0] * v[bj][n][0] + v[bj][n][1] * v[bj][n][1]) + (v[bj][n][2] * v[bj][n][2] + v[bj][n][3] * v[bj][n][3]);
                    ss += __shfl_xor(ss, 16); ss += __shfl_xor(ss, 32);
                    const float rn = rsqrtf(ss * (1.0f / HD) + EPS);
#pragma unroll
                    for (int bj = 0; bj < 2; ++bj)
#pragma unroll
                        for (int n = 0; n < 2; ++n) v[bj][n] = v[bj][n] * rn * gn[bj][n];
                    bf16_t* fb = (region == 0 ? qh : kh) + ((size_t)(head * (S / 32) + (row >> 5)) * 4 * 64 + (row & 31)) * 8;
#pragma unroll
                    for (int bj = 0; bj < 2; ++bj) {
                        pg8::u32x4 w; w.x = pg8::cvt_pk_bf16(v[bj][0][0], v[bj][0][1]); w.y = pg8::cvt_pk_bf16(v[bj][0][2], v[bj][0][3]);
                        w.z = pg8::cvt_pk_bf16(v[bj][1][0], v[bj][1][1]); w.w = pg8::cvt_pk_bf16(v[bj][1][2], v[bj][1][3]);
                        *(pg8::u32x4*)(fb + ((2 * bj + (fq >> 1)) * 64 + 32 * (fq & 1)) * 8) = w;
                    }
                    continue;
                } else if (region == 2) {
#pragma unroll
                    for (int bj = 0; bj < 2; ++bj)
#pragma unroll
                        for (int n = 0; n < 2; ++n)
#pragma unroll
                            for (int i = 0; i < 4; ++i) {
                                const int d = 32 * bj + 8 * fq + 4 * n + i, kl = row & 31;
                                vh[(((((size_t)head * (S / 32) + (row >> 5)) * 2 + (d >> 5)) * 2 + (kl >> 4)) * 64 + (d & 31) + 32 * ((kl >> 2) & 1)) * 8 + 4 * ((kl >> 3) & 1) + (kl & 3)] = (bf16_t)f2bf(v[bj][n][i]);
                            }
                    continue;
                } else if (region == 3) {
                    dst = xrg + (size_t)row * DRG + head * 64;
                } else {
#pragma unroll
                    for (int bj = 0; bj < 2; ++bj)
#pragma unroll
                        for (int n = 0; n < 2; ++n)
#pragma unroll
                            for (int i = 0; i < 4; ++i) v[bj][n][i] = gelu_tanh(v[bj][n][i]);
#pragma unroll
                    for (int bj = 0; bj < 2; ++bj)
#pragma unroll
                        for (int n = 0; n < 2; ++n)
                            *(uint2*)(gg + ((((size_t)(row >> 5) * 8 + head) * 8 + (4 * bj + fq)) * 64 + (row & 31) + 32 * n) * 4) = make_uint2(pg8::cvt_pk_bf16(v[bj][n][0], v[bj][n][1]), pg8::cvt_pk_bf16(v[bj][n][2], v[bj][n][3]));
                    continue;
                }
#pragma unroll
                for (int bj = 0; bj < 2; ++bj) {
                    pg8::u32x4 w; w.x = pg8::cvt_pk_bf16(v[bj][0][0], v[bj][0][1]); w.y = pg8::cvt_pk_bf16(v[bj][0][2], v[bj][0][3]);
                    w.z = pg8::cvt_pk_bf16(v[bj][1][0], v[bj][1][1]); w.w = pg8::cvt_pk_bf16(v[bj][1][2], v[bj][1][3]);
                    *(pg8::u32x4*)(dst + 32 * bj + 8 * fq) = w;
                }
            }
    }
};
struct EpiOutProj {
    static constexpr bool PERM = true, AFTER_DRAIN = false, MIDSCALE = true;
    __device__ __forceinline__ void mid(pg8::f32x4 (&acc)[2][2][4][2], const pg8::Unit& u, int wr, int wc, int fr, int fq) const {
        float sc[2][4];
        int fro = fr; asm volatile("" : "+v"(fro));
#pragma unroll
        for (int ai = 0; ai < 2; ++ai)
#pragma unroll
            for (int m = 0; m < 4; ++m) sc[ai][m] = rsb[u.pm * 256 + ai * 128 + wr * 64 + m * 16 + fro];
#pragma unroll
        for (int ai = 0; ai < 2; ++ai)
#pragma unroll
            for (int bj = 0; bj < 2; ++bj)
#pragma unroll
                for (int m = 0; m < 4; ++m)
#pragma unroll
                    for (int n = 0; n < 2; ++n) acc[ai][bj][m][n] = acc[ai][bj][m][n] * sc[ai][m];
    }
    const float* rsb;
    const float* x; bf16_t* x1b; float* ssq; unsigned char* x1q; float* xsc;
    __device__ __forceinline__ void operator()(const pg8::f32x4 (&acc)[2][2][4][2], const pg8::Unit& u, int wr, int wc, int fr, int fq) const {
        pg8::u32x4 xv[2][2][2];
#define OUTPROJ_LD(buf, ai_, mh_) do { _Pragma("unroll") for (int mm_ = 0; mm_ < 2; ++mm_) _Pragma("unroll") for (int bj_ = 0; bj_ < 2; ++bj_) { \
            const size_t o_ = (size_t)(u.pm * 256 + (ai_) * 128 + wr * 64 + (2 * (mh_) + mm_) * 16 + fr) * D + u.pn * 256 + bj_ * 128 + wc * 32 + 8 * fq; \
            xv[buf][mm_][bj_] = *(const pg8::u32x4*)(x1b + o_); } } while (0)
        OUTPROJ_LD(0, 0, 0);
#pragma unroll
        for (int ai = 0; ai < 2; ++ai)
#pragma unroll
            for (int m = 0; m < 4; ++m) {
                const int kb = ai * 2 + (m >> 1);
                if ((m & 1) == 0 && kb < 3) OUTPROJ_LD((kb + 1) & 1, (kb + 1) >> 1, (kb + 1) & 1);
                const int row = u.pm * 256 + ai * 128 + wr * 64 + m * 16 + fr;
                float ss = 0.f;
#pragma unroll
                for (int bj = 0; bj < 2; ++bj) {
                    const int col = u.pn * 256 + bj * 128 + wc * 32 + 8 * fq;
                    const size_t o = (size_t)row * D + col;
                    const pg8::u32x4 xw = xv[kb & 1][m & 1][bj];
                    const pg8::f32x4 a = (pg8::f32x4){u2f(xw.x << 16), u2f(xw.x & 0xffff0000u), u2f(xw.y << 16), u2f(xw.y & 0xffff0000u)} + acc[ai][bj][m][0];
                    const pg8::f32x4 b = (pg8::f32x4){u2f(xw.z << 16), u2f(xw.z & 0xffff0000u), u2f(xw.w << 16), u2f(xw.w & 0xffff0000u)} + acc[ai][bj][m][1];
                    ss += (a[0] * a[0] + a[1] * a[1]) + (a[2] * a[2] + a[3] * a[3]) + (b[0] * b[0] + b[1] * b[1]) + (b[2] * b[2] + b[3] * b[3]);
                    pg8::u32x4 w; w.x = pg8::cvt_pk_bf16(a[0], a[1]); w.y = pg8::cvt_pk_bf16(a[2], a[3]); w.z = pg8::cvt_pk_bf16(b[0], b[1]); w.w = pg8::cvt_pk_bf16(b[2], b[3]);
                    *(pg8::u32x4*)(x1b + o) = w;
                    float mx = fmaxf(fmaxf(fmaxf(fabsf(a[0]), fabsf(a[1])), fmaxf(fabsf(a[2]), fabsf(a[3]))), fmaxf(fmaxf(fabsf(b[0]), fabsf(b[1])), fmaxf(fabsf(b[2]), fabsf(b[3]))));
                    mx = fmaxf(mx, __shfl_xor(mx, 16)); mx = fmaxf(mx, __shfl_xor(mx, 32));
                    const float inv = mx > 0.f ? 119.0f / mx : 0.f;
                    unsigned pl = 0u, ph = 0u;
#pragma unroll
                    for (int i = 0; i < 4; ++i) {
                        const int qa = __float2int_rn(a[i] * inv), qb = __float2int_rn(b[i] * inv);
                        pl |= ((unsigned)(qa & 15) << (8 * i)) | ((unsigned)(qb & 15) << (8 * i + 4));
                        ph |= ((unsigned)(((qa + 8) >> 4) & 15) << (8 * i)) | ((unsigned)(((qb + 8) >> 4) & 15) << (8 * i + 4));
                    }
                    unsigned* cq = (unsigned*)(x1q + (size_t)row * D + (col & ~31));
                    cq[fq] = pl; cq[4 + fq] = ph;
                    if (fq == 0) xsc[(size_t)row * 32 + (col >> 5)] = mx * (1.0f / 119.0f);
                }
                ss += __shfl_xor(ss, 16); ss += __shfl_xor(ss, 32);
                if (fq == 0) ssq[(size_t)row * 16 + u.pn * 4 + wc] = ss;
            }
    }
};
#undef OUTPROJ_LD
struct EpiPeerQ {
    static constexpr bool PERM = true, AFTER_DRAIN = false, MIDSCALE = false;
    bf16_t* qp;
    __device__ __forceinline__ void operator()(const pg8::f32x4 (&acc)[2][2][4][2], const pg8::Unit& u, int wr, int wc, int fr, int fq) const {
#pragma unroll
        for (int ai = 0; ai < 2; ++ai)
#pragma unroll
            for (int m = 0; m < 4; ++m) {
                const int row = u.pm * 256 + ai * 128 + wr * 64 + m * 16 + fr;
#pragma unroll
                for (int bj = 0; bj < 2; ++bj) {
                    const pg8::f32x4 a = acc[ai][bj][m][0], b = acc[ai][bj][m][1];
                    pg8::u32x4 w; w.x = pg8::cvt_pk_bf16(a[0], a[1]); w.y = pg8::cvt_pk_bf16(a[2], a[3]); w.z = pg8::cvt_pk_bf16(b[0], b[1]); w.w = pg8::cvt_pk_bf16(b[2], b[3]);
                    *(pg8::u32x4*)(qp + ((((size_t)((row >> 5) * 8 + u.pn) * 2 + bj) * 8 + 2 * wc + (fq >> 1)) * 64 + (row & 31) + 32 * (fq & 1)) * 8) = w;
                }
            }
    }
};

typedef float f32x2v __attribute__((ext_vector_type(2)));
typedef __bf16 bf16x2v __attribute__((ext_vector_type(2)));
__device__ __forceinline__ unsigned cvtpk(float lo, float hi) { const f32x2v v = {lo, hi}; const bf16x2v b = __builtin_convertvector(v, bf16x2v); return __builtin_bit_cast(unsigned, b); }
__device__ __forceinline__ bf16x8 pack_step(const f32x16& x, int s) {
    u32x4 pkd; pkd.x = cvtpk(x[8 * s], x[8 * s + 1]); pkd.y = cvtpk(x[8 * s + 2], x[8 * s + 3]); pkd.z = cvtpk(x[8 * s + 4], x[8 * s + 5]); pkd.w = cvtpk(x[8 * s + 6], x[8 * s + 7]);
    return __builtin_bit_cast(bf16x8, pkd);
}
#define MFMA32(a, b, c) __builtin_amdgcn_mfma_f32_32x32x16_bf16((a), (b), (c), 0, 0, 0)
__device__ __forceinline__ void ph_attn(const Params& p) {
    unsigned char* ws = p.ws;
    const bf16_t* qh = (const bf16_t*)(ws + WS_QH); const bf16_t* kh = (const bf16_t*)(ws + WS_KH); const bf16_t* vT = (const bf16_t*)(ws + WS_VH);
    bf16_t* mixo = (bf16_t*)(ws + WS_MIX); float* ssb = (float*)(ws + WS_SSB);
    const int tid = phase_tid(), lane = tid & 63, r = lane & 31, hh = lane >> 5;
    const int gwave = (blockIdx.x * blockDim.x + tid) >> 6, nwave = (gridDim.x * blockDim.x) >> 6;
    bf16x8 tp[2];
#pragma unroll
    for (int ss = 0; ss < 2; ++ss)
#pragma unroll
        for (int e = 0; e < 8; ++e) { const int k = 16 * ss + 8 * (e >> 2) + 4 * hh + (e & 3); tp[ss][e] = (k > r) ? (short)0x3F80 : (short)0; }
    f32x16 zero16;
#pragma unroll
    for (int i = 0; i < 16; ++i) zero16[i] = 0.f;
    for (int u = gwave; u < NH * (S / 32); u += nwave) {
        const int h = u / (S / 32), t0 = (u % (S / 32)) * 32;
        bf16x8 bq[4];
#pragma unroll
        for (int s = 0; s < 4; ++s) bq[s] = *(const bf16x8*)(qh + (((size_t)(h * (S / 32) + (t0 >> 5)) * 4 + s) * 64 + lane) * 8);
        f32x16 ot[2] = {zero16, zero16};
        float carry = 0.f;
        for (int kt0 = t0; kt0 >= 0; kt0 -= 32) {
            bf16x8 ak[4], av[2][2];
#pragma unroll
            for (int s = 0; s < 4; ++s) ak[s] = *(const bf16x8*)(kh + (((size_t)(h * (S / 32) + (kt0 >> 5)) * 4 + s) * 64 + lane) * 8);
#pragma unroll
            for (int dt = 0; dt < 2; ++dt)
#pragma unroll
                for (int ss = 0; ss < 2; ++ss) av[dt][ss] = *(const bf16x8*)(vT + ((((size_t)(h * (S / 32) + (kt0 >> 5)) * 2 + dt) * 2 + ss) * 64 + lane) * 8);
            f32x16 st = zero16;
#pragma unroll
            for (int s = 0; s < 4; ++s) st = MFMA32(ak[s], bq[s], st);
            const bool diag = (kt0 == t0);
            f32x16 lom, lb;
            float csum = 0.f;
#pragma unroll
            for (int i = 0; i < 16; ++i) {
                const float z = st[i];
                const float sp2 = fmaxf(z, 0.f) + __builtin_amdgcn_logf(1.0f + __builtin_amdgcn_exp2f(-fabsf(z)));
                const bool valid = !diag || ((i & 3) + 8 * (i >> 2) + 4 * hh < r);
                lom[i] = valid ? -sp2 : 0.f;
                lb[i] = z - sp2;
                csum += lom[i];
            }
            f32x16 suf = MFMA32(tp[0], pack_step(lom, 0), zero16);
            suf = MFMA32(tp[1], pack_step(lom, 1), suf);
            f32x16 w;
#pragma unroll
            for (int i = 0; i < 16; ++i) {
                const bool valid = !diag || ((i & 3) + 8 * (i >> 2) + 4 * hh < r);
                w[i] = valid ? __builtin_amdgcn_exp2f(lb[i] + suf[i] + carry) : 0.f;
            }
            const bf16x8 w0 = pack_step(w, 0), w1 = pack_step(w, 1);
#pragma unroll
            for (int dt = 0; dt < 2; ++dt) { ot[dt] = MFMA32(av[dt][0], w0, ot[dt]); ot[dt] = MFMA32(av[dt][1], w1, ot[dt]); }
            carry += csum + __shfl_xor(csum, 32);
            if (__all(carry < CARRY_STOP)) break;
        }
        float oss = 0.f;
#pragma unroll
        for (int dt = 0; dt < 2; ++dt)
#pragma unroll
            for (int g = 0; g < 4; ++g) {
                uint2 o; o.x = cvtpk(ot[dt][4 * g], ot[dt][4 * g + 1]); o.y = cvtpk(ot[dt][4 * g + 2], ot[dt][4 * g + 3]);
                oss += (ot[dt][4 * g] * ot[dt][4 * g] + ot[dt][4 * g + 1] * ot[dt][4 * g + 1]) + (ot[dt][4 * g + 2] * ot[dt][4 * g + 2] + ot[dt][4 * g + 3] * ot[dt][4 * g + 3]);
                *(uint2*)(mixo + (size_t)(t0 + r) * D + h * HD + 32 * dt + 8 * g + 4 * hh) = o;
            }
        oss += __shfl_xor(oss, 32);
        if (hh == 0) ssb[(size_t)(t0 + r) * NH + h] = oss;
    }
}

constexpr int RG_LDS_CST = 0, RG_LDS_HIN = 16384, RG_LDS_P = 18432, RG_LDS_SSQ = 20480;
constexpr int RG_LDS_X = 22528, RG_XP = 1032, RG_LDS_O = 91904;
typedef unsigned u32x2 __attribute__((ext_vector_type(2)));
typedef __attribute__((address_space(3))) float lds_f;
typedef __attribute__((address_space(3))) unsigned char lds_b;
template <int CTRL, int ROWMASK>
__device__ __forceinline__ float dpp_mov(float oob, float x) {
    return __builtin_bit_cast(float, __builtin_amdgcn_update_dpp(__builtin_bit_cast(int, oob), __builtin_bit_cast(int, x), CTRL, ROWMASK, 0xf, false));
}
template <int CTRL, int ROWMASK>
__device__ __forceinline__ void scan_step(float (&av)[16], float (&bv)[16]) {
#pragma unroll
    for (int i = 0; i < 16; ++i) {
        const float ap = dpp_mov<CTRL, ROWMASK>(1.0f, av[i]), bp = dpp_mov<CTRL, ROWMASK>(0.0f, bv[i]);
        bv[i] = __builtin_fmaf(av[i], bp, bv[i]); av[i] *= ap;
    }
}
template <int PASS>
__device__ __forceinline__ void ph_rg(const Params& p, unsigned char* lds_raw) {
    float* lds = (float*)lds_raw;
    unsigned char* ws = p.ws;
    const bf16_t* xrg = (const bf16_t*)(ws + WS_XRG); const bf16_t* gg = (const bf16_t*)(ws + WS_GG); const bf16_t* wfrag = (const bf16_t*)(ws + WS_RGW);
    bf16_t* mix = (bf16_t*)(ws + WS_MIX);
    float* rgP = (float*)(ws + WS_RGP); float* rgH = (float*)(ws + WS_RGH);
    bf16_t* scA = (bf16_t*)(ws + WS_RGSA); bf16_t* scB = (bf16_t*)(ws + WS_RGSB);
    const int tid = phase_tid(), lane = tid & 63, r = lane & 31, hh = lane >> 5, n = __builtin_amdgcn_readfirstlane(tid >> 6);
    __syncthreads();
    if (PASS == 0) {
        static_assert(NTHR == 512, "constant-table indexing assumes 512 threads");
        const int q = tid & 31, k = (tid >> 5) & 7, h2 = (tid >> 8) & 1;
        const int cb = 32 * (q >> 4) + (q & 3) + 8 * ((q >> 2) & 3) + 4 * h2;
        const float* sp = k < 4 ? p.in[I_CONV_W] + k * DRG : k == 4 ? p.in[I_CONV_B] : k == 5 ? p.in[I_RG_B_A] : k == 6 ? p.in[I_RG_B_X] : p.in[I_RG_LAMBDA];
        float cv[8];
#pragma unroll
        for (int nn = 0; nn < 8; ++nn) cv[nn] = sp[64 * nn + cb];
#pragma unroll
        for (int nn = 0; nn < 8; ++nn) lds[tid + NTHR * nn] = k == 7 ? 8.0f * LOG2E * log1pf(__expf(-cv[nn])) : cv[nn];
    }
    const unsigned lds0 = (unsigned)(size_t)((lds_b*)lds_raw);
    const unsigned cst_base = lds0 + (unsigned)((n * 2 + hh) * 1024);
    lds_f* hin_l = (lds_f*)(size_t)(lds0 + RG_LDS_HIN + (n * 2 + hh) * 128);
    lds_f* pc_l = (lds_f*)(size_t)(lds0 + RG_LDS_P + (n * 2 + hh) * 128);
    lds_b* xt = (lds_b*)(size_t)(lds0 + RG_LDS_X);
    lds_b* ot = (lds_b*)(size_t)(lds0 + RG_LDS_O);
    f32x16 zero16;
#pragma unroll
    for (int i = 0; i < 16; ++i) zero16[i] = 0.f;
    for (int ch = blockIdx.x; ch < NCHUNK; ch += gridDim.x) {
        const int t0 = ch * CHUNK;
        constexpr int NXS = ((CHUNK + 3) * 64 + NTHR - 1) / NTHR;
        u32x4 xs[PASS == 0 ? NXS : 1];
        if (PASS == 0) {
#pragma unroll
            for (int j = 0; j < NXS; ++j) {
                const int ci = tid + NTHR * j, row = ci >> 6, c16 = ci & 63, tt = t0 - 3 + row;
                xs[j] = (u32x4){0u, 0u, 0u, 0u};
                if (ci < (CHUNK + 3) * 64 && tt >= 0) xs[j] = *(const u32x4*)(xrg + (size_t)tt * DRG + 8 * c16);
            }
            __builtin_amdgcn_sched_barrier(0);
        }
        __syncthreads();
        if (PASS == 0) {
#pragma unroll
            for (int j = 0; j < NXS; ++j) {
                const int ci = tid + NTHR * j, row = ci >> 6, c16 = ci & 63;
                if (ci < (CHUNK + 3) * 64) {
                    __attribute__((address_space(3))) u32x2* d = (__attribute__((address_space(3))) u32x2*)(xt + row * RG_XP + 16 * c16);
                    d[0] = (u32x2){xs[j].x, xs[j].y}; d[1] = (u32x2){xs[j].z, xs[j].w};
                }
            }
        }
        if (PASS == 1) {
            const int c = 64 * n + lane;
            float h = 0.f;
            int k = 0;
            for (; k + 32 <= ch; k += 32) {
                float pv[32], hv[32];
#pragma unroll
                for (int j = 0; j < 32; ++j) { pv[j] = rgP[(k + j) * DRG + c]; hv[j] = rgH[(k + j) * DRG + c]; }
#pragma unroll
                for (int j = 0; j < 32; ++j) h = pv[j] * h + hv[j];
            }
            for (; k + 8 <= ch; k += 8) {
                float pv[8], hv[8];
#pragma unroll
                for (int j = 0; j < 8; ++j) { pv[j] = rgP[(k + j) * DRG + c]; hv[j] = rgH[(k + j) * DRG + c]; }
#pragma unroll
                for (int j = 0; j < 8; ++j) h = pv[j] * h + hv[j];
            }
            for (; k < ch; ++k) h = rgP[k * DRG + c] * h + rgH[k * DRG + c];
            lds[RG_LDS_HIN / 4 + (n * 2 + ((lane >> 2) & 1)) * 32 + 16 * (lane >> 5) + 4 * ((lane >> 3) & 3) + (lane & 3)] = h;
        } else {
            if (r == 0) {
#pragma unroll
                for (int q = 0; q < 32; ++q) { hin_l[q] = 0.f; pc_l[q] = 1.f; }
            }
        }
        __syncthreads();
#pragma unroll 1
        for (int tl = 0; tl < 2; ++tl) {
            const int tok = t0 + 32 * tl + r;
            unsigned cst_a = cst_base; asm volatile("" : "+v"(cst_a));
            const lds_f* cst = (const lds_f*)(size_t)cst_a;
            float xcv[32]; bf16x8 bx[4];
            if (PASS == 0) {
#pragma unroll
            for (int q = 0; q < 32; ++q) xcv[q] = cst[4 * 32 + q];
#pragma unroll
            for (int k = 0; k < 4; ++k) {
                const lds_b* xr = xt + (32 * tl + r + k) * RG_XP + (64 * n + 4 * hh) * 2;
#pragma unroll
                for (int m = 0; m < 8; ++m) {
                    const u32x2 xw = *(const __attribute__((address_space(3))) u32x2*)(xr + 16 * m);
                    xcv[4 * m + 0] += cst[k * 32 + 4 * m + 0] * bf2f(xw.x & 0xffffu); xcv[4 * m + 1] += cst[k * 32 + 4 * m + 1] * bf2f(xw.x >> 16);
                    xcv[4 * m + 2] += cst[k * 32 + 4 * m + 2] * bf2f(xw.y & 0xffffu); xcv[4 * m + 3] += cst[k * 32 + 4 * m + 3] * bf2f(xw.y >> 16);
                }
                __builtin_amdgcn_sched_barrier(0);
            }
#pragma unroll
            for (int s = 0; s < 4; ++s) {
                u32x4 pk; pk.x = cvtpk(xcv[8 * s], xcv[8 * s + 1]); pk.y = cvtpk(xcv[8 * s + 2], xcv[8 * s + 3]); pk.z = cvtpk(xcv[8 * s + 4], xcv[8 * s + 5]); pk.w = cvtpk(xcv[8 * s + 6], xcv[8 * s + 7]);
                bx[s] = __builtin_bit_cast(bf16x8, pk);
            }
            }
            float ss = 0.f;
            const bf16_t* wb = wfrag + ((size_t)n * 16 * 64 + lane) * 8; asm volatile("" : "+v"(wb));
#pragma unroll
            for (int jt = 0; jt < 2; ++jt) {
                float av[16], bv[16];
                const size_t sco = ((((size_t)(2 * ch + tl) * 8 + n) * 2 + jt) * 64 + lane) * 16;
                if (PASS == 0) {
#pragma unroll
                for (int g = 0; g < 2; ++g) {
                    f32x16 acc = zero16;
#pragma unroll
                    for (int s = 0; s < 4; ++s) {
                        const bf16x8 aw = *(const __attribute__((address_space(1))) bf16x8*)(wb + (((g * 2 + jt) * 4 + s) * 64) * 8);
                        acc = MFMA32(aw, bx[s], acc);
                    }
#pragma unroll
                    for (int i = 0; i < 16; ++i) {
                        const int q = 16 * jt + i;
                        const float pre = acc[i] + cst[(5 + g) * 32 + q];
                        const float sg = 1.0f / (1.0f + __builtin_amdgcn_exp2f(-LOG2E * pre));
                        if (g == 0) av[i] = __builtin_amdgcn_exp2f(-sg * cst[7 * 32 + q]);
                        else bv[i] = __builtin_amdgcn_sqrtf(fmaxf(__builtin_fmaf(-av[i], av[i], 1.0f), 0.f)) * (sg * xcv[q]);
                    }
                    __builtin_amdgcn_sched_barrier(0);
                }
                scan_step<0x111, 0xf>(av, bv); scan_step<0x112, 0xf>(av, bv); scan_step<0x114, 0xf>(av, bv); scan_step<0x118, 0xf>(av, bv);
                scan_step<0x142, 0xa>(av, bv);
                u32x4 sa0, sa1, sb0, sb1;
                sa0.x = cvtpk(av[0], av[1]); sa0.y = cvtpk(av[2], av[3]); sa0.z = cvtpk(av[4], av[5]); sa0.w = cvtpk(av[6], av[7]); sa1.x = cvtpk(av[8], av[9]); sa1.y = cvtpk(av[10], av[11]); sa1.z = cvtpk(av[12], av[13]); sa1.w = cvtpk(av[14], av[15]);
                sb0.x = cvtpk(bv[0], bv[1]); sb0.y = cvtpk(bv[2], bv[3]); sb0.z = cvtpk(bv[4], bv[5]); sb0.w = cvtpk(bv[6], bv[7]); sb1.x = cvtpk(bv[8], bv[9]); sb1.y = cvtpk(bv[10], bv[11]); sb1.z = cvtpk(bv[12], bv[13]); sb1.w = cvtpk(bv[14], bv[15]);
                *(u32x4*)(scA + sco) = sa0; *(u32x4*)(scA + sco + 8) = sa1; *(u32x4*)(scB + sco) = sb0; *(u32x4*)(scB + sco + 8) = sb1;
                } else {
                    const u32x4 sa0 = *(const u32x4*)(scA + sco), sa1 = *(const u32x4*)(scA + sco + 8), sb0 = *(const u32x4*)(scB + sco), sb1 = *(const u32x4*)(scB + sco + 8);
                    const unsigned wa[8] = {sa0.x, sa0.y, sa0.z, sa0.w, sa1.x, sa1.y, sa1.z, sa1.w}, wbb[8] = {sb0.x, sb0.y, sb0.z, sb0.w, sb1.x, sb1.y, sb1.z, sb1.w};
#pragma unroll
                    for (int k = 0; k < 8; ++k) { av[2 * k] = bf2f(wa[k] & 0xffffu); av[2 * k + 1] = bf2f(wa[k] >> 16); bv[2 * k] = bf2f(wbb[k] & 0xffffu); bv[2 * k + 1] = bf2f(wbb[k] >> 16); }
                }
                __builtin_amdgcn_sched_barrier(0);
#pragma unroll
                for (int i = 0; i < 16; ++i) {
                    const int q = 16 * jt + i;
                    const float h = __builtin_fmaf(av[i], hin_l[q], bv[i]);
                    if (r == 31) { hin_l[q] = h; if (PASS == 0) pc_l[q] *= av[i]; }
                    bv[i] = h;
                }
                if (PASS == 1) {
#pragma unroll
                    for (int g4 = 0; g4 < 4; ++g4) {
                        const int m = 4 * jt + g4;
                        const uint2 gw = *(const uint2*)(gg + ((((size_t)(tok >> 5) * 8 + n) * 8 + m) * 64 + lane) * 4);
                        const float o0 = bv[4 * g4] * bf2f(gw.x & 0xffffu), o1 = bv[4 * g4 + 1] * bf2f(gw.x >> 16), o2 = bv[4 * g4 + 2] * bf2f(gw.y & 0xffffu), o3 = bv[4 * g4 + 3] * bf2f(gw.y >> 16);
                        ss += (o0 * o0 + o1 * o1) + (o2 * o2 + o3 * o3);
                        *(__attribute__((address_space(3))) u32x2*)(ot + (32 * tl + r) * RG_XP + (64 * n + 8 * m + 4 * hh) * 2) = (u32x2){cvtpk(o0, o1), cvtpk(o2, o3)};
                    }
                }
                __builtin_amdgcn_sched_barrier(0);
            }
            if (PASS == 1) { ss += __shfl_xor(ss, 32); if (hh == 0) lds[RG_LDS_SSQ / 4 + (tl * 8 + n) * 32 + r] = ss; }
        }
        if (PASS == 0) {
            if (r == 0) {
#pragma unroll
                for (int m = 0; m < 8; ++m) {
                    const int c = 64 * n + 8 * m + 4 * hh;
                    *(f32x4*)(rgP + (size_t)ch * DRG + c) = (f32x4){pc_l[4 * m], pc_l[4 * m + 1], pc_l[4 * m + 2], pc_l[4 * m + 3]};
                    *(f32x4*)(rgH + (size_t)ch * DRG + c) = (f32x4){hin_l[4 * m], hin_l[4 * m + 1], hin_l[4 * m + 2], hin_l[4 * m + 3]};
                }
            }
        } else {
            __syncthreads();
            for (int j = 0; j < 8; ++j) {
                const int tr = 8 * n + j, tok = t0 + tr;
                float tot = 0.f;
#pragma unroll
                for (int w = 0; w < 8; ++w) tot += lds[RG_LDS_SSQ / 4 + ((tr >> 5) * 8 + w) * 32 + (tr & 31)];
                const float rn = rsqrtf(tot * (1.0f / DRG) + EPS);
                const __attribute__((address_space(3))) u32x2* op = (const __attribute__((address_space(3))) u32x2*)(ot + tr * RG_XP + 16 * lane);
                const u32x2 w0 = op[0], w1 = op[1];
                u32x4 o2; o2.x = cvtpk(bf2f(w0.x & 0xffffu) * rn, bf2f(w0.x >> 16) * rn); o2.y = cvtpk(bf2f(w0.y & 0xffffu) * rn, bf2f(w0.y >> 16) * rn);
                o2.z = cvtpk(bf2f(w1.x & 0xffffu) * rn, bf2f(w1.x >> 16) * rn); o2.w = cvtpk(bf2f(w1.y & 0xffffu) * rn, bf2f(w1.y >> 16) * rn);
                *((u32x4*)(mix + (size_t)tok * D + DSB) + lane) = o2;
            }
            if (tid < CHUNK) {
                const f32x4 s0 = *(const f32x4*)(ws + WS_SSB + (size_t)(t0 + tid) * NH * 4), s1 = *(const f32x4*)(ws + WS_SSB + (size_t)(t0 + tid) * NH * 4 + 16);
                ((float*)(ws + WS_RSB))[t0 + tid] = rsqrtf(((s0.x + s0.y) + (s0.z + s0.w) + (s1.x + s1.y) + (s1.z + s1.w)) * (1.0f / DSB) + EPS);
            }
        }
    }
}

__device__ __forceinline__ float kmax(float a, float b) { float r; asm("v_max_f32 %0, %1, %2" : "=v"(r) : "v"(a), "v"(b)); return r; }
__device__ __forceinline__ float kmin(float a, float b) { float r; asm("v_min_f32 %0, %1, %2" : "=v"(r) : "v"(a), "v"(b)); return r; }
__device__ __forceinline__ float key_tag(float f, unsigned keep, unsigned tag) { return __builtin_bit_cast(float, (__builtin_bit_cast(unsigned, f) & keep) | tag); }
#define TOPK_CE(a, b) do { const float hi_ = kmax(a, b), lo_ = kmin(a, b); a = hi_; b = lo_; } while (0)
__device__ __forceinline__ void sort16_desc(float (&v)[16]) { TOPK_CE(v[0], v[1]); TOPK_CE(v[2], v[3]); TOPK_CE(v[0], v[2]); TOPK_CE(v[1], v[3]); TOPK_CE(v[1], v[2]); TOPK_CE(v[4], v[5]); TOPK_CE(v[6], v[7]); TOPK_CE(v[4], v[6]); TOPK_CE(v[5], v[7]); TOPK_CE(v[5], v[6]); TOPK_CE(v[0], v[4]); TOPK_CE(v[2], v[6]); TOPK_CE(v[2], v[4]); TOPK_CE(v[1], v[5]); TOPK_CE(v[3], v[7]); TOPK_CE(v[3], v[5]); TOPK_CE(v[1], v[2]); TOPK_CE(v[3], v[4]); TOPK_CE(v[5], v[6]); TOPK_CE(v[8], v[9]); TOPK_CE(v[10], v[11]); TOPK_CE(v[8], v[10]); TOPK_CE(v[9], v[11]); TOPK_CE(v[9], v[10]); TOPK_CE(v[12], v[13]); TOPK_CE(v[14], v[15]); TOPK_CE(v[12], v[14]); TOPK_CE(v[13], v[15]); TOPK_CE(v[13], v[14]); TOPK_CE(v[8], v[12]); TOPK_CE(v[10], v[14]); TOPK_CE(v[10], v[12]); TOPK_CE(v[9], v[13]); TOPK_CE(v[11], v[15]); TOPK_CE(v[11], v[13]); TOPK_CE(v[9], v[10]); TOPK_CE(v[11], v[12]); TOPK_CE(v[13], v[14]); TOPK_CE(v[0], v[8]); TOPK_CE(v[4], v[12]); TOPK_CE(v[4], v[8]); TOPK_CE(v[2], v[10]); TOPK_CE(v[6], v[14]); TOPK_CE(v[6], v[10]); TOPK_CE(v[2], v[4]); TOPK_CE(v[6], v[8]); TOPK_CE(v[10], v[12]); TOPK_CE(v[1], v[9]); TOPK_CE(v[5], v[13]); TOPK_CE(v[5], v[9]); TOPK_CE(v[3], v[11]); TOPK_CE(v[7], v[15]); TOPK_CE(v[7], v[11]); TOPK_CE(v[3], v[5]); TOPK_CE(v[7], v[9]); TOPK_CE(v[11], v[13]); TOPK_CE(v[1], v[2]); TOPK_CE(v[3], v[4]); TOPK_CE(v[5], v[6]); TOPK_CE(v[7], v[8]); TOPK_CE(v[9], v[10]); TOPK_CE(v[11], v[12]); TOPK_CE(v[13], v[14]); }
__device__ __forceinline__ void merge16_desc(float (&a)[16], const float (&b)[16]) {
#pragma unroll
    for (int i = 0; i < 16; ++i) a[i] = kmax(a[i], b[15 - i]);
#pragma unroll
    for (int d = 8; d >= 1; d >>= 1)
#pragma unroll
        for (int i = 0; i < 16; ++i) if ((i & d) == 0) TOPK_CE(a[i], a[i + d]);
}
__device__ __forceinline__ void ph_topk(const Params& p, int* lds) {
    unsigned char* ws = p.ws;
    const bf16_t* qp = (const bf16_t*)(ws + WS_B); const bf16_t* subk = (const bf16_t*)(ws + WS_SUBK);
    int* seli = (int*)(ws + WS_SELI); float* selg = (float*)(ws + WS_SELG);
    const float* ssq = (const float*)(ws + WS_SSQ); float* rstd2 = (float*)(ws + WS_RSTD2);
    const int tid = phase_tid(), lane = tid & 63, r = lane & 31, hh = lane >> 5, hx = 4 * hh;
    const int gwave = (blockIdx.x * blockDim.x + tid) >> 6, nwave = (gridDim.x * blockDim.x) >> 6;
    constexpr int SK_OFF = 65536, SK_PITCH = 272;
    typedef __attribute__((address_space(3))) unsigned char lds_b;
    lds_b* skl = (lds_b*)lds + SK_OFF;
    const int w = tid >> 6;
    pg8::StaticOrder so; so.init(S, NQ, (int)gridDim.x, (int)blockIdx.x);
    pg8::Unit gu;
    for (int ui = 0; so.next(ui, gu); ++ui) {
        const int h = gu.pn, t0 = gu.pm * 256 + 32 * w, t = t0 + r;
        u32x4 skv[8]; bf16x8 bq[2][8];
#pragma unroll
        for (int j = 0; j < 8; ++j) {
            const int ci = tid + NTHR * j, row = ci >> 4, c16 = ci & 15;
            skv[j] = *(const u32x4*)(subk + ((size_t)h * 256 + row) * PHALF + 8 * c16);
        }
#pragma unroll
        for (int pp = 0; pp < 2; ++pp)
#pragma unroll
            for (int s = 0; s < 8; ++s) bq[pp][s] = *(const bf16x8*)(qp + ((((size_t)((t0 >> 5) * 8 + h) * 2 + pp) * 8 + s) * 64 + lane) * 8);
        __builtin_amdgcn_sched_barrier(0);
        __syncthreads();
#pragma unroll
        for (int j = 0; j < 8; ++j) {
            const int ci = tid + NTHR * j, row = ci >> 4, c16 = ci & 15;
            *(__attribute__((address_space(3))) u32x4*)(skl + row * SK_PITCH + 16 * c16) = skv[j];
        }
        __syncthreads();
        float tk[2][16];
#pragma unroll
        for (int pp = 0; pp < 2; ++pp) {
            f32x16 acc[4];
#pragma unroll
            for (int T = 0; T < 4; ++T)
#pragma unroll
                for (int i = 0; i < 16; ++i) acc[T][i] = 0.f;
            const lds_b* krow = skl + (pp * PNK + r) * SK_PITCH + 16 * hh;
#pragma unroll
            for (int s = 0; s < 8; ++s) {
                const bf16x8 b = bq[pp][s];
#pragma unroll
                for (int T = 0; T < 4; ++T) {
                    const bf16x8 a = *(const __attribute__((address_space(3))) bf16x8*)(krow + (32 * T) * SK_PITCH + 32 * s);
                    acc[T] = __builtin_amdgcn_mfma_f32_32x32x16_bf16(a, b, acc[T], 0, 0, 0);
                }
            }
            float kq[4][16];
#pragma unroll
            for (int T = 0; T < 4; ++T) {
#pragma unroll
                for (int i = 0; i < 16; ++i) {
                    const int nb = 32 * T + (i & 3) + 8 * (i >> 2);
                    kq[T][i] = key_tag(acc[T][i], ~127u, (unsigned)(127 - nb));
                }
                sort16_desc(kq[T]);
            }
            merge16_desc(kq[0], kq[1]); merge16_desc(kq[2], kq[3]); merge16_desc(kq[0], kq[2]);
            float m[16], po[16];
#pragma unroll
            for (int i = 0; i < 16; ++i) { m[i] = __builtin_bit_cast(float, __builtin_bit_cast(int, kq[0][i]) ^ hx); po[i] = __shfl_xor(m[i], 32); }
            merge16_desc(m, po);
#pragma unroll
            for (int i = 0; i < 16; ++i) tk[pp][i] = m[i];
        }
#pragma unroll
        for (int i = 0; i < 16; ++i) { lds[i * NTHR + tid] = __builtin_bit_cast(int, tk[0][i]); lds[(16 + i) * NTHR + tid] = __builtin_bit_cast(int, tk[1][i]); }
        const float (&v0)[16] = tk[0]; const float (&v1)[16] = tk[1];
#define CKEY(a, b) key_tag(v0[a] + v1[b], ~255u, (unsigned)(255 - ((a) * 16 + (b))))
        const float NEGK = __builtin_bit_cast(float, 0xff800000u);
        float bk[16], l1[16], ga[16], gb[16];
#pragma unroll
        for (int b = 0; b < 16; ++b) bk[b] = CKEY(0, b);
#pragma unroll
        for (int b = 0; b < 16; ++b) l1[b] = b < 8 ? CKEY(1, b) : NEGK;
        ga[0] = CKEY(2, 0); ga[1] = CKEY(2, 1); ga[2] = CKEY(2, 2); ga[3] = CKEY(2, 3); ga[4] = CKEY(2, 4);
        ga[5] = CKEY(3, 0); ga[6] = CKEY(3, 1); ga[7] = CKEY(3, 2); ga[8] = CKEY(3, 3);
        ga[9] = CKEY(4, 0); ga[10] = CKEY(4, 1); ga[11] = CKEY(4, 2); ga[12] = CKEY(5, 0); ga[13] = CKEY(5, 1); ga[14] = NEGK; ga[15] = NEGK;
        gb[0] = CKEY(6, 0); gb[1] = CKEY(6, 1); gb[2] = CKEY(7, 0); gb[3] = CKEY(7, 1);
#pragma unroll
        for (int a = 8; a < 16; ++a) gb[a - 4] = CKEY(a, 0);
        gb[12] = NEGK; gb[13] = NEGK; gb[14] = NEGK; gb[15] = NEGK;
#undef CKEY
        sort16_desc(ga); sort16_desc(gb);
        merge16_desc(bk, l1); merge16_desc(ga, gb); merge16_desc(bk, ga);
        float ssum = 0.f;
#pragma unroll
        for (int i = 0; i < 4; ++i) { const f32x4 q4 = *(const f32x4*)(ssq + (size_t)t * 16 + 4 * i); ssum += (q4.x + q4.y) + (q4.z + q4.w); }
        const float rs = rsqrtf(ssum * (1.0f / D) + EPS);
        float e[16], sum = 0.f; const float mx = bk[0];
#pragma unroll
        for (int i = 0; i < 16; ++i) { e[i] = __expf((bk[i] - mx) * rs); sum += e[i]; }
        const float inv = 1.0f / sum;
        int eidx[16];
#pragma unroll
        for (int i = 0; i < 16; ++i) {
            const int code = 255 - (__builtin_bit_cast(int, bk[i]) & 255), a = code >> 4, b = code & 15;
            const int i1 = 127 - (lds[a * NTHR + tid] & 127), i2 = 127 - (lds[(16 + b) * NTHR + tid] & 127);
            eidx[i] = i1 * PNK + i2; e[i] *= inv;
        }
        if (hh == 0) {
            int4* o = (int4*)(seli + (size_t)t * 128 + h * 16);
#pragma unroll
            for (int i = 0; i < 4; ++i) o[i] = make_int4(eidx[4 * i], eidx[4 * i + 1], eidx[4 * i + 2], eidx[4 * i + 3]);
            if (h == 0) rstd2[t] = rs;
        } else {
            f32x4* o = (f32x4*)(selg + (size_t)t * 128 + h * 16);
#pragma unroll
            for (int i = 0; i < 4; ++i) o[i] = (f32x4){e[4 * i], e[4 * i + 1], e[4 * i + 2], e[4 * i + 3]};
        }
    }
}

typedef __bf16 bf16x2_t __attribute__((ext_vector_type(2)));
typedef float f32x2 __attribute__((ext_vector_type(2)));
template <int NV, int XS0, int XS1, int XS2>
__device__ __forceinline__ void reduce_over8(float (&v)[NV], int sel) {
    { const bool up = sel & 1;
#pragma unroll
      for (int i = 0; i < NV / 2; ++i) { const float a = v[2 * i], b = v[2 * i + 1]; v[i] = (up ? b : a) + __shfl_xor(up ? a : b, XS0); } }
    { const bool up = (sel >> 1) & 1;
#pragma unroll
      for (int i = 0; i < NV / 4; ++i) { const float a = v[2 * i], b = v[2 * i + 1]; v[i] = (up ? b : a) + __shfl_xor(up ? a : b, XS1); } }
    { const bool up = (sel >> 2) & 1;
#pragma unroll
      for (int i = 0; i < NV / 8; ++i) { const float a = v[2 * i], b = v[2 * i + 1]; v[i] = (up ? b : a) + __shfl_xor(up ? a : b, XS2); } }
}
__device__ __forceinline__ void peer_load_idx(const unsigned char* ws, int t, int rsl, int (&ei)[16]) {
    const unsigned off = (unsigned)WS_SELI + ((unsigned)t * 128u + 16u * (unsigned)rsl) * 4u;
#pragma unroll
    for (int j = 0; j < 4; ++j) { const int4 v = *(const int4*)(ws + (off + 16u * j)); ei[4 * j] = v.x; ei[4 * j + 1] = v.y; ei[4 * j + 2] = v.z; ei[4 * j + 3] = v.w; }
}
template <int PASS>
__device__ __forceinline__ void peer_load_rows(const unsigned char* ws, int t, int sl, int rsl, int c, const int (&ei)[16], u32x4 (&row)[16], u32x4 (&aux)[4]) {
    const unsigned tab = (unsigned)(PASS == 0 ? WS_UB : WS_VB) + (unsigned)sl * (unsigned)(NEXP * 128) + 16u * (unsigned)c;
#pragma unroll
    for (int i = 0; i < 16; ++i) row[i] = *(const u32x4*)(ws + (tab + (unsigned)ei[i] * 128u));
    const unsigned xo = (unsigned)WS_X1Q + (unsigned)t * (unsigned)D + 256u * sl + 32u * c;
    aux[0] = *(const u32x4*)(ws + xo); aux[1] = *(const u32x4*)(ws + (xo + 16u));
    aux[2].x = *(const unsigned*)(ws + ((unsigned)WS_XSC + ((unsigned)t * 32u + 8u * sl + c) * 4u));
}
constexpr int PEER_IMG_PITCH = 136, PEER_IMG_BYTES = 128 * PEER_IMG_PITCH;
template <int PASS  >
__device__ __forceinline__ void peer_compute(const Params& p, unsigned char* lds, int lane_w, int t, int sl, int rsl, int c, const u32x4 (&row)[16], const u32x4 (&aux)[4]) {
    unsigned char* ws = p.ws;
    if (PASS == 0) {
        const u32x4 x0 = aux[0], x1_ = aux[1]; const unsigned xl[4] = {x0.x, x0.y, x0.z, x0.w}, xh[4] = {x1_.x, x1_.y, x1_.z, x1_.w};
        const unsigned xsu = aux[2].x; const float xs = u2f(xsu);
        float pd[16];
#pragma unroll
        for (int i = 0; i < 16; ++i) {
            const u32x4 rw = row[i]; const unsigned w4[4] = {rw.x, rw.y, rw.z, rw.w};
            int al = 0, ah = 0;
#pragma unroll
            for (int j = 0; j < 4; ++j) { al = __builtin_amdgcn_sdot8((int)w4[j], (int)xl[j], al, false); ah = __builtin_amdgcn_sdot8((int)w4[j], (int)xh[j], ah, false); }
            pd[i] = (float)(16 * ah + al) * xs;
        }
        reduce_over8<16, 1, 2, 4>(pd, c);
        const unsigned po = (unsigned)WS_PD + (((unsigned)sl * S + (unsigned)t) * 128u + 16u * rsl + c) * 4u;
        *(float*)(ws + po) = pd[0]; *(float*)(ws + (po + 32u)) = pd[1];
    }
}
template <int PASS>
__device__ __forceinline__ void peer_stream(const Params& p, unsigned char* lds, int lane_w, int sl, int t0, int dt, int n) {
    const unsigned char* ws = p.ws;
    const int lane = lane_w & 63, rsl = lane >> 3, c = lane & 7;
    int eiA[16], eiB[16]; u32x4 rowA[16], rowB[16], auxA[4], auxB[4];
    if (n <= 0) return;
    peer_load_idx(ws, t0, rsl, eiA);
    peer_load_rows<PASS>(ws, t0, sl, rsl, c, eiA, rowA, auxA);
    if (n > 1) peer_load_idx(ws, t0 + dt, rsl, eiB);
    for (int i = 0; i < n; i += 2) {
        const int t = t0 + i * dt;
        if (i + 1 < n) peer_load_rows<PASS>(ws, t + dt, sl, rsl, c, eiB, rowB, auxB);
        if (i + 2 < n) peer_load_idx(ws, t + 2 * dt, rsl, eiA);
        peer_compute<PASS>(p, lds, lane_w, t, sl, rsl, c, rowA, auxA);
        if (i + 1 < n) {
            if (i + 2 < n) peer_load_rows<PASS>(ws, t + 2 * dt, sl, rsl, c, eiA, rowA, auxA);
            if (i + 3 < n) peer_load_idx(ws, t + 3 * dt, rsl, eiB);
            peer_compute<PASS>(p, lds, lane_w, t + dt, sl, rsl, c, rowB, auxB);
        }
    }
}
__device__ __forceinline__ void peerv_load_idx(const unsigned char* ws, int t, int hf, int rsl, int (&ei)[8]) {
    const unsigned off = (unsigned)WS_SELI + ((unsigned)t * 128u + 16u * (unsigned)rsl + 8u * (unsigned)hf) * 4u;
    const int4 v0 = *(const int4*)(ws + off), v1 = *(const int4*)(ws + (off + 16u));
    ei[0] = v0.x; ei[1] = v0.y; ei[2] = v0.z; ei[3] = v0.w; ei[4] = v1.x; ei[5] = v1.y; ei[6] = v1.z; ei[7] = v1.w;
}
__device__ __forceinline__ void peerv_load_rows(const unsigned char* ws, int sl, int c, const int (&ei)[8], u32x4 (&row)[8]) {
    const unsigned tab = (unsigned)WS_VB + (unsigned)sl * (unsigned)(NEXP * 128) + 16u * (unsigned)c;
#pragma unroll
    for (int i = 0; i < 8; ++i) row[i] = *(const u32x4*)(ws + (tab + (unsigned)ei[i] * 128u));
}
struct PeerVAux { u32x4 cp; unsigned cs; unsigned xo[4]; };
__device__ __forceinline__ void peerv_load_aux(const unsigned char* ws, int t, int sl, int lane, PeerVAux& a) {
    a.cp = *(const u32x4*)(ws + ((unsigned)WS_CBUF + (unsigned)t * 128u + 16u * (unsigned)(lane & 7)));
    a.cs = *(const unsigned*)(ws + ((unsigned)WS_CSC + (unsigned)t * 4u));
    const unsigned xo = (unsigned)WS_A + ((unsigned)t * (unsigned)D + 256u * sl + (unsigned)lane) * 2u;
    a.xo[0] = *(const bf16_t*)(ws + xo); a.xo[1] = *(const bf16_t*)(ws + (xo + 128u)); a.xo[2] = *(const bf16_t*)(ws + (xo + 256u)); a.xo[3] = *(const bf16_t*)(ws + (xo + 384u));
}
template <int HF>
__device__ __forceinline__ void peerv_half(lds_b* img, int lane, const u32x4 (&row)[8], const PeerVAux& a, int (&acc)[4]) {
    const int rsl = lane >> 3, c = lane & 7;
#pragma unroll
    for (int i = 0; i < 8; ++i) {
        const u32x4 rw = row[i];
        __attribute__((address_space(3))) u32x2* d = (__attribute__((address_space(3))) u32x2*)(img + (16 * rsl + i) * PEER_IMG_PITCH + 16 * c);
        d[0] = (u32x2){rw.x, rw.y}; d[1] = (u32x2){rw.z, rw.w};
    }
    const unsigned cpl = HF == 0 ? a.cp.x : a.cp.y, cph = HF == 0 ? a.cp.z : a.cp.w;
    asm volatile("s_waitcnt lgkmcnt(0)" ::: "memory");
    const unsigned ra = (unsigned)(size_t)img + (unsigned)((lane & 15) * PEER_IMG_PITCH + 8 * (lane >> 4));
#define PEER_TR4(R0, R1, R2, R3, RS) asm volatile("ds_read_b64_tr_b4 %0, %4 offset:%5\n\tds_read_b64_tr_b4 %1, %4 offset:%6\n\tds_read_b64_tr_b4 %2, %4 offset:%7\n\tds_read_b64_tr_b4 %3, %4 offset:%8" \
            : "=&v"(R0), "=&v"(R1), "=&v"(R2), "=&v"(R3) : "v"(ra), "i"((RS) * 16 * PEER_IMG_PITCH), "i"((RS) * 16 * PEER_IMG_PITCH + 32), "i"((RS) * 16 * PEER_IMG_PITCH + 64), "i"((RS) * 16 * PEER_IMG_PITCH + 96) : "memory")
#define PEER_USE4(R0, R1, R2, R3, RS, WAITSTR) do { \
            asm volatile(WAITSTR : "+v"(R0), "+v"(R1), "+v"(R2), "+v"(R3) :: "memory"); \
            const int cl_ = __builtin_amdgcn_readlane((int)cpl, RS), ch_ = __builtin_amdgcn_readlane((int)cph, RS); \
            const unsigned lo4_[4] = {R0.x, R1.x, R2.x, R3.x}; \
            _Pragma("unroll") for (int tcg = 0; tcg < 4; ++tcg) acc[tcg] += 16 * __builtin_amdgcn_sdot8((int)lo4_[tcg], ch_, 0, false) + __builtin_amdgcn_sdot8((int)lo4_[tcg], cl_, 0, false); } while (0)
    {
        u32x2 a0, a1, a2, a3, b0, b1, b2, b3;
        PEER_TR4(a0, a1, a2, a3, 0);
        PEER_TR4(b0, b1, b2, b3, 1); PEER_USE4(a0, a1, a2, a3, 0, "s_waitcnt lgkmcnt(4)");
        PEER_TR4(a0, a1, a2, a3, 2); PEER_USE4(b0, b1, b2, b3, 1, "s_waitcnt lgkmcnt(4)");
        PEER_TR4(b0, b1, b2, b3, 3); PEER_USE4(a0, a1, a2, a3, 2, "s_waitcnt lgkmcnt(4)");
        PEER_TR4(a0, a1, a2, a3, 4); PEER_USE4(b0, b1, b2, b3, 3, "s_waitcnt lgkmcnt(4)");
        PEER_TR4(b0, b1, b2, b3, 5); PEER_USE4(a0, a1, a2, a3, 4, "s_waitcnt lgkmcnt(4)");
        PEER_TR4(a0, a1, a2, a3, 6); PEER_USE4(b0, b1, b2, b3, 5, "s_waitcnt lgkmcnt(4)");
        PEER_TR4(b0, b1, b2, b3, 7); PEER_USE4(a0, a1, a2, a3, 6, "s_waitcnt lgkmcnt(4)");
        PEER_USE4(b0, b1, b2, b3, 7, "s_waitcnt lgkmcnt(0)");
    }
#undef PEER_TR4
#undef PEER_USE4
}
__device__ __forceinline__ void peerv_stream(const Params& p, unsigned char* lds, int tid_, int sl, int t0, int dt, int n) {
    const unsigned char* ws = p.ws;
    const int lane = tid_ & 63, rsl = lane >> 3, c = lane & 7;
    lds_b* img = (lds_b*)lds + (tid_ >> 6) * PEER_IMG_BYTES;
    for (int e = lane; e < 64 * (PEER_IMG_PITCH / 8); e += 64) {
        const int zr = e / (PEER_IMG_PITCH / 8), zc = e % (PEER_IMG_PITCH / 8);
        *(__attribute__((address_space(3))) u32x2*)(img + (16 * (zr >> 3) + 8 + (zr & 7)) * PEER_IMG_PITCH + 8 * zc) = (u32x2){0u, 0u};
    }
    if (n <= 0) return;
    int ei0[8], ei1[8]; u32x4 rowA[8], rowB[8]; PeerVAux ax, axn;
    peerv_load_idx(ws, t0, 0, rsl, ei0);
    peerv_load_rows(ws, sl, c, ei0, rowA); peerv_load_aux(ws, t0, sl, lane, ax);
    peerv_load_idx(ws, t0, 1, rsl, ei1);
    for (int i = 0; i < n; ++i) {
        const int t = t0 + i * dt; const bool more = i + 1 < n;
        int acc[4] = {0, 0, 0, 0};
        peerv_load_rows(ws, sl, c, ei1, rowB);
        if (more) peerv_load_idx(ws, t + dt, 0, rsl, ei0);
        peerv_half<0>(img, lane, rowA, ax, acc);
        if (more) { peerv_load_rows(ws, sl, c, ei0, rowA); peerv_load_aux(ws, t + dt, sl, lane, axn); peerv_load_idx(ws, t + dt, 1, rsl, ei1); }
        peerv_half<1>(img, lane, rowB, ax, acc);
        const float cs = u2f(ax.cs);
#pragma unroll
        for (int tcg = 0; tcg < 4; ++tcg) {
            const unsigned oo = ((unsigned)t * (unsigned)D + 256u * sl + 64u * tcg + (unsigned)lane) * 4u;
            *(float*)((unsigned char*)p.out + oo) = bf2f(ax.xo[tcg]) + (float)acc[tcg] * cs;
        }
        if (more) ax = axn;
    }
}
template <int PASS>
__device__ __forceinline__ void ph_peer(const Params& p, unsigned char* lds) {
    const int tid_ = phase_tid();
    const int lane = tid_ & 63, w = tid_ >> 6, b = blockIdx.x, G = gridDim.x;
    if ((G & 7) == 0) {
        const int g = b & 7, nsw = (G >> 3) * 2 * (NTHR / 64), t0 = ((g >> 2) * (G >> 3) + (b >> 3)) * (NTHR / 64) + w;
        if (PASS == 0) peer_stream<0>(p, lds, tid_, g & 3, t0, nsw, t0 < S ? (S - 1 - t0) / nsw + 1 : 0);
        else peerv_stream(p, lds, tid_, g & 3, t0, nsw, t0 < S ? (S - 1 - t0) / nsw + 1 : 0);
    } else {
        const int nw = G * (NTHR / 64), it0 = b * (NTHR / 64) + w;
        for (int it = it0; it < S * 4; it += nw) { if (PASS == 0) peer_stream<0>(p, lds, tid_, it & 3, it >> 2, 0, 1); else peerv_stream(p, lds, tid_, it & 3, it >> 2, 0, 1); }
    }
}
__device__ __forceinline__ void ph_peer_combine(const Params& p) {
    unsigned char* ws = p.ws;
    const int* seli = (const int*)(ws + WS_SELI); const float* selg = (const float*)(ws + WS_SELG); const float* rstd2 = (const float*)(ws + WS_RSTD2);
    const float2* uvsc = (const float2*)(ws + WS_USC);
    const float* pd = (const float*)(ws + WS_PD);
    unsigned* cpl = (unsigned*)(ws + WS_CBUF); float* csc = (float*)(ws + WS_CSC);
    const int tid_ = phase_tid(), lane = tid_ & 63, gwave = (blockIdx.x * blockDim.x + tid_) >> 6, nwave = (gridDim.x * blockDim.x) >> 6;
    constexpr int TT = 4;
    for (int tb = gwave; tb < S; tb += TT * nwave) {
        float dsum[TT][2], sg[TT][2], rsd[TT]; int ei[TT][2];
#pragma unroll
        for (int k = 0; k < TT; ++k) {
            const int t = min(tb + k * nwave, S - 1);
#pragma unroll
            for (int hf = 0; hf < 2; ++hf) {
                const int e = t * 128 + 64 * hf + lane;
                ei[k][hf] = seli[e]; sg[k][hf] = selg[e];
                float d = 0.f;
#pragma unroll
                for (int g = 0; g < 4; ++g) d += pd[(size_t)g * S * 128 + e];
                dsum[k][hf] = d;
            }
            rsd[k] = rstd2[t];
        }
        float2 sc2[TT][2];
#pragma unroll
        for (int k = 0; k < TT; ++k)
#pragma unroll
            for (int hf = 0; hf < 2; ++hf) sc2[k][hf] = uvsc[ei[k][hf]];
#pragma unroll
        for (int k = 0; k < TT; ++k) {
            const int t = tb + k * nwave;
            if (t >= S) break;
            float cf[2];
#pragma unroll
            for (int hf = 0; hf < 2; ++hf) cf[hf] = sg[k][hf] * gelu_tanh(dsum[k][hf] * sc2[k][hf].x * rsd[k]) * sc2[k][hf].y;
            float m = fmaxf(fabsf(cf[0]), fabsf(cf[1]));
#pragma unroll
            for (int o = 1; o < 64; o <<= 1) m = fmaxf(m, __shfl_xor(m, o));
            const float inv = m > 0.f ? 119.0f / m : 0.f;
#pragma unroll
            for (int hf = 0; hf < 2; ++hf) {
                const int q = __float2int_rn(cf[hf] * inv);
                unsigned dl = (unsigned)(q & 15) << (4 * (lane & 7)), dh = (unsigned)(((q + 8) >> 4) & 15) << (4 * (lane & 7));
                dl |= __shfl_xor(dl, 1); dh |= __shfl_xor(dh, 1); dl |= __shfl_xor(dl, 2); dh |= __shfl_xor(dh, 2); dl |= __shfl_xor(dl, 4); dh |= __shfl_xor(dh, 4);
                if ((lane & 7) == 0) {
                    const int dk = 8 * hf + (lane >> 3), rs = dk >> 1, half = dk & 1;
                    cpl[(size_t)t * 32 + 4 * rs + half] = dl; cpl[(size_t)t * 32 + 4 * rs + 2 + half] = dh;
                }
            }
            if (lane == 0) csc[t] = m * (1.0f / 119.0f);
        }
    }
}

#define LAS __attribute__((address_space(3)))
#define XB_TMO      128
#define XB_XCNT(j)  (256  + 64 * (j))
#define XB_XSUB(j)  (1280 + 64 * (j))
#define XB_XGEN(j)  (2304 + 64 * (j))
#define XB_TOP      3328
#define XB_TOPGEN   3392
#define XCD_BAR_WORDS 3456
#define XB_SPIN_CAP (1u << 18)
__device__ __forceinline__ unsigned xb_ld(unsigned* p)              { return __hip_atomic_load(p, __ATOMIC_RELAXED, __HIP_MEMORY_SCOPE_AGENT); }
__device__ __forceinline__ unsigned xb_add(unsigned* p, unsigned v) { return __hip_atomic_fetch_add(p, v, __ATOMIC_RELAXED, __HIP_MEMORY_SCOPE_AGENT); }
__device__ __forceinline__ unsigned xb_xcc_id() { return (unsigned)__builtin_amdgcn_s_getreg((3 << 11) | 20) & 0xFu; }
#define XB_SPIN(cond, bar) do { unsigned _sp = 0; while (cond) { __builtin_amdgcn_s_sleep(1); \
    if ((++_sp & 255u) == 0u) { if (xb_ld(&(bar)[XB_TMO])) break; if (_sp > XB_SPIN_CAP) { atomicAdd(&(bar)[XB_TMO], 1u); break; } } } } while (0)
struct XcdBarrier { unsigned* bar; unsigned x; volatile LAS unsigned* st; };
__device__ __forceinline__ XcdBarrier xcd_barrier_post(unsigned* bar, volatile LAS unsigned* st) {
    XcdBarrier b; b.bar = bar; b.x = xb_xcc_id(); b.st = st;
    if (threadIdx.x == 0) (void)xb_add(&bar[XB_XCNT(b.x)], 1u);
    return b;
}
__device__ __forceinline__ void xcd_barrier_complete(unsigned* bar, unsigned x, unsigned& nloc, unsigned& nx) {
    const unsigned G = gridDim.x * gridDim.y * gridDim.z;
    unsigned sum, cnt, mine, sp = 0u;
    for (;;) {
        sum = 0u; cnt = 0u; mine = 0u;
#pragma unroll
        for (unsigned j = 0; j < 16; ++j) { const unsigned c = xb_ld(&bar[XB_XCNT(j)]); sum += c; cnt += (c > 0u) ? 1u : 0u; mine = (j == x) ? c : mine; }
        if (sum == G) break;
        __builtin_amdgcn_s_sleep(1);
        if ((++sp & 255u) == 0u) { if (xb_ld(&bar[XB_TMO])) break; if (sp > XB_SPIN_CAP) { atomicAdd(&bar[XB_TMO], 1u); break; } }
    }
    nloc = mine > 0u ? mine : 1u; nx = cnt > 0u ? cnt : 1u;
}
__device__ __forceinline__ void xcd_barrier(const XcdBarrier& b) {
    asm volatile("s_waitcnt vmcnt(0)" ::: "memory");
    __syncthreads();
    if (threadIdx.x == 0) {
        unsigned* bar = b.bar;
        __builtin_amdgcn_s_waitcnt(0);
        unsigned nloc = b.st[0], nx = b.st[1];
        if (nloc == 0u) { xcd_barrier_complete(bar, b.x, nloc, nx); b.st[0] = nloc; b.st[1] = nx; }
        const unsigned old = xb_add(&bar[XB_XSUB(b.x)], 1u);
        const unsigned gen = old / nloc;
        if (old + 1u == (gen + 1u) * nloc) {
            __builtin_amdgcn_fence(__ATOMIC_RELEASE, "agent");
            asm volatile("s_waitcnt vmcnt(0)" ::: "memory");
            const unsigned og = xb_add(&bar[XB_TOP], 1u);
            const unsigned tg = og / nx;
            if (og + 1u == (tg + 1u) * nx) xb_add(&bar[XB_TOPGEN], 1u);
            else XB_SPIN(xb_ld(&bar[XB_TOPGEN]) == tg, bar);
            __builtin_amdgcn_fence(__ATOMIC_ACQUIRE, "agent");
            xb_add(&bar[XB_XGEN(b.x)], 1u);
            asm volatile("s_waitcnt vmcnt(0)" ::: "memory");
        } else {
            XB_SPIN(xb_ld(&bar[XB_XGEN(b.x)]) == gen, bar);
            __builtin_amdgcn_fence(__ATOMIC_ACQUIRE, "agent");
            asm volatile("s_waitcnt vmcnt(0)" ::: "memory");
        }
    }
    __syncthreads();
}

constexpr int LDS_MISC = 158720;
constexpr int LDS_BYTES = LDS_MISC + 1024;

__global__ void __launch_bounds__(NTHR, 2) hymba_fwd(Params p) {
    extern __shared__ __attribute__((aligned(16))) unsigned char lds[];
    volatile LAS unsigned* misc = (volatile LAS unsigned*)((LAS unsigned char*)lds + LDS_MISC);
    if (threadIdx.x < 4) misc[threadIdx.x] = 0u;
    __syncthreads();
    XcdBarrier bar = xcd_barrier_post((unsigned*)(p.ws + WS_CTL), misc);

    PG8_LAS unsigned char* ring = (PG8_LAS unsigned char*)lds;
    unsigned char* ws = p.ws;
    ph_prep(p, lds);                          xcd_barrier(bar);
    {
        pg8::Gemm g{(const bf16_t*)(ws + WS_A), (const bf16_t*)(ws + WS_WINT), S, NPROJ, D}; pg8::StaticOrder so; so.init(S, NPROJ, (int)gridDim.x, (int)blockIdx.x);
        EpiInProj E{(const float*)(ws + WS_RSTD1), p.in[I_Q_NORM], p.in[I_K_NORM], (bf16_t*)(ws + WS_QH), (bf16_t*)(ws + WS_KH), (bf16_t*)(ws + WS_VH), (bf16_t*)(ws + WS_XRG), (bf16_t*)(ws + WS_GG)};
        pg8::gemm_phase<EpiInProj, pg8::StaticOrder, true, true>(ring, g, so, E);
        const int G = (int)gridDim.x, nunits = (S / 256) * (NPROJ / 256), rem = nunits % G, b = (int)blockIdx.x;
        const int tid_ = phase_tid(), w = tid_ >> 6, lane = tid_ & 63;
        if (rem == 0) ph_tables(p, b * (NTHR / 64) + w, G * (NTHR / 64), lane);
        else if (b >= rem) ph_tables(p, (b - rem) * (NTHR / 64) + w, (G - rem) * (NTHR / 64), lane);
    }
    xcd_barrier(bar);
    ph_attn(p); ph_rg<0>(p, lds);             xcd_barrier(bar);
    ph_rg<1>(p, lds);                         xcd_barrier(bar);
    {
        pg8::Gemm g{(const bf16_t*)(ws + WS_MIX), (const bf16_t*)(ws + WS_WOUTT), S, D, D}; pg8::StaticOrder so; so.init(S, D, (int)gridDim.x, (int)blockIdx.x);
        EpiOutProj E{(const float*)(ws + WS_RSB), p.in[I_X], (bf16_t*)(ws + WS_A), (float*)(ws + WS_SSQ), ws + WS_X1Q, (float*)(ws + WS_XSC)};
        pg8::gemm_phase<EpiOutProj, pg8::StaticOrder, true, true>(ring, g, so, E);
    }
    xcd_barrier(bar);
    {
        pg8::Gemm g{(const bf16_t*)(ws + WS_A), (const bf16_t*)(ws + WS_WQT), S, NQ, D}; pg8::StaticOrder so; so.init(S, NQ, (int)gridDim.x, (int)blockIdx.x);
        EpiPeerQ E{(bf16_t*)(ws + WS_B)};
        pg8::gemm_phase<EpiPeerQ, pg8::StaticOrder, true, true>(ring, g, so, E);
    }
    asm volatile("s_waitcnt vmcnt(0)" ::: "memory"); __syncthreads();
    ph_topk(p, (int*)lds);                    xcd_barrier(bar);
    ph_peer<0>(p, lds);                       xcd_barrier(bar);
    ph_peer_combine(p);                       xcd_barrier(bar);
    ph_peer<1>(p, lds);
}

extern "C" void kernel_launch(void* const* d_in, const int* in_sizes, int n_in, void* d_out, int out_size, void* d_ws, size_t ws_size, hipStream_t stream) {
    static int grid = 0;
    if (grid == 0) {
        if (n_in != 20 || out_size != S * D || ws_size < WS_END) { fprintf(stderr, "kernel_launch: unexpected shapes (n_in %d out %d ws %zu)\n", n_in, out_size, ws_size); grid = -1; return; }
        int dev = 0, cus = 0, per_cu = 0;
        if (hipGetDevice(&dev) != hipSuccess || hipDeviceGetAttribute(&cus, hipDeviceAttributeMultiprocessorCount, dev) != hipSuccess) { grid = -1; return; }
        if (hipFuncSetAttribute((const void*)hymba_fwd, hipFuncAttributeMaxDynamicSharedMemorySize, LDS_BYTES) != hipSuccess) { fprintf(stderr, "kernel_launch: hipFuncSetAttribute failed\n"); grid = -1; return; }
        if (hipOccupancyMaxActiveBlocksPerMultiprocessor(&per_cu, (const void*)hymba_fwd, NTHR, LDS_BYTES) != hipSuccess || per_cu < 1) { fprintf(stderr, "kernel_launch: occupancy query says %d blocks per CU\n", per_cu); grid = -1; return; }
        (void)hipGetLastError();
        grid = cus;
    }
    if (grid < 0) return;
    (void)hipMemsetAsync((char*)d_ws + WS_CTL, 0, XCD_BAR_WORDS * 4, stream);
    Params p{};
    for (int i = 0; i < 20; ++i) p.in[i] = (const float*)d_in[i];
    p.out = (float*)d_out; p.ws = (unsigned char*)d_ws;
    hipLaunchKernelGGL(hymba_fwd, dim3(grid), dim3(NTHR), LDS_BYTES, stream, p);
}
```

```cpp
#include <hip/hip_runtime.h>
#include <cstdint>
#include <cstdio>

typedef unsigned short bf16_t;
typedef short bf16x8 __attribute__((ext_vector_type(8)));
typedef float f32x4 __attribute__((ext_vector_type(4)));
typedef unsigned u32x4 __attribute__((ext_vector_type(4)));
typedef float f32x16 __attribute__((ext_vector_type(16)));

constexpr int S = 16384, D = 1024, NPROJ = 2560, DSB = 512, DRG = 512, NH = 8, HD = 64;
constexpr int PH = 8, PNK = 128, PDK = 256, PHALF = 128, PTOPK = 16, NEXP = 16384, NQ = PH * PDK;
constexpr int CHUNK = 64, NCHUNK = S / CHUNK;
constexpr float EPS = 1e-6f;
constexpr float LOG2E = 1.4426950408889634f;
constexpr float QSCALE = 0.125f * LOG2E;
constexpr int NTHR = 512;
constexpr float CARRY_STOP = -135.0f;

constexpr size_t MiB = 1u << 20;
constexpr size_t WS_CTL = 0;
constexpr size_t WS_WINT = 1 * MiB;
constexpr size_t WS_WOUTT = 6 * MiB;
constexpr size_t WS_WQT = 8 * MiB;
constexpr size_t WS_SUBK = 12 * MiB;
constexpr size_t WS_RSTD1 = 12 * MiB + 512 * 1024;
constexpr size_t WS_RSTD2 = WS_RSTD1 + 64 * 1024;
constexpr size_t WS_RGP = WS_RSTD2 + 64 * 1024;
constexpr size_t WS_RGH = WS_RGP + 512 * 1024;
constexpr int RG_GRP = 16;
constexpr size_t WS_RGGP = WS_RGH + 512 * 1024, WS_RGGH = WS_RGGP + 32 * 1024;
constexpr int CTL_RGCNT = 3584;
constexpr size_t WS_RGSA = 207 * MiB, WS_RGSB = 223 * MiB;
constexpr size_t WS_A = 14 * MiB;
constexpr size_t WS_B = 46 * MiB;
constexpr size_t WS_QH = WS_B, WS_KH = WS_B + 16 * MiB, WS_VH = WS_B + 32 * MiB, WS_XRG = WS_B + 48 * MiB;
constexpr size_t WS_GG = 110 * MiB;
constexpr size_t WS_OSB = 126 * MiB;
constexpr size_t WS_MIX = 142 * MiB;
constexpr size_t WS_SSB = 198 * MiB;
constexpr size_t WS_RSB = WS_SSB + 512 * 1024;
constexpr size_t WS_SELI = WS_MIX, WS_SELG = WS_MIX + 8 * MiB;
constexpr size_t WS_PD = WS_B;
constexpr size_t WS_CBUF = WS_GG;
constexpr size_t WS_CSC = WS_GG + 4 * MiB;
constexpr size_t WS_X1Q = WS_OSB;
constexpr size_t WS_XSC = WS_GG + 8 * MiB;
constexpr size_t WS_UB = 174 * MiB;
constexpr size_t WS_VB = 190 * MiB;
constexpr size_t WS_USC = 206 * MiB;
constexpr size_t WS_SSQ = 238 * MiB;
constexpr size_t WS_RGW = 239 * MiB;
constexpr size_t WS_END = 240 * MiB;

__device__ __forceinline__ unsigned f2bf(float f) { unsigned u = __builtin_bit_cast(unsigned, f); return (u + 0x7fffu + ((u >> 16) & 1u)) >> 16; }
__device__ __forceinline__ float u2f(unsigned u) { return __builtin_bit_cast(float, u); }
__device__ __forceinline__ float bf2f(unsigned h) { return __builtin_bit_cast(float, h << 16); }
__device__ __forceinline__ unsigned pk2(float lo, float hi) { return f2bf(lo) | (f2bf(hi) << 16); }
__device__ __forceinline__ unsigned pack_i8(float a, float b, float c, float d) {
    const int qa = __float2int_rn(a), qb = __float2int_rn(b), qc = __float2int_rn(c), qd = __float2int_rn(d);
    return (unsigned)(qa & 255) | ((unsigned)(qb & 255) << 8) | ((unsigned)(qc & 255) << 16) | ((unsigned)qd << 24);
}
__device__ __forceinline__ unsigned pack_n4(float a, float b, float c, float d) {
    const int qa = min(max(__float2int_rn(a), -7), 7) & 15, qb = min(max(__float2int_rn(b), -7), 7) & 15, qc = min(max(__float2int_rn(c), -7), 7) & 15, qd = min(max(__float2int_rn(d), -7), 7) & 15;
    return (unsigned)qa | ((unsigned)qb << 4) | ((unsigned)qc << 8) | ((unsigned)qd << 12);
}
template <int OFFS>
__device__ __forceinline__ unsigned pack_u4(float a, float b, float c, float d) {
    const int qa = (min(max(__float2int_rn(a), -7), 7) + OFFS) & 15, qb = (min(max(__float2int_rn(b), -7), 7) + OFFS) & 15, qc = (min(max(__float2int_rn(c), -7), 7) + OFFS) & 15, qd = (min(max(__float2int_rn(d), -7), 7) + OFFS) & 15;
    return (unsigned)qa | ((unsigned)qb << 8) | ((unsigned)qc << 16) | ((unsigned)qd << 24);
}
__device__ __forceinline__ float wave_sum(float v) {
#pragma unroll
    for (int o = 1; o < 64; o <<= 1) v += __shfl_xor(v, o);
    return v;
}
__device__ __forceinline__ float gelu_tanh(float x) {
    const float u = 0.7978845608028654f * (x + 0.044715f * x * x * x);
    const float e = __expf(2.0f * u);
    const float th = 1.0f - 2.0f * __builtin_amdgcn_rcpf(e + 1.0f);
    return 0.5f * x * (1.0f + th);
}

__host__ __device__ __forceinline__ int inproj_phys_row(int nlog) { const int t = nlog >> 8, L = nlog & 255; return (t << 8) + 128 * ((L & 63) >> 5) + 32 * (L >> 6) + (L & 31); }

__device__ __forceinline__ int phase_tid() { int t = threadIdx.x; asm volatile("" : "+v"(t)); return t; }

struct Params {
    const float* in[20];
    float* out;
    unsigned char* ws;
};
__device__ __forceinline__ __amdgpu_buffer_rsrc_t ws_rsrc(unsigned char* ws) { return __builtin_amdgcn_make_buffer_rsrc(ws, 0, (int)WS_END, 0x00020000); }
__device__ __forceinline__ void wt16(__amdgpu_buffer_rsrc_t r, unsigned off, u32x4 v) { __builtin_amdgcn_raw_buffer_store_b128(v, r, (int)off, 0, 16); }
enum { I_X = 0, I_NORM_MIX, I_W_IN, I_Q_NORM, I_K_NORM, I_CONV_W, I_CONV_B, I_RG_W_A, I_RG_B_A, I_RG_W_X, I_RG_B_X, I_RG_LAMBDA,
       I_OUT_NORM_SB, I_OUT_NORM_RG, I_W_OUT, I_NORM_FFN, I_PEER_WQ, I_PEER_SUBK, I_PEER_U, I_PEER_V };

template <bool INPROJ_PERM>
__device__ __forceinline__ void prep_transpose_item(const float* W, const float* gain0, const float* gain1, int K, int N, bf16_t* WT, float* scr, int item, int lane) {
    const int nblk = N / 32, kb = item / nblk, nb = item % nblk, k0 = 64 * kb, n0 = 32 * nb;
#pragma unroll
    for (int i = 0; i < 32; ++i) {
        const int kk = 2 * i + (lane >> 5), k = k0 + kk;
        const float g = (gain1 && k >= 512) ? gain1[k - 512] : gain0[k];
        scr[kk * 33 + (lane & 31)] = g * __builtin_nontemporal_load(W + (size_t)k * N + n0 + (lane & 31));
    }
    asm volatile("s_waitcnt lgkmcnt(0)" ::: "memory");
    const int c = lane & 7;
#pragma unroll
    for (int j = 0; j < 4; ++j) {
        const int n = (lane >> 3) + 8 * j; const float* s = scr + (8 * c) * 33 + n;
        u32x4 o; o.x = pk2(s[0 * 33], s[1 * 33]); o.y = pk2(s[2 * 33], s[3 * 33]); o.z = pk2(s[4 * 33], s[5 * 33]); o.w = pk2(s[6 * 33], s[7 * 33]);
        const int nr = INPROJ_PERM ? inproj_phys_row(n0 + n) : n0 + n;
        *(u32x4*)(WT + (size_t)nr * K + k0 + 8 * c) = o;
    }
    asm volatile("s_waitcnt lgkmcnt(0)" ::: "memory");
}
template <int CTRL, int ROWMASK>
__device__ __forceinline__ float tdpp(float x) { return __builtin_bit_cast(float, __builtin_amdgcn_update_dpp(0, __builtin_bit_cast(int, x), CTRL, ROWMASK, 0xf, false)); }
template <bool MAX>
__device__ __forceinline__ float wave_all(float x) {
#define TAB_STEP(CTRL, RM) do { const float y_ = tdpp<CTRL, RM>(x); x = MAX ? fmaxf(x, y_) : x + y_; } while (0)
    TAB_STEP(0xB1, 0xf); TAB_STEP(0x4E, 0xf); TAB_STEP(0x141, 0xf); TAB_STEP(0x140, 0xf); TAB_STEP(0x142, 0xa); TAB_STEP(0x143, 0xc);
#undef TAB_STEP
    return __builtin_bit_cast(float, __builtin_amdgcn_readlane(__builtin_bit_cast(int, x), 63));
}
__device__ __forceinline__ unsigned tab_q4(f32x4 v, float s) {
    const unsigned r0 = __builtin_bit_cast(unsigned, __builtin_amdgcn_fmed3f(v.x * s, -7.0f, 7.0f) + 12582912.0f), r1 = __builtin_bit_cast(unsigned, __builtin_amdgcn_fmed3f(v.y * s, -7.0f, 7.0f) + 12582912.0f);
    const unsigned r2 = __builtin_bit_cast(unsigned, __builtin_amdgcn_fmed3f(v.z * s, -7.0f, 7.0f) + 12582912.0f), r3 = __builtin_bit_cast(unsigned, __builtin_amdgcn_fmed3f(v.w * s, -7.0f, 7.0f) + 12582912.0f);
    return (__builtin_amdgcn_perm(r1, r0, 0x0c0c0400u) | __builtin_amdgcn_perm(r3, r2, 0x04000c0cu)) & 0x0f0f0f0fu;
}
struct TabRows { f32x4 a[2][4], b[2][4]; };
__device__ __forceinline__ void tab_load(const float* u, const float* v, int e0, int ncw, int lane, TabRows& R) {
#pragma unroll
    for (int rr = 0; rr < 2; ++rr) {
        const int e = min(e0 + rr * ncw, NEXP - 1);
#pragma unroll
        for (int j = 0; j < 4; ++j) {
            R.a[rr][j] = __builtin_nontemporal_load((const f32x4*)(u + (size_t)e * D) + lane + 64 * j); R.b[rr][j] = __builtin_nontemporal_load((const f32x4*)(v + (size_t)e * D) + lane + 64 * j);
        }
    }
}
__device__ __forceinline__ void tab_convert(unsigned char* ws, const f32x4 (&gq)[4], int e0, int ncw, int lane, TabRows& R) {
    unsigned* ub = (unsigned*)(ws + WS_UB); unsigned* vb = (unsigned*)(ws + WS_VB); float2* uvsc = (float2*)(ws + WS_USC);
#pragma unroll
    for (int rr = 0; rr < 2; ++rr) {
        const int e = e0 + rr * ncw;
        float ma = 0.f, mb = 0.f, sa2 = 0.f, sb2 = 0.f;
#pragma unroll
        for (int j = 0; j < 4; ++j) {
            R.a[rr][j] = R.a[rr][j] * gq[j];
            const f32x4 aa = R.a[rr][j], bb = R.b[rr][j];
            ma = fmaxf(ma, fmaxf(fmaxf(fabsf(aa.x), fabsf(aa.y)), fmaxf(fabsf(aa.z), fabsf(aa.w))));
            mb = fmaxf(mb, fmaxf(fmaxf(fabsf(bb.x), fabsf(bb.y)), fmaxf(fabsf(bb.z), fabsf(bb.w))));
            sa2 += (aa.x * aa.x + aa.y * aa.y) + (aa.z * aa.z + aa.w * aa.w);
            sb2 += (bb.x * bb.x + bb.y * bb.y) + (bb.z * bb.z + bb.w * bb.w);
        }
        ma = wave_all<true>(ma); mb = wave_all<true>(mb); sa2 = wave_all<false>(sa2); sb2 = wave_all<false>(sb2);
        if (e < NEXP) {
            const float ca = fminf(ma, 2.5f * sqrtf(sa2 * (1.0f / D))), cb = fminf(mb, 2.5f * sqrtf(sb2 * (1.0f / D)));
            const float ia = ca > 0.f ? 7.0f / ca : 0.f, ib = cb > 0.f ? 7.0f / cb : 0.f;
#pragma unroll
            for (int j = 0; j < 4; ++j) {
                const unsigned na = tab_q4(R.a[rr][j], ia), nb = tab_q4(R.b[rr][j], ib);
                const unsigned y = nb | (nb >> 4);
                const unsigned pa = (unsigned)__builtin_amdgcn_update_dpp(0, (int)na, 0xB1, 0xf, 0xf, false), py = (unsigned)__builtin_amdgcn_update_dpp(0, (int)y, 0xB1, 0xf, 0xf, false);
                if ((lane & 1) == 0) {
                    ub[((size_t)j * NEXP + e) * 32 + (lane >> 1)] = na | (pa << 4);
                    vb[((size_t)j * NEXP + e) * 32 + (lane >> 1)] = __builtin_amdgcn_perm(py, y, 0x06040200u);
                }
            }
            if (lane == 0) uvsc[e] = make_float2(ca * (1.0f / 7.0f), cb * (1.0f / 7.0f));
        }
    }
}
__device__ __forceinline__ void ph_tables(const Params& p, int cw, int ncw, int lane) {
    unsigned char* ws = p.ws;
    const float* u = p.in[I_PEER_U]; const float* v = p.in[I_PEER_V]; const float* g = p.in[I_NORM_FFN];
    f32x4 gq[4];
#pragma unroll
    for (int j = 0; j < 4; ++j) gq[j] = *((const f32x4*)g + lane + 64 * j);
    if (cw >= NEXP) return;
    TabRows A, B;
    tab_load(u, v, cw, ncw, lane, A);
    for (int e0 = cw; e0 < NEXP; e0 += 4 * ncw) {
        const bool hasB = e0 + 2 * ncw < NEXP;
        if (hasB) tab_load(u, v, e0 + 2 * ncw, ncw, lane, B);
        asm volatile("" ::: "memory");
        tab_convert(ws, gq, e0, ncw, lane, A);
        if (e0 + 4 * ncw < NEXP) tab_load(u, v, e0 + 4 * ncw, ncw, lane, A);
        asm volatile("" ::: "memory");
        if (hasB) tab_convert(ws, gq, e0 + 2 * ncw, ncw, lane, B);
    }
}

__device__ __forceinline__ void ph_prep(const Params& p, unsigned char* lds, const bool late_q) {
    const int tid_ = phase_tid();
    const int gtid = blockIdx.x * blockDim.x + tid_, gsize = gridDim.x * blockDim.x;
    const int lane = tid_ & 63, gwave = gtid >> 6, nwave = gsize >> 6;
    unsigned char* ws = p.ws;
    {
        float* scr = (float*)lds + (tid_ >> 6) * (64 * 33);
        constexpr int I_IN = (D / 64) * (NPROJ / 32), I_OUT = (D / 64) * (D / 32), I_Q = (D / 64) * (NQ / 32);
        for (int it = gwave; it < I_IN + I_OUT + (late_q ? 0 : I_Q); it += nwave) {
            if (it < I_IN) prep_transpose_item<true>(p.in[I_W_IN], p.in[I_NORM_MIX], nullptr, D, NPROJ, (bf16_t*)(ws + WS_WINT), scr, it, lane);
            else if (it < I_IN + I_OUT) prep_transpose_item<false>(p.in[I_W_OUT], p.in[I_OUT_NORM_SB], p.in[I_OUT_NORM_RG], D, D, (bf16_t*)(ws + WS_WOUTT), scr, it - I_IN, lane);
            else prep_transpose_item<false>(p.in[I_PEER_WQ], p.in[I_NORM_FFN], nullptr, D, NQ, (bf16_t*)(ws + WS_WQT), scr, it - I_IN - I_OUT, lane);
        }
    }
    {
        const float* wa = p.in[I_RG_W_A]; const float* wx = p.in[I_RG_W_X]; bf16_t* o = (bf16_t*)(ws + WS_RGW);
        for (int e = gtid; e < 8 * 2 * 2 * 4 * 64 * 8; e += gsize) {
            const int el = e & 7, ln = (e >> 3) & 63, s = (e >> 9) & 3, jt = (e >> 11) & 1, g = (e >> 12) & 1, n = e >> 13;
            const int j = 32 * jt + (ln & 31), i = 16 * s + 8 * (el >> 2) + 4 * (ln >> 5) + (el & 3);
            o[e] = (bf16_t)f2bf((g == 0 ? wa : wx)[((size_t)n * 64 + i) * 64 + j]);
        }
    }
    {
        const float* sk = p.in[I_PEER_SUBK]; bf16_t* o = (bf16_t*)(ws + WS_SUBK);
        for (int e = gtid; e < PH * 2 * PNK * PHALF; e += gsize) o[e] = (bf16_t)f2bf(sk[e]);
    }
    {
        const float* x = p.in[I_X]; bf16_t* xb = (bf16_t*)(ws + WS_A); float* rstd1 = (float*)(ws + WS_RSTD1);
        for (int row0 = gwave; row0 < S; row0 += 4 * nwave) {
            f32x4 v[4][4];
#pragma unroll
            for (int rr = 0; rr < 4; ++rr) {
                const int row = min(row0 + rr * nwave, S - 1);
#pragma unroll
                for (int j = 0; j < 4; ++j) v[rr][j] = __builtin_nontemporal_load((const f32x4*)(x + (size_t)row * D) + lane + 64 * j);
            }
#pragma unroll
            for (int rr = 0; rr < 4; ++rr) {
                const int row = row0 + rr * nwave;
                float ss = 0.f;
#pragma unroll
                for (int j = 0; j < 4; ++j) ss += (v[rr][j].x * v[rr][j].x + v[rr][j].y * v[rr][j].y) + (v[rr][j].z * v[rr][j].z + v[rr][j].w * v[rr][j].w);
                ss = wave_sum(ss);
                if (row < S) {
                    uint2* o = (uint2*)(xb + (size_t)row * D) + lane;
#pragma unroll
                    for (int j = 0; j < 4; ++j) o[64 * j] = make_uint2(pk2(v[rr][j].x, v[rr][j].y), pk2(v[rr][j].z, v[rr][j].w));
                    if (lane == 0) rstd1[row] = rsqrtf(ss * (1.0f / D) + EPS);
                }
            }
        }
    }
}

namespace pg8 {
#define PG8_LAS __attribute__((address_space(3)))
typedef unsigned short bf16_t;
typedef short bf16x8 __attribute__((ext_vector_type(8)));
typedef float f32x4 __attribute__((ext_vector_type(4)));
typedef unsigned u32x4 __attribute__((ext_vector_type(4)));
constexpr int BM = 256, BK = 64, HALF = 128, HTB = HALF * BK * 2  , STAGE_BYTES = 8 * HTB, NXCD = 8, WGM = 8;

__host__ __device__ __forceinline__ int lds_byte(int r, int c) { const int st = (r >> 4) * 2 + (c >> 5), rr = r & 15, cc = c & 31, ob = rr * 64 + cc * 2; return st * 1024 + (ob ^ (((ob >> 9) & 1) << 5)); }
__host__ __device__ __forceinline__ void stage_rc(int b, int& R, int& C) { const int st = b / 1024, sb = b % 1024, swz = sb ^ (((sb >> 9) & 1) << 5); R = (st >> 1) * 16 + swz / 64; C = (st & 1) * 32 + (swz % 64) / 2; }
__host__ __device__ __forceinline__ int perm32(int rho) { const int n = rho >> 4, i = rho & 15; return 8 * (i >> 2) + 4 * n + (i & 3); }

struct Unit { int pm, pn; };
struct Gemm { const bf16_t* A; const bf16_t* Bt; int M, N, K; int krot = 0; };

struct StaticOrder {
    int nM, nN, nwg, G, c;
    __host__ __device__ void init(int M, int N, int G_, int c_) { nM = M / BM; nN = N / BM; nwg = nM * nN; G = G_; c = c_; }
    __host__ __device__ bool next(int i, Unit& u) const {
        const long L = (long)i * G + c; if (L >= nwg) return false;
        int wgid = (int)L; { const int q = nwg / NXCD, r = nwg % NXCD, xcd = wgid % NXCD, off = wgid / NXCD; wgid = (xcd < r ? xcd * (q + 1) : r * (q + 1) + (xcd - r) * q) + off; }
        const int nig = WGM * nN, gid = wgid / nig, fm = gid * WGM, gsz = (nM - fm) < WGM ? (nM - fm) : WGM;
        u.pm = fm + ((wgid % nig) % gsz); u.pn = (wgid % nig) / gsz; return true;
    }
    __device__ __forceinline__ void a_ready(const Unit&) const {}
    __device__ __forceinline__ void done(const Unit&) const {}
};

__device__ __forceinline__ unsigned cvt_pk_bf16(float lo, float hi) { unsigned r; asm volatile("v_cvt_pk_bf16_f32 %0, %1, %2" : "=v"(r) : "v"(lo), "v"(hi)); return r; }
template <class Epi, class Sched, bool ALIGN_EPI = false, bool SP2 = false>
__device__ __forceinline__ void gemm_phase(PG8_LAS unsigned char* lds, const Gemm g, const Sched& S, const Epi& E) {
    const int tid = phase_tid(), wid = __builtin_amdgcn_readfirstlane(tid >> 6), lane = tid & 63, wr = wid >> 2, wc = wid & 3, fr = lane & 15, fq = lane >> 4;
    const int K = g.K, nt = K / BK, krot = g.krot;
#define PG8_KT(i) ((size_t)((((i) + krot) & (nt - 1)) * (BK * 2)))
    unsigned voffA[2], voffB[2];
#pragma unroll
    for (int i = 0; i < 2; ++i) { int R, C; stage_rc(tid * 16 + i * 8192, R, C); const int Rb = Epi::PERM ? ((R & ~31) + perm32(R & 31)) : R;
        voffA[i] = (unsigned)(R * K + C) * 2u; voffB[i] = (unsigned)(Rb * K + C) * 2u; }
    const size_t kstep = (size_t)(BK * 2);
    const size_t hstep = (size_t)HALF * K * 2;
    const size_t tstep = 2 * hstep;
    const unsigned ldsw = (unsigned)wid * 1024u;
    const int aoff = lds_byte(wr * 64 + fr, fq * 8), boff = lds_byte(wc * 32 + fr, fq * 8);
#define PG8_SA(b, h) (((b) * 2 + (h)) * HTB)
#define PG8_SB(b, h) ((4 + (b) * 2 + (h)) * HTB)
#define PG8_STAGE(bufoff, gbase, voff) do { _Pragma("unroll") for (int _i = 0; _i < 2; ++_i) \
        __builtin_amdgcn_global_load_lds((const unsigned*)((const char*)(gbase) + (voff)[_i]), (PG8_LAS unsigned*)(lds + (bufoff) + ldsw + _i * 8192), 16, 0, 0); } while (0)
#define PG8_LDA(dst, b, h) do { _Pragma("unroll") for (int m = 0; m < 4; ++m) _Pragma("unroll") for (int k = 0; k < 2; ++k) dst[m][k] = *(const PG8_LAS bf16x8*)(lds + PG8_SA(b, h) + aoff + m * 2048 + k * 1024); } while (0)
#define PG8_LDB(dst, b, h) do { _Pragma("unroll") for (int n = 0; n < 2; ++n) _Pragma("unroll") for (int k = 0; k < 2; ++k) dst[n][k] = *(const PG8_LAS bf16x8*)(lds + PG8_SB(b, h) + boff + n * 2048 + k * 1024); } while (0)
#define PG8_MMA(ai, bj, At, Bt) do { __builtin_amdgcn_s_setprio(1); _Pragma("unroll") for (int m = 0; m < 4; ++m) _Pragma("unroll") for (int n = 0; n < 2; ++n) _Pragma("unroll") for (int k = 0; k < 2; ++k) \
        acc[ai][bj][m][n] = __builtin_amdgcn_mfma_f32_16x16x32_bf16(Bt[n][k], At[m][k], acc[ai][bj][m][n], 0, 0, 0); __builtin_amdgcn_s_setprio(0); } while (0)
#define PG8_WAIT_V(n) asm volatile("s_waitcnt vmcnt(" #n ")" ::: "memory")
#define PG8_WAIT_L(n) asm volatile("s_waitcnt lgkmcnt(" #n ")" ::: "memory")
#define PG8_BAR __builtin_amdgcn_s_barrier()
#define PG8_SCHED __builtin_amdgcn_sched_barrier(0)
    Unit cur, nxt; int ui = 0;
    if (!S.next(0, cur)) { if constexpr (Epi::PREWAIT) E.prewait(); return; }
    bool prewaited = false;
    f32x4 acc[2][2][4][2];
#pragma unroll
    for (int a = 0; a < 2; ++a)
#pragma unroll
        for (int b = 0; b < 2; ++b)
#pragma unroll
            for (int m = 0; m < 4; ++m)
#pragma unroll
                for (int n = 0; n < 2; ++n) acc[a][b][m][n] = (f32x4){0.f, 0.f, 0.f, 0.f};
    bf16x8 At[4][2], B0[2][2], B1[2][2];
    const char* cA = (const char*)g.A + (size_t)cur.pm * tstep; const char* cB = (const char*)g.Bt + (size_t)cur.pn * tstep;
    S.a_ready(cur);
    if constexpr (SP2) {
        PG8_STAGE(PG8_SB(0, 0), cB + PG8_KT(0), voffB); PG8_STAGE(PG8_SB(0, 1), cB + hstep + PG8_KT(0), voffB); PG8_STAGE(PG8_SA(0, 0), cA + PG8_KT(0), voffA); PG8_STAGE(PG8_SA(0, 1), cA + hstep + PG8_KT(0), voffA);
        if (wr == 1) PG8_BAR;
        PG8_WAIT_V(2); PG8_BAR;
        PG8_STAGE(PG8_SB(1, 0), cB + PG8_KT(1), voffB); PG8_STAGE(PG8_SA(1, 0), cA + PG8_KT(1), voffA); PG8_STAGE(PG8_SB(1, 1), cB + hstep + PG8_KT(1), voffB);
        PG8_WAIT_V(6); PG8_BAR;
    } else {
        PG8_STAGE(PG8_SB(0, 0), cB + PG8_KT(0), voffB); PG8_STAGE(PG8_SA(0, 0), cA + PG8_KT(0), voffA); PG8_STAGE(PG8_SB(0, 1), cB + hstep + PG8_KT(0), voffB); PG8_STAGE(PG8_SA(0, 1), cA + hstep + PG8_KT(0), voffA);
        if (wr == 1) PG8_BAR;
        PG8_WAIT_V(4); PG8_BAR;
        PG8_STAGE(PG8_SB(1, 0), cB + PG8_KT(1), voffB); PG8_STAGE(PG8_SA(1, 0), cA + PG8_KT(1), voffA); PG8_STAGE(PG8_SB(1, 1), cB + hstep + PG8_KT(1), voffB);
        PG8_WAIT_V(6); PG8_BAR;
    }
    for (;;) {
        const bool has_next = S.next(ui + 1, nxt);
        const char* nA = has_next ? (const char*)g.A + (size_t)nxt.pm * tstep : cA; const char* nB = has_next ? (const char*)g.Bt + (size_t)nxt.pn * tstep : cB;
        for (int t = 0; t < nt; t += 2) {
            if constexpr (Epi::PREWAIT && !SP2) { if (!prewaited && t == Epi::PREWAIT_T) { E.prewait(); prewaited = true; } }
            if constexpr (Epi::MIDSCALE) { if (t == nt / 2) E.mid(acc, cur, wr, wc, fr, fq); }
            const bool last = (t == nt - 2);
            const char* a1 = cA + PG8_KT(t + 1);
            const char* a2 = last ? nA + PG8_KT(0) : cA + PG8_KT(t + 2); const char* b2 = last ? nB + PG8_KT(0) : cB + PG8_KT(t + 2);
            const char* a3 = last ? nA + PG8_KT(1) : cA + PG8_KT(t + 3); const char* b3 = last ? nB + PG8_KT(1) : cB + PG8_KT(t + 3);
            if (last && has_next) S.a_ready(nxt);
            if constexpr (SP2) {
            PG8_LDB(B0, 0, 0); PG8_LDB(B1, 0, 1); PG8_SCHED; PG8_LDA(At, 0, 0); PG8_STAGE(PG8_SA(1, 1), a1 + hstep, voffA);
            PG8_WAIT_V(8); PG8_WAIT_L(0); PG8_BAR; PG8_MMA(0, 0, At, B0); PG8_MMA(0, 1, At, B1); PG8_BAR; PG8_SCHED;
            if constexpr (Epi::PREWAIT) { if (!prewaited && t == Epi::PREWAIT_T) { E.prewait(); prewaited = true; } }
            PG8_LDA(At, 0, 1); PG8_STAGE(PG8_SB(0, 0), b2, voffB); PG8_STAGE(PG8_SB(0, 1), b2 + hstep, voffB); PG8_STAGE(PG8_SA(0, 0), a2, voffA);
            PG8_WAIT_V(8); PG8_WAIT_L(0); PG8_BAR; PG8_MMA(1, 0, At, B0); PG8_MMA(1, 1, At, B1); PG8_BAR; PG8_SCHED;
            PG8_LDB(B0, 1, 0); PG8_LDB(B1, 1, 1); PG8_SCHED; PG8_LDA(At, 1, 0); PG8_STAGE(PG8_SA(0, 1), a2 + hstep, voffA);
            PG8_WAIT_V(8); PG8_WAIT_L(0); PG8_BAR; PG8_MMA(0, 0, At, B0); PG8_MMA(0, 1, At, B1); PG8_BAR; PG8_SCHED;
            PG8_LDA(At, 1, 1); PG8_STAGE(PG8_SB(1, 0), b3, voffB); PG8_STAGE(PG8_SB(1, 1), b3 + hstep, voffB); PG8_STAGE(PG8_SA(1, 0), a3, voffA);
            PG8_WAIT_V(8); PG8_WAIT_L(0); PG8_BAR; PG8_MMA(1, 0, At, B0); PG8_MMA(1, 1, At, B1); PG8_BAR; PG8_SCHED;
            } else {
            PG8_LDB(B0, 0, 0); PG8_SCHED; PG8_LDA(At, 0, 0); PG8_STAGE(PG8_SA(1, 1), a1 + hstep, voffA);
            PG8_WAIT_L(8); PG8_BAR; PG8_WAIT_L(0); PG8_MMA(0, 0, At, B0); PG8_BAR; PG8_SCHED;
            PG8_LDB(B1, 0, 1); PG8_STAGE(PG8_SB(0, 0), b2, voffB);
            PG8_BAR; PG8_WAIT_L(0); PG8_MMA(0, 1, At, B1); PG8_BAR;
            PG8_LDA(At, 0, 1); PG8_STAGE(PG8_SA(0, 0), a2, voffA);
            PG8_BAR; PG8_WAIT_L(0); PG8_MMA(1, 0, At, B0); PG8_BAR; PG8_SCHED;
            PG8_STAGE(PG8_SB(0, 1), b2 + hstep, voffB);
            PG8_WAIT_V(6); PG8_BAR; PG8_MMA(1, 1, At, B1); PG8_BAR;
            PG8_LDB(B0, 1, 0); PG8_SCHED; PG8_LDA(At, 1, 0); PG8_STAGE(PG8_SA(0, 1), a2 + hstep, voffA);
            PG8_WAIT_L(8); PG8_BAR; PG8_WAIT_L(0); PG8_MMA(0, 0, At, B0); PG8_BAR; PG8_SCHED;
            PG8_LDB(B1, 1, 1); PG8_STAGE(PG8_SB(1, 0), b3, voffB);
            PG8_BAR; PG8_WAIT_L(0); PG8_MMA(0, 1, At, B1); PG8_BAR;
            PG8_LDA(At, 1, 1); PG8_STAGE(PG8_SA(1, 0), a3, voffA);
            PG8_BAR; PG8_WAIT_L(0); PG8_MMA(1, 0, At, B0); PG8_BAR; PG8_SCHED;
            PG8_STAGE(PG8_SB(1, 1), b3 + hstep, voffB);
            PG8_WAIT_V(6); PG8_BAR; PG8_MMA(1, 1, At, B1); PG8_BAR;
            }
        }
        if constexpr (ALIGN_EPI) { if (wr == 0) PG8_BAR; }
        if constexpr (!Epi::AFTER_DRAIN) { E(acc, cur, wr, wc, fr, fq); S.done(cur); }
        if (!has_next) break;
#pragma unroll
        for (int a = 0; a < 2; ++a)
#pragma unroll
            for (int b = 0; b < 2; ++b)
#pragma unroll
                for (int m = 0; m < 4; ++m)
#pragma unroll
                    for (int n = 0; n < 2; ++n) acc[a][b][m][n] = (f32x4){0.f, 0.f, 0.f, 0.f};
        cur = nxt; cA = nA; cB = nB; ++ui;
        if constexpr (ALIGN_EPI) { if (wr == 1) PG8_BAR; }
    }
    PG8_WAIT_V(0);
    if constexpr (!ALIGN_EPI) { if (wr == 0) PG8_BAR; }
    PG8_BAR;
    if constexpr (Epi::AFTER_DRAIN) { E.fused(acc, cur, wr, wc, fr, fq, lds, wid, lane); S.done(cur); }
#undef PG8_KT
#undef PG8_SA
#undef PG8_SB
#undef PG8_STAGE
#undef PG8_LDA
#undef PG8_LDB
#undef PG8_MMA
#undef PG8_WAIT_V
#undef PG8_WAIT_L
#undef PG8_BAR
#undef PG8_SCHED
}
}

struct RevOrder : pg8::StaticOrder {
    int n;
    __host__ __device__ void init_rev(int M, int N, int G_, int c_) { init(M, N, G_, c_); pg8::Unit t; n = 0; while (pg8::StaticOrder::next(n, t)) ++n; }
    __host__ __device__ bool next(int i, pg8::Unit& u) const { return i < n && pg8::StaticOrder::next(n - 1 - i, u); }
};

struct PeerOrder : pg8::StaticOrder {
    bool pair; int pm0, pn0;
    __device__ __forceinline__ void init_peer(int M, int N, int G_, int c_, bool pair_) {
        init(M, N, G_, c_); pair = pair_; pm0 = 0; pn0 = 0;
        if (pair) { pg8::StaticOrder o; o.init(S, D, G_, c_); pg8::Unit u; o.next(0, u); pm0 = u.pm; pn0 = u.pn; }
    }
    __device__ __forceinline__ bool next(int i, pg8::Unit& u) const {
        if (!pair) return pg8::StaticOrder::next(i, u);
        if (i >= 2) return false;
        u.pm = pm0; u.pn = 2 * pn0 + i; return true;
    }
};

struct EpiInProj {
    static constexpr bool PERM = true, AFTER_DRAIN = false, MIDSCALE = false, PREWAIT = false;
    const float* rstd1; const float* qn; const float* kn; bf16_t *qh, *kh, *vh, *xrg, *gg;
    __device__ __forceinline__ void operator()(const pg8::f32x4 (&acc)[2][2][4][2], const pg8::Unit& u, int wr, int wc, int fr, int fq) const {
        const int region = u.pn >> 1;
        const int head = (u.pn & 1) * 4 + wc;
        float rsv[2][4];
#pragma unroll
        for (int ai = 0; ai < 2; ++ai)
#pragma unroll
            for (int m = 0; m < 4; ++m) rsv[ai][m] = rstd1[u.pm * 256 + ai * 128 + wr * 64 + m * 16 + fr];
        pg8::f32x4 gn[2][2];
        if (region <= 1) {
            const float* g = region == 0 ? qn : kn; const float sc = region == 0 ? QSCALE : 1.0f;
#pragma unroll
            for (int bj = 0; bj < 2; ++bj)
#pragma unroll
                for (int n = 0; n < 2; ++n) gn[bj][n] = *(const pg8::f32x4*)(g + 32 * bj + 8 * fq + 4 * n) * sc;
        }
#pragma unroll
        for (int ai = 0; ai < 2; ++ai)
#pragma unroll
            for (int m = 0; m < 4; ++m) {
                const int row = u.pm * 256 + ai * 128 + wr * 64 + m * 16 + fr;
                const float rs = rsv[ai][m];
                pg8::f32x4 v[2][2];
#pragma unroll
                for (int bj = 0; bj < 2; ++bj)
#pragma unroll
                    for (int n = 0; n < 2; ++n) v[bj][n] = acc[ai][bj][m][n] * rs;
                bf16_t* dst;
                if (region <= 1) {
                    float ss = 0.f;
#pragma unroll
                    for (int bj = 0; bj < 2; ++bj)
#pragma unroll
                        for (int n = 0; n < 2; ++n) ss += (v[bj][n][0] * v[bj][n][0] + v[bj][n][1] * v[bj][n][1]) + (v[bj][n][2] * v[bj][n][2] + v[bj][n][3] * v[bj][n][3]);
                    ss += __shfl_xor(ss, 16); ss += __shfl_xor(ss, 32);
                    const float rn = rsqrtf(ss * (1.0f / HD) + EPS);
#pragma unroll
                    for (int bj = 0; bj < 2; ++bj)
#pragma unroll
                        for (int n = 0; n < 2; ++n) v[bj][n] = v[bj][n] * rn * gn[bj][n];
                    bf16_t* fb = (region == 0 ? qh : kh) + ((size_t)(head * (S / 32) + (row >> 5)) * 4 * 64 + (row & 31)) * 8;
#pragma unroll
                    for (int bj = 0; bj < 2; ++bj) {
                        pg8::u32x4 w; w.x = pg8::cvt_pk_bf16(v[bj][0][0], v[bj][0][1]); w.y = pg8::cvt_pk_bf16(v[bj][0][2], v[bj][0][3]);
                        w.z = pg8::cvt_pk_bf16(v[bj][1][0], v[bj][1][1]); w.w = pg8::cvt_pk_bf16(v[bj][1][2], v[bj][1][3]);
                        *(pg8::u32x4*)(fb + ((2 * bj + (fq >> 1)) * 64 + 32 * (fq & 1)) * 8) = w;
                    }
                    continue;
                } else if (region == 2) {
#pragma unroll
                    for (int bj = 0; bj < 2; ++bj)
#pragma unroll
                        for (int n = 0; n < 2; ++n)
#pragma unroll
                            for (int i = 0; i < 4; ++i) {
                                const int d = 32 * bj + 8 * fq + 4 * n + i, kl = row & 31;
                                vh[(((((size_t)head * (S / 32) + (row >> 5)) * 2 + (d >> 5)) * 2 + (kl >> 4)) * 64 + (d & 31) + 32 * ((kl >> 2) & 1)) * 8 + 4 * ((kl >> 3) & 1) + (kl & 3)] = (bf16_t)f2bf(v[bj][n][i]);
                            }
                    continue;
                } else if (region == 3) {
                    dst = xrg + (size_t)row * DRG + head * 64;
                } else {
#pragma unroll
                    for (int bj = 0; bj < 2; ++bj)
#pragma unroll
                        for (int n = 0; n < 2; ++n)
                            *(uint2*)(gg + ((((size_t)(row >> 5) * 8 + head) * 8 + (4 * bj + fq)) * 64 + (row & 31) + 32 * n) * 4) = make_uint2(pg8::cvt_pk_bf16(v[bj][n][0], v[bj][n][1]), pg8::cvt_pk_bf16(v[bj][n][2], v[bj][n][3]));
                    continue;
                }
#pragma unroll
                for (int bj = 0; bj < 2; ++bj) {
                    pg8::u32x4 w; w.x = pg8::cvt_pk_bf16(v[bj][0][0], v[bj][0][1]); w.y = pg8::cvt_pk_bf16(v[bj][0][2], v[bj][0][3]);
                    w.z = pg8::cvt_pk_bf16(v[bj][1][0], v[bj][1][1]); w.w = pg8::cvt_pk_bf16(v[bj][1][2], v[bj][1][3]);
                    *(pg8::u32x4*)(dst + 32 * bj + 8 * fq) = w;
                }
            }
    }
};
struct XcdBarrier;
__device__ __forceinline__ void xcd_barrier_wait_inloop(const XcdBarrier& b);
struct EpiOutProj {
    static constexpr bool PERM = true, AFTER_DRAIN = false, MIDSCALE = true, PREWAIT = true;
    static constexpr int PREWAIT_T = D / pg8::BK / 2 - 2;
    __device__ __forceinline__ void prewait() const { xcd_barrier_wait_inloop(*bar); }
    __device__ __forceinline__ void mid(pg8::f32x4 (&acc)[2][2][4][2], const pg8::Unit& u, int wr, int wc, int fr, int fq) const {
        float sc[2][4];
        int fro = fr; asm volatile("" : "+v"(fro));
#pragma unroll
        for (int ai = 0; ai < 2; ++ai)
#pragma unroll
            for (int m = 0; m < 4; ++m) sc[ai][m] = rsb[u.pm * 256 + ai * 128 + wr * 64 + m * 16 + fro];
#pragma unroll
        for (int ai = 0; ai < 2; ++ai)
#pragma unroll
            for (int bj = 0; bj < 2; ++bj)
#pragma unroll
                for (int m = 0; m < 4; ++m)
#pragma unroll
                    for (int n = 0; n < 2; ++n) acc[ai][bj][m][n] = acc[ai][bj][m][n] * sc[ai][m];
    }
    const float* rsb;
    const float* x; bf16_t* x1b; float* ssq; unsigned char* x1q; float* xsc; const XcdBarrier* bar;
    __device__ __forceinline__ void operator()(const pg8::f32x4 (&acc)[2][2][4][2], const pg8::Unit& u, int wr, int wc, int fr, int fq) const {
        pg8::u32x4 xv[2][2][2];
#define OUTPROJ_LD(buf, ai_, mh_) do { _Pragma("unroll") for (int mm_ = 0; mm_ < 2; ++mm_) _Pragma("unroll") for (int bj_ = 0; bj_ < 2; ++bj_) { \
            const size_t o_ = (size_t)(u.pm * 256 + (ai_) * 128 + wr * 64 + (2 * (mh_) + mm_) * 16 + fr) * D + u.pn * 256 + bj_ * 128 + wc * 32 + 8 * fq; \
            xv[buf][mm_][bj_] = *(const pg8::u32x4*)(x1b + o_); } } while (0)
        OUTPROJ_LD(0, 0, 0);
#pragma unroll
        for (int ai = 0; ai < 2; ++ai)
#pragma unroll
            for (int m = 0; m < 4; ++m) {
                const int kb = ai * 2 + (m >> 1);
                if ((m & 1) == 0 && kb < 3) OUTPROJ_LD((kb + 1) & 1, (kb + 1) >> 1, (kb + 1) & 1);
                const int row = u.pm * 256 + ai * 128 + wr * 64 + m * 16 + fr;
                float ss = 0.f;
#pragma unroll
                for (int bj = 0; bj < 2; ++bj) {
                    const int col = u.pn * 256 + bj * 128 + wc * 32 + 8 * fq;
                    const size_t o = (size_t)row * D + col;
                    const pg8::u32x4 xw = xv[kb & 1][m & 1][bj];
                    const pg8::f32x4 a = (pg8::f32x4){u2f(xw.x << 16), u2f(xw.x & 0xffff0000u), u2f(xw.y << 16), u2f(xw.y & 0xffff0000u)} + acc[ai][bj][m][0];
                    const pg8::f32x4 b = (pg8::f32x4){u2f(xw.z << 16), u2f(xw.z & 0xffff0000u), u2f(xw.w << 16), u2f(xw.w & 0xffff0000u)} + acc[ai][bj][m][1];
                    ss += (a[0] * a[0] + a[1] * a[1]) + (a[2] * a[2] + a[3] * a[3]) + (b[0] * b[0] + b[1] * b[1]) + (b[2] * b[2] + b[3] * b[3]);
                    pg8::u32x4 w; w.x = pg8::cvt_pk_bf16(a[0], a[1]); w.y = pg8::cvt_pk_bf16(a[2], a[3]); w.z = pg8::cvt_pk_bf16(b[0], b[1]); w.w = pg8::cvt_pk_bf16(b[2], b[3]);
                    *(pg8::u32x4*)(x1b + o) = w;
                    float mx = fmaxf(fmaxf(fmaxf(fabsf(a[0]), fabsf(a[1])), fmaxf(fabsf(a[2]), fabsf(a[3]))), fmaxf(fmaxf(fabsf(b[0]), fabsf(b[1])), fmaxf(fabsf(b[2]), fabsf(b[3]))));
                    mx = fmaxf(mx, __shfl_xor(mx, 16)); mx = fmaxf(mx, __shfl_xor(mx, 32));
                    const float inv = mx > 0.f ? 119.0f * __builtin_amdgcn_rcpf(mx) : 0.f;
                    unsigned ra[4], rb[4], ta[4], tb[4];
#pragma unroll
                    for (int i = 0; i < 4; ++i) { ra[i] = __builtin_bit_cast(unsigned, a[i] * inv + 12582912.0f); rb[i] = __builtin_bit_cast(unsigned, b[i] * inv + 12582912.0f); ta[i] = ra[i] + 8u; tb[i] = rb[i] + 8u; }
#define OP_PACK4(r) (__builtin_amdgcn_perm(r[1], r[0], 0x0c0c0400u) | __builtin_amdgcn_perm(r[3], r[2], 0x04000c0cu))
                    const unsigned pl = (OP_PACK4(ra) & 0x0f0f0f0fu) | ((OP_PACK4(rb) & 0x0f0f0f0fu) << 4);
                    const unsigned ph = ((OP_PACK4(ta) >> 4) & 0x0f0f0f0fu) | (OP_PACK4(tb) & 0xf0f0f0f0u);
#undef OP_PACK4
                    unsigned* cq = (unsigned*)(x1q + (size_t)row * D + (col & ~31));
                    *(uint2*)(cq + 2 * fq) = make_uint2(pl, ph);
                    if (fq == 0) xsc[(size_t)row * 32 + (col >> 5)] = mx * (1.0f / 119.0f);
                }
                ss += __shfl_xor(ss, 16); ss += __shfl_xor(ss, 32);
                if (fq == 0) ssq[(size_t)row * 16 + u.pn * 4 + wc] = ss;
            }
    }
};
#undef OUTPROJ_LD
struct EpiPeerQ {
    static constexpr bool PERM = true, AFTER_DRAIN = false, MIDSCALE = false, PREWAIT = true;
    static constexpr int PREWAIT_T = 2;
    bf16_t* qp; const XcdBarrier* bar; bool pre;
    __device__ __forceinline__ void prewait() const { if (pre) xcd_barrier_wait_inloop(*bar); }
    __device__ __forceinline__ void operator()(const pg8::f32x4 (&acc)[2][2][4][2], const pg8::Unit& u, int wr, int wc, int fr, int fq) const {
#pragma unroll
        for (int ai = 0; ai < 2; ++ai)
#pragma unroll
            for (int m = 0; m < 4; ++m) {
                const int row = u.pm * 256 + ai * 128 + wr * 64 + m * 16 + fr;
#pragma unroll
                for (int bj = 0; bj < 2; ++bj) {
                    const pg8::f32x4 a = acc[ai][bj][m][0], b = acc[ai][bj][m][1];
                    pg8::u32x4 w; w.x = pg8::cvt_pk_bf16(a[0], a[1]); w.y = pg8::cvt_pk_bf16(a[2], a[3]); w.z = pg8::cvt_pk_bf16(b[0], b[1]); w.w = pg8::cvt_pk_bf16(b[2], b[3]);
                    *(pg8::u32x4*)(qp + ((((size_t)((row >> 5) * 8 + u.pn) * 2 + bj) * 8 + 2 * wc + (fq >> 1)) * 64 + (row & 31) + 32 * (fq & 1)) * 8) = w;
                }
            }
    }
};

typedef float f32x2v __attribute__((ext_vector_type(2)));
typedef __bf16 bf16x2v __attribute__((ext_vector_type(2)));
__device__ __forceinline__ unsigned cvtpk(float lo, float hi) { const f32x2v v = {lo, hi}; const bf16x2v b = __builtin_convertvector(v, bf16x2v); return __builtin_bit_cast(unsigned, b); }
__device__ __forceinline__ bf16x8 pack_step(const f32x16& x, int s) {
    u32x4 pkd; pkd.x = cvtpk(x[8 * s], x[8 * s + 1]); pkd.y = cvtpk(x[8 * s + 2], x[8 * s + 3]); pkd.z = cvtpk(x[8 * s + 4], x[8 * s + 5]); pkd.w = cvtpk(x[8 * s + 6], x[8 * s + 7]);
    return __builtin_bit_cast(bf16x8, pkd);
}
#define MFMA32(a, b, c) __builtin_amdgcn_mfma_f32_32x32x16_bf16((a), (b), (c), 0, 0, 0)
__device__ __forceinline__ void ph_attn(const Params& p) {
    unsigned char* ws = p.ws;
    const bf16_t* qh = (const bf16_t*)(ws + WS_QH); const bf16_t* kh = (const bf16_t*)(ws + WS_KH); const bf16_t* vT = (const bf16_t*)(ws + WS_VH);
    bf16_t* mixo = (bf16_t*)(ws + WS_MIX); float* ssb = (float*)(ws + WS_SSB);
    const int tid = phase_tid(), lane = tid & 63, r = lane & 31, hh = lane >> 5;
    const int gwave = (blockIdx.x * blockDim.x + tid) >> 6, nwave = (gridDim.x * blockDim.x) >> 6;
    bf16x8 tp[2];
#pragma unroll
    for (int ss = 0; ss < 2; ++ss)
#pragma unroll
        for (int e = 0; e < 8; ++e) { const int k = 16 * ss + 8 * (e >> 2) + 4 * hh + (e & 3); tp[ss][e] = (k > r) ? (short)0x3F80 : (short)0; }
    f32x16 zero16;
#pragma unroll
    for (int i = 0; i < 16; ++i) zero16[i] = 0.f;
    for (int u = gwave; u < NH * (S / 32); u += nwave) {
        const int h = u / (S / 32), t0 = (u % (S / 32)) * 32;
        bf16x8 bq[4];
#pragma unroll
        for (int s = 0; s < 4; ++s) bq[s] = *(const bf16x8*)(qh + (((size_t)(h * (S / 32) + (t0 >> 5)) * 4 + s) * 64 + lane) * 8);
        f32x16 ot[2] = {zero16, zero16};
        float carry = 0.f;
        for (int kt0 = t0; kt0 >= 0; kt0 -= 32) {
            bf16x8 ak[4], av[2][2];
#pragma unroll
            for (int s = 0; s < 4; ++s) ak[s] = *(const bf16x8*)(kh + (((size_t)(h * (S / 32) + (kt0 >> 5)) * 4 + s) * 64 + lane) * 8);
#pragma unroll
            for (int dt = 0; dt < 2; ++dt)
#pragma unroll
                for (int ss = 0; ss < 2; ++ss) av[dt][ss] = *(const bf16x8*)(vT + ((((size_t)(h * (S / 32) + (kt0 >> 5)) * 2 + dt) * 2 + ss) * 64 + lane) * 8);
            f32x16 st = zero16;
#pragma unroll
            for (int s = 0; s < 4; ++s) st = MFMA32(ak[s], bq[s], st);
            const bool diag = (kt0 == t0);
            f32x16 lom, lb;
            float csum = 0.f;
#pragma unroll
            for (int i = 0; i < 16; ++i) {
                const float z = st[i];
                const float sp2 = fmaxf(z, 0.f) + __builtin_amdgcn_logf(1.0f + __builtin_amdgcn_exp2f(-fabsf(z)));
                const bool valid = !diag || ((i & 3) + 8 * (i >> 2) + 4 * hh < r);
                lom[i] = valid ? -sp2 : 0.f;
                lb[i] = z - sp2;
                csum += lom[i];
            }
            f32x16 suf = MFMA32(tp[0], pack_step(lom, 0), zero16);
            suf = MFMA32(tp[1], pack_step(lom, 1), suf);
            f32x16 w;
#pragma unroll
            for (int i = 0; i < 16; ++i) {
                const bool valid = !diag || ((i & 3) + 8 * (i >> 2) + 4 * hh < r);
                w[i] = valid ? __builtin_amdgcn_exp2f(lb[i] + suf[i] + carry) : 0.f;
            }
            const bf16x8 w0 = pack_step(w, 0), w1 = pack_step(w, 1);
#pragma unroll
            for (int dt = 0; dt < 2; ++dt) { ot[dt] = MFMA32(av[dt][0], w0, ot[dt]); ot[dt] = MFMA32(av[dt][1], w1, ot[dt]); }
            carry += csum + __shfl_xor(csum, 32);
            if (__all(carry < CARRY_STOP)) break;
        }
        float oss = 0.f;
#pragma unroll
        for (int dt = 0; dt < 2; ++dt)
#pragma unroll
            for (int g = 0; g < 4; ++g) {
                uint2 o; o.x = cvtpk(ot[dt][4 * g], ot[dt][4 * g + 1]); o.y = cvtpk(ot[dt][4 * g + 2], ot[dt][4 * g + 3]);
                oss += (ot[dt][4 * g] * ot[dt][4 * g] + ot[dt][4 * g + 1] * ot[dt][4 * g + 1]) + (ot[dt][4 * g + 2] * ot[dt][4 * g + 2] + ot[dt][4 * g + 3] * ot[dt][4 * g + 3]);
                *(uint2*)(mixo + (size_t)(t0 + r) * D + h * HD + 32 * dt + 8 * g + 4 * hh) = o;
            }
        oss += __shfl_xor(oss, 32);
        if (hh == 0) ssb[(size_t)(t0 + r) * NH + h] = oss;
    }
}

constexpr int RG_LDS_CST = 0, RG_LDS_HIN = 16384, RG_LDS_P = 18432, RG_LDS_SSQ = 20480;
constexpr int RG_LDS_X = 22528, RG_XP = 1032, RG_LDS_O = 91904;
typedef unsigned u32x2 __attribute__((ext_vector_type(2)));
typedef __attribute__((address_space(3))) float lds_f;
typedef __attribute__((address_space(3))) unsigned char lds_b;
template <int CTRL, int ROWMASK>
__device__ __forceinline__ float dpp_mov(float oob, float x) {
    return __builtin_bit_cast(float, __builtin_amdgcn_update_dpp(__builtin_bit_cast(int, oob), __builtin_bit_cast(int, x), CTRL, ROWMASK, 0xf, false));
}
template <int CTRL, int ROWMASK>
__device__ __forceinline__ void scan_step(float (&av)[16], float (&bv)[16]) {
#pragma unroll
    for (int i = 0; i < 16; ++i) {
        const float ap = dpp_mov<CTRL, ROWMASK>(1.0f, av[i]), bp = dpp_mov<CTRL, ROWMASK>(0.0f, bv[i]);
        bv[i] = __builtin_fmaf(av[i], bp, bv[i]); av[i] *= ap;
    }
}
__device__ __forceinline__ void rg1_prefetch(const Params& p, int ch, uint2 (&gwp)[16]) {
    const bf16_t* gg = (const bf16_t*)(p.ws + WS_GG);
    const int tid = phase_tid(), lane = tid & 63, n = __builtin_amdgcn_readfirstlane(tid >> 6);
#pragma unroll
    for (int tl = 0; tl < 2; ++tl)
#pragma unroll
        for (int m = 0; m < 8; ++m) gwp[8 * tl + m] = ch < NCHUNK ? *(const uint2*)(gg + ((((size_t)(2 * ch + tl) * 8 + n) * 8 + m) * 64 + lane) * 4) : make_uint2(0u, 0u);
    __builtin_amdgcn_sched_barrier(0);
}
__device__ __forceinline__ void rg0_consts(const Params& p, unsigned char* lds_raw) {
    float* lds = (float*)lds_raw;
    const int tid = phase_tid();
    {
        static_assert(NTHR == 512, "constant-table indexing assumes 512 threads");
        const int q = tid & 31, k = (tid >> 5) & 7, h2 = (tid >> 8) & 1;
        const int cb = 32 * (q >> 4) + (q & 3) + 8 * ((q >> 2) & 3) + 4 * h2;
        const float* sp = k < 4 ? p.in[I_CONV_W] + k * DRG : k == 4 ? p.in[I_CONV_B] : k == 5 ? p.in[I_RG_B_A] : k == 6 ? p.in[I_RG_B_X] : p.in[I_RG_LAMBDA];
        float cv[8];
#pragma unroll
        for (int nn = 0; nn < 8; ++nn) cv[nn] = sp[64 * nn + cb];
#pragma unroll
        for (int nn = 0; nn < 8; ++nn) lds[tid + NTHR * nn] = k == 7 ? 8.0f * LOG2E * log1pf(__expf(-cv[nn])) : cv[nn];
    }
}
template <int PASS>
__device__ __forceinline__ void ph_rg(const Params& p, unsigned char* lds_raw, uint2 (&gwp)[16]) {
    float* lds = (float*)lds_raw;
    unsigned char* ws = p.ws;
    const bf16_t* xrg = (const bf16_t*)(ws + WS_XRG); const bf16_t* gg = (const bf16_t*)(ws + WS_GG); const bf16_t* wfrag = (const bf16_t*)(ws + WS_RGW);
    bf16_t* mix = (bf16_t*)(ws + WS_MIX);
    float* rgP = (float*)(ws + WS_RGP); float* rgH = (float*)(ws + WS_RGH);
    const __amdgpu_buffer_rsrc_t wsr = ws_rsrc(ws);
    bf16_t* scA = (bf16_t*)(ws + WS_RGSA); bf16_t* scB = (bf16_t*)(ws + WS_RGSB);
    const int tid = phase_tid(), lane = tid & 63, r = lane & 31, hh = lane >> 5, n = __builtin_amdgcn_readfirstlane(tid >> 6);
    __syncthreads();
    const unsigned lds0 = (unsigned)(size_t)((lds_b*)lds_raw);
    const unsigned cst_base = lds0 + (unsigned)((n * 2 + hh) * 1024);
    lds_f* hin_l = (lds_f*)(size_t)(lds0 + RG_LDS_HIN + (n * 2 + hh) * 128);
    lds_f* pc_l = (lds_f*)(size_t)(lds0 + RG_LDS_P + (n * 2 + hh) * 128);
    lds_b* xt = (lds_b*)(size_t)(lds0 + RG_LDS_X);
    lds_b* ot = (lds_b*)(size_t)(lds0 + RG_LDS_O);
    const bool lds_res = (int)gridDim.x >= NCHUNK;
    f32x16 zero16;
#pragma unroll
    for (int i = 0; i < 16; ++i) zero16[i] = 0.f;
    for (int ch = blockIdx.x; ch < NCHUNK; ch += gridDim.x) {
        const int t0 = ch * CHUNK;
        if (PASS == 1 && ch != (int)blockIdx.x) rg1_prefetch(p, ch, gwp);
        constexpr int NXS = ((CHUNK + 3) * 64 + NTHR - 1) / NTHR;
        u32x4 xs[PASS == 0 ? NXS : 1];
        if (PASS == 0) {
#pragma unroll
            for (int j = 0; j < NXS; ++j) {
                const int ci = tid + NTHR * j, row = ci >> 6, c16 = ci & 63, tt = t0 - 3 + row;
                xs[j] = (u32x4){0u, 0u, 0u, 0u};
                if (ci < (CHUNK + 3) * 64 && tt >= 0) xs[j] = *(const u32x4*)(xrg + (size_t)tt * DRG + 8 * c16);
            }
            __builtin_amdgcn_sched_barrier(0);
        }
        __syncthreads();
        if (PASS == 0) {
#pragma unroll
            for (int j = 0; j < NXS; ++j) {
                const int ci = tid + NTHR * j, row = ci >> 6, c16 = ci & 63;
                if (ci < (CHUNK + 3) * 64) {
                    __attribute__((address_space(3))) u32x2* d = (__attribute__((address_space(3))) u32x2*)(xt + row * RG_XP + 16 * c16);
                    d[0] = (u32x2){xs[j].x, xs[j].y}; d[1] = (u32x2){xs[j].z, xs[j].w};
                }
            }
        }
        if (PASS == 1) {
            const int c = 64 * n + lane;
            float h = 0.f;
            {
                const float* gP = (const float*)(ws + WS_RGGP); const float* gH = (const float*)(ws + WS_RGGH);
                const int g = ch / RG_GRP, k0 = g * RG_GRP;
                float pv[RG_GRP], hv[RG_GRP], pw[RG_GRP], hw[RG_GRP];
#pragma unroll
                for (int j = 0; j < RG_GRP; ++j) {
                    const bool on = j < g; const int jj = on ? j : 0;
                    const float a = gP[jj * DRG + c], b2 = gH[jj * DRG + c];
                    pv[j] = on ? a : 1.f; hv[j] = on ? b2 : 0.f;
                    const bool on2 = k0 + j < ch; const int kk = on2 ? k0 + j : 0;
                    const float a2 = rgP[kk * DRG + c], b3 = rgH[kk * DRG + c];
                    pw[j] = on2 ? a2 : 1.f; hw[j] = on2 ? b3 : 0.f;
                }
#pragma unroll
                for (int j = 0; j < RG_GRP; ++j) h = pv[j] * h + hv[j];
#pragma unroll
                for (int j = 0; j < RG_GRP; ++j) h = pw[j] * h + hw[j];
            }
            lds[RG_LDS_HIN / 4 + (n * 2 + ((lane >> 2) & 1)) * 32 + 16 * (lane >> 5) + 4 * ((lane >> 3) & 3) + (lane & 3)] = h;
        } else {
            if (r == 0) {
#pragma unroll
                for (int q = 0; q < 32; ++q) { hin_l[q] = 0.f; pc_l[q] = 1.f; }
            }
        }
        __syncthreads();
#pragma unroll 1
        for (int tl = 0; tl < 2; ++tl) {
            const int tok = t0 + 32 * tl + r;
            unsigned cst_a = cst_base; asm volatile("" : "+v"(cst_a));
            const lds_f* cst = (const lds_f*)(size_t)cst_a;
            float xcv[32]; bf16x8 bx[4];
            if (PASS == 0) {
#pragma unroll
            for (int q = 0; q < 32; ++q) xcv[q] = cst[4 * 32 + q];
#pragma unroll
            for (int k = 0; k < 4; ++k) {
                const lds_b* xr = xt + (32 * tl + r + k) * RG_XP + (64 * n + 4 * hh) * 2;
#pragma unroll
                for (int m = 0; m < 8; ++m) {
                    const u32x2 xw = *(const __attribute__((address_space(3))) u32x2*)(xr + 16 * m);
                    xcv[4 * m + 0] += cst[k * 32 + 4 * m + 0] * bf2f(xw.x & 0xffffu); xcv[4 * m + 1] += cst[k * 32 + 4 * m + 1] * bf2f(xw.x >> 16);
                    xcv[4 * m + 2] += cst[k * 32 + 4 * m + 2] * bf2f(xw.y & 0xffffu); xcv[4 * m + 3] += cst[k * 32 + 4 * m + 3] * bf2f(xw.y >> 16);
                }
                __builtin_amdgcn_sched_barrier(0);
            }
#pragma unroll
            for (int s = 0; s < 4; ++s) {
                u32x4 pk; pk.x = cvtpk(xcv[8 * s], xcv[8 * s + 1]); pk.y = cvtpk(xcv[8 * s + 2], xcv[8 * s + 3]); pk.z = cvtpk(xcv[8 * s + 4], xcv[8 * s + 5]); pk.w = cvtpk(xcv[8 * s + 6], xcv[8 * s + 7]);
                bx[s] = __builtin_bit_cast(bf16x8, pk);
            }
            }
            float ss = 0.f;
            const bf16_t* wb = wfrag + ((size_t)n * 16 * 64 + lane) * 8; asm volatile("" : "+v"(wb));
#pragma unroll
            for (int jt = 0; jt < 2; ++jt) {
                float av[16], bv[16];
                const size_t sco = ((((size_t)(2 * ch + tl) * 8 + n) * 2 + jt) * 64 + lane) * 16;
                if (PASS == 0) {
#pragma unroll
                for (int g = 0; g < 2; ++g) {
                    f32x16 acc = zero16;
#pragma unroll
                    for (int s = 0; s < 4; ++s) {
                        const bf16x8 aw = *(const __attribute__((address_space(1))) bf16x8*)(wb + (((g * 2 + jt) * 4 + s) * 64) * 8);
                        acc = MFMA32(aw, bx[s], acc);
                    }
#pragma unroll
                    for (int i = 0; i < 16; ++i) {
                        const int q = 16 * jt + i;
                        const float pre = acc[i] + cst[(5 + g) * 32 + q];
                        const float sg = __builtin_amdgcn_rcpf(1.0f + __builtin_amdgcn_exp2f(-LOG2E * pre));
                        if (g == 0) av[i] = __builtin_amdgcn_exp2f(-sg * cst[7 * 32 + q]);
                        else bv[i] = __builtin_amdgcn_sqrtf(fmaxf(__builtin_fmaf(-av[i], av[i], 1.0f), 0.f)) * (sg * xcv[q]);
                    }
                    __builtin_amdgcn_sched_barrier(0);
                }
#define RG_SCAN(DPPSTR) do { asm volatile("s_nop 1"); _Pragma("unroll") for (int i_ = 0; i_ < 16; ++i_) { \
                    asm volatile("v_fmac_f32_dpp %0, %0, %1 " DPPSTR : "+v"(bv[i_]) : "v"(av[i_])); \
                    asm volatile("v_mul_f32_dpp %0, %0, %0 " DPPSTR : "+v"(av[i_])); } } while (0)
                RG_SCAN("row_shr:1 row_mask:0xf bank_mask:0xf"); RG_SCAN("row_shr:2 row_mask:0xf bank_mask:0xf"); RG_SCAN("row_shr:4 row_mask:0xf bank_mask:0xf"); RG_SCAN("row_shr:8 row_mask:0xf bank_mask:0xf");
                RG_SCAN("row_bcast:15 row_mask:0xa bank_mask:0xf");
#undef RG_SCAN
                u32x4 sa0, sa1, sb0, sb1;
                sa0.x = cvtpk(av[0], av[1]); sa0.y = cvtpk(av[2], av[3]); sa0.z = cvtpk(av[4], av[5]); sa0.w = cvtpk(av[6], av[7]); sa1.x = cvtpk(av[8], av[9]); sa1.y = cvtpk(av[10], av[11]); sa1.z = cvtpk(av[12], av[13]); sa1.w = cvtpk(av[14], av[15]);
                sb0.x = cvtpk(bv[0], bv[1]); sb0.y = cvtpk(bv[2], bv[3]); sb0.z = cvtpk(bv[4], bv[5]); sb0.w = cvtpk(bv[6], bv[7]); sb1.x = cvtpk(bv[8], bv[9]); sb1.y = cvtpk(bv[10], bv[11]); sb1.z = cvtpk(bv[12], bv[13]); sb1.w = cvtpk(bv[14], bv[15]);
                if (lds_res) {
                    const unsigned so_ = (unsigned)((32 * tl + r) * RG_XP + (64 * n + 32 * jt + 4 * hh) * 2);
                    __attribute__((address_space(3))) u32x2* da = (__attribute__((address_space(3))) u32x2*)(xt + so_); __attribute__((address_space(3))) u32x2* db = (__attribute__((address_space(3))) u32x2*)(ot + so_);
                    da[0] = (u32x2){sa0.x, sa0.y}; da[2] = (u32x2){sa0.z, sa0.w}; da[4] = (u32x2){sa1.x, sa1.y}; da[6] = (u32x2){sa1.z, sa1.w};
                    db[0] = (u32x2){sb0.x, sb0.y}; db[2] = (u32x2){sb0.z, sb0.w}; db[4] = (u32x2){sb1.x, sb1.y}; db[6] = (u32x2){sb1.z, sb1.w};
                } else { *(u32x4*)(scA + sco) = sa0; *(u32x4*)(scA + sco + 8) = sa1; *(u32x4*)(scB + sco) = sb0; *(u32x4*)(scB + sco + 8) = sb1; }
                } else {
                    u32x4 sa0, sa1, sb0, sb1;
                    if (lds_res) {
                        const unsigned so_ = (unsigned)((32 * tl + r) * RG_XP + (64 * n + 32 * jt + 4 * hh) * 2);
                        const __attribute__((address_space(3))) u32x2* da = (const __attribute__((address_space(3))) u32x2*)(xt + so_); const __attribute__((address_space(3))) u32x2* db = (const __attribute__((address_space(3))) u32x2*)(ot + so_);
                        const u32x2 a0 = da[0], a1 = da[2], a2 = da[4], a3 = da[6], b0 = db[0], b1 = db[2], b2 = db[4], b3 = db[6];
                        sa0 = (u32x4){a0.x, a0.y, a1.x, a1.y}; sa1 = (u32x4){a2.x, a2.y, a3.x, a3.y}; sb0 = (u32x4){b0.x, b0.y, b1.x, b1.y}; sb1 = (u32x4){b2.x, b2.y, b3.x, b3.y};
                    } else { sa0 = *(const u32x4*)(scA + sco); sa1 = *(const u32x4*)(scA + sco + 8); sb0 = *(const u32x4*)(scB + sco); sb1 = *(const u32x4*)(scB + sco + 8); }
                    const unsigned wa[8] = {sa0.x, sa0.y, sa0.z, sa0.w, sa1.x, sa1.y, sa1.z, sa1.w}, wbb[8] = {sb0.x, sb0.y, sb0.z, sb0.w, sb1.x, sb1.y, sb1.z, sb1.w};
#pragma unroll
                    for (int k = 0; k < 8; ++k) { av[2 * k] = bf2f(wa[k] & 0xffffu); av[2 * k + 1] = bf2f(wa[k] >> 16); bv[2 * k] = bf2f(wbb[k] & 0xffffu); bv[2 * k + 1] = bf2f(wbb[k] >> 16); }
                }
                __builtin_amdgcn_sched_barrier(0);
#pragma unroll
                for (int i = 0; i < 16; ++i) {
                    const int q = 16 * jt + i;
                    bv[i] = __builtin_fmaf(av[i], hin_l[q], bv[i]);
                }
                if (r == 31) {
#pragma unroll
                    for (int i = 0; i < 16; ++i) { const int q = 16 * jt + i; hin_l[q] = bv[i]; if (PASS == 0) pc_l[q] *= av[i]; }
                }
                if (PASS == 1) {
#pragma unroll
                    for (int g4 = 0; g4 < 4; ++g4) {
                        const int m = 4 * jt + g4;
                        const uint2 gw = tl ? gwp[8 + m] : gwp[m];
                        const float o0 = bv[4 * g4] * gelu_tanh(bf2f(gw.x & 0xffffu)), o1 = bv[4 * g4 + 1] * gelu_tanh(bf2f(gw.x >> 16)), o2 = bv[4 * g4 + 2] * gelu_tanh(bf2f(gw.y & 0xffffu)), o3 = bv[4 * g4 + 3] * gelu_tanh(bf2f(gw.y >> 16));
                        ss += (o0 * o0 + o1 * o1) + (o2 * o2 + o3 * o3);
                        *(__attribute__((address_space(3))) u32x2*)(ot + (32 * tl + r) * RG_XP + (64 * n + 8 * m + 4 * hh) * 2) = (u32x2){cvtpk(o0, o1), cvtpk(o2, o3)};
                    }
                }
                __builtin_amdgcn_sched_barrier(0);
            }
            if (PASS == 1) { ss += __shfl_xor(ss, 32); if (hh == 0) lds[RG_LDS_SSQ / 4 + (tl * 8 + n) * 32 + r] = ss; }
        }
        if (PASS == 0) {
            if (r == 0) {
#pragma unroll
                for (int m = 0; m < 8; ++m) {
                    const int c = 64 * n + 8 * m + 4 * hh;
                    const f32x4 pq = {pc_l[4 * m], pc_l[4 * m + 1], pc_l[4 * m + 2], pc_l[4 * m + 3]}, hq = {hin_l[4 * m], hin_l[4 * m + 1], hin_l[4 * m + 2], hin_l[4 * m + 3]};
                    wt16(wsr, (unsigned)WS_RGP + (unsigned)(ch * DRG + c) * 4u, __builtin_bit_cast(u32x4, pq));
                    wt16(wsr, (unsigned)WS_RGH + (unsigned)(ch * DRG + c) * 4u, __builtin_bit_cast(u32x4, hq));
                }
            }
            asm volatile("s_waitcnt vmcnt(0)" ::: "memory");
            __syncthreads();
            if (tid == 0) {
                const unsigned old = __hip_atomic_fetch_add((unsigned*)(ws + WS_CTL) + CTL_RGCNT + ch / RG_GRP, 1u, __ATOMIC_RELAXED, __HIP_MEMORY_SCOPE_AGENT);
                lds[RG_LDS_SSQ / 4] = __builtin_bit_cast(float, old);
            }
            __syncthreads();
            if (__builtin_bit_cast(unsigned, lds[RG_LDS_SSQ / 4]) == (unsigned)(RG_GRP - 1)) {
                if (tid == 0) { __builtin_amdgcn_fence(__ATOMIC_ACQUIRE, "agent"); asm volatile("s_waitcnt vmcnt(0)" ::: "memory"); }
                __syncthreads();
                const int k0 = (ch / RG_GRP) * RG_GRP;
                float pv[RG_GRP], hv[RG_GRP];
#pragma unroll
                for (int j = 0; j < RG_GRP; ++j) { pv[j] = rgP[(k0 + j) * DRG + tid]; hv[j] = rgH[(k0 + j) * DRG + tid]; }
                float pp = 1.f, hq = 0.f;
#pragma unroll
                for (int j = 0; j < RG_GRP; ++j) { hq = pv[j] * hq + hv[j]; pp *= pv[j]; }
                ((float*)(ws + WS_RGGP))[(ch / RG_GRP) * DRG + tid] = pp; ((float*)(ws + WS_RGGH))[(ch / RG_GRP) * DRG + tid] = hq;
            }
        } else {
            __syncthreads();
            for (int j = 0; j < 8; ++j) {
                const int tr = 8 * n + j, tok = t0 + tr;
                float tot = 0.f;
#pragma unroll
                for (int w = 0; w < 8; ++w) tot += lds[RG_LDS_SSQ / 4 + ((tr >> 5) * 8 + w) * 32 + (tr & 31)];
                const float rn = rsqrtf(tot * (1.0f / DRG) + EPS);
                const __attribute__((address_space(3))) u32x2* op = (const __attribute__((address_space(3))) u32x2*)(ot + tr * RG_XP + 16 * lane);
                const u32x2 w0 = op[0], w1 = op[1];
                u32x4 o2; o2.x = cvtpk(bf2f(w0.x & 0xffffu) * rn, bf2f(w0.x >> 16) * rn); o2.y = cvtpk(bf2f(w0.y & 0xffffu) * rn, bf2f(w0.y >> 16) * rn);
                o2.z = cvtpk(bf2f(w1.x & 0xffffu) * rn, bf2f(w1.x >> 16) * rn); o2.w = cvtpk(bf2f(w1.y & 0xffffu) * rn, bf2f(w1.y >> 16) * rn);
                *((u32x4*)(mix + (size_t)tok * D + DSB) + lane) = o2;
            }
            if (tid < CHUNK) {
                const f32x4 s0 = *(const f32x4*)(ws + WS_SSB + (size_t)(t0 + tid) * NH * 4), s1 = *(const f32x4*)(ws + WS_SSB + (size_t)(t0 + tid) * NH * 4 + 16);
                ((float*)(ws + WS_RSB))[t0 + tid] = rsqrtf(((s0.x + s0.y) + (s0.z + s0.w) + (s1.x + s1.y) + (s1.z + s1.w)) * (1.0f / DSB) + EPS);
            }
        }
    }
}

__device__ __forceinline__ float kmax(float a, float b) { float r; asm("v_max_f32 %0, %1, %2" : "=v"(r) : "v"(a), "v"(b)); return r; }
__device__ __forceinline__ float kmin(float a, float b) { float r; asm("v_min_f32 %0, %1, %2" : "=v"(r) : "v"(a), "v"(b)); return r; }
__device__ __forceinline__ float key_tag(float f, unsigned keep, unsigned tag) { return __builtin_bit_cast(float, (__builtin_bit_cast(unsigned, f) & keep) | tag); }
#define TOPK_CE(a, b) do { const float hi_ = kmax(a, b), lo_ = kmin(a, b); a = hi_; b = lo_; } while (0)
__device__ __forceinline__ void sort16_desc(float (&v)[16]) { TOPK_CE(v[0], v[1]); TOPK_CE(v[2], v[3]); TOPK_CE(v[0], v[2]); TOPK_CE(v[1], v[3]); TOPK_CE(v[1], v[2]); TOPK_CE(v[4], v[5]); TOPK_CE(v[6], v[7]); TOPK_CE(v[4], v[6]); TOPK_CE(v[5], v[7]); TOPK_CE(v[5], v[6]); TOPK_CE(v[0], v[4]); TOPK_CE(v[2], v[6]); TOPK_CE(v[2], v[4]); TOPK_CE(v[1], v[5]); TOPK_CE(v[3], v[7]); TOPK_CE(v[3], v[5]); TOPK_CE(v[1], v[2]); TOPK_CE(v[3], v[4]); TOPK_CE(v[5], v[6]); TOPK_CE(v[8], v[9]); TOPK_CE(v[10], v[11]); TOPK_CE(v[8], v[10]); TOPK_CE(v[9], v[11]); TOPK_CE(v[9], v[10]); TOPK_CE(v[12], v[13]); TOPK_CE(v[14], v[15]); TOPK_CE(v[12], v[14]); TOPK_CE(v[13], v[15]); TOPK_CE(v[13], v[14]); TOPK_CE(v[8], v[12]); TOPK_CE(v[10], v[14]); TOPK_CE(v[10], v[12]); TOPK_CE(v[9], v[13]); TOPK_CE(v[11], v[15]); TOPK_CE(v[11], v[13]); TOPK_CE(v[9], v[10]); TOPK_CE(v[11], v[12]); TOPK_CE(v[13], v[14]); TOPK_CE(v[0], v[8]); TOPK_CE(v[4], v[12]); TOPK_CE(v[4], v[8]); TOPK_CE(v[2], v[10]); TOPK_CE(v[6], v[14]); TOPK_CE(v[6], v[10]); TOPK_CE(v[2], v[4]); TOPK_CE(v[6], v[8]); TOPK_CE(v[10], v[12]); TOPK_CE(v[1], v[9]); TOPK_CE(v[5], v[13]); TOPK_CE(v[5], v[9]); TOPK_CE(v[3], v[11]); TOPK_CE(v[7], v[15]); TOPK_CE(v[7], v[11]); TOPK_CE(v[3], v[5]); TOPK_CE(v[7], v[9]); TOPK_CE(v[11], v[13]); TOPK_CE(v[1], v[2]); TOPK_CE(v[3], v[4]); TOPK_CE(v[5], v[6]); TOPK_CE(v[7], v[8]); TOPK_CE(v[9], v[10]); TOPK_CE(v[11], v[12]); TOPK_CE(v[13], v[14]); }
__device__ __forceinline__ void merge16_desc(float (&a)[16], const float (&b)[16]) {
#pragma unroll
    for (int i = 0; i < 16; ++i) a[i] = kmax(a[i], b[15 - i]);
#pragma unroll
    for (int d = 8; d >= 1; d >>= 1)
#pragma unroll
        for (int i = 0; i < 16; ++i) if ((i & d) == 0) TOPK_CE(a[i], a[i + d]);
}
__device__ __forceinline__ void ph_topk(const Params& p, int* lds) {
    unsigned char* ws = p.ws;
    const bf16_t* qp = (const bf16_t*)(ws + WS_B); const bf16_t* subk = (const bf16_t*)(ws + WS_SUBK);
    int* seli = (int*)(ws + WS_SELI); float* selg = (float*)(ws + WS_SELG);
    const float* ssq = (const float*)(ws + WS_SSQ); float* rstd2 = (float*)(ws + WS_RSTD2);
    const int tid = phase_tid(), lane = tid & 63, r = lane & 31, hh = lane >> 5, hx = 4 * hh;
    const int gwave = (blockIdx.x * blockDim.x + tid) >> 6, nwave = (gridDim.x * blockDim.x) >> 6;
    constexpr int SK_OFF = 65536, SK_PITCH = 272;
    typedef __attribute__((address_space(3))) unsigned char lds_b;
    lds_b* skl = (lds_b*)lds + SK_OFF;
    const int w = tid >> 6;
    PeerOrder so; so.init_peer(S, NQ, (int)gridDim.x, (int)blockIdx.x, (int)gridDim.x == (S / 256) * (D / 256));
    pg8::Unit gu;
    for (int ui = 0; so.next(ui, gu); ++ui) {
        const int h = gu.pn, t0 = gu.pm * 256 + 32 * w, t = t0 + r;
        u32x4 skv[8]; bf16x8 bq[2][8];
#pragma unroll
        for (int j = 0; j < 8; ++j) {
            const int ci = tid + NTHR * j, row = ci >> 4, c16 = ci & 15;
            skv[j] = *(const u32x4*)(subk + ((size_t)h * 256 + row) * PHALF + 8 * c16);
        }
#pragma unroll
        for (int pp = 0; pp < 2; ++pp)
#pragma unroll
            for (int s = 0; s < 8; ++s) bq[pp][s] = *(const bf16x8*)(qp + ((((size_t)((t0 >> 5) * 8 + h) * 2 + pp) * 8 + s) * 64 + lane) * 8);
        __builtin_amdgcn_sched_barrier(0);
        __syncthreads();
#pragma unroll
        for (int j = 0; j < 8; ++j) {
            const int ci = tid + NTHR * j, row = ci >> 4, c16 = ci & 15;
            *(__attribute__((address_space(3))) u32x4*)(skl + row * SK_PITCH + 16 * c16) = skv[j];
        }
        __syncthreads();
        float tk[2][16];
#pragma unroll
        for (int pp = 0; pp < 2; ++pp) {
            f32x16 acc[4];
            const lds_b* krow = skl + (pp * PNK + r) * SK_PITCH + 16 * hh;
#pragma unroll
            for (int s = 0; s < 8; ++s) {
                const bf16x8 b = bq[pp][s];
#pragma unroll
                for (int T = 0; T < 4; ++T) {
                    const bf16x8 a = *(const __attribute__((address_space(3))) bf16x8*)(krow + (32 * T) * SK_PITCH + 32 * s);
                    acc[T] = s == 0 ? __builtin_amdgcn_mfma_f32_32x32x16_bf16(a, b, (f32x16){0.f, 0.f, 0.f, 0.f, 0.f, 0.f, 0.f, 0.f, 0.f, 0.f, 0.f, 0.f, 0.f, 0.f, 0.f, 0.f}, 0, 0, 0)
                                    : __builtin_amdgcn_mfma_f32_32x32x16_bf16(a, b, acc[T], 0, 0, 0);
                }
            }
            float kq[4][16];
#pragma unroll
            for (int T = 0; T < 4; ++T) {
#pragma unroll
                for (int i = 0; i < 16; ++i) {
                    const int nb = 32 * T + (i & 3) + 8 * (i >> 2);
                    kq[T][i] = key_tag(acc[T][i], ~127u, (unsigned)(127 - nb));
                }
                sort16_desc(kq[T]);
            }
            merge16_desc(kq[0], kq[1]); merge16_desc(kq[2], kq[3]); merge16_desc(kq[0], kq[2]);
            float m[16], po[16];
#pragma unroll
            for (int i = 0; i < 16; ++i) { m[i] = __builtin_bit_cast(float, __builtin_bit_cast(int, kq[0][i]) ^ hx); po[i] = __shfl_xor(m[i], 32); }
            merge16_desc(m, po);
#pragma unroll
            for (int i = 0; i < 16; ++i) tk[pp][i] = m[i];
        }
#pragma unroll
        for (int i = 0; i < 16; ++i) { lds[i * NTHR + tid] = __builtin_bit_cast(int, tk[0][i]); lds[(16 + i) * NTHR + tid] = __builtin_bit_cast(int, tk[1][i]); }
        const float (&v0)[16] = tk[0]; const float (&v1)[16] = tk[1];
#define CKEY(a, b) key_tag(v0[a] + v1[b], ~255u, (unsigned)(255 - ((a) * 16 + (b))))
        const float NEGK = __builtin_bit_cast(float, 0xff800000u);
        float bk[16], l1[16], ga[16], gb[16];
#pragma unroll
        for (int b = 0; b < 16; ++b) bk[b] = CKEY(0, b);
#pragma unroll
        for (int b = 0; b < 16; ++b) l1[b] = b < 8 ? CKEY(1, b) : NEGK;
        ga[0] = CKEY(2, 0); ga[1] = CKEY(2, 1); ga[2] = CKEY(2, 2); ga[3] = CKEY(2, 3); ga[4] = CKEY(2, 4);
        ga[5] = CKEY(3, 0); ga[6] = CKEY(3, 1); ga[7] = CKEY(3, 2); ga[8] = CKEY(3, 3);
        ga[9] = CKEY(4, 0); ga[10] = CKEY(4, 1); ga[11] = CKEY(4, 2); ga[12] = CKEY(5, 0); ga[13] = CKEY(5, 1); ga[14] = NEGK; ga[15] = NEGK;
        gb[0] = CKEY(6, 0); gb[1] = CKEY(6, 1); gb[2] = CKEY(7, 0); gb[3] = CKEY(7, 1);
#pragma unroll
        for (int a = 8; a < 16; ++a) gb[a - 4] = CKEY(a, 0);
        gb[12] = NEGK; gb[13] = NEGK; gb[14] = NEGK; gb[15] = NEGK;
#undef CKEY
        sort16_desc(ga); sort16_desc(gb);
        merge16_desc(bk, l1); merge16_desc(ga, gb); merge16_desc(bk, ga);
        float ssum = 0.f;
#pragma unroll
        for (int i = 0; i < 4; ++i) { const f32x4 q4 = *(const f32x4*)(ssq + (size_t)t * 16 + 4 * i); ssum += (q4.x + q4.y) + (q4.z + q4.w); }
        const float rs = rsqrtf(ssum * (1.0f / D) + EPS);
        float e[16], sum = 0.f; const float mx = bk[0];
#pragma unroll
        for (int i = 0; i < 16; ++i) { e[i] = __expf((bk[i] - mx) * rs); sum += e[i]; }
        const float inv = 1.0f / sum;
        int eidx[16];
#pragma unroll
        for (int i = 0; i < 16; ++i) {
            const int code = 255 - (__builtin_bit_cast(int, bk[i]) & 255), a = code >> 4, b = code & 15;
            const int i1 = 127 - (lds[a * NTHR + tid] & 127), i2 = 127 - (lds[(16 + b) * NTHR + tid] & 127);
            eidx[i] = i1 * PNK + i2; e[i] *= inv;
        }
        if (hh == 0) {
            int4* o = (int4*)(seli + (size_t)t * 128 + h * 16);
#pragma unroll
            for (int i = 0; i < 4; ++i) o[i] = make_int4(eidx[4 * i], eidx[4 * i + 1], eidx[4 * i + 2], eidx[4 * i + 3]);
            if (h == 0) rstd2[t] = rs;
        } else {
            f32x4* o = (f32x4*)(selg + (size_t)t * 128 + h * 16);
#pragma unroll
            for (int i = 0; i < 4; ++i) o[i] = (f32x4){e[4 * i], e[4 * i + 1], e[4 * i + 2], e[4 * i + 3]};
        }
    }
}

typedef __bf16 bf16x2_t __attribute__((ext_vector_type(2)));
typedef float f32x2 __attribute__((ext_vector_type(2)));
template <int NV, int XS0, int XS1, int XS2>
__device__ __forceinline__ void reduce_over8(float (&v)[NV], int sel) {
    { const bool up = sel & 1;
#pragma unroll
      for (int i = 0; i < NV / 2; ++i) { const float a = v[2 * i], b = v[2 * i + 1]; v[i] = (up ? b : a) + __shfl_xor(up ? a : b, XS0); } }
    { const bool up = (sel >> 1) & 1;
#pragma unroll
      for (int i = 0; i < NV / 4; ++i) { const float a = v[2 * i], b = v[2 * i + 1]; v[i] = (up ? b : a) + __shfl_xor(up ? a : b, XS1); } }
    { const bool up = (sel >> 2) & 1;
#pragma unroll
      for (int i = 0; i < NV / 8; ++i) { const float a = v[2 * i], b = v[2 * i + 1]; v[i] = (up ? b : a) + __shfl_xor(up ? a : b, XS2); } }
}
__device__ __forceinline__ void peer_load_idx(const unsigned char* ws, int t, int rsl, int (&ei)[16]) {
    const unsigned off = (unsigned)WS_SELI + ((unsigned)t * 128u + 16u * (unsigned)rsl) * 4u;
#pragma unroll
    for (int j = 0; j < 4; ++j) { const int4 v = *(const int4*)(ws + (off + 16u * j)); ei[4 * j] = v.x; ei[4 * j + 1] = v.y; ei[4 * j + 2] = v.z; ei[4 * j + 3] = v.w; }
}
template <int PASS>
__device__ __forceinline__ void peer_load_rows(const unsigned char* ws, int t, int sl, int rsl, int c, const int (&ei)[16], u32x4 (&row)[16], u32x4 (&aux)[4]) {
    const unsigned tab = (unsigned)(PASS == 0 ? WS_UB : WS_VB) + (unsigned)sl * (unsigned)(NEXP * 128) + 16u * (unsigned)c;
#pragma unroll
    for (int i = 0; i < 16; ++i) row[i] = *(const u32x4*)(ws + (tab + (unsigned)ei[i] * 128u));
    const unsigned xo = (unsigned)WS_X1Q + (unsigned)t * (unsigned)D + 256u * sl + 32u * c;
    aux[0] = *(const u32x4*)(ws + xo); aux[1] = *(const u32x4*)(ws + (xo + 16u));
    aux[2].x = *(const unsigned*)(ws + ((unsigned)WS_XSC + ((unsigned)t * 32u + 8u * sl + c) * 4u));
}
constexpr int PEER_IMG_PITCH = 136, PEER_IMG_BYTES = 128 * PEER_IMG_PITCH;
template <int PASS  >
__device__ __forceinline__ void peer_compute(const Params& p, unsigned char* lds, int lane_w, int t, int sl, int rsl, int c, const u32x4 (&row)[16], const u32x4 (&aux)[4]) {
    unsigned char* ws = p.ws;
    if (PASS == 0) {
        const u32x4 x0 = aux[0], x1_ = aux[1]; const unsigned xl[4] = {x0.x, x0.z, x1_.x, x1_.z}, xh[4] = {x0.y, x0.w, x1_.y, x1_.w};
        const unsigned xsu = aux[2].x; const float xs = u2f(xsu);
        float pd[16];
#pragma unroll
        for (int i = 0; i < 16; ++i) {
            const u32x4 rw = row[i]; const unsigned w4[4] = {rw.x, rw.y, rw.z, rw.w};
            int al = 0, ah = 0;
#pragma unroll
            for (int j = 0; j < 4; ++j) { al = __builtin_amdgcn_sdot8((int)w4[j], (int)xl[j], al, false); ah = __builtin_amdgcn_sdot8((int)w4[j], (int)xh[j], ah, false); }
            pd[i] = (float)(16 * ah + al) * xs;
        }
        reduce_over8<16, 1, 2, 4>(pd, c);
        const unsigned po = (unsigned)WS_PD + (((unsigned)sl * S + (unsigned)t) * 64u + 8u * rsl + c) * 4u;
        *(unsigned*)(ws + po) = pk2(pd[0], pd[1]);
    }
}
template <int PASS>
__device__ __forceinline__ void peer_stream(const Params& p, unsigned char* lds, int lane_w, int sl, int t0, int dt, int n) {
    const unsigned char* ws = p.ws;
    const int lane = lane_w & 63, rsl = lane >> 3, c = lane & 7;
    int eiA[16], eiB[16]; u32x4 rowA[16], rowB[16], auxA[4], auxB[4];
    if (n <= 0) return;
    peer_load_idx(ws, t0, rsl, eiA);
    peer_load_rows<PASS>(ws, t0, sl, rsl, c, eiA, rowA, auxA);
    if (n > 1) peer_load_idx(ws, t0 + dt, rsl, eiB);
    for (int i = 0; i < n; i += 2) {
        const int t = t0 + i * dt;
        if (i + 1 < n) peer_load_rows<PASS>(ws, t + dt, sl, rsl, c, eiB, rowB, auxB);
        if (i + 2 < n) peer_load_idx(ws, t + 2 * dt, rsl, eiA);
        peer_compute<PASS>(p, lds, lane_w, t, sl, rsl, c, rowA, auxA);
        if (i + 1 < n) {
            if (i + 2 < n) peer_load_rows<PASS>(ws, t + 2 * dt, sl, rsl, c, eiA, rowA, auxA);
            if (i + 3 < n) peer_load_idx(ws, t + 3 * dt, rsl, eiB);
            peer_compute<PASS>(p, lds, lane_w, t + dt, sl, rsl, c, rowB, auxB);
        }
    }
}
struct PeerVAux { u32x4 cp; unsigned cs; unsigned xo[4]; };
__device__ __forceinline__ void peerv_load_aux(const unsigned char* ws, int t, int sl, int lane, PeerVAux& a) {
    a.cp = *(const u32x4*)(ws + ((unsigned)WS_CBUF + (unsigned)t * 128u + 16u * (unsigned)(lane & 7)));
    a.cs = *(const unsigned*)(ws + ((unsigned)WS_CSC + (unsigned)t * 4u));
    const unsigned xo = (unsigned)WS_A + ((unsigned)t * (unsigned)D + 256u * sl + (unsigned)lane) * 2u;
    a.xo[0] = *(const bf16_t*)(ws + xo); a.xo[1] = *(const bf16_t*)(ws + (xo + 128u)); a.xo[2] = *(const bf16_t*)(ws + (xo + 256u)); a.xo[3] = *(const bf16_t*)(ws + (xo + 384u));
}
__device__ __forceinline__ void peerv_item(lds_b* img, int lane, const PeerVAux& a, int (&accl)[4], int (&acch)[4]) {
    const unsigned ra = (unsigned)(size_t)img + (unsigned)((lane & 15) * PEER_IMG_PITCH + 8 * (lane >> 4));
#define PEER_TR4(R0, R1, R2, R3, RS) asm volatile("ds_read_b64_tr_b4 %0, %4 offset:%5\n\tds_read_b64_tr_b4 %1, %4 offset:%6\n\tds_read_b64_tr_b4 %2, %4 offset:%7\n\tds_read_b64_tr_b4 %3, %4 offset:%8" \
            : "=&v"(R0), "=&v"(R1), "=&v"(R2), "=&v"(R3) : "v"(ra), "i"((RS) * 16 * PEER_IMG_PITCH), "i"((RS) * 16 * PEER_IMG_PITCH + 32), "i"((RS) * 16 * PEER_IMG_PITCH + 64), "i"((RS) * 16 * PEER_IMG_PITCH + 96) : "memory")
#define PEER_USE4(R0, R1, R2, R3, RS, WAITSTR) do { \
            asm volatile(WAITSTR : "+v"(R0), "+v"(R1), "+v"(R2), "+v"(R3) :: "memory"); \
            const int cl0_ = __builtin_amdgcn_readlane((int)a.cp.x, RS), cl1_ = __builtin_amdgcn_readlane((int)a.cp.y, RS), ch0_ = __builtin_amdgcn_readlane((int)a.cp.z, RS), ch1_ = __builtin_amdgcn_readlane((int)a.cp.w, RS); \
            const unsigned lo4_[4] = {R0.x, R1.x, R2.x, R3.x}, hi4_[4] = {R0.y, R1.y, R2.y, R3.y}; \
            _Pragma("unroll") for (int tcg = 0; tcg < 4; ++tcg) { \
                accl[tcg] = __builtin_amdgcn_sdot8((int)hi4_[tcg], cl1_, __builtin_amdgcn_sdot8((int)lo4_[tcg], cl0_, accl[tcg], false), false); \
                acch[tcg] = __builtin_amdgcn_sdot8((int)hi4_[tcg], ch1_, __builtin_amdgcn_sdot8((int)lo4_[tcg], ch0_, acch[tcg], false), false); } } while (0)
    {
        u32x2 a0, a1, a2, a3, b0, b1, b2, b3;
        PEER_TR4(a0, a1, a2, a3, 0);
        PEER_TR4(b0, b1, b2, b3, 1); PEER_USE4(a0, a1, a2, a3, 0, "s_waitcnt lgkmcnt(4)");
        PEER_TR4(a0, a1, a2, a3, 2); PEER_USE4(b0, b1, b2, b3, 1, "s_waitcnt lgkmcnt(4)");
        PEER_TR4(b0, b1, b2, b3, 3); PEER_USE4(a0, a1, a2, a3, 2, "s_waitcnt lgkmcnt(4)");
        PEER_TR4(a0, a1, a2, a3, 4); PEER_USE4(b0, b1, b2, b3, 3, "s_waitcnt lgkmcnt(4)");
        PEER_TR4(b0, b1, b2, b3, 5); PEER_USE4(a0, a1, a2, a3, 4, "s_waitcnt lgkmcnt(4)");
        PEER_TR4(a0, a1, a2, a3, 6); PEER_USE4(b0, b1, b2, b3, 5, "s_waitcnt lgkmcnt(4)");
        PEER_TR4(b0, b1, b2, b3, 7); PEER_USE4(a0, a1, a2, a3, 6, "s_waitcnt lgkmcnt(4)");
        PEER_USE4(b0, b1, b2, b3, 7, "s_waitcnt lgkmcnt(0)");
    }
#undef PEER_TR4
#undef PEER_USE4
}
__device__ __forceinline__ void peerv_load_rows16(const unsigned char* ws, int sl, int c, const int (&ei)[16], u32x4 (&row)[16]) {
    const unsigned tab = (unsigned)WS_VB + (unsigned)sl * (unsigned)(NEXP * 128) + 16u * (unsigned)c;
#pragma unroll
    for (int i = 0; i < 16; ++i) row[i] = *(const u32x4*)(ws + (tab + (unsigned)ei[i] * 128u));
}
__device__ __forceinline__ void peerv_stream(const Params& p, unsigned char* lds, int tid_, int sl, int t0, int dt, int n) {
    const unsigned char* ws = p.ws;
    const int lane = tid_ & 63, rsl = lane >> 3, c = lane & 7;
    lds_b* img = (lds_b*)lds + (tid_ >> 6) * PEER_IMG_BYTES;
    if (n <= 0) return;
    const __amdgpu_buffer_rsrc_t outr = __builtin_amdgcn_make_buffer_rsrc((void*)p.out, 0, S * D * 4, 0x00020000);
    int ein[16]; u32x4 row[16]; PeerVAux ax, axn;
    peer_load_idx(ws, t0, rsl, ein);
    peerv_load_rows16(ws, sl, c, ein, row); peerv_load_aux(ws, t0, sl, lane, ax);
    if (n > 1) peer_load_idx(ws, t0 + dt, rsl, ein);
    for (int i = 0; i < n; ++i) {
        const int t = t0 + i * dt; const bool more = i + 1 < n;
#pragma unroll
        for (int k = 0; k < 16; ++k) {
            const u32x4 rw = row[k];
            __attribute__((address_space(3))) u32x2* d = (__attribute__((address_space(3))) u32x2*)(img + (16 * rsl + k) * PEER_IMG_PITCH + 16 * c);
            d[0] = (u32x2){rw.x, rw.y}; d[1] = (u32x2){rw.z, rw.w};
        }
        if (more) { peerv_load_rows16(ws, sl, c, ein, row); peerv_load_aux(ws, t + dt, sl, lane, axn); }
        if (i + 2 < n) peer_load_idx(ws, t + 2 * dt, rsl, ein);
        asm volatile("s_waitcnt lgkmcnt(0)" ::: "memory");
        int accl[4] = {0, 0, 0, 0}, acch[4] = {0, 0, 0, 0};
        peerv_item(img, lane, ax, accl, acch);
        const float cs = u2f(ax.cs);
#pragma unroll
        for (int tcg = 0; tcg < 4; ++tcg) {
            const unsigned oo = ((unsigned)t * (unsigned)D + 256u * sl + 64u * tcg + (unsigned)lane) * 4u;
            __builtin_amdgcn_raw_buffer_store_b32(__builtin_bit_cast(unsigned, bf2f(ax.xo[tcg]) + (float)(16 * acch[tcg] + accl[tcg]) * cs), outr, (int)oo, 0, 16);
        }
        if (more) ax = axn;
    }
}
template <int PASS>
__device__ __forceinline__ void ph_peer(const Params& p, unsigned char* lds) {
    const int tid_ = phase_tid();
    const int lane = tid_ & 63, w = tid_ >> 6, b = blockIdx.x, G = gridDim.x;
    if ((G & 7) == 0) {
        const int g = b & 7, nsw = (G >> 3) * 2 * (NTHR / 64), t0 = ((g >> 2) * (G >> 3) + (b >> 3)) * (NTHR / 64) + w;
        if (PASS == 0) peer_stream<0>(p, lds, tid_, g & 3, t0, nsw, t0 < S ? (S - 1 - t0) / nsw + 1 : 0);
        else peerv_stream(p, lds, tid_, g & 3, t0, nsw, t0 < S ? (S - 1 - t0) / nsw + 1 : 0);
    } else {
        const int nw = G * (NTHR / 64), it0 = b * (NTHR / 64) + w;
        for (int it = it0; it < S * 4; it += nw) { if (PASS == 0) peer_stream<0>(p, lds, tid_, it & 3, it >> 2, 0, 1); else peerv_stream(p, lds, tid_, it & 3, it >> 2, 0, 1); }
    }
}
struct CombPre { int ei[8][2]; float sg[8][2]; float rsd[8]; };
__device__ __forceinline__ void ph_peer_combine_pre(const Params& p, unsigned char* lds_raw, CombPre& c) {
    unsigned char* ws = p.ws;
    const int* seli = (const int*)(ws + WS_SELI); const float* selg = (const float*)(ws + WS_SELG); const float* rstd2 = (const float*)(ws + WS_RSTD2);
    const float2* uvsc = (const float2*)(ws + WS_USC);
    const int tid_ = phase_tid(), lane = tid_ & 63, gwave = (blockIdx.x * blockDim.x + tid_) >> 6, nwave = (gridDim.x * blockDim.x) >> 6;
    const int pA = 16 * (lane >> 3) + (lane & 7);
#pragma unroll
    for (int k = 0; k < 8; ++k) {
        const int t = min(gwave + k * nwave, S - 1);
#pragma unroll
        for (int hf = 0; hf < 2; ++hf) { const int e = t * 128 + pA + 8 * hf; c.ei[k][hf] = seli[e]; c.sg[k][hf] = selg[e]; }
        c.rsd[k] = rstd2[t];
    }
    typedef __attribute__((address_space(3))) u32x2 lds_u2;
    static_assert(NEXP * 8 <= 131072 && (NEXP * 8) % (NTHR * 16) == 0, "the de-scale table is staged whole in LDS");
    {
        constexpr int NLD = NEXP * 8 / (NTHR * 16);
        u32x4 tv[NLD];
#pragma unroll
        for (int j = 0; j < NLD; ++j) tv[j] = *((const u32x4*)uvsc + tid_ + NTHR * j);
        __syncthreads();
#pragma unroll
        for (int j = 0; j < NLD; ++j) *((__attribute__((address_space(3))) u32x4*)lds_raw + tid_ + NTHR * j) = tv[j];
        __syncthreads();
    }
}
__device__ __forceinline__ void ph_peer_combine(const Params& p, unsigned char* lds_raw, const CombPre& c) {
    unsigned char* ws = p.ws;
    const int* seli = (const int*)(ws + WS_SELI); const float* selg = (const float*)(ws + WS_SELG); const float* rstd2 = (const float*)(ws + WS_RSTD2);
    const float2* uvsc = (const float2*)(ws + WS_USC);
    const unsigned* pdw = (const unsigned*)(ws + WS_PD);
    unsigned* cpl = (unsigned*)(ws + WS_CBUF); float* csc = (float*)(ws + WS_CSC);
    const int tid_ = phase_tid(), lane = tid_ & 63, gwave = (blockIdx.x * blockDim.x + tid_) >> 6, nwave = (gridDim.x * blockDim.x) >> 6;
    typedef __attribute__((address_space(3))) u32x2 lds_u2;
    const lds_u2* luv = (const lds_u2*)lds_raw;
    const int pA = 16 * (lane >> 3) + (lane & 7);
    constexpr int TT = 8;
    for (int tb = gwave; tb < S; tb += TT * nwave) {
        float dsum[TT][2], sg[TT][2], rsd[TT]; int ei[TT][2];
#pragma unroll
        for (int k = 0; k < TT; ++k) {
            const int t = min(tb + k * nwave, S - 1);
            float d0 = 0.f, d1 = 0.f;
#pragma unroll
            for (int g = 0; g < 4; ++g) { const unsigned w = pdw[((size_t)g * S + t) * 64 + lane]; d0 += bf2f(w & 0xffffu); d1 += u2f(w & 0xffff0000u); }
            dsum[k][0] = d0; dsum[k][1] = d1;
            if (tb == gwave) {
                ei[k][0] = c.ei[k][0]; ei[k][1] = c.ei[k][1]; sg[k][0] = c.sg[k][0]; sg[k][1] = c.sg[k][1]; rsd[k] = c.rsd[k];
            } else {
#pragma unroll
                for (int hf = 0; hf < 2; ++hf) {
                    const int e = t * 128 + pA + 8 * hf;
                    ei[k][hf] = seli[e]; sg[k][hf] = selg[e];
                }
                rsd[k] = rstd2[t];
            }
        }
        float2 sc2[TT][2];
#pragma unroll
        for (int k = 0; k < TT; ++k)
#pragma unroll
            for (int hf = 0; hf < 2; ++hf) { const u32x2 g2 = luv[ei[k][hf]]; sc2[k][hf] = make_float2(u2f(g2.x), u2f(g2.y)); }
#pragma unroll
        for (int k = 0; k < TT; ++k) {
            const int t = tb + k * nwave;
            if (t >= S) break;
            float cf[2];
#pragma unroll
            for (int hf = 0; hf < 2; ++hf) cf[hf] = sg[k][hf] * gelu_tanh(dsum[k][hf] * sc2[k][hf].x * rsd[k]) * sc2[k][hf].y;
            float m = fmaxf(fabsf(cf[0]), fabsf(cf[1]));
#pragma unroll
            for (int o = 1; o < 64; o <<= 1) m = fmaxf(m, __shfl_xor(m, o));
            const float inv = m > 0.f ? 119.0f / m : 0.f;
#pragma unroll
            for (int hf = 0; hf < 2; ++hf) {
                const int q = __float2int_rn(cf[hf] * inv);
                unsigned dl = (unsigned)(q & 15) << (4 * (lane & 7)), dh = (unsigned)(((q + 8) >> 4) & 15) << (4 * (lane & 7));
                dl |= __shfl_xor(dl, 1); dh |= __shfl_xor(dh, 1); dl |= __shfl_xor(dl, 2); dh |= __shfl_xor(dh, 2); dl |= __shfl_xor(dl, 4); dh |= __shfl_xor(dh, 4);
                if ((lane & 7) == 0) {
                    const int dk = 2 * (lane >> 3) + hf, rs = dk >> 1, half = dk & 1;
                    cpl[(size_t)t * 32 + 4 * rs + half] = dl; cpl[(size_t)t * 32 + 4 * rs + 2 + half] = dh;
                }
            }
            if (lane == 0) csc[t] = m * (1.0f / 119.0f);
        }
    }
}

#define LAS __attribute__((address_space(3)))
#define XB_TMO      128
#define XB_XCNT(j)  (256  + 64 * (j))
#define XB_XSUB(j)  (1280 + 64 * (j))
#define XB_XGEN(j)  (2304 + 64 * (j))
#define XB_TOP      3328
#define XB_TOPGEN   3392
#define XCD_BAR_WORDS 3456
#define XB_SPIN_CAP (1u << 18)
__device__ __forceinline__ unsigned xb_ld(unsigned* p)              { return __hip_atomic_load(p, __ATOMIC_RELAXED, __HIP_MEMORY_SCOPE_AGENT); }
__device__ __forceinline__ unsigned xb_add(unsigned* p, unsigned v) { return __hip_atomic_fetch_add(p, v, __ATOMIC_RELAXED, __HIP_MEMORY_SCOPE_AGENT); }
__device__ __forceinline__ unsigned xb_xcc_id() { return (unsigned)__builtin_amdgcn_s_getreg((3 << 11) | 20) & 0xFu; }
#define XB_SPIN(cond, bar) do { unsigned _sp = 0; while (cond) { __builtin_amdgcn_s_sleep(1); \
    if ((++_sp & 255u) == 0u) { if (xb_ld(&(bar)[XB_TMO])) break; if (_sp > XB_SPIN_CAP) { atomicAdd(&(bar)[XB_TMO], 1u); break; } } } } while (0)
struct XcdBarrier { unsigned* bar; unsigned x; volatile LAS unsigned* st; };
__device__ __forceinline__ XcdBarrier xcd_barrier_post(unsigned* bar, volatile LAS unsigned* st) {
    XcdBarrier b; b.bar = bar; b.x = xb_xcc_id(); b.st = st;
    if (threadIdx.x == 0) (void)xb_add(&bar[XB_XCNT(b.x)], 1u);
    return b;
}
__device__ __forceinline__ void xcd_barrier_complete(unsigned* bar, unsigned x, unsigned& nloc, unsigned& nx) {
    const unsigned G = gridDim.x * gridDim.y * gridDim.z;
    unsigned sum, cnt, mine, sp = 0u;
    for (;;) {
        sum = 0u; cnt = 0u; mine = 0u;
#pragma unroll
        for (unsigned j = 0; j < 16; ++j) { const unsigned c = xb_ld(&bar[XB_XCNT(j)]); sum += c; cnt += (c > 0u) ? 1u : 0u; mine = (j == x) ? c : mine; }
        if (sum == G) break;
        __builtin_amdgcn_s_sleep(1);
        if ((++sp & 255u) == 0u) { if (xb_ld(&bar[XB_TMO])) break; if (sp > XB_SPIN_CAP) { atomicAdd(&bar[XB_TMO], 1u); break; } }
    }
    nloc = mine > 0u ? mine : 1u; nx = cnt > 0u ? cnt : 1u;
}
__device__ __forceinline__ void xcd_barrier(const XcdBarrier& b) {
    asm volatile("s_waitcnt vmcnt(0)" ::: "memory");
    __syncthreads();
    if (threadIdx.x == 0) {
        unsigned* bar = b.bar;
        __builtin_amdgcn_s_waitcnt(0);
        unsigned nloc = b.st[0], nx = b.st[1];
        if (nloc == 0u) { xcd_barrier_complete(bar, b.x, nloc, nx); b.st[0] = nloc; b.st[1] = nx; }
        const unsigned old = xb_add(&bar[XB_XSUB(b.x)], 1u);
        const unsigned gen = old / nloc;
        if (old + 1u == (gen + 1u) * nloc) {
            __builtin_amdgcn_fence(__ATOMIC_RELEASE, "agent");
            asm volatile("s_waitcnt vmcnt(0)" ::: "memory");
            const unsigned og = xb_add(&bar[XB_TOP], 1u);
            const unsigned tg = og / nx;
            if (og + 1u == (tg + 1u) * nx) xb_add(&bar[XB_TOPGEN], 1u);
            else XB_SPIN(xb_ld(&bar[XB_TOPGEN]) == tg, bar);
            __builtin_amdgcn_fence(__ATOMIC_ACQUIRE, "agent");
            xb_add(&bar[XB_XGEN(b.x)], 1u);
            asm volatile("s_waitcnt vmcnt(0)" ::: "memory");
        } else {
            XB_SPIN(xb_ld(&bar[XB_XGEN(b.x)]) <= gen, bar);
            __builtin_amdgcn_fence(__ATOMIC_ACQUIRE, "agent");
            asm volatile("s_waitcnt vmcnt(0)" ::: "memory");
        }
    }
    __syncthreads();
}

__device__ __forceinline__ void xcd_barrier_wait_inloop(const XcdBarrier& b) {
    if (threadIdx.x == 0) {
        unsigned* bar = b.bar;
        const unsigned gen = b.st[3];
        XB_SPIN(xb_ld(&bar[XB_TOPGEN]) <= gen, bar);
        __builtin_amdgcn_fence(__ATOMIC_ACQUIRE, "agent");
        if (b.st[2]) xb_add(&bar[XB_XGEN(b.x)], 1u);
        asm volatile("s_waitcnt vmcnt(0)" ::: "memory");
    }
    asm volatile("" ::: "memory");
    __builtin_amdgcn_s_barrier();
    asm volatile("" ::: "memory");
    __builtin_amdgcn_sched_barrier(0);
}
__device__ __forceinline__ void ph_prep_wq(const Params& p, unsigned char* lds, int cw, int ncw) {
    const int tid_ = phase_tid(), lane = tid_ & 63;
    float* scr = (float*)lds + (tid_ >> 6) * (64 * 33);
    constexpr int I_Q = (D / 64) * (NQ / 32);
    for (int it = cw; it < I_Q; it += ncw) prep_transpose_item<false>(p.in[I_PEER_WQ], p.in[I_NORM_FFN], nullptr, D, NQ, (bf16_t*)(p.ws + WS_WQT), scr, it, lane);
}
__device__ __forceinline__ void xcd_barrier_arrive(const XcdBarrier& b) {
    asm volatile("s_waitcnt vmcnt(0)" ::: "memory");
    __syncthreads();
    if (threadIdx.x == 0) {
        unsigned* bar = b.bar;
        __builtin_amdgcn_s_waitcnt(0);
        unsigned nloc = b.st[0], nx = b.st[1];
        if (nloc == 0u) { xcd_barrier_complete(bar, b.x, nloc, nx); b.st[0] = nloc; b.st[1] = nx; }
        const unsigned old = xb_add(&bar[XB_XSUB(b.x)], 1u);
        const unsigned gen = old / nloc;
        unsigned lead = 0u;
        if (old + 1u == (gen + 1u) * nloc) {
            __builtin_amdgcn_fence(__ATOMIC_RELEASE, "agent");
            asm volatile("s_waitcnt vmcnt(0)" ::: "memory");
            const unsigned og = xb_add(&bar[XB_TOP], 1u);
            const unsigned tg = og / nx;
            if (og + 1u == (tg + 1u) * nx) xb_add(&bar[XB_TOPGEN], 1u);
            lead = 1u;
        }
        b.st[2] = lead; b.st[3] = gen;
    }
}
__device__ __forceinline__ void xcd_barrier_wait(const XcdBarrier& b) {
    if (threadIdx.x == 0) {
        unsigned* bar = b.bar;
        const unsigned gen = b.st[3];
        XB_SPIN(xb_ld(&bar[XB_TOPGEN]) <= gen, bar);
        __builtin_amdgcn_fence(__ATOMIC_ACQUIRE, "agent");
        if (b.st[2]) xb_add(&bar[XB_XGEN(b.x)], 1u);
        asm volatile("s_waitcnt vmcnt(0)" ::: "memory");
    }
    __syncthreads();
}

constexpr int LDS_MISC = 158720;
constexpr int LDS_BYTES = LDS_MISC + 1024;

__global__ void __launch_bounds__(NTHR, 2) hymba_fwd(Params p) {
    extern __shared__ __attribute__((aligned(16))) unsigned char lds[];
    volatile LAS unsigned* misc = (volatile LAS unsigned*)((LAS unsigned char*)lds + LDS_MISC);
    if (threadIdx.x < 4) misc[threadIdx.x] = 0u;
    __syncthreads();
    XcdBarrier bar = xcd_barrier_post((unsigned*)(p.ws + WS_CTL), misc);

    PG8_LAS unsigned char* ring = (PG8_LAS unsigned char*)lds;
    unsigned char* ws = p.ws;
    const bool late_q = ((S / 256) * (NPROJ / 256)) % (int)gridDim.x != 0;
    ph_prep(p, lds, late_q);                  xcd_barrier_arrive(bar);
    {
        pg8::Gemm g{(const bf16_t*)(ws + WS_A), (const bf16_t*)(ws + WS_WINT), S, NPROJ, D}; RevOrder so; so.init_rev(S, NPROJ, (int)gridDim.x, (int)blockIdx.x);
        EpiInProj E{(const float*)(ws + WS_RSTD1), p.in[I_Q_NORM], p.in[I_K_NORM], (bf16_t*)(ws + WS_QH), (bf16_t*)(ws + WS_KH), (bf16_t*)(ws + WS_VH), (bf16_t*)(ws + WS_XRG), (bf16_t*)(ws + WS_GG)};
        const int G = (int)gridDim.x, nunits = (S / 256) * (NPROJ / 256), rem = nunits % G, b = (int)blockIdx.x;
        const int tid_ = phase_tid(), w = tid_ >> 6, lane = tid_ & 63;
        if (rem == 0) ph_tables(p, b * (NTHR / 64) + w, G * (NTHR / 64), lane);
        else if (b >= rem) { ph_prep_wq(p, lds, (b - rem) * (NTHR / 64) + w, (G - rem) * (NTHR / 64)); ph_tables(p, (b - rem) * (NTHR / 64) + w, (G - rem) * (NTHR / 64), lane); }
        xcd_barrier_wait(bar);
        pg8::gemm_phase<EpiInProj, RevOrder, true, true>(ring, g, so, E);
    }
    xcd_barrier_arrive(bar); rg0_consts(p, lds); xcd_barrier_wait(bar);
    uint2 gwp[16];
    ph_attn(p); ph_rg<0>(p, lds, gwp);        xcd_barrier_arrive(bar);
    rg1_prefetch(p, (int)blockIdx.x, gwp);    xcd_barrier_wait(bar);
    ph_rg<1>(p, lds, gwp);                    xcd_barrier_arrive(bar);
    {
        pg8::Gemm g{(const bf16_t*)(ws + WS_MIX), (const bf16_t*)(ws + WS_WOUTT), S, D, D}; pg8::StaticOrder so; so.init(S, D, (int)gridDim.x, (int)blockIdx.x);
        EpiOutProj E{(const float*)(ws + WS_RSB), p.in[I_X], (bf16_t*)(ws + WS_A), (float*)(ws + WS_SSQ), ws + WS_X1Q, (float*)(ws + WS_XSC), &bar};
        pg8::gemm_phase<EpiOutProj, pg8::StaticOrder, true, true>(ring, g, so, E);
    }
    const bool pair = (int)gridDim.x == (S / 256) * (D / 256);
    xcd_barrier_arrive(bar);
    if (!pair) xcd_barrier_wait(bar);
    {
        PeerOrder so; so.init_peer(S, NQ, (int)gridDim.x, (int)blockIdx.x, pair);
        pg8::Gemm g{(const bf16_t*)(ws + WS_A), (const bf16_t*)(ws + WS_WQT), S, NQ, D, pair ? 4 * so.pn0 : 0};
        EpiPeerQ E{(bf16_t*)(ws + WS_B), &bar, pair};
        pg8::gemm_phase<EpiPeerQ, PeerOrder, true, true>(ring, g, so, E);
    }
    asm volatile("s_waitcnt vmcnt(0)" ::: "memory"); __syncthreads();
    ph_topk(p, (int*)lds);                    xcd_barrier(bar);
    ph_peer<0>(p, lds);                       xcd_barrier_arrive(bar);
    CombPre cpre; ph_peer_combine_pre(p, lds, cpre); xcd_barrier_wait(bar);
    ph_peer_combine(p, lds, cpre);            xcd_barrier(bar);
    ph_peer<1>(p, lds);
}

extern "C" void kernel_launch(void* const* d_in, const int* in_sizes, int n_in, void* d_out, int out_size, void* d_ws, size_t ws_size, hipStream_t stream) {
    static int grid = 0;
    if (grid == 0) {
        if (n_in != 20 || out_size != S * D || ws_size < WS_END) { fprintf(stderr, "kernel_launch: unexpected shapes (n_in %d out %d ws %zu)\n", n_in, out_size, ws_size); grid = -1; return; }
        int dev = 0, cus = 0, per_cu = 0;
        if (hipGetDevice(&dev) != hipSuccess || hipDeviceGetAttribute(&cus, hipDeviceAttributeMultiprocessorCount, dev) != hipSuccess) { grid = -1; return; }
        if (hipFuncSetAttribute((const void*)hymba_fwd, hipFuncAttributeMaxDynamicSharedMemorySize, LDS_BYTES) != hipSuccess) { fprintf(stderr, "kernel_launch: hipFuncSetAttribute failed\n"); grid = -1; return; }
        if (hipOccupancyMaxActiveBlocksPerMultiprocessor(&per_cu, (const void*)hymba_fwd, NTHR, LDS_BYTES) != hipSuccess || per_cu < 1) { fprintf(stderr, "kernel_launch: occupancy query says %d blocks per CU\n", per_cu); grid = -1; return; }
        (void)hipGetLastError();
        grid = cus;
    }
    if (grid < 0) return;
    (void)hipMemsetAsync((char*)d_ws + WS_CTL, 0, (CTL_RGCNT + NCHUNK / RG_GRP) * 4, stream);
    Params p{};
    for (int i = 0; i < 20; ++i) p.in[i] = (const float*)d_in[i];
    p.out = (float*)d_out; p.ws = (unsigned char*)d_ws;
    hipLaunchKernelGGL(hymba_fwd, dim3(grid), dim3(NTHR), LDS_BYTES, stream, p);
}
```
